# Optimizing an MI355X kernel written in HIP

```python
import math
import jax, jax.numpy as jnp
from jax import lax
import numpy as np

D_MODEL = 1024
BATCH = 8
SEQ = 4096
DEPTH = 2

CTX_LEN = 256
GRID_W = 64
F32 = jnp.float32
NORM_EPS = 1e-6

N_BRANCH = 4
BRANCH_W = D_MODEL // N_BRANCH

A_HD = 64
A_HEADS = BRANCH_W // A_HD
A_W = A_HEADS * A_HD
A_DECAY_R = 32
A_AAA_R = 32
A_GATE_R = 64
A_GN_EPS = 64e-5
A_COLS = (A_W, A_W, A_W, A_DECAY_R, A_DECAY_R, A_AAA_R, A_AAA_R, A_GATE_R)
A_IN = sum(A_COLS)

B_DK = 64
B_DV = 64
B_HEADS = BRANCH_W // B_DV
B_QK = B_HEADS * B_DK
B_VW = B_HEADS * B_DV
B_CONV = 7
B_CHUNK = 64
B_COLS = (B_QK, B_QK, B_VW, B_HEADS, B_HEADS, B_HEADS, B_HEADS, B_VW)
B_IN = sum(B_COLS)

C_DV = 64
C_HEADS = BRANCH_W // C_DV
C_DK = C_DV // 2
C_QK = C_HEADS * C_DK
C_VW = C_HEADS * C_DV
C_GATE_R = 16
C_GATE_NORM = 16.0
C_CHUNK = 64
C_COLS = (C_QK, C_QK, C_VW, C_GATE_R, C_GATE_R, C_VW)
C_IN = sum(C_COLS)

D_HD = 64
D_HEADS = BRANCH_W // D_HD
D_KV_HEADS = 2
WINDOW = 128
BLOCK = 128
ROPE_BASE = 10000.0
D_COLS = (D_HEADS * D_HD, D_KV_HEADS * D_HD, D_KV_HEADS * D_HD)
D_IN = sum(D_COLS)

MIXER_COLS = (A_IN, B_IN, C_IN, D_IN, N_BRANCH * D_MODEL)
IN_WIDTH = sum(MIXER_COLS)
FFN_HIDDEN = ((8 * D_MODEL + 3 * 256 - 1) // (3 * 256)) * 256

kernel_name = 'hybrid_flow_block'


def _split(t, sizes):
    cuts, acc = [], 0
    for s in sizes[:-1]:
        acc += s
        cuts.append(acc)
    return jnp.split(t, cuts, axis=-1)


def _rms(x, g, eps=NORM_EPS):
    xf = x.astype(F32)
    y = xf * lax.rsqrt(jnp.mean(xf * xf, axis=-1, keepdims=True) + eps)
    return y * g.astype(F32)


def _l2norm(x):
    return x * lax.rsqrt(jnp.sum(x * x, axis=-1, keepdims=True) + 1e-6)


def _centred_shift(x):
    xp = jnp.pad(x, ((0, 0), (1, 1), (0, 0)))
    return 0.5 * (xp[:, :-2] + xp[:, 2:])


def _centred_dwconv(x, w):
    k = w.shape[0]
    return lax.conv_general_dilated(x, w[:, None, :].astype(x.dtype), window_strides=(1,),
                                    padding=[(k // 2, k // 2)], dimension_numbers=('NWC', 'WIO', 'NWC'),
                                    feature_group_count=x.shape[-1])


def _to_chunks(t, c):
    b, n = t.shape[:2]
    return jnp.swapaxes(t.reshape(b, n // c, c, *t.shape[2:]), 2, 3)


def _from_chunks(t):
    t = jnp.swapaxes(t, 2, 3)
    return t.reshape(t.shape[0], -1, *t.shape[3:])


def _dir_fn(d):
    return (lambda t: jnp.flip(t, axis=1)) if d == 1 else (lambda t: t)


def _rwkv7_inputs(p, mu, w0, w2, a0, a2, g2, k_k, k_a):
    b, t, _ = p.shape
    xm = p + (_centred_shift(p) - p) * mu
    r, k, v, xwf, xwb, xaf, xab, xg = _split(xm, A_COLS)
    hd = lambda z: z.reshape(b, t, A_HEADS, A_HD)
    gate = jax.nn.sigmoid(xg) @ g2
    kk = _l2norm(hd(k * k_k))
    dirs = []
    for d, (xw, xa) in enumerate(((xwf, xaf), (xwb, xab))):
        w_raw = w0[d] + jnp.tanh(xw) @ w2[d]
        decay = jnp.exp(-jnp.exp(-jax.nn.softplus(-w_raw) - 0.5))
        a = jax.nn.sigmoid(a0[d] + xa @ a2[d])
        kd = k * (1.0 + (a - 1.0) * k_a)
        dirs.append((hd(decay), hd(kd), hd(a)))
    return hd(r), hd(v), kk, gate, dirs


def _rwkv7_scan(inputs, d, s0, reverse):
    r, v, kk, _, dirs = inputs
    decay, kd, a = dirs[d]

    def step(s, inp):
        r_t, w_t, k_t, v_t, kk_t, a_t = inp
        sa = jnp.einsum('bhvk,bhk->bhv', s, kk_t)
        s = (s * w_t[:, :, None, :] - sa[..., None] * (kk_t * a_t)[:, :, None, :]
             + v_t[..., None] * k_t[:, :, None, :])
        return s, jnp.einsum('bhvk,bhk->bhv', s, r_t)

    xs = tuple(jnp.moveaxis(z, 1, 0) for z in (r, decay, kd, v, kk, a))
    s, y = lax.scan(step, s0, xs, reverse=reverse)
    return s, jnp.moveaxis(y, 0, 1)


def _rwkv7_output(y, inputs, r_k, ln_g, ln_b):
    r, v, _, gate, dirs = inputs
    b, t = y.shape[:2]
    mean = jnp.mean(y, axis=-1, keepdims=True)
    var = jnp.mean(jnp.square(y - mean), axis=-1, keepdims=True)
    yn = ((y - mean) * lax.rsqrt(var + A_GN_EPS)).reshape(b, t, A_W) * ln_g + ln_b
    bonus = sum(jnp.sum(r * kd * r_k, axis=-1, keepdims=True) * v for (_, kd, _) in dirs)
    return (yn + bonus.reshape(b, t, A_W)) * gate


def _rwkv7_mixer(pa, ca, mu, w0, w2, a0, a2, g2, k_k, k_a, r_k, ln_g, ln_b, with_ctx):
    lat = _rwkv7_inputs(pa, mu, w0, w2, a0, a2, g2, k_k, k_a)
    ctx = _rwkv7_inputs(ca, mu, w0, w2, a0, a2, g2, k_k, k_a)
    y_lat, y_ctx = 0.0, 0.0
    for d in range(2):
        s0 = jnp.zeros((pa.shape[0], A_HEADS, A_HD, A_HD), F32)
        s_c, yc = _rwkv7_scan(ctx, d, s0, d == 1)
        _, yl = _rwkv7_scan(lat, d, s_c, d == 1)
        y_lat, y_ctx = y_lat + yl, y_ctx + yc
    out = _rwkv7_output(y_lat, lat, r_k, ln_g, ln_b)
    out_c = _rwkv7_output(y_ctx, ctx, r_k, ln_g, ln_b) if with_ctx else None
    return out, out_c


def _gdn_inputs(p, conv_w, a_log, dt_bias):
    b, t, _ = p.shape
    q, k, v, bf, bb, af, ab, g = _split(p, B_COLS)
    qkv = jax.nn.silu(_centred_dwconv(jnp.concatenate([q, k, v], axis=-1), conv_w))
    q, k, v = _split(qkv, (B_QK, B_QK, B_VW))
    q = _l2norm(q.reshape(b, t, B_HEADS, B_DK)) * (B_DK ** -0.5)
    k = _l2norm(k.reshape(b, t, B_HEADS, B_DK))
    v = v.reshape(b, t, B_HEADS, B_DV)
    dirs = []
    for d, (bx, ax) in enumerate(((bf, af), (bb, ab))):
        beta = jax.nn.sigmoid(bx)
        log_decay = -jnp.exp(a_log[d]) * jax.nn.softplus(ax + dt_bias[d])
        dirs.append((beta, log_decay))
    return q, k, v, g, dirs


def _gdn_chunked(q, k, v, beta, g, s0):
    c = B_CHUNK
    q, k, v = _to_chunks(q, c), _to_chunks(k, c), _to_chunks(v, c)
    beta, g = _to_chunks(beta, c), _to_chunks(g, c)
    gc = jnp.cumsum(g, axis=-1)
    causal = jnp.tril(jnp.ones((c, c), bool))
    strict = jnp.tril(jnp.ones((c, c), bool), -1)
    decay = jnp.exp(jnp.where(causal, gc[..., :, None] - gc[..., None, :], -jnp.inf))
    lmat = jnp.where(strict, beta[..., :, None] * jnp.einsum('bnhid,bnhjd->bnhij', k, k) * decay, 0.0)
    m = lmat + jnp.eye(c, dtype=F32)
    u = lax.linalg.triangular_solve(m, v * beta[..., None], left_side=True, lower=True, unit_diagonal=True)
    w = lax.linalg.triangular_solve(m, k * (beta * jnp.exp(gc))[..., None], left_side=True, lower=True,
                                    unit_diagonal=True)
    attn = jnp.einsum('bnhid,bnhjd->bnhij', q, k) * decay
    q_in = q * jnp.exp(gc)[..., None]
    k_st = k * jnp.exp(gc[..., -1:] - gc)[..., None]
    dec_last = jnp.exp(gc[..., -1])

    def step(s, inp):
        qi, ki, ui, wi, ai, di = inp
        v_new = ui - jnp.einsum('bhcd,bhde->bhce', wi, s)
        o = jnp.einsum('bhcd,bhde->bhce', qi, s) + jnp.einsum('bhij,bhje->bhie', ai, v_new)
        s = s * di[..., None, None] + jnp.einsum('bhcd,bhce->bhde', ki, v_new)
        return s, o

    xs = tuple(jnp.moveaxis(z, 1, 0) for z in (q_in, k_st, u, w, attn, dec_last))
    s, o = lax.scan(step, s0, xs)
    return s, _from_chunks(jnp.moveaxis(o, 0, 1))


def _gdn_mixer(pb, cb, conv_w, a_log, dt_bias, norm_g, with_ctx):
    lat = _gdn_inputs(pb, conv_w, a_log, dt_bias)
    ctx = _gdn_inputs(cb, conv_w, a_log, dt_bias)
    y_lat, y_ctx = 0.0, 0.0
    for d in range(2):
        f = _dir_fn(d)
        s0 = jnp.zeros((pb.shape[0], B_HEADS, B_DK, B_DV), F32)
        s_c, oc = _gdn_chunked(f(ctx[0]), f(ctx[1]), f(ctx[2]), f(ctx[4][d][0]), f(ctx[4][d][1]), s0)
        _, ol = _gdn_chunked(f(lat[0]), f(lat[1]), f(lat[2]), f(lat[4][d][0]), f(lat[4][d][1]), s_c)
        y_lat, y_ctx = y_lat + f(ol), y_ctx + f(oc)

    def finish(y, gate):
        b, t = y.shape[:2]
        return (_rms(y, norm_g) * jax.nn.silu(gate.reshape(b, t, B_HEADS, B_DV))).reshape(b, t, B_VW)

    return finish(y_lat, lat[3]), (finish(y_ctx, ctx[3]) if with_ctx else None)


def _gla_inputs(p, gw2, gb):
    b, t, _ = p.shape
    q, k, v, gf, gbk, g = _split(p, C_COLS)
    q = q.reshape(b, t, C_HEADS, C_DK) * (C_DK ** -0.5)
    k = k.reshape(b, t, C_HEADS, C_DK)
    v = v.reshape(b, t, C_HEADS, C_DV)
    logg = [(jax.nn.log_sigmoid(xg @ gw2[d] + gb[d]) / C_GATE_NORM).reshape(b, t, C_HEADS, C_DK)
            for d, xg in enumerate((gf, gbk))]
    return q, k, v, g, logg


def _gla_chunked(q, k, v, lg, s0):
    c = C_CHUNK
    q, k, v, lg = (_to_chunks(z, c) for z in (q, k, v, lg))
    bcum = jnp.cumsum(lg, axis=3)
    ref = bcum[:, :, :, c // 2:c // 2 + 1]
    causal = jnp.tril(jnp.ones((c, c), bool))
    a = jnp.einsum('bnhid,bnhjd->bnhij', q * jnp.exp(bcum - ref), k * jnp.exp(ref - bcum))
    o_intra = jnp.einsum('bnhij,bnhje->bnhie', jnp.where(causal, a, 0.0), v)
    b_last = bcum[:, :, :, -1:]
    q_in = q * jnp.exp(bcum)
    k_st = k * jnp.exp(b_last - bcum)
    dec_last = jnp.exp(b_last[:, :, :, 0])

    def step(s, inp):
        qi, ki, vi, di = inp
        o = jnp.einsum('bhcd,bhde->bhce', qi, s)
        s = s * di[..., None] + jnp.einsum('bhcd,bhce->bhde', ki, vi)
        return s, o

    xs = tuple(jnp.moveaxis(z, 1, 0) for z in (q_in, k_st, v, dec_last))
    s, o_inter = lax.scan(step, s0, xs)
    return s, _from_chunks(o_intra + jnp.moveaxis(o_inter, 0, 1))


def _gla_mixer(pc, cc, gw2, gb, norm_g, with_ctx):
    lat = _gla_inputs(pc, gw2, gb)
    ctx = _gla_inputs(cc, gw2, gb)
    y_lat, y_ctx = 0.0, 0.0
    for d in range(2):
        f = _dir_fn(d)
        s0 = jnp.zeros((pc.shape[0], C_HEADS, C_DK, C_DV), F32)
        s_c, oc = _gla_chunked(f(ctx[0]), f(ctx[1]), f(ctx[2]), f(ctx[4][d]), s0)
        _, ol = _gla_chunked(f(lat[0]), f(lat[1]), f(lat[2]), f(lat[4][d]), s_c)
        y_lat, y_ctx = y_lat + f(ol), y_ctx + f(oc)

    def finish(y, gate):
        b, t = y.shape[:2]
        return (_rms(y, norm_g) * jax.nn.silu(gate.reshape(b, t, C_HEADS, C_DV))).reshape(b, t, C_VW)

    return finish(y_lat, lat[3]), (finish(y_ctx, ctx[3]) if with_ctx else None)


def _axial_rope(x, rows, cols):
    half = x.shape[-1] // 2
    quarter = half // 2
    inv = ROPE_BASE ** (-jnp.arange(quarter, dtype=F32) / quarter)

    def rot(xa, pos):
        ang = pos[:, None] * inv[None, :]
        cos, sin = jnp.cos(ang)[None, :, None, :], jnp.sin(ang)[None, :, None, :]
        x1, x2 = xa[..., :quarter], xa[..., quarter:]
        return jnp.concatenate([x1 * cos - x2 * sin, x1 * sin + x2 * cos], axis=-1)

    return jnp.concatenate([rot(x[..., :half], rows), rot(x[..., half:], cols)], axis=-1)


def _window_attention(q, k, v, kc, vc, sink):
    b, s, h, hd = q.shape
    nb, grp, lc = s // BLOCK, h // D_KV_HEADS, kc.shape[1]
    scale = hd ** -0.5
    qb = q.reshape(b, nb, BLOCK, D_KV_HEADS, grp, hd)

    def band(t):
        tp = jnp.pad(t, ((0, 0), (BLOCK, BLOCK), (0, 0), (0, 0)))
        return jnp.concatenate([tp[:, o:o + s].reshape(b, nb, BLOCK, D_KV_HEADS, hd)
                                for o in (0, BLOCK, 2 * BLOCK)], axis=2)

    kb, vb = band(k), band(v)
    qpos = jnp.arange(s).reshape(nb, BLOCK)
    kpos = (jnp.arange(nb) * BLOCK - BLOCK)[:, None] + jnp.arange(3 * BLOCK)[None, :]
    valid = ((jnp.abs(qpos[:, :, None] - kpos[:, None, :]) <= WINDOW)
             & (kpos >= 0)[:, None, :] & (kpos < s)[:, None, :])
    s_loc = jnp.einsum('bnqhgd,bnkhd->bnhgqk', qb, kb) * scale
    s_loc = jnp.where(valid[None, :, None, None], s_loc, -jnp.inf)
    s_ctx = jnp.einsum('bnqhgd,bkhd->bnhgqk', qb, kc) * scale
    sink_col = jnp.broadcast_to(sink.reshape(D_KV_HEADS, grp)[:, :, None, None], s_ctx.shape[:-1] + (1,))
    prob = jax.nn.softmax(jnp.concatenate([s_ctx, s_loc, sink_col], axis=-1), axis=-1)
    o = (jnp.einsum('bnhgqk,bkhd->bnqhgd', prob[..., :lc], vc)
         + jnp.einsum('bnhgqk,bnkhd->bnqhgd', prob[..., lc:lc + 3 * BLOCK], vb))
    return o.reshape(b, s, h * hd)


def _context_attention(qc, kc, vc, sink):
    b, lc, h, hd = qc.shape
    grp = h // D_KV_HEADS
    qg = qc.reshape(b, lc, D_KV_HEADS, grp, hd)
    sc = jnp.einsum('bqhgd,bkhd->bhgqk', qg, kc) * (hd ** -0.5)
    sink_col = jnp.broadcast_to(sink.reshape(D_KV_HEADS, grp)[:, :, None, None], sc.shape[:-1] + (1,))
    prob = jax.nn.softmax(jnp.concatenate([sc, sink_col], axis=-1), axis=-1)
    return jnp.einsum('bhgqk,bkhd->bqhgd', prob[..., :lc], vc).reshape(b, lc, h * hd)


def _attn_mixer(pd, cd, sink, rows, cols, with_ctx):
    def heads(p):
        b, t, _ = p.shape
        q, k, v = _split(p, D_COLS)
        return (q.reshape(b, t, D_HEADS, D_HD), k.reshape(b, t, D_KV_HEADS, D_HD),
                v.reshape(b, t, D_KV_HEADS, D_HD))

    q, k, v = heads(pd)
    qc, kc, vc = heads(cd)
    q, k = _axial_rope(q, rows, cols), _axial_rope(k, rows, cols)
    sink = sink.astype(F32)
    y = _window_attention(q, k, v, kc, vc, sink)
    yc = _context_attention(qc, kc, vc, sink) if with_ctx else None
    return y, yc


def _merge(ys, gate_pre, gate_b, w_branch, w_out):
    acc = 0.0
    for i, y in enumerate(ys):
        g = jax.nn.sigmoid(gate_pre[..., i * D_MODEL:(i + 1) * D_MODEL] + gate_b[i])
        acc = acc + g * (y @ w_branch[i])
    return acc @ w_out


def _mixer_block(h, hc, w_in, gate_b, w_branch, w_out,
                 rwkv_mu, rwkv_w0, rwkv_w2, rwkv_a0, rwkv_a2, rwkv_g2, rwkv_kk, rwkv_ka, rwkv_rk,
                 rwkv_ln_g, rwkv_ln_b, gdn_conv, gdn_a_log, gdn_dt_bias, gdn_norm_g,
                 gla_gw2, gla_gb, gla_norm_g, attn_sink, rows, cols, with_ctx):
    p = (h @ w_in).astype(F32)
    pc = (hc @ w_in).astype(F32)
    pa, pb, pg, pd, gl = _split(p, MIXER_COLS)
    ca, cb, cg, cd, gcx = _split(pc, MIXER_COLS)
    ya, yac = _rwkv7_mixer(pa, ca, rwkv_mu, rwkv_w0, rwkv_w2, rwkv_a0, rwkv_a2, rwkv_g2, rwkv_kk, rwkv_ka,
                           rwkv_rk, rwkv_ln_g, rwkv_ln_b, with_ctx)
    yb, ybc = _gdn_mixer(pb, cb, gdn_conv, gdn_a_log, gdn_dt_bias, gdn_norm_g, with_ctx)
    yg, ygc = _gla_mixer(pg, cg, gla_gw2, gla_gb, gla_norm_g, with_ctx)
    yd, ydc = _attn_mixer(pd, cd, attn_sink, rows, cols, with_ctx)
    out = _merge((ya, yb, yg, yd), gl, gate_b, w_branch, w_out)
    out_c = _merge((yac, ybc, ygc, ydc), gcx, gate_b, w_branch, w_out) if with_ctx else None
    return out, out_c


def _swiglu(h, w1, w2):
    gt, up = jnp.split(h @ w1, 2, axis=-1)
    return (jax.nn.silu(gt) * up) @ w2


def setup_inputs(seed: int = 0) -> dict:
    key = jax.random.key(seed)
    ks = iter(jax.random.split(key, 48))
    nrm = lambda shape, s: jax.random.normal(next(ks), shape, F32) * s
    L = DEPTH
    dt = jnp.exp(jax.random.uniform(next(ks), (L, 2, B_HEADS), F32, math.log(1e-3), math.log(1e-1)))
    return {
        'x': nrm((BATCH, SEQ, D_MODEL), 1.0),
        'c': nrm((BATCH, D_MODEL), 1.0),
        'ctx': nrm((BATCH, CTX_LEN, D_MODEL), 1.0),
        'c_ctx': nrm((D_MODEL,), 1.0),
        'ada_w': nrm((L, D_MODEL, 6 * D_MODEL), 0.5 * D_MODEL ** -0.5),
        'ada_b': nrm((L, 6 * D_MODEL), 0.01),
        'norm_g': 1.0 + nrm((L, 4, D_MODEL), 0.02),
        'w_in': nrm((L, D_MODEL, IN_WIDTH), D_MODEL ** -0.5),
        'gate_b': nrm((L, N_BRANCH, D_MODEL), 0.01),
        'w_branch': nrm((L, N_BRANCH, BRANCH_W, D_MODEL), BRANCH_W ** -0.5),
        'w_out': nrm((L, D_MODEL, D_MODEL), D_MODEL ** -0.5),
        'rwkv_mu': jax.random.uniform(next(ks), (L, A_IN), F32),
        'rwkv_w0': nrm((L, 2, A_W), 0.5),
        'rwkv_w2': nrm((L, 2, A_DECAY_R, A_W), A_DECAY_R ** -0.5),
        'rwkv_a0': nrm((L, 2, A_W), 0.5),
        'rwkv_a2': nrm((L, 2, A_AAA_R, A_W), A_AAA_R ** -0.5),
        'rwkv_g2': nrm((L, A_GATE_R, A_W), A_GATE_R ** -0.5),
        'rwkv_kk': 0.85 + nrm((L, A_W), 0.05),
        'rwkv_ka': 1.0 + nrm((L, A_W), 0.05),
        'rwkv_rk': nrm((L, A_HEADS, A_HD), 0.1),
        'rwkv_ln_g': 1.0 + nrm((L, A_W), 0.02),
        'rwkv_ln_b': nrm((L, A_W), 0.01),
        'gdn_conv': nrm((L, B_CONV, 2 * B_QK + B_VW), B_CONV ** -0.5),
        'gdn_a_log': jnp.log(jax.random.uniform(next(ks), (L, 2, B_HEADS), F32, 1.0, 16.0)),
        'gdn_dt_bias': dt + jnp.log(-jnp.expm1(-dt)),
        'gdn_norm_g': 1.0 + nrm((L, B_DV), 0.02),
        'gla_gw2': nrm((L, 2, C_GATE_R, C_QK), C_GATE_R ** -0.5),
        'gla_gb': nrm((L, 2, C_QK), 0.1),
        'gla_norm_g': 1.0 + nrm((L, C_DV), 0.02),
        'attn_sink': nrm((L, D_HEADS), 0.5),
        'ffn_w1': nrm((L, D_MODEL, 2 * FFN_HIDDEN), D_MODEL ** -0.5),
        'ffn_w2': nrm((L, FFN_HIDDEN, D_MODEL), FFN_HIDDEN ** -0.5),
    }


def reference(x, c, ctx, c_ctx, ada_w, ada_b, norm_g, w_in, gate_b, w_branch, w_out,
              rwkv_mu, rwkv_w0, rwkv_w2, rwkv_a0, rwkv_a2, rwkv_g2, rwkv_kk, rwkv_ka, rwkv_rk,
              rwkv_ln_g, rwkv_ln_b, gdn_conv, gdn_a_log, gdn_dt_bias, gdn_norm_g,
              gla_gw2, gla_gb, gla_norm_g, attn_sink, ffn_w1, ffn_w2):
    n_rows = x.shape[1] // GRID_W
    rows = jnp.repeat(jnp.arange(n_rows, dtype=F32), GRID_W)
    cols = jnp.tile(jnp.arange(GRID_W, dtype=F32), n_rows)
    xc = ctx
    for l in range(DEPTH):
        last = l == DEPTH - 1
        mod = (jax.nn.silu(c) @ ada_w[l] + ada_b[l])[:, None, :]
        mod_c = (jax.nn.silu(c_ctx) @ ada_w[l] + ada_b[l])[None, None, :]
        sh1, sc1, g1, sh2, sc2, g2 = jnp.split(mod, 6, axis=-1)
        csh1, csc1, cg1, csh2, csc2, cg2 = jnp.split(mod_c, 6, axis=-1)
        ng = norm_g[l]
        h = (_rms(x, ng[0]) * (1.0 + sc1) + sh1).astype(x.dtype)
        hc = (_rms(xc, ng[0]) * (1.0 + csc1) + csh1).astype(xc.dtype)
        y, yc = _mixer_block(h, hc, w_in[l], gate_b[l], w_branch[l], w_out[l],
                             rwkv_mu[l], rwkv_w0[l], rwkv_w2[l], rwkv_a0[l], rwkv_a2[l], rwkv_g2[l],
                             rwkv_kk[l], rwkv_ka[l], rwkv_rk[l], rwkv_ln_g[l], rwkv_ln_b[l],
                             gdn_conv[l], gdn_a_log[l], gdn_dt_bias[l], gdn_norm_g[l],
                             gla_gw2[l], gla_gb[l], gla_norm_g[l], attn_sink[l], rows, cols, not last)
        x = x + (g1 * _rms(y, ng[1])).astype(x.dtype)
        h = (_rms(x, ng[2]) * (1.0 + sc2) + sh2).astype(x.dtype)
        x = x + (g2 * _rms(_swiglu(h, ffn_w1[l], ffn_w2[l]), ng[3])).astype(x.dtype)
        if not last:
            xc = xc + (cg1 * _rms(yc, ng[1])).astype(xc.dtype)
            hc = (_rms(xc, ng[2]) * (1.0 + csc2) + csh2).astype(xc.dtype)
            xc = xc + (cg2 * _rms(_swiglu(hc, ffn_w1[l], ffn_w2[l]), ng[3])).astype(xc.dtype)
    return x
```

```cpp
#include <hip/hip_runtime.h>
#include <hip/hip_cooperative_groups.h>
#include <cstdio>
namespace cg = cooperative_groups;

typedef unsigned short u16;
using bf16x8 = __attribute__((ext_vector_type(8))) short;
using f32x4 = __attribute__((ext_vector_type(4))) float;

#define DM 1024
#define NBATCH 8
#define SEQ 4096
#define LC 256
#define TPB 4352
#define NROWS 34816
#define PST 3328
#define YST 1792
#define FH 2816
#define INW 7408
#define NTHR 512
#define PA 0
#define PB 960
#define PC 2000
#define PD 2800
#define NPHASE 21

struct Params {
  const float *x, *c, *ctx, *c_ctx, *ada_w, *ada_b, *norm_g, *w_in, *gate_b, *w_branch, *w_out,
      *rwkv_mu, *rwkv_w0, *rwkv_w2, *rwkv_a0, *rwkv_a2, *rwkv_g2, *rwkv_kk, *rwkv_ka, *rwkv_rk, *rwkv_ln_g,
      *rwkv_ln_b, *gdn_conv, *gdn_a_log, *gdn_dt_bias, *gdn_norm_g, *gla_gw2, *gla_gb, *gla_norm_g, *attn_sink,
      *ffn_w1, *ffn_w2;
  float* out;
  unsigned char* ws;
};

constexpr size_t SZ_WL = 36700160;
constexpr size_t OW_IN = 0;
constexpr size_t OW_G = OW_IN + (size_t)PST * 1024 * 2;
constexpr size_t OW_B = OW_G + (size_t)4096 * 1024 * 2;
constexpr size_t OW_O = OW_B + (size_t)4 * 1024 * 256 * 2;
constexpr size_t OW_1 = OW_O + (size_t)1024 * 1024 * 2;
constexpr size_t OW_2 = OW_1 + (size_t)5632 * 1024 * 2;
static_assert(OW_2 + (size_t)1024 * FH * 2 == SZ_WL, "weights size");
constexpr size_t SZ_ACT = (size_t)NROWS * DM * 2;
constexpr size_t OFF_W = 0;
constexpr size_t OFF_XC = OFF_W + 2 * SZ_WL;
constexpr size_t OFF_MODP = OFF_XC + (size_t)NBATCH * LC * DM * 4;
constexpr size_t OFF_MOD = OFF_MODP + (size_t)2 * 8 * 9 * 6144 * 4;
constexpr size_t OFF_BC = OFF_MOD + (size_t)2 * 9 * 6144 * 4;
constexpr size_t OFF_H = OFF_BC + (size_t)NROWS * 8 * 4;
constexpr size_t OFF_YS = OFF_H + SZ_ACT;
constexpr size_t OFF_BIG = OFF_YS + (size_t)NROWS * YST * 2;
constexpr size_t WS_END = OFF_BIG + (size_t)NROWS * PST * 2;
static_assert(WS_END <= (size_t)536870912, "ws too large");

__device__ __forceinline__ int launder_tid() { int t = threadIdx.x; asm volatile("" : "+v"(t)); return t; }
#define TIDX (launder_tid())
__device__ __forceinline__ u16 f2bf(float f) {
  unsigned u = __float_as_uint(f);
  u += 0x7fffu + ((u >> 16) & 1u);
  return (u16)(u >> 16);
}
__device__ __forceinline__ float bf2f(u16 h) { return __uint_as_float(((unsigned)h) << 16); }
__device__ __forceinline__ unsigned pack2(float a, float b) { return (unsigned)f2bf(a) | ((unsigned)f2bf(b) << 16); }
__device__ __forceinline__ float sigm(float x) { return 1.f / (1.f + __expf(-x)); }
__device__ __forceinline__ float siluf(float x) { return x / (1.f + __expf(-x)); }
__device__ __forceinline__ float softplusf(float x) { return fmaxf(x, 0.f) + log1pf(__expf(-fabsf(x))); }
__device__ __forceinline__ float wsum(float v) {
#pragma unroll
  for (int o = 32; o > 0; o >>= 1) v += __shfl_xor(v, o);
  return v;
}
template <int CTRL>
__device__ __forceinline__ float dppf(float x) {
  return __int_as_float(__builtin_amdgcn_update_dpp(0, __float_as_int(x), CTRL, 0xf, 0xf, false));
}
__device__ __forceinline__ float red8(float x) {
  x += dppf<0xB1>(x);
  x += dppf<0x4E>(x);
  x += dppf<0x141>(x);
  return x;
}
__device__ __forceinline__ const float* xin_row(const Params& p, int r) {
  int b = r / TPB, t = r - b * TPB;
  return t < LC ? p.ctx + ((size_t)(b * LC + t)) * DM : p.x + ((size_t)(b * SEQ + t - LC)) * DM;
}
__device__ __forceinline__ float* x_row(const Params& p, int r) {
  int b = r / TPB, t = r - b * TPB;
  return t < LC ? (float*)(p.ws + OFF_XC) + ((size_t)(b * LC + t)) * DM : p.out + ((size_t)(b * SEQ + t - LC)) * DM;
}
__device__ __forceinline__ int mod_row(int r) {
  int b = r / TPB, t = r - b * TPB;
  return t < LC ? 8 : b;
}

struct MapId { int lim, off; __device__ int operator()(int n) const { return n < lim ? n + off : -1; } };
struct MapW1 { __device__ int operator()(int n) const { int q = n >> 5, s = n & 31; return s < 16 ? q * 16 + s : FH + q * 16 + (s - 16); } };

template <class Map>
__device__ __forceinline__ void conv_tile(const float* __restrict__ src, int ld, u16* __restrict__ dst, int K, int n0,
                                          int k0, Map map, float* tile) {
  const int tid = TIDX;
  const int nn = tid & 63, kr = tid >> 6;
  const int sc = map(n0 + nn);
#pragma unroll
  for (int ps = 0; ps < 8; ps++) {
    int kk = ps * 8 + kr;
    float v = sc >= 0 ? src[(size_t)(k0 + kk) * ld + sc] : 0.f;
    tile[kk * 65 + nn] = v;
  }
  __syncthreads();
  const int n2 = tid >> 3, kc = tid & 7;
  uint4 o;
  o.x = pack2(tile[(kc * 8 + 0) * 65 + n2], tile[(kc * 8 + 1) * 65 + n2]);
  o.y = pack2(tile[(kc * 8 + 2) * 65 + n2], tile[(kc * 8 + 3) * 65 + n2]);
  o.z = pack2(tile[(kc * 8 + 4) * 65 + n2], tile[(kc * 8 + 5) * 65 + n2]);
  o.w = pack2(tile[(kc * 8 + 6) * 65 + n2], tile[(kc * 8 + 7) * 65 + n2]);
  *(uint4*)(dst + (size_t)(n0 + n2) * K + k0 + kc * 8) = o;
  __syncthreads();
}

__device__ __forceinline__ void phase_init0(const Params& p, float* sm) {
  const int tid = TIDX;
  constexpr int NMOD = 192, NCONV = 4480 * 2;
  for (int it = blockIdx.x; it < NMOD + NCONV; it += gridDim.x) {
    if (it < NMOD) {
      int l = it / 96, rem = it - l * 96, cc = rem >> 3, ks = rem & 7;
      for (int i = tid; i < 9 * 128; i += NTHR) {
        int r = i >> 7, k = i & 127;
        float v = r < 8 ? p.c[r * DM + ks * 128 + k] : p.c_ctx[ks * 128 + k];
        sm[i] = siluf(v);
      }
      __syncthreads();
      const int n = cc * 512 + tid;
      const float* w = p.ada_w + ((size_t)l * DM + ks * 128) * 6144 + n;
      float acc[9];
#pragma unroll
      for (int r = 0; r < 9; r++) acc[r] = 0.f;
#pragma unroll 4
      for (int k = 0; k < 128; k++) {
        float wv = w[(size_t)k * 6144];
#pragma unroll
        for (int r = 0; r < 9; r++) acc[r] += sm[r * 128 + k] * wv;
      }
      float* mp = (float*)(p.ws + OFF_MODP) + ((size_t)(l * 8 + ks) * 9) * 6144 + n;
#pragma unroll
      for (int r = 0; r < 9; r++) mp[(size_t)r * 6144] = acc[r];
      __syncthreads();
    } else {
      int ci = it - NMOD;
      int l = ci / 4480, rem = ci - l * 4480;
      u16* wl = (u16*)(p.ws + OFF_W + (size_t)l * SZ_WL);
      if (rem < 832) {
        int nt = rem >> 4, kt = rem & 15;
        conv_tile(p.w_in + (size_t)l * DM * INW, INW, (u16*)((char*)wl + OW_IN), 1024, nt * 64, kt * 64, MapId{3312, 0}, sm);
      } else if (rem < 832 + 1024) {
        rem -= 832;
        int nt = rem >> 4, kt = rem & 15;
        conv_tile(p.w_in + (size_t)l * DM * INW, INW, (u16*)((char*)wl + OW_G), 1024, nt * 64, kt * 64, MapId{4096, 3312}, sm);
      } else if (rem < 1856 + 256) {
        rem -= 1856;
        int br = rem >> 6, r2 = rem & 63, nt = r2 >> 2, kt = r2 & 3;
        conv_tile(p.w_branch + ((size_t)(l * 4 + br)) * 256 * DM, DM, (u16*)((char*)wl + OW_B) + (size_t)br * 1024 * 256, 256,
                  nt * 64, kt * 64, MapId{1024, 0}, sm);
      } else if (rem < 2112 + 256) {
        rem -= 2112;
        int nt = rem >> 4, kt = rem & 15;
        conv_tile(p.w_out + (size_t)l * DM * DM, DM, (u16*)((char*)wl + OW_O), 1024, nt * 64, kt * 64, MapId{1024, 0}, sm);
      } else if (rem < 2368 + 1408) {
        rem -= 2368;
        int nt = rem >> 4, kt = rem & 15;
        conv_tile(p.ffn_w1 + (size_t)l * DM * 5632, 5632, (u16*)((char*)wl + OW_1), 1024, nt * 64, kt * 64, MapW1{}, sm);
      } else {
        rem -= 3776;
        int nt = rem / 44, kt = rem - nt * 44;
        conv_tile(p.ffn_w2 + (size_t)l * FH * DM, DM, (u16*)((char*)wl + OW_2), FH, nt * 64, kt * 64, MapId{1024, 0}, sm);
      }
    }
  }
}

__device__ __forceinline__ void phase_init1(const Params& p) {
  const float* mp = (const float*)(p.ws + OFF_MODP);
  float* mo = (float*)(p.ws + OFF_MOD);
  for (int i = blockIdx.x * NTHR + TIDX; i < 2 * 9 * 6144; i += gridDim.x * NTHR) {
    int l = i / (9 * 6144), rem = i - l * 9 * 6144, r = rem / 6144, n = rem - r * 6144;
    float s = p.ada_b[l * 6144 + n];
#pragma unroll
    for (int ks = 0; ks < 8; ks++) s += mp[((size_t)((l * 8 + ks) * 9 + r)) * 6144 + n];
    mo[i] = s;
  }
}

__device__ __forceinline__ void rowpass(const Params& p, int l, int mode) {
  const int lane = TIDX & 63, wv = TIDX >> 6;
  const float* MOD = (const float*)(p.ws + OFF_MOD);
  u16* H = (u16*)(p.ws + OFF_H);
  for (int r = blockIdx.x * 8 + wv; r < NROWS; r += gridDim.x * 8) {
    const int mr = mod_row(r);
    const float* modl = MOD + ((size_t)(l * 9 + mr)) * 6144;
    float xv[16];
    if (mode == 0) {
      const float* xs = xin_row(p, r);
#pragma unroll
      for (int i = 0; i < 4; i++) {
        float4 t = *(const float4*)(xs + i * 256 + lane * 4);
        xv[i * 4 + 0] = t.x; xv[i * 4 + 1] = t.y; xv[i * 4 + 2] = t.z; xv[i * 4 + 3] = t.w;
      }
    } else {
      const u16* src = (const u16*)(p.ws + (mode == 1 ? OFF_BIG + SZ_ACT : OFF_YS)) + (size_t)r * DM;
      const float* xs = (mode == 1 && l == 0) ? xin_row(p, r) : (const float*)x_row(p, r);
      float ov[16];
      float ss = 0.f;
#pragma unroll
      for (int i = 0; i < 4; i++) {
        uint2 t = *(const uint2*)(src + i * 256 + lane * 4);
        ov[i * 4 + 0] = bf2f((u16)(t.x & 0xffff)); ov[i * 4 + 1] = bf2f((u16)(t.x >> 16));
        ov[i * 4 + 2] = bf2f((u16)(t.y & 0xffff)); ov[i * 4 + 3] = bf2f((u16)(t.y >> 16));
      }
#pragma unroll
      for (int i = 0; i < 16; i++) ss += ov[i] * ov[i];
      ss = wsum(ss);
      const float inv = rsqrtf(ss * (1.f / 1024.f) + 1e-6f);
      const float* ng = p.norm_g + (size_t)(l * 4 + (mode == 1 ? 1 : 3)) * DM;
      const float* gt = modl + (mode == 1 ? 2048 : 5120);
      float* xd = x_row(p, r);
#pragma unroll
      for (int i = 0; i < 4; i++) {
        const int col = i * 256 + lane * 4;
        float4 xo = *(const float4*)(xs + col);
        float4 g4 = *(const float4*)(gt + col);
        float4 n4 = *(const float4*)(ng + col);
        xv[i * 4 + 0] = xo.x + g4.x * (ov[i * 4 + 0] * inv * n4.x);
        xv[i * 4 + 1] = xo.y + g4.y * (ov[i * 4 + 1] * inv * n4.y);
        xv[i * 4 + 2] = xo.z + g4.z * (ov[i * 4 + 2] * inv * n4.z);
        xv[i * 4 + 3] = xo.w + g4.w * (ov[i * 4 + 3] * inv * n4.w);
        *(float4*)(xd + col) = make_float4(xv[i * 4 + 0], xv[i * 4 + 1], xv[i * 4 + 2], xv[i * 4 + 3]);
      }
    }
    int ln = l, ni = 0, sho = 0, sco = 1024;
    if (mode == 1) { ni = 2; sho = 3072; sco = 4096; }
    if (mode == 2) { if (l == 1) continue; ln = l + 1; }
    const float* modn = MOD + ((size_t)(ln * 9 + mr)) * 6144;
    const float* ng2 = p.norm_g + (size_t)(ln * 4 + ni) * DM;
    float ss2 = 0.f;
#pragma unroll
    for (int i = 0; i < 16; i++) ss2 += xv[i] * xv[i];
    ss2 = wsum(ss2);
    const float inv2 = rsqrtf(ss2 * (1.f / 1024.f) + 1e-6f);
#pragma unroll
    for (int i = 0; i < 4; i++) {
      const int col = i * 256 + lane * 4;
      float4 n4 = *(const float4*)(ng2 + col);
      float4 sc = *(const float4*)(modn + sco + col);
      float4 sh = *(const float4*)(modn + sho + col);
      float h0 = xv[i * 4 + 0] * inv2 * n4.x * (1.f + sc.x) + sh.x;
      float h1 = xv[i * 4 + 1] * inv2 * n4.y * (1.f + sc.y) + sh.y;
      float h2 = xv[i * 4 + 2] * inv2 * n4.z * (1.f + sc.z) + sh.z;
      float h3 = xv[i * 4 + 3] * inv2 * n4.w * (1.f + sc.w) + sh.w;
      uint2 o;
      o.x = pack2(h0, h1);
      o.y = pack2(h2, h3);
      *(uint2*)(H + (size_t)r * DM + col) = o;
    }
  }
}

#define LDT 72
template <int MI>
__device__ __forceinline__ void gemm_loop(const u16* __restrict__ A, int lda, const u16* __restrict__ Bt, int ldb, int K,
                                          f32x4 (&acc)[MI][4], u16* sA, u16* sB) {
  constexpr int BMT = MI * 64;
  const int tid = TIDX, lane = tid & 63, w = tid >> 6, wm = w >> 1, wn = w & 1, fr = lane & 15, fq = lane >> 4;
  uint4 ra[MI], rb[2];
  const u16* ga = A + (size_t)(tid >> 3) * lda + (tid & 7) * 8;
  const u16* gb = Bt + (size_t)(tid >> 3) * ldb + (tid & 7) * 8;
  const int so = (tid >> 3) * LDT + (tid & 7) * 8;
#pragma unroll
  for (int i = 0; i < MI; i++) ra[i] = *(const uint4*)(ga + (size_t)(i * 64) * lda);
#pragma unroll
  for (int i = 0; i < 2; i++) rb[i] = *(const uint4*)(gb + (size_t)(i * 64) * ldb);
#pragma unroll
  for (int i = 0; i < MI; i++) *(uint4*)(sA + so + i * 64 * LDT) = ra[i];
#pragma unroll
  for (int i = 0; i < 2; i++) *(uint4*)(sB + so + i * 64 * LDT) = rb[i];
  __syncthreads();
  const int nk = K >> 6;
  for (int kt = 0; kt < nk; kt++) {
    const bool more = kt + 1 < nk;
    if (more) {
#pragma unroll
      for (int i = 0; i < MI; i++) ra[i] = *(const uint4*)(ga + (size_t)(i * 64) * lda + (kt + 1) * 64);
#pragma unroll
      for (int i = 0; i < 2; i++) rb[i] = *(const uint4*)(gb + (size_t)(i * 64) * ldb + (kt + 1) * 64);
    }
    const u16* a = sA + (kt & 1) * BMT * LDT + (wm * (MI * 16) + fr) * LDT + fq * 8;
    const u16* b = sB + (kt & 1) * 128 * LDT + (wn * 64 + fr) * LDT + fq * 8;
#pragma unroll
    for (int ks = 0; ks < 2; ks++) {
      bf16x8 af[MI], bfr[4];
#pragma unroll
      for (int i = 0; i < MI; i++) af[i] = *(const bf16x8*)(a + i * 16 * LDT + ks * 32);
#pragma unroll
      for (int j = 0; j < 4; j++) bfr[j] = *(const bf16x8*)(b + j * 16 * LDT + ks * 32);
#pragma unroll
      for (int i = 0; i < MI; i++)
#pragma unroll
        for (int j = 0; j < 4; j++) acc[i][j] = __builtin_amdgcn_mfma_f32_16x16x32_bf16(af[i], bfr[j], acc[i][j], 0, 0, 0);
    }
    if (more) {
      u16* da = sA + ((kt + 1) & 1) * BMT * LDT + so;
      u16* db = sB + ((kt + 1) & 1) * 128 * LDT + so;
#pragma unroll
      for (int i = 0; i < MI; i++) *(uint4*)(da + i * 64 * LDT) = ra[i];
#pragma unroll
      for (int i = 0; i < 2; i++) *(uint4*)(db + i * 64 * LDT) = rb[i];
    }
    __syncthreads();
  }
}

template <int MI>
__device__ __forceinline__ void zero_acc(f32x4 (&acc)[MI][4]) {
#pragma unroll
  for (int i = 0; i < MI; i++)
#pragma unroll
    for (int j = 0; j < 4; j++) acc[i][j] = f32x4{0.f, 0.f, 0.f, 0.f};
}

__device__ __forceinline__ void gemm_plain(const u16* A, int lda, const u16* Bt, int K, int NT, u16* C, int ldc, unsigned char* smem) {
  u16* sA = (u16*)smem;
  u16* sB = sA + 2 * 256 * LDT;
  const int lane = TIDX & 63, w = TIDX >> 6, wm = w >> 1, wn = w & 1, fr = lane & 15, fq = lane >> 4;
  const int ntiles = (NROWS / 256) * NT;
  for (int t = blockIdx.x; t < ntiles; t += gridDim.x) {
    const int mt = t / NT, nt = t - mt * NT;
    f32x4 acc[4][4];
    zero_acc<4>(acc);
    gemm_loop<4>(A + (size_t)mt * 256 * lda, lda, Bt + (size_t)nt * 128 * K, K, K, acc, sA, sB);
    const int r0 = mt * 256 + wm * 64 + fq * 4, c0 = nt * 128 + wn * 64 + fr;
#pragma unroll
    for (int i = 0; i < 4; i++)
#pragma unroll
      for (int j = 0; j < 4; j++)
#pragma unroll
        for (int r = 0; r < 4; r++) C[(size_t)(r0 + i * 16 + r) * ldc + c0 + j * 16] = f2bf(acc[i][j][r]);
  }
}

__device__ __forceinline__ void gemm_swiglu(const u16* A, const u16* Bt, u16* C, unsigned char* smem) {
  u16* sA = (u16*)smem;
  u16* sB = sA + 2 * 256 * LDT;
  const int lane = TIDX & 63, w = TIDX >> 6, wm = w >> 1, wn = w & 1, fr = lane & 15, fq = lane >> 4;
  constexpr int NT = 44;
  const int ntiles = (NROWS / 256) * NT;
  for (int t = blockIdx.x; t < ntiles; t += gridDim.x) {
    const int mt = t / NT, nt = t - mt * NT;
    f32x4 acc[4][4];
    zero_acc<4>(acc);
    gemm_loop<4>(A + (size_t)mt * 256 * DM, DM, Bt + (size_t)nt * 128 * DM, DM, DM, acc, sA, sB);
    const int r0 = mt * 256 + wm * 64 + fq * 4, c0 = nt * 64 + wn * 32 + fr;
#pragma unroll
    for (int i = 0; i < 4; i++)
#pragma unroll
      for (int jj = 0; jj < 2; jj++)
#pragma unroll
        for (int r = 0; r < 4; r++) {
          float g = acc[i][jj * 2][r], u = acc[i][jj * 2 + 1][r];
          C[(size_t)(r0 + i * 16 + r) * FH + c0 + jj * 16] = f2bf(siluf(g) * u);
        }
  }
}

__device__ __forceinline__ void gemm_merge(const Params& p, int l, unsigned char* smem) {
  u16* sA = (u16*)smem;
  u16* sB = sA + 2 * 256 * LDT;
  const int lane = TIDX & 63, w = TIDX >> 6, wm = w >> 1, wn = w & 1, fr = lane & 15, fq = lane >> 4;
  const u16* H = (const u16*)(p.ws + OFF_H);
  const u16* Y = (const u16*)(p.ws + OFF_YS);
  const u16* Wg = (const u16*)(p.ws + OFF_W + (size_t)l * SZ_WL + OW_G);
  const u16* Wb = (const u16*)(p.ws + OFF_W + (size_t)l * SZ_WL + OW_B);
  u16* C = (u16*)(p.ws + OFF_BIG);
  constexpr int NT = 8;
  const int ntiles = (NROWS / 128) * NT;
  for (int t = blockIdx.x; t < ntiles; t += gridDim.x) {
    const int mt = t / NT, nt = t - mt * NT;
    f32x4 tot[2][4];
    zero_acc<2>(tot);
    const int c0 = nt * 128 + wn * 64 + fr;
#pragma unroll 1
    for (int br = 0; br < 4; br++) {
      f32x4 ag[2][4];
      zero_acc<2>(ag);
      gemm_loop<2>(H + (size_t)mt * 128 * DM, DM, Wg + ((size_t)br * 1024 + nt * 128) * DM, DM, DM, ag, sA, sB);
#pragma unroll
      for (int j = 0; j < 4; j++) {
        const float gb = p.gate_b[(l * 4 + br) * DM + c0 + j * 16];
#pragma unroll
        for (int i = 0; i < 2; i++)
#pragma unroll
          for (int r = 0; r < 4; r++) ag[i][j][r] = sigm(ag[i][j][r] + gb);
      }
      f32x4 ay[2][4];
      zero_acc<2>(ay);
      const int ycol = br < 3 ? br * 256 : 1536;
      gemm_loop<2>(Y + (size_t)mt * 128 * YST + ycol, YST, Wb + ((size_t)br * 1024 + nt * 128) * 256, 256, 256, ay, sA, sB);
#pragma unroll
      for (int i = 0; i < 2; i++)
#pragma unroll
        for (int j = 0; j < 4; j++)
#pragma unroll
          for (int r = 0; r < 4; r++) tot[i][j][r] += ag[i][j][r] * ay[i][j][r];
    }
    const int r0 = mt * 128 + wm * 32 + fq * 4;
#pragma unroll
    for (int i = 0; i < 2; i++)
#pragma unroll
      for (int j = 0; j < 4; j++)
#pragma unroll
        for (int r = 0; r < 4; r++) C[(size_t)(r0 + i * 16 + r) * DM + c0 + j * 16] = f2bf(tot[i][j][r]);
  }
}

#define SC_D 0
#define SC_U 2048
#define SC_P 4096
#define SC_K 6144
#define SC_DQ 8192
#define SC_YB 10240
#define SC_C1 12288
#define SC_C2 12320
#define SC_XM 12352
#define SC_W2 20544
#define SC_A2 22592
#define SC_RAW 24640

template <int MIX>
__device__ __forceinline__ void scan_item(const Params& p, int l, int b, int h, int dir, float* sm) {
  constexpr int DK = (MIX == 2) ? 32 : 64;
  constexpr int EPL = DK / 8;
  constexpr int VOFF = (MIX == 2) ? 64 : 128;
  const int tid = TIDX, lane = tid & 63, w = tid >> 6;
  const int erow = w * 8 + (lane >> 3), part = lane & 7;
  const u16* P = (const u16*)(p.ws + OFF_BIG);
  u16* YS = (u16*)(p.ws + OFF_YS);
  float* BC = (float*)(p.ws + OFF_BC);
  float* XM = sm + SC_XM;
  float s[EPL];
#pragma unroll
  for (int i = 0; i < EPL; i++) s[i] = 0.f;
  __syncthreads();
  if (MIX == 0) {
    for (int i = tid; i < 2048; i += NTHR) {
      int ii = i >> 6, n = i & 63;
      sm[SC_W2 + i] = p.rwkv_w2[((size_t)(l * 2 + dir) * 32 + ii) * 256 + h * 64 + n];
      sm[SC_A2 + i] = p.rwkv_a2[((size_t)(l * 2 + dir) * 32 + ii) * 256 + h * 64 + n];
    }
  } else if (MIX == 1) {
    for (int i = tid; i < 7 * 192; i += NTHR) {
      int ii = i / 192, c = i - ii * 192;
      int cc = (c >> 6) * 256 + h * 64 + (c & 63);
      sm[SC_W2 + i] = p.gdn_conv[((size_t)l * 7 + ii) * 768 + cc];
    }
  } else {
    for (int i = tid; i < 512; i += NTHR) {
      int ii = i >> 5, n = i & 31;
      sm[SC_W2 + i] = p.gla_gw2[((size_t)(l * 2 + dir) * 16 + ii) * 128 + h * 32 + n];
    }
  }
  __syncthreads();

  for (int ch = 0; ch < TPB / 32; ch++) {
    int seg_row0, seg_len, t_lo;
    if (ch < 8) {
      seg_row0 = b * TPB; seg_len = LC;
      t_lo = dir == 0 ? ch * 32 : (LC - 32 - ch * 32);
    } else {
      seg_row0 = b * TPB + LC; seg_len = SEQ;
      t_lo = dir == 0 ? (ch - 8) * 32 : (SEQ - 32 - (ch - 8) * 32);
    }
    const u16* Pseg = P + (size_t)seg_row0 * PST;
    if (MIX == 0) {
#pragma unroll 4
      for (int i = 0; i < 16; i++) {
        int idx = tid + i * NTHR;
        int tt = idx >> 8, c = idx & 255;
        int col = c < 64 ? h * 64 + c
                : c < 128 ? 256 + h * 64 + (c - 64)
                : c < 192 ? 512 + h * 64 + (c - 128)
                : c < 224 ? 768 + dir * 32 + (c - 192)
                          : 832 + dir * 32 + (c - 224);
        int t = t_lo + tt;
        const u16* pp = Pseg + (size_t)t * PST + PA + col;
        float pv = bf2f(pp[0]);
        float pprev = t > 0 ? bf2f(pp[-PST]) : 0.f;
        float pnext = t < seg_len - 1 ? bf2f(pp[PST]) : 0.f;
        float xm = pv + (0.5f * (pprev + pnext) - pv) * p.rwkv_mu[l * 960 + col];
        if (c >= 192 && c < 224) xm = tanhf(xm);
        XM[tt * 256 + c] = xm;
      }
    } else if (MIX == 1) {
      u16* RAW = (u16*)(sm + SC_RAW);
      for (int idx = tid; idx < 38 * 192; idx += NTHR) {
        int tr = idx / 192, c = idx - tr * 192;
        int t = t_lo - 3 + tr;
        int col = PB + (c >> 6) * 256 + h * 64 + (c & 63);
        RAW[idx] = (t >= 0 && t < seg_len) ? Pseg[(size_t)t * PST + col] : (u16)0;
      }
      if (tid < 32) {
        const u16* pp = Pseg + (size_t)(t_lo + tid) * PST + PB;
        float bx = bf2f(pp[768 + dir * 4 + h]);
        float ax = bf2f(pp[776 + dir * 4 + h]);
        float beta = sigm(bx);
        float ld = -__expf(p.gdn_a_log[(l * 2 + dir) * 4 + h]) * softplusf(ax + p.gdn_dt_bias[(l * 2 + dir) * 4 + h]);
        XM[tid * 256 + 192] = beta;
        XM[tid * 256 + 193] = __expf(ld);
      }
      __syncthreads();
      for (int idx = tid; idx < 32 * 192; idx += NTHR) {
        int tt = idx / 192, c = idx - tt * 192;
        float a = 0.f;
#pragma unroll
        for (int i = 0; i < 7; i++) a += bf2f(RAW[(tt + i) * 192 + c]) * sm[SC_W2 + i * 192 + c];
        XM[tt * 256 + c] = siluf(a);
      }
    } else {
      for (int idx = tid; idx < 32 * 144; idx += NTHR) {
        int tt = idx / 144, c = idx - tt * 144;
        int col = c < 32 ? h * 32 + c
                : c < 64 ? 128 + h * 32 + (c - 32)
                : c < 128 ? 256 + h * 64 + (c - 64)
                          : 512 + dir * 16 + (c - 128);
        float v = bf2f(Pseg[(size_t)(t_lo + tt) * PST + PC + col]);
        if (c < 32) v *= 0.17677669529663687f;
        XM[tt * 256 + c] = v;
      }
    }
    __syncthreads();
    if (MIX == 0) {
      const int n = lane, j = h * 64 + n;
      const float kkp = p.rwkv_kk[l * 256 + j], kap = p.rwkv_ka[l * 256 + j], rkp = p.rwkv_rk[l * 256 + j];
      const float w0 = p.rwkv_w0[(l * 2 + dir) * 256 + j], a0 = p.rwkv_a0[(l * 2 + dir) * 256 + j];
#pragma unroll 1
      for (int q = 0; q < 4; q++) {
        const int tt = w + q * 8;
        const float* xr = XM + tt * 256;
        float r = xr[n], k = xr[64 + n];
        float kx = k * kkp;
        float ss = wsum(kx * kx);
        float kk = kx * rsqrtf(ss + 1e-6f);
        float wr = w0, ar = a0;
#pragma unroll 8
        for (int i = 0; i < 32; i++) {
          wr += xr[192 + i] * sm[SC_W2 + i * 64 + n];
          ar += xr[224 + i] * sm[SC_A2 + i * 64 + n];
        }
        float decay = __expf(-0.6065306597126334f * sigm(wr));
        float a = sigm(ar);
        float kd = k * (1.f + (a - 1.f) * kap);
        sm[SC_D + tt * 64 + n] = decay;
        sm[SC_U + tt * 64 + n] = kk;
        sm[SC_P + tt * 64 + n] = -kk * a;
        sm[SC_K + tt * 64 + n] = kd;
        sm[SC_DQ + tt * 64 + n] = decay * r;
        float c1 = wsum(-kk * a * r), c2 = wsum(kd * r), bc = wsum(r * kd * rkp);
        if (lane == 0) {
          sm[SC_C1 + tt] = c1;
          sm[SC_C2 + tt] = c2;
          BC[(size_t)(seg_row0 + t_lo + tt) * 8 + h * 2 + dir] = bc;
        }
      }
    } else if (MIX == 1) {
      const int n = lane;
#pragma unroll 1
      for (int q = 0; q < 4; q++) {
        const int tt = w + q * 8;
        const float* xr = XM + tt * 256;
        float qv = xr[n], k = xr[64 + n];
        float sq = wsum(qv * qv), sk = wsum(k * k);
        float qn = qv * rsqrtf(sq + 1e-6f) * 0.125f;
        float kn = k * rsqrtf(sk + 1e-6f);
        float beta = xr[192], alpha = xr[193];
        sm[SC_D + tt * 64 + n] = alpha;
        sm[SC_U + tt * 64 + n] = kn;
        sm[SC_P + tt * 64 + n] = -alpha * beta * kn;
        sm[SC_K + tt * 64 + n] = beta * kn;
        sm[SC_DQ + tt * 64 + n] = alpha * qn;
        float dkq = wsum(kn * qn);
        if (lane == 0) {
          sm[SC_C1 + tt] = -alpha * beta * dkq;
          sm[SC_C2 + tt] = beta * dkq;
        }
      }
    } else {
#pragma unroll
      for (int q = 0; q < 2; q++) {
        const int idx = tid + q * NTHR;
        const int tt = idx >> 5, n = idx & 31;
        const float* xr = XM + tt * 256;
        float lg = p.gla_gb[(l * 2 + dir) * 128 + h * 32 + n];
#pragma unroll
        for (int i = 0; i < 16; i++) lg += xr[128 + i] * sm[SC_W2 + i * 32 + n];
        float ls = fminf(lg, 0.f) - log1pf(__expf(-fabsf(lg)));
        float alpha = __expf(ls * (1.f / 16.f));
        float qv = xr[n], k = xr[32 + n];
        sm[SC_D + tt * 64 + n] = alpha;
        sm[SC_K + tt * 64 + n] = k;
        sm[SC_DQ + tt * 64 + n] = alpha * qv;
        float d = k * qv;
#pragma unroll
        for (int o = 16; o > 0; o >>= 1) d += __shfl_xor(d, o);
        if (n == 0) sm[SC_C2 + tt] = d;
      }
    }
    __syncthreads();
#pragma unroll 2
    for (int st = 0; st < 32; st++) {
      const int tt = dir ? 31 - st : st;
      const int o = tt * 64 + part * EPL;
      float dv[EPL], kv[EPL], qv[EPL], uv[EPL], pv[EPL];
#pragma unroll
      for (int i = 0; i < EPL; i += 4) {
        float4 t4 = *(const float4*)(sm + SC_D + o + i);
        dv[i] = t4.x; dv[i + 1] = t4.y; dv[i + 2] = t4.z; dv[i + 3] = t4.w;
        t4 = *(const float4*)(sm + SC_K + o + i);
        kv[i] = t4.x; kv[i + 1] = t4.y; kv[i + 2] = t4.z; kv[i + 3] = t4.w;
        t4 = *(const float4*)(sm + SC_DQ + o + i);
        qv[i] = t4.x; qv[i + 1] = t4.y; qv[i + 2] = t4.z; qv[i + 3] = t4.w;
        if (MIX != 2) {
          t4 = *(const float4*)(sm + SC_U + o + i);
          uv[i] = t4.x; uv[i + 1] = t4.y; uv[i + 2] = t4.z; uv[i + 3] = t4.w;
          t4 = *(const float4*)(sm + SC_P + o + i);
          pv[i] = t4.x; pv[i + 1] = t4.y; pv[i + 2] = t4.z; pv[i + 3] = t4.w;
        }
      }
      const float vv = XM[tt * 256 + VOFF + erow];
      const float c2 = sm[SC_C2 + tt];
      float sq = 0.f, sa = 0.f;
#pragma unroll
      for (int i = 0; i < EPL; i++) sq += s[i] * qv[i];
      if (MIX != 2) {
#pragma unroll
        for (int i = 0; i < EPL; i++) sa += s[i] * uv[i];
        sa = red8(sa);
      }
      sq = red8(sq);
      float y = sq + vv * c2;
      if (MIX != 2) y += sa * sm[SC_C1 + tt];
#pragma unroll
      for (int i = 0; i < EPL; i++) {
        float t = s[i] * dv[i] + vv * kv[i];
        if (MIX != 2) t += sa * pv[i];
        s[i] = t;
      }
      if (part == 0) sm[SC_YB + tt * 64 + erow] = y;
    }
    __syncthreads();
    for (int idx = tid; idx < 2048; idx += NTHR) {
      int tt = idx >> 6, e = idx & 63;
      YS[(size_t)(seg_row0 + t_lo + tt) * YST + dir * 768 + MIX * 256 + h * 64 + e] = f2bf(sm[SC_YB + idx]);
    }
  }
}

__device__ __forceinline__ void attn_item(const Params& p, int l, int b, int qb, int hk, bool isctx, unsigned char* smem) {
  u16* KS = (u16*)smem;
  u16* VT = KS + 64 * LDT;
  u16* PL = VT + 64 * LDT;
  float2* ROPE = (float2*)(PL + 8 * 32 * LDT);
  const int tid = TIDX, lane = tid & 63, w = tid >> 6, fr = lane & 15, fq = lane >> 4;
  const u16* P = (const u16*)(p.ws + OFF_BIG);
  u16* Y = (u16*)(p.ws + OFF_YS);
  const int qh = hk * 2 + (w >> 2);
  const int tb = qb * 128 + (w & 3) * 32;
  const int qrow0 = b * TPB + (isctx ? 0 : LC);
  __syncthreads();
  for (int i = tid; i < 1024; i += NTHR) {
    int pos = i >> 4, fi = i & 15;
    float inv = powf(10000.f, -(float)fi / 16.f);
    float sn, cs;
    sincosf((float)pos * inv, &sn, &cs);
    ROPE[i] = make_float2(cs, sn);
  }
  __syncthreads();
  bf16x8 qf[2][2];
#pragma unroll
  for (int mi = 0; mi < 2; mi++)
#pragma unroll
    for (int ks = 0; ks < 2; ks++) {
      const int tq = tb + mi * 16 + fr;
      const u16* qp = P + (size_t)(qrow0 + tq) * PST + PD + qh * 64 + ks * 32;
      uint4 own = *(const uint4*)(qp + fq * 8);
      uint4 par = *(const uint4*)(qp + (fq ^ 2) * 8);
      const unsigned ow[4] = {own.x, own.y, own.z, own.w};
      const unsigned pw[4] = {par.x, par.y, par.z, par.w};
      const int pos = ks == 0 ? (tq >> 6) : (tq & 63);
      bf16x8 f;
#pragma unroll
      for (int jj = 0; jj < 8; jj++) {
        float xo = bf2f((u16)((ow[jj >> 1] >> ((jj & 1) * 16)) & 0xffff));
        float xp = bf2f((u16)((pw[jj >> 1] >> ((jj & 1) * 16)) & 0xffff));
        float v = xo;
        if (!isctx) {
          float2 cs = ROPE[pos * 16 + (fq & 1) * 8 + jj];
          v = fq < 2 ? xo * cs.x - xp * cs.y : xp * cs.y + xo * cs.x;
        }
        f[jj] = (short)f2bf(v * 0.125f);
      }
      qf[mi][ks] = f;
    }
  f32x4 oacc[2][4];
#pragma unroll
  for (int mi = 0; mi < 2; mi++)
#pragma unroll
    for (int nd = 0; nd < 4; nd++) oacc[mi][nd] = f32x4{0.f, 0.f, 0.f, 0.f};
  float mrow[2][4], lrow[2][4];
#pragma unroll
  for (int mi = 0; mi < 2; mi++)
#pragma unroll
    for (int r = 0; r < 4; r++) { mrow[mi][r] = -1e30f; lrow[mi][r] = 0.f; }

  const int q0 = qb * 128;
  const int band_lo = isctx ? 0 : max(0, q0 - 128), band_hi = isctx ? 0 : min(SEQ, q0 + 256);
  const int ntile = 4 + (band_hi - band_lo) / 64;
  u16* pl = PL + w * 32 * LDT;
  for (int tl = 0; tl < ntile; tl++) {
    const bool band = tl >= 4;
    const int k0 = band ? band_lo + (tl - 4) * 64 : tl * 64;
    __syncthreads();
    {
      const int key = tid >> 3, kc = tid & 7;
      const int kpos = k0 + key;
      const u16* kp = P + (size_t)(b * TPB + (band ? LC : 0) + kpos) * PST + PD + 256 + hk * 64;
      uint4 own = *(const uint4*)(kp + kc * 8);
      uint4 vv = *(const uint4*)(kp + 128 + kc * 8);
      if (band) {
        uint4 par = *(const uint4*)(kp + (kc ^ 2) * 8);
        const unsigned ow[4] = {own.x, own.y, own.z, own.w};
        const unsigned pw[4] = {par.x, par.y, par.z, par.w};
        const int pos = kc < 4 ? (kpos >> 6) : (kpos & 63);
        unsigned res[4];
#pragma unroll
        for (int jj = 0; jj < 8; jj += 2) {
          float v2[2];
#pragma unroll
          for (int e = 0; e < 2; e++) {
            float xo = bf2f((u16)((ow[jj >> 1] >> (e * 16)) & 0xffff));
            float xp = bf2f((u16)((pw[jj >> 1] >> (e * 16)) & 0xffff));
            float2 cs = ROPE[pos * 16 + (kc & 1) * 8 + jj + e];
            v2[e] = (kc & 2) == 0 ? xo * cs.x - xp * cs.y : xp * cs.y + xo * cs.x;
          }
          res[jj >> 1] = pack2(v2[0], v2[1]);
        }
        own = make_uint4(res[0], res[1], res[2], res[3]);
      }
      *(uint4*)(KS + key * LDT + kc * 8) = own;
      const unsigned vw[4] = {vv.x, vv.y, vv.z, vv.w};
#pragma unroll
      for (int jj = 0; jj < 8; jj++) VT[(kc * 8 + jj) * LDT + key] = (u16)((vw[jj >> 1] >> ((jj & 1) * 16)) & 0xffff);
    }
    __syncthreads();
    f32x4 sc[2][4];
#pragma unroll
    for (int mi = 0; mi < 2; mi++)
#pragma unroll
      for (int nj = 0; nj < 4; nj++) sc[mi][nj] = f32x4{0.f, 0.f, 0.f, 0.f};
#pragma unroll
    for (int ks = 0; ks < 2; ks++) {
      bf16x8 kf[4];
#pragma unroll
      for (int nj = 0; nj < 4; nj++) kf[nj] = *(const bf16x8*)(KS + (nj * 16 + fr) * LDT + ks * 32 + fq * 8);
#pragma unroll
      for (int mi = 0; mi < 2; mi++)
#pragma unroll
        for (int nj = 0; nj < 4; nj++) sc[mi][nj] = __builtin_amdgcn_mfma_f32_16x16x32_bf16(qf[mi][ks], kf[nj], sc[mi][nj], 0, 0, 0);
    }
#pragma unroll
    for (int mi = 0; mi < 2; mi++)
#pragma unroll
      for (int r = 0; r < 4; r++) {
        const int qpos = tb + mi * 16 + fq * 4 + r;
        float mx = -1e30f;
#pragma unroll
        for (int nj = 0; nj < 4; nj++) {
          float v = sc[mi][nj][r];
          if (band) {
            int d = qpos - (k0 + nj * 16 + fr);
            if (d > 128 || d < -128) v = -1e30f;
          }
          sc[mi][nj][r] = v;
          mx = fmaxf(mx, v);
        }
        mx = fmaxf(mx, __shfl_xor(mx, 1));
        mx = fmaxf(mx, __shfl_xor(mx, 2));
        mx = fmaxf(mx, __shfl_xor(mx, 4));
        mx = fmaxf(mx, __shfl_xor(mx, 8));
        const float mnew = fmaxf(mrow[mi][r], mx);
        const float alpha = __expf(mrow[mi][r] - mnew);
        mrow[mi][r] = mnew;
        float ls = 0.f;
#pragma unroll
        for (int nj = 0; nj < 4; nj++) {
          float pe = __expf(sc[mi][nj][r] - mnew);
          ls += pe;
          pl[(mi * 16 + fq * 4 + r) * LDT + nj * 16 + fr] = f2bf(pe);
        }
        lrow[mi][r] = lrow[mi][r] * alpha + ls;
#pragma unroll
        for (int nd = 0; nd < 4; nd++) oacc[mi][nd][r] *= alpha;
      }
    asm volatile("s_waitcnt lgkmcnt(0)" ::: "memory");
    __builtin_amdgcn_wave_barrier();
#pragma unroll
    for (int ks = 0; ks < 2; ks++) {
      bf16x8 pf[2], vf[4];
#pragma unroll
      for (int mi = 0; mi < 2; mi++) pf[mi] = *(const bf16x8*)(pl + (mi * 16 + fr) * LDT + ks * 32 + fq * 8);
#pragma unroll
      for (int nd = 0; nd < 4; nd++) vf[nd] = *(const bf16x8*)(VT + (nd * 16 + fr) * LDT + ks * 32 + fq * 8);
#pragma unroll
      for (int mi = 0; mi < 2; mi++)
#pragma unroll
        for (int nd = 0; nd < 4; nd++) oacc[mi][nd] = __builtin_amdgcn_mfma_f32_16x16x32_bf16(pf[mi], vf[nd], oacc[mi][nd], 0, 0, 0);
    }
    asm volatile("s_waitcnt lgkmcnt(0)" ::: "memory");
    __builtin_amdgcn_wave_barrier();
  }
  const float sink = p.attn_sink[l * 4 + qh];
#pragma unroll
  for (int mi = 0; mi < 2; mi++)
#pragma unroll
    for (int r = 0; r < 4; r++) {
      float ls = lrow[mi][r];
      ls += __shfl_xor(ls, 1);
      ls += __shfl_xor(ls, 2);
      ls += __shfl_xor(ls, 4);
      ls += __shfl_xor(ls, 8);
      ls += __expf(sink - mrow[mi][r]);
      const float inv = 1.f / ls;
      const int tq = tb + mi * 16 + fq * 4 + r;
#pragma unroll
      for (int nd = 0; nd < 4; nd++) Y[(size_t)(qrow0 + tq) * YST + 1536 + qh * 64 + nd * 16 + fr] = f2bf(oacc[mi][nd][r] * inv);
    }
}

__device__ __forceinline__ void phase_mix(const Params& p, int l, unsigned char* smem) {
  float* sm = (float*)smem;
  constexpr int NSCAN = 192, NATT = 512 + 32;
  const int G = gridDim.x;
  int nscan_blocks = G > NSCAN ? NSCAN : G;
  int natt_blocks = G > NSCAN ? G - NSCAN : G;
  int att_first = G > NSCAN ? NSCAN : 0;
  if ((int)blockIdx.x < nscan_blocks) {
    for (int it = blockIdx.x; it < NSCAN; it += nscan_blocks) {
      int mix = it / 64, rem = it & 63, b = rem >> 3, h = (rem >> 1) & 3, dir = rem & 1;
      if (mix == 0) scan_item<0>(p, l, b, h, dir, sm);
      else if (mix == 1) scan_item<1>(p, l, b, h, dir, sm);
      else scan_item<2>(p, l, b, h, dir, sm);
    }
  }
  if ((int)blockIdx.x >= att_first) {
    for (int it = blockIdx.x - att_first; it < NATT; it += natt_blocks) {
      if (it < 512) {
        int b = it >> 6, qb = (it >> 1) & 31, hk = it & 1;
        attn_item(p, l, b, qb, hk, false, smem);
      } else {
        int r = it - 512, b = r >> 2, qb = (r >> 1) & 1, hk = r & 1;
        attn_item(p, l, b, qb, hk, true, smem);
      }
    }
  }
}

__device__ __forceinline__ void phase_post(const Params& p, int l) {
  const int lane = TIDX & 63, wv = TIDX >> 6;
  const u16* P = (const u16*)(p.ws + OFF_BIG);
  u16* YS = (u16*)(p.ws + OFF_YS);
  const float* BC = (const float*)(p.ws + OFF_BC);
  const int j0 = lane * 4, hd = lane >> 4;
  for (int r = blockIdx.x * 8 + wv; r < NROWS; r += gridDim.x * 8) {
    const int b = r / TPB, t = r - b * TPB;
    const bool has_prev = (t != 0) && (t != LC), has_next = (t != LC - 1) && (t != TPB - 1);
    u16* ys = YS + (size_t)r * YST;
    const u16* pr = P + (size_t)r * PST;
    float y[3][4];
#pragma unroll
    for (int m = 0; m < 3; m++) {
      uint2 a = *(const uint2*)(ys + m * 256 + j0);
      uint2 c = *(const uint2*)(ys + 768 + m * 256 + j0);
      y[m][0] = bf2f((u16)(a.x & 0xffff)) + bf2f((u16)(c.x & 0xffff));
      y[m][1] = bf2f((u16)(a.x >> 16)) + bf2f((u16)(c.x >> 16));
      y[m][2] = bf2f((u16)(a.y & 0xffff)) + bf2f((u16)(c.y & 0xffff));
      y[m][3] = bf2f((u16)(a.y >> 16)) + bf2f((u16)(c.y >> 16));
    }
    float o[3][4];
    {
      float sum = y[0][0] + y[0][1] + y[0][2] + y[0][3];
      sum += __shfl_xor(sum, 1); sum += __shfl_xor(sum, 2); sum += __shfl_xor(sum, 4); sum += __shfl_xor(sum, 8);
      const float mean = sum * (1.f / 64.f);
      float vs = 0.f;
#pragma unroll
      for (int i = 0; i < 4; i++) { float d = y[0][i] - mean; vs += d * d; }
      vs += __shfl_xor(vs, 1); vs += __shfl_xor(vs, 2); vs += __shfl_xor(vs, 4); vs += __shfl_xor(vs, 8);
      const float rstd = rsqrtf(vs * (1.f / 64.f) + 64e-5f);
      float sg;
      {
        const int col = 896 + lane;
        float pv = bf2f(pr[PA + col]);
        float pp = has_prev ? bf2f(pr[PA + col - PST]) : 0.f;
        float pn = has_next ? bf2f(pr[PA + col + PST]) : 0.f;
        float xm = pv + (0.5f * (pp + pn) - pv) * p.rwkv_mu[l * 960 + col];
        sg = sigm(xm);
      }
      float gate[4] = {0.f, 0.f, 0.f, 0.f};
      const float* g2 = p.rwkv_g2 + (size_t)l * 64 * 256 + j0;
#pragma unroll 8
      for (int i = 0; i < 64; i++) {
        float si = __shfl(sg, i);
        float4 gw = *(const float4*)(g2 + i * 256);
        gate[0] += si * gw.x; gate[1] += si * gw.y; gate[2] += si * gw.z; gate[3] += si * gw.w;
      }
      const float bcs = BC[(size_t)r * 8 + hd * 2] + BC[(size_t)r * 8 + hd * 2 + 1];
#pragma unroll
      for (int i = 0; i < 4; i++) {
        const int col = 512 + j0 + i;
        float pv = bf2f(pr[PA + col]);
        float pp = has_prev ? bf2f(pr[PA + col - PST]) : 0.f;
        float pn = has_next ? bf2f(pr[PA + col + PST]) : 0.f;
        float v = pv + (0.5f * (pp + pn) - pv) * p.rwkv_mu[l * 960 + col];
        float yn = (y[0][i] - mean) * rstd * p.rwkv_ln_g[l * 256 + j0 + i] + p.rwkv_ln_b[l * 256 + j0 + i];
        o[0][i] = (yn + bcs * v) * gate[i];
      }
    }
#pragma unroll
    for (int m = 1; m < 3; m++) {
      float ss = y[m][0] * y[m][0] + y[m][1] * y[m][1] + y[m][2] * y[m][2] + y[m][3] * y[m][3];
      ss += __shfl_xor(ss, 1); ss += __shfl_xor(ss, 2); ss += __shfl_xor(ss, 4); ss += __shfl_xor(ss, 8);
      const float inv = rsqrtf(ss * (1.f / 64.f) + 1e-6f);
      const float* ng = (m == 1 ? p.gdn_norm_g : p.gla_norm_g) + l * 64 + (lane & 15) * 4;
      const u16* gp = pr + (m == 1 ? PB + 784 : PC + 544) + j0;
#pragma unroll
      for (int i = 0; i < 4; i++) o[m][i] = y[m][i] * inv * ng[i] * siluf(bf2f(gp[i]));
    }
    asm volatile("s_waitcnt vmcnt(0)" ::: "memory");
    __builtin_amdgcn_wave_barrier();
#pragma unroll
    for (int m = 0; m < 3; m++) {
      uint2 ov;
      ov.x = pack2(o[m][0], o[m][1]);
      ov.y = pack2(o[m][2], o[m][3]);
      *(uint2*)(ys + m * 256 + j0) = ov;
    }
  }
}

#if defined(SKIPS)
#define EN(k) (SKIPS != (k))
#elif !defined(ONLYS)
#define EN(k) 1
#else
#define EN(k) (ONLYS == (k))
#endif
__device__ __forceinline__ void run_phase(const Params& p, int ph, unsigned char* smem) {
  if (ph == 0) { if (EN(10)) phase_init0(p, (float*)smem); return; }
  if (ph == 1) { if (EN(11)) phase_init1(p); return; }
  int l = 0, s = 9;
  if (ph >= 3) { l = (ph - 3) / 9; s = (ph - 3) - l * 9; }
  unsigned char* wl = p.ws + OFF_W + (size_t)l * SZ_WL;
  if (s == 9 || s == 5 || s == 8) {
    if (EN(5)) rowpass(p, l, s == 9 ? 0 : (s == 5 ? 1 : 2));
  } else if (s == 0 || s == 4 || s == 7) {
    const u16 *A, *Bt; u16* C; int lda, K, NT, ldc;
    if (s == 0) { A = (const u16*)(p.ws + OFF_H); lda = DM; Bt = (const u16*)(wl + OW_IN); K = DM; NT = PST / 128; C = (u16*)(p.ws + OFF_BIG); ldc = PST; }
    else if (s == 4) { A = (const u16*)(p.ws + OFF_BIG); lda = DM; Bt = (const u16*)(wl + OW_O); K = DM; NT = 8; C = (u16*)(p.ws + OFF_BIG + SZ_ACT); ldc = DM; }
    else { A = (const u16*)(p.ws + OFF_BIG); lda = FH; Bt = (const u16*)(wl + OW_2); K = FH; NT = 8; C = (u16*)(p.ws + OFF_YS); ldc = DM; }
    if (EN(0)) gemm_plain(A, lda, Bt, K, NT, C, ldc, smem);
  } else if (s == 1) {
    if (EN(1)) phase_mix(p, l, smem);
  } else if (s == 2) {
    if (EN(2)) phase_post(p, l);
  } else if (s == 3) {
    if (EN(3)) gemm_merge(p, l, smem);
  } else {
    if (EN(6)) gemm_swiglu((const u16*)(p.ws + OFF_H), (const u16*)(wl + OW_1), (u16*)(p.ws + OFF_BIG), smem);
  }
}

__global__ void __launch_bounds__(NTHR) hybrid_flow_mega(Params p, int ph0, int ph1) {
  __shared__ __attribute__((aligned(16))) unsigned char smem[114688];
  cg::grid_group grid = cg::this_grid();
  for (int ph = ph0; ph < ph1; ph++) {
    run_phase(p, ph, smem);
    if (ph + 1 < ph1) grid.sync();
  }
}

extern "C" void kernel_launch(void* const* d_in, const int* in_sizes, int n_in, void* d_out, int out_size, void* d_ws,
                              size_t ws_size, hipStream_t stream) {
  Params p{};
  const float** pp = (const float**)&p;
  for (int i = 0; i < 32; i++) pp[i] = (const float*)d_in[i];
  p.out = (float*)d_out;
  p.ws = (unsigned char*)d_ws;
  static int grid_blocks = 0;
  if (!grid_blocks) {
    int dev = 0, cus = 0, per_cu = 0;
    hipGetDevice(&dev);
    hipDeviceGetAttribute(&cus, hipDeviceAttributeMultiprocessorCount, dev);
    hipOccupancyMaxActiveBlocksPerMultiprocessor(&per_cu, hybrid_flow_mega, NTHR, 0);
    if (per_cu < 1) per_cu = 1;
    grid_blocks = cus * per_cu;
  }
#ifdef MULTI_LAUNCH
  for (int ph = 0; ph < NPHASE; ph++) {
    hipLaunchKernelGGL(hybrid_flow_mega, dim3(grid_blocks), dim3(NTHR), 0, stream, p, ph, ph + 1);
  }
#else
  int ph0 = 0, ph1 = NPHASE;
  void* args[] = {&p, &ph0, &ph1};
  hipError_t e = hipLaunchCooperativeKernel((void*)hybrid_flow_mega, dim3(grid_blocks), dim3(NTHR), args, 0, stream);
  if (e != hipSuccess) fprintf(stderr, "cooperative launch failed: %s (grid %d)\n", hipGetErrorString(e), grid_blocks);
#endif
}
```

```cpp
#include <hip/hip_runtime.h>
#include <hip/hip_cooperative_groups.h>
#include <cstdio>
namespace cg = cooperative_groups;

typedef unsigned short u16;
using bf16x8 = __attribute__((ext_vector_type(8))) short;
using f32x4 = __attribute__((ext_vector_type(4))) float;

#define DM 1024
#define NBATCH 8
#define SEQ 4096
#define LC 256
#define TPB 4352
#define NROWS 34816
#define PST 3328
#define YST 1792
#define FH 2816
#define INW 7408
#define NTHR 512
#define PA 0
#define PB 960
#define PC 2000
#define PD 2800
#define NPHASE 21

struct Params {
  const float *x, *c, *ctx, *c_ctx, *ada_w, *ada_b, *norm_g, *w_in, *gate_b, *w_branch, *w_out,
      *rwkv_mu, *rwkv_w0, *rwkv_w2, *rwkv_a0, *rwkv_a2, *rwkv_g2, *rwkv_kk, *rwkv_ka, *rwkv_rk, *rwkv_ln_g,
      *rwkv_ln_b, *gdn_conv, *gdn_a_log, *gdn_dt_bias, *gdn_norm_g, *gla_gw2, *gla_gb, *gla_norm_g, *attn_sink,
      *ffn_w1, *ffn_w2;
  float* out;
  unsigned char* ws;
};

constexpr size_t SZ_WL = 36700160;
constexpr size_t OW_IN = 0;
constexpr size_t OW_G = OW_IN + (size_t)PST * 1024 * 2;
constexpr size_t OW_B = OW_G + (size_t)4096 * 1024 * 2;
constexpr size_t OW_O = OW_B + (size_t)4 * 1024 * 256 * 2;
constexpr size_t OW_1 = OW_O + (size_t)1024 * 1024 * 2;
constexpr size_t OW_2 = OW_1 + (size_t)5632 * 1024 * 2;
static_assert(OW_2 + (size_t)1024 * FH * 2 == SZ_WL, "weights size");
constexpr size_t SZ_ACT = (size_t)NROWS * DM * 2;
constexpr size_t OFF_W = 0;
constexpr size_t OFF_XC = OFF_W + 2 * SZ_WL;
constexpr size_t OFF_MODP = OFF_XC + (size_t)NBATCH * LC * DM * 4;
constexpr size_t OFF_MOD = OFF_MODP + (size_t)2 * 8 * 9 * 6144 * 4;
constexpr size_t OFF_BC = OFF_MOD + (size_t)2 * 9 * 6144 * 4;
constexpr size_t OFF_H = OFF_BC + (size_t)NROWS * 8 * 4;
constexpr size_t OFF_YS = OFF_H + SZ_ACT;
constexpr size_t OFF_BIG = OFF_YS + (size_t)NROWS * YST * 2;
constexpr size_t WS_END = OFF_BIG + (size_t)NROWS * PST * 2;
static_assert(WS_END <= (size_t)536870912, "ws too large");

__device__ __forceinline__ int launder_tid() { int t = threadIdx.x; asm volatile("" : "+v"(t)); return t; }
#define TIDX (launder_tid())
__device__ __forceinline__ u16 f2bf(float f) {
  unsigned u = __float_as_uint(f);
  u += 0x7fffu + ((u >> 16) & 1u);
  return (u16)(u >> 16);
}
__device__ __forceinline__ float bf2f(u16 h) { return __uint_as_float(((unsigned)h) << 16); }
__device__ __forceinline__ unsigned pack2(float a, float b) { return (unsigned)f2bf(a) | ((unsigned)f2bf(b) << 16); }
__device__ __forceinline__ float sigm(float x) { return __builtin_amdgcn_rcpf(1.f + __expf(-x)); }
__device__ __forceinline__ float siluf(float x) { return x * __builtin_amdgcn_rcpf(1.f + __expf(-x)); }
__device__ __forceinline__ float rsq(float x) { return __builtin_amdgcn_rsqf(x); }
__device__ __forceinline__ float softplusf(float x) { return fmaxf(x, 0.f) + log1pf(__expf(-fabsf(x))); }
__device__ __forceinline__ float wsum(float v) {
#pragma unroll
  for (int o = 32; o > 0; o >>= 1) v += __shfl_xor(v, o);
  return v;
}
template <int CTRL>
__device__ __forceinline__ float dppf(float x) {
  return __int_as_float(__builtin_amdgcn_update_dpp(0, __float_as_int(x), CTRL, 0xf, 0xf, false));
}
__device__ __forceinline__ float red8(float x) {
  x += dppf<0xB1>(x);
  x += dppf<0x4E>(x);
  x += dppf<0x141>(x);
  return x;
}
__device__ __forceinline__ const float* xin_row(const Params& p, int r) {
  int b = r / TPB, t = r - b * TPB;
  return t < LC ? p.ctx + ((size_t)(b * LC + t)) * DM : p.x + ((size_t)(b * SEQ + t - LC)) * DM;
}
__device__ __forceinline__ float* x_row(const Params& p, int r) {
  int b = r / TPB, t = r - b * TPB;
  return t < LC ? (float*)(p.ws + OFF_XC) + ((size_t)(b * LC + t)) * DM : p.out + ((size_t)(b * SEQ + t - LC)) * DM;
}
__device__ __forceinline__ int mod_row(int r) {
  int b = r / TPB, t = r - b * TPB;
  return t < LC ? 8 : b;
}

struct MapId { int lim, off; __device__ int operator()(int n) const { return n < lim ? n + off : -1; } };
struct MapW1 { __device__ int operator()(int n) const { int q = n >> 5, s = n & 31; return s < 16 ? q * 16 + s : FH + q * 16 + (s - 16); } };

template <class Map>
__device__ __forceinline__ void conv_tile(const float* __restrict__ src, int ld, u16* __restrict__ dst, int K, int n0,
                                          int k0, Map map, float* tile) {
  const int tid = TIDX;
  const int nn = tid & 63, kr = tid >> 6;
  const int sc = map(n0 + nn);
#pragma unroll
  for (int ps = 0; ps < 8; ps++) {
    int kk = ps * 8 + kr;
    float v = sc >= 0 ? src[(size_t)(k0 + kk) * ld + sc] : 0.f;
    tile[kk * 65 + nn] = v;
  }
  __syncthreads();
  const int n2 = tid >> 3, kc = tid & 7;
  uint4 o;
  o.x = pack2(tile[(kc * 8 + 0) * 65 + n2], tile[(kc * 8 + 1) * 65 + n2]);
  o.y = pack2(tile[(kc * 8 + 2) * 65 + n2], tile[(kc * 8 + 3) * 65 + n2]);
  o.z = pack2(tile[(kc * 8 + 4) * 65 + n2], tile[(kc * 8 + 5) * 65 + n2]);
  o.w = pack2(tile[(kc * 8 + 6) * 65 + n2], tile[(kc * 8 + 7) * 65 + n2]);
  *(uint4*)(dst + (size_t)(n0 + n2) * K + k0 + kc * 8) = o;
  __syncthreads();
}

__device__ __forceinline__ void phase_init0(const Params& p, float* sm) {
  const int tid = TIDX;
  constexpr int NMOD = 192, NCONV = 4480 * 2;
  for (int it = blockIdx.x; it < NMOD + NCONV; it += gridDim.x) {
    if (it < NMOD) {
      int l = it / 96, rem = it - l * 96, cc = rem >> 3, ks = rem & 7;
      for (int i = tid; i < 9 * 128; i += NTHR) {
        int r = i >> 7, k = i & 127;
        float v = r < 8 ? p.c[r * DM + ks * 128 + k] : p.c_ctx[ks * 128 + k];
        sm[i] = siluf(v);
      }
      __syncthreads();
      const int n = cc * 512 + tid;
      const float* w = p.ada_w + ((size_t)l * DM + ks * 128) * 6144 + n;
      float acc[9];
#pragma unroll
      for (int r = 0; r < 9; r++) acc[r] = 0.f;
#pragma unroll 4
      for (int k = 0; k < 128; k++) {
        float wv = w[(size_t)k * 6144];
#pragma unroll
        for (int r = 0; r < 9; r++) acc[r] += sm[r * 128 + k] * wv;
      }
      float* mp = (float*)(p.ws + OFF_MODP) + ((size_t)(l * 8 + ks) * 9) * 6144 + n;
#pragma unroll
      for (int r = 0; r < 9; r++) mp[(size_t)r * 6144] = acc[r];
      __syncthreads();
    } else {
      int ci = it - NMOD;
      int l = ci / 4480, rem = ci - l * 4480;
      u16* wl = (u16*)(p.ws + OFF_W + (size_t)l * SZ_WL);
      if (rem < 832) {
        int nt = rem >> 4, kt = rem & 15;
        conv_tile(p.w_in + (size_t)l * DM * INW, INW, (u16*)((char*)wl + OW_IN), 1024, nt * 64, kt * 64, MapId{3312, 0}, sm);
      } else if (rem < 832 + 1024) {
        rem -= 832;
        int nt = rem >> 4, kt = rem & 15;
        conv_tile(p.w_in + (size_t)l * DM * INW, INW, (u16*)((char*)wl + OW_G), 1024, nt * 64, kt * 64, MapId{4096, 3312}, sm);
      } else if (rem < 1856 + 256) {
        rem -= 1856;
        int br = rem >> 6, r2 = rem & 63, nt = r2 >> 2, kt = r2 & 3;
        conv_tile(p.w_branch + ((size_t)(l * 4 + br)) * 256 * DM, DM, (u16*)((char*)wl + OW_B) + (size_t)br * 1024 * 256, 256,
                  nt * 64, kt * 64, MapId{1024, 0}, sm);
      } else if (rem < 2112 + 256) {
        rem -= 2112;
        int nt = rem >> 4, kt = rem & 15;
        conv_tile(p.w_out + (size_t)l * DM * DM, DM, (u16*)((char*)wl + OW_O), 1024, nt * 64, kt * 64, MapId{1024, 0}, sm);
      } else if (rem < 2368 + 1408) {
        rem -= 2368;
        int nt = rem >> 4, kt = rem & 15;
        conv_tile(p.ffn_w1 + (size_t)l * DM * 5632, 5632, (u16*)((char*)wl + OW_1), 1024, nt * 64, kt * 64, MapW1{}, sm);
      } else {
        rem -= 3776;
        int nt = rem / 44, kt = rem - nt * 44;
        conv_tile(p.ffn_w2 + (size_t)l * FH * DM, DM, (u16*)((char*)wl + OW_2), FH, nt * 64, kt * 64, MapId{1024, 0}, sm);
      }
    }
  }
}

__device__ __forceinline__ void phase_init1(const Params& p) {
  const float* mp = (const float*)(p.ws + OFF_MODP);
  float* mo = (float*)(p.ws + OFF_MOD);
  for (int i = blockIdx.x * NTHR + TIDX; i < 2 * 9 * 6144; i += gridDim.x * NTHR) {
    int l = i / (9 * 6144), rem = i - l * 9 * 6144, r = rem / 6144, n = rem - r * 6144;
    float s = p.ada_b[l * 6144 + n];
#pragma unroll
    for (int ks = 0; ks < 8; ks++) s += mp[((size_t)((l * 8 + ks) * 9 + r)) * 6144 + n];
    mo[i] = s;
  }
}

__device__ __forceinline__ void rowpass(const Params& p, int l, int mode) {
  const int lane = TIDX & 63, wv = TIDX >> 6;
  const float* MOD = (const float*)(p.ws + OFF_MOD);
  u16* H = (u16*)(p.ws + OFF_H);
  for (int r = blockIdx.x * 8 + wv; r < NROWS; r += gridDim.x * 8) {
    const int mr = mod_row(r);
    const float* modl = MOD + ((size_t)(l * 9 + mr)) * 6144;
    float xv[16];
    if (mode == 0) {
      const float* xs = xin_row(p, r);
#pragma unroll
      for (int i = 0; i < 4; i++) {
        float4 t = *(const float4*)(xs + i * 256 + lane * 4);
        xv[i * 4 + 0] = t.x; xv[i * 4 + 1] = t.y; xv[i * 4 + 2] = t.z; xv[i * 4 + 3] = t.w;
      }
    } else {
      const u16* src = (const u16*)(p.ws + (mode == 1 ? OFF_BIG + SZ_ACT : OFF_YS)) + (size_t)r * DM;
      const float* xs = (mode == 1 && l == 0) ? xin_row(p, r) : (const float*)x_row(p, r);
      float ov[16];
      float ss = 0.f;
#pragma unroll
      for (int i = 0; i < 4; i++) {
        uint2 t = *(const uint2*)(src + i * 256 + lane * 4);
        ov[i * 4 + 0] = bf2f((u16)(t.x & 0xffff)); ov[i * 4 + 1] = bf2f((u16)(t.x >> 16));
        ov[i * 4 + 2] = bf2f((u16)(t.y & 0xffff)); ov[i * 4 + 3] = bf2f((u16)(t.y >> 16));
      }
#pragma unroll
      for (int i = 0; i < 16; i++) ss += ov[i] * ov[i];
      ss = wsum(ss);
      const float inv = rsq(ss * (1.f / 1024.f) + 1e-6f);
      const float* ng = p.norm_g + (size_t)(l * 4 + (mode == 1 ? 1 : 3)) * DM;
      const float* gt = modl + (mode == 1 ? 2048 : 5120);
      float* xd = x_row(p, r);
#pragma unroll
      for (int i = 0; i < 4; i++) {
        const int col = i * 256 + lane * 4;
        float4 xo = *(const float4*)(xs + col);
        float4 g4 = *(const float4*)(gt + col);
        float4 n4 = *(const float4*)(ng + col);
        xv[i * 4 + 0] = xo.x + g4.x * (ov[i * 4 + 0] * inv * n4.x);
        xv[i * 4 + 1] = xo.y + g4.y * (ov[i * 4 + 1] * inv * n4.y);
        xv[i * 4 + 2] = xo.z + g4.z * (ov[i * 4 + 2] * inv * n4.z);
        xv[i * 4 + 3] = xo.w + g4.w * (ov[i * 4 + 3] * inv * n4.w);
        *(float4*)(xd + col) = make_float4(xv[i * 4 + 0], xv[i * 4 + 1], xv[i * 4 + 2], xv[i * 4 + 3]);
      }
    }
    int ln = l, ni = 0, sho = 0, sco = 1024;
    if (mode == 1) { ni = 2; sho = 3072; sco = 4096; }
    if (mode == 2) { if (l == 1) continue; ln = l + 1; }
    const float* modn = MOD + ((size_t)(ln * 9 + mr)) * 6144;
    const float* ng2 = p.norm_g + (size_t)(ln * 4 + ni) * DM;
    float ss2 = 0.f;
#pragma unroll
    for (int i = 0; i < 16; i++) ss2 += xv[i] * xv[i];
    ss2 = wsum(ss2);
    const float inv2 = rsq(ss2 * (1.f / 1024.f) + 1e-6f);
#pragma unroll
    for (int i = 0; i < 4; i++) {
      const int col = i * 256 + lane * 4;
      float4 n4 = *(const float4*)(ng2 + col);
      float4 sc = *(const float4*)(modn + sco + col);
      float4 sh = *(const float4*)(modn + sho + col);
      float h0 = xv[i * 4 + 0] * inv2 * n4.x * (1.f + sc.x) + sh.x;
      float h1 = xv[i * 4 + 1] * inv2 * n4.y * (1.f + sc.y) + sh.y;
      float h2 = xv[i * 4 + 2] * inv2 * n4.z * (1.f + sc.z) + sh.z;
      float h3 = xv[i * 4 + 3] * inv2 * n4.w * (1.f + sc.w) + sh.w;
      uint2 o;
      o.x = pack2(h0, h1);
      o.y = pack2(h2, h3);
      *(uint2*)(H + (size_t)r * DM + col) = o;
    }
  }
}

#define LDT 72
template <int MI>
__device__ __forceinline__ void gemm_loop(const u16* __restrict__ A, int lda, const u16* __restrict__ Bt, int ldb, int K,
                                          f32x4 (&acc)[MI][4], u16* sA, u16* sB) {
  constexpr int BMT = MI * 64;
  const int tid = TIDX, lane = tid & 63, w = tid >> 6, wm = w >> 1, wn = w & 1, fr = lane & 15, fq = lane >> 4;
  uint4 ra[MI], rb[2];
  const u16* ga = A + (size_t)(tid >> 3) * lda + (tid & 7) * 8;
  const u16* gb = Bt + (size_t)(tid >> 3) * ldb + (tid & 7) * 8;
  const int so = (tid >> 3) * LDT + (tid & 7) * 8;
#pragma unroll
  for (int i = 0; i < MI; i++) ra[i] = *(const uint4*)(ga + (size_t)(i * 64) * lda);
#pragma unroll
  for (int i = 0; i < 2; i++) rb[i] = *(const uint4*)(gb + (size_t)(i * 64) * ldb);
#pragma unroll
  for (int i = 0; i < MI; i++) *(uint4*)(sA + so + i * 64 * LDT) = ra[i];
#pragma unroll
  for (int i = 0; i < 2; i++) *(uint4*)(sB + so + i * 64 * LDT) = rb[i];
  __syncthreads();
  const int nk = K >> 6;
  for (int kt = 0; kt < nk; kt++) {
    const bool more = kt + 1 < nk;
    if (more) {
#pragma unroll
      for (int i = 0; i < MI; i++) ra[i] = *(const uint4*)(ga + (size_t)(i * 64) * lda + (kt + 1) * 64);
#pragma unroll
      for (int i = 0; i < 2; i++) rb[i] = *(const uint4*)(gb + (size_t)(i * 64) * ldb + (kt + 1) * 64);
    }
    const u16* a = sA + (kt & 1) * BMT * LDT + (wm * (MI * 16) + fr) * LDT + fq * 8;
    const u16* b = sB + (kt & 1) * 128 * LDT + (wn * 64 + fr) * LDT + fq * 8;
#pragma unroll
    for (int ks = 0; ks < 2; ks++) {
      bf16x8 af[MI], bfr[4];
#pragma unroll
      for (int i = 0; i < MI; i++) af[i] = *(const bf16x8*)(a + i * 16 * LDT + ks * 32);
#pragma unroll
      for (int j = 0; j < 4; j++) bfr[j] = *(const bf16x8*)(b + j * 16 * LDT + ks * 32);
#pragma unroll
      for (int i = 0; i < MI; i++)
#pragma unroll
        for (int j = 0; j < 4; j++) acc[i][j] = __builtin_amdgcn_mfma_f32_16x16x32_bf16(af[i], bfr[j], acc[i][j], 0, 0, 0);
    }
    if (more) {
      u16* da = sA + ((kt + 1) & 1) * BMT * LDT + so;
      u16* db = sB + ((kt + 1) & 1) * 128 * LDT + so;
#pragma unroll
      for (int i = 0; i < MI; i++) *(uint4*)(da + i * 64 * LDT) = ra[i];
#pragma unroll
      for (int i = 0; i < 2; i++) *(uint4*)(db + i * 64 * LDT) = rb[i];
    }
    __syncthreads();
  }
}

template <int MI>
__device__ __forceinline__ void zero_acc(f32x4 (&acc)[MI][4]) {
#pragma unroll
  for (int i = 0; i < MI; i++)
#pragma unroll
    for (int j = 0; j < 4; j++) acc[i][j] = f32x4{0.f, 0.f, 0.f, 0.f};
}

__device__ __forceinline__ void gemm_plain(const u16* A, int lda, const u16* Bt, int K, int NT, u16* C, int ldc, unsigned char* smem) {
  u16* sA = (u16*)smem;
  u16* sB = sA + 2 * 256 * LDT;
  const int lane = TIDX & 63, w = TIDX >> 6, wm = w >> 1, wn = w & 1, fr = lane & 15, fq = lane >> 4;
  const int ntiles = (NROWS / 256) * NT;
  for (int t = blockIdx.x; t < ntiles; t += gridDim.x) {
    const int mt = t / NT, nt = t - mt * NT;
    f32x4 acc[4][4];
    zero_acc<4>(acc);
    gemm_loop<4>(A + (size_t)mt * 256 * lda, lda, Bt + (size_t)nt * 128 * K, K, K, acc, sA, sB);
    const int r0 = mt * 256 + wm * 64 + fq * 4, c0 = nt * 128 + wn * 64 + fr;
#pragma unroll
    for (int i = 0; i < 4; i++)
#pragma unroll
      for (int j = 0; j < 4; j++)
#pragma unroll
        for (int r = 0; r < 4; r++) C[(size_t)(r0 + i * 16 + r) * ldc + c0 + j * 16] = f2bf(acc[i][j][r]);
  }
}

__device__ __forceinline__ void gemm_swiglu(const u16* A, const u16* Bt, u16* C, unsigned char* smem) {
  u16* sA = (u16*)smem;
  u16* sB = sA + 2 * 256 * LDT;
  const int lane = TIDX & 63, w = TIDX >> 6, wm = w >> 1, wn = w & 1, fr = lane & 15, fq = lane >> 4;
  constexpr int NT = 44;
  const int ntiles = (NROWS / 256) * NT;
  for (int t = blockIdx.x; t < ntiles; t += gridDim.x) {
    const int mt = t / NT, nt = t - mt * NT;
    f32x4 acc[4][4];
    zero_acc<4>(acc);
    gemm_loop<4>(A + (size_t)mt * 256 * DM, DM, Bt + (size_t)nt * 128 * DM, DM, DM, acc, sA, sB);
    const int r0 = mt * 256 + wm * 64 + fq * 4, c0 = nt * 64 + wn * 32 + fr;
#pragma unroll
    for (int i = 0; i < 4; i++)
#pragma unroll
      for (int jj = 0; jj < 2; jj++)
#pragma unroll
        for (int r = 0; r < 4; r++) {
          float g = acc[i][jj * 2][r], u = acc[i][jj * 2 + 1][r];
          C[(size_t)(r0 + i * 16 + r) * FH + c0 + jj * 16] = f2bf(siluf(g) * u);
        }
  }
}

__device__ __forceinline__ void gemm_merge(const Params& p, int l, unsigned char* smem) {
  u16* sA = (u16*)smem;
  u16* sB = sA + 2 * 256 * LDT;
  const int lane = TIDX & 63, w = TIDX >> 6, wm = w >> 1, wn = w & 1, fr = lane & 15, fq = lane >> 4;
  const u16* H = (const u16*)(p.ws + OFF_H);
  const u16* Y = (const u16*)(p.ws + OFF_YS);
  const u16* Wg = (const u16*)(p.ws + OFF_W + (size_t)l * SZ_WL + OW_G);
  const u16* Wb = (const u16*)(p.ws + OFF_W + (size_t)l * SZ_WL + OW_B);
  u16* C = (u16*)(p.ws + OFF_BIG);
  constexpr int NT = 8;
  const int ntiles = (NROWS / 128) * NT;
  for (int t = blockIdx.x; t < ntiles; t += gridDim.x) {
    const int mt = t / NT, nt = t - mt * NT;
    f32x4 tot[2][4];
    zero_acc<2>(tot);
    const int c0 = nt * 128 + wn * 64 + fr;
#pragma unroll 1
    for (int br = 0; br < 4; br++) {
      f32x4 ag[2][4];
      zero_acc<2>(ag);
      gemm_loop<2>(H + (size_t)mt * 128 * DM, DM, Wg + ((size_t)br * 1024 + nt * 128) * DM, DM, DM, ag, sA, sB);
#pragma unroll
      for (int j = 0; j < 4; j++) {
        const float gb = p.gate_b[(l * 4 + br) * DM + c0 + j * 16];
#pragma unroll
        for (int i = 0; i < 2; i++)
#pragma unroll
          for (int r = 0; r < 4; r++) ag[i][j][r] = sigm(ag[i][j][r] + gb);
      }
      f32x4 ay[2][4];
      zero_acc<2>(ay);
      const int ycol = br < 3 ? br * 256 : 1536;
      gemm_loop<2>(Y + (size_t)mt * 128 * YST + ycol, YST, Wb + ((size_t)br * 1024 + nt * 128) * 256, 256, 256, ay, sA, sB);
#pragma unroll
      for (int i = 0; i < 2; i++)
#pragma unroll
        for (int j = 0; j < 4; j++)
#pragma unroll
          for (int r = 0; r < 4; r++) tot[i][j][r] += ag[i][j][r] * ay[i][j][r];
    }
    const int r0 = mt * 128 + wm * 32 + fq * 4;
#pragma unroll
    for (int i = 0; i < 2; i++)
#pragma unroll
      for (int j = 0; j < 4; j++)
#pragma unroll
        for (int r = 0; r < 4; r++) C[(size_t)(r0 + i * 16 + r) * DM + c0 + j * 16] = f2bf(tot[i][j][r]);
  }
}

#define S2_BUF 10816
#define S2_D 0
#define S2_U 2048
#define S2_P 4096
#define S2_K 6144
#define S2_DQ 8192
#define S2_V 10240
#define S2_C1 10752
#define S2_C2 10784
#define S2_ST (2 * S2_BUF)
#define S2_YB (S2_ST + 8192)

__device__ __forceinline__ float red16(float x) {
  x += dppf<0xB1>(x);
  x += dppf<0x4E>(x);
  x += dppf<0x141>(x);
  x += dppf<0x140>(x);
  return x;
}
__device__ __forceinline__ void wave_lds_sync() {
  asm volatile("s_waitcnt lgkmcnt(0)" ::: "memory");
  __builtin_amdgcn_wave_barrier();
}

template <int MIX>
__device__ __forceinline__ void scan2_item(const Params& p, int l, int b, int h, int dir, int rq, float* sm) {
  constexpr int EPL = (MIX == 2) ? 2 : 4;
  constexpr int VOFF = (MIX == 2) ? 64 : 128;
  const int tid = TIDX, lane = tid & 63, w = tid >> 6, fr = lane & 15, fq = lane >> 4;
  const bool producer = w >= 4;
  const int pw = w & 3;
  const u16* P = (const u16*)(p.ws + OFF_BIG);
  u16* YS = (u16*)(p.ws + OFF_YS);
  float* BC = (float*)(p.ws + OFF_BC);
  float* ST = sm + S2_ST + pw * 2048;
  float s[EPL];
#pragma unroll
  for (int i = 0; i < EPL; i++) s[i] = 0.f;

  bf16x8 bw2[4], ba2[4];
  float cst[5][4];
  float cw[3][7];
  float muv[4];
  int colv[4];
#pragma unroll
  for (int i = 0; i < 4; i++) { bw2[i] = bf16x8{0, 0, 0, 0, 0, 0, 0, 0}; ba2[i] = bw2[i]; muv[i] = 0.f; colv[i] = 0; }
  if (producer) {
    if (MIX == 0) {
#pragma unroll
      for (int nt = 0; nt < 4; nt++) {
        const int jch = h * 64 + nt * 16 + fr;
#pragma unroll
        for (int jj = 0; jj < 8; jj++) {
          bw2[nt][jj] = (short)f2bf(p.rwkv_w2[((size_t)(l * 2 + dir) * 32 + fq * 8 + jj) * 256 + jch]);
          ba2[nt][jj] = (short)f2bf(p.rwkv_a2[((size_t)(l * 2 + dir) * 32 + fq * 8 + jj) * 256 + jch]);
        }
        cst[0][nt] = p.rwkv_w0[(l * 2 + dir) * 256 + jch];
        cst[1][nt] = p.rwkv_a0[(l * 2 + dir) * 256 + jch];
        cst[2][nt] = p.rwkv_ka[l * 256 + jch];
        cst[3][nt] = p.rwkv_kk[l * 256 + jch];
        cst[4][nt] = p.rwkv_rk[l * 256 + jch];
      }
#pragma unroll
      for (int i = 0; i < 4; i++) {
        const int c = lane + 64 * i;
        colv[i] = i < 3 ? i * 256 + h * 64 + lane : (lane < 32 ? 768 + dir * 32 + lane : 832 + dir * 32 + (lane - 32));
        muv[i] = p.rwkv_mu[l * 960 + colv[i]];
        (void)c;
      }
    } else if (MIX == 1) {
#pragma unroll
      for (int i = 0; i < 3; i++) {
        colv[i] = PB + i * 256 + h * 64 + lane;
#pragma unroll
        for (int tp = 0; tp < 7; tp++) cw[i][tp] = p.gdn_conv[((size_t)l * 7 + tp) * 768 + i * 256 + h * 64 + lane];
      }
    } else {
#pragma unroll
      for (int nt = 0; nt < 2; nt++) {
#pragma unroll
        for (int jj = 0; jj < 8; jj++)
          bw2[nt][jj] = fq < 2 ? (short)f2bf(p.gla_gw2[((size_t)(l * 2 + dir) * 16 + fq * 8 + jj) * 128 + h * 32 + nt * 16 + fr]) : (short)0;
        cst[0][nt] = p.gla_gb[(l * 2 + dir) * 128 + h * 32 + nt * 16 + fr];
      }
      colv[0] = PC + h * 32 + lane;
      if (lane >= 32) colv[0] = PC + 128 + h * 32 + (lane - 32);
      colv[1] = PC + 256 + h * 64 + lane;
      colv[2] = PC + 512 + dir * 16 + (lane & 15);
    }
  }
  __syncthreads();

  for (int c = 0; c <= TPB / 32 + 1; c++) {
    if (producer) {
      if (c >= 2) {
        const int cc = c - 2;
        int seg_row0, t_lo;
        if (cc < 8) { seg_row0 = b * TPB; t_lo = dir == 0 ? cc * 32 : (LC - 32 - cc * 32); }
        else { seg_row0 = b * TPB + LC; t_lo = dir == 0 ? (cc - 8) * 32 : (SEQ - 32 - (cc - 8) * 32); }
        const float* yb = sm + S2_YB + (cc & 1) * 512;
        const int t2 = tid - 256;
#pragma unroll
        for (int i = 0; i < 2; i++) {
          const int idx = t2 + i * 256, tt = idx >> 4, e = idx & 15;
          YS[(size_t)(seg_row0 + t_lo + tt) * YST + dir * 768 + MIX * 256 + h * 64 + rq * 16 + e] = f2bf(yb[idx]);
        }
      }
      if (c < TPB / 32) {
        int seg_row0, seg_len, t_lo;
        if (c < 8) { seg_row0 = b * TPB; seg_len = LC; t_lo = dir == 0 ? c * 32 : (LC - 32 - c * 32); }
        else { seg_row0 = b * TPB + LC; seg_len = SEQ; t_lo = dir == 0 ? (c - 8) * 32 : (SEQ - 32 - (c - 8) * 32); }
        const u16* Pseg = P + (size_t)seg_row0 * PST;
        float* B = sm + (c & 1) * S2_BUF;
        const int t0 = t_lo + pw * 8;
        if (MIX == 0) {
          float raw[10][4];
#pragma unroll
          for (int rr = 0; rr < 10; rr++) {
            const int t = t0 - 1 + rr;
            const float okf = (t >= 0 && t < seg_len) ? 1.f : 0.f;
            const int tc = min(max(t, 0), seg_len - 1);
#pragma unroll
            for (int i = 0; i < 4; i++) raw[rr][i] = bf2f(Pseg[(size_t)tc * PST + PA + colv[i]]) * okf;
          }
#pragma unroll
          for (int j = 0; j < 8; j++)
#pragma unroll
            for (int i = 0; i < 4; i++) {
              float xm = raw[j + 1][i] + (0.5f * (raw[j][i] + raw[j + 2][i]) - raw[j + 1][i]) * muv[i];
              if (i == 3 && lane < 32) xm = tanhf(xm);
              ST[j * 256 + lane + 64 * i] = xm;
            }
        } else if (MIX == 1) {
          float raw[14][3];
#pragma unroll
          for (int rr = 0; rr < 14; rr++) {
            const int t = t0 - 3 + rr;
            const float okf = (t >= 0 && t < seg_len) ? 1.f : 0.f;
            const int tc = min(max(t, 0), seg_len - 1);
#pragma unroll
            for (int i = 0; i < 3; i++) raw[rr][i] = bf2f(Pseg[(size_t)tc * PST + colv[i]]) * okf;
          }
#pragma unroll
          for (int j = 0; j < 8; j++)
#pragma unroll
            for (int i = 0; i < 3; i++) {
              float a = 0.f;
#pragma unroll
              for (int tp = 0; tp < 7; tp++) a += raw[j + tp][i] * cw[i][tp];
              ST[j * 256 + lane + 64 * i] = siluf(a);
            }
          if (lane < 8) {
            const u16* pp = Pseg + (size_t)(t0 + lane) * PST + PB;
            float bx = bf2f(pp[768 + dir * 4 + h]);
            float ax = bf2f(pp[776 + dir * 4 + h]);
            float ld = -__expf(p.gdn_a_log[(l * 2 + dir) * 4 + h]) * softplusf(ax + p.gdn_dt_bias[(l * 2 + dir) * 4 + h]);
            ST[lane * 256 + 192] = sigm(bx);
            ST[lane * 256 + 193] = __expf(ld);
          }
        } else {
          u16 raw[8][3];
#pragma unroll
          for (int j = 0; j < 8; j++) {
            const u16* pp = Pseg + (size_t)(t0 + j) * PST;
#pragma unroll
            for (int i = 0; i < 3; i++) raw[j][i] = pp[colv[i]];
          }
          const float qs = lane < 32 ? 0.17677669529663687f : 1.f;
#pragma unroll
          for (int j = 0; j < 8; j++) {
            ST[j * 256 + lane] = bf2f(raw[j][0]) * qs;
            ST[j * 256 + 64 + lane] = bf2f(raw[j][1]);
            if (lane < 16) ST[j * 256 + 128 + lane] = bf2f(raw[j][2]);
          }
        }
        wave_lds_sync();
        const bool vl = fq < 2;
        if (MIX == 0) {
          bf16x8 aw, aa;
#pragma unroll
          for (int jj = 0; jj < 8; jj++) {
            aw[jj] = fr < 8 ? (short)f2bf(ST[fr * 256 + 192 + fq * 8 + jj]) : (short)0;
            aa[jj] = fr < 8 ? (short)f2bf(ST[fr * 256 + 224 + fq * 8 + jj]) : (short)0;
          }
          f32x4 accw[4], acca[4];
#pragma unroll
          for (int nt = 0; nt < 4; nt++) {
            accw[nt] = __builtin_amdgcn_mfma_f32_16x16x32_bf16(aw, bw2[nt], f32x4{0.f, 0.f, 0.f, 0.f}, 0, 0, 0);
            acca[nt] = __builtin_amdgcn_mfma_f32_16x16x32_bf16(aa, ba2[nt], f32x4{0.f, 0.f, 0.f, 0.f}, 0, 0, 0);
          }
#pragma unroll
          for (int r = 0; r < 4; r++) {
            const int j = (fq & 1) * 4 + r, tt = pw * 8 + j;
            float kkx[4], av[4], kdv[4], rv[4], dec[4];
            float ss = 0.f;
#pragma unroll
            for (int nt = 0; nt < 4; nt++) {
              const int n = nt * 16 + fr;
              rv[nt] = ST[j * 256 + n];
              const float kx = ST[j * 256 + 64 + n];
              dec[nt] = __expf(-0.6065306597126334f * sigm(cst[0][nt] + accw[nt][r]));
              av[nt] = sigm(cst[1][nt] + acca[nt][r]);
              kdv[nt] = kx * (1.f + (av[nt] - 1.f) * cst[2][nt]);
              kkx[nt] = kx * cst[3][nt];
              ss += kkx[nt] * kkx[nt];
            }
            ss = red16(ss);
            const float rs = rsq(ss + 1e-6f);
            float c1 = 0.f, c2 = 0.f, bc = 0.f;
#pragma unroll
            for (int nt = 0; nt < 4; nt++) {
              const int n = nt * 16 + fr;
              const float kk = kkx[nt] * rs;
              if (vl) {
                B[S2_D + tt * 64 + n] = dec[nt];
                B[S2_U + tt * 64 + n] = kk;
                B[S2_P + tt * 64 + n] = -kk * av[nt];
                B[S2_K + tt * 64 + n] = kdv[nt];
                B[S2_DQ + tt * 64 + n] = dec[nt] * rv[nt];
              }
              c1 += -kk * av[nt] * rv[nt];
              c2 += kdv[nt] * rv[nt];
              bc += rv[nt] * kdv[nt] * cst[4][nt];
            }
            c1 = red16(c1); c2 = red16(c2); bc = red16(bc);
            if (vl && fr == 0) {
              B[S2_C1 + tt] = c1;
              B[S2_C2 + tt] = c2;
              if (rq == 0) BC[(size_t)(seg_row0 + t_lo + tt) * 8 + h * 2 + dir] = bc;
            }
          }
        } else if (MIX == 1) {
#pragma unroll
          for (int r = 0; r < 4; r++) {
            const int j = (fq & 1) * 4 + r, tt = pw * 8 + j;
            float qv[4], kv[4];
            float sq = 0.f, sk = 0.f;
#pragma unroll
            for (int nt = 0; nt < 4; nt++) {
              const int n = nt * 16 + fr;
              qv[nt] = ST[j * 256 + n];
              kv[nt] = ST[j * 256 + 64 + n];
              sq += qv[nt] * qv[nt];
              sk += kv[nt] * kv[nt];
            }
            sq = red16(sq); sk = red16(sk);
            const float rq_ = rsq(sq + 1e-6f) * 0.125f, rk_ = rsq(sk + 1e-6f);
            const float beta = ST[j * 256 + 192], alpha = ST[j * 256 + 193];
            float dkq = 0.f;
#pragma unroll
            for (int nt = 0; nt < 4; nt++) {
              const int n = nt * 16 + fr;
              const float qn = qv[nt] * rq_, kn = kv[nt] * rk_;
              if (vl) {
                B[S2_D + tt * 64 + n] = alpha;
                B[S2_U + tt * 64 + n] = kn;
                B[S2_P + tt * 64 + n] = -alpha * beta * kn;
                B[S2_K + tt * 64 + n] = beta * kn;
                B[S2_DQ + tt * 64 + n] = alpha * qn;
              }
              dkq += kn * qn;
            }
            dkq = red16(dkq);
            if (vl && fr == 0) {
              B[S2_C1 + tt] = -alpha * beta * dkq;
              B[S2_C2 + tt] = beta * dkq;
            }
          }
        } else {
          bf16x8 ag;
#pragma unroll
          for (int jj = 0; jj < 8; jj++) ag[jj] = (fr < 8 && fq < 2) ? (short)f2bf(ST[fr * 256 + 128 + fq * 8 + jj]) : (short)0;
          f32x4 accg[2];
#pragma unroll
          for (int nt = 0; nt < 2; nt++) accg[nt] = __builtin_amdgcn_mfma_f32_16x16x32_bf16(ag, bw2[nt], f32x4{0.f, 0.f, 0.f, 0.f}, 0, 0, 0);
#pragma unroll
          for (int r = 0; r < 4; r++) {
            const int j = (fq & 1) * 4 + r, tt = pw * 8 + j;
            float dkq = 0.f;
#pragma unroll
            for (int nt = 0; nt < 2; nt++) {
              const int n = nt * 16 + fr;
              const float lg = cst[0][nt] + accg[nt][r];
              const float ls = fminf(lg, 0.f) - log1pf(__expf(-fabsf(lg)));
              const float alpha = __expf(ls * (1.f / 16.f));
              const float qv = ST[j * 256 + n], kv = ST[j * 256 + 32 + n];
              if (vl) {
                B[S2_D + tt * 64 + n] = alpha;
                B[S2_K + tt * 64 + n] = kv;
                B[S2_DQ + tt * 64 + n] = alpha * qv;
              }
              dkq += kv * qv;
            }
            dkq = red16(dkq);
            if (vl && fr == 0) B[S2_C2 + tt] = dkq;
          }
        }
#pragma unroll
        for (int i = 0; i < 2; i++) {
          const int idx = lane + 64 * i, j = idx >> 4, e = idx & 15;
          B[S2_V + (pw * 8 + j) * 16 + e] = ST[j * 256 + VOFF + rq * 16 + e];
        }
      }
    } else if (c >= 1 && c <= TPB / 32) {
      const float* B = sm + ((c - 1) & 1) * S2_BUF;
      float* yb = sm + S2_YB + ((c - 1) & 1) * 512;
      const int rl = w * 4 + fq;
#pragma unroll 4
      for (int st = 0; st < 32; st++) {
        const int tt = dir ? 31 - st : st;
        const int o = tt * 64 + fr * EPL;
        float dv[EPL], kv[EPL], qv[EPL], uv[EPL], pv[EPL];
        if (EPL == 4) {
          float4 t4 = *(const float4*)(B + S2_D + o);
          dv[0] = t4.x; dv[1] = t4.y; dv[2] = t4.z; dv[3] = t4.w;
          t4 = *(const float4*)(B + S2_K + o);
          kv[0] = t4.x; kv[1] = t4.y; kv[2] = t4.z; kv[3] = t4.w;
          t4 = *(const float4*)(B + S2_DQ + o);
          qv[0] = t4.x; qv[1] = t4.y; qv[2] = t4.z; qv[3] = t4.w;
          t4 = *(const float4*)(B + S2_U + o);
          uv[0] = t4.x; uv[1] = t4.y; uv[2] = t4.z; uv[3] = t4.w;
          t4 = *(const float4*)(B + S2_P + o);
          pv[0] = t4.x; pv[1] = t4.y; pv[2] = t4.z; pv[3] = t4.w;
        } else {
          float2 t2 = *(const float2*)(B + S2_D + o);
          dv[0] = t2.x; dv[1] = t2.y;
          t2 = *(const float2*)(B + S2_K + o);
          kv[0] = t2.x; kv[1] = t2.y;
          t2 = *(const float2*)(B + S2_DQ + o);
          qv[0] = t2.x; qv[1] = t2.y;
          uv[0] = uv[1] = pv[0] = pv[1] = 0.f;
        }
        const float vv = B[S2_V + tt * 16 + rl];
        const float c2 = B[S2_C2 + tt];
        float sq = 0.f, sa = 0.f;
#pragma unroll
        for (int i = 0; i < EPL; i++) sq += s[i] * qv[i];
        if (MIX != 2) {
#pragma unroll
          for (int i = 0; i < EPL; i++) sa += s[i] * uv[i];
          sa = red16(sa);
        }
        sq = red16(sq);
        float y = sq + vv * c2;
        if (MIX != 2) y += sa * B[S2_C1 + tt];
#pragma unroll
        for (int i = 0; i < EPL; i++) {
          float t = s[i] * dv[i] + vv * kv[i];
          if (MIX != 2) t += sa * pv[i];
          s[i] = t;
        }
        yb[tt * 16 + rl] = y;
      }
    }
    __syncthreads();
  }
}

__device__ __forceinline__ void attn_item(const Params& p, int l, int b, int qb, int hk, bool isctx, unsigned char* smem) {
  u16* KS = (u16*)smem;
  u16* VT = KS + 64 * LDT;
  u16* PL = VT + 64 * LDT;
  float2* ROPE = (float2*)(PL + 8 * 32 * LDT);
  const int tid = TIDX, lane = tid & 63, w = tid >> 6, fr = lane & 15, fq = lane >> 4;
  const u16* P = (const u16*)(p.ws + OFF_BIG);
  u16* Y = (u16*)(p.ws + OFF_YS);
  const int qh = hk * 2 + (w >> 2);
  const int tb = qb * 128 + (w & 3) * 32;
  const int qrow0 = b * TPB + (isctx ? 0 : LC);
  __syncthreads();
  for (int i = tid; i < 1024; i += NTHR) {
    int pos = i >> 4, fi = i & 15;
    float inv = powf(10000.f, -(float)fi / 16.f);
    float sn, cs;
    sincosf((float)pos * inv, &sn, &cs);
    ROPE[i] = make_float2(cs, sn);
  }
  __syncthreads();
  bf16x8 qf[2][2];
#pragma unroll
  for (int mi = 0; mi < 2; mi++)
#pragma unroll
    for (int ks = 0; ks < 2; ks++) {
      const int tq = tb + mi * 16 + fr;
      const u16* qp = P + (size_t)(qrow0 + tq) * PST + PD + qh * 64 + ks * 32;
      uint4 own = *(const uint4*)(qp + fq * 8);
      uint4 par = *(const uint4*)(qp + (fq ^ 2) * 8);
      const unsigned ow[4] = {own.x, own.y, own.z, own.w};
      const unsigned pw[4] = {par.x, par.y, par.z, par.w};
      const int pos = ks == 0 ? (tq >> 6) : (tq & 63);
      bf16x8 f;
#pragma unroll
      for (int jj = 0; jj < 8; jj++) {
        float xo = bf2f((u16)((ow[jj >> 1] >> ((jj & 1) * 16)) & 0xffff));
        float xp = bf2f((u16)((pw[jj >> 1] >> ((jj & 1) * 16)) & 0xffff));
        float v = xo;
        if (!isctx) {
          float2 cs = ROPE[pos * 16 + (fq & 1) * 8 + jj];
          v = fq < 2 ? xo * cs.x - xp * cs.y : xp * cs.y + xo * cs.x;
        }
        f[jj] = (short)f2bf(v * 0.125f);
      }
      qf[mi][ks] = f;
    }
  f32x4 oacc[2][4];
#pragma unroll
  for (int mi = 0; mi < 2; mi++)
#pragma unroll
    for (int nd = 0; nd < 4; nd++) oacc[mi][nd] = f32x4{0.f, 0.f, 0.f, 0.f};
  float mrow[2][4], lrow[2][4];
#pragma unroll
  for (int mi = 0; mi < 2; mi++)
#pragma unroll
    for (int r = 0; r < 4; r++) { mrow[mi][r] = -1e30f; lrow[mi][r] = 0.f; }

  const int q0 = qb * 128;
  const int band_lo = isctx ? 0 : max(0, q0 - 128), band_hi = isctx ? 0 : min(SEQ, q0 + 256);
  const int ntile = 4 + (band_hi - band_lo) / 64;
  u16* pl = PL + w * 32 * LDT;
  for (int tl = 0; tl < ntile; tl++) {
    const bool band = tl >= 4;
    const int k0 = band ? band_lo + (tl - 4) * 64 : tl * 64;
    __syncthreads();
    {
      const int key = tid >> 3, kc = tid & 7;
      const int kpos = k0 + key;
      const u16* kp = P + (size_t)(b * TPB + (band ? LC : 0) + kpos) * PST + PD + 256 + hk * 64;
      uint4 own = *(const uint4*)(kp + kc * 8);
      uint4 vv = *(const uint4*)(kp + 128 + kc * 8);
      uint4 par = *(const uint4*)(kp + (kc ^ 2) * 8);
      if (band) {
        const unsigned ow[4] = {own.x, own.y, own.z, own.w};
        const unsigned pw[4] = {par.x, par.y, par.z, par.w};
        const int pos = kc < 4 ? (kpos >> 6) : (kpos & 63);
        unsigned res[4];
#pragma unroll
        for (int jj = 0; jj < 8; jj += 2) {
          float v2[2];
#pragma unroll
          for (int e = 0; e < 2; e++) {
            float xo = bf2f((u16)((ow[jj >> 1] >> (e * 16)) & 0xffff));
            float xp = bf2f((u16)((pw[jj >> 1] >> (e * 16)) & 0xffff));
            float2 cs = ROPE[pos * 16 + (kc & 1) * 8 + jj + e];
            v2[e] = (kc & 2) == 0 ? xo * cs.x - xp * cs.y : xp * cs.y + xo * cs.x;
          }
          res[jj >> 1] = pack2(v2[0], v2[1]);
        }
        own = make_uint4(res[0], res[1], res[2], res[3]);
      }
      *(uint4*)(KS + key * LDT + kc * 8) = own;
      const unsigned vw[4] = {vv.x, vv.y, vv.z, vv.w};
#pragma unroll
      for (int jj = 0; jj < 8; jj++) VT[(kc * 8 + jj) * LDT + key] = (u16)((vw[jj >> 1] >> ((jj & 1) * 16)) & 0xffff);
    }
    __syncthreads();
    f32x4 sc[2][4];
#pragma unroll
    for (int mi = 0; mi < 2; mi++)
#pragma unroll
      for (int nj = 0; nj < 4; nj++) sc[mi][nj] = f32x4{0.f, 0.f, 0.f, 0.f};
#pragma unroll
    for (int ks = 0; ks < 2; ks++) {
      bf16x8 kf[4];
#pragma unroll
      for (int nj = 0; nj < 4; nj++) kf[nj] = *(const bf16x8*)(KS + (nj * 16 + fr) * LDT + ks * 32 + fq * 8);
#pragma unroll
      for (int mi = 0; mi < 2; mi++)
#pragma unroll
        for (int nj = 0; nj < 4; nj++) sc[mi][nj] = __builtin_amdgcn_mfma_f32_16x16x32_bf16(qf[mi][ks], kf[nj], sc[mi][nj], 0, 0, 0);
    }
#pragma unroll
    for (int mi = 0; mi < 2; mi++)
#pragma unroll
      for (int r = 0; r < 4; r++) {
        const int qpos = tb + mi * 16 + fq * 4 + r;
        float mx = -1e30f;
#pragma unroll
        for (int nj = 0; nj < 4; nj++) {
          float v = sc[mi][nj][r];
          if (band) {
            int d = qpos - (k0 + nj * 16 + fr);
            if (d > 128 || d < -128) v = -1e30f;
          }
          sc[mi][nj][r] = v;
          mx = fmaxf(mx, v);
        }
        mx = fmaxf(mx, __shfl_xor(mx, 1));
        mx = fmaxf(mx, __shfl_xor(mx, 2));
        mx = fmaxf(mx, __shfl_xor(mx, 4));
        mx = fmaxf(mx, __shfl_xor(mx, 8));
        const float mnew = fmaxf(mrow[mi][r], mx);
        const float alpha = __expf(mrow[mi][r] - mnew);
        mrow[mi][r] = mnew;
        float ls = 0.f;
#pragma unroll
        for (int nj = 0; nj < 4; nj++) {
          float pe = __expf(sc[mi][nj][r] - mnew);
          ls += pe;
          pl[(mi * 16 + fq * 4 + r) * LDT + nj * 16 + fr] = f2bf(pe);
        }
        lrow[mi][r] = lrow[mi][r] * alpha + ls;
#pragma unroll
        for (int nd = 0; nd < 4; nd++) oacc[mi][nd][r] *= alpha;
      }
    asm volatile("s_waitcnt lgkmcnt(0)" ::: "memory");
    __builtin_amdgcn_wave_barrier();
#pragma unroll
    for (int ks = 0; ks < 2; ks++) {
      bf16x8 pf[2], vf[4];
#pragma unroll
      for (int mi = 0; mi < 2; mi++) pf[mi] = *(const bf16x8*)(pl + (mi * 16 + fr) * LDT + ks * 32 + fq * 8);
#pragma unroll
      for (int nd = 0; nd < 4; nd++) vf[nd] = *(const bf16x8*)(VT + (nd * 16 + fr) * LDT + ks * 32 + fq * 8);
#pragma unroll
      for (int mi = 0; mi < 2; mi++)
#pragma unroll
        for (int nd = 0; nd < 4; nd++) oacc[mi][nd] = __builtin_amdgcn_mfma_f32_16x16x32_bf16(pf[mi], vf[nd], oacc[mi][nd], 0, 0, 0);
    }
    asm volatile("s_waitcnt lgkmcnt(0)" ::: "memory");
    __builtin_amdgcn_wave_barrier();
  }
  const float sink = p.attn_sink[l * 4 + qh];
#pragma unroll
  for (int mi = 0; mi < 2; mi++)
#pragma unroll
    for (int r = 0; r < 4; r++) {
      float ls = lrow[mi][r];
      ls += __shfl_xor(ls, 1);
      ls += __shfl_xor(ls, 2);
      ls += __shfl_xor(ls, 4);
      ls += __shfl_xor(ls, 8);
      ls += __expf(sink - mrow[mi][r]);
      const float inv = 1.f / ls;
      const int tq = tb + mi * 16 + fq * 4 + r;
#pragma unroll
      for (int nd = 0; nd < 4; nd++) Y[(size_t)(qrow0 + tq) * YST + 1536 + qh * 64 + nd * 16 + fr] = f2bf(oacc[mi][nd][r] * inv);
    }
}

__device__ __forceinline__ void phase_mix(const Params& p, int l, unsigned char* smem) {
  float* sm = (float*)smem;
  const int G = gridDim.x;
  for (int it = blockIdx.x; it < 768; it += G) {
    const int mix = it >> 8, rem = it & 255, b = rem >> 5, h = (rem >> 3) & 3, dir = (rem >> 2) & 1, rq = rem & 3;
    if (mix == 0) scan2_item<0>(p, l, b, h, dir, rq, sm);
    else if (mix == 1) scan2_item<1>(p, l, b, h, dir, rq, sm);
    else scan2_item<2>(p, l, b, h, dir, rq, sm);
  }
  for (int it = blockIdx.x; it < 544; it += G) {
    if (it < 512) {
      int b = it >> 6, qb = (it >> 1) & 31, hk = it & 1;
      attn_item(p, l, b, qb, hk, false, smem);
    } else {
      int r = it - 512, b = r >> 2, qb = (r >> 1) & 1, hk = r & 1;
      attn_item(p, l, b, qb, hk, true, smem);
    }
  }
}

__device__ __forceinline__ void phase_post(const Params& p, int l) {
  const int lane = TIDX & 63, wv = TIDX >> 6;
  const u16* P = (const u16*)(p.ws + OFF_BIG);
  u16* YS = (u16*)(p.ws + OFF_YS);
  const float* BC = (const float*)(p.ws + OFF_BC);
  const int j0 = lane * 4, hd = lane >> 4;
  for (int r = blockIdx.x * 8 + wv; r < NROWS; r += gridDim.x * 8) {
    const int b = r / TPB, t = r - b * TPB;
    const bool has_prev = (t != 0) && (t != LC), has_next = (t != LC - 1) && (t != TPB - 1);
    const int poff = has_prev ? PST : 0, noff = has_next ? PST : 0;
    const float pmul = has_prev ? 1.f : 0.f, nmul = has_next ? 1.f : 0.f;
    u16* ys = YS + (size_t)r * YST;
    const u16* pr = P + (size_t)r * PST;
    float y[3][4];
#pragma unroll
    for (int m = 0; m < 3; m++) {
      uint2 a = *(const uint2*)(ys + m * 256 + j0);
      uint2 c = *(const uint2*)(ys + 768 + m * 256 + j0);
      y[m][0] = bf2f((u16)(a.x & 0xffff)) + bf2f((u16)(c.x & 0xffff));
      y[m][1] = bf2f((u16)(a.x >> 16)) + bf2f((u16)(c.x >> 16));
      y[m][2] = bf2f((u16)(a.y & 0xffff)) + bf2f((u16)(c.y & 0xffff));
      y[m][3] = bf2f((u16)(a.y >> 16)) + bf2f((u16)(c.y >> 16));
    }
    float o[3][4];
    {
      float sum = y[0][0] + y[0][1] + y[0][2] + y[0][3];
      sum += __shfl_xor(sum, 1); sum += __shfl_xor(sum, 2); sum += __shfl_xor(sum, 4); sum += __shfl_xor(sum, 8);
      const float mean = sum * (1.f / 64.f);
      float vs = 0.f;
#pragma unroll
      for (int i = 0; i < 4; i++) { float d = y[0][i] - mean; vs += d * d; }
      vs += __shfl_xor(vs, 1); vs += __shfl_xor(vs, 2); vs += __shfl_xor(vs, 4); vs += __shfl_xor(vs, 8);
      const float rstd = rsq(vs * (1.f / 64.f) + 64e-5f);
      float sg;
      {
        const int col = 896 + lane;
        float pv = bf2f(pr[PA + col]);
        float pp = bf2f(pr[PA + col - poff]) * pmul;
        float pn = bf2f(pr[PA + col + noff]) * nmul;
        float xm = pv + (0.5f * (pp + pn) - pv) * p.rwkv_mu[l * 960 + col];
        sg = sigm(xm);
      }
      float gate[4] = {0.f, 0.f, 0.f, 0.f};
      const float* g2 = p.rwkv_g2 + (size_t)l * 64 * 256 + j0;
#pragma unroll 8
      for (int i = 0; i < 64; i++) {
        float si = __shfl(sg, i);
        float4 gw = *(const float4*)(g2 + i * 256);
        gate[0] += si * gw.x; gate[1] += si * gw.y; gate[2] += si * gw.z; gate[3] += si * gw.w;
      }
      const float bcs = BC[(size_t)r * 8 + hd * 2] + BC[(size_t)r * 8 + hd * 2 + 1];
#pragma unroll
      for (int i = 0; i < 4; i++) {
        const int col = 512 + j0 + i;
        float pv = bf2f(pr[PA + col]);
        float pp = bf2f(pr[PA + col - poff]) * pmul;
        float pn = bf2f(pr[PA + col + noff]) * nmul;
        float v = pv + (0.5f * (pp + pn) - pv) * p.rwkv_mu[l * 960 + col];
        float yn = (y[0][i] - mean) * rstd * p.rwkv_ln_g[l * 256 + j0 + i] + p.rwkv_ln_b[l * 256 + j0 + i];
        o[0][i] = (yn + bcs * v) * gate[i];
      }
    }
#pragma unroll
    for (int m = 1; m < 3; m++) {
      float ss = y[m][0] * y[m][0] + y[m][1] * y[m][1] + y[m][2] * y[m][2] + y[m][3] * y[m][3];
      ss += __shfl_xor(ss, 1); ss += __shfl_xor(ss, 2); ss += __shfl_xor(ss, 4); ss += __shfl_xor(ss, 8);
      const float inv = rsq(ss * (1.f / 64.f) + 1e-6f);
      const float* ng = (m == 1 ? p.gdn_norm_g : p.gla_norm_g) + l * 64 + (lane & 15) * 4;
      const u16* gp = pr + (m == 1 ? PB + 784 : PC + 544) + j0;
#pragma unroll
      for (int i = 0; i < 4; i++) o[m][i] = y[m][i] * inv * ng[i] * siluf(bf2f(gp[i]));
    }
    asm volatile("s_waitcnt vmcnt(0)" ::: "memory");
    __builtin_amdgcn_wave_barrier();
#pragma unroll
    for (int m = 0; m < 3; m++) {
      uint2 ov;
      ov.x = pack2(o[m][0], o[m][1]);
      ov.y = pack2(o[m][2], o[m][3]);
      *(uint2*)(ys + m * 256 + j0) = ov;
    }
  }
}

#if defined(SKIPS)
#define EN(k) (SKIPS != (k))
#elif !defined(ONLYS)
#define EN(k) 1
#else
#define EN(k) (ONLYS == (k))
#endif
__device__ __forceinline__ void run_phase(const Params& p, int ph, unsigned char* smem) {
  if (ph == 0) { if (EN(10)) phase_init0(p, (float*)smem); return; }
  if (ph == 1) { if (EN(11)) phase_init1(p); return; }
  int l = 0, s = 9;
  if (ph >= 3) { l = (ph - 3) / 9; s = (ph - 3) - l * 9; }
  unsigned char* wl = p.ws + OFF_W + (size_t)l * SZ_WL;
  if (s == 9 || s == 5 || s == 8) {
    if (EN(5)) rowpass(p, l, s == 9 ? 0 : (s == 5 ? 1 : 2));
  } else if (s == 0 || s == 4 || s == 7) {
    const u16 *A, *Bt; u16* C; int lda, K, NT, ldc;
    if (s == 0) { A = (const u16*)(p.ws + OFF_H); lda = DM; Bt = (const u16*)(wl + OW_IN); K = DM; NT = PST / 128; C = (u16*)(p.ws + OFF_BIG); ldc = PST; }
    else if (s == 4) { A = (const u16*)(p.ws + OFF_BIG); lda = DM; Bt = (const u16*)(wl + OW_O); K = DM; NT = 8; C = (u16*)(p.ws + OFF_BIG + SZ_ACT); ldc = DM; }
    else { A = (const u16*)(p.ws + OFF_BIG); lda = FH; Bt = (const u16*)(wl + OW_2); K = FH; NT = 8; C = (u16*)(p.ws + OFF_YS); ldc = DM; }
    if (EN(0)) gemm_plain(A, lda, Bt, K, NT, C, ldc, smem);
  } else if (s == 1) {
    if (EN(1)) phase_mix(p, l, smem);
  } else if (s == 2) {
    if (EN(2)) phase_post(p, l);
  } else if (s == 3) {
    if (EN(3)) gemm_merge(p, l, smem);
  } else {
    if (EN(6)) gemm_swiglu((const u16*)(p.ws + OFF_H), (const u16*)(wl + OW_1), (u16*)(p.ws + OFF_BIG), smem);
  }
}

__global__ void __launch_bounds__(NTHR) hybrid_flow_mega(Params p, int ph0, int ph1) {
  __shared__ __attribute__((aligned(16))) unsigned char smem[123392];
  cg::grid_group grid = cg::this_grid();
  for (int ph = ph0; ph < ph1; ph++) {
    run_phase(p, ph, smem);
#ifdef DUPMASK
    {
      int sidx = ph >= 3 ? (ph - 3) % 9 : 10 + ph;
      if ((DUPMASK >> sidx) & 1) { __syncthreads(); run_phase(p, ph, smem); }
    }
#endif
    if (ph + 1 < ph1) grid.sync();
  }
}

extern "C" void kernel_launch(void* const* d_in, const int* in_sizes, int n_in, void* d_out, int out_size, void* d_ws,
                              size_t ws_size, hipStream_t stream) {
  Params p{};
  const float** pp = (const float**)&p;
  for (int i = 0; i < 32; i++) pp[i] = (const float*)d_in[i];
  p.out = (float*)d_out;
  p.ws = (unsigned char*)d_ws;
  static int grid_blocks = 0;
  if (!grid_blocks) {
    int dev = 0, cus = 0, per_cu = 0;
    hipGetDevice(&dev);
    hipDeviceGetAttribute(&cus, hipDeviceAttributeMultiprocessorCount, dev);
    hipOccupancyMaxActiveBlocksPerMultiprocessor(&per_cu, hybrid_flow_mega, NTHR, 0);
    if (per_cu < 1) per_cu = 1;
    grid_blocks = cus * per_cu;
  }
#ifdef MULTI_LAUNCH
  for (int ph = 0; ph < NPHASE; ph++) {
    hipLaunchKernelGGL(hybrid_flow_mega, dim3(grid_blocks), dim3(NTHR), 0, stream, p, ph, ph + 1);
  }
#else
  int ph0 = 0, ph1 = NPHASE;
  void* args[] = {&p, &ph0, &ph1};
  hipError_t e = hipLaunchCooperativeKernel((void*)hybrid_flow_mega, dim3(grid_blocks), dim3(NTHR), args, 0, stream);
  if (e != hipSuccess) fprintf(stderr, "cooperative launch failed: %s (grid %d)\n", hipGetErrorString(e), grid_blocks);
#endif
}
```

```cpp
#include <hip/hip_runtime.h>
#include <hip/hip_cooperative_groups.h>
#include <cstdio>
namespace cg = cooperative_groups;

typedef unsigned short u16;
using bf16x8 = __attribute__((ext_vector_type(8))) short;
using f32x4 = __attribute__((ext_vector_type(4))) float;

#define DM 1024
#define NBATCH 8
#define SEQ 4096
#define LC 256
#define TPB 4352
#define NROWS 34816
#define PST 3328
#define YST 1792
#define FH 2816
#define INW 7408
#define NTHR 512
#define PA 0
#define PB 960
#define PC 2000
#define PD 2800
#define NPHASE 27

struct Params {
  const float *x, *c, *ctx, *c_ctx, *ada_w, *ada_b, *norm_g, *w_in, *gate_b, *w_branch, *w_out,
      *rwkv_mu, *rwkv_w0, *rwkv_w2, *rwkv_a0, *rwkv_a2, *rwkv_g2, *rwkv_kk, *rwkv_ka, *rwkv_rk, *rwkv_ln_g,
      *rwkv_ln_b, *gdn_conv, *gdn_a_log, *gdn_dt_bias, *gdn_norm_g, *gla_gw2, *gla_gb, *gla_norm_g, *attn_sink,
      *ffn_w1, *ffn_w2;
  float* out;
  unsigned char* ws;
};

constexpr size_t SZ_WL = 36700160;
constexpr size_t OW_IN = 0;
constexpr size_t OW_G = OW_IN + (size_t)PST * 1024 * 2;
constexpr size_t OW_B = OW_G + (size_t)4096 * 1024 * 2;
constexpr size_t OW_O = OW_B + (size_t)4 * 1024 * 256 * 2;
constexpr size_t OW_1 = OW_O + (size_t)1024 * 1024 * 2;
constexpr size_t OW_2 = OW_1 + (size_t)5632 * 1024 * 2;
static_assert(OW_2 + (size_t)1024 * FH * 2 == SZ_WL, "weights size");
constexpr size_t SZ_ACT = (size_t)NROWS * DM * 2;
constexpr size_t OFF_W = 0;
constexpr size_t OFF_XC = OFF_W + 2 * SZ_WL;
constexpr size_t OFF_MODP = OFF_XC + (size_t)NBATCH * LC * DM * 4;
constexpr size_t OFF_MOD = OFF_MODP + (size_t)2 * 8 * 9 * 6144 * 4;
constexpr size_t OFF_BC = OFF_MOD + (size_t)2 * 9 * 6144 * 4;
constexpr size_t OFF_H = OFF_BC + (size_t)NROWS * 8 * 4;
constexpr size_t OFF_YS = OFF_H + SZ_ACT;
constexpr size_t OFF_BIG = OFF_YS + (size_t)NROWS * YST * 2;
constexpr size_t WS_END = OFF_BIG + (size_t)NROWS * PST * 2;
static_assert(WS_END <= (size_t)536870912, "ws too large");

__device__ __forceinline__ int launder_tid() { int t = threadIdx.x; asm volatile("" : "+v"(t)); return t; }
#define TIDX (launder_tid())
__device__ __forceinline__ u16 f2bf(float f) {
  unsigned u = __float_as_uint(f);
  u += 0x7fffu + ((u >> 16) & 1u);
  return (u16)(u >> 16);
}
__device__ __forceinline__ float bf2f(u16 h) { return __uint_as_float(((unsigned)h) << 16); }
__device__ __forceinline__ unsigned pack2(float a, float b) { return (unsigned)f2bf(a) | ((unsigned)f2bf(b) << 16); }
__device__ __forceinline__ float sigm(float x) { return __builtin_amdgcn_rcpf(1.f + __expf(-x)); }
__device__ __forceinline__ float siluf(float x) { return x * __builtin_amdgcn_rcpf(1.f + __expf(-x)); }
__device__ __forceinline__ float rsq(float x) { return __builtin_amdgcn_rsqf(x); }
__device__ __forceinline__ float softplusf(float x) { return fmaxf(x, 0.f) + log1pf(__expf(-fabsf(x))); }
__device__ __forceinline__ float wsum(float v) {
#pragma unroll
  for (int o = 32; o > 0; o >>= 1) v += __shfl_xor(v, o);
  return v;
}
template <int CTRL>
__device__ __forceinline__ float dppf(float x) {
  return __int_as_float(__builtin_amdgcn_update_dpp(__float_as_int(x), __float_as_int(x), CTRL, 0xf, 0xf, false));
}
__device__ __forceinline__ float red8(float x) {
  x += dppf<0xB1>(x);
  x += dppf<0x4E>(x);
  x += dppf<0x141>(x);
  return x;
}
__device__ __forceinline__ const float* xin_row(const Params& p, int r) {
  int b = r / TPB, t = r - b * TPB;
  return t < LC ? p.ctx + ((size_t)(b * LC + t)) * DM : p.x + ((size_t)(b * SEQ + t - LC)) * DM;
}
__device__ __forceinline__ float* x_row(const Params& p, int r) {
  int b = r / TPB, t = r - b * TPB;
  return t < LC ? (float*)(p.ws + OFF_XC) + ((size_t)(b * LC + t)) * DM : p.out + ((size_t)(b * SEQ + t - LC)) * DM;
}
__device__ __forceinline__ int mod_row(int r) {
  int b = r / TPB, t = r - b * TPB;
  return t < LC ? 8 : b;
}

struct MapId { int lim, off; __device__ int operator()(int n) const { return n < lim ? n + off : -1; } };
struct MapW1 { __device__ int operator()(int n) const { int q = n >> 3, s = n & 7; return s < 4 ? q * 4 + s : FH + q * 4 + (s - 4); } };

template <class Map>
__device__ __forceinline__ void conv_tile(const float* __restrict__ src, int ld, u16* __restrict__ dst, int K, int n0,
                                          int k0, Map map, float* tile) {
  const int tid = TIDX;
  const int nn = tid & 63, kr = tid >> 6;
  const int sc = map(n0 + nn);
#pragma unroll
  for (int ps = 0; ps < 8; ps++) {
    int kk = ps * 8 + kr;
    float v = sc >= 0 ? src[(size_t)(k0 + kk) * ld + sc] : 0.f;
    tile[kk * 65 + nn] = v;
  }
  __syncthreads();
  const int n2 = tid >> 3, kc = tid & 7;
  uint4 o;
  o.x = pack2(tile[(kc * 8 + 0) * 65 + n2], tile[(kc * 8 + 1) * 65 + n2]);
  o.y = pack2(tile[(kc * 8 + 2) * 65 + n2], tile[(kc * 8 + 3) * 65 + n2]);
  o.z = pack2(tile[(kc * 8 + 4) * 65 + n2], tile[(kc * 8 + 5) * 65 + n2]);
  o.w = pack2(tile[(kc * 8 + 6) * 65 + n2], tile[(kc * 8 + 7) * 65 + n2]);
  *(uint4*)(dst + (size_t)(n0 + n2) * K + k0 + kc * 8) = o;
  __syncthreads();
}

__device__ __forceinline__ void phase_init0(const Params& p, float* sm) {
  const int tid = TIDX;
  constexpr int NMOD = 192, NCONV = 4480 * 2;
  for (int it = blockIdx.x; it < NMOD + NCONV; it += gridDim.x) {
    if (it < NMOD) {
      int l = it / 96, rem = it - l * 96, cc = rem >> 3, ks = rem & 7;
      for (int i = tid; i < 9 * 128; i += NTHR) {
        int r = i >> 7, k = i & 127;
        float v = r < 8 ? p.c[r * DM + ks * 128 + k] : p.c_ctx[ks * 128 + k];
        sm[i] = siluf(v);
      }
      __syncthreads();
      const int n = cc * 512 + tid;
      const float* w = p.ada_w + ((size_t)l * DM + ks * 128) * 6144 + n;
      float acc[9];
#pragma unroll
      for (int r = 0; r < 9; r++) acc[r] = 0.f;
#pragma unroll 4
      for (int k = 0; k < 128; k++) {
        float wv = w[(size_t)k * 6144];
#pragma unroll
        for (int r = 0; r < 9; r++) acc[r] += sm[r * 128 + k] * wv;
      }
      float* mp = (float*)(p.ws + OFF_MODP) + ((size_t)(l * 8 + ks) * 9) * 6144 + n;
#pragma unroll
      for (int r = 0; r < 9; r++) mp[(size_t)r * 6144] = acc[r];
      __syncthreads();
    } else {
      int ci = it - NMOD;
      int l = ci / 4480, rem = ci - l * 4480;
      u16* wl = (u16*)(p.ws + OFF_W + (size_t)l * SZ_WL);
      if (rem < 832) {
        int nt = rem >> 4, kt = rem & 15;
        conv_tile(p.w_in + (size_t)l * DM * INW, INW, (u16*)((char*)wl + OW_IN), 1024, nt * 64, kt * 64, MapId{3312, 0}, sm);
      } else if (rem < 832 + 1024) {
        rem -= 832;
        int nt = rem >> 4, kt = rem & 15;
        conv_tile(p.w_in + (size_t)l * DM * INW, INW, (u16*)((char*)wl + OW_G), 1024, nt * 64, kt * 64, MapId{4096, 3312}, sm);
      } else if (rem < 1856 + 256) {
        rem -= 1856;
        int br = rem >> 6, r2 = rem & 63, nt = r2 >> 2, kt = r2 & 3;
        conv_tile(p.w_branch + ((size_t)(l * 4 + br)) * 256 * DM, DM, (u16*)((char*)wl + OW_B) + (size_t)br * 1024 * 256, 256,
                  nt * 64, kt * 64, MapId{1024, 0}, sm);
      } else if (rem < 2112 + 256) {
        rem -= 2112;
        int nt = rem >> 4, kt = rem & 15;
        conv_tile(p.w_out + (size_t)l * DM * DM, DM, (u16*)((char*)wl + OW_O), 1024, nt * 64, kt * 64, MapId{1024, 0}, sm);
      } else if (rem < 2368 + 1408) {
        rem -= 2368;
        int nt = rem >> 4, kt = rem & 15;
        conv_tile(p.ffn_w1 + (size_t)l * DM * 5632, 5632, (u16*)((char*)wl + OW_1), 1024, nt * 64, kt * 64, MapW1{}, sm);
      } else {
        rem -= 3776;
        int nt = rem / 44, kt = rem - nt * 44;
        conv_tile(p.ffn_w2 + (size_t)l * FH * DM, DM, (u16*)((char*)wl + OW_2), FH, nt * 64, kt * 64, MapId{1024, 0}, sm);
      }
    }
  }
}

__device__ __forceinline__ void phase_init1(const Params& p) {
  const float* mp = (const float*)(p.ws + OFF_MODP);
  float* mo = (float*)(p.ws + OFF_MOD);
  for (int i = blockIdx.x * NTHR + TIDX; i < 2 * 9 * 6144; i += gridDim.x * NTHR) {
    int l = i / (9 * 6144), rem = i - l * 9 * 6144, r = rem / 6144, n = rem - r * 6144;
    float s = p.ada_b[l * 6144 + n];
#pragma unroll
    for (int ks = 0; ks < 8; ks++) s += mp[((size_t)((l * 8 + ks) * 9 + r)) * 6144 + n];
    mo[i] = s;
  }
}

__device__ __forceinline__ void rowpass(const Params& p, int l, int mode) {
  const int lane = TIDX & 63, wv = TIDX >> 6;
  const float* MOD = (const float*)(p.ws + OFF_MOD);
  u16* H = (u16*)(p.ws + OFF_H);
  for (int r = blockIdx.x * 8 + wv; r < NROWS; r += gridDim.x * 8) {
    const int mr = mod_row(r);
    const float* modl = MOD + ((size_t)(l * 9 + mr)) * 6144;
    float xv[16];
    if (mode == 0) {
      const float* xs = xin_row(p, r);
#pragma unroll
      for (int i = 0; i < 4; i++) {
        float4 t = *(const float4*)(xs + i * 256 + lane * 4);
        xv[i * 4 + 0] = t.x; xv[i * 4 + 1] = t.y; xv[i * 4 + 2] = t.z; xv[i * 4 + 3] = t.w;
      }
    } else {
      const u16* src = (const u16*)(p.ws + (mode == 1 ? OFF_BIG : OFF_YS)) + (size_t)r * DM;
      const float* xs = (mode == 1 && l == 0) ? xin_row(p, r) : (const float*)x_row(p, r);
      float ov[16];
      float ss = 0.f;
#pragma unroll
      for (int i = 0; i < 4; i++) {
        uint2 t = *(const uint2*)(src + i * 256 + lane * 4);
        ov[i * 4 + 0] = bf2f((u16)(t.x & 0xffff)); ov[i * 4 + 1] = bf2f((u16)(t.x >> 16));
        ov[i * 4 + 2] = bf2f((u16)(t.y & 0xffff)); ov[i * 4 + 3] = bf2f((u16)(t.y >> 16));
      }
#pragma unroll
      for (int i = 0; i < 16; i++) ss += ov[i] * ov[i];
      ss = wsum(ss);
      const float inv = rsq(ss * (1.f / 1024.f) + 1e-6f);
      const float* ng = p.norm_g + (size_t)(l * 4 + (mode == 1 ? 1 : 3)) * DM;
      const float* gt = modl + (mode == 1 ? 2048 : 5120);
      float* xd = x_row(p, r);
#pragma unroll
      for (int i = 0; i < 4; i++) {
        const int col = i * 256 + lane * 4;
        float4 xo = *(const float4*)(xs + col);
        float4 g4 = *(const float4*)(gt + col);
        float4 n4 = *(const float4*)(ng + col);
        xv[i * 4 + 0] = xo.x + g4.x * (ov[i * 4 + 0] * inv * n4.x);
        xv[i * 4 + 1] = xo.y + g4.y * (ov[i * 4 + 1] * inv * n4.y);
        xv[i * 4 + 2] = xo.z + g4.z * (ov[i * 4 + 2] * inv * n4.z);
        xv[i * 4 + 3] = xo.w + g4.w * (ov[i * 4 + 3] * inv * n4.w);
        *(float4*)(xd + col) = make_float4(xv[i * 4 + 0], xv[i * 4 + 1], xv[i * 4 + 2], xv[i * 4 + 3]);
      }
    }
    int ln = l, ni = 0, sho = 0, sco = 1024;
    if (mode == 1) { ni = 2; sho = 3072; sco = 4096; }
    if (mode == 2) { if (l == 1) continue; ln = l + 1; }
    const float* modn = MOD + ((size_t)(ln * 9 + mr)) * 6144;
    const float* ng2 = p.norm_g + (size_t)(ln * 4 + ni) * DM;
    float ss2 = 0.f;
#pragma unroll
    for (int i = 0; i < 16; i++) ss2 += xv[i] * xv[i];
    ss2 = wsum(ss2);
    const float inv2 = rsq(ss2 * (1.f / 1024.f) + 1e-6f);
#pragma unroll
    for (int i = 0; i < 4; i++) {
      const int col = i * 256 + lane * 4;
      float4 n4 = *(const float4*)(ng2 + col);
      float4 sc = *(const float4*)(modn + sco + col);
      float4 sh = *(const float4*)(modn + sho + col);
      float h0 = xv[i * 4 + 0] * inv2 * n4.x * (1.f + sc.x) + sh.x;
      float h1 = xv[i * 4 + 1] * inv2 * n4.y * (1.f + sc.y) + sh.y;
      float h2 = xv[i * 4 + 2] * inv2 * n4.z * (1.f + sc.z) + sh.z;
      float h3 = xv[i * 4 + 3] * inv2 * n4.w * (1.f + sc.w) + sh.w;
      uint2 o;
      o.x = pack2(h0, h1);
      o.y = pack2(h2, h3);
      *(uint2*)(H + (size_t)r * DM + col) = o;
    }
  }
}

#define LDT 72
namespace pg8 {
#define PG8_LAS __attribute__((address_space(3)))
typedef unsigned short bf16_t;
typedef short bf16x8 __attribute__((ext_vector_type(8)));
typedef float f32x4 __attribute__((ext_vector_type(4)));
typedef unsigned u32x4 __attribute__((ext_vector_type(4)));
constexpr int BM = 256, BK = 64, HALF = 128, HTB = HALF * BK * 2  , STAGE_BYTES = 8 * HTB, NXCD = 8, WGM = 8;

__host__ __device__ __forceinline__ int lds_byte(int r, int c) { const int st = (r >> 4) * 2 + (c >> 5), rr = r & 15, cc = c & 31, ob = rr * 64 + cc * 2; return st * 1024 + (ob ^ (((ob >> 9) & 1) << 5)); }
__host__ __device__ __forceinline__ void stage_rc(int b, int& R, int& C) { const int st = b / 1024, sb = b % 1024, swz = sb ^ (((sb >> 9) & 1) << 5); R = (st >> 1) * 16 + swz / 64; C = (st & 1) * 32 + (swz % 64) / 2; }
__host__ __device__ __forceinline__ int perm32(int rho) { const int n = rho >> 4, i = rho & 15; return 8 * (i >> 2) + 4 * n + (i & 3); }

struct Unit { int pm, pn; };
struct Gemm { const bf16_t* A; const bf16_t* Bt; int M, N, K, lda; };
struct StaticOrder {
    int nM, nN, nwg, G, c;
    __host__ __device__ void init(int M, int N, int G_, int c_) { nM = M / BM; nN = N / BM; nwg = nM * nN; G = G_; c = c_; }
    __host__ __device__ bool next(int i, Unit& u) const {
        const long L = (long)i * G + c; if (L >= nwg) return false;
        int wgid = (int)L; { const int q = nwg / NXCD, r = nwg % NXCD, xcd = wgid % NXCD, off = wgid / NXCD; wgid = (xcd < r ? xcd * (q + 1) : r * (q + 1) + (xcd - r) * q) + off; }
        const int nig = WGM * nN, gid = wgid / nig, fm = gid * WGM, gsz = (nM - fm) < WGM ? (nM - fm) : WGM;
        u.pm = fm + ((wgid % nig) % gsz); u.pn = (wgid % nig) / gsz; return true;
    }
    __device__ __forceinline__ void a_ready(const Unit&) const {}
    __device__ __forceinline__ void done(const Unit&) const {}
};
__device__ __forceinline__ unsigned cvt_pk_bf16(float lo, float hi) { unsigned r; asm volatile("v_cvt_pk_bf16_f32 %0, %1, %2" : "=v"(r) : "v"(lo), "v"(hi)); return r; }
template <class Epi, class Sched, bool STAMP = false>
__device__ __forceinline__ void gemm_phase(PG8_LAS unsigned char* lds, const Gemm g, const Sched& S, const Epi& E, unsigned long long* stamps) {
    const int tid = TIDX, wid = __builtin_amdgcn_readfirstlane(tid >> 6), lane = tid & 63, wr = wid >> 2, wc = wid & 3, fr = lane & 15, fq = lane >> 4;
    const int K = g.K, nt = K / BK;
    int ts_lo = 0, ts_hi = 0, nts = 0; const unsigned long long rt_entry = STAMP ? (unsigned long long)wall_clock64() : 0ull;
#define PG8_STAMP() do { if (STAMP && wid == 0 && nts < 64) { const unsigned long long _c = (unsigned long long)clock64(); \
        ts_lo = (lane == nts) ? (int)(unsigned)_c : ts_lo; ts_hi = (lane == nts) ? (int)(unsigned)(_c >> 32) : ts_hi; ++nts; } } while (0)
    PG8_STAMP();
    unsigned voffA[2], voffB[2];
#pragma unroll
    for (int i = 0; i < 2; ++i) { int R, C; stage_rc(tid * 16 + i * 8192, R, C); const int Rb = Epi::PERM ? ((R & ~31) + perm32(R & 31)) : R;
        voffA[i] = (unsigned)(R * g.lda + C) * 2u; voffB[i] = (unsigned)(Rb * K + C) * 2u; }
    const size_t kstep = (size_t)(BK * 2);
    const size_t hstepB = (size_t)HALF * K * 2, hstepA = (size_t)HALF * g.lda * 2;
    const size_t tstepB = 2 * hstepB, tstepA = 2 * hstepA;
    const unsigned ldsw = (unsigned)wid * 1024u;
    const int aoff = lds_byte(wr * 64 + fr, fq * 8), boff = lds_byte(wc * 32 + fr, fq * 8);
#define PG8_SA(b, h) (((b) * 2 + (h)) * HTB)
#define PG8_SB(b, h) ((4 + (b) * 2 + (h)) * HTB)
#define PG8_STAGE(bufoff, gbase, voff) do { _Pragma("unroll") for (int _i = 0; _i < 2; ++_i) \
        __builtin_amdgcn_global_load_lds((const unsigned*)((const char*)(gbase) + (voff)[_i]), (PG8_LAS unsigned*)(lds + (bufoff) + ldsw + _i * 8192), 16, 0, 0); } while (0)
#define PG8_LDA(dst, b, h) do { _Pragma("unroll") for (int m = 0; m < 4; ++m) _Pragma("unroll") for (int k = 0; k < 2; ++k) dst[m][k] = *(const PG8_LAS bf16x8*)(lds + PG8_SA(b, h) + aoff + m * 2048 + k * 1024); } while (0)
#define PG8_LDB(dst, b, h) do { _Pragma("unroll") for (int n = 0; n < 2; ++n) _Pragma("unroll") for (int k = 0; k < 2; ++k) dst[n][k] = *(const PG8_LAS bf16x8*)(lds + PG8_SB(b, h) + boff + n * 2048 + k * 1024); } while (0)
#define PG8_MMA(ai, bj, At, Bt) do { __builtin_amdgcn_s_setprio(1); _Pragma("unroll") for (int m = 0; m < 4; ++m) _Pragma("unroll") for (int n = 0; n < 2; ++n) _Pragma("unroll") for (int k = 0; k < 2; ++k) \
        acc[ai][bj][m][n] = __builtin_amdgcn_mfma_f32_16x16x32_bf16(Bt[n][k], At[m][k], acc[ai][bj][m][n], 0, 0, 0); __builtin_amdgcn_s_setprio(0); } while (0)
#define PG8_WAIT_V(n) asm volatile("s_waitcnt vmcnt(" #n ")" ::: "memory")
#define PG8_WAIT_L(n) asm volatile("s_waitcnt lgkmcnt(" #n ")" ::: "memory")
#define PG8_BAR __builtin_amdgcn_s_barrier()
#define PG8_SCHED __builtin_amdgcn_sched_barrier(0)
    Unit cur, nxt; int ui = 0;
    if (!S.next(0, cur)) return;
    f32x4 acc[2][2][4][2];
#pragma unroll
    for (int a = 0; a < 2; ++a)
#pragma unroll
        for (int b = 0; b < 2; ++b)
#pragma unroll
            for (int m = 0; m < 4; ++m)
#pragma unroll
                for (int n = 0; n < 2; ++n) acc[a][b][m][n] = (f32x4){0.f, 0.f, 0.f, 0.f};
    bf16x8 At[4][2], B0[2][2], B1[2][2];
    const char* cA = (const char*)g.A + (size_t)cur.pm * tstepA; const char* cB = (const char*)g.Bt + (size_t)cur.pn * tstepB;
    S.a_ready(cur);
    PG8_STAGE(PG8_SB(0, 0), cB, voffB); PG8_STAGE(PG8_SA(0, 0), cA, voffA); PG8_STAGE(PG8_SB(0, 1), cB + hstepB, voffB); PG8_STAGE(PG8_SA(0, 1), cA + hstepA, voffA);
    if (wr == 1) PG8_BAR;
    PG8_WAIT_V(4); PG8_BAR;
    PG8_STAGE(PG8_SB(1, 0), cB + kstep, voffB); PG8_STAGE(PG8_SA(1, 0), cA + kstep, voffA); PG8_STAGE(PG8_SB(1, 1), cB + hstepB + kstep, voffB);
    PG8_WAIT_V(6); PG8_BAR;
    PG8_STAMP();
    for (;;) {
        const bool has_next = S.next(ui + 1, nxt);
        const char* nA = has_next ? (const char*)g.A + (size_t)nxt.pm * tstepA : cA; const char* nB = has_next ? (const char*)g.Bt + (size_t)nxt.pn * tstepB : cB;
        for (int t = 0; t < nt; t += 2) {
            const bool last = (t == nt - 2);
            const char* a1 = cA + (size_t)(t + 1) * kstep;
            const char* a2 = last ? nA : cA + (size_t)(t + 2) * kstep; const char* b2 = last ? nB : cB + (size_t)(t + 2) * kstep;
            const char* a3 = a2 + kstep; const char* b3 = b2 + kstep;
            if (last && has_next) S.a_ready(nxt);
            PG8_LDB(B0, 0, 0); PG8_SCHED; PG8_LDA(At, 0, 0); PG8_STAGE(PG8_SA(1, 1), a1 + hstepA, voffA);
            PG8_WAIT_L(8); PG8_BAR; PG8_WAIT_L(0); PG8_MMA(0, 0, At, B0); PG8_BAR; PG8_SCHED;
            PG8_LDB(B1, 0, 1); PG8_STAGE(PG8_SB(0, 0), b2, voffB);
            PG8_BAR; PG8_WAIT_L(0); PG8_MMA(0, 1, At, B1); PG8_BAR;
            PG8_LDA(At, 0, 1); PG8_STAGE(PG8_SA(0, 0), a2, voffA);
            PG8_BAR; PG8_WAIT_L(0); PG8_MMA(1, 0, At, B0); PG8_BAR; PG8_SCHED;
            PG8_STAGE(PG8_SB(0, 1), b2 + hstepB, voffB);
            PG8_WAIT_V(6); PG8_BAR; PG8_MMA(1, 1, At, B1); PG8_BAR;
            PG8_LDB(B0, 1, 0); PG8_SCHED; PG8_LDA(At, 1, 0); PG8_STAGE(PG8_SA(0, 1), a2 + hstepA, voffA);
            PG8_WAIT_L(8); PG8_BAR; PG8_WAIT_L(0); PG8_MMA(0, 0, At, B0); PG8_BAR; PG8_SCHED;
            PG8_LDB(B1, 1, 1); PG8_STAGE(PG8_SB(1, 0), b3, voffB);
            PG8_BAR; PG8_WAIT_L(0); PG8_MMA(0, 1, At, B1); PG8_BAR;
            PG8_LDA(At, 1, 1); PG8_STAGE(PG8_SA(1, 0), a3, voffA);
            PG8_BAR; PG8_WAIT_L(0); PG8_MMA(1, 0, At, B0); PG8_BAR; PG8_SCHED;
            PG8_STAGE(PG8_SB(1, 1), b3 + hstepB, voffB);
            PG8_WAIT_V(6); PG8_BAR; PG8_MMA(1, 1, At, B1); PG8_BAR;
        }
        PG8_STAMP();
        if constexpr (!Epi::AFTER_DRAIN) { E(acc, cur, wr, wc, fr, fq); S.done(cur); }
        PG8_STAMP();
        if (!has_next) break;
#pragma unroll
        for (int a = 0; a < 2; ++a)
#pragma unroll
            for (int b = 0; b < 2; ++b)
#pragma unroll
                for (int m = 0; m < 4; ++m)
#pragma unroll
                    for (int n = 0; n < 2; ++n) acc[a][b][m][n] = (f32x4){0.f, 0.f, 0.f, 0.f};
        cur = nxt; cA = nA; cB = nB; ++ui;
    }
    PG8_WAIT_V(0);
    if (wr == 0) PG8_BAR;
    PG8_BAR;
    if constexpr (Epi::AFTER_DRAIN) { E.fused(acc, cur, wr, wc, fr, fq, lds, wid, lane); S.done(cur); }
    PG8_STAMP();
    if (STAMP && wid == 0) { stamps[lane] = lane < nts ? (((unsigned long long)(unsigned)ts_hi << 32) | (unsigned)ts_lo) : 0ull;
        if (lane == 62) stamps[62] = rt_entry; if (lane == 63) stamps[63] = (unsigned long long)wall_clock64(); }
#undef PG8_STAMP
#undef PG8_SA
#undef PG8_SB
#undef PG8_STAGE
#undef PG8_LDA
#undef PG8_LDB
#undef PG8_MMA
#undef PG8_WAIT_V
#undef PG8_WAIT_L
#undef PG8_BAR
#undef PG8_SCHED
}
}

struct EpiBf {
  static constexpr bool PERM = true, AFTER_DRAIN = false;
  u16* O; int ldc; const float* bias; int act;
  __device__ __forceinline__ void operator()(const f32x4 (&acc)[2][2][4][2], const pg8::Unit& u, int wr, int wc, int fr, int fq) const {
    const int row0 = u.pm * 256 + wr * 64 + fr, col0 = u.pn * 256 + wc * 32 + 8 * fq;
    f32x4 bv[2][2];
#pragma unroll
    for (int bj = 0; bj < 2; ++bj)
#pragma unroll
      for (int n = 0; n < 2; ++n) bv[bj][n] = bias ? *(const f32x4*)(bias + col0 + bj * 128 + 4 * n) : f32x4{0.f, 0.f, 0.f, 0.f};
#pragma unroll
    for (int ai = 0; ai < 2; ++ai)
#pragma unroll
      for (int m = 0; m < 4; ++m) {
        u16* rowp = O + (size_t)(row0 + ai * 128 + m * 16) * ldc + col0;
#pragma unroll
        for (int bj = 0; bj < 2; ++bj) {
          f32x4 v0 = acc[ai][bj][m][0] + bv[bj][0], v1 = acc[ai][bj][m][1] + bv[bj][1];
          if (act == 1) {
#pragma unroll
            for (int j = 0; j < 4; ++j) { v0[j] = sigm(v0[j]); v1[j] = sigm(v1[j]); }
          }
          uint4 wv;
          wv.x = pack2(v0[0], v0[1]); wv.y = pack2(v0[2], v0[3]); wv.z = pack2(v1[0], v1[1]); wv.w = pack2(v1[2], v1[3]);
          *(uint4*)(rowp + bj * 128) = wv;
        }
      }
  }
};
struct EpiSwiglu {
  static constexpr bool PERM = true, AFTER_DRAIN = false;
  u16* O;
  __device__ __forceinline__ void operator()(const f32x4 (&acc)[2][2][4][2], const pg8::Unit& u, int wr, int wc, int fr, int fq) const {
    const int row0 = u.pm * 256 + wr * 64 + fr, col0 = u.pn * 128 + wc * 16 + 4 * fq;
#pragma unroll
    for (int ai = 0; ai < 2; ++ai)
#pragma unroll
      for (int m = 0; m < 4; ++m) {
        u16* rowp = O + (size_t)(row0 + ai * 128 + m * 16) * FH + col0;
#pragma unroll
        for (int bj = 0; bj < 2; ++bj) {
          const f32x4 g = acc[ai][bj][m][0], up = acc[ai][bj][m][1];
          uint2 wv;
          wv.x = pack2(siluf(g[0]) * up[0], siluf(g[1]) * up[1]);
          wv.y = pack2(siluf(g[2]) * up[2], siluf(g[3]) * up[3]);
          *(uint2*)(rowp + bj * 64) = wv;
        }
      }
  }
};
template <int MI>
__device__ __forceinline__ void gemm_loop(const u16* __restrict__ A, int lda, const u16* __restrict__ Bt, int ldb, int K,
                                          f32x4 (&acc)[MI][4], u16* sA, u16* sB) {
  constexpr int BMT = MI * 64;
  const int tid = TIDX, lane = tid & 63, w = tid >> 6, wm = w >> 1, wn = w & 1, fr = lane & 15, fq = lane >> 4;
  uint4 ra[MI], rb[2];
  const u16* ga = A + (size_t)(tid >> 3) * lda + (tid & 7) * 8;
  const u16* gb = Bt + (size_t)(tid >> 3) * ldb + (tid & 7) * 8;
  const int so = (tid >> 3) * LDT + (tid & 7) * 8;
#pragma unroll
  for (int i = 0; i < MI; i++) ra[i] = *(const uint4*)(ga + (size_t)(i * 64) * lda);
#pragma unroll
  for (int i = 0; i < 2; i++) rb[i] = *(const uint4*)(gb + (size_t)(i * 64) * ldb);
#pragma unroll
  for (int i = 0; i < MI; i++) *(uint4*)(sA + so + i * 64 * LDT) = ra[i];
#pragma unroll
  for (int i = 0; i < 2; i++) *(uint4*)(sB + so + i * 64 * LDT) = rb[i];
  __syncthreads();
  const int nk = K >> 6;
  for (int kt = 0; kt < nk; kt++) {
    const bool more = kt + 1 < nk;
    if (more) {
#pragma unroll
      for (int i = 0; i < MI; i++) ra[i] = *(const uint4*)(ga + (size_t)(i * 64) * lda + (kt + 1) * 64);
#pragma unroll
      for (int i = 0; i < 2; i++) rb[i] = *(const uint4*)(gb + (size_t)(i * 64) * ldb + (kt + 1) * 64);
    }
    const u16* a = sA + (kt & 1) * BMT * LDT + (wm * (MI * 16) + fr) * LDT + fq * 8;
    const u16* b = sB + (kt & 1) * 128 * LDT + (wn * 64 + fr) * LDT + fq * 8;
#pragma unroll
    for (int ks = 0; ks < 2; ks++) {
      bf16x8 af[MI], bfr[4];
#pragma unroll
      for (int i = 0; i < MI; i++) af[i] = *(const bf16x8*)(a + i * 16 * LDT + ks * 32);
#pragma unroll
      for (int j = 0; j < 4; j++) bfr[j] = *(const bf16x8*)(b + j * 16 * LDT + ks * 32);
#pragma unroll
      for (int i = 0; i < MI; i++)
#pragma unroll
        for (int j = 0; j < 4; j++) acc[i][j] = __builtin_amdgcn_mfma_f32_16x16x32_bf16(bfr[j], af[i], acc[i][j], 0, 0, 0);
    }
    if (more) {
      u16* da = sA + ((kt + 1) & 1) * BMT * LDT + so;
      u16* db = sB + ((kt + 1) & 1) * 128 * LDT + so;
#pragma unroll
      for (int i = 0; i < MI; i++) *(uint4*)(da + i * 64 * LDT) = ra[i];
#pragma unroll
      for (int i = 0; i < 2; i++) *(uint4*)(db + i * 64 * LDT) = rb[i];
    }
    __syncthreads();
  }
}

template <int MI>
__device__ __forceinline__ void zero_acc(f32x4 (&acc)[MI][4]) {
#pragma unroll
  for (int i = 0; i < MI; i++)
#pragma unroll
    for (int j = 0; j < 4; j++) acc[i][j] = f32x4{0.f, 0.f, 0.f, 0.f};
}


__device__ __forceinline__ void phase_ypart(const Params& p, int l, int hf, unsigned char* smem) {
  u16* sA = (u16*)smem;
  u16* sB = sA + 2 * 256 * LDT;
  const int lane = TIDX & 63, w = TIDX >> 6, wm = w >> 1, wn = w & 1, fr = lane & 15, fq = lane >> 4;
  const u16* Y = (const u16*)(p.ws + OFF_YS);
  const u16* Wb = (const u16*)(p.ws + OFF_W + (size_t)l * SZ_WL + OW_B);
  const u16* G = (const u16*)(p.ws + OFF_BIG);
  u16* ACC = (u16*)(p.ws + OFF_BIG + 2 * SZ_ACT);
  constexpr int NT = 8;
  const int ntiles = (NROWS / 128) * NT;
  for (int t = blockIdx.x; t < ntiles; t += gridDim.x) {
    const int mt = t / NT, nt = t - mt * NT;
    f32x4 tot[2][4];
    zero_acc<2>(tot);
    const int r0 = mt * 128 + wm * 32 + fr, c0 = nt * 128 + wn * 64 + fq * 4;
#pragma unroll 1
    for (int k = 0; k < 2; k++) {
      const int br = hf * 2 + k;
      f32x4 ay[2][4];
      zero_acc<2>(ay);
      const int ycol = br < 3 ? br * 256 : 1536;
      gemm_loop<2>(Y + (size_t)mt * 128 * YST + ycol, YST, Wb + ((size_t)br * 1024 + nt * 128) * 256, 256, 256, ay, sA, sB);
#pragma unroll
      for (int i = 0; i < 2; i++)
#pragma unroll
        for (int j = 0; j < 4; j++) {
          const uint2 gv = *(const uint2*)(G + (size_t)(r0 + i * 16) * 2048 + k * 1024 + c0 + j * 16);
          tot[i][j][0] += __uint_as_float(gv.x << 16) * ay[i][j][0];
          tot[i][j][1] += __uint_as_float(gv.x & 0xffff0000u) * ay[i][j][1];
          tot[i][j][2] += __uint_as_float(gv.y << 16) * ay[i][j][2];
          tot[i][j][3] += __uint_as_float(gv.y & 0xffff0000u) * ay[i][j][3];
        }
    }
#pragma unroll
    for (int i = 0; i < 2; i++)
#pragma unroll
      for (int j = 0; j < 4; j++) {
        u16* ap = ACC + (size_t)(r0 + i * 16) * DM + c0 + j * 16;
        f32x4 v = tot[i][j];
        if (hf) {
          const uint2 av = *(const uint2*)ap;
          v[0] += __uint_as_float(av.x << 16); v[1] += __uint_as_float(av.x & 0xffff0000u);
          v[2] += __uint_as_float(av.y << 16); v[3] += __uint_as_float(av.y & 0xffff0000u);
        }
        uint2 ov;
        ov.x = pack2(v[0], v[1]); ov.y = pack2(v[2], v[3]);
        *(uint2*)ap = ov;
      }
  }
}

#define S2_BUF 10816
#define S2_D 0
#define S2_U 2048
#define S2_P 4096
#define S2_K 6144
#define S2_DQ 8192
#define S2_V 10240
#define S2_C1 10752
#define S2_C2 10784
#define S2_ST (2 * S2_BUF)
#define S2_YB (S2_ST + 8192)

__device__ __forceinline__ float red16(float x) {
  x += dppf<0xB1>(x);
  x += dppf<0x4E>(x);
  x += dppf<0x141>(x);
  x += dppf<0x140>(x);
  return x;
}
__device__ __forceinline__ void wave_lds_sync() {
  asm volatile("s_waitcnt lgkmcnt(0)" ::: "memory");
  __builtin_amdgcn_wave_barrier();
}

template <int MIX>
__device__ __forceinline__ void scan2_item(const Params& p, int l, int b, int h, int dir, int rq, float* sm) {
  constexpr int EPL = (MIX == 2) ? 2 : 4;
  constexpr int VOFF = (MIX == 2) ? 64 : 128;
  const int tid = TIDX, lane = tid & 63, w = tid >> 6, fr = lane & 15, fq = lane >> 4;
  const bool producer = w >= 4;
  const int pw = w & 3;
  const u16* P = (const u16*)(p.ws + OFF_BIG);
  u16* YS = (u16*)(p.ws + OFF_YS);
  float* BC = (float*)(p.ws + OFF_BC);
  float* ST = sm + S2_ST + pw * 2048;
  float s[EPL];
#pragma unroll
  for (int i = 0; i < EPL; i++) s[i] = 0.f;

  bf16x8 bw2[4], ba2[4];
  float cst[5][4];
  float cw[3][7];
  float muv[4];
  int colv[4];
#pragma unroll
  for (int i = 0; i < 4; i++) { bw2[i] = bf16x8{0, 0, 0, 0, 0, 0, 0, 0}; ba2[i] = bw2[i]; muv[i] = 0.f; colv[i] = 0; }
  if (producer) {
    if (MIX == 0) {
#pragma unroll
      for (int nt = 0; nt < 4; nt++) {
        const int jch = h * 64 + nt * 16 + fr;
#pragma unroll
        for (int jj = 0; jj < 8; jj++) {
          bw2[nt][jj] = (short)f2bf(p.rwkv_w2[((size_t)(l * 2 + dir) * 32 + fq * 8 + jj) * 256 + jch]);
          ba2[nt][jj] = (short)f2bf(p.rwkv_a2[((size_t)(l * 2 + dir) * 32 + fq * 8 + jj) * 256 + jch]);
        }
        cst[0][nt] = p.rwkv_w0[(l * 2 + dir) * 256 + jch];
        cst[1][nt] = p.rwkv_a0[(l * 2 + dir) * 256 + jch];
        cst[2][nt] = p.rwkv_ka[l * 256 + jch];
        cst[3][nt] = p.rwkv_kk[l * 256 + jch];
        cst[4][nt] = p.rwkv_rk[l * 256 + jch];
      }
#pragma unroll
      for (int i = 0; i < 4; i++) {
        const int c = lane + 64 * i;
        colv[i] = i < 3 ? i * 256 + h * 64 + lane : (lane < 32 ? 768 + dir * 32 + lane : 832 + dir * 32 + (lane - 32));
        muv[i] = p.rwkv_mu[l * 960 + colv[i]];
        (void)c;
      }
    } else if (MIX == 1) {
#pragma unroll
      for (int i = 0; i < 3; i++) {
        colv[i] = PB + i * 256 + h * 64 + lane;
#pragma unroll
        for (int tp = 0; tp < 7; tp++) cw[i][tp] = p.gdn_conv[((size_t)l * 7 + tp) * 768 + i * 256 + h * 64 + lane];
      }
    } else {
#pragma unroll
      for (int nt = 0; nt < 2; nt++) {
#pragma unroll
        for (int jj = 0; jj < 8; jj++)
          bw2[nt][jj] = fq < 2 ? (short)f2bf(p.gla_gw2[((size_t)(l * 2 + dir) * 16 + fq * 8 + jj) * 128 + h * 32 + nt * 16 + fr]) : (short)0;
        cst[0][nt] = p.gla_gb[(l * 2 + dir) * 128 + h * 32 + nt * 16 + fr];
      }
      colv[0] = PC + h * 32 + lane;
      if (lane >= 32) colv[0] = PC + 128 + h * 32 + (lane - 32);
      colv[1] = PC + 256 + h * 64 + lane;
      colv[2] = PC + 512 + dir * 16 + (lane & 15);
    }
  }
  __syncthreads();

  for (int c = 0; c <= TPB / 32 + 1; c++) {
    if (producer) {
      if (c >= 2) {
        const int cc = c - 2;
        int seg_row0, t_lo;
        if (cc < 8) { seg_row0 = b * TPB; t_lo = dir == 0 ? cc * 32 : (LC - 32 - cc * 32); }
        else { seg_row0 = b * TPB + LC; t_lo = dir == 0 ? (cc - 8) * 32 : (SEQ - 32 - (cc - 8) * 32); }
        const float* yb = sm + S2_YB + (cc & 1) * 512;
        const int t2 = tid - 256;
#pragma unroll
        for (int i = 0; i < 2; i++) {
          const int idx = t2 + i * 256, tt = idx >> 4, e = idx & 15;
          YS[(size_t)(seg_row0 + t_lo + tt) * YST + dir * 768 + MIX * 256 + h * 64 + rq * 16 + e] = f2bf(yb[idx]);
        }
      }
      if (c < TPB / 32) {
        int seg_row0, seg_len, t_lo;
        if (c < 8) { seg_row0 = b * TPB; seg_len = LC; t_lo = dir == 0 ? c * 32 : (LC - 32 - c * 32); }
        else { seg_row0 = b * TPB + LC; seg_len = SEQ; t_lo = dir == 0 ? (c - 8) * 32 : (SEQ - 32 - (c - 8) * 32); }
        const u16* Pseg = P + (size_t)seg_row0 * PST;
        float* B = sm + (c & 1) * S2_BUF;
        const int t0 = t_lo + pw * 8;
        if (MIX == 0) {
          float raw[10][4];
#pragma unroll
          for (int rr = 0; rr < 10; rr++) {
            const int t = t0 - 1 + rr;
            const float okf = (t >= 0 && t < seg_len) ? 1.f : 0.f;
            const int tc = min(max(t, 0), seg_len - 1);
#pragma unroll
            for (int i = 0; i < 4; i++) raw[rr][i] = bf2f(Pseg[(size_t)tc * PST + PA + colv[i]]) * okf;
          }
#pragma unroll
          for (int j = 0; j < 8; j++)
#pragma unroll
            for (int i = 0; i < 4; i++) {
              float xm = raw[j + 1][i] + (0.5f * (raw[j][i] + raw[j + 2][i]) - raw[j + 1][i]) * muv[i];
              if (i == 3 && lane < 32) xm = tanhf(xm);
              ST[j * 256 + lane + 64 * i] = xm;
            }
        } else if (MIX == 1) {
          float raw[14][3];
#pragma unroll
          for (int rr = 0; rr < 14; rr++) {
            const int t = t0 - 3 + rr;
            const float okf = (t >= 0 && t < seg_len) ? 1.f : 0.f;
            const int tc = min(max(t, 0), seg_len - 1);
#pragma unroll
            for (int i = 0; i < 3; i++) raw[rr][i] = bf2f(Pseg[(size_t)tc * PST + colv[i]]) * okf;
          }
#pragma unroll
          for (int j = 0; j < 8; j++)
#pragma unroll
            for (int i = 0; i < 3; i++) {
              float a = 0.f;
#pragma unroll
              for (int tp = 0; tp < 7; tp++) a += raw[j + tp][i] * cw[i][tp];
              ST[j * 256 + lane + 64 * i] = siluf(a);
            }
          if (lane < 8) {
            const u16* pp = Pseg + (size_t)(t0 + lane) * PST + PB;
            float bx = bf2f(pp[768 + dir * 4 + h]);
            float ax = bf2f(pp[776 + dir * 4 + h]);
            float ld = -__expf(p.gdn_a_log[(l * 2 + dir) * 4 + h]) * softplusf(ax + p.gdn_dt_bias[(l * 2 + dir) * 4 + h]);
            ST[lane * 256 + 192] = sigm(bx);
            ST[lane * 256 + 193] = __expf(ld);
          }
        } else {
          u16 raw[8][3];
#pragma unroll
          for (int j = 0; j < 8; j++) {
            const u16* pp = Pseg + (size_t)(t0 + j) * PST;
#pragma unroll
            for (int i = 0; i < 3; i++) raw[j][i] = pp[colv[i]];
          }
          const float qs = lane < 32 ? 0.17677669529663687f : 1.f;
#pragma unroll
          for (int j = 0; j < 8; j++) {
            ST[j * 256 + lane] = bf2f(raw[j][0]) * qs;
            ST[j * 256 + 64 + lane] = bf2f(raw[j][1]);
            if (lane < 16) ST[j * 256 + 128 + lane] = bf2f(raw[j][2]);
          }
        }
        wave_lds_sync();
        const bool vl = fq < 2;
        if (MIX == 0) {
          bf16x8 aw, aa;
#pragma unroll
          for (int jj = 0; jj < 8; jj++) {
            aw[jj] = fr < 8 ? (short)f2bf(ST[fr * 256 + 192 + fq * 8 + jj]) : (short)0;
            aa[jj] = fr < 8 ? (short)f2bf(ST[fr * 256 + 224 + fq * 8 + jj]) : (short)0;
          }
          f32x4 accw[4], acca[4];
#pragma unroll
          for (int nt = 0; nt < 4; nt++) {
            accw[nt] = __builtin_amdgcn_mfma_f32_16x16x32_bf16(aw, bw2[nt], f32x4{0.f, 0.f, 0.f, 0.f}, 0, 0, 0);
            acca[nt] = __builtin_amdgcn_mfma_f32_16x16x32_bf16(aa, ba2[nt], f32x4{0.f, 0.f, 0.f, 0.f}, 0, 0, 0);
          }
#pragma unroll
          for (int r = 0; r < 4; r++) {
            const int j = (fq & 1) * 4 + r, tt = pw * 8 + j;
            float kkx[4], av[4], kdv[4], rv[4], dec[4];
            float ss = 0.f;
#pragma unroll
            for (int nt = 0; nt < 4; nt++) {
              const int n = nt * 16 + fr;
              rv[nt] = ST[j * 256 + n];
              const float kx = ST[j * 256 + 64 + n];
              dec[nt] = __expf(-0.6065306597126334f * sigm(cst[0][nt] + accw[nt][r]));
              av[nt] = sigm(cst[1][nt] + acca[nt][r]);
              kdv[nt] = kx * (1.f + (av[nt] - 1.f) * cst[2][nt]);
              kkx[nt] = kx * cst[3][nt];
              ss += kkx[nt] * kkx[nt];
            }
            ss = red16(ss);
            const float rs = rsq(ss + 1e-6f);
            float c1 = 0.f, c2 = 0.f, bc = 0.f;
#pragma unroll
            for (int nt = 0; nt < 4; nt++) {
              const int n = nt * 16 + fr;
              const float kk = kkx[nt] * rs;
              if (vl) {
                B[S2_D + tt * 64 + n] = dec[nt];
                B[S2_U + tt * 64 + n] = kk;
                B[S2_P + tt * 64 + n] = -kk * av[nt];
                B[S2_K + tt * 64 + n] = kdv[nt];
                B[S2_DQ + tt * 64 + n] = dec[nt] * rv[nt];
              }
              c1 += -kk * av[nt] * rv[nt];
              c2 += kdv[nt] * rv[nt];
              bc += rv[nt] * kdv[nt] * cst[4][nt];
            }
            c1 = red16(c1); c2 = red16(c2); bc = red16(bc);
            if (vl && fr == 0) {
              B[S2_C1 + tt] = c1;
              B[S2_C2 + tt] = c2;
              if (rq == 0) BC[(size_t)(seg_row0 + t_lo + tt) * 8 + h * 2 + dir] = bc;
            }
          }
        } else if (MIX == 1) {
#pragma unroll
          for (int r = 0; r < 4; r++) {
            const int j = (fq & 1) * 4 + r, tt = pw * 8 + j;
            float qv[4], kv[4];
            float sq = 0.f, sk = 0.f;
#pragma unroll
            for (int nt = 0; nt < 4; nt++) {
              const int n = nt * 16 + fr;
              qv[nt] = ST[j * 256 + n];
              kv[nt] = ST[j * 256 + 64 + n];
              sq += qv[nt] * qv[nt];
              sk += kv[nt] * kv[nt];
            }
            sq = red16(sq); sk = red16(sk);
            const float rq_ = rsq(sq + 1e-6f) * 0.125f, rk_ = rsq(sk + 1e-6f);
            const float beta = ST[j * 256 + 192], alpha = ST[j * 256 + 193];
            float dkq = 0.f;
#pragma unroll
            for (int nt = 0; nt < 4; nt++) {
              const int n = nt * 16 + fr;
              const float qn = qv[nt] * rq_, kn = kv[nt] * rk_;
              if (vl) {
                B[S2_D + tt * 64 + n] = alpha;
                B[S2_U + tt * 64 + n] = kn;
                B[S2_P + tt * 64 + n] = -alpha * beta * kn;
                B[S2_K + tt * 64 + n] = beta * kn;
                B[S2_DQ + tt * 64 + n] = alpha * qn;
              }
              dkq += kn * qn;
            }
            dkq = red16(dkq);
            if (vl && fr == 0) {
              B[S2_C1 + tt] = -alpha * beta * dkq;
              B[S2_C2 + tt] = beta * dkq;
            }
          }
        } else {
          bf16x8 ag;
#pragma unroll
          for (int jj = 0; jj < 8; jj++) ag[jj] = (fr < 8 && fq < 2) ? (short)f2bf(ST[fr * 256 + 128 + fq * 8 + jj]) : (short)0;
          f32x4 accg[2];
#pragma unroll
          for (int nt = 0; nt < 2; nt++) accg[nt] = __builtin_amdgcn_mfma_f32_16x16x32_bf16(ag, bw2[nt], f32x4{0.f, 0.f, 0.f, 0.f}, 0, 0, 0);
#pragma unroll
          for (int r = 0; r < 4; r++) {
            const int j = (fq & 1) * 4 + r, tt = pw * 8 + j;
            float dkq = 0.f;
#pragma unroll
            for (int nt = 0; nt < 2; nt++) {
              const int n = nt * 16 + fr;
              const float lg = cst[0][nt] + accg[nt][r];
              const float ls = fminf(lg, 0.f) - log1pf(__expf(-fabsf(lg)));
              const float alpha = __expf(ls * (1.f / 16.f));
              const float qv = ST[j * 256 + n], kv = ST[j * 256 + 32 + n];
              if (vl) {
                B[S2_D + tt * 64 + n] = alpha;
                B[S2_K + tt * 64 + n] = kv;
                B[S2_DQ + tt * 64 + n] = alpha * qv;
              }
              dkq += kv * qv;
            }
            dkq = red16(dkq);
            if (vl && fr == 0) B[S2_C2 + tt] = dkq;
          }
        }
#pragma unroll
        for (int i = 0; i < 2; i++) {
          const int idx = lane + 64 * i, j = idx >> 4, e = idx & 15;
          B[S2_V + (pw * 8 + j) * 16 + e] = ST[j * 256 + VOFF + rq * 16 + e];
        }
      }
    } else if (c >= 1 && c <= TPB / 32) {
      const float* B = sm + ((c - 1) & 1) * S2_BUF;
      float* yb = sm + S2_YB + ((c - 1) & 1) * 512;
      const int rl = w * 4 + fq;
      const int dtt = dir ? -1 : 1;
      int tt = dir ? 31 : 0;
      float dv[EPL], kv[EPL], qv[EPL], uv[EPL], pv[EPL], vv, c1v, c2v;
      float dn[EPL], kn[EPL], qn[EPL], un[EPL], pn[EPL], vn, c1n, c2n;
#define S2_LOAD(D_, K_, Q_, U_, P_, V_, C1_, C2_, T_)                                   \
  do {                                                                                  \
    const int o_ = (T_) * 64 + fr * EPL;                                                \
    if (EPL == 4) {                                                                     \
      float4 t4 = *(const float4*)(B + S2_D + o_);                                      \
      D_[0] = t4.x; D_[1] = t4.y; D_[2] = t4.z; D_[3] = t4.w;                           \
      t4 = *(const float4*)(B + S2_K + o_);                                             \
      K_[0] = t4.x; K_[1] = t4.y; K_[2] = t4.z; K_[3] = t4.w;                           \
      t4 = *(const float4*)(B + S2_DQ + o_);                                            \
      Q_[0] = t4.x; Q_[1] = t4.y; Q_[2] = t4.z; Q_[3] = t4.w;                           \
      t4 = *(const float4*)(B + S2_U + o_);                                             \
      U_[0] = t4.x; U_[1] = t4.y; U_[2] = t4.z; U_[3] = t4.w;                           \
      t4 = *(const float4*)(B + S2_P + o_);                                             \
      P_[0] = t4.x; P_[1] = t4.y; P_[2] = t4.z; P_[3] = t4.w;                           \
      C1_ = B[S2_C1 + (T_)];                                                            \
    } else {                                                                            \
      float2 t2 = *(const float2*)(B + S2_D + o_);                                      \
      D_[0] = t2.x; D_[1] = t2.y;                                                       \
      t2 = *(const float2*)(B + S2_K + o_);                                             \
      K_[0] = t2.x; K_[1] = t2.y;                                                       \
      t2 = *(const float2*)(B + S2_DQ + o_);                                            \
      Q_[0] = t2.x; Q_[1] = t2.y;                                                       \
      U_[0] = U_[1] = P_[0] = P_[1] = 0.f; C1_ = 0.f;                                   \
    }                                                                                   \
    V_ = B[S2_V + (T_) * 16 + rl];                                                      \
    C2_ = B[S2_C2 + (T_)];                                                              \
  } while (0)
#define S2_STEP(D_, K_, Q_, U_, P_, V_, C1_, C2_, T_)                                   \
  do {                                                                                  \
    float sq = 0.f, sa = 0.f;                                                           \
    _Pragma("unroll") for (int i = 0; i < EPL; i++) sq += s[i] * Q_[i];                 \
    if (MIX != 2) {                                                                     \
      _Pragma("unroll") for (int i = 0; i < EPL; i++) sa += s[i] * U_[i];               \
      sa = red16(sa);                                                                   \
    }                                                                                   \
    sq = red16(sq);                                                                     \
    float y = sq + V_ * C2_;                                                            \
    if (MIX != 2) y += sa * C1_;                                                        \
    _Pragma("unroll") for (int i = 0; i < EPL; i++) {                                   \
      float t = s[i] * D_[i] + V_ * K_[i];                                              \
      if (MIX != 2) t += sa * P_[i];                                                    \
      s[i] = t;                                                                         \
    }                                                                                   \
    yb[(T_) * 16 + rl] = y;                                                             \
  } while (0)
      S2_LOAD(dv, kv, qv, uv, pv, vv, c1v, c2v, tt);
#pragma unroll 1
      for (int st = 0; st < 32; st += 2) {
        const int t1 = tt + dtt;
        S2_LOAD(dn, kn, qn, un, pn, vn, c1n, c2n, t1);
        S2_STEP(dv, kv, qv, uv, pv, vv, c1v, c2v, tt);
        const int t2 = st + 2 < 32 ? t1 + dtt : t1;
        S2_LOAD(dv, kv, qv, uv, pv, vv, c1v, c2v, t2);
        S2_STEP(dn, kn, qn, un, pn, vn, c1n, c2n, t1);
        tt = t2;
      }
#undef S2_LOAD
#undef S2_STEP
    }
    __syncthreads();
  }
}

__device__ __forceinline__ void attn_item(const Params& p, int l, int b, int qb, int hk, bool isctx, unsigned char* smem) {
  u16* KS = (u16*)smem;
  u16* VT = KS + 64 * LDT;
  u16* PL = VT + 64 * LDT;
  float2* ROPE = (float2*)(PL + 8 * 32 * LDT);
  const int tid = TIDX, lane = tid & 63, w = tid >> 6, fr = lane & 15, fq = lane >> 4;
  const u16* P = (const u16*)(p.ws + OFF_BIG);
  u16* Y = (u16*)(p.ws + OFF_YS);
  const int qh = hk * 2 + (w >> 2);
  const int tb = qb * 128 + (w & 3) * 32;
  const int qrow0 = b * TPB + (isctx ? 0 : LC);
  __syncthreads();
  for (int i = tid; i < 1024; i += NTHR) {
    int pos = i >> 4, fi = i & 15;
    float inv = powf(10000.f, -(float)fi / 16.f);
    float sn, cs;
    sincosf((float)pos * inv, &sn, &cs);
    ROPE[i] = make_float2(cs, sn);
  }
  __syncthreads();
  bf16x8 qf[2][2];
#pragma unroll
  for (int mi = 0; mi < 2; mi++)
#pragma unroll
    for (int ks = 0; ks < 2; ks++) {
      const int tq = tb + mi * 16 + fr;
      const u16* qp = P + (size_t)(qrow0 + tq) * PST + PD + qh * 64 + ks * 32;
      uint4 own = *(const uint4*)(qp + fq * 8);
      uint4 par = *(const uint4*)(qp + (fq ^ 2) * 8);
      const unsigned ow[4] = {own.x, own.y, own.z, own.w};
      const unsigned pw[4] = {par.x, par.y, par.z, par.w};
      const int pos = ks == 0 ? (tq >> 6) : (tq & 63);
      bf16x8 f;
#pragma unroll
      for (int jj = 0; jj < 8; jj++) {
        float xo = bf2f((u16)((ow[jj >> 1] >> ((jj & 1) * 16)) & 0xffff));
        float xp = bf2f((u16)((pw[jj >> 1] >> ((jj & 1) * 16)) & 0xffff));
        float v = xo;
        if (!isctx) {
          float2 cs = ROPE[pos * 16 + (fq & 1) * 8 + jj];
          v = fq < 2 ? xo * cs.x - xp * cs.y : xp * cs.y + xo * cs.x;
        }
        f[jj] = (short)f2bf(v * 0.125f);
      }
      qf[mi][ks] = f;
    }
  f32x4 oacc[2][4];
#pragma unroll
  for (int mi = 0; mi < 2; mi++)
#pragma unroll
    for (int nd = 0; nd < 4; nd++) oacc[mi][nd] = f32x4{0.f, 0.f, 0.f, 0.f};
  float mrow[2][4], lrow[2][4];
#pragma unroll
  for (int mi = 0; mi < 2; mi++)
#pragma unroll
    for (int r = 0; r < 4; r++) { mrow[mi][r] = -1e30f; lrow[mi][r] = 0.f; }

  const int q0 = qb * 128;
  const int band_lo = isctx ? 0 : max(0, q0 - 128), band_hi = isctx ? 0 : min(SEQ, q0 + 256);
  const int ntile = 4 + (band_hi - band_lo) / 64;
  u16* pl = PL + w * 32 * LDT;
  for (int tl = 0; tl < ntile; tl++) {
    const bool band = tl >= 4;
    const int k0 = band ? band_lo + (tl - 4) * 64 : tl * 64;
    __syncthreads();
    {
      const int key = tid >> 3, kc = tid & 7;
      const int kpos = k0 + key;
      const u16* kp = P + (size_t)(b * TPB + (band ? LC : 0) + kpos) * PST + PD + 256 + hk * 64;
      uint4 own = *(const uint4*)(kp + kc * 8);
      uint4 vv = *(const uint4*)(kp + 128 + kc * 8);
      uint4 par = *(const uint4*)(kp + (kc ^ 2) * 8);
      if (band) {
        const unsigned ow[4] = {own.x, own.y, own.z, own.w};
        const unsigned pw[4] = {par.x, par.y, par.z, par.w};
        const int pos = kc < 4 ? (kpos >> 6) : (kpos & 63);
        unsigned res[4];
#pragma unroll
        for (int jj = 0; jj < 8; jj += 2) {
          float v2[2];
#pragma unroll
          for (int e = 0; e < 2; e++) {
            float xo = bf2f((u16)((ow[jj >> 1] >> (e * 16)) & 0xffff));
            float xp = bf2f((u16)((pw[jj >> 1] >> (e * 16)) & 0xffff));
            float2 cs = ROPE[pos * 16 + (kc & 1) * 8 + jj + e];
            v2[e] = (kc & 2) == 0 ? xo * cs.x - xp * cs.y : xp * cs.y + xo * cs.x;
          }
          res[jj >> 1] = pack2(v2[0], v2[1]);
        }
        own = make_uint4(res[0], res[1], res[2], res[3]);
      }
      *(uint4*)(KS + key * LDT + kc * 8) = own;
      const unsigned vw[4] = {vv.x, vv.y, vv.z, vv.w};
#pragma unroll
      for (int jj = 0; jj < 8; jj++) VT[(kc * 8 + jj) * LDT + key] = (u16)((vw[jj >> 1] >> ((jj & 1) * 16)) & 0xffff);
    }
    __syncthreads();
    f32x4 sc[2][4];
#pragma unroll
    for (int mi = 0; mi < 2; mi++)
#pragma unroll
      for (int nj = 0; nj < 4; nj++) sc[mi][nj] = f32x4{0.f, 0.f, 0.f, 0.f};
#pragma unroll
    for (int ks = 0; ks < 2; ks++) {
      bf16x8 kf[4];
#pragma unroll
      for (int nj = 0; nj < 4; nj++) kf[nj] = *(const bf16x8*)(KS + (nj * 16 + fr) * LDT + ks * 32 + fq * 8);
#pragma unroll
      for (int mi = 0; mi < 2; mi++)
#pragma unroll
        for (int nj = 0; nj < 4; nj++) sc[mi][nj] = __builtin_amdgcn_mfma_f32_16x16x32_bf16(qf[mi][ks], kf[nj], sc[mi][nj], 0, 0, 0);
    }
#pragma unroll
    for (int mi = 0; mi < 2; mi++)
#pragma unroll
      for (int r = 0; r < 4; r++) {
        const int qpos = tb + mi * 16 + fq * 4 + r;
        float mx = -1e30f;
#pragma unroll
        for (int nj = 0; nj < 4; nj++) {
          float v = sc[mi][nj][r];
          if (band) {
            int d = qpos - (k0 + nj * 16 + fr);
            if (d > 128 || d < -128) v = -1e30f;
          }
          sc[mi][nj][r] = v;
          mx = fmaxf(mx, v);
        }
        mx = fmaxf(mx, __shfl_xor(mx, 1));
        mx = fmaxf(mx, __shfl_xor(mx, 2));
        mx = fmaxf(mx, __shfl_xor(mx, 4));
        mx = fmaxf(mx, __shfl_xor(mx, 8));
        const float mnew = fmaxf(mrow[mi][r], mx);
        const float alpha = __expf(mrow[mi][r] - mnew);
        mrow[mi][r] = mnew;
        float ls = 0.f;
#pragma unroll
        for (int nj = 0; nj < 4; nj++) {
          float pe = __expf(sc[mi][nj][r] - mnew);
          ls += pe;
          pl[(mi * 16 + fq * 4 + r) * LDT + nj * 16 + fr] = f2bf(pe);
        }
        lrow[mi][r] = lrow[mi][r] * alpha + ls;
#pragma unroll
        for (int nd = 0; nd < 4; nd++) oacc[mi][nd][r] *= alpha;
      }
    asm volatile("s_waitcnt lgkmcnt(0)" ::: "memory");
    __builtin_amdgcn_wave_barrier();
#pragma unroll
    for (int ks = 0; ks < 2; ks++) {
      bf16x8 pf[2], vf[4];
#pragma unroll
      for (int mi = 0; mi < 2; mi++) pf[mi] = *(const bf16x8*)(pl + (mi * 16 + fr) * LDT + ks * 32 + fq * 8);
#pragma unroll
      for (int nd = 0; nd < 4; nd++) vf[nd] = *(const bf16x8*)(VT + (nd * 16 + fr) * LDT + ks * 32 + fq * 8);
#pragma unroll
      for (int mi = 0; mi < 2; mi++)
#pragma unroll
        for (int nd = 0; nd < 4; nd++) oacc[mi][nd] = __builtin_amdgcn_mfma_f32_16x16x32_bf16(pf[mi], vf[nd], oacc[mi][nd], 0, 0, 0);
    }
    asm volatile("s_waitcnt lgkmcnt(0)" ::: "memory");
    __builtin_amdgcn_wave_barrier();
  }
  const float sink = p.attn_sink[l * 4 + qh];
#pragma unroll
  for (int mi = 0; mi < 2; mi++)
#pragma unroll
    for (int r = 0; r < 4; r++) {
      float ls = lrow[mi][r];
      ls += __shfl_xor(ls, 1);
      ls += __shfl_xor(ls, 2);
      ls += __shfl_xor(ls, 4);
      ls += __shfl_xor(ls, 8);
      ls += __expf(sink - mrow[mi][r]);
      const float inv = 1.f / ls;
      const int tq = tb + mi * 16 + fq * 4 + r;
#pragma unroll
      for (int nd = 0; nd < 4; nd++) Y[(size_t)(qrow0 + tq) * YST + 1536 + qh * 64 + nd * 16 + fr] = f2bf(oacc[mi][nd][r] * inv);
    }
}

__device__ __forceinline__ void phase_mix(const Params& p, int l, unsigned char* smem) {
  float* sm = (float*)smem;
  const int G = gridDim.x;
  for (int it = blockIdx.x; it < 768; it += G) {
    const int mix = it >> 8, rem = it & 255, b = rem >> 5, h = (rem >> 3) & 3, dir = (rem >> 2) & 1, rq = rem & 3;
    if (mix == 0) scan2_item<0>(p, l, b, h, dir, rq, sm);
    else if (mix == 1) scan2_item<1>(p, l, b, h, dir, rq, sm);
    else scan2_item<2>(p, l, b, h, dir, rq, sm);
  }
  for (int it = blockIdx.x; it < 544; it += G) {
    if (it < 512) {
      int b = it >> 6, qb = (it >> 1) & 31, hk = it & 1;
      attn_item(p, l, b, qb, hk, false, smem);
    } else {
      int r = it - 512, b = r >> 2, qb = (r >> 1) & 1, hk = r & 1;
      attn_item(p, l, b, qb, hk, true, smem);
    }
  }
}

__device__ __forceinline__ void phase_post(const Params& p, int l) {
  const int lane = TIDX & 63, wv = TIDX >> 6;
  const u16* P = (const u16*)(p.ws + OFF_BIG);
  u16* YS = (u16*)(p.ws + OFF_YS);
  const float* BC = (const float*)(p.ws + OFF_BC);
  const int j0 = lane * 4, hd = lane >> 4;
  for (int r = blockIdx.x * 8 + wv; r < NROWS; r += gridDim.x * 8) {
    const int b = r / TPB, t = r - b * TPB;
    const bool has_prev = (t != 0) && (t != LC), has_next = (t != LC - 1) && (t != TPB - 1);
    const int poff = has_prev ? PST : 0, noff = has_next ? PST : 0;
    const float pmul = has_prev ? 1.f : 0.f, nmul = has_next ? 1.f : 0.f;
    u16* ys = YS + (size_t)r * YST;
    const u16* pr = P + (size_t)r * PST;
    float y[3][4];
#pragma unroll
    for (int m = 0; m < 3; m++) {
      uint2 a = *(const uint2*)(ys + m * 256 + j0);
      uint2 c = *(const uint2*)(ys + 768 + m * 256 + j0);
      y[m][0] = bf2f((u16)(a.x & 0xffff)) + bf2f((u16)(c.x & 0xffff));
      y[m][1] = bf2f((u16)(a.x >> 16)) + bf2f((u16)(c.x >> 16));
      y[m][2] = bf2f((u16)(a.y & 0xffff)) + bf2f((u16)(c.y & 0xffff));
      y[m][3] = bf2f((u16)(a.y >> 16)) + bf2f((u16)(c.y >> 16));
    }
    float o[3][4];
    {
      float sum = y[0][0] + y[0][1] + y[0][2] + y[0][3];
      sum += __shfl_xor(sum, 1); sum += __shfl_xor(sum, 2); sum += __shfl_xor(sum, 4); sum += __shfl_xor(sum, 8);
      const float mean = sum * (1.f / 64.f);
      float vs = 0.f;
#pragma unroll
      for (int i = 0; i < 4; i++) { float d = y[0][i] - mean; vs += d * d; }
      vs += __shfl_xor(vs, 1); vs += __shfl_xor(vs, 2); vs += __shfl_xor(vs, 4); vs += __shfl_xor(vs, 8);
      const float rstd = rsq(vs * (1.f / 64.f) + 64e-5f);
      float sg;
      {
        const int col = 896 + lane;
        float pv = bf2f(pr[PA + col]);
        float pp = bf2f(pr[PA + col - poff]) * pmul;
        float pn = bf2f(pr[PA + col + noff]) * nmul;
        float xm = pv + (0.5f * (pp + pn) - pv) * p.rwkv_mu[l * 960 + col];
        sg = sigm(xm);
      }
      float gate[4] = {0.f, 0.f, 0.f, 0.f};
      const float* g2 = p.rwkv_g2 + (size_t)l * 64 * 256 + j0;
#pragma unroll 8
      for (int i = 0; i < 64; i++) {
        float si = __shfl(sg, i);
        float4 gw = *(const float4*)(g2 + i * 256);
        gate[0] += si * gw.x; gate[1] += si * gw.y; gate[2] += si * gw.z; gate[3] += si * gw.w;
      }
      const float bcs = BC[(size_t)r * 8 + hd * 2] + BC[(size_t)r * 8 + hd * 2 + 1];
#pragma unroll
      for (int i = 0; i < 4; i++) {
        const int col = 512 + j0 + i;
        float pv = bf2f(pr[PA + col]);
        float pp = bf2f(pr[PA + col - poff]) * pmul;
        float pn = bf2f(pr[PA + col + noff]) * nmul;
        float v = pv + (0.5f * (pp + pn) - pv) * p.rwkv_mu[l * 960 + col];
        float yn = (y[0][i] - mean) * rstd * p.rwkv_ln_g[l * 256 + j0 + i] + p.rwkv_ln_b[l * 256 + j0 + i];
        o[0][i] = (yn + bcs * v) * gate[i];
      }
    }
#pragma unroll
    for (int m = 1; m < 3; m++) {
      float ss = y[m][0] * y[m][0] + y[m][1] * y[m][1] + y[m][2] * y[m][2] + y[m][3] * y[m][3];
      ss += __shfl_xor(ss, 1); ss += __shfl_xor(ss, 2); ss += __shfl_xor(ss, 4); ss += __shfl_xor(ss, 8);
      const float inv = rsq(ss * (1.f / 64.f) + 1e-6f);
      const float* ng = (m == 1 ? p.gdn_norm_g : p.gla_norm_g) + l * 64 + (lane & 15) * 4;
      const u16* gp = pr + (m == 1 ? PB + 784 : PC + 544) + j0;
#pragma unroll
      for (int i = 0; i < 4; i++) o[m][i] = y[m][i] * inv * ng[i] * siluf(bf2f(gp[i]));
    }
    asm volatile("s_waitcnt vmcnt(0)" ::: "memory");
    __builtin_amdgcn_wave_barrier();
#pragma unroll
    for (int m = 0; m < 3; m++) {
      uint2 ov;
      ov.x = pack2(o[m][0], o[m][1]);
      ov.y = pack2(o[m][2], o[m][3]);
      *(uint2*)(ys + m * 256 + j0) = ov;
    }
  }
}

#if defined(SKIPS)
#define EN(k) (SKIPS != (k))
#elif !defined(ONLYS)
#define EN(k) 1
#else
#define EN(k) (ONLYS == (k))
#endif
__device__ __forceinline__ void run_phase(const Params& p, int ph, unsigned char* smem) {
  if (ph == 0) { if (EN(10)) phase_init0(p, (float*)smem); return; }
  if (ph == 1) { if (EN(11)) phase_init1(p); return; }
  int l = 0, s = 12;
  if (ph >= 3) { l = (ph - 3) / 12; s = (ph - 3) - l * 12; }
  unsigned char* wl = p.ws + OFF_W + (size_t)l * SZ_WL;
  PG8_LAS unsigned char* lds = (PG8_LAS unsigned char*)smem;
  pg8::StaticOrder S;
  if (s == 12 || s == 8 || s == 11) {
    if (EN(5)) rowpass(p, l, s == 12 ? 0 : (s == 8 ? 1 : 2));
  } else if (s == 0 || s == 3 || s == 5 || s == 7 || s == 10) {
    pg8::Gemm g; EpiBf E;
    g.M = NROWS; E.bias = nullptr; E.act = 0;
    if (s == 0) { g.A = (const u16*)(p.ws + OFF_H); g.lda = DM; g.Bt = (const u16*)(wl + OW_IN); g.K = DM; g.N = PST; E.O = (u16*)(p.ws + OFF_BIG); E.ldc = PST; }
    else if (s == 3 || s == 5) {
      const int hf = s == 5;
      g.A = (const u16*)(p.ws + OFF_H); g.lda = DM; g.Bt = (const u16*)(wl + OW_G) + (size_t)hf * 2048 * DM; g.K = DM; g.N = 2048;
      E.O = (u16*)(p.ws + OFF_BIG); E.ldc = 2048; E.bias = p.gate_b + (size_t)l * 4096 + hf * 2048; E.act = 1;
    }
    else if (s == 7) { g.A = (const u16*)(p.ws + OFF_BIG + 2 * SZ_ACT); g.lda = DM; g.Bt = (const u16*)(wl + OW_O); g.K = DM; g.N = DM; E.O = (u16*)(p.ws + OFF_BIG); E.ldc = DM; }
    else { g.A = (const u16*)(p.ws + OFF_BIG); g.lda = FH; g.Bt = (const u16*)(wl + OW_2); g.K = FH; g.N = DM; E.O = (u16*)(p.ws + OFF_YS); E.ldc = DM; }
    S.init(g.M, g.N, gridDim.x, blockIdx.x);
    if (EN(0)) pg8::gemm_phase<EpiBf, pg8::StaticOrder, false>(lds, g, S, E, nullptr);
  } else if (s == 4 || s == 6) {
    if (EN(3)) phase_ypart(p, l, s == 6, smem);
  } else if (s == 1) {
    if (EN(1)) phase_mix(p, l, smem);
  } else if (s == 2) {
    if (EN(2)) phase_post(p, l);
  } else {
    pg8::Gemm g; EpiSwiglu E;
    g.M = NROWS; g.N = 2 * FH; g.K = DM; g.lda = DM; g.A = (const u16*)(p.ws + OFF_H); g.Bt = (const u16*)(wl + OW_1);
    E.O = (u16*)(p.ws + OFF_BIG);
    S.init(g.M, g.N, gridDim.x, blockIdx.x);
    if (EN(6)) pg8::gemm_phase<EpiSwiglu, pg8::StaticOrder, false>(lds, g, S, E, nullptr);
  }
}

__global__ void __launch_bounds__(NTHR) hybrid_flow_mega(Params p, int ph0, int ph1) {
  __shared__ __attribute__((aligned(16))) unsigned char smem[131072];
  cg::grid_group grid = cg::this_grid();
  for (int ph = ph0; ph < ph1; ph++) {
    run_phase(p, ph, smem);
#ifdef DUPMASK
    {
      int sidx = ph >= 3 ? (ph - 3) % 12 : 12 + ph;
      if ((DUPMASK >> sidx) & 1) { __syncthreads(); run_phase(p, ph, smem); }
    }
#endif
    if (ph + 1 < ph1) grid.sync();
  }
}

extern "C" void kernel_launch(void* const* d_in, const int* in_sizes, int n_in, void* d_out, int out_size, void* d_ws,
                              size_t ws_size, hipStream_t stream) {
  Params p{};
  const float** pp = (const float**)&p;
  for (int i = 0; i < 32; i++) pp[i] = (const float*)d_in[i];
  p.out = (float*)d_out;
  p.ws = (unsigned char*)d_ws;
  static int grid_blocks = 0;
  if (!grid_blocks) {
    int dev = 0, cus = 0, per_cu = 0;
    hipGetDevice(&dev);
    hipDeviceGetAttribute(&cus, hipDeviceAttributeMultiprocessorCount, dev);
    hipOccupancyMaxActiveBlocksPerMultiprocessor(&per_cu, hybrid_flow_mega, NTHR, 0);
    if (per_cu < 1) per_cu = 1;
    grid_blocks = cus * per_cu;
  }
#ifdef MULTI_LAUNCH
  for (int ph = 0; ph < NPHASE; ph++) {
    hipLaunchKernelGGL(hybrid_flow_mega, dim3(grid_blocks), dim3(NTHR), 0, stream, p, ph, ph + 1);
  }
#else
  int ph0 = 0, ph1 = NPHASE;
  void* args[] = {&p, &ph0, &ph1};
  hipError_t e = hipLaunchCooperativeKernel((void*)hybrid_flow_mega, dim3(grid_blocks), dim3(NTHR), args, 0, stream);
  if (e != hipSuccess) fprintf(stderr, "cooperative launch failed: %s (grid %d)\n", hipGetErrorString(e), grid_blocks);
#endif
}
```

```cpp
#include <hip/hip_runtime.h>
#include <hip/hip_cooperative_groups.h>
#include <cstdio>
namespace cg = cooperative_groups;

typedef unsigned short u16;
using bf16x8 = __attribute__((ext_vector_type(8))) short;
using f32x4 = __attribute__((ext_vector_type(4))) float;

#define DM 1024
#define NBATCH 8
#define SEQ 4096
#define LC 256
#define TPB 4352
#define NROWS 34816
#define PST 3328
#define YST 1792
#define FH 2816
#define INW 7408
#define NTHR 512
#define PA 0
#define PB 960
#define PC 2000
#define PD 2800
#define NPHASE 27
#define SCAN3_MASK 7

struct Params {
  const float *x, *c, *ctx, *c_ctx, *ada_w, *ada_b, *norm_g, *w_in, *gate_b, *w_branch, *w_out,
      *rwkv_mu, *rwkv_w0, *rwkv_w2, *rwkv_a0, *rwkv_a2, *rwkv_g2, *rwkv_kk, *rwkv_ka, *rwkv_rk, *rwkv_ln_g,
      *rwkv_ln_b, *gdn_conv, *gdn_a_log, *gdn_dt_bias, *gdn_norm_g, *gla_gw2, *gla_gb, *gla_norm_g, *attn_sink,
      *ffn_w1, *ffn_w2;
  float* out;
  unsigned char* ws;
};

constexpr size_t SZ_WL = 36700160;
constexpr size_t OW_IN = 0;
constexpr size_t OW_G = OW_IN + (size_t)PST * 1024 * 2;
constexpr size_t OW_B = OW_G + (size_t)4096 * 1024 * 2;
constexpr size_t OW_O = OW_B + (size_t)4 * 1024 * 256 * 2;
constexpr size_t OW_1 = OW_O + (size_t)1024 * 1024 * 2;
constexpr size_t OW_2 = OW_1 + (size_t)5632 * 1024 * 2;
static_assert(OW_2 + (size_t)1024 * FH * 2 == SZ_WL, "weights size");
constexpr size_t SZ_ACT = (size_t)NROWS * DM * 2;
constexpr size_t OFF_W = 0;
constexpr size_t OFF_XC = OFF_W + 2 * SZ_WL;
constexpr size_t OFF_MODP = OFF_XC + (size_t)NBATCH * LC * DM * 4;
constexpr size_t OFF_MOD = OFF_MODP + (size_t)2 * 8 * 9 * 6144 * 4;
constexpr size_t OFF_BC = OFF_MOD + (size_t)2 * 9 * 6144 * 4;
constexpr size_t OFF_H = OFF_BC + (size_t)NROWS * 8 * 4;
constexpr size_t OFF_YS = OFF_H + SZ_ACT;
constexpr size_t OFF_BIG = OFF_YS + (size_t)NROWS * YST * 2;
constexpr size_t WS_END = OFF_BIG + (size_t)NROWS * PST * 2;
static_assert(WS_END <= (size_t)536870912, "ws too large");

__device__ __forceinline__ int launder_tid() { int t = threadIdx.x; asm volatile("" : "+v"(t)); return t; }
#define TIDX (launder_tid())
__device__ __forceinline__ u16 f2bf(float f) {
  unsigned u = __float_as_uint(f);
  u += 0x7fffu + ((u >> 16) & 1u);
  return (u16)(u >> 16);
}
__device__ __forceinline__ float bf2f(u16 h) { return __uint_as_float(((unsigned)h) << 16); }
__device__ __forceinline__ unsigned pack2(float a, float b) { return (unsigned)f2bf(a) | ((unsigned)f2bf(b) << 16); }
__device__ __forceinline__ float sigm(float x) { return __builtin_amdgcn_rcpf(1.f + __expf(-x)); }
__device__ __forceinline__ float siluf(float x) { return x * __builtin_amdgcn_rcpf(1.f + __expf(-x)); }
__device__ __forceinline__ float rsq(float x) { return __builtin_amdgcn_rsqf(x); }
__device__ __forceinline__ float softplusf(float x) { return fmaxf(x, 0.f) + log1pf(__expf(-fabsf(x))); }
__device__ __forceinline__ float wsum(float v) {
#pragma unroll
  for (int o = 32; o > 0; o >>= 1) v += __shfl_xor(v, o);
  return v;
}
template <int CTRL>
__device__ __forceinline__ float dppf(float x) {
  return __int_as_float(__builtin_amdgcn_update_dpp(__float_as_int(x), __float_as_int(x), CTRL, 0xf, 0xf, false));
}
__device__ __forceinline__ float red8(float x) {
  x += dppf<0xB1>(x);
  x += dppf<0x4E>(x);
  x += dppf<0x141>(x);
  return x;
}
__device__ __forceinline__ const float* xin_row(const Params& p, int r) {
  int b = r / TPB, t = r - b * TPB;
  return t < LC ? p.ctx + ((size_t)(b * LC + t)) * DM : p.x + ((size_t)(b * SEQ + t - LC)) * DM;
}
__device__ __forceinline__ float* x_row(const Params& p, int r) {
  int b = r / TPB, t = r - b * TPB;
  return t < LC ? (float*)(p.ws + OFF_XC) + ((size_t)(b * LC + t)) * DM : p.out + ((size_t)(b * SEQ + t - LC)) * DM;
}
__device__ __forceinline__ int mod_row(int r) {
  int b = r / TPB, t = r - b * TPB;
  return t < LC ? 8 : b;
}

struct MapId { int lim, off; __device__ int operator()(int n) const { return n < lim ? n + off : -1; } };
struct MapW1 { __device__ int operator()(int n) const { int q = n >> 3, s = n & 7; return s < 4 ? q * 4 + s : FH + q * 4 + (s - 4); } };

template <class Map>
__device__ __forceinline__ void conv_tile(const float* __restrict__ src, int ld, u16* __restrict__ dst, int K, int n0,
                                          int k0, Map map, float* tile) {
  const int tid = TIDX;
  const int nn = tid & 63, kr = tid >> 6;
  const int sc = map(n0 + nn);
#pragma unroll
  for (int ps = 0; ps < 8; ps++) {
    int kk = ps * 8 + kr;
    float v = sc >= 0 ? src[(size_t)(k0 + kk) * ld + sc] : 0.f;
    tile[kk * 65 + nn] = v;
  }
  __syncthreads();
  const int n2 = tid >> 3, kc = tid & 7;
  uint4 o;
  o.x = pack2(tile[(kc * 8 + 0) * 65 + n2], tile[(kc * 8 + 1) * 65 + n2]);
  o.y = pack2(tile[(kc * 8 + 2) * 65 + n2], tile[(kc * 8 + 3) * 65 + n2]);
  o.z = pack2(tile[(kc * 8 + 4) * 65 + n2], tile[(kc * 8 + 5) * 65 + n2]);
  o.w = pack2(tile[(kc * 8 + 6) * 65 + n2], tile[(kc * 8 + 7) * 65 + n2]);
  *(uint4*)(dst + (size_t)(n0 + n2) * K + k0 + kc * 8) = o;
  __syncthreads();
}

__device__ __forceinline__ void phase_init0(const Params& p, float* sm) {
  const int tid = TIDX;
  constexpr int NMOD = 192, NCONV = 4480 * 2;
  for (int it = blockIdx.x; it < NMOD + NCONV; it += gridDim.x) {
    if (it < NMOD) {
      int l = it / 96, rem = it - l * 96, cc = rem >> 3, ks = rem & 7;
      for (int i = tid; i < 9 * 128; i += NTHR) {
        int r = i >> 7, k = i & 127;
        float v = r < 8 ? p.c[r * DM + ks * 128 + k] : p.c_ctx[ks * 128 + k];
        sm[i] = siluf(v);
      }
      __syncthreads();
      const int n = cc * 512 + tid;
      const float* w = p.ada_w + ((size_t)l * DM + ks * 128) * 6144 + n;
      float acc[9];
#pragma unroll
      for (int r = 0; r < 9; r++) acc[r] = 0.f;
#pragma unroll 4
      for (int k = 0; k < 128; k++) {
        float wv = w[(size_t)k * 6144];
#pragma unroll
        for (int r = 0; r < 9; r++) acc[r] += sm[r * 128 + k] * wv;
      }
      float* mp = (float*)(p.ws + OFF_MODP) + ((size_t)(l * 8 + ks) * 9) * 6144 + n;
#pragma unroll
      for (int r = 0; r < 9; r++) mp[(size_t)r * 6144] = acc[r];
      __syncthreads();
    } else {
      int ci = it - NMOD;
      int l = ci / 4480, rem = ci - l * 4480;
      u16* wl = (u16*)(p.ws + OFF_W + (size_t)l * SZ_WL);
      if (rem < 832) {
        int nt = rem >> 4, kt = rem & 15;
        conv_tile(p.w_in + (size_t)l * DM * INW, INW, (u16*)((char*)wl + OW_IN), 1024, nt * 64, kt * 64, MapId{3312, 0}, sm);
      } else if (rem < 832 + 1024) {
        rem -= 832;
        int nt = rem >> 4, kt = rem & 15;
        conv_tile(p.w_in + (size_t)l * DM * INW, INW, (u16*)((char*)wl + OW_G), 1024, nt * 64, kt * 64, MapId{4096, 3312}, sm);
      } else if (rem < 1856 + 256) {
        rem -= 1856;
        int br = rem >> 6, r2 = rem & 63, nt = r2 >> 2, kt = r2 & 3;
        conv_tile(p.w_branch + ((size_t)(l * 4 + br)) * 256 * DM, DM, (u16*)((char*)wl + OW_B) + (size_t)br * 1024 * 256, 256,
                  nt * 64, kt * 64, MapId{1024, 0}, sm);
      } else if (rem < 2112 + 256) {
        rem -= 2112;
        int nt = rem >> 4, kt = rem & 15;
        conv_tile(p.w_out + (size_t)l * DM * DM, DM, (u16*)((char*)wl + OW_O), 1024, nt * 64, kt * 64, MapId{1024, 0}, sm);
      } else if (rem < 2368 + 1408) {
        rem -= 2368;
        int nt = rem >> 4, kt = rem & 15;
        conv_tile(p.ffn_w1 + (size_t)l * DM * 5632, 5632, (u16*)((char*)wl + OW_1), 1024, nt * 64, kt * 64, MapW1{}, sm);
      } else {
        rem -= 3776;
        int nt = rem / 44, kt = rem - nt * 44;
        conv_tile(p.ffn_w2 + (size_t)l * FH * DM, DM, (u16*)((char*)wl + OW_2), FH, nt * 64, kt * 64, MapId{1024, 0}, sm);
      }
    }
  }
}

__device__ __forceinline__ void phase_init1(const Params& p) {
  const float* mp = (const float*)(p.ws + OFF_MODP);
  float* mo = (float*)(p.ws + OFF_MOD);
  for (int i = blockIdx.x * NTHR + TIDX; i < 2 * 9 * 6144; i += gridDim.x * NTHR) {
    int l = i / (9 * 6144), rem = i - l * 9 * 6144, r = rem / 6144, n = rem - r * 6144;
    float s = p.ada_b[l * 6144 + n];
#pragma unroll
    for (int ks = 0; ks < 8; ks++) s += mp[((size_t)((l * 8 + ks) * 9 + r)) * 6144 + n];
    mo[i] = s;
  }
}

__device__ __forceinline__ void rowpass(const Params& p, int l, int mode) {
  const int lane = TIDX & 63, wv = TIDX >> 6;
  const float* MOD = (const float*)(p.ws + OFF_MOD);
  u16* H = (u16*)(p.ws + OFF_H);
  for (int r = blockIdx.x * 8 + wv; r < NROWS; r += gridDim.x * 8) {
    const int mr = mod_row(r);
    const float* modl = MOD + ((size_t)(l * 9 + mr)) * 6144;
    float xv[16];
    if (mode == 0) {
      const float* xs = xin_row(p, r);
#pragma unroll
      for (int i = 0; i < 4; i++) {
        float4 t = *(const float4*)(xs + i * 256 + lane * 4);
        xv[i * 4 + 0] = t.x; xv[i * 4 + 1] = t.y; xv[i * 4 + 2] = t.z; xv[i * 4 + 3] = t.w;
      }
    } else {
      const u16* src = (const u16*)(p.ws + (mode == 1 ? OFF_BIG : OFF_YS)) + (size_t)r * DM;
      const float* xs = (mode == 1 && l == 0) ? xin_row(p, r) : (const float*)x_row(p, r);
      float ov[16];
      float ss = 0.f;
#pragma unroll
      for (int i = 0; i < 4; i++) {
        uint2 t = *(const uint2*)(src + i * 256 + lane * 4);
        ov[i * 4 + 0] = bf2f((u16)(t.x & 0xffff)); ov[i * 4 + 1] = bf2f((u16)(t.x >> 16));
        ov[i * 4 + 2] = bf2f((u16)(t.y & 0xffff)); ov[i * 4 + 3] = bf2f((u16)(t.y >> 16));
      }
#pragma unroll
      for (int i = 0; i < 16; i++) ss += ov[i] * ov[i];
      ss = wsum(ss);
      const float inv = rsq(ss * (1.f / 1024.f) + 1e-6f);
      const float* ng = p.norm_g + (size_t)(l * 4 + (mode == 1 ? 1 : 3)) * DM;
      const float* gt = modl + (mode == 1 ? 2048 : 5120);
      float* xd = x_row(p, r);
#pragma unroll
      for (int i = 0; i < 4; i++) {
        const int col = i * 256 + lane * 4;
        float4 xo = *(const float4*)(xs + col);
        float4 g4 = *(const float4*)(gt + col);
        float4 n4 = *(const float4*)(ng + col);
        xv[i * 4 + 0] = xo.x + g4.x * (ov[i * 4 + 0] * inv * n4.x);
        xv[i * 4 + 1] = xo.y + g4.y * (ov[i * 4 + 1] * inv * n4.y);
        xv[i * 4 + 2] = xo.z + g4.z * (ov[i * 4 + 2] * inv * n4.z);
        xv[i * 4 + 3] = xo.w + g4.w * (ov[i * 4 + 3] * inv * n4.w);
        *(float4*)(xd + col) = make_float4(xv[i * 4 + 0], xv[i * 4 + 1], xv[i * 4 + 2], xv[i * 4 + 3]);
      }
    }
    int ln = l, ni = 0, sho = 0, sco = 1024;
    if (mode == 1) { ni = 2; sho = 3072; sco = 4096; }
    if (mode == 2) { if (l == 1) continue; ln = l + 1; }
    const float* modn = MOD + ((size_t)(ln * 9 + mr)) * 6144;
    const float* ng2 = p.norm_g + (size_t)(ln * 4 + ni) * DM;
    float ss2 = 0.f;
#pragma unroll
    for (int i = 0; i < 16; i++) ss2 += xv[i] * xv[i];
    ss2 = wsum(ss2);
    const float inv2 = rsq(ss2 * (1.f / 1024.f) + 1e-6f);
#pragma unroll
    for (int i = 0; i < 4; i++) {
      const int col = i * 256 + lane * 4;
      float4 n4 = *(const float4*)(ng2 + col);
      float4 sc = *(const float4*)(modn + sco + col);
      float4 sh = *(const float4*)(modn + sho + col);
      float h0 = xv[i * 4 + 0] * inv2 * n4.x * (1.f + sc.x) + sh.x;
      float h1 = xv[i * 4 + 1] * inv2 * n4.y * (1.f + sc.y) + sh.y;
      float h2 = xv[i * 4 + 2] * inv2 * n4.z * (1.f + sc.z) + sh.z;
      float h3 = xv[i * 4 + 3] * inv2 * n4.w * (1.f + sc.w) + sh.w;
      uint2 o;
      o.x = pack2(h0, h1);
      o.y = pack2(h2, h3);
      *(uint2*)(H + (size_t)r * DM + col) = o;
    }
  }
}

#define LDT 72
namespace pg8 {
#define PG8_LAS __attribute__((address_space(3)))
typedef unsigned short bf16_t;
typedef short bf16x8 __attribute__((ext_vector_type(8)));
typedef float f32x4 __attribute__((ext_vector_type(4)));
typedef unsigned u32x4 __attribute__((ext_vector_type(4)));
constexpr int BM = 256, BK = 64, HALF = 128, HTB = HALF * BK * 2  , STAGE_BYTES = 8 * HTB, NXCD = 8, WGM = 8;

__host__ __device__ __forceinline__ int lds_byte(int r, int c) { const int st = (r >> 4) * 2 + (c >> 5), rr = r & 15, cc = c & 31, ob = rr * 64 + cc * 2; return st * 1024 + (ob ^ (((ob >> 9) & 1) << 5)); }
__host__ __device__ __forceinline__ void stage_rc(int b, int& R, int& C) { const int st = b / 1024, sb = b % 1024, swz = sb ^ (((sb >> 9) & 1) << 5); R = (st >> 1) * 16 + swz / 64; C = (st & 1) * 32 + (swz % 64) / 2; }
__host__ __device__ __forceinline__ int perm32(int rho) { const int n = rho >> 4, i = rho & 15; return 8 * (i >> 2) + 4 * n + (i & 3); }

struct Unit { int pm, pn; };
struct Gemm { const bf16_t* A; const bf16_t* Bt; int M, N, K, lda; };
struct StaticOrder {
    int nM, nN, nwg, G, c;
    __host__ __device__ void init(int M, int N, int G_, int c_) { nM = M / BM; nN = N / BM; nwg = nM * nN; G = G_; c = c_; }
    __host__ __device__ bool next(int i, Unit& u) const {
        const long L = (long)i * G + c; if (L >= nwg) return false;
        int wgid = (int)L; { const int q = nwg / NXCD, r = nwg % NXCD, xcd = wgid % NXCD, off = wgid / NXCD; wgid = (xcd < r ? xcd * (q + 1) : r * (q + 1) + (xcd - r) * q) + off; }
        const int nig = WGM * nN, gid = wgid / nig, fm = gid * WGM, gsz = (nM - fm) < WGM ? (nM - fm) : WGM;
        u.pm = fm + ((wgid % nig) % gsz); u.pn = (wgid % nig) / gsz; return true;
    }
    __device__ __forceinline__ void a_ready(const Unit&) const {}
    __device__ __forceinline__ void done(const Unit&) const {}
};
__device__ __forceinline__ unsigned cvt_pk_bf16(float lo, float hi) { unsigned r; asm volatile("v_cvt_pk_bf16_f32 %0, %1, %2" : "=v"(r) : "v"(lo), "v"(hi)); return r; }
template <class Epi, class Sched, bool STAMP = false>
__device__ __forceinline__ void gemm_phase(PG8_LAS unsigned char* lds, const Gemm g, const Sched& S, const Epi& E, unsigned long long* stamps) {
    const int tid = TIDX, wid = __builtin_amdgcn_readfirstlane(tid >> 6), lane = tid & 63, wr = wid >> 2, wc = wid & 3, fr = lane & 15, fq = lane >> 4;
    const int K = g.K, nt = K / BK;
    int ts_lo = 0, ts_hi = 0, nts = 0; const unsigned long long rt_entry = STAMP ? (unsigned long long)wall_clock64() : 0ull;
#define PG8_STAMP() do { if (STAMP && wid == 0 && nts < 64) { const unsigned long long _c = (unsigned long long)clock64(); \
        ts_lo = (lane == nts) ? (int)(unsigned)_c : ts_lo; ts_hi = (lane == nts) ? (int)(unsigned)(_c >> 32) : ts_hi; ++nts; } } while (0)
    PG8_STAMP();
    unsigned voffA[2], voffB[2];
#pragma unroll
    for (int i = 0; i < 2; ++i) { int R, C; stage_rc(tid * 16 + i * 8192, R, C); const int Rb = Epi::PERM ? ((R & ~31) + perm32(R & 31)) : R;
        voffA[i] = (unsigned)(R * g.lda + C) * 2u; voffB[i] = (unsigned)(Rb * K + C) * 2u; }
    const size_t kstep = (size_t)(BK * 2);
    const size_t hstepB = (size_t)HALF * K * 2, hstepA = (size_t)HALF * g.lda * 2;
    const size_t tstepB = 2 * hstepB, tstepA = 2 * hstepA;
    const unsigned ldsw = (unsigned)wid * 1024u;
    const int aoff = lds_byte(wr * 64 + fr, fq * 8), boff = lds_byte(wc * 32 + fr, fq * 8);
#define PG8_SA(b, h) (((b) * 2 + (h)) * HTB)
#define PG8_SB(b, h) ((4 + (b) * 2 + (h)) * HTB)
#define PG8_STAGE(bufoff, gbase, voff) do { _Pragma("unroll") for (int _i = 0; _i < 2; ++_i) \
        __builtin_amdgcn_global_load_lds((const unsigned*)((const char*)(gbase) + (voff)[_i]), (PG8_LAS unsigned*)(lds + (bufoff) + ldsw + _i * 8192), 16, 0, 0); } while (0)
#define PG8_LDA(dst, b, h) do { _Pragma("unroll") for (int m = 0; m < 4; ++m) _Pragma("unroll") for (int k = 0; k < 2; ++k) dst[m][k] = *(const PG8_LAS bf16x8*)(lds + PG8_SA(b, h) + aoff + m * 2048 + k * 1024); } while (0)
#define PG8_LDB(dst, b, h) do { _Pragma("unroll") for (int n = 0; n < 2; ++n) _Pragma("unroll") for (int k = 0; k < 2; ++k) dst[n][k] = *(const PG8_LAS bf16x8*)(lds + PG8_SB(b, h) + boff + n * 2048 + k * 1024); } while (0)
#define PG8_MMA(ai, bj, At, Bt) do { __builtin_amdgcn_s_setprio(1); _Pragma("unroll") for (int m = 0; m < 4; ++m) _Pragma("unroll") for (int n = 0; n < 2; ++n) _Pragma("unroll") for (int k = 0; k < 2; ++k) \
        acc[ai][bj][m][n] = __builtin_amdgcn_mfma_f32_16x16x32_bf16(Bt[n][k], At[m][k], acc[ai][bj][m][n], 0, 0, 0); __builtin_amdgcn_s_setprio(0); } while (0)
#define PG8_WAIT_V(n) asm volatile("s_waitcnt vmcnt(" #n ")" ::: "memory")
#define PG8_WAIT_L(n) asm volatile("s_waitcnt lgkmcnt(" #n ")" ::: "memory")
#define PG8_BAR __builtin_amdgcn_s_barrier()
#define PG8_SCHED __builtin_amdgcn_sched_barrier(0)
    Unit cur, nxt; int ui = 0;
    if (!S.next(0, cur)) return;
    f32x4 acc[2][2][4][2];
#pragma unroll
    for (int a = 0; a < 2; ++a)
#pragma unroll
        for (int b = 0; b < 2; ++b)
#pragma unroll
            for (int m = 0; m < 4; ++m)
#pragma unroll
                for (int n = 0; n < 2; ++n) acc[a][b][m][n] = (f32x4){0.f, 0.f, 0.f, 0.f};
    bf16x8 At[4][2], B0[2][2], B1[2][2];
    const char* cA = (const char*)g.A + (size_t)cur.pm * tstepA; const char* cB = (const char*)g.Bt + (size_t)cur.pn * tstepB;
    S.a_ready(cur);
    PG8_STAGE(PG8_SB(0, 0), cB, voffB); PG8_STAGE(PG8_SA(0, 0), cA, voffA); PG8_STAGE(PG8_SB(0, 1), cB + hstepB, voffB); PG8_STAGE(PG8_SA(0, 1), cA + hstepA, voffA);
    if (wr == 1) PG8_BAR;
    PG8_WAIT_V(4); PG8_BAR;
    PG8_STAGE(PG8_SB(1, 0), cB + kstep, voffB); PG8_STAGE(PG8_SA(1, 0), cA + kstep, voffA); PG8_STAGE(PG8_SB(1, 1), cB + hstepB + kstep, voffB);
    PG8_WAIT_V(6); PG8_BAR;
    PG8_STAMP();
    for (;;) {
        const bool has_next = S.next(ui + 1, nxt);
        const char* nA = has_next ? (const char*)g.A + (size_t)nxt.pm * tstepA : cA; const char* nB = has_next ? (const char*)g.Bt + (size_t)nxt.pn * tstepB : cB;
        for (int t = 0; t < nt; t += 2) {
            const bool last = (t == nt - 2);
            const char* a1 = cA + (size_t)(t + 1) * kstep;
            const char* a2 = last ? nA : cA + (size_t)(t + 2) * kstep; const char* b2 = last ? nB : cB + (size_t)(t + 2) * kstep;
            const char* a3 = a2 + kstep; const char* b3 = b2 + kstep;
            if (last && has_next) S.a_ready(nxt);
            PG8_LDB(B0, 0, 0); PG8_SCHED; PG8_LDA(At, 0, 0); PG8_STAGE(PG8_SA(1, 1), a1 + hstepA, voffA);
            PG8_WAIT_L(8); PG8_BAR; PG8_WAIT_L(0); PG8_MMA(0, 0, At, B0); PG8_BAR; PG8_SCHED;
            PG8_LDB(B1, 0, 1); PG8_STAGE(PG8_SB(0, 0), b2, voffB);
            PG8_BAR; PG8_WAIT_L(0); PG8_MMA(0, 1, At, B1); PG8_BAR;
            PG8_LDA(At, 0, 1); PG8_STAGE(PG8_SA(0, 0), a2, voffA);
            PG8_BAR; PG8_WAIT_L(0); PG8_MMA(1, 0, At, B0); PG8_BAR; PG8_SCHED;
            PG8_STAGE(PG8_SB(0, 1), b2 + hstepB, voffB);
            PG8_WAIT_V(6); PG8_BAR; PG8_MMA(1, 1, At, B1); PG8_BAR;
            PG8_LDB(B0, 1, 0); PG8_SCHED; PG8_LDA(At, 1, 0); PG8_STAGE(PG8_SA(0, 1), a2 + hstepA, voffA);
            PG8_WAIT_L(8); PG8_BAR; PG8_WAIT_L(0); PG8_MMA(0, 0, At, B0); PG8_BAR; PG8_SCHED;
            PG8_LDB(B1, 1, 1); PG8_STAGE(PG8_SB(1, 0), b3, voffB);
            PG8_BAR; PG8_WAIT_L(0); PG8_MMA(0, 1, At, B1); PG8_BAR;
            PG8_LDA(At, 1, 1); PG8_STAGE(PG8_SA(1, 0), a3, voffA);
            PG8_BAR; PG8_WAIT_L(0); PG8_MMA(1, 0, At, B0); PG8_BAR; PG8_SCHED;
            PG8_STAGE(PG8_SB(1, 1), b3 + hstepB, voffB);
            PG8_WAIT_V(6); PG8_BAR; PG8_MMA(1, 1, At, B1); PG8_BAR;
        }
        PG8_STAMP();
        if constexpr (!Epi::AFTER_DRAIN) { E(acc, cur, wr, wc, fr, fq); S.done(cur); }
        PG8_STAMP();
        if (!has_next) break;
#pragma unroll
        for (int a = 0; a < 2; ++a)
#pragma unroll
            for (int b = 0; b < 2; ++b)
#pragma unroll
                for (int m = 0; m < 4; ++m)
#pragma unroll
                    for (int n = 0; n < 2; ++n) acc[a][b][m][n] = (f32x4){0.f, 0.f, 0.f, 0.f};
        cur = nxt; cA = nA; cB = nB; ++ui;
    }
    PG8_WAIT_V(0);
    if (wr == 0) PG8_BAR;
    PG8_BAR;
    if constexpr (Epi::AFTER_DRAIN) { E.fused(acc, cur, wr, wc, fr, fq, lds, wid, lane); S.done(cur); }
    PG8_STAMP();
    if (STAMP && wid == 0) { stamps[lane] = lane < nts ? (((unsigned long long)(unsigned)ts_hi << 32) | (unsigned)ts_lo) : 0ull;
        if (lane == 62) stamps[62] = rt_entry; if (lane == 63) stamps[63] = (unsigned long long)wall_clock64(); }
#undef PG8_STAMP
#undef PG8_SA
#undef PG8_SB
#undef PG8_STAGE
#undef PG8_LDA
#undef PG8_LDB
#undef PG8_MMA
#undef PG8_WAIT_V
#undef PG8_WAIT_L
#undef PG8_BAR
#undef PG8_SCHED
}
}

struct EpiBf {
  static constexpr bool PERM = true, AFTER_DRAIN = false;
  u16* O; int ldc; const float* bias; int act;
  __device__ __forceinline__ void operator()(const f32x4 (&acc)[2][2][4][2], const pg8::Unit& u, int wr, int wc, int fr, int fq) const {
    const int row0 = u.pm * 256 + wr * 64 + fr, col0 = u.pn * 256 + wc * 32 + 8 * fq;
    f32x4 bv[2][2];
#pragma unroll
    for (int bj = 0; bj < 2; ++bj)
#pragma unroll
      for (int n = 0; n < 2; ++n) bv[bj][n] = bias ? *(const f32x4*)(bias + col0 + bj * 128 + 4 * n) : f32x4{0.f, 0.f, 0.f, 0.f};
#pragma unroll
    for (int ai = 0; ai < 2; ++ai)
#pragma unroll
      for (int m = 0; m < 4; ++m) {
        u16* rowp = O + (size_t)(row0 + ai * 128 + m * 16) * ldc + col0;
#pragma unroll
        for (int bj = 0; bj < 2; ++bj) {
          f32x4 v0 = acc[ai][bj][m][0] + bv[bj][0], v1 = acc[ai][bj][m][1] + bv[bj][1];
          if (act == 1) {
#pragma unroll
            for (int j = 0; j < 4; ++j) { v0[j] = sigm(v0[j]); v1[j] = sigm(v1[j]); }
          }
          uint4 wv;
          wv.x = pack2(v0[0], v0[1]); wv.y = pack2(v0[2], v0[3]); wv.z = pack2(v1[0], v1[1]); wv.w = pack2(v1[2], v1[3]);
          *(uint4*)(rowp + bj * 128) = wv;
        }
      }
  }
};
struct EpiSwiglu {
  static constexpr bool PERM = true, AFTER_DRAIN = false;
  u16* O;
  __device__ __forceinline__ void operator()(const f32x4 (&acc)[2][2][4][2], const pg8::Unit& u, int wr, int wc, int fr, int fq) const {
    const int row0 = u.pm * 256 + wr * 64 + fr, col0 = u.pn * 128 + wc * 16 + 4 * fq;
#pragma unroll
    for (int ai = 0; ai < 2; ++ai)
#pragma unroll
      for (int m = 0; m < 4; ++m) {
        u16* rowp = O + (size_t)(row0 + ai * 128 + m * 16) * FH + col0;
#pragma unroll
        for (int bj = 0; bj < 2; ++bj) {
          const f32x4 g = acc[ai][bj][m][0], up = acc[ai][bj][m][1];
          uint2 wv;
          wv.x = pack2(siluf(g[0]) * up[0], siluf(g[1]) * up[1]);
          wv.y = pack2(siluf(g[2]) * up[2], siluf(g[3]) * up[3]);
          *(uint2*)(rowp + bj * 64) = wv;
        }
      }
  }
};
template <int MI>
__device__ __forceinline__ void gemm_loop(const u16* __restrict__ A, int lda, const u16* __restrict__ Bt, int ldb, int K,
                                          f32x4 (&acc)[MI][4], u16* sA, u16* sB) {
  constexpr int BMT = MI * 64;
  const int tid = TIDX, lane = tid & 63, w = tid >> 6, wm = w >> 1, wn = w & 1, fr = lane & 15, fq = lane >> 4;
  uint4 ra[MI], rb[2];
  const u16* ga = A + (size_t)(tid >> 3) * lda + (tid & 7) * 8;
  const u16* gb = Bt + (size_t)(tid >> 3) * ldb + (tid & 7) * 8;
  const int so = (tid >> 3) * LDT + (tid & 7) * 8;
#pragma unroll
  for (int i = 0; i < MI; i++) ra[i] = *(const uint4*)(ga + (size_t)(i * 64) * lda);
#pragma unroll
  for (int i = 0; i < 2; i++) rb[i] = *(const uint4*)(gb + (size_t)(i * 64) * ldb);
#pragma unroll
  for (int i = 0; i < MI; i++) *(uint4*)(sA + so + i * 64 * LDT) = ra[i];
#pragma unroll
  for (int i = 0; i < 2; i++) *(uint4*)(sB + so + i * 64 * LDT) = rb[i];
  __syncthreads();
  const int nk = K >> 6;
  for (int kt = 0; kt < nk; kt++) {
    const bool more = kt + 1 < nk;
    if (more) {
#pragma unroll
      for (int i = 0; i < MI; i++) ra[i] = *(const uint4*)(ga + (size_t)(i * 64) * lda + (kt + 1) * 64);
#pragma unroll
      for (int i = 0; i < 2; i++) rb[i] = *(const uint4*)(gb + (size_t)(i * 64) * ldb + (kt + 1) * 64);
    }
    const u16* a = sA + (kt & 1) * BMT * LDT + (wm * (MI * 16) + fr) * LDT + fq * 8;
    const u16* b = sB + (kt & 1) * 128 * LDT + (wn * 64 + fr) * LDT + fq * 8;
#pragma unroll
    for (int ks = 0; ks < 2; ks++) {
      bf16x8 af[MI], bfr[4];
#pragma unroll
      for (int i = 0; i < MI; i++) af[i] = *(const bf16x8*)(a + i * 16 * LDT + ks * 32);
#pragma unroll
      for (int j = 0; j < 4; j++) bfr[j] = *(const bf16x8*)(b + j * 16 * LDT + ks * 32);
#pragma unroll
      for (int i = 0; i < MI; i++)
#pragma unroll
        for (int j = 0; j < 4; j++) acc[i][j] = __builtin_amdgcn_mfma_f32_16x16x32_bf16(bfr[j], af[i], acc[i][j], 0, 0, 0);
    }
    if (more) {
      u16* da = sA + ((kt + 1) & 1) * BMT * LDT + so;
      u16* db = sB + ((kt + 1) & 1) * 128 * LDT + so;
#pragma unroll
      for (int i = 0; i < MI; i++) *(uint4*)(da + i * 64 * LDT) = ra[i];
#pragma unroll
      for (int i = 0; i < 2; i++) *(uint4*)(db + i * 64 * LDT) = rb[i];
    }
    __syncthreads();
  }
}

template <int MI>
__device__ __forceinline__ void zero_acc(f32x4 (&acc)[MI][4]) {
#pragma unroll
  for (int i = 0; i < MI; i++)
#pragma unroll
    for (int j = 0; j < 4; j++) acc[i][j] = f32x4{0.f, 0.f, 0.f, 0.f};
}


__device__ __forceinline__ void phase_ypart(const Params& p, int l, int hf, unsigned char* smem) {
  u16* sA = (u16*)smem;
  u16* sB = sA + 2 * 256 * LDT;
  const int lane = TIDX & 63, w = TIDX >> 6, wm = w >> 1, wn = w & 1, fr = lane & 15, fq = lane >> 4;
  const u16* Y = (const u16*)(p.ws + OFF_YS);
  const u16* Wb = (const u16*)(p.ws + OFF_W + (size_t)l * SZ_WL + OW_B);
  const u16* G = (const u16*)(p.ws + OFF_BIG);
  u16* ACC = (u16*)(p.ws + OFF_BIG + 2 * SZ_ACT);
  constexpr int NT = 8;
  const int ntiles = (NROWS / 128) * NT;
  for (int t = blockIdx.x; t < ntiles; t += gridDim.x) {
    const int mt = t / NT, nt = t - mt * NT;
    f32x4 tot[2][4];
    zero_acc<2>(tot);
    const int r0 = mt * 128 + wm * 32 + fr, c0 = nt * 128 + wn * 64 + fq * 4;
#pragma unroll 1
    for (int k = 0; k < 2; k++) {
      const int br = hf * 2 + k;
      f32x4 ay[2][4];
      zero_acc<2>(ay);
      const int ycol = br < 3 ? br * 256 : 1536;
      gemm_loop<2>(Y + (size_t)mt * 128 * YST + ycol, YST, Wb + ((size_t)br * 1024 + nt * 128) * 256, 256, 256, ay, sA, sB);
#pragma unroll
      for (int i = 0; i < 2; i++)
#pragma unroll
        for (int j = 0; j < 4; j++) {
          const uint2 gv = *(const uint2*)(G + (size_t)(r0 + i * 16) * 2048 + k * 1024 + c0 + j * 16);
          tot[i][j][0] += __uint_as_float(gv.x << 16) * ay[i][j][0];
          tot[i][j][1] += __uint_as_float(gv.x & 0xffff0000u) * ay[i][j][1];
          tot[i][j][2] += __uint_as_float(gv.y << 16) * ay[i][j][2];
          tot[i][j][3] += __uint_as_float(gv.y & 0xffff0000u) * ay[i][j][3];
        }
    }
#pragma unroll
    for (int i = 0; i < 2; i++)
#pragma unroll
      for (int j = 0; j < 4; j++) {
        u16* ap = ACC + (size_t)(r0 + i * 16) * DM + c0 + j * 16;
        f32x4 v = tot[i][j];
        if (hf) {
          const uint2 av = *(const uint2*)ap;
          v[0] += __uint_as_float(av.x << 16); v[1] += __uint_as_float(av.x & 0xffff0000u);
          v[2] += __uint_as_float(av.y << 16); v[3] += __uint_as_float(av.y & 0xffff0000u);
        }
        uint2 ov;
        ov.x = pack2(v[0], v[1]); ov.y = pack2(v[2], v[3]);
        *(uint2*)ap = ov;
      }
  }
}

#define S2_BUF 10816
#define S2_D 0
#define S2_U 2048
#define S2_P 4096
#define S2_K 6144
#define S2_DQ 8192
#define S2_V 10240
#define S2_C1 10752
#define S2_C2 10784
#define S2_ST (2 * S2_BUF)
#define S2_YB (S2_ST + 8192)

__device__ __forceinline__ float red16(float x) {
  x += dppf<0xB1>(x);
  x += dppf<0x4E>(x);
  x += dppf<0x141>(x);
  x += dppf<0x140>(x);
  return x;
}
__device__ __forceinline__ void wave_lds_sync() {
  asm volatile("s_waitcnt lgkmcnt(0)" ::: "memory");
  __builtin_amdgcn_wave_barrier();
}

template <int MIX>
__device__ __forceinline__ void scan2_item(const Params& p, int l, int b, int h, int dir, int rq, float* sm) {
  constexpr int EPL = (MIX == 2) ? 2 : 4;
  constexpr int VOFF = (MIX == 2) ? 64 : 128;
  const int tid = TIDX, lane = tid & 63, w = tid >> 6, fr = lane & 15, fq = lane >> 4;
  const bool producer = w >= 4;
  const int pw = w & 3;
  const u16* P = (const u16*)(p.ws + OFF_BIG);
  u16* YS = (u16*)(p.ws + OFF_YS);
  float* BC = (float*)(p.ws + OFF_BC);
  float* ST = sm + S2_ST + pw * 2048;
  float s[EPL];
#pragma unroll
  for (int i = 0; i < EPL; i++) s[i] = 0.f;

  bf16x8 bw2[4], ba2[4];
  float cst[5][4];
  float cw[3][7];
  float muv[4];
  int colv[4];
#pragma unroll
  for (int i = 0; i < 4; i++) { bw2[i] = bf16x8{0, 0, 0, 0, 0, 0, 0, 0}; ba2[i] = bw2[i]; muv[i] = 0.f; colv[i] = 0; }
  if (producer) {
    if (MIX == 0) {
#pragma unroll
      for (int nt = 0; nt < 4; nt++) {
        const int jch = h * 64 + nt * 16 + fr;
#pragma unroll
        for (int jj = 0; jj < 8; jj++) {
          bw2[nt][jj] = (short)f2bf(p.rwkv_w2[((size_t)(l * 2 + dir) * 32 + fq * 8 + jj) * 256 + jch]);
          ba2[nt][jj] = (short)f2bf(p.rwkv_a2[((size_t)(l * 2 + dir) * 32 + fq * 8 + jj) * 256 + jch]);
        }
        cst[0][nt] = p.rwkv_w0[(l * 2 + dir) * 256 + jch];
        cst[1][nt] = p.rwkv_a0[(l * 2 + dir) * 256 + jch];
        cst[2][nt] = p.rwkv_ka[l * 256 + jch];
        cst[3][nt] = p.rwkv_kk[l * 256 + jch];
        cst[4][nt] = p.rwkv_rk[l * 256 + jch];
      }
#pragma unroll
      for (int i = 0; i < 4; i++) {
        const int c = lane + 64 * i;
        colv[i] = i < 3 ? i * 256 + h * 64 + lane : (lane < 32 ? 768 + dir * 32 + lane : 832 + dir * 32 + (lane - 32));
        muv[i] = p.rwkv_mu[l * 960 + colv[i]];
        (void)c;
      }
    } else if (MIX == 1) {
#pragma unroll
      for (int i = 0; i < 3; i++) {
        colv[i] = PB + i * 256 + h * 64 + lane;
#pragma unroll
        for (int tp = 0; tp < 7; tp++) cw[i][tp] = p.gdn_conv[((size_t)l * 7 + tp) * 768 + i * 256 + h * 64 + lane];
      }
    } else {
#pragma unroll
      for (int nt = 0; nt < 2; nt++) {
#pragma unroll
        for (int jj = 0; jj < 8; jj++)
          bw2[nt][jj] = fq < 2 ? (short)f2bf(p.gla_gw2[((size_t)(l * 2 + dir) * 16 + fq * 8 + jj) * 128 + h * 32 + nt * 16 + fr]) : (short)0;
        cst[0][nt] = p.gla_gb[(l * 2 + dir) * 128 + h * 32 + nt * 16 + fr];
      }
      colv[0] = PC + h * 32 + lane;
      if (lane >= 32) colv[0] = PC + 128 + h * 32 + (lane - 32);
      colv[1] = PC + 256 + h * 64 + lane;
      colv[2] = PC + 512 + dir * 16 + (lane & 15);
    }
  }
  __syncthreads();

  for (int c = 0; c <= TPB / 32 + 1; c++) {
    if (producer) {
      if (c >= 2) {
        const int cc = c - 2;
        int seg_row0, t_lo;
        if (cc < 8) { seg_row0 = b * TPB; t_lo = dir == 0 ? cc * 32 : (LC - 32 - cc * 32); }
        else { seg_row0 = b * TPB + LC; t_lo = dir == 0 ? (cc - 8) * 32 : (SEQ - 32 - (cc - 8) * 32); }
        const float* yb = sm + S2_YB + (cc & 1) * 512;
        const int t2 = tid - 256;
#pragma unroll
        for (int i = 0; i < 2; i++) {
          const int idx = t2 + i * 256, tt = idx >> 4, e = idx & 15;
          YS[(size_t)(seg_row0 + t_lo + tt) * YST + dir * 768 + MIX * 256 + h * 64 + rq * 16 + e] = f2bf(yb[idx]);
        }
      }
      if (c < TPB / 32) {
        int seg_row0, seg_len, t_lo;
        if (c < 8) { seg_row0 = b * TPB; seg_len = LC; t_lo = dir == 0 ? c * 32 : (LC - 32 - c * 32); }
        else { seg_row0 = b * TPB + LC; seg_len = SEQ; t_lo = dir == 0 ? (c - 8) * 32 : (SEQ - 32 - (c - 8) * 32); }
        const u16* Pseg = P + (size_t)seg_row0 * PST;
        float* B = sm + (c & 1) * S2_BUF;
        const int t0 = t_lo + pw * 8;
        if (MIX == 0) {
          float raw[10][4];
#pragma unroll
          for (int rr = 0; rr < 10; rr++) {
            const int t = t0 - 1 + rr;
            const float okf = (t >= 0 && t < seg_len) ? 1.f : 0.f;
            const int tc = min(max(t, 0), seg_len - 1);
#pragma unroll
            for (int i = 0; i < 4; i++) raw[rr][i] = bf2f(Pseg[(size_t)tc * PST + PA + colv[i]]) * okf;
          }
#pragma unroll
          for (int j = 0; j < 8; j++)
#pragma unroll
            for (int i = 0; i < 4; i++) {
              float xm = raw[j + 1][i] + (0.5f * (raw[j][i] + raw[j + 2][i]) - raw[j + 1][i]) * muv[i];
              if (i == 3 && lane < 32) xm = tanhf(xm);
              ST[j * 256 + lane + 64 * i] = xm;
            }
        } else if (MIX == 1) {
          float raw[14][3];
#pragma unroll
          for (int rr = 0; rr < 14; rr++) {
            const int t = t0 - 3 + rr;
            const float okf = (t >= 0 && t < seg_len) ? 1.f : 0.f;
            const int tc = min(max(t, 0), seg_len - 1);
#pragma unroll
            for (int i = 0; i < 3; i++) raw[rr][i] = bf2f(Pseg[(size_t)tc * PST + colv[i]]) * okf;
          }
#pragma unroll
          for (int j = 0; j < 8; j++)
#pragma unroll
            for (int i = 0; i < 3; i++) {
              float a = 0.f;
#pragma unroll
              for (int tp = 0; tp < 7; tp++) a += raw[j + tp][i] * cw[i][tp];
              ST[j * 256 + lane + 64 * i] = siluf(a);
            }
          if (lane < 8) {
            const u16* pp = Pseg + (size_t)(t0 + lane) * PST + PB;
            float bx = bf2f(pp[768 + dir * 4 + h]);
            float ax = bf2f(pp[776 + dir * 4 + h]);
            float ld = -__expf(p.gdn_a_log[(l * 2 + dir) * 4 + h]) * softplusf(ax + p.gdn_dt_bias[(l * 2 + dir) * 4 + h]);
            ST[lane * 256 + 192] = sigm(bx);
            ST[lane * 256 + 193] = __expf(ld);
          }
        } else {
          u16 raw[8][3];
#pragma unroll
          for (int j = 0; j < 8; j++) {
            const u16* pp = Pseg + (size_t)(t0 + j) * PST;
#pragma unroll
            for (int i = 0; i < 3; i++) raw[j][i] = pp[colv[i]];
          }
          const float qs = lane < 32 ? 0.17677669529663687f : 1.f;
#pragma unroll
          for (int j = 0; j < 8; j++) {
            ST[j * 256 + lane] = bf2f(raw[j][0]) * qs;
            ST[j * 256 + 64 + lane] = bf2f(raw[j][1]);
            if (lane < 16) ST[j * 256 + 128 + lane] = bf2f(raw[j][2]);
          }
        }
        wave_lds_sync();
        const bool vl = fq < 2;
        if (MIX == 0) {
          bf16x8 aw, aa;
#pragma unroll
          for (int jj = 0; jj < 8; jj++) {
            aw[jj] = fr < 8 ? (short)f2bf(ST[fr * 256 + 192 + fq * 8 + jj]) : (short)0;
            aa[jj] = fr < 8 ? (short)f2bf(ST[fr * 256 + 224 + fq * 8 + jj]) : (short)0;
          }
          f32x4 accw[4], acca[4];
#pragma unroll
          for (int nt = 0; nt < 4; nt++) {
            accw[nt] = __builtin_amdgcn_mfma_f32_16x16x32_bf16(aw, bw2[nt], f32x4{0.f, 0.f, 0.f, 0.f}, 0, 0, 0);
            acca[nt] = __builtin_amdgcn_mfma_f32_16x16x32_bf16(aa, ba2[nt], f32x4{0.f, 0.f, 0.f, 0.f}, 0, 0, 0);
          }
#pragma unroll
          for (int r = 0; r < 4; r++) {
            const int j = (fq & 1) * 4 + r, tt = pw * 8 + j;
            float kkx[4], av[4], kdv[4], rv[4], dec[4];
            float ss = 0.f;
#pragma unroll
            for (int nt = 0; nt < 4; nt++) {
              const int n = nt * 16 + fr;
              rv[nt] = ST[j * 256 + n];
              const float kx = ST[j * 256 + 64 + n];
              dec[nt] = __expf(-0.6065306597126334f * sigm(cst[0][nt] + accw[nt][r]));
              av[nt] = sigm(cst[1][nt] + acca[nt][r]);
              kdv[nt] = kx * (1.f + (av[nt] - 1.f) * cst[2][nt]);
              kkx[nt] = kx * cst[3][nt];
              ss += kkx[nt] * kkx[nt];
            }
            ss = red16(ss);
            const float rs = rsq(ss + 1e-6f);
            float c1 = 0.f, c2 = 0.f, bc = 0.f;
#pragma unroll
            for (int nt = 0; nt < 4; nt++) {
              const int n = nt * 16 + fr;
              const float kk = kkx[nt] * rs;
              if (vl) {
                B[S2_D + tt * 64 + n] = dec[nt];
                B[S2_U + tt * 64 + n] = kk;
                B[S2_P + tt * 64 + n] = -kk * av[nt];
                B[S2_K + tt * 64 + n] = kdv[nt];
                B[S2_DQ + tt * 64 + n] = dec[nt] * rv[nt];
              }
              c1 += -kk * av[nt] * rv[nt];
              c2 += kdv[nt] * rv[nt];
              bc += rv[nt] * kdv[nt] * cst[4][nt];
            }
            c1 = red16(c1); c2 = red16(c2); bc = red16(bc);
            if (vl && fr == 0) {
              B[S2_C1 + tt] = c1;
              B[S2_C2 + tt] = c2;
              if (rq == 0) BC[(size_t)(seg_row0 + t_lo + tt) * 8 + h * 2 + dir] = bc;
            }
          }
        } else if (MIX == 1) {
#pragma unroll
          for (int r = 0; r < 4; r++) {
            const int j = (fq & 1) * 4 + r, tt = pw * 8 + j;
            float qv[4], kv[4];
            float sq = 0.f, sk = 0.f;
#pragma unroll
            for (int nt = 0; nt < 4; nt++) {
              const int n = nt * 16 + fr;
              qv[nt] = ST[j * 256 + n];
              kv[nt] = ST[j * 256 + 64 + n];
              sq += qv[nt] * qv[nt];
              sk += kv[nt] * kv[nt];
            }
            sq = red16(sq); sk = red16(sk);
            const float rq_ = rsq(sq + 1e-6f) * 0.125f, rk_ = rsq(sk + 1e-6f);
            const float beta = ST[j * 256 + 192], alpha = ST[j * 256 + 193];
            float dkq = 0.f;
#pragma unroll
            for (int nt = 0; nt < 4; nt++) {
              const int n = nt * 16 + fr;
              const float qn = qv[nt] * rq_, kn = kv[nt] * rk_;
              if (vl) {
                B[S2_D + tt * 64 + n] = alpha;
                B[S2_U + tt * 64 + n] = kn;
                B[S2_P + tt * 64 + n] = -alpha * beta * kn;
                B[S2_K + tt * 64 + n] = beta * kn;
                B[S2_DQ + tt * 64 + n] = alpha * qn;
              }
              dkq += kn * qn;
            }
            dkq = red16(dkq);
            if (vl && fr == 0) {
              B[S2_C1 + tt] = -alpha * beta * dkq;
              B[S2_C2 + tt] = beta * dkq;
            }
          }
        } else {
          bf16x8 ag;
#pragma unroll
          for (int jj = 0; jj < 8; jj++) ag[jj] = (fr < 8 && fq < 2) ? (short)f2bf(ST[fr * 256 + 128 + fq * 8 + jj]) : (short)0;
          f32x4 accg[2];
#pragma unroll
          for (int nt = 0; nt < 2; nt++) accg[nt] = __builtin_amdgcn_mfma_f32_16x16x32_bf16(ag, bw2[nt], f32x4{0.f, 0.f, 0.f, 0.f}, 0, 0, 0);
#pragma unroll
          for (int r = 0; r < 4; r++) {
            const int j = (fq & 1) * 4 + r, tt = pw * 8 + j;
            float dkq = 0.f;
#pragma unroll
            for (int nt = 0; nt < 2; nt++) {
              const int n = nt * 16 + fr;
              const float lg = cst[0][nt] + accg[nt][r];
              const float ls = fminf(lg, 0.f) - log1pf(__expf(-fabsf(lg)));
              const float alpha = __expf(ls * (1.f / 16.f));
              const float qv = ST[j * 256 + n], kv = ST[j * 256 + 32 + n];
              if (vl) {
                B[S2_D + tt * 64 + n] = alpha;
                B[S2_K + tt * 64 + n] = kv;
                B[S2_DQ + tt * 64 + n] = alpha * qv;
              }
              dkq += kv * qv;
            }
            dkq = red16(dkq);
            if (vl && fr == 0) B[S2_C2 + tt] = dkq;
          }
        }
#pragma unroll
        for (int i = 0; i < 2; i++) {
          const int idx = lane + 64 * i, j = idx >> 4, e = idx & 15;
          B[S2_V + (pw * 8 + j) * 16 + e] = ST[j * 256 + VOFF + rq * 16 + e];
        }
      }
    } else if (c >= 1 && c <= TPB / 32) {
      const float* B = sm + ((c - 1) & 1) * S2_BUF;
      float* yb = sm + S2_YB + ((c - 1) & 1) * 512;
      const int rl = w * 4 + fq;
      const int dtt = dir ? -1 : 1;
      int tt = dir ? 31 : 0;
      float dv[EPL], kv[EPL], qv[EPL], uv[EPL], pv[EPL], vv, c1v, c2v;
      float dn[EPL], kn[EPL], qn[EPL], un[EPL], pn[EPL], vn, c1n, c2n;
#define S2_LOAD(D_, K_, Q_, U_, P_, V_, C1_, C2_, T_)                                   \
  do {                                                                                  \
    const int o_ = (T_) * 64 + fr * EPL;                                                \
    if (EPL == 4) {                                                                     \
      float4 t4 = *(const float4*)(B + S2_D + o_);                                      \
      D_[0] = t4.x; D_[1] = t4.y; D_[2] = t4.z; D_[3] = t4.w;                           \
      t4 = *(const float4*)(B + S2_K + o_);                                             \
      K_[0] = t4.x; K_[1] = t4.y; K_[2] = t4.z; K_[3] = t4.w;                           \
      t4 = *(const float4*)(B + S2_DQ + o_);                                            \
      Q_[0] = t4.x; Q_[1] = t4.y; Q_[2] = t4.z; Q_[3] = t4.w;                           \
      t4 = *(const float4*)(B + S2_U + o_);                                             \
      U_[0] = t4.x; U_[1] = t4.y; U_[2] = t4.z; U_[3] = t4.w;                           \
      t4 = *(const float4*)(B + S2_P + o_);                                             \
      P_[0] = t4.x; P_[1] = t4.y; P_[2] = t4.z; P_[3] = t4.w;                           \
      C1_ = B[S2_C1 + (T_)];                                                            \
    } else {                                                                            \
      float2 t2 = *(const float2*)(B + S2_D + o_);                                      \
      D_[0] = t2.x; D_[1] = t2.y;                                                       \
      t2 = *(const float2*)(B + S2_K + o_);                                             \
      K_[0] = t2.x; K_[1] = t2.y;                                                       \
      t2 = *(const float2*)(B + S2_DQ + o_);                                            \
      Q_[0] = t2.x; Q_[1] = t2.y;                                                       \
      U_[0] = U_[1] = P_[0] = P_[1] = 0.f; C1_ = 0.f;                                   \
    }                                                                                   \
    V_ = B[S2_V + (T_) * 16 + rl];                                                      \
    C2_ = B[S2_C2 + (T_)];                                                              \
  } while (0)
#define S2_STEP(D_, K_, Q_, U_, P_, V_, C1_, C2_, T_)                                   \
  do {                                                                                  \
    float sq = 0.f, sa = 0.f;                                                           \
    _Pragma("unroll") for (int i = 0; i < EPL; i++) sq += s[i] * Q_[i];                 \
    if (MIX != 2) {                                                                     \
      _Pragma("unroll") for (int i = 0; i < EPL; i++) sa += s[i] * U_[i];               \
      sa = red16(sa);                                                                   \
    }                                                                                   \
    sq = red16(sq);                                                                     \
    float y = sq + V_ * C2_;                                                            \
    if (MIX != 2) y += sa * C1_;                                                        \
    _Pragma("unroll") for (int i = 0; i < EPL; i++) {                                   \
      float t = s[i] * D_[i] + V_ * K_[i];                                              \
      if (MIX != 2) t += sa * P_[i];                                                    \
      s[i] = t;                                                                         \
    }                                                                                   \
    yb[(T_) * 16 + rl] = y;                                                             \
  } while (0)
      S2_LOAD(dv, kv, qv, uv, pv, vv, c1v, c2v, tt);
#pragma unroll 1
      for (int st = 0; st < 32; st += 2) {
        const int t1 = tt + dtt;
        S2_LOAD(dn, kn, qn, un, pn, vn, c1n, c2n, t1);
        S2_STEP(dv, kv, qv, uv, pv, vv, c1v, c2v, tt);
        const int t2 = st + 2 < 32 ? t1 + dtt : t1;
        S2_LOAD(dv, kv, qv, uv, pv, vv, c1v, c2v, t2);
        S2_STEP(dn, kn, qn, un, pn, vn, c1n, c2n, t1);
        tt = t2;
      }
#undef S2_LOAD
#undef S2_STEP
    }
    __syncthreads();
  }
}

#define S3_SUB 12800
#define S3_GM 0
#define S3_KVT 9216
#define S3_QB 10240
#define S3_QV 11392
#define S3_VT 11520
#define S3_WC 12544
#define S3_STG (2 * 4 * S3_SUB)
#define S3_STB (S3_STG + 4 * 8192)
#define S3_END (S3_STB + 4 * 2304)

__device__ __forceinline__ float rlane(float x, int l) { return __int_as_float(__builtin_amdgcn_readlane(__float_as_int(x), l)); }
__device__ __forceinline__ float wave_sum(float x) {
  x = red16(x);
  return (rlane(x, 0) + rlane(x, 16)) + (rlane(x, 32) + rlane(x, 48));
}
__device__ __forceinline__ float clampe(float x) { return fminf(fmaxf(x, -80.f), 80.f); }
__device__ __forceinline__ uint4 pack8(const float (&v)[8]) {
  return make_uint4(pack2(v[0], v[1]), pack2(v[2], v[3]), pack2(v[4], v[5]), pack2(v[6], v[7]));
}
__device__ __forceinline__ bf16x8 ld_frag(const void* p) { return *(const bf16x8*)p; }
__device__ __forceinline__ bf16x8 zfrag() { return bf16x8{0, 0, 0, 0, 0, 0, 0, 0}; }

template <int MIX>
__device__ __forceinline__ void scan3_item(const Params& p, int l, int b, int h, int dir, unsigned char* smb) {
  constexpr int VOFF = (MIX == 2) ? 64 : 128;
  constexpr bool DELTA = (MIX != 2);
  const int tid = TIDX, lane = tid & 63, w = tid >> 6, fr = lane & 15, fq = lane >> 4;
  const bool producer = w >= 4;
  const int pw = w & 3;
  const u16* P = (const u16*)(p.ws + OFF_BIG);
  u16* YS = (u16*)(p.ws + OFF_YS);
  float* BC = (float*)(p.ws + OFF_BC);
  float* ST = (float*)(smb + S3_STG + pw * 8192);
  unsigned char* STBY = smb + S3_STG + pw * 8192;
  const f32x4 z4 = f32x4{0.f, 0.f, 0.f, 0.f};
  f32x4 st[4];
#pragma unroll
  for (int i = 0; i < 4; i++) st[i] = z4;

  bf16x8 bw2[4], ba2[4];
  float cw[3][7];
  float muv[4];
  int colv[4];
  float c_w0 = 0.f, c_a0 = 0.f, c_ka = 0.f, c_kk = 0.f, c_rk = 0.f, c_gb = 0.f;
#pragma unroll
  for (int i = 0; i < 4; i++) { bw2[i] = zfrag(); ba2[i] = zfrag(); muv[i] = 0.f; colv[i] = 0; }
  if (producer) {
    if (MIX == 0) {
#pragma unroll
      for (int nt = 0; nt < 4; nt++) {
        const int jch = h * 64 + nt * 16 + fr;
#pragma unroll
        for (int jj = 0; jj < 8; jj++) {
          bw2[nt][jj] = (short)f2bf(p.rwkv_w2[((size_t)(l * 2 + dir) * 32 + fq * 8 + jj) * 256 + jch]);
          ba2[nt][jj] = (short)f2bf(p.rwkv_a2[((size_t)(l * 2 + dir) * 32 + fq * 8 + jj) * 256 + jch]);
        }
      }
      const int jl = h * 64 + lane;
      c_w0 = p.rwkv_w0[(l * 2 + dir) * 256 + jl];
      c_a0 = p.rwkv_a0[(l * 2 + dir) * 256 + jl];
      c_ka = p.rwkv_ka[l * 256 + jl];
      c_kk = p.rwkv_kk[l * 256 + jl];
      c_rk = p.rwkv_rk[l * 256 + jl];
#pragma unroll
      for (int i = 0; i < 4; i++) {
        colv[i] = i < 3 ? i * 256 + h * 64 + lane : (lane < 32 ? 768 + dir * 32 + lane : 832 + dir * 32 + (lane - 32));
        muv[i] = p.rwkv_mu[l * 960 + colv[i]];
      }
    } else if (MIX == 1) {
#pragma unroll
      for (int i = 0; i < 3; i++) {
        colv[i] = PB + i * 256 + h * 64 + lane;
#pragma unroll
        for (int tp = 0; tp < 7; tp++) cw[i][tp] = p.gdn_conv[((size_t)l * 7 + tp) * 768 + i * 256 + h * 64 + lane];
      }
    } else {
#pragma unroll
      for (int nt = 0; nt < 2; nt++) {
#pragma unroll
        for (int jj = 0; jj < 8; jj++)
          bw2[nt][jj] = fq < 2 ? (short)f2bf(p.gla_gw2[((size_t)(l * 2 + dir) * 16 + fq * 8 + jj) * 128 + h * 32 + nt * 16 + fr]) : (short)0;
      }
      c_gb = p.gla_gb[(l * 2 + dir) * 128 + h * 32 + (lane & 31)];
      colv[0] = PC + h * 32 + lane;
      if (lane >= 32) colv[0] = PC + 128 + h * 32 + (lane - 32);
      colv[1] = PC + 256 + h * 64 + lane;
      colv[2] = PC + 512 + dir * 16 + (lane & 15);
    }
  }
  __syncthreads();

  for (int c = 0; c <= TPB / 32; c++) {
    if (producer) {
      if (c < TPB / 32) {
        int seg_row0, seg_len, t_lo;
        if (c < 8) { seg_row0 = b * TPB; seg_len = LC; t_lo = dir == 0 ? c * 32 : (LC - 32 - c * 32); }
        else { seg_row0 = b * TPB + LC; seg_len = SEQ; t_lo = dir == 0 ? (c - 8) * 32 : (SEQ - 32 - (c - 8) * 32); }
        const u16* Pseg = P + (size_t)seg_row0 * PST;
        unsigned char* SB = smb + ((c & 1) * 4 + pw) * S3_SUB;
        const int t0 = t_lo + pw * 8;
        if (MIX == 0) {
          float raw[10][4];
#pragma unroll
          for (int rr = 0; rr < 10; rr++) {
            const int t = t0 - 1 + rr;
            const float okf = (t >= 0 && t < seg_len) ? 1.f : 0.f;
            const int tc = min(max(t, 0), seg_len - 1);
#pragma unroll
            for (int i = 0; i < 4; i++) raw[rr][i] = bf2f(Pseg[(size_t)tc * PST + PA + colv[i]]) * okf;
          }
#pragma unroll
          for (int j = 0; j < 8; j++)
#pragma unroll
            for (int i = 0; i < 4; i++) {
              float xm = raw[j + 1][i] + (0.5f * (raw[j][i] + raw[j + 2][i]) - raw[j + 1][i]) * muv[i];
              if (i == 3 && lane < 32) xm = tanhf(xm);
              ST[j * 256 + lane + 64 * i] = xm;
            }
        } else if (MIX == 1) {
          float raw[14][3];
#pragma unroll
          for (int rr = 0; rr < 14; rr++) {
            const int t = t0 - 3 + rr;
            const float okf = (t >= 0 && t < seg_len) ? 1.f : 0.f;
            const int tc = min(max(t, 0), seg_len - 1);
#pragma unroll
            for (int i = 0; i < 3; i++) raw[rr][i] = bf2f(Pseg[(size_t)tc * PST + colv[i]]) * okf;
          }
#pragma unroll
          for (int j = 0; j < 8; j++)
#pragma unroll
            for (int i = 0; i < 3; i++) {
              float a = 0.f;
#pragma unroll
              for (int tp = 0; tp < 7; tp++) a += raw[j + tp][i] * cw[i][tp];
              ST[j * 256 + lane + 64 * i] = siluf(a);
            }
          if (lane < 8) {
            const u16* pp = Pseg + (size_t)(t0 + lane) * PST + PB;
            float bx = bf2f(pp[768 + dir * 4 + h]);
            float ax = bf2f(pp[776 + dir * 4 + h]);
            float ld = -__expf(p.gdn_a_log[(l * 2 + dir) * 4 + h]) * softplusf(ax + p.gdn_dt_bias[(l * 2 + dir) * 4 + h]);
            ST[lane * 256 + 192] = sigm(bx);
            ST[lane * 256 + 193] = ld;
          }
        } else {
          u16 raw[8][3];
#pragma unroll
          for (int j = 0; j < 8; j++) {
            const u16* pp = Pseg + (size_t)(t0 + j) * PST;
#pragma unroll
            for (int i = 0; i < 3; i++) raw[j][i] = pp[colv[i]];
          }
          const float qs = lane < 32 ? 0.17677669529663687f : 1.f;
#pragma unroll
          for (int j = 0; j < 8; j++) {
            ST[j * 256 + lane] = bf2f(raw[j][0]) * qs;
            ST[j * 256 + 64 + lane] = bf2f(raw[j][1]);
            if (lane < 16) ST[j * 256 + 128 + lane] = bf2f(raw[j][2]);
          }
        }
        wave_lds_sync();
        {
          float vv[8];
#pragma unroll
          for (int i = 0; i < 8; i++) vv[i] = ST[(dir ? 7 - i : i) * 256 + VOFF + lane];
          *(uint4*)(SB + S3_VT + lane * 16) = pack8(vv);
        }
        if (MIX == 0) {
          bf16x8 aw, aa;
#pragma unroll
          for (int jj = 0; jj < 8; jj++) {
            aw[jj] = fr < 8 ? (short)f2bf(ST[fr * 256 + 192 + fq * 8 + jj]) : (short)0;
            aa[jj] = fr < 8 ? (short)f2bf(ST[fr * 256 + 224 + fq * 8 + jj]) : (short)0;
          }
          f32x4 accw[4], acca[4];
#pragma unroll
          for (int nt = 0; nt < 4; nt++) {
            accw[nt] = __builtin_amdgcn_mfma_f32_16x16x32_bf16(aw, bw2[nt], z4, 0, 0, 0);
            acca[nt] = __builtin_amdgcn_mfma_f32_16x16x32_bf16(aa, ba2[nt], z4, 0, 0, 0);
          }
          wave_lds_sync();
          if (fq < 2) {
#pragma unroll
            for (int nt = 0; nt < 4; nt++)
#pragma unroll
              for (int r = 0; r < 4; r++) {
                ST[(fq * 4 + r) * 256 + 128 + nt * 16 + fr] = accw[nt][r];
                ST[(fq * 4 + r) * 256 + 192 + nt * 16 + fr] = acca[nt][r];
              }
          }
          wave_lds_sync();
        } else if (MIX == 2) {
          bf16x8 ag;
#pragma unroll
          for (int jj = 0; jj < 8; jj++) ag[jj] = (fr < 8 && fq < 2) ? (short)f2bf(ST[fr * 256 + 128 + fq * 8 + jj]) : (short)0;
          f32x4 accg[2];
#pragma unroll
          for (int nt = 0; nt < 2; nt++) accg[nt] = __builtin_amdgcn_mfma_f32_16x16x32_bf16(ag, bw2[nt], z4, 0, 0, 0);
          if (fq < 2) {
#pragma unroll
            for (int nt = 0; nt < 2; nt++)
#pragma unroll
              for (int r = 0; r < 4; r++) ST[(fq * 4 + r) * 256 + 192 + nt * 16 + fr] = accg[nt][r];
          }
          wave_lds_sync();
        }
        float logd[8], kap[8], bb[8], kp[8], qq[8];
#pragma unroll
        for (int i = 0; i < 8; i++) {
          const int j = dir ? 7 - i : i;
          const float* row = ST + j * 256;
          if (MIX == 0) {
            const float r_ = row[lane], k_ = row[64 + lane];
            const float sg = sigm(c_w0 + row[128 + lane]);
            const float a_ = sigm(c_a0 + row[192 + lane]);
            const float kd = k_ * (1.f + (a_ - 1.f) * c_ka);
            const float kkx = k_ * c_kk;
            const float ss = wave_sum(kkx * kkx);
            const float kk = kkx * rsq(ss + 1e-6f);
            const float bc = wave_sum(r_ * kd * c_rk);
            if (lane == 0) BC[(size_t)(seg_row0 + t0 + j) * 8 + h * 2 + dir] = bc;
            logd[i] = -0.6065306597126334f * sg;
            kap[i] = kk; bb[i] = kk * a_; kp[i] = kd; qq[i] = r_;
          } else if (MIX == 1) {
            const float q_ = row[lane], k_ = row[64 + lane];
            const float sq = wave_sum(q_ * q_), sk = wave_sum(k_ * k_);
            const float qn = q_ * rsq(sq + 1e-6f) * 0.125f, kn = k_ * rsq(sk + 1e-6f);
            const float beta = row[192], ld = row[193];
            const float alpha = __expf(ld);
            logd[i] = ld;
            kap[i] = kn; bb[i] = alpha * beta * kn; kp[i] = beta * kn; qq[i] = qn;
          } else {
            const int n = lane & 31;
            const float lg = c_gb + row[192 + n];
            const float ls = fminf(lg, 0.f) - log1pf(__expf(-fabsf(lg)));
            logd[i] = ls * (1.f / 16.f);
            kap[i] = 0.f; bb[i] = 0.f;
            kp[i] = lane < 32 ? row[32 + n] : 0.f;
            qq[i] = lane < 32 ? row[n] : 0.f;
          }
        }
        wave_lds_sync();
        float kt[8], qt[8], bck[8], kck[8];
        {
          float L[8];
          float run = 0.f;
#pragma unroll
          for (int i = 0; i < 8; i++) { run += logd[i]; L[i] = run; }
          const float Lr = L[3], L7 = L[7];
          float prevE = __expf(clampe(-Lr)), prevT = 1.f;
          u16* OPA = (u16*)STBY;
#pragma unroll
          for (int i = 0; i < 8; i++) {
            const float eI = __expf(clampe(L[i] - Lr)), eInv = __expf(clampe(Lr - L[i]));
            const float tI = __expf(L[i]), eEnd = __expf(L7 - L[i]);
            if (DELTA) {
              OPA[0 * 576 + i * 72 + lane] = f2bf(kap[i] * prevE);
              OPA[1 * 576 + i * 72 + lane] = f2bf(bb[i] * eInv);
            }
            OPA[2 * 576 + i * 72 + lane] = f2bf(kp[i] * eInv);
            OPA[3 * 576 + i * 72 + lane] = f2bf(qq[i] * eI);
            kt[i] = kap[i] * prevT; qt[i] = qq[i] * tI;
            bck[i] = bb[i] * eEnd; kck[i] = kp[i] * eEnd;
            prevE = eI; prevT = tI;
          }
          *(float*)(SB + S3_WC + lane * 4) = __expf(L7);
        }
        wave_lds_sync();
        f32x4 accA = z4, accBm = z4, accQb = z4, accQk = z4;
        {
          const u16* OPA = (const u16*)STBY;
          const int ro = (fr & 7) * 72 + fq * 8;
#pragma unroll
          for (int ks = 0; ks < 2; ks++) {
            const bf16x8 fk = ld_frag(OPA + 2 * 576 + ro + ks * 32), fqh = ld_frag(OPA + 3 * 576 + ro + ks * 32);
            accQk = __builtin_amdgcn_mfma_f32_16x16x32_bf16(fqh, fk, accQk, 0, 0, 0);
            if (DELTA) {
              const bf16x8 fka = ld_frag(OPA + 0 * 576 + ro + ks * 32), fb = ld_frag(OPA + 1 * 576 + ro + ks * 32);
              accA = __builtin_amdgcn_mfma_f32_16x16x32_bf16(fka, fb, accA, 0, 0, 0);
              accBm = __builtin_amdgcn_mfma_f32_16x16x32_bf16(fka, fk, accBm, 0, 0, 0);
              accQb = __builtin_amdgcn_mfma_f32_16x16x32_bf16(fqh, fb, accQb, 0, 0, 0);
            }
          }
#pragma unroll
          for (int r = 0; r < 4; r++) {
            const int i = fq * 4 + r;
            const bool ok = fq < 2 && fr < 8;
            if (!(ok && fr < i)) { accA[r] = 0.f; accBm[r] = 0.f; }
            if (!(ok && fr <= i)) { accQb[r] = 0.f; accQk[r] = 0.f; }
          }
        }
        float bmc[8], qkc[8];
#pragma unroll
        for (int m = 0; m < 4; m++) {
          bmc[m] = accBm[m]; qkc[m] = accQk[m];
          bmc[m + 4] = __shfl(accBm[m], (lane & 15) + 16);
          qkc[m + 4] = __shfl(accQk[m], (lane & 15) + 16);
        }
        float kbar[8], qbar[8], Kv[8], TB[8], Qv[8];
        if (DELTA) {
          float t[8];
#pragma unroll
          for (int i = 0; i < 8; i++) {
            float ti = (lane == i) ? 1.f : 0.f;
#pragma unroll
            for (int m = 0; m < i; m++) ti -= rlane(accA[i & 3], (i >> 2) * 16 + m) * t[m];
            t[i] = ti;
          }
#pragma unroll
          for (int i = 0; i < 8; i++) {
            float tb = 0.f, kb = 0.f;
#pragma unroll
            for (int m = 0; m <= i; m++) {
              const float tim = rlane(t[i], m);
              tb += tim * bmc[m];
              kb += tim * kt[m];
            }
            TB[i] = tb; kbar[i] = kb;
            float qv = qkc[i], qb = qt[i];
#pragma unroll
            for (int m = 0; m <= i; m++) {
              const float qbim = rlane(accQb[i & 3], (i >> 2) * 16 + m);
              qv -= qbim * TB[m];
              qb -= qbim * kbar[m];
            }
            Qv[i] = qv; qbar[i] = qb;
          }
#pragma unroll
          for (int j = 0; j < 8; j++) Kv[j] = kck[j];
#pragma unroll
          for (int i = 1; i < 8; i++)
#pragma unroll
            for (int j = 0; j < i; j++) Kv[j] -= rlane(TB[i], j) * bck[i];
        } else {
#pragma unroll
          for (int i = 0; i < 8; i++) { Qv[i] = qkc[i]; qbar[i] = qt[i]; Kv[i] = kck[i]; kbar[i] = 0.f; TB[i] = 0.f; }
        }
        *(uint4*)(SB + S3_KVT + lane * 16) = pack8(Kv);
#pragma unroll
        for (int i = 0; i < 8; i++) ((u16*)(SB + S3_QB))[i * 72 + lane] = f2bf(qbar[i]);
        if (lane < 8) {
#pragma unroll
          for (int i = 0; i < 8; i++) ((u16*)(SB + S3_QV))[i * 8 + lane] = f2bf(Qv[i]);
        }
        if (DELTA) {
          float nk[8];
#pragma unroll
          for (int i = 0; i < 8; i++) nk[i] = -kbar[i];
          *(uint4*)(STBY + 4608 + lane * 16) = pack8(bck);
          *(uint4*)(STBY + 5632 + lane * 16) = pack8(nk);
          wave_lds_sync();
          bf16x8 fa[4], fb[4];
#pragma unroll
          for (int x = 0; x < 4; x++) {
            fa[x] = fq == 0 ? ld_frag(STBY + 5632 + (x * 16 + fr) * 16) : zfrag();
            fb[x] = fq == 0 ? ld_frag(STBY + 4608 + (x * 16 + fr) * 16) : zfrag();
          }
#pragma unroll
          for (int nt = 0; nt < 4; nt++)
#pragma unroll
            for (int mt = 0; mt < 4; mt++) {
              const f32x4 g = __builtin_amdgcn_mfma_f32_16x16x32_bf16(fa[mt], fb[nt], z4, 0, 0, 0);
              uint2 gv;
              gv.x = pack2(g[0], g[1]); gv.y = pack2(g[2], g[3]);
              *(uint2*)(SB + S3_GM + ((nt * 16 + fr) * 72 + mt * 16 + fq * 4) * 2) = gv;
            }
        }
      }
    } else if (c >= 1) {
      const int cc = c - 1;
      int seg_row0, t_lo;
      if (cc < 8) { seg_row0 = b * TPB; t_lo = dir == 0 ? cc * 32 : (LC - 32 - cc * 32); }
      else { seg_row0 = b * TPB + LC; t_lo = dir == 0 ? (cc - 8) * 32 : (SEQ - 32 - (cc - 8) * 32); }
      unsigned char* STB = smb + S3_STB + w * 2304;
#pragma unroll 1
      for (int k = 0; k < 4; k++) {
        const int sc = dir ? 3 - k : k;
        const unsigned char* SB = smb + ((cc & 1) * 4 + sc) * S3_SUB;
#pragma unroll
        for (int nt = 0; nt < 4; nt++) {
          uint2 sv;
          sv.x = pack2(st[nt][0], st[nt][1]); sv.y = pack2(st[nt][2], st[nt][3]);
          *(uint2*)(STB + (fr * 72 + nt * 16 + fq * 4) * 2) = sv;
        }
        wave_lds_sync();
        const bf16x8 bs0 = ld_frag(STB + (fr * 72 + fq * 8) * 2), bs1 = ld_frag(STB + (fr * 72 + 32 + fq * 8) * 2);
        const bf16x8 bv = fq == 0 ? ld_frag(SB + S3_VT + (w * 16 + fr) * 16) : zfrag();
        const bf16x8 aq0 = ld_frag(SB + S3_QB + ((fr & 7) * 72 + fq * 8) * 2), aq1 = ld_frag(SB + S3_QB + ((fr & 7) * 72 + 32 + fq * 8) * 2);
        const bf16x8 aqv = fq == 0 ? ld_frag(SB + S3_QV + (fr & 7) * 16) : zfrag();
        f32x4 accY = __builtin_amdgcn_mfma_f32_16x16x32_bf16(aq0, bs0, z4, 0, 0, 0);
        accY = __builtin_amdgcn_mfma_f32_16x16x32_bf16(aq1, bs1, accY, 0, 0, 0);
        accY = __builtin_amdgcn_mfma_f32_16x16x32_bf16(aqv, bv, accY, 0, 0, 0);
        if (fq < 2) {
#pragma unroll
          for (int r = 0; r < 4; r++) {
            const int i = fq * 4 + r, j = dir ? 7 - i : i;
            YS[(size_t)(seg_row0 + t_lo + sc * 8 + j) * YST + dir * 768 + MIX * 256 + h * 64 + w * 16 + fr] = f2bf(accY[r]);
          }
        }
#pragma unroll
        for (int nt = 0; nt < 4; nt++) {
          f32x4 an = z4;
          if (DELTA) {
            const bf16x8 g0 = ld_frag(SB + S3_GM + ((nt * 16 + fr) * 72 + fq * 8) * 2), g1 = ld_frag(SB + S3_GM + ((nt * 16 + fr) * 72 + 32 + fq * 8) * 2);
            an = __builtin_amdgcn_mfma_f32_16x16x32_bf16(g0, bs0, an, 0, 0, 0);
            an = __builtin_amdgcn_mfma_f32_16x16x32_bf16(g1, bs1, an, 0, 0, 0);
          }
          const bf16x8 akv = fq == 0 ? ld_frag(SB + S3_KVT + (nt * 16 + fr) * 16) : zfrag();
          an = __builtin_amdgcn_mfma_f32_16x16x32_bf16(akv, bv, an, 0, 0, 0);
          const float4 wc = *(const float4*)(SB + S3_WC + (nt * 16 + fq * 4) * 4);
          st[nt][0] = st[nt][0] * wc.x + an[0];
          st[nt][1] = st[nt][1] * wc.y + an[1];
          st[nt][2] = st[nt][2] * wc.z + an[2];
          st[nt][3] = st[nt][3] * wc.w + an[3];
        }
        wave_lds_sync();
      }
    }
    __syncthreads();
  }
}

__device__ __forceinline__ void attn_item(const Params& p, int l, int b, int qb, int hk, bool isctx, unsigned char* smem) {
  u16* KS = (u16*)smem;
  u16* VT = KS + 64 * LDT;
  u16* PL = VT + 64 * LDT;
  float2* ROPE = (float2*)(PL + 8 * 32 * LDT);
  const int tid = TIDX, lane = tid & 63, w = tid >> 6, fr = lane & 15, fq = lane >> 4;
  const u16* P = (const u16*)(p.ws + OFF_BIG);
  u16* Y = (u16*)(p.ws + OFF_YS);
  const int qh = hk * 2 + (w >> 2);
  const int tb = qb * 128 + (w & 3) * 32;
  const int qrow0 = b * TPB + (isctx ? 0 : LC);
  __syncthreads();
  for (int i = tid; i < 1024; i += NTHR) {
    int pos = i >> 4, fi = i & 15;
    float inv = powf(10000.f, -(float)fi / 16.f);
    float sn, cs;
    sincosf((float)pos * inv, &sn, &cs);
    ROPE[i] = make_float2(cs, sn);
  }
  __syncthreads();
  bf16x8 qf[2][2];
#pragma unroll
  for (int mi = 0; mi < 2; mi++)
#pragma unroll
    for (int ks = 0; ks < 2; ks++) {
      const int tq = tb + mi * 16 + fr;
      const u16* qp = P + (size_t)(qrow0 + tq) * PST + PD + qh * 64 + ks * 32;
      uint4 own = *(const uint4*)(qp + fq * 8);
      uint4 par = *(const uint4*)(qp + (fq ^ 2) * 8);
      const unsigned ow[4] = {own.x, own.y, own.z, own.w};
      const unsigned pw[4] = {par.x, par.y, par.z, par.w};
      const int pos = ks == 0 ? (tq >> 6) : (tq & 63);
      bf16x8 f;
#pragma unroll
      for (int jj = 0; jj < 8; jj++) {
        float xo = bf2f((u16)((ow[jj >> 1] >> ((jj & 1) * 16)) & 0xffff));
        float xp = bf2f((u16)((pw[jj >> 1] >> ((jj & 1) * 16)) & 0xffff));
        float v = xo;
        if (!isctx) {
          float2 cs = ROPE[pos * 16 + (fq & 1) * 8 + jj];
          v = fq < 2 ? xo * cs.x - xp * cs.y : xp * cs.y + xo * cs.x;
        }
        f[jj] = (short)f2bf(v * 0.125f);
      }
      qf[mi][ks] = f;
    }
  f32x4 oacc[2][4];
#pragma unroll
  for (int mi = 0; mi < 2; mi++)
#pragma unroll
    for (int nd = 0; nd < 4; nd++) oacc[mi][nd] = f32x4{0.f, 0.f, 0.f, 0.f};
  float mrow[2][4], lrow[2][4];
#pragma unroll
  for (int mi = 0; mi < 2; mi++)
#pragma unroll
    for (int r = 0; r < 4; r++) { mrow[mi][r] = -1e30f; lrow[mi][r] = 0.f; }

  const int q0 = qb * 128;
  const int band_lo = isctx ? 0 : max(0, q0 - 128), band_hi = isctx ? 0 : min(SEQ, q0 + 256);
  const int ntile = 4 + (band_hi - band_lo) / 64;
  u16* pl = PL + w * 32 * LDT;
  for (int tl = 0; tl < ntile; tl++) {
    const bool band = tl >= 4;
    const int k0 = band ? band_lo + (tl - 4) * 64 : tl * 64;
    __syncthreads();
    {
      const int key = tid >> 3, kc = tid & 7;
      const int kpos = k0 + key;
      const u16* kp = P + (size_t)(b * TPB + (band ? LC : 0) + kpos) * PST + PD + 256 + hk * 64;
      uint4 own = *(const uint4*)(kp + kc * 8);
      uint4 vv = *(const uint4*)(kp + 128 + kc * 8);
      uint4 par = *(const uint4*)(kp + (kc ^ 2) * 8);
      if (band) {
        const unsigned ow[4] = {own.x, own.y, own.z, own.w};
        const unsigned pw[4] = {par.x, par.y, par.z, par.w};
        const int pos = kc < 4 ? (kpos >> 6) : (kpos & 63);
        unsigned res[4];
#pragma unroll
        for (int jj = 0; jj < 8; jj += 2) {
          float v2[2];
#pragma unroll
          for (int e = 0; e < 2; e++) {
            float xo = bf2f((u16)((ow[jj >> 1] >> (e * 16)) & 0xffff));
            float xp = bf2f((u16)((pw[jj >> 1] >> (e * 16)) & 0xffff));
            float2 cs = ROPE[pos * 16 + (kc & 1) * 8 + jj + e];
            v2[e] = (kc & 2) == 0 ? xo * cs.x - xp * cs.y : xp * cs.y + xo * cs.x;
          }
          res[jj >> 1] = pack2(v2[0], v2[1]);
        }
        own = make_uint4(res[0], res[1], res[2], res[3]);
      }
      *(uint4*)(KS + key * LDT + kc * 8) = own;
      const unsigned vw[4] = {vv.x, vv.y, vv.z, vv.w};
#pragma unroll
      for (int jj = 0; jj < 8; jj++) VT[(kc * 8 + jj) * LDT + key] = (u16)((vw[jj >> 1] >> ((jj & 1) * 16)) & 0xffff);
    }
    __syncthreads();
    f32x4 sc[2][4];
#pragma unroll
    for (int mi = 0; mi < 2; mi++)
#pragma unroll
      for (int nj = 0; nj < 4; nj++) sc[mi][nj] = f32x4{0.f, 0.f, 0.f, 0.f};
#pragma unroll
    for (int ks = 0; ks < 2; ks++) {
      bf16x8 kf[4];
#pragma unroll
      for (int nj = 0; nj < 4; nj++) kf[nj] = *(const bf16x8*)(KS + (nj * 16 + fr) * LDT + ks * 32 + fq * 8);
#pragma unroll
      for (int mi = 0; mi < 2; mi++)
#pragma unroll
        for (int nj = 0; nj < 4; nj++) sc[mi][nj] = __builtin_amdgcn_mfma_f32_16x16x32_bf16(qf[mi][ks], kf[nj], sc[mi][nj], 0, 0, 0);
    }
#pragma unroll
    for (int mi = 0; mi < 2; mi++)
#pragma unroll
      for (int r = 0; r < 4; r++) {
        const int qpos = tb + mi * 16 + fq * 4 + r;
        float mx = -1e30f;
#pragma unroll
        for (int nj = 0; nj < 4; nj++) {
          float v = sc[mi][nj][r];
          if (band) {
            int d = qpos - (k0 + nj * 16 + fr);
            if (d > 128 || d < -128) v = -1e30f;
          }
          sc[mi][nj][r] = v;
          mx = fmaxf(mx, v);
        }
        mx = fmaxf(mx, __shfl_xor(mx, 1));
        mx = fmaxf(mx, __shfl_xor(mx, 2));
        mx = fmaxf(mx, __shfl_xor(mx, 4));
        mx = fmaxf(mx, __shfl_xor(mx, 8));
        const float mnew = fmaxf(mrow[mi][r], mx);
        const float alpha = __expf(mrow[mi][r] - mnew);
        mrow[mi][r] = mnew;
        float ls = 0.f;
#pragma unroll
        for (int nj = 0; nj < 4; nj++) {
          float pe = __expf(sc[mi][nj][r] - mnew);
          ls += pe;
          pl[(mi * 16 + fq * 4 + r) * LDT + nj * 16 + fr] = f2bf(pe);
        }
        lrow[mi][r] = lrow[mi][r] * alpha + ls;
#pragma unroll
        for (int nd = 0; nd < 4; nd++) oacc[mi][nd][r] *= alpha;
      }
    asm volatile("s_waitcnt lgkmcnt(0)" ::: "memory");
    __builtin_amdgcn_wave_barrier();
#pragma unroll
    for (int ks = 0; ks < 2; ks++) {
      bf16x8 pf[2], vf[4];
#pragma unroll
      for (int mi = 0; mi < 2; mi++) pf[mi] = *(const bf16x8*)(pl + (mi * 16 + fr) * LDT + ks * 32 + fq * 8);
#pragma unroll
      for (int nd = 0; nd < 4; nd++) vf[nd] = *(const bf16x8*)(VT + (nd * 16 + fr) * LDT + ks * 32 + fq * 8);
#pragma unroll
      for (int mi = 0; mi < 2; mi++)
#pragma unroll
        for (int nd = 0; nd < 4; nd++) oacc[mi][nd] = __builtin_amdgcn_mfma_f32_16x16x32_bf16(pf[mi], vf[nd], oacc[mi][nd], 0, 0, 0);
    }
    asm volatile("s_waitcnt lgkmcnt(0)" ::: "memory");
    __builtin_amdgcn_wave_barrier();
  }
  const float sink = p.attn_sink[l * 4 + qh];
#pragma unroll
  for (int mi = 0; mi < 2; mi++)
#pragma unroll
    for (int r = 0; r < 4; r++) {
      float ls = lrow[mi][r];
      ls += __shfl_xor(ls, 1);
      ls += __shfl_xor(ls, 2);
      ls += __shfl_xor(ls, 4);
      ls += __shfl_xor(ls, 8);
      ls += __expf(sink - mrow[mi][r]);
      const float inv = 1.f / ls;
      const int tq = tb + mi * 16 + fq * 4 + r;
#pragma unroll
      for (int nd = 0; nd < 4; nd++) Y[(size_t)(qrow0 + tq) * YST + 1536 + qh * 64 + nd * 16 + fr] = f2bf(oacc[mi][nd][r] * inv);
    }
}

#ifndef SCAN3_MASK
#define SCAN3_MASK 7
#endif
__device__ __forceinline__ void phase_mix(const Params& p, int l, unsigned char* smem) {
  float* sm = (float*)smem;
  const int G = gridDim.x;
  for (int it = blockIdx.x; it < 192; it += G) {
    const int mix = it >> 6, rem = it & 63, b = rem >> 3, h = (rem >> 1) & 3, dir = rem & 1;
    if (mix == 0 && (SCAN3_MASK & 1)) scan3_item<0>(p, l, b, h, dir, smem);
    else if (mix == 1 && (SCAN3_MASK & 2)) scan3_item<1>(p, l, b, h, dir, smem);
    else if (mix == 2 && (SCAN3_MASK & 4)) scan3_item<2>(p, l, b, h, dir, smem);
  }
  if (SCAN3_MASK != 7) {
    for (int it = blockIdx.x; it < 768; it += G) {
      const int mix = it >> 8, rem = it & 255, b = rem >> 5, h = (rem >> 3) & 3, dir = (rem >> 2) & 1, rq = rem & 3;
      if (mix == 0 && !(SCAN3_MASK & 1)) scan2_item<0>(p, l, b, h, dir, rq, sm);
      else if (mix == 1 && !(SCAN3_MASK & 2)) scan2_item<1>(p, l, b, h, dir, rq, sm);
      else if (mix == 2 && !(SCAN3_MASK & 4)) scan2_item<2>(p, l, b, h, dir, rq, sm);
    }
  }
  __syncthreads();
  const int first = G > 192 ? 192 : 0;
  const int bi = ((int)blockIdx.x - first + G) % G;
  for (int it = bi; it < 544; it += G) {
    if (it < 512) {
      int b = it >> 6, qb = (it >> 1) & 31, hk = it & 1;
      attn_item(p, l, b, qb, hk, false, smem);
    } else {
      int r = it - 512, b = r >> 2, qb = (r >> 1) & 1, hk = r & 1;
      attn_item(p, l, b, qb, hk, true, smem);
    }
  }
}

__device__ __forceinline__ void phase_post(const Params& p, int l) {
  const int lane = TIDX & 63, wv = TIDX >> 6;
  const u16* P = (const u16*)(p.ws + OFF_BIG);
  u16* YS = (u16*)(p.ws + OFF_YS);
  const float* BC = (const float*)(p.ws + OFF_BC);
  const int j0 = lane * 4, hd = lane >> 4;
  for (int r = blockIdx.x * 8 + wv; r < NROWS; r += gridDim.x * 8) {
    const int b = r / TPB, t = r - b * TPB;
    const bool has_prev = (t != 0) && (t != LC), has_next = (t != LC - 1) && (t != TPB - 1);
    const int poff = has_prev ? PST : 0, noff = has_next ? PST : 0;
    const float pmul = has_prev ? 1.f : 0.f, nmul = has_next ? 1.f : 0.f;
    u16* ys = YS + (size_t)r * YST;
    const u16* pr = P + (size_t)r * PST;
    float y[3][4];
#pragma unroll
    for (int m = 0; m < 3; m++) {
      uint2 a = *(const uint2*)(ys + m * 256 + j0);
      uint2 c = *(const uint2*)(ys + 768 + m * 256 + j0);
      y[m][0] = bf2f((u16)(a.x & 0xffff)) + bf2f((u16)(c.x & 0xffff));
      y[m][1] = bf2f((u16)(a.x >> 16)) + bf2f((u16)(c.x >> 16));
      y[m][2] = bf2f((u16)(a.y & 0xffff)) + bf2f((u16)(c.y & 0xffff));
      y[m][3] = bf2f((u16)(a.y >> 16)) + bf2f((u16)(c.y >> 16));
    }
    float o[3][4];
    {
      float sum = y[0][0] + y[0][1] + y[0][2] + y[0][3];
      sum += __shfl_xor(sum, 1); sum += __shfl_xor(sum, 2); sum += __shfl_xor(sum, 4); sum += __shfl_xor(sum, 8);
      const float mean = sum * (1.f / 64.f);
      float vs = 0.f;
#pragma unroll
      for (int i = 0; i < 4; i++) { float d = y[0][i] - mean; vs += d * d; }
      vs += __shfl_xor(vs, 1); vs += __shfl_xor(vs, 2); vs += __shfl_xor(vs, 4); vs += __shfl_xor(vs, 8);
      const float rstd = rsq(vs * (1.f / 64.f) + 64e-5f);
      float sg;
      {
        const int col = 896 + lane;
        float pv = bf2f(pr[PA + col]);
        float pp = bf2f(pr[PA + col - poff]) * pmul;
        float pn = bf2f(pr[PA + col + noff]) * nmul;
        float xm = pv + (0.5f * (pp + pn) - pv) * p.rwkv_mu[l * 960 + col];
        sg = sigm(xm);
      }
      float gate[4] = {0.f, 0.f, 0.f, 0.f};
      const float* g2 = p.rwkv_g2 + (size_t)l * 64 * 256 + j0;
#pragma unroll 8
      for (int i = 0; i < 64; i++) {
        float si = __shfl(sg, i);
        float4 gw = *(const float4*)(g2 + i * 256);
        gate[0] += si * gw.x; gate[1] += si * gw.y; gate[2] += si * gw.z; gate[3] += si * gw.w;
      }
      const float bcs = BC[(size_t)r * 8 + hd * 2] + BC[(size_t)r * 8 + hd * 2 + 1];
#pragma unroll
      for (int i = 0; i < 4; i++) {
        const int col = 512 + j0 + i;
        float pv = bf2f(pr[PA + col]);
        float pp = bf2f(pr[PA + col - poff]) * pmul;
        float pn = bf2f(pr[PA + col + noff]) * nmul;
        float v = pv + (0.5f * (pp + pn) - pv) * p.rwkv_mu[l * 960 + col];
        float yn = (y[0][i] - mean) * rstd * p.rwkv_ln_g[l * 256 + j0 + i] + p.rwkv_ln_b[l * 256 + j0 + i];
        o[0][i] = (yn + bcs * v) * gate[i];
      }
    }
#pragma unroll
    for (int m = 1; m < 3; m++) {
      float ss = y[m][0] * y[m][0] + y[m][1] * y[m][1] + y[m][2] * y[m][2] + y[m][3] * y[m][3];
      ss += __shfl_xor(ss, 1); ss += __shfl_xor(ss, 2); ss += __shfl_xor(ss, 4); ss += __shfl_xor(ss, 8);
      const float inv = rsq(ss * (1.f / 64.f) + 1e-6f);
      const float* ng = (m == 1 ? p.gdn_norm_g : p.gla_norm_g) + l * 64 + (lane & 15) * 4;
      const u16* gp = pr + (m == 1 ? PB + 784 : PC + 544) + j0;
#pragma unroll
      for (int i = 0; i < 4; i++) o[m][i] = y[m][i] * inv * ng[i] * siluf(bf2f(gp[i]));
    }
    asm volatile("s_waitcnt vmcnt(0)" ::: "memory");
    __builtin_amdgcn_wave_barrier();
#pragma unroll
    for (int m = 0; m < 3; m++) {
      uint2 ov;
      ov.x = pack2(o[m][0], o[m][1]);
      ov.y = pack2(o[m][2], o[m][3]);
      *(uint2*)(ys + m * 256 + j0) = ov;
    }
  }
}

#if defined(SKIPS)
#define EN(k) (SKIPS != (k))
#elif !defined(ONLYS)
#define EN(k) 1
#else
#define EN(k) (ONLYS == (k))
#endif
__device__ __forceinline__ void run_phase(const Params& p, int ph, unsigned char* smem) {
  if (ph == 0) { if (EN(10)) phase_init0(p, (float*)smem); return; }
  if (ph == 1) { if (EN(11)) phase_init1(p); return; }
  int l = 0, s = 12;
  if (ph >= 3) { l = (ph - 3) / 12; s = (ph - 3) - l * 12; }
  unsigned char* wl = p.ws + OFF_W + (size_t)l * SZ_WL;
  PG8_LAS unsigned char* lds = (PG8_LAS unsigned char*)smem;
  pg8::StaticOrder S;
  if (s == 12 || s == 8 || s == 11) {
    if (EN(5)) rowpass(p, l, s == 12 ? 0 : (s == 8 ? 1 : 2));
  } else if (s == 0 || s == 3 || s == 5 || s == 7 || s == 10) {
    pg8::Gemm g; EpiBf E;
    g.M = NROWS; E.bias = nullptr; E.act = 0;
    if (s == 0) { g.A = (const u16*)(p.ws + OFF_H); g.lda = DM; g.Bt = (const u16*)(wl + OW_IN); g.K = DM; g.N = PST; E.O = (u16*)(p.ws + OFF_BIG); E.ldc = PST; }
    else if (s == 3 || s == 5) {
      const int hf = s == 5;
      g.A = (const u16*)(p.ws + OFF_H); g.lda = DM; g.Bt = (const u16*)(wl + OW_G) + (size_t)hf * 2048 * DM; g.K = DM; g.N = 2048;
      E.O = (u16*)(p.ws + OFF_BIG); E.ldc = 2048; E.bias = p.gate_b + (size_t)l * 4096 + hf * 2048; E.act = 1;
    }
    else if (s == 7) { g.A = (const u16*)(p.ws + OFF_BIG + 2 * SZ_ACT); g.lda = DM; g.Bt = (const u16*)(wl + OW_O); g.K = DM; g.N = DM; E.O = (u16*)(p.ws + OFF_BIG); E.ldc = DM; }
    else { g.A = (const u16*)(p.ws + OFF_BIG); g.lda = FH; g.Bt = (const u16*)(wl + OW_2); g.K = FH; g.N = DM; E.O = (u16*)(p.ws + OFF_YS); E.ldc = DM; }
    S.init(g.M, g.N, gridDim.x, blockIdx.x);
    if (EN(0)) pg8::gemm_phase<EpiBf, pg8::StaticOrder, false>(lds, g, S, E, nullptr);
  } else if (s == 4 || s == 6) {
    if (EN(3)) phase_ypart(p, l, s == 6, smem);
  } else if (s == 1) {
    if (EN(1)) phase_mix(p, l, smem);
  } else if (s == 2) {
    if (EN(2)) phase_post(p, l);
  } else {
    pg8::Gemm g; EpiSwiglu E;
    g.M = NROWS; g.N = 2 * FH; g.K = DM; g.lda = DM; g.A = (const u16*)(p.ws + OFF_H); g.Bt = (const u16*)(wl + OW_1);
    E.O = (u16*)(p.ws + OFF_BIG);
    S.init(g.M, g.N, gridDim.x, blockIdx.x);
    if (EN(6)) pg8::gemm_phase<EpiSwiglu, pg8::StaticOrder, false>(lds, g, S, E, nullptr);
  }
}

__global__ void __launch_bounds__(NTHR) hybrid_flow_mega(Params p, int ph0, int ph1) {
  __shared__ __attribute__((aligned(16))) unsigned char smem[147456];
  cg::grid_group grid = cg::this_grid();
  for (int ph = ph0; ph < ph1; ph++) {
    run_phase(p, ph, smem);
#ifdef DUPMASK
    {
      int sidx = ph >= 3 ? (ph - 3) % 12 : 12 + ph;
      if ((DUPMASK >> sidx) & 1) { __syncthreads(); run_phase(p, ph, smem); }
    }
#endif
    if (ph + 1 < ph1) grid.sync();
  }
}

extern "C" void kernel_launch(void* const* d_in, const int* in_sizes, int n_in, void* d_out, int out_size, void* d_ws,
                              size_t ws_size, hipStream_t stream) {
  Params p{};
  const float** pp = (const float**)&p;
  for (int i = 0; i < 32; i++) pp[i] = (const float*)d_in[i];
  p.out = (float*)d_out;
  p.ws = (unsigned char*)d_ws;
  static int grid_blocks = 0;
  if (!grid_blocks) {
    int dev = 0, cus = 0, per_cu = 0;
    hipGetDevice(&dev);
    hipDeviceGetAttribute(&cus, hipDeviceAttributeMultiprocessorCount, dev);
    hipOccupancyMaxActiveBlocksPerMultiprocessor(&per_cu, hybrid_flow_mega, NTHR, 0);
    if (per_cu < 1) per_cu = 1;
    grid_blocks = cus * per_cu;
  }
#ifdef MULTI_LAUNCH
  for (int ph = 0; ph < NPHASE; ph++) {
    hipLaunchKernelGGL(hybrid_flow_mega, dim3(grid_blocks), dim3(NTHR), 0, stream, p, ph, ph + 1);
  }
#else
  int ph0 = 0, ph1 = NPHASE;
  void* args[] = {&p, &ph0, &ph1};
  hipError_t e = hipLaunchCooperativeKernel((void*)hybrid_flow_mega, dim3(grid_blocks), dim3(NTHR), args, 0, stream);
  if (e != hipSuccess) fprintf(stderr, "cooperative launch failed: %s (grid %d)\n", hipGetErrorString(e), grid_blocks);
#endif
}
```

```cpp
#include <hip/hip_runtime.h>
#include <hip/hip_cooperative_groups.h>
#include <cstdio>
namespace cg = cooperative_groups;

typedef unsigned short u16;
using bf16x8 = __attribute__((ext_vector_type(8))) short;
using f32x4 = __attribute__((ext_vector_type(4))) float;

#define DM 1024
#define NBATCH 8
#define SEQ 4096
#define LC 256
#define TPB 4352
#define NROWS 34816
#define PST 3328
#define YST 1792
#define FH 2816
#define INW 7408
#define NTHR 512
#define PA 0
#define PB 960
#define PC 2000
#define PD 2800
#define NPHASE 27
#define SCAN3_MASK 7

struct Params {
  const float *x, *c, *ctx, *c_ctx, *ada_w, *ada_b, *norm_g, *w_in, *gate_b, *w_branch, *w_out,
      *rwkv_mu, *rwkv_w0, *rwkv_w2, *rwkv_a0, *rwkv_a2, *rwkv_g2, *rwkv_kk, *rwkv_ka, *rwkv_rk, *rwkv_ln_g,
      *rwkv_ln_b, *gdn_conv, *gdn_a_log, *gdn_dt_bias, *gdn_norm_g, *gla_gw2, *gla_gb, *gla_norm_g, *attn_sink,
      *ffn_w1, *ffn_w2;
  float* out;
  unsigned char* ws;
};

constexpr size_t SZ_WL = 36700160;
constexpr size_t OW_IN = 0;
constexpr size_t OW_G = OW_IN + (size_t)PST * 1024 * 2;
constexpr size_t OW_B = OW_G + (size_t)4096 * 1024 * 2;
constexpr size_t OW_O = OW_B + (size_t)4 * 1024 * 256 * 2;
constexpr size_t OW_1 = OW_O + (size_t)1024 * 1024 * 2;
constexpr size_t OW_2 = OW_1 + (size_t)5632 * 1024 * 2;
static_assert(OW_2 + (size_t)1024 * FH * 2 == SZ_WL, "weights size");
constexpr size_t SZ_ACT = (size_t)NROWS * DM * 2;
constexpr size_t OFF_W = 0;
constexpr size_t OFF_XC = OFF_W + 2 * SZ_WL;
constexpr size_t OFF_MODP = OFF_XC + (size_t)NBATCH * LC * DM * 4;
constexpr size_t OFF_MOD = OFF_MODP + (size_t)2 * 8 * 9 * 6144 * 4;
constexpr size_t OFF_BC = OFF_MOD + (size_t)2 * 9 * 6144 * 4;
constexpr size_t OFF_H = OFF_BC + (size_t)NROWS * 8 * 4;
constexpr size_t OFF_YS = OFF_H + SZ_ACT;
constexpr size_t OFF_BIG = OFF_YS + (size_t)NROWS * YST * 2;
constexpr size_t OFF_CTR = OFF_BIG + (size_t)NROWS * PST * 2;
constexpr size_t WS_END = OFF_CTR + 256;
static_assert(WS_END <= (size_t)536870912, "ws too large");

__device__ __forceinline__ int launder_tid() { int t = threadIdx.x; asm volatile("" : "+v"(t)); return t; }
#define TIDX (launder_tid())
typedef float f32x2_t __attribute__((ext_vector_type(2)));
typedef __bf16 bf16x2_t __attribute__((ext_vector_type(2)));
__device__ __forceinline__ unsigned pack2(float a, float b) {
  const f32x2_t v = {a, b};
  const bf16x2_t r = __builtin_convertvector(v, bf16x2_t);
  return __builtin_bit_cast(unsigned, r);
}
__device__ __forceinline__ u16 f2bf(float f) { return (u16)(pack2(f, 0.f) & 0xffffu); }
__device__ __forceinline__ float bf2f(u16 h) { return __uint_as_float(((unsigned)h) << 16); }
__device__ __forceinline__ float sigm(float x) { return __builtin_amdgcn_rcpf(1.f + __expf(-x)); }
__device__ __forceinline__ float siluf(float x) { return x * __builtin_amdgcn_rcpf(1.f + __expf(-x)); }
__device__ __forceinline__ float rsq(float x) { return __builtin_amdgcn_rsqf(x); }
__device__ __forceinline__ float softplusf(float x) { return fmaxf(x, 0.f) + log1pf(__expf(-fabsf(x))); }
__device__ __forceinline__ float wsum(float v) {
#pragma unroll
  for (int o = 32; o > 0; o >>= 1) v += __shfl_xor(v, o);
  return v;
}
template <int CTRL>
__device__ __forceinline__ float dppf(float x) {
  return __int_as_float(__builtin_amdgcn_update_dpp(__float_as_int(x), __float_as_int(x), CTRL, 0xf, 0xf, false));
}
__device__ __forceinline__ float red8(float x) {
  x += dppf<0xB1>(x);
  x += dppf<0x4E>(x);
  x += dppf<0x141>(x);
  return x;
}
__device__ __forceinline__ const float* xin_row(const Params& p, int r) {
  int b = r / TPB, t = r - b * TPB;
  return t < LC ? p.ctx + ((size_t)(b * LC + t)) * DM : p.x + ((size_t)(b * SEQ + t - LC)) * DM;
}
__device__ __forceinline__ float* x_row(const Params& p, int r) {
  int b = r / TPB, t = r - b * TPB;
  return t < LC ? (float*)(p.ws + OFF_XC) + ((size_t)(b * LC + t)) * DM : p.out + ((size_t)(b * SEQ + t - LC)) * DM;
}
__device__ __forceinline__ int mod_row(int r) {
  int b = r / TPB, t = r - b * TPB;
  return t < LC ? 8 : b;
}

struct MapId { int lim, off; __device__ int operator()(int n) const { return n < lim ? n + off : -1; } };
struct MapW1 { __device__ int operator()(int n) const { int q = n >> 3, s = n & 7; return s < 4 ? q * 4 + s : FH + q * 4 + (s - 4); } };

template <class Map>
__device__ __forceinline__ void conv_tile(const float* __restrict__ src, int ld, u16* __restrict__ dst, int K, int n0,
                                          int k0, Map map, float* tile) {
  const int tid = TIDX;
  const int nn = tid & 63, kr = tid >> 6;
  const int sc = map(n0 + nn);
#pragma unroll
  for (int ps = 0; ps < 8; ps++) {
    int kk = ps * 8 + kr;
    float v = sc >= 0 ? src[(size_t)(k0 + kk) * ld + sc] : 0.f;
    tile[kk * 65 + nn] = v;
  }
  __syncthreads();
  const int n2 = tid >> 3, kc = tid & 7;
  uint4 o;
  o.x = pack2(tile[(kc * 8 + 0) * 65 + n2], tile[(kc * 8 + 1) * 65 + n2]);
  o.y = pack2(tile[(kc * 8 + 2) * 65 + n2], tile[(kc * 8 + 3) * 65 + n2]);
  o.z = pack2(tile[(kc * 8 + 4) * 65 + n2], tile[(kc * 8 + 5) * 65 + n2]);
  o.w = pack2(tile[(kc * 8 + 6) * 65 + n2], tile[(kc * 8 + 7) * 65 + n2]);
  *(uint4*)(dst + (size_t)(n0 + n2) * K + k0 + kc * 8) = o;
  __syncthreads();
}

__device__ __forceinline__ void phase_init0(const Params& p, float* sm) {
  const int tid = TIDX;
  if (blockIdx.x == 0 && tid < 64) ((unsigned*)(p.ws + OFF_CTR))[tid] = 0u;
  constexpr int NMOD = 192, NCONV = 4480 * 2;
  for (int it = blockIdx.x; it < NMOD + NCONV; it += gridDim.x) {
    if (it < NMOD) {
      int l = it / 96, rem = it - l * 96, cc = rem >> 3, ks = rem & 7;
      for (int i = tid; i < 9 * 128; i += NTHR) {
        int r = i >> 7, k = i & 127;
        float v = r < 8 ? p.c[r * DM + ks * 128 + k] : p.c_ctx[ks * 128 + k];
        sm[i] = siluf(v);
      }
      __syncthreads();
      const int n = cc * 512 + tid;
      const float* w = p.ada_w + ((size_t)l * DM + ks * 128) * 6144 + n;
      float acc[9];
#pragma unroll
      for (int r = 0; r < 9; r++) acc[r] = 0.f;
#pragma unroll 4
      for (int k = 0; k < 128; k++) {
        float wv = w[(size_t)k * 6144];
#pragma unroll
        for (int r = 0; r < 9; r++) acc[r] += sm[r * 128 + k] * wv;
      }
      float* mp = (float*)(p.ws + OFF_MODP) + ((size_t)(l * 8 + ks) * 9) * 6144 + n;
#pragma unroll
      for (int r = 0; r < 9; r++) mp[(size_t)r * 6144] = acc[r];
      __syncthreads();
    } else {
      int ci = it - NMOD;
      int l = ci / 4480, rem = ci - l * 4480;
      u16* wl = (u16*)(p.ws + OFF_W + (size_t)l * SZ_WL);
      if (rem < 832) {
        int nt = rem >> 4, kt = rem & 15;
        conv_tile(p.w_in + (size_t)l * DM * INW, INW, (u16*)((char*)wl + OW_IN), 1024, nt * 64, kt * 64, MapId{3312, 0}, sm);
      } else if (rem < 832 + 1024) {
        rem -= 832;
        int nt = rem >> 4, kt = rem & 15;
        conv_tile(p.w_in + (size_t)l * DM * INW, INW, (u16*)((char*)wl + OW_G), 1024, nt * 64, kt * 64, MapId{4096, 3312}, sm);
      } else if (rem < 1856 + 256) {
        rem -= 1856;
        int br = rem >> 6, r2 = rem & 63, nt = r2 >> 2, kt = r2 & 3;
        conv_tile(p.w_branch + ((size_t)(l * 4 + br)) * 256 * DM, DM, (u16*)((char*)wl + OW_B) + (size_t)br * 1024 * 256, 256,
                  nt * 64, kt * 64, MapId{1024, 0}, sm);
      } else if (rem < 2112 + 256) {
        rem -= 2112;
        int nt = rem >> 4, kt = rem & 15;
        conv_tile(p.w_out + (size_t)l * DM * DM, DM, (u16*)((char*)wl + OW_O), 1024, nt * 64, kt * 64, MapId{1024, 0}, sm);
      } else if (rem < 2368 + 1408) {
        rem -= 2368;
        int nt = rem >> 4, kt = rem & 15;
        conv_tile(p.ffn_w1 + (size_t)l * DM * 5632, 5632, (u16*)((char*)wl + OW_1), 1024, nt * 64, kt * 64, MapW1{}, sm);
      } else {
        rem -= 3776;
        int nt = rem / 44, kt = rem - nt * 44;
        conv_tile(p.ffn_w2 + (size_t)l * FH * DM, DM, (u16*)((char*)wl + OW_2), FH, nt * 64, kt * 64, MapId{1024, 0}, sm);
      }
    }
  }
}

__device__ __forceinline__ void phase_init1(const Params& p) {
  const float* mp = (const float*)(p.ws + OFF_MODP);
  float* mo = (float*)(p.ws + OFF_MOD);
  for (int i = blockIdx.x * NTHR + TIDX; i < 2 * 9 * 6144; i += gridDim.x * NTHR) {
    int l = i / (9 * 6144), rem = i - l * 9 * 6144, r = rem / 6144, n = rem - r * 6144;
    float s = p.ada_b[l * 6144 + n];
#pragma unroll
    for (int ks = 0; ks < 8; ks++) s += mp[((size_t)((l * 8 + ks) * 9 + r)) * 6144 + n];
    mo[i] = s;
  }
}

__device__ __forceinline__ void rowpass(const Params& p, int l, int mode) {
  const int lane = TIDX & 63, wv = TIDX >> 6;
  const float* MOD = (const float*)(p.ws + OFF_MOD);
  u16* H = (u16*)(p.ws + OFF_H);
  const bool do_norm = !(mode == 2 && l == 1);
  const int ln = (mode == 2) ? (l == 1 ? l : l + 1) : l;
  const int ni = (mode == 1) ? 2 : 0, sho = (mode == 1) ? 3072 : 0, sco = (mode == 1) ? 4096 : 1024;
  for (int r = blockIdx.x * 8 + wv; r < NROWS; r += gridDim.x * 8) {
    const int mr = mod_row(r);
    const float* modl = MOD + ((size_t)(l * 9 + mr)) * 6144;
    const float* modn = MOD + ((size_t)(ln * 9 + mr)) * 6144;
    const float* ng2 = p.norm_g + (size_t)(ln * 4 + ni) * DM;
    const float* xs = (mode == 0 || (mode == 1 && l == 0)) ? xin_row(p, r) : (const float*)x_row(p, r);
    float4 xo[4], n2[4], sc4[4], sh4[4];
#pragma unroll
    for (int i = 0; i < 4; i++) {
      const int col = i * 256 + lane * 4;
      xo[i] = *(const float4*)(xs + col);
      n2[i] = *(const float4*)(ng2 + col);
      sc4[i] = *(const float4*)(modn + sco + col);
      sh4[i] = *(const float4*)(modn + sho + col);
    }
    float xv[16];
    if (mode == 0) {
#pragma unroll
      for (int i = 0; i < 4; i++) { xv[i * 4 + 0] = xo[i].x; xv[i * 4 + 1] = xo[i].y; xv[i * 4 + 2] = xo[i].z; xv[i * 4 + 3] = xo[i].w; }
    } else {
      const u16* src = (const u16*)(p.ws + (mode == 1 ? OFF_BIG : OFF_YS)) + (size_t)r * DM;
      const float* ng = p.norm_g + (size_t)(l * 4 + (mode == 1 ? 1 : 3)) * DM;
      const float* gt = modl + (mode == 1 ? 2048 : 5120);
      uint2 sv[4];
      float4 g4[4], n4[4];
#pragma unroll
      for (int i = 0; i < 4; i++) {
        const int col = i * 256 + lane * 4;
        sv[i] = *(const uint2*)(src + col);
        g4[i] = *(const float4*)(gt + col);
        n4[i] = *(const float4*)(ng + col);
      }
      float ov[16];
      float ss = 0.f;
#pragma unroll
      for (int i = 0; i < 4; i++) {
        ov[i * 4 + 0] = __uint_as_float(sv[i].x << 16); ov[i * 4 + 1] = __uint_as_float(sv[i].x & 0xffff0000u);
        ov[i * 4 + 2] = __uint_as_float(sv[i].y << 16); ov[i * 4 + 3] = __uint_as_float(sv[i].y & 0xffff0000u);
      }
#pragma unroll
      for (int i = 0; i < 16; i++) ss += ov[i] * ov[i];
      ss = wsum(ss);
      const float inv = rsq(ss * (1.f / 1024.f) + 1e-6f);
      float* xd = x_row(p, r);
#pragma unroll
      for (int i = 0; i < 4; i++) {
        xv[i * 4 + 0] = xo[i].x + g4[i].x * (ov[i * 4 + 0] * inv * n4[i].x);
        xv[i * 4 + 1] = xo[i].y + g4[i].y * (ov[i * 4 + 1] * inv * n4[i].y);
        xv[i * 4 + 2] = xo[i].z + g4[i].z * (ov[i * 4 + 2] * inv * n4[i].z);
        xv[i * 4 + 3] = xo[i].w + g4[i].w * (ov[i * 4 + 3] * inv * n4[i].w);
      }
#pragma unroll
      for (int i = 0; i < 4; i++)
        *(float4*)(xd + i * 256 + lane * 4) = make_float4(xv[i * 4 + 0], xv[i * 4 + 1], xv[i * 4 + 2], xv[i * 4 + 3]);
    }
    if (!do_norm) continue;
    float ss2 = 0.f;
#pragma unroll
    for (int i = 0; i < 16; i++) ss2 += xv[i] * xv[i];
    ss2 = wsum(ss2);
    const float inv2 = rsq(ss2 * (1.f / 1024.f) + 1e-6f);
#pragma unroll
    for (int i = 0; i < 4; i++) {
      const int col = i * 256 + lane * 4;
      float h0 = xv[i * 4 + 0] * inv2 * n2[i].x * (1.f + sc4[i].x) + sh4[i].x;
      float h1 = xv[i * 4 + 1] * inv2 * n2[i].y * (1.f + sc4[i].y) + sh4[i].y;
      float h2 = xv[i * 4 + 2] * inv2 * n2[i].z * (1.f + sc4[i].z) + sh4[i].z;
      float h3 = xv[i * 4 + 3] * inv2 * n2[i].w * (1.f + sc4[i].w) + sh4[i].w;
      uint2 o;
      o.x = pack2(h0, h1);
      o.y = pack2(h2, h3);
      *(uint2*)(H + (size_t)r * DM + col) = o;
    }
  }
}

#define LDT 72
namespace pg8 {
#define PG8_LAS __attribute__((address_space(3)))
typedef unsigned short bf16_t;
typedef short bf16x8 __attribute__((ext_vector_type(8)));
typedef float f32x4 __attribute__((ext_vector_type(4)));
typedef unsigned u32x4 __attribute__((ext_vector_type(4)));
constexpr int BM = 256, BK = 64, HALF = 128, HTB = HALF * BK * 2  , STAGE_BYTES = 8 * HTB, NXCD = 8, WGM = 8;

__host__ __device__ __forceinline__ int lds_byte(int r, int c) { const int st = (r >> 4) * 2 + (c >> 5), rr = r & 15, cc = c & 31, ob = rr * 64 + cc * 2; return st * 1024 + (ob ^ (((ob >> 9) & 1) << 5)); }
__host__ __device__ __forceinline__ void stage_rc(int b, int& R, int& C) { const int st = b / 1024, sb = b % 1024, swz = sb ^ (((sb >> 9) & 1) << 5); R = (st >> 1) * 16 + swz / 64; C = (st & 1) * 32 + (swz % 64) / 2; }
__host__ __device__ __forceinline__ int perm32(int rho) { const int n = rho >> 4, i = rho & 15; return 8 * (i >> 2) + 4 * n + (i & 3); }

struct Unit { int pm, pn; };
struct Gemm { const bf16_t* A; const bf16_t* Bt; int M, N, K, lda; };
struct StaticOrder {
    int nM, nN, nwg, G, c;
    __host__ __device__ void init(int M, int N, int G_, int c_) { nM = M / BM; nN = N / BM; nwg = nM * nN; G = G_; c = c_; }
    __host__ __device__ bool next(int i, Unit& u) const {
        const long L = (long)i * G + c; if (L >= nwg) return false;
        int wgid = (int)L; { const int q = nwg / NXCD, r = nwg % NXCD, xcd = wgid % NXCD, off = wgid / NXCD; wgid = (xcd < r ? xcd * (q + 1) : r * (q + 1) + (xcd - r) * q) + off; }
        const int nig = WGM * nN, gid = wgid / nig, fm = gid * WGM, gsz = (nM - fm) < WGM ? (nM - fm) : WGM;
        u.pm = fm + ((wgid % nig) % gsz); u.pn = (wgid % nig) / gsz; return true;
    }
    __device__ __forceinline__ void a_ready(const Unit&) const {}
    __device__ __forceinline__ void done(const Unit&) const {}
};
__device__ __forceinline__ unsigned cvt_pk_bf16(float lo, float hi) { unsigned r; asm volatile("v_cvt_pk_bf16_f32 %0, %1, %2" : "=v"(r) : "v"(lo), "v"(hi)); return r; }
template <class Epi, class Sched, bool STAMP = false>
__device__ __forceinline__ void gemm_phase(PG8_LAS unsigned char* lds, const Gemm g, const Sched& S, const Epi& E, unsigned long long* stamps) {
    const int tid = TIDX, wid = __builtin_amdgcn_readfirstlane(tid >> 6), lane = tid & 63, wr = wid >> 2, wc = wid & 3, fr = lane & 15, fq = lane >> 4;
    const int K = g.K, nt = K / BK;
    int ts_lo = 0, ts_hi = 0, nts = 0; const unsigned long long rt_entry = STAMP ? (unsigned long long)wall_clock64() : 0ull;
#define PG8_STAMP() do { if (STAMP && wid == 0 && nts < 64) { const unsigned long long _c = (unsigned long long)clock64(); \
        ts_lo = (lane == nts) ? (int)(unsigned)_c : ts_lo; ts_hi = (lane == nts) ? (int)(unsigned)(_c >> 32) : ts_hi; ++nts; } } while (0)
    PG8_STAMP();
    unsigned voffA[2], voffB[2];
#pragma unroll
    for (int i = 0; i < 2; ++i) { int R, C; stage_rc(tid * 16 + i * 8192, R, C); const int Rb = Epi::PERM ? ((R & ~31) + perm32(R & 31)) : R;
        voffA[i] = (unsigned)(R * g.lda + C) * 2u; voffB[i] = (unsigned)(Rb * K + C) * 2u; }
    const size_t kstep = (size_t)(BK * 2);
    const size_t hstepB = (size_t)HALF * K * 2, hstepA = (size_t)HALF * g.lda * 2;
    const size_t tstepB = 2 * hstepB, tstepA = 2 * hstepA;
    const unsigned ldsw = (unsigned)wid * 1024u;
    const int aoff = lds_byte(wr * 64 + fr, fq * 8), boff = lds_byte(wc * 32 + fr, fq * 8);
#define PG8_SA(b, h) (((b) * 2 + (h)) * HTB)
#define PG8_SB(b, h) ((4 + (b) * 2 + (h)) * HTB)
#define PG8_STAGE(bufoff, gbase, voff) do { _Pragma("unroll") for (int _i = 0; _i < 2; ++_i) \
        __builtin_amdgcn_global_load_lds((const unsigned*)((const char*)(gbase) + (voff)[_i]), (PG8_LAS unsigned*)(lds + (bufoff) + ldsw + _i * 8192), 16, 0, 0); } while (0)
#define PG8_LDA(dst, b, h) do { _Pragma("unroll") for (int m = 0; m < 4; ++m) _Pragma("unroll") for (int k = 0; k < 2; ++k) dst[m][k] = *(const PG8_LAS bf16x8*)(lds + PG8_SA(b, h) + aoff + m * 2048 + k * 1024); } while (0)
#define PG8_LDB(dst, b, h) do { _Pragma("unroll") for (int n = 0; n < 2; ++n) _Pragma("unroll") for (int k = 0; k < 2; ++k) dst[n][k] = *(const PG8_LAS bf16x8*)(lds + PG8_SB(b, h) + boff + n * 2048 + k * 1024); } while (0)
#define PG8_MMA(ai, bj, At, Bt) do { __builtin_amdgcn_s_setprio(1); _Pragma("unroll") for (int m = 0; m < 4; ++m) _Pragma("unroll") for (int n = 0; n < 2; ++n) _Pragma("unroll") for (int k = 0; k < 2; ++k) \
        acc[ai][bj][m][n] = __builtin_amdgcn_mfma_f32_16x16x32_bf16(Bt[n][k], At[m][k], acc[ai][bj][m][n], 0, 0, 0); __builtin_amdgcn_s_setprio(0); } while (0)
#define PG8_WAIT_V(n) asm volatile("s_waitcnt vmcnt(" #n ")" ::: "memory")
#define PG8_WAIT_L(n) asm volatile("s_waitcnt lgkmcnt(" #n ")" ::: "memory")
#define PG8_BAR __builtin_amdgcn_s_barrier()
#define PG8_SCHED __builtin_amdgcn_sched_barrier(0)
    Unit cur, nxt; int ui = 0;
    if (!S.next(0, cur)) return;
    f32x4 acc[2][2][4][2];
#pragma unroll
    for (int a = 0; a < 2; ++a)
#pragma unroll
        for (int b = 0; b < 2; ++b)
#pragma unroll
            for (int m = 0; m < 4; ++m)
#pragma unroll
                for (int n = 0; n < 2; ++n) acc[a][b][m][n] = (f32x4){0.f, 0.f, 0.f, 0.f};
    bf16x8 At[4][2], B0[2][2], B1[2][2];
    const char* cA = (const char*)g.A + (size_t)cur.pm * tstepA; const char* cB = (const char*)g.Bt + (size_t)cur.pn * tstepB;
    S.a_ready(cur);
    PG8_STAGE(PG8_SB(0, 0), cB, voffB); PG8_STAGE(PG8_SA(0, 0), cA, voffA); PG8_STAGE(PG8_SB(0, 1), cB + hstepB, voffB); PG8_STAGE(PG8_SA(0, 1), cA + hstepA, voffA);
    if (wr == 1) PG8_BAR;
    PG8_WAIT_V(4); PG8_BAR;
    PG8_STAGE(PG8_SB(1, 0), cB + kstep, voffB); PG8_STAGE(PG8_SA(1, 0), cA + kstep, voffA); PG8_STAGE(PG8_SB(1, 1), cB + hstepB + kstep, voffB);
    PG8_WAIT_V(6); PG8_BAR;
    PG8_STAMP();
    for (;;) {
        const bool has_next = S.next(ui + 1, nxt);
        const char* nA = has_next ? (const char*)g.A + (size_t)nxt.pm * tstepA : cA; const char* nB = has_next ? (const char*)g.Bt + (size_t)nxt.pn * tstepB : cB;
        for (int t = 0; t < nt; t += 2) {
            const bool last = (t == nt - 2);
            const char* a1 = cA + (size_t)(t + 1) * kstep;
            const char* a2 = last ? nA : cA + (size_t)(t + 2) * kstep; const char* b2 = last ? nB : cB + (size_t)(t + 2) * kstep;
            const char* a3 = a2 + kstep; const char* b3 = b2 + kstep;
            if (last && has_next) S.a_ready(nxt);
            PG8_LDB(B0, 0, 0); PG8_SCHED; PG8_LDA(At, 0, 0); PG8_STAGE(PG8_SA(1, 1), a1 + hstepA, voffA);
            PG8_WAIT_L(8); PG8_BAR; PG8_WAIT_L(0); PG8_MMA(0, 0, At, B0); PG8_BAR; PG8_SCHED;
            PG8_LDB(B1, 0, 1); PG8_STAGE(PG8_SB(0, 0), b2, voffB);
            PG8_BAR; PG8_WAIT_L(0); PG8_MMA(0, 1, At, B1); PG8_BAR;
            PG8_LDA(At, 0, 1); PG8_STAGE(PG8_SA(0, 0), a2, voffA);
            PG8_BAR; PG8_WAIT_L(0); PG8_MMA(1, 0, At, B0); PG8_BAR; PG8_SCHED;
            PG8_STAGE(PG8_SB(0, 1), b2 + hstepB, voffB);
            PG8_WAIT_V(6); PG8_BAR; PG8_MMA(1, 1, At, B1); PG8_BAR;
            PG8_LDB(B0, 1, 0); PG8_SCHED; PG8_LDA(At, 1, 0); PG8_STAGE(PG8_SA(0, 1), a2 + hstepA, voffA);
            PG8_WAIT_L(8); PG8_BAR; PG8_WAIT_L(0); PG8_MMA(0, 0, At, B0); PG8_BAR; PG8_SCHED;
            PG8_LDB(B1, 1, 1); PG8_STAGE(PG8_SB(1, 0), b3, voffB);
            PG8_BAR; PG8_WAIT_L(0); PG8_MMA(0, 1, At, B1); PG8_BAR;
            PG8_LDA(At, 1, 1); PG8_STAGE(PG8_SA(1, 0), a3, voffA);
            PG8_BAR; PG8_WAIT_L(0); PG8_MMA(1, 0, At, B0); PG8_BAR; PG8_SCHED;
            PG8_STAGE(PG8_SB(1, 1), b3 + hstepB, voffB);
            PG8_WAIT_V(6); PG8_BAR; PG8_MMA(1, 1, At, B1); PG8_BAR;
        }
        PG8_STAMP();
        if constexpr (!Epi::AFTER_DRAIN) { E(acc, cur, wr, wc, fr, fq); S.done(cur); }
        PG8_STAMP();
        if (!has_next) break;
#pragma unroll
        for (int a = 0; a < 2; ++a)
#pragma unroll
            for (int b = 0; b < 2; ++b)
#pragma unroll
                for (int m = 0; m < 4; ++m)
#pragma unroll
                    for (int n = 0; n < 2; ++n) acc[a][b][m][n] = (f32x4){0.f, 0.f, 0.f, 0.f};
        cur = nxt; cA = nA; cB = nB; ++ui;
    }
    PG8_WAIT_V(0);
    if (wr == 0) PG8_BAR;
    PG8_BAR;
    if constexpr (Epi::AFTER_DRAIN) { E.fused(acc, cur, wr, wc, fr, fq, lds, wid, lane); S.done(cur); }
    PG8_STAMP();
    if (STAMP && wid == 0) { stamps[lane] = lane < nts ? (((unsigned long long)(unsigned)ts_hi << 32) | (unsigned)ts_lo) : 0ull;
        if (lane == 62) stamps[62] = rt_entry; if (lane == 63) stamps[63] = (unsigned long long)wall_clock64(); }
#undef PG8_STAMP
#undef PG8_SA
#undef PG8_SB
#undef PG8_STAGE
#undef PG8_LDA
#undef PG8_LDB
#undef PG8_MMA
#undef PG8_WAIT_V
#undef PG8_WAIT_L
#undef PG8_BAR
#undef PG8_SCHED
}
}

struct EpiBf {
  static constexpr bool PERM = true, AFTER_DRAIN = false;
  u16* O; int ldc; const float* bias; int act;
  __device__ __forceinline__ void operator()(const f32x4 (&acc)[2][2][4][2], const pg8::Unit& u, int wr, int wc, int fr, int fq) const {
    const int row0 = u.pm * 256 + wr * 64 + fr, col0 = u.pn * 256 + wc * 32 + 8 * fq;
    f32x4 bv[2][2];
#pragma unroll
    for (int bj = 0; bj < 2; ++bj)
#pragma unroll
      for (int n = 0; n < 2; ++n) bv[bj][n] = bias ? *(const f32x4*)(bias + col0 + bj * 128 + 4 * n) : f32x4{0.f, 0.f, 0.f, 0.f};
#pragma unroll
    for (int ai = 0; ai < 2; ++ai)
#pragma unroll
      for (int m = 0; m < 4; ++m) {
        u16* rowp = O + (size_t)(row0 + ai * 128 + m * 16) * ldc + col0;
#pragma unroll
        for (int bj = 0; bj < 2; ++bj) {
          f32x4 v0 = acc[ai][bj][m][0] + bv[bj][0], v1 = acc[ai][bj][m][1] + bv[bj][1];
          if (act == 1) {
#pragma unroll
            for (int j = 0; j < 4; ++j) { v0[j] = sigm(v0[j]); v1[j] = sigm(v1[j]); }
          }
          uint4 wv;
          wv.x = pack2(v0[0], v0[1]); wv.y = pack2(v0[2], v0[3]); wv.z = pack2(v1[0], v1[1]); wv.w = pack2(v1[2], v1[3]);
          *(uint4*)(rowp + bj * 128) = wv;
        }
      }
  }
};
struct EpiSwiglu {
  static constexpr bool PERM = true, AFTER_DRAIN = false;
  u16* O;
  __device__ __forceinline__ void operator()(const f32x4 (&acc)[2][2][4][2], const pg8::Unit& u, int wr, int wc, int fr, int fq) const {
    const int row0 = u.pm * 256 + wr * 64 + fr, col0 = u.pn * 128 + wc * 16 + 4 * fq;
#pragma unroll
    for (int ai = 0; ai < 2; ++ai)
#pragma unroll
      for (int m = 0; m < 4; ++m) {
        u16* rowp = O + (size_t)(row0 + ai * 128 + m * 16) * FH + col0;
#pragma unroll
        for (int bj = 0; bj < 2; ++bj) {
          const f32x4 g = acc[ai][bj][m][0], up = acc[ai][bj][m][1];
          uint2 wv;
          wv.x = pack2(siluf(g[0]) * up[0], siluf(g[1]) * up[1]);
          wv.y = pack2(siluf(g[2]) * up[2], siluf(g[3]) * up[3]);
          *(uint2*)(rowp + bj * 64) = wv;
        }
      }
  }
};
template <int MI>
__device__ __forceinline__ void gemm_loop(const u16* __restrict__ A, int lda, const u16* __restrict__ Bt, int ldb, int K,
                                          f32x4 (&acc)[MI][4], u16* sA, u16* sB) {
  constexpr int BMT = MI * 64;
  const int tid = TIDX, lane = tid & 63, w = tid >> 6, wm = w >> 1, wn = w & 1, fr = lane & 15, fq = lane >> 4;
  uint4 ra[MI], rb[2];
  const u16* ga = A + (size_t)(tid >> 3) * lda + (tid & 7) * 8;
  const u16* gb = Bt + (size_t)(tid >> 3) * ldb + (tid & 7) * 8;
  const int so = (tid >> 3) * LDT + (tid & 7) * 8;
#pragma unroll
  for (int i = 0; i < MI; i++) ra[i] = *(const uint4*)(ga + (size_t)(i * 64) * lda);
#pragma unroll
  for (int i = 0; i < 2; i++) rb[i] = *(const uint4*)(gb + (size_t)(i * 64) * ldb);
#pragma unroll
  for (int i = 0; i < MI; i++) *(uint4*)(sA + so + i * 64 * LDT) = ra[i];
#pragma unroll
  for (int i = 0; i < 2; i++) *(uint4*)(sB + so + i * 64 * LDT) = rb[i];
  __syncthreads();
  const int nk = K >> 6;
  for (int kt = 0; kt < nk; kt++) {
    const bool more = kt + 1 < nk;
    if (more) {
#pragma unroll
      for (int i = 0; i < MI; i++) ra[i] = *(const uint4*)(ga + (size_t)(i * 64) * lda + (kt + 1) * 64);
#pragma unroll
      for (int i = 0; i < 2; i++) rb[i] = *(const uint4*)(gb + (size_t)(i * 64) * ldb + (kt + 1) * 64);
    }
    const u16* a = sA + (kt & 1) * BMT * LDT + (wm * (MI * 16) + fr) * LDT + fq * 8;
    const u16* b = sB + (kt & 1) * 128 * LDT + (wn * 64 + fr) * LDT + fq * 8;
#pragma unroll
    for (int ks = 0; ks < 2; ks++) {
      bf16x8 af[MI], bfr[4];
#pragma unroll
      for (int i = 0; i < MI; i++) af[i] = *(const bf16x8*)(a + i * 16 * LDT + ks * 32);
#pragma unroll
      for (int j = 0; j < 4; j++) bfr[j] = *(const bf16x8*)(b + j * 16 * LDT + ks * 32);
#pragma unroll
      for (int i = 0; i < MI; i++)
#pragma unroll
        for (int j = 0; j < 4; j++) acc[i][j] = __builtin_amdgcn_mfma_f32_16x16x32_bf16(bfr[j], af[i], acc[i][j], 0, 0, 0);
    }
    if (more) {
      u16* da = sA + ((kt + 1) & 1) * BMT * LDT + so;
      u16* db = sB + ((kt + 1) & 1) * 128 * LDT + so;
#pragma unroll
      for (int i = 0; i < MI; i++) *(uint4*)(da + i * 64 * LDT) = ra[i];
#pragma unroll
      for (int i = 0; i < 2; i++) *(uint4*)(db + i * 64 * LDT) = rb[i];
    }
    __syncthreads();
  }
}

template <int MI>
__device__ __forceinline__ void zero_acc(f32x4 (&acc)[MI][4]) {
#pragma unroll
  for (int i = 0; i < MI; i++)
#pragma unroll
    for (int j = 0; j < 4; j++) acc[i][j] = f32x4{0.f, 0.f, 0.f, 0.f};
}


__device__ __forceinline__ void phase_ypart(const Params& p, int l, int hf, unsigned char* smem) {
  u16* sA = (u16*)smem;
  u16* sB = sA + 2 * 256 * LDT;
  const int lane = TIDX & 63, w = TIDX >> 6, wm = w >> 1, wn = w & 1, fr = lane & 15, fq = lane >> 4;
  const u16* Y = (const u16*)(p.ws + OFF_YS);
  const u16* Wb = (const u16*)(p.ws + OFF_W + (size_t)l * SZ_WL + OW_B);
  const u16* G = (const u16*)(p.ws + OFF_BIG);
  u16* ACC = (u16*)(p.ws + OFF_BIG + 2 * SZ_ACT);
  constexpr int NT = 8;
  const int ntiles = (NROWS / 128) * NT;
  for (int t = blockIdx.x; t < ntiles; t += gridDim.x) {
    const int mt = t / NT, nt = t - mt * NT;
    f32x4 tot[2][4];
    zero_acc<2>(tot);
    const int r0 = mt * 128 + wm * 32 + fr, c0 = nt * 128 + wn * 64 + fq * 4;
#pragma unroll 1
    for (int k = 0; k < 2; k++) {
      const int br = hf * 2 + k;
      f32x4 ay[2][4];
      zero_acc<2>(ay);
      const int ycol = br < 3 ? br * 256 : 1536;
      gemm_loop<2>(Y + (size_t)mt * 128 * YST + ycol, YST, Wb + ((size_t)br * 1024 + nt * 128) * 256, 256, 256, ay, sA, sB);
      uint2 gv[2][4];
#pragma unroll
      for (int i = 0; i < 2; i++)
#pragma unroll
        for (int j = 0; j < 4; j++) gv[i][j] = *(const uint2*)(G + (size_t)(r0 + i * 16) * 2048 + k * 1024 + c0 + j * 16);
#pragma unroll
      for (int i = 0; i < 2; i++)
#pragma unroll
        for (int j = 0; j < 4; j++) {
          tot[i][j][0] += __uint_as_float(gv[i][j].x << 16) * ay[i][j][0];
          tot[i][j][1] += __uint_as_float(gv[i][j].x & 0xffff0000u) * ay[i][j][1];
          tot[i][j][2] += __uint_as_float(gv[i][j].y << 16) * ay[i][j][2];
          tot[i][j][3] += __uint_as_float(gv[i][j].y & 0xffff0000u) * ay[i][j][3];
        }
    }
    uint2 av[2][4];
#pragma unroll
    for (int i = 0; i < 2; i++)
#pragma unroll
      for (int j = 0; j < 4; j++) av[i][j] = *(const uint2*)(ACC + (size_t)(r0 + i * 16) * DM + c0 + j * 16);
    const unsigned amask = hf ? 0xffffffffu : 0u;
#pragma unroll
    for (int i = 0; i < 2; i++)
#pragma unroll
      for (int j = 0; j < 4; j++) {
        u16* ap = ACC + (size_t)(r0 + i * 16) * DM + c0 + j * 16;
        f32x4 v = tot[i][j];
        const unsigned ax = av[i][j].x & amask, ay_ = av[i][j].y & amask;
        v[0] += __uint_as_float(ax << 16); v[1] += __uint_as_float(ax & 0xffff0000u);
        v[2] += __uint_as_float(ay_ << 16); v[3] += __uint_as_float(ay_ & 0xffff0000u);
        uint2 ov;
        ov.x = pack2(v[0], v[1]); ov.y = pack2(v[2], v[3]);
        *(uint2*)ap = ov;
      }
  }
}

#define S2_BUF 10816
#define S2_D 0
#define S2_U 2048
#define S2_P 4096
#define S2_K 6144
#define S2_DQ 8192
#define S2_V 10240
#define S2_C1 10752
#define S2_C2 10784
#define S2_ST (2 * S2_BUF)
#define S2_YB (S2_ST + 8192)

__device__ __forceinline__ float red16(float x) {
  x += dppf<0xB1>(x);
  x += dppf<0x4E>(x);
  x += dppf<0x141>(x);
  x += dppf<0x140>(x);
  return x;
}
__device__ __forceinline__ void wave_lds_sync() {
  asm volatile("s_waitcnt lgkmcnt(0)" ::: "memory");
  __builtin_amdgcn_wave_barrier();
}

template <int MIX>
__device__ __forceinline__ void scan2_item(const Params& p, int l, int b, int h, int dir, int rq, float* sm) {
  constexpr int EPL = (MIX == 2) ? 2 : 4;
  constexpr int VOFF = (MIX == 2) ? 64 : 128;
  const int tid = TIDX, lane = tid & 63, w = tid >> 6, fr = lane & 15, fq = lane >> 4;
  const bool producer = w >= 4;
  const int pw = w & 3;
  const u16* P = (const u16*)(p.ws + OFF_BIG);
  u16* YS = (u16*)(p.ws + OFF_YS);
  float* BC = (float*)(p.ws + OFF_BC);
  float* ST = sm + S2_ST + pw * 2048;
  float s[EPL];
#pragma unroll
  for (int i = 0; i < EPL; i++) s[i] = 0.f;

  bf16x8 bw2[4], ba2[4];
  float cst[5][4];
  float cw[3][7];
  float muv[4];
  int colv[4];
#pragma unroll
  for (int i = 0; i < 4; i++) { bw2[i] = bf16x8{0, 0, 0, 0, 0, 0, 0, 0}; ba2[i] = bw2[i]; muv[i] = 0.f; colv[i] = 0; }
  if (producer) {
    if (MIX == 0) {
#pragma unroll
      for (int nt = 0; nt < 4; nt++) {
        const int jch = h * 64 + nt * 16 + fr;
#pragma unroll
        for (int jj = 0; jj < 8; jj++) {
          bw2[nt][jj] = (short)f2bf(p.rwkv_w2[((size_t)(l * 2 + dir) * 32 + fq * 8 + jj) * 256 + jch]);
          ba2[nt][jj] = (short)f2bf(p.rwkv_a2[((size_t)(l * 2 + dir) * 32 + fq * 8 + jj) * 256 + jch]);
        }
        cst[0][nt] = p.rwkv_w0[(l * 2 + dir) * 256 + jch];
        cst[1][nt] = p.rwkv_a0[(l * 2 + dir) * 256 + jch];
        cst[2][nt] = p.rwkv_ka[l * 256 + jch];
        cst[3][nt] = p.rwkv_kk[l * 256 + jch];
        cst[4][nt] = p.rwkv_rk[l * 256 + jch];
      }
#pragma unroll
      for (int i = 0; i < 4; i++) {
        const int c = lane + 64 * i;
        colv[i] = i < 3 ? i * 256 + h * 64 + lane : (lane < 32 ? 768 + dir * 32 + lane : 832 + dir * 32 + (lane - 32));
        muv[i] = p.rwkv_mu[l * 960 + colv[i]];
        (void)c;
      }
    } else if (MIX == 1) {
#pragma unroll
      for (int i = 0; i < 3; i++) {
        colv[i] = PB + i * 256 + h * 64 + lane;
#pragma unroll
        for (int tp = 0; tp < 7; tp++) cw[i][tp] = p.gdn_conv[((size_t)l * 7 + tp) * 768 + i * 256 + h * 64 + lane];
      }
    } else {
#pragma unroll
      for (int nt = 0; nt < 2; nt++) {
#pragma unroll
        for (int jj = 0; jj < 8; jj++)
          bw2[nt][jj] = fq < 2 ? (short)f2bf(p.gla_gw2[((size_t)(l * 2 + dir) * 16 + fq * 8 + jj) * 128 + h * 32 + nt * 16 + fr]) : (short)0;
        cst[0][nt] = p.gla_gb[(l * 2 + dir) * 128 + h * 32 + nt * 16 + fr];
      }
      colv[0] = PC + h * 32 + lane;
      if (lane >= 32) colv[0] = PC + 128 + h * 32 + (lane - 32);
      colv[1] = PC + 256 + h * 64 + lane;
      colv[2] = PC + 512 + dir * 16 + (lane & 15);
    }
  }
  __syncthreads();

  for (int c = 0; c <= TPB / 32 + 1; c++) {
    if (producer) {
      if (c >= 2) {
        const int cc = c - 2;
        int seg_row0, t_lo;
        if (cc < 8) { seg_row0 = b * TPB; t_lo = dir == 0 ? cc * 32 : (LC - 32 - cc * 32); }
        else { seg_row0 = b * TPB + LC; t_lo = dir == 0 ? (cc - 8) * 32 : (SEQ - 32 - (cc - 8) * 32); }
        const float* yb = sm + S2_YB + (cc & 1) * 512;
        const int t2 = tid - 256;
#pragma unroll
        for (int i = 0; i < 2; i++) {
          const int idx = t2 + i * 256, tt = idx >> 4, e = idx & 15;
          YS[(size_t)(seg_row0 + t_lo + tt) * YST + dir * 768 + MIX * 256 + h * 64 + rq * 16 + e] = f2bf(yb[idx]);
        }
      }
      if (c < TPB / 32) {
        int seg_row0, seg_len, t_lo;
        if (c < 8) { seg_row0 = b * TPB; seg_len = LC; t_lo = dir == 0 ? c * 32 : (LC - 32 - c * 32); }
        else { seg_row0 = b * TPB + LC; seg_len = SEQ; t_lo = dir == 0 ? (c - 8) * 32 : (SEQ - 32 - (c - 8) * 32); }
        const u16* Pseg = P + (size_t)seg_row0 * PST;
        float* B = sm + (c & 1) * S2_BUF;
        const int t0 = t_lo + pw * 8;
        if (MIX == 0) {
          float raw[10][4];
#pragma unroll
          for (int rr = 0; rr < 10; rr++) {
            const int t = t0 - 1 + rr;
            const float okf = (t >= 0 && t < seg_len) ? 1.f : 0.f;
            const int tc = min(max(t, 0), seg_len - 1);
#pragma unroll
            for (int i = 0; i < 4; i++) raw[rr][i] = bf2f(Pseg[(size_t)tc * PST + PA + colv[i]]) * okf;
          }
#pragma unroll
          for (int j = 0; j < 8; j++)
#pragma unroll
            for (int i = 0; i < 4; i++) {
              float xm = raw[j + 1][i] + (0.5f * (raw[j][i] + raw[j + 2][i]) - raw[j + 1][i]) * muv[i];
              if (i == 3 && lane < 32) xm = tanhf(xm);
              ST[j * 256 + lane + 64 * i] = xm;
            }
        } else if (MIX == 1) {
          float raw[14][3];
#pragma unroll
          for (int rr = 0; rr < 14; rr++) {
            const int t = t0 - 3 + rr;
            const float okf = (t >= 0 && t < seg_len) ? 1.f : 0.f;
            const int tc = min(max(t, 0), seg_len - 1);
#pragma unroll
            for (int i = 0; i < 3; i++) raw[rr][i] = bf2f(Pseg[(size_t)tc * PST + colv[i]]) * okf;
          }
#pragma unroll
          for (int j = 0; j < 8; j++)
#pragma unroll
            for (int i = 0; i < 3; i++) {
              float a = 0.f;
#pragma unroll
              for (int tp = 0; tp < 7; tp++) a += raw[j + tp][i] * cw[i][tp];
              ST[j * 256 + lane + 64 * i] = siluf(a);
            }
          if (lane < 8) {
            const u16* pp = Pseg + (size_t)(t0 + lane) * PST + PB;
            float bx = bf2f(pp[768 + dir * 4 + h]);
            float ax = bf2f(pp[776 + dir * 4 + h]);
            float ld = -__expf(p.gdn_a_log[(l * 2 + dir) * 4 + h]) * softplusf(ax + p.gdn_dt_bias[(l * 2 + dir) * 4 + h]);
            ST[lane * 256 + 192] = sigm(bx);
            ST[lane * 256 + 193] = __expf(ld);
          }
        } else {
          u16 raw[8][3];
#pragma unroll
          for (int j = 0; j < 8; j++) {
            const u16* pp = Pseg + (size_t)(t0 + j) * PST;
#pragma unroll
            for (int i = 0; i < 3; i++) raw[j][i] = pp[colv[i]];
          }
          const float qs = lane < 32 ? 0.17677669529663687f : 1.f;
#pragma unroll
          for (int j = 0; j < 8; j++) {
            ST[j * 256 + lane] = bf2f(raw[j][0]) * qs;
            ST[j * 256 + 64 + lane] = bf2f(raw[j][1]);
            if (lane < 16) ST[j * 256 + 128 + lane] = bf2f(raw[j][2]);
          }
        }
        wave_lds_sync();
        const bool vl = fq < 2;
        if (MIX == 0) {
          bf16x8 aw, aa;
#pragma unroll
          for (int jj = 0; jj < 8; jj++) {
            aw[jj] = fr < 8 ? (short)f2bf(ST[fr * 256 + 192 + fq * 8 + jj]) : (short)0;
            aa[jj] = fr < 8 ? (short)f2bf(ST[fr * 256 + 224 + fq * 8 + jj]) : (short)0;
          }
          f32x4 accw[4], acca[4];
#pragma unroll
          for (int nt = 0; nt < 4; nt++) {
            accw[nt] = __builtin_amdgcn_mfma_f32_16x16x32_bf16(aw, bw2[nt], f32x4{0.f, 0.f, 0.f, 0.f}, 0, 0, 0);
            acca[nt] = __builtin_amdgcn_mfma_f32_16x16x32_bf16(aa, ba2[nt], f32x4{0.f, 0.f, 0.f, 0.f}, 0, 0, 0);
          }
#pragma unroll
          for (int r = 0; r < 4; r++) {
            const int j = (fq & 1) * 4 + r, tt = pw * 8 + j;
            float kkx[4], av[4], kdv[4], rv[4], dec[4];
            float ss = 0.f;
#pragma unroll
            for (int nt = 0; nt < 4; nt++) {
              const int n = nt * 16 + fr;
              rv[nt] = ST[j * 256 + n];
              const float kx = ST[j * 256 + 64 + n];
              dec[nt] = __expf(-0.6065306597126334f * sigm(cst[0][nt] + accw[nt][r]));
              av[nt] = sigm(cst[1][nt] + acca[nt][r]);
              kdv[nt] = kx * (1.f + (av[nt] - 1.f) * cst[2][nt]);
              kkx[nt] = kx * cst[3][nt];
              ss += kkx[nt] * kkx[nt];
            }
            ss = red16(ss);
            const float rs = rsq(ss + 1e-6f);
            float c1 = 0.f, c2 = 0.f, bc = 0.f;
#pragma unroll
            for (int nt = 0; nt < 4; nt++) {
              const int n = nt * 16 + fr;
              const float kk = kkx[nt] * rs;
              if (vl) {
                B[S2_D + tt * 64 + n] = dec[nt];
                B[S2_U + tt * 64 + n] = kk;
                B[S2_P + tt * 64 + n] = -kk * av[nt];
                B[S2_K + tt * 64 + n] = kdv[nt];
                B[S2_DQ + tt * 64 + n] = dec[nt] * rv[nt];
              }
              c1 += -kk * av[nt] * rv[nt];
              c2 += kdv[nt] * rv[nt];
              bc += rv[nt] * kdv[nt] * cst[4][nt];
            }
            c1 = red16(c1); c2 = red16(c2); bc = red16(bc);
            if (vl && fr == 0) {
              B[S2_C1 + tt] = c1;
              B[S2_C2 + tt] = c2;
              if (rq == 0) BC[(size_t)(seg_row0 + t_lo + tt) * 8 + h * 2 + dir] = bc;
            }
          }
        } else if (MIX == 1) {
#pragma unroll
          for (int r = 0; r < 4; r++) {
            const int j = (fq & 1) * 4 + r, tt = pw * 8 + j;
            float qv[4], kv[4];
            float sq = 0.f, sk = 0.f;
#pragma unroll
            for (int nt = 0; nt < 4; nt++) {
              const int n = nt * 16 + fr;
              qv[nt] = ST[j * 256 + n];
              kv[nt] = ST[j * 256 + 64 + n];
              sq += qv[nt] * qv[nt];
              sk += kv[nt] * kv[nt];
            }
            sq = red16(sq); sk = red16(sk);
            const float rq_ = rsq(sq + 1e-6f) * 0.125f, rk_ = rsq(sk + 1e-6f);
            const float beta = ST[j * 256 + 192], alpha = ST[j * 256 + 193];
            float dkq = 0.f;
#pragma unroll
            for (int nt = 0; nt < 4; nt++) {
              const int n = nt * 16 + fr;
              const float qn = qv[nt] * rq_, kn = kv[nt] * rk_;
              if (vl) {
                B[S2_D + tt * 64 + n] = alpha;
                B[S2_U + tt * 64 + n] = kn;
                B[S2_P + tt * 64 + n] = -alpha * beta * kn;
                B[S2_K + tt * 64 + n] = beta * kn;
                B[S2_DQ + tt * 64 + n] = alpha * qn;
              }
              dkq += kn * qn;
            }
            dkq = red16(dkq);
            if (vl && fr == 0) {
              B[S2_C1 + tt] = -alpha * beta * dkq;
              B[S2_C2 + tt] = beta * dkq;
            }
          }
        } else {
          bf16x8 ag;
#pragma unroll
          for (int jj = 0; jj < 8; jj++) ag[jj] = (fr < 8 && fq < 2) ? (short)f2bf(ST[fr * 256 + 128 + fq * 8 + jj]) : (short)0;
          f32x4 accg[2];
#pragma unroll
          for (int nt = 0; nt < 2; nt++) accg[nt] = __builtin_amdgcn_mfma_f32_16x16x32_bf16(ag, bw2[nt], f32x4{0.f, 0.f, 0.f, 0.f}, 0, 0, 0);
#pragma unroll
          for (int r = 0; r < 4; r++) {
            const int j = (fq & 1) * 4 + r, tt = pw * 8 + j;
            float dkq = 0.f;
#pragma unroll
            for (int nt = 0; nt < 2; nt++) {
              const int n = nt * 16 + fr;
              const float lg = cst[0][nt] + accg[nt][r];
              const float ls = fminf(lg, 0.f) - log1pf(__expf(-fabsf(lg)));
              const float alpha = __expf(ls * (1.f / 16.f));
              const float qv = ST[j * 256 + n], kv = ST[j * 256 + 32 + n];
              if (vl) {
                B[S2_D + tt * 64 + n] = alpha;
                B[S2_K + tt * 64 + n] = kv;
                B[S2_DQ + tt * 64 + n] = alpha * qv;
              }
              dkq += kv * qv;
            }
            dkq = red16(dkq);
            if (vl && fr == 0) B[S2_C2 + tt] = dkq;
          }
        }
#pragma unroll
        for (int i = 0; i < 2; i++) {
          const int idx = lane + 64 * i, j = idx >> 4, e = idx & 15;
          B[S2_V + (pw * 8 + j) * 16 + e] = ST[j * 256 + VOFF + rq * 16 + e];
        }
      }
    } else if (c >= 1 && c <= TPB / 32) {
      const float* B = sm + ((c - 1) & 1) * S2_BUF;
      float* yb = sm + S2_YB + ((c - 1) & 1) * 512;
      const int rl = w * 4 + fq;
      const int dtt = dir ? -1 : 1;
      int tt = dir ? 31 : 0;
      float dv[EPL], kv[EPL], qv[EPL], uv[EPL], pv[EPL], vv, c1v, c2v;
      float dn[EPL], kn[EPL], qn[EPL], un[EPL], pn[EPL], vn, c1n, c2n;
#define S2_LOAD(D_, K_, Q_, U_, P_, V_, C1_, C2_, T_)                                   \
  do {                                                                                  \
    const int o_ = (T_) * 64 + fr * EPL;                                                \
    if (EPL == 4) {                                                                     \
      float4 t4 = *(const float4*)(B + S2_D + o_);                                      \
      D_[0] = t4.x; D_[1] = t4.y; D_[2] = t4.z; D_[3] = t4.w;                           \
      t4 = *(const float4*)(B + S2_K + o_);                                             \
      K_[0] = t4.x; K_[1] = t4.y; K_[2] = t4.z; K_[3] = t4.w;                           \
      t4 = *(const float4*)(B + S2_DQ + o_);                                            \
      Q_[0] = t4.x; Q_[1] = t4.y; Q_[2] = t4.z; Q_[3] = t4.w;                           \
      t4 = *(const float4*)(B + S2_U + o_);                                             \
      U_[0] = t4.x; U_[1] = t4.y; U_[2] = t4.z; U_[3] = t4.w;                           \
      t4 = *(const float4*)(B + S2_P + o_);                                             \
      P_[0] = t4.x; P_[1] = t4.y; P_[2] = t4.z; P_[3] = t4.w;                           \
      C1_ = B[S2_C1 + (T_)];                                                            \
    } else {                                                                            \
      float2 t2 = *(const float2*)(B + S2_D + o_);                                      \
      D_[0] = t2.x; D_[1] = t2.y;                                                       \
      t2 = *(const float2*)(B + S2_K + o_);                                             \
      K_[0] = t2.x; K_[1] = t2.y;                                                       \
      t2 = *(const float2*)(B + S2_DQ + o_);                                            \
      Q_[0] = t2.x; Q_[1] = t2.y;                                                       \
      U_[0] = U_[1] = P_[0] = P_[1] = 0.f; C1_ = 0.f;                                   \
    }                                                                                   \
    V_ = B[S2_V + (T_) * 16 + rl];                                                      \
    C2_ = B[S2_C2 + (T_)];                                                              \
  } while (0)
#define S2_STEP(D_, K_, Q_, U_, P_, V_, C1_, C2_, T_)                                   \
  do {                                                                                  \
    float sq = 0.f, sa = 0.f;                                                           \
    _Pragma("unroll") for (int i = 0; i < EPL; i++) sq += s[i] * Q_[i];                 \
    if (MIX != 2) {                                                                     \
      _Pragma("unroll") for (int i = 0; i < EPL; i++) sa += s[i] * U_[i];               \
      sa = red16(sa);                                                                   \
    }                                                                                   \
    sq = red16(sq);                                                                     \
    float y = sq + V_ * C2_;                                                            \
    if (MIX != 2) y += sa * C1_;                                                        \
    _Pragma("unroll") for (int i = 0; i < EPL; i++) {                                   \
      float t = s[i] * D_[i] + V_ * K_[i];                                              \
      if (MIX != 2) t += sa * P_[i];                                                    \
      s[i] = t;                                                                         \
    }                                                                                   \
    yb[(T_) * 16 + rl] = y;                                                             \
  } while (0)
      S2_LOAD(dv, kv, qv, uv, pv, vv, c1v, c2v, tt);
#pragma unroll 1
      for (int st = 0; st < 32; st += 2) {
        const int t1 = tt + dtt;
        S2_LOAD(dn, kn, qn, un, pn, vn, c1n, c2n, t1);
        S2_STEP(dv, kv, qv, uv, pv, vv, c1v, c2v, tt);
        const int t2 = st + 2 < 32 ? t1 + dtt : t1;
        S2_LOAD(dv, kv, qv, uv, pv, vv, c1v, c2v, t2);
        S2_STEP(dn, kn, qn, un, pn, vn, c1n, c2n, t1);
        tt = t2;
      }
#undef S2_LOAD
#undef S2_STEP
    }
    __syncthreads();
  }
}

#define S3_SUB 12800
#define S3_GM 0
#define S3_KVT 9216
#define S3_QB 10240
#define S3_QV 11392
#define S3_VT 11520
#define S3_WC 12544
#define S3_STB (8 * S3_SUB)
#define S3_END (S3_STB + 4 * 2304)

__device__ __forceinline__ float rlane(float x, int l) { return __int_as_float(__builtin_amdgcn_readlane(__float_as_int(x), l)); }
__device__ __forceinline__ float wave_sum(float x) {
  x = red16(x);
  return (rlane(x, 0) + rlane(x, 16)) + (rlane(x, 32) + rlane(x, 48));
}
__device__ __forceinline__ float clampe(float x) { return fminf(fmaxf(x, -80.f), 80.f); }
__device__ __forceinline__ uint4 pack8(const float (&v)[8]) {
  return make_uint4(pack2(v[0], v[1]), pack2(v[2], v[3]), pack2(v[4], v[5]), pack2(v[6], v[7]));
}
__device__ __forceinline__ bf16x8 ld_frag(const void* p) { return *(const bf16x8*)p; }
__device__ __forceinline__ bf16x8 zfrag() { return bf16x8{0, 0, 0, 0, 0, 0, 0, 0}; }

template <int MIX>
__device__ __forceinline__ void scan3_item(const Params& p, int l, int b, int h, int dir, unsigned char* smb) {
  constexpr int VOFF = (MIX == 2) ? 64 : 128;
  constexpr bool DELTA = (MIX != 2);
  const int tid = TIDX, lane = tid & 63, w = tid >> 6, fr = lane & 15, fq = lane >> 4;
  const bool producer = true;
  const int pw = w & 3, half = w >> 2;
  const u16* P = (const u16*)(p.ws + OFF_BIG);
  u16* YS = (u16*)(p.ws + OFF_YS);
  float* BC = (float*)(p.ws + OFF_BC);
  float* ST = (float*)(smb + w * S3_SUB + S3_GM);
  unsigned char* STBY = smb + w * S3_SUB + S3_GM;
  const f32x4 z4 = f32x4{0.f, 0.f, 0.f, 0.f};
  f32x4 st[4];
#pragma unroll
  for (int i = 0; i < 4; i++) st[i] = z4;

  bf16x8 bw2[4], ba2[4];
  float cw[3][7];
  float muv[4];
  int colv[4];
  float c_w0 = 0.f, c_a0 = 0.f, c_ka = 0.f, c_kk = 0.f, c_rk = 0.f, c_gb = 0.f;
#pragma unroll
  for (int i = 0; i < 4; i++) { bw2[i] = zfrag(); ba2[i] = zfrag(); muv[i] = 0.f; colv[i] = 0; }
  if (producer) {
    if (MIX == 0) {
#pragma unroll
      for (int nt = 0; nt < 4; nt++) {
        const int jch = h * 64 + nt * 16 + fr;
#pragma unroll
        for (int jj = 0; jj < 8; jj++) {
          bw2[nt][jj] = (short)f2bf(p.rwkv_w2[((size_t)(l * 2 + dir) * 32 + fq * 8 + jj) * 256 + jch]);
          ba2[nt][jj] = (short)f2bf(p.rwkv_a2[((size_t)(l * 2 + dir) * 32 + fq * 8 + jj) * 256 + jch]);
        }
      }
      const int jl = h * 64 + lane;
      c_w0 = p.rwkv_w0[(l * 2 + dir) * 256 + jl];
      c_a0 = p.rwkv_a0[(l * 2 + dir) * 256 + jl];
      c_ka = p.rwkv_ka[l * 256 + jl];
      c_kk = p.rwkv_kk[l * 256 + jl];
      c_rk = p.rwkv_rk[l * 256 + jl];
#pragma unroll
      for (int i = 0; i < 4; i++) {
        colv[i] = i < 3 ? i * 256 + h * 64 + lane : (lane < 32 ? 768 + dir * 32 + lane : 832 + dir * 32 + (lane - 32));
        muv[i] = p.rwkv_mu[l * 960 + colv[i]];
      }
    } else if (MIX == 1) {
#pragma unroll
      for (int i = 0; i < 3; i++) {
        colv[i] = PB + i * 256 + h * 64 + lane;
#pragma unroll
        for (int tp = 0; tp < 7; tp++) cw[i][tp] = p.gdn_conv[((size_t)l * 7 + tp) * 768 + i * 256 + h * 64 + lane];
      }
    } else {
#pragma unroll
      for (int nt = 0; nt < 2; nt++) {
#pragma unroll
        for (int jj = 0; jj < 8; jj++)
          bw2[nt][jj] = fq < 2 ? (short)f2bf(p.gla_gw2[((size_t)(l * 2 + dir) * 16 + fq * 8 + jj) * 128 + h * 32 + nt * 16 + fr]) : (short)0;
      }
      c_gb = p.gla_gb[(l * 2 + dir) * 128 + h * 32 + (lane & 31)];
      colv[0] = PC + h * 32 + lane;
      if (lane >= 32) colv[0] = PC + 128 + h * 32 + (lane - 32);
      colv[1] = PC + 256 + h * 64 + lane;
      colv[2] = PC + 512 + dir * 16 + (lane & 15);
    }
  }
  __syncthreads();

  for (int it = 0; it < TPB / 64; it++) {
    {
      {
        const int c = it * 2 + half;
        int seg_row0, seg_len, t_lo;
        if (c < 8) { seg_row0 = b * TPB; seg_len = LC; t_lo = dir == 0 ? c * 32 : (LC - 32 - c * 32); }
        else { seg_row0 = b * TPB + LC; seg_len = SEQ; t_lo = dir == 0 ? (c - 8) * 32 : (SEQ - 32 - (c - 8) * 32); }
        const u16* Pseg = P + (size_t)seg_row0 * PST;
        unsigned char* SB = smb + w * S3_SUB;
        const int t0 = t_lo + pw * 8;
        if (MIX == 0) {
          float raw[10][4];
#pragma unroll
          for (int rr = 0; rr < 10; rr++) {
            const int t = t0 - 1 + rr;
            const float okf = (t >= 0 && t < seg_len) ? 1.f : 0.f;
            const int tc = min(max(t, 0), seg_len - 1);
#pragma unroll
            for (int i = 0; i < 4; i++) raw[rr][i] = bf2f(Pseg[(size_t)tc * PST + PA + colv[i]]) * okf;
          }
#pragma unroll
          for (int j = 0; j < 8; j++)
#pragma unroll
            for (int i = 0; i < 4; i++) {
              float xm = raw[j + 1][i] + (0.5f * (raw[j][i] + raw[j + 2][i]) - raw[j + 1][i]) * muv[i];
              if (i == 3 && lane < 32) xm = tanhf(xm);
              ST[j * 256 + lane + 64 * i] = xm;
            }
        } else if (MIX == 1) {
          float raw[14][3];
#pragma unroll
          for (int rr = 0; rr < 14; rr++) {
            const int t = t0 - 3 + rr;
            const float okf = (t >= 0 && t < seg_len) ? 1.f : 0.f;
            const int tc = min(max(t, 0), seg_len - 1);
#pragma unroll
            for (int i = 0; i < 3; i++) raw[rr][i] = bf2f(Pseg[(size_t)tc * PST + colv[i]]) * okf;
          }
#pragma unroll
          for (int j = 0; j < 8; j++)
#pragma unroll
            for (int i = 0; i < 3; i++) {
              float a = 0.f;
#pragma unroll
              for (int tp = 0; tp < 7; tp++) a += raw[j + tp][i] * cw[i][tp];
              ST[j * 256 + lane + 64 * i] = siluf(a);
            }
          if (lane < 8) {
            const u16* pp = Pseg + (size_t)(t0 + lane) * PST + PB;
            float bx = bf2f(pp[768 + dir * 4 + h]);
            float ax = bf2f(pp[776 + dir * 4 + h]);
            float ld = -__expf(p.gdn_a_log[(l * 2 + dir) * 4 + h]) * softplusf(ax + p.gdn_dt_bias[(l * 2 + dir) * 4 + h]);
            ST[lane * 256 + 192] = sigm(bx);
            ST[lane * 256 + 193] = ld;
          }
        } else {
          u16 raw[8][3];
#pragma unroll
          for (int j = 0; j < 8; j++) {
            const u16* pp = Pseg + (size_t)(t0 + j) * PST;
#pragma unroll
            for (int i = 0; i < 3; i++) raw[j][i] = pp[colv[i]];
          }
          const float qs = lane < 32 ? 0.17677669529663687f : 1.f;
#pragma unroll
          for (int j = 0; j < 8; j++) {
            ST[j * 256 + lane] = bf2f(raw[j][0]) * qs;
            ST[j * 256 + 64 + lane] = bf2f(raw[j][1]);
            if (lane < 16) ST[j * 256 + 128 + lane] = bf2f(raw[j][2]);
          }
        }
        wave_lds_sync();
        {
          float vv[8];
#pragma unroll
          for (int i = 0; i < 8; i++) vv[i] = ST[(dir ? 7 - i : i) * 256 + VOFF + lane];
          *(uint4*)(SB + S3_VT + lane * 16) = pack8(vv);
        }
        if (MIX == 0) {
          bf16x8 aw, aa;
#pragma unroll
          for (int jj = 0; jj < 8; jj++) {
            aw[jj] = fr < 8 ? (short)f2bf(ST[fr * 256 + 192 + fq * 8 + jj]) : (short)0;
            aa[jj] = fr < 8 ? (short)f2bf(ST[fr * 256 + 224 + fq * 8 + jj]) : (short)0;
          }
          f32x4 accw[4], acca[4];
#pragma unroll
          for (int nt = 0; nt < 4; nt++) {
            accw[nt] = __builtin_amdgcn_mfma_f32_16x16x32_bf16(aw, bw2[nt], z4, 0, 0, 0);
            acca[nt] = __builtin_amdgcn_mfma_f32_16x16x32_bf16(aa, ba2[nt], z4, 0, 0, 0);
          }
          wave_lds_sync();
          if (fq < 2) {
#pragma unroll
            for (int nt = 0; nt < 4; nt++)
#pragma unroll
              for (int r = 0; r < 4; r++) {
                ST[(fq * 4 + r) * 256 + 128 + nt * 16 + fr] = accw[nt][r];
                ST[(fq * 4 + r) * 256 + 192 + nt * 16 + fr] = acca[nt][r];
              }
          }
          wave_lds_sync();
        } else if (MIX == 2) {
          bf16x8 ag;
#pragma unroll
          for (int jj = 0; jj < 8; jj++) ag[jj] = (fr < 8 && fq < 2) ? (short)f2bf(ST[fr * 256 + 128 + fq * 8 + jj]) : (short)0;
          f32x4 accg[2];
#pragma unroll
          for (int nt = 0; nt < 2; nt++) accg[nt] = __builtin_amdgcn_mfma_f32_16x16x32_bf16(ag, bw2[nt], z4, 0, 0, 0);
          if (fq < 2) {
#pragma unroll
            for (int nt = 0; nt < 2; nt++)
#pragma unroll
              for (int r = 0; r < 4; r++) ST[(fq * 4 + r) * 256 + 192 + nt * 16 + fr] = accg[nt][r];
          }
          wave_lds_sync();
        }
        float logd[8], kap[8], bb[8], kp[8], qq[8];
#pragma unroll
        for (int i = 0; i < 8; i++) {
          const int j = dir ? 7 - i : i;
          const float* row = ST + j * 256;
          if (MIX == 0) {
            const float r_ = row[lane], k_ = row[64 + lane];
            const float sg = sigm(c_w0 + row[128 + lane]);
            const float a_ = sigm(c_a0 + row[192 + lane]);
            const float kd = k_ * (1.f + (a_ - 1.f) * c_ka);
            const float kkx = k_ * c_kk;
            const float ss = wave_sum(kkx * kkx);
            const float kk = kkx * rsq(ss + 1e-6f);
            const float bc = wave_sum(r_ * kd * c_rk);
            if (lane == 0) BC[(size_t)(seg_row0 + t0 + j) * 8 + h * 2 + dir] = bc;
            logd[i] = -0.6065306597126334f * sg;
            kap[i] = kk; bb[i] = kk * a_; kp[i] = kd; qq[i] = r_;
          } else if (MIX == 1) {
            const float q_ = row[lane], k_ = row[64 + lane];
            const float sq = wave_sum(q_ * q_), sk = wave_sum(k_ * k_);
            const float qn = q_ * rsq(sq + 1e-6f) * 0.125f, kn = k_ * rsq(sk + 1e-6f);
            const float beta = row[192], ld = row[193];
            const float alpha = __expf(ld);
            logd[i] = ld;
            kap[i] = kn; bb[i] = alpha * beta * kn; kp[i] = beta * kn; qq[i] = qn;
          } else {
            const int n = lane & 31;
            const float lg = c_gb + row[192 + n];
            const float ls = fminf(lg, 0.f) - log1pf(__expf(-fabsf(lg)));
            logd[i] = ls * (1.f / 16.f);
            kap[i] = 0.f; bb[i] = 0.f;
            kp[i] = lane < 32 ? row[32 + n] : 0.f;
            qq[i] = lane < 32 ? row[n] : 0.f;
          }
        }
        wave_lds_sync();
        float kt[8], qt[8], bck[8], kck[8];
        {
          float L[8];
          float run = 0.f;
#pragma unroll
          for (int i = 0; i < 8; i++) { run += logd[i]; L[i] = run; }
          const float Lr = L[3], L7 = L[7];
          float prevE = __expf(clampe(-Lr)), prevT = 1.f;
          u16* OPA = (u16*)STBY;
#pragma unroll
          for (int i = 0; i < 8; i++) {
            const float eI = __expf(clampe(L[i] - Lr)), eInv = __expf(clampe(Lr - L[i]));
            const float tI = __expf(L[i]), eEnd = __expf(L7 - L[i]);
            if (DELTA) {
              OPA[0 * 576 + i * 72 + lane] = f2bf(kap[i] * prevE);
              OPA[1 * 576 + i * 72 + lane] = f2bf(bb[i] * eInv);
            }
            OPA[2 * 576 + i * 72 + lane] = f2bf(kp[i] * eInv);
            OPA[3 * 576 + i * 72 + lane] = f2bf(qq[i] * eI);
            kt[i] = kap[i] * prevT; qt[i] = qq[i] * tI;
            bck[i] = bb[i] * eEnd; kck[i] = kp[i] * eEnd;
            prevE = eI; prevT = tI;
          }
          *(float*)(SB + S3_WC + lane * 4) = __expf(L7);
        }
        wave_lds_sync();
        f32x4 accA = z4, accBm = z4, accQb = z4, accQk = z4;
        {
          const u16* OPA = (const u16*)STBY;
          const int ro = (fr & 7) * 72 + fq * 8;
#pragma unroll
          for (int ks = 0; ks < 2; ks++) {
            const bf16x8 fk = ld_frag(OPA + 2 * 576 + ro + ks * 32), fqh = ld_frag(OPA + 3 * 576 + ro + ks * 32);
            accQk = __builtin_amdgcn_mfma_f32_16x16x32_bf16(fqh, fk, accQk, 0, 0, 0);
            if (DELTA) {
              const bf16x8 fka = ld_frag(OPA + 0 * 576 + ro + ks * 32), fb = ld_frag(OPA + 1 * 576 + ro + ks * 32);
              accA = __builtin_amdgcn_mfma_f32_16x16x32_bf16(fka, fb, accA, 0, 0, 0);
              accBm = __builtin_amdgcn_mfma_f32_16x16x32_bf16(fka, fk, accBm, 0, 0, 0);
              accQb = __builtin_amdgcn_mfma_f32_16x16x32_bf16(fqh, fb, accQb, 0, 0, 0);
            }
          }
#pragma unroll
          for (int r = 0; r < 4; r++) {
            const int i = fq * 4 + r;
            const bool ok = fq < 2 && fr < 8;
            if (!(ok && fr < i)) { accA[r] = 0.f; accBm[r] = 0.f; }
            if (!(ok && fr <= i)) { accQb[r] = 0.f; accQk[r] = 0.f; }
          }
        }
        float bmc[8], qkc[8];
#pragma unroll
        for (int m = 0; m < 4; m++) {
          bmc[m] = accBm[m]; qkc[m] = accQk[m];
          bmc[m + 4] = __shfl(accBm[m], (lane & 15) + 16);
          qkc[m + 4] = __shfl(accQk[m], (lane & 15) + 16);
        }
        float kbar[8], qbar[8], Kv[8], TB[8], Qv[8];
        if (DELTA) {
          float t[8];
#pragma unroll
          for (int i = 0; i < 8; i++) {
            float ti = (lane == i) ? 1.f : 0.f;
#pragma unroll
            for (int m = 0; m < i; m++) ti -= rlane(accA[i & 3], (i >> 2) * 16 + m) * t[m];
            t[i] = ti;
          }
#pragma unroll
          for (int i = 0; i < 8; i++) {
            float tb = 0.f, kb = 0.f;
#pragma unroll
            for (int m = 0; m <= i; m++) {
              const float tim = rlane(t[i], m);
              tb += tim * bmc[m];
              kb += tim * kt[m];
            }
            TB[i] = tb; kbar[i] = kb;
            float qv = qkc[i], qb = qt[i];
#pragma unroll
            for (int m = 0; m <= i; m++) {
              const float qbim = rlane(accQb[i & 3], (i >> 2) * 16 + m);
              qv -= qbim * TB[m];
              qb -= qbim * kbar[m];
            }
            Qv[i] = qv; qbar[i] = qb;
          }
#pragma unroll
          for (int j = 0; j < 8; j++) Kv[j] = kck[j];
#pragma unroll
          for (int i = 1; i < 8; i++)
#pragma unroll
            for (int j = 0; j < i; j++) Kv[j] -= rlane(TB[i], j) * bck[i];
        } else {
#pragma unroll
          for (int i = 0; i < 8; i++) { Qv[i] = qkc[i]; qbar[i] = qt[i]; Kv[i] = kck[i]; kbar[i] = 0.f; TB[i] = 0.f; }
        }
        *(uint4*)(SB + S3_KVT + lane * 16) = pack8(Kv);
#pragma unroll
        for (int i = 0; i < 8; i++) ((u16*)(SB + S3_QB))[i * 72 + lane] = f2bf(qbar[i]);
        if (lane < 8) {
#pragma unroll
          for (int i = 0; i < 8; i++) ((u16*)(SB + S3_QV))[i * 8 + lane] = f2bf(Qv[i]);
        }
        if (DELTA) {
          float nk[8];
#pragma unroll
          for (int i = 0; i < 8; i++) nk[i] = -kbar[i];
          *(uint4*)(STBY + 4608 + lane * 16) = pack8(bck);
          *(uint4*)(STBY + 5632 + lane * 16) = pack8(nk);
          wave_lds_sync();
          bf16x8 fa[4], fb[4];
#pragma unroll
          for (int x = 0; x < 4; x++) {
            fa[x] = fq == 0 ? ld_frag(STBY + 5632 + (x * 16 + fr) * 16) : zfrag();
            fb[x] = fq == 0 ? ld_frag(STBY + 4608 + (x * 16 + fr) * 16) : zfrag();
          }
#pragma unroll
          for (int nt = 0; nt < 4; nt++)
#pragma unroll
            for (int mt = 0; mt < 4; mt++) {
              const f32x4 g = __builtin_amdgcn_mfma_f32_16x16x32_bf16(fa[mt], fb[nt], z4, 0, 0, 0);
              uint2 gv;
              gv.x = pack2(g[0], g[1]); gv.y = pack2(g[2], g[3]);
              *(uint2*)(SB + S3_GM + ((nt * 16 + fr) * 72 + mt * 16 + fq * 4) * 2) = gv;
            }
        }
      }
    }
    __syncthreads();
    if (w < 4) {
      unsigned char* STB = smb + S3_STB + w * 2304;
#pragma unroll 1
      for (int kk = 0; kk < 8; kk++) {
        const int cc = it * 2 + (kk >> 2), k = kk & 3;
        int seg_row0, t_lo;
        if (cc < 8) { seg_row0 = b * TPB; t_lo = dir == 0 ? cc * 32 : (LC - 32 - cc * 32); }
        else { seg_row0 = b * TPB + LC; t_lo = dir == 0 ? (cc - 8) * 32 : (SEQ - 32 - (cc - 8) * 32); }
        const int sc = dir ? 3 - k : k;
        const unsigned char* SB = smb + ((kk >> 2) * 4 + sc) * S3_SUB;
#pragma unroll
        for (int nt = 0; nt < 4; nt++) {
          uint2 sv;
          sv.x = pack2(st[nt][0], st[nt][1]); sv.y = pack2(st[nt][2], st[nt][3]);
          *(uint2*)(STB + (fr * 72 + nt * 16 + fq * 4) * 2) = sv;
        }
        wave_lds_sync();
        const bf16x8 bs0 = ld_frag(STB + (fr * 72 + fq * 8) * 2), bs1 = ld_frag(STB + (fr * 72 + 32 + fq * 8) * 2);
        const bf16x8 bv = fq == 0 ? ld_frag(SB + S3_VT + (w * 16 + fr) * 16) : zfrag();
        const bf16x8 aq0 = ld_frag(SB + S3_QB + ((fr & 7) * 72 + fq * 8) * 2), aq1 = ld_frag(SB + S3_QB + ((fr & 7) * 72 + 32 + fq * 8) * 2);
        const bf16x8 aqv = fq == 0 ? ld_frag(SB + S3_QV + (fr & 7) * 16) : zfrag();
        f32x4 accY = __builtin_amdgcn_mfma_f32_16x16x32_bf16(aq0, bs0, z4, 0, 0, 0);
        accY = __builtin_amdgcn_mfma_f32_16x16x32_bf16(aq1, bs1, accY, 0, 0, 0);
        accY = __builtin_amdgcn_mfma_f32_16x16x32_bf16(aqv, bv, accY, 0, 0, 0);
        if (fq < 2) {
#pragma unroll
          for (int r = 0; r < 4; r++) {
            const int i = fq * 4 + r, j = dir ? 7 - i : i;
            YS[(size_t)(seg_row0 + t_lo + sc * 8 + j) * YST + dir * 768 + MIX * 256 + h * 64 + w * 16 + fr] = f2bf(accY[r]);
          }
        }
#pragma unroll
        for (int nt = 0; nt < 4; nt++) {
          f32x4 an = z4;
          if (DELTA) {
            const bf16x8 g0 = ld_frag(SB + S3_GM + ((nt * 16 + fr) * 72 + fq * 8) * 2), g1 = ld_frag(SB + S3_GM + ((nt * 16 + fr) * 72 + 32 + fq * 8) * 2);
            an = __builtin_amdgcn_mfma_f32_16x16x32_bf16(g0, bs0, an, 0, 0, 0);
            an = __builtin_amdgcn_mfma_f32_16x16x32_bf16(g1, bs1, an, 0, 0, 0);
          }
          const bf16x8 akv = fq == 0 ? ld_frag(SB + S3_KVT + (nt * 16 + fr) * 16) : zfrag();
          an = __builtin_amdgcn_mfma_f32_16x16x32_bf16(akv, bv, an, 0, 0, 0);
          const float4 wc = *(const float4*)(SB + S3_WC + (nt * 16 + fq * 4) * 4);
          st[nt][0] = st[nt][0] * wc.x + an[0];
          st[nt][1] = st[nt][1] * wc.y + an[1];
          st[nt][2] = st[nt][2] * wc.z + an[2];
          st[nt][3] = st[nt][3] * wc.w + an[3];
        }
        wave_lds_sync();
      }
    }
    __syncthreads();
  }
}

__device__ __forceinline__ void attn_item(const Params& p, int l, int b, int qb, int hk, bool isctx, unsigned char* smem) {
  u16* KS = (u16*)smem;
  u16* VT = KS + 64 * LDT;
  u16* PL = VT + 64 * LDT;
  float2* ROPE = (float2*)(PL + 8 * 32 * LDT);
  const int tid = TIDX, lane = tid & 63, w = tid >> 6, fr = lane & 15, fq = lane >> 4;
  const u16* P = (const u16*)(p.ws + OFF_BIG);
  u16* Y = (u16*)(p.ws + OFF_YS);
  const int qh = hk * 2 + (w >> 2);
  const int tb = qb * 128 + (w & 3) * 32;
  const int qrow0 = b * TPB + (isctx ? 0 : LC);
  __syncthreads();
  for (int i = tid; i < 1024; i += NTHR) {
    int pos = i >> 4, fi = i & 15;
    float inv = powf(10000.f, -(float)fi / 16.f);
    float sn, cs;
    sincosf((float)pos * inv, &sn, &cs);
    ROPE[i] = make_float2(cs, sn);
  }
  __syncthreads();
  bf16x8 qf[2][2];
#pragma unroll
  for (int mi = 0; mi < 2; mi++)
#pragma unroll
    for (int ks = 0; ks < 2; ks++) {
      const int tq = tb + mi * 16 + fr;
      const u16* qp = P + (size_t)(qrow0 + tq) * PST + PD + qh * 64 + ks * 32;
      uint4 own = *(const uint4*)(qp + fq * 8);
      uint4 par = *(const uint4*)(qp + (fq ^ 2) * 8);
      const unsigned ow[4] = {own.x, own.y, own.z, own.w};
      const unsigned pw[4] = {par.x, par.y, par.z, par.w};
      const int pos = ks == 0 ? (tq >> 6) : (tq & 63);
      bf16x8 f;
#pragma unroll
      for (int jj = 0; jj < 8; jj++) {
        float xo = bf2f((u16)((ow[jj >> 1] >> ((jj & 1) * 16)) & 0xffff));
        float xp = bf2f((u16)((pw[jj >> 1] >> ((jj & 1) * 16)) & 0xffff));
        float v = xo;
        if (!isctx) {
          float2 cs = ROPE[pos * 16 + (fq & 1) * 8 + jj];
          v = fq < 2 ? xo * cs.x - xp * cs.y : xp * cs.y + xo * cs.x;
        }
        f[jj] = (short)f2bf(v * 0.125f);
      }
      qf[mi][ks] = f;
    }
  f32x4 oacc[2][4];
#pragma unroll
  for (int mi = 0; mi < 2; mi++)
#pragma unroll
    for (int nd = 0; nd < 4; nd++) oacc[mi][nd] = f32x4{0.f, 0.f, 0.f, 0.f};
  float mrow[2][4], lrow[2][4];
#pragma unroll
  for (int mi = 0; mi < 2; mi++)
#pragma unroll
    for (int r = 0; r < 4; r++) { mrow[mi][r] = -1e30f; lrow[mi][r] = 0.f; }

  const int q0 = qb * 128;
  const int band_lo = isctx ? 0 : max(0, q0 - 128), band_hi = isctx ? 0 : min(SEQ, q0 + 256);
  const int ntile = 4 + (band_hi - band_lo) / 64;
  u16* pl = PL + w * 32 * LDT;
  for (int tl = 0; tl < ntile; tl++) {
    const bool band = tl >= 4;
    const int k0 = band ? band_lo + (tl - 4) * 64 : tl * 64;
    __syncthreads();
    {
      const int key = tid >> 3, kc = tid & 7;
      const int kpos = k0 + key;
      const u16* kp = P + (size_t)(b * TPB + (band ? LC : 0) + kpos) * PST + PD + 256 + hk * 64;
      uint4 own = *(const uint4*)(kp + kc * 8);
      uint4 vv = *(const uint4*)(kp + 128 + kc * 8);
      uint4 par = *(const uint4*)(kp + (kc ^ 2) * 8);
      if (band) {
        const unsigned ow[4] = {own.x, own.y, own.z, own.w};
        const unsigned pw[4] = {par.x, par.y, par.z, par.w};
        const int pos = kc < 4 ? (kpos >> 6) : (kpos & 63);
        unsigned res[4];
#pragma unroll
        for (int jj = 0; jj < 8; jj += 2) {
          float v2[2];
#pragma unroll
          for (int e = 0; e < 2; e++) {
            float xo = bf2f((u16)((ow[jj >> 1] >> (e * 16)) & 0xffff));
            float xp = bf2f((u16)((pw[jj >> 1] >> (e * 16)) & 0xffff));
            float2 cs = ROPE[pos * 16 + (kc & 1) * 8 + jj + e];
            v2[e] = (kc & 2) == 0 ? xo * cs.x - xp * cs.y : xp * cs.y + xo * cs.x;
          }
          res[jj >> 1] = pack2(v2[0], v2[1]);
        }
        own = make_uint4(res[0], res[1], res[2], res[3]);
      }
      *(uint4*)(KS + key * LDT + kc * 8) = own;
      const unsigned vw[4] = {vv.x, vv.y, vv.z, vv.w};
#pragma unroll
      for (int jj = 0; jj < 8; jj++) VT[(kc * 8 + jj) * LDT + key] = (u16)((vw[jj >> 1] >> ((jj & 1) * 16)) & 0xffff);
    }
    __syncthreads();
    f32x4 sc[2][4];
#pragma unroll
    for (int mi = 0; mi < 2; mi++)
#pragma unroll
      for (int nj = 0; nj < 4; nj++) sc[mi][nj] = f32x4{0.f, 0.f, 0.f, 0.f};
#pragma unroll
    for (int ks = 0; ks < 2; ks++) {
      bf16x8 kf[4];
#pragma unroll
      for (int nj = 0; nj < 4; nj++) kf[nj] = *(const bf16x8*)(KS + (nj * 16 + fr) * LDT + ks * 32 + fq * 8);
#pragma unroll
      for (int mi = 0; mi < 2; mi++)
#pragma unroll
        for (int nj = 0; nj < 4; nj++) sc[mi][nj] = __builtin_amdgcn_mfma_f32_16x16x32_bf16(qf[mi][ks], kf[nj], sc[mi][nj], 0, 0, 0);
    }
#pragma unroll
    for (int mi = 0; mi < 2; mi++)
#pragma unroll
      for (int r = 0; r < 4; r++) {
        const int qpos = tb + mi * 16 + fq * 4 + r;
        float mx = -1e30f;
#pragma unroll
        for (int nj = 0; nj < 4; nj++) {
          float v = sc[mi][nj][r];
          if (band) {
            int d = qpos - (k0 + nj * 16 + fr);
            if (d > 128 || d < -128) v = -1e30f;
          }
          sc[mi][nj][r] = v;
          mx = fmaxf(mx, v);
        }
        mx = fmaxf(mx, __shfl_xor(mx, 1));
        mx = fmaxf(mx, __shfl_xor(mx, 2));
        mx = fmaxf(mx, __shfl_xor(mx, 4));
        mx = fmaxf(mx, __shfl_xor(mx, 8));
        const float mnew = fmaxf(mrow[mi][r], mx);
        const float alpha = __expf(mrow[mi][r] - mnew);
        mrow[mi][r] = mnew;
        float ls = 0.f;
#pragma unroll
        for (int nj = 0; nj < 4; nj++) {
          float pe = __expf(sc[mi][nj][r] - mnew);
          ls += pe;
          pl[(mi * 16 + fq * 4 + r) * LDT + nj * 16 + fr] = f2bf(pe);
        }
        lrow[mi][r] = lrow[mi][r] * alpha + ls;
#pragma unroll
        for (int nd = 0; nd < 4; nd++) oacc[mi][nd][r] *= alpha;
      }
    asm volatile("s_waitcnt lgkmcnt(0)" ::: "memory");
    __builtin_amdgcn_wave_barrier();
#pragma unroll
    for (int ks = 0; ks < 2; ks++) {
      bf16x8 pf[2], vf[4];
#pragma unroll
      for (int mi = 0; mi < 2; mi++) pf[mi] = *(const bf16x8*)(pl + (mi * 16 + fr) * LDT + ks * 32 + fq * 8);
#pragma unroll
      for (int nd = 0; nd < 4; nd++) vf[nd] = *(const bf16x8*)(VT + (nd * 16 + fr) * LDT + ks * 32 + fq * 8);
#pragma unroll
      for (int mi = 0; mi < 2; mi++)
#pragma unroll
        for (int nd = 0; nd < 4; nd++) oacc[mi][nd] = __builtin_amdgcn_mfma_f32_16x16x32_bf16(pf[mi], vf[nd], oacc[mi][nd], 0, 0, 0);
    }
    asm volatile("s_waitcnt lgkmcnt(0)" ::: "memory");
    __builtin_amdgcn_wave_barrier();
  }
  const float sink = p.attn_sink[l * 4 + qh];
#pragma unroll
  for (int mi = 0; mi < 2; mi++)
#pragma unroll
    for (int r = 0; r < 4; r++) {
      float ls = lrow[mi][r];
      ls += __shfl_xor(ls, 1);
      ls += __shfl_xor(ls, 2);
      ls += __shfl_xor(ls, 4);
      ls += __shfl_xor(ls, 8);
      ls += __expf(sink - mrow[mi][r]);
      const float inv = 1.f / ls;
      const int tq = tb + mi * 16 + fq * 4 + r;
#pragma unroll
      for (int nd = 0; nd < 4; nd++) Y[(size_t)(qrow0 + tq) * YST + 1536 + qh * 64 + nd * 16 + fr] = f2bf(oacc[mi][nd][r] * inv);
    }
}

#ifndef SCAN3_MASK
#define SCAN3_MASK 7
#endif
__device__ __forceinline__ void phase_mix(const Params& p, int l, unsigned char* smem) {
  float* sm = (float*)smem;
  const int G = gridDim.x;
  for (int it = blockIdx.x; it < 192; it += G) {
    const int mix = it >> 6, rem = it & 63, b = rem >> 3, h = (rem >> 1) & 3, dir = rem & 1;
    if (mix == 0 && (SCAN3_MASK & 1)) scan3_item<0>(p, l, b, h, dir, smem);
    else if (mix == 1 && (SCAN3_MASK & 2)) scan3_item<1>(p, l, b, h, dir, smem);
    else if (mix == 2 && (SCAN3_MASK & 4)) scan3_item<2>(p, l, b, h, dir, smem);
  }
  if (SCAN3_MASK != 7) {
    for (int it = blockIdx.x; it < 768; it += G) {
      const int mix = it >> 8, rem = it & 255, b = rem >> 5, h = (rem >> 3) & 3, dir = (rem >> 2) & 1, rq = rem & 3;
      if (mix == 0 && !(SCAN3_MASK & 1)) scan2_item<0>(p, l, b, h, dir, rq, sm);
      else if (mix == 1 && !(SCAN3_MASK & 2)) scan2_item<1>(p, l, b, h, dir, rq, sm);
      else if (mix == 2 && !(SCAN3_MASK & 4)) scan2_item<2>(p, l, b, h, dir, rq, sm);
    }
  }
  __syncthreads();
  unsigned* ctr = (unsigned*)(p.ws + OFF_CTR) + l * 16;
  volatile int* slot = (volatile int*)(smem + 131072 - 16);
  for (;;) {
    if (TIDX == 0) *slot = (int)atomicAdd(ctr, 1u);
    __syncthreads();
    const int it = *slot;
    __syncthreads();
    if (it >= 544) break;
    if (it < 512) {
      int b = it >> 6, qb = (it >> 1) & 31, hk = it & 1;
      attn_item(p, l, b, qb, hk, false, smem);
    } else {
      int r = it - 512, b = r >> 2, qb = (r >> 1) & 1, hk = r & 1;
      attn_item(p, l, b, qb, hk, true, smem);
    }
  }
}

__device__ __forceinline__ void phase_post(const Params& p, int l, float* g2s) {
  const int lane = TIDX & 63, wv = TIDX >> 6;
  const u16* P = (const u16*)(p.ws + OFF_BIG);
  u16* YS = (u16*)(p.ws + OFF_YS);
  const float* BC = (const float*)(p.ws + OFF_BC);
  const int j0 = lane * 4, hd = lane >> 4;
  {
    const float4* src = (const float4*)(p.rwkv_g2 + (size_t)l * 64 * 256);
    for (int i = TIDX; i < 64 * 256 / 4; i += NTHR) ((float4*)g2s)[i] = src[i];
  }
  __syncthreads();
  for (int r = blockIdx.x * 8 + wv; r < NROWS; r += gridDim.x * 8) {
    const int b = r / TPB, t = r - b * TPB;
    const bool has_prev = (t != 0) && (t != LC), has_next = (t != LC - 1) && (t != TPB - 1);
    const int poff = has_prev ? PST : 0, noff = has_next ? PST : 0;
    const float pmul = has_prev ? 1.f : 0.f, nmul = has_next ? 1.f : 0.f;
    u16* ys = YS + (size_t)r * YST;
    const u16* pr = P + (size_t)r * PST;
    float y[3][4];
#pragma unroll
    for (int m = 0; m < 3; m++) {
      uint2 a = *(const uint2*)(ys + m * 256 + j0);
      uint2 c = *(const uint2*)(ys + 768 + m * 256 + j0);
      y[m][0] = bf2f((u16)(a.x & 0xffff)) + bf2f((u16)(c.x & 0xffff));
      y[m][1] = bf2f((u16)(a.x >> 16)) + bf2f((u16)(c.x >> 16));
      y[m][2] = bf2f((u16)(a.y & 0xffff)) + bf2f((u16)(c.y & 0xffff));
      y[m][3] = bf2f((u16)(a.y >> 16)) + bf2f((u16)(c.y >> 16));
    }
    float o[3][4];
    {
      float sum = y[0][0] + y[0][1] + y[0][2] + y[0][3];
      sum += __shfl_xor(sum, 1); sum += __shfl_xor(sum, 2); sum += __shfl_xor(sum, 4); sum += __shfl_xor(sum, 8);
      const float mean = sum * (1.f / 64.f);
      float vs = 0.f;
#pragma unroll
      for (int i = 0; i < 4; i++) { float d = y[0][i] - mean; vs += d * d; }
      vs += __shfl_xor(vs, 1); vs += __shfl_xor(vs, 2); vs += __shfl_xor(vs, 4); vs += __shfl_xor(vs, 8);
      const float rstd = rsq(vs * (1.f / 64.f) + 64e-5f);
      float sg;
      {
        const int col = 896 + lane;
        float pv = bf2f(pr[PA + col]);
        float pp = bf2f(pr[PA + col - poff]) * pmul;
        float pn = bf2f(pr[PA + col + noff]) * nmul;
        float xm = pv + (0.5f * (pp + pn) - pv) * p.rwkv_mu[l * 960 + col];
        sg = sigm(xm);
      }
      float gate[4] = {0.f, 0.f, 0.f, 0.f};
      const float* g2 = g2s + j0;
#pragma unroll
      for (int i = 0; i < 64; i++) {
        const float si = __int_as_float(__builtin_amdgcn_readlane(__float_as_int(sg), i));
        const float4 gw = *(const float4*)(g2 + i * 256);
        gate[0] += si * gw.x; gate[1] += si * gw.y; gate[2] += si * gw.z; gate[3] += si * gw.w;
      }
      const float bcs = BC[(size_t)r * 8 + hd * 2] + BC[(size_t)r * 8 + hd * 2 + 1];
#pragma unroll
      for (int i = 0; i < 4; i++) {
        const int col = 512 + j0 + i;
        float pv = bf2f(pr[PA + col]);
        float pp = bf2f(pr[PA + col - poff]) * pmul;
        float pn = bf2f(pr[PA + col + noff]) * nmul;
        float v = pv + (0.5f * (pp + pn) - pv) * p.rwkv_mu[l * 960 + col];
        float yn = (y[0][i] - mean) * rstd * p.rwkv_ln_g[l * 256 + j0 + i] + p.rwkv_ln_b[l * 256 + j0 + i];
        o[0][i] = (yn + bcs * v) * gate[i];
      }
    }
#pragma unroll
    for (int m = 1; m < 3; m++) {
      float ss = y[m][0] * y[m][0] + y[m][1] * y[m][1] + y[m][2] * y[m][2] + y[m][3] * y[m][3];
      ss += __shfl_xor(ss, 1); ss += __shfl_xor(ss, 2); ss += __shfl_xor(ss, 4); ss += __shfl_xor(ss, 8);
      const float inv = rsq(ss * (1.f / 64.f) + 1e-6f);
      const float* ng = (m == 1 ? p.gdn_norm_g : p.gla_norm_g) + l * 64 + (lane & 15) * 4;
      const u16* gp = pr + (m == 1 ? PB + 784 : PC + 544) + j0;
#pragma unroll
      for (int i = 0; i < 4; i++) o[m][i] = y[m][i] * inv * ng[i] * siluf(bf2f(gp[i]));
    }
    asm volatile("s_waitcnt vmcnt(0)" ::: "memory");
    __builtin_amdgcn_wave_barrier();
#pragma unroll
    for (int m = 0; m < 3; m++) {
      uint2 ov;
      ov.x = pack2(o[m][0], o[m][1]);
      ov.y = pack2(o[m][2], o[m][3]);
      *(uint2*)(ys + m * 256 + j0) = ov;
    }
  }
}

#if defined(SKIPS)
#define EN(k) (SKIPS != (k))
#elif !defined(ONLYS)
#define EN(k) 1
#else
#define EN(k) (ONLYS == (k))
#endif
__device__ __forceinline__ void run_phase(const Params& p, int ph, unsigned char* smem) {
  if (ph == 0) { if (EN(10)) phase_init0(p, (float*)smem); return; }
  if (ph == 1) { if (EN(11)) phase_init1(p); return; }
  int l = 0, s = 12;
  if (ph >= 3) { l = (ph - 3) / 12; s = (ph - 3) - l * 12; }
  unsigned char* wl = p.ws + OFF_W + (size_t)l * SZ_WL;
  PG8_LAS unsigned char* lds = (PG8_LAS unsigned char*)smem;
  pg8::StaticOrder S;
  if (s == 12 || s == 8 || s == 11) {
    if (EN(5)) rowpass(p, l, s == 12 ? 0 : (s == 8 ? 1 : 2));
  } else if (s == 0 || s == 3 || s == 5 || s == 7 || s == 10) {
    pg8::Gemm g; EpiBf E;
    g.M = NROWS; E.bias = nullptr; E.act = 0;
    if (s == 0) { g.A = (const u16*)(p.ws + OFF_H); g.lda = DM; g.Bt = (const u16*)(wl + OW_IN); g.K = DM; g.N = PST; E.O = (u16*)(p.ws + OFF_BIG); E.ldc = PST; }
    else if (s == 3 || s == 5) {
      const int hf = s == 5;
      g.A = (const u16*)(p.ws + OFF_H); g.lda = DM; g.Bt = (const u16*)(wl + OW_G) + (size_t)hf * 2048 * DM; g.K = DM; g.N = 2048;
      E.O = (u16*)(p.ws + OFF_BIG); E.ldc = 2048; E.bias = p.gate_b + (size_t)l * 4096 + hf * 2048; E.act = 1;
    }
    else if (s == 7) { g.A = (const u16*)(p.ws + OFF_BIG + 2 * SZ_ACT); g.lda = DM; g.Bt = (const u16*)(wl + OW_O); g.K = DM; g.N = DM; E.O = (u16*)(p.ws + OFF_BIG); E.ldc = DM; }
    else { g.A = (const u16*)(p.ws + OFF_BIG); g.lda = FH; g.Bt = (const u16*)(wl + OW_2); g.K = FH; g.N = DM; E.O = (u16*)(p.ws + OFF_YS); E.ldc = DM; }
    S.init(g.M, g.N, gridDim.x, blockIdx.x);
    if (EN(0)) pg8::gemm_phase<EpiBf, pg8::StaticOrder, false>(lds, g, S, E, nullptr);
  } else if (s == 4 || s == 6) {
    if (EN(3)) phase_ypart(p, l, s == 6, smem);
  } else if (s == 1) {
    if (EN(1)) phase_mix(p, l, smem);
  } else if (s == 2) {
    if (EN(2)) phase_post(p, l, (float*)smem);
  } else {
    pg8::Gemm g; EpiSwiglu E;
    g.M = NROWS; g.N = 2 * FH; g.K = DM; g.lda = DM; g.A = (const u16*)(p.ws + OFF_H); g.Bt = (const u16*)(wl + OW_1);
    E.O = (u16*)(p.ws + OFF_BIG);
    S.init(g.M, g.N, gridDim.x, blockIdx.x);
    if (EN(6)) pg8::gemm_phase<EpiSwiglu, pg8::StaticOrder, false>(lds, g, S, E, nullptr);
  }
}

__global__ void __launch_bounds__(NTHR) hybrid_flow_mega(Params p, int ph0, int ph1) {
  __shared__ __attribute__((aligned(16))) unsigned char smem[131072];
  cg::grid_group grid = cg::this_grid();
  for (int ph = ph0; ph < ph1; ph++) {
    run_phase(p, ph, smem);
#ifdef DUPMASK
    {
      int sidx = ph >= 3 ? (ph - 3) % 12 : 12 + ph;
      if ((DUPMASK >> sidx) & 1) { __syncthreads(); run_phase(p, ph, smem); }
    }
#endif
    if (ph + 1 < ph1) grid.sync();
  }
}

extern "C" void kernel_launch(void* const* d_in, const int* in_sizes, int n_in, void* d_out, int out_size, void* d_ws,
                              size_t ws_size, hipStream_t stream) {
  Params p{};
  const float** pp = (const float**)&p;
  for (int i = 0; i < 32; i++) pp[i] = (const float*)d_in[i];
  p.out = (float*)d_out;
  p.ws = (unsigned char*)d_ws;
  static int grid_blocks = 0;
  if (!grid_blocks) {
    int dev = 0, cus = 0, per_cu = 0;
    hipGetDevice(&dev);
    hipDeviceGetAttribute(&cus, hipDeviceAttributeMultiprocessorCount, dev);
    hipOccupancyMaxActiveBlocksPerMultiprocessor(&per_cu, hybrid_flow_mega, NTHR, 0);
    if (per_cu < 1) per_cu = 1;
    grid_blocks = cus * per_cu;
  }
#ifdef MULTI_LAUNCH
  for (int ph = 0; ph < NPHASE; ph++) {
    hipLaunchKernelGGL(hybrid_flow_mega, dim3(grid_blocks), dim3(NTHR), 0, stream, p, ph, ph + 1);
  }
#else
  int ph0 = 0, ph1 = NPHASE;
  void* args[] = {&p, &ph0, &ph1};
  hipError_t e = hipLaunchCooperativeKernel((void*)hybrid_flow_mega, dim3(grid_blocks), dim3(NTHR), args, 0, stream);
  if (e != hipSuccess) fprintf(stderr, "cooperative launch failed: %s (grid %d)\n", hipGetErrorString(e), grid_blocks);
#endif
}
```

```cpp
#include <hip/hip_runtime.h>
#include <hip/hip_cooperative_groups.h>
#include <cstdio>
namespace cg = cooperative_groups;

typedef unsigned short u16;
using bf16x8 = __attribute__((ext_vector_type(8))) short;
using f32x4 = __attribute__((ext_vector_type(4))) float;

#define DM 1024
#define NBATCH 8
#define SEQ 4096
#define LC 256
#define TPB 4352
#define NROWS 34816
#define PST 3328
#define YST 1792
#define FH 2816
#define INW 7408
#define NTHR 512
#define PA 0
#define PB 960
#define PC 2000
#define PD 2800
#define NPHASE 27
#define SCAN3_MASK 7

struct Params {
  const float *x, *c, *ctx, *c_ctx, *ada_w, *ada_b, *norm_g, *w_in, *gate_b, *w_branch, *w_out,
      *rwkv_mu, *rwkv_w0, *rwkv_w2, *rwkv_a0, *rwkv_a2, *rwkv_g2, *rwkv_kk, *rwkv_ka, *rwkv_rk, *rwkv_ln_g,
      *rwkv_ln_b, *gdn_conv, *gdn_a_log, *gdn_dt_bias, *gdn_norm_g, *gla_gw2, *gla_gb, *gla_norm_g, *attn_sink,
      *ffn_w1, *ffn_w2;
  float* out;
  unsigned char* ws;
};

constexpr size_t SZ_WL = 36700160;
constexpr size_t OW_IN = 0;
constexpr size_t OW_G = OW_IN + (size_t)PST * 1024 * 2;
constexpr size_t OW_B = OW_G + (size_t)4096 * 1024 * 2;
constexpr size_t OW_O = OW_B + (size_t)4 * 1024 * 256 * 2;
constexpr size_t OW_1 = OW_O + (size_t)1024 * 1024 * 2;
constexpr size_t OW_2 = OW_1 + (size_t)5632 * 1024 * 2;
static_assert(OW_2 + (size_t)1024 * FH * 2 == SZ_WL, "weights size");
constexpr size_t SZ_ACT = (size_t)NROWS * DM * 2;
constexpr size_t OFF_W = 0;
constexpr size_t OFF_XC = OFF_W + 2 * SZ_WL;
constexpr size_t OFF_MODP = OFF_XC + (size_t)NBATCH * LC * DM * 4;
constexpr size_t OFF_MOD = OFF_MODP + (size_t)2 * 8 * 9 * 6144 * 4;
constexpr size_t OFF_BC = OFF_MOD + (size_t)2 * 9 * 6144 * 4;
constexpr size_t OFF_H = OFF_BC + (size_t)NROWS * 8 * 4;
constexpr size_t OFF_YS = OFF_H + SZ_ACT;
constexpr size_t OFF_BIG = OFF_YS + (size_t)NROWS * YST * 2;
constexpr size_t OFF_CTR = OFF_BIG + (size_t)NROWS * PST * 2;
constexpr size_t WS_END = OFF_CTR + 256;
static_assert(WS_END <= (size_t)536870912, "ws too large");

__device__ __forceinline__ int launder_tid() { int t = threadIdx.x; asm volatile("" : "+v"(t)); return t; }
#define TIDX (launder_tid())
typedef float f32x2_t __attribute__((ext_vector_type(2)));
typedef __bf16 bf16x2_t __attribute__((ext_vector_type(2)));
__device__ __forceinline__ unsigned pack2(float a, float b) {
  const f32x2_t v = {a, b};
  const bf16x2_t r = __builtin_convertvector(v, bf16x2_t);
  return __builtin_bit_cast(unsigned, r);
}
__device__ __forceinline__ u16 f2bf(float f) { return (u16)(pack2(f, 0.f) & 0xffffu); }
__device__ __forceinline__ float bf2f(u16 h) { return __uint_as_float(((unsigned)h) << 16); }
__device__ __forceinline__ float sigm(float x) { return __builtin_amdgcn_rcpf(1.f + __expf(-x)); }
__device__ __forceinline__ float siluf(float x) { return x * __builtin_amdgcn_rcpf(1.f + __expf(-x)); }
__device__ __forceinline__ float rsq(float x) { return __builtin_amdgcn_rsqf(x); }
__device__ __forceinline__ float softplusf(float x) { return fmaxf(x, 0.f) + log1pf(__expf(-fabsf(x))); }
__device__ __forceinline__ float wsum(float v) {
#pragma unroll
  for (int o = 32; o > 0; o >>= 1) v += __shfl_xor(v, o);
  return v;
}
template <int CTRL>
__device__ __forceinline__ float dppf(float x) {
  return __int_as_float(__builtin_amdgcn_update_dpp(__float_as_int(x), __float_as_int(x), CTRL, 0xf, 0xf, false));
}
__device__ __forceinline__ float red8(float x) {
  x += dppf<0xB1>(x);
  x += dppf<0x4E>(x);
  x += dppf<0x141>(x);
  return x;
}
__device__ __forceinline__ const float* xin_row(const Params& p, int r) {
  int b = r / TPB, t = r - b * TPB;
  return t < LC ? p.ctx + ((size_t)(b * LC + t)) * DM : p.x + ((size_t)(b * SEQ + t - LC)) * DM;
}
__device__ __forceinline__ float* x_row(const Params& p, int r) {
  int b = r / TPB, t = r - b * TPB;
  return t < LC ? (float*)(p.ws + OFF_XC) + ((size_t)(b * LC + t)) * DM : p.out + ((size_t)(b * SEQ + t - LC)) * DM;
}
__device__ __forceinline__ int mod_row(int r) {
  int b = r / TPB, t = r - b * TPB;
  return t < LC ? 8 : b;
}

struct MapId { int lim, off; __device__ int operator()(int n) const { return n < lim ? n + off : -1; } };
struct MapW1 { __device__ int operator()(int n) const { int q = n >> 3, s = n & 7; return s < 4 ? q * 4 + s : FH + q * 4 + (s - 4); } };

template <class Map>
__device__ __forceinline__ void conv_tile(const float* __restrict__ src, int ld, u16* __restrict__ dst, int K, int n0,
                                          int k0, Map map, float* tile) {
  const int tid = TIDX;
  const int nn = tid & 63, kr = tid >> 6;
  const int sc = map(n0 + nn);
#pragma unroll
  for (int ps = 0; ps < 8; ps++) {
    int kk = ps * 8 + kr;
    float v = sc >= 0 ? src[(size_t)(k0 + kk) * ld + sc] : 0.f;
    tile[kk * 65 + nn] = v;
  }
  __syncthreads();
  const int n2 = tid >> 3, kc = tid & 7;
  uint4 o;
  o.x = pack2(tile[(kc * 8 + 0) * 65 + n2], tile[(kc * 8 + 1) * 65 + n2]);
  o.y = pack2(tile[(kc * 8 + 2) * 65 + n2], tile[(kc * 8 + 3) * 65 + n2]);
  o.z = pack2(tile[(kc * 8 + 4) * 65 + n2], tile[(kc * 8 + 5) * 65 + n2]);
  o.w = pack2(tile[(kc * 8 + 6) * 65 + n2], tile[(kc * 8 + 7) * 65 + n2]);
  *(uint4*)(dst + (size_t)(n0 + n2) * K + k0 + kc * 8) = o;
  __syncthreads();
}

__device__ __forceinline__ void phase_init0(const Params& p, float* sm) {
  const int tid = TIDX;
  if (blockIdx.x == 0 && tid < 64) ((unsigned*)(p.ws + OFF_CTR))[tid] = 0u;
  constexpr int NMOD = 192, NCONV = 4480 * 2;
  for (int it = blockIdx.x; it < NMOD + NCONV; it += gridDim.x) {
    if (it < NMOD) {
      int l = it / 96, rem = it - l * 96, cc = rem >> 3, ks = rem & 7;
      for (int i = tid; i < 9 * 128; i += NTHR) {
        int r = i >> 7, k = i & 127;
        float v = r < 8 ? p.c[r * DM + ks * 128 + k] : p.c_ctx[ks * 128 + k];
        sm[i] = siluf(v);
      }
      __syncthreads();
      const int n = cc * 512 + tid;
      const float* w = p.ada_w + ((size_t)l * DM + ks * 128) * 6144 + n;
      float acc[9];
#pragma unroll
      for (int r = 0; r < 9; r++) acc[r] = 0.f;
#pragma unroll 4
      for (int k = 0; k < 128; k++) {
        float wv = w[(size_t)k * 6144];
#pragma unroll
        for (int r = 0; r < 9; r++) acc[r] += sm[r * 128 + k] * wv;
      }
      float* mp = (float*)(p.ws + OFF_MODP) + ((size_t)(l * 8 + ks) * 9) * 6144 + n;
#pragma unroll
      for (int r = 0; r < 9; r++) mp[(size_t)r * 6144] = acc[r];
      __syncthreads();
    } else {
      int ci = it - NMOD;
      int l = ci / 4480, rem = ci - l * 4480;
      u16* wl = (u16*)(p.ws + OFF_W + (size_t)l * SZ_WL);
      if (rem < 832) {
        int nt = rem >> 4, kt = rem & 15;
        conv_tile(p.w_in + (size_t)l * DM * INW, INW, (u16*)((char*)wl + OW_IN), 1024, nt * 64, kt * 64, MapId{3312, 0}, sm);
      } else if (rem < 832 + 1024) {
        rem -= 832;
        int nt = rem >> 4, kt = rem & 15;
        conv_tile(p.w_in + (size_t)l * DM * INW, INW, (u16*)((char*)wl + OW_G), 1024, nt * 64, kt * 64, MapId{4096, 3312}, sm);
      } else if (rem < 1856 + 256) {
        rem -= 1856;
        int br = rem >> 6, r2 = rem & 63, nt = r2 >> 2, kt = r2 & 3;
        conv_tile(p.w_branch + ((size_t)(l * 4 + br)) * 256 * DM, DM, (u16*)((char*)wl + OW_B) + (size_t)br * 1024 * 256, 256,
                  nt * 64, kt * 64, MapId{1024, 0}, sm);
      } else if (rem < 2112 + 256) {
        rem -= 2112;
        int nt = rem >> 4, kt = rem & 15;
        conv_tile(p.w_out + (size_t)l * DM * DM, DM, (u16*)((char*)wl + OW_O), 1024, nt * 64, kt * 64, MapId{1024, 0}, sm);
      } else if (rem < 2368 + 1408) {
        rem -= 2368;
        int nt = rem >> 4, kt = rem & 15;
        conv_tile(p.ffn_w1 + (size_t)l * DM * 5632, 5632, (u16*)((char*)wl + OW_1), 1024, nt * 64, kt * 64, MapW1{}, sm);
      } else {
        rem -= 3776;
        int nt = rem / 44, kt = rem - nt * 44;
        conv_tile(p.ffn_w2 + (size_t)l * FH * DM, DM, (u16*)((char*)wl + OW_2), FH, nt * 64, kt * 64, MapId{1024, 0}, sm);
      }
    }
  }
}

__device__ __forceinline__ void phase_init1(const Params& p) {
  const float* mp = (const float*)(p.ws + OFF_MODP);
  float* mo = (float*)(p.ws + OFF_MOD);
  for (int i = blockIdx.x * NTHR + TIDX; i < 2 * 9 * 6144; i += gridDim.x * NTHR) {
    int l = i / (9 * 6144), rem = i - l * 9 * 6144, r = rem / 6144, n = rem - r * 6144;
    float s = p.ada_b[l * 6144 + n];
#pragma unroll
    for (int ks = 0; ks < 8; ks++) s += mp[((size_t)((l * 8 + ks) * 9 + r)) * 6144 + n];
    mo[i] = s;
  }
}

__device__ __forceinline__ void rowpass(const Params& p, int l, int mode) {
  const int lane = TIDX & 63, wv = TIDX >> 6;
  const float* MOD = (const float*)(p.ws + OFF_MOD);
  u16* H = (u16*)(p.ws + OFF_H);
  const bool do_norm = !(mode == 2 && l == 1);
  const int ln = (mode == 2) ? (l == 1 ? l : l + 1) : l;
  const int ni = (mode == 1) ? 2 : 0, sho = (mode == 1) ? 3072 : 0, sco = (mode == 1) ? 4096 : 1024;
  for (int r = blockIdx.x * 8 + wv; r < NROWS; r += gridDim.x * 8) {
    const int mr = mod_row(r);
    const float* modl = MOD + ((size_t)(l * 9 + mr)) * 6144;
    const float* modn = MOD + ((size_t)(ln * 9 + mr)) * 6144;
    const float* ng2 = p.norm_g + (size_t)(ln * 4 + ni) * DM;
    const float* xs = (mode == 0 || (mode == 1 && l == 0)) ? xin_row(p, r) : (const float*)x_row(p, r);
    float4 xo[4], n2[4], sc4[4], sh4[4];
#pragma unroll
    for (int i = 0; i < 4; i++) {
      const int col = i * 256 + lane * 4;
      xo[i] = *(const float4*)(xs + col);
      n2[i] = *(const float4*)(ng2 + col);
      sc4[i] = *(const float4*)(modn + sco + col);
      sh4[i] = *(const float4*)(modn + sho + col);
    }
    float xv[16];
    if (mode == 0) {
#pragma unroll
      for (int i = 0; i < 4; i++) { xv[i * 4 + 0] = xo[i].x; xv[i * 4 + 1] = xo[i].y; xv[i * 4 + 2] = xo[i].z; xv[i * 4 + 3] = xo[i].w; }
    } else {
      const u16* src = (const u16*)(p.ws + (mode == 1 ? OFF_BIG : OFF_YS)) + (size_t)r * DM;
      const float* ng = p.norm_g + (size_t)(l * 4 + (mode == 1 ? 1 : 3)) * DM;
      const float* gt = modl + (mode == 1 ? 2048 : 5120);
      uint2 sv[4];
      float4 g4[4], n4[4];
#pragma unroll
      for (int i = 0; i < 4; i++) {
        const int col = i * 256 + lane * 4;
        sv[i] = *(const uint2*)(src + col);
        g4[i] = *(const float4*)(gt + col);
        n4[i] = *(const float4*)(ng + col);
      }
      float ov[16];
      float ss = 0.f;
#pragma unroll
      for (int i = 0; i < 4; i++) {
        ov[i * 4 + 0] = __uint_as_float(sv[i].x << 16); ov[i * 4 + 1] = __uint_as_float(sv[i].x & 0xffff0000u);
        ov[i * 4 + 2] = __uint_as_float(sv[i].y << 16); ov[i * 4 + 3] = __uint_as_float(sv[i].y & 0xffff0000u);
      }
#pragma unroll
      for (int i = 0; i < 16; i++) ss += ov[i] * ov[i];
      ss = wsum(ss);
      const float inv = rsq(ss * (1.f / 1024.f) + 1e-6f);
      float* xd = x_row(p, r);
#pragma unroll
      for (int i = 0; i < 4; i++) {
        xv[i * 4 + 0] = xo[i].x + g4[i].x * (ov[i * 4 + 0] * inv * n4[i].x);
        xv[i * 4 + 1] = xo[i].y + g4[i].y * (ov[i * 4 + 1] * inv * n4[i].y);
        xv[i * 4 + 2] = xo[i].z + g4[i].z * (ov[i * 4 + 2] * inv * n4[i].z);
        xv[i * 4 + 3] = xo[i].w + g4[i].w * (ov[i * 4 + 3] * inv * n4[i].w);
      }
#pragma unroll
      for (int i = 0; i < 4; i++)
        *(float4*)(xd + i * 256 + lane * 4) = make_float4(xv[i * 4 + 0], xv[i * 4 + 1], xv[i * 4 + 2], xv[i * 4 + 3]);
    }
    if (!do_norm) continue;
    float ss2 = 0.f;
#pragma unroll
    for (int i = 0; i < 16; i++) ss2 += xv[i] * xv[i];
    ss2 = wsum(ss2);
    const float inv2 = rsq(ss2 * (1.f / 1024.f) + 1e-6f);
#pragma unroll
    for (int i = 0; i < 4; i++) {
      const int col = i * 256 + lane * 4;
      float h0 = xv[i * 4 + 0] * inv2 * n2[i].x * (1.f + sc4[i].x) + sh4[i].x;
      float h1 = xv[i * 4 + 1] * inv2 * n2[i].y * (1.f + sc4[i].y) + sh4[i].y;
      float h2 = xv[i * 4 + 2] * inv2 * n2[i].z * (1.f + sc4[i].z) + sh4[i].z;
      float h3 = xv[i * 4 + 3] * inv2 * n2[i].w * (1.f + sc4[i].w) + sh4[i].w;
      uint2 o;
      o.x = pack2(h0, h1);
      o.y = pack2(h2, h3);
      *(uint2*)(H + (size_t)r * DM + col) = o;
    }
  }
}

#define LDT 72
namespace pg8 {
#define PG8_LAS __attribute__((address_space(3)))
typedef unsigned short bf16_t;
typedef short bf16x8 __attribute__((ext_vector_type(8)));
typedef float f32x4 __attribute__((ext_vector_type(4)));
typedef unsigned u32x4 __attribute__((ext_vector_type(4)));
constexpr int BM = 256, BK = 64, HALF = 128, HTB = HALF * BK * 2  , STAGE_BYTES = 8 * HTB, NXCD = 8, WGM = 8;

__host__ __device__ __forceinline__ int lds_byte(int r, int c) { const int st = (r >> 4) * 2 + (c >> 5), rr = r & 15, cc = c & 31, ob = rr * 64 + cc * 2; return st * 1024 + (ob ^ (((ob >> 9) & 1) << 5)); }
__host__ __device__ __forceinline__ void stage_rc(int b, int& R, int& C) { const int st = b / 1024, sb = b % 1024, swz = sb ^ (((sb >> 9) & 1) << 5); R = (st >> 1) * 16 + swz / 64; C = (st & 1) * 32 + (swz % 64) / 2; }
__host__ __device__ __forceinline__ int perm32(int rho) { const int n = rho >> 4, i = rho & 15; return 8 * (i >> 2) + 4 * n + (i & 3); }

struct Unit { int pm, pn; };
struct Gemm { const bf16_t* A; const bf16_t* Bt; int M, N, K, lda; };
struct StaticOrder {
    int nM, nN, nwg, G, c;
    __host__ __device__ void init(int M, int N, int G_, int c_) { nM = M / BM; nN = N / BM; nwg = nM * nN; G = G_; c = c_; }
    __host__ __device__ bool next(int i, Unit& u) const {
        const long L = (long)i * G + c; if (L >= nwg) return false;
        int wgid = (int)L; { const int q = nwg / NXCD, r = nwg % NXCD, xcd = wgid % NXCD, off = wgid / NXCD; wgid = (xcd < r ? xcd * (q + 1) : r * (q + 1) + (xcd - r) * q) + off; }
        const int nig = WGM * nN, gid = wgid / nig, fm = gid * WGM, gsz = (nM - fm) < WGM ? (nM - fm) : WGM;
        u.pm = fm + ((wgid % nig) % gsz); u.pn = (wgid % nig) / gsz; return true;
    }
    __device__ __forceinline__ void a_ready(const Unit&) const {}
    __device__ __forceinline__ void done(const Unit&) const {}
};
__device__ __forceinline__ unsigned cvt_pk_bf16(float lo, float hi) { unsigned r; asm volatile("v_cvt_pk_bf16_f32 %0, %1, %2" : "=v"(r) : "v"(lo), "v"(hi)); return r; }
template <class Epi, class Sched, bool STAMP = false>
__device__ __forceinline__ void gemm_phase(PG8_LAS unsigned char* lds, const Gemm g, const Sched& S, const Epi& E, unsigned long long* stamps) {
    const int tid = TIDX, wid = __builtin_amdgcn_readfirstlane(tid >> 6), lane = tid & 63, wr = wid >> 2, wc = wid & 3, fr = lane & 15, fq = lane >> 4;
    const int K = g.K, nt = K / BK;
    int ts_lo = 0, ts_hi = 0, nts = 0; const unsigned long long rt_entry = STAMP ? (unsigned long long)wall_clock64() : 0ull;
#define PG8_STAMP() do { if (STAMP && wid == 0 && nts < 64) { const unsigned long long _c = (unsigned long long)clock64(); \
        ts_lo = (lane == nts) ? (int)(unsigned)_c : ts_lo; ts_hi = (lane == nts) ? (int)(unsigned)(_c >> 32) : ts_hi; ++nts; } } while (0)
    PG8_STAMP();
    unsigned voffA[2], voffB[2];
#pragma unroll
    for (int i = 0; i < 2; ++i) { int R, C; stage_rc(tid * 16 + i * 8192, R, C); const int Rb = Epi::PERM ? ((R & ~31) + perm32(R & 31)) : R;
        voffA[i] = (unsigned)(R * g.lda + C) * 2u; voffB[i] = (unsigned)(Rb * K + C) * 2u; }
    const size_t kstep = (size_t)(BK * 2);
    const size_t hstepB = (size_t)HALF * K * 2, hstepA = (size_t)HALF * g.lda * 2;
    const size_t tstepB = 2 * hstepB, tstepA = 2 * hstepA;
    const unsigned ldsw = (unsigned)wid * 1024u;
    const int aoff = lds_byte(wr * 64 + fr, fq * 8), boff = lds_byte(wc * 32 + fr, fq * 8);
#define PG8_SA(b, h) (((b) * 2 + (h)) * HTB)
#define PG8_SB(b, h) ((4 + (b) * 2 + (h)) * HTB)
#define PG8_STAGE(bufoff, gbase, voff) do { _Pragma("unroll") for (int _i = 0; _i < 2; ++_i) \
        __builtin_amdgcn_global_load_lds((const unsigned*)((const char*)(gbase) + (voff)[_i]), (PG8_LAS unsigned*)(lds + (bufoff) + ldsw + _i * 8192), 16, 0, 0); } while (0)
#define PG8_LDA(dst, b, h) do { _Pragma("unroll") for (int m = 0; m < 4; ++m) _Pragma("unroll") for (int k = 0; k < 2; ++k) dst[m][k] = *(const PG8_LAS bf16x8*)(lds + PG8_SA(b, h) + aoff + m * 2048 + k * 1024); } while (0)
#define PG8_LDB(dst, b, h) do { _Pragma("unroll") for (int n = 0; n < 2; ++n) _Pragma("unroll") for (int k = 0; k < 2; ++k) dst[n][k] = *(const PG8_LAS bf16x8*)(lds + PG8_SB(b, h) + boff + n * 2048 + k * 1024); } while (0)
#define PG8_MMA(ai, bj, At, Bt) do { __builtin_amdgcn_s_setprio(1); _Pragma("unroll") for (int m = 0; m < 4; ++m) _Pragma("unroll") for (int n = 0; n < 2; ++n) _Pragma("unroll") for (int k = 0; k < 2; ++k) \
        acc[ai][bj][m][n] = __builtin_amdgcn_mfma_f32_16x16x32_bf16(Bt[n][k], At[m][k], acc[ai][bj][m][n], 0, 0, 0); __builtin_amdgcn_s_setprio(0); } while (0)
#define PG8_WAIT_V(n) asm volatile("s_waitcnt vmcnt(" #n ")" ::: "memory")
#define PG8_WAIT_L(n) asm volatile("s_waitcnt lgkmcnt(" #n ")" ::: "memory")
#define PG8_BAR __builtin_amdgcn_s_barrier()
#define PG8_SCHED __builtin_amdgcn_sched_barrier(0)
    Unit cur, nxt; int ui = 0;
    if (!S.next(0, cur)) return;
    f32x4 acc[2][2][4][2];
#pragma unroll
    for (int a = 0; a < 2; ++a)
#pragma unroll
        for (int b = 0; b < 2; ++b)
#pragma unroll
            for (int m = 0; m < 4; ++m)
#pragma unroll
                for (int n = 0; n < 2; ++n) acc[a][b][m][n] = (f32x4){0.f, 0.f, 0.f, 0.f};
    bf16x8 At[4][2], B0[2][2], B1[2][2];
    const char* cA = (const char*)g.A + (size_t)cur.pm * tstepA; const char* cB = (const char*)g.Bt + (size_t)cur.pn * tstepB;
    S.a_ready(cur);
    PG8_STAGE(PG8_SB(0, 0), cB, voffB); PG8_STAGE(PG8_SA(0, 0), cA, voffA); PG8_STAGE(PG8_SB(0, 1), cB + hstepB, voffB); PG8_STAGE(PG8_SA(0, 1), cA + hstepA, voffA);
    if (wr == 1) PG8_BAR;
    PG8_WAIT_V(4); PG8_BAR;
    PG8_STAGE(PG8_SB(1, 0), cB + kstep, voffB); PG8_STAGE(PG8_SA(1, 0), cA + kstep, voffA); PG8_STAGE(PG8_SB(1, 1), cB + hstepB + kstep, voffB);
    PG8_WAIT_V(6); PG8_BAR;
    PG8_STAMP();
    for (;;) {
        const bool has_next = S.next(ui + 1, nxt);
        const char* nA = has_next ? (const char*)g.A + (size_t)nxt.pm * tstepA : cA; const char* nB = has_next ? (const char*)g.Bt + (size_t)nxt.pn * tstepB : cB;
        for (int t = 0; t < nt; t += 2) {
            const bool last = (t == nt - 2);
            const char* a1 = cA + (size_t)(t + 1) * kstep;
            const char* a2 = last ? nA : cA + (size_t)(t + 2) * kstep; const char* b2 = last ? nB : cB + (size_t)(t + 2) * kstep;
            const char* a3 = a2 + kstep; const char* b3 = b2 + kstep;
            if (last && has_next) S.a_ready(nxt);
            PG8_LDB(B0, 0, 0); PG8_SCHED; PG8_LDA(At, 0, 0); PG8_STAGE(PG8_SA(1, 1), a1 + hstepA, voffA);
            PG8_WAIT_L(8); PG8_BAR; PG8_WAIT_L(0); PG8_MMA(0, 0, At, B0); PG8_BAR; PG8_SCHED;
            PG8_LDB(B1, 0, 1); PG8_STAGE(PG8_SB(0, 0), b2, voffB);
            PG8_BAR; PG8_WAIT_L(0); PG8_MMA(0, 1, At, B1); PG8_BAR;
            PG8_LDA(At, 0, 1); PG8_STAGE(PG8_SA(0, 0), a2, voffA);
            PG8_BAR; PG8_WAIT_L(0); PG8_MMA(1, 0, At, B0); PG8_BAR; PG8_SCHED;
            PG8_STAGE(PG8_SB(0, 1), b2 + hstepB, voffB);
            PG8_WAIT_V(6); PG8_BAR; PG8_MMA(1, 1, At, B1); PG8_BAR;
            PG8_LDB(B0, 1, 0); PG8_SCHED; PG8_LDA(At, 1, 0); PG8_STAGE(PG8_SA(0, 1), a2 + hstepA, voffA);
            PG8_WAIT_L(8); PG8_BAR; PG8_WAIT_L(0); PG8_MMA(0, 0, At, B0); PG8_BAR; PG8_SCHED;
            PG8_LDB(B1, 1, 1); PG8_STAGE(PG8_SB(1, 0), b3, voffB);
            PG8_BAR; PG8_WAIT_L(0); PG8_MMA(0, 1, At, B1); PG8_BAR;
            PG8_LDA(At, 1, 1); PG8_STAGE(PG8_SA(1, 0), a3, voffA);
            PG8_BAR; PG8_WAIT_L(0); PG8_MMA(1, 0, At, B0); PG8_BAR; PG8_SCHED;
            PG8_STAGE(PG8_SB(1, 1), b3 + hstepB, voffB);
            PG8_WAIT_V(6); PG8_BAR; PG8_MMA(1, 1, At, B1); PG8_BAR;
        }
        PG8_STAMP();
        if constexpr (!Epi::AFTER_DRAIN) { E(acc, cur, wr, wc, fr, fq); S.done(cur); }
        PG8_STAMP();
        if (!has_next) break;
#pragma unroll
        for (int a = 0; a < 2; ++a)
#pragma unroll
            for (int b = 0; b < 2; ++b)
#pragma unroll
                for (int m = 0; m < 4; ++m)
#pragma unroll
                    for (int n = 0; n < 2; ++n) acc[a][b][m][n] = (f32x4){0.f, 0.f, 0.f, 0.f};
        cur = nxt; cA = nA; cB = nB; ++ui;
    }
    PG8_WAIT_V(0);
    if (wr == 0) PG8_BAR;
    PG8_BAR;
    if constexpr (Epi::AFTER_DRAIN) { E.fused(acc, cur, wr, wc, fr, fq, lds, wid, lane); S.done(cur); }
    PG8_STAMP();
    if (STAMP && wid == 0) { stamps[lane] = lane < nts ? (((unsigned long long)(unsigned)ts_hi << 32) | (unsigned)ts_lo) : 0ull;
        if (lane == 62) stamps[62] = rt_entry; if (lane == 63) stamps[63] = (unsigned long long)wall_clock64(); }
#undef PG8_STAMP
#undef PG8_SA
#undef PG8_SB
#undef PG8_STAGE
#undef PG8_LDA
#undef PG8_LDB
#undef PG8_MMA
#undef PG8_WAIT_V
#undef PG8_WAIT_L
#undef PG8_BAR
#undef PG8_SCHED
}
}

struct EpiBf {
  static constexpr bool PERM = true, AFTER_DRAIN = false;
  u16* O; int ldc; const float* bias; int act;
  __device__ __forceinline__ void operator()(const f32x4 (&acc)[2][2][4][2], const pg8::Unit& u, int wr, int wc, int fr, int fq) const {
    const int row0 = u.pm * 256 + wr * 64 + fr, col0 = u.pn * 256 + wc * 32 + 8 * fq;
    f32x4 bv[2][2];
#pragma unroll
    for (int bj = 0; bj < 2; ++bj)
#pragma unroll
      for (int n = 0; n < 2; ++n) bv[bj][n] = bias ? *(const f32x4*)(bias + col0 + bj * 128 + 4 * n) : f32x4{0.f, 0.f, 0.f, 0.f};
#pragma unroll
    for (int ai = 0; ai < 2; ++ai)
#pragma unroll
      for (int m = 0; m < 4; ++m) {
        u16* rowp = O + (size_t)(row0 + ai * 128 + m * 16) * ldc + col0;
#pragma unroll
        for (int bj = 0; bj < 2; ++bj) {
          f32x4 v0 = acc[ai][bj][m][0] + bv[bj][0], v1 = acc[ai][bj][m][1] + bv[bj][1];
          if (act == 1) {
#pragma unroll
            for (int j = 0; j < 4; ++j) { v0[j] = sigm(v0[j]); v1[j] = sigm(v1[j]); }
          }
          uint4 wv;
          wv.x = pack2(v0[0], v0[1]); wv.y = pack2(v0[2], v0[3]); wv.z = pack2(v1[0], v1[1]); wv.w = pack2(v1[2], v1[3]);
          *(uint4*)(rowp + bj * 128) = wv;
        }
      }
  }
};
struct EpiSwiglu {
  static constexpr bool PERM = true, AFTER_DRAIN = false;
  u16* O;
  __device__ __forceinline__ void operator()(const f32x4 (&acc)[2][2][4][2], const pg8::Unit& u, int wr, int wc, int fr, int fq) const {
    const int row0 = u.pm * 256 + wr * 64 + fr, col0 = u.pn * 128 + wc * 16 + 4 * fq;
#pragma unroll
    for (int ai = 0; ai < 2; ++ai)
#pragma unroll
      for (int m = 0; m < 4; ++m) {
        u16* rowp = O + (size_t)(row0 + ai * 128 + m * 16) * FH + col0;
#pragma unroll
        for (int bj = 0; bj < 2; ++bj) {
          const f32x4 g = acc[ai][bj][m][0], up = acc[ai][bj][m][1];
          uint2 wv;
          wv.x = pack2(siluf(g[0]) * up[0], siluf(g[1]) * up[1]);
          wv.y = pack2(siluf(g[2]) * up[2], siluf(g[3]) * up[3]);
          *(uint2*)(rowp + bj * 64) = wv;
        }
      }
  }
};
template <int MI>
__device__ __forceinline__ void gemm_loop(const u16* __restrict__ A, int lda, const u16* __restrict__ Bt, int ldb, int K,
                                          f32x4 (&acc)[MI][4], u16* sA, u16* sB) {
  constexpr int BMT = MI * 64;
  const int tid = TIDX, lane = tid & 63, w = tid >> 6, wm = w >> 1, wn = w & 1, fr = lane & 15, fq = lane >> 4;
  uint4 ra[MI], rb[2];
  const u16* ga = A + (size_t)(tid >> 3) * lda + (tid & 7) * 8;
  const u16* gb = Bt + (size_t)(tid >> 3) * ldb + (tid & 7) * 8;
  const int so = (tid >> 3) * LDT + (tid & 7) * 8;
#pragma unroll
  for (int i = 0; i < MI; i++) ra[i] = *(const uint4*)(ga + (size_t)(i * 64) * lda);
#pragma unroll
  for (int i = 0; i < 2; i++) rb[i] = *(const uint4*)(gb + (size_t)(i * 64) * ldb);
#pragma unroll
  for (int i = 0; i < MI; i++) *(uint4*)(sA + so + i * 64 * LDT) = ra[i];
#pragma unroll
  for (int i = 0; i < 2; i++) *(uint4*)(sB + so + i * 64 * LDT) = rb[i];
  __syncthreads();
  const int nk = K >> 6;
  for (int kt = 0; kt < nk; kt++) {
    const bool more = kt + 1 < nk;
    if (more) {
#pragma unroll
      for (int i = 0; i < MI; i++) ra[i] = *(const uint4*)(ga + (size_t)(i * 64) * lda + (kt + 1) * 64);
#pragma unroll
      for (int i = 0; i < 2; i++) rb[i] = *(const uint4*)(gb + (size_t)(i * 64) * ldb + (kt + 1) * 64);
    }
    const u16* a = sA + (kt & 1) * BMT * LDT + (wm * (MI * 16) + fr) * LDT + fq * 8;
    const u16* b = sB + (kt & 1) * 128 * LDT + (wn * 64 + fr) * LDT + fq * 8;
#pragma unroll
    for (int ks = 0; ks < 2; ks++) {
      bf16x8 af[MI], bfr[4];
#pragma unroll
      for (int i = 0; i < MI; i++) af[i] = *(const bf16x8*)(a + i * 16 * LDT + ks * 32);
#pragma unroll
      for (int j = 0; j < 4; j++) bfr[j] = *(const bf16x8*)(b + j * 16 * LDT + ks * 32);
#pragma unroll
      for (int i = 0; i < MI; i++)
#pragma unroll
        for (int j = 0; j < 4; j++) acc[i][j] = __builtin_amdgcn_mfma_f32_16x16x32_bf16(bfr[j], af[i], acc[i][j], 0, 0, 0);
    }
    if (more) {
      u16* da = sA + ((kt + 1) & 1) * BMT * LDT + so;
      u16* db = sB + ((kt + 1) & 1) * 128 * LDT + so;
#pragma unroll
      for (int i = 0; i < MI; i++) *(uint4*)(da + i * 64 * LDT) = ra[i];
#pragma unroll
      for (int i = 0; i < 2; i++) *(uint4*)(db + i * 64 * LDT) = rb[i];
    }
    __syncthreads();
  }
}

template <int MI>
__device__ __forceinline__ void zero_acc(f32x4 (&acc)[MI][4]) {
#pragma unroll
  for (int i = 0; i < MI; i++)
#pragma unroll
    for (int j = 0; j < 4; j++) acc[i][j] = f32x4{0.f, 0.f, 0.f, 0.f};
}


__device__ __forceinline__ void phase_ypart(const Params& p, int l, int hf, unsigned char* smem) {
  u16* sA = (u16*)smem;
  u16* sB = sA + 2 * 256 * LDT;
  const int lane = TIDX & 63, w = TIDX >> 6, wm = w >> 1, wn = w & 1, fr = lane & 15, fq = lane >> 4;
  const u16* Y = (const u16*)(p.ws + OFF_YS);
  const u16* Wb = (const u16*)(p.ws + OFF_W + (size_t)l * SZ_WL + OW_B);
  const u16* G = (const u16*)(p.ws + OFF_BIG);
  u16* ACC = (u16*)(p.ws + OFF_BIG + 2 * SZ_ACT);
  constexpr int NT = 8;
  const int ntiles = (NROWS / 128) * NT;
  for (int t = blockIdx.x; t < ntiles; t += gridDim.x) {
    const int mt = t / NT, nt = t - mt * NT;
    f32x4 tot[2][4];
    zero_acc<2>(tot);
    const int r0 = mt * 128 + wm * 32 + fr, c0 = nt * 128 + wn * 64 + fq * 4;
#pragma unroll 1
    for (int k = 0; k < 2; k++) {
      const int br = hf * 2 + k;
      f32x4 ay[2][4];
      zero_acc<2>(ay);
      const int ycol = br < 3 ? br * 256 : 1536;
      gemm_loop<2>(Y + (size_t)mt * 128 * YST + ycol, YST, Wb + ((size_t)br * 1024 + nt * 128) * 256, 256, 256, ay, sA, sB);
      uint2 gv[2][4];
#pragma unroll
      for (int i = 0; i < 2; i++)
#pragma unroll
        for (int j = 0; j < 4; j++) gv[i][j] = *(const uint2*)(G + (size_t)(r0 + i * 16) * 2048 + k * 1024 + c0 + j * 16);
#pragma unroll
      for (int i = 0; i < 2; i++)
#pragma unroll
        for (int j = 0; j < 4; j++) {
          tot[i][j][0] += __uint_as_float(gv[i][j].x << 16) * ay[i][j][0];
          tot[i][j][1] += __uint_as_float(gv[i][j].x & 0xffff0000u) * ay[i][j][1];
          tot[i][j][2] += __uint_as_float(gv[i][j].y << 16) * ay[i][j][2];
          tot[i][j][3] += __uint_as_float(gv[i][j].y & 0xffff0000u) * ay[i][j][3];
        }
    }
    uint2 av[2][4];
#pragma unroll
    for (int i = 0; i < 2; i++)
#pragma unroll
      for (int j = 0; j < 4; j++) av[i][j] = *(const uint2*)(ACC + (size_t)(r0 + i * 16) * DM + c0 + j * 16);
    const unsigned amask = hf ? 0xffffffffu : 0u;
#pragma unroll
    for (int i = 0; i < 2; i++)
#pragma unroll
      for (int j = 0; j < 4; j++) {
        u16* ap = ACC + (size_t)(r0 + i * 16) * DM + c0 + j * 16;
        f32x4 v = tot[i][j];
        const unsigned ax = av[i][j].x & amask, ay_ = av[i][j].y & amask;
        v[0] += __uint_as_float(ax << 16); v[1] += __uint_as_float(ax & 0xffff0000u);
        v[2] += __uint_as_float(ay_ << 16); v[3] += __uint_as_float(ay_ & 0xffff0000u);
        uint2 ov;
        ov.x = pack2(v[0], v[1]); ov.y = pack2(v[2], v[3]);
        *(uint2*)ap = ov;
      }
  }
}

#define S2_BUF 10816
#define S2_D 0
#define S2_U 2048
#define S2_P 4096
#define S2_K 6144
#define S2_DQ 8192
#define S2_V 10240
#define S2_C1 10752
#define S2_C2 10784
#define S2_ST (2 * S2_BUF)
#define S2_YB (S2_ST + 8192)

__device__ __forceinline__ float red16(float x) {
  x += dppf<0xB1>(x);
  x += dppf<0x4E>(x);
  x += dppf<0x141>(x);
  x += dppf<0x140>(x);
  return x;
}
__device__ __forceinline__ void wave_lds_sync() {
  asm volatile("s_waitcnt lgkmcnt(0)" ::: "memory");
  __builtin_amdgcn_wave_barrier();
}

template <int MIX>
__device__ __forceinline__ void scan2_item(const Params& p, int l, int b, int h, int dir, int rq, float* sm) {
  constexpr int EPL = (MIX == 2) ? 2 : 4;
  constexpr int VOFF = (MIX == 2) ? 64 : 128;
  const int tid = TIDX, lane = tid & 63, w = tid >> 6, fr = lane & 15, fq = lane >> 4;
  const bool producer = w >= 4;
  const int pw = w & 3;
  const u16* P = (const u16*)(p.ws + OFF_BIG);
  u16* YS = (u16*)(p.ws + OFF_YS);
  float* BC = (float*)(p.ws + OFF_BC);
  float* ST = sm + S2_ST + pw * 2048;
  float s[EPL];
#pragma unroll
  for (int i = 0; i < EPL; i++) s[i] = 0.f;

  bf16x8 bw2[4], ba2[4];
  float cst[5][4];
  float cw[3][7];
  float muv[4];
  int colv[4];
#pragma unroll
  for (int i = 0; i < 4; i++) { bw2[i] = bf16x8{0, 0, 0, 0, 0, 0, 0, 0}; ba2[i] = bw2[i]; muv[i] = 0.f; colv[i] = 0; }
  if (producer) {
    if (MIX == 0) {
#pragma unroll
      for (int nt = 0; nt < 4; nt++) {
        const int jch = h * 64 + nt * 16 + fr;
#pragma unroll
        for (int jj = 0; jj < 8; jj++) {
          bw2[nt][jj] = (short)f2bf(p.rwkv_w2[((size_t)(l * 2 + dir) * 32 + fq * 8 + jj) * 256 + jch]);
          ba2[nt][jj] = (short)f2bf(p.rwkv_a2[((size_t)(l * 2 + dir) * 32 + fq * 8 + jj) * 256 + jch]);
        }
        cst[0][nt] = p.rwkv_w0[(l * 2 + dir) * 256 + jch];
        cst[1][nt] = p.rwkv_a0[(l * 2 + dir) * 256 + jch];
        cst[2][nt] = p.rwkv_ka[l * 256 + jch];
        cst[3][nt] = p.rwkv_kk[l * 256 + jch];
        cst[4][nt] = p.rwkv_rk[l * 256 + jch];
      }
#pragma unroll
      for (int i = 0; i < 4; i++) {
        const int c = lane + 64 * i;
        colv[i] = i < 3 ? i * 256 + h * 64 + lane : (lane < 32 ? 768 + dir * 32 + lane : 832 + dir * 32 + (lane - 32));
        muv[i] = p.rwkv_mu[l * 960 + colv[i]];
        (void)c;
      }
    } else if (MIX == 1) {
#pragma unroll
      for (int i = 0; i < 3; i++) {
        colv[i] = PB + i * 256 + h * 64 + lane;
#pragma unroll
        for (int tp = 0; tp < 7; tp++) cw[i][tp] = p.gdn_conv[((size_t)l * 7 + tp) * 768 + i * 256 + h * 64 + lane];
      }
    } else {
#pragma unroll
      for (int nt = 0; nt < 2; nt++) {
#pragma unroll
        for (int jj = 0; jj < 8; jj++)
          bw2[nt][jj] = fq < 2 ? (short)f2bf(p.gla_gw2[((size_t)(l * 2 + dir) * 16 + fq * 8 + jj) * 128 + h * 32 + nt * 16 + fr]) : (short)0;
        cst[0][nt] = p.gla_gb[(l * 2 + dir) * 128 + h * 32 + nt * 16 + fr];
      }
      colv[0] = PC + h * 32 + lane;
      if (lane >= 32) colv[0] = PC + 128 + h * 32 + (lane - 32);
      colv[1] = PC + 256 + h * 64 + lane;
      colv[2] = PC + 512 + dir * 16 + (lane & 15);
    }
  }
  __syncthreads();

  for (int c = 0; c <= TPB / 32 + 1; c++) {
    if (producer) {
      if (c >= 2) {
        const int cc = c - 2;
        int seg_row0, t_lo;
        if (cc < 8) { seg_row0 = b * TPB; t_lo = dir == 0 ? cc * 32 : (LC - 32 - cc * 32); }
        else { seg_row0 = b * TPB + LC; t_lo = dir == 0 ? (cc - 8) * 32 : (SEQ - 32 - (cc - 8) * 32); }
        const float* yb = sm + S2_YB + (cc & 1) * 512;
        const int t2 = tid - 256;
#pragma unroll
        for (int i = 0; i < 2; i++) {
          const int idx = t2 + i * 256, tt = idx >> 4, e = idx & 15;
          YS[(size_t)(seg_row0 + t_lo + tt) * YST + dir * 768 + MIX * 256 + h * 64 + rq * 16 + e] = f2bf(yb[idx]);
        }
      }
      if (c < TPB / 32) {
        int seg_row0, seg_len, t_lo;
        if (c < 8) { seg_row0 = b * TPB; seg_len = LC; t_lo = dir == 0 ? c * 32 : (LC - 32 - c * 32); }
        else { seg_row0 = b * TPB + LC; seg_len = SEQ; t_lo = dir == 0 ? (c - 8) * 32 : (SEQ - 32 - (c - 8) * 32); }
        const u16* Pseg = P + (size_t)seg_row0 * PST;
        float* B = sm + (c & 1) * S2_BUF;
        const int t0 = t_lo + pw * 8;
        if (MIX == 0) {
          float raw[10][4];
#pragma unroll
          for (int rr = 0; rr < 10; rr++) {
            const int t = t0 - 1 + rr;
            const float okf = (t >= 0 && t < seg_len) ? 1.f : 0.f;
            const int tc = min(max(t, 0), seg_len - 1);
#pragma unroll
            for (int i = 0; i < 4; i++) raw[rr][i] = bf2f(Pseg[(size_t)tc * PST + PA + colv[i]]) * okf;
          }
#pragma unroll
          for (int j = 0; j < 8; j++)
#pragma unroll
            for (int i = 0; i < 4; i++) {
              float xm = raw[j + 1][i] + (0.5f * (raw[j][i] + raw[j + 2][i]) - raw[j + 1][i]) * muv[i];
              if (i == 3 && lane < 32) xm = tanhf(xm);
              ST[j * 256 + lane + 64 * i] = xm;
            }
        } else if (MIX == 1) {
          float raw[14][3];
#pragma unroll
          for (int rr = 0; rr < 14; rr++) {
            const int t = t0 - 3 + rr;
            const float okf = (t >= 0 && t < seg_len) ? 1.f : 0.f;
            const int tc = min(max(t, 0), seg_len - 1);
#pragma unroll
            for (int i = 0; i < 3; i++) raw[rr][i] = bf2f(Pseg[(size_t)tc * PST + colv[i]]) * okf;
          }
#pragma unroll
          for (int j = 0; j < 8; j++)
#pragma unroll
            for (int i = 0; i < 3; i++) {
              float a = 0.f;
#pragma unroll
              for (int tp = 0; tp < 7; tp++) a += raw[j + tp][i] * cw[i][tp];
              ST[j * 256 + lane + 64 * i] = siluf(a);
            }
          if (lane < 8) {
            const u16* pp = Pseg + (size_t)(t0 + lane) * PST + PB;
            float bx = bf2f(pp[768 + dir * 4 + h]);
            float ax = bf2f(pp[776 + dir * 4 + h]);
            float ld = -__expf(p.gdn_a_log[(l * 2 + dir) * 4 + h]) * softplusf(ax + p.gdn_dt_bias[(l * 2 + dir) * 4 + h]);
            ST[lane * 256 + 192] = sigm(bx);
            ST[lane * 256 + 193] = __expf(ld);
          }
        } else {
          u16 raw[8][3];
#pragma unroll
          for (int j = 0; j < 8; j++) {
            const u16* pp = Pseg + (size_t)(t0 + j) * PST;
#pragma unroll
            for (int i = 0; i < 3; i++) raw[j][i] = pp[colv[i]];
          }
          const float qs = lane < 32 ? 0.17677669529663687f : 1.f;
#pragma unroll
          for (int j = 0; j < 8; j++) {
            ST[j * 256 + lane] = bf2f(raw[j][0]) * qs;
            ST[j * 256 + 64 + lane] = bf2f(raw[j][1]);
            if (lane < 16) ST[j * 256 + 128 + lane] = bf2f(raw[j][2]);
          }
        }
        wave_lds_sync();
        const bool vl = fq < 2;
        if (MIX == 0) {
          bf16x8 aw, aa;
#pragma unroll
          for (int jj = 0; jj < 8; jj++) {
            aw[jj] = fr < 8 ? (short)f2bf(ST[fr * 256 + 192 + fq * 8 + jj]) : (short)0;
            aa[jj] = fr < 8 ? (short)f2bf(ST[fr * 256 + 224 + fq * 8 + jj]) : (short)0;
          }
          f32x4 accw[4], acca[4];
#pragma unroll
          for (int nt = 0; nt < 4; nt++) {
            accw[nt] = __builtin_amdgcn_mfma_f32_16x16x32_bf16(aw, bw2[nt], f32x4{0.f, 0.f, 0.f, 0.f}, 0, 0, 0);
            acca[nt] = __builtin_amdgcn_mfma_f32_16x16x32_bf16(aa, ba2[nt], f32x4{0.f, 0.f, 0.f, 0.f}, 0, 0, 0);
          }
#pragma unroll
          for (int r = 0; r < 4; r++) {
            const int j = (fq & 1) * 4 + r, tt = pw * 8 + j;
            float kkx[4], av[4], kdv[4], rv[4], dec[4];
            float ss = 0.f;
#pragma unroll
            for (int nt = 0; nt < 4; nt++) {
              const int n = nt * 16 + fr;
              rv[nt] = ST[j * 256 + n];
              const float kx = ST[j * 256 + 64 + n];
              dec[nt] = __expf(-0.6065306597126334f * sigm(cst[0][nt] + accw[nt][r]));
              av[nt] = sigm(cst[1][nt] + acca[nt][r]);
              kdv[nt] = kx * (1.f + (av[nt] - 1.f) * cst[2][nt]);
              kkx[nt] = kx * cst[3][nt];
              ss += kkx[nt] * kkx[nt];
            }
            ss = red16(ss);
            const float rs = rsq(ss + 1e-6f);
            float c1 = 0.f, c2 = 0.f, bc = 0.f;
#pragma unroll
            for (int nt = 0; nt < 4; nt++) {
              const int n = nt * 16 + fr;
              const float kk = kkx[nt] * rs;
              if (vl) {
                B[S2_D + tt * 64 + n] = dec[nt];
                B[S2_U + tt * 64 + n] = kk;
                B[S2_P + tt * 64 + n] = -kk * av[nt];
                B[S2_K + tt * 64 + n] = kdv[nt];
                B[S2_DQ + tt * 64 + n] = dec[nt] * rv[nt];
              }
              c1 += -kk * av[nt] * rv[nt];
              c2 += kdv[nt] * rv[nt];
              bc += rv[nt] * kdv[nt] * cst[4][nt];
            }
            c1 = red16(c1); c2 = red16(c2); bc = red16(bc);
            if (vl && fr == 0) {
              B[S2_C1 + tt] = c1;
              B[S2_C2 + tt] = c2;
              if (rq == 0) BC[(size_t)(seg_row0 + t_lo + tt) * 8 + h * 2 + dir] = bc;
            }
          }
        } else if (MIX == 1) {
#pragma unroll
          for (int r = 0; r < 4; r++) {
            const int j = (fq & 1) * 4 + r, tt = pw * 8 + j;
            float qv[4], kv[4];
            float sq = 0.f, sk = 0.f;
#pragma unroll
            for (int nt = 0; nt < 4; nt++) {
              const int n = nt * 16 + fr;
              qv[nt] = ST[j * 256 + n];
              kv[nt] = ST[j * 256 + 64 + n];
              sq += qv[nt] * qv[nt];
              sk += kv[nt] * kv[nt];
            }
            sq = red16(sq); sk = red16(sk);
            const float rq_ = rsq(sq + 1e-6f) * 0.125f, rk_ = rsq(sk + 1e-6f);
            const float beta = ST[j * 256 + 192], alpha = ST[j * 256 + 193];
            float dkq = 0.f;
#pragma unroll
            for (int nt = 0; nt < 4; nt++) {
              const int n = nt * 16 + fr;
              const float qn = qv[nt] * rq_, kn = kv[nt] * rk_;
              if (vl) {
                B[S2_D + tt * 64 + n] = alpha;
                B[S2_U + tt * 64 + n] = kn;
                B[S2_P + tt * 64 + n] = -alpha * beta * kn;
                B[S2_K + tt * 64 + n] = beta * kn;
                B[S2_DQ + tt * 64 + n] = alpha * qn;
              }
              dkq += kn * qn;
            }
            dkq = red16(dkq);
            if (vl && fr == 0) {
              B[S2_C1 + tt] = -alpha * beta * dkq;
              B[S2_C2 + tt] = beta * dkq;
            }
          }
        } else {
          bf16x8 ag;
#pragma unroll
          for (int jj = 0; jj < 8; jj++) ag[jj] = (fr < 8 && fq < 2) ? (short)f2bf(ST[fr * 256 + 128 + fq * 8 + jj]) : (short)0;
          f32x4 accg[2];
#pragma unroll
          for (int nt = 0; nt < 2; nt++) accg[nt] = __builtin_amdgcn_mfma_f32_16x16x32_bf16(ag, bw2[nt], f32x4{0.f, 0.f, 0.f, 0.f}, 0, 0, 0);
#pragma unroll
          for (int r = 0; r < 4; r++) {
            const int j = (fq & 1) * 4 + r, tt = pw * 8 + j;
            float dkq = 0.f;
#pragma unroll
            for (int nt = 0; nt < 2; nt++) {
              const int n = nt * 16 + fr;
              const float lg = cst[0][nt] + accg[nt][r];
              const float ls = fminf(lg, 0.f) - log1pf(__expf(-fabsf(lg)));
              const float alpha = __expf(ls * (1.f / 16.f));
              const float qv = ST[j * 256 + n], kv = ST[j * 256 + 32 + n];
              if (vl) {
                B[S2_D + tt * 64 + n] = alpha;
                B[S2_K + tt * 64 + n] = kv;
                B[S2_DQ + tt * 64 + n] = alpha * qv;
              }
              dkq += kv * qv;
            }
            dkq = red16(dkq);
            if (vl && fr == 0) B[S2_C2 + tt] = dkq;
          }
        }
#pragma unroll
        for (int i = 0; i < 2; i++) {
          const int idx = lane + 64 * i, j = idx >> 4, e = idx & 15;
          B[S2_V + (pw * 8 + j) * 16 + e] = ST[j * 256 + VOFF + rq * 16 + e];
        }
      }
    } else if (c >= 1 && c <= TPB / 32) {
      const float* B = sm + ((c - 1) & 1) * S2_BUF;
      float* yb = sm + S2_YB + ((c - 1) & 1) * 512;
      const int rl = w * 4 + fq;
      const int dtt = dir ? -1 : 1;
      int tt = dir ? 31 : 0;
      float dv[EPL], kv[EPL], qv[EPL], uv[EPL], pv[EPL], vv, c1v, c2v;
      float dn[EPL], kn[EPL], qn[EPL], un[EPL], pn[EPL], vn, c1n, c2n;
#define S2_LOAD(D_, K_, Q_, U_, P_, V_, C1_, C2_, T_)                                   \
  do {                                                                                  \
    const int o_ = (T_) * 64 + fr * EPL;                                                \
    if (EPL == 4) {                                                                     \
      float4 t4 = *(const float4*)(B + S2_D + o_);                                      \
      D_[0] = t4.x; D_[1] = t4.y; D_[2] = t4.z; D_[3] = t4.w;                           \
      t4 = *(const float4*)(B + S2_K + o_);                                             \
      K_[0] = t4.x; K_[1] = t4.y; K_[2] = t4.z; K_[3] = t4.w;                           \
      t4 = *(const float4*)(B + S2_DQ + o_);                                            \
      Q_[0] = t4.x; Q_[1] = t4.y; Q_[2] = t4.z; Q_[3] = t4.w;                           \
      t4 = *(const float4*)(B + S2_U + o_);                                             \
      U_[0] = t4.x; U_[1] = t4.y; U_[2] = t4.z; U_[3] = t4.w;                           \
      t4 = *(const float4*)(B + S2_P + o_);                                             \
      P_[0] = t4.x; P_[1] = t4.y; P_[2] = t4.z; P_[3] = t4.w;                           \
      C1_ = B[S2_C1 + (T_)];                                                            \
    } else {                                                                            \
      float2 t2 = *(const float2*)(B + S2_D + o_);                                      \
      D_[0] = t2.x; D_[1] = t2.y;                                                       \
      t2 = *(const float2*)(B + S2_K + o_);                                             \
      K_[0] = t2.x; K_[1] = t2.y;                                                       \
      t2 = *(const float2*)(B + S2_DQ + o_);                                            \
      Q_[0] = t2.x; Q_[1] = t2.y;                                                       \
      U_[0] = U_[1] = P_[0] = P_[1] = 0.f; C1_ = 0.f;                                   \
    }                                                                                   \
    V_ = B[S2_V + (T_) * 16 + rl];                                                      \
    C2_ = B[S2_C2 + (T_)];                                                              \
  } while (0)
#define S2_STEP(D_, K_, Q_, U_, P_, V_, C1_, C2_, T_)                                   \
  do {                                                                                  \
    float sq = 0.f, sa = 0.f;                                                           \
    _Pragma("unroll") for (int i = 0; i < EPL; i++) sq += s[i] * Q_[i];                 \
    if (MIX != 2) {                                                                     \
      _Pragma("unroll") for (int i = 0; i < EPL; i++) sa += s[i] * U_[i];               \
      sa = red16(sa);                                                                   \
    }                                                                                   \
    sq = red16(sq);                                                                     \
    float y = sq + V_ * C2_;                                                            \
    if (MIX != 2) y += sa * C1_;                                                        \
    _Pragma("unroll") for (int i = 0; i < EPL; i++) {                                   \
      float t = s[i] * D_[i] + V_ * K_[i];                                              \
      if (MIX != 2) t += sa * P_[i];                                                    \
      s[i] = t;                                                                         \
    }                                                                                   \
    yb[(T_) * 16 + rl] = y;                                                             \
  } while (0)
      S2_LOAD(dv, kv, qv, uv, pv, vv, c1v, c2v, tt);
#pragma unroll 1
      for (int st = 0; st < 32; st += 2) {
        const int t1 = tt + dtt;
        S2_LOAD(dn, kn, qn, un, pn, vn, c1n, c2n, t1);
        S2_STEP(dv, kv, qv, uv, pv, vv, c1v, c2v, tt);
        const int t2 = st + 2 < 32 ? t1 + dtt : t1;
        S2_LOAD(dv, kv, qv, uv, pv, vv, c1v, c2v, t2);
        S2_STEP(dn, kn, qn, un, pn, vn, c1n, c2n, t1);
        tt = t2;
      }
#undef S2_LOAD
#undef S2_STEP
    }
    __syncthreads();
  }
}

#define S3_SUB 12800
#define S3_GM 0
#define S3_KVT 9216
#define S3_QB 10240
#define S3_QV 11392
#define S3_VT 11520
#define S3_WC 12544
#define S3_STB (8 * S3_SUB)
#define S3_END (S3_STB + 4 * 2304)

__device__ __forceinline__ float rlane(float x, int l) { return __int_as_float(__builtin_amdgcn_readlane(__float_as_int(x), l)); }
__device__ __forceinline__ float wave_sum(float x) {
  x = red16(x);
  return (rlane(x, 0) + rlane(x, 16)) + (rlane(x, 32) + rlane(x, 48));
}
__device__ __forceinline__ float clampe(float x) { return fminf(fmaxf(x, -80.f), 80.f); }
__device__ __forceinline__ uint4 pack8(const float (&v)[8]) {
  return make_uint4(pack2(v[0], v[1]), pack2(v[2], v[3]), pack2(v[4], v[5]), pack2(v[6], v[7]));
}
__device__ __forceinline__ bf16x8 ld_frag(const void* p) { return *(const bf16x8*)p; }
__device__ __forceinline__ bf16x8 zfrag() { return bf16x8{0, 0, 0, 0, 0, 0, 0, 0}; }

__device__ __forceinline__ void chunk_geom(int c, int dir, int b, int& seg_row0, int& seg_len, int& t_lo) {
  if (c < 8) { seg_row0 = b * TPB; seg_len = LC; t_lo = dir == 0 ? c * 32 : (LC - 32 - c * 32); }
  else { seg_row0 = b * TPB + LC; seg_len = SEQ; t_lo = dir == 0 ? (c - 8) * 32 : (SEQ - 32 - (c - 8) * 32); }
}
template <int MIX>
__device__ __forceinline__ void fetch_raw(const u16* P, int c, int dir, int b, int h, int pw, int lane, const int (&colv)[4], unsigned (&rawq)[14][2]) {
  int seg_row0, seg_len, t_lo;
  chunk_geom(c, dir, b, seg_row0, seg_len, t_lo);
  const u16* Pseg = P + (size_t)seg_row0 * PST;
  const int t0 = t_lo + pw * 8;
  if (MIX == 0) {
#pragma unroll
    for (int rr = 0; rr < 10; rr++) {
      const int tc = min(max(t0 - 1 + rr, 0), seg_len - 1);
#pragma unroll
      for (int i = 0; i < 2; i++)
        rawq[rr][i] = (unsigned)Pseg[(size_t)tc * PST + PA + colv[2 * i]] | ((unsigned)Pseg[(size_t)tc * PST + PA + colv[2 * i + 1]] << 16);
    }
  } else if (MIX == 1) {
#pragma unroll
    for (int rr = 0; rr < 14; rr++) {
      const int tc = min(max(t0 - 3 + rr, 0), seg_len - 1);
      rawq[rr][0] = (unsigned)Pseg[(size_t)tc * PST + colv[0]] | ((unsigned)Pseg[(size_t)tc * PST + colv[1]] << 16);
      rawq[rr][1] = (rawq[rr][1] & 0xffff0000u) | (unsigned)Pseg[(size_t)tc * PST + colv[2]];
    }
    const u16* pp = Pseg + (size_t)(t0 + (lane & 7)) * PST + PB;
    rawq[0][1] = (rawq[0][1] & 0xffffu) | ((unsigned)pp[768 + dir * 4 + h] << 16);
    rawq[1][1] = (rawq[1][1] & 0xffffu) | ((unsigned)pp[776 + dir * 4 + h] << 16);
  } else {
#pragma unroll
    for (int j = 0; j < 8; j++) {
      const u16* pp = Pseg + (size_t)(t0 + j) * PST;
      rawq[j][0] = (unsigned)pp[colv[0]] | ((unsigned)pp[colv[1]] << 16);
      rawq[j][1] = (unsigned)pp[colv[2]];
    }
  }
}

template <int MIX>
__device__ __forceinline__ void scan3_item(const Params& p, int l, int b, int h, int dir, unsigned char* smb) {
  constexpr int VOFF = (MIX == 2) ? 64 : 128;
  constexpr bool DELTA = (MIX != 2);
  const int tid = TIDX, lane = tid & 63, w = tid >> 6, fr = lane & 15, fq = lane >> 4;
  const bool producer = true;
  const int pw = w & 3, half = w >> 2;
  const u16* P = (const u16*)(p.ws + OFF_BIG);
  u16* YS = (u16*)(p.ws + OFF_YS);
  float* BC = (float*)(p.ws + OFF_BC);
  float* ST = (float*)(smb + w * S3_SUB + S3_GM);
  unsigned char* STBY = smb + w * S3_SUB + S3_GM;
  const f32x4 z4 = f32x4{0.f, 0.f, 0.f, 0.f};
  f32x4 st[4];
#pragma unroll
  for (int i = 0; i < 4; i++) st[i] = z4;

  bf16x8 bw2[4], ba2[4];
  float cw[3][7];
  float muv[4];
  int colv[4];
  float c_w0 = 0.f, c_a0 = 0.f, c_ka = 0.f, c_kk = 0.f, c_rk = 0.f, c_gb = 0.f;
#pragma unroll
  for (int i = 0; i < 4; i++) { bw2[i] = zfrag(); ba2[i] = zfrag(); muv[i] = 0.f; colv[i] = 0; }
  if (producer) {
    if (MIX == 0) {
#pragma unroll
      for (int nt = 0; nt < 4; nt++) {
        const int jch = h * 64 + nt * 16 + fr;
#pragma unroll
        for (int jj = 0; jj < 8; jj++) {
          bw2[nt][jj] = (short)f2bf(p.rwkv_w2[((size_t)(l * 2 + dir) * 32 + fq * 8 + jj) * 256 + jch]);
          ba2[nt][jj] = (short)f2bf(p.rwkv_a2[((size_t)(l * 2 + dir) * 32 + fq * 8 + jj) * 256 + jch]);
        }
      }
      const int jl = h * 64 + lane;
      c_w0 = p.rwkv_w0[(l * 2 + dir) * 256 + jl];
      c_a0 = p.rwkv_a0[(l * 2 + dir) * 256 + jl];
      c_ka = p.rwkv_ka[l * 256 + jl];
      c_kk = p.rwkv_kk[l * 256 + jl];
      c_rk = p.rwkv_rk[l * 256 + jl];
#pragma unroll
      for (int i = 0; i < 4; i++) {
        colv[i] = i < 3 ? i * 256 + h * 64 + lane : (lane < 32 ? 768 + dir * 32 + lane : 832 + dir * 32 + (lane - 32));
        muv[i] = p.rwkv_mu[l * 960 + colv[i]];
      }
    } else if (MIX == 1) {
#pragma unroll
      for (int i = 0; i < 3; i++) {
        colv[i] = PB + i * 256 + h * 64 + lane;
#pragma unroll
        for (int tp = 0; tp < 7; tp++) cw[i][tp] = p.gdn_conv[((size_t)l * 7 + tp) * 768 + i * 256 + h * 64 + lane];
      }
    } else {
#pragma unroll
      for (int nt = 0; nt < 2; nt++) {
#pragma unroll
        for (int jj = 0; jj < 8; jj++)
          bw2[nt][jj] = fq < 2 ? (short)f2bf(p.gla_gw2[((size_t)(l * 2 + dir) * 16 + fq * 8 + jj) * 128 + h * 32 + nt * 16 + fr]) : (short)0;
      }
      c_gb = p.gla_gb[(l * 2 + dir) * 128 + h * 32 + (lane & 31)];
      colv[0] = PC + h * 32 + lane;
      if (lane >= 32) colv[0] = PC + 128 + h * 32 + (lane - 32);
      colv[1] = PC + 256 + h * 64 + lane;
      colv[2] = PC + 512 + dir * 16 + (lane & 15);
    }
  }
  __syncthreads();
  unsigned rawq[14][2];
#pragma unroll
  for (int i = 0; i < 14; i++) { rawq[i][0] = 0u; rawq[i][1] = 0u; }
  fetch_raw<MIX>(P, half, dir, b, h, pw, lane, colv, rawq);
#define RAWP(r_, i_) ((u16)((rawq[r_][(i_) >> 1] >> (((i_) & 1) * 16)) & 0xffffu))

  for (int it = 0; it < TPB / 64; it++) {
    {
      {
        const int c = it * 2 + half;
        int seg_row0, seg_len, t_lo;
        chunk_geom(c, dir, b, seg_row0, seg_len, t_lo);
        unsigned char* SB = smb + w * S3_SUB;
        const int t0 = t_lo + pw * 8;
        if (MIX == 0) {
          float raw[10][4];
#pragma unroll
          for (int rr = 0; rr < 10; rr++) {
            const int t = t0 - 1 + rr;
            const float okf = (t >= 0 && t < seg_len) ? 1.f : 0.f;
#pragma unroll
            for (int i = 0; i < 4; i++) raw[rr][i] = bf2f(RAWP(rr, i)) * okf;
          }
#pragma unroll
          for (int j = 0; j < 8; j++)
#pragma unroll
            for (int i = 0; i < 4; i++) {
              float xm = raw[j + 1][i] + (0.5f * (raw[j][i] + raw[j + 2][i]) - raw[j + 1][i]) * muv[i];
              if (i == 3 && lane < 32) xm = tanhf(xm);
              ST[j * 256 + lane + 64 * i] = xm;
            }
        } else if (MIX == 1) {
          float raw[14][3];
#pragma unroll
          for (int rr = 0; rr < 14; rr++) {
            const int t = t0 - 3 + rr;
            const float okf = (t >= 0 && t < seg_len) ? 1.f : 0.f;
#pragma unroll
            for (int i = 0; i < 3; i++) raw[rr][i] = bf2f(RAWP(rr, i)) * okf;
          }
#pragma unroll
          for (int j = 0; j < 8; j++)
#pragma unroll
            for (int i = 0; i < 3; i++) {
              float a = 0.f;
#pragma unroll
              for (int tp = 0; tp < 7; tp++) a += raw[j + tp][i] * cw[i][tp];
              ST[j * 256 + lane + 64 * i] = siluf(a);
            }
          if (lane < 8) {
            float bx = bf2f(RAWP(0, 3));
            float ax = bf2f(RAWP(1, 3));
            float ld = -__expf(p.gdn_a_log[(l * 2 + dir) * 4 + h]) * softplusf(ax + p.gdn_dt_bias[(l * 2 + dir) * 4 + h]);
            ST[lane * 256 + 192] = sigm(bx);
            ST[lane * 256 + 193] = ld;
          }
        } else {
          const float qs = lane < 32 ? 0.17677669529663687f : 1.f;
#pragma unroll
          for (int j = 0; j < 8; j++) {
            ST[j * 256 + lane] = bf2f(RAWP(j, 0)) * qs;
            ST[j * 256 + 64 + lane] = bf2f(RAWP(j, 1));
            if (lane < 16) ST[j * 256 + 128 + lane] = bf2f(RAWP(j, 2));
          }
        }
        wave_lds_sync();
        {
          float vv[8];
#pragma unroll
          for (int i = 0; i < 8; i++) vv[i] = ST[(dir ? 7 - i : i) * 256 + VOFF + lane];
          *(uint4*)(SB + S3_VT + lane * 16) = pack8(vv);
        }
        if (MIX == 0) {
          bf16x8 aw, aa;
#pragma unroll
          for (int jj = 0; jj < 8; jj++) {
            aw[jj] = fr < 8 ? (short)f2bf(ST[fr * 256 + 192 + fq * 8 + jj]) : (short)0;
            aa[jj] = fr < 8 ? (short)f2bf(ST[fr * 256 + 224 + fq * 8 + jj]) : (short)0;
          }
          f32x4 accw[4], acca[4];
#pragma unroll
          for (int nt = 0; nt < 4; nt++) {
            accw[nt] = __builtin_amdgcn_mfma_f32_16x16x32_bf16(aw, bw2[nt], z4, 0, 0, 0);
            acca[nt] = __builtin_amdgcn_mfma_f32_16x16x32_bf16(aa, ba2[nt], z4, 0, 0, 0);
          }
          wave_lds_sync();
          if (fq < 2) {
#pragma unroll
            for (int nt = 0; nt < 4; nt++)
#pragma unroll
              for (int r = 0; r < 4; r++) {
                ST[(fq * 4 + r) * 256 + 128 + nt * 16 + fr] = accw[nt][r];
                ST[(fq * 4 + r) * 256 + 192 + nt * 16 + fr] = acca[nt][r];
              }
          }
          wave_lds_sync();
        } else if (MIX == 2) {
          bf16x8 ag;
#pragma unroll
          for (int jj = 0; jj < 8; jj++) ag[jj] = (fr < 8 && fq < 2) ? (short)f2bf(ST[fr * 256 + 128 + fq * 8 + jj]) : (short)0;
          f32x4 accg[2];
#pragma unroll
          for (int nt = 0; nt < 2; nt++) accg[nt] = __builtin_amdgcn_mfma_f32_16x16x32_bf16(ag, bw2[nt], z4, 0, 0, 0);
          if (fq < 2) {
#pragma unroll
            for (int nt = 0; nt < 2; nt++)
#pragma unroll
              for (int r = 0; r < 4; r++) ST[(fq * 4 + r) * 256 + 192 + nt * 16 + fr] = accg[nt][r];
          }
          wave_lds_sync();
        }
        float logd[8], kap[8], bb[8], kp[8], qq[8];
#pragma unroll
        for (int i = 0; i < 8; i++) {
          const int j = dir ? 7 - i : i;
          const float* row = ST + j * 256;
          if (MIX == 0) {
            const float r_ = row[lane], k_ = row[64 + lane];
            const float sg = sigm(c_w0 + row[128 + lane]);
            const float a_ = sigm(c_a0 + row[192 + lane]);
            const float kd = k_ * (1.f + (a_ - 1.f) * c_ka);
            const float kkx = k_ * c_kk;
            const float ss = wave_sum(kkx * kkx);
            const float kk = kkx * rsq(ss + 1e-6f);
            const float bc = wave_sum(r_ * kd * c_rk);
            if (lane == 0) BC[(size_t)(seg_row0 + t0 + j) * 8 + h * 2 + dir] = bc;
            logd[i] = -0.6065306597126334f * sg;
            kap[i] = kk; bb[i] = kk * a_; kp[i] = kd; qq[i] = r_;
          } else if (MIX == 1) {
            const float q_ = row[lane], k_ = row[64 + lane];
            const float sq = wave_sum(q_ * q_), sk = wave_sum(k_ * k_);
            const float qn = q_ * rsq(sq + 1e-6f) * 0.125f, kn = k_ * rsq(sk + 1e-6f);
            const float beta = row[192], ld = row[193];
            const float alpha = __expf(ld);
            logd[i] = ld;
            kap[i] = kn; bb[i] = alpha * beta * kn; kp[i] = beta * kn; qq[i] = qn;
          } else {
            const int n = lane & 31;
            const float lg = c_gb + row[192 + n];
            const float ls = fminf(lg, 0.f) - log1pf(__expf(-fabsf(lg)));
            logd[i] = ls * (1.f / 16.f);
            kap[i] = 0.f; bb[i] = 0.f;
            kp[i] = lane < 32 ? row[32 + n] : 0.f;
            qq[i] = lane < 32 ? row[n] : 0.f;
          }
        }
        wave_lds_sync();
        float kt[8], qt[8], bck[8], kck[8];
        {
          float L[8];
          float run = 0.f;
#pragma unroll
          for (int i = 0; i < 8; i++) { run += logd[i]; L[i] = run; }
          const float Lr = L[3], L7 = L[7];
          float prevE = __expf(clampe(-Lr)), prevT = 1.f;
          u16* OPA = (u16*)STBY;
#pragma unroll
          for (int i = 0; i < 8; i++) {
            const float eI = __expf(clampe(L[i] - Lr)), eInv = __expf(clampe(Lr - L[i]));
            const float tI = __expf(L[i]), eEnd = __expf(L7 - L[i]);
            if (DELTA) {
              OPA[0 * 576 + i * 72 + lane] = f2bf(kap[i] * prevE);
              OPA[1 * 576 + i * 72 + lane] = f2bf(bb[i] * eInv);
            }
            OPA[2 * 576 + i * 72 + lane] = f2bf(kp[i] * eInv);
            OPA[3 * 576 + i * 72 + lane] = f2bf(qq[i] * eI);
            kt[i] = kap[i] * prevT; qt[i] = qq[i] * tI;
            bck[i] = bb[i] * eEnd; kck[i] = kp[i] * eEnd;
            prevE = eI; prevT = tI;
          }
          *(float*)(SB + S3_WC + lane * 4) = __expf(L7);
        }
        wave_lds_sync();
        f32x4 accA = z4, accBm = z4, accQb = z4, accQk = z4;
        {
          const u16* OPA = (const u16*)STBY;
          const int ro = (fr & 7) * 72 + fq * 8;
#pragma unroll
          for (int ks = 0; ks < 2; ks++) {
            const bf16x8 fk = ld_frag(OPA + 2 * 576 + ro + ks * 32), fqh = ld_frag(OPA + 3 * 576 + ro + ks * 32);
            accQk = __builtin_amdgcn_mfma_f32_16x16x32_bf16(fqh, fk, accQk, 0, 0, 0);
            if (DELTA) {
              const bf16x8 fka = ld_frag(OPA + 0 * 576 + ro + ks * 32), fb = ld_frag(OPA + 1 * 576 + ro + ks * 32);
              accA = __builtin_amdgcn_mfma_f32_16x16x32_bf16(fka, fb, accA, 0, 0, 0);
              accBm = __builtin_amdgcn_mfma_f32_16x16x32_bf16(fka, fk, accBm, 0, 0, 0);
              accQb = __builtin_amdgcn_mfma_f32_16x16x32_bf16(fqh, fb, accQb, 0, 0, 0);
            }
          }
#pragma unroll
          for (int r = 0; r < 4; r++) {
            const int i = fq * 4 + r;
            const bool ok = fq < 2 && fr < 8;
            if (!(ok && fr < i)) { accA[r] = 0.f; accBm[r] = 0.f; }
            if (!(ok && fr <= i)) { accQb[r] = 0.f; accQk[r] = 0.f; }
          }
        }
        float bmc[8], qkc[8];
#pragma unroll
        for (int m = 0; m < 4; m++) {
          bmc[m] = accBm[m]; qkc[m] = accQk[m];
          bmc[m + 4] = __shfl(accBm[m], (lane & 15) + 16);
          qkc[m + 4] = __shfl(accQk[m], (lane & 15) + 16);
        }
        float kbar[8], qbar[8], Kv[8], TB[8], Qv[8];
        if (DELTA) {
          float t[8];
#pragma unroll
          for (int i = 0; i < 8; i++) {
            float ti = (lane == i) ? 1.f : 0.f;
#pragma unroll
            for (int m = 0; m < i; m++) ti -= rlane(accA[i & 3], (i >> 2) * 16 + m) * t[m];
            t[i] = ti;
          }
#pragma unroll
          for (int i = 0; i < 8; i++) {
            float tb = 0.f, kb = 0.f;
#pragma unroll
            for (int m = 0; m <= i; m++) {
              const float tim = rlane(t[i], m);
              tb += tim * bmc[m];
              kb += tim * kt[m];
            }
            TB[i] = tb; kbar[i] = kb;
            float qv = qkc[i], qb = qt[i];
#pragma unroll
            for (int m = 0; m <= i; m++) {
              const float qbim = rlane(accQb[i & 3], (i >> 2) * 16 + m);
              qv -= qbim * TB[m];
              qb -= qbim * kbar[m];
            }
            Qv[i] = qv; qbar[i] = qb;
          }
#pragma unroll
          for (int j = 0; j < 8; j++) Kv[j] = kck[j];
#pragma unroll
          for (int i = 1; i < 8; i++)
#pragma unroll
            for (int j = 0; j < i; j++) Kv[j] -= rlane(TB[i], j) * bck[i];
        } else {
#pragma unroll
          for (int i = 0; i < 8; i++) { Qv[i] = qkc[i]; qbar[i] = qt[i]; Kv[i] = kck[i]; kbar[i] = 0.f; TB[i] = 0.f; }
        }
        *(uint4*)(SB + S3_KVT + lane * 16) = pack8(Kv);
#pragma unroll
        for (int i = 0; i < 8; i++) ((u16*)(SB + S3_QB))[i * 72 + lane] = f2bf(qbar[i]);
        if (lane < 8) {
#pragma unroll
          for (int i = 0; i < 8; i++) ((u16*)(SB + S3_QV))[i * 8 + lane] = f2bf(Qv[i]);
        }
        if (DELTA) {
          float nk[8];
#pragma unroll
          for (int i = 0; i < 8; i++) nk[i] = -kbar[i];
          *(uint4*)(STBY + 4608 + lane * 16) = pack8(bck);
          *(uint4*)(STBY + 5632 + lane * 16) = pack8(nk);
          wave_lds_sync();
          bf16x8 fa[4], fb[4];
#pragma unroll
          for (int x = 0; x < 4; x++) {
            fa[x] = fq == 0 ? ld_frag(STBY + 5632 + (x * 16 + fr) * 16) : zfrag();
            fb[x] = fq == 0 ? ld_frag(STBY + 4608 + (x * 16 + fr) * 16) : zfrag();
          }
#pragma unroll
          for (int nt = 0; nt < 4; nt++)
#pragma unroll
            for (int mt = 0; mt < 4; mt++) {
              const f32x4 g = __builtin_amdgcn_mfma_f32_16x16x32_bf16(fa[mt], fb[nt], z4, 0, 0, 0);
              uint2 gv;
              gv.x = pack2(g[0], g[1]); gv.y = pack2(g[2], g[3]);
              *(uint2*)(SB + S3_GM + ((nt * 16 + fr) * 72 + mt * 16 + fq * 4) * 2) = gv;
            }
        }
      }
    }
    fetch_raw<MIX>(P, min(it + 1, TPB / 64 - 1) * 2 + half, dir, b, h, pw, lane, colv, rawq);
    __syncthreads();
    if (w < 4) {
      unsigned char* STB = smb + S3_STB + w * 2304;
#pragma unroll 1
      for (int kk = 0; kk < 8; kk++) {
        const int cc = it * 2 + (kk >> 2), k = kk & 3;
        int seg_row0, t_lo;
        if (cc < 8) { seg_row0 = b * TPB; t_lo = dir == 0 ? cc * 32 : (LC - 32 - cc * 32); }
        else { seg_row0 = b * TPB + LC; t_lo = dir == 0 ? (cc - 8) * 32 : (SEQ - 32 - (cc - 8) * 32); }
        const int sc = dir ? 3 - k : k;
        const unsigned char* SB = smb + ((kk >> 2) * 4 + sc) * S3_SUB;
#pragma unroll
        for (int nt = 0; nt < 4; nt++) {
          uint2 sv;
          sv.x = pack2(st[nt][0], st[nt][1]); sv.y = pack2(st[nt][2], st[nt][3]);
          *(uint2*)(STB + (fr * 72 + nt * 16 + fq * 4) * 2) = sv;
        }
        wave_lds_sync();
        const bf16x8 bs0 = ld_frag(STB + (fr * 72 + fq * 8) * 2), bs1 = ld_frag(STB + (fr * 72 + 32 + fq * 8) * 2);
        const bf16x8 bv = fq == 0 ? ld_frag(SB + S3_VT + (w * 16 + fr) * 16) : zfrag();
        const bf16x8 aq0 = ld_frag(SB + S3_QB + ((fr & 7) * 72 + fq * 8) * 2), aq1 = ld_frag(SB + S3_QB + ((fr & 7) * 72 + 32 + fq * 8) * 2);
        const bf16x8 aqv = fq == 0 ? ld_frag(SB + S3_QV + (fr & 7) * 16) : zfrag();
        f32x4 accY = __builtin_amdgcn_mfma_f32_16x16x32_bf16(aq0, bs0, z4, 0, 0, 0);
        accY = __builtin_amdgcn_mfma_f32_16x16x32_bf16(aq1, bs1, accY, 0, 0, 0);
        accY = __builtin_amdgcn_mfma_f32_16x16x32_bf16(aqv, bv, accY, 0, 0, 0);
        if (fq < 2) {
#pragma unroll
          for (int r = 0; r < 4; r++) {
            const int i = fq * 4 + r, j = dir ? 7 - i : i;
            YS[(size_t)(seg_row0 + t_lo + sc * 8 + j) * YST + dir * 768 + MIX * 256 + h * 64 + w * 16 + fr] = f2bf(accY[r]);
          }
        }
#pragma unroll
        for (int nt = 0; nt < 4; nt++) {
          f32x4 an = z4;
          if (DELTA) {
            const bf16x8 g0 = ld_frag(SB + S3_GM + ((nt * 16 + fr) * 72 + fq * 8) * 2), g1 = ld_frag(SB + S3_GM + ((nt * 16 + fr) * 72 + 32 + fq * 8) * 2);
            an = __builtin_amdgcn_mfma_f32_16x16x32_bf16(g0, bs0, an, 0, 0, 0);
            an = __builtin_amdgcn_mfma_f32_16x16x32_bf16(g1, bs1, an, 0, 0, 0);
          }
          const bf16x8 akv = fq == 0 ? ld_frag(SB + S3_KVT + (nt * 16 + fr) * 16) : zfrag();
          an = __builtin_amdgcn_mfma_f32_16x16x32_bf16(akv, bv, an, 0, 0, 0);
          const float4 wc = *(const float4*)(SB + S3_WC + (nt * 16 + fq * 4) * 4);
          st[nt][0] = st[nt][0] * wc.x + an[0];
          st[nt][1] = st[nt][1] * wc.y + an[1];
          st[nt][2] = st[nt][2] * wc.z + an[2];
          st[nt][3] = st[nt][3] * wc.w + an[3];
        }
        wave_lds_sync();
      }
    }
    __syncthreads();
  }
}

__device__ __forceinline__ void attn_item(const Params& p, int l, int b, int qb, int hk, bool isctx, unsigned char* smem) {
  u16* KS = (u16*)smem;
  u16* VT = KS + 64 * LDT;
  u16* PL = VT + 64 * LDT;
  float2* ROPE = (float2*)(PL + 8 * 32 * LDT);
  const int tid = TIDX, lane = tid & 63, w = tid >> 6, fr = lane & 15, fq = lane >> 4;
  const u16* P = (const u16*)(p.ws + OFF_BIG);
  u16* Y = (u16*)(p.ws + OFF_YS);
  const int qh = hk * 2 + (w >> 2);
  const int tb = qb * 128 + (w & 3) * 32;
  const int qrow0 = b * TPB + (isctx ? 0 : LC);
  __syncthreads();
  for (int i = tid; i < 1024; i += NTHR) {
    int pos = i >> 4, fi = i & 15;
    float inv = powf(10000.f, -(float)fi / 16.f);
    float sn, cs;
    sincosf((float)pos * inv, &sn, &cs);
    ROPE[i] = make_float2(cs, sn);
  }
  __syncthreads();
  bf16x8 qf[2][2];
#pragma unroll
  for (int mi = 0; mi < 2; mi++)
#pragma unroll
    for (int ks = 0; ks < 2; ks++) {
      const int tq = tb + mi * 16 + fr;
      const u16* qp = P + (size_t)(qrow0 + tq) * PST + PD + qh * 64 + ks * 32;
      uint4 own = *(const uint4*)(qp + fq * 8);
      uint4 par = *(const uint4*)(qp + (fq ^ 2) * 8);
      const unsigned ow[4] = {own.x, own.y, own.z, own.w};
      const unsigned pw[4] = {par.x, par.y, par.z, par.w};
      const int pos = ks == 0 ? (tq >> 6) : (tq & 63);
      bf16x8 f;
#pragma unroll
      for (int jj = 0; jj < 8; jj++) {
        float xo = bf2f((u16)((ow[jj >> 1] >> ((jj & 1) * 16)) & 0xffff));
        float xp = bf2f((u16)((pw[jj >> 1] >> ((jj & 1) * 16)) & 0xffff));
        float v = xo;
        if (!isctx) {
          float2 cs = ROPE[pos * 16 + (fq & 1) * 8 + jj];
          v = fq < 2 ? xo * cs.x - xp * cs.y : xp * cs.y + xo * cs.x;
        }
        f[jj] = (short)f2bf(v * 0.125f);
      }
      qf[mi][ks] = f;
    }
  f32x4 oacc[2][4];
#pragma unroll
  for (int mi = 0; mi < 2; mi++)
#pragma unroll
    for (int nd = 0; nd < 4; nd++) oacc[mi][nd] = f32x4{0.f, 0.f, 0.f, 0.f};
  float mrow[2][4], lrow[2][4];
#pragma unroll
  for (int mi = 0; mi < 2; mi++)
#pragma unroll
    for (int r = 0; r < 4; r++) { mrow[mi][r] = -1e30f; lrow[mi][r] = 0.f; }

  const int q0 = qb * 128;
  const int band_lo = isctx ? 0 : max(0, q0 - 128), band_hi = isctx ? 0 : min(SEQ, q0 + 256);
  const int ntile = 4 + (band_hi - band_lo) / 64;
  u16* pl = PL + w * 32 * LDT;
  for (int tl = 0; tl < ntile; tl++) {
    const bool band = tl >= 4;
    const int k0 = band ? band_lo + (tl - 4) * 64 : tl * 64;
    __syncthreads();
    {
      const int key = tid >> 3, kc = tid & 7;
      const int kpos = k0 + key;
      const u16* kp = P + (size_t)(b * TPB + (band ? LC : 0) + kpos) * PST + PD + 256 + hk * 64;
      uint4 own = *(const uint4*)(kp + kc * 8);
      uint4 vv = *(const uint4*)(kp + 128 + kc * 8);
      uint4 par = *(const uint4*)(kp + (kc ^ 2) * 8);
      if (band) {
        const unsigned ow[4] = {own.x, own.y, own.z, own.w};
        const unsigned pw[4] = {par.x, par.y, par.z, par.w};
        const int pos = kc < 4 ? (kpos >> 6) : (kpos & 63);
        unsigned res[4];
#pragma unroll
        for (int jj = 0; jj < 8; jj += 2) {
          float v2[2];
#pragma unroll
          for (int e = 0; e < 2; e++) {
            float xo = bf2f((u16)((ow[jj >> 1] >> (e * 16)) & 0xffff));
            float xp = bf2f((u16)((pw[jj >> 1] >> (e * 16)) & 0xffff));
            float2 cs = ROPE[pos * 16 + (kc & 1) * 8 + jj + e];
            v2[e] = (kc & 2) == 0 ? xo * cs.x - xp * cs.y : xp * cs.y + xo * cs.x;
          }
          res[jj >> 1] = pack2(v2[0], v2[1]);
        }
        own = make_uint4(res[0], res[1], res[2], res[3]);
      }
      *(uint4*)(KS + key * LDT + kc * 8) = own;
      const unsigned vw[4] = {vv.x, vv.y, vv.z, vv.w};
#pragma unroll
      for (int jj = 0; jj < 8; jj++) VT[(kc * 8 + jj) * LDT + key] = (u16)((vw[jj >> 1] >> ((jj & 1) * 16)) & 0xffff);
    }
    __syncthreads();
    f32x4 sc[2][4];
#pragma unroll
    for (int mi = 0; mi < 2; mi++)
#pragma unroll
      for (int nj = 0; nj < 4; nj++) sc[mi][nj] = f32x4{0.f, 0.f, 0.f, 0.f};
#pragma unroll
    for (int ks = 0; ks < 2; ks++) {
      bf16x8 kf[4];
#pragma unroll
      for (int nj = 0; nj < 4; nj++) kf[nj] = *(const bf16x8*)(KS + (nj * 16 + fr) * LDT + ks * 32 + fq * 8);
#pragma unroll
      for (int mi = 0; mi < 2; mi++)
#pragma unroll
        for (int nj = 0; nj < 4; nj++) sc[mi][nj] = __builtin_amdgcn_mfma_f32_16x16x32_bf16(qf[mi][ks], kf[nj], sc[mi][nj], 0, 0, 0);
    }
#pragma unroll
    for (int mi = 0; mi < 2; mi++)
#pragma unroll
      for (int r = 0; r < 4; r++) {
        const int qpos = tb + mi * 16 + fq * 4 + r;
        float mx = -1e30f;
#pragma unroll
        for (int nj = 0; nj < 4; nj++) {
          float v = sc[mi][nj][r];
          if (band) {
            int d = qpos - (k0 + nj * 16 + fr);
            if (d > 128 || d < -128) v = -1e30f;
          }
          sc[mi][nj][r] = v;
          mx = fmaxf(mx, v);
        }
        mx = fmaxf(mx, __shfl_xor(mx, 1));
        mx = fmaxf(mx, __shfl_xor(mx, 2));
        mx = fmaxf(mx, __shfl_xor(mx, 4));
        mx = fmaxf(mx, __shfl_xor(mx, 8));
        const float mnew = fmaxf(mrow[mi][r], mx);
        const float alpha = __expf(mrow[mi][r] - mnew);
        mrow[mi][r] = mnew;
        float ls = 0.f;
#pragma unroll
        for (int nj = 0; nj < 4; nj++) {
          float pe = __expf(sc[mi][nj][r] - mnew);
          ls += pe;
          pl[(mi * 16 + fq * 4 + r) * LDT + nj * 16 + fr] = f2bf(pe);
        }
        lrow[mi][r] = lrow[mi][r] * alpha + ls;
#pragma unroll
        for (int nd = 0; nd < 4; nd++) oacc[mi][nd][r] *= alpha;
      }
    asm volatile("s_waitcnt lgkmcnt(0)" ::: "memory");
    __builtin_amdgcn_wave_barrier();
#pragma unroll
    for (int ks = 0; ks < 2; ks++) {
      bf16x8 pf[2], vf[4];
#pragma unroll
      for (int mi = 0; mi < 2; mi++) pf[mi] = *(const bf16x8*)(pl + (mi * 16 + fr) * LDT + ks * 32 + fq * 8);
#pragma unroll
      for (int nd = 0; nd < 4; nd++) vf[nd] = *(const bf16x8*)(VT + (nd * 16 + fr) * LDT + ks * 32 + fq * 8);
#pragma unroll
      for (int mi = 0; mi < 2; mi++)
#pragma unroll
        for (int nd = 0; nd < 4; nd++) oacc[mi][nd] = __builtin_amdgcn_mfma_f32_16x16x32_bf16(pf[mi], vf[nd], oacc[mi][nd], 0, 0, 0);
    }
    asm volatile("s_waitcnt lgkmcnt(0)" ::: "memory");
    __builtin_amdgcn_wave_barrier();
  }
  const float sink = p.attn_sink[l * 4 + qh];
#pragma unroll
  for (int mi = 0; mi < 2; mi++)
#pragma unroll
    for (int r = 0; r < 4; r++) {
      float ls = lrow[mi][r];
      ls += __shfl_xor(ls, 1);
      ls += __shfl_xor(ls, 2);
      ls += __shfl_xor(ls, 4);
      ls += __shfl_xor(ls, 8);
      ls += __expf(sink - mrow[mi][r]);
      const float inv = 1.f / ls;
      const int tq = tb + mi * 16 + fq * 4 + r;
#pragma unroll
      for (int nd = 0; nd < 4; nd++) Y[(size_t)(qrow0 + tq) * YST + 1536 + qh * 64 + nd * 16 + fr] = f2bf(oacc[mi][nd][r] * inv);
    }
}

#ifndef SCAN3_MASK
#define SCAN3_MASK 7
#endif
__device__ __forceinline__ void phase_mix(const Params& p, int l, unsigned char* smem) {
  float* sm = (float*)smem;
  const int G = gridDim.x;
  for (int it = blockIdx.x; it < 192; it += G) {
    const int mix = it >> 6, rem = it & 63, b = rem >> 3, h = (rem >> 1) & 3, dir = rem & 1;
    if (mix == 0 && (SCAN3_MASK & 1)) scan3_item<0>(p, l, b, h, dir, smem);
    else if (mix == 1 && (SCAN3_MASK & 2)) scan3_item<1>(p, l, b, h, dir, smem);
    else if (mix == 2 && (SCAN3_MASK & 4)) scan3_item<2>(p, l, b, h, dir, smem);
  }
  if (SCAN3_MASK != 7) {
    for (int it = blockIdx.x; it < 768; it += G) {
      const int mix = it >> 8, rem = it & 255, b = rem >> 5, h = (rem >> 3) & 3, dir = (rem >> 2) & 1, rq = rem & 3;
      if (mix == 0 && !(SCAN3_MASK & 1)) scan2_item<0>(p, l, b, h, dir, rq, sm);
      else if (mix == 1 && !(SCAN3_MASK & 2)) scan2_item<1>(p, l, b, h, dir, rq, sm);
      else if (mix == 2 && !(SCAN3_MASK & 4)) scan2_item<2>(p, l, b, h, dir, rq, sm);
    }
  }
  __syncthreads();
  unsigned* ctr = (unsigned*)(p.ws + OFF_CTR) + l * 16;
  volatile int* slot = (volatile int*)(smem + 131072 - 16);
  for (;;) {
    if (TIDX == 0) *slot = (int)atomicAdd(ctr, 1u);
    __syncthreads();
    const int it = *slot;
    __syncthreads();
    if (it >= 544) break;
    if (it < 512) {
      int b = it >> 6, qb = (it >> 1) & 31, hk = it & 1;
      attn_item(p, l, b, qb, hk, false, smem);
    } else {
      int r = it - 512, b = r >> 2, qb = (r >> 1) & 1, hk = r & 1;
      attn_item(p, l, b, qb, hk, true, smem);
    }
  }
}

__device__ __forceinline__ void phase_post(const Params& p, int l, float* g2s) {
  const int lane = TIDX & 63, wv = TIDX >> 6;
  const u16* P = (const u16*)(p.ws + OFF_BIG);
  u16* YS = (u16*)(p.ws + OFF_YS);
  const float* BC = (const float*)(p.ws + OFF_BC);
  const int j0 = lane * 4, hd = lane >> 4;
  {
    const float4* src = (const float4*)(p.rwkv_g2 + (size_t)l * 64 * 256);
    for (int i = TIDX; i < 64 * 256 / 4; i += NTHR) ((float4*)g2s)[i] = src[i];
  }
  __syncthreads();
  for (int r = blockIdx.x * 8 + wv; r < NROWS; r += gridDim.x * 8) {
    const int b = r / TPB, t = r - b * TPB;
    const bool has_prev = (t != 0) && (t != LC), has_next = (t != LC - 1) && (t != TPB - 1);
    const int poff = has_prev ? PST : 0, noff = has_next ? PST : 0;
    const float pmul = has_prev ? 1.f : 0.f, nmul = has_next ? 1.f : 0.f;
    u16* ys = YS + (size_t)r * YST;
    const u16* pr = P + (size_t)r * PST;
    float y[3][4];
#pragma unroll
    for (int m = 0; m < 3; m++) {
      uint2 a = *(const uint2*)(ys + m * 256 + j0);
      uint2 c = *(const uint2*)(ys + 768 + m * 256 + j0);
      y[m][0] = bf2f((u16)(a.x & 0xffff)) + bf2f((u16)(c.x & 0xffff));
      y[m][1] = bf2f((u16)(a.x >> 16)) + bf2f((u16)(c.x >> 16));
      y[m][2] = bf2f((u16)(a.y & 0xffff)) + bf2f((u16)(c.y & 0xffff));
      y[m][3] = bf2f((u16)(a.y >> 16)) + bf2f((u16)(c.y >> 16));
    }
    float o[3][4];
    {
      float sum = y[0][0] + y[0][1] + y[0][2] + y[0][3];
      sum += __shfl_xor(sum, 1); sum += __shfl_xor(sum, 2); sum += __shfl_xor(sum, 4); sum += __shfl_xor(sum, 8);
      const float mean = sum * (1.f / 64.f);
      float vs = 0.f;
#pragma unroll
      for (int i = 0; i < 4; i++) { float d = y[0][i] - mean; vs += d * d; }
      vs += __shfl_xor(vs, 1); vs += __shfl_xor(vs, 2); vs += __shfl_xor(vs, 4); vs += __shfl_xor(vs, 8);
      const float rstd = rsq(vs * (1.f / 64.f) + 64e-5f);
      float sg;
      {
        const int col = 896 + lane;
        float pv = bf2f(pr[PA + col]);
        float pp = bf2f(pr[PA + col - poff]) * pmul;
        float pn = bf2f(pr[PA + col + noff]) * nmul;
        float xm = pv + (0.5f * (pp + pn) - pv) * p.rwkv_mu[l * 960 + col];
        sg = sigm(xm);
      }
      float gate[4] = {0.f, 0.f, 0.f, 0.f};
      const float* g2 = g2s + j0;
#pragma unroll
      for (int i = 0; i < 64; i++) {
        const float si = __int_as_float(__builtin_amdgcn_readlane(__float_as_int(sg), i));
        const float4 gw = *(const float4*)(g2 + i * 256);
        gate[0] += si * gw.x; gate[1] += si * gw.y; gate[2] += si * gw.z; gate[3] += si * gw.w;
      }
      const float bcs = BC[(size_t)r * 8 + hd * 2] + BC[(size_t)r * 8 + hd * 2 + 1];
#pragma unroll
      for (int i = 0; i < 4; i++) {
        const int col = 512 + j0 + i;
        float pv = bf2f(pr[PA + col]);
        float pp = bf2f(pr[PA + col - poff]) * pmul;
        float pn = bf2f(pr[PA + col + noff]) * nmul;
        float v = pv + (0.5f * (pp + pn) - pv) * p.rwkv_mu[l * 960 + col];
        float yn = (y[0][i] - mean) * rstd * p.rwkv_ln_g[l * 256 + j0 + i] + p.rwkv_ln_b[l * 256 + j0 + i];
        o[0][i] = (yn + bcs * v) * gate[i];
      }
    }
#pragma unroll
    for (int m = 1; m < 3; m++) {
      float ss = y[m][0] * y[m][0] + y[m][1] * y[m][1] + y[m][2] * y[m][2] + y[m][3] * y[m][3];
      ss += __shfl_xor(ss, 1); ss += __shfl_xor(ss, 2); ss += __shfl_xor(ss, 4); ss += __shfl_xor(ss, 8);
      const float inv = rsq(ss * (1.f / 64.f) + 1e-6f);
      const float* ng = (m == 1 ? p.gdn_norm_g : p.gla_norm_g) + l * 64 + (lane & 15) * 4;
      const u16* gp = pr + (m == 1 ? PB + 784 : PC + 544) + j0;
#pragma unroll
      for (int i = 0; i < 4; i++) o[m][i] = y[m][i] * inv * ng[i] * siluf(bf2f(gp[i]));
    }
    asm volatile("s_waitcnt vmcnt(0)" ::: "memory");
    __builtin_amdgcn_wave_barrier();
#pragma unroll
    for (int m = 0; m < 3; m++) {
      uint2 ov;
      ov.x = pack2(o[m][0], o[m][1]);
      ov.y = pack2(o[m][2], o[m][3]);
      *(uint2*)(ys + m * 256 + j0) = ov;
    }
  }
}

#if defined(SKIPS)
#define EN(k) (SKIPS != (k))
#elif !defined(ONLYS)
#define EN(k) 1
#else
#define EN(k) (ONLYS == (k))
#endif
__device__ __forceinline__ void run_phase(const Params& p, int ph, unsigned char* smem) {
  if (ph == 0) { if (EN(10)) phase_init0(p, (float*)smem); return; }
  if (ph == 1) { if (EN(11)) phase_init1(p); return; }
  int l = 0, s = 12;
  if (ph >= 3) { l = (ph - 3) / 12; s = (ph - 3) - l * 12; }
  unsigned char* wl = p.ws + OFF_W + (size_t)l * SZ_WL;
  PG8_LAS unsigned char* lds = (PG8_LAS unsigned char*)smem;
  pg8::StaticOrder S;
  if (s == 12 || s == 8 || s == 11) {
    if (EN(5)) rowpass(p, l, s == 12 ? 0 : (s == 8 ? 1 : 2));
  } else if (s == 0 || s == 3 || s == 5 || s == 7 || s == 10) {
    pg8::Gemm g; EpiBf E;
    g.M = NROWS; E.bias = nullptr; E.act = 0;
    if (s == 0) { g.A = (const u16*)(p.ws + OFF_H); g.lda = DM; g.Bt = (const u16*)(wl + OW_IN); g.K = DM; g.N = PST; E.O = (u16*)(p.ws + OFF_BIG); E.ldc = PST; }
    else if (s == 3 || s == 5) {
      const int hf = s == 5;
      g.A = (const u16*)(p.ws + OFF_H); g.lda = DM; g.Bt = (const u16*)(wl + OW_G) + (size_t)hf * 2048 * DM; g.K = DM; g.N = 2048;
      E.O = (u16*)(p.ws + OFF_BIG); E.ldc = 2048; E.bias = p.gate_b + (size_t)l * 4096 + hf * 2048; E.act = 1;
    }
    else if (s == 7) { g.A = (const u16*)(p.ws + OFF_BIG + 2 * SZ_ACT); g.lda = DM; g.Bt = (const u16*)(wl + OW_O); g.K = DM; g.N = DM; E.O = (u16*)(p.ws + OFF_BIG); E.ldc = DM; }
    else { g.A = (const u16*)(p.ws + OFF_BIG); g.lda = FH; g.Bt = (const u16*)(wl + OW_2); g.K = FH; g.N = DM; E.O = (u16*)(p.ws + OFF_YS); E.ldc = DM; }
    S.init(g.M, g.N, gridDim.x, blockIdx.x);
    if (EN(0)) pg8::gemm_phase<EpiBf, pg8::StaticOrder, false>(lds, g, S, E, nullptr);
  } else if (s == 4 || s == 6) {
    if (EN(3)) phase_ypart(p, l, s == 6, smem);
  } else if (s == 1) {
    if (EN(1)) phase_mix(p, l, smem);
  } else if (s == 2) {
    if (EN(2)) phase_post(p, l, (float*)smem);
  } else {
    pg8::Gemm g; EpiSwiglu E;
    g.M = NROWS; g.N = 2 * FH; g.K = DM; g.lda = DM; g.A = (const u16*)(p.ws + OFF_H); g.Bt = (const u16*)(wl + OW_1);
    E.O = (u16*)(p.ws + OFF_BIG);
    S.init(g.M, g.N, gridDim.x, blockIdx.x);
    if (EN(6)) pg8::gemm_phase<EpiSwiglu, pg8::StaticOrder, false>(lds, g, S, E, nullptr);
  }
}

__global__ void __launch_bounds__(NTHR) hybrid_flow_mega(Params p, int ph0, int ph1) {
  __shared__ __attribute__((aligned(16))) unsigned char smem[131072];
  cg::grid_group grid = cg::this_grid();
  for (int ph = ph0; ph < ph1; ph++) {
    run_phase(p, ph, smem);
#ifdef DUPMASK
    {
      int sidx = ph >= 3 ? (ph - 3) % 12 : 12 + ph;
      if ((DUPMASK >> sidx) & 1) { __syncthreads(); run_phase(p, ph, smem); }
    }
#endif
    if (ph + 1 < ph1) grid.sync();
  }
}

extern "C" void kernel_launch(void* const* d_in, const int* in_sizes, int n_in, void* d_out, int out_size, void* d_ws,
                              size_t ws_size, hipStream_t stream) {
  Params p{};
  const float** pp = (const float**)&p;
  for (int i = 0; i < 32; i++) pp[i] = (const float*)d_in[i];
  p.out = (float*)d_out;
  p.ws = (unsigned char*)d_ws;
  static int grid_blocks = 0;
  if (!grid_blocks) {
    int dev = 0, cus = 0, per_cu = 0;
    hipGetDevice(&dev);
    hipDeviceGetAttribute(&cus, hipDeviceAttributeMultiprocessorCount, dev);
    hipOccupancyMaxActiveBlocksPerMultiprocessor(&per_cu, hybrid_flow_mega, NTHR, 0);
    if (per_cu < 1) per_cu = 1;
    grid_blocks = cus * per_cu;
  }
#ifdef MULTI_LAUNCH
  for (int ph = 0; ph < NPHASE; ph++) {
    hipLaunchKernelGGL(hybrid_flow_mega, dim3(grid_blocks), dim3(NTHR), 0, stream, p, ph, ph + 1);
  }
#else
  int ph0 = 0, ph1 = NPHASE;
  void* args[] = {&p, &ph0, &ph1};
  hipError_t e = hipLaunchCooperativeKernel((void*)hybrid_flow_mega, dim3(grid_blocks), dim3(NTHR), args, 0, stream);
  if (e != hipSuccess) fprintf(stderr, "cooperative launch failed: %s (grid %d)\n", hipGetErrorString(e), grid_blocks);
#endif
}
```

```cpp
#include <hip/hip_runtime.h>
#include <hip/hip_cooperative_groups.h>
#include <cstdio>
namespace cg = cooperative_groups;

typedef unsigned short u16;
using bf16x8 = __attribute__((ext_vector_type(8))) short;
using f32x4 = __attribute__((ext_vector_type(4))) float;

#define DM 1024
#define NBATCH 8
#define SEQ 4096
#define LC 256
#define TPB 4352
#define NROWS 34816
#define PST 3328
#define YST 1792
#define FH 2816
#define INW 7408
#define NTHR 512
#define PA 0
#define PB 960
#define PC 2000
#define PD 2800
#define NPHASE 27
#define SCAN3_MASK 7

struct Params {
  const float *x, *c, *ctx, *c_ctx, *ada_w, *ada_b, *norm_g, *w_in, *gate_b, *w_branch, *w_out,
      *rwkv_mu, *rwkv_w0, *rwkv_w2, *rwkv_a0, *rwkv_a2, *rwkv_g2, *rwkv_kk, *rwkv_ka, *rwkv_rk, *rwkv_ln_g,
      *rwkv_ln_b, *gdn_conv, *gdn_a_log, *gdn_dt_bias, *gdn_norm_g, *gla_gw2, *gla_gb, *gla_norm_g, *attn_sink,
      *ffn_w1, *ffn_w2;
  float* out;
  unsigned char* ws;
};

constexpr size_t SZ_WL = 36700160;
constexpr size_t OW_IN = 0;
constexpr size_t OW_G = OW_IN + (size_t)PST * 1024 * 2;
constexpr size_t OW_B = OW_G + (size_t)4096 * 1024 * 2;
constexpr size_t OW_O = OW_B + (size_t)4 * 1024 * 256 * 2;
constexpr size_t OW_1 = OW_O + (size_t)1024 * 1024 * 2;
constexpr size_t OW_2 = OW_1 + (size_t)5632 * 1024 * 2;
static_assert(OW_2 + (size_t)1024 * FH * 2 == SZ_WL, "weights size");
constexpr size_t SZ_ACT = (size_t)NROWS * DM * 2;
constexpr size_t OFF_W = 0;
constexpr size_t OFF_XC = OFF_W + 2 * SZ_WL;
constexpr size_t OFF_MODP = OFF_XC + (size_t)NBATCH * LC * DM * 4;
constexpr size_t OFF_MOD = OFF_MODP + (size_t)2 * 8 * 9 * 6144 * 4;
constexpr size_t OFF_BC = OFF_MOD + (size_t)2 * 9 * 6144 * 4;
constexpr size_t OFF_H = OFF_BC + (size_t)NROWS * 8 * 4;
constexpr size_t OFF_YS = OFF_H + SZ_ACT;
constexpr size_t OFF_BIG = OFF_YS + (size_t)NROWS * YST * 2;
constexpr size_t OFF_CTR = OFF_BIG + (size_t)NROWS * PST * 2;
constexpr size_t OFF_XBAR = OFF_CTR + 256;
constexpr size_t WS_END = OFF_XBAR + 3456 * 4;
static_assert(WS_END <= (size_t)536870912, "ws too large");

__device__ __forceinline__ int launder_tid() { int t = threadIdx.x; asm volatile("" : "+v"(t)); return t; }
#define TIDX (launder_tid())
typedef float f32x2_t __attribute__((ext_vector_type(2)));
typedef __bf16 bf16x2_t __attribute__((ext_vector_type(2)));
__device__ __forceinline__ unsigned pack2(float a, float b) {
  const f32x2_t v = {a, b};
  const bf16x2_t r = __builtin_convertvector(v, bf16x2_t);
  return __builtin_bit_cast(unsigned, r);
}
__device__ __forceinline__ u16 f2bf(float f) { return (u16)(pack2(f, 0.f) & 0xffffu); }
__device__ __forceinline__ float bf2f(u16 h) { return __uint_as_float(((unsigned)h) << 16); }
__device__ __forceinline__ float sigm(float x) { return __builtin_amdgcn_rcpf(1.f + __expf(-x)); }
__device__ __forceinline__ float siluf(float x) { return x * __builtin_amdgcn_rcpf(1.f + __expf(-x)); }
__device__ __forceinline__ float rsq(float x) { return __builtin_amdgcn_rsqf(x); }
__device__ __forceinline__ float softplusf(float x) { return fmaxf(x, 0.f) + log1pf(__expf(-fabsf(x))); }
__device__ __forceinline__ float wsum(float v) {
#pragma unroll
  for (int o = 32; o > 0; o >>= 1) v += __shfl_xor(v, o);
  return v;
}
template <int CTRL>
__device__ __forceinline__ float dppf(float x) {
  return __int_as_float(__builtin_amdgcn_update_dpp(__float_as_int(x), __float_as_int(x), CTRL, 0xf, 0xf, false));
}
__device__ __forceinline__ float red8(float x) {
  x += dppf<0xB1>(x);
  x += dppf<0x4E>(x);
  x += dppf<0x141>(x);
  return x;
}
__device__ __forceinline__ const float* xin_row(const Params& p, int r) {
  int b = r / TPB, t = r - b * TPB;
  return t < LC ? p.ctx + ((size_t)(b * LC + t)) * DM : p.x + ((size_t)(b * SEQ + t - LC)) * DM;
}
__device__ __forceinline__ float* x_row(const Params& p, int r) {
  int b = r / TPB, t = r - b * TPB;
  return t < LC ? (float*)(p.ws + OFF_XC) + ((size_t)(b * LC + t)) * DM : p.out + ((size_t)(b * SEQ + t - LC)) * DM;
}
__device__ __forceinline__ int mod_row(int r) {
  int b = r / TPB, t = r - b * TPB;
  return t < LC ? 8 : b;
}

struct MapId { int lim, off; __device__ int operator()(int n) const { return n < lim ? n + off : -1; } };
struct MapW1 { __device__ int operator()(int n) const { int q = n >> 3, s = n & 7; return s < 4 ? q * 4 + s : FH + q * 4 + (s - 4); } };

template <class Map>
__device__ __forceinline__ void conv_tile(const float* __restrict__ src, int ld, u16* __restrict__ dst, int K, int n0,
                                          int k0, Map map, float* tile) {
  const int tid = TIDX;
  const int nn = tid & 63, kr = tid >> 6;
  const int sc = map(n0 + nn);
#pragma unroll
  for (int ps = 0; ps < 8; ps++) {
    int kk = ps * 8 + kr;
    float v = sc >= 0 ? src[(size_t)(k0 + kk) * ld + sc] : 0.f;
    tile[kk * 65 + nn] = v;
  }
  __syncthreads();
  const int n2 = tid >> 3, kc = tid & 7;
  uint4 o;
  o.x = pack2(tile[(kc * 8 + 0) * 65 + n2], tile[(kc * 8 + 1) * 65 + n2]);
  o.y = pack2(tile[(kc * 8 + 2) * 65 + n2], tile[(kc * 8 + 3) * 65 + n2]);
  o.z = pack2(tile[(kc * 8 + 4) * 65 + n2], tile[(kc * 8 + 5) * 65 + n2]);
  o.w = pack2(tile[(kc * 8 + 6) * 65 + n2], tile[(kc * 8 + 7) * 65 + n2]);
  *(uint4*)(dst + (size_t)(n0 + n2) * K + k0 + kc * 8) = o;
  __syncthreads();
}

__device__ __forceinline__ void phase_init0(const Params& p, float* sm) {
  const int tid = TIDX;
  if (blockIdx.x == 0) {
    if (tid < 64) ((unsigned*)(p.ws + OFF_CTR))[tid] = 0u;
    for (int i = tid; i < 3456; i += NTHR) ((unsigned*)(p.ws + OFF_XBAR))[i] = 0u;
  }
  constexpr int NMOD = 192, NCONV = 4480 * 2;
  for (int it = blockIdx.x; it < NMOD + NCONV; it += gridDim.x) {
    if (it < NMOD) {
      int l = it / 96, rem = it - l * 96, cc = rem >> 3, ks = rem & 7;
      for (int i = tid; i < 9 * 128; i += NTHR) {
        int r = i >> 7, k = i & 127;
        float v = r < 8 ? p.c[r * DM + ks * 128 + k] : p.c_ctx[ks * 128 + k];
        sm[i] = siluf(v);
      }
      __syncthreads();
      const int n = cc * 512 + tid;
      const float* w = p.ada_w + ((size_t)l * DM + ks * 128) * 6144 + n;
      float acc[9];
#pragma unroll
      for (int r = 0; r < 9; r++) acc[r] = 0.f;
#pragma unroll 4
      for (int k = 0; k < 128; k++) {
        float wv = w[(size_t)k * 6144];
#pragma unroll
        for (int r = 0; r < 9; r++) acc[r] += sm[r * 128 + k] * wv;
      }
      float* mp = (float*)(p.ws + OFF_MODP) + ((size_t)(l * 8 + ks) * 9) * 6144 + n;
#pragma unroll
      for (int r = 0; r < 9; r++) mp[(size_t)r * 6144] = acc[r];
      __syncthreads();
    } else {
      int ci = it - NMOD;
      int l = ci / 4480, rem = ci - l * 4480;
      u16* wl = (u16*)(p.ws + OFF_W + (size_t)l * SZ_WL);
      if (rem < 832) {
        int nt = rem >> 4, kt = rem & 15;
        conv_tile(p.w_in + (size_t)l * DM * INW, INW, (u16*)((char*)wl + OW_IN), 1024, nt * 64, kt * 64, MapId{3312, 0}, sm);
      } else if (rem < 832 + 1024) {
        rem -= 832;
        int nt = rem >> 4, kt = rem & 15;
        conv_tile(p.w_in + (size_t)l * DM * INW, INW, (u16*)((char*)wl + OW_G), 1024, nt * 64, kt * 64, MapId{4096, 3312}, sm);
      } else if (rem < 1856 + 256) {
        rem -= 1856;
        int br = rem >> 6, r2 = rem & 63, nt = r2 >> 2, kt = r2 & 3;
        conv_tile(p.w_branch + ((size_t)(l * 4 + br)) * 256 * DM, DM, (u16*)((char*)wl + OW_B) + (size_t)br * 1024 * 256, 256,
                  nt * 64, kt * 64, MapId{1024, 0}, sm);
      } else if (rem < 2112 + 256) {
        rem -= 2112;
        int nt = rem >> 4, kt = rem & 15;
        conv_tile(p.w_out + (size_t)l * DM * DM, DM, (u16*)((char*)wl + OW_O), 1024, nt * 64, kt * 64, MapId{1024, 0}, sm);
      } else if (rem < 2368 + 1408) {
        rem -= 2368;
        int nt = rem >> 4, kt = rem & 15;
        conv_tile(p.ffn_w1 + (size_t)l * DM * 5632, 5632, (u16*)((char*)wl + OW_1), 1024, nt * 64, kt * 64, MapW1{}, sm);
      } else {
        rem -= 3776;
        int nt = rem / 44, kt = rem - nt * 44;
        conv_tile(p.ffn_w2 + (size_t)l * FH * DM, DM, (u16*)((char*)wl + OW_2), FH, nt * 64, kt * 64, MapId{1024, 0}, sm);
      }
    }
  }
}

__device__ __forceinline__ void phase_init1(const Params& p) {
  const float* mp = (const float*)(p.ws + OFF_MODP);
  float* mo = (float*)(p.ws + OFF_MOD);
  for (int i = blockIdx.x * NTHR + TIDX; i < 2 * 9 * 6144; i += gridDim.x * NTHR) {
    int l = i / (9 * 6144), rem = i - l * 9 * 6144, r = rem / 6144, n = rem - r * 6144;
    float s = p.ada_b[l * 6144 + n];
#pragma unroll
    for (int ks = 0; ks < 8; ks++) s += mp[((size_t)((l * 8 + ks) * 9 + r)) * 6144 + n];
    mo[i] = s;
  }
}

__device__ __forceinline__ void rowpass(const Params& p, int l, int mode) {
  const int lane = TIDX & 63, wv = TIDX >> 6;
  const float* MOD = (const float*)(p.ws + OFF_MOD);
  u16* H = (u16*)(p.ws + OFF_H);
  const bool do_norm = !(mode == 2 && l == 1);
  const int ln = (mode == 2) ? (l == 1 ? l : l + 1) : l;
  const int ni = (mode == 1) ? 2 : 0, sho = (mode == 1) ? 3072 : 0, sco = (mode == 1) ? 4096 : 1024;
  for (int r = blockIdx.x * 8 + wv; r < NROWS; r += gridDim.x * 8) {
    const int mr = mod_row(r);
    const float* modl = MOD + ((size_t)(l * 9 + mr)) * 6144;
    const float* modn = MOD + ((size_t)(ln * 9 + mr)) * 6144;
    const float* ng2 = p.norm_g + (size_t)(ln * 4 + ni) * DM;
    const float* xs = (mode == 0 || (mode == 1 && l == 0)) ? xin_row(p, r) : (const float*)x_row(p, r);
    float4 xo[4], n2[4], sc4[4], sh4[4];
#pragma unroll
    for (int i = 0; i < 4; i++) {
      const int col = i * 256 + lane * 4;
      xo[i] = *(const float4*)(xs + col);
      n2[i] = *(const float4*)(ng2 + col);
      sc4[i] = *(const float4*)(modn + sco + col);
      sh4[i] = *(const float4*)(modn + sho + col);
    }
    float xv[16];
    if (mode == 0) {
#pragma unroll
      for (int i = 0; i < 4; i++) { xv[i * 4 + 0] = xo[i].x; xv[i * 4 + 1] = xo[i].y; xv[i * 4 + 2] = xo[i].z; xv[i * 4 + 3] = xo[i].w; }
    } else {
      const u16* src = (const u16*)(p.ws + (mode == 1 ? OFF_BIG : OFF_YS)) + (size_t)r * DM;
      const float* ng = p.norm_g + (size_t)(l * 4 + (mode == 1 ? 1 : 3)) * DM;
      const float* gt = modl + (mode == 1 ? 2048 : 5120);
      uint2 sv[4];
      float4 g4[4], n4[4];
#pragma unroll
      for (int i = 0; i < 4; i++) {
        const int col = i * 256 + lane * 4;
        sv[i] = *(const uint2*)(src + col);
        g4[i] = *(const float4*)(gt + col);
        n4[i] = *(const float4*)(ng + col);
      }
      float ov[16];
      float ss = 0.f;
#pragma unroll
      for (int i = 0; i < 4; i++) {
        ov[i * 4 + 0] = __uint_as_float(sv[i].x << 16); ov[i * 4 + 1] = __uint_as_float(sv[i].x & 0xffff0000u);
        ov[i * 4 + 2] = __uint_as_float(sv[i].y << 16); ov[i * 4 + 3] = __uint_as_float(sv[i].y & 0xffff0000u);
      }
#pragma unroll
      for (int i = 0; i < 16; i++) ss += ov[i] * ov[i];
      ss = wsum(ss);
      const float inv = rsq(ss * (1.f / 1024.f) + 1e-6f);
      float* xd = x_row(p, r);
#pragma unroll
      for (int i = 0; i < 4; i++) {
        xv[i * 4 + 0] = xo[i].x + g4[i].x * (ov[i * 4 + 0] * inv * n4[i].x);
        xv[i * 4 + 1] = xo[i].y + g4[i].y * (ov[i * 4 + 1] * inv * n4[i].y);
        xv[i * 4 + 2] = xo[i].z + g4[i].z * (ov[i * 4 + 2] * inv * n4[i].z);
        xv[i * 4 + 3] = xo[i].w + g4[i].w * (ov[i * 4 + 3] * inv * n4[i].w);
      }
#pragma unroll
      for (int i = 0; i < 4; i++)
        *(float4*)(xd + i * 256 + lane * 4) = make_float4(xv[i * 4 + 0], xv[i * 4 + 1], xv[i * 4 + 2], xv[i * 4 + 3]);
    }
    if (!do_norm) continue;
    float ss2 = 0.f;
#pragma unroll
    for (int i = 0; i < 16; i++) ss2 += xv[i] * xv[i];
    ss2 = wsum(ss2);
    const float inv2 = rsq(ss2 * (1.f / 1024.f) + 1e-6f);
#pragma unroll
    for (int i = 0; i < 4; i++) {
      const int col = i * 256 + lane * 4;
      float h0 = xv[i * 4 + 0] * inv2 * n2[i].x * (1.f + sc4[i].x) + sh4[i].x;
      float h1 = xv[i * 4 + 1] * inv2 * n2[i].y * (1.f + sc4[i].y) + sh4[i].y;
      float h2 = xv[i * 4 + 2] * inv2 * n2[i].z * (1.f + sc4[i].z) + sh4[i].z;
      float h3 = xv[i * 4 + 3] * inv2 * n2[i].w * (1.f + sc4[i].w) + sh4[i].w;
      uint2 o;
      o.x = pack2(h0, h1);
      o.y = pack2(h2, h3);
      *(uint2*)(H + (size_t)r * DM + col) = o;
    }
  }
}

#define LDT 72
namespace pg8 {
#define PG8_LAS __attribute__((address_space(3)))
typedef unsigned short bf16_t;
typedef short bf16x8 __attribute__((ext_vector_type(8)));
typedef float f32x4 __attribute__((ext_vector_type(4)));
typedef unsigned u32x4 __attribute__((ext_vector_type(4)));
constexpr int BM = 256, BK = 64, HALF = 128, HTB = HALF * BK * 2  , STAGE_BYTES = 8 * HTB, NXCD = 8, WGM = 8;

__host__ __device__ __forceinline__ int lds_byte(int r, int c) { const int st = (r >> 4) * 2 + (c >> 5), rr = r & 15, cc = c & 31, ob = rr * 64 + cc * 2; return st * 1024 + (ob ^ (((ob >> 9) & 1) << 5)); }
__host__ __device__ __forceinline__ void stage_rc(int b, int& R, int& C) { const int st = b / 1024, sb = b % 1024, swz = sb ^ (((sb >> 9) & 1) << 5); R = (st >> 1) * 16 + swz / 64; C = (st & 1) * 32 + (swz % 64) / 2; }
__host__ __device__ __forceinline__ int perm32(int rho) { const int n = rho >> 4, i = rho & 15; return 8 * (i >> 2) + 4 * n + (i & 3); }

struct Unit { int pm, pn; };
struct Gemm { const bf16_t* A; const bf16_t* Bt; int M, N, K, lda; };
struct StaticOrder {
    int nM, nN, nwg, G, c;
    __host__ __device__ void init(int M, int N, int G_, int c_) { nM = M / BM; nN = N / BM; nwg = nM * nN; G = G_; c = c_; }
    __host__ __device__ bool next(int i, Unit& u) const {
        const long L = (long)i * G + c; if (L >= nwg) return false;
        int wgid = (int)L; { const int q = nwg / NXCD, r = nwg % NXCD, xcd = wgid % NXCD, off = wgid / NXCD; wgid = (xcd < r ? xcd * (q + 1) : r * (q + 1) + (xcd - r) * q) + off; }
        const int nig = WGM * nN, gid = wgid / nig, fm = gid * WGM, gsz = (nM - fm) < WGM ? (nM - fm) : WGM;
        u.pm = fm + ((wgid % nig) % gsz); u.pn = (wgid % nig) / gsz; return true;
    }
    __device__ __forceinline__ void a_ready(const Unit&) const {}
    __device__ __forceinline__ void done(const Unit&) const {}
};
__device__ __forceinline__ unsigned cvt_pk_bf16(float lo, float hi) { unsigned r; asm volatile("v_cvt_pk_bf16_f32 %0, %1, %2" : "=v"(r) : "v"(lo), "v"(hi)); return r; }
template <class Epi, class Sched, bool STAMP = false>
__device__ __forceinline__ void gemm_phase(PG8_LAS unsigned char* lds, const Gemm g, const Sched& S, const Epi& E, unsigned long long* stamps) {
    const int tid = TIDX, wid = __builtin_amdgcn_readfirstlane(tid >> 6), lane = tid & 63, wr = wid >> 2, wc = wid & 3, fr = lane & 15, fq = lane >> 4;
    const int K = g.K, nt = K / BK;
    int ts_lo = 0, ts_hi = 0, nts = 0; const unsigned long long rt_entry = STAMP ? (unsigned long long)wall_clock64() : 0ull;
#define PG8_STAMP() do { if (STAMP && wid == 0 && nts < 64) { const unsigned long long _c = (unsigned long long)clock64(); \
        ts_lo = (lane == nts) ? (int)(unsigned)_c : ts_lo; ts_hi = (lane == nts) ? (int)(unsigned)(_c >> 32) : ts_hi; ++nts; } } while (0)
    PG8_STAMP();
    unsigned voffA[2], voffB[2];
#pragma unroll
    for (int i = 0; i < 2; ++i) { int R, C; stage_rc(tid * 16 + i * 8192, R, C); const int Rb = Epi::PERM ? ((R & ~31) + perm32(R & 31)) : R;
        voffA[i] = (unsigned)(R * g.lda + C) * 2u; voffB[i] = (unsigned)(Rb * K + C) * 2u; }
    const size_t kstep = (size_t)(BK * 2);
    const size_t hstepB = (size_t)HALF * K * 2, hstepA = (size_t)HALF * g.lda * 2;
    const size_t tstepB = 2 * hstepB, tstepA = 2 * hstepA;
    const unsigned ldsw = (unsigned)wid * 1024u;
    const int aoff = lds_byte(wr * 64 + fr, fq * 8), boff = lds_byte(wc * 32 + fr, fq * 8);
#define PG8_SA(b, h) (((b) * 2 + (h)) * HTB)
#define PG8_SB(b, h) ((4 + (b) * 2 + (h)) * HTB)
#define PG8_STAGE(bufoff, gbase, voff) do { _Pragma("unroll") for (int _i = 0; _i < 2; ++_i) \
        __builtin_amdgcn_global_load_lds((const unsigned*)((const char*)(gbase) + (voff)[_i]), (PG8_LAS unsigned*)(lds + (bufoff) + ldsw + _i * 8192), 16, 0, 0); } while (0)
#define PG8_LDA(dst, b, h) do { _Pragma("unroll") for (int m = 0; m < 4; ++m) _Pragma("unroll") for (int k = 0; k < 2; ++k) dst[m][k] = *(const PG8_LAS bf16x8*)(lds + PG8_SA(b, h) + aoff + m * 2048 + k * 1024); } while (0)
#define PG8_LDB(dst, b, h) do { _Pragma("unroll") for (int n = 0; n < 2; ++n) _Pragma("unroll") for (int k = 0; k < 2; ++k) dst[n][k] = *(const PG8_LAS bf16x8*)(lds + PG8_SB(b, h) + boff + n * 2048 + k * 1024); } while (0)
#define PG8_MMA(ai, bj, At, Bt) do { __builtin_amdgcn_s_setprio(1); _Pragma("unroll") for (int m = 0; m < 4; ++m) _Pragma("unroll") for (int n = 0; n < 2; ++n) _Pragma("unroll") for (int k = 0; k < 2; ++k) \
        acc[ai][bj][m][n] = __builtin_amdgcn_mfma_f32_16x16x32_bf16(Bt[n][k], At[m][k], acc[ai][bj][m][n], 0, 0, 0); __builtin_amdgcn_s_setprio(0); } while (0)
#define PG8_WAIT_V(n) asm volatile("s_waitcnt vmcnt(" #n ")" ::: "memory")
#define PG8_WAIT_L(n) asm volatile("s_waitcnt lgkmcnt(" #n ")" ::: "memory")
#define PG8_BAR __builtin_amdgcn_s_barrier()
#define PG8_SCHED __builtin_amdgcn_sched_barrier(0)
    Unit cur, nxt; int ui = 0;
    if (!S.next(0, cur)) return;
    f32x4 acc[2][2][4][2];
#pragma unroll
    for (int a = 0; a < 2; ++a)
#pragma unroll
        for (int b = 0; b < 2; ++b)
#pragma unroll
            for (int m = 0; m < 4; ++m)
#pragma unroll
                for (int n = 0; n < 2; ++n) acc[a][b][m][n] = (f32x4){0.f, 0.f, 0.f, 0.f};
    bf16x8 At[4][2], B0[2][2], B1[2][2];
    const char* cA = (const char*)g.A + (size_t)cur.pm * tstepA; const char* cB = (const char*)g.Bt + (size_t)cur.pn * tstepB;
    S.a_ready(cur);
    PG8_STAGE(PG8_SB(0, 0), cB, voffB); PG8_STAGE(PG8_SA(0, 0), cA, voffA); PG8_STAGE(PG8_SB(0, 1), cB + hstepB, voffB); PG8_STAGE(PG8_SA(0, 1), cA + hstepA, voffA);
    if (wr == 1) PG8_BAR;
    PG8_WAIT_V(4); PG8_BAR;
    PG8_STAGE(PG8_SB(1, 0), cB + kstep, voffB); PG8_STAGE(PG8_SA(1, 0), cA + kstep, voffA); PG8_STAGE(PG8_SB(1, 1), cB + hstepB + kstep, voffB);
    PG8_WAIT_V(6); PG8_BAR;
    PG8_STAMP();
    for (;;) {
        const bool has_next = S.next(ui + 1, nxt);
        const char* nA = has_next ? (const char*)g.A + (size_t)nxt.pm * tstepA : cA; const char* nB = has_next ? (const char*)g.Bt + (size_t)nxt.pn * tstepB : cB;
        for (int t = 0; t < nt; t += 2) {
            const bool last = (t == nt - 2);
            const char* a1 = cA + (size_t)(t + 1) * kstep;
            const char* a2 = last ? nA : cA + (size_t)(t + 2) * kstep; const char* b2 = last ? nB : cB + (size_t)(t + 2) * kstep;
            const char* a3 = a2 + kstep; const char* b3 = b2 + kstep;
            if (last && has_next) S.a_ready(nxt);
            PG8_LDB(B0, 0, 0); PG8_SCHED; PG8_LDA(At, 0, 0); PG8_STAGE(PG8_SA(1, 1), a1 + hstepA, voffA);
            PG8_WAIT_L(8); PG8_BAR; PG8_WAIT_L(0); PG8_MMA(0, 0, At, B0); PG8_BAR; PG8_SCHED;
            PG8_LDB(B1, 0, 1); PG8_STAGE(PG8_SB(0, 0), b2, voffB);
            PG8_BAR; PG8_WAIT_L(0); PG8_MMA(0, 1, At, B1); PG8_BAR;
            PG8_LDA(At, 0, 1); PG8_STAGE(PG8_SA(0, 0), a2, voffA);
            PG8_BAR; PG8_WAIT_L(0); PG8_MMA(1, 0, At, B0); PG8_BAR; PG8_SCHED;
            PG8_STAGE(PG8_SB(0, 1), b2 + hstepB, voffB);
            PG8_WAIT_V(6); PG8_BAR; PG8_MMA(1, 1, At, B1); PG8_BAR;
            PG8_LDB(B0, 1, 0); PG8_SCHED; PG8_LDA(At, 1, 0); PG8_STAGE(PG8_SA(0, 1), a2 + hstepA, voffA);
            PG8_WAIT_L(8); PG8_BAR; PG8_WAIT_L(0); PG8_MMA(0, 0, At, B0); PG8_BAR; PG8_SCHED;
            PG8_LDB(B1, 1, 1); PG8_STAGE(PG8_SB(1, 0), b3, voffB);
            PG8_BAR; PG8_WAIT_L(0); PG8_MMA(0, 1, At, B1); PG8_BAR;
            PG8_LDA(At, 1, 1); PG8_STAGE(PG8_SA(1, 0), a3, voffA);
            PG8_BAR; PG8_WAIT_L(0); PG8_MMA(1, 0, At, B0); PG8_BAR; PG8_SCHED;
            PG8_STAGE(PG8_SB(1, 1), b3 + hstepB, voffB);
            PG8_WAIT_V(6); PG8_BAR; PG8_MMA(1, 1, At, B1); PG8_BAR;
        }
        PG8_STAMP();
        if constexpr (!Epi::AFTER_DRAIN) { E(acc, cur, wr, wc, fr, fq); S.done(cur); }
        PG8_STAMP();
        if (!has_next) break;
#pragma unroll
        for (int a = 0; a < 2; ++a)
#pragma unroll
            for (int b = 0; b < 2; ++b)
#pragma unroll
                for (int m = 0; m < 4; ++m)
#pragma unroll
                    for (int n = 0; n < 2; ++n) acc[a][b][m][n] = (f32x4){0.f, 0.f, 0.f, 0.f};
        cur = nxt; cA = nA; cB = nB; ++ui;
    }
    PG8_WAIT_V(0);
    if (wr == 0) PG8_BAR;
    PG8_BAR;
    if constexpr (Epi::AFTER_DRAIN) { E.fused(acc, cur, wr, wc, fr, fq, lds, wid, lane); S.done(cur); }
    PG8_STAMP();
    if (STAMP && wid == 0) { stamps[lane] = lane < nts ? (((unsigned long long)(unsigned)ts_hi << 32) | (unsigned)ts_lo) : 0ull;
        if (lane == 62) stamps[62] = rt_entry; if (lane == 63) stamps[63] = (unsigned long long)wall_clock64(); }
#undef PG8_STAMP
#undef PG8_SA
#undef PG8_SB
#undef PG8_STAGE
#undef PG8_LDA
#undef PG8_LDB
#undef PG8_MMA
#undef PG8_WAIT_V
#undef PG8_WAIT_L
#undef PG8_BAR
#undef PG8_SCHED
}
}

struct EpiBf {
  static constexpr bool PERM = true, AFTER_DRAIN = false;
  u16* O; int ldc; const float* bias; int act;
  __device__ __forceinline__ void operator()(const f32x4 (&acc)[2][2][4][2], const pg8::Unit& u, int wr, int wc, int fr, int fq) const {
    const int row0 = u.pm * 256 + wr * 64 + fr, col0 = u.pn * 256 + wc * 32 + 8 * fq;
    f32x4 bv[2][2];
#pragma unroll
    for (int bj = 0; bj < 2; ++bj)
#pragma unroll
      for (int n = 0; n < 2; ++n) bv[bj][n] = bias ? *(const f32x4*)(bias + col0 + bj * 128 + 4 * n) : f32x4{0.f, 0.f, 0.f, 0.f};
#pragma unroll
    for (int ai = 0; ai < 2; ++ai)
#pragma unroll
      for (int m = 0; m < 4; ++m) {
        u16* rowp = O + (size_t)(row0 + ai * 128 + m * 16) * ldc + col0;
#pragma unroll
        for (int bj = 0; bj < 2; ++bj) {
          f32x4 v0 = acc[ai][bj][m][0] + bv[bj][0], v1 = acc[ai][bj][m][1] + bv[bj][1];
          if (act == 1) {
#pragma unroll
            for (int j = 0; j < 4; ++j) { v0[j] = sigm(v0[j]); v1[j] = sigm(v1[j]); }
          }
          uint4 wv;
          wv.x = pack2(v0[0], v0[1]); wv.y = pack2(v0[2], v0[3]); wv.z = pack2(v1[0], v1[1]); wv.w = pack2(v1[2], v1[3]);
          *(uint4*)(rowp + bj * 128) = wv;
        }
      }
  }
};
struct EpiSwiglu {
  static constexpr bool PERM = true, AFTER_DRAIN = false;
  u16* O;
  __device__ __forceinline__ void operator()(const f32x4 (&acc)[2][2][4][2], const pg8::Unit& u, int wr, int wc, int fr, int fq) const {
    const int row0 = u.pm * 256 + wr * 64 + fr, col0 = u.pn * 128 + wc * 16 + 4 * fq;
#pragma unroll
    for (int ai = 0; ai < 2; ++ai)
#pragma unroll
      for (int m = 0; m < 4; ++m) {
        u16* rowp = O + (size_t)(row0 + ai * 128 + m * 16) * FH + col0;
#pragma unroll
        for (int bj = 0; bj < 2; ++bj) {
          const f32x4 g = acc[ai][bj][m][0], up = acc[ai][bj][m][1];
          uint2 wv;
          wv.x = pack2(siluf(g[0]) * up[0], siluf(g[1]) * up[1]);
          wv.y = pack2(siluf(g[2]) * up[2], siluf(g[3]) * up[3]);
          *(uint2*)(rowp + bj * 64) = wv;
        }
      }
  }
};
template <int MI>
__device__ __forceinline__ void gemm_loop(const u16* __restrict__ A, int lda, const u16* __restrict__ Bt, int ldb, int K,
                                          f32x4 (&acc)[MI][4], u16* sA, u16* sB) {
  constexpr int BMT = MI * 64;
  const int tid = TIDX, lane = tid & 63, w = tid >> 6, wm = w >> 1, wn = w & 1, fr = lane & 15, fq = lane >> 4;
  uint4 ra[MI], rb[2];
  const u16* ga = A + (size_t)(tid >> 3) * lda + (tid & 7) * 8;
  const u16* gb = Bt + (size_t)(tid >> 3) * ldb + (tid & 7) * 8;
  const int so = (tid >> 3) * LDT + (tid & 7) * 8;
#pragma unroll
  for (int i = 0; i < MI; i++) ra[i] = *(const uint4*)(ga + (size_t)(i * 64) * lda);
#pragma unroll
  for (int i = 0; i < 2; i++) rb[i] = *(const uint4*)(gb + (size_t)(i * 64) * ldb);
#pragma unroll
  for (int i = 0; i < MI; i++) *(uint4*)(sA + so + i * 64 * LDT) = ra[i];
#pragma unroll
  for (int i = 0; i < 2; i++) *(uint4*)(sB + so + i * 64 * LDT) = rb[i];
  __syncthreads();
  const int nk = K >> 6;
  for (int kt = 0; kt < nk; kt++) {
    const bool more = kt + 1 < nk;
    if (more) {
#pragma unroll
      for (int i = 0; i < MI; i++) ra[i] = *(const uint4*)(ga + (size_t)(i * 64) * lda + (kt + 1) * 64);
#pragma unroll
      for (int i = 0; i < 2; i++) rb[i] = *(const uint4*)(gb + (size_t)(i * 64) * ldb + (kt + 1) * 64);
    }
    const u16* a = sA + (kt & 1) * BMT * LDT + (wm * (MI * 16) + fr) * LDT + fq * 8;
    const u16* b = sB + (kt & 1) * 128 * LDT + (wn * 64 + fr) * LDT + fq * 8;
#pragma unroll
    for (int ks = 0; ks < 2; ks++) {
      bf16x8 af[MI], bfr[4];
#pragma unroll
      for (int i = 0; i < MI; i++) af[i] = *(const bf16x8*)(a + i * 16 * LDT + ks * 32);
#pragma unroll
      for (int j = 0; j < 4; j++) bfr[j] = *(const bf16x8*)(b + j * 16 * LDT + ks * 32);
#pragma unroll
      for (int i = 0; i < MI; i++)
#pragma unroll
        for (int j = 0; j < 4; j++) acc[i][j] = __builtin_amdgcn_mfma_f32_16x16x32_bf16(bfr[j], af[i], acc[i][j], 0, 0, 0);
    }
    if (more) {
      u16* da = sA + ((kt + 1) & 1) * BMT * LDT + so;
      u16* db = sB + ((kt + 1) & 1) * 128 * LDT + so;
#pragma unroll
      for (int i = 0; i < MI; i++) *(uint4*)(da + i * 64 * LDT) = ra[i];
#pragma unroll
      for (int i = 0; i < 2; i++) *(uint4*)(db + i * 64 * LDT) = rb[i];
    }
    __syncthreads();
  }
}

template <int MI>
__device__ __forceinline__ void zero_acc(f32x4 (&acc)[MI][4]) {
#pragma unroll
  for (int i = 0; i < MI; i++)
#pragma unroll
    for (int j = 0; j < 4; j++) acc[i][j] = f32x4{0.f, 0.f, 0.f, 0.f};
}


typedef unsigned u32x4v __attribute__((ext_vector_type(4)));
__device__ __forceinline__ void yp_issue(const u16* __restrict__ A, const u16* __restrict__ B, u32x4v (&ra)[8], u32x4v (&rb)[8], int tid) {
#pragma unroll
  for (int i = 0; i < 8; i++) {
    const int c = tid + i * NTHR, row = c >> 5, ch = c & 31;
    ra[i] = *(const u32x4v*)(A + (size_t)row * YST + ch * 8);
    rb[i] = *(const u32x4v*)(B + (size_t)row * 256 + ch * 8);
  }
}
__device__ __forceinline__ void yp_stage(unsigned char* sA, unsigned char* sB, const u32x4v (&ra)[8], const u32x4v (&rb)[8], int tid) {
#pragma unroll
  for (int i = 0; i < 8; i++) {
    const int c = tid + i * NTHR, row = c >> 5, ch = c & 31;
    const int off = row * 512 + ((ch ^ (row & 7)) << 4);
    *(u32x4v*)(sA + off) = ra[i];
    *(u32x4v*)(sB + off) = rb[i];
  }
}
__device__ __forceinline__ void phase_ypart(const Params& p, int l, int hf, unsigned char* smem) {
  unsigned char* sA = smem;
  unsigned char* sB = smem + 65536;
  const int tid = TIDX, lane = tid & 63, w = tid >> 6, wm = w >> 1, wn = w & 1, fr = lane & 15, fq = lane >> 4;
  const u16* Y = (const u16*)(p.ws + OFF_YS);
  const u16* Wb = (const u16*)(p.ws + OFF_W + (size_t)l * SZ_WL + OW_B);
  const u16* G = (const u16*)(p.ws + OFF_BIG);
  u16* ACC = (u16*)(p.ws + OFF_BIG + 2 * SZ_ACT);
  constexpr int NT = 8;
  const int ntiles = (NROWS / 128) * NT;
  const int G_ = gridDim.x;
  const int nmine = ((int)blockIdx.x < ntiles) ? (ntiles - 1 - (int)blockIdx.x) / G_ + 1 : 0;
  if (nmine == 0) return;
  u32x4v ra[8], rb[8];
  {
    const int t = blockIdx.x, mt = t / NT, nt = t - mt * NT;
    const int br = hf * 2, yc = br < 3 ? br * 256 : 1536;
    yp_issue(Y + (size_t)mt * 128 * YST + yc, Wb + ((size_t)br * 1024 + nt * 128) * 256, ra, rb, tid);
  }
  f32x4 tot[2][4];
  zero_acc<2>(tot);
  for (int qi = 0; qi < 2 * nmine; qi++) {
    const int q = qi >> 1, k = qi & 1;
    const int t = blockIdx.x + q * G_, mt = t / NT, nt = t - mt * NT;
    const int r0 = mt * 128 + wm * 32 + fr, c0 = nt * 128 + wn * 64 + fq * 4;
    __syncthreads();
    yp_stage(sA, sB, ra, rb, tid);
    __syncthreads();
    {
      const int qn = qi + 1 < 2 * nmine ? qi + 1 : qi;
      const int tn = blockIdx.x + (qn >> 1) * G_, mtn = tn / NT, ntn = tn - mtn * NT;
      const int brn = hf * 2 + (qn & 1), ycn = brn < 3 ? brn * 256 : 1536;
      yp_issue(Y + (size_t)mtn * 128 * YST + ycn, Wb + ((size_t)brn * 1024 + ntn * 128) * 256, ra, rb, tid);
    }
    uint2 gv[2][4];
#pragma unroll
    for (int i = 0; i < 2; i++)
#pragma unroll
      for (int j = 0; j < 4; j++) gv[i][j] = *(const uint2*)(G + (size_t)(r0 + i * 16) * 2048 + k * 1024 + c0 + j * 16);
    f32x4 ay[2][4];
    zero_acc<2>(ay);
#pragma unroll 2
    for (int ks = 0; ks < 8; ks++) {
      bf16x8 af[2], bfr[4];
#pragma unroll
      for (int i = 0; i < 2; i++) {
        const int row = wm * 32 + i * 16 + fr;
        af[i] = *(const bf16x8*)(sA + row * 512 + (((ks * 4 + fq) ^ (row & 7)) << 4));
      }
#pragma unroll
      for (int j = 0; j < 4; j++) {
        const int row = wn * 64 + j * 16 + fr;
        bfr[j] = *(const bf16x8*)(sB + row * 512 + (((ks * 4 + fq) ^ (row & 7)) << 4));
      }
#pragma unroll
      for (int i = 0; i < 2; i++)
#pragma unroll
        for (int j = 0; j < 4; j++) ay[i][j] = __builtin_amdgcn_mfma_f32_16x16x32_bf16(bfr[j], af[i], ay[i][j], 0, 0, 0);
    }
#pragma unroll
    for (int i = 0; i < 2; i++)
#pragma unroll
      for (int j = 0; j < 4; j++) {
        tot[i][j][0] += __uint_as_float(gv[i][j].x << 16) * ay[i][j][0];
        tot[i][j][1] += __uint_as_float(gv[i][j].x & 0xffff0000u) * ay[i][j][1];
        tot[i][j][2] += __uint_as_float(gv[i][j].y << 16) * ay[i][j][2];
        tot[i][j][3] += __uint_as_float(gv[i][j].y & 0xffff0000u) * ay[i][j][3];
      }
    if (k == 1) {
      const unsigned amask = hf ? 0xffffffffu : 0u;
      uint2 av[2][4];
#pragma unroll
      for (int i = 0; i < 2; i++)
#pragma unroll
        for (int j = 0; j < 4; j++) av[i][j] = *(const uint2*)(ACC + (size_t)(r0 + i * 16) * DM + c0 + j * 16);
#pragma unroll
      for (int i = 0; i < 2; i++)
#pragma unroll
        for (int j = 0; j < 4; j++) {
          u16* ap = ACC + (size_t)(r0 + i * 16) * DM + c0 + j * 16;
          f32x4 v = tot[i][j];
          const unsigned ax = av[i][j].x & amask, ay_ = av[i][j].y & amask;
          v[0] += __uint_as_float(ax << 16); v[1] += __uint_as_float(ax & 0xffff0000u);
          v[2] += __uint_as_float(ay_ << 16); v[3] += __uint_as_float(ay_ & 0xffff0000u);
          uint2 ov;
          ov.x = pack2(v[0], v[1]); ov.y = pack2(v[2], v[3]);
          *(uint2*)ap = ov;
        }
      zero_acc<2>(tot);
    }
  }
  __syncthreads();
}

#define S2_BUF 10816
#define S2_D 0
#define S2_U 2048
#define S2_P 4096
#define S2_K 6144
#define S2_DQ 8192
#define S2_V 10240
#define S2_C1 10752
#define S2_C2 10784
#define S2_ST (2 * S2_BUF)
#define S2_YB (S2_ST + 8192)

__device__ __forceinline__ float red16(float x) {
  x += dppf<0xB1>(x);
  x += dppf<0x4E>(x);
  x += dppf<0x141>(x);
  x += dppf<0x140>(x);
  return x;
}
__device__ __forceinline__ void wave_lds_sync() {
  asm volatile("s_waitcnt lgkmcnt(0)" ::: "memory");
  __builtin_amdgcn_wave_barrier();
}

template <int MIX>
__device__ __forceinline__ void scan2_item(const Params& p, int l, int b, int h, int dir, int rq, float* sm) {
  constexpr int EPL = (MIX == 2) ? 2 : 4;
  constexpr int VOFF = (MIX == 2) ? 64 : 128;
  const int tid = TIDX, lane = tid & 63, w = tid >> 6, fr = lane & 15, fq = lane >> 4;
  const bool producer = w >= 4;
  const int pw = w & 3;
  const u16* P = (const u16*)(p.ws + OFF_BIG);
  u16* YS = (u16*)(p.ws + OFF_YS);
  float* BC = (float*)(p.ws + OFF_BC);
  float* ST = sm + S2_ST + pw * 2048;
  float s[EPL];
#pragma unroll
  for (int i = 0; i < EPL; i++) s[i] = 0.f;

  bf16x8 bw2[4], ba2[4];
  float cst[5][4];
  float cw[3][7];
  float muv[4];
  int colv[4];
#pragma unroll
  for (int i = 0; i < 4; i++) { bw2[i] = bf16x8{0, 0, 0, 0, 0, 0, 0, 0}; ba2[i] = bw2[i]; muv[i] = 0.f; colv[i] = 0; }
  if (producer) {
    if (MIX == 0) {
#pragma unroll
      for (int nt = 0; nt < 4; nt++) {
        const int jch = h * 64 + nt * 16 + fr;
#pragma unroll
        for (int jj = 0; jj < 8; jj++) {
          bw2[nt][jj] = (short)f2bf(p.rwkv_w2[((size_t)(l * 2 + dir) * 32 + fq * 8 + jj) * 256 + jch]);
          ba2[nt][jj] = (short)f2bf(p.rwkv_a2[((size_t)(l * 2 + dir) * 32 + fq * 8 + jj) * 256 + jch]);
        }
        cst[0][nt] = p.rwkv_w0[(l * 2 + dir) * 256 + jch];
        cst[1][nt] = p.rwkv_a0[(l * 2 + dir) * 256 + jch];
        cst[2][nt] = p.rwkv_ka[l * 256 + jch];
        cst[3][nt] = p.rwkv_kk[l * 256 + jch];
        cst[4][nt] = p.rwkv_rk[l * 256 + jch];
      }
#pragma unroll
      for (int i = 0; i < 4; i++) {
        const int c = lane + 64 * i;
        colv[i] = i < 3 ? i * 256 + h * 64 + lane : (lane < 32 ? 768 + dir * 32 + lane : 832 + dir * 32 + (lane - 32));
        muv[i] = p.rwkv_mu[l * 960 + colv[i]];
        (void)c;
      }
    } else if (MIX == 1) {
#pragma unroll
      for (int i = 0; i < 3; i++) {
        colv[i] = PB + i * 256 + h * 64 + lane;
#pragma unroll
        for (int tp = 0; tp < 7; tp++) cw[i][tp] = p.gdn_conv[((size_t)l * 7 + tp) * 768 + i * 256 + h * 64 + lane];
      }
    } else {
#pragma unroll
      for (int nt = 0; nt < 2; nt++) {
#pragma unroll
        for (int jj = 0; jj < 8; jj++)
          bw2[nt][jj] = fq < 2 ? (short)f2bf(p.gla_gw2[((size_t)(l * 2 + dir) * 16 + fq * 8 + jj) * 128 + h * 32 + nt * 16 + fr]) : (short)0;
        cst[0][nt] = p.gla_gb[(l * 2 + dir) * 128 + h * 32 + nt * 16 + fr];
      }
      colv[0] = PC + h * 32 + lane;
      if (lane >= 32) colv[0] = PC + 128 + h * 32 + (lane - 32);
      colv[1] = PC + 256 + h * 64 + lane;
      colv[2] = PC + 512 + dir * 16 + (lane & 15);
    }
  }
  __syncthreads();

  for (int c = 0; c <= TPB / 32 + 1; c++) {
    if (producer) {
      if (c >= 2) {
        const int cc = c - 2;
        int seg_row0, t_lo;
        if (cc < 8) { seg_row0 = b * TPB; t_lo = dir == 0 ? cc * 32 : (LC - 32 - cc * 32); }
        else { seg_row0 = b * TPB + LC; t_lo = dir == 0 ? (cc - 8) * 32 : (SEQ - 32 - (cc - 8) * 32); }
        const float* yb = sm + S2_YB + (cc & 1) * 512;
        const int t2 = tid - 256;
#pragma unroll
        for (int i = 0; i < 2; i++) {
          const int idx = t2 + i * 256, tt = idx >> 4, e = idx & 15;
          YS[(size_t)(seg_row0 + t_lo + tt) * YST + dir * 768 + MIX * 256 + h * 64 + rq * 16 + e] = f2bf(yb[idx]);
        }
      }
      if (c < TPB / 32) {
        int seg_row0, seg_len, t_lo;
        if (c < 8) { seg_row0 = b * TPB; seg_len = LC; t_lo = dir == 0 ? c * 32 : (LC - 32 - c * 32); }
        else { seg_row0 = b * TPB + LC; seg_len = SEQ; t_lo = dir == 0 ? (c - 8) * 32 : (SEQ - 32 - (c - 8) * 32); }
        const u16* Pseg = P + (size_t)seg_row0 * PST;
        float* B = sm + (c & 1) * S2_BUF;
        const int t0 = t_lo + pw * 8;
        if (MIX == 0) {
          float raw[10][4];
#pragma unroll
          for (int rr = 0; rr < 10; rr++) {
            const int t = t0 - 1 + rr;
            const float okf = (t >= 0 && t < seg_len) ? 1.f : 0.f;
            const int tc = min(max(t, 0), seg_len - 1);
#pragma unroll
            for (int i = 0; i < 4; i++) raw[rr][i] = bf2f(Pseg[(size_t)tc * PST + PA + colv[i]]) * okf;
          }
#pragma unroll
          for (int j = 0; j < 8; j++)
#pragma unroll
            for (int i = 0; i < 4; i++) {
              float xm = raw[j + 1][i] + (0.5f * (raw[j][i] + raw[j + 2][i]) - raw[j + 1][i]) * muv[i];
              if (i == 3 && lane < 32) xm = tanhf(xm);
              ST[j * 256 + lane + 64 * i] = xm;
            }
        } else if (MIX == 1) {
          float raw[14][3];
#pragma unroll
          for (int rr = 0; rr < 14; rr++) {
            const int t = t0 - 3 + rr;
            const float okf = (t >= 0 && t < seg_len) ? 1.f : 0.f;
            const int tc = min(max(t, 0), seg_len - 1);
#pragma unroll
            for (int i = 0; i < 3; i++) raw[rr][i] = bf2f(Pseg[(size_t)tc * PST + colv[i]]) * okf;
          }
#pragma unroll
          for (int j = 0; j < 8; j++)
#pragma unroll
            for (int i = 0; i < 3; i++) {
              float a = 0.f;
#pragma unroll
              for (int tp = 0; tp < 7; tp++) a += raw[j + tp][i] * cw[i][tp];
              ST[j * 256 + lane + 64 * i] = siluf(a);
            }
          if (lane < 8) {
            const u16* pp = Pseg + (size_t)(t0 + lane) * PST + PB;
            float bx = bf2f(pp[768 + dir * 4 + h]);
            float ax = bf2f(pp[776 + dir * 4 + h]);
            float ld = -__expf(p.gdn_a_log[(l * 2 + dir) * 4 + h]) * softplusf(ax + p.gdn_dt_bias[(l * 2 + dir) * 4 + h]);
            ST[lane * 256 + 192] = sigm(bx);
            ST[lane * 256 + 193] = __expf(ld);
          }
        } else {
          u16 raw[8][3];
#pragma unroll
          for (int j = 0; j < 8; j++) {
            const u16* pp = Pseg + (size_t)(t0 + j) * PST;
#pragma unroll
            for (int i = 0; i < 3; i++) raw[j][i] = pp[colv[i]];
          }
          const float qs = lane < 32 ? 0.17677669529663687f : 1.f;
#pragma unroll
          for (int j = 0; j < 8; j++) {
            ST[j * 256 + lane] = bf2f(raw[j][0]) * qs;
            ST[j * 256 + 64 + lane] = bf2f(raw[j][1]);
            if (lane < 16) ST[j * 256 + 128 + lane] = bf2f(raw[j][2]);
          }
        }
        wave_lds_sync();
        const bool vl = fq < 2;
        if (MIX == 0) {
          bf16x8 aw, aa;
#pragma unroll
          for (int jj = 0; jj < 8; jj++) {
            aw[jj] = fr < 8 ? (short)f2bf(ST[fr * 256 + 192 + fq * 8 + jj]) : (short)0;
            aa[jj] = fr < 8 ? (short)f2bf(ST[fr * 256 + 224 + fq * 8 + jj]) : (short)0;
          }
          f32x4 accw[4], acca[4];
#pragma unroll
          for (int nt = 0; nt < 4; nt++) {
            accw[nt] = __builtin_amdgcn_mfma_f32_16x16x32_bf16(aw, bw2[nt], f32x4{0.f, 0.f, 0.f, 0.f}, 0, 0, 0);
            acca[nt] = __builtin_amdgcn_mfma_f32_16x16x32_bf16(aa, ba2[nt], f32x4{0.f, 0.f, 0.f, 0.f}, 0, 0, 0);
          }
#pragma unroll
          for (int r = 0; r < 4; r++) {
            const int j = (fq & 1) * 4 + r, tt = pw * 8 + j;
            float kkx[4], av[4], kdv[4], rv[4], dec[4];
            float ss = 0.f;
#pragma unroll
            for (int nt = 0; nt < 4; nt++) {
              const int n = nt * 16 + fr;
              rv[nt] = ST[j * 256 + n];
              const float kx = ST[j * 256 + 64 + n];
              dec[nt] = __expf(-0.6065306597126334f * sigm(cst[0][nt] + accw[nt][r]));
              av[nt] = sigm(cst[1][nt] + acca[nt][r]);
              kdv[nt] = kx * (1.f + (av[nt] - 1.f) * cst[2][nt]);
              kkx[nt] = kx * cst[3][nt];
              ss += kkx[nt] * kkx[nt];
            }
            ss = red16(ss);
            const float rs = rsq(ss + 1e-6f);
            float c1 = 0.f, c2 = 0.f, bc = 0.f;
#pragma unroll
            for (int nt = 0; nt < 4; nt++) {
              const int n = nt * 16 + fr;
              const float kk = kkx[nt] * rs;
              if (vl) {
                B[S2_D + tt * 64 + n] = dec[nt];
                B[S2_U + tt * 64 + n] = kk;
                B[S2_P + tt * 64 + n] = -kk * av[nt];
                B[S2_K + tt * 64 + n] = kdv[nt];
                B[S2_DQ + tt * 64 + n] = dec[nt] * rv[nt];
              }
              c1 += -kk * av[nt] * rv[nt];
              c2 += kdv[nt] * rv[nt];
              bc += rv[nt] * kdv[nt] * cst[4][nt];
            }
            c1 = red16(c1); c2 = red16(c2); bc = red16(bc);
            if (vl && fr == 0) {
              B[S2_C1 + tt] = c1;
              B[S2_C2 + tt] = c2;
              if (rq == 0) BC[(size_t)(seg_row0 + t_lo + tt) * 8 + h * 2 + dir] = bc;
            }
          }
        } else if (MIX == 1) {
#pragma unroll
          for (int r = 0; r < 4; r++) {
            const int j = (fq & 1) * 4 + r, tt = pw * 8 + j;
            float qv[4], kv[4];
            float sq = 0.f, sk = 0.f;
#pragma unroll
            for (int nt = 0; nt < 4; nt++) {
              const int n = nt * 16 + fr;
              qv[nt] = ST[j * 256 + n];
              kv[nt] = ST[j * 256 + 64 + n];
              sq += qv[nt] * qv[nt];
              sk += kv[nt] * kv[nt];
            }
            sq = red16(sq); sk = red16(sk);
            const float rq_ = rsq(sq + 1e-6f) * 0.125f, rk_ = rsq(sk + 1e-6f);
            const float beta = ST[j * 256 + 192], alpha = ST[j * 256 + 193];
            float dkq = 0.f;
#pragma unroll
            for (int nt = 0; nt < 4; nt++) {
              const int n = nt * 16 + fr;
              const float qn = qv[nt] * rq_, kn = kv[nt] * rk_;
              if (vl) {
                B[S2_D + tt * 64 + n] = alpha;
                B[S2_U + tt * 64 + n] = kn;
                B[S2_P + tt * 64 + n] = -alpha * beta * kn;
                B[S2_K + tt * 64 + n] = beta * kn;
                B[S2_DQ + tt * 64 + n] = alpha * qn;
              }
              dkq += kn * qn;
            }
            dkq = red16(dkq);
            if (vl && fr == 0) {
              B[S2_C1 + tt] = -alpha * beta * dkq;
              B[S2_C2 + tt] = beta * dkq;
            }
          }
        } else {
          bf16x8 ag;
#pragma unroll
          for (int jj = 0; jj < 8; jj++) ag[jj] = (fr < 8 && fq < 2) ? (short)f2bf(ST[fr * 256 + 128 + fq * 8 + jj]) : (short)0;
          f32x4 accg[2];
#pragma unroll
          for (int nt = 0; nt < 2; nt++) accg[nt] = __builtin_amdgcn_mfma_f32_16x16x32_bf16(ag, bw2[nt], f32x4{0.f, 0.f, 0.f, 0.f}, 0, 0, 0);
#pragma unroll
          for (int r = 0; r < 4; r++) {
            const int j = (fq & 1) * 4 + r, tt = pw * 8 + j;
            float dkq = 0.f;
#pragma unroll
            for (int nt = 0; nt < 2; nt++) {
              const int n = nt * 16 + fr;
              const float lg = cst[0][nt] + accg[nt][r];
              const float ls = fminf(lg, 0.f) - log1pf(__expf(-fabsf(lg)));
              const float alpha = __expf(ls * (1.f / 16.f));
              const float qv = ST[j * 256 + n], kv = ST[j * 256 + 32 + n];
              if (vl) {
                B[S2_D + tt * 64 + n] = alpha;
                B[S2_K + tt * 64 + n] = kv;
                B[S2_DQ + tt * 64 + n] = alpha * qv;
              }
              dkq += kv * qv;
            }
            dkq = red16(dkq);
            if (vl && fr == 0) B[S2_C2 + tt] = dkq;
          }
        }
#pragma unroll
        for (int i = 0; i < 2; i++) {
          const int idx = lane + 64 * i, j = idx >> 4, e = idx & 15;
          B[S2_V + (pw * 8 + j) * 16 + e] = ST[j * 256 + VOFF + rq * 16 + e];
        }
      }
    } else if (c >= 1 && c <= TPB / 32) {
      const float* B = sm + ((c - 1) & 1) * S2_BUF;
      float* yb = sm + S2_YB + ((c - 1) & 1) * 512;
      const int rl = w * 4 + fq;
      const int dtt = dir ? -1 : 1;
      int tt = dir ? 31 : 0;
      float dv[EPL], kv[EPL], qv[EPL], uv[EPL], pv[EPL], vv, c1v, c2v;
      float dn[EPL], kn[EPL], qn[EPL], un[EPL], pn[EPL], vn, c1n, c2n;
#define S2_LOAD(D_, K_, Q_, U_, P_, V_, C1_, C2_, T_)                                   \
  do {                                                                                  \
    const int o_ = (T_) * 64 + fr * EPL;                                                \
    if (EPL == 4) {                                                                     \
      float4 t4 = *(const float4*)(B + S2_D + o_);                                      \
      D_[0] = t4.x; D_[1] = t4.y; D_[2] = t4.z; D_[3] = t4.w;                           \
      t4 = *(const float4*)(B + S2_K + o_);                                             \
      K_[0] = t4.x; K_[1] = t4.y; K_[2] = t4.z; K_[3] = t4.w;                           \
      t4 = *(const float4*)(B + S2_DQ + o_);                                            \
      Q_[0] = t4.x; Q_[1] = t4.y; Q_[2] = t4.z; Q_[3] = t4.w;                           \
      t4 = *(const float4*)(B + S2_U + o_);                                             \
      U_[0] = t4.x; U_[1] = t4.y; U_[2] = t4.z; U_[3] = t4.w;                           \
      t4 = *(const float4*)(B + S2_P + o_);                                             \
      P_[0] = t4.x; P_[1] = t4.y; P_[2] = t4.z; P_[3] = t4.w;                           \
      C1_ = B[S2_C1 + (T_)];                                                            \
    } else {                                                                            \
      float2 t2 = *(const float2*)(B + S2_D + o_);                                      \
      D_[0] = t2.x; D_[1] = t2.y;                                                       \
      t2 = *(const float2*)(B + S2_K + o_);                                             \
      K_[0] = t2.x; K_[1] = t2.y;                                                       \
      t2 = *(const float2*)(B + S2_DQ + o_);                                            \
      Q_[0] = t2.x; Q_[1] = t2.y;                                                       \
      U_[0] = U_[1] = P_[0] = P_[1] = 0.f; C1_ = 0.f;                                   \
    }                                                                                   \
    V_ = B[S2_V + (T_) * 16 + rl];                                                      \
    C2_ = B[S2_C2 + (T_)];                                                              \
  } while (0)
#define S2_STEP(D_, K_, Q_, U_, P_, V_, C1_, C2_, T_)                                   \
  do {                                                                                  \
    float sq = 0.f, sa = 0.f;                                                           \
    _Pragma("unroll") for (int i = 0; i < EPL; i++) sq += s[i] * Q_[i];                 \
    if (MIX != 2) {                                                                     \
      _Pragma("unroll") for (int i = 0; i < EPL; i++) sa += s[i] * U_[i];               \
      sa = red16(sa);                                                                   \
    }                                                                                   \
    sq = red16(sq);                                                                     \
    float y = sq + V_ * C2_;                                                            \
    if (MIX != 2) y += sa * C1_;                                                        \
    _Pragma("unroll") for (int i = 0; i < EPL; i++) {                                   \
      float t = s[i] * D_[i] + V_ * K_[i];                                              \
      if (MIX != 2) t += sa * P_[i];                                                    \
      s[i] = t;                                                                         \
    }                                                                                   \
    yb[(T_) * 16 + rl] = y;                                                             \
  } while (0)
      S2_LOAD(dv, kv, qv, uv, pv, vv, c1v, c2v, tt);
#pragma unroll 1
      for (int st = 0; st < 32; st += 2) {
        const int t1 = tt + dtt;
        S2_LOAD(dn, kn, qn, un, pn, vn, c1n, c2n, t1);
        S2_STEP(dv, kv, qv, uv, pv, vv, c1v, c2v, tt);
        const int t2 = st + 2 < 32 ? t1 + dtt : t1;
        S2_LOAD(dv, kv, qv, uv, pv, vv, c1v, c2v, t2);
        S2_STEP(dn, kn, qn, un, pn, vn, c1n, c2n, t1);
        tt = t2;
      }
#undef S2_LOAD
#undef S2_STEP
    }
    __syncthreads();
  }
}

#define S3_SUB 12800
#define S3_GM 0
#define S3_KVT 9216
#define S3_QB 10240
#define S3_QV 11392
#define S3_VT 11520
#define S3_WC 12544
#define S3_STB (8 * S3_SUB)
#define S3_END (S3_STB + 4 * 2304)

__device__ __forceinline__ float rlane(float x, int l) { return __int_as_float(__builtin_amdgcn_readlane(__float_as_int(x), l)); }
__device__ __forceinline__ float wave_sum(float x) {
  x = red16(x);
  return (rlane(x, 0) + rlane(x, 16)) + (rlane(x, 32) + rlane(x, 48));
}
__device__ __forceinline__ float clampe(float x) { return fminf(fmaxf(x, -80.f), 80.f); }
__device__ __forceinline__ uint4 pack8(const float (&v)[8]) {
  return make_uint4(pack2(v[0], v[1]), pack2(v[2], v[3]), pack2(v[4], v[5]), pack2(v[6], v[7]));
}
__device__ __forceinline__ bf16x8 ld_frag(const void* p) { return *(const bf16x8*)p; }
__device__ __forceinline__ bf16x8 zfrag() { return bf16x8{0, 0, 0, 0, 0, 0, 0, 0}; }

__device__ __forceinline__ void chunk_geom(int c, int dir, int b, int& seg_row0, int& seg_len, int& t_lo) {
  if (c < 8) { seg_row0 = b * TPB; seg_len = LC; t_lo = dir == 0 ? c * 32 : (LC - 32 - c * 32); }
  else { seg_row0 = b * TPB + LC; seg_len = SEQ; t_lo = dir == 0 ? (c - 8) * 32 : (SEQ - 32 - (c - 8) * 32); }
}
template <int MIX>
__device__ __forceinline__ void fetch_raw(const u16* P, int c, int dir, int b, int h, int pw, int lane, const int (&colv)[4], unsigned (&rawq)[14][2]) {
  int seg_row0, seg_len, t_lo;
  chunk_geom(c, dir, b, seg_row0, seg_len, t_lo);
  const u16* Pseg = P + (size_t)seg_row0 * PST;
  const int t0 = t_lo + pw * 8;
  if (MIX == 0) {
#pragma unroll
    for (int rr = 0; rr < 10; rr++) {
      const int tc = min(max(t0 - 1 + rr, 0), seg_len - 1);
#pragma unroll
      for (int i = 0; i < 2; i++)
        rawq[rr][i] = (unsigned)Pseg[(size_t)tc * PST + PA + colv[2 * i]] | ((unsigned)Pseg[(size_t)tc * PST + PA + colv[2 * i + 1]] << 16);
    }
  } else if (MIX == 1) {
#pragma unroll
    for (int rr = 0; rr < 14; rr++) {
      const int tc = min(max(t0 - 3 + rr, 0), seg_len - 1);
      rawq[rr][0] = (unsigned)Pseg[(size_t)tc * PST + colv[0]] | ((unsigned)Pseg[(size_t)tc * PST + colv[1]] << 16);
      rawq[rr][1] = (rawq[rr][1] & 0xffff0000u) | (unsigned)Pseg[(size_t)tc * PST + colv[2]];
    }
    const u16* pp = Pseg + (size_t)(t0 + (lane & 7)) * PST + PB;
    rawq[0][1] = (rawq[0][1] & 0xffffu) | ((unsigned)pp[768 + dir * 4 + h] << 16);
    rawq[1][1] = (rawq[1][1] & 0xffffu) | ((unsigned)pp[776 + dir * 4 + h] << 16);
  } else {
#pragma unroll
    for (int j = 0; j < 8; j++) {
      const u16* pp = Pseg + (size_t)(t0 + j) * PST;
      rawq[j][0] = (unsigned)pp[colv[0]] | ((unsigned)pp[colv[1]] << 16);
      rawq[j][1] = (unsigned)pp[colv[2]];
    }
  }
}

template <int MIX>
__device__ __forceinline__ void scan3_item(const Params& p, int l, int b, int h, int dir, unsigned char* smb) {
  constexpr int VOFF = (MIX == 2) ? 64 : 128;
  constexpr bool DELTA = (MIX != 2);
  const int tid = TIDX, lane = tid & 63, w = tid >> 6, fr = lane & 15, fq = lane >> 4;
  const bool producer = true;
  const int pw = w & 3, half = w >> 2;
  const u16* P = (const u16*)(p.ws + OFF_BIG);
  u16* YS = (u16*)(p.ws + OFF_YS);
  float* BC = (float*)(p.ws + OFF_BC);
  float* ST = (float*)(smb + w * S3_SUB + S3_GM);
  unsigned char* STBY = smb + w * S3_SUB + S3_GM;
  const f32x4 z4 = f32x4{0.f, 0.f, 0.f, 0.f};
  f32x4 st[4];
#pragma unroll
  for (int i = 0; i < 4; i++) st[i] = z4;

  bf16x8 bw2[4], ba2[4];
  float cw[3][7];
  float muv[4];
  int colv[4];
  float c_w0 = 0.f, c_a0 = 0.f, c_ka = 0.f, c_kk = 0.f, c_rk = 0.f, c_gb = 0.f;
#pragma unroll
  for (int i = 0; i < 4; i++) { bw2[i] = zfrag(); ba2[i] = zfrag(); muv[i] = 0.f; colv[i] = 0; }
  if (producer) {
    if (MIX == 0) {
#pragma unroll
      for (int nt = 0; nt < 4; nt++) {
        const int jch = h * 64 + nt * 16 + fr;
#pragma unroll
        for (int jj = 0; jj < 8; jj++) {
          bw2[nt][jj] = (short)f2bf(p.rwkv_w2[((size_t)(l * 2 + dir) * 32 + fq * 8 + jj) * 256 + jch]);
          ba2[nt][jj] = (short)f2bf(p.rwkv_a2[((size_t)(l * 2 + dir) * 32 + fq * 8 + jj) * 256 + jch]);
        }
      }
      const int jl = h * 64 + lane;
      c_w0 = p.rwkv_w0[(l * 2 + dir) * 256 + jl];
      c_a0 = p.rwkv_a0[(l * 2 + dir) * 256 + jl];
      c_ka = p.rwkv_ka[l * 256 + jl];
      c_kk = p.rwkv_kk[l * 256 + jl];
      c_rk = p.rwkv_rk[l * 256 + jl];
#pragma unroll
      for (int i = 0; i < 4; i++) {
        colv[i] = i < 3 ? i * 256 + h * 64 + lane : (lane < 32 ? 768 + dir * 32 + lane : 832 + dir * 32 + (lane - 32));
        muv[i] = p.rwkv_mu[l * 960 + colv[i]];
      }
    } else if (MIX == 1) {
#pragma unroll
      for (int i = 0; i < 3; i++) {
        colv[i] = PB + i * 256 + h * 64 + lane;
#pragma unroll
        for (int tp = 0; tp < 7; tp++) cw[i][tp] = p.gdn_conv[((size_t)l * 7 + tp) * 768 + i * 256 + h * 64 + lane];
      }
    } else {
#pragma unroll
      for (int nt = 0; nt < 2; nt++) {
#pragma unroll
        for (int jj = 0; jj < 8; jj++)
          bw2[nt][jj] = fq < 2 ? (short)f2bf(p.gla_gw2[((size_t)(l * 2 + dir) * 16 + fq * 8 + jj) * 128 + h * 32 + nt * 16 + fr]) : (short)0;
      }
      c_gb = p.gla_gb[(l * 2 + dir) * 128 + h * 32 + (lane & 31)];
      colv[0] = PC + h * 32 + lane;
      if (lane >= 32) colv[0] = PC + 128 + h * 32 + (lane - 32);
      colv[1] = PC + 256 + h * 64 + lane;
      colv[2] = PC + 512 + dir * 16 + (lane & 15);
    }
  }
  __syncthreads();
  unsigned rawq[14][2];
#pragma unroll
  for (int i = 0; i < 14; i++) { rawq[i][0] = 0u; rawq[i][1] = 0u; }
  fetch_raw<MIX>(P, half, dir, b, h, pw, lane, colv, rawq);
#define RAWP(r_, i_) ((u16)((rawq[r_][(i_) >> 1] >> (((i_) & 1) * 16)) & 0xffffu))

  for (int it = 0; it < TPB / 64; it++) {
    {
      {
        const int c = it * 2 + half;
        int seg_row0, seg_len, t_lo;
        chunk_geom(c, dir, b, seg_row0, seg_len, t_lo);
        unsigned char* SB = smb + w * S3_SUB;
        const int t0 = t_lo + pw * 8;
        if (MIX == 0) {
          float raw[10][4];
#pragma unroll
          for (int rr = 0; rr < 10; rr++) {
            const int t = t0 - 1 + rr;
            const float okf = (t >= 0 && t < seg_len) ? 1.f : 0.f;
#pragma unroll
            for (int i = 0; i < 4; i++) raw[rr][i] = bf2f(RAWP(rr, i)) * okf;
          }
#pragma unroll
          for (int j = 0; j < 8; j++)
#pragma unroll
            for (int i = 0; i < 4; i++) {
              float xm = raw[j + 1][i] + (0.5f * (raw[j][i] + raw[j + 2][i]) - raw[j + 1][i]) * muv[i];
              if (i == 3 && lane < 32) xm = tanhf(xm);
              ST[j * 256 + lane + 64 * i] = xm;
            }
        } else if (MIX == 1) {
          float raw[14][3];
#pragma unroll
          for (int rr = 0; rr < 14; rr++) {
            const int t = t0 - 3 + rr;
            const float okf = (t >= 0 && t < seg_len) ? 1.f : 0.f;
#pragma unroll
            for (int i = 0; i < 3; i++) raw[rr][i] = bf2f(RAWP(rr, i)) * okf;
          }
#pragma unroll
          for (int j = 0; j < 8; j++)
#pragma unroll
            for (int i = 0; i < 3; i++) {
              float a = 0.f;
#pragma unroll
              for (int tp = 0; tp < 7; tp++) a += raw[j + tp][i] * cw[i][tp];
              ST[j * 256 + lane + 64 * i] = siluf(a);
            }
          if (lane < 8) {
            float bx = bf2f(RAWP(0, 3));
            float ax = bf2f(RAWP(1, 3));
            float ld = -__expf(p.gdn_a_log[(l * 2 + dir) * 4 + h]) * softplusf(ax + p.gdn_dt_bias[(l * 2 + dir) * 4 + h]);
            ST[lane * 256 + 192] = sigm(bx);
            ST[lane * 256 + 193] = ld;
          }
        } else {
          const float qs = lane < 32 ? 0.17677669529663687f : 1.f;
#pragma unroll
          for (int j = 0; j < 8; j++) {
            ST[j * 256 + lane] = bf2f(RAWP(j, 0)) * qs;
            ST[j * 256 + 64 + lane] = bf2f(RAWP(j, 1));
            if (lane < 16) ST[j * 256 + 128 + lane] = bf2f(RAWP(j, 2));
          }
        }
        wave_lds_sync();
        {
          float vv[8];
#pragma unroll
          for (int i = 0; i < 8; i++) vv[i] = ST[(dir ? 7 - i : i) * 256 + VOFF + lane];
          *(uint4*)(SB + S3_VT + lane * 16) = pack8(vv);
        }
        if (MIX == 0) {
          bf16x8 aw, aa;
#pragma unroll
          for (int jj = 0; jj < 8; jj++) {
            aw[jj] = fr < 8 ? (short)f2bf(ST[fr * 256 + 192 + fq * 8 + jj]) : (short)0;
            aa[jj] = fr < 8 ? (short)f2bf(ST[fr * 256 + 224 + fq * 8 + jj]) : (short)0;
          }
          f32x4 accw[4], acca[4];
#pragma unroll
          for (int nt = 0; nt < 4; nt++) {
            accw[nt] = __builtin_amdgcn_mfma_f32_16x16x32_bf16(aw, bw2[nt], z4, 0, 0, 0);
            acca[nt] = __builtin_amdgcn_mfma_f32_16x16x32_bf16(aa, ba2[nt], z4, 0, 0, 0);
          }
          wave_lds_sync();
          if (fq < 2) {
#pragma unroll
            for (int nt = 0; nt < 4; nt++)
#pragma unroll
              for (int r = 0; r < 4; r++) {
                ST[(fq * 4 + r) * 256 + 128 + nt * 16 + fr] = accw[nt][r];
                ST[(fq * 4 + r) * 256 + 192 + nt * 16 + fr] = acca[nt][r];
              }
          }
          wave_lds_sync();
        } else if (MIX == 2) {
          bf16x8 ag;
#pragma unroll
          for (int jj = 0; jj < 8; jj++) ag[jj] = (fr < 8 && fq < 2) ? (short)f2bf(ST[fr * 256 + 128 + fq * 8 + jj]) : (short)0;
          f32x4 accg[2];
#pragma unroll
          for (int nt = 0; nt < 2; nt++) accg[nt] = __builtin_amdgcn_mfma_f32_16x16x32_bf16(ag, bw2[nt], z4, 0, 0, 0);
          if (fq < 2) {
#pragma unroll
            for (int nt = 0; nt < 2; nt++)
#pragma unroll
              for (int r = 0; r < 4; r++) ST[(fq * 4 + r) * 256 + 192 + nt * 16 + fr] = accg[nt][r];
          }
          wave_lds_sync();
        }
        float logd[8], kap[8], bb[8], kp[8], qq[8];
#pragma unroll
        for (int i = 0; i < 8; i++) {
          const int j = dir ? 7 - i : i;
          const float* row = ST + j * 256;
          if (MIX == 0) {
            const float r_ = row[lane], k_ = row[64 + lane];
            const float sg = sigm(c_w0 + row[128 + lane]);
            const float a_ = sigm(c_a0 + row[192 + lane]);
            const float kd = k_ * (1.f + (a_ - 1.f) * c_ka);
            const float kkx = k_ * c_kk;
            const float ss = wave_sum(kkx * kkx);
            const float kk = kkx * rsq(ss + 1e-6f);
            const float bc = wave_sum(r_ * kd * c_rk);
            if (lane == 0) BC[(size_t)(seg_row0 + t0 + j) * 8 + h * 2 + dir] = bc;
            logd[i] = -0.6065306597126334f * sg;
            kap[i] = kk; bb[i] = kk * a_; kp[i] = kd; qq[i] = r_;
          } else if (MIX == 1) {
            const float q_ = row[lane], k_ = row[64 + lane];
            const float sq = wave_sum(q_ * q_), sk = wave_sum(k_ * k_);
            const float qn = q_ * rsq(sq + 1e-6f) * 0.125f, kn = k_ * rsq(sk + 1e-6f);
            const float beta = row[192], ld = row[193];
            const float alpha = __expf(ld);
            logd[i] = ld;
            kap[i] = kn; bb[i] = alpha * beta * kn; kp[i] = beta * kn; qq[i] = qn;
          } else {
            const int n = lane & 31;
            const float lg = c_gb + row[192 + n];
            const float ls = fminf(lg, 0.f) - log1pf(__expf(-fabsf(lg)));
            logd[i] = ls * (1.f / 16.f);
            kap[i] = 0.f; bb[i] = 0.f;
            kp[i] = lane < 32 ? row[32 + n] : 0.f;
            qq[i] = lane < 32 ? row[n] : 0.f;
          }
        }
        wave_lds_sync();
        float kt[8], qt[8], bck[8], kck[8];
        {
          float L[8];
          float run = 0.f;
#pragma unroll
          for (int i = 0; i < 8; i++) { run += logd[i]; L[i] = run; }
          const float Lr = L[3], L7 = L[7];
          float prevE = __expf(clampe(-Lr)), prevT = 1.f;
          u16* OPA = (u16*)STBY;
#pragma unroll
          for (int i = 0; i < 8; i++) {
            const float eI = __expf(clampe(L[i] - Lr)), eInv = __expf(clampe(Lr - L[i]));
            const float tI = __expf(L[i]), eEnd = __expf(L7 - L[i]);
            if (DELTA) {
              OPA[0 * 576 + i * 72 + lane] = f2bf(kap[i] * prevE);
              OPA[1 * 576 + i * 72 + lane] = f2bf(bb[i] * eInv);
            }
            OPA[2 * 576 + i * 72 + lane] = f2bf(kp[i] * eInv);
            OPA[3 * 576 + i * 72 + lane] = f2bf(qq[i] * eI);
            kt[i] = kap[i] * prevT; qt[i] = qq[i] * tI;
            bck[i] = bb[i] * eEnd; kck[i] = kp[i] * eEnd;
            prevE = eI; prevT = tI;
          }
          *(float*)(SB + S3_WC + lane * 4) = __expf(L7);
        }
        wave_lds_sync();
        f32x4 accA = z4, accBm = z4, accQb = z4, accQk = z4;
        {
          const u16* OPA = (const u16*)STBY;
          const int ro = (fr & 7) * 72 + fq * 8;
#pragma unroll
          for (int ks = 0; ks < 2; ks++) {
            const bf16x8 fk = ld_frag(OPA + 2 * 576 + ro + ks * 32), fqh = ld_frag(OPA + 3 * 576 + ro + ks * 32);
            accQk = __builtin_amdgcn_mfma_f32_16x16x32_bf16(fqh, fk, accQk, 0, 0, 0);
            if (DELTA) {
              const bf16x8 fka = ld_frag(OPA + 0 * 576 + ro + ks * 32), fb = ld_frag(OPA + 1 * 576 + ro + ks * 32);
              accA = __builtin_amdgcn_mfma_f32_16x16x32_bf16(fka, fb, accA, 0, 0, 0);
              accBm = __builtin_amdgcn_mfma_f32_16x16x32_bf16(fka, fk, accBm, 0, 0, 0);
              accQb = __builtin_amdgcn_mfma_f32_16x16x32_bf16(fqh, fb, accQb, 0, 0, 0);
            }
          }
#pragma unroll
          for (int r = 0; r < 4; r++) {
            const int i = fq * 4 + r;
            const bool ok = fq < 2 && fr < 8;
            if (!(ok && fr < i)) { accA[r] = 0.f; accBm[r] = 0.f; }
            if (!(ok && fr <= i)) { accQb[r] = 0.f; accQk[r] = 0.f; }
          }
        }
        float bmc[8], qkc[8];
#pragma unroll
        for (int m = 0; m < 4; m++) {
          bmc[m] = accBm[m]; qkc[m] = accQk[m];
          bmc[m + 4] = __shfl(accBm[m], (lane & 15) + 16);
          qkc[m + 4] = __shfl(accQk[m], (lane & 15) + 16);
        }
        float kbar[8], qbar[8], Kv[8], TB[8], Qv[8];
        if (DELTA) {
          float t[8];
#pragma unroll
          for (int i = 0; i < 8; i++) {
            float ti = (lane == i) ? 1.f : 0.f;
#pragma unroll
            for (int m = 0; m < i; m++) ti -= rlane(accA[i & 3], (i >> 2) * 16 + m) * t[m];
            t[i] = ti;
          }
#pragma unroll
          for (int i = 0; i < 8; i++) {
            float tb = 0.f, kb = 0.f;
#pragma unroll
            for (int m = 0; m <= i; m++) {
              const float tim = rlane(t[i], m);
              tb += tim * bmc[m];
              kb += tim * kt[m];
            }
            TB[i] = tb; kbar[i] = kb;
            float qv = qkc[i], qb = qt[i];
#pragma unroll
            for (int m = 0; m <= i; m++) {
              const float qbim = rlane(accQb[i & 3], (i >> 2) * 16 + m);
              qv -= qbim * TB[m];
              qb -= qbim * kbar[m];
            }
            Qv[i] = qv; qbar[i] = qb;
          }
#pragma unroll
          for (int j = 0; j < 8; j++) Kv[j] = kck[j];
#pragma unroll
          for (int i = 1; i < 8; i++)
#pragma unroll
            for (int j = 0; j < i; j++) Kv[j] -= rlane(TB[i], j) * bck[i];
        } else {
#pragma unroll
          for (int i = 0; i < 8; i++) { Qv[i] = qkc[i]; qbar[i] = qt[i]; Kv[i] = kck[i]; kbar[i] = 0.f; TB[i] = 0.f; }
        }
        *(uint4*)(SB + S3_KVT + lane * 16) = pack8(Kv);
#pragma unroll
        for (int i = 0; i < 8; i++) ((u16*)(SB + S3_QB))[i * 72 + lane] = f2bf(qbar[i]);
        if (lane < 8) {
#pragma unroll
          for (int i = 0; i < 8; i++) ((u16*)(SB + S3_QV))[i * 8 + lane] = f2bf(Qv[i]);
        }
        if (DELTA) {
          float nk[8];
#pragma unroll
          for (int i = 0; i < 8; i++) nk[i] = -kbar[i];
          *(uint4*)(STBY + 4608 + lane * 16) = pack8(bck);
          *(uint4*)(STBY + 5632 + lane * 16) = pack8(nk);
          wave_lds_sync();
          bf16x8 fa[4], fb[4];
#pragma unroll
          for (int x = 0; x < 4; x++) {
            fa[x] = fq == 0 ? ld_frag(STBY + 5632 + (x * 16 + fr) * 16) : zfrag();
            fb[x] = fq == 0 ? ld_frag(STBY + 4608 + (x * 16 + fr) * 16) : zfrag();
          }
#pragma unroll
          for (int nt = 0; nt < 4; nt++)
#pragma unroll
            for (int mt = 0; mt < 4; mt++) {
              const f32x4 g = __builtin_amdgcn_mfma_f32_16x16x32_bf16(fa[mt], fb[nt], z4, 0, 0, 0);
              uint2 gv;
              gv.x = pack2(g[0], g[1]); gv.y = pack2(g[2], g[3]);
              *(uint2*)(SB + S3_GM + ((nt * 16 + fr) * 72 + mt * 16 + fq * 4) * 2) = gv;
            }
        }
      }
    }
    fetch_raw<MIX>(P, min(it + 1, TPB / 64 - 1) * 2 + half, dir, b, h, pw, lane, colv, rawq);
    __syncthreads();
    if (w < 4) {
      unsigned char* STB = smb + S3_STB + w * 2304;
#pragma unroll 1
      for (int kk = 0; kk < 8; kk++) {
        const int cc = it * 2 + (kk >> 2), k = kk & 3;
        int seg_row0, t_lo;
        if (cc < 8) { seg_row0 = b * TPB; t_lo = dir == 0 ? cc * 32 : (LC - 32 - cc * 32); }
        else { seg_row0 = b * TPB + LC; t_lo = dir == 0 ? (cc - 8) * 32 : (SEQ - 32 - (cc - 8) * 32); }
        const int sc = dir ? 3 - k : k;
        const unsigned char* SB = smb + ((kk >> 2) * 4 + sc) * S3_SUB;
#pragma unroll
        for (int nt = 0; nt < 4; nt++) {
          uint2 sv;
          sv.x = pack2(st[nt][0], st[nt][1]); sv.y = pack2(st[nt][2], st[nt][3]);
          *(uint2*)(STB + (fr * 72 + nt * 16 + fq * 4) * 2) = sv;
        }
        wave_lds_sync();
        const bf16x8 bs0 = ld_frag(STB + (fr * 72 + fq * 8) * 2), bs1 = ld_frag(STB + (fr * 72 + 32 + fq * 8) * 2);
        const bf16x8 bv = fq == 0 ? ld_frag(SB + S3_VT + (w * 16 + fr) * 16) : zfrag();
        const bf16x8 aq0 = ld_frag(SB + S3_QB + ((fr & 7) * 72 + fq * 8) * 2), aq1 = ld_frag(SB + S3_QB + ((fr & 7) * 72 + 32 + fq * 8) * 2);
        const bf16x8 aqv = fq == 0 ? ld_frag(SB + S3_QV + (fr & 7) * 16) : zfrag();
        f32x4 accY = __builtin_amdgcn_mfma_f32_16x16x32_bf16(aq0, bs0, z4, 0, 0, 0);
        accY = __builtin_amdgcn_mfma_f32_16x16x32_bf16(aq1, bs1, accY, 0, 0, 0);
        accY = __builtin_amdgcn_mfma_f32_16x16x32_bf16(aqv, bv, accY, 0, 0, 0);
        if (fq < 2) {
#pragma unroll
          for (int r = 0; r < 4; r++) {
            const int i = fq * 4 + r, j = dir ? 7 - i : i;
            YS[(size_t)(seg_row0 + t_lo + sc * 8 + j) * YST + dir * 768 + MIX * 256 + h * 64 + w * 16 + fr] = f2bf(accY[r]);
          }
        }
#pragma unroll
        for (int nt = 0; nt < 4; nt++) {
          f32x4 an = z4;
          if (DELTA) {
            const bf16x8 g0 = ld_frag(SB + S3_GM + ((nt * 16 + fr) * 72 + fq * 8) * 2), g1 = ld_frag(SB + S3_GM + ((nt * 16 + fr) * 72 + 32 + fq * 8) * 2);
            an = __builtin_amdgcn_mfma_f32_16x16x32_bf16(g0, bs0, an, 0, 0, 0);
            an = __builtin_amdgcn_mfma_f32_16x16x32_bf16(g1, bs1, an, 0, 0, 0);
          }
          const bf16x8 akv = fq == 0 ? ld_frag(SB + S3_KVT + (nt * 16 + fr) * 16) : zfrag();
          an = __builtin_amdgcn_mfma_f32_16x16x32_bf16(akv, bv, an, 0, 0, 0);
          const float4 wc = *(const float4*)(SB + S3_WC + (nt * 16 + fq * 4) * 4);
          st[nt][0] = st[nt][0] * wc.x + an[0];
          st[nt][1] = st[nt][1] * wc.y + an[1];
          st[nt][2] = st[nt][2] * wc.z + an[2];
          st[nt][3] = st[nt][3] * wc.w + an[3];
        }
        wave_lds_sync();
      }
    }
    __syncthreads();
  }
}

__device__ __forceinline__ void attn_item(const Params& p, int l, int b, int qb, int hk, bool isctx, unsigned char* smem) {
  u16* KS = (u16*)smem;
  u16* VT = KS + 64 * LDT;
  u16* PL = VT + 64 * LDT;
  float2* ROPE = (float2*)(PL + 8 * 32 * LDT);
  const int tid = TIDX, lane = tid & 63, w = tid >> 6, fr = lane & 15, fq = lane >> 4;
  const u16* P = (const u16*)(p.ws + OFF_BIG);
  u16* Y = (u16*)(p.ws + OFF_YS);
  const int qh = hk * 2 + (w >> 2);
  const int tb = qb * 128 + (w & 3) * 32;
  const int qrow0 = b * TPB + (isctx ? 0 : LC);
  __syncthreads();
  for (int i = tid; i < 1024; i += NTHR) {
    int pos = i >> 4, fi = i & 15;
    float inv = powf(10000.f, -(float)fi / 16.f);
    float sn, cs;
    sincosf((float)pos * inv, &sn, &cs);
    ROPE[i] = make_float2(cs, sn);
  }
  __syncthreads();
  bf16x8 qf[2][2];
#pragma unroll
  for (int mi = 0; mi < 2; mi++)
#pragma unroll
    for (int ks = 0; ks < 2; ks++) {
      const int tq = tb + mi * 16 + fr;
      const u16* qp = P + (size_t)(qrow0 + tq) * PST + PD + qh * 64 + ks * 32;
      uint4 own = *(const uint4*)(qp + fq * 8);
      uint4 par = *(const uint4*)(qp + (fq ^ 2) * 8);
      const unsigned ow[4] = {own.x, own.y, own.z, own.w};
      const unsigned pw[4] = {par.x, par.y, par.z, par.w};
      const int pos = ks == 0 ? (tq >> 6) : (tq & 63);
      bf16x8 f;
#pragma unroll
      for (int jj = 0; jj < 8; jj++) {
        float xo = bf2f((u16)((ow[jj >> 1] >> ((jj & 1) * 16)) & 0xffff));
        float xp = bf2f((u16)((pw[jj >> 1] >> ((jj & 1) * 16)) & 0xffff));
        float v = xo;
        if (!isctx) {
          float2 cs = ROPE[pos * 16 + (fq & 1) * 8 + jj];
          v = fq < 2 ? xo * cs.x - xp * cs.y : xp * cs.y + xo * cs.x;
        }
        f[jj] = (short)f2bf(v * 0.125f);
      }
      qf[mi][ks] = f;
    }
  f32x4 oacc[2][4];
#pragma unroll
  for (int mi = 0; mi < 2; mi++)
#pragma unroll
    for (int nd = 0; nd < 4; nd++) oacc[mi][nd] = f32x4{0.f, 0.f, 0.f, 0.f};
  float mrow[2][4], lrow[2][4];
#pragma unroll
  for (int mi = 0; mi < 2; mi++)
#pragma unroll
    for (int r = 0; r < 4; r++) { mrow[mi][r] = -1e30f; lrow[mi][r] = 0.f; }

  const int q0 = qb * 128;
  const int band_lo = isctx ? 0 : max(0, q0 - 128), band_hi = isctx ? 0 : min(SEQ, q0 + 256);
  const int ntile = 4 + (band_hi - band_lo) / 64;
  u16* pl = PL + w * 32 * LDT;
  for (int tl = 0; tl < ntile; tl++) {
    const bool band = tl >= 4;
    const int k0 = band ? band_lo + (tl - 4) * 64 : tl * 64;
    __syncthreads();
    {
      const int key = tid >> 3, kc = tid & 7;
      const int kpos = k0 + key;
      const u16* kp = P + (size_t)(b * TPB + (band ? LC : 0) + kpos) * PST + PD + 256 + hk * 64;
      uint4 own = *(const uint4*)(kp + kc * 8);
      uint4 vv = *(const uint4*)(kp + 128 + kc * 8);
      uint4 par = *(const uint4*)(kp + (kc ^ 2) * 8);
      if (band) {
        const unsigned ow[4] = {own.x, own.y, own.z, own.w};
        const unsigned pw[4] = {par.x, par.y, par.z, par.w};
        const int pos = kc < 4 ? (kpos >> 6) : (kpos & 63);
        unsigned res[4];
#pragma unroll
        for (int jj = 0; jj < 8; jj += 2) {
          float v2[2];
#pragma unroll
          for (int e = 0; e < 2; e++) {
            float xo = bf2f((u16)((ow[jj >> 1] >> (e * 16)) & 0xffff));
            float xp = bf2f((u16)((pw[jj >> 1] >> (e * 16)) & 0xffff));
            float2 cs = ROPE[pos * 16 + (kc & 1) * 8 + jj + e];
            v2[e] = (kc & 2) == 0 ? xo * cs.x - xp * cs.y : xp * cs.y + xo * cs.x;
          }
          res[jj >> 1] = pack2(v2[0], v2[1]);
        }
        own = make_uint4(res[0], res[1], res[2], res[3]);
      }
      *(uint4*)(KS + key * LDT + kc * 8) = own;
      const unsigned vw[4] = {vv.x, vv.y, vv.z, vv.w};
#pragma unroll
      for (int jj = 0; jj < 8; jj++) VT[(kc * 8 + jj) * LDT + key] = (u16)((vw[jj >> 1] >> ((jj & 1) * 16)) & 0xffff);
    }
    __syncthreads();
    f32x4 sc[2][4];
#pragma unroll
    for (int mi = 0; mi < 2; mi++)
#pragma unroll
      for (int nj = 0; nj < 4; nj++) sc[mi][nj] = f32x4{0.f, 0.f, 0.f, 0.f};
#pragma unroll
    for (int ks = 0; ks < 2; ks++) {
      bf16x8 kf[4];
#pragma unroll
      for (int nj = 0; nj < 4; nj++) kf[nj] = *(const bf16x8*)(KS + (nj * 16 + fr) * LDT + ks * 32 + fq * 8);
#pragma unroll
      for (int mi = 0; mi < 2; mi++)
#pragma unroll
        for (int nj = 0; nj < 4; nj++) sc[mi][nj] = __builtin_amdgcn_mfma_f32_16x16x32_bf16(qf[mi][ks], kf[nj], sc[mi][nj], 0, 0, 0);
    }
#pragma unroll
    for (int mi = 0; mi < 2; mi++)
#pragma unroll
      for (int r = 0; r < 4; r++) {
        const int qpos = tb + mi * 16 + fq * 4 + r;
        float mx = -1e30f;
#pragma unroll
        for (int nj = 0; nj < 4; nj++) {
          float v = sc[mi][nj][r];
          if (band) {
            int d = qpos - (k0 + nj * 16 + fr);
            if (d > 128 || d < -128) v = -1e30f;
          }
          sc[mi][nj][r] = v;
          mx = fmaxf(mx, v);
        }
        mx = fmaxf(mx, __shfl_xor(mx, 1));
        mx = fmaxf(mx, __shfl_xor(mx, 2));
        mx = fmaxf(mx, __shfl_xor(mx, 4));
        mx = fmaxf(mx, __shfl_xor(mx, 8));
        const float mnew = fmaxf(mrow[mi][r], mx);
        const float alpha = __expf(mrow[mi][r] - mnew);
        mrow[mi][r] = mnew;
        float ls = 0.f;
#pragma unroll
        for (int nj = 0; nj < 4; nj++) {
          float pe = __expf(sc[mi][nj][r] - mnew);
          ls += pe;
          pl[(mi * 16 + fq * 4 + r) * LDT + nj * 16 + fr] = f2bf(pe);
        }
        lrow[mi][r] = lrow[mi][r] * alpha + ls;
#pragma unroll
        for (int nd = 0; nd < 4; nd++) oacc[mi][nd][r] *= alpha;
      }
    asm volatile("s_waitcnt lgkmcnt(0)" ::: "memory");
    __builtin_amdgcn_wave_barrier();
#pragma unroll
    for (int ks = 0; ks < 2; ks++) {
      bf16x8 pf[2], vf[4];
#pragma unroll
      for (int mi = 0; mi < 2; mi++) pf[mi] = *(const bf16x8*)(pl + (mi * 16 + fr) * LDT + ks * 32 + fq * 8);
#pragma unroll
      for (int nd = 0; nd < 4; nd++) vf[nd] = *(const bf16x8*)(VT + (nd * 16 + fr) * LDT + ks * 32 + fq * 8);
#pragma unroll
      for (int mi = 0; mi < 2; mi++)
#pragma unroll
        for (int nd = 0; nd < 4; nd++) oacc[mi][nd] = __builtin_amdgcn_mfma_f32_16x16x32_bf16(pf[mi], vf[nd], oacc[mi][nd], 0, 0, 0);
    }
    asm volatile("s_waitcnt lgkmcnt(0)" ::: "memory");
    __builtin_amdgcn_wave_barrier();
  }
  const float sink = p.attn_sink[l * 4 + qh];
#pragma unroll
  for (int mi = 0; mi < 2; mi++)
#pragma unroll
    for (int r = 0; r < 4; r++) {
      float ls = lrow[mi][r];
      ls += __shfl_xor(ls, 1);
      ls += __shfl_xor(ls, 2);
      ls += __shfl_xor(ls, 4);
      ls += __shfl_xor(ls, 8);
      ls += __expf(sink - mrow[mi][r]);
      const float inv = 1.f / ls;
      const int tq = tb + mi * 16 + fq * 4 + r;
#pragma unroll
      for (int nd = 0; nd < 4; nd++) Y[(size_t)(qrow0 + tq) * YST + 1536 + qh * 64 + nd * 16 + fr] = f2bf(oacc[mi][nd][r] * inv);
    }
}

#ifndef SCAN3_MASK
#define SCAN3_MASK 7
#endif
__device__ __forceinline__ void phase_mix(const Params& p, int l, unsigned char* smem) {
  float* sm = (float*)smem;
  const int G = gridDim.x;
  for (int it = blockIdx.x; it < 192; it += G) {
    const int mix = it >> 6, rem = it & 63, b = rem >> 3, h = (rem >> 1) & 3, dir = rem & 1;
    if (mix == 0 && (SCAN3_MASK & 1)) scan3_item<0>(p, l, b, h, dir, smem);
    else if (mix == 1 && (SCAN3_MASK & 2)) scan3_item<1>(p, l, b, h, dir, smem);
    else if (mix == 2 && (SCAN3_MASK & 4)) scan3_item<2>(p, l, b, h, dir, smem);
  }
  if (SCAN3_MASK != 7) {
    for (int it = blockIdx.x; it < 768; it += G) {
      const int mix = it >> 8, rem = it & 255, b = rem >> 5, h = (rem >> 3) & 3, dir = (rem >> 2) & 1, rq = rem & 3;
      if (mix == 0 && !(SCAN3_MASK & 1)) scan2_item<0>(p, l, b, h, dir, rq, sm);
      else if (mix == 1 && !(SCAN3_MASK & 2)) scan2_item<1>(p, l, b, h, dir, rq, sm);
      else if (mix == 2 && !(SCAN3_MASK & 4)) scan2_item<2>(p, l, b, h, dir, rq, sm);
    }
  }
  __syncthreads();
  unsigned* ctr = (unsigned*)(p.ws + OFF_CTR) + l * 16;
  volatile int* slot = (volatile int*)(smem + 131072 - 16);
  for (;;) {
    if (TIDX == 0) *slot = (int)atomicAdd(ctr, 1u);
    __syncthreads();
    const int it = *slot;
    __syncthreads();
    if (it >= 544) break;
    if (it < 512) {
      int b = it >> 6, qb = (it >> 1) & 31, hk = it & 1;
      attn_item(p, l, b, qb, hk, false, smem);
    } else {
      int r = it - 512, b = r >> 2, qb = (r >> 1) & 1, hk = r & 1;
      attn_item(p, l, b, qb, hk, true, smem);
    }
  }
}

#define POST_DECL(PFX) uint2 PFX##ya0, PFX##ya1, PFX##ya2, PFX##yc0, PFX##yc1, PFX##yc2, PFX##vp, PFX##vc, PFX##vn, PFX##gb, PFX##gc; \
  u16 PFX##xp, PFX##xc, PFX##xn; float2 PFX##bc
#define POST_LOAD(PFX, R_)                                                                         \
  do {                                                                                             \
    const int r_ = (R_);                                                                           \
    const int b_ = r_ / TPB, t_ = r_ - b_ * TPB;                                                   \
    const bool hp_ = (t_ != 0) && (t_ != LC), hn_ = (t_ != LC - 1) && (t_ != TPB - 1);            \
    const u16* ys_ = YSc + (size_t)r_ * YST;                                                       \
    const u16* pr_ = Pc + (size_t)r_ * PST;                                                        \
    const u16* pp_ = pr_ - (hp_ ? PST : 0);                                                        \
    const u16* pn_ = pr_ + (hn_ ? PST : 0);                                                        \
    PFX##ya0 = *(const uint2*)(ys_ + j0); PFX##ya1 = *(const uint2*)(ys_ + 256 + j0); PFX##ya2 = *(const uint2*)(ys_ + 512 + j0); \
    PFX##yc0 = *(const uint2*)(ys_ + 768 + j0); PFX##yc1 = *(const uint2*)(ys_ + 1024 + j0); PFX##yc2 = *(const uint2*)(ys_ + 1280 + j0); \
    PFX##vp = *(const uint2*)(pp_ + PA + 512 + j0);                                                \
    PFX##vc = *(const uint2*)(pr_ + PA + 512 + j0);                                                \
    PFX##vn = *(const uint2*)(pn_ + PA + 512 + j0);                                                \
    PFX##gb = *(const uint2*)(pr_ + PB + 784 + j0);                                                \
    PFX##gc = *(const uint2*)(pr_ + PC + 544 + j0);                                                \
    PFX##xp = pp_[PA + 896 + lane]; PFX##xc = pr_[PA + 896 + lane]; PFX##xn = pn_[PA + 896 + lane]; \
    PFX##bc = *(const float2*)(BCc + (size_t)r_ * 8 + (lane >> 4) * 2);                            \
  } while (0)
__device__ __forceinline__ void unpack4(uint2 v, float (&o)[4]) {
  o[0] = __uint_as_float(v.x << 16); o[1] = __uint_as_float(v.x & 0xffff0000u);
  o[2] = __uint_as_float(v.y << 16); o[3] = __uint_as_float(v.y & 0xffff0000u);
}

__device__ __forceinline__ void phase_post(const Params& p, int l, float* g2s) {
  const int lane = TIDX & 63, wv = TIDX >> 6;
  u16* YS = (u16*)(p.ws + OFF_YS);
  const int j0 = lane * 4;
  {
    const float4* src = (const float4*)(p.rwkv_g2 + (size_t)l * 64 * 256);
    for (int i = TIDX; i < 64 * 256 / 4; i += NTHR) ((float4*)g2s)[i] = src[i];
  }
  float mu_v[4], lng[4], lnb[4], ngb[4], ngc[4];
#pragma unroll
  for (int i = 0; i < 4; i++) {
    mu_v[i] = p.rwkv_mu[l * 960 + 512 + j0 + i];
    lng[i] = p.rwkv_ln_g[l * 256 + j0 + i];
    lnb[i] = p.rwkv_ln_b[l * 256 + j0 + i];
    ngb[i] = p.gdn_norm_g[l * 64 + (lane & 15) * 4 + i];
    ngc[i] = p.gla_norm_g[l * 64 + (lane & 15) * 4 + i];
  }
  const float mu_x = p.rwkv_mu[l * 960 + 896 + lane];
  __syncthreads();
  const int stride = gridDim.x * 8;
  int r = blockIdx.x * 8 + wv;
  const u16* Pc = (const u16*)(p.ws + OFF_BIG);
  const u16* YSc = (const u16*)(p.ws + OFF_YS);
  const float* BCc = (const float*)(p.ws + OFF_BC);
  POST_DECL(cur_);
  POST_DECL(nxt_);
  POST_LOAD(cur_, r);
  for (; r < NROWS; r += stride) {
    const int rn = r + stride < NROWS ? r + stride : r;
    POST_LOAD(nxt_, rn);
    const int b = r / TPB, t = r - b * TPB;
    const float pmul = ((t != 0) && (t != LC)) ? 1.f : 0.f, nmul = ((t != LC - 1) && (t != TPB - 1)) ? 1.f : 0.f;
    float y[3][4];
    {
      float a4[4], c4[4];
      unpack4(cur_ya0, a4); unpack4(cur_yc0, c4);
#pragma unroll
      for (int i = 0; i < 4; i++) y[0][i] = a4[i] + c4[i];
      unpack4(cur_ya1, a4); unpack4(cur_yc1, c4);
#pragma unroll
      for (int i = 0; i < 4; i++) y[1][i] = a4[i] + c4[i];
      unpack4(cur_ya2, a4); unpack4(cur_yc2, c4);
#pragma unroll
      for (int i = 0; i < 4; i++) y[2][i] = a4[i] + c4[i];
    }
    float o[3][4];
    {
      float sum = y[0][0] + y[0][1] + y[0][2] + y[0][3];
      sum = red16(sum);
      const float mean = sum * (1.f / 64.f);
      float vs = 0.f;
#pragma unroll
      for (int i = 0; i < 4; i++) { float d = y[0][i] - mean; vs += d * d; }
      vs = red16(vs);
      const float rstd = rsq(vs * (1.f / 64.f) + 64e-5f);
      const float pv = bf2f(cur_xc), ppv = bf2f(cur_xp) * pmul, pnv = bf2f(cur_xn) * nmul;
      const float sg = sigm(pv + (0.5f * (ppv + pnv) - pv) * mu_x);
      float gate[4] = {0.f, 0.f, 0.f, 0.f};
      const float* g2 = g2s + j0;
#pragma unroll 8
      for (int i = 0; i < 64; i++) {
        const float si = __int_as_float(__builtin_amdgcn_readlane(__float_as_int(sg), i));
        const float4 gw = *(const float4*)(g2 + i * 256);
        gate[0] += si * gw.x; gate[1] += si * gw.y; gate[2] += si * gw.z; gate[3] += si * gw.w;
      }
      const float bcs = cur_bc.x + cur_bc.y;
      float vc4[4], vp4[4], vn4[4];
      unpack4(cur_vc, vc4); unpack4(cur_vp, vp4); unpack4(cur_vn, vn4);
#pragma unroll
      for (int i = 0; i < 4; i++) {
        const float v = vc4[i] + (0.5f * (vp4[i] * pmul + vn4[i] * nmul) - vc4[i]) * mu_v[i];
        const float yn = (y[0][i] - mean) * rstd * lng[i] + lnb[i];
        o[0][i] = (yn + bcs * v) * gate[i];
      }
    }
#pragma unroll
    for (int m = 1; m < 3; m++) {
      float ss = y[m][0] * y[m][0] + y[m][1] * y[m][1] + y[m][2] * y[m][2] + y[m][3] * y[m][3];
      ss = red16(ss);
      const float inv = rsq(ss * (1.f / 64.f) + 1e-6f);
      float g4[4];
      unpack4(m == 1 ? cur_gb : cur_gc, g4);
#pragma unroll
      for (int i = 0; i < 4; i++) o[m][i] = y[m][i] * inv * (m == 1 ? ngb[i] : ngc[i]) * siluf(g4[i]);
    }
    u16* ys = YS + (size_t)r * YST;
#pragma unroll
    for (int m = 0; m < 3; m++) {
      uint2 ov;
      ov.x = pack2(o[m][0], o[m][1]);
      ov.y = pack2(o[m][2], o[m][3]);
      *(uint2*)(ys + m * 256 + j0) = ov;
    }
    cur_ya0 = nxt_ya0; cur_ya1 = nxt_ya1; cur_ya2 = nxt_ya2; cur_yc0 = nxt_yc0; cur_yc1 = nxt_yc1; cur_yc2 = nxt_yc2;
    cur_vp = nxt_vp; cur_vc = nxt_vc; cur_vn = nxt_vn; cur_gb = nxt_gb; cur_gc = nxt_gc;
    cur_xp = nxt_xp; cur_xc = nxt_xc; cur_xn = nxt_xn; cur_bc = nxt_bc;
  }
}

#define XB_TMO      128
#define XB_XCNT(j)  (256  + 64 * (j))
#define XB_XSUB(j)  (1280 + 64 * (j))
#define XB_XGEN(j)  (2304 + 64 * (j))
#define XB_TOP      3328
#define XB_TOPGEN   3392
#define XCD_BAR_WORDS 3456
#define XB_SPIN_CAP (1u << 18)
#define LAS __attribute__((address_space(3)))

__device__ __forceinline__ unsigned xb_ld(unsigned* p)              { return __hip_atomic_load(p, __ATOMIC_RELAXED, __HIP_MEMORY_SCOPE_AGENT); }
__device__ __forceinline__ unsigned xb_add(unsigned* p, unsigned v) { return __hip_atomic_fetch_add(p, v, __ATOMIC_RELAXED, __HIP_MEMORY_SCOPE_AGENT); }
__device__ __forceinline__ unsigned xb_xcc_id() { return (unsigned)__builtin_amdgcn_s_getreg((3 << 11) | 20) & 0xFu; }
#define XB_SPIN(cond, bar) do { unsigned _sp = 0; while (cond) { __builtin_amdgcn_s_sleep(1); \
    if ((++_sp & 255u) == 0u) { if (xb_ld(&(bar)[XB_TMO])) break; if (_sp > XB_SPIN_CAP) { atomicAdd(&(bar)[XB_TMO], 1u); break; } } } } while (0)

struct XcdBarrier {
    unsigned* bar; unsigned x;
    volatile LAS unsigned* st;
};

__device__ __forceinline__ XcdBarrier xcd_barrier_post(unsigned* bar, volatile LAS unsigned* st) {
    XcdBarrier b; b.bar = bar; b.x = xb_xcc_id(); b.st = st;
    if (threadIdx.x == 0) (void)xb_add(&bar[XB_XCNT(b.x)], 1u);
    return b;
}
__device__ __forceinline__ void xcd_barrier_complete(unsigned* bar, unsigned x, unsigned& nloc, unsigned& nx) {
    const unsigned G = gridDim.x * gridDim.y * gridDim.z;
    unsigned sum, cnt, mine, sp = 0u;
    for (;;) {
        sum = 0u; cnt = 0u; mine = 0u;
#pragma unroll
        for (unsigned j = 0; j < 16; ++j) { const unsigned c = xb_ld(&bar[XB_XCNT(j)]); sum += c; cnt += (c > 0u) ? 1u : 0u; mine = (j == x) ? c : mine; }
        if (sum == G) break;
        __builtin_amdgcn_s_sleep(1);
        if ((++sp & 255u) == 0u) { if (xb_ld(&bar[XB_TMO])) break; if (sp > XB_SPIN_CAP) { atomicAdd(&bar[XB_TMO], 1u); break; } }
    }
    nloc = mine > 0u ? mine : 1u; nx = cnt > 0u ? cnt : 1u;
}

__device__ __forceinline__ void xcd_barrier(const XcdBarrier& b) {
    asm volatile("s_waitcnt vmcnt(0)" ::: "memory");
    __syncthreads();
    if (threadIdx.x == 0) {
        unsigned* bar = b.bar;
        __builtin_amdgcn_s_waitcnt(0);
        unsigned nloc = b.st[0], nx = b.st[1];
        if (nloc == 0u) { xcd_barrier_complete(bar, b.x, nloc, nx); b.st[0] = nloc; b.st[1] = nx; }
        const unsigned old = xb_add(&bar[XB_XSUB(b.x)], 1u);
        const unsigned gen = old / nloc;
        if (old + 1u == (gen + 1u) * nloc) {
            __builtin_amdgcn_fence(__ATOMIC_RELEASE, "agent");
            asm volatile("s_waitcnt vmcnt(0)" ::: "memory");
            const unsigned og = xb_add(&bar[XB_TOP], 1u);
            const unsigned tg = og / nx;
            if (og + 1u == (tg + 1u) * nx) xb_add(&bar[XB_TOPGEN], 1u);
            else XB_SPIN(xb_ld(&bar[XB_TOPGEN]) == tg, bar);
            __builtin_amdgcn_fence(__ATOMIC_ACQUIRE, "agent");
            xb_add(&bar[XB_XGEN(b.x)], 1u);
            asm volatile("s_waitcnt vmcnt(0)" ::: "memory");
        } else {
            XB_SPIN(xb_ld(&bar[XB_XGEN(b.x)]) == gen, bar);
            __builtin_amdgcn_fence(__ATOMIC_ACQUIRE, "agent");
            asm volatile("s_waitcnt vmcnt(0)" ::: "memory");
        }
    }
    __syncthreads();
}

#if defined(SKIPS)
#define EN(k) (SKIPS != (k))
#elif !defined(ONLYS)
#define EN(k) 1
#else
#define EN(k) (ONLYS == (k))
#endif
__device__ __forceinline__ void run_phase(const Params& p, int ph, unsigned char* smem) {
  if (ph == 0) { if (EN(10)) phase_init0(p, (float*)smem); return; }
  if (ph == 1) { if (EN(11)) phase_init1(p); return; }
  int l = 0, s = 12;
  if (ph >= 3) { l = (ph - 3) / 12; s = (ph - 3) - l * 12; }
  unsigned char* wl = p.ws + OFF_W + (size_t)l * SZ_WL;
  PG8_LAS unsigned char* lds = (PG8_LAS unsigned char*)smem;
  pg8::StaticOrder S;
  if (s == 12 || s == 8 || s == 11) {
    if (EN(5)) rowpass(p, l, s == 12 ? 0 : (s == 8 ? 1 : 2));
  } else if (s == 0 || s == 3 || s == 5 || s == 7 || s == 10) {
    pg8::Gemm g; EpiBf E;
    g.M = NROWS; E.bias = nullptr; E.act = 0;
    if (s == 0) { g.A = (const u16*)(p.ws + OFF_H); g.lda = DM; g.Bt = (const u16*)(wl + OW_IN); g.K = DM; g.N = PST; E.O = (u16*)(p.ws + OFF_BIG); E.ldc = PST; }
    else if (s == 3 || s == 5) {
      const int hf = s == 5;
      g.A = (const u16*)(p.ws + OFF_H); g.lda = DM; g.Bt = (const u16*)(wl + OW_G) + (size_t)hf * 2048 * DM; g.K = DM; g.N = 2048;
      E.O = (u16*)(p.ws + OFF_BIG); E.ldc = 2048; E.bias = p.gate_b + (size_t)l * 4096 + hf * 2048; E.act = 1;
    }
    else if (s == 7) { g.A = (const u16*)(p.ws + OFF_BIG + 2 * SZ_ACT); g.lda = DM; g.Bt = (const u16*)(wl + OW_O); g.K = DM; g.N = DM; E.O = (u16*)(p.ws + OFF_BIG); E.ldc = DM; }
    else { g.A = (const u16*)(p.ws + OFF_BIG); g.lda = FH; g.Bt = (const u16*)(wl + OW_2); g.K = FH; g.N = DM; E.O = (u16*)(p.ws + OFF_YS); E.ldc = DM; }
    S.init(g.M, g.N, gridDim.x, blockIdx.x);
    if (EN(0)) pg8::gemm_phase<EpiBf, pg8::StaticOrder, false>(lds, g, S, E, nullptr);
  } else if (s == 4 || s == 6) {
    if (EN(3)) phase_ypart(p, l, s == 6, smem);
  } else if (s == 1) {
    if (EN(1)) phase_mix(p, l, smem);
  } else if (s == 2) {
    if (EN(2)) phase_post(p, l, (float*)smem);
  } else {
    pg8::Gemm g; EpiSwiglu E;
    g.M = NROWS; g.N = 2 * FH; g.K = DM; g.lda = DM; g.A = (const u16*)(p.ws + OFF_H); g.Bt = (const u16*)(wl + OW_1);
    E.O = (u16*)(p.ws + OFF_BIG);
    S.init(g.M, g.N, gridDim.x, blockIdx.x);
    if (EN(6)) pg8::gemm_phase<EpiSwiglu, pg8::StaticOrder, false>(lds, g, S, E, nullptr);
  }
}

__global__ void __launch_bounds__(NTHR) hybrid_flow_mega(Params p, int ph0, int ph1) {
  __shared__ __attribute__((aligned(16))) unsigned char smem[131072];
  __shared__ __attribute__((aligned(16))) unsigned xbw[4];
  cg::grid_group grid = cg::this_grid();
  XcdBarrier xb;
  xb.bar = (unsigned*)(p.ws + OFF_XBAR); xb.x = 0u; xb.st = (volatile LAS unsigned*)xbw;
  for (int ph = ph0; ph < ph1; ph++) {
    run_phase(p, ph, smem);
#ifdef DUPMASK
    {
      int sidx = ph >= 3 ? (ph - 3) % 12 : 12 + ph;
      if ((DUPMASK >> sidx) & 1) { __syncthreads(); run_phase(p, ph, smem); }
    }
#endif
    if (ph + 1 < ph1) {
      if (ph == ph0) {
        grid.sync();
        if (threadIdx.x < 4) xbw[threadIdx.x] = 0u;
        __syncthreads();
        xb = xcd_barrier_post((unsigned*)(p.ws + OFF_XBAR), (volatile LAS unsigned*)xbw);
      } else {
        xcd_barrier(xb);
      }
    }
  }
  if (ph1 - ph0 > 2 && threadIdx.x == 0 && xb_ld(&xb.bar[XB_TMO]) != 0u) p.out[blockIdx.x] = __int_as_float(0x7fc00000);
}

extern "C" void kernel_launch(void* const* d_in, const int* in_sizes, int n_in, void* d_out, int out_size, void* d_ws,
                              size_t ws_size, hipStream_t stream) {
  Params p{};
  const float** pp = (const float**)&p;
  for (int i = 0; i < 32; i++) pp[i] = (const float*)d_in[i];
  p.out = (float*)d_out;
  p.ws = (unsigned char*)d_ws;
  static int grid_blocks = 0;
  if (!grid_blocks) {
    int dev = 0, cus = 0, per_cu = 0;
    hipGetDevice(&dev);
    hipDeviceGetAttribute(&cus, hipDeviceAttributeMultiprocessorCount, dev);
    hipOccupancyMaxActiveBlocksPerMultiprocessor(&per_cu, hybrid_flow_mega, NTHR, 0);
    if (per_cu < 1) per_cu = 1;
    grid_blocks = cus * per_cu;
  }
#ifdef MULTI_LAUNCH
  for (int ph = 0; ph < NPHASE; ph++) {
    hipLaunchKernelGGL(hybrid_flow_mega, dim3(grid_blocks), dim3(NTHR), 0, stream, p, ph, ph + 1);
  }
#else
  int ph0 = 0, ph1 = NPHASE;
  void* args[] = {&p, &ph0, &ph1};
  hipError_t e = hipLaunchCooperativeKernel((void*)hybrid_flow_mega, dim3(grid_blocks), dim3(NTHR), args, 0, stream);
  if (e != hipSuccess) fprintf(stderr, "cooperative launch failed: %s (grid %d)\n", hipGetErrorString(e), grid_blocks);
#endif
}
```

```cpp
#include <hip/hip_runtime.h>
#include <hip/hip_cooperative_groups.h>
#include <cstdio>
namespace cg = cooperative_groups;

typedef unsigned short u16;
using bf16x8 = __attribute__((ext_vector_type(8))) short;
using f32x4 = __attribute__((ext_vector_type(4))) float;

#define DM 1024
#define NBATCH 8
#define SEQ 4096
#define LC 256
#define TPB 4352
#define NROWS 34816
#define PST 3328
#define YST 1792
#define FH 2816
#define INW 7408
#define NTHR 512
#define PA 0
#define PB 960
#define PC 2000
#define PD 2800
#define NPHASE 27
#define SCAN3_MASK 7

struct Params {
  const float *x, *c, *ctx, *c_ctx, *ada_w, *ada_b, *norm_g, *w_in, *gate_b, *w_branch, *w_out,
      *rwkv_mu, *rwkv_w0, *rwkv_w2, *rwkv_a0, *rwkv_a2, *rwkv_g2, *rwkv_kk, *rwkv_ka, *rwkv_rk, *rwkv_ln_g,
      *rwkv_ln_b, *gdn_conv, *gdn_a_log, *gdn_dt_bias, *gdn_norm_g, *gla_gw2, *gla_gb, *gla_norm_g, *attn_sink,
      *ffn_w1, *ffn_w2;
  float* out;
  unsigned char* ws;
};

constexpr size_t SZ_WL = 36700160;
constexpr size_t OW_IN = 0;
constexpr size_t OW_G = OW_IN + (size_t)PST * 1024 * 2;
constexpr size_t OW_B = OW_G + (size_t)4096 * 1024 * 2;
constexpr size_t OW_O = OW_B + (size_t)4 * 1024 * 256 * 2;
constexpr size_t OW_1 = OW_O + (size_t)1024 * 1024 * 2;
constexpr size_t OW_2 = OW_1 + (size_t)5632 * 1024 * 2;
static_assert(OW_2 + (size_t)1024 * FH * 2 == SZ_WL, "weights size");
constexpr size_t SZ_ACT = (size_t)NROWS * DM * 2;
constexpr size_t OFF_W = 0;
constexpr size_t OFF_XC = OFF_W + 2 * SZ_WL;
constexpr size_t OFF_MODP = OFF_XC + (size_t)NBATCH * LC * DM * 4;
constexpr size_t OFF_MOD = OFF_MODP + (size_t)2 * 8 * 9 * 6144 * 4;
constexpr size_t OFF_BC = OFF_MOD + (size_t)2 * 9 * 6144 * 4;
constexpr size_t OFF_H = OFF_BC + (size_t)NROWS * 8 * 4;
constexpr size_t OFF_YS = OFF_H + SZ_ACT;
constexpr size_t OFF_BIG = OFF_YS + (size_t)NROWS * YST * 2;
constexpr size_t OFF_CTR = OFF_BIG + (size_t)NROWS * PST * 2;
constexpr size_t OFF_XBAR = OFF_CTR + 256;
constexpr size_t WS_END = OFF_XBAR + 3456 * 4;
static_assert(WS_END <= (size_t)536870912, "ws too large");

__device__ __forceinline__ int launder_tid() { int t = threadIdx.x; asm volatile("" : "+v"(t)); return t; }
#define TIDX (launder_tid())
typedef float f32x2_t __attribute__((ext_vector_type(2)));
typedef __bf16 bf16x2_t __attribute__((ext_vector_type(2)));
__device__ __forceinline__ unsigned pack2(float a, float b) {
  const f32x2_t v = {a, b};
  const bf16x2_t r = __builtin_convertvector(v, bf16x2_t);
  return __builtin_bit_cast(unsigned, r);
}
__device__ __forceinline__ u16 f2bf(float f) { return (u16)(pack2(f, 0.f) & 0xffffu); }
__device__ __forceinline__ float bf2f(u16 h) { return __uint_as_float(((unsigned)h) << 16); }
__device__ __forceinline__ float sigm(float x) { return __builtin_amdgcn_rcpf(1.f + __expf(-x)); }
__device__ __forceinline__ float siluf(float x) { return x * __builtin_amdgcn_rcpf(1.f + __expf(-x)); }
__device__ __forceinline__ float rsq(float x) { return __builtin_amdgcn_rsqf(x); }
__device__ __forceinline__ float softplusf(float x) { return fmaxf(x, 0.f) + __logf(1.f + __expf(-fabsf(x))); }
__device__ __forceinline__ float tanh_fast(float x) { return 1.f - 2.f * __builtin_amdgcn_rcpf(1.f + __expf(2.f * x)); }
__device__ __forceinline__ float wsum(float v) {
#pragma unroll
  for (int o = 32; o > 0; o >>= 1) v += __shfl_xor(v, o);
  return v;
}
template <int CTRL>
__device__ __forceinline__ float dppf(float x) {
  return __int_as_float(__builtin_amdgcn_update_dpp(__float_as_int(x), __float_as_int(x), CTRL, 0xf, 0xf, false));
}
__device__ __forceinline__ float red8(float x) {
  x += dppf<0xB1>(x);
  x += dppf<0x4E>(x);
  x += dppf<0x141>(x);
  return x;
}
__device__ __forceinline__ const float* xin_row(const Params& p, int r) {
  int b = r / TPB, t = r - b * TPB;
  return t < LC ? p.ctx + ((size_t)(b * LC + t)) * DM : p.x + ((size_t)(b * SEQ + t - LC)) * DM;
}
__device__ __forceinline__ float* x_row(const Params& p, int r) {
  int b = r / TPB, t = r - b * TPB;
  return t < LC ? (float*)(p.ws + OFF_XC) + ((size_t)(b * LC + t)) * DM : p.out + ((size_t)(b * SEQ + t - LC)) * DM;
}
__device__ __forceinline__ int mod_row(int r) {
  int b = r / TPB, t = r - b * TPB;
  return t < LC ? 8 : b;
}

struct MapId { int lim, off; __device__ int operator()(int n) const { return n < lim ? n + off : -1; } };
struct MapW1 { __device__ int operator()(int n) const { int q = n >> 3, s = n & 7; return s < 4 ? q * 4 + s : FH + q * 4 + (s - 4); } };

template <class Map>
__device__ __forceinline__ void conv_tile(const float* __restrict__ src, int ld, u16* __restrict__ dst, int K, int n0,
                                          int k0, Map map, float* tile) {
  const int tid = TIDX;
  const int nn = tid & 63, kr = tid >> 6;
  const int sc = map(n0 + nn);
#pragma unroll
  for (int ps = 0; ps < 8; ps++) {
    int kk = ps * 8 + kr;
    float v = sc >= 0 ? src[(size_t)(k0 + kk) * ld + sc] : 0.f;
    tile[kk * 65 + nn] = v;
  }
  __syncthreads();
  const int n2 = tid >> 3, kc = tid & 7;
  uint4 o;
  o.x = pack2(tile[(kc * 8 + 0) * 65 + n2], tile[(kc * 8 + 1) * 65 + n2]);
  o.y = pack2(tile[(kc * 8 + 2) * 65 + n2], tile[(kc * 8 + 3) * 65 + n2]);
  o.z = pack2(tile[(kc * 8 + 4) * 65 + n2], tile[(kc * 8 + 5) * 65 + n2]);
  o.w = pack2(tile[(kc * 8 + 6) * 65 + n2], tile[(kc * 8 + 7) * 65 + n2]);
  *(uint4*)(dst + (size_t)(n0 + n2) * K + k0 + kc * 8) = o;
  __syncthreads();
}

__device__ __forceinline__ void phase_init0(const Params& p, float* sm) {
  const int tid = TIDX;
  if (blockIdx.x == 0) {
    if (tid < 64) ((unsigned*)(p.ws + OFF_CTR))[tid] = 0u;
    for (int i = tid; i < 3456; i += NTHR) ((unsigned*)(p.ws + OFF_XBAR))[i] = 0u;
  }
  constexpr int NMOD = 192, NCONV = 4480 * 2;
  for (int it = blockIdx.x; it < NMOD + NCONV; it += gridDim.x) {
    if (it < NMOD) {
      int l = it / 96, rem = it - l * 96, cc = rem >> 3, ks = rem & 7;
      for (int i = tid; i < 9 * 128; i += NTHR) {
        int r = i >> 7, k = i & 127;
        float v = r < 8 ? p.c[r * DM + ks * 128 + k] : p.c_ctx[ks * 128 + k];
        sm[i] = siluf(v);
      }
      __syncthreads();
      const int n = cc * 512 + tid;
      const float* w = p.ada_w + ((size_t)l * DM + ks * 128) * 6144 + n;
      float acc[9];
#pragma unroll
      for (int r = 0; r < 9; r++) acc[r] = 0.f;
#pragma unroll 4
      for (int k = 0; k < 128; k++) {
        float wv = w[(size_t)k * 6144];
#pragma unroll
        for (int r = 0; r < 9; r++) acc[r] += sm[r * 128 + k] * wv;
      }
      float* mp = (float*)(p.ws + OFF_MODP) + ((size_t)(l * 8 + ks) * 9) * 6144 + n;
#pragma unroll
      for (int r = 0; r < 9; r++) mp[(size_t)r * 6144] = acc[r];
      __syncthreads();
    } else {
      int ci = it - NMOD;
      int l = ci / 4480, rem = ci - l * 4480;
      u16* wl = (u16*)(p.ws + OFF_W + (size_t)l * SZ_WL);
      if (rem < 832) {
        int nt = rem >> 4, kt = rem & 15;
        conv_tile(p.w_in + (size_t)l * DM * INW, INW, (u16*)((char*)wl + OW_IN), 1024, nt * 64, kt * 64, MapId{3312, 0}, sm);
      } else if (rem < 832 + 1024) {
        rem -= 832;
        int nt = rem >> 4, kt = rem & 15;
        conv_tile(p.w_in + (size_t)l * DM * INW, INW, (u16*)((char*)wl + OW_G), 1024, nt * 64, kt * 64, MapId{4096, 3312}, sm);
      } else if (rem < 1856 + 256) {
        rem -= 1856;
        int br = rem >> 6, r2 = rem & 63, nt = r2 >> 2, kt = r2 & 3;
        conv_tile(p.w_branch + ((size_t)(l * 4 + br)) * 256 * DM, DM, (u16*)((char*)wl + OW_B) + (size_t)br * 1024 * 256, 256,
                  nt * 64, kt * 64, MapId{1024, 0}, sm);
      } else if (rem < 2112 + 256) {
        rem -= 2112;
        int nt = rem >> 4, kt = rem & 15;
        conv_tile(p.w_out + (size_t)l * DM * DM, DM, (u16*)((char*)wl + OW_O), 1024, nt * 64, kt * 64, MapId{1024, 0}, sm);
      } else if (rem < 2368 + 1408) {
        rem -= 2368;
        int nt = rem >> 4, kt = rem & 15;
        conv_tile(p.ffn_w1 + (size_t)l * DM * 5632, 5632, (u16*)((char*)wl + OW_1), 1024, nt * 64, kt * 64, MapW1{}, sm);
      } else {
        rem -= 3776;
        int nt = rem / 44, kt = rem - nt * 44;
        conv_tile(p.ffn_w2 + (size_t)l * FH * DM, DM, (u16*)((char*)wl + OW_2), FH, nt * 64, kt * 64, MapId{1024, 0}, sm);
      }
    }
  }
}

__device__ __forceinline__ void phase_init1(const Params& p) {
  const float* mp = (const float*)(p.ws + OFF_MODP);
  float* mo = (float*)(p.ws + OFF_MOD);
  for (int i = blockIdx.x * NTHR + TIDX; i < 2 * 9 * 6144; i += gridDim.x * NTHR) {
    int l = i / (9 * 6144), rem = i - l * 9 * 6144, r = rem / 6144, n = rem - r * 6144;
    float s = p.ada_b[l * 6144 + n];
#pragma unroll
    for (int ks = 0; ks < 8; ks++) s += mp[((size_t)((l * 8 + ks) * 9 + r)) * 6144 + n];
    mo[i] = s;
  }
}

__device__ __forceinline__ void rowpass(const Params& p, int l, int mode) {
  const int lane = TIDX & 63, wv = TIDX >> 6;
  const float* MOD = (const float*)(p.ws + OFF_MOD);
  u16* H = (u16*)(p.ws + OFF_H);
  const bool do_norm = !(mode == 2 && l == 1);
  const int ln = (mode == 2) ? (l == 1 ? l : l + 1) : l;
  const int ni = (mode == 1) ? 2 : 0, sho = (mode == 1) ? 3072 : 0, sco = (mode == 1) ? 4096 : 1024;
  for (int r = blockIdx.x * 8 + wv; r < NROWS; r += gridDim.x * 8) {
    const int mr = mod_row(r);
    const float* modl = MOD + ((size_t)(l * 9 + mr)) * 6144;
    const float* modn = MOD + ((size_t)(ln * 9 + mr)) * 6144;
    const float* ng2 = p.norm_g + (size_t)(ln * 4 + ni) * DM;
    const float* xs = (mode == 0 || (mode == 1 && l == 0)) ? xin_row(p, r) : (const float*)x_row(p, r);
    float4 xo[4], n2[4], sc4[4], sh4[4];
#pragma unroll
    for (int i = 0; i < 4; i++) {
      const int col = i * 256 + lane * 4;
      xo[i] = *(const float4*)(xs + col);
      n2[i] = *(const float4*)(ng2 + col);
      sc4[i] = *(const float4*)(modn + sco + col);
      sh4[i] = *(const float4*)(modn + sho + col);
    }
    float xv[16];
    if (mode == 0) {
#pragma unroll
      for (int i = 0; i < 4; i++) { xv[i * 4 + 0] = xo[i].x; xv[i * 4 + 1] = xo[i].y; xv[i * 4 + 2] = xo[i].z; xv[i * 4 + 3] = xo[i].w; }
    } else {
      const u16* src = (const u16*)(p.ws + (mode == 1 ? OFF_BIG : OFF_YS)) + (size_t)r * DM;
      const float* ng = p.norm_g + (size_t)(l * 4 + (mode == 1 ? 1 : 3)) * DM;
      const float* gt = modl + (mode == 1 ? 2048 : 5120);
      uint2 sv[4];
      float4 g4[4], n4[4];
#pragma unroll
      for (int i = 0; i < 4; i++) {
        const int col = i * 256 + lane * 4;
        sv[i] = *(const uint2*)(src + col);
        g4[i] = *(const float4*)(gt + col);
        n4[i] = *(const float4*)(ng + col);
      }
      float ov[16];
      float ss = 0.f;
#pragma unroll
      for (int i = 0; i < 4; i++) {
        ov[i * 4 + 0] = __uint_as_float(sv[i].x << 16); ov[i * 4 + 1] = __uint_as_float(sv[i].x & 0xffff0000u);
        ov[i * 4 + 2] = __uint_as_float(sv[i].y << 16); ov[i * 4 + 3] = __uint_as_float(sv[i].y & 0xffff0000u);
      }
#pragma unroll
      for (int i = 0; i < 16; i++) ss += ov[i] * ov[i];
      ss = wsum(ss);
      const float inv = rsq(ss * (1.f / 1024.f) + 1e-6f);
      float* xd = x_row(p, r);
#pragma unroll
      for (int i = 0; i < 4; i++) {
        xv[i * 4 + 0] = xo[i].x + g4[i].x * (ov[i * 4 + 0] * inv * n4[i].x);
        xv[i * 4 + 1] = xo[i].y + g4[i].y * (ov[i * 4 + 1] * inv * n4[i].y);
        xv[i * 4 + 2] = xo[i].z + g4[i].z * (ov[i * 4 + 2] * inv * n4[i].z);
        xv[i * 4 + 3] = xo[i].w + g4[i].w * (ov[i * 4 + 3] * inv * n4[i].w);
      }
#pragma unroll
      for (int i = 0; i < 4; i++)
        *(float4*)(xd + i * 256 + lane * 4) = make_float4(xv[i * 4 + 0], xv[i * 4 + 1], xv[i * 4 + 2], xv[i * 4 + 3]);
    }
    if (!do_norm) continue;
    float ss2 = 0.f;
#pragma unroll
    for (int i = 0; i < 16; i++) ss2 += xv[i] * xv[i];
    ss2 = wsum(ss2);
    const float inv2 = rsq(ss2 * (1.f / 1024.f) + 1e-6f);
#pragma unroll
    for (int i = 0; i < 4; i++) {
      const int col = i * 256 + lane * 4;
      float h0 = xv[i * 4 + 0] * inv2 * n2[i].x * (1.f + sc4[i].x) + sh4[i].x;
      float h1 = xv[i * 4 + 1] * inv2 * n2[i].y * (1.f + sc4[i].y) + sh4[i].y;
      float h2 = xv[i * 4 + 2] * inv2 * n2[i].z * (1.f + sc4[i].z) + sh4[i].z;
      float h3 = xv[i * 4 + 3] * inv2 * n2[i].w * (1.f + sc4[i].w) + sh4[i].w;
      uint2 o;
      o.x = pack2(h0, h1);
      o.y = pack2(h2, h3);
      *(uint2*)(H + (size_t)r * DM + col) = o;
    }
  }
}

#define LDT 72
namespace pg8 {
#define PG8_LAS __attribute__((address_space(3)))
typedef unsigned short bf16_t;
typedef short bf16x8 __attribute__((ext_vector_type(8)));
typedef float f32x4 __attribute__((ext_vector_type(4)));
typedef unsigned u32x4 __attribute__((ext_vector_type(4)));
constexpr int BM = 256, BK = 64, HALF = 128, HTB = HALF * BK * 2  , STAGE_BYTES = 8 * HTB, NXCD = 8, WGM = 8;

__host__ __device__ __forceinline__ int lds_byte(int r, int c) { const int st = (r >> 4) * 2 + (c >> 5), rr = r & 15, cc = c & 31, ob = rr * 64 + cc * 2; return st * 1024 + (ob ^ (((ob >> 9) & 1) << 5)); }
__host__ __device__ __forceinline__ void stage_rc(int b, int& R, int& C) { const int st = b / 1024, sb = b % 1024, swz = sb ^ (((sb >> 9) & 1) << 5); R = (st >> 1) * 16 + swz / 64; C = (st & 1) * 32 + (swz % 64) / 2; }
__host__ __device__ __forceinline__ int perm32(int rho) { const int n = rho >> 4, i = rho & 15; return 8 * (i >> 2) + 4 * n + (i & 3); }

struct Unit { int pm, pn; };
struct Gemm { const bf16_t* A; const bf16_t* Bt; int M, N, K, lda; };
struct StaticOrder {
    int nM, nN, nwg, G, c;
    __host__ __device__ void init(int M, int N, int G_, int c_) { nM = M / BM; nN = N / BM; nwg = nM * nN; G = G_; c = c_; }
    __host__ __device__ bool next(int i, Unit& u) const {
        const long L = (long)i * G + c; if (L >= nwg) return false;
        int wgid = (int)L; { const int q = nwg / NXCD, r = nwg % NXCD, xcd = wgid % NXCD, off = wgid / NXCD; wgid = (xcd < r ? xcd * (q + 1) : r * (q + 1) + (xcd - r) * q) + off; }
        const int nig = WGM * nN, gid = wgid / nig, fm = gid * WGM, gsz = (nM - fm) < WGM ? (nM - fm) : WGM;
        u.pm = fm + ((wgid % nig) % gsz); u.pn = (wgid % nig) / gsz; return true;
    }
    __device__ __forceinline__ void a_ready(const Unit&) const {}
    __device__ __forceinline__ void done(const Unit&) const {}
};
__device__ __forceinline__ unsigned cvt_pk_bf16(float lo, float hi) { unsigned r; asm volatile("v_cvt_pk_bf16_f32 %0, %1, %2" : "=v"(r) : "v"(lo), "v"(hi)); return r; }
template <class Epi, class Sched, bool STAMP = false>
__device__ __forceinline__ void gemm_phase(PG8_LAS unsigned char* lds, const Gemm g, const Sched& S, const Epi& E, unsigned long long* stamps) {
    const int tid = TIDX, wid = __builtin_amdgcn_readfirstlane(tid >> 6), lane = tid & 63, wr = wid >> 2, wc = wid & 3, fr = lane & 15, fq = lane >> 4;
    const int K = g.K, nt = K / BK;
    int ts_lo = 0, ts_hi = 0, nts = 0; const unsigned long long rt_entry = STAMP ? (unsigned long long)wall_clock64() : 0ull;
#define PG8_STAMP() do { if (STAMP && wid == 0 && nts < 64) { const unsigned long long _c = (unsigned long long)clock64(); \
        ts_lo = (lane == nts) ? (int)(unsigned)_c : ts_lo; ts_hi = (lane == nts) ? (int)(unsigned)(_c >> 32) : ts_hi; ++nts; } } while (0)
    PG8_STAMP();
    unsigned voffA[2], voffB[2];
#pragma unroll
    for (int i = 0; i < 2; ++i) { int R, C; stage_rc(tid * 16 + i * 8192, R, C); const int Rb = Epi::PERM ? ((R & ~31) + perm32(R & 31)) : R;
        voffA[i] = (unsigned)(R * g.lda + C) * 2u; voffB[i] = (unsigned)(Rb * K + C) * 2u; }
    const size_t kstep = (size_t)(BK * 2);
    const size_t hstepB = (size_t)HALF * K * 2, hstepA = (size_t)HALF * g.lda * 2;
    const size_t tstepB = 2 * hstepB, tstepA = 2 * hstepA;
    const unsigned ldsw = (unsigned)wid * 1024u;
    const int aoff = lds_byte(wr * 64 + fr, fq * 8), boff = lds_byte(wc * 32 + fr, fq * 8);
#define PG8_SA(b, h) (((b) * 2 + (h)) * HTB)
#define PG8_SB(b, h) ((4 + (b) * 2 + (h)) * HTB)
#define PG8_STAGE(bufoff, gbase, voff) do { _Pragma("unroll") for (int _i = 0; _i < 2; ++_i) \
        __builtin_amdgcn_global_load_lds((const unsigned*)((const char*)(gbase) + (voff)[_i]), (PG8_LAS unsigned*)(lds + (bufoff) + ldsw + _i * 8192), 16, 0, 0); } while (0)
#define PG8_LDA(dst, b, h) do { _Pragma("unroll") for (int m = 0; m < 4; ++m) _Pragma("unroll") for (int k = 0; k < 2; ++k) dst[m][k] = *(const PG8_LAS bf16x8*)(lds + PG8_SA(b, h) + aoff + m * 2048 + k * 1024); } while (0)
#define PG8_LDB(dst, b, h) do { _Pragma("unroll") for (int n = 0; n < 2; ++n) _Pragma("unroll") for (int k = 0; k < 2; ++k) dst[n][k] = *(const PG8_LAS bf16x8*)(lds + PG8_SB(b, h) + boff + n * 2048 + k * 1024); } while (0)
#define PG8_MMA(ai, bj, At, Bt) do { __builtin_amdgcn_s_setprio(1); _Pragma("unroll") for (int m = 0; m < 4; ++m) _Pragma("unroll") for (int n = 0; n < 2; ++n) _Pragma("unroll") for (int k = 0; k < 2; ++k) \
        acc[ai][bj][m][n] = __builtin_amdgcn_mfma_f32_16x16x32_bf16(Bt[n][k], At[m][k], acc[ai][bj][m][n], 0, 0, 0); __builtin_amdgcn_s_setprio(0); } while (0)
#define PG8_WAIT_V(n) asm volatile("s_waitcnt vmcnt(" #n ")" ::: "memory")
#define PG8_WAIT_L(n) asm volatile("s_waitcnt lgkmcnt(" #n ")" ::: "memory")
#define PG8_BAR __builtin_amdgcn_s_barrier()
#define PG8_SCHED __builtin_amdgcn_sched_barrier(0)
    Unit cur, nxt; int ui = 0;
    if (!S.next(0, cur)) return;
    f32x4 acc[2][2][4][2];
#pragma unroll
    for (int a = 0; a < 2; ++a)
#pragma unroll
        for (int b = 0; b < 2; ++b)
#pragma unroll
            for (int m = 0; m < 4; ++m)
#pragma unroll
                for (int n = 0; n < 2; ++n) acc[a][b][m][n] = (f32x4){0.f, 0.f, 0.f, 0.f};
    bf16x8 At[4][2], B0[2][2], B1[2][2];
    const char* cA = (const char*)g.A + (size_t)cur.pm * tstepA; const char* cB = (const char*)g.Bt + (size_t)cur.pn * tstepB;
    S.a_ready(cur);
    PG8_STAGE(PG8_SB(0, 0), cB, voffB); PG8_STAGE(PG8_SA(0, 0), cA, voffA); PG8_STAGE(PG8_SB(0, 1), cB + hstepB, voffB); PG8_STAGE(PG8_SA(0, 1), cA + hstepA, voffA);
    if (wr == 1) PG8_BAR;
    PG8_WAIT_V(4); PG8_BAR;
    PG8_STAGE(PG8_SB(1, 0), cB + kstep, voffB); PG8_STAGE(PG8_SA(1, 0), cA + kstep, voffA); PG8_STAGE(PG8_SB(1, 1), cB + hstepB + kstep, voffB);
    PG8_WAIT_V(6); PG8_BAR;
    PG8_STAMP();
    for (;;) {
        const bool has_next = S.next(ui + 1, nxt);
        const char* nA = has_next ? (const char*)g.A + (size_t)nxt.pm * tstepA : cA; const char* nB = has_next ? (const char*)g.Bt + (size_t)nxt.pn * tstepB : cB;
        for (int t = 0; t < nt; t += 2) {
            const bool last = (t == nt - 2);
            const char* a1 = cA + (size_t)(t + 1) * kstep;
            const char* a2 = last ? nA : cA + (size_t)(t + 2) * kstep; const char* b2 = last ? nB : cB + (size_t)(t + 2) * kstep;
            const char* a3 = a2 + kstep; const char* b3 = b2 + kstep;
            if (last && has_next) S.a_ready(nxt);
            PG8_LDB(B0, 0, 0); PG8_SCHED; PG8_LDA(At, 0, 0); PG8_STAGE(PG8_SA(1, 1), a1 + hstepA, voffA);
            PG8_WAIT_L(8); PG8_BAR; PG8_WAIT_L(0); PG8_MMA(0, 0, At, B0); PG8_BAR; PG8_SCHED;
            PG8_LDB(B1, 0, 1); PG8_STAGE(PG8_SB(0, 0), b2, voffB);
            PG8_BAR; PG8_WAIT_L(0); PG8_MMA(0, 1, At, B1); PG8_BAR;
            PG8_LDA(At, 0, 1); PG8_STAGE(PG8_SA(0, 0), a2, voffA);
            PG8_BAR; PG8_WAIT_L(0); PG8_MMA(1, 0, At, B0); PG8_BAR; PG8_SCHED;
            PG8_STAGE(PG8_SB(0, 1), b2 + hstepB, voffB);
            PG8_WAIT_V(6); PG8_BAR; PG8_MMA(1, 1, At, B1); PG8_BAR;
            PG8_LDB(B0, 1, 0); PG8_SCHED; PG8_LDA(At, 1, 0); PG8_STAGE(PG8_SA(0, 1), a2 + hstepA, voffA);
            PG8_WAIT_L(8); PG8_BAR; PG8_WAIT_L(0); PG8_MMA(0, 0, At, B0); PG8_BAR; PG8_SCHED;
            PG8_LDB(B1, 1, 1); PG8_STAGE(PG8_SB(1, 0), b3, voffB);
            PG8_BAR; PG8_WAIT_L(0); PG8_MMA(0, 1, At, B1); PG8_BAR;
            PG8_LDA(At, 1, 1); PG8_STAGE(PG8_SA(1, 0), a3, voffA);
            PG8_BAR; PG8_WAIT_L(0); PG8_MMA(1, 0, At, B0); PG8_BAR; PG8_SCHED;
            PG8_STAGE(PG8_SB(1, 1), b3 + hstepB, voffB);
            PG8_WAIT_V(6); PG8_BAR; PG8_MMA(1, 1, At, B1); PG8_BAR;
        }
        PG8_STAMP();
        if constexpr (!Epi::AFTER_DRAIN) { E(acc, cur, wr, wc, fr, fq); S.done(cur); }
        PG8_STAMP();
        if (!has_next) break;
#pragma unroll
        for (int a = 0; a < 2; ++a)
#pragma unroll
            for (int b = 0; b < 2; ++b)
#pragma unroll
                for (int m = 0; m < 4; ++m)
#pragma unroll
                    for (int n = 0; n < 2; ++n) acc[a][b][m][n] = (f32x4){0.f, 0.f, 0.f, 0.f};
        cur = nxt; cA = nA; cB = nB; ++ui;
    }
    PG8_WAIT_V(0);
    if (wr == 0) PG8_BAR;
    PG8_BAR;
    if constexpr (Epi::AFTER_DRAIN) { E.fused(acc, cur, wr, wc, fr, fq, lds, wid, lane); S.done(cur); }
    PG8_STAMP();
    if (STAMP && wid == 0) { stamps[lane] = lane < nts ? (((unsigned long long)(unsigned)ts_hi << 32) | (unsigned)ts_lo) : 0ull;
        if (lane == 62) stamps[62] = rt_entry; if (lane == 63) stamps[63] = (unsigned long long)wall_clock64(); }
#undef PG8_STAMP
#undef PG8_SA
#undef PG8_SB
#undef PG8_STAGE
#undef PG8_LDA
#undef PG8_LDB
#undef PG8_MMA
#undef PG8_WAIT_V
#undef PG8_WAIT_L
#undef PG8_BAR
#undef PG8_SCHED
}
}

struct EpiBf {
  static constexpr bool PERM = true, AFTER_DRAIN = false;
  u16* O; int ldc; const float* bias; int act;
  __device__ __forceinline__ void operator()(const f32x4 (&acc)[2][2][4][2], const pg8::Unit& u, int wr, int wc, int fr, int fq) const {
    const int row0 = u.pm * 256 + wr * 64 + fr, col0 = u.pn * 256 + wc * 32 + 8 * fq;
    f32x4 bv[2][2];
#pragma unroll
    for (int bj = 0; bj < 2; ++bj)
#pragma unroll
      for (int n = 0; n < 2; ++n) bv[bj][n] = bias ? *(const f32x4*)(bias + col0 + bj * 128 + 4 * n) : f32x4{0.f, 0.f, 0.f, 0.f};
#pragma unroll
    for (int ai = 0; ai < 2; ++ai)
#pragma unroll
      for (int m = 0; m < 4; ++m) {
        u16* rowp = O + (size_t)(row0 + ai * 128 + m * 16) * ldc + col0;
#pragma unroll
        for (int bj = 0; bj < 2; ++bj) {
          f32x4 v0 = acc[ai][bj][m][0] + bv[bj][0], v1 = acc[ai][bj][m][1] + bv[bj][1];
          if (act == 1) {
#pragma unroll
            for (int j = 0; j < 4; ++j) { v0[j] = sigm(v0[j]); v1[j] = sigm(v1[j]); }
          }
          uint4 wv;
          wv.x = pack2(v0[0], v0[1]); wv.y = pack2(v0[2], v0[3]); wv.z = pack2(v1[0], v1[1]); wv.w = pack2(v1[2], v1[3]);
          *(uint4*)(rowp + bj * 128) = wv;
        }
      }
  }
};
struct EpiSwiglu {
  static constexpr bool PERM = true, AFTER_DRAIN = false;
  u16* O;
  __device__ __forceinline__ void operator()(const f32x4 (&acc)[2][2][4][2], const pg8::Unit& u, int wr, int wc, int fr, int fq) const {
    const int row0 = u.pm * 256 + wr * 64 + fr, col0 = u.pn * 128 + wc * 16 + 4 * fq;
#pragma unroll
    for (int ai = 0; ai < 2; ++ai)
#pragma unroll
      for (int m = 0; m < 4; ++m) {
        u16* rowp = O + (size_t)(row0 + ai * 128 + m * 16) * FH + col0;
#pragma unroll
        for (int bj = 0; bj < 2; ++bj) {
          const f32x4 g = acc[ai][bj][m][0], up = acc[ai][bj][m][1];
          uint2 wv;
          wv.x = pack2(siluf(g[0]) * up[0], siluf(g[1]) * up[1]);
          wv.y = pack2(siluf(g[2]) * up[2], siluf(g[3]) * up[3]);
          *(uint2*)(rowp + bj * 64) = wv;
        }
      }
  }
};
struct EpiGateAcc {
  static constexpr bool PERM = true, AFTER_DRAIN = false;
  u16* ACC; const u16* G; int gcol; unsigned amask;
  __device__ __forceinline__ void operator()(const f32x4 (&acc)[2][2][4][2], const pg8::Unit& u, int wr, int wc, int fr, int fq) const {
    unsigned pk[2][2][4][4];
#pragma unroll
    for (int ai = 0; ai < 2; ++ai)
#pragma unroll
      for (int bj = 0; bj < 2; ++bj)
#pragma unroll
        for (int m = 0; m < 4; ++m) {
          pk[ai][bj][m][0] = pack2(acc[ai][bj][m][0][0], acc[ai][bj][m][0][1]);
          pk[ai][bj][m][1] = pack2(acc[ai][bj][m][0][2], acc[ai][bj][m][0][3]);
          pk[ai][bj][m][2] = pack2(acc[ai][bj][m][1][0], acc[ai][bj][m][1][1]);
          pk[ai][bj][m][3] = pack2(acc[ai][bj][m][1][2], acc[ai][bj][m][1][3]);
        }
    asm volatile("" ::: "memory");
    const int row0 = u.pm * 256 + wr * 64 + fr, col0 = u.pn * 256 + wc * 32 + 8 * fq;
#pragma unroll
    for (int ai = 0; ai < 2; ++ai)
#pragma unroll
      for (int m = 0; m < 4; ++m) {
        const size_t row = (size_t)(row0 + ai * 128 + m * 16);
#pragma unroll
        for (int bj = 0; bj < 2; ++bj) {
          const int col = col0 + bj * 128;
          const uint4 gv = *(const uint4*)(G + row * 2048 + gcol + col);
          const uint4 av = *(const uint4*)(ACC + row * DM + col);
          const unsigned gw[4] = {gv.x, gv.y, gv.z, gv.w};
          const unsigned aw[4] = {av.x & amask, av.y & amask, av.z & amask, av.w & amask};
          unsigned ow[4];
#pragma unroll
          for (int q = 0; q < 4; ++q) {
            const unsigned pv = pk[ai][bj][m][q];
            const float lo = __uint_as_float(aw[q] << 16) + __uint_as_float(gw[q] << 16) * __uint_as_float(pv << 16);
            const float hi = __uint_as_float(aw[q] & 0xffff0000u) + __uint_as_float(gw[q] & 0xffff0000u) * __uint_as_float(pv & 0xffff0000u);
            ow[q] = pack2(lo, hi);
          }
          *(uint4*)(ACC + row * DM + col) = make_uint4(ow[0], ow[1], ow[2], ow[3]);
        }
        asm volatile("" ::: "memory");
      }
  }
};

template <int MI>
__device__ __forceinline__ void gemm_loop(const u16* __restrict__ A, int lda, const u16* __restrict__ Bt, int ldb, int K,
                                          f32x4 (&acc)[MI][4], u16* sA, u16* sB) {
  constexpr int BMT = MI * 64;
  const int tid = TIDX, lane = tid & 63, w = tid >> 6, wm = w >> 1, wn = w & 1, fr = lane & 15, fq = lane >> 4;
  uint4 ra[MI], rb[2];
  const u16* ga = A + (size_t)(tid >> 3) * lda + (tid & 7) * 8;
  const u16* gb = Bt + (size_t)(tid >> 3) * ldb + (tid & 7) * 8;
  const int so = (tid >> 3) * LDT + (tid & 7) * 8;
#pragma unroll
  for (int i = 0; i < MI; i++) ra[i] = *(const uint4*)(ga + (size_t)(i * 64) * lda);
#pragma unroll
  for (int i = 0; i < 2; i++) rb[i] = *(const uint4*)(gb + (size_t)(i * 64) * ldb);
#pragma unroll
  for (int i = 0; i < MI; i++) *(uint4*)(sA + so + i * 64 * LDT) = ra[i];
#pragma unroll
  for (int i = 0; i < 2; i++) *(uint4*)(sB + so + i * 64 * LDT) = rb[i];
  __syncthreads();
  const int nk = K >> 6;
  for (int kt = 0; kt < nk; kt++) {
    const bool more = kt + 1 < nk;
    if (more) {
#pragma unroll
      for (int i = 0; i < MI; i++) ra[i] = *(const uint4*)(ga + (size_t)(i * 64) * lda + (kt + 1) * 64);
#pragma unroll
      for (int i = 0; i < 2; i++) rb[i] = *(const uint4*)(gb + (size_t)(i * 64) * ldb + (kt + 1) * 64);
    }
    const u16* a = sA + (kt & 1) * BMT * LDT + (wm * (MI * 16) + fr) * LDT + fq * 8;
    const u16* b = sB + (kt & 1) * 128 * LDT + (wn * 64 + fr) * LDT + fq * 8;
#pragma unroll
    for (int ks = 0; ks < 2; ks++) {
      bf16x8 af[MI], bfr[4];
#pragma unroll
      for (int i = 0; i < MI; i++) af[i] = *(const bf16x8*)(a + i * 16 * LDT + ks * 32);
#pragma unroll
      for (int j = 0; j < 4; j++) bfr[j] = *(const bf16x8*)(b + j * 16 * LDT + ks * 32);
#pragma unroll
      for (int i = 0; i < MI; i++)
#pragma unroll
        for (int j = 0; j < 4; j++) acc[i][j] = __builtin_amdgcn_mfma_f32_16x16x32_bf16(bfr[j], af[i], acc[i][j], 0, 0, 0);
    }
    if (more) {
      u16* da = sA + ((kt + 1) & 1) * BMT * LDT + so;
      u16* db = sB + ((kt + 1) & 1) * 128 * LDT + so;
#pragma unroll
      for (int i = 0; i < MI; i++) *(uint4*)(da + i * 64 * LDT) = ra[i];
#pragma unroll
      for (int i = 0; i < 2; i++) *(uint4*)(db + i * 64 * LDT) = rb[i];
    }
    __syncthreads();
  }
}

template <int MI>
__device__ __forceinline__ void zero_acc(f32x4 (&acc)[MI][4]) {
#pragma unroll
  for (int i = 0; i < MI; i++)
#pragma unroll
    for (int j = 0; j < 4; j++) acc[i][j] = f32x4{0.f, 0.f, 0.f, 0.f};
}


typedef unsigned u32x4v __attribute__((ext_vector_type(4)));
__device__ __forceinline__ void yp_issue(const u16* __restrict__ A, const u16* __restrict__ B, u32x4v (&ra)[8], u32x4v (&rb)[8], int tid) {
#pragma unroll
  for (int i = 0; i < 8; i++) {
    const int c = tid + i * NTHR, row = c >> 5, ch = c & 31;
    ra[i] = *(const u32x4v*)(A + (size_t)row * YST + ch * 8);
    rb[i] = *(const u32x4v*)(B + (size_t)row * 256 + ch * 8);
  }
}
__device__ __forceinline__ void yp_stage(unsigned char* sA, unsigned char* sB, const u32x4v (&ra)[8], const u32x4v (&rb)[8], int tid) {
#pragma unroll
  for (int i = 0; i < 8; i++) {
    const int c = tid + i * NTHR, row = c >> 5, ch = c & 31;
    const int off = row * 512 + ((ch ^ (row & 7)) << 4);
    *(u32x4v*)(sA + off) = ra[i];
    *(u32x4v*)(sB + off) = rb[i];
  }
}
__device__ __forceinline__ void phase_ypart(const Params& p, int l, int hf, unsigned char* smem) {
  unsigned char* sA = smem;
  unsigned char* sB = smem + 65536;
  const int tid = TIDX, lane = tid & 63, w = tid >> 6, wm = w >> 1, wn = w & 1, fr = lane & 15, fq = lane >> 4;
  const u16* Y = (const u16*)(p.ws + OFF_YS);
  const u16* Wb = (const u16*)(p.ws + OFF_W + (size_t)l * SZ_WL + OW_B);
  const u16* G = (const u16*)(p.ws + OFF_BIG);
  u16* ACC = (u16*)(p.ws + OFF_BIG + 2 * SZ_ACT);
  constexpr int NT = 8;
  const int ntiles = (NROWS / 128) * NT;
  const int G_ = gridDim.x;
  const bool xmap = (G_ == 256);
  const int xj = blockIdx.x >> 3, xx = blockIdx.x & 7;
  const int nmine = xmap ? (xj < 272 ? (271 - xj) / 32 + 1 : 0)
                         : (((int)blockIdx.x < ntiles) ? (ntiles - 1 - (int)blockIdx.x) / G_ + 1 : 0);
  if (nmine == 0) return;
#define YP_TILE(Q_, MT_, NT_)                                                        \
  do {                                                                               \
    if (xmap) { const int s_ = (Q_) * 32 + xj; MT_ = (s_ >> 3) * 8 + xx; NT_ = s_ & 7; } \
    else { const int t_ = blockIdx.x + (Q_) * G_; MT_ = t_ / NT; NT_ = t_ - MT_ * NT; }  \
  } while (0)
  u32x4v ra[8], rb[8];
  {
    int mt, nt;
    YP_TILE(0, mt, nt);
    const int br = hf * 2, yc = br < 3 ? br * 256 : 1536;
    yp_issue(Y + (size_t)mt * 128 * YST + yc, Wb + ((size_t)br * 1024 + nt * 128) * 256, ra, rb, tid);
  }
  f32x4 tot[2][4];
  zero_acc<2>(tot);
  for (int qi = 0; qi < 2 * nmine; qi++) {
    const int q = qi >> 1, k = qi & 1;
    int mt, nt;
    YP_TILE(q, mt, nt);
    const int r0 = mt * 128 + wm * 32 + fr, c0 = nt * 128 + wn * 64 + fq * 4;
    __syncthreads();
    yp_stage(sA, sB, ra, rb, tid);
    __syncthreads();
    {
      const int qn = qi + 1 < 2 * nmine ? qi + 1 : qi;
      int mtn, ntn;
      YP_TILE(qn >> 1, mtn, ntn);
      const int brn = hf * 2 + (qn & 1), ycn = brn < 3 ? brn * 256 : 1536;
      yp_issue(Y + (size_t)mtn * 128 * YST + ycn, Wb + ((size_t)brn * 1024 + ntn * 128) * 256, ra, rb, tid);
    }
    uint2 gv[2][4];
#pragma unroll
    for (int i = 0; i < 2; i++)
#pragma unroll
      for (int j = 0; j < 4; j++) gv[i][j] = *(const uint2*)(G + (size_t)(r0 + i * 16) * 2048 + k * 1024 + c0 + j * 16);
    f32x4 ay[2][4];
    zero_acc<2>(ay);
#pragma unroll 2
    for (int ks = 0; ks < 8; ks++) {
      bf16x8 af[2], bfr[4];
#pragma unroll
      for (int i = 0; i < 2; i++) {
        const int row = wm * 32 + i * 16 + fr;
        af[i] = *(const bf16x8*)(sA + row * 512 + (((ks * 4 + fq) ^ (row & 7)) << 4));
      }
#pragma unroll
      for (int j = 0; j < 4; j++) {
        const int row = wn * 64 + j * 16 + fr;
        bfr[j] = *(const bf16x8*)(sB + row * 512 + (((ks * 4 + fq) ^ (row & 7)) << 4));
      }
#pragma unroll
      for (int i = 0; i < 2; i++)
#pragma unroll
        for (int j = 0; j < 4; j++) ay[i][j] = __builtin_amdgcn_mfma_f32_16x16x32_bf16(bfr[j], af[i], ay[i][j], 0, 0, 0);
    }
#pragma unroll
    for (int i = 0; i < 2; i++)
#pragma unroll
      for (int j = 0; j < 4; j++) {
        tot[i][j][0] += __uint_as_float(gv[i][j].x << 16) * ay[i][j][0];
        tot[i][j][1] += __uint_as_float(gv[i][j].x & 0xffff0000u) * ay[i][j][1];
        tot[i][j][2] += __uint_as_float(gv[i][j].y << 16) * ay[i][j][2];
        tot[i][j][3] += __uint_as_float(gv[i][j].y & 0xffff0000u) * ay[i][j][3];
      }
    if (k == 1) {
      const unsigned amask = hf ? 0xffffffffu : 0u;
      uint2 av[2][4];
#pragma unroll
      for (int i = 0; i < 2; i++)
#pragma unroll
        for (int j = 0; j < 4; j++) av[i][j] = *(const uint2*)(ACC + (size_t)(r0 + i * 16) * DM + c0 + j * 16);
#pragma unroll
      for (int i = 0; i < 2; i++)
#pragma unroll
        for (int j = 0; j < 4; j++) {
          u16* ap = ACC + (size_t)(r0 + i * 16) * DM + c0 + j * 16;
          f32x4 v = tot[i][j];
          const unsigned ax = av[i][j].x & amask, ay_ = av[i][j].y & amask;
          v[0] += __uint_as_float(ax << 16); v[1] += __uint_as_float(ax & 0xffff0000u);
          v[2] += __uint_as_float(ay_ << 16); v[3] += __uint_as_float(ay_ & 0xffff0000u);
          uint2 ov;
          ov.x = pack2(v[0], v[1]); ov.y = pack2(v[2], v[3]);
          *(uint2*)ap = ov;
        }
      zero_acc<2>(tot);
    }
  }
  __syncthreads();
#undef YP_TILE
}

#define S2_BUF 10816
#define S2_D 0
#define S2_U 2048
#define S2_P 4096
#define S2_K 6144
#define S2_DQ 8192
#define S2_V 10240
#define S2_C1 10752
#define S2_C2 10784
#define S2_ST (2 * S2_BUF)
#define S2_YB (S2_ST + 8192)

__device__ __forceinline__ float red16(float x) {
  x += dppf<0xB1>(x);
  x += dppf<0x4E>(x);
  x += dppf<0x141>(x);
  x += dppf<0x140>(x);
  return x;
}
__device__ __forceinline__ void wave_lds_sync() {
  asm volatile("s_waitcnt lgkmcnt(0)" ::: "memory");
  __builtin_amdgcn_wave_barrier();
}

template <int MIX>
__device__ __forceinline__ void scan2_item(const Params& p, int l, int b, int h, int dir, int rq, float* sm) {
  constexpr int EPL = (MIX == 2) ? 2 : 4;
  constexpr int VOFF = (MIX == 2) ? 64 : 128;
  const int tid = TIDX, lane = tid & 63, w = tid >> 6, fr = lane & 15, fq = lane >> 4;
  const bool producer = w >= 4;
  const int pw = w & 3;
  const u16* P = (const u16*)(p.ws + OFF_BIG);
  u16* YS = (u16*)(p.ws + OFF_YS);
  float* BC = (float*)(p.ws + OFF_BC);
  float* ST = sm + S2_ST + pw * 2048;
  float s[EPL];
#pragma unroll
  for (int i = 0; i < EPL; i++) s[i] = 0.f;

  bf16x8 bw2[4], ba2[4];
  float cst[5][4];
  float cw[3][7];
  float muv[4];
  int colv[4];
#pragma unroll
  for (int i = 0; i < 4; i++) { bw2[i] = bf16x8{0, 0, 0, 0, 0, 0, 0, 0}; ba2[i] = bw2[i]; muv[i] = 0.f; colv[i] = 0; }
  if (producer) {
    if (MIX == 0) {
#pragma unroll
      for (int nt = 0; nt < 4; nt++) {
        const int jch = h * 64 + nt * 16 + fr;
#pragma unroll
        for (int jj = 0; jj < 8; jj++) {
          bw2[nt][jj] = (short)f2bf(p.rwkv_w2[((size_t)(l * 2 + dir) * 32 + fq * 8 + jj) * 256 + jch]);
          ba2[nt][jj] = (short)f2bf(p.rwkv_a2[((size_t)(l * 2 + dir) * 32 + fq * 8 + jj) * 256 + jch]);
        }
        cst[0][nt] = p.rwkv_w0[(l * 2 + dir) * 256 + jch];
        cst[1][nt] = p.rwkv_a0[(l * 2 + dir) * 256 + jch];
        cst[2][nt] = p.rwkv_ka[l * 256 + jch];
        cst[3][nt] = p.rwkv_kk[l * 256 + jch];
        cst[4][nt] = p.rwkv_rk[l * 256 + jch];
      }
#pragma unroll
      for (int i = 0; i < 4; i++) {
        const int c = lane + 64 * i;
        colv[i] = i < 3 ? i * 256 + h * 64 + lane : (lane < 32 ? 768 + dir * 32 + lane : 832 + dir * 32 + (lane - 32));
        muv[i] = p.rwkv_mu[l * 960 + colv[i]];
        (void)c;
      }
    } else if (MIX == 1) {
#pragma unroll
      for (int i = 0; i < 3; i++) {
        colv[i] = PB + i * 256 + h * 64 + lane;
#pragma unroll
        for (int tp = 0; tp < 7; tp++) cw[i][tp] = p.gdn_conv[((size_t)l * 7 + tp) * 768 + i * 256 + h * 64 + lane];
      }
    } else {
#pragma unroll
      for (int nt = 0; nt < 2; nt++) {
#pragma unroll
        for (int jj = 0; jj < 8; jj++)
          bw2[nt][jj] = fq < 2 ? (short)f2bf(p.gla_gw2[((size_t)(l * 2 + dir) * 16 + fq * 8 + jj) * 128 + h * 32 + nt * 16 + fr]) : (short)0;
        cst[0][nt] = p.gla_gb[(l * 2 + dir) * 128 + h * 32 + nt * 16 + fr];
      }
      colv[0] = PC + h * 32 + lane;
      if (lane >= 32) colv[0] = PC + 128 + h * 32 + (lane - 32);
      colv[1] = PC + 256 + h * 64 + lane;
      colv[2] = PC + 512 + dir * 16 + (lane & 15);
    }
  }
  __syncthreads();

  for (int c = 0; c <= TPB / 32 + 1; c++) {
    if (producer) {
      if (c >= 2) {
        const int cc = c - 2;
        int seg_row0, t_lo;
        if (cc < 8) { seg_row0 = b * TPB; t_lo = dir == 0 ? cc * 32 : (LC - 32 - cc * 32); }
        else { seg_row0 = b * TPB + LC; t_lo = dir == 0 ? (cc - 8) * 32 : (SEQ - 32 - (cc - 8) * 32); }
        const float* yb = sm + S2_YB + (cc & 1) * 512;
        const int t2 = tid - 256;
#pragma unroll
        for (int i = 0; i < 2; i++) {
          const int idx = t2 + i * 256, tt = idx >> 4, e = idx & 15;
          YS[(size_t)(seg_row0 + t_lo + tt) * YST + dir * 768 + MIX * 256 + h * 64 + rq * 16 + e] = f2bf(yb[idx]);
        }
      }
      if (c < TPB / 32) {
        int seg_row0, seg_len, t_lo;
        if (c < 8) { seg_row0 = b * TPB; seg_len = LC; t_lo = dir == 0 ? c * 32 : (LC - 32 - c * 32); }
        else { seg_row0 = b * TPB + LC; seg_len = SEQ; t_lo = dir == 0 ? (c - 8) * 32 : (SEQ - 32 - (c - 8) * 32); }
        const u16* Pseg = P + (size_t)seg_row0 * PST;
        float* B = sm + (c & 1) * S2_BUF;
        const int t0 = t_lo + pw * 8;
        if (MIX == 0) {
          float raw[10][4];
#pragma unroll
          for (int rr = 0; rr < 10; rr++) {
            const int t = t0 - 1 + rr;
            const float okf = (t >= 0 && t < seg_len) ? 1.f : 0.f;
            const int tc = min(max(t, 0), seg_len - 1);
#pragma unroll
            for (int i = 0; i < 4; i++) raw[rr][i] = bf2f(Pseg[(size_t)tc * PST + PA + colv[i]]) * okf;
          }
#pragma unroll
          for (int j = 0; j < 8; j++)
#pragma unroll
            for (int i = 0; i < 4; i++) {
              float xm = raw[j + 1][i] + (0.5f * (raw[j][i] + raw[j + 2][i]) - raw[j + 1][i]) * muv[i];
              if (i == 3 && lane < 32) xm = tanh_fast(xm);
              ST[j * 256 + lane + 64 * i] = xm;
            }
        } else if (MIX == 1) {
          float raw[14][3];
#pragma unroll
          for (int rr = 0; rr < 14; rr++) {
            const int t = t0 - 3 + rr;
            const float okf = (t >= 0 && t < seg_len) ? 1.f : 0.f;
            const int tc = min(max(t, 0), seg_len - 1);
#pragma unroll
            for (int i = 0; i < 3; i++) raw[rr][i] = bf2f(Pseg[(size_t)tc * PST + colv[i]]) * okf;
          }
#pragma unroll
          for (int j = 0; j < 8; j++)
#pragma unroll
            for (int i = 0; i < 3; i++) {
              float a = 0.f;
#pragma unroll
              for (int tp = 0; tp < 7; tp++) a += raw[j + tp][i] * cw[i][tp];
              ST[j * 256 + lane + 64 * i] = siluf(a);
            }
          if (lane < 8) {
            const u16* pp = Pseg + (size_t)(t0 + lane) * PST + PB;
            float bx = bf2f(pp[768 + dir * 4 + h]);
            float ax = bf2f(pp[776 + dir * 4 + h]);
            float ld = -__expf(p.gdn_a_log[(l * 2 + dir) * 4 + h]) * softplusf(ax + p.gdn_dt_bias[(l * 2 + dir) * 4 + h]);
            ST[lane * 256 + 192] = sigm(bx);
            ST[lane * 256 + 193] = __expf(ld);
          }
        } else {
          u16 raw[8][3];
#pragma unroll
          for (int j = 0; j < 8; j++) {
            const u16* pp = Pseg + (size_t)(t0 + j) * PST;
#pragma unroll
            for (int i = 0; i < 3; i++) raw[j][i] = pp[colv[i]];
          }
          const float qs = lane < 32 ? 0.17677669529663687f : 1.f;
#pragma unroll
          for (int j = 0; j < 8; j++) {
            ST[j * 256 + lane] = bf2f(raw[j][0]) * qs;
            ST[j * 256 + 64 + lane] = bf2f(raw[j][1]);
            if (lane < 16) ST[j * 256 + 128 + lane] = bf2f(raw[j][2]);
          }
        }
        wave_lds_sync();
        const bool vl = fq < 2;
        if (MIX == 0) {
          bf16x8 aw, aa;
#pragma unroll
          for (int jj = 0; jj < 8; jj++) {
            aw[jj] = fr < 8 ? (short)f2bf(ST[fr * 256 + 192 + fq * 8 + jj]) : (short)0;
            aa[jj] = fr < 8 ? (short)f2bf(ST[fr * 256 + 224 + fq * 8 + jj]) : (short)0;
          }
          f32x4 accw[4], acca[4];
#pragma unroll
          for (int nt = 0; nt < 4; nt++) {
            accw[nt] = __builtin_amdgcn_mfma_f32_16x16x32_bf16(aw, bw2[nt], f32x4{0.f, 0.f, 0.f, 0.f}, 0, 0, 0);
            acca[nt] = __builtin_amdgcn_mfma_f32_16x16x32_bf16(aa, ba2[nt], f32x4{0.f, 0.f, 0.f, 0.f}, 0, 0, 0);
          }
#pragma unroll
          for (int r = 0; r < 4; r++) {
            const int j = (fq & 1) * 4 + r, tt = pw * 8 + j;
            float kkx[4], av[4], kdv[4], rv[4], dec[4];
            float ss = 0.f;
#pragma unroll
            for (int nt = 0; nt < 4; nt++) {
              const int n = nt * 16 + fr;
              rv[nt] = ST[j * 256 + n];
              const float kx = ST[j * 256 + 64 + n];
              dec[nt] = __expf(-0.6065306597126334f * sigm(cst[0][nt] + accw[nt][r]));
              av[nt] = sigm(cst[1][nt] + acca[nt][r]);
              kdv[nt] = kx * (1.f + (av[nt] - 1.f) * cst[2][nt]);
              kkx[nt] = kx * cst[3][nt];
              ss += kkx[nt] * kkx[nt];
            }
            ss = red16(ss);
            const float rs = rsq(ss + 1e-6f);
            float c1 = 0.f, c2 = 0.f, bc = 0.f;
#pragma unroll
            for (int nt = 0; nt < 4; nt++) {
              const int n = nt * 16 + fr;
              const float kk = kkx[nt] * rs;
              if (vl) {
                B[S2_D + tt * 64 + n] = dec[nt];
                B[S2_U + tt * 64 + n] = kk;
                B[S2_P + tt * 64 + n] = -kk * av[nt];
                B[S2_K + tt * 64 + n] = kdv[nt];
                B[S2_DQ + tt * 64 + n] = dec[nt] * rv[nt];
              }
              c1 += -kk * av[nt] * rv[nt];
              c2 += kdv[nt] * rv[nt];
              bc += rv[nt] * kdv[nt] * cst[4][nt];
            }
            c1 = red16(c1); c2 = red16(c2); bc = red16(bc);
            if (vl && fr == 0) {
              B[S2_C1 + tt] = c1;
              B[S2_C2 + tt] = c2;
              if (rq == 0) BC[(size_t)(seg_row0 + t_lo + tt) * 8 + h * 2 + dir] = bc;
            }
          }
        } else if (MIX == 1) {
#pragma unroll
          for (int r = 0; r < 4; r++) {
            const int j = (fq & 1) * 4 + r, tt = pw * 8 + j;
            float qv[4], kv[4];
            float sq = 0.f, sk = 0.f;
#pragma unroll
            for (int nt = 0; nt < 4; nt++) {
              const int n = nt * 16 + fr;
              qv[nt] = ST[j * 256 + n];
              kv[nt] = ST[j * 256 + 64 + n];
              sq += qv[nt] * qv[nt];
              sk += kv[nt] * kv[nt];
            }
            sq = red16(sq); sk = red16(sk);
            const float rq_ = rsq(sq + 1e-6f) * 0.125f, rk_ = rsq(sk + 1e-6f);
            const float beta = ST[j * 256 + 192], alpha = ST[j * 256 + 193];
            float dkq = 0.f;
#pragma unroll
            for (int nt = 0; nt < 4; nt++) {
              const int n = nt * 16 + fr;
              const float qn = qv[nt] * rq_, kn = kv[nt] * rk_;
              if (vl) {
                B[S2_D + tt * 64 + n] = alpha;
                B[S2_U + tt * 64 + n] = kn;
                B[S2_P + tt * 64 + n] = -alpha * beta * kn;
                B[S2_K + tt * 64 + n] = beta * kn;
                B[S2_DQ + tt * 64 + n] = alpha * qn;
              }
              dkq += kn * qn;
            }
            dkq = red16(dkq);
            if (vl && fr == 0) {
              B[S2_C1 + tt] = -alpha * beta * dkq;
              B[S2_C2 + tt] = beta * dkq;
            }
          }
        } else {
          bf16x8 ag;
#pragma unroll
          for (int jj = 0; jj < 8; jj++) ag[jj] = (fr < 8 && fq < 2) ? (short)f2bf(ST[fr * 256 + 128 + fq * 8 + jj]) : (short)0;
          f32x4 accg[2];
#pragma unroll
          for (int nt = 0; nt < 2; nt++) accg[nt] = __builtin_amdgcn_mfma_f32_16x16x32_bf16(ag, bw2[nt], f32x4{0.f, 0.f, 0.f, 0.f}, 0, 0, 0);
#pragma unroll
          for (int r = 0; r < 4; r++) {
            const int j = (fq & 1) * 4 + r, tt = pw * 8 + j;
            float dkq = 0.f;
#pragma unroll
            for (int nt = 0; nt < 2; nt++) {
              const int n = nt * 16 + fr;
              const float lg = cst[0][nt] + accg[nt][r];
              const float ls = fminf(lg, 0.f) - __logf(1.f + __expf(-fabsf(lg)));
              const float alpha = __expf(ls * (1.f / 16.f));
              const float qv = ST[j * 256 + n], kv = ST[j * 256 + 32 + n];
              if (vl) {
                B[S2_D + tt * 64 + n] = alpha;
                B[S2_K + tt * 64 + n] = kv;
                B[S2_DQ + tt * 64 + n] = alpha * qv;
              }
              dkq += kv * qv;
            }
            dkq = red16(dkq);
            if (vl && fr == 0) B[S2_C2 + tt] = dkq;
          }
        }
#pragma unroll
        for (int i = 0; i < 2; i++) {
          const int idx = lane + 64 * i, j = idx >> 4, e = idx & 15;
          B[S2_V + (pw * 8 + j) * 16 + e] = ST[j * 256 + VOFF + rq * 16 + e];
        }
      }
    } else if (c >= 1 && c <= TPB / 32) {
      const float* B = sm + ((c - 1) & 1) * S2_BUF;
      float* yb = sm + S2_YB + ((c - 1) & 1) * 512;
      const int rl = w * 4 + fq;
      const int dtt = dir ? -1 : 1;
      int tt = dir ? 31 : 0;
      float dv[EPL], kv[EPL], qv[EPL], uv[EPL], pv[EPL], vv, c1v, c2v;
      float dn[EPL], kn[EPL], qn[EPL], un[EPL], pn[EPL], vn, c1n, c2n;
#define S2_LOAD(D_, K_, Q_, U_, P_, V_, C1_, C2_, T_)                                   \
  do {                                                                                  \
    const int o_ = (T_) * 64 + fr * EPL;                                                \
    if (EPL == 4) {                                                                     \
      float4 t4 = *(const float4*)(B + S2_D + o_);                                      \
      D_[0] = t4.x; D_[1] = t4.y; D_[2] = t4.z; D_[3] = t4.w;                           \
      t4 = *(const float4*)(B + S2_K + o_);                                             \
      K_[0] = t4.x; K_[1] = t4.y; K_[2] = t4.z; K_[3] = t4.w;                           \
      t4 = *(const float4*)(B + S2_DQ + o_);                                            \
      Q_[0] = t4.x; Q_[1] = t4.y; Q_[2] = t4.z; Q_[3] = t4.w;                           \
      t4 = *(const float4*)(B + S2_U + o_);                                             \
      U_[0] = t4.x; U_[1] = t4.y; U_[2] = t4.z; U_[3] = t4.w;                           \
      t4 = *(const float4*)(B + S2_P + o_);                                             \
      P_[0] = t4.x; P_[1] = t4.y; P_[2] = t4.z; P_[3] = t4.w;                           \
      C1_ = B[S2_C1 + (T_)];                                                            \
    } else {                                                                            \
      float2 t2 = *(const float2*)(B + S2_D + o_);                                      \
      D_[0] = t2.x; D_[1] = t2.y;                                                       \
      t2 = *(const float2*)(B + S2_K + o_);                                             \
      K_[0] = t2.x; K_[1] = t2.y;                                                       \
      t2 = *(const float2*)(B + S2_DQ + o_);                                            \
      Q_[0] = t2.x; Q_[1] = t2.y;                                                       \
      U_[0] = U_[1] = P_[0] = P_[1] = 0.f; C1_ = 0.f;                                   \
    }                                                                                   \
    V_ = B[S2_V + (T_) * 16 + rl];                                                      \
    C2_ = B[S2_C2 + (T_)];                                                              \
  } while (0)
#define S2_STEP(D_, K_, Q_, U_, P_, V_, C1_, C2_, T_)                                   \
  do {                                                                                  \
    float sq = 0.f, sa = 0.f;                                                           \
    _Pragma("unroll") for (int i = 0; i < EPL; i++) sq += s[i] * Q_[i];                 \
    if (MIX != 2) {                                                                     \
      _Pragma("unroll") for (int i = 0; i < EPL; i++) sa += s[i] * U_[i];               \
      sa = red16(sa);                                                                   \
    }                                                                                   \
    sq = red16(sq);                                                                     \
    float y = sq + V_ * C2_;                                                            \
    if (MIX != 2) y += sa * C1_;                                                        \
    _Pragma("unroll") for (int i = 0; i < EPL; i++) {                                   \
      float t = s[i] * D_[i] + V_ * K_[i];                                              \
      if (MIX != 2) t += sa * P_[i];                                                    \
      s[i] = t;                                                                         \
    }                                                                                   \
    yb[(T_) * 16 + rl] = y;                                                             \
  } while (0)
      S2_LOAD(dv, kv, qv, uv, pv, vv, c1v, c2v, tt);
#pragma unroll 1
      for (int st = 0; st < 32; st += 2) {
        const int t1 = tt + dtt;
        S2_LOAD(dn, kn, qn, un, pn, vn, c1n, c2n, t1);
        S2_STEP(dv, kv, qv, uv, pv, vv, c1v, c2v, tt);
        const int t2 = st + 2 < 32 ? t1 + dtt : t1;
        S2_LOAD(dv, kv, qv, uv, pv, vv, c1v, c2v, t2);
        S2_STEP(dn, kn, qn, un, pn, vn, c1n, c2n, t1);
        tt = t2;
      }
#undef S2_LOAD
#undef S2_STEP
    }
    __syncthreads();
  }
}

#define S3_SUB 12800
#define S3_GM 0
#define S3_KVT 9216
#define S3_QB 10240
#define S3_QV 11392
#define S3_VT 11520
#define S3_WC 12544
#define S3_STB (8 * S3_SUB)
#define S3_END (S3_STB + 4 * 2304)

__device__ __forceinline__ float rlane(float x, int l) { return __int_as_float(__builtin_amdgcn_readlane(__float_as_int(x), l)); }
__device__ __forceinline__ float wave_sum(float x) {
  x = red16(x);
  return (rlane(x, 0) + rlane(x, 16)) + (rlane(x, 32) + rlane(x, 48));
}
__device__ __forceinline__ float clampe(float x) { return fminf(fmaxf(x, -80.f), 80.f); }
__device__ __forceinline__ uint4 pack8(const float (&v)[8]) {
  return make_uint4(pack2(v[0], v[1]), pack2(v[2], v[3]), pack2(v[4], v[5]), pack2(v[6], v[7]));
}
__device__ __forceinline__ bf16x8 ld_frag(const void* p) { return *(const bf16x8*)p; }
__device__ __forceinline__ bf16x8 zfrag() { return bf16x8{0, 0, 0, 0, 0, 0, 0, 0}; }

__device__ __forceinline__ void chunk_geom(int c, int dir, int b, int& seg_row0, int& seg_len, int& t_lo) {
  if (c < 8) { seg_row0 = b * TPB; seg_len = LC; t_lo = dir == 0 ? c * 32 : (LC - 32 - c * 32); }
  else { seg_row0 = b * TPB + LC; seg_len = SEQ; t_lo = dir == 0 ? (c - 8) * 32 : (SEQ - 32 - (c - 8) * 32); }
}
template <int MIX>
__device__ __forceinline__ void fetch_raw(const u16* P, int c, int dir, int b, int h, int pw, int lane, const int (&colv)[4], unsigned (&rawq)[14][2]) {
  int seg_row0, seg_len, t_lo;
  chunk_geom(c, dir, b, seg_row0, seg_len, t_lo);
  const u16* Pseg = P + (size_t)seg_row0 * PST;
  const int t0 = t_lo + pw * 8;
  if (MIX == 0) {
#pragma unroll
    for (int rr = 0; rr < 10; rr++) {
      const int tc = min(max(t0 - 1 + rr, 0), seg_len - 1);
#pragma unroll
      for (int i = 0; i < 2; i++)
        rawq[rr][i] = (unsigned)Pseg[(size_t)tc * PST + PA + colv[2 * i]] | ((unsigned)Pseg[(size_t)tc * PST + PA + colv[2 * i + 1]] << 16);
    }
  } else if (MIX == 1) {
#pragma unroll
    for (int rr = 0; rr < 14; rr++) {
      const int tc = min(max(t0 - 3 + rr, 0), seg_len - 1);
      rawq[rr][0] = (unsigned)Pseg[(size_t)tc * PST + colv[0]] | ((unsigned)Pseg[(size_t)tc * PST + colv[1]] << 16);
      rawq[rr][1] = (rawq[rr][1] & 0xffff0000u) | (unsigned)Pseg[(size_t)tc * PST + colv[2]];
    }
    const u16* pp = Pseg + (size_t)(t0 + (lane & 7)) * PST + PB;
    rawq[0][1] = (rawq[0][1] & 0xffffu) | ((unsigned)pp[768 + dir * 4 + h] << 16);
    rawq[1][1] = (rawq[1][1] & 0xffffu) | ((unsigned)pp[776 + dir * 4 + h] << 16);
  } else {
#pragma unroll
    for (int j = 0; j < 8; j++) {
      const u16* pp = Pseg + (size_t)(t0 + j) * PST;
      rawq[j][0] = (unsigned)pp[colv[0]] | ((unsigned)pp[colv[1]] << 16);
      rawq[j][1] = (unsigned)pp[colv[2]];
    }
  }
}

template <int MIX>
__device__ __forceinline__ void scan3_item(const Params& p, int l, int b, int h, int dir, unsigned char* smb) {
  constexpr int VOFF = (MIX == 2) ? 64 : 128;
  constexpr bool DELTA = (MIX != 2);
  const int tid = TIDX, lane = tid & 63, w = tid >> 6, fr = lane & 15, fq = lane >> 4;
  const bool producer = true;
  const int pw = w & 3, half = w >> 2;
  const u16* P = (const u16*)(p.ws + OFF_BIG);
  u16* YS = (u16*)(p.ws + OFF_YS);
  float* BC = (float*)(p.ws + OFF_BC);
  float* ST = (float*)(smb + w * S3_SUB + S3_GM);
  unsigned char* STBY = smb + w * S3_SUB + S3_GM;
  const f32x4 z4 = f32x4{0.f, 0.f, 0.f, 0.f};
  f32x4 st[4];
#pragma unroll
  for (int i = 0; i < 4; i++) st[i] = z4;

  bf16x8 bw2[4], ba2[4];
  float cw[3][7];
  float muv[4];
  int colv[4];
  float c_w0 = 0.f, c_a0 = 0.f, c_ka = 0.f, c_kk = 0.f, c_rk = 0.f, c_gb = 0.f;
#pragma unroll
  for (int i = 0; i < 4; i++) { bw2[i] = zfrag(); ba2[i] = zfrag(); muv[i] = 0.f; colv[i] = 0; }
  if (producer) {
    if (MIX == 0) {
#pragma unroll
      for (int nt = 0; nt < 4; nt++) {
        const int jch = h * 64 + nt * 16 + fr;
#pragma unroll
        for (int jj = 0; jj < 8; jj++) {
          bw2[nt][jj] = (short)f2bf(p.rwkv_w2[((size_t)(l * 2 + dir) * 32 + fq * 8 + jj) * 256 + jch]);
          ba2[nt][jj] = (short)f2bf(p.rwkv_a2[((size_t)(l * 2 + dir) * 32 + fq * 8 + jj) * 256 + jch]);
        }
      }
      const int jl = h * 64 + lane;
      c_w0 = p.rwkv_w0[(l * 2 + dir) * 256 + jl];
      c_a0 = p.rwkv_a0[(l * 2 + dir) * 256 + jl];
      c_ka = p.rwkv_ka[l * 256 + jl];
      c_kk = p.rwkv_kk[l * 256 + jl];
      c_rk = p.rwkv_rk[l * 256 + jl];
#pragma unroll
      for (int i = 0; i < 4; i++) {
        colv[i] = i < 3 ? i * 256 + h * 64 + lane : (lane < 32 ? 768 + dir * 32 + lane : 832 + dir * 32 + (lane - 32));
        muv[i] = p.rwkv_mu[l * 960 + colv[i]];
      }
    } else if (MIX == 1) {
#pragma unroll
      for (int i = 0; i < 3; i++) {
        colv[i] = PB + i * 256 + h * 64 + lane;
#pragma unroll
        for (int tp = 0; tp < 7; tp++) cw[i][tp] = p.gdn_conv[((size_t)l * 7 + tp) * 768 + i * 256 + h * 64 + lane];
      }
    } else {
#pragma unroll
      for (int nt = 0; nt < 2; nt++) {
#pragma unroll
        for (int jj = 0; jj < 8; jj++)
          bw2[nt][jj] = fq < 2 ? (short)f2bf(p.gla_gw2[((size_t)(l * 2 + dir) * 16 + fq * 8 + jj) * 128 + h * 32 + nt * 16 + fr]) : (short)0;
      }
      c_gb = p.gla_gb[(l * 2 + dir) * 128 + h * 32 + (lane & 31)];
      colv[0] = PC + h * 32 + lane;
      if (lane >= 32) colv[0] = PC + 128 + h * 32 + (lane - 32);
      colv[1] = PC + 256 + h * 64 + lane;
      colv[2] = PC + 512 + dir * 16 + (lane & 15);
    }
  }
  __syncthreads();
  unsigned rawq[14][2];
#pragma unroll
  for (int i = 0; i < 14; i++) { rawq[i][0] = 0u; rawq[i][1] = 0u; }
  fetch_raw<MIX>(P, half, dir, b, h, pw, lane, colv, rawq);
#define RAWP(r_, i_) ((u16)((rawq[r_][(i_) >> 1] >> (((i_) & 1) * 16)) & 0xffffu))

  for (int it = 0; it < TPB / 64; it++) {
    {
      {
        const int c = it * 2 + half;
        int seg_row0, seg_len, t_lo;
        chunk_geom(c, dir, b, seg_row0, seg_len, t_lo);
        unsigned char* SB = smb + w * S3_SUB;
        const int t0 = t_lo + pw * 8;
        if (MIX == 0) {
          float raw[10][4];
#pragma unroll
          for (int rr = 0; rr < 10; rr++) {
            const int t = t0 - 1 + rr;
            const float okf = (t >= 0 && t < seg_len) ? 1.f : 0.f;
#pragma unroll
            for (int i = 0; i < 4; i++) raw[rr][i] = bf2f(RAWP(rr, i)) * okf;
          }
#pragma unroll
          for (int j = 0; j < 8; j++)
#pragma unroll
            for (int i = 0; i < 4; i++) {
              float xm = raw[j + 1][i] + (0.5f * (raw[j][i] + raw[j + 2][i]) - raw[j + 1][i]) * muv[i];
              if (i == 3 && lane < 32) xm = tanh_fast(xm);
              ST[j * 256 + lane + 64 * i] = xm;
            }
        } else if (MIX == 1) {
          float raw[14][3];
#pragma unroll
          for (int rr = 0; rr < 14; rr++) {
            const int t = t0 - 3 + rr;
            const float okf = (t >= 0 && t < seg_len) ? 1.f : 0.f;
#pragma unroll
            for (int i = 0; i < 3; i++) raw[rr][i] = bf2f(RAWP(rr, i)) * okf;
          }
#pragma unroll
          for (int j = 0; j < 8; j++)
#pragma unroll
            for (int i = 0; i < 3; i++) {
              float a = 0.f;
#pragma unroll
              for (int tp = 0; tp < 7; tp++) a += raw[j + tp][i] * cw[i][tp];
              ST[j * 256 + lane + 64 * i] = siluf(a);
            }
          if (lane < 8) {
            float bx = bf2f(RAWP(0, 3));
            float ax = bf2f(RAWP(1, 3));
            float ld = -__expf(p.gdn_a_log[(l * 2 + dir) * 4 + h]) * softplusf(ax + p.gdn_dt_bias[(l * 2 + dir) * 4 + h]);
            ST[lane * 256 + 192] = sigm(bx);
            ST[lane * 256 + 193] = ld;
          }
        } else {
          const float qs = lane < 32 ? 0.17677669529663687f : 1.f;
#pragma unroll
          for (int j = 0; j < 8; j++) {
            ST[j * 256 + lane] = bf2f(RAWP(j, 0)) * qs;
            ST[j * 256 + 64 + lane] = bf2f(RAWP(j, 1));
            if (lane < 16) ST[j * 256 + 128 + lane] = bf2f(RAWP(j, 2));
          }
        }
        wave_lds_sync();
        {
          float vv[8];
#pragma unroll
          for (int i = 0; i < 8; i++) vv[i] = ST[(dir ? 7 - i : i) * 256 + VOFF + lane];
          *(uint4*)(SB + S3_VT + lane * 16) = pack8(vv);
        }
        if (MIX == 0) {
          bf16x8 aw, aa;
#pragma unroll
          for (int jj = 0; jj < 8; jj++) {
            aw[jj] = fr < 8 ? (short)f2bf(ST[fr * 256 + 192 + fq * 8 + jj]) : (short)0;
            aa[jj] = fr < 8 ? (short)f2bf(ST[fr * 256 + 224 + fq * 8 + jj]) : (short)0;
          }
          f32x4 accw[4], acca[4];
#pragma unroll
          for (int nt = 0; nt < 4; nt++) {
            accw[nt] = __builtin_amdgcn_mfma_f32_16x16x32_bf16(aw, bw2[nt], z4, 0, 0, 0);
            acca[nt] = __builtin_amdgcn_mfma_f32_16x16x32_bf16(aa, ba2[nt], z4, 0, 0, 0);
          }
          wave_lds_sync();
          if (fq < 2) {
#pragma unroll
            for (int nt = 0; nt < 4; nt++)
#pragma unroll
              for (int r = 0; r < 4; r++) {
                ST[(fq * 4 + r) * 256 + 128 + nt * 16 + fr] = accw[nt][r];
                ST[(fq * 4 + r) * 256 + 192 + nt * 16 + fr] = acca[nt][r];
              }
          }
          wave_lds_sync();
        } else if (MIX == 2) {
          bf16x8 ag;
#pragma unroll
          for (int jj = 0; jj < 8; jj++) ag[jj] = (fr < 8 && fq < 2) ? (short)f2bf(ST[fr * 256 + 128 + fq * 8 + jj]) : (short)0;
          f32x4 accg[2];
#pragma unroll
          for (int nt = 0; nt < 2; nt++) accg[nt] = __builtin_amdgcn_mfma_f32_16x16x32_bf16(ag, bw2[nt], z4, 0, 0, 0);
          if (fq < 2) {
#pragma unroll
            for (int nt = 0; nt < 2; nt++)
#pragma unroll
              for (int r = 0; r < 4; r++) ST[(fq * 4 + r) * 256 + 192 + nt * 16 + fr] = accg[nt][r];
          }
          wave_lds_sync();
        }
        float logd[8], kap[8], bb[8], kp[8], qq[8];
        if (MIX == 0) {
          float a8[8], p1[8], p2[8];
#pragma unroll
          for (int i = 0; i < 8; i++) {
            const float* row = ST + (dir ? 7 - i : i) * 256;
            const float r_ = row[lane], k_ = row[64 + lane];
            const float sg = sigm(c_w0 + row[128 + lane]);
            a8[i] = sigm(c_a0 + row[192 + lane]);
            kp[i] = k_ * (1.f + (a8[i] - 1.f) * c_ka);
            kap[i] = k_ * c_kk;
            qq[i] = r_;
            logd[i] = -0.6065306597126334f * sg;
            p1[i] = kap[i] * kap[i];
            p2[i] = r_ * kp[i] * c_rk;
          }
#pragma unroll
          for (int i = 0; i < 8; i++) { p1[i] = red16(p1[i]); p2[i] = red16(p2[i]); }
#pragma unroll
          for (int i = 0; i < 8; i++) {
            const float ss = (rlane(p1[i], 0) + rlane(p1[i], 16)) + (rlane(p1[i], 32) + rlane(p1[i], 48));
            const float bc = (rlane(p2[i], 0) + rlane(p2[i], 16)) + (rlane(p2[i], 32) + rlane(p2[i], 48));
            kap[i] *= rsq(ss + 1e-6f);
            bb[i] = kap[i] * a8[i];
            if (lane == 0) BC[(size_t)(seg_row0 + t0 + (dir ? 7 - i : i)) * 8 + h * 2 + dir] = bc;
          }
        } else {
#pragma unroll
        for (int i = 0; i < 8; i++) {
          const int j = dir ? 7 - i : i;
          const float* row = ST + j * 256;
          if (MIX == 1) {
            const float q_ = row[lane], k_ = row[64 + lane];
            const float sq = wave_sum(q_ * q_), sk = wave_sum(k_ * k_);
            const float qn = q_ * rsq(sq + 1e-6f) * 0.125f, kn = k_ * rsq(sk + 1e-6f);
            const float beta = row[192], ld = row[193];
            const float alpha = __expf(ld);
            logd[i] = ld;
            kap[i] = kn; bb[i] = alpha * beta * kn; kp[i] = beta * kn; qq[i] = qn;
          } else {
            const int n = lane & 31;
            const float lg = c_gb + row[192 + n];
            const float ls = fminf(lg, 0.f) - __logf(1.f + __expf(-fabsf(lg)));
            logd[i] = ls * (1.f / 16.f);
            kap[i] = 0.f; bb[i] = 0.f;
            kp[i] = lane < 32 ? row[32 + n] : 0.f;
            qq[i] = lane < 32 ? row[n] : 0.f;
          }
        }
        }
        wave_lds_sync();
        float kt[8], qt[8], bck[8], kck[8];
        {
          float L[8];
          float run = 0.f;
#pragma unroll
          for (int i = 0; i < 8; i++) { run += logd[i]; L[i] = run; }
          const float Lr = L[3], L7 = L[7];
          float prevE = __expf(clampe(-Lr)), prevT = 1.f;
          u16* OPA = (u16*)STBY;
#pragma unroll
          for (int i = 0; i < 8; i++) {
            const float eI = __expf(clampe(L[i] - Lr)), eInv = __expf(clampe(Lr - L[i]));
            const float tI = __expf(L[i]), eEnd = __expf(L7 - L[i]);
            if (DELTA) {
              OPA[0 * 576 + i * 72 + lane] = f2bf(kap[i] * prevE);
              OPA[1 * 576 + i * 72 + lane] = f2bf(bb[i] * eInv);
            }
            OPA[2 * 576 + i * 72 + lane] = f2bf(kp[i] * eInv);
            OPA[3 * 576 + i * 72 + lane] = f2bf(qq[i] * eI);
            kt[i] = kap[i] * prevT; qt[i] = qq[i] * tI;
            bck[i] = bb[i] * eEnd; kck[i] = kp[i] * eEnd;
            prevE = eI; prevT = tI;
          }
          *(float*)(SB + S3_WC + lane * 4) = __expf(L7);
        }
        wave_lds_sync();
        f32x4 accA = z4, accBm = z4, accQb = z4, accQk = z4;
        {
          const u16* OPA = (const u16*)STBY;
          const int ro = (fr & 7) * 72 + fq * 8;
#pragma unroll
          for (int ks = 0; ks < 2; ks++) {
            const bf16x8 fk = ld_frag(OPA + 2 * 576 + ro + ks * 32), fqh = ld_frag(OPA + 3 * 576 + ro + ks * 32);
            accQk = __builtin_amdgcn_mfma_f32_16x16x32_bf16(fqh, fk, accQk, 0, 0, 0);
            if (DELTA) {
              const bf16x8 fka = ld_frag(OPA + 0 * 576 + ro + ks * 32), fb = ld_frag(OPA + 1 * 576 + ro + ks * 32);
              accA = __builtin_amdgcn_mfma_f32_16x16x32_bf16(fka, fb, accA, 0, 0, 0);
              accBm = __builtin_amdgcn_mfma_f32_16x16x32_bf16(fka, fk, accBm, 0, 0, 0);
              accQb = __builtin_amdgcn_mfma_f32_16x16x32_bf16(fqh, fb, accQb, 0, 0, 0);
            }
          }
#pragma unroll
          for (int r = 0; r < 4; r++) {
            const int i = fq * 4 + r;
            const bool ok = fq < 2 && fr < 8;
            if (!(ok && fr < i)) { accA[r] = 0.f; accBm[r] = 0.f; }
            if (!(ok && fr <= i)) { accQb[r] = 0.f; accQk[r] = 0.f; }
          }
        }
        float bmc[8], qkc[8];
#pragma unroll
        for (int m = 0; m < 4; m++) {
          bmc[m] = accBm[m]; qkc[m] = accQk[m];
          bmc[m + 4] = __shfl(accBm[m], (lane & 15) + 16);
          qkc[m + 4] = __shfl(accQk[m], (lane & 15) + 16);
        }
        float kbar[8], qbar[8], Kv[8], TB[8], Qv[8];
        if (DELTA) {
          float t[8];
#pragma unroll
          for (int i = 0; i < 8; i++) {
            float ti = (lane == i) ? 1.f : 0.f;
#pragma unroll
            for (int m = 0; m < i; m++) ti -= rlane(accA[i & 3], (i >> 2) * 16 + m) * t[m];
            t[i] = ti;
          }
#pragma unroll
          for (int i = 0; i < 8; i++) {
            float tb = 0.f, kb = 0.f;
#pragma unroll
            for (int m = 0; m <= i; m++) {
              const float tim = rlane(t[i], m);
              tb += tim * bmc[m];
              kb += tim * kt[m];
            }
            TB[i] = tb; kbar[i] = kb;
            float qv = qkc[i], qb = qt[i];
#pragma unroll
            for (int m = 0; m <= i; m++) {
              const float qbim = rlane(accQb[i & 3], (i >> 2) * 16 + m);
              qv -= qbim * TB[m];
              qb -= qbim * kbar[m];
            }
            Qv[i] = qv; qbar[i] = qb;
          }
#pragma unroll
          for (int j = 0; j < 8; j++) Kv[j] = kck[j];
#pragma unroll
          for (int i = 1; i < 8; i++)
#pragma unroll
            for (int j = 0; j < i; j++) Kv[j] -= rlane(TB[i], j) * bck[i];
        } else {
#pragma unroll
          for (int i = 0; i < 8; i++) { Qv[i] = qkc[i]; qbar[i] = qt[i]; Kv[i] = kck[i]; kbar[i] = 0.f; TB[i] = 0.f; }
        }
        *(uint4*)(SB + S3_KVT + lane * 16) = pack8(Kv);
#pragma unroll
        for (int i = 0; i < 8; i++) ((u16*)(SB + S3_QB))[i * 72 + lane] = f2bf(qbar[i]);
        if (lane < 8) {
#pragma unroll
          for (int i = 0; i < 8; i++) ((u16*)(SB + S3_QV))[i * 8 + lane] = f2bf(Qv[i]);
        }
        if (DELTA) {
          float nk[8];
#pragma unroll
          for (int i = 0; i < 8; i++) nk[i] = -kbar[i];
          *(uint4*)(STBY + 4608 + lane * 16) = pack8(bck);
          *(uint4*)(STBY + 5632 + lane * 16) = pack8(nk);
          wave_lds_sync();
          bf16x8 fa[4], fb[4];
#pragma unroll
          for (int x = 0; x < 4; x++) {
            fa[x] = fq == 0 ? ld_frag(STBY + 5632 + (x * 16 + fr) * 16) : zfrag();
            fb[x] = fq == 0 ? ld_frag(STBY + 4608 + (x * 16 + fr) * 16) : zfrag();
          }
#pragma unroll
          for (int nt = 0; nt < 4; nt++)
#pragma unroll
            for (int mt = 0; mt < 4; mt++) {
              const f32x4 g = __builtin_amdgcn_mfma_f32_16x16x32_bf16(fa[mt], fb[nt], z4, 0, 0, 0);
              uint2 gv;
              gv.x = pack2(g[0], g[1]); gv.y = pack2(g[2], g[3]);
              *(uint2*)(SB + S3_GM + ((nt * 16 + fr) * 72 + mt * 16 + fq * 4) * 2) = gv;
            }
        }
      }
    }
    fetch_raw<MIX>(P, min(it + 1, TPB / 64 - 1) * 2 + half, dir, b, h, pw, lane, colv, rawq);
    __syncthreads();
    if (w < 4) {
      unsigned char* STB = smb + S3_STB + w * 2304;
#pragma unroll 2
      for (int kk = 0; kk < 8; kk++) {
        const int cc = it * 2 + (kk >> 2), k = kk & 3;
        int seg_row0, t_lo;
        if (cc < 8) { seg_row0 = b * TPB; t_lo = dir == 0 ? cc * 32 : (LC - 32 - cc * 32); }
        else { seg_row0 = b * TPB + LC; t_lo = dir == 0 ? (cc - 8) * 32 : (SEQ - 32 - (cc - 8) * 32); }
        const int sc = dir ? 3 - k : k;
        const unsigned char* SB = smb + ((kk >> 2) * 4 + sc) * S3_SUB;
#pragma unroll
        for (int nt = 0; nt < 4; nt++) {
          uint2 sv;
          sv.x = pack2(st[nt][0], st[nt][1]); sv.y = pack2(st[nt][2], st[nt][3]);
          *(uint2*)(STB + (fr * 72 + nt * 16 + fq * 4) * 2) = sv;
        }
        wave_lds_sync();
        const bf16x8 bs0 = ld_frag(STB + (fr * 72 + fq * 8) * 2), bs1 = ld_frag(STB + (fr * 72 + 32 + fq * 8) * 2);
        const bf16x8 bv = fq == 0 ? ld_frag(SB + S3_VT + (w * 16 + fr) * 16) : zfrag();
        const bf16x8 aq0 = ld_frag(SB + S3_QB + ((fr & 7) * 72 + fq * 8) * 2), aq1 = ld_frag(SB + S3_QB + ((fr & 7) * 72 + 32 + fq * 8) * 2);
        const bf16x8 aqv = fq == 0 ? ld_frag(SB + S3_QV + (fr & 7) * 16) : zfrag();
        f32x4 accY = __builtin_amdgcn_mfma_f32_16x16x32_bf16(aq0, bs0, z4, 0, 0, 0);
        accY = __builtin_amdgcn_mfma_f32_16x16x32_bf16(aq1, bs1, accY, 0, 0, 0);
        accY = __builtin_amdgcn_mfma_f32_16x16x32_bf16(aqv, bv, accY, 0, 0, 0);
        if (fq < 2) {
#pragma unroll
          for (int r = 0; r < 4; r++) {
            const int i = fq * 4 + r, j = dir ? 7 - i : i;
            YS[(size_t)(seg_row0 + t_lo + sc * 8 + j) * YST + dir * 768 + MIX * 256 + h * 64 + w * 16 + fr] = f2bf(accY[r]);
          }
        }
#pragma unroll
        for (int nt = 0; nt < 4; nt++) {
          f32x4 an = z4;
          if (DELTA) {
            const bf16x8 g0 = ld_frag(SB + S3_GM + ((nt * 16 + fr) * 72 + fq * 8) * 2), g1 = ld_frag(SB + S3_GM + ((nt * 16 + fr) * 72 + 32 + fq * 8) * 2);
            an = __builtin_amdgcn_mfma_f32_16x16x32_bf16(g0, bs0, an, 0, 0, 0);
            an = __builtin_amdgcn_mfma_f32_16x16x32_bf16(g1, bs1, an, 0, 0, 0);
          }
          const bf16x8 akv = fq == 0 ? ld_frag(SB + S3_KVT + (nt * 16 + fr) * 16) : zfrag();
          an = __builtin_amdgcn_mfma_f32_16x16x32_bf16(akv, bv, an, 0, 0, 0);
          const float4 wc = *(const float4*)(SB + S3_WC + (nt * 16 + fq * 4) * 4);
          st[nt][0] = st[nt][0] * wc.x + an[0];
          st[nt][1] = st[nt][1] * wc.y + an[1];
          st[nt][2] = st[nt][2] * wc.z + an[2];
          st[nt][3] = st[nt][3] * wc.w + an[3];
        }
      }
    }
    __syncthreads();
  }
}

__device__ __forceinline__ void attn_item(const Params& p, int l, int b, int qb, int hk, bool isctx, unsigned char* smem) {
  u16* KS = (u16*)smem;
  u16* VT = KS + 64 * LDT;
  u16* PL = VT + 64 * LDT;
  float2* ROPE = (float2*)(PL + 8 * 32 * LDT);
  const int tid = TIDX, lane = tid & 63, w = tid >> 6, fr = lane & 15, fq = lane >> 4;
  const u16* P = (const u16*)(p.ws + OFF_BIG);
  u16* Y = (u16*)(p.ws + OFF_YS);
  const int qh = hk * 2 + (w >> 2);
  const int tb = qb * 128 + (w & 3) * 32;
  const int qrow0 = b * TPB + (isctx ? 0 : LC);
  __syncthreads();
  for (int i = tid; i < 1024; i += NTHR) {
    int pos = i >> 4, fi = i & 15;
    float inv = powf(10000.f, -(float)fi / 16.f);
    float sn, cs;
    sincosf((float)pos * inv, &sn, &cs);
    ROPE[i] = make_float2(cs, sn);
  }
  __syncthreads();
  bf16x8 qf[2][2];
#pragma unroll
  for (int mi = 0; mi < 2; mi++)
#pragma unroll
    for (int ks = 0; ks < 2; ks++) {
      const int tq = tb + mi * 16 + fr;
      const u16* qp = P + (size_t)(qrow0 + tq) * PST + PD + qh * 64 + ks * 32;
      uint4 own = *(const uint4*)(qp + fq * 8);
      uint4 par = *(const uint4*)(qp + (fq ^ 2) * 8);
      const unsigned ow[4] = {own.x, own.y, own.z, own.w};
      const unsigned pw[4] = {par.x, par.y, par.z, par.w};
      const int pos = ks == 0 ? (tq >> 6) : (tq & 63);
      bf16x8 f;
#pragma unroll
      for (int jj = 0; jj < 8; jj++) {
        float xo = bf2f((u16)((ow[jj >> 1] >> ((jj & 1) * 16)) & 0xffff));
        float xp = bf2f((u16)((pw[jj >> 1] >> ((jj & 1) * 16)) & 0xffff));
        float v = xo;
        if (!isctx) {
          float2 cs = ROPE[pos * 16 + (fq & 1) * 8 + jj];
          v = fq < 2 ? xo * cs.x - xp * cs.y : xp * cs.y + xo * cs.x;
        }
        f[jj] = (short)f2bf(v * 0.125f);
      }
      qf[mi][ks] = f;
    }
  f32x4 oacc[2][4];
#pragma unroll
  for (int mi = 0; mi < 2; mi++)
#pragma unroll
    for (int nd = 0; nd < 4; nd++) oacc[mi][nd] = f32x4{0.f, 0.f, 0.f, 0.f};
  float mrow[2][4], lrow[2][4];
#pragma unroll
  for (int mi = 0; mi < 2; mi++)
#pragma unroll
    for (int r = 0; r < 4; r++) { mrow[mi][r] = -1e30f; lrow[mi][r] = 0.f; }

  const int q0 = qb * 128;
  const int band_lo = isctx ? 0 : max(0, q0 - 128), band_hi = isctx ? 0 : min(SEQ, q0 + 256);
  const int ntile = 4 + (band_hi - band_lo) / 64;
  u16* pl = PL + w * 32 * LDT;
  for (int tl = 0; tl < ntile; tl++) {
    const bool band = tl >= 4;
    const int k0 = band ? band_lo + (tl - 4) * 64 : tl * 64;
    __syncthreads();
    {
      const int key = tid >> 3, kc = tid & 7;
      const int kpos = k0 + key;
      const u16* kp = P + (size_t)(b * TPB + (band ? LC : 0) + kpos) * PST + PD + 256 + hk * 64;
      uint4 own = *(const uint4*)(kp + kc * 8);
      uint4 vv = *(const uint4*)(kp + 128 + kc * 8);
      uint4 par = *(const uint4*)(kp + (kc ^ 2) * 8);
      if (band) {
        const unsigned ow[4] = {own.x, own.y, own.z, own.w};
        const unsigned pw[4] = {par.x, par.y, par.z, par.w};
        const int pos = kc < 4 ? (kpos >> 6) : (kpos & 63);
        unsigned res[4];
#pragma unroll
        for (int jj = 0; jj < 8; jj += 2) {
          float v2[2];
#pragma unroll
          for (int e = 0; e < 2; e++) {
            float xo = bf2f((u16)((ow[jj >> 1] >> (e * 16)) & 0xffff));
            float xp = bf2f((u16)((pw[jj >> 1] >> (e * 16)) & 0xffff));
            float2 cs = ROPE[pos * 16 + (kc & 1) * 8 + jj + e];
            v2[e] = (kc & 2) == 0 ? xo * cs.x - xp * cs.y : xp * cs.y + xo * cs.x;
          }
          res[jj >> 1] = pack2(v2[0], v2[1]);
        }
        own = make_uint4(res[0], res[1], res[2], res[3]);
      }
      *(uint4*)(KS + key * LDT + kc * 8) = own;
      const unsigned vw[4] = {vv.x, vv.y, vv.z, vv.w};
#pragma unroll
      for (int jj = 0; jj < 8; jj++) VT[(kc * 8 + jj) * LDT + key] = (u16)((vw[jj >> 1] >> ((jj & 1) * 16)) & 0xffff);
    }
    __syncthreads();
    f32x4 sc[2][4];
#pragma unroll
    for (int mi = 0; mi < 2; mi++)
#pragma unroll
      for (int nj = 0; nj < 4; nj++) sc[mi][nj] = f32x4{0.f, 0.f, 0.f, 0.f};
#pragma unroll
    for (int ks = 0; ks < 2; ks++) {
      bf16x8 kf[4];
#pragma unroll
      for (int nj = 0; nj < 4; nj++) kf[nj] = *(const bf16x8*)(KS + (nj * 16 + fr) * LDT + ks * 32 + fq * 8);
#pragma unroll
      for (int mi = 0; mi < 2; mi++)
#pragma unroll
        for (int nj = 0; nj < 4; nj++) sc[mi][nj] = __builtin_amdgcn_mfma_f32_16x16x32_bf16(qf[mi][ks], kf[nj], sc[mi][nj], 0, 0, 0);
    }
#pragma unroll
    for (int mi = 0; mi < 2; mi++)
#pragma unroll
      for (int r = 0; r < 4; r++) {
        const int qpos = tb + mi * 16 + fq * 4 + r;
        float mx = -1e30f;
#pragma unroll
        for (int nj = 0; nj < 4; nj++) {
          float v = sc[mi][nj][r];
          if (band) {
            int d = qpos - (k0 + nj * 16 + fr);
            if (d > 128 || d < -128) v = -1e30f;
          }
          sc[mi][nj][r] = v;
          mx = fmaxf(mx, v);
        }
        mx = fmaxf(mx, __shfl_xor(mx, 1));
        mx = fmaxf(mx, __shfl_xor(mx, 2));
        mx = fmaxf(mx, __shfl_xor(mx, 4));
        mx = fmaxf(mx, __shfl_xor(mx, 8));
        const float mnew = fmaxf(mrow[mi][r], mx);
        const float alpha = __expf(mrow[mi][r] - mnew);
        mrow[mi][r] = mnew;
        float ls = 0.f;
#pragma unroll
        for (int nj = 0; nj < 4; nj++) {
          float pe = __expf(sc[mi][nj][r] - mnew);
          ls += pe;
          pl[(mi * 16 + fq * 4 + r) * LDT + nj * 16 + fr] = f2bf(pe);
        }
        lrow[mi][r] = lrow[mi][r] * alpha + ls;
#pragma unroll
        for (int nd = 0; nd < 4; nd++) oacc[mi][nd][r] *= alpha;
      }
    asm volatile("s_waitcnt lgkmcnt(0)" ::: "memory");
    __builtin_amdgcn_wave_barrier();
#pragma unroll
    for (int ks = 0; ks < 2; ks++) {
      bf16x8 pf[2], vf[4];
#pragma unroll
      for (int mi = 0; mi < 2; mi++) pf[mi] = *(const bf16x8*)(pl + (mi * 16 + fr) * LDT + ks * 32 + fq * 8);
#pragma unroll
      for (int nd = 0; nd < 4; nd++) vf[nd] = *(const bf16x8*)(VT + (nd * 16 + fr) * LDT + ks * 32 + fq * 8);
#pragma unroll
      for (int mi = 0; mi < 2; mi++)
#pragma unroll
        for (int nd = 0; nd < 4; nd++) oacc[mi][nd] = __builtin_amdgcn_mfma_f32_16x16x32_bf16(pf[mi], vf[nd], oacc[mi][nd], 0, 0, 0);
    }
    asm volatile("s_waitcnt lgkmcnt(0)" ::: "memory");
    __builtin_amdgcn_wave_barrier();
  }
  const float sink = p.attn_sink[l * 4 + qh];
#pragma unroll
  for (int mi = 0; mi < 2; mi++)
#pragma unroll
    for (int r = 0; r < 4; r++) {
      float ls = lrow[mi][r];
      ls += __shfl_xor(ls, 1);
      ls += __shfl_xor(ls, 2);
      ls += __shfl_xor(ls, 4);
      ls += __shfl_xor(ls, 8);
      ls += __expf(sink - mrow[mi][r]);
      const float inv = 1.f / ls;
      const int tq = tb + mi * 16 + fq * 4 + r;
#pragma unroll
      for (int nd = 0; nd < 4; nd++) Y[(size_t)(qrow0 + tq) * YST + 1536 + qh * 64 + nd * 16 + fr] = f2bf(oacc[mi][nd][r] * inv);
    }
}

#ifndef SCAN3_MASK
#define SCAN3_MASK 7
#endif
__device__ __forceinline__ void phase_mix(const Params& p, int l, unsigned char* smem) {
  float* sm = (float*)smem;
  const int G = gridDim.x;
  for (int it = blockIdx.x; it < 192; it += G) {
    const int mix = it >> 6, rem = it & 63, b = rem >> 3, h = (rem >> 1) & 3, dir = rem & 1;
    if (mix == 0 && (SCAN3_MASK & 1)) scan3_item<0>(p, l, b, h, dir, smem);
    else if (mix == 1 && (SCAN3_MASK & 2)) scan3_item<1>(p, l, b, h, dir, smem);
    else if (mix == 2 && (SCAN3_MASK & 4)) scan3_item<2>(p, l, b, h, dir, smem);
  }
  if (SCAN3_MASK != 7) {
    for (int it = blockIdx.x; it < 768; it += G) {
      const int mix = it >> 8, rem = it & 255, b = rem >> 5, h = (rem >> 3) & 3, dir = (rem >> 2) & 1, rq = rem & 3;
      if (mix == 0 && !(SCAN3_MASK & 1)) scan2_item<0>(p, l, b, h, dir, rq, sm);
      else if (mix == 1 && !(SCAN3_MASK & 2)) scan2_item<1>(p, l, b, h, dir, rq, sm);
      else if (mix == 2 && !(SCAN3_MASK & 4)) scan2_item<2>(p, l, b, h, dir, rq, sm);
    }
  }
  __syncthreads();
  unsigned* ctr = (unsigned*)(p.ws + OFF_CTR) + l * 16;
  volatile int* slot = (volatile int*)(smem + 131072 - 16);
  for (;;) {
    if (TIDX == 0) *slot = (int)atomicAdd(ctr, 1u);
    __syncthreads();
    const int it = *slot;
    __syncthreads();
    if (it >= 544) break;
    if (it < 512) {
      int b = it >> 6, qb = (it >> 1) & 31, hk = it & 1;
      attn_item(p, l, b, qb, hk, false, smem);
    } else {
      int r = it - 512, b = r >> 2, qb = (r >> 1) & 1, hk = r & 1;
      attn_item(p, l, b, qb, hk, true, smem);
    }
  }
}

#define POST_DECL(PFX) uint2 PFX##ya0, PFX##ya1, PFX##ya2, PFX##yc0, PFX##yc1, PFX##yc2, PFX##vp, PFX##vc, PFX##vn, PFX##gb, PFX##gc; \
  u16 PFX##xp, PFX##xc, PFX##xn; float2 PFX##bc
#define POST_LOAD(PFX, R_)                                                                         \
  do {                                                                                             \
    const int r_ = (R_);                                                                           \
    const int b_ = r_ / TPB, t_ = r_ - b_ * TPB;                                                   \
    const bool hp_ = (t_ != 0) && (t_ != LC), hn_ = (t_ != LC - 1) && (t_ != TPB - 1);            \
    const u16* ys_ = YSc + (size_t)r_ * YST;                                                       \
    const u16* pr_ = Pc + (size_t)r_ * PST;                                                        \
    const u16* pp_ = pr_ - (hp_ ? PST : 0);                                                        \
    const u16* pn_ = pr_ + (hn_ ? PST : 0);                                                        \
    PFX##ya0 = *(const uint2*)(ys_ + j0); PFX##ya1 = *(const uint2*)(ys_ + 256 + j0); PFX##ya2 = *(const uint2*)(ys_ + 512 + j0); \
    PFX##yc0 = *(const uint2*)(ys_ + 768 + j0); PFX##yc1 = *(const uint2*)(ys_ + 1024 + j0); PFX##yc2 = *(const uint2*)(ys_ + 1280 + j0); \
    PFX##vp = *(const uint2*)(pp_ + PA + 512 + j0);                                                \
    PFX##vc = *(const uint2*)(pr_ + PA + 512 + j0);                                                \
    PFX##vn = *(const uint2*)(pn_ + PA + 512 + j0);                                                \
    PFX##gb = *(const uint2*)(pr_ + PB + 784 + j0);                                                \
    PFX##gc = *(const uint2*)(pr_ + PC + 544 + j0);                                                \
    PFX##xp = pp_[PA + 896 + lane]; PFX##xc = pr_[PA + 896 + lane]; PFX##xn = pn_[PA + 896 + lane]; \
    PFX##bc = *(const float2*)(BCc + (size_t)r_ * 8 + (lane >> 4) * 2);                            \
  } while (0)
__device__ __forceinline__ void unpack4(uint2 v, float (&o)[4]) {
  o[0] = __uint_as_float(v.x << 16); o[1] = __uint_as_float(v.x & 0xffff0000u);
  o[2] = __uint_as_float(v.y << 16); o[3] = __uint_as_float(v.y & 0xffff0000u);
}

__device__ __forceinline__ void phase_post(const Params& p, int l, float* g2s) {
  const int lane = TIDX & 63, wv = TIDX >> 6;
  u16* YS = (u16*)(p.ws + OFF_YS);
  const int j0 = lane * 4;
  {
    const float4* src = (const float4*)(p.rwkv_g2 + (size_t)l * 64 * 256);
    for (int i = TIDX; i < 64 * 256 / 4; i += NTHR) ((float4*)g2s)[i] = src[i];
  }
  float mu_v[4], lng[4], lnb[4], ngb[4], ngc[4];
#pragma unroll
  for (int i = 0; i < 4; i++) {
    mu_v[i] = p.rwkv_mu[l * 960 + 512 + j0 + i];
    lng[i] = p.rwkv_ln_g[l * 256 + j0 + i];
    lnb[i] = p.rwkv_ln_b[l * 256 + j0 + i];
    ngb[i] = p.gdn_norm_g[l * 64 + (lane & 15) * 4 + i];
    ngc[i] = p.gla_norm_g[l * 64 + (lane & 15) * 4 + i];
  }
  const float mu_x = p.rwkv_mu[l * 960 + 896 + lane];
  __syncthreads();
  const int stride = gridDim.x * 8;
  int r = blockIdx.x * 8 + wv;
  const u16* Pc = (const u16*)(p.ws + OFF_BIG);
  const u16* YSc = (const u16*)(p.ws + OFF_YS);
  const float* BCc = (const float*)(p.ws + OFF_BC);
  POST_DECL(cur_);
  POST_DECL(nxt_);
  POST_LOAD(cur_, r);
  for (; r < NROWS; r += stride) {
    const int rn = r + stride < NROWS ? r + stride : r;
    POST_LOAD(nxt_, rn);
    const int b = r / TPB, t = r - b * TPB;
    const float pmul = ((t != 0) && (t != LC)) ? 1.f : 0.f, nmul = ((t != LC - 1) && (t != TPB - 1)) ? 1.f : 0.f;
    float y[3][4];
    {
      float a4[4], c4[4];
      unpack4(cur_ya0, a4); unpack4(cur_yc0, c4);
#pragma unroll
      for (int i = 0; i < 4; i++) y[0][i] = a4[i] + c4[i];
      unpack4(cur_ya1, a4); unpack4(cur_yc1, c4);
#pragma unroll
      for (int i = 0; i < 4; i++) y[1][i] = a4[i] + c4[i];
      unpack4(cur_ya2, a4); unpack4(cur_yc2, c4);
#pragma unroll
      for (int i = 0; i < 4; i++) y[2][i] = a4[i] + c4[i];
    }
    float o[3][4];
    {
      float sum = y[0][0] + y[0][1] + y[0][2] + y[0][3];
      sum = red16(sum);
      const float mean = sum * (1.f / 64.f);
      float vs = 0.f;
#pragma unroll
      for (int i = 0; i < 4; i++) { float d = y[0][i] - mean; vs += d * d; }
      vs = red16(vs);
      const float rstd = rsq(vs * (1.f / 64.f) + 64e-5f);
      const float pv = bf2f(cur_xc), ppv = bf2f(cur_xp) * pmul, pnv = bf2f(cur_xn) * nmul;
      const float sg = sigm(pv + (0.5f * (ppv + pnv) - pv) * mu_x);
      float gate[4] = {0.f, 0.f, 0.f, 0.f};
      const float* g2 = g2s + j0;
#pragma unroll 8
      for (int i = 0; i < 64; i++) {
        const float si = __int_as_float(__builtin_amdgcn_readlane(__float_as_int(sg), i));
        const float4 gw = *(const float4*)(g2 + i * 256);
        gate[0] += si * gw.x; gate[1] += si * gw.y; gate[2] += si * gw.z; gate[3] += si * gw.w;
      }
      const float bcs = cur_bc.x + cur_bc.y;
      float vc4[4], vp4[4], vn4[4];
      unpack4(cur_vc, vc4); unpack4(cur_vp, vp4); unpack4(cur_vn, vn4);
#pragma unroll
      for (int i = 0; i < 4; i++) {
        const float v = vc4[i] + (0.5f * (vp4[i] * pmul + vn4[i] * nmul) - vc4[i]) * mu_v[i];
        const float yn = (y[0][i] - mean) * rstd * lng[i] + lnb[i];
        o[0][i] = (yn + bcs * v) * gate[i];
      }
    }
#pragma unroll
    for (int m = 1; m < 3; m++) {
      float ss = y[m][0] * y[m][0] + y[m][1] * y[m][1] + y[m][2] * y[m][2] + y[m][3] * y[m][3];
      ss = red16(ss);
      const float inv = rsq(ss * (1.f / 64.f) + 1e-6f);
      float g4[4];
      unpack4(m == 1 ? cur_gb : cur_gc, g4);
#pragma unroll
      for (int i = 0; i < 4; i++) o[m][i] = y[m][i] * inv * (m == 1 ? ngb[i] : ngc[i]) * siluf(g4[i]);
    }
    u16* ys = YS + (size_t)r * YST;
#pragma unroll
    for (int m = 0; m < 3; m++) {
      uint2 ov;
      ov.x = pack2(o[m][0], o[m][1]);
      ov.y = pack2(o[m][2], o[m][3]);
      *(uint2*)(ys + m * 256 + j0) = ov;
    }
    cur_ya0 = nxt_ya0; cur_ya1 = nxt_ya1; cur_ya2 = nxt_ya2; cur_yc0 = nxt_yc0; cur_yc1 = nxt_yc1; cur_yc2 = nxt_yc2;
    cur_vp = nxt_vp; cur_vc = nxt_vc; cur_vn = nxt_vn; cur_gb = nxt_gb; cur_gc = nxt_gc;
    cur_xp = nxt_xp; cur_xc = nxt_xc; cur_xn = nxt_xn; cur_bc = nxt_bc;
  }
}

#define XB_TMO      128
#define XB_XCNT(j)  (256  + 64 * (j))
#define XB_XSUB(j)  (1280 + 64 * (j))
#define XB_XGEN(j)  (2304 + 64 * (j))
#define XB_TOP      3328
#define XB_TOPGEN   3392
#define XCD_BAR_WORDS 3456
#define XB_SPIN_CAP (1u << 18)
#define LAS __attribute__((address_space(3)))

__device__ __forceinline__ unsigned xb_ld(unsigned* p)              { return __hip_atomic_load(p, __ATOMIC_RELAXED, __HIP_MEMORY_SCOPE_AGENT); }
__device__ __forceinline__ unsigned xb_add(unsigned* p, unsigned v) { return __hip_atomic_fetch_add(p, v, __ATOMIC_RELAXED, __HIP_MEMORY_SCOPE_AGENT); }
__device__ __forceinline__ unsigned xb_xcc_id() { return (unsigned)__builtin_amdgcn_s_getreg((3 << 11) | 20) & 0xFu; }
#define XB_SPIN(cond, bar) do { unsigned _sp = 0; while (cond) { __builtin_amdgcn_s_sleep(1); \
    if ((++_sp & 255u) == 0u) { if (xb_ld(&(bar)[XB_TMO])) break; if (_sp > XB_SPIN_CAP) { atomicAdd(&(bar)[XB_TMO], 1u); break; } } } } while (0)

struct XcdBarrier {
    unsigned* bar; unsigned x;
    volatile LAS unsigned* st;
};

__device__ __forceinline__ XcdBarrier xcd_barrier_post(unsigned* bar, volatile LAS unsigned* st) {
    XcdBarrier b; b.bar = bar; b.x = xb_xcc_id(); b.st = st;
    if (threadIdx.x == 0) (void)xb_add(&bar[XB_XCNT(b.x)], 1u);
    return b;
}
__device__ __forceinline__ void xcd_barrier_complete(unsigned* bar, unsigned x, unsigned& nloc, unsigned& nx) {
    const unsigned G = gridDim.x * gridDim.y * gridDim.z;
    unsigned sum, cnt, mine, sp = 0u;
    for (;;) {
        sum = 0u; cnt = 0u; mine = 0u;
#pragma unroll
        for (unsigned j = 0; j < 16; ++j) { const unsigned c = xb_ld(&bar[XB_XCNT(j)]); sum += c; cnt += (c > 0u) ? 1u : 0u; mine = (j == x) ? c : mine; }
        if (sum == G) break;
        __builtin_amdgcn_s_sleep(1);
        if ((++sp & 255u) == 0u) { if (xb_ld(&bar[XB_TMO])) break; if (sp > XB_SPIN_CAP) { atomicAdd(&bar[XB_TMO], 1u); break; } }
    }
    nloc = mine > 0u ? mine : 1u; nx = cnt > 0u ? cnt : 1u;
}

__device__ __forceinline__ void xcd_barrier(const XcdBarrier& b) {
    asm volatile("s_waitcnt vmcnt(0)" ::: "memory");
    __syncthreads();
    if (threadIdx.x == 0) {
        unsigned* bar = b.bar;
        __builtin_amdgcn_s_waitcnt(0);
        unsigned nloc = b.st[0], nx = b.st[1];
        if (nloc == 0u) { xcd_barrier_complete(bar, b.x, nloc, nx); b.st[0] = nloc; b.st[1] = nx; }
        const unsigned old = xb_add(&bar[XB_XSUB(b.x)], 1u);
        const unsigned gen = old / nloc;
        if (old + 1u == (gen + 1u) * nloc) {
            __builtin_amdgcn_fence(__ATOMIC_RELEASE, "agent");
            asm volatile("s_waitcnt vmcnt(0)" ::: "memory");
            const unsigned og = xb_add(&bar[XB_TOP], 1u);
            const unsigned tg = og / nx;
            if (og + 1u == (tg + 1u) * nx) xb_add(&bar[XB_TOPGEN], 1u);
            else XB_SPIN(xb_ld(&bar[XB_TOPGEN]) == tg, bar);
            __builtin_amdgcn_fence(__ATOMIC_ACQUIRE, "agent");
            xb_add(&bar[XB_XGEN(b.x)], 1u);
            asm volatile("s_waitcnt vmcnt(0)" ::: "memory");
        } else {
            XB_SPIN(xb_ld(&bar[XB_XGEN(b.x)]) == gen, bar);
            __builtin_amdgcn_fence(__ATOMIC_ACQUIRE, "agent");
            asm volatile("s_waitcnt vmcnt(0)" ::: "memory");
        }
    }
    __syncthreads();
}

#if defined(SKIPS)
#define EN(k) (SKIPS != (k))
#elif !defined(ONLYS)
#define EN(k) 1
#else
#define EN(k) (ONLYS == (k))
#endif
__device__ __forceinline__ void run_phase(const Params& p, int ph, unsigned char* smem) {
  if (ph == 0) { if (EN(10)) phase_init0(p, (float*)smem); return; }
  if (ph == 1) { if (EN(11)) phase_init1(p); return; }
  int l = 0, s = 12;
  if (ph >= 3) { l = (ph - 3) / 12; s = (ph - 3) - l * 12; }
  unsigned char* wl = p.ws + OFF_W + (size_t)l * SZ_WL;
  PG8_LAS unsigned char* lds = (PG8_LAS unsigned char*)smem;
  pg8::StaticOrder S;
  if (s == 12 || s == 8 || s == 11) {
    if (EN(5)) rowpass(p, l, s == 12 ? 0 : (s == 8 ? 1 : 2));
  } else if (s == 0 || s == 3 || s == 5 || s == 7 || s == 10) {
    pg8::Gemm g; EpiBf E;
    g.M = NROWS; E.bias = nullptr; E.act = 0;
    if (s == 0) { g.A = (const u16*)(p.ws + OFF_H); g.lda = DM; g.Bt = (const u16*)(wl + OW_IN); g.K = DM; g.N = PST; E.O = (u16*)(p.ws + OFF_BIG); E.ldc = PST; }
    else if (s == 3 || s == 5) {
      const int hf = s == 5;
      g.A = (const u16*)(p.ws + OFF_H); g.lda = DM; g.Bt = (const u16*)(wl + OW_G) + (size_t)hf * 2048 * DM; g.K = DM; g.N = 2048;
      E.O = (u16*)(p.ws + OFF_BIG); E.ldc = 2048; E.bias = p.gate_b + (size_t)l * 4096 + hf * 2048; E.act = 1;
    }
    else if (s == 7) { g.A = (const u16*)(p.ws + OFF_BIG + 2 * SZ_ACT); g.lda = DM; g.Bt = (const u16*)(wl + OW_O); g.K = DM; g.N = DM; E.O = (u16*)(p.ws + OFF_BIG); E.ldc = DM; }
    else { g.A = (const u16*)(p.ws + OFF_BIG); g.lda = FH; g.Bt = (const u16*)(wl + OW_2); g.K = FH; g.N = DM; E.O = (u16*)(p.ws + OFF_YS); E.ldc = DM; }
    S.init(g.M, g.N, gridDim.x, blockIdx.x);
    if (EN(0)) pg8::gemm_phase<EpiBf, pg8::StaticOrder, false>(lds, g, S, E, nullptr);
  } else if (s == 4 || s == 6) {
#ifdef YPART_ENGINE
    const int hf = s == 6;
#pragma unroll 1
    for (int k = 0; k < 2; k++) {
      const int br = hf * 2 + k;
      pg8::Gemm g; EpiGateAcc E;
      g.M = NROWS; g.N = DM; g.K = 256; g.lda = YST;
      g.A = (const u16*)(p.ws + OFF_YS) + (br < 3 ? br * 256 : 1536);
      g.Bt = (const u16*)(wl + OW_B) + (size_t)br * 1024 * 256;
      E.ACC = (u16*)(p.ws + OFF_BIG + 2 * SZ_ACT); E.G = (const u16*)(p.ws + OFF_BIG); E.gcol = k * 1024; E.amask = br != 0 ? 0xffffffffu : 0u;
      S.init(g.M, g.N, gridDim.x, blockIdx.x);
      if (EN(3)) pg8::gemm_phase<EpiGateAcc, pg8::StaticOrder, false>(lds, g, S, E, nullptr);
      __syncthreads();
    }
#else
    if (EN(3)) phase_ypart(p, l, s == 6, smem);
#endif
  } else if (s == 1) {
    if (EN(1)) phase_mix(p, l, smem);
  } else if (s == 2) {
    if (EN(2)) phase_post(p, l, (float*)smem);
  } else {
    pg8::Gemm g; EpiSwiglu E;
    g.M = NROWS; g.N = 2 * FH; g.K = DM; g.lda = DM; g.A = (const u16*)(p.ws + OFF_H); g.Bt = (const u16*)(wl + OW_1);
    E.O = (u16*)(p.ws + OFF_BIG);
    S.init(g.M, g.N, gridDim.x, blockIdx.x);
    if (EN(6)) pg8::gemm_phase<EpiSwiglu, pg8::StaticOrder, false>(lds, g, S, E, nullptr);
  }
}

__global__ void __launch_bounds__(NTHR) hybrid_flow_mega(Params p, int ph0, int ph1) {
  __shared__ __attribute__((aligned(16))) unsigned char smem[131072];
  __shared__ __attribute__((aligned(16))) unsigned xbw[4];
  cg::grid_group grid = cg::this_grid();
  XcdBarrier xb;
  xb.bar = (unsigned*)(p.ws + OFF_XBAR); xb.x = 0u; xb.st = (volatile LAS unsigned*)xbw;
  for (int ph = ph0; ph < ph1; ph++) {
    run_phase(p, ph, smem);
#ifdef DUPMASK
    {
      int sidx = ph >= 3 ? (ph - 3) % 12 : 12 + ph;
      if ((DUPMASK >> sidx) & 1) { __syncthreads(); run_phase(p, ph, smem); }
    }
#endif
    if (ph + 1 < ph1) {
      if (ph == ph0) {
        grid.sync();
        if (threadIdx.x < 4) xbw[threadIdx.x] = 0u;
        __syncthreads();
        xb = xcd_barrier_post((unsigned*)(p.ws + OFF_XBAR), (volatile LAS unsigned*)xbw);
      } else {
        xcd_barrier(xb);
      }
    }
  }
  if (ph1 - ph0 > 2 && threadIdx.x == 0 && xb_ld(&xb.bar[XB_TMO]) != 0u) p.out[blockIdx.x] = __int_as_float(0x7fc00000);
}

extern "C" void kernel_launch(void* const* d_in, const int* in_sizes, int n_in, void* d_out, int out_size, void* d_ws,
                              size_t ws_size, hipStream_t stream) {
  Params p{};
  const float** pp = (const float**)&p;
  for (int i = 0; i < 32; i++) pp[i] = (const float*)d_in[i];
  p.out = (float*)d_out;
  p.ws = (unsigned char*)d_ws;
  static int grid_blocks = 0;
  if (!grid_blocks) {
    int dev = 0, cus = 0, per_cu = 0;
    hipGetDevice(&dev);
    hipDeviceGetAttribute(&cus, hipDeviceAttributeMultiprocessorCount, dev);
    hipOccupancyMaxActiveBlocksPerMultiprocessor(&per_cu, hybrid_flow_mega, NTHR, 0);
    if (per_cu < 1) per_cu = 1;
    grid_blocks = cus * per_cu;
  }
#ifdef MULTI_LAUNCH
  for (int ph = 0; ph < NPHASE; ph++) {
    hipLaunchKernelGGL(hybrid_flow_mega, dim3(grid_blocks), dim3(NTHR), 0, stream, p, ph, ph + 1);
  }
#else
  int ph0 = 0, ph1 = NPHASE;
  void* args[] = {&p, &ph0, &ph1};
  hipError_t e = hipLaunchCooperativeKernel((void*)hybrid_flow_mega, dim3(grid_blocks), dim3(NTHR), args, 0, stream);
  if (e != hipSuccess) fprintf(stderr, "cooperative launch failed: %s (grid %d)\n", hipGetErrorString(e), grid_blocks);
#endif
}
```

```cpp
#include <hip/hip_runtime.h>
#include <hip/hip_cooperative_groups.h>
#include <cstdio>
namespace cg = cooperative_groups;

typedef unsigned short u16;
using bf16x8 = __attribute__((ext_vector_type(8))) short;
using f32x4 = __attribute__((ext_vector_type(4))) float;

#define DM 1024
#define NBATCH 8
#define SEQ 4096
#define LC 256
#define TPB 4352
#define NROWS 34816
#define PST 3328
#define YST 1792
#define FH 2816
#define INW 7408
#define NTHR 512
#define PA 0
#define PB 960
#define PC 2000
#define PD 2800
#define NPHASE 27
#define SCAN3_MASK 7

struct Params {
  const float *x, *c, *ctx, *c_ctx, *ada_w, *ada_b, *norm_g, *w_in, *gate_b, *w_branch, *w_out,
      *rwkv_mu, *rwkv_w0, *rwkv_w2, *rwkv_a0, *rwkv_a2, *rwkv_g2, *rwkv_kk, *rwkv_ka, *rwkv_rk, *rwkv_ln_g,
      *rwkv_ln_b, *gdn_conv, *gdn_a_log, *gdn_dt_bias, *gdn_norm_g, *gla_gw2, *gla_gb, *gla_norm_g, *attn_sink,
      *ffn_w1, *ffn_w2;
  float* out;
  unsigned char* ws;
};

constexpr size_t SZ_WL = 36700160;
constexpr size_t OW_IN = 0;
constexpr size_t OW_G = OW_IN + (size_t)PST * 1024 * 2;
constexpr size_t OW_B = OW_G + (size_t)4096 * 1024 * 2;
constexpr size_t OW_O = OW_B + (size_t)4 * 1024 * 256 * 2;
constexpr size_t OW_1 = OW_O + (size_t)1024 * 1024 * 2;
constexpr size_t OW_2 = OW_1 + (size_t)5632 * 1024 * 2;
static_assert(OW_2 + (size_t)1024 * FH * 2 == SZ_WL, "weights size");
constexpr size_t SZ_ACT = (size_t)NROWS * DM * 2;
constexpr size_t OFF_W = 0;
constexpr size_t OFF_XC = OFF_W + 2 * SZ_WL;
constexpr size_t OFF_MODP = OFF_XC + (size_t)NBATCH * LC * DM * 4;
constexpr size_t OFF_MOD = OFF_MODP + (size_t)2 * 8 * 9 * 6144 * 4;
constexpr size_t OFF_BC = OFF_MOD + (size_t)2 * 9 * 6144 * 4;
constexpr size_t OFF_H = OFF_BC + (size_t)NROWS * 8 * 4;
constexpr size_t OFF_YS = OFF_H + SZ_ACT;
constexpr size_t OFF_BIG = OFF_YS + (size_t)NROWS * YST * 2;
constexpr size_t OFF_CTR = OFF_BIG + (size_t)NROWS * PST * 2;
constexpr size_t OFF_XBAR = OFF_CTR + 256;
constexpr size_t WS_END = OFF_XBAR + 3456 * 4;
static_assert(WS_END <= (size_t)536870912, "ws too large");

__device__ __forceinline__ int launder_tid() { int t = threadIdx.x; asm volatile("" : "+v"(t)); return t; }
#define TIDX (launder_tid())
typedef float f32x2_t __attribute__((ext_vector_type(2)));
typedef __bf16 bf16x2_t __attribute__((ext_vector_type(2)));
__device__ __forceinline__ unsigned pack2(float a, float b) {
  const f32x2_t v = {a, b};
  const bf16x2_t r = __builtin_convertvector(v, bf16x2_t);
  return __builtin_bit_cast(unsigned, r);
}
__device__ __forceinline__ u16 f2bf(float f) { return (u16)(pack2(f, 0.f) & 0xffffu); }
__device__ __forceinline__ float bf2f(u16 h) { return __uint_as_float(((unsigned)h) << 16); }
__device__ __forceinline__ float sigm(float x) { return __builtin_amdgcn_rcpf(1.f + __expf(-x)); }
__device__ __forceinline__ float siluf(float x) { return x * __builtin_amdgcn_rcpf(1.f + __expf(-x)); }
__device__ __forceinline__ float rsq(float x) { return __builtin_amdgcn_rsqf(x); }
__device__ __forceinline__ float softplusf(float x) { return fmaxf(x, 0.f) + __logf(1.f + __expf(-fabsf(x))); }
__device__ __forceinline__ float tanh_fast(float x) { return 1.f - 2.f * __builtin_amdgcn_rcpf(1.f + __expf(2.f * x)); }
__device__ __forceinline__ float wsum(float v) {
#pragma unroll
  for (int o = 32; o > 0; o >>= 1) v += __shfl_xor(v, o);
  return v;
}
template <int CTRL>
__device__ __forceinline__ float dppf(float x) {
  return __int_as_float(__builtin_amdgcn_update_dpp(__float_as_int(x), __float_as_int(x), CTRL, 0xf, 0xf, false));
}
__device__ __forceinline__ float red8(float x) {
  x += dppf<0xB1>(x);
  x += dppf<0x4E>(x);
  x += dppf<0x141>(x);
  return x;
}
__device__ __forceinline__ const float* xin_row(const Params& p, int r) {
  int b = r / TPB, t = r - b * TPB;
  return t < LC ? p.ctx + ((size_t)(b * LC + t)) * DM : p.x + ((size_t)(b * SEQ + t - LC)) * DM;
}
__device__ __forceinline__ float* x_row(const Params& p, int r) {
  int b = r / TPB, t = r - b * TPB;
  return t < LC ? (float*)(p.ws + OFF_XC) + ((size_t)(b * LC + t)) * DM : p.out + ((size_t)(b * SEQ + t - LC)) * DM;
}
__device__ __forceinline__ int mod_row(int r) {
  int b = r / TPB, t = r - b * TPB;
  return t < LC ? 8 : b;
}

struct MapId { int lim, off; __device__ int operator()(int n) const { return n < lim ? n + off : -1; } };
struct MapW1 { __device__ int operator()(int n) const { int q = n >> 3, s = n & 7; return s < 4 ? q * 4 + s : FH + q * 4 + (s - 4); } };

template <class Map>
__device__ __forceinline__ void conv_tile(const float* __restrict__ src, int ld, u16* __restrict__ dst, int K, int n0,
                                          int k0, Map map, float* tile) {
  const int tid = TIDX;
  const int nn = tid & 63, kr = tid >> 6;
  const int sc = map(n0 + nn);
#pragma unroll
  for (int ps = 0; ps < 8; ps++) {
    int kk = ps * 8 + kr;
    float v = sc >= 0 ? src[(size_t)(k0 + kk) * ld + sc] : 0.f;
    tile[kk * 65 + nn] = v;
  }
  __syncthreads();
  const int n2 = tid >> 3, kc = tid & 7;
  uint4 o;
  o.x = pack2(tile[(kc * 8 + 0) * 65 + n2], tile[(kc * 8 + 1) * 65 + n2]);
  o.y = pack2(tile[(kc * 8 + 2) * 65 + n2], tile[(kc * 8 + 3) * 65 + n2]);
  o.z = pack2(tile[(kc * 8 + 4) * 65 + n2], tile[(kc * 8 + 5) * 65 + n2]);
  o.w = pack2(tile[(kc * 8 + 6) * 65 + n2], tile[(kc * 8 + 7) * 65 + n2]);
  *(uint4*)(dst + (size_t)(n0 + n2) * K + k0 + kc * 8) = o;
  __syncthreads();
}

__device__ __forceinline__ void phase_init0(const Params& p, float* sm) {
  const int tid = TIDX;
  if (blockIdx.x == 0) {
    if (tid < 64) ((unsigned*)(p.ws + OFF_CTR))[tid] = 0u;
    for (int i = tid; i < 3456; i += NTHR) ((unsigned*)(p.ws + OFF_XBAR))[i] = 0u;
  }
  constexpr int NMOD = 192, NCONV = 4480 * 2;
  for (int it = blockIdx.x; it < NMOD + NCONV; it += gridDim.x) {
    if (it < NMOD) {
      int l = it / 96, rem = it - l * 96, cc = rem >> 3, ks = rem & 7;
      for (int i = tid; i < 9 * 128; i += NTHR) {
        int r = i >> 7, k = i & 127;
        float v = r < 8 ? p.c[r * DM + ks * 128 + k] : p.c_ctx[ks * 128 + k];
        sm[i] = siluf(v);
      }
      __syncthreads();
      const int n = cc * 512 + tid;
      const float* w = p.ada_w + ((size_t)l * DM + ks * 128) * 6144 + n;
      float acc[9];
#pragma unroll
      for (int r = 0; r < 9; r++) acc[r] = 0.f;
#pragma unroll 4
      for (int k = 0; k < 128; k++) {
        float wv = w[(size_t)k * 6144];
#pragma unroll
        for (int r = 0; r < 9; r++) acc[r] += sm[r * 128 + k] * wv;
      }
      float* mp = (float*)(p.ws + OFF_MODP) + ((size_t)(l * 8 + ks) * 9) * 6144 + n;
#pragma unroll
      for (int r = 0; r < 9; r++) mp[(size_t)r * 6144] = acc[r];
      __syncthreads();
    } else {
      int ci = it - NMOD;
      int l = ci / 4480, rem = ci - l * 4480;
      u16* wl = (u16*)(p.ws + OFF_W + (size_t)l * SZ_WL);
      if (rem < 832) {
        int nt = rem >> 4, kt = rem & 15;
        conv_tile(p.w_in + (size_t)l * DM * INW, INW, (u16*)((char*)wl + OW_IN), 1024, nt * 64, kt * 64, MapId{3312, 0}, sm);
      } else if (rem < 832 + 1024) {
        rem -= 832;
        int nt = rem >> 4, kt = rem & 15;
        conv_tile(p.w_in + (size_t)l * DM * INW, INW, (u16*)((char*)wl + OW_G), 1024, nt * 64, kt * 64, MapId{4096, 3312}, sm);
      } else if (rem < 1856 + 256) {
        rem -= 1856;
        int br = rem >> 6, r2 = rem & 63, nt = r2 >> 2, kt = r2 & 3;
        conv_tile(p.w_branch + ((size_t)(l * 4 + br)) * 256 * DM, DM, (u16*)((char*)wl + OW_B) + (size_t)br * 1024 * 256, 256,
                  nt * 64, kt * 64, MapId{1024, 0}, sm);
      } else if (rem < 2112 + 256) {
        rem -= 2112;
        int nt = rem >> 4, kt = rem & 15;
        conv_tile(p.w_out + (size_t)l * DM * DM, DM, (u16*)((char*)wl + OW_O), 1024, nt * 64, kt * 64, MapId{1024, 0}, sm);
      } else if (rem < 2368 + 1408) {
        rem -= 2368;
        int nt = rem >> 4, kt = rem & 15;
        conv_tile(p.ffn_w1 + (size_t)l * DM * 5632, 5632, (u16*)((char*)wl + OW_1), 1024, nt * 64, kt * 64, MapW1{}, sm);
      } else {
        rem -= 3776;
        int nt = rem / 44, kt = rem - nt * 44;
        conv_tile(p.ffn_w2 + (size_t)l * FH * DM, DM, (u16*)((char*)wl + OW_2), FH, nt * 64, kt * 64, MapId{1024, 0}, sm);
      }
    }
  }
}

__device__ __forceinline__ void phase_init1(const Params& p) {
  const float* mp = (const float*)(p.ws + OFF_MODP);
  float* mo = (float*)(p.ws + OFF_MOD);
  for (int i = blockIdx.x * NTHR + TIDX; i < 2 * 9 * 6144; i += gridDim.x * NTHR) {
    int l = i / (9 * 6144), rem = i - l * 9 * 6144, r = rem / 6144, n = rem - r * 6144;
    float s = p.ada_b[l * 6144 + n];
#pragma unroll
    for (int ks = 0; ks < 8; ks++) s += mp[((size_t)((l * 8 + ks) * 9 + r)) * 6144 + n];
    mo[i] = s;
  }
}

__device__ __forceinline__ void rowpass(const Params& p, int l, int mode) {
  const int lane = TIDX & 63, wv = TIDX >> 6;
  const float* MOD = (const float*)(p.ws + OFF_MOD);
  u16* H = (u16*)(p.ws + OFF_H);
  const bool do_norm = !(mode == 2 && l == 1);
  const int ln = (mode == 2) ? (l == 1 ? l : l + 1) : l;
  const int ni = (mode == 1) ? 2 : 0, sho = (mode == 1) ? 3072 : 0, sco = (mode == 1) ? 4096 : 1024;
  for (int r = blockIdx.x * 8 + wv; r < NROWS; r += gridDim.x * 8) {
    const int mr = mod_row(r);
    if (l == 1 && mode != 0 && mr == 8) continue;
    const float* modl = MOD + ((size_t)(l * 9 + mr)) * 6144;
    const float* modn = MOD + ((size_t)(ln * 9 + mr)) * 6144;
    const float* ng2 = p.norm_g + (size_t)(ln * 4 + ni) * DM;
    const float* xs = (mode == 0 || (mode == 1 && l == 0)) ? xin_row(p, r) : (const float*)x_row(p, r);
    float4 xo[4], n2[4], sc4[4], sh4[4];
#pragma unroll
    for (int i = 0; i < 4; i++) {
      const int col = i * 256 + lane * 4;
      xo[i] = *(const float4*)(xs + col);
      n2[i] = *(const float4*)(ng2 + col);
      sc4[i] = *(const float4*)(modn + sco + col);
      sh4[i] = *(const float4*)(modn + sho + col);
    }
    float xv[16];
    if (mode == 0) {
#pragma unroll
      for (int i = 0; i < 4; i++) { xv[i * 4 + 0] = xo[i].x; xv[i * 4 + 1] = xo[i].y; xv[i * 4 + 2] = xo[i].z; xv[i * 4 + 3] = xo[i].w; }
    } else {
      const u16* src = (const u16*)(p.ws + (mode == 1 ? OFF_BIG : OFF_YS)) + (size_t)r * DM;
      const float* ng = p.norm_g + (size_t)(l * 4 + (mode == 1 ? 1 : 3)) * DM;
      const float* gt = modl + (mode == 1 ? 2048 : 5120);
      uint2 sv[4];
      float4 g4[4], n4[4];
#pragma unroll
      for (int i = 0; i < 4; i++) {
        const int col = i * 256 + lane * 4;
        sv[i] = *(const uint2*)(src + col);
        g4[i] = *(const float4*)(gt + col);
        n4[i] = *(const float4*)(ng + col);
      }
      float ov[16];
      float ss = 0.f;
#pragma unroll
      for (int i = 0; i < 4; i++) {
        ov[i * 4 + 0] = __uint_as_float(sv[i].x << 16); ov[i * 4 + 1] = __uint_as_float(sv[i].x & 0xffff0000u);
        ov[i * 4 + 2] = __uint_as_float(sv[i].y << 16); ov[i * 4 + 3] = __uint_as_float(sv[i].y & 0xffff0000u);
      }
#pragma unroll
      for (int i = 0; i < 16; i++) ss += ov[i] * ov[i];
      ss = wsum(ss);
      const float inv = rsq(ss * (1.f / 1024.f) + 1e-6f);
      float* xd = x_row(p, r);
#pragma unroll
      for (int i = 0; i < 4; i++) {
        xv[i * 4 + 0] = xo[i].x + g4[i].x * (ov[i * 4 + 0] * inv * n4[i].x);
        xv[i * 4 + 1] = xo[i].y + g4[i].y * (ov[i * 4 + 1] * inv * n4[i].y);
        xv[i * 4 + 2] = xo[i].z + g4[i].z * (ov[i * 4 + 2] * inv * n4[i].z);
        xv[i * 4 + 3] = xo[i].w + g4[i].w * (ov[i * 4 + 3] * inv * n4[i].w);
      }
#pragma unroll
      for (int i = 0; i < 4; i++)
        *(float4*)(xd + i * 256 + lane * 4) = make_float4(xv[i * 4 + 0], xv[i * 4 + 1], xv[i * 4 + 2], xv[i * 4 + 3]);
    }
    if (!do_norm) continue;
    float ss2 = 0.f;
#pragma unroll
    for (int i = 0; i < 16; i++) ss2 += xv[i] * xv[i];
    ss2 = wsum(ss2);
    const float inv2 = rsq(ss2 * (1.f / 1024.f) + 1e-6f);
#pragma unroll
    for (int i = 0; i < 4; i++) {
      const int col = i * 256 + lane * 4;
      float h0 = xv[i * 4 + 0] * inv2 * n2[i].x * (1.f + sc4[i].x) + sh4[i].x;
      float h1 = xv[i * 4 + 1] * inv2 * n2[i].y * (1.f + sc4[i].y) + sh4[i].y;
      float h2 = xv[i * 4 + 2] * inv2 * n2[i].z * (1.f + sc4[i].z) + sh4[i].z;
      float h3 = xv[i * 4 + 3] * inv2 * n2[i].w * (1.f + sc4[i].w) + sh4[i].w;
      uint2 o;
      o.x = pack2(h0, h1);
      o.y = pack2(h2, h3);
      *(uint2*)(H + (size_t)r * DM + col) = o;
    }
  }
}

#define LDT 72
namespace pg8 {
#define PG8_LAS __attribute__((address_space(3)))
typedef unsigned short bf16_t;
typedef short bf16x8 __attribute__((ext_vector_type(8)));
typedef float f32x4 __attribute__((ext_vector_type(4)));
typedef unsigned u32x4 __attribute__((ext_vector_type(4)));
constexpr int BM = 256, BK = 64, HALF = 128, HTB = HALF * BK * 2  , STAGE_BYTES = 8 * HTB, NXCD = 8, WGM = 8;

__host__ __device__ __forceinline__ int lds_byte(int r, int c) { const int st = (r >> 4) * 2 + (c >> 5), rr = r & 15, cc = c & 31, ob = rr * 64 + cc * 2; return st * 1024 + (ob ^ (((ob >> 9) & 1) << 5)); }
__host__ __device__ __forceinline__ void stage_rc(int b, int& R, int& C) { const int st = b / 1024, sb = b % 1024, swz = sb ^ (((sb >> 9) & 1) << 5); R = (st >> 1) * 16 + swz / 64; C = (st & 1) * 32 + (swz % 64) / 2; }
__host__ __device__ __forceinline__ int perm32(int rho) { const int n = rho >> 4, i = rho & 15; return 8 * (i >> 2) + 4 * n + (i & 3); }

struct Unit { int pm, pn; };
struct Gemm { const bf16_t* A; const bf16_t* Bt; int M, N, K, lda; };
struct StaticOrder {
    int nM, nN, nwg, G, c, skip;
    __host__ __device__ void init(int M, int N, int G_, int c_, int skip_ = 0) { nM = M / BM; nN = N / BM; nwg = nM * nN; G = G_; c = c_; skip = skip_; }
    __host__ __device__ bool next(int i, Unit& u) const {
        const long L = (long)i * G + c; if (L >= nwg) return false;
        int wgid = (int)L; { const int q = nwg / NXCD, r = nwg % NXCD, xcd = wgid % NXCD, off = wgid / NXCD; wgid = (xcd < r ? xcd * (q + 1) : r * (q + 1) + (xcd - r) * q) + off; }
        const int nig = WGM * nN, gid = wgid / nig, fm = gid * WGM, gsz = (nM - fm) < WGM ? (nM - fm) : WGM;
        u.pm = fm + ((wgid % nig) % gsz); u.pn = (wgid % nig) / gsz;
        if (skip) u.pm = (u.pm >> 4) * 17 + 1 + (u.pm & 15);
        return true;
    }
    __device__ __forceinline__ void a_ready(const Unit&) const {}
    __device__ __forceinline__ void done(const Unit&) const {}
};
__device__ __forceinline__ unsigned cvt_pk_bf16(float lo, float hi) { unsigned r; asm volatile("v_cvt_pk_bf16_f32 %0, %1, %2" : "=v"(r) : "v"(lo), "v"(hi)); return r; }
template <class Epi, class Sched, bool STAMP = false>
__device__ __forceinline__ void gemm_phase(PG8_LAS unsigned char* lds, const Gemm g, const Sched& S, const Epi& E, unsigned long long* stamps) {
    const int tid = TIDX, wid = __builtin_amdgcn_readfirstlane(tid >> 6), lane = tid & 63, wr = wid >> 2, wc = wid & 3, fr = lane & 15, fq = lane >> 4;
    const int K = g.K, nt = K / BK;
    int ts_lo = 0, ts_hi = 0, nts = 0; const unsigned long long rt_entry = STAMP ? (unsigned long long)wall_clock64() : 0ull;
#define PG8_STAMP() do { if (STAMP && wid == 0 && nts < 64) { const unsigned long long _c = (unsigned long long)clock64(); \
        ts_lo = (lane == nts) ? (int)(unsigned)_c : ts_lo; ts_hi = (lane == nts) ? (int)(unsigned)(_c >> 32) : ts_hi; ++nts; } } while (0)
    PG8_STAMP();
    unsigned voffA[2], voffB[2];
#pragma unroll
    for (int i = 0; i < 2; ++i) { int R, C; stage_rc(tid * 16 + i * 8192, R, C); const int Rb = Epi::PERM ? ((R & ~31) + perm32(R & 31)) : R;
        voffA[i] = (unsigned)(R * g.lda + C) * 2u; voffB[i] = (unsigned)(Rb * K + C) * 2u; }
    const size_t kstep = (size_t)(BK * 2);
    const size_t hstepB = (size_t)HALF * K * 2, hstepA = (size_t)HALF * g.lda * 2;
    const size_t tstepB = 2 * hstepB, tstepA = 2 * hstepA;
    const unsigned ldsw = (unsigned)wid * 1024u;
    const int aoff = lds_byte(wr * 64 + fr, fq * 8), boff = lds_byte(wc * 32 + fr, fq * 8);
#define PG8_SA(b, h) (((b) * 2 + (h)) * HTB)
#define PG8_SB(b, h) ((4 + (b) * 2 + (h)) * HTB)
#define PG8_STAGE(bufoff, gbase, voff) do { _Pragma("unroll") for (int _i = 0; _i < 2; ++_i) \
        __builtin_amdgcn_global_load_lds((const unsigned*)((const char*)(gbase) + (voff)[_i]), (PG8_LAS unsigned*)(lds + (bufoff) + ldsw + _i * 8192), 16, 0, 0); } while (0)
#define PG8_LDA(dst, b, h) do { _Pragma("unroll") for (int m = 0; m < 4; ++m) _Pragma("unroll") for (int k = 0; k < 2; ++k) dst[m][k] = *(const PG8_LAS bf16x8*)(lds + PG8_SA(b, h) + aoff + m * 2048 + k * 1024); } while (0)
#define PG8_LDB(dst, b, h) do { _Pragma("unroll") for (int n = 0; n < 2; ++n) _Pragma("unroll") for (int k = 0; k < 2; ++k) dst[n][k] = *(const PG8_LAS bf16x8*)(lds + PG8_SB(b, h) + boff + n * 2048 + k * 1024); } while (0)
#define PG8_MMA(ai, bj, At, Bt) do { __builtin_amdgcn_s_setprio(1); _Pragma("unroll") for (int m = 0; m < 4; ++m) _Pragma("unroll") for (int n = 0; n < 2; ++n) _Pragma("unroll") for (int k = 0; k < 2; ++k) \
        acc[ai][bj][m][n] = __builtin_amdgcn_mfma_f32_16x16x32_bf16(Bt[n][k], At[m][k], acc[ai][bj][m][n], 0, 0, 0); __builtin_amdgcn_s_setprio(0); } while (0)
#define PG8_WAIT_V(n) asm volatile("s_waitcnt vmcnt(" #n ")" ::: "memory")
#define PG8_WAIT_L(n) asm volatile("s_waitcnt lgkmcnt(" #n ")" ::: "memory")
#define PG8_BAR __builtin_amdgcn_s_barrier()
#define PG8_SCHED __builtin_amdgcn_sched_barrier(0)
    Unit cur, nxt; int ui = 0;
    if (!S.next(0, cur)) return;
    f32x4 acc[2][2][4][2];
#pragma unroll
    for (int a = 0; a < 2; ++a)
#pragma unroll
        for (int b = 0; b < 2; ++b)
#pragma unroll
            for (int m = 0; m < 4; ++m)
#pragma unroll
                for (int n = 0; n < 2; ++n) acc[a][b][m][n] = (f32x4){0.f, 0.f, 0.f, 0.f};
    bf16x8 At[4][2], B0[2][2], B1[2][2];
    const char* cA = (const char*)g.A + (size_t)cur.pm * tstepA; const char* cB = (const char*)g.Bt + (size_t)cur.pn * tstepB;
    S.a_ready(cur);
    PG8_STAGE(PG8_SB(0, 0), cB, voffB); PG8_STAGE(PG8_SA(0, 0), cA, voffA); PG8_STAGE(PG8_SB(0, 1), cB + hstepB, voffB); PG8_STAGE(PG8_SA(0, 1), cA + hstepA, voffA);
    if (wr == 1) PG8_BAR;
    PG8_WAIT_V(4); PG8_BAR;
    PG8_STAGE(PG8_SB(1, 0), cB + kstep, voffB); PG8_STAGE(PG8_SA(1, 0), cA + kstep, voffA); PG8_STAGE(PG8_SB(1, 1), cB + hstepB + kstep, voffB);
    PG8_WAIT_V(6); PG8_BAR;
    PG8_STAMP();
    for (;;) {
        const bool has_next = S.next(ui + 1, nxt);
        const char* nA = has_next ? (const char*)g.A + (size_t)nxt.pm * tstepA : cA; const char* nB = has_next ? (const char*)g.Bt + (size_t)nxt.pn * tstepB : cB;
        for (int t = 0; t < nt; t += 2) {
            const bool last = (t == nt - 2);
            const char* a1 = cA + (size_t)(t + 1) * kstep;
            const char* a2 = last ? nA : cA + (size_t)(t + 2) * kstep; const char* b2 = last ? nB : cB + (size_t)(t + 2) * kstep;
            const char* a3 = a2 + kstep; const char* b3 = b2 + kstep;
            if (last && has_next) S.a_ready(nxt);
            PG8_LDB(B0, 0, 0); PG8_SCHED; PG8_LDA(At, 0, 0); PG8_STAGE(PG8_SA(1, 1), a1 + hstepA, voffA);
            PG8_WAIT_L(8); PG8_BAR; PG8_WAIT_L(0); PG8_MMA(0, 0, At, B0); PG8_BAR; PG8_SCHED;
            PG8_LDB(B1, 0, 1); PG8_STAGE(PG8_SB(0, 0), b2, voffB);
            PG8_BAR; PG8_WAIT_L(0); PG8_MMA(0, 1, At, B1); PG8_BAR;
            PG8_LDA(At, 0, 1); PG8_STAGE(PG8_SA(0, 0), a2, voffA);
            PG8_BAR; PG8_WAIT_L(0); PG8_MMA(1, 0, At, B0); PG8_BAR; PG8_SCHED;
            PG8_STAGE(PG8_SB(0, 1), b2 + hstepB, voffB);
            PG8_WAIT_V(6); PG8_BAR; PG8_MMA(1, 1, At, B1); PG8_BAR;
            PG8_LDB(B0, 1, 0); PG8_SCHED; PG8_LDA(At, 1, 0); PG8_STAGE(PG8_SA(0, 1), a2 + hstepA, voffA);
            PG8_WAIT_L(8); PG8_BAR; PG8_WAIT_L(0); PG8_MMA(0, 0, At, B0); PG8_BAR; PG8_SCHED;
            PG8_LDB(B1, 1, 1); PG8_STAGE(PG8_SB(1, 0), b3, voffB);
            PG8_BAR; PG8_WAIT_L(0); PG8_MMA(0, 1, At, B1); PG8_BAR;
            PG8_LDA(At, 1, 1); PG8_STAGE(PG8_SA(1, 0), a3, voffA);
            PG8_BAR; PG8_WAIT_L(0); PG8_MMA(1, 0, At, B0); PG8_BAR; PG8_SCHED;
            PG8_STAGE(PG8_SB(1, 1), b3 + hstepB, voffB);
            PG8_WAIT_V(6); PG8_BAR; PG8_MMA(1, 1, At, B1); PG8_BAR;
        }
        PG8_STAMP();
        if constexpr (!Epi::AFTER_DRAIN) { E(acc, cur, wr, wc, fr, fq); S.done(cur); }
        PG8_STAMP();
        if (!has_next) break;
#pragma unroll
        for (int a = 0; a < 2; ++a)
#pragma unroll
            for (int b = 0; b < 2; ++b)
#pragma unroll
                for (int m = 0; m < 4; ++m)
#pragma unroll
                    for (int n = 0; n < 2; ++n) acc[a][b][m][n] = (f32x4){0.f, 0.f, 0.f, 0.f};
        cur = nxt; cA = nA; cB = nB; ++ui;
    }
    PG8_WAIT_V(0);
    if (wr == 0) PG8_BAR;
    PG8_BAR;
    if constexpr (Epi::AFTER_DRAIN) { E.fused(acc, cur, wr, wc, fr, fq, lds, wid, lane); S.done(cur); }
    PG8_STAMP();
    if (STAMP && wid == 0) { stamps[lane] = lane < nts ? (((unsigned long long)(unsigned)ts_hi << 32) | (unsigned)ts_lo) : 0ull;
        if (lane == 62) stamps[62] = rt_entry; if (lane == 63) stamps[63] = (unsigned long long)wall_clock64(); }
#undef PG8_STAMP
#undef PG8_SA
#undef PG8_SB
#undef PG8_STAGE
#undef PG8_LDA
#undef PG8_LDB
#undef PG8_MMA
#undef PG8_WAIT_V
#undef PG8_WAIT_L
#undef PG8_BAR
#undef PG8_SCHED
}
}

struct EpiBf {
  static constexpr bool PERM = true, AFTER_DRAIN = false;
  u16* O; int ldc; const float* bias; int act;
  __device__ __forceinline__ void operator()(const f32x4 (&acc)[2][2][4][2], const pg8::Unit& u, int wr, int wc, int fr, int fq) const {
    const int row0 = u.pm * 256 + wr * 64 + fr, col0 = u.pn * 256 + wc * 32 + 8 * fq;
    f32x4 bv[2][2];
#pragma unroll
    for (int bj = 0; bj < 2; ++bj)
#pragma unroll
      for (int n = 0; n < 2; ++n) bv[bj][n] = bias ? *(const f32x4*)(bias + col0 + bj * 128 + 4 * n) : f32x4{0.f, 0.f, 0.f, 0.f};
#pragma unroll
    for (int ai = 0; ai < 2; ++ai)
#pragma unroll
      for (int m = 0; m < 4; ++m) {
        u16* rowp = O + (size_t)(row0 + ai * 128 + m * 16) * ldc + col0;
#pragma unroll
        for (int bj = 0; bj < 2; ++bj) {
          f32x4 v0 = acc[ai][bj][m][0] + bv[bj][0], v1 = acc[ai][bj][m][1] + bv[bj][1];
          if (act == 1) {
#pragma unroll
            for (int j = 0; j < 4; ++j) { v0[j] = sigm(v0[j]); v1[j] = sigm(v1[j]); }
          }
          uint4 wv;
          wv.x = pack2(v0[0], v0[1]); wv.y = pack2(v0[2], v0[3]); wv.z = pack2(v1[0], v1[1]); wv.w = pack2(v1[2], v1[3]);
          *(uint4*)(rowp + bj * 128) = wv;
        }
      }
  }
};
struct EpiSwiglu {
  static constexpr bool PERM = true, AFTER_DRAIN = false;
  u16* O;
  __device__ __forceinline__ void operator()(const f32x4 (&acc)[2][2][4][2], const pg8::Unit& u, int wr, int wc, int fr, int fq) const {
    const int row0 = u.pm * 256 + wr * 64 + fr, col0 = u.pn * 128 + wc * 16 + 4 * fq;
#pragma unroll
    for (int ai = 0; ai < 2; ++ai)
#pragma unroll
      for (int m = 0; m < 4; ++m) {
        u16* rowp = O + (size_t)(row0 + ai * 128 + m * 16) * FH + col0;
#pragma unroll
        for (int bj = 0; bj < 2; ++bj) {
          const f32x4 g = acc[ai][bj][m][0], up = acc[ai][bj][m][1];
          uint2 wv;
          wv.x = pack2(siluf(g[0]) * up[0], siluf(g[1]) * up[1]);
          wv.y = pack2(siluf(g[2]) * up[2], siluf(g[3]) * up[3]);
          *(uint2*)(rowp + bj * 64) = wv;
        }
      }
  }
};
struct EpiGateAcc {
  static constexpr bool PERM = true, AFTER_DRAIN = false;
  u16* ACC; const u16* G; int gcol; unsigned amask;
  __device__ __forceinline__ void operator()(const f32x4 (&acc)[2][2][4][2], const pg8::Unit& u, int wr, int wc, int fr, int fq) const {
    unsigned pk[2][2][4][4];
#pragma unroll
    for (int ai = 0; ai < 2; ++ai)
#pragma unroll
      for (int bj = 0; bj < 2; ++bj)
#pragma unroll
        for (int m = 0; m < 4; ++m) {
          pk[ai][bj][m][0] = pack2(acc[ai][bj][m][0][0], acc[ai][bj][m][0][1]);
          pk[ai][bj][m][1] = pack2(acc[ai][bj][m][0][2], acc[ai][bj][m][0][3]);
          pk[ai][bj][m][2] = pack2(acc[ai][bj][m][1][0], acc[ai][bj][m][1][1]);
          pk[ai][bj][m][3] = pack2(acc[ai][bj][m][1][2], acc[ai][bj][m][1][3]);
        }
    asm volatile("" ::: "memory");
    const int row0 = u.pm * 256 + wr * 64 + fr, col0 = u.pn * 256 + wc * 32 + 8 * fq;
#pragma unroll
    for (int ai = 0; ai < 2; ++ai)
#pragma unroll
      for (int m = 0; m < 4; ++m) {
        const size_t row = (size_t)(row0 + ai * 128 + m * 16);
#pragma unroll
        for (int bj = 0; bj < 2; ++bj) {
          const int col = col0 + bj * 128;
          const uint4 gv = *(const uint4*)(G + row * 2048 + gcol + col);
          const uint4 av = *(const uint4*)(ACC + row * DM + col);
          const unsigned gw[4] = {gv.x, gv.y, gv.z, gv.w};
          const unsigned aw[4] = {av.x & amask, av.y & amask, av.z & amask, av.w & amask};
          unsigned ow[4];
#pragma unroll
          for (int q = 0; q < 4; ++q) {
            const unsigned pv = pk[ai][bj][m][q];
            const float lo = __uint_as_float(aw[q] << 16) + __uint_as_float(gw[q] << 16) * __uint_as_float(pv << 16);
            const float hi = __uint_as_float(aw[q] & 0xffff0000u) + __uint_as_float(gw[q] & 0xffff0000u) * __uint_as_float(pv & 0xffff0000u);
            ow[q] = pack2(lo, hi);
          }
          *(uint4*)(ACC + row * DM + col) = make_uint4(ow[0], ow[1], ow[2], ow[3]);
        }
        asm volatile("" ::: "memory");
      }
  }
};

template <int MI>
__device__ __forceinline__ void gemm_loop(const u16* __restrict__ A, int lda, const u16* __restrict__ Bt, int ldb, int K,
                                          f32x4 (&acc)[MI][4], u16* sA, u16* sB) {
  constexpr int BMT = MI * 64;
  const int tid = TIDX, lane = tid & 63, w = tid >> 6, wm = w >> 1, wn = w & 1, fr = lane & 15, fq = lane >> 4;
  uint4 ra[MI], rb[2];
  const u16* ga = A + (size_t)(tid >> 3) * lda + (tid & 7) * 8;
  const u16* gb = Bt + (size_t)(tid >> 3) * ldb + (tid & 7) * 8;
  const int so = (tid >> 3) * LDT + (tid & 7) * 8;
#pragma unroll
  for (int i = 0; i < MI; i++) ra[i] = *(const uint4*)(ga + (size_t)(i * 64) * lda);
#pragma unroll
  for (int i = 0; i < 2; i++) rb[i] = *(const uint4*)(gb + (size_t)(i * 64) * ldb);
#pragma unroll
  for (int i = 0; i < MI; i++) *(uint4*)(sA + so + i * 64 * LDT) = ra[i];
#pragma unroll
  for (int i = 0; i < 2; i++) *(uint4*)(sB + so + i * 64 * LDT) = rb[i];
  __syncthreads();
  const int nk = K >> 6;
  for (int kt = 0; kt < nk; kt++) {
    const bool more = kt + 1 < nk;
    if (more) {
#pragma unroll
      for (int i = 0; i < MI; i++) ra[i] = *(const uint4*)(ga + (size_t)(i * 64) * lda + (kt + 1) * 64);
#pragma unroll
      for (int i = 0; i < 2; i++) rb[i] = *(const uint4*)(gb + (size_t)(i * 64) * ldb + (kt + 1) * 64);
    }
    const u16* a = sA + (kt & 1) * BMT * LDT + (wm * (MI * 16) + fr) * LDT + fq * 8;
    const u16* b = sB + (kt & 1) * 128 * LDT + (wn * 64 + fr) * LDT + fq * 8;
#pragma unroll
    for (int ks = 0; ks < 2; ks++) {
      bf16x8 af[MI], bfr[4];
#pragma unroll
      for (int i = 0; i < MI; i++) af[i] = *(const bf16x8*)(a + i * 16 * LDT + ks * 32);
#pragma unroll
      for (int j = 0; j < 4; j++) bfr[j] = *(const bf16x8*)(b + j * 16 * LDT + ks * 32);
#pragma unroll
      for (int i = 0; i < MI; i++)
#pragma unroll
        for (int j = 0; j < 4; j++) acc[i][j] = __builtin_amdgcn_mfma_f32_16x16x32_bf16(bfr[j], af[i], acc[i][j], 0, 0, 0);
    }
    if (more) {
      u16* da = sA + ((kt + 1) & 1) * BMT * LDT + so;
      u16* db = sB + ((kt + 1) & 1) * 128 * LDT + so;
#pragma unroll
      for (int i = 0; i < MI; i++) *(uint4*)(da + i * 64 * LDT) = ra[i];
#pragma unroll
      for (int i = 0; i < 2; i++) *(uint4*)(db + i * 64 * LDT) = rb[i];
    }
    __syncthreads();
  }
}

template <int MI>
__device__ __forceinline__ void zero_acc(f32x4 (&acc)[MI][4]) {
#pragma unroll
  for (int i = 0; i < MI; i++)
#pragma unroll
    for (int j = 0; j < 4; j++) acc[i][j] = f32x4{0.f, 0.f, 0.f, 0.f};
}


typedef unsigned u32x4v __attribute__((ext_vector_type(4)));
__device__ __forceinline__ void yp_issue(const u16* __restrict__ A, const u16* __restrict__ B, u32x4v (&ra)[8], u32x4v (&rb)[8], int tid) {
#pragma unroll
  for (int i = 0; i < 8; i++) {
    const int c = tid + i * NTHR, row = c >> 5, ch = c & 31;
    ra[i] = *(const u32x4v*)(A + (size_t)row * YST + ch * 8);
    rb[i] = *(const u32x4v*)(B + (size_t)row * 256 + ch * 8);
  }
}
__device__ __forceinline__ void yp_stage(unsigned char* sA, unsigned char* sB, const u32x4v (&ra)[8], const u32x4v (&rb)[8], int tid) {
#pragma unroll
  for (int i = 0; i < 8; i++) {
    const int c = tid + i * NTHR, row = c >> 5, ch = c & 31;
    const int off = row * 512 + ((ch ^ (row & 7)) << 4);
    *(u32x4v*)(sA + off) = ra[i];
    *(u32x4v*)(sB + off) = rb[i];
  }
}
__device__ __forceinline__ void phase_ypart(const Params& p, int l, int hf, unsigned char* smem) {
  unsigned char* sA = smem;
  unsigned char* sB = smem + 65536;
  const int tid = TIDX, lane = tid & 63, w = tid >> 6, wm = w >> 1, wn = w & 1, fr = lane & 15, fq = lane >> 4;
  const u16* Y = (const u16*)(p.ws + OFF_YS);
  const u16* Wb = (const u16*)(p.ws + OFF_W + (size_t)l * SZ_WL + OW_B);
  const u16* G = (const u16*)(p.ws + OFF_BIG);
  u16* ACC = (u16*)(p.ws + OFF_BIG + 2 * SZ_ACT);
  constexpr int NT = 8;
  const int ntiles = (NROWS / 128) * NT;
  const int G_ = gridDim.x;
  const bool xmap = (G_ == 256);
  const int xj = blockIdx.x >> 3, xx = blockIdx.x & 7;
  const bool skipc = (l == 1);
  const int nrt = skipc ? 256 : 272;
  const int ntl = nrt * NT;
  const int nmine = xmap ? (xj < nrt ? (nrt - 1 - xj) / 32 + 1 : 0)
                         : (((int)blockIdx.x < ntl) ? (ntl - 1 - (int)blockIdx.x) / G_ + 1 : 0);
  if (nmine == 0) return;
#define YP_TILE(Q_, MT_, NT_)                                                        \
  do {                                                                               \
    if (xmap) { const int s_ = (Q_) * 32 + xj; MT_ = (s_ >> 3) * 8 + xx; NT_ = s_ & 7; } \
    else { const int t_ = blockIdx.x + (Q_) * G_; MT_ = t_ / NT; NT_ = t_ - MT_ * NT; }  \
    if (skipc) MT_ = (MT_ >> 5) * 34 + 2 + (MT_ & 31);                                   \
  } while (0)
  u32x4v ra[8], rb[8];
  {
    int mt, nt;
    YP_TILE(0, mt, nt);
    const int br = hf * 2, yc = br < 3 ? br * 256 : 1536;
    yp_issue(Y + (size_t)mt * 128 * YST + yc, Wb + ((size_t)br * 1024 + nt * 128) * 256, ra, rb, tid);
  }
  f32x4 tot[2][4];
  zero_acc<2>(tot);
  for (int qi = 0; qi < 2 * nmine; qi++) {
    const int q = qi >> 1, k = qi & 1;
    int mt, nt;
    YP_TILE(q, mt, nt);
    const int r0 = mt * 128 + wm * 32 + fr, c0 = nt * 128 + wn * 64 + fq * 4;
    __syncthreads();
    yp_stage(sA, sB, ra, rb, tid);
    __syncthreads();
    {
      const int qn = qi + 1 < 2 * nmine ? qi + 1 : qi;
      int mtn, ntn;
      YP_TILE(qn >> 1, mtn, ntn);
      const int brn = hf * 2 + (qn & 1), ycn = brn < 3 ? brn * 256 : 1536;
      yp_issue(Y + (size_t)mtn * 128 * YST + ycn, Wb + ((size_t)brn * 1024 + ntn * 128) * 256, ra, rb, tid);
    }
    uint2 gv[2][4];
#pragma unroll
    for (int i = 0; i < 2; i++)
#pragma unroll
      for (int j = 0; j < 4; j++) gv[i][j] = *(const uint2*)(G + (size_t)(r0 + i * 16) * 2048 + k * 1024 + c0 + j * 16);
    f32x4 ay[2][4];
    zero_acc<2>(ay);
#pragma unroll 2
    for (int ks = 0; ks < 8; ks++) {
      bf16x8 af[2], bfr[4];
#pragma unroll
      for (int i = 0; i < 2; i++) {
        const int row = wm * 32 + i * 16 + fr;
        af[i] = *(const bf16x8*)(sA + row * 512 + (((ks * 4 + fq) ^ (row & 7)) << 4));
      }
#pragma unroll
      for (int j = 0; j < 4; j++) {
        const int row = wn * 64 + j * 16 + fr;
        bfr[j] = *(const bf16x8*)(sB + row * 512 + (((ks * 4 + fq) ^ (row & 7)) << 4));
      }
#pragma unroll
      for (int i = 0; i < 2; i++)
#pragma unroll
        for (int j = 0; j < 4; j++) ay[i][j] = __builtin_amdgcn_mfma_f32_16x16x32_bf16(bfr[j], af[i], ay[i][j], 0, 0, 0);
    }
#pragma unroll
    for (int i = 0; i < 2; i++)
#pragma unroll
      for (int j = 0; j < 4; j++) {
        tot[i][j][0] += __uint_as_float(gv[i][j].x << 16) * ay[i][j][0];
        tot[i][j][1] += __uint_as_float(gv[i][j].x & 0xffff0000u) * ay[i][j][1];
        tot[i][j][2] += __uint_as_float(gv[i][j].y << 16) * ay[i][j][2];
        tot[i][j][3] += __uint_as_float(gv[i][j].y & 0xffff0000u) * ay[i][j][3];
      }
    if (k == 1) {
      const unsigned amask = hf ? 0xffffffffu : 0u;
      uint2 av[2][4];
#pragma unroll
      for (int i = 0; i < 2; i++)
#pragma unroll
        for (int j = 0; j < 4; j++) av[i][j] = *(const uint2*)(ACC + (size_t)(r0 + i * 16) * DM + c0 + j * 16);
#pragma unroll
      for (int i = 0; i < 2; i++)
#pragma unroll
        for (int j = 0; j < 4; j++) {
          u16* ap = ACC + (size_t)(r0 + i * 16) * DM + c0 + j * 16;
          f32x4 v = tot[i][j];
          const unsigned ax = av[i][j].x & amask, ay_ = av[i][j].y & amask;
          v[0] += __uint_as_float(ax << 16); v[1] += __uint_as_float(ax & 0xffff0000u);
          v[2] += __uint_as_float(ay_ << 16); v[3] += __uint_as_float(ay_ & 0xffff0000u);
          uint2 ov;
          ov.x = pack2(v[0], v[1]); ov.y = pack2(v[2], v[3]);
          *(uint2*)ap = ov;
        }
      zero_acc<2>(tot);
    }
  }
  __syncthreads();
#undef YP_TILE
}

#define S2_BUF 10816
#define S2_D 0
#define S2_U 2048
#define S2_P 4096
#define S2_K 6144
#define S2_DQ 8192
#define S2_V 10240
#define S2_C1 10752
#define S2_C2 10784
#define S2_ST (2 * S2_BUF)
#define S2_YB (S2_ST + 8192)

__device__ __forceinline__ float red16(float x) {
  x += dppf<0xB1>(x);
  x += dppf<0x4E>(x);
  x += dppf<0x141>(x);
  x += dppf<0x140>(x);
  return x;
}
__device__ __forceinline__ void wave_lds_sync() {
  asm volatile("s_waitcnt lgkmcnt(0)" ::: "memory");
  __builtin_amdgcn_wave_barrier();
}

template <int MIX>
__device__ __forceinline__ void scan2_item(const Params& p, int l, int b, int h, int dir, int rq, float* sm) {
  constexpr int EPL = (MIX == 2) ? 2 : 4;
  constexpr int VOFF = (MIX == 2) ? 64 : 128;
  const int tid = TIDX, lane = tid & 63, w = tid >> 6, fr = lane & 15, fq = lane >> 4;
  const bool producer = w >= 4;
  const int pw = w & 3;
  const u16* P = (const u16*)(p.ws + OFF_BIG);
  u16* YS = (u16*)(p.ws + OFF_YS);
  float* BC = (float*)(p.ws + OFF_BC);
  float* ST = sm + S2_ST + pw * 2048;
  float s[EPL];
#pragma unroll
  for (int i = 0; i < EPL; i++) s[i] = 0.f;

  bf16x8 bw2[4], ba2[4];
  float cst[5][4];
  float cw[3][7];
  float muv[4];
  int colv[4];
#pragma unroll
  for (int i = 0; i < 4; i++) { bw2[i] = bf16x8{0, 0, 0, 0, 0, 0, 0, 0}; ba2[i] = bw2[i]; muv[i] = 0.f; colv[i] = 0; }
  if (producer) {
    if (MIX == 0) {
#pragma unroll
      for (int nt = 0; nt < 4; nt++) {
        const int jch = h * 64 + nt * 16 + fr;
#pragma unroll
        for (int jj = 0; jj < 8; jj++) {
          bw2[nt][jj] = (short)f2bf(p.rwkv_w2[((size_t)(l * 2 + dir) * 32 + fq * 8 + jj) * 256 + jch]);
          ba2[nt][jj] = (short)f2bf(p.rwkv_a2[((size_t)(l * 2 + dir) * 32 + fq * 8 + jj) * 256 + jch]);
        }
        cst[0][nt] = p.rwkv_w0[(l * 2 + dir) * 256 + jch];
        cst[1][nt] = p.rwkv_a0[(l * 2 + dir) * 256 + jch];
        cst[2][nt] = p.rwkv_ka[l * 256 + jch];
        cst[3][nt] = p.rwkv_kk[l * 256 + jch];
        cst[4][nt] = p.rwkv_rk[l * 256 + jch];
      }
#pragma unroll
      for (int i = 0; i < 4; i++) {
        const int c = lane + 64 * i;
        colv[i] = i < 3 ? i * 256 + h * 64 + lane : (lane < 32 ? 768 + dir * 32 + lane : 832 + dir * 32 + (lane - 32));
        muv[i] = p.rwkv_mu[l * 960 + colv[i]];
        (void)c;
      }
    } else if (MIX == 1) {
#pragma unroll
      for (int i = 0; i < 3; i++) {
        colv[i] = PB + i * 256 + h * 64 + lane;
#pragma unroll
        for (int tp = 0; tp < 7; tp++) cw[i][tp] = p.gdn_conv[((size_t)l * 7 + tp) * 768 + i * 256 + h * 64 + lane];
      }
    } else {
#pragma unroll
      for (int nt = 0; nt < 2; nt++) {
#pragma unroll
        for (int jj = 0; jj < 8; jj++)
          bw2[nt][jj] = fq < 2 ? (short)f2bf(p.gla_gw2[((size_t)(l * 2 + dir) * 16 + fq * 8 + jj) * 128 + h * 32 + nt * 16 + fr]) : (short)0;
        cst[0][nt] = p.gla_gb[(l * 2 + dir) * 128 + h * 32 + nt * 16 + fr];
      }
      colv[0] = PC + h * 32 + lane;
      if (lane >= 32) colv[0] = PC + 128 + h * 32 + (lane - 32);
      colv[1] = PC + 256 + h * 64 + lane;
      colv[2] = PC + 512 + dir * 16 + (lane & 15);
    }
  }
  __syncthreads();

  for (int c = 0; c <= TPB / 32 + 1; c++) {
    if (producer) {
      if (c >= 2) {
        const int cc = c - 2;
        int seg_row0, t_lo;
        if (cc < 8) { seg_row0 = b * TPB; t_lo = dir == 0 ? cc * 32 : (LC - 32 - cc * 32); }
        else { seg_row0 = b * TPB + LC; t_lo = dir == 0 ? (cc - 8) * 32 : (SEQ - 32 - (cc - 8) * 32); }
        const float* yb = sm + S2_YB + (cc & 1) * 512;
        const int t2 = tid - 256;
#pragma unroll
        for (int i = 0; i < 2; i++) {
          const int idx = t2 + i * 256, tt = idx >> 4, e = idx & 15;
          YS[(size_t)(seg_row0 + t_lo + tt) * YST + dir * 768 + MIX * 256 + h * 64 + rq * 16 + e] = f2bf(yb[idx]);
        }
      }
      if (c < TPB / 32) {
        int seg_row0, seg_len, t_lo;
        if (c < 8) { seg_row0 = b * TPB; seg_len = LC; t_lo = dir == 0 ? c * 32 : (LC - 32 - c * 32); }
        else { seg_row0 = b * TPB + LC; seg_len = SEQ; t_lo = dir == 0 ? (c - 8) * 32 : (SEQ - 32 - (c - 8) * 32); }
        const u16* Pseg = P + (size_t)seg_row0 * PST;
        float* B = sm + (c & 1) * S2_BUF;
        const int t0 = t_lo + pw * 8;
        if (MIX == 0) {
          float raw[10][4];
#pragma unroll
          for (int rr = 0; rr < 10; rr++) {
            const int t = t0 - 1 + rr;
            const float okf = (t >= 0 && t < seg_len) ? 1.f : 0.f;
            const int tc = min(max(t, 0), seg_len - 1);
#pragma unroll
            for (int i = 0; i < 4; i++) raw[rr][i] = bf2f(Pseg[(size_t)tc * PST + PA + colv[i]]) * okf;
          }
#pragma unroll
          for (int j = 0; j < 8; j++)
#pragma unroll
            for (int i = 0; i < 4; i++) {
              float xm = raw[j + 1][i] + (0.5f * (raw[j][i] + raw[j + 2][i]) - raw[j + 1][i]) * muv[i];
              if (i == 3 && lane < 32) xm = tanh_fast(xm);
              ST[j * 256 + lane + 64 * i] = xm;
            }
        } else if (MIX == 1) {
          float raw[14][3];
#pragma unroll
          for (int rr = 0; rr < 14; rr++) {
            const int t = t0 - 3 + rr;
            const float okf = (t >= 0 && t < seg_len) ? 1.f : 0.f;
            const int tc = min(max(t, 0), seg_len - 1);
#pragma unroll
            for (int i = 0; i < 3; i++) raw[rr][i] = bf2f(Pseg[(size_t)tc * PST + colv[i]]) * okf;
          }
#pragma unroll
          for (int j = 0; j < 8; j++)
#pragma unroll
            for (int i = 0; i < 3; i++) {
              float a = 0.f;
#pragma unroll
              for (int tp = 0; tp < 7; tp++) a += raw[j + tp][i] * cw[i][tp];
              ST[j * 256 + lane + 64 * i] = siluf(a);
            }
          if (lane < 8) {
            const u16* pp = Pseg + (size_t)(t0 + lane) * PST + PB;
            float bx = bf2f(pp[768 + dir * 4 + h]);
            float ax = bf2f(pp[776 + dir * 4 + h]);
            float ld = -__expf(p.gdn_a_log[(l * 2 + dir) * 4 + h]) * softplusf(ax + p.gdn_dt_bias[(l * 2 + dir) * 4 + h]);
            ST[lane * 256 + 192] = sigm(bx);
            ST[lane * 256 + 193] = __expf(ld);
          }
        } else {
          u16 raw[8][3];
#pragma unroll
          for (int j = 0; j < 8; j++) {
            const u16* pp = Pseg + (size_t)(t0 + j) * PST;
#pragma unroll
            for (int i = 0; i < 3; i++) raw[j][i] = pp[colv[i]];
          }
          const float qs = lane < 32 ? 0.17677669529663687f : 1.f;
#pragma unroll
          for (int j = 0; j < 8; j++) {
            ST[j * 256 + lane] = bf2f(raw[j][0]) * qs;
            ST[j * 256 + 64 + lane] = bf2f(raw[j][1]);
            if (lane < 16) ST[j * 256 + 128 + lane] = bf2f(raw[j][2]);
          }
        }
        wave_lds_sync();
        const bool vl = fq < 2;
        if (MIX == 0) {
          bf16x8 aw, aa;
#pragma unroll
          for (int jj = 0; jj < 8; jj++) {
            aw[jj] = fr < 8 ? (short)f2bf(ST[fr * 256 + 192 + fq * 8 + jj]) : (short)0;
            aa[jj] = fr < 8 ? (short)f2bf(ST[fr * 256 + 224 + fq * 8 + jj]) : (short)0;
          }
          f32x4 accw[4], acca[4];
#pragma unroll
          for (int nt = 0; nt < 4; nt++) {
            accw[nt] = __builtin_amdgcn_mfma_f32_16x16x32_bf16(aw, bw2[nt], f32x4{0.f, 0.f, 0.f, 0.f}, 0, 0, 0);
            acca[nt] = __builtin_amdgcn_mfma_f32_16x16x32_bf16(aa, ba2[nt], f32x4{0.f, 0.f, 0.f, 0.f}, 0, 0, 0);
          }
#pragma unroll
          for (int r = 0; r < 4; r++) {
            const int j = (fq & 1) * 4 + r, tt = pw * 8 + j;
            float kkx[4], av[4], kdv[4], rv[4], dec[4];
            float ss = 0.f;
#pragma unroll
            for (int nt = 0; nt < 4; nt++) {
              const int n = nt * 16 + fr;
              rv[nt] = ST[j * 256 + n];
              const float kx = ST[j * 256 + 64 + n];
              dec[nt] = __expf(-0.6065306597126334f * sigm(cst[0][nt] + accw[nt][r]));
              av[nt] = sigm(cst[1][nt] + acca[nt][r]);
              kdv[nt] = kx * (1.f + (av[nt] - 1.f) * cst[2][nt]);
              kkx[nt] = kx * cst[3][nt];
              ss += kkx[nt] * kkx[nt];
            }
            ss = red16(ss);
            const float rs = rsq(ss + 1e-6f);
            float c1 = 0.f, c2 = 0.f, bc = 0.f;
#pragma unroll
            for (int nt = 0; nt < 4; nt++) {
              const int n = nt * 16 + fr;
              const float kk = kkx[nt] * rs;
              if (vl) {
                B[S2_D + tt * 64 + n] = dec[nt];
                B[S2_U + tt * 64 + n] = kk;
                B[S2_P + tt * 64 + n] = -kk * av[nt];
                B[S2_K + tt * 64 + n] = kdv[nt];
                B[S2_DQ + tt * 64 + n] = dec[nt] * rv[nt];
              }
              c1 += -kk * av[nt] * rv[nt];
              c2 += kdv[nt] * rv[nt];
              bc += rv[nt] * kdv[nt] * cst[4][nt];
            }
            c1 = red16(c1); c2 = red16(c2); bc = red16(bc);
            if (vl && fr == 0) {
              B[S2_C1 + tt] = c1;
              B[S2_C2 + tt] = c2;
              if (rq == 0) BC[(size_t)(seg_row0 + t_lo + tt) * 8 + h * 2 + dir] = bc;
            }
          }
        } else if (MIX == 1) {
#pragma unroll
          for (int r = 0; r < 4; r++) {
            const int j = (fq & 1) * 4 + r, tt = pw * 8 + j;
            float qv[4], kv[4];
            float sq = 0.f, sk = 0.f;
#pragma unroll
            for (int nt = 0; nt < 4; nt++) {
              const int n = nt * 16 + fr;
              qv[nt] = ST[j * 256 + n];
              kv[nt] = ST[j * 256 + 64 + n];
              sq += qv[nt] * qv[nt];
              sk += kv[nt] * kv[nt];
            }
            sq = red16(sq); sk = red16(sk);
            const float rq_ = rsq(sq + 1e-6f) * 0.125f, rk_ = rsq(sk + 1e-6f);
            const float beta = ST[j * 256 + 192], alpha = ST[j * 256 + 193];
            float dkq = 0.f;
#pragma unroll
            for (int nt = 0; nt < 4; nt++) {
              const int n = nt * 16 + fr;
              const float qn = qv[nt] * rq_, kn = kv[nt] * rk_;
              if (vl) {
                B[S2_D + tt * 64 + n] = alpha;
                B[S2_U + tt * 64 + n] = kn;
                B[S2_P + tt * 64 + n] = -alpha * beta * kn;
                B[S2_K + tt * 64 + n] = beta * kn;
                B[S2_DQ + tt * 64 + n] = alpha * qn;
              }
              dkq += kn * qn;
            }
            dkq = red16(dkq);
            if (vl && fr == 0) {
              B[S2_C1 + tt] = -alpha * beta * dkq;
              B[S2_C2 + tt] = beta * dkq;
            }
          }
        } else {
          bf16x8 ag;
#pragma unroll
          for (int jj = 0; jj < 8; jj++) ag[jj] = (fr < 8 && fq < 2) ? (short)f2bf(ST[fr * 256 + 128 + fq * 8 + jj]) : (short)0;
          f32x4 accg[2];
#pragma unroll
          for (int nt = 0; nt < 2; nt++) accg[nt] = __builtin_amdgcn_mfma_f32_16x16x32_bf16(ag, bw2[nt], f32x4{0.f, 0.f, 0.f, 0.f}, 0, 0, 0);
#pragma unroll
          for (int r = 0; r < 4; r++) {
            const int j = (fq & 1) * 4 + r, tt = pw * 8 + j;
            float dkq = 0.f;
#pragma unroll
            for (int nt = 0; nt < 2; nt++) {
              const int n = nt * 16 + fr;
              const float lg = cst[0][nt] + accg[nt][r];
              const float ls = fminf(lg, 0.f) - __logf(1.f + __expf(-fabsf(lg)));
              const float alpha = __expf(ls * (1.f / 16.f));
              const float qv = ST[j * 256 + n], kv = ST[j * 256 + 32 + n];
              if (vl) {
                B[S2_D + tt * 64 + n] = alpha;
                B[S2_K + tt * 64 + n] = kv;
                B[S2_DQ + tt * 64 + n] = alpha * qv;
              }
              dkq += kv * qv;
            }
            dkq = red16(dkq);
            if (vl && fr == 0) B[S2_C2 + tt] = dkq;
          }
        }
#pragma unroll
        for (int i = 0; i < 2; i++) {
          const int idx = lane + 64 * i, j = idx >> 4, e = idx & 15;
          B[S2_V + (pw * 8 + j) * 16 + e] = ST[j * 256 + VOFF + rq * 16 + e];
        }
      }
    } else if (c >= 1 && c <= TPB / 32) {
      const float* B = sm + ((c - 1) & 1) * S2_BUF;
      float* yb = sm + S2_YB + ((c - 1) & 1) * 512;
      const int rl = w * 4 + fq;
      const int dtt = dir ? -1 : 1;
      int tt = dir ? 31 : 0;
      float dv[EPL], kv[EPL], qv[EPL], uv[EPL], pv[EPL], vv, c1v, c2v;
      float dn[EPL], kn[EPL], qn[EPL], un[EPL], pn[EPL], vn, c1n, c2n;
#define S2_LOAD(D_, K_, Q_, U_, P_, V_, C1_, C2_, T_)                                   \
  do {                                                                                  \
    const int o_ = (T_) * 64 + fr * EPL;                                                \
    if (EPL == 4) {                                                                     \
      float4 t4 = *(const float4*)(B + S2_D + o_);                                      \
      D_[0] = t4.x; D_[1] = t4.y; D_[2] = t4.z; D_[3] = t4.w;                           \
      t4 = *(const float4*)(B + S2_K + o_);                                             \
      K_[0] = t4.x; K_[1] = t4.y; K_[2] = t4.z; K_[3] = t4.w;                           \
      t4 = *(const float4*)(B + S2_DQ + o_);                                            \
      Q_[0] = t4.x; Q_[1] = t4.y; Q_[2] = t4.z; Q_[3] = t4.w;                           \
      t4 = *(const float4*)(B + S2_U + o_);                                             \
      U_[0] = t4.x; U_[1] = t4.y; U_[2] = t4.z; U_[3] = t4.w;                           \
      t4 = *(const float4*)(B + S2_P + o_);                                             \
      P_[0] = t4.x; P_[1] = t4.y; P_[2] = t4.z; P_[3] = t4.w;                           \
      C1_ = B[S2_C1 + (T_)];                                                            \
    } else {                                                                            \
      float2 t2 = *(const float2*)(B + S2_D + o_);                                      \
      D_[0] = t2.x; D_[1] = t2.y;                                                       \
      t2 = *(const float2*)(B + S2_K + o_);                                             \
      K_[0] = t2.x; K_[1] = t2.y;                                                       \
      t2 = *(const float2*)(B + S2_DQ + o_);                                            \
      Q_[0] = t2.x; Q_[1] = t2.y;                                                       \
      U_[0] = U_[1] = P_[0] = P_[1] = 0.f; C1_ = 0.f;                                   \
    }                                                                                   \
    V_ = B[S2_V + (T_) * 16 + rl];                                                      \
    C2_ = B[S2_C2 + (T_)];                                                              \
  } while (0)
#define S2_STEP(D_, K_, Q_, U_, P_, V_, C1_, C2_, T_)                                   \
  do {                                                                                  \
    float sq = 0.f, sa = 0.f;                                                           \
    _Pragma("unroll") for (int i = 0; i < EPL; i++) sq += s[i] * Q_[i];                 \
    if (MIX != 2) {                                                                     \
      _Pragma("unroll") for (int i = 0; i < EPL; i++) sa += s[i] * U_[i];               \
      sa = red16(sa);                                                                   \
    }                                                                                   \
    sq = red16(sq);                                                                     \
    float y = sq + V_ * C2_;                                                            \
    if (MIX != 2) y += sa * C1_;                                                        \
    _Pragma("unroll") for (int i = 0; i < EPL; i++) {                                   \
      float t = s[i] * D_[i] + V_ * K_[i];                                              \
      if (MIX != 2) t += sa * P_[i];                                                    \
      s[i] = t;                                                                         \
    }                                                                                   \
    yb[(T_) * 16 + rl] = y;                                                             \
  } while (0)
      S2_LOAD(dv, kv, qv, uv, pv, vv, c1v, c2v, tt);
#pragma unroll 1
      for (int st = 0; st < 32; st += 2) {
        const int t1 = tt + dtt;
        S2_LOAD(dn, kn, qn, un, pn, vn, c1n, c2n, t1);
        S2_STEP(dv, kv, qv, uv, pv, vv, c1v, c2v, tt);
        const int t2 = st + 2 < 32 ? t1 + dtt : t1;
        S2_LOAD(dv, kv, qv, uv, pv, vv, c1v, c2v, t2);
        S2_STEP(dn, kn, qn, un, pn, vn, c1n, c2n, t1);
        tt = t2;
      }
#undef S2_LOAD
#undef S2_STEP
    }
    __syncthreads();
  }
}

#define S3_SUB 12800
#define S3_GM 0
#define S3_KVT 9216
#define S3_QB 10240
#define S3_QV 11392
#define S3_VT 11520
#define S3_WC 12544
#define S3_STB (8 * S3_SUB)
#define S3_END (S3_STB + 4 * 2304)

__device__ __forceinline__ float rlane(float x, int l) { return __int_as_float(__builtin_amdgcn_readlane(__float_as_int(x), l)); }
__device__ __forceinline__ float wave_sum(float x) {
  x = red16(x);
  return (rlane(x, 0) + rlane(x, 16)) + (rlane(x, 32) + rlane(x, 48));
}
__device__ __forceinline__ float clampe(float x) { return fminf(fmaxf(x, -80.f), 80.f); }
__device__ __forceinline__ uint4 pack8(const float (&v)[8]) {
  return make_uint4(pack2(v[0], v[1]), pack2(v[2], v[3]), pack2(v[4], v[5]), pack2(v[6], v[7]));
}
__device__ __forceinline__ bf16x8 ld_frag(const void* p) { return *(const bf16x8*)p; }
__device__ __forceinline__ bf16x8 zfrag() { return bf16x8{0, 0, 0, 0, 0, 0, 0, 0}; }

__device__ __forceinline__ void chunk_geom(int c, int dir, int b, int& seg_row0, int& seg_len, int& t_lo) {
  if (c < 8) { seg_row0 = b * TPB; seg_len = LC; t_lo = dir == 0 ? c * 32 : (LC - 32 - c * 32); }
  else { seg_row0 = b * TPB + LC; seg_len = SEQ; t_lo = dir == 0 ? (c - 8) * 32 : (SEQ - 32 - (c - 8) * 32); }
}
template <int MIX>
__device__ __forceinline__ void fetch_raw(const u16* P, int c, int dir, int b, int h, int pw, int lane, const int (&colv)[4], unsigned (&rawq)[14][2]) {
  int seg_row0, seg_len, t_lo;
  chunk_geom(c, dir, b, seg_row0, seg_len, t_lo);
  const u16* Pseg = P + (size_t)seg_row0 * PST;
  const int t0 = t_lo + pw * 8;
  if (MIX == 0) {
#pragma unroll
    for (int rr = 0; rr < 10; rr++) {
      const int tc = min(max(t0 - 1 + rr, 0), seg_len - 1);
#pragma unroll
      for (int i = 0; i < 2; i++)
        rawq[rr][i] = (unsigned)Pseg[(size_t)tc * PST + PA + colv[2 * i]] | ((unsigned)Pseg[(size_t)tc * PST + PA + colv[2 * i + 1]] << 16);
    }
  } else if (MIX == 1) {
#pragma unroll
    for (int rr = 0; rr < 14; rr++) {
      const int tc = min(max(t0 - 3 + rr, 0), seg_len - 1);
      rawq[rr][0] = (unsigned)Pseg[(size_t)tc * PST + colv[0]] | ((unsigned)Pseg[(size_t)tc * PST + colv[1]] << 16);
      rawq[rr][1] = (rawq[rr][1] & 0xffff0000u) | (unsigned)Pseg[(size_t)tc * PST + colv[2]];
    }
    const u16* pp = Pseg + (size_t)(t0 + (lane & 7)) * PST + PB;
    rawq[0][1] = (rawq[0][1] & 0xffffu) | ((unsigned)pp[768 + dir * 4 + h] << 16);
    rawq[1][1] = (rawq[1][1] & 0xffffu) | ((unsigned)pp[776 + dir * 4 + h] << 16);
  } else {
#pragma unroll
    for (int j = 0; j < 8; j++) {
      const u16* pp = Pseg + (size_t)(t0 + j) * PST;
      rawq[j][0] = (unsigned)pp[colv[0]] | ((unsigned)pp[colv[1]] << 16);
      rawq[j][1] = (unsigned)pp[colv[2]];
    }
  }
}

template <int MIX>
__device__ __forceinline__ void scan3_item(const Params& p, int l, int b, int h, int dir, unsigned char* smb) {
  constexpr int VOFF = (MIX == 2) ? 64 : 128;
  constexpr bool DELTA = (MIX != 2);
  const int tid = TIDX, lane = tid & 63, w = tid >> 6, fr = lane & 15, fq = lane >> 4;
  const bool producer = true;
  const int pw = w & 3, half = w >> 2;
  const u16* P = (const u16*)(p.ws + OFF_BIG);
  u16* YS = (u16*)(p.ws + OFF_YS);
  float* BC = (float*)(p.ws + OFF_BC);
  float* ST = (float*)(smb + w * S3_SUB + S3_GM);
  unsigned char* STBY = smb + w * S3_SUB + S3_GM;
  const f32x4 z4 = f32x4{0.f, 0.f, 0.f, 0.f};
  f32x4 st[4];
#pragma unroll
  for (int i = 0; i < 4; i++) st[i] = z4;

  bf16x8 bw2[4], ba2[4];
  float cw[3][7];
  float muv[4];
  int colv[4];
  float c_w0 = 0.f, c_a0 = 0.f, c_ka = 0.f, c_kk = 0.f, c_rk = 0.f, c_gb = 0.f;
#pragma unroll
  for (int i = 0; i < 4; i++) { bw2[i] = zfrag(); ba2[i] = zfrag(); muv[i] = 0.f; colv[i] = 0; }
  if (producer) {
    if (MIX == 0) {
#pragma unroll
      for (int nt = 0; nt < 4; nt++) {
        const int jch = h * 64 + nt * 16 + fr;
#pragma unroll
        for (int jj = 0; jj < 8; jj++) {
          bw2[nt][jj] = (short)f2bf(p.rwkv_w2[((size_t)(l * 2 + dir) * 32 + fq * 8 + jj) * 256 + jch]);
          ba2[nt][jj] = (short)f2bf(p.rwkv_a2[((size_t)(l * 2 + dir) * 32 + fq * 8 + jj) * 256 + jch]);
        }
      }
      const int jl = h * 64 + lane;
      c_w0 = p.rwkv_w0[(l * 2 + dir) * 256 + jl];
      c_a0 = p.rwkv_a0[(l * 2 + dir) * 256 + jl];
      c_ka = p.rwkv_ka[l * 256 + jl];
      c_kk = p.rwkv_kk[l * 256 + jl];
      c_rk = p.rwkv_rk[l * 256 + jl];
#pragma unroll
      for (int i = 0; i < 4; i++) {
        colv[i] = i < 3 ? i * 256 + h * 64 + lane : (lane < 32 ? 768 + dir * 32 + lane : 832 + dir * 32 + (lane - 32));
        muv[i] = p.rwkv_mu[l * 960 + colv[i]];
      }
    } else if (MIX == 1) {
#pragma unroll
      for (int i = 0; i < 3; i++) {
        colv[i] = PB + i * 256 + h * 64 + lane;
#pragma unroll
        for (int tp = 0; tp < 7; tp++) cw[i][tp] = p.gdn_conv[((size_t)l * 7 + tp) * 768 + i * 256 + h * 64 + lane];
      }
    } else {
#pragma unroll
      for (int nt = 0; nt < 2; nt++) {
#pragma unroll
        for (int jj = 0; jj < 8; jj++)
          bw2[nt][jj] = fq < 2 ? (short)f2bf(p.gla_gw2[((size_t)(l * 2 + dir) * 16 + fq * 8 + jj) * 128 + h * 32 + nt * 16 + fr]) : (short)0;
      }
      c_gb = p.gla_gb[(l * 2 + dir) * 128 + h * 32 + (lane & 31)];
      colv[0] = PC + h * 32 + lane;
      if (lane >= 32) colv[0] = PC + 128 + h * 32 + (lane - 32);
      colv[1] = PC + 256 + h * 64 + lane;
      colv[2] = PC + 512 + dir * 16 + (lane & 15);
    }
  }
  __syncthreads();
  unsigned rawq[14][2];
#pragma unroll
  for (int i = 0; i < 14; i++) { rawq[i][0] = 0u; rawq[i][1] = 0u; }
  fetch_raw<MIX>(P, half, dir, b, h, pw, lane, colv, rawq);
#define RAWP(r_, i_) ((u16)((rawq[r_][(i_) >> 1] >> (((i_) & 1) * 16)) & 0xffffu))

  for (int it = 0; it < TPB / 64; it++) {
    {
      {
        const int c = it * 2 + half;
        int seg_row0, seg_len, t_lo;
        chunk_geom(c, dir, b, seg_row0, seg_len, t_lo);
        unsigned char* SB = smb + w * S3_SUB;
        const int t0 = t_lo + pw * 8;
        if (MIX == 0) {
          float raw[10][4];
#pragma unroll
          for (int rr = 0; rr < 10; rr++) {
            const int t = t0 - 1 + rr;
            const float okf = (t >= 0 && t < seg_len) ? 1.f : 0.f;
#pragma unroll
            for (int i = 0; i < 4; i++) raw[rr][i] = bf2f(RAWP(rr, i)) * okf;
          }
#pragma unroll
          for (int j = 0; j < 8; j++)
#pragma unroll
            for (int i = 0; i < 4; i++) {
              float xm = raw[j + 1][i] + (0.5f * (raw[j][i] + raw[j + 2][i]) - raw[j + 1][i]) * muv[i];
              if (i == 3 && lane < 32) xm = tanh_fast(xm);
              ST[j * 256 + lane + 64 * i] = xm;
            }
        } else if (MIX == 1) {
          float raw[14][3];
#pragma unroll
          for (int rr = 0; rr < 14; rr++) {
            const int t = t0 - 3 + rr;
            const float okf = (t >= 0 && t < seg_len) ? 1.f : 0.f;
#pragma unroll
            for (int i = 0; i < 3; i++) raw[rr][i] = bf2f(RAWP(rr, i)) * okf;
          }
#pragma unroll
          for (int j = 0; j < 8; j++)
#pragma unroll
            for (int i = 0; i < 3; i++) {
              float a = 0.f;
#pragma unroll
              for (int tp = 0; tp < 7; tp++) a += raw[j + tp][i] * cw[i][tp];
              ST[j * 256 + lane + 64 * i] = siluf(a);
            }
          if (lane < 8) {
            float bx = bf2f(RAWP(0, 3));
            float ax = bf2f(RAWP(1, 3));
            float ld = -__expf(p.gdn_a_log[(l * 2 + dir) * 4 + h]) * softplusf(ax + p.gdn_dt_bias[(l * 2 + dir) * 4 + h]);
            ST[lane * 256 + 192] = sigm(bx);
            ST[lane * 256 + 193] = ld;
          }
        } else {
          const float qs = lane < 32 ? 0.17677669529663687f : 1.f;
#pragma unroll
          for (int j = 0; j < 8; j++) {
            ST[j * 256 + lane] = bf2f(RAWP(j, 0)) * qs;
            ST[j * 256 + 64 + lane] = bf2f(RAWP(j, 1));
            if (lane < 16) ST[j * 256 + 128 + lane] = bf2f(RAWP(j, 2));
          }
        }
        wave_lds_sync();
        {
          float vv[8];
#pragma unroll
          for (int i = 0; i < 8; i++) vv[i] = ST[(dir ? 7 - i : i) * 256 + VOFF + lane];
          *(uint4*)(SB + S3_VT + lane * 16) = pack8(vv);
        }
        if (MIX == 0) {
          bf16x8 aw, aa;
#pragma unroll
          for (int jj = 0; jj < 8; jj++) {
            aw[jj] = fr < 8 ? (short)f2bf(ST[fr * 256 + 192 + fq * 8 + jj]) : (short)0;
            aa[jj] = fr < 8 ? (short)f2bf(ST[fr * 256 + 224 + fq * 8 + jj]) : (short)0;
          }
          f32x4 accw[4], acca[4];
#pragma unroll
          for (int nt = 0; nt < 4; nt++) {
            accw[nt] = __builtin_amdgcn_mfma_f32_16x16x32_bf16(aw, bw2[nt], z4, 0, 0, 0);
            acca[nt] = __builtin_amdgcn_mfma_f32_16x16x32_bf16(aa, ba2[nt], z4, 0, 0, 0);
          }
          wave_lds_sync();
          if (fq < 2) {
#pragma unroll
            for (int nt = 0; nt < 4; nt++)
#pragma unroll
              for (int r = 0; r < 4; r++) {
                ST[(fq * 4 + r) * 256 + 128 + nt * 16 + fr] = accw[nt][r];
                ST[(fq * 4 + r) * 256 + 192 + nt * 16 + fr] = acca[nt][r];
              }
          }
          wave_lds_sync();
        } else if (MIX == 2) {
          bf16x8 ag;
#pragma unroll
          for (int jj = 0; jj < 8; jj++) ag[jj] = (fr < 8 && fq < 2) ? (short)f2bf(ST[fr * 256 + 128 + fq * 8 + jj]) : (short)0;
          f32x4 accg[2];
#pragma unroll
          for (int nt = 0; nt < 2; nt++) accg[nt] = __builtin_amdgcn_mfma_f32_16x16x32_bf16(ag, bw2[nt], z4, 0, 0, 0);
          if (fq < 2) {
#pragma unroll
            for (int nt = 0; nt < 2; nt++)
#pragma unroll
              for (int r = 0; r < 4; r++) ST[(fq * 4 + r) * 256 + 192 + nt * 16 + fr] = accg[nt][r];
          }
          wave_lds_sync();
        }
        float logd[8], kap[8], bb[8], kp[8], qq[8];
        if (MIX == 0) {
          float a8[8], p1[8], p2[8];
#pragma unroll
          for (int i = 0; i < 8; i++) {
            const float* row = ST + (dir ? 7 - i : i) * 256;
            const float r_ = row[lane], k_ = row[64 + lane];
            const float sg = sigm(c_w0 + row[128 + lane]);
            a8[i] = sigm(c_a0 + row[192 + lane]);
            kp[i] = k_ * (1.f + (a8[i] - 1.f) * c_ka);
            kap[i] = k_ * c_kk;
            qq[i] = r_;
            logd[i] = -0.6065306597126334f * sg;
            p1[i] = kap[i] * kap[i];
            p2[i] = r_ * kp[i] * c_rk;
          }
#pragma unroll
          for (int i = 0; i < 8; i++) { p1[i] = red16(p1[i]); p2[i] = red16(p2[i]); }
#pragma unroll
          for (int i = 0; i < 8; i++) {
            const float ss = (rlane(p1[i], 0) + rlane(p1[i], 16)) + (rlane(p1[i], 32) + rlane(p1[i], 48));
            const float bc = (rlane(p2[i], 0) + rlane(p2[i], 16)) + (rlane(p2[i], 32) + rlane(p2[i], 48));
            kap[i] *= rsq(ss + 1e-6f);
            bb[i] = kap[i] * a8[i];
            if (lane == 0) BC[(size_t)(seg_row0 + t0 + (dir ? 7 - i : i)) * 8 + h * 2 + dir] = bc;
          }
        } else {
#pragma unroll
        for (int i = 0; i < 8; i++) {
          const int j = dir ? 7 - i : i;
          const float* row = ST + j * 256;
          if (MIX == 1) {
            const float q_ = row[lane], k_ = row[64 + lane];
            const float sq = wave_sum(q_ * q_), sk = wave_sum(k_ * k_);
            const float qn = q_ * rsq(sq + 1e-6f) * 0.125f, kn = k_ * rsq(sk + 1e-6f);
            const float beta = row[192], ld = row[193];
            const float alpha = __expf(ld);
            logd[i] = ld;
            kap[i] = kn; bb[i] = alpha * beta * kn; kp[i] = beta * kn; qq[i] = qn;
          } else {
            const int n = lane & 31;
            const float lg = c_gb + row[192 + n];
            const float ls = fminf(lg, 0.f) - __logf(1.f + __expf(-fabsf(lg)));
            logd[i] = ls * (1.f / 16.f);
            kap[i] = 0.f; bb[i] = 0.f;
            kp[i] = lane < 32 ? row[32 + n] : 0.f;
            qq[i] = lane < 32 ? row[n] : 0.f;
          }
        }
        }
        wave_lds_sync();
        float kt[8], qt[8], bck[8], kck[8];
        {
          float L[8];
          float run = 0.f;
#pragma unroll
          for (int i = 0; i < 8; i++) { run += logd[i]; L[i] = run; }
          const float Lr = L[3], L7 = L[7];
          float prevE = __expf(clampe(-Lr)), prevT = 1.f;
          u16* OPA = (u16*)STBY;
#pragma unroll
          for (int i = 0; i < 8; i++) {
            const float eI = __expf(clampe(L[i] - Lr)), eInv = __expf(clampe(Lr - L[i]));
            const float tI = __expf(L[i]), eEnd = __expf(L7 - L[i]);
            if (DELTA) {
              OPA[0 * 576 + i * 72 + lane] = f2bf(kap[i] * prevE);
              OPA[1 * 576 + i * 72 + lane] = f2bf(bb[i] * eInv);
            }
            OPA[2 * 576 + i * 72 + lane] = f2bf(kp[i] * eInv);
            OPA[3 * 576 + i * 72 + lane] = f2bf(qq[i] * eI);
            kt[i] = kap[i] * prevT; qt[i] = qq[i] * tI;
            bck[i] = bb[i] * eEnd; kck[i] = kp[i] * eEnd;
            prevE = eI; prevT = tI;
          }
          *(float*)(SB + S3_WC + lane * 4) = __expf(L7);
        }
        wave_lds_sync();
        f32x4 accA = z4, accBm = z4, accQb = z4, accQk = z4;
        {
          const u16* OPA = (const u16*)STBY;
          const int ro = (fr & 7) * 72 + fq * 8;
#pragma unroll
          for (int ks = 0; ks < 2; ks++) {
            const bf16x8 fk = ld_frag(OPA + 2 * 576 + ro + ks * 32), fqh = ld_frag(OPA + 3 * 576 + ro + ks * 32);
            accQk = __builtin_amdgcn_mfma_f32_16x16x32_bf16(fqh, fk, accQk, 0, 0, 0);
            if (DELTA) {
              const bf16x8 fka = ld_frag(OPA + 0 * 576 + ro + ks * 32), fb = ld_frag(OPA + 1 * 576 + ro + ks * 32);
              accA = __builtin_amdgcn_mfma_f32_16x16x32_bf16(fka, fb, accA, 0, 0, 0);
              accBm = __builtin_amdgcn_mfma_f32_16x16x32_bf16(fka, fk, accBm, 0, 0, 0);
              accQb = __builtin_amdgcn_mfma_f32_16x16x32_bf16(fqh, fb, accQb, 0, 0, 0);
            }
          }
#pragma unroll
          for (int r = 0; r < 4; r++) {
            const int i = fq * 4 + r;
            const bool ok = fq < 2 && fr < 8;
            if (!(ok && fr < i)) { accA[r] = 0.f; accBm[r] = 0.f; }
            if (!(ok && fr <= i)) { accQb[r] = 0.f; accQk[r] = 0.f; }
          }
        }
        float bmc[8], qkc[8];
#pragma unroll
        for (int m = 0; m < 4; m++) {
          bmc[m] = accBm[m]; qkc[m] = accQk[m];
          bmc[m + 4] = __shfl(accBm[m], (lane & 15) + 16);
          qkc[m + 4] = __shfl(accQk[m], (lane & 15) + 16);
        }
        float kbar[8], qbar[8], Kv[8], TB[8], Qv[8];
        if (DELTA) {
          float t[8];
#pragma unroll
          for (int i = 0; i < 8; i++) {
            float ti = (lane == i) ? 1.f : 0.f;
#pragma unroll
            for (int m = 0; m < i; m++) ti -= rlane(accA[i & 3], (i >> 2) * 16 + m) * t[m];
            t[i] = ti;
          }
#pragma unroll
          for (int i = 0; i < 8; i++) {
            float tb = 0.f, kb = 0.f;
#pragma unroll
            for (int m = 0; m <= i; m++) {
              const float tim = rlane(t[i], m);
              tb += tim * bmc[m];
              kb += tim * kt[m];
            }
            TB[i] = tb; kbar[i] = kb;
            float qv = qkc[i], qb = qt[i];
#pragma unroll
            for (int m = 0; m <= i; m++) {
              const float qbim = rlane(accQb[i & 3], (i >> 2) * 16 + m);
              qv -= qbim * TB[m];
              qb -= qbim * kbar[m];
            }
            Qv[i] = qv; qbar[i] = qb;
          }
#pragma unroll
          for (int j = 0; j < 8; j++) Kv[j] = kck[j];
#pragma unroll
          for (int i = 1; i < 8; i++)
#pragma unroll
            for (int j = 0; j < i; j++) Kv[j] -= rlane(TB[i], j) * bck[i];
        } else {
#pragma unroll
          for (int i = 0; i < 8; i++) { Qv[i] = qkc[i]; qbar[i] = qt[i]; Kv[i] = kck[i]; kbar[i] = 0.f; TB[i] = 0.f; }
        }
        *(uint4*)(SB + S3_KVT + lane * 16) = pack8(Kv);
#pragma unroll
        for (int i = 0; i < 8; i++) ((u16*)(SB + S3_QB))[i * 72 + lane] = f2bf(qbar[i]);
        if (lane < 8) {
#pragma unroll
          for (int i = 0; i < 8; i++) ((u16*)(SB + S3_QV))[i * 8 + lane] = f2bf(Qv[i]);
        }
        if (DELTA) {
          float nk[8];
#pragma unroll
          for (int i = 0; i < 8; i++) nk[i] = -kbar[i];
          *(uint4*)(STBY + 4608 + lane * 16) = pack8(bck);
          *(uint4*)(STBY + 5632 + lane * 16) = pack8(nk);
          wave_lds_sync();
          bf16x8 fa[4], fb[4];
#pragma unroll
          for (int x = 0; x < 4; x++) {
            fa[x] = fq == 0 ? ld_frag(STBY + 5632 + (x * 16 + fr) * 16) : zfrag();
            fb[x] = fq == 0 ? ld_frag(STBY + 4608 + (x * 16 + fr) * 16) : zfrag();
          }
#pragma unroll
          for (int nt = 0; nt < 4; nt++)
#pragma unroll
            for (int mt = 0; mt < 4; mt++) {
              const f32x4 g = __builtin_amdgcn_mfma_f32_16x16x32_bf16(fa[mt], fb[nt], z4, 0, 0, 0);
              uint2 gv;
              gv.x = pack2(g[0], g[1]); gv.y = pack2(g[2], g[3]);
              *(uint2*)(SB + S3_GM + ((nt * 16 + fr) * 72 + mt * 16 + fq * 4) * 2) = gv;
            }
        }
      }
    }
    fetch_raw<MIX>(P, min(it + 1, TPB / 64 - 1) * 2 + half, dir, b, h, pw, lane, colv, rawq);
    __syncthreads();
    if (w < 4) {
      unsigned char* STB = smb + S3_STB + w * 2304;
#pragma unroll 2
      for (int kk = 0; kk < 8; kk++) {
        const int cc = it * 2 + (kk >> 2), k = kk & 3;
        int seg_row0, t_lo;
        if (cc < 8) { seg_row0 = b * TPB; t_lo = dir == 0 ? cc * 32 : (LC - 32 - cc * 32); }
        else { seg_row0 = b * TPB + LC; t_lo = dir == 0 ? (cc - 8) * 32 : (SEQ - 32 - (cc - 8) * 32); }
        const int sc = dir ? 3 - k : k;
        const unsigned char* SB = smb + ((kk >> 2) * 4 + sc) * S3_SUB;
#pragma unroll
        for (int nt = 0; nt < 4; nt++) {
          uint2 sv;
          sv.x = pack2(st[nt][0], st[nt][1]); sv.y = pack2(st[nt][2], st[nt][3]);
          *(uint2*)(STB + (fr * 72 + nt * 16 + fq * 4) * 2) = sv;
        }
        wave_lds_sync();
        const bf16x8 bs0 = ld_frag(STB + (fr * 72 + fq * 8) * 2), bs1 = ld_frag(STB + (fr * 72 + 32 + fq * 8) * 2);
        const bf16x8 bv = fq == 0 ? ld_frag(SB + S3_VT + (w * 16 + fr) * 16) : zfrag();
        const bf16x8 aq0 = ld_frag(SB + S3_QB + ((fr & 7) * 72 + fq * 8) * 2), aq1 = ld_frag(SB + S3_QB + ((fr & 7) * 72 + 32 + fq * 8) * 2);
        const bf16x8 aqv = fq == 0 ? ld_frag(SB + S3_QV + (fr & 7) * 16) : zfrag();
        f32x4 accY = __builtin_amdgcn_mfma_f32_16x16x32_bf16(aq0, bs0, z4, 0, 0, 0);
        accY = __builtin_amdgcn_mfma_f32_16x16x32_bf16(aq1, bs1, accY, 0, 0, 0);
        accY = __builtin_amdgcn_mfma_f32_16x16x32_bf16(aqv, bv, accY, 0, 0, 0);
        if (fq < 2) {
#pragma unroll
          for (int r = 0; r < 4; r++) {
            const int i = fq * 4 + r, j = dir ? 7 - i : i;
            YS[(size_t)(seg_row0 + t_lo + sc * 8 + j) * YST + dir * 768 + MIX * 256 + h * 64 + w * 16 + fr] = f2bf(accY[r]);
          }
        }
#pragma unroll
        for (int nt = 0; nt < 4; nt++) {
          f32x4 an = z4;
          if (DELTA) {
            const bf16x8 g0 = ld_frag(SB + S3_GM + ((nt * 16 + fr) * 72 + fq * 8) * 2), g1 = ld_frag(SB + S3_GM + ((nt * 16 + fr) * 72 + 32 + fq * 8) * 2);
            an = __builtin_amdgcn_mfma_f32_16x16x32_bf16(g0, bs0, an, 0, 0, 0);
            an = __builtin_amdgcn_mfma_f32_16x16x32_bf16(g1, bs1, an, 0, 0, 0);
          }
          const bf16x8 akv = fq == 0 ? ld_frag(SB + S3_KVT + (nt * 16 + fr) * 16) : zfrag();
          an = __builtin_amdgcn_mfma_f32_16x16x32_bf16(akv, bv, an, 0, 0, 0);
          const float4 wc = *(const float4*)(SB + S3_WC + (nt * 16 + fq * 4) * 4);
          st[nt][0] = st[nt][0] * wc.x + an[0];
          st[nt][1] = st[nt][1] * wc.y + an[1];
          st[nt][2] = st[nt][2] * wc.z + an[2];
          st[nt][3] = st[nt][3] * wc.w + an[3];
        }
      }
    }
    __syncthreads();
  }
}

__device__ __forceinline__ void attn_item(const Params& p, int l, int b, int qb, int hk, bool isctx, unsigned char* smem) {
  u16* KS = (u16*)smem;
  u16* VT = KS + 64 * LDT;
  u16* PL = VT + 64 * LDT;
  float2* ROPE = (float2*)(PL + 8 * 32 * LDT);
  const int tid = TIDX, lane = tid & 63, w = tid >> 6, fr = lane & 15, fq = lane >> 4;
  const u16* P = (const u16*)(p.ws + OFF_BIG);
  u16* Y = (u16*)(p.ws + OFF_YS);
  const int qh = hk * 2 + (w >> 2);
  const int tb = qb * 128 + (w & 3) * 32;
  const int qrow0 = b * TPB + (isctx ? 0 : LC);
  __syncthreads();
  for (int i = tid; i < 1024; i += NTHR) {
    int pos = i >> 4, fi = i & 15;
    float inv = powf(10000.f, -(float)fi / 16.f);
    float sn, cs;
    sincosf((float)pos * inv, &sn, &cs);
    ROPE[i] = make_float2(cs, sn);
  }
  __syncthreads();
  bf16x8 qf[2][2];
#pragma unroll
  for (int mi = 0; mi < 2; mi++)
#pragma unroll
    for (int ks = 0; ks < 2; ks++) {
      const int tq = tb + mi * 16 + fr;
      const u16* qp = P + (size_t)(qrow0 + tq) * PST + PD + qh * 64 + ks * 32;
      uint4 own = *(const uint4*)(qp + fq * 8);
      uint4 par = *(const uint4*)(qp + (fq ^ 2) * 8);
      const unsigned ow[4] = {own.x, own.y, own.z, own.w};
      const unsigned pw[4] = {par.x, par.y, par.z, par.w};
      const int pos = ks == 0 ? (tq >> 6) : (tq & 63);
      bf16x8 f;
#pragma unroll
      for (int jj = 0; jj < 8; jj++) {
        float xo = bf2f((u16)((ow[jj >> 1] >> ((jj & 1) * 16)) & 0xffff));
        float xp = bf2f((u16)((pw[jj >> 1] >> ((jj & 1) * 16)) & 0xffff));
        float v = xo;
        if (!isctx) {
          float2 cs = ROPE[pos * 16 + (fq & 1) * 8 + jj];
          v = fq < 2 ? xo * cs.x - xp * cs.y : xp * cs.y + xo * cs.x;
        }
        f[jj] = (short)f2bf(v * 0.125f);
      }
      qf[mi][ks] = f;
    }
  f32x4 oacc[2][4];
#pragma unroll
  for (int mi = 0; mi < 2; mi++)
#pragma unroll
    for (int nd = 0; nd < 4; nd++) oacc[mi][nd] = f32x4{0.f, 0.f, 0.f, 0.f};
  float mrow[2][4], lrow[2][4];
#pragma unroll
  for (int mi = 0; mi < 2; mi++)
#pragma unroll
    for (int r = 0; r < 4; r++) { mrow[mi][r] = -1e30f; lrow[mi][r] = 0.f; }

  const int q0 = qb * 128;
  const int band_lo = isctx ? 0 : max(0, q0 - 128), band_hi = isctx ? 0 : min(SEQ, q0 + 256);
  const int ntile = 4 + (band_hi - band_lo) / 64;
  u16* pl = PL + w * 32 * LDT;
  for (int tl = 0; tl < ntile; tl++) {
    const bool band = tl >= 4;
    const int k0 = band ? band_lo + (tl - 4) * 64 : tl * 64;
    __syncthreads();
    {
      const int key = tid >> 3, kc = tid & 7;
      const int kpos = k0 + key;
      const u16* kp = P + (size_t)(b * TPB + (band ? LC : 0) + kpos) * PST + PD + 256 + hk * 64;
      uint4 own = *(const uint4*)(kp + kc * 8);
      uint4 vv = *(const uint4*)(kp + 128 + kc * 8);
      uint4 par = *(const uint4*)(kp + (kc ^ 2) * 8);
      if (band) {
        const unsigned ow[4] = {own.x, own.y, own.z, own.w};
        const unsigned pw[4] = {par.x, par.y, par.z, par.w};
        const int pos = kc < 4 ? (kpos >> 6) : (kpos & 63);
        unsigned res[4];
#pragma unroll
        for (int jj = 0; jj < 8; jj += 2) {
          float v2[2];
#pragma unroll
          for (int e = 0; e < 2; e++) {
            float xo = bf2f((u16)((ow[jj >> 1] >> (e * 16)) & 0xffff));
            float xp = bf2f((u16)((pw[jj >> 1] >> (e * 16)) & 0xffff));
            float2 cs = ROPE[pos * 16 + (kc & 1) * 8 + jj + e];
            v2[e] = (kc & 2) == 0 ? xo * cs.x - xp * cs.y : xp * cs.y + xo * cs.x;
          }
          res[jj >> 1] = pack2(v2[0], v2[1]);
        }
        own = make_uint4(res[0], res[1], res[2], res[3]);
      }
      *(uint4*)(KS + key * LDT + kc * 8) = own;
      const unsigned vw[4] = {vv.x, vv.y, vv.z, vv.w};
#pragma unroll
      for (int jj = 0; jj < 8; jj++) VT[(kc * 8 + jj) * LDT + key] = (u16)((vw[jj >> 1] >> ((jj & 1) * 16)) & 0xffff);
    }
    __syncthreads();
    f32x4 sc[2][4];
#pragma unroll
    for (int mi = 0; mi < 2; mi++)
#pragma unroll
      for (int nj = 0; nj < 4; nj++) sc[mi][nj] = f32x4{0.f, 0.f, 0.f, 0.f};
#pragma unroll
    for (int ks = 0; ks < 2; ks++) {
      bf16x8 kf[4];
#pragma unroll
      for (int nj = 0; nj < 4; nj++) kf[nj] = *(const bf16x8*)(KS + (nj * 16 + fr) * LDT + ks * 32 + fq * 8);
#pragma unroll
      for (int mi = 0; mi < 2; mi++)
#pragma unroll
        for (int nj = 0; nj < 4; nj++) sc[mi][nj] = __builtin_amdgcn_mfma_f32_16x16x32_bf16(qf[mi][ks], kf[nj], sc[mi][nj], 0, 0, 0);
    }
#pragma unroll
    for (int mi = 0; mi < 2; mi++)
#pragma unroll
      for (int r = 0; r < 4; r++) {
        const int qpos = tb + mi * 16 + fq * 4 + r;
        float mx = -1e30f;
#pragma unroll
        for (int nj = 0; nj < 4; nj++) {
          float v = sc[mi][nj][r];
          if (band) {
            int d = qpos - (k0 + nj * 16 + fr);
            if (d > 128 || d < -128) v = -1e30f;
          }
          sc[mi][nj][r] = v;
          mx = fmaxf(mx, v);
        }
        mx = fmaxf(mx, __shfl_xor(mx, 1));
        mx = fmaxf(mx, __shfl_xor(mx, 2));
        mx = fmaxf(mx, __shfl_xor(mx, 4));
        mx = fmaxf(mx, __shfl_xor(mx, 8));
        const float mnew = fmaxf(mrow[mi][r], mx);
        const float alpha = __expf(mrow[mi][r] - mnew);
        mrow[mi][r] = mnew;
        float ls = 0.f;
#pragma unroll
        for (int nj = 0; nj < 4; nj++) {
          float pe = __expf(sc[mi][nj][r] - mnew);
          ls += pe;
          pl[(mi * 16 + fq * 4 + r) * LDT + nj * 16 + fr] = f2bf(pe);
        }
        lrow[mi][r] = lrow[mi][r] * alpha + ls;
#pragma unroll
        for (int nd = 0; nd < 4; nd++) oacc[mi][nd][r] *= alpha;
      }
    asm volatile("s_waitcnt lgkmcnt(0)" ::: "memory");
    __builtin_amdgcn_wave_barrier();
#pragma unroll
    for (int ks = 0; ks < 2; ks++) {
      bf16x8 pf[2], vf[4];
#pragma unroll
      for (int mi = 0; mi < 2; mi++) pf[mi] = *(const bf16x8*)(pl + (mi * 16 + fr) * LDT + ks * 32 + fq * 8);
#pragma unroll
      for (int nd = 0; nd < 4; nd++) vf[nd] = *(const bf16x8*)(VT + (nd * 16 + fr) * LDT + ks * 32 + fq * 8);
#pragma unroll
      for (int mi = 0; mi < 2; mi++)
#pragma unroll
        for (int nd = 0; nd < 4; nd++) oacc[mi][nd] = __builtin_amdgcn_mfma_f32_16x16x32_bf16(pf[mi], vf[nd], oacc[mi][nd], 0, 0, 0);
    }
    asm volatile("s_waitcnt lgkmcnt(0)" ::: "memory");
    __builtin_amdgcn_wave_barrier();
  }
  const float sink = p.attn_sink[l * 4 + qh];
#pragma unroll
  for (int mi = 0; mi < 2; mi++)
#pragma unroll
    for (int r = 0; r < 4; r++) {
      float ls = lrow[mi][r];
      ls += __shfl_xor(ls, 1);
      ls += __shfl_xor(ls, 2);
      ls += __shfl_xor(ls, 4);
      ls += __shfl_xor(ls, 8);
      ls += __expf(sink - mrow[mi][r]);
      const float inv = 1.f / ls;
      const int tq = tb + mi * 16 + fq * 4 + r;
#pragma unroll
      for (int nd = 0; nd < 4; nd++) Y[(size_t)(qrow0 + tq) * YST + 1536 + qh * 64 + nd * 16 + fr] = f2bf(oacc[mi][nd][r] * inv);
    }
}

#ifndef SCAN3_MASK
#define SCAN3_MASK 7
#endif
__device__ __forceinline__ void phase_mix(const Params& p, int l, unsigned char* smem) {
  float* sm = (float*)smem;
  const int G = gridDim.x;
  for (int it = blockIdx.x; it < 192; it += G) {
    const int mix = it >> 6, rem = it & 63, b = rem >> 3, h = (rem >> 1) & 3, dir = rem & 1;
    if (mix == 0 && (SCAN3_MASK & 1)) scan3_item<0>(p, l, b, h, dir, smem);
    else if (mix == 1 && (SCAN3_MASK & 2)) scan3_item<1>(p, l, b, h, dir, smem);
    else if (mix == 2 && (SCAN3_MASK & 4)) scan3_item<2>(p, l, b, h, dir, smem);
  }
  if (SCAN3_MASK != 7) {
    for (int it = blockIdx.x; it < 768; it += G) {
      const int mix = it >> 8, rem = it & 255, b = rem >> 5, h = (rem >> 3) & 3, dir = (rem >> 2) & 1, rq = rem & 3;
      if (mix == 0 && !(SCAN3_MASK & 1)) scan2_item<0>(p, l, b, h, dir, rq, sm);
      else if (mix == 1 && !(SCAN3_MASK & 2)) scan2_item<1>(p, l, b, h, dir, rq, sm);
      else if (mix == 2 && !(SCAN3_MASK & 4)) scan2_item<2>(p, l, b, h, dir, rq, sm);
    }
  }
  __syncthreads();
  unsigned* ctr = (unsigned*)(p.ws + OFF_CTR) + l * 16;
  volatile int* slot = (volatile int*)(smem + 131072 - 16);
  for (;;) {
    if (TIDX == 0) *slot = (int)atomicAdd(ctr, 1u);
    __syncthreads();
    const int it = *slot;
    __syncthreads();
    if (it >= (l == 0 ? 544 : 512)) break;
    if (it < 512) {
      int b = it >> 6, qb = (it >> 1) & 31, hk = it & 1;
      attn_item(p, l, b, qb, hk, false, smem);
    } else {
      int r = it - 512, b = r >> 2, qb = (r >> 1) & 1, hk = r & 1;
      attn_item(p, l, b, qb, hk, true, smem);
    }
  }
}

#define POST_DECL(PFX) uint2 PFX##ya0, PFX##ya1, PFX##ya2, PFX##yc0, PFX##yc1, PFX##yc2, PFX##vp, PFX##vc, PFX##vn, PFX##gb, PFX##gc; \
  u16 PFX##xp, PFX##xc, PFX##xn; float2 PFX##bc
#define POST_LOAD(PFX, R_)                                                                         \
  do {                                                                                             \
    const int r_ = (R_);                                                                           \
    const int b_ = r_ / TPB, t_ = r_ - b_ * TPB;                                                   \
    const bool hp_ = (t_ != 0) && (t_ != LC), hn_ = (t_ != LC - 1) && (t_ != TPB - 1);            \
    const u16* ys_ = YSc + (size_t)r_ * YST;                                                       \
    const u16* pr_ = Pc + (size_t)r_ * PST;                                                        \
    const u16* pp_ = pr_ - (hp_ ? PST : 0);                                                        \
    const u16* pn_ = pr_ + (hn_ ? PST : 0);                                                        \
    PFX##ya0 = *(const uint2*)(ys_ + j0); PFX##ya1 = *(const uint2*)(ys_ + 256 + j0); PFX##ya2 = *(const uint2*)(ys_ + 512 + j0); \
    PFX##yc0 = *(const uint2*)(ys_ + 768 + j0); PFX##yc1 = *(const uint2*)(ys_ + 1024 + j0); PFX##yc2 = *(const uint2*)(ys_ + 1280 + j0); \
    PFX##vp = *(const uint2*)(pp_ + PA + 512 + j0);                                                \
    PFX##vc = *(const uint2*)(pr_ + PA + 512 + j0);                                                \
    PFX##vn = *(const uint2*)(pn_ + PA + 512 + j0);                                                \
    PFX##gb = *(const uint2*)(pr_ + PB + 784 + j0);                                                \
    PFX##gc = *(const uint2*)(pr_ + PC + 544 + j0);                                                \
    PFX##xp = pp_[PA + 896 + lane]; PFX##xc = pr_[PA + 896 + lane]; PFX##xn = pn_[PA + 896 + lane]; \
    PFX##bc = *(const float2*)(BCc + (size_t)r_ * 8 + (lane >> 4) * 2);                            \
  } while (0)
__device__ __forceinline__ void unpack4(uint2 v, float (&o)[4]) {
  o[0] = __uint_as_float(v.x << 16); o[1] = __uint_as_float(v.x & 0xffff0000u);
  o[2] = __uint_as_float(v.y << 16); o[3] = __uint_as_float(v.y & 0xffff0000u);
}

__device__ __forceinline__ void phase_post(const Params& p, int l, float* g2s) {
  const int lane = TIDX & 63, wv = TIDX >> 6;
  u16* YS = (u16*)(p.ws + OFF_YS);
  const int j0 = lane * 4;
  {
    const float4* src = (const float4*)(p.rwkv_g2 + (size_t)l * 64 * 256);
    for (int i = TIDX; i < 64 * 256 / 4; i += NTHR) ((float4*)g2s)[i] = src[i];
  }
  float mu_v[4], lng[4], lnb[4], ngb[4], ngc[4];
#pragma unroll
  for (int i = 0; i < 4; i++) {
    mu_v[i] = p.rwkv_mu[l * 960 + 512 + j0 + i];
    lng[i] = p.rwkv_ln_g[l * 256 + j0 + i];
    lnb[i] = p.rwkv_ln_b[l * 256 + j0 + i];
    ngb[i] = p.gdn_norm_g[l * 64 + (lane & 15) * 4 + i];
    ngc[i] = p.gla_norm_g[l * 64 + (lane & 15) * 4 + i];
  }
  const float mu_x = p.rwkv_mu[l * 960 + 896 + lane];
  __syncthreads();
  const int stride = gridDim.x * 8;
  int r = blockIdx.x * 8 + wv;
  const u16* Pc = (const u16*)(p.ws + OFF_BIG);
  const u16* YSc = (const u16*)(p.ws + OFF_YS);
  const float* BCc = (const float*)(p.ws + OFF_BC);
  POST_DECL(cur_);
  POST_DECL(nxt_);
  POST_LOAD(cur_, r);
  for (; r < NROWS; r += stride) {
    const int rn = r + stride < NROWS ? r + stride : r;
    POST_LOAD(nxt_, rn);
    const int b = r / TPB, t = r - b * TPB;
    const float pmul = ((t != 0) && (t != LC)) ? 1.f : 0.f, nmul = ((t != LC - 1) && (t != TPB - 1)) ? 1.f : 0.f;
    if (!(l == 1 && t < LC)) {
    float y[3][4];
    {
      float a4[4], c4[4];
      unpack4(cur_ya0, a4); unpack4(cur_yc0, c4);
#pragma unroll
      for (int i = 0; i < 4; i++) y[0][i] = a4[i] + c4[i];
      unpack4(cur_ya1, a4); unpack4(cur_yc1, c4);
#pragma unroll
      for (int i = 0; i < 4; i++) y[1][i] = a4[i] + c4[i];
      unpack4(cur_ya2, a4); unpack4(cur_yc2, c4);
#pragma unroll
      for (int i = 0; i < 4; i++) y[2][i] = a4[i] + c4[i];
    }
    float o[3][4];
    {
      float sum = y[0][0] + y[0][1] + y[0][2] + y[0][3];
      sum = red16(sum);
      const float mean = sum * (1.f / 64.f);
      float vs = 0.f;
#pragma unroll
      for (int i = 0; i < 4; i++) { float d = y[0][i] - mean; vs += d * d; }
      vs = red16(vs);
      const float rstd = rsq(vs * (1.f / 64.f) + 64e-5f);
      const float pv = bf2f(cur_xc), ppv = bf2f(cur_xp) * pmul, pnv = bf2f(cur_xn) * nmul;
      const float sg = sigm(pv + (0.5f * (ppv + pnv) - pv) * mu_x);
      float gate[4] = {0.f, 0.f, 0.f, 0.f};
      const float* g2 = g2s + j0;
#pragma unroll 8
      for (int i = 0; i < 64; i++) {
        const float si = __int_as_float(__builtin_amdgcn_readlane(__float_as_int(sg), i));
        const float4 gw = *(const float4*)(g2 + i * 256);
        gate[0] += si * gw.x; gate[1] += si * gw.y; gate[2] += si * gw.z; gate[3] += si * gw.w;
      }
      const float bcs = cur_bc.x + cur_bc.y;
      float vc4[4], vp4[4], vn4[4];
      unpack4(cur_vc, vc4); unpack4(cur_vp, vp4); unpack4(cur_vn, vn4);
#pragma unroll
      for (int i = 0; i < 4; i++) {
        const float v = vc4[i] + (0.5f * (vp4[i] * pmul + vn4[i] * nmul) - vc4[i]) * mu_v[i];
        const float yn = (y[0][i] - mean) * rstd * lng[i] + lnb[i];
        o[0][i] = (yn + bcs * v) * gate[i];
      }
    }
#pragma unroll
    for (int m = 1; m < 3; m++) {
      float ss = y[m][0] * y[m][0] + y[m][1] * y[m][1] + y[m][2] * y[m][2] + y[m][3] * y[m][3];
      ss = red16(ss);
      const float inv = rsq(ss * (1.f / 64.f) + 1e-6f);
      float g4[4];
      unpack4(m == 1 ? cur_gb : cur_gc, g4);
#pragma unroll
      for (int i = 0; i < 4; i++) o[m][i] = y[m][i] * inv * (m == 1 ? ngb[i] : ngc[i]) * siluf(g4[i]);
    }
    u16* ys = YS + (size_t)r * YST;
#pragma unroll
    for (int m = 0; m < 3; m++) {
      uint2 ov;
      ov.x = pack2(o[m][0], o[m][1]);
      ov.y = pack2(o[m][2], o[m][3]);
      *(uint2*)(ys + m * 256 + j0) = ov;
    }
    }
    cur_ya0 = nxt_ya0; cur_ya1 = nxt_ya1; cur_ya2 = nxt_ya2; cur_yc0 = nxt_yc0; cur_yc1 = nxt_yc1; cur_yc2 = nxt_yc2;
    cur_vp = nxt_vp; cur_vc = nxt_vc; cur_vn = nxt_vn; cur_gb = nxt_gb; cur_gc = nxt_gc;
    cur_xp = nxt_xp; cur_xc = nxt_xc; cur_xn = nxt_xn; cur_bc = nxt_bc;
  }
}

#define XB_TMO      128
#define XB_XCNT(j)  (256  + 64 * (j))
#define XB_XSUB(j)  (1280 + 64 * (j))
#define XB_XGEN(j)  (2304 + 64 * (j))
#define XB_TOP      3328
#define XB_TOPGEN   3392
#define XCD_BAR_WORDS 3456
#define XB_SPIN_CAP (1u << 18)
#define LAS __attribute__((address_space(3)))

__device__ __forceinline__ unsigned xb_ld(unsigned* p)              { return __hip_atomic_load(p, __ATOMIC_RELAXED, __HIP_MEMORY_SCOPE_AGENT); }
__device__ __forceinline__ unsigned xb_add(unsigned* p, unsigned v) { return __hip_atomic_fetch_add(p, v, __ATOMIC_RELAXED, __HIP_MEMORY_SCOPE_AGENT); }
__device__ __forceinline__ unsigned xb_xcc_id() { return (unsigned)__builtin_amdgcn_s_getreg((3 << 11) | 20) & 0xFu; }
#define XB_SPIN(cond, bar) do { unsigned _sp = 0; while (cond) { __builtin_amdgcn_s_sleep(1); \
    if ((++_sp & 255u) == 0u) { if (xb_ld(&(bar)[XB_TMO])) break; if (_sp > XB_SPIN_CAP) { atomicAdd(&(bar)[XB_TMO], 1u); break; } } } } while (0)

struct XcdBarrier {
    unsigned* bar; unsigned x;
    volatile LAS unsigned* st;
};

__device__ __forceinline__ XcdBarrier xcd_barrier_post(unsigned* bar, volatile LAS unsigned* st) {
    XcdBarrier b; b.bar = bar; b.x = xb_xcc_id(); b.st = st;
    if (threadIdx.x == 0) (void)xb_add(&bar[XB_XCNT(b.x)], 1u);
    return b;
}
__device__ __forceinline__ void xcd_barrier_complete(unsigned* bar, unsigned x, unsigned& nloc, unsigned& nx) {
    const unsigned G = gridDim.x * gridDim.y * gridDim.z;
    unsigned sum, cnt, mine, sp = 0u;
    for (;;) {
        sum = 0u; cnt = 0u; mine = 0u;
#pragma unroll
        for (unsigned j = 0; j < 16; ++j) { const unsigned c = xb_ld(&bar[XB_XCNT(j)]); sum += c; cnt += (c > 0u) ? 1u : 0u; mine = (j == x) ? c : mine; }
        if (sum == G) break;
        __builtin_amdgcn_s_sleep(1);
        if ((++sp & 255u) == 0u) { if (xb_ld(&bar[XB_TMO])) break; if (sp > XB_SPIN_CAP) { atomicAdd(&bar[XB_TMO], 1u); break; } }
    }
    nloc = mine > 0u ? mine : 1u; nx = cnt > 0u ? cnt : 1u;
}

__device__ __forceinline__ void xcd_barrier(const XcdBarrier& b) {
    asm volatile("s_waitcnt vmcnt(0)" ::: "memory");
    __syncthreads();
    if (threadIdx.x == 0) {
        unsigned* bar = b.bar;
        __builtin_amdgcn_s_waitcnt(0);
        unsigned nloc = b.st[0], nx = b.st[1];
        if (nloc == 0u) { xcd_barrier_complete(bar, b.x, nloc, nx); b.st[0] = nloc; b.st[1] = nx; }
        const unsigned old = xb_add(&bar[XB_XSUB(b.x)], 1u);
        const unsigned gen = old / nloc;
        if (old + 1u == (gen + 1u) * nloc) {
            __builtin_amdgcn_fence(__ATOMIC_RELEASE, "agent");
            asm volatile("s_waitcnt vmcnt(0)" ::: "memory");
            const unsigned og = xb_add(&bar[XB_TOP], 1u);
            const unsigned tg = og / nx;
            if (og + 1u == (tg + 1u) * nx) xb_add(&bar[XB_TOPGEN], 1u);
            else XB_SPIN(xb_ld(&bar[XB_TOPGEN]) == tg, bar);
            __builtin_amdgcn_fence(__ATOMIC_ACQUIRE, "agent");
            xb_add(&bar[XB_XGEN(b.x)], 1u);
            asm volatile("s_waitcnt vmcnt(0)" ::: "memory");
        } else {
            XB_SPIN(xb_ld(&bar[XB_XGEN(b.x)]) == gen, bar);
            __builtin_amdgcn_fence(__ATOMIC_ACQUIRE, "agent");
            asm volatile("s_waitcnt vmcnt(0)" ::: "memory");
        }
    }
    __syncthreads();
}

#if defined(SKIPS)
#define EN(k) (SKIPS != (k))
#elif !defined(ONLYS)
#define EN(k) 1
#else
#define EN(k) (ONLYS == (k))
#endif
__device__ __forceinline__ void run_phase(const Params& p, int ph, unsigned char* smem) {
  if (ph == 0) { if (EN(10)) phase_init0(p, (float*)smem); return; }
  if (ph == 1) { if (EN(11)) phase_init1(p); return; }
  int l = 0, s = 12;
  if (ph >= 3) { l = (ph - 3) / 12; s = (ph - 3) - l * 12; }
  unsigned char* wl = p.ws + OFF_W + (size_t)l * SZ_WL;
  PG8_LAS unsigned char* lds = (PG8_LAS unsigned char*)smem;
  pg8::StaticOrder S;
  if (s == 12 || s == 8 || s == 11) {
    if (EN(5)) rowpass(p, l, s == 12 ? 0 : (s == 8 ? 1 : 2));
  } else if (s == 0 || s == 3 || s == 5 || s == 7 || s == 10) {
    pg8::Gemm g; EpiBf E;
    g.M = NROWS; E.bias = nullptr; E.act = 0;
    if (s == 0) { g.A = (const u16*)(p.ws + OFF_H); g.lda = DM; g.Bt = (const u16*)(wl + OW_IN); g.K = DM; g.N = PST; E.O = (u16*)(p.ws + OFF_BIG); E.ldc = PST; }
    else if (s == 3 || s == 5) {
      const int hf = s == 5;
      g.A = (const u16*)(p.ws + OFF_H); g.lda = DM; g.Bt = (const u16*)(wl + OW_G) + (size_t)hf * 2048 * DM; g.K = DM; g.N = 2048;
      E.O = (u16*)(p.ws + OFF_BIG); E.ldc = 2048; E.bias = p.gate_b + (size_t)l * 4096 + hf * 2048; E.act = 1;
    }
    else if (s == 7) { g.A = (const u16*)(p.ws + OFF_BIG + 2 * SZ_ACT); g.lda = DM; g.Bt = (const u16*)(wl + OW_O); g.K = DM; g.N = DM; E.O = (u16*)(p.ws + OFF_BIG); E.ldc = DM; }
    else { g.A = (const u16*)(p.ws + OFF_BIG); g.lda = FH; g.Bt = (const u16*)(wl + OW_2); g.K = FH; g.N = DM; E.O = (u16*)(p.ws + OFF_YS); E.ldc = DM; }
    if (l == 1 && s != 0) S.init(NBATCH * SEQ, g.N, gridDim.x, blockIdx.x, 1);
    else S.init(g.M, g.N, gridDim.x, blockIdx.x);
    if (EN(0)) pg8::gemm_phase<EpiBf, pg8::StaticOrder, false>(lds, g, S, E, nullptr);
  } else if (s == 4 || s == 6) {
#ifdef YPART_ENGINE
    const int hf = s == 6;
#pragma unroll 1
    for (int k = 0; k < 2; k++) {
      const int br = hf * 2 + k;
      pg8::Gemm g; EpiGateAcc E;
      g.M = NROWS; g.N = DM; g.K = 256; g.lda = YST;
      g.A = (const u16*)(p.ws + OFF_YS) + (br < 3 ? br * 256 : 1536);
      g.Bt = (const u16*)(wl + OW_B) + (size_t)br * 1024 * 256;
      E.ACC = (u16*)(p.ws + OFF_BIG + 2 * SZ_ACT); E.G = (const u16*)(p.ws + OFF_BIG); E.gcol = k * 1024; E.amask = br != 0 ? 0xffffffffu : 0u;
      S.init(g.M, g.N, gridDim.x, blockIdx.x);
      if (EN(3)) pg8::gemm_phase<EpiGateAcc, pg8::StaticOrder, false>(lds, g, S, E, nullptr);
      __syncthreads();
    }
#else
    if (EN(3)) phase_ypart(p, l, s == 6, smem);
#endif
  } else if (s == 1) {
    if (EN(1)) phase_mix(p, l, smem);
  } else if (s == 2) {
    if (EN(2)) phase_post(p, l, (float*)smem);
  } else {
    pg8::Gemm g; EpiSwiglu E;
    g.M = NROWS; g.N = 2 * FH; g.K = DM; g.lda = DM; g.A = (const u16*)(p.ws + OFF_H); g.Bt = (const u16*)(wl + OW_1);
    E.O = (u16*)(p.ws + OFF_BIG);
    if (l == 1) S.init(NBATCH * SEQ, g.N, gridDim.x, blockIdx.x, 1);
    else S.init(g.M, g.N, gridDim.x, blockIdx.x);
    if (EN(6)) pg8::gemm_phase<EpiSwiglu, pg8::StaticOrder, false>(lds, g, S, E, nullptr);
  }
}

__global__ void __launch_bounds__(NTHR) hybrid_flow_mega(Params p, int ph0, int ph1) {
  __shared__ __attribute__((aligned(16))) unsigned char smem[131072];
  __shared__ __attribute__((aligned(16))) unsigned xbw[4];
  cg::grid_group grid = cg::this_grid();
  XcdBarrier xb;
  xb.bar = (unsigned*)(p.ws + OFF_XBAR); xb.x = 0u; xb.st = (volatile LAS unsigned*)xbw;
  for (int ph = ph0; ph < ph1; ph++) {
    run_phase(p, ph, smem);
#ifdef DUPMASK
    {
      int sidx = ph >= 3 ? (ph - 3) % 12 : 12 + ph;
      if ((DUPMASK >> sidx) & 1) { __syncthreads(); run_phase(p, ph, smem); }
    }
#endif
    if (ph + 1 < ph1) {
      if (ph == ph0) {
        grid.sync();
        if (threadIdx.x < 4) xbw[threadIdx.x] = 0u;
        __syncthreads();
        xb = xcd_barrier_post((unsigned*)(p.ws + OFF_XBAR), (volatile LAS unsigned*)xbw);
      } else {
        xcd_barrier(xb);
      }
    }
  }
  if (ph1 - ph0 > 2 && threadIdx.x == 0 && xb_ld(&xb.bar[XB_TMO]) != 0u) p.out[blockIdx.x] = __int_as_float(0x7fc00000);
}

extern "C" void kernel_launch(void* const* d_in, const int* in_sizes, int n_in, void* d_out, int out_size, void* d_ws,
                              size_t ws_size, hipStream_t stream) {
  Params p{};
  const float** pp = (const float**)&p;
  for (int i = 0; i < 32; i++) pp[i] = (const float*)d_in[i];
  p.out = (float*)d_out;
  p.ws = (unsigned char*)d_ws;
  static int grid_blocks = 0;
  if (!grid_blocks) {
    int dev = 0, cus = 0, per_cu = 0;
    hipGetDevice(&dev);
    hipDeviceGetAttribute(&cus, hipDeviceAttributeMultiprocessorCount, dev);
    hipOccupancyMaxActiveBlocksPerMultiprocessor(&per_cu, hybrid_flow_mega, NTHR, 0);
    if (per_cu < 1) per_cu = 1;
    grid_blocks = cus * per_cu;
  }
#ifdef MULTI_LAUNCH
  for (int ph = 0; ph < NPHASE; ph++) {
    hipLaunchKernelGGL(hybrid_flow_mega, dim3(grid_blocks), dim3(NTHR), 0, stream, p, ph, ph + 1);
  }
#else
  int ph0 = 0, ph1 = NPHASE;
  void* args[] = {&p, &ph0, &ph1};
  hipError_t e = hipLaunchCooperativeKernel((void*)hybrid_flow_mega, dim3(grid_blocks), dim3(NTHR), args, 0, stream);
  if (e != hipSuccess) fprintf(stderr, "cooperative launch failed: %s (grid %d)\n", hipGetErrorString(e), grid_blocks);
#endif
}
```

```cpp
#include <hip/hip_runtime.h>
#include <hip/hip_cooperative_groups.h>
#include <cstdio>
namespace cg = cooperative_groups;

typedef unsigned short u16;
using bf16x8 = __attribute__((ext_vector_type(8))) short;
using f32x4 = __attribute__((ext_vector_type(4))) float;

#define DM 1024
#define NBATCH 8
#define SEQ 4096
#define LC 256
#define TPB 4352
#define NROWS 34816
#define PST 3328
#define YST 1792
#define FH 2816
#define INW 7408
#define NTHR 512
#define PA 0
#define PB 960
#define PC 2000
#define PD 2800
#define NPHASE 23
#define SCAN3_MASK 7

struct Params {
  const float *x, *c, *ctx, *c_ctx, *ada_w, *ada_b, *norm_g, *w_in, *gate_b, *w_branch, *w_out,
      *rwkv_mu, *rwkv_w0, *rwkv_w2, *rwkv_a0, *rwkv_a2, *rwkv_g2, *rwkv_kk, *rwkv_ka, *rwkv_rk, *rwkv_ln_g,
      *rwkv_ln_b, *gdn_conv, *gdn_a_log, *gdn_dt_bias, *gdn_norm_g, *gla_gw2, *gla_gb, *gla_norm_g, *attn_sink,
      *ffn_w1, *ffn_w2;
  float* out;
  unsigned char* ws;
};

constexpr size_t SZ_WL = 36700160;
constexpr size_t OW_IN = 0;
constexpr size_t OW_G = OW_IN + (size_t)PST * 1024 * 2;
constexpr size_t OW_B = OW_G + (size_t)4096 * 1024 * 2;
constexpr size_t OW_O = OW_B + (size_t)4 * 1024 * 256 * 2;
constexpr size_t OW_1 = OW_O + (size_t)1024 * 1024 * 2;
constexpr size_t OW_2 = OW_1 + (size_t)5632 * 1024 * 2;
static_assert(OW_2 + (size_t)1024 * FH * 2 == SZ_WL, "weights size");
constexpr size_t SZ_ACT = (size_t)NROWS * DM * 2;
constexpr size_t OFF_W = 0;
constexpr size_t OFF_XC = OFF_W + SZ_WL;
constexpr size_t OFF_MODP = OFF_XC + (size_t)NBATCH * LC * DM * 4;
constexpr size_t OFF_MOD = OFF_MODP + (size_t)2 * 8 * 9 * 6144 * 4;
constexpr size_t OFF_BC = OFF_MOD + (size_t)2 * 9 * 6144 * 4;
constexpr size_t OFF_H = OFF_BC + (size_t)NROWS * 8 * 4;
constexpr size_t OFF_YS = OFF_H + SZ_ACT;
constexpr size_t OFF_BIG = OFF_YS + (size_t)NROWS * YST * 2;
constexpr size_t OFF_CTR = OFF_BIG + (size_t)NROWS * 4096 * 2;
constexpr size_t OFF_XBAR = OFF_CTR + 256;
constexpr size_t WS_END = OFF_XBAR + 3456 * 4;
static_assert(WS_END <= (size_t)536870912, "ws too large");

__device__ __forceinline__ int launder_tid() { int t = threadIdx.x; asm volatile("" : "+v"(t)); return t; }
#define TIDX (launder_tid())
typedef float f32x2_t __attribute__((ext_vector_type(2)));
typedef __bf16 bf16x2_t __attribute__((ext_vector_type(2)));
__device__ __forceinline__ unsigned pack2(float a, float b) {
  const f32x2_t v = {a, b};
  const bf16x2_t r = __builtin_convertvector(v, bf16x2_t);
  return __builtin_bit_cast(unsigned, r);
}
__device__ __forceinline__ u16 f2bf(float f) { return (u16)(pack2(f, 0.f) & 0xffffu); }
__device__ __forceinline__ float bf2f(u16 h) { return __uint_as_float(((unsigned)h) << 16); }
__device__ __forceinline__ float sigm(float x) { return __builtin_amdgcn_rcpf(1.f + __expf(-x)); }
__device__ __forceinline__ float siluf(float x) { return x * __builtin_amdgcn_rcpf(1.f + __expf(-x)); }
__device__ __forceinline__ float rsq(float x) { return __builtin_amdgcn_rsqf(x); }
__device__ __forceinline__ float softplusf(float x) { return fmaxf(x, 0.f) + __logf(1.f + __expf(-fabsf(x))); }
__device__ __forceinline__ float tanh_fast(float x) { return 1.f - 2.f * __builtin_amdgcn_rcpf(1.f + __expf(2.f * x)); }
__device__ __forceinline__ float wsum(float v) {
#pragma unroll
  for (int o = 32; o > 0; o >>= 1) v += __shfl_xor(v, o);
  return v;
}
template <int CTRL>
__device__ __forceinline__ float dppf(float x) {
  return __int_as_float(__builtin_amdgcn_update_dpp(__float_as_int(x), __float_as_int(x), CTRL, 0xf, 0xf, false));
}
__device__ __forceinline__ float red8(float x) {
  x += dppf<0xB1>(x);
  x += dppf<0x4E>(x);
  x += dppf<0x141>(x);
  return x;
}
__device__ __forceinline__ const float* xin_row(const Params& p, int r) {
  int b = r / TPB, t = r - b * TPB;
  return t < LC ? p.ctx + ((size_t)(b * LC + t)) * DM : p.x + ((size_t)(b * SEQ + t - LC)) * DM;
}
__device__ __forceinline__ float* x_row(const Params& p, int r) {
  int b = r / TPB, t = r - b * TPB;
  return t < LC ? (float*)(p.ws + OFF_XC) + ((size_t)(b * LC + t)) * DM : p.out + ((size_t)(b * SEQ + t - LC)) * DM;
}
__device__ __forceinline__ int mod_row(int r) {
  int b = r / TPB, t = r - b * TPB;
  return t < LC ? 8 : b;
}

struct MapId { int lim, off; __device__ int operator()(int n) const { return n < lim ? n + off : -1; } };
struct MapW1 { __device__ int operator()(int n) const { int q = n >> 3, s = n & 7; return s < 4 ? q * 4 + s : FH + q * 4 + (s - 4); } };

template <class Map>
__device__ __forceinline__ void conv_tile(const float* __restrict__ src, int ld, u16* __restrict__ dst, int K, int n0,
                                          int k0, Map map, float* tile) {
  const int tid = TIDX;
  const int nn = tid & 63, kr = tid >> 6;
  const int sc = map(n0 + nn);
#pragma unroll
  for (int ps = 0; ps < 8; ps++) {
    int kk = ps * 8 + kr;
    float v = sc >= 0 ? src[(size_t)(k0 + kk) * ld + sc] : 0.f;
    tile[kk * 65 + nn] = v;
  }
  __syncthreads();
  const int n2 = tid >> 3, kc = tid & 7;
  uint4 o;
  o.x = pack2(tile[(kc * 8 + 0) * 65 + n2], tile[(kc * 8 + 1) * 65 + n2]);
  o.y = pack2(tile[(kc * 8 + 2) * 65 + n2], tile[(kc * 8 + 3) * 65 + n2]);
  o.z = pack2(tile[(kc * 8 + 4) * 65 + n2], tile[(kc * 8 + 5) * 65 + n2]);
  o.w = pack2(tile[(kc * 8 + 6) * 65 + n2], tile[(kc * 8 + 7) * 65 + n2]);
  *(uint4*)(dst + (size_t)(n0 + n2) * K + k0 + kc * 8) = o;
  __syncthreads();
}

__device__ __forceinline__ void conv_item(const Params& p, int l, int rem, float* sm) {
      u16* wl = (u16*)(p.ws + OFF_W);
      if (rem < 832) {
        int nt = rem >> 4, kt = rem & 15;
        conv_tile(p.w_in + (size_t)l * DM * INW, INW, (u16*)((char*)wl + OW_IN), 1024, nt * 64, kt * 64, MapId{3312, 0}, sm);
      } else if (rem < 832 + 1024) {
        rem -= 832;
        int nt = rem >> 4, kt = rem & 15;
        conv_tile(p.w_in + (size_t)l * DM * INW, INW, (u16*)((char*)wl + OW_G), 1024, nt * 64, kt * 64, MapId{4096, 3312}, sm);
      } else if (rem < 1856 + 256) {
        rem -= 1856;
        int br = rem >> 6, r2 = rem & 63, nt = r2 >> 2, kt = r2 & 3;
        conv_tile(p.w_branch + ((size_t)(l * 4 + br)) * 256 * DM, DM, (u16*)((char*)wl + OW_B) + (size_t)br * 1024 * 256, 256,
                  nt * 64, kt * 64, MapId{1024, 0}, sm);
      } else if (rem < 2112 + 256) {
        rem -= 2112;
        int nt = rem >> 4, kt = rem & 15;
        conv_tile(p.w_out + (size_t)l * DM * DM, DM, (u16*)((char*)wl + OW_O), 1024, nt * 64, kt * 64, MapId{1024, 0}, sm);
      } else if (rem < 2368 + 1408) {
        rem -= 2368;
        int nt = rem >> 4, kt = rem & 15;
        conv_tile(p.ffn_w1 + (size_t)l * DM * 5632, 5632, (u16*)((char*)wl + OW_1), 1024, nt * 64, kt * 64, MapW1{}, sm);
      } else {
        rem -= 3776;
        int nt = rem / 44, kt = rem - nt * 44;
        conv_tile(p.ffn_w2 + (size_t)l * FH * DM, DM, (u16*)((char*)wl + OW_2), FH, nt * 64, kt * 64, MapId{1024, 0}, sm);
      }
}

__device__ __forceinline__ void phase_init0(const Params& p, float* sm) {
  const int tid = TIDX;
  if (blockIdx.x == 0) {
    if (tid < 64) ((unsigned*)(p.ws + OFF_CTR))[tid] = 0u;
    for (int i = tid; i < 3456; i += NTHR) ((unsigned*)(p.ws + OFF_XBAR))[i] = 0u;
  }
  constexpr int NMOD = 192, NCONV = 4480;
  for (int it = blockIdx.x; it < NMOD + NCONV; it += gridDim.x) {
    if (it < NMOD) {
      int l = it / 96, rem = it - l * 96, cc = rem >> 3, ks = rem & 7;
      for (int i = tid; i < 9 * 128; i += NTHR) {
        int r = i >> 7, k = i & 127;
        float v = r < 8 ? p.c[r * DM + ks * 128 + k] : p.c_ctx[ks * 128 + k];
        sm[i] = siluf(v);
      }
      __syncthreads();
      const int n = cc * 512 + tid;
      const float* w = p.ada_w + ((size_t)l * DM + ks * 128) * 6144 + n;
      float acc[9];
#pragma unroll
      for (int r = 0; r < 9; r++) acc[r] = 0.f;
#pragma unroll 4
      for (int k = 0; k < 128; k++) {
        float wv = w[(size_t)k * 6144];
#pragma unroll
        for (int r = 0; r < 9; r++) acc[r] += sm[r * 128 + k] * wv;
      }
      float* mp = (float*)(p.ws + OFF_MODP) + ((size_t)(l * 8 + ks) * 9) * 6144 + n;
#pragma unroll
      for (int r = 0; r < 9; r++) mp[(size_t)r * 6144] = acc[r];
      __syncthreads();
    } else {
      conv_item(p, 0, it - NMOD, sm);
    }
  }
}

__device__ __forceinline__ void phase_init1(const Params& p) {
  const float* mp = (const float*)(p.ws + OFF_MODP);
  float* mo = (float*)(p.ws + OFF_MOD);
  for (int i = blockIdx.x * NTHR + TIDX; i < 2 * 9 * 6144; i += gridDim.x * NTHR) {
    int l = i / (9 * 6144), rem = i - l * 9 * 6144, r = rem / 6144, n = rem - r * 6144;
    float s = p.ada_b[l * 6144 + n];
#pragma unroll
    for (int ks = 0; ks < 8; ks++) s += mp[((size_t)((l * 8 + ks) * 9 + r)) * 6144 + n];
    mo[i] = s;
  }
}

__device__ __forceinline__ void rowpass(const Params& p, int l, int mode) {
  const int lane = TIDX & 63, wv = TIDX >> 6;
  const float* MOD = (const float*)(p.ws + OFF_MOD);
  u16* H = (u16*)(p.ws + OFF_H);
  const bool do_norm = !(mode == 2 && l == 1);
  const int ln = (mode == 2) ? (l == 1 ? l : l + 1) : l;
  const int ni = (mode == 1) ? 2 : 0, sho = (mode == 1) ? 3072 : 0, sco = (mode == 1) ? 4096 : 1024;
  for (int r = blockIdx.x * 8 + wv; r < NROWS; r += gridDim.x * 8) {
    const int mr = mod_row(r);
    if (l == 1 && mode != 0 && mr == 8) continue;
    const float* modl = MOD + ((size_t)(l * 9 + mr)) * 6144;
    const float* modn = MOD + ((size_t)(ln * 9 + mr)) * 6144;
    const float* ng2 = p.norm_g + (size_t)(ln * 4 + ni) * DM;
    const float* xs = (mode == 0 || (mode == 1 && l == 0)) ? xin_row(p, r) : (const float*)x_row(p, r);
    float4 xo[4], n2[4], sc4[4], sh4[4];
#pragma unroll
    for (int i = 0; i < 4; i++) {
      const int col = i * 256 + lane * 4;
      xo[i] = *(const float4*)(xs + col);
      n2[i] = *(const float4*)(ng2 + col);
      sc4[i] = *(const float4*)(modn + sco + col);
      sh4[i] = *(const float4*)(modn + sho + col);
    }
    float xv[16];
    if (mode == 0) {
#pragma unroll
      for (int i = 0; i < 4; i++) { xv[i * 4 + 0] = xo[i].x; xv[i * 4 + 1] = xo[i].y; xv[i * 4 + 2] = xo[i].z; xv[i * 4 + 3] = xo[i].w; }
    } else {
      const u16* src = (const u16*)(p.ws + (mode == 1 ? OFF_BIG : OFF_YS)) + (size_t)r * DM;
      const float* ng = p.norm_g + (size_t)(l * 4 + (mode == 1 ? 1 : 3)) * DM;
      const float* gt = modl + (mode == 1 ? 2048 : 5120);
      uint2 sv[4];
      float4 g4[4], n4[4];
#pragma unroll
      for (int i = 0; i < 4; i++) {
        const int col = i * 256 + lane * 4;
        sv[i] = *(const uint2*)(src + col);
        g4[i] = *(const float4*)(gt + col);
        n4[i] = *(const float4*)(ng + col);
      }
      float ov[16];
      float ss = 0.f;
#pragma unroll
      for (int i = 0; i < 4; i++) {
        ov[i * 4 + 0] = __uint_as_float(sv[i].x << 16); ov[i * 4 + 1] = __uint_as_float(sv[i].x & 0xffff0000u);
        ov[i * 4 + 2] = __uint_as_float(sv[i].y << 16); ov[i * 4 + 3] = __uint_as_float(sv[i].y & 0xffff0000u);
      }
#pragma unroll
      for (int i = 0; i < 16; i++) ss += ov[i] * ov[i];
      ss = wsum(ss);
      const float inv = rsq(ss * (1.f / 1024.f) + 1e-6f);
      float* xd = x_row(p, r);
#pragma unroll
      for (int i = 0; i < 4; i++) {
        xv[i * 4 + 0] = xo[i].x + g4[i].x * (ov[i * 4 + 0] * inv * n4[i].x);
        xv[i * 4 + 1] = xo[i].y + g4[i].y * (ov[i * 4 + 1] * inv * n4[i].y);
        xv[i * 4 + 2] = xo[i].z + g4[i].z * (ov[i * 4 + 2] * inv * n4[i].z);
        xv[i * 4 + 3] = xo[i].w + g4[i].w * (ov[i * 4 + 3] * inv * n4[i].w);
      }
#pragma unroll
      for (int i = 0; i < 4; i++)
        *(float4*)(xd + i * 256 + lane * 4) = make_float4(xv[i * 4 + 0], xv[i * 4 + 1], xv[i * 4 + 2], xv[i * 4 + 3]);
    }
    if (!do_norm) continue;
    float ss2 = 0.f;
#pragma unroll
    for (int i = 0; i < 16; i++) ss2 += xv[i] * xv[i];
    ss2 = wsum(ss2);
    const float inv2 = rsq(ss2 * (1.f / 1024.f) + 1e-6f);
#pragma unroll
    for (int i = 0; i < 4; i++) {
      const int col = i * 256 + lane * 4;
      float h0 = xv[i * 4 + 0] * inv2 * n2[i].x * (1.f + sc4[i].x) + sh4[i].x;
      float h1 = xv[i * 4 + 1] * inv2 * n2[i].y * (1.f + sc4[i].y) + sh4[i].y;
      float h2 = xv[i * 4 + 2] * inv2 * n2[i].z * (1.f + sc4[i].z) + sh4[i].z;
      float h3 = xv[i * 4 + 3] * inv2 * n2[i].w * (1.f + sc4[i].w) + sh4[i].w;
      uint2 o;
      o.x = pack2(h0, h1);
      o.y = pack2(h2, h3);
      *(uint2*)(H + (size_t)r * DM + col) = o;
    }
  }
}

#define LDT 72
namespace pg8 {
#define PG8_LAS __attribute__((address_space(3)))
typedef unsigned short bf16_t;
typedef short bf16x8 __attribute__((ext_vector_type(8)));
typedef float f32x4 __attribute__((ext_vector_type(4)));
typedef unsigned u32x4 __attribute__((ext_vector_type(4)));
constexpr int BM = 256, BK = 64, HALF = 128, HTB = HALF * BK * 2  , STAGE_BYTES = 8 * HTB, NXCD = 8, WGM = 8;

__host__ __device__ __forceinline__ int lds_byte(int r, int c) { const int st = (r >> 4) * 2 + (c >> 5), rr = r & 15, cc = c & 31, ob = rr * 64 + cc * 2; return st * 1024 + (ob ^ (((ob >> 9) & 1) << 5)); }
__host__ __device__ __forceinline__ void stage_rc(int b, int& R, int& C) { const int st = b / 1024, sb = b % 1024, swz = sb ^ (((sb >> 9) & 1) << 5); R = (st >> 1) * 16 + swz / 64; C = (st & 1) * 32 + (swz % 64) / 2; }
__host__ __device__ __forceinline__ int perm32(int rho) { const int n = rho >> 4, i = rho & 15; return 8 * (i >> 2) + 4 * n + (i & 3); }

struct Unit { int pm, pn; };
struct Gemm { const bf16_t* A; const bf16_t* Bt; int M, N, K, lda; };
struct StaticOrder {
    int nM, nN, nwg, G, c, skip;
    __host__ __device__ void init(int M, int N, int G_, int c_, int skip_ = 0) { nM = M / BM; nN = N / BM; nwg = nM * nN; G = G_; c = c_; skip = skip_; }
    __host__ __device__ bool next(int i, Unit& u) const {
        const long L = (long)i * G + c; if (L >= nwg) return false;
        int wgid = (int)L; { const int q = nwg / NXCD, r = nwg % NXCD, xcd = wgid % NXCD, off = wgid / NXCD; wgid = (xcd < r ? xcd * (q + 1) : r * (q + 1) + (xcd - r) * q) + off; }
        const int nig = WGM * nN, gid = wgid / nig, fm = gid * WGM, gsz = (nM - fm) < WGM ? (nM - fm) : WGM;
        u.pm = fm + ((wgid % nig) % gsz); u.pn = (wgid % nig) / gsz;
        if (skip) u.pm = (u.pm >> 4) * 17 + 1 + (u.pm & 15);
        return true;
    }
    __device__ __forceinline__ void a_ready(const Unit&) const {}
    __device__ __forceinline__ void done(const Unit&) const {}
};
__device__ __forceinline__ unsigned cvt_pk_bf16(float lo, float hi) { unsigned r; asm volatile("v_cvt_pk_bf16_f32 %0, %1, %2" : "=v"(r) : "v"(lo), "v"(hi)); return r; }
template <class Epi, class Sched, bool STAMP = false>
__device__ __forceinline__ void gemm_phase(PG8_LAS unsigned char* lds, const Gemm g, const Sched& S, const Epi& E, unsigned long long* stamps) {
    const int tid = TIDX, wid = __builtin_amdgcn_readfirstlane(tid >> 6), lane = tid & 63, wr = wid >> 2, wc = wid & 3, fr = lane & 15, fq = lane >> 4;
    const int K = g.K, nt = K / BK;
    int ts_lo = 0, ts_hi = 0, nts = 0; const unsigned long long rt_entry = STAMP ? (unsigned long long)wall_clock64() : 0ull;
#define PG8_STAMP() do { if (STAMP && wid == 0 && nts < 64) { const unsigned long long _c = (unsigned long long)clock64(); \
        ts_lo = (lane == nts) ? (int)(unsigned)_c : ts_lo; ts_hi = (lane == nts) ? (int)(unsigned)(_c >> 32) : ts_hi; ++nts; } } while (0)
    PG8_STAMP();
    unsigned voffA[2], voffB[2];
#pragma unroll
    for (int i = 0; i < 2; ++i) { int R, C; stage_rc(tid * 16 + i * 8192, R, C); const int Rb = Epi::PERM ? ((R & ~31) + perm32(R & 31)) : R;
        voffA[i] = (unsigned)(R * g.lda + C) * 2u; voffB[i] = (unsigned)(Rb * K + C) * 2u; }
    const size_t kstep = (size_t)(BK * 2);
    const size_t hstepB = (size_t)HALF * K * 2, hstepA = (size_t)HALF * g.lda * 2;
    const size_t tstepB = 2 * hstepB, tstepA = 2 * hstepA;
    const unsigned ldsw = (unsigned)wid * 1024u;
    const int aoff = lds_byte(wr * 64 + fr, fq * 8), boff = lds_byte(wc * 32 + fr, fq * 8);
#define PG8_SA(b, h) (((b) * 2 + (h)) * HTB)
#define PG8_SB(b, h) ((4 + (b) * 2 + (h)) * HTB)
#define PG8_STAGE(bufoff, gbase, voff) do { _Pragma("unroll") for (int _i = 0; _i < 2; ++_i) \
        __builtin_amdgcn_global_load_lds((const unsigned*)((const char*)(gbase) + (voff)[_i]), (PG8_LAS unsigned*)(lds + (bufoff) + ldsw + _i * 8192), 16, 0, 0); } while (0)
#define PG8_LDA(dst, b, h) do { _Pragma("unroll") for (int m = 0; m < 4; ++m) _Pragma("unroll") for (int k = 0; k < 2; ++k) dst[m][k] = *(const PG8_LAS bf16x8*)(lds + PG8_SA(b, h) + aoff + m * 2048 + k * 1024); } while (0)
#define PG8_LDB(dst, b, h) do { _Pragma("unroll") for (int n = 0; n < 2; ++n) _Pragma("unroll") for (int k = 0; k < 2; ++k) dst[n][k] = *(const PG8_LAS bf16x8*)(lds + PG8_SB(b, h) + boff + n * 2048 + k * 1024); } while (0)
#define PG8_MMA(ai, bj, At, Bt) do { __builtin_amdgcn_s_setprio(1); _Pragma("unroll") for (int m = 0; m < 4; ++m) _Pragma("unroll") for (int n = 0; n < 2; ++n) _Pragma("unroll") for (int k = 0; k < 2; ++k) \
        acc[ai][bj][m][n] = __builtin_amdgcn_mfma_f32_16x16x32_bf16(Bt[n][k], At[m][k], acc[ai][bj][m][n], 0, 0, 0); __builtin_amdgcn_s_setprio(0); } while (0)
#define PG8_WAIT_V(n) asm volatile("s_waitcnt vmcnt(" #n ")" ::: "memory")
#define PG8_WAIT_L(n) asm volatile("s_waitcnt lgkmcnt(" #n ")" ::: "memory")
#define PG8_BAR __builtin_amdgcn_s_barrier()
#define PG8_SCHED __builtin_amdgcn_sched_barrier(0)
    Unit cur, nxt; int ui = 0;
    if (!S.next(0, cur)) return;
    f32x4 acc[2][2][4][2];
#pragma unroll
    for (int a = 0; a < 2; ++a)
#pragma unroll
        for (int b = 0; b < 2; ++b)
#pragma unroll
            for (int m = 0; m < 4; ++m)
#pragma unroll
                for (int n = 0; n < 2; ++n) acc[a][b][m][n] = (f32x4){0.f, 0.f, 0.f, 0.f};
    bf16x8 At[4][2], B0[2][2], B1[2][2];
    const char* cA = (const char*)g.A + (size_t)cur.pm * tstepA; const char* cB = (const char*)g.Bt + (size_t)cur.pn * tstepB;
    S.a_ready(cur);
    PG8_STAGE(PG8_SB(0, 0), cB, voffB); PG8_STAGE(PG8_SA(0, 0), cA, voffA); PG8_STAGE(PG8_SB(0, 1), cB + hstepB, voffB); PG8_STAGE(PG8_SA(0, 1), cA + hstepA, voffA);
    if (wr == 1) PG8_BAR;
    PG8_WAIT_V(4); PG8_BAR;
    PG8_STAGE(PG8_SB(1, 0), cB + kstep, voffB); PG8_STAGE(PG8_SA(1, 0), cA + kstep, voffA); PG8_STAGE(PG8_SB(1, 1), cB + hstepB + kstep, voffB);
    PG8_WAIT_V(6); PG8_BAR;
    PG8_STAMP();
    for (;;) {
        const bool has_next = S.next(ui + 1, nxt);
        const char* nA = has_next ? (const char*)g.A + (size_t)nxt.pm * tstepA : cA; const char* nB = has_next ? (const char*)g.Bt + (size_t)nxt.pn * tstepB : cB;
        for (int t = 0; t < nt; t += 2) {
            const bool last = (t == nt - 2);
            const char* a1 = cA + (size_t)(t + 1) * kstep;
            const char* a2 = last ? nA : cA + (size_t)(t + 2) * kstep; const char* b2 = last ? nB : cB + (size_t)(t + 2) * kstep;
            const char* a3 = a2 + kstep; const char* b3 = b2 + kstep;
            if (last && has_next) S.a_ready(nxt);
            PG8_LDB(B0, 0, 0); PG8_SCHED; PG8_LDA(At, 0, 0); PG8_STAGE(PG8_SA(1, 1), a1 + hstepA, voffA);
            PG8_WAIT_L(8); PG8_BAR; PG8_WAIT_L(0); PG8_MMA(0, 0, At, B0); PG8_BAR; PG8_SCHED;
            PG8_LDB(B1, 0, 1); PG8_STAGE(PG8_SB(0, 0), b2, voffB);
            PG8_BAR; PG8_WAIT_L(0); PG8_MMA(0, 1, At, B1); PG8_BAR;
            PG8_LDA(At, 0, 1); PG8_STAGE(PG8_SA(0, 0), a2, voffA);
            PG8_BAR; PG8_WAIT_L(0); PG8_MMA(1, 0, At, B0); PG8_BAR; PG8_SCHED;
            PG8_STAGE(PG8_SB(0, 1), b2 + hstepB, voffB);
            PG8_WAIT_V(6); PG8_BAR; PG8_MMA(1, 1, At, B1); PG8_BAR;
            PG8_LDB(B0, 1, 0); PG8_SCHED; PG8_LDA(At, 1, 0); PG8_STAGE(PG8_SA(0, 1), a2 + hstepA, voffA);
            PG8_WAIT_L(8); PG8_BAR; PG8_WAIT_L(0); PG8_MMA(0, 0, At, B0); PG8_BAR; PG8_SCHED;
            PG8_LDB(B1, 1, 1); PG8_STAGE(PG8_SB(1, 0), b3, voffB);
            PG8_BAR; PG8_WAIT_L(0); PG8_MMA(0, 1, At, B1); PG8_BAR;
            PG8_LDA(At, 1, 1); PG8_STAGE(PG8_SA(1, 0), a3, voffA);
            PG8_BAR; PG8_WAIT_L(0); PG8_MMA(1, 0, At, B0); PG8_BAR; PG8_SCHED;
            PG8_STAGE(PG8_SB(1, 1), b3 + hstepB, voffB);
            PG8_WAIT_V(6); PG8_BAR; PG8_MMA(1, 1, At, B1); PG8_BAR;
        }
        PG8_STAMP();
        if constexpr (!Epi::AFTER_DRAIN) { E(acc, cur, wr, wc, fr, fq); S.done(cur); }
        PG8_STAMP();
        if (!has_next) break;
#pragma unroll
        for (int a = 0; a < 2; ++a)
#pragma unroll
            for (int b = 0; b < 2; ++b)
#pragma unroll
                for (int m = 0; m < 4; ++m)
#pragma unroll
                    for (int n = 0; n < 2; ++n) acc[a][b][m][n] = (f32x4){0.f, 0.f, 0.f, 0.f};
        cur = nxt; cA = nA; cB = nB; ++ui;
    }
    PG8_WAIT_V(0);
    if (wr == 0) PG8_BAR;
    PG8_BAR;
    if constexpr (Epi::AFTER_DRAIN) { E.fused(acc, cur, wr, wc, fr, fq, lds, wid, lane); S.done(cur); }
    PG8_STAMP();
    if (STAMP && wid == 0) { stamps[lane] = lane < nts ? (((unsigned long long)(unsigned)ts_hi << 32) | (unsigned)ts_lo) : 0ull;
        if (lane == 62) stamps[62] = rt_entry; if (lane == 63) stamps[63] = (unsigned long long)wall_clock64(); }
#undef PG8_STAMP
#undef PG8_SA
#undef PG8_SB
#undef PG8_STAGE
#undef PG8_LDA
#undef PG8_LDB
#undef PG8_MMA
#undef PG8_WAIT_V
#undef PG8_WAIT_L
#undef PG8_BAR
#undef PG8_SCHED
}
}

struct EpiBf {
  static constexpr bool PERM = true, AFTER_DRAIN = false;
  u16* O; int ldc; const float* bias; int act;
  __device__ __forceinline__ void operator()(const f32x4 (&acc)[2][2][4][2], const pg8::Unit& u, int wr, int wc, int fr, int fq) const {
    const int row0 = u.pm * 256 + wr * 64 + fr, col0 = u.pn * 256 + wc * 32 + 8 * fq;
    f32x4 bv[2][2];
#pragma unroll
    for (int bj = 0; bj < 2; ++bj)
#pragma unroll
      for (int n = 0; n < 2; ++n) bv[bj][n] = bias ? *(const f32x4*)(bias + col0 + bj * 128 + 4 * n) : f32x4{0.f, 0.f, 0.f, 0.f};
#pragma unroll
    for (int ai = 0; ai < 2; ++ai)
#pragma unroll
      for (int m = 0; m < 4; ++m) {
        u16* rowp = O + (size_t)(row0 + ai * 128 + m * 16) * ldc + col0;
#pragma unroll
        for (int bj = 0; bj < 2; ++bj) {
          f32x4 v0 = acc[ai][bj][m][0] + bv[bj][0], v1 = acc[ai][bj][m][1] + bv[bj][1];
          if (act == 1) {
#pragma unroll
            for (int j = 0; j < 4; ++j) { v0[j] = sigm(v0[j]); v1[j] = sigm(v1[j]); }
          }
          uint4 wv;
          wv.x = pack2(v0[0], v0[1]); wv.y = pack2(v0[2], v0[3]); wv.z = pack2(v1[0], v1[1]); wv.w = pack2(v1[2], v1[3]);
          *(uint4*)(rowp + bj * 128) = wv;
        }
      }
  }
};
struct EpiSwiglu {
  static constexpr bool PERM = true, AFTER_DRAIN = false;
  u16* O;
  __device__ __forceinline__ void operator()(const f32x4 (&acc)[2][2][4][2], const pg8::Unit& u, int wr, int wc, int fr, int fq) const {
    const int row0 = u.pm * 256 + wr * 64 + fr, col0 = u.pn * 128 + wc * 16 + 4 * fq;
#pragma unroll
    for (int ai = 0; ai < 2; ++ai)
#pragma unroll
      for (int m = 0; m < 4; ++m) {
        u16* rowp = O + (size_t)(row0 + ai * 128 + m * 16) * FH + col0;
#pragma unroll
        for (int bj = 0; bj < 2; ++bj) {
          const f32x4 g = acc[ai][bj][m][0], up = acc[ai][bj][m][1];
          uint2 wv;
          wv.x = pack2(siluf(g[0]) * up[0], siluf(g[1]) * up[1]);
          wv.y = pack2(siluf(g[2]) * up[2], siluf(g[3]) * up[3]);
          *(uint2*)(rowp + bj * 64) = wv;
        }
      }
  }
};
struct EpiGateAcc {
  static constexpr bool PERM = true, AFTER_DRAIN = false;
  u16* ACC; const u16* G; int gcol; unsigned amask;
  __device__ __forceinline__ void operator()(const f32x4 (&acc)[2][2][4][2], const pg8::Unit& u, int wr, int wc, int fr, int fq) const {
    unsigned pk[2][2][4][4];
#pragma unroll
    for (int ai = 0; ai < 2; ++ai)
#pragma unroll
      for (int bj = 0; bj < 2; ++bj)
#pragma unroll
        for (int m = 0; m < 4; ++m) {
          pk[ai][bj][m][0] = pack2(acc[ai][bj][m][0][0], acc[ai][bj][m][0][1]);
          pk[ai][bj][m][1] = pack2(acc[ai][bj][m][0][2], acc[ai][bj][m][0][3]);
          pk[ai][bj][m][2] = pack2(acc[ai][bj][m][1][0], acc[ai][bj][m][1][1]);
          pk[ai][bj][m][3] = pack2(acc[ai][bj][m][1][2], acc[ai][bj][m][1][3]);
        }
    asm volatile("" ::: "memory");
    const int row0 = u.pm * 256 + wr * 64 + fr, col0 = u.pn * 256 + wc * 32 + 8 * fq;
#pragma unroll
    for (int ai = 0; ai < 2; ++ai)
#pragma unroll
      for (int m = 0; m < 4; ++m) {
        const size_t row = (size_t)(row0 + ai * 128 + m * 16);
#pragma unroll
        for (int bj = 0; bj < 2; ++bj) {
          const int col = col0 + bj * 128;
          const uint4 gv = *(const uint4*)(G + row * 2048 + gcol + col);
          const uint4 av = *(const uint4*)(ACC + row * DM + col);
          const unsigned gw[4] = {gv.x, gv.y, gv.z, gv.w};
          const unsigned aw[4] = {av.x & amask, av.y & amask, av.z & amask, av.w & amask};
          unsigned ow[4];
#pragma unroll
          for (int q = 0; q < 4; ++q) {
            const unsigned pv = pk[ai][bj][m][q];
            const float lo = __uint_as_float(aw[q] << 16) + __uint_as_float(gw[q] << 16) * __uint_as_float(pv << 16);
            const float hi = __uint_as_float(aw[q] & 0xffff0000u) + __uint_as_float(gw[q] & 0xffff0000u) * __uint_as_float(pv & 0xffff0000u);
            ow[q] = pack2(lo, hi);
          }
          *(uint4*)(ACC + row * DM + col) = make_uint4(ow[0], ow[1], ow[2], ow[3]);
        }
        asm volatile("" ::: "memory");
      }
  }
};

template <int MI>
__device__ __forceinline__ void gemm_loop(const u16* __restrict__ A, int lda, const u16* __restrict__ Bt, int ldb, int K,
                                          f32x4 (&acc)[MI][4], u16* sA, u16* sB) {
  constexpr int BMT = MI * 64;
  const int tid = TIDX, lane = tid & 63, w = tid >> 6, wm = w >> 1, wn = w & 1, fr = lane & 15, fq = lane >> 4;
  uint4 ra[MI], rb[2];
  const u16* ga = A + (size_t)(tid >> 3) * lda + (tid & 7) * 8;
  const u16* gb = Bt + (size_t)(tid >> 3) * ldb + (tid & 7) * 8;
  const int so = (tid >> 3) * LDT + (tid & 7) * 8;
#pragma unroll
  for (int i = 0; i < MI; i++) ra[i] = *(const uint4*)(ga + (size_t)(i * 64) * lda);
#pragma unroll
  for (int i = 0; i < 2; i++) rb[i] = *(const uint4*)(gb + (size_t)(i * 64) * ldb);
#pragma unroll
  for (int i = 0; i < MI; i++) *(uint4*)(sA + so + i * 64 * LDT) = ra[i];
#pragma unroll
  for (int i = 0; i < 2; i++) *(uint4*)(sB + so + i * 64 * LDT) = rb[i];
  __syncthreads();
  const int nk = K >> 6;
  for (int kt = 0; kt < nk; kt++) {
    const bool more = kt + 1 < nk;
    if (more) {
#pragma unroll
      for (int i = 0; i < MI; i++) ra[i] = *(const uint4*)(ga + (size_t)(i * 64) * lda + (kt + 1) * 64);
#pragma unroll
      for (int i = 0; i < 2; i++) rb[i] = *(const uint4*)(gb + (size_t)(i * 64) * ldb + (kt + 1) * 64);
    }
    const u16* a = sA + (kt & 1) * BMT * LDT + (wm * (MI * 16) + fr) * LDT + fq * 8;
    const u16* b = sB + (kt & 1) * 128 * LDT + (wn * 64 + fr) * LDT + fq * 8;
#pragma unroll
    for (int ks = 0; ks < 2; ks++) {
      bf16x8 af[MI], bfr[4];
#pragma unroll
      for (int i = 0; i < MI; i++) af[i] = *(const bf16x8*)(a + i * 16 * LDT + ks * 32);
#pragma unroll
      for (int j = 0; j < 4; j++) bfr[j] = *(const bf16x8*)(b + j * 16 * LDT + ks * 32);
#pragma unroll
      for (int i = 0; i < MI; i++)
#pragma unroll
        for (int j = 0; j < 4; j++) acc[i][j] = __builtin_amdgcn_mfma_f32_16x16x32_bf16(bfr[j], af[i], acc[i][j], 0, 0, 0);
    }
    if (more) {
      u16* da = sA + ((kt + 1) & 1) * BMT * LDT + so;
      u16* db = sB + ((kt + 1) & 1) * 128 * LDT + so;
#pragma unroll
      for (int i = 0; i < MI; i++) *(uint4*)(da + i * 64 * LDT) = ra[i];
#pragma unroll
      for (int i = 0; i < 2; i++) *(uint4*)(db + i * 64 * LDT) = rb[i];
    }
    __syncthreads();
  }
}

template <int MI>
__device__ __forceinline__ void zero_acc(f32x4 (&acc)[MI][4]) {
#pragma unroll
  for (int i = 0; i < MI; i++)
#pragma unroll
    for (int j = 0; j < 4; j++) acc[i][j] = f32x4{0.f, 0.f, 0.f, 0.f};
}


typedef unsigned u32x4v __attribute__((ext_vector_type(4)));
__device__ __forceinline__ void yp_issue(const u16* __restrict__ A, const u16* __restrict__ B, u32x4v (&ra)[8], u32x4v (&rb)[8], int tid) {
#pragma unroll
  for (int i = 0; i < 8; i++) {
    const int c = tid + i * NTHR, row = c >> 5, ch = c & 31;
    ra[i] = *(const u32x4v*)(A + (size_t)row * YST + ch * 8);
    rb[i] = *(const u32x4v*)(B + (size_t)row * 256 + ch * 8);
  }
}
__device__ __forceinline__ void yp_stage(unsigned char* sA, unsigned char* sB, const u32x4v (&ra)[8], const u32x4v (&rb)[8], int tid) {
#pragma unroll
  for (int i = 0; i < 8; i++) {
    const int c = tid + i * NTHR, row = c >> 5, ch = c & 31;
    const int off = row * 512 + ((ch ^ (row & 7)) << 4);
    *(u32x4v*)(sA + off) = ra[i];
    *(u32x4v*)(sB + off) = rb[i];
  }
}
__device__ __forceinline__ void phase_ypart(const Params& p, int l, unsigned char* smem) {
  unsigned char* sA = smem;
  unsigned char* sB = smem + 65536;
  const int tid = TIDX, lane = tid & 63, w = tid >> 6, wm = w >> 1, wn = w & 1, fr = lane & 15, fq = lane >> 4;
  const u16* Y = (const u16*)(p.ws + OFF_YS);
  const u16* Wb = (const u16*)(p.ws + OFF_W + OW_B);
  const u16* G = (const u16*)(p.ws + OFF_BIG);
  u16* ACC = (u16*)(p.ws + OFF_H);
  constexpr int NT = 8;
  const int ntiles = (NROWS / 128) * NT;
  const int G_ = gridDim.x;
  const bool xmap = (G_ == 256);
  const int xj = blockIdx.x >> 3, xx = blockIdx.x & 7;
  const bool skipc = (l == 1);
  const int nrt = skipc ? 256 : 272;
  const int ntl = nrt * NT;
  const int nmine = xmap ? (xj < nrt ? (nrt - 1 - xj) / 32 + 1 : 0)
                         : (((int)blockIdx.x < ntl) ? (ntl - 1 - (int)blockIdx.x) / G_ + 1 : 0);
  if (nmine == 0) return;
#define YP_TILE(Q_, MT_, NT_)                                                        \
  do {                                                                               \
    if (xmap) { const int s_ = (Q_) * 32 + xj; MT_ = (s_ >> 3) * 8 + xx; NT_ = s_ & 7; } \
    else { const int t_ = blockIdx.x + (Q_) * G_; MT_ = t_ / NT; NT_ = t_ - MT_ * NT; }  \
    if (skipc) MT_ = (MT_ >> 5) * 34 + 2 + (MT_ & 31);                                   \
  } while (0)
  u32x4v ra[8], rb[8];
  {
    int mt, nt;
    YP_TILE(0, mt, nt);
    yp_issue(Y + (size_t)mt * 128 * YST, Wb + ((size_t)nt * 128) * 256, ra, rb, tid);
  }
  f32x4 tot[2][4];
  zero_acc<2>(tot);
  for (int qi = 0; qi < 4 * nmine; qi++) {
    const int q = qi >> 2, k = qi & 3;
    int mt, nt;
    YP_TILE(q, mt, nt);
    const int r0 = mt * 128 + wm * 32 + fr, c0 = nt * 128 + wn * 64 + fq * 4;
    __syncthreads();
    yp_stage(sA, sB, ra, rb, tid);
    __syncthreads();
    {
      const int qn = qi + 1 < 4 * nmine ? qi + 1 : qi;
      int mtn, ntn;
      YP_TILE(qn >> 2, mtn, ntn);
      const int brn = qn & 3, ycn = brn < 3 ? brn * 256 : 1536;
      yp_issue(Y + (size_t)mtn * 128 * YST + ycn, Wb + ((size_t)brn * 1024 + ntn * 128) * 256, ra, rb, tid);
    }
    uint2 gv[2][4];
#pragma unroll
    for (int i = 0; i < 2; i++)
#pragma unroll
      for (int j = 0; j < 4; j++) gv[i][j] = *(const uint2*)(G + (size_t)(r0 + i * 16) * 4096 + k * 1024 + c0 + j * 16);
    f32x4 ay[2][4];
    zero_acc<2>(ay);
#pragma unroll 2
    for (int ks = 0; ks < 8; ks++) {
      bf16x8 af[2], bfr[4];
#pragma unroll
      for (int i = 0; i < 2; i++) {
        const int row = wm * 32 + i * 16 + fr;
        af[i] = *(const bf16x8*)(sA + row * 512 + (((ks * 4 + fq) ^ (row & 7)) << 4));
      }
#pragma unroll
      for (int j = 0; j < 4; j++) {
        const int row = wn * 64 + j * 16 + fr;
        bfr[j] = *(const bf16x8*)(sB + row * 512 + (((ks * 4 + fq) ^ (row & 7)) << 4));
      }
#pragma unroll
      for (int i = 0; i < 2; i++)
#pragma unroll
        for (int j = 0; j < 4; j++) ay[i][j] = __builtin_amdgcn_mfma_f32_16x16x32_bf16(bfr[j], af[i], ay[i][j], 0, 0, 0);
    }
#pragma unroll
    for (int i = 0; i < 2; i++)
#pragma unroll
      for (int j = 0; j < 4; j++) {
        tot[i][j][0] += __uint_as_float(gv[i][j].x << 16) * ay[i][j][0];
        tot[i][j][1] += __uint_as_float(gv[i][j].x & 0xffff0000u) * ay[i][j][1];
        tot[i][j][2] += __uint_as_float(gv[i][j].y << 16) * ay[i][j][2];
        tot[i][j][3] += __uint_as_float(gv[i][j].y & 0xffff0000u) * ay[i][j][3];
      }
    if (k == 3) {
#pragma unroll
      for (int i = 0; i < 2; i++)
#pragma unroll
        for (int j = 0; j < 4; j++) {
          uint2 ov;
          ov.x = pack2(tot[i][j][0], tot[i][j][1]); ov.y = pack2(tot[i][j][2], tot[i][j][3]);
          *(uint2*)(ACC + (size_t)(r0 + i * 16) * DM + c0 + j * 16) = ov;
        }
      zero_acc<2>(tot);
    }
  }
  __syncthreads();
#undef YP_TILE
}

#define S2_BUF 10816
#define S2_D 0
#define S2_U 2048
#define S2_P 4096
#define S2_K 6144
#define S2_DQ 8192
#define S2_V 10240
#define S2_C1 10752
#define S2_C2 10784
#define S2_ST (2 * S2_BUF)
#define S2_YB (S2_ST + 8192)

__device__ __forceinline__ float red16(float x) {
  x += dppf<0xB1>(x);
  x += dppf<0x4E>(x);
  x += dppf<0x141>(x);
  x += dppf<0x140>(x);
  return x;
}
__device__ __forceinline__ void wave_lds_sync() {
  asm volatile("s_waitcnt lgkmcnt(0)" ::: "memory");
  __builtin_amdgcn_wave_barrier();
}

template <int MIX>
__device__ __forceinline__ void scan2_item(const Params& p, int l, int b, int h, int dir, int rq, float* sm) {
  constexpr int EPL = (MIX == 2) ? 2 : 4;
  constexpr int VOFF = (MIX == 2) ? 64 : 128;
  const int tid = TIDX, lane = tid & 63, w = tid >> 6, fr = lane & 15, fq = lane >> 4;
  const bool producer = w >= 4;
  const int pw = w & 3;
  const u16* P = (const u16*)(p.ws + OFF_BIG);
  u16* YS = (u16*)(p.ws + OFF_YS);
  float* BC = (float*)(p.ws + OFF_BC);
  float* ST = sm + S2_ST + pw * 2048;
  float s[EPL];
#pragma unroll
  for (int i = 0; i < EPL; i++) s[i] = 0.f;

  bf16x8 bw2[4], ba2[4];
  float cst[5][4];
  float cw[3][7];
  float muv[4];
  int colv[4];
#pragma unroll
  for (int i = 0; i < 4; i++) { bw2[i] = bf16x8{0, 0, 0, 0, 0, 0, 0, 0}; ba2[i] = bw2[i]; muv[i] = 0.f; colv[i] = 0; }
  if (producer) {
    if (MIX == 0) {
#pragma unroll
      for (int nt = 0; nt < 4; nt++) {
        const int jch = h * 64 + nt * 16 + fr;
#pragma unroll
        for (int jj = 0; jj < 8; jj++) {
          bw2[nt][jj] = (short)f2bf(p.rwkv_w2[((size_t)(l * 2 + dir) * 32 + fq * 8 + jj) * 256 + jch]);
          ba2[nt][jj] = (short)f2bf(p.rwkv_a2[((size_t)(l * 2 + dir) * 32 + fq * 8 + jj) * 256 + jch]);
        }
        cst[0][nt] = p.rwkv_w0[(l * 2 + dir) * 256 + jch];
        cst[1][nt] = p.rwkv_a0[(l * 2 + dir) * 256 + jch];
        cst[2][nt] = p.rwkv_ka[l * 256 + jch];
        cst[3][nt] = p.rwkv_kk[l * 256 + jch];
        cst[4][nt] = p.rwkv_rk[l * 256 + jch];
      }
#pragma unroll
      for (int i = 0; i < 4; i++) {
        const int c = lane + 64 * i;
        colv[i] = i < 3 ? i * 256 + h * 64 + lane : (lane < 32 ? 768 + dir * 32 + lane : 832 + dir * 32 + (lane - 32));
        muv[i] = p.rwkv_mu[l * 960 + colv[i]];
        (void)c;
      }
    } else if (MIX == 1) {
#pragma unroll
      for (int i = 0; i < 3; i++) {
        colv[i] = PB + i * 256 + h * 64 + lane;
#pragma unroll
        for (int tp = 0; tp < 7; tp++) cw[i][tp] = p.gdn_conv[((size_t)l * 7 + tp) * 768 + i * 256 + h * 64 + lane];
      }
    } else {
#pragma unroll
      for (int nt = 0; nt < 2; nt++) {
#pragma unroll
        for (int jj = 0; jj < 8; jj++)
          bw2[nt][jj] = fq < 2 ? (short)f2bf(p.gla_gw2[((size_t)(l * 2 + dir) * 16 + fq * 8 + jj) * 128 + h * 32 + nt * 16 + fr]) : (short)0;
        cst[0][nt] = p.gla_gb[(l * 2 + dir) * 128 + h * 32 + nt * 16 + fr];
      }
      colv[0] = PC + h * 32 + lane;
      if (lane >= 32) colv[0] = PC + 128 + h * 32 + (lane - 32);
      colv[1] = PC + 256 + h * 64 + lane;
      colv[2] = PC + 512 + dir * 16 + (lane & 15);
    }
  }
  __syncthreads();

  for (int c = 0; c <= TPB / 32 + 1; c++) {
    if (producer) {
      if (c >= 2) {
        const int cc = c - 2;
        int seg_row0, t_lo;
        if (cc < 8) { seg_row0 = b * TPB; t_lo = dir == 0 ? cc * 32 : (LC - 32 - cc * 32); }
        else { seg_row0 = b * TPB + LC; t_lo = dir == 0 ? (cc - 8) * 32 : (SEQ - 32 - (cc - 8) * 32); }
        const float* yb = sm + S2_YB + (cc & 1) * 512;
        const int t2 = tid - 256;
#pragma unroll
        for (int i = 0; i < 2; i++) {
          const int idx = t2 + i * 256, tt = idx >> 4, e = idx & 15;
          YS[(size_t)(seg_row0 + t_lo + tt) * YST + dir * 768 + MIX * 256 + h * 64 + rq * 16 + e] = f2bf(yb[idx]);
        }
      }
      if (c < TPB / 32) {
        int seg_row0, seg_len, t_lo;
        if (c < 8) { seg_row0 = b * TPB; seg_len = LC; t_lo = dir == 0 ? c * 32 : (LC - 32 - c * 32); }
        else { seg_row0 = b * TPB + LC; seg_len = SEQ; t_lo = dir == 0 ? (c - 8) * 32 : (SEQ - 32 - (c - 8) * 32); }
        const u16* Pseg = P + (size_t)seg_row0 * PST;
        float* B = sm + (c & 1) * S2_BUF;
        const int t0 = t_lo + pw * 8;
        if (MIX == 0) {
          float raw[10][4];
#pragma unroll
          for (int rr = 0; rr < 10; rr++) {
            const int t = t0 - 1 + rr;
            const float okf = (t >= 0 && t < seg_len) ? 1.f : 0.f;
            const int tc = min(max(t, 0), seg_len - 1);
#pragma unroll
            for (int i = 0; i < 4; i++) raw[rr][i] = bf2f(Pseg[(size_t)tc * PST + PA + colv[i]]) * okf;
          }
#pragma unroll
          for (int j = 0; j < 8; j++)
#pragma unroll
            for (int i = 0; i < 4; i++) {
              float xm = raw[j + 1][i] + (0.5f * (raw[j][i] + raw[j + 2][i]) - raw[j + 1][i]) * muv[i];
              if (i == 3 && lane < 32) xm = tanh_fast(xm);
              ST[j * 256 + lane + 64 * i] = xm;
            }
        } else if (MIX == 1) {
          float raw[14][3];
#pragma unroll
          for (int rr = 0; rr < 14; rr++) {
            const int t = t0 - 3 + rr;
            const float okf = (t >= 0 && t < seg_len) ? 1.f : 0.f;
            const int tc = min(max(t, 0), seg_len - 1);
#pragma unroll
            for (int i = 0; i < 3; i++) raw[rr][i] = bf2f(Pseg[(size_t)tc * PST + colv[i]]) * okf;
          }
#pragma unroll
          for (int j = 0; j < 8; j++)
#pragma unroll
            for (int i = 0; i < 3; i++) {
              float a = 0.f;
#pragma unroll
              for (int tp = 0; tp < 7; tp++) a += raw[j + tp][i] * cw[i][tp];
              ST[j * 256 + lane + 64 * i] = siluf(a);
            }
          if (lane < 8) {
            const u16* pp = Pseg + (size_t)(t0 + lane) * PST + PB;
            float bx = bf2f(pp[768 + dir * 4 + h]);
            float ax = bf2f(pp[776 + dir * 4 + h]);
            float ld = -__expf(p.gdn_a_log[(l * 2 + dir) * 4 + h]) * softplusf(ax + p.gdn_dt_bias[(l * 2 + dir) * 4 + h]);
            ST[lane * 256 + 192] = sigm(bx);
            ST[lane * 256 + 193] = __expf(ld);
          }
        } else {
          u16 raw[8][3];
#pragma unroll
          for (int j = 0; j < 8; j++) {
            const u16* pp = Pseg + (size_t)(t0 + j) * PST;
#pragma unroll
            for (int i = 0; i < 3; i++) raw[j][i] = pp[colv[i]];
          }
          const float qs = lane < 32 ? 0.17677669529663687f : 1.f;
#pragma unroll
          for (int j = 0; j < 8; j++) {
            ST[j * 256 + lane] = bf2f(raw[j][0]) * qs;
            ST[j * 256 + 64 + lane] = bf2f(raw[j][1]);
            if (lane < 16) ST[j * 256 + 128 + lane] = bf2f(raw[j][2]);
          }
        }
        wave_lds_sync();
        const bool vl = fq < 2;
        if (MIX == 0) {
          bf16x8 aw, aa;
#pragma unroll
          for (int jj = 0; jj < 8; jj++) {
            aw[jj] = fr < 8 ? (short)f2bf(ST[fr * 256 + 192 + fq * 8 + jj]) : (short)0;
            aa[jj] = fr < 8 ? (short)f2bf(ST[fr * 256 + 224 + fq * 8 + jj]) : (short)0;
          }
          f32x4 accw[4], acca[4];
#pragma unroll
          for (int nt = 0; nt < 4; nt++) {
            accw[nt] = __builtin_amdgcn_mfma_f32_16x16x32_bf16(aw, bw2[nt], f32x4{0.f, 0.f, 0.f, 0.f}, 0, 0, 0);
            acca[nt] = __builtin_amdgcn_mfma_f32_16x16x32_bf16(aa, ba2[nt], f32x4{0.f, 0.f, 0.f, 0.f}, 0, 0, 0);
          }
#pragma unroll
          for (int r = 0; r < 4; r++) {
            const int j = (fq & 1) * 4 + r, tt = pw * 8 + j;
            float kkx[4], av[4], kdv[4], rv[4], dec[4];
            float ss = 0.f;
#pragma unroll
            for (int nt = 0; nt < 4; nt++) {
              const int n = nt * 16 + fr;
              rv[nt] = ST[j * 256 + n];
              const float kx = ST[j * 256 + 64 + n];
              dec[nt] = __expf(-0.6065306597126334f * sigm(cst[0][nt] + accw[nt][r]));
              av[nt] = sigm(cst[1][nt] + acca[nt][r]);
              kdv[nt] = kx * (1.f + (av[nt] - 1.f) * cst[2][nt]);
              kkx[nt] = kx * cst[3][nt];
              ss += kkx[nt] * kkx[nt];
            }
            ss = red16(ss);
            const float rs = rsq(ss + 1e-6f);
            float c1 = 0.f, c2 = 0.f, bc = 0.f;
#pragma unroll
            for (int nt = 0; nt < 4; nt++) {
              const int n = nt * 16 + fr;
              const float kk = kkx[nt] * rs;
              if (vl) {
                B[S2_D + tt * 64 + n] = dec[nt];
                B[S2_U + tt * 64 + n] = kk;
                B[S2_P + tt * 64 + n] = -kk * av[nt];
                B[S2_K + tt * 64 + n] = kdv[nt];
                B[S2_DQ + tt * 64 + n] = dec[nt] * rv[nt];
              }
              c1 += -kk * av[nt] * rv[nt];
              c2 += kdv[nt] * rv[nt];
              bc += rv[nt] * kdv[nt] * cst[4][nt];
            }
            c1 = red16(c1); c2 = red16(c2); bc = red16(bc);
            if (vl && fr == 0) {
              B[S2_C1 + tt] = c1;
              B[S2_C2 + tt] = c2;
              if (rq == 0) BC[(size_t)(seg_row0 + t_lo + tt) * 8 + h * 2 + dir] = bc;
            }
          }
        } else if (MIX == 1) {
#pragma unroll
          for (int r = 0; r < 4; r++) {
            const int j = (fq & 1) * 4 + r, tt = pw * 8 + j;
            float qv[4], kv[4];
            float sq = 0.f, sk = 0.f;
#pragma unroll
            for (int nt = 0; nt < 4; nt++) {
              const int n = nt * 16 + fr;
              qv[nt] = ST[j * 256 + n];
              kv[nt] = ST[j * 256 + 64 + n];
              sq += qv[nt] * qv[nt];
              sk += kv[nt] * kv[nt];
            }
            sq = red16(sq); sk = red16(sk);
            const float rq_ = rsq(sq + 1e-6f) * 0.125f, rk_ = rsq(sk + 1e-6f);
            const float beta = ST[j * 256 + 192], alpha = ST[j * 256 + 193];
            float dkq = 0.f;
#pragma unroll
            for (int nt = 0; nt < 4; nt++) {
              const int n = nt * 16 + fr;
              const float qn = qv[nt] * rq_, kn = kv[nt] * rk_;
              if (vl) {
                B[S2_D + tt * 64 + n] = alpha;
                B[S2_U + tt * 64 + n] = kn;
                B[S2_P + tt * 64 + n] = -alpha * beta * kn;
                B[S2_K + tt * 64 + n] = beta * kn;
                B[S2_DQ + tt * 64 + n] = alpha * qn;
              }
              dkq += kn * qn;
            }
            dkq = red16(dkq);
            if (vl && fr == 0) {
              B[S2_C1 + tt] = -alpha * beta * dkq;
              B[S2_C2 + tt] = beta * dkq;
            }
          }
        } else {
          bf16x8 ag;
#pragma unroll
          for (int jj = 0; jj < 8; jj++) ag[jj] = (fr < 8 && fq < 2) ? (short)f2bf(ST[fr * 256 + 128 + fq * 8 + jj]) : (short)0;
          f32x4 accg[2];
#pragma unroll
          for (int nt = 0; nt < 2; nt++) accg[nt] = __builtin_amdgcn_mfma_f32_16x16x32_bf16(ag, bw2[nt], f32x4{0.f, 0.f, 0.f, 0.f}, 0, 0, 0);
#pragma unroll
          for (int r = 0; r < 4; r++) {
            const int j = (fq & 1) * 4 + r, tt = pw * 8 + j;
            float dkq = 0.f;
#pragma unroll
            for (int nt = 0; nt < 2; nt++) {
              const int n = nt * 16 + fr;
              const float lg = cst[0][nt] + accg[nt][r];
              const float ls = fminf(lg, 0.f) - __logf(1.f + __expf(-fabsf(lg)));
              const float alpha = __expf(ls * (1.f / 16.f));
              const float qv = ST[j * 256 + n], kv = ST[j * 256 + 32 + n];
              if (vl) {
                B[S2_D + tt * 64 + n] = alpha;
                B[S2_K + tt * 64 + n] = kv;
                B[S2_DQ + tt * 64 + n] = alpha * qv;
              }
              dkq += kv * qv;
            }
            dkq = red16(dkq);
            if (vl && fr == 0) B[S2_C2 + tt] = dkq;
          }
        }
#pragma unroll
        for (int i = 0; i < 2; i++) {
          const int idx = lane + 64 * i, j = idx >> 4, e = idx & 15;
          B[S2_V + (pw * 8 + j) * 16 + e] = ST[j * 256 + VOFF + rq * 16 + e];
        }
      }
    } else if (c >= 1 && c <= TPB / 32) {
      const float* B = sm + ((c - 1) & 1) * S2_BUF;
      float* yb = sm + S2_YB + ((c - 1) & 1) * 512;
      const int rl = w * 4 + fq;
      const int dtt = dir ? -1 : 1;
      int tt = dir ? 31 : 0;
      float dv[EPL], kv[EPL], qv[EPL], uv[EPL], pv[EPL], vv, c1v, c2v;
      float dn[EPL], kn[EPL], qn[EPL], un[EPL], pn[EPL], vn, c1n, c2n;
#define S2_LOAD(D_, K_, Q_, U_, P_, V_, C1_, C2_, T_)                                   \
  do {                                                                                  \
    const int o_ = (T_) * 64 + fr * EPL;                                                \
    if (EPL == 4) {                                                                     \
      float4 t4 = *(const float4*)(B + S2_D + o_);                                      \
      D_[0] = t4.x; D_[1] = t4.y; D_[2] = t4.z; D_[3] = t4.w;                           \
      t4 = *(const float4*)(B + S2_K + o_);                                             \
      K_[0] = t4.x; K_[1] = t4.y; K_[2] = t4.z; K_[3] = t4.w;                           \
      t4 = *(const float4*)(B + S2_DQ + o_);                                            \
      Q_[0] = t4.x; Q_[1] = t4.y; Q_[2] = t4.z; Q_[3] = t4.w;                           \
      t4 = *(const float4*)(B + S2_U + o_);                                             \
      U_[0] = t4.x; U_[1] = t4.y; U_[2] = t4.z; U_[3] = t4.w;                           \
      t4 = *(const float4*)(B + S2_P + o_);                                             \
      P_[0] = t4.x; P_[1] = t4.y; P_[2] = t4.z; P_[3] = t4.w;                           \
      C1_ = B[S2_C1 + (T_)];                                                            \
    } else {                                                                            \
      float2 t2 = *(const float2*)(B + S2_D + o_);                                      \
      D_[0] = t2.x; D_[1] = t2.y;                                                       \
      t2 = *(const float2*)(B + S2_K + o_);                                             \
      K_[0] = t2.x; K_[1] = t2.y;                                                       \
      t2 = *(const float2*)(B + S2_DQ + o_);                                            \
      Q_[0] = t2.x; Q_[1] = t2.y;                                                       \
      U_[0] = U_[1] = P_[0] = P_[1] = 0.f; C1_ = 0.f;                                   \
    }                                                                                   \
    V_ = B[S2_V + (T_) * 16 + rl];                                                      \
    C2_ = B[S2_C2 + (T_)];                                                              \
  } while (0)
#define S2_STEP(D_, K_, Q_, U_, P_, V_, C1_, C2_, T_)                                   \
  do {                                                                                  \
    float sq = 0.f, sa = 0.f;                                                           \
    _Pragma("unroll") for (int i = 0; i < EPL; i++) sq += s[i] * Q_[i];                 \
    if (MIX != 2) {                                                                     \
      _Pragma("unroll") for (int i = 0; i < EPL; i++) sa += s[i] * U_[i];               \
      sa = red16(sa);                                                                   \
    }                                                                                   \
    sq = red16(sq);                                                                     \
    float y = sq + V_ * C2_;                                                            \
    if (MIX != 2) y += sa * C1_;                                                        \
    _Pragma("unroll") for (int i = 0; i < EPL; i++) {                                   \
      float t = s[i] * D_[i] + V_ * K_[i];                                              \
      if (MIX != 2) t += sa * P_[i];                                                    \
      s[i] = t;                                                                         \
    }                                                                                   \
    yb[(T_) * 16 + rl] = y;                                                             \
  } while (0)
      S2_LOAD(dv, kv, qv, uv, pv, vv, c1v, c2v, tt);
#pragma unroll 1
      for (int st = 0; st < 32; st += 2) {
        const int t1 = tt + dtt;
        S2_LOAD(dn, kn, qn, un, pn, vn, c1n, c2n, t1);
        S2_STEP(dv, kv, qv, uv, pv, vv, c1v, c2v, tt);
        const int t2 = st + 2 < 32 ? t1 + dtt : t1;
        S2_LOAD(dv, kv, qv, uv, pv, vv, c1v, c2v, t2);
        S2_STEP(dn, kn, qn, un, pn, vn, c1n, c2n, t1);
        tt = t2;
      }
#undef S2_LOAD
#undef S2_STEP
    }
    __syncthreads();
  }
}

#define S3_SUB 12800
#define S3_GM 0
#define S3_KVT 9216
#define S3_QB 10240
#define S3_QV 11392
#define S3_VT 11520
#define S3_WC 12544
#define S3_STB (8 * S3_SUB)
#define S3_END (S3_STB + 4 * 2304)

__device__ __forceinline__ float rlane(float x, int l) { return __int_as_float(__builtin_amdgcn_readlane(__float_as_int(x), l)); }
__device__ __forceinline__ float wave_sum(float x) {
  x = red16(x);
  return (rlane(x, 0) + rlane(x, 16)) + (rlane(x, 32) + rlane(x, 48));
}
__device__ __forceinline__ float clampe(float x) { return fminf(fmaxf(x, -80.f), 80.f); }
__device__ __forceinline__ uint4 pack8(const float (&v)[8]) {
  return make_uint4(pack2(v[0], v[1]), pack2(v[2], v[3]), pack2(v[4], v[5]), pack2(v[6], v[7]));
}
__device__ __forceinline__ bf16x8 ld_frag(const void* p) { return *(const bf16x8*)p; }
__device__ __forceinline__ bf16x8 zfrag() { return bf16x8{0, 0, 0, 0, 0, 0, 0, 0}; }

__device__ __forceinline__ void chunk_geom(int c, int dir, int b, int& seg_row0, int& seg_len, int& t_lo) {
  if (c < 8) { seg_row0 = b * TPB; seg_len = LC; t_lo = dir == 0 ? c * 32 : (LC - 32 - c * 32); }
  else { seg_row0 = b * TPB + LC; seg_len = SEQ; t_lo = dir == 0 ? (c - 8) * 32 : (SEQ - 32 - (c - 8) * 32); }
}
template <int MIX>
__device__ __forceinline__ void fetch_raw(const u16* P, int c, int dir, int b, int h, int pw, int lane, const int (&colv)[4], unsigned (&rawq)[14][2]) {
  int seg_row0, seg_len, t_lo;
  chunk_geom(c, dir, b, seg_row0, seg_len, t_lo);
  const u16* Pseg = P + (size_t)seg_row0 * PST;
  const int t0 = t_lo + pw * 8;
  if (MIX == 0) {
#pragma unroll
    for (int rr = 0; rr < 10; rr++) {
      const int tc = min(max(t0 - 1 + rr, 0), seg_len - 1);
#pragma unroll
      for (int i = 0; i < 2; i++)
        rawq[rr][i] = (unsigned)Pseg[(size_t)tc * PST + PA + colv[2 * i]] | ((unsigned)Pseg[(size_t)tc * PST + PA + colv[2 * i + 1]] << 16);
    }
  } else if (MIX == 1) {
#pragma unroll
    for (int rr = 0; rr < 14; rr++) {
      const int tc = min(max(t0 - 3 + rr, 0), seg_len - 1);
      rawq[rr][0] = (unsigned)Pseg[(size_t)tc * PST + colv[0]] | ((unsigned)Pseg[(size_t)tc * PST + colv[1]] << 16);
      rawq[rr][1] = (rawq[rr][1] & 0xffff0000u) | (unsigned)Pseg[(size_t)tc * PST + colv[2]];
    }
    const u16* pp = Pseg + (size_t)(t0 + (lane & 7)) * PST + PB;
    rawq[0][1] = (rawq[0][1] & 0xffffu) | ((unsigned)pp[768 + dir * 4 + h] << 16);
    rawq[1][1] = (rawq[1][1] & 0xffffu) | ((unsigned)pp[776 + dir * 4 + h] << 16);
  } else {
#pragma unroll
    for (int j = 0; j < 8; j++) {
      const u16* pp = Pseg + (size_t)(t0 + j) * PST;
      rawq[j][0] = (unsigned)pp[colv[0]] | ((unsigned)pp[colv[1]] << 16);
      rawq[j][1] = (unsigned)pp[colv[2]];
    }
  }
}

template <int MIX>
__device__ __forceinline__ void scan3_item(const Params& p, int l, int b, int h, int dir, unsigned char* smb) {
  constexpr int VOFF = (MIX == 2) ? 64 : 128;
  constexpr bool DELTA = (MIX != 2);
  const int tid = TIDX, lane = tid & 63, w = tid >> 6, fr = lane & 15, fq = lane >> 4;
  const bool producer = true;
  const int pw = w & 3, half = w >> 2;
  const u16* P = (const u16*)(p.ws + OFF_BIG);
  u16* YS = (u16*)(p.ws + OFF_YS);
  float* BC = (float*)(p.ws + OFF_BC);
  float* ST = (float*)(smb + w * S3_SUB + S3_GM);
  unsigned char* STBY = smb + w * S3_SUB + S3_GM;
  const f32x4 z4 = f32x4{0.f, 0.f, 0.f, 0.f};
  f32x4 st[4];
#pragma unroll
  for (int i = 0; i < 4; i++) st[i] = z4;

  bf16x8 bw2[4], ba2[4];
  float cw[3][7];
  float muv[4];
  int colv[4];
  float c_w0 = 0.f, c_a0 = 0.f, c_ka = 0.f, c_kk = 0.f, c_rk = 0.f, c_gb = 0.f;
#pragma unroll
  for (int i = 0; i < 4; i++) { bw2[i] = zfrag(); ba2[i] = zfrag(); muv[i] = 0.f; colv[i] = 0; }
  if (producer) {
    if (MIX == 0) {
#pragma unroll
      for (int nt = 0; nt < 4; nt++) {
        const int jch = h * 64 + nt * 16 + fr;
#pragma unroll
        for (int jj = 0; jj < 8; jj++) {
          bw2[nt][jj] = (short)f2bf(p.rwkv_w2[((size_t)(l * 2 + dir) * 32 + fq * 8 + jj) * 256 + jch]);
          ba2[nt][jj] = (short)f2bf(p.rwkv_a2[((size_t)(l * 2 + dir) * 32 + fq * 8 + jj) * 256 + jch]);
        }
      }
      const int jl = h * 64 + lane;
      c_w0 = p.rwkv_w0[(l * 2 + dir) * 256 + jl];
      c_a0 = p.rwkv_a0[(l * 2 + dir) * 256 + jl];
      c_ka = p.rwkv_ka[l * 256 + jl];
      c_kk = p.rwkv_kk[l * 256 + jl];
      c_rk = p.rwkv_rk[l * 256 + jl];
#pragma unroll
      for (int i = 0; i < 4; i++) {
        colv[i] = i < 3 ? i * 256 + h * 64 + lane : (lane < 32 ? 768 + dir * 32 + lane : 832 + dir * 32 + (lane - 32));
        muv[i] = p.rwkv_mu[l * 960 + colv[i]];
      }
    } else if (MIX == 1) {
#pragma unroll
      for (int i = 0; i < 3; i++) {
        colv[i] = PB + i * 256 + h * 64 + lane;
#pragma unroll
        for (int tp = 0; tp < 7; tp++) cw[i][tp] = p.gdn_conv[((size_t)l * 7 + tp) * 768 + i * 256 + h * 64 + lane];
      }
    } else {
#pragma unroll
      for (int nt = 0; nt < 2; nt++) {
#pragma unroll
        for (int jj = 0; jj < 8; jj++)
          bw2[nt][jj] = fq < 2 ? (short)f2bf(p.gla_gw2[((size_t)(l * 2 + dir) * 16 + fq * 8 + jj) * 128 + h * 32 + nt * 16 + fr]) : (short)0;
      }
      c_gb = p.gla_gb[(l * 2 + dir) * 128 + h * 32 + (lane & 31)];
      colv[0] = PC + h * 32 + lane;
      if (lane >= 32) colv[0] = PC + 128 + h * 32 + (lane - 32);
      colv[1] = PC + 256 + h * 64 + lane;
      colv[2] = PC + 512 + dir * 16 + (lane & 15);
    }
  }
  __syncthreads();
  unsigned rawq[14][2];
#pragma unroll
  for (int i = 0; i < 14; i++) { rawq[i][0] = 0u; rawq[i][1] = 0u; }
  fetch_raw<MIX>(P, half, dir, b, h, pw, lane, colv, rawq);
#define RAWP(r_, i_) ((u16)((rawq[r_][(i_) >> 1] >> (((i_) & 1) * 16)) & 0xffffu))

  for (int it = 0; it < TPB / 64; it++) {
    {
      {
        const int c = it * 2 + half;
        int seg_row0, seg_len, t_lo;
        chunk_geom(c, dir, b, seg_row0, seg_len, t_lo);
        unsigned char* SB = smb + w * S3_SUB;
        const int t0 = t_lo + pw * 8;
        if (MIX == 0) {
          float raw[10][4];
#pragma unroll
          for (int rr = 0; rr < 10; rr++) {
            const int t = t0 - 1 + rr;
            const float okf = (t >= 0 && t < seg_len) ? 1.f : 0.f;
#pragma unroll
            for (int i = 0; i < 4; i++) raw[rr][i] = bf2f(RAWP(rr, i)) * okf;
          }
#pragma unroll
          for (int j = 0; j < 8; j++)
#pragma unroll
            for (int i = 0; i < 4; i++) {
              float xm = raw[j + 1][i] + (0.5f * (raw[j][i] + raw[j + 2][i]) - raw[j + 1][i]) * muv[i];
              if (i == 3 && lane < 32) xm = tanh_fast(xm);
              ST[j * 256 + lane + 64 * i] = xm;
            }
        } else if (MIX == 1) {
          float raw[14][3];
#pragma unroll
          for (int rr = 0; rr < 14; rr++) {
            const int t = t0 - 3 + rr;
            const float okf = (t >= 0 && t < seg_len) ? 1.f : 0.f;
#pragma unroll
            for (int i = 0; i < 3; i++) raw[rr][i] = bf2f(RAWP(rr, i)) * okf;
          }
#pragma unroll
          for (int j = 0; j < 8; j++)
#pragma unroll
            for (int i = 0; i < 3; i++) {
              float a = 0.f;
#pragma unroll
              for (int tp = 0; tp < 7; tp++) a += raw[j + tp][i] * cw[i][tp];
              ST[j * 256 + lane + 64 * i] = siluf(a);
            }
          if (lane < 8) {
            float bx = bf2f(RAWP(0, 3));
            float ax = bf2f(RAWP(1, 3));
            float ld = -__expf(p.gdn_a_log[(l * 2 + dir) * 4 + h]) * softplusf(ax + p.gdn_dt_bias[(l * 2 + dir) * 4 + h]);
            ST[lane * 256 + 192] = sigm(bx);
            ST[lane * 256 + 193] = ld;
          }
        } else {
          const float qs = lane < 32 ? 0.17677669529663687f : 1.f;
#pragma unroll
          for (int j = 0; j < 8; j++) {
            ST[j * 256 + lane] = bf2f(RAWP(j, 0)) * qs;
            ST[j * 256 + 64 + lane] = bf2f(RAWP(j, 1));
            if (lane < 16) ST[j * 256 + 128 + lane] = bf2f(RAWP(j, 2));
          }
        }
        wave_lds_sync();
        {
          float vv[8];
#pragma unroll
          for (int i = 0; i < 8; i++) vv[i] = ST[(dir ? 7 - i : i) * 256 + VOFF + lane];
          *(uint4*)(SB + S3_VT + lane * 16) = pack8(vv);
        }
        if (MIX == 0) {
          bf16x8 aw, aa;
#pragma unroll
          for (int jj = 0; jj < 8; jj++) {
            aw[jj] = fr < 8 ? (short)f2bf(ST[fr * 256 + 192 + fq * 8 + jj]) : (short)0;
            aa[jj] = fr < 8 ? (short)f2bf(ST[fr * 256 + 224 + fq * 8 + jj]) : (short)0;
          }
          f32x4 accw[4], acca[4];
#pragma unroll
          for (int nt = 0; nt < 4; nt++) {
            accw[nt] = __builtin_amdgcn_mfma_f32_16x16x32_bf16(aw, bw2[nt], z4, 0, 0, 0);
            acca[nt] = __builtin_amdgcn_mfma_f32_16x16x32_bf16(aa, ba2[nt], z4, 0, 0, 0);
          }
          wave_lds_sync();
          if (fq < 2) {
#pragma unroll
            for (int nt = 0; nt < 4; nt++)
#pragma unroll
              for (int r = 0; r < 4; r++) {
                ST[(fq * 4 + r) * 256 + 128 + nt * 16 + fr] = accw[nt][r];
                ST[(fq * 4 + r) * 256 + 192 + nt * 16 + fr] = acca[nt][r];
              }
          }
          wave_lds_sync();
        } else if (MIX == 2) {
          bf16x8 ag;
#pragma unroll
          for (int jj = 0; jj < 8; jj++) ag[jj] = (fr < 8 && fq < 2) ? (short)f2bf(ST[fr * 256 + 128 + fq * 8 + jj]) : (short)0;
          f32x4 accg[2];
#pragma unroll
          for (int nt = 0; nt < 2; nt++) accg[nt] = __builtin_amdgcn_mfma_f32_16x16x32_bf16(ag, bw2[nt], z4, 0, 0, 0);
          if (fq < 2) {
#pragma unroll
            for (int nt = 0; nt < 2; nt++)
#pragma unroll
              for (int r = 0; r < 4; r++) ST[(fq * 4 + r) * 256 + 192 + nt * 16 + fr] = accg[nt][r];
          }
          wave_lds_sync();
        }
        float logd[8], kap[8], bb[8], kp[8], qq[8];
        if (MIX == 0) {
          float a8[8], p1[8], p2[8];
#pragma unroll
          for (int i = 0; i < 8; i++) {
            const float* row = ST + (dir ? 7 - i : i) * 256;
            const float r_ = row[lane], k_ = row[64 + lane];
            const float sg = sigm(c_w0 + row[128 + lane]);
            a8[i] = sigm(c_a0 + row[192 + lane]);
            kp[i] = k_ * (1.f + (a8[i] - 1.f) * c_ka);
            kap[i] = k_ * c_kk;
            qq[i] = r_;
            logd[i] = -0.6065306597126334f * sg;
            p1[i] = kap[i] * kap[i];
            p2[i] = r_ * kp[i] * c_rk;
          }
#pragma unroll
          for (int i = 0; i < 8; i++) { p1[i] = red16(p1[i]); p2[i] = red16(p2[i]); }
#pragma unroll
          for (int i = 0; i < 8; i++) {
            const float ss = (rlane(p1[i], 0) + rlane(p1[i], 16)) + (rlane(p1[i], 32) + rlane(p1[i], 48));
            const float bc = (rlane(p2[i], 0) + rlane(p2[i], 16)) + (rlane(p2[i], 32) + rlane(p2[i], 48));
            kap[i] *= rsq(ss + 1e-6f);
            bb[i] = kap[i] * a8[i];
            if (lane == 0) BC[(size_t)(seg_row0 + t0 + (dir ? 7 - i : i)) * 8 + h * 2 + dir] = bc;
          }
        } else {
#pragma unroll
        for (int i = 0; i < 8; i++) {
          const int j = dir ? 7 - i : i;
          const float* row = ST + j * 256;
          if (MIX == 1) {
            const float q_ = row[lane], k_ = row[64 + lane];
            const float sq = wave_sum(q_ * q_), sk = wave_sum(k_ * k_);
            const float qn = q_ * rsq(sq + 1e-6f) * 0.125f, kn = k_ * rsq(sk + 1e-6f);
            const float beta = row[192], ld = row[193];
            const float alpha = __expf(ld);
            logd[i] = ld;
            kap[i] = kn; bb[i] = alpha * beta * kn; kp[i] = beta * kn; qq[i] = qn;
          } else {
            const int n = lane & 31;
            const float lg = c_gb + row[192 + n];
            const float ls = fminf(lg, 0.f) - __logf(1.f + __expf(-fabsf(lg)));
            logd[i] = ls * (1.f / 16.f);
            kap[i] = 0.f; bb[i] = 0.f;
            kp[i] = lane < 32 ? row[32 + n] : 0.f;
            qq[i] = lane < 32 ? row[n] : 0.f;
          }
        }
        }
        wave_lds_sync();
        float kt[8], qt[8], bck[8], kck[8];
        {
          float L[8];
          float run = 0.f;
#pragma unroll
          for (int i = 0; i < 8; i++) { run += logd[i]; L[i] = run; }
          const float Lr = L[3], L7 = L[7];
          float prevE = __expf(clampe(-Lr)), prevT = 1.f;
          u16* OPA = (u16*)STBY;
#pragma unroll
          for (int i = 0; i < 8; i++) {
            const float eI = __expf(clampe(L[i] - Lr)), eInv = __expf(clampe(Lr - L[i]));
            const float tI = __expf(L[i]), eEnd = __expf(L7 - L[i]);
            if (DELTA) {
              OPA[0 * 576 + i * 72 + lane] = f2bf(kap[i] * prevE);
              OPA[1 * 576 + i * 72 + lane] = f2bf(bb[i] * eInv);
            }
            OPA[2 * 576 + i * 72 + lane] = f2bf(kp[i] * eInv);
            OPA[3 * 576 + i * 72 + lane] = f2bf(qq[i] * eI);
            kt[i] = kap[i] * prevT; qt[i] = qq[i] * tI;
            bck[i] = bb[i] * eEnd; kck[i] = kp[i] * eEnd;
            prevE = eI; prevT = tI;
          }
          *(float*)(SB + S3_WC + lane * 4) = __expf(L7);
        }
        wave_lds_sync();
        f32x4 accA = z4, accBm = z4, accQb = z4, accQk = z4;
        {
          const u16* OPA = (const u16*)STBY;
          const int ro = (fr & 7) * 72 + fq * 8;
#pragma unroll
          for (int ks = 0; ks < 2; ks++) {
            const bf16x8 fk = ld_frag(OPA + 2 * 576 + ro + ks * 32), fqh = ld_frag(OPA + 3 * 576 + ro + ks * 32);
            accQk = __builtin_amdgcn_mfma_f32_16x16x32_bf16(fqh, fk, accQk, 0, 0, 0);
            if (DELTA) {
              const bf16x8 fka = ld_frag(OPA + 0 * 576 + ro + ks * 32), fb = ld_frag(OPA + 1 * 576 + ro + ks * 32);
              accA = __builtin_amdgcn_mfma_f32_16x16x32_bf16(fka, fb, accA, 0, 0, 0);
              accBm = __builtin_amdgcn_mfma_f32_16x16x32_bf16(fka, fk, accBm, 0, 0, 0);
              accQb = __builtin_amdgcn_mfma_f32_16x16x32_bf16(fqh, fb, accQb, 0, 0, 0);
            }
          }
#pragma unroll
          for (int r = 0; r < 4; r++) {
            const int i = fq * 4 + r;
            const bool ok = fq < 2 && fr < 8;
            if (!(ok && fr < i)) { accA[r] = 0.f; accBm[r] = 0.f; }
            if (!(ok && fr <= i)) { accQb[r] = 0.f; accQk[r] = 0.f; }
          }
        }
        float bmc[8], qkc[8];
#pragma unroll
        for (int m = 0; m < 4; m++) {
          bmc[m] = accBm[m]; qkc[m] = accQk[m];
          bmc[m + 4] = __shfl(accBm[m], (lane & 15) + 16);
          qkc[m + 4] = __shfl(accQk[m], (lane & 15) + 16);
        }
        float kbar[8], qbar[8], Kv[8], TB[8], Qv[8];
        if (DELTA) {
          float t[8];
#pragma unroll
          for (int i = 0; i < 8; i++) {
            float ti = (lane == i) ? 1.f : 0.f;
#pragma unroll
            for (int m = 0; m < i; m++) ti -= rlane(accA[i & 3], (i >> 2) * 16 + m) * t[m];
            t[i] = ti;
          }
#pragma unroll
          for (int i = 0; i < 8; i++) {
            float tb = 0.f, kb = 0.f;
#pragma unroll
            for (int m = 0; m <= i; m++) {
              const float tim = rlane(t[i], m);
              tb += tim * bmc[m];
              kb += tim * kt[m];
            }
            TB[i] = tb; kbar[i] = kb;
            float qv = qkc[i], qb = qt[i];
#pragma unroll
            for (int m = 0; m <= i; m++) {
              const float qbim = rlane(accQb[i & 3], (i >> 2) * 16 + m);
              qv -= qbim * TB[m];
              qb -= qbim * kbar[m];
            }
            Qv[i] = qv; qbar[i] = qb;
          }
#pragma unroll
          for (int j = 0; j < 8; j++) Kv[j] = kck[j];
#pragma unroll
          for (int i = 1; i < 8; i++)
#pragma unroll
            for (int j = 0; j < i; j++) Kv[j] -= rlane(TB[i], j) * bck[i];
        } else {
#pragma unroll
          for (int i = 0; i < 8; i++) { Qv[i] = qkc[i]; qbar[i] = qt[i]; Kv[i] = kck[i]; kbar[i] = 0.f; TB[i] = 0.f; }
        }
        *(uint4*)(SB + S3_KVT + lane * 16) = pack8(Kv);
#pragma unroll
        for (int i = 0; i < 8; i++) ((u16*)(SB + S3_QB))[i * 72 + lane] = f2bf(qbar[i]);
        if (lane < 8) {
#pragma unroll
          for (int i = 0; i < 8; i++) ((u16*)(SB + S3_QV))[i * 8 + lane] = f2bf(Qv[i]);
        }
        if (DELTA) {
          float nk[8];
#pragma unroll
          for (int i = 0; i < 8; i++) nk[i] = -kbar[i];
          *(uint4*)(STBY + 4608 + lane * 16) = pack8(bck);
          *(uint4*)(STBY + 5632 + lane * 16) = pack8(nk);
          wave_lds_sync();
          bf16x8 fa[4], fb[4];
#pragma unroll
          for (int x = 0; x < 4; x++) {
            fa[x] = fq == 0 ? ld_frag(STBY + 5632 + (x * 16 + fr) * 16) : zfrag();
            fb[x] = fq == 0 ? ld_frag(STBY + 4608 + (x * 16 + fr) * 16) : zfrag();
          }
#pragma unroll
          for (int nt = 0; nt < 4; nt++)
#pragma unroll
            for (int mt = 0; mt < 4; mt++) {
              const f32x4 g = __builtin_amdgcn_mfma_f32_16x16x32_bf16(fa[mt], fb[nt], z4, 0, 0, 0);
              uint2 gv;
              gv.x = pack2(g[0], g[1]); gv.y = pack2(g[2], g[3]);
              *(uint2*)(SB + S3_GM + ((nt * 16 + fr) * 72 + mt * 16 + fq * 4) * 2) = gv;
            }
        }
      }
    }
    fetch_raw<MIX>(P, min(it + 1, TPB / 64 - 1) * 2 + half, dir, b, h, pw, lane, colv, rawq);
    __syncthreads();
    if (w < 4) {
      unsigned char* STB = smb + S3_STB + w * 2304;
#pragma unroll 2
      for (int kk = 0; kk < 8; kk++) {
        const int cc = it * 2 + (kk >> 2), k = kk & 3;
        int seg_row0, t_lo;
        if (cc < 8) { seg_row0 = b * TPB; t_lo = dir == 0 ? cc * 32 : (LC - 32 - cc * 32); }
        else { seg_row0 = b * TPB + LC; t_lo = dir == 0 ? (cc - 8) * 32 : (SEQ - 32 - (cc - 8) * 32); }
        const int sc = dir ? 3 - k : k;
        const unsigned char* SB = smb + ((kk >> 2) * 4 + sc) * S3_SUB;
#pragma unroll
        for (int nt = 0; nt < 4; nt++) {
          uint2 sv;
          sv.x = pack2(st[nt][0], st[nt][1]); sv.y = pack2(st[nt][2], st[nt][3]);
          *(uint2*)(STB + (fr * 72 + nt * 16 + fq * 4) * 2) = sv;
        }
        wave_lds_sync();
        const bf16x8 bs0 = ld_frag(STB + (fr * 72 + fq * 8) * 2), bs1 = ld_frag(STB + (fr * 72 + 32 + fq * 8) * 2);
        const bf16x8 bv = fq == 0 ? ld_frag(SB + S3_VT + (w * 16 + fr) * 16) : zfrag();
        const bf16x8 aq0 = ld_frag(SB + S3_QB + ((fr & 7) * 72 + fq * 8) * 2), aq1 = ld_frag(SB + S3_QB + ((fr & 7) * 72 + 32 + fq * 8) * 2);
        const bf16x8 aqv = fq == 0 ? ld_frag(SB + S3_QV + (fr & 7) * 16) : zfrag();
        f32x4 accY = __builtin_amdgcn_mfma_f32_16x16x32_bf16(aq0, bs0, z4, 0, 0, 0);
        accY = __builtin_amdgcn_mfma_f32_16x16x32_bf16(aq1, bs1, accY, 0, 0, 0);
        accY = __builtin_amdgcn_mfma_f32_16x16x32_bf16(aqv, bv, accY, 0, 0, 0);
        if (fq < 2) {
#pragma unroll
          for (int r = 0; r < 4; r++) {
            const int i = fq * 4 + r, j = dir ? 7 - i : i;
            YS[(size_t)(seg_row0 + t_lo + sc * 8 + j) * YST + dir * 768 + MIX * 256 + h * 64 + w * 16 + fr] = f2bf(accY[r]);
          }
        }
#pragma unroll
        for (int nt = 0; nt < 4; nt++) {
          f32x4 an = z4;
          if (DELTA) {
            const bf16x8 g0 = ld_frag(SB + S3_GM + ((nt * 16 + fr) * 72 + fq * 8) * 2), g1 = ld_frag(SB + S3_GM + ((nt * 16 + fr) * 72 + 32 + fq * 8) * 2);
            an = __builtin_amdgcn_mfma_f32_16x16x32_bf16(g0, bs0, an, 0, 0, 0);
            an = __builtin_amdgcn_mfma_f32_16x16x32_bf16(g1, bs1, an, 0, 0, 0);
          }
          const bf16x8 akv = fq == 0 ? ld_frag(SB + S3_KVT + (nt * 16 + fr) * 16) : zfrag();
          an = __builtin_amdgcn_mfma_f32_16x16x32_bf16(akv, bv, an, 0, 0, 0);
          const float4 wc = *(const float4*)(SB + S3_WC + (nt * 16 + fq * 4) * 4);
          st[nt][0] = st[nt][0] * wc.x + an[0];
          st[nt][1] = st[nt][1] * wc.y + an[1];
          st[nt][2] = st[nt][2] * wc.z + an[2];
          st[nt][3] = st[nt][3] * wc.w + an[3];
        }
      }
    }
    __syncthreads();
  }
}

__device__ __forceinline__ void attn_item(const Params& p, int l, int b, int qb, int hk, bool isctx, unsigned char* smem) {
  u16* KS = (u16*)smem;
  u16* VT = KS + 64 * LDT;
  u16* PL = VT + 64 * LDT;
  float2* ROPE = (float2*)(PL + 8 * 32 * LDT);
  const int tid = TIDX, lane = tid & 63, w = tid >> 6, fr = lane & 15, fq = lane >> 4;
  const u16* P = (const u16*)(p.ws + OFF_BIG);
  u16* Y = (u16*)(p.ws + OFF_YS);
  const int qh = hk * 2 + (w >> 2);
  const int tb = qb * 128 + (w & 3) * 32;
  const int qrow0 = b * TPB + (isctx ? 0 : LC);
  __syncthreads();
  for (int i = tid; i < 1024; i += NTHR) {
    int pos = i >> 4, fi = i & 15;
    float inv = powf(10000.f, -(float)fi / 16.f);
    float sn, cs;
    sincosf((float)pos * inv, &sn, &cs);
    ROPE[i] = make_float2(cs, sn);
  }
  __syncthreads();
  bf16x8 qf[2][2];
#pragma unroll
  for (int mi = 0; mi < 2; mi++)
#pragma unroll
    for (int ks = 0; ks < 2; ks++) {
      const int tq = tb + mi * 16 + fr;
      const u16* qp = P + (size_t)(qrow0 + tq) * PST + PD + qh * 64 + ks * 32;
      uint4 own = *(const uint4*)(qp + fq * 8);
      uint4 par = *(const uint4*)(qp + (fq ^ 2) * 8);
      const unsigned ow[4] = {own.x, own.y, own.z, own.w};
      const unsigned pw[4] = {par.x, par.y, par.z, par.w};
      const int pos = ks == 0 ? (tq >> 6) : (tq & 63);
      bf16x8 f;
#pragma unroll
      for (int jj = 0; jj < 8; jj++) {
        float xo = bf2f((u16)((ow[jj >> 1] >> ((jj & 1) * 16)) & 0xffff));
        float xp = bf2f((u16)((pw[jj >> 1] >> ((jj & 1) * 16)) & 0xffff));
        float v = xo;
        if (!isctx) {
          float2 cs = ROPE[pos * 16 + (fq & 1) * 8 + jj];
          v = fq < 2 ? xo * cs.x - xp * cs.y : xp * cs.y + xo * cs.x;
        }
        f[jj] = (short)f2bf(v * 0.125f);
      }
      qf[mi][ks] = f;
    }
  f32x4 oacc[2][4];
#pragma unroll
  for (int mi = 0; mi < 2; mi++)
#pragma unroll
    for (int nd = 0; nd < 4; nd++) oacc[mi][nd] = f32x4{0.f, 0.f, 0.f, 0.f};
  float mrow[2][4], lrow[2][4];
#pragma unroll
  for (int mi = 0; mi < 2; mi++)
#pragma unroll
    for (int r = 0; r < 4; r++) { mrow[mi][r] = -1e30f; lrow[mi][r] = 0.f; }

  const int q0 = qb * 128;
  const int band_lo = isctx ? 0 : max(0, q0 - 128), band_hi = isctx ? 0 : min(SEQ, q0 + 256);
  const int ntile = 4 + (band_hi - band_lo) / 64;
  u16* pl = PL + w * 32 * LDT;
  for (int tl = 0; tl < ntile; tl++) {
    const bool band = tl >= 4;
    const int k0 = band ? band_lo + (tl - 4) * 64 : tl * 64;
    __syncthreads();
    {
      const int key = tid >> 3, kc = tid & 7;
      const int kpos = k0 + key;
      const u16* kp = P + (size_t)(b * TPB + (band ? LC : 0) + kpos) * PST + PD + 256 + hk * 64;
      uint4 own = *(const uint4*)(kp + kc * 8);
      uint4 vv = *(const uint4*)(kp + 128 + kc * 8);
      uint4 par = *(const uint4*)(kp + (kc ^ 2) * 8);
      if (band) {
        const unsigned ow[4] = {own.x, own.y, own.z, own.w};
        const unsigned pw[4] = {par.x, par.y, par.z, par.w};
        const int pos = kc < 4 ? (kpos >> 6) : (kpos & 63);
        unsigned res[4];
#pragma unroll
        for (int jj = 0; jj < 8; jj += 2) {
          float v2[2];
#pragma unroll
          for (int e = 0; e < 2; e++) {
            float xo = bf2f((u16)((ow[jj >> 1] >> (e * 16)) & 0xffff));
            float xp = bf2f((u16)((pw[jj >> 1] >> (e * 16)) & 0xffff));
            float2 cs = ROPE[pos * 16 + (kc & 1) * 8 + jj + e];
            v2[e] = (kc & 2) == 0 ? xo * cs.x - xp * cs.y : xp * cs.y + xo * cs.x;
          }
          res[jj >> 1] = pack2(v2[0], v2[1]);
        }
        own = make_uint4(res[0], res[1], res[2], res[3]);
      }
      *(uint4*)(KS + key * LDT + kc * 8) = own;
      const unsigned vw[4] = {vv.x, vv.y, vv.z, vv.w};
#pragma unroll
      for (int jj = 0; jj < 8; jj++) VT[(kc * 8 + jj) * LDT + key] = (u16)((vw[jj >> 1] >> ((jj & 1) * 16)) & 0xffff);
    }
    __syncthreads();
    f32x4 sc[2][4];
#pragma unroll
    for (int mi = 0; mi < 2; mi++)
#pragma unroll
      for (int nj = 0; nj < 4; nj++) sc[mi][nj] = f32x4{0.f, 0.f, 0.f, 0.f};
#pragma unroll
    for (int ks = 0; ks < 2; ks++) {
      bf16x8 kf[4];
#pragma unroll
      for (int nj = 0; nj < 4; nj++) kf[nj] = *(const bf16x8*)(KS + (nj * 16 + fr) * LDT + ks * 32 + fq * 8);
#pragma unroll
      for (int mi = 0; mi < 2; mi++)
#pragma unroll
        for (int nj = 0; nj < 4; nj++) sc[mi][nj] = __builtin_amdgcn_mfma_f32_16x16x32_bf16(qf[mi][ks], kf[nj], sc[mi][nj], 0, 0, 0);
    }
#pragma unroll
    for (int mi = 0; mi < 2; mi++)
#pragma unroll
      for (int r = 0; r < 4; r++) {
        const int qpos = tb + mi * 16 + fq * 4 + r;
        float mx = -1e30f;
#pragma unroll
        for (int nj = 0; nj < 4; nj++) {
          float v = sc[mi][nj][r];
          if (band) {
            int d = qpos - (k0 + nj * 16 + fr);
            if (d > 128 || d < -128) v = -1e30f;
          }
          sc[mi][nj][r] = v;
          mx = fmaxf(mx, v);
        }
        mx = fmaxf(mx, __shfl_xor(mx, 1));
        mx = fmaxf(mx, __shfl_xor(mx, 2));
        mx = fmaxf(mx, __shfl_xor(mx, 4));
        mx = fmaxf(mx, __shfl_xor(mx, 8));
        const float mnew = fmaxf(mrow[mi][r], mx);
        const float alpha = __expf(mrow[mi][r] - mnew);
        mrow[mi][r] = mnew;
        float ls = 0.f;
#pragma unroll
        for (int nj = 0; nj < 4; nj++) {
          float pe = __expf(sc[mi][nj][r] - mnew);
          ls += pe;
          pl[(mi * 16 + fq * 4 + r) * LDT + nj * 16 + fr] = f2bf(pe);
        }
        lrow[mi][r] = lrow[mi][r] * alpha + ls;
#pragma unroll
        for (int nd = 0; nd < 4; nd++) oacc[mi][nd][r] *= alpha;
      }
    asm volatile("s_waitcnt lgkmcnt(0)" ::: "memory");
    __builtin_amdgcn_wave_barrier();
#pragma unroll
    for (int ks = 0; ks < 2; ks++) {
      bf16x8 pf[2], vf[4];
#pragma unroll
      for (int mi = 0; mi < 2; mi++) pf[mi] = *(const bf16x8*)(pl + (mi * 16 + fr) * LDT + ks * 32 + fq * 8);
#pragma unroll
      for (int nd = 0; nd < 4; nd++) vf[nd] = *(const bf16x8*)(VT + (nd * 16 + fr) * LDT + ks * 32 + fq * 8);
#pragma unroll
      for (int mi = 0; mi < 2; mi++)
#pragma unroll
        for (int nd = 0; nd < 4; nd++) oacc[mi][nd] = __builtin_amdgcn_mfma_f32_16x16x32_bf16(pf[mi], vf[nd], oacc[mi][nd], 0, 0, 0);
    }
    asm volatile("s_waitcnt lgkmcnt(0)" ::: "memory");
    __builtin_amdgcn_wave_barrier();
  }
  const float sink = p.attn_sink[l * 4 + qh];
#pragma unroll
  for (int mi = 0; mi < 2; mi++)
#pragma unroll
    for (int r = 0; r < 4; r++) {
      float ls = lrow[mi][r];
      ls += __shfl_xor(ls, 1);
      ls += __shfl_xor(ls, 2);
      ls += __shfl_xor(ls, 4);
      ls += __shfl_xor(ls, 8);
      ls += __expf(sink - mrow[mi][r]);
      const float inv = 1.f / ls;
      const int tq = tb + mi * 16 + fq * 4 + r;
#pragma unroll
      for (int nd = 0; nd < 4; nd++) Y[(size_t)(qrow0 + tq) * YST + 1536 + qh * 64 + nd * 16 + fr] = f2bf(oacc[mi][nd][r] * inv);
    }
}

#ifndef SCAN3_MASK
#define SCAN3_MASK 7
#endif
__device__ __forceinline__ void phase_mix(const Params& p, int l, unsigned char* smem) {
  float* sm = (float*)smem;
  const int G = gridDim.x;
  for (int it = blockIdx.x; it < 192; it += G) {
    const int mix = it >> 6, rem = it & 63, b = rem >> 3, h = (rem >> 1) & 3, dir = rem & 1;
    if (mix == 0 && (SCAN3_MASK & 1)) scan3_item<0>(p, l, b, h, dir, smem);
    else if (mix == 1 && (SCAN3_MASK & 2)) scan3_item<1>(p, l, b, h, dir, smem);
    else if (mix == 2 && (SCAN3_MASK & 4)) scan3_item<2>(p, l, b, h, dir, smem);
  }
  if (SCAN3_MASK != 7) {
    for (int it = blockIdx.x; it < 768; it += G) {
      const int mix = it >> 8, rem = it & 255, b = rem >> 5, h = (rem >> 3) & 3, dir = (rem >> 2) & 1, rq = rem & 3;
      if (mix == 0 && !(SCAN3_MASK & 1)) scan2_item<0>(p, l, b, h, dir, rq, sm);
      else if (mix == 1 && !(SCAN3_MASK & 2)) scan2_item<1>(p, l, b, h, dir, rq, sm);
      else if (mix == 2 && !(SCAN3_MASK & 4)) scan2_item<2>(p, l, b, h, dir, rq, sm);
    }
  }
  __syncthreads();
  unsigned* ctr = (unsigned*)(p.ws + OFF_CTR) + l * 16;
  volatile int* slot = (volatile int*)(smem + 131072 - 16);
  for (;;) {
    if (TIDX == 0) *slot = (int)atomicAdd(ctr, 1u);
    __syncthreads();
    const int it = *slot;
    __syncthreads();
    if (it >= (l == 0 ? 544 : 512)) break;
    if (it < 512) {
      int b = it >> 6, qb = (it >> 1) & 31, hk = it & 1;
      attn_item(p, l, b, qb, hk, false, smem);
    } else {
      int r = it - 512, b = r >> 2, qb = (r >> 1) & 1, hk = r & 1;
      attn_item(p, l, b, qb, hk, true, smem);
    }
  }
}

#define POST_DECL(PFX) uint2 PFX##ya0, PFX##ya1, PFX##ya2, PFX##yc0, PFX##yc1, PFX##yc2, PFX##vp, PFX##vc, PFX##vn, PFX##gb, PFX##gc; \
  u16 PFX##xp, PFX##xc, PFX##xn; float2 PFX##bc
#define POST_LOAD(PFX, R_)                                                                         \
  do {                                                                                             \
    const int r_ = (R_);                                                                           \
    const int b_ = r_ / TPB, t_ = r_ - b_ * TPB;                                                   \
    const bool hp_ = (t_ != 0) && (t_ != LC), hn_ = (t_ != LC - 1) && (t_ != TPB - 1);            \
    const u16* ys_ = YSc + (size_t)r_ * YST;                                                       \
    const u16* pr_ = Pc + (size_t)r_ * PST;                                                        \
    const u16* pp_ = pr_ - (hp_ ? PST : 0);                                                        \
    const u16* pn_ = pr_ + (hn_ ? PST : 0);                                                        \
    PFX##ya0 = *(const uint2*)(ys_ + j0); PFX##ya1 = *(const uint2*)(ys_ + 256 + j0); PFX##ya2 = *(const uint2*)(ys_ + 512 + j0); \
    PFX##yc0 = *(const uint2*)(ys_ + 768 + j0); PFX##yc1 = *(const uint2*)(ys_ + 1024 + j0); PFX##yc2 = *(const uint2*)(ys_ + 1280 + j0); \
    PFX##vp = *(const uint2*)(pp_ + PA + 512 + j0);                                                \
    PFX##vc = *(const uint2*)(pr_ + PA + 512 + j0);                                                \
    PFX##vn = *(const uint2*)(pn_ + PA + 512 + j0);                                                \
    PFX##gb = *(const uint2*)(pr_ + PB + 784 + j0);                                                \
    PFX##gc = *(const uint2*)(pr_ + PC + 544 + j0);                                                \
    PFX##xp = pp_[PA + 896 + lane]; PFX##xc = pr_[PA + 896 + lane]; PFX##xn = pn_[PA + 896 + lane]; \
    PFX##bc = *(const float2*)(BCc + (size_t)r_ * 8 + (lane >> 4) * 2);                            \
  } while (0)
__device__ __forceinline__ void unpack4(uint2 v, float (&o)[4]) {
  o[0] = __uint_as_float(v.x << 16); o[1] = __uint_as_float(v.x & 0xffff0000u);
  o[2] = __uint_as_float(v.y << 16); o[3] = __uint_as_float(v.y & 0xffff0000u);
}

__device__ __forceinline__ void phase_post(const Params& p, int l, float* g2s) {
  const int lane = TIDX & 63, wv = TIDX >> 6;
  u16* YS = (u16*)(p.ws + OFF_YS);
  const int j0 = lane * 4;
  {
    const float4* src = (const float4*)(p.rwkv_g2 + (size_t)l * 64 * 256);
    for (int i = TIDX; i < 64 * 256 / 4; i += NTHR) ((float4*)g2s)[i] = src[i];
  }
  float mu_v[4], lng[4], lnb[4], ngb[4], ngc[4];
#pragma unroll
  for (int i = 0; i < 4; i++) {
    mu_v[i] = p.rwkv_mu[l * 960 + 512 + j0 + i];
    lng[i] = p.rwkv_ln_g[l * 256 + j0 + i];
    lnb[i] = p.rwkv_ln_b[l * 256 + j0 + i];
    ngb[i] = p.gdn_norm_g[l * 64 + (lane & 15) * 4 + i];
    ngc[i] = p.gla_norm_g[l * 64 + (lane & 15) * 4 + i];
  }
  const float mu_x = p.rwkv_mu[l * 960 + 896 + lane];
  __syncthreads();
  const int stride = gridDim.x * 8;
  int r = blockIdx.x * 8 + wv;
  const u16* Pc = (const u16*)(p.ws + OFF_BIG);
  const u16* YSc = (const u16*)(p.ws + OFF_YS);
  const float* BCc = (const float*)(p.ws + OFF_BC);
  POST_DECL(cur_);
  POST_DECL(nxt_);
  POST_LOAD(cur_, r);
  for (; r < NROWS; r += stride) {
    const int rn = r + stride < NROWS ? r + stride : r;
    POST_LOAD(nxt_, rn);
    const int b = r / TPB, t = r - b * TPB;
    const float pmul = ((t != 0) && (t != LC)) ? 1.f : 0.f, nmul = ((t != LC - 1) && (t != TPB - 1)) ? 1.f : 0.f;
    if (!(l == 1 && t < LC)) {
    float y[3][4];
    {
      float a4[4], c4[4];
      unpack4(cur_ya0, a4); unpack4(cur_yc0, c4);
#pragma unroll
      for (int i = 0; i < 4; i++) y[0][i] = a4[i] + c4[i];
      unpack4(cur_ya1, a4); unpack4(cur_yc1, c4);
#pragma unroll
      for (int i = 0; i < 4; i++) y[1][i] = a4[i] + c4[i];
      unpack4(cur_ya2, a4); unpack4(cur_yc2, c4);
#pragma unroll
      for (int i = 0; i < 4; i++) y[2][i] = a4[i] + c4[i];
    }
    float o[3][4];
    {
      float sum = y[0][0] + y[0][1] + y[0][2] + y[0][3];
      sum = red16(sum);
      const float mean = sum * (1.f / 64.f);
      float vs = 0.f;
#pragma unroll
      for (int i = 0; i < 4; i++) { float d = y[0][i] - mean; vs += d * d; }
      vs = red16(vs);
      const float rstd = rsq(vs * (1.f / 64.f) + 64e-5f);
      const float pv = bf2f(cur_xc), ppv = bf2f(cur_xp) * pmul, pnv = bf2f(cur_xn) * nmul;
      const float sg = sigm(pv + (0.5f * (ppv + pnv) - pv) * mu_x);
      float gate[4] = {0.f, 0.f, 0.f, 0.f};
      const float* g2 = g2s + j0;
#pragma unroll 8
      for (int i = 0; i < 64; i++) {
        const float si = __int_as_float(__builtin_amdgcn_readlane(__float_as_int(sg), i));
        const float4 gw = *(const float4*)(g2 + i * 256);
        gate[0] += si * gw.x; gate[1] += si * gw.y; gate[2] += si * gw.z; gate[3] += si * gw.w;
      }
      const float bcs = cur_bc.x + cur_bc.y;
      float vc4[4], vp4[4], vn4[4];
      unpack4(cur_vc, vc4); unpack4(cur_vp, vp4); unpack4(cur_vn, vn4);
#pragma unroll
      for (int i = 0; i < 4; i++) {
        const float v = vc4[i] + (0.5f * (vp4[i] * pmul + vn4[i] * nmul) - vc4[i]) * mu_v[i];
        const float yn = (y[0][i] - mean) * rstd * lng[i] + lnb[i];
        o[0][i] = (yn + bcs * v) * gate[i];
      }
    }
#pragma unroll
    for (int m = 1; m < 3; m++) {
      float ss = y[m][0] * y[m][0] + y[m][1] * y[m][1] + y[m][2] * y[m][2] + y[m][3] * y[m][3];
      ss = red16(ss);
      const float inv = rsq(ss * (1.f / 64.f) + 1e-6f);
      float g4[4];
      unpack4(m == 1 ? cur_gb : cur_gc, g4);
#pragma unroll
      for (int i = 0; i < 4; i++) o[m][i] = y[m][i] * inv * (m == 1 ? ngb[i] : ngc[i]) * siluf(g4[i]);
    }
    u16* ys = YS + (size_t)r * YST;
#pragma unroll
    for (int m = 0; m < 3; m++) {
      uint2 ov;
      ov.x = pack2(o[m][0], o[m][1]);
      ov.y = pack2(o[m][2], o[m][3]);
      *(uint2*)(ys + m * 256 + j0) = ov;
    }
    }
    cur_ya0 = nxt_ya0; cur_ya1 = nxt_ya1; cur_ya2 = nxt_ya2; cur_yc0 = nxt_yc0; cur_yc1 = nxt_yc1; cur_yc2 = nxt_yc2;
    cur_vp = nxt_vp; cur_vc = nxt_vc; cur_vn = nxt_vn; cur_gb = nxt_gb; cur_gc = nxt_gc;
    cur_xp = nxt_xp; cur_xc = nxt_xc; cur_xn = nxt_xn; cur_bc = nxt_bc;
  }
}

#define XB_TMO      128
#define XB_XCNT(j)  (256  + 64 * (j))
#define XB_XSUB(j)  (1280 + 64 * (j))
#define XB_XGEN(j)  (2304 + 64 * (j))
#define XB_TOP      3328
#define XB_TOPGEN   3392
#define XCD_BAR_WORDS 3456
#define XB_SPIN_CAP (1u << 18)
#define LAS __attribute__((address_space(3)))

__device__ __forceinline__ unsigned xb_ld(unsigned* p)              { return __hip_atomic_load(p, __ATOMIC_RELAXED, __HIP_MEMORY_SCOPE_AGENT); }
__device__ __forceinline__ unsigned xb_add(unsigned* p, unsigned v) { return __hip_atomic_fetch_add(p, v, __ATOMIC_RELAXED, __HIP_MEMORY_SCOPE_AGENT); }
__device__ __forceinline__ unsigned xb_xcc_id() { return (unsigned)__builtin_amdgcn_s_getreg((3 << 11) | 20) & 0xFu; }
#define XB_SPIN(cond, bar) do { unsigned _sp = 0; while (cond) { __builtin_amdgcn_s_sleep(1); \
    if ((++_sp & 255u) == 0u) { if (xb_ld(&(bar)[XB_TMO])) break; if (_sp > XB_SPIN_CAP) { atomicAdd(&(bar)[XB_TMO], 1u); break; } } } } while (0)

struct XcdBarrier {
    unsigned* bar; unsigned x;
    volatile LAS unsigned* st;
};

__device__ __forceinline__ XcdBarrier xcd_barrier_post(unsigned* bar, volatile LAS unsigned* st) {
    XcdBarrier b; b.bar = bar; b.x = xb_xcc_id(); b.st = st;
    if (threadIdx.x == 0) (void)xb_add(&bar[XB_XCNT(b.x)], 1u);
    return b;
}
__device__ __forceinline__ void xcd_barrier_complete(unsigned* bar, unsigned x, unsigned& nloc, unsigned& nx) {
    const unsigned G = gridDim.x * gridDim.y * gridDim.z;
    unsigned sum, cnt, mine, sp = 0u;
    for (;;) {
        sum = 0u; cnt = 0u; mine = 0u;
#pragma unroll
        for (unsigned j = 0; j < 16; ++j) { const unsigned c = xb_ld(&bar[XB_XCNT(j)]); sum += c; cnt += (c > 0u) ? 1u : 0u; mine = (j == x) ? c : mine; }
        if (sum == G) break;
        __builtin_amdgcn_s_sleep(1);
        if ((++sp & 255u) == 0u) { if (xb_ld(&bar[XB_TMO])) break; if (sp > XB_SPIN_CAP) { atomicAdd(&bar[XB_TMO], 1u); break; } }
    }
    nloc = mine > 0u ? mine : 1u; nx = cnt > 0u ? cnt : 1u;
}

__device__ __forceinline__ void xcd_barrier(const XcdBarrier& b) {
    asm volatile("s_waitcnt vmcnt(0)" ::: "memory");
    __syncthreads();
    if (threadIdx.x == 0) {
        unsigned* bar = b.bar;
        __builtin_amdgcn_s_waitcnt(0);
        unsigned nloc = b.st[0], nx = b.st[1];
        if (nloc == 0u) { xcd_barrier_complete(bar, b.x, nloc, nx); b.st[0] = nloc; b.st[1] = nx; }
        const unsigned old = xb_add(&bar[XB_XSUB(b.x)], 1u);
        const unsigned gen = old / nloc;
        if (old + 1u == (gen + 1u) * nloc) {
            __builtin_amdgcn_fence(__ATOMIC_RELEASE, "agent");
            asm volatile("s_waitcnt vmcnt(0)" ::: "memory");
            const unsigned og = xb_add(&bar[XB_TOP], 1u);
            const unsigned tg = og / nx;
            if (og + 1u == (tg + 1u) * nx) xb_add(&bar[XB_TOPGEN], 1u);
            else XB_SPIN(xb_ld(&bar[XB_TOPGEN]) == tg, bar);
            __builtin_amdgcn_fence(__ATOMIC_ACQUIRE, "agent");
            xb_add(&bar[XB_XGEN(b.x)], 1u);
            asm volatile("s_waitcnt vmcnt(0)" ::: "memory");
        } else {
            XB_SPIN(xb_ld(&bar[XB_XGEN(b.x)]) == gen, bar);
            __builtin_amdgcn_fence(__ATOMIC_ACQUIRE, "agent");
            asm volatile("s_waitcnt vmcnt(0)" ::: "memory");
        }
    }
    __syncthreads();
}

#if defined(SKIPS)
#define EN(k) (SKIPS != (k))
#elif !defined(ONLYS)
#define EN(k) 1
#else
#define EN(k) (ONLYS == (k))
#endif
__device__ __forceinline__ void run_phase(const Params& p, int ph, unsigned char* smem) {
  if (ph == 0) { if (EN(10)) phase_init0(p, (float*)smem); return; }
  if (ph == 1) { if (EN(11)) phase_init1(p); return; }
  int l = 0, s = 10;
  if (ph >= 3) { l = (ph - 3) / 10; s = (ph - 3) - l * 10; }
  unsigned char* wl = p.ws + OFF_W;
  PG8_LAS unsigned char* lds = (PG8_LAS unsigned char*)smem;
  pg8::StaticOrder S;
  if (s == 10 || s == 6 || s == 9) {
    if (EN(5)) rowpass(p, l, s == 10 ? 0 : (s == 6 ? 1 : 2));
    if (s == 9 && l == 0) {
      __syncthreads();
      for (int it = blockIdx.x; it < 4480; it += gridDim.x) conv_item(p, 1, it, (float*)smem);
    }
  } else if (s == 0 || s == 3 || s == 5 || s == 8) {
    pg8::Gemm g; EpiBf E;
    g.M = NROWS; E.bias = nullptr; E.act = 0;
    if (s == 0) { g.A = (const u16*)(p.ws + OFF_H); g.lda = DM; g.Bt = (const u16*)(wl + OW_IN); g.K = DM; g.N = PST; E.O = (u16*)(p.ws + OFF_BIG); E.ldc = PST; }
    else if (s == 3) {
      g.A = (const u16*)(p.ws + OFF_H); g.lda = DM; g.Bt = (const u16*)(wl + OW_G); g.K = DM; g.N = 4096;
      E.O = (u16*)(p.ws + OFF_BIG); E.ldc = 4096; E.bias = p.gate_b + (size_t)l * 4096; E.act = 1;
    }
    else if (s == 5) { g.A = (const u16*)(p.ws + OFF_H); g.lda = DM; g.Bt = (const u16*)(wl + OW_O); g.K = DM; g.N = DM; E.O = (u16*)(p.ws + OFF_BIG); E.ldc = DM; }
    else { g.A = (const u16*)(p.ws + OFF_BIG); g.lda = FH; g.Bt = (const u16*)(wl + OW_2); g.K = FH; g.N = DM; E.O = (u16*)(p.ws + OFF_YS); E.ldc = DM; }
    if (l == 1 && s != 0) S.init(NBATCH * SEQ, g.N, gridDim.x, blockIdx.x, 1);
    else S.init(g.M, g.N, gridDim.x, blockIdx.x);
    if (EN(0)) pg8::gemm_phase<EpiBf, pg8::StaticOrder, false>(lds, g, S, E, nullptr);
  } else if (s == 4) {
    if (EN(3)) phase_ypart(p, l, smem);
  } else if (s == 1) {
    if (EN(1)) phase_mix(p, l, smem);
  } else if (s == 2) {
    if (EN(2)) phase_post(p, l, (float*)smem);
  } else {
    pg8::Gemm g; EpiSwiglu E;
    g.M = NROWS; g.N = 2 * FH; g.K = DM; g.lda = DM; g.A = (const u16*)(p.ws + OFF_H); g.Bt = (const u16*)(wl + OW_1);
    E.O = (u16*)(p.ws + OFF_BIG);
    if (l == 1) S.init(NBATCH * SEQ, g.N, gridDim.x, blockIdx.x, 1);
    else S.init(g.M, g.N, gridDim.x, blockIdx.x);
    if (EN(6)) pg8::gemm_phase<EpiSwiglu, pg8::StaticOrder, false>(lds, g, S, E, nullptr);
  }
}

__global__ void __launch_bounds__(NTHR) hybrid_flow_mega(Params p, int ph0, int ph1) {
  __shared__ __attribute__((aligned(16))) unsigned char smem[131072];
  __shared__ __attribute__((aligned(16))) unsigned xbw[4];
  cg::grid_group grid = cg::this_grid();
  XcdBarrier xb;
  xb.bar = (unsigned*)(p.ws + OFF_XBAR); xb.x = 0u; xb.st = (volatile LAS unsigned*)xbw;
  for (int ph = ph0; ph < ph1; ph++) {
    run_phase(p, ph, smem);
#ifdef DUPMASK
    {
      int sidx = ph >= 3 ? (ph - 3) % 10 : 12 + ph;
      if ((DUPMASK >> sidx) & 1) { __syncthreads(); run_phase(p, ph, smem); }
    }
#endif
    if (ph + 1 < ph1) {
      if (ph == ph0) {
        grid.sync();
        if (threadIdx.x < 4) xbw[threadIdx.x] = 0u;
        __syncthreads();
        xb = xcd_barrier_post((unsigned*)(p.ws + OFF_XBAR), (volatile LAS unsigned*)xbw);
      } else {
        xcd_barrier(xb);
      }
    }
  }
  if (ph1 - ph0 > 2 && threadIdx.x == 0 && xb_ld(&xb.bar[XB_TMO]) != 0u) p.out[blockIdx.x] = __int_as_float(0x7fc00000);
}

extern "C" void kernel_launch(void* const* d_in, const int* in_sizes, int n_in, void* d_out, int out_size, void* d_ws,
                              size_t ws_size, hipStream_t stream) {
  Params p{};
  const float** pp = (const float**)&p;
  for (int i = 0; i < 32; i++) pp[i] = (const float*)d_in[i];
  p.out = (float*)d_out;
  p.ws = (unsigned char*)d_ws;
  static int grid_blocks = 0;
  if (!grid_blocks) {
    int dev = 0, cus = 0, per_cu = 0;
    hipGetDevice(&dev);
    hipDeviceGetAttribute(&cus, hipDeviceAttributeMultiprocessorCount, dev);
    hipOccupancyMaxActiveBlocksPerMultiprocessor(&per_cu, hybrid_flow_mega, NTHR, 0);
    if (per_cu < 1) per_cu = 1;
    grid_blocks = cus * per_cu;
  }
#ifdef MULTI_LAUNCH
  for (int ph = 0; ph < NPHASE; ph++) {
    hipLaunchKernelGGL(hybrid_flow_mega, dim3(grid_blocks), dim3(NTHR), 0, stream, p, ph, ph + 1);
  }
#else
  int ph0 = 0, ph1 = NPHASE;
  void* args[] = {&p, &ph0, &ph1};
  hipError_t e = hipLaunchCooperativeKernel((void*)hybrid_flow_mega, dim3(grid_blocks), dim3(NTHR), args, 0, stream);
  if (e != hipSuccess) fprintf(stderr, "cooperative launch failed: %s (grid %d)\n", hipGetErrorString(e), grid_blocks);
#endif
}
```

```cpp
#include <hip/hip_runtime.h>
#include <hip/hip_cooperative_groups.h>
#include <cstdio>
namespace cg = cooperative_groups;

typedef unsigned short u16;
using bf16x8 = __attribute__((ext_vector_type(8))) short;
using f32x4 = __attribute__((ext_vector_type(4))) float;

#define DM 1024
#define NBATCH 8
#define SEQ 4096
#define LC 256
#define TPB 4352
#define NROWS 34816
#define PST 3328
#define YST 1792
#define FH 2816
#define INW 7408
#define NTHR 512
#define PA 0
#define PB 960
#define PC 2000
#define PD 2800
#define NPHASE 23
#define SCAN3_MASK 7

struct Params {
  const float *x, *c, *ctx, *c_ctx, *ada_w, *ada_b, *norm_g, *w_in, *gate_b, *w_branch, *w_out,
      *rwkv_mu, *rwkv_w0, *rwkv_w2, *rwkv_a0, *rwkv_a2, *rwkv_g2, *rwkv_kk, *rwkv_ka, *rwkv_rk, *rwkv_ln_g,
      *rwkv_ln_b, *gdn_conv, *gdn_a_log, *gdn_dt_bias, *gdn_norm_g, *gla_gw2, *gla_gb, *gla_norm_g, *attn_sink,
      *ffn_w1, *ffn_w2;
  float* out;
  unsigned char* ws;
};

constexpr size_t SZ_WL = 36700160;
constexpr size_t OW_IN = 0;
constexpr size_t OW_G = OW_IN + (size_t)PST * 1024 * 2;
constexpr size_t OW_B = OW_G + (size_t)4096 * 1024 * 2;
constexpr size_t OW_O = OW_B + (size_t)4 * 1024 * 256 * 2;
constexpr size_t OW_1 = OW_O + (size_t)1024 * 1024 * 2;
constexpr size_t OW_2 = OW_1 + (size_t)5632 * 1024 * 2;
static_assert(OW_2 + (size_t)1024 * FH * 2 == SZ_WL, "weights size");
constexpr size_t SZ_ACT = (size_t)NROWS * DM * 2;
constexpr size_t OFF_W = 0;
constexpr size_t OFF_XC = OFF_W + SZ_WL;
constexpr size_t OFF_MODP = OFF_XC + (size_t)NBATCH * LC * DM * 4;
constexpr size_t OFF_MOD = OFF_MODP + (size_t)2 * 8 * 9 * 6144 * 4;
constexpr size_t OFF_BC = OFF_MOD + (size_t)2 * 9 * 6144 * 4;
constexpr size_t OFF_H = OFF_BC + (size_t)NROWS * 8 * 4;
constexpr size_t OFF_YS = OFF_H + SZ_ACT;
constexpr size_t OFF_BIG = OFF_YS + (size_t)NROWS * YST * 2;
constexpr size_t OFF_CTR = OFF_BIG + (size_t)NROWS * 4096 * 2;
constexpr size_t OFF_XBAR = OFF_CTR + 256;
constexpr size_t WS_END = OFF_XBAR + 3456 * 4;
static_assert(WS_END <= (size_t)536870912, "ws too large");

__device__ __forceinline__ int launder_tid() { int t = threadIdx.x; asm volatile("" : "+v"(t)); return t; }
#define TIDX (launder_tid())
typedef float f32x2_t __attribute__((ext_vector_type(2)));
typedef __bf16 bf16x2_t __attribute__((ext_vector_type(2)));
__device__ __forceinline__ unsigned pack2(float a, float b) {
  const f32x2_t v = {a, b};
  const bf16x2_t r = __builtin_convertvector(v, bf16x2_t);
  return __builtin_bit_cast(unsigned, r);
}
__device__ __forceinline__ u16 f2bf(float f) { return (u16)(pack2(f, 0.f) & 0xffffu); }
__device__ __forceinline__ float bf2f(u16 h) { return __uint_as_float(((unsigned)h) << 16); }
__device__ __forceinline__ float sigm(float x) { return __builtin_amdgcn_rcpf(1.f + __expf(-x)); }
__device__ __forceinline__ float siluf(float x) { return x * __builtin_amdgcn_rcpf(1.f + __expf(-x)); }
__device__ __forceinline__ float rsq(float x) { return __builtin_amdgcn_rsqf(x); }
__device__ __forceinline__ float softplusf(float x) { return fmaxf(x, 0.f) + __logf(1.f + __expf(-fabsf(x))); }
__device__ __forceinline__ float tanh_fast(float x) { return 1.f - 2.f * __builtin_amdgcn_rcpf(1.f + __expf(2.f * x)); }
__device__ __forceinline__ float wsum(float v) {
#pragma unroll
  for (int o = 32; o > 0; o >>= 1) v += __shfl_xor(v, o);
  return v;
}
template <int CTRL>
__device__ __forceinline__ float dppf(float x) {
  return __int_as_float(__builtin_amdgcn_update_dpp(__float_as_int(x), __float_as_int(x), CTRL, 0xf, 0xf, false));
}
__device__ __forceinline__ float red8(float x) {
  x += dppf<0xB1>(x);
  x += dppf<0x4E>(x);
  x += dppf<0x141>(x);
  return x;
}
__device__ __forceinline__ const float* xin_row(const Params& p, int r) {
  int b = r / TPB, t = r - b * TPB;
  return t < LC ? p.ctx + ((size_t)(b * LC + t)) * DM : p.x + ((size_t)(b * SEQ + t - LC)) * DM;
}
__device__ __forceinline__ float* x_row(const Params& p, int r) {
  int b = r / TPB, t = r - b * TPB;
  return t < LC ? (float*)(p.ws + OFF_XC) + ((size_t)(b * LC + t)) * DM : p.out + ((size_t)(b * SEQ + t - LC)) * DM;
}
__device__ __forceinline__ int mod_row(int r) {
  int b = r / TPB, t = r - b * TPB;
  return t < LC ? 8 : b;
}

struct MapId { int lim, off; __device__ int operator()(int n) const { return n < lim ? n + off : -1; } };
struct MapW1 { __device__ int operator()(int n) const { int q = n >> 3, s = n & 7; return s < 4 ? q * 4 + s : FH + q * 4 + (s - 4); } };

template <class Map>
__device__ __forceinline__ void conv_tile(const float* __restrict__ src, int ld, u16* __restrict__ dst, int K, int n0,
                                          int k0, Map map, float* tile) {
  const int tid = TIDX;
  const int nn = tid & 63, kr = tid >> 6;
  const int sc = map(n0 + nn);
  float tv[8];
  const int scc = sc >= 0 ? sc : 0;
  const float scm = sc >= 0 ? 1.f : 0.f;
#pragma unroll
  for (int ps = 0; ps < 8; ps++) tv[ps] = src[(size_t)(k0 + ps * 8 + kr) * ld + scc];
#pragma unroll
  for (int ps = 0; ps < 8; ps++) tile[(ps * 8 + kr) * 65 + nn] = tv[ps] * scm;
  __syncthreads();
  const int n2 = tid >> 3, kc = tid & 7;
  uint4 o;
  o.x = pack2(tile[(kc * 8 + 0) * 65 + n2], tile[(kc * 8 + 1) * 65 + n2]);
  o.y = pack2(tile[(kc * 8 + 2) * 65 + n2], tile[(kc * 8 + 3) * 65 + n2]);
  o.z = pack2(tile[(kc * 8 + 4) * 65 + n2], tile[(kc * 8 + 5) * 65 + n2]);
  o.w = pack2(tile[(kc * 8 + 6) * 65 + n2], tile[(kc * 8 + 7) * 65 + n2]);
  *(uint4*)(dst + (size_t)(n0 + n2) * K + k0 + kc * 8) = o;
  __syncthreads();
}

__device__ __forceinline__ void conv_item(const Params& p, int l, int rem, float* sm) {
      u16* wl = (u16*)(p.ws + OFF_W);
      if (rem < 832) {
        int nt = rem >> 4, kt = rem & 15;
        conv_tile(p.w_in + (size_t)l * DM * INW, INW, (u16*)((char*)wl + OW_IN), 1024, nt * 64, kt * 64, MapId{3312, 0}, sm);
      } else if (rem < 832 + 1024) {
        rem -= 832;
        int nt = rem >> 4, kt = rem & 15;
        conv_tile(p.w_in + (size_t)l * DM * INW, INW, (u16*)((char*)wl + OW_G), 1024, nt * 64, kt * 64, MapId{4096, 3312}, sm);
      } else if (rem < 1856 + 256) {
        rem -= 1856;
        int br = rem >> 6, r2 = rem & 63, nt = r2 >> 2, kt = r2 & 3;
        conv_tile(p.w_branch + ((size_t)(l * 4 + br)) * 256 * DM, DM, (u16*)((char*)wl + OW_B) + (size_t)br * 1024 * 256, 256,
                  nt * 64, kt * 64, MapId{1024, 0}, sm);
      } else if (rem < 2112 + 256) {
        rem -= 2112;
        int nt = rem >> 4, kt = rem & 15;
        conv_tile(p.w_out + (size_t)l * DM * DM, DM, (u16*)((char*)wl + OW_O), 1024, nt * 64, kt * 64, MapId{1024, 0}, sm);
      } else if (rem < 2368 + 1408) {
        rem -= 2368;
        int nt = rem >> 4, kt = rem & 15;
        conv_tile(p.ffn_w1 + (size_t)l * DM * 5632, 5632, (u16*)((char*)wl + OW_1), 1024, nt * 64, kt * 64, MapW1{}, sm);
      } else {
        rem -= 3776;
        int nt = rem / 44, kt = rem - nt * 44;
        conv_tile(p.ffn_w2 + (size_t)l * FH * DM, DM, (u16*)((char*)wl + OW_2), FH, nt * 64, kt * 64, MapId{1024, 0}, sm);
      }
}

__device__ __forceinline__ void phase_init0(const Params& p, float* sm) {
  const int tid = TIDX;
  if (blockIdx.x == 0) {
    if (tid < 64) ((unsigned*)(p.ws + OFF_CTR))[tid] = 0u;
    for (int i = tid; i < 3456; i += NTHR) ((unsigned*)(p.ws + OFF_XBAR))[i] = 0u;
  }
  constexpr int NMOD = 192, NCONV = 832;
  for (int it = blockIdx.x; it < NMOD + NCONV; it += gridDim.x) {
    if (it < NMOD) {
      int l = it / 96, rem = it - l * 96, cc = rem >> 3, ks = rem & 7;
      for (int i = tid; i < 9 * 128; i += NTHR) {
        int r = i >> 7, k = i & 127;
        float v = r < 8 ? p.c[r * DM + ks * 128 + k] : p.c_ctx[ks * 128 + k];
        sm[i] = siluf(v);
      }
      __syncthreads();
      const int n = cc * 512 + tid;
      const float* w = p.ada_w + ((size_t)l * DM + ks * 128) * 6144 + n;
      float acc[9];
#pragma unroll
      for (int r = 0; r < 9; r++) acc[r] = 0.f;
#pragma unroll 1
      for (int k0 = 0; k0 < 128; k0 += 16) {
        float wv[16];
#pragma unroll
        for (int kk = 0; kk < 16; kk++) wv[kk] = w[(size_t)(k0 + kk) * 6144];
#pragma unroll
        for (int kk = 0; kk < 16; kk++)
#pragma unroll
          for (int r = 0; r < 9; r++) acc[r] += sm[r * 128 + k0 + kk] * wv[kk];
      }
      float* mp = (float*)(p.ws + OFF_MODP) + ((size_t)(l * 8 + ks) * 9) * 6144 + n;
#pragma unroll
      for (int r = 0; r < 9; r++) mp[(size_t)r * 6144] = acc[r];
      __syncthreads();
    } else {
      conv_item(p, 0, it - NMOD, sm);
    }
  }
}

__device__ __forceinline__ void phase_init1(const Params& p) {
  const float* mp = (const float*)(p.ws + OFF_MODP);
  float* mo = (float*)(p.ws + OFF_MOD);
  for (int i = blockIdx.x * NTHR + TIDX; i < 2 * 9 * 6144; i += gridDim.x * NTHR) {
    int l = i / (9 * 6144), rem = i - l * 9 * 6144, r = rem / 6144, n = rem - r * 6144;
    float s = p.ada_b[l * 6144 + n];
#pragma unroll
    for (int ks = 0; ks < 8; ks++) s += mp[((size_t)((l * 8 + ks) * 9 + r)) * 6144 + n];
    mo[i] = s;
  }
}

__device__ __forceinline__ void rowpass(const Params& p, int l, int mode) {
  const int lane = TIDX & 63, wv = TIDX >> 6;
  const float* MOD = (const float*)(p.ws + OFF_MOD);
  u16* H = (u16*)(p.ws + OFF_H);
  const bool do_norm = !(mode == 2 && l == 1);
  const int ln = (mode == 2) ? (l == 1 ? l : l + 1) : l;
  const int ni = (mode == 1) ? 2 : 0, sho = (mode == 1) ? 3072 : 0, sco = (mode == 1) ? 4096 : 1024;
  for (int r = blockIdx.x * 8 + wv; r < NROWS; r += gridDim.x * 8) {
    const int mr = mod_row(r);
    if (l == 1 && mode != 0 && mr == 8) continue;
    const float* modl = MOD + ((size_t)(l * 9 + mr)) * 6144;
    const float* modn = MOD + ((size_t)(ln * 9 + mr)) * 6144;
    const float* ng2 = p.norm_g + (size_t)(ln * 4 + ni) * DM;
    const float* xs = (mode == 0 || (mode == 1 && l == 0)) ? xin_row(p, r) : (const float*)x_row(p, r);
    float4 xo[4], n2[4], sc4[4], sh4[4];
#pragma unroll
    for (int i = 0; i < 4; i++) {
      const int col = i * 256 + lane * 4;
      xo[i] = *(const float4*)(xs + col);
      n2[i] = *(const float4*)(ng2 + col);
      sc4[i] = *(const float4*)(modn + sco + col);
      sh4[i] = *(const float4*)(modn + sho + col);
    }
    float xv[16];
    if (mode == 0) {
#pragma unroll
      for (int i = 0; i < 4; i++) { xv[i * 4 + 0] = xo[i].x; xv[i * 4 + 1] = xo[i].y; xv[i * 4 + 2] = xo[i].z; xv[i * 4 + 3] = xo[i].w; }
    } else {
      const u16* src = (const u16*)(p.ws + (mode == 1 ? OFF_BIG : OFF_YS)) + (size_t)r * DM;
      const float* ng = p.norm_g + (size_t)(l * 4 + (mode == 1 ? 1 : 3)) * DM;
      const float* gt = modl + (mode == 1 ? 2048 : 5120);
      uint2 sv[4];
      float4 g4[4], n4[4];
#pragma unroll
      for (int i = 0; i < 4; i++) {
        const int col = i * 256 + lane * 4;
        sv[i] = *(const uint2*)(src + col);
        g4[i] = *(const float4*)(gt + col);
        n4[i] = *(const float4*)(ng + col);
      }
      float ov[16];
      float ss = 0.f;
#pragma unroll
      for (int i = 0; i < 4; i++) {
        ov[i * 4 + 0] = __uint_as_float(sv[i].x << 16); ov[i * 4 + 1] = __uint_as_float(sv[i].x & 0xffff0000u);
        ov[i * 4 + 2] = __uint_as_float(sv[i].y << 16); ov[i * 4 + 3] = __uint_as_float(sv[i].y & 0xffff0000u);
      }
#pragma unroll
      for (int i = 0; i < 16; i++) ss += ov[i] * ov[i];
      ss = wsum(ss);
      const float inv = rsq(ss * (1.f / 1024.f) + 1e-6f);
      float* xd = x_row(p, r);
#pragma unroll
      for (int i = 0; i < 4; i++) {
        xv[i * 4 + 0] = xo[i].x + g4[i].x * (ov[i * 4 + 0] * inv * n4[i].x);
        xv[i * 4 + 1] = xo[i].y + g4[i].y * (ov[i * 4 + 1] * inv * n4[i].y);
        xv[i * 4 + 2] = xo[i].z + g4[i].z * (ov[i * 4 + 2] * inv * n4[i].z);
        xv[i * 4 + 3] = xo[i].w + g4[i].w * (ov[i * 4 + 3] * inv * n4[i].w);
      }
#pragma unroll
      for (int i = 0; i < 4; i++)
        *(float4*)(xd + i * 256 + lane * 4) = make_float4(xv[i * 4 + 0], xv[i * 4 + 1], xv[i * 4 + 2], xv[i * 4 + 3]);
    }
    if (!do_norm) continue;
    float ss2 = 0.f;
#pragma unroll
    for (int i = 0; i < 16; i++) ss2 += xv[i] * xv[i];
    ss2 = wsum(ss2);
    const float inv2 = rsq(ss2 * (1.f / 1024.f) + 1e-6f);
#pragma unroll
    for (int i = 0; i < 4; i++) {
      const int col = i * 256 + lane * 4;
      float h0 = xv[i * 4 + 0] * inv2 * n2[i].x * (1.f + sc4[i].x) + sh4[i].x;
      float h1 = xv[i * 4 + 1] * inv2 * n2[i].y * (1.f + sc4[i].y) + sh4[i].y;
      float h2 = xv[i * 4 + 2] * inv2 * n2[i].z * (1.f + sc4[i].z) + sh4[i].z;
      float h3 = xv[i * 4 + 3] * inv2 * n2[i].w * (1.f + sc4[i].w) + sh4[i].w;
      uint2 o;
      o.x = pack2(h0, h1);
      o.y = pack2(h2, h3);
      *(uint2*)(H + (size_t)r * DM + col) = o;
    }
  }
}

#define LDT 72
namespace pg8 {
#define PG8_LAS __attribute__((address_space(3)))
typedef unsigned short bf16_t;
typedef short bf16x8 __attribute__((ext_vector_type(8)));
typedef float f32x4 __attribute__((ext_vector_type(4)));
typedef unsigned u32x4 __attribute__((ext_vector_type(4)));
constexpr int BM = 256, BK = 64, HALF = 128, HTB = HALF * BK * 2  , STAGE_BYTES = 8 * HTB, NXCD = 8, WGM = 8;

__host__ __device__ __forceinline__ int lds_byte(int r, int c) { const int st = (r >> 4) * 2 + (c >> 5), rr = r & 15, cc = c & 31, ob = rr * 64 + cc * 2; return st * 1024 + (ob ^ (((ob >> 9) & 1) << 5)); }
__host__ __device__ __forceinline__ void stage_rc(int b, int& R, int& C) { const int st = b / 1024, sb = b % 1024, swz = sb ^ (((sb >> 9) & 1) << 5); R = (st >> 1) * 16 + swz / 64; C = (st & 1) * 32 + (swz % 64) / 2; }
__host__ __device__ __forceinline__ int perm32(int rho) { const int n = rho >> 4, i = rho & 15; return 8 * (i >> 2) + 4 * n + (i & 3); }

struct Unit { int pm, pn; };
struct Gemm { const bf16_t* A; const bf16_t* Bt; int M, N, K, lda; };
struct StaticOrder {
    int nM, nN, nwg, G, c, skip;
    __host__ __device__ void init(int M, int N, int G_, int c_, int skip_ = 0) { nM = M / BM; nN = N / BM; nwg = nM * nN; G = G_; c = c_; skip = skip_; }
    __host__ __device__ bool next(int i, Unit& u) const {
        const long L = (long)i * G + c; if (L >= nwg) return false;
        int wgid = (int)L; { const int q = nwg / NXCD, r = nwg % NXCD, xcd = wgid % NXCD, off = wgid / NXCD; wgid = (xcd < r ? xcd * (q + 1) : r * (q + 1) + (xcd - r) * q) + off; }
        const int nig = WGM * nN, gid = wgid / nig, fm = gid * WGM, gsz = (nM - fm) < WGM ? (nM - fm) : WGM;
        u.pm = fm + ((wgid % nig) % gsz); u.pn = (wgid % nig) / gsz;
        if (skip) u.pm = (u.pm >> 4) * 17 + 1 + (u.pm & 15);
        return true;
    }
    __device__ __forceinline__ void a_ready(const Unit&) const {}
    __device__ __forceinline__ void done(const Unit&) const {}
};
__device__ __forceinline__ unsigned cvt_pk_bf16(float lo, float hi) { unsigned r; asm volatile("v_cvt_pk_bf16_f32 %0, %1, %2" : "=v"(r) : "v"(lo), "v"(hi)); return r; }
template <class Epi, class Sched, bool STAMP = false>
__device__ __forceinline__ void gemm_phase(PG8_LAS unsigned char* lds, const Gemm g, const Sched& S, const Epi& E, unsigned long long* stamps) {
    const int tid = TIDX, wid = __builtin_amdgcn_readfirstlane(tid >> 6), lane = tid & 63, wr = wid >> 2, wc = wid & 3, fr = lane & 15, fq = lane >> 4;
    const int K = g.K, nt = K / BK;
    int ts_lo = 0, ts_hi = 0, nts = 0; const unsigned long long rt_entry = STAMP ? (unsigned long long)wall_clock64() : 0ull;
#define PG8_STAMP() do { if (STAMP && wid == 0 && nts < 64) { const unsigned long long _c = (unsigned long long)clock64(); \
        ts_lo = (lane == nts) ? (int)(unsigned)_c : ts_lo; ts_hi = (lane == nts) ? (int)(unsigned)(_c >> 32) : ts_hi; ++nts; } } while (0)
    PG8_STAMP();
    unsigned voffA[2], voffB[2];
#pragma unroll
    for (int i = 0; i < 2; ++i) { int R, C; stage_rc(tid * 16 + i * 8192, R, C); const int Rb = Epi::PERM ? ((R & ~31) + perm32(R & 31)) : R;
        voffA[i] = (unsigned)(R * g.lda + C) * 2u; voffB[i] = (unsigned)(Rb * K + C) * 2u; }
    const size_t kstep = (size_t)(BK * 2);
    const size_t hstepB = (size_t)HALF * K * 2, hstepA = (size_t)HALF * g.lda * 2;
    const size_t tstepB = 2 * hstepB, tstepA = 2 * hstepA;
    const unsigned ldsw = (unsigned)wid * 1024u;
    const int aoff = lds_byte(wr * 64 + fr, fq * 8), boff = lds_byte(wc * 32 + fr, fq * 8);
#define PG8_SA(b, h) (((b) * 2 + (h)) * HTB)
#define PG8_SB(b, h) ((4 + (b) * 2 + (h)) * HTB)
#define PG8_STAGE(bufoff, gbase, voff) do { _Pragma("unroll") for (int _i = 0; _i < 2; ++_i) \
        __builtin_amdgcn_global_load_lds((const unsigned*)((const char*)(gbase) + (voff)[_i]), (PG8_LAS unsigned*)(lds + (bufoff) + ldsw + _i * 8192), 16, 0, 0); } while (0)
#define PG8_LDA(dst, b, h) do { _Pragma("unroll") for (int m = 0; m < 4; ++m) _Pragma("unroll") for (int k = 0; k < 2; ++k) dst[m][k] = *(const PG8_LAS bf16x8*)(lds + PG8_SA(b, h) + aoff + m * 2048 + k * 1024); } while (0)
#define PG8_LDB(dst, b, h) do { _Pragma("unroll") for (int n = 0; n < 2; ++n) _Pragma("unroll") for (int k = 0; k < 2; ++k) dst[n][k] = *(const PG8_LAS bf16x8*)(lds + PG8_SB(b, h) + boff + n * 2048 + k * 1024); } while (0)
#define PG8_MMA(ai, bj, At, Bt) do { __builtin_amdgcn_s_setprio(1); _Pragma("unroll") for (int m = 0; m < 4; ++m) _Pragma("unroll") for (int n = 0; n < 2; ++n) _Pragma("unroll") for (int k = 0; k < 2; ++k) \
        acc[ai][bj][m][n] = __builtin_amdgcn_mfma_f32_16x16x32_bf16(Bt[n][k], At[m][k], acc[ai][bj][m][n], 0, 0, 0); __builtin_amdgcn_s_setprio(0); } while (0)
#define PG8_WAIT_V(n) asm volatile("s_waitcnt vmcnt(" #n ")" ::: "memory")
#define PG8_WAIT_L(n) asm volatile("s_waitcnt lgkmcnt(" #n ")" ::: "memory")
#define PG8_BAR __builtin_amdgcn_s_barrier()
#define PG8_SCHED __builtin_amdgcn_sched_barrier(0)
    Unit cur, nxt; int ui = 0;
    if (!S.next(0, cur)) return;
    f32x4 acc[2][2][4][2];
#pragma unroll
    for (int a = 0; a < 2; ++a)
#pragma unroll
        for (int b = 0; b < 2; ++b)
#pragma unroll
            for (int m = 0; m < 4; ++m)
#pragma unroll
                for (int n = 0; n < 2; ++n) acc[a][b][m][n] = (f32x4){0.f, 0.f, 0.f, 0.f};
    bf16x8 At[4][2], B0[2][2], B1[2][2];
    const char* cA = (const char*)g.A + (size_t)cur.pm * tstepA; const char* cB = (const char*)g.Bt + (size_t)cur.pn * tstepB;
    S.a_ready(cur);
    PG8_STAGE(PG8_SB(0, 0), cB, voffB); PG8_STAGE(PG8_SA(0, 0), cA, voffA); PG8_STAGE(PG8_SB(0, 1), cB + hstepB, voffB); PG8_STAGE(PG8_SA(0, 1), cA + hstepA, voffA);
    if (wr == 1) PG8_BAR;
    PG8_WAIT_V(4); PG8_BAR;
    PG8_STAGE(PG8_SB(1, 0), cB + kstep, voffB); PG8_STAGE(PG8_SA(1, 0), cA + kstep, voffA); PG8_STAGE(PG8_SB(1, 1), cB + hstepB + kstep, voffB);
    PG8_WAIT_V(6); PG8_BAR;
    PG8_STAMP();
    for (;;) {
        const bool has_next = S.next(ui + 1, nxt);
        const char* nA = has_next ? (const char*)g.A + (size_t)nxt.pm * tstepA : cA; const char* nB = has_next ? (const char*)g.Bt + (size_t)nxt.pn * tstepB : cB;
        for (int t = 0; t < nt; t += 2) {
            const bool last = (t == nt - 2);
            const char* a1 = cA + (size_t)(t + 1) * kstep;
            const char* a2 = last ? nA : cA + (size_t)(t + 2) * kstep; const char* b2 = last ? nB : cB + (size_t)(t + 2) * kstep;
            const char* a3 = a2 + kstep; const char* b3 = b2 + kstep;
            if (last && has_next) S.a_ready(nxt);
            PG8_LDB(B0, 0, 0); PG8_SCHED; PG8_LDA(At, 0, 0); PG8_STAGE(PG8_SA(1, 1), a1 + hstepA, voffA);
            PG8_WAIT_L(8); PG8_BAR; PG8_WAIT_L(0); PG8_MMA(0, 0, At, B0); PG8_BAR; PG8_SCHED;
            PG8_LDB(B1, 0, 1); PG8_STAGE(PG8_SB(0, 0), b2, voffB);
            PG8_BAR; PG8_WAIT_L(0); PG8_MMA(0, 1, At, B1); PG8_BAR;
            PG8_LDA(At, 0, 1); PG8_STAGE(PG8_SA(0, 0), a2, voffA);
            PG8_BAR; PG8_WAIT_L(0); PG8_MMA(1, 0, At, B0); PG8_BAR; PG8_SCHED;
            PG8_STAGE(PG8_SB(0, 1), b2 + hstepB, voffB);
            PG8_WAIT_V(6); PG8_BAR; PG8_MMA(1, 1, At, B1); PG8_BAR;
            PG8_LDB(B0, 1, 0); PG8_SCHED; PG8_LDA(At, 1, 0); PG8_STAGE(PG8_SA(0, 1), a2 + hstepA, voffA);
            PG8_WAIT_L(8); PG8_BAR; PG8_WAIT_L(0); PG8_MMA(0, 0, At, B0); PG8_BAR; PG8_SCHED;
            PG8_LDB(B1, 1, 1); PG8_STAGE(PG8_SB(1, 0), b3, voffB);
            PG8_BAR; PG8_WAIT_L(0); PG8_MMA(0, 1, At, B1); PG8_BAR;
            PG8_LDA(At, 1, 1); PG8_STAGE(PG8_SA(1, 0), a3, voffA);
            PG8_BAR; PG8_WAIT_L(0); PG8_MMA(1, 0, At, B0); PG8_BAR; PG8_SCHED;
            PG8_STAGE(PG8_SB(1, 1), b3 + hstepB, voffB);
            PG8_WAIT_V(6); PG8_BAR; PG8_MMA(1, 1, At, B1); PG8_BAR;
        }
        PG8_STAMP();
        if constexpr (!Epi::AFTER_DRAIN) { E(acc, cur, wr, wc, fr, fq); S.done(cur); }
        PG8_STAMP();
        if (!has_next) break;
#pragma unroll
        for (int a = 0; a < 2; ++a)
#pragma unroll
            for (int b = 0; b < 2; ++b)
#pragma unroll
                for (int m = 0; m < 4; ++m)
#pragma unroll
                    for (int n = 0; n < 2; ++n) acc[a][b][m][n] = (f32x4){0.f, 0.f, 0.f, 0.f};
        cur = nxt; cA = nA; cB = nB; ++ui;
    }
    PG8_WAIT_V(0);
    if (wr == 0) PG8_BAR;
    PG8_BAR;
    if constexpr (Epi::AFTER_DRAIN) { E.fused(acc, cur, wr, wc, fr, fq, lds, wid, lane); S.done(cur); }
    PG8_STAMP();
    if (STAMP && wid == 0) { stamps[lane] = lane < nts ? (((unsigned long long)(unsigned)ts_hi << 32) | (unsigned)ts_lo) : 0ull;
        if (lane == 62) stamps[62] = rt_entry; if (lane == 63) stamps[63] = (unsigned long long)wall_clock64(); }
#undef PG8_STAMP
#undef PG8_SA
#undef PG8_SB
#undef PG8_STAGE
#undef PG8_LDA
#undef PG8_LDB
#undef PG8_MMA
#undef PG8_WAIT_V
#undef PG8_WAIT_L
#undef PG8_BAR
#undef PG8_SCHED
}
}

struct EpiBf {
  static constexpr bool PERM = true, AFTER_DRAIN = false;
  u16* O; int ldc; const float* bias; int act;
  __device__ __forceinline__ void operator()(const f32x4 (&acc)[2][2][4][2], const pg8::Unit& u, int wr, int wc, int fr, int fq) const {
    const int row0 = u.pm * 256 + wr * 64 + fr, col0 = u.pn * 256 + wc * 32 + 8 * fq;
    f32x4 bv[2][2];
#pragma unroll
    for (int bj = 0; bj < 2; ++bj)
#pragma unroll
      for (int n = 0; n < 2; ++n) bv[bj][n] = bias ? *(const f32x4*)(bias + col0 + bj * 128 + 4 * n) : f32x4{0.f, 0.f, 0.f, 0.f};
#pragma unroll
    for (int ai = 0; ai < 2; ++ai)
#pragma unroll
      for (int m = 0; m < 4; ++m) {
        u16* rowp = O + (size_t)(row0 + ai * 128 + m * 16) * ldc + col0;
#pragma unroll
        for (int bj = 0; bj < 2; ++bj) {
          f32x4 v0 = acc[ai][bj][m][0] + bv[bj][0], v1 = acc[ai][bj][m][1] + bv[bj][1];
          if (act == 1) {
#pragma unroll
            for (int j = 0; j < 4; ++j) { v0[j] = sigm(v0[j]); v1[j] = sigm(v1[j]); }
          }
          uint4 wv;
          wv.x = pack2(v0[0], v0[1]); wv.y = pack2(v0[2], v0[3]); wv.z = pack2(v1[0], v1[1]); wv.w = pack2(v1[2], v1[3]);
          *(uint4*)(rowp + bj * 128) = wv;
        }
      }
  }
};
struct EpiSwiglu {
  static constexpr bool PERM = true, AFTER_DRAIN = false;
  u16* O;
  __device__ __forceinline__ void operator()(const f32x4 (&acc)[2][2][4][2], const pg8::Unit& u, int wr, int wc, int fr, int fq) const {
    const int row0 = u.pm * 256 + wr * 64 + fr, col0 = u.pn * 128 + wc * 16 + 4 * fq;
#pragma unroll
    for (int ai = 0; ai < 2; ++ai)
#pragma unroll
      for (int m = 0; m < 4; ++m) {
        u16* rowp = O + (size_t)(row0 + ai * 128 + m * 16) * FH + col0;
#pragma unroll
        for (int bj = 0; bj < 2; ++bj) {
          const f32x4 g = acc[ai][bj][m][0], up = acc[ai][bj][m][1];
          uint2 wv;
          wv.x = pack2(siluf(g[0]) * up[0], siluf(g[1]) * up[1]);
          wv.y = pack2(siluf(g[2]) * up[2], siluf(g[3]) * up[3]);
          *(uint2*)(rowp + bj * 64) = wv;
        }
      }
  }
};
struct EpiGateAcc {
  static constexpr bool PERM = true, AFTER_DRAIN = false;
  u16* ACC; const u16* G; int gcol; unsigned amask;
  __device__ __forceinline__ void operator()(const f32x4 (&acc)[2][2][4][2], const pg8::Unit& u, int wr, int wc, int fr, int fq) const {
    unsigned pk[2][2][4][4];
#pragma unroll
    for (int ai = 0; ai < 2; ++ai)
#pragma unroll
      for (int bj = 0; bj < 2; ++bj)
#pragma unroll
        for (int m = 0; m < 4; ++m) {
          pk[ai][bj][m][0] = pack2(acc[ai][bj][m][0][0], acc[ai][bj][m][0][1]);
          pk[ai][bj][m][1] = pack2(acc[ai][bj][m][0][2], acc[ai][bj][m][0][3]);
          pk[ai][bj][m][2] = pack2(acc[ai][bj][m][1][0], acc[ai][bj][m][1][1]);
          pk[ai][bj][m][3] = pack2(acc[ai][bj][m][1][2], acc[ai][bj][m][1][3]);
        }
    asm volatile("" ::: "memory");
    const int row0 = u.pm * 256 + wr * 64 + fr, col0 = u.pn * 256 + wc * 32 + 8 * fq;
#pragma unroll
    for (int ai = 0; ai < 2; ++ai)
#pragma unroll
      for (int m = 0; m < 4; ++m) {
        const size_t row = (size_t)(row0 + ai * 128 + m * 16);
#pragma unroll
        for (int bj = 0; bj < 2; ++bj) {
          const int col = col0 + bj * 128;
          const uint4 gv = *(const uint4*)(G + row * 2048 + gcol + col);
          const uint4 av = *(const uint4*)(ACC + row * DM + col);
          const unsigned gw[4] = {gv.x, gv.y, gv.z, gv.w};
          const unsigned aw[4] = {av.x & amask, av.y & amask, av.z & amask, av.w & amask};
          unsigned ow[4];
#pragma unroll
          for (int q = 0; q < 4; ++q) {
            const unsigned pv = pk[ai][bj][m][q];
            const float lo = __uint_as_float(aw[q] << 16) + __uint_as_float(gw[q] << 16) * __uint_as_float(pv << 16);
            const float hi = __uint_as_float(aw[q] & 0xffff0000u) + __uint_as_float(gw[q] & 0xffff0000u) * __uint_as_float(pv & 0xffff0000u);
            ow[q] = pack2(lo, hi);
          }
          *(uint4*)(ACC + row * DM + col) = make_uint4(ow[0], ow[1], ow[2], ow[3]);
        }
        asm volatile("" ::: "memory");
      }
  }
};

template <int MI>
__device__ __forceinline__ void gemm_loop(const u16* __restrict__ A, int lda, const u16* __restrict__ Bt, int ldb, int K,
                                          f32x4 (&acc)[MI][4], u16* sA, u16* sB) {
  constexpr int BMT = MI * 64;
  const int tid = TIDX, lane = tid & 63, w = tid >> 6, wm = w >> 1, wn = w & 1, fr = lane & 15, fq = lane >> 4;
  uint4 ra[MI], rb[2];
  const u16* ga = A + (size_t)(tid >> 3) * lda + (tid & 7) * 8;
  const u16* gb = Bt + (size_t)(tid >> 3) * ldb + (tid & 7) * 8;
  const int so = (tid >> 3) * LDT + (tid & 7) * 8;
#pragma unroll
  for (int i = 0; i < MI; i++) ra[i] = *(const uint4*)(ga + (size_t)(i * 64) * lda);
#pragma unroll
  for (int i = 0; i < 2; i++) rb[i] = *(const uint4*)(gb + (size_t)(i * 64) * ldb);
#pragma unroll
  for (int i = 0; i < MI; i++) *(uint4*)(sA + so + i * 64 * LDT) = ra[i];
#pragma unroll
  for (int i = 0; i < 2; i++) *(uint4*)(sB + so + i * 64 * LDT) = rb[i];
  __syncthreads();
  const int nk = K >> 6;
  for (int kt = 0; kt < nk; kt++) {
    const bool more = kt + 1 < nk;
    if (more) {
#pragma unroll
      for (int i = 0; i < MI; i++) ra[i] = *(const uint4*)(ga + (size_t)(i * 64) * lda + (kt + 1) * 64);
#pragma unroll
      for (int i = 0; i < 2; i++) rb[i] = *(const uint4*)(gb + (size_t)(i * 64) * ldb + (kt + 1) * 64);
    }
    const u16* a = sA + (kt & 1) * BMT * LDT + (wm * (MI * 16) + fr) * LDT + fq * 8;
    const u16* b = sB + (kt & 1) * 128 * LDT + (wn * 64 + fr) * LDT + fq * 8;
#pragma unroll
    for (int ks = 0; ks < 2; ks++) {
      bf16x8 af[MI], bfr[4];
#pragma unroll
      for (int i = 0; i < MI; i++) af[i] = *(const bf16x8*)(a + i * 16 * LDT + ks * 32);
#pragma unroll
      for (int j = 0; j < 4; j++) bfr[j] = *(const bf16x8*)(b + j * 16 * LDT + ks * 32);
#pragma unroll
      for (int i = 0; i < MI; i++)
#pragma unroll
        for (int j = 0; j < 4; j++) acc[i][j] = __builtin_amdgcn_mfma_f32_16x16x32_bf16(bfr[j], af[i], acc[i][j], 0, 0, 0);
    }
    if (more) {
      u16* da = sA + ((kt + 1) & 1) * BMT * LDT + so;
      u16* db = sB + ((kt + 1) & 1) * 128 * LDT + so;
#pragma unroll
      for (int i = 0; i < MI; i++) *(uint4*)(da + i * 64 * LDT) = ra[i];
#pragma unroll
      for (int i = 0; i < 2; i++) *(uint4*)(db + i * 64 * LDT) = rb[i];
    }
    __syncthreads();
  }
}

template <int MI>
__device__ __forceinline__ void zero_acc(f32x4 (&acc)[MI][4]) {
#pragma unroll
  for (int i = 0; i < MI; i++)
#pragma unroll
    for (int j = 0; j < 4; j++) acc[i][j] = f32x4{0.f, 0.f, 0.f, 0.f};
}


typedef unsigned u32x4v __attribute__((ext_vector_type(4)));
__device__ __forceinline__ void yp_issue(const u16* __restrict__ A, const u16* __restrict__ B, u32x4v (&ra)[8], u32x4v (&rb)[8], int tid) {
#pragma unroll
  for (int i = 0; i < 8; i++) {
    const int c = tid + i * NTHR, row = c >> 5, ch = c & 31;
    ra[i] = *(const u32x4v*)(A + (size_t)row * YST + ch * 8);
    rb[i] = *(const u32x4v*)(B + (size_t)row * 256 + ch * 8);
  }
}
__device__ __forceinline__ void yp_stage(unsigned char* sA, unsigned char* sB, const u32x4v (&ra)[8], const u32x4v (&rb)[8], int tid) {
#pragma unroll
  for (int i = 0; i < 8; i++) {
    const int c = tid + i * NTHR, row = c >> 5, ch = c & 31;
    const int off = row * 512 + ((ch ^ (row & 7)) << 4);
    *(u32x4v*)(sA + off) = ra[i];
    *(u32x4v*)(sB + off) = rb[i];
  }
}
__device__ __forceinline__ void phase_ypart(const Params& p, int l, unsigned char* smem) {
  unsigned char* sA = smem;
  unsigned char* sB = smem + 65536;
  const int tid = TIDX, lane = tid & 63, w = tid >> 6, wm = w >> 1, wn = w & 1, fr = lane & 15, fq = lane >> 4;
  const u16* Y = (const u16*)(p.ws + OFF_YS);
  const u16* Wb = (const u16*)(p.ws + OFF_W + OW_B);
  const u16* G = (const u16*)(p.ws + OFF_BIG);
  u16* ACC = (u16*)(p.ws + OFF_H);
  constexpr int NT = 8;
  const int ntiles = (NROWS / 128) * NT;
  const int G_ = gridDim.x;
  const bool xmap = (G_ == 256);
  const int xj = blockIdx.x >> 3, xx = blockIdx.x & 7;
  const bool skipc = (l == 1);
  const int nrt = skipc ? 256 : 272;
  const int ntl = nrt * NT;
  const int nmine = xmap ? (xj < nrt ? (nrt - 1 - xj) / 32 + 1 : 0)
                         : (((int)blockIdx.x < ntl) ? (ntl - 1 - (int)blockIdx.x) / G_ + 1 : 0);
  if (nmine == 0) return;
#define YP_TILE(Q_, MT_, NT_)                                                        \
  do {                                                                               \
    if (xmap) { const int s_ = (Q_) * 32 + xj; MT_ = (s_ >> 3) * 8 + xx; NT_ = s_ & 7; } \
    else { const int t_ = blockIdx.x + (Q_) * G_; MT_ = t_ / NT; NT_ = t_ - MT_ * NT; }  \
    if (skipc) MT_ = (MT_ >> 5) * 34 + 2 + (MT_ & 31);                                   \
  } while (0)
  u32x4v ra[8], rb[8];
  {
    int mt, nt;
    YP_TILE(0, mt, nt);
    yp_issue(Y + (size_t)mt * 128 * YST, Wb + ((size_t)nt * 128) * 256, ra, rb, tid);
  }
  f32x4 tot[2][4];
  zero_acc<2>(tot);
  for (int qi = 0; qi < 4 * nmine; qi++) {
    const int q = qi >> 2, k = qi & 3;
    int mt, nt;
    YP_TILE(q, mt, nt);
    const int r0 = mt * 128 + wm * 32 + fr, c0 = nt * 128 + wn * 64 + fq * 4;
    __syncthreads();
    yp_stage(sA, sB, ra, rb, tid);
    __syncthreads();
    {
      const int qn = qi + 1 < 4 * nmine ? qi + 1 : qi;
      int mtn, ntn;
      YP_TILE(qn >> 2, mtn, ntn);
      const int brn = qn & 3, ycn = brn < 3 ? brn * 256 : 1536;
      yp_issue(Y + (size_t)mtn * 128 * YST + ycn, Wb + ((size_t)brn * 1024 + ntn * 128) * 256, ra, rb, tid);
    }
    uint2 gv[2][4];
#pragma unroll
    for (int i = 0; i < 2; i++)
#pragma unroll
      for (int j = 0; j < 4; j++) gv[i][j] = *(const uint2*)(G + (size_t)(r0 + i * 16) * 4096 + k * 1024 + c0 + j * 16);
    f32x4 ay[2][4];
    zero_acc<2>(ay);
#pragma unroll 2
    for (int ks = 0; ks < 8; ks++) {
      bf16x8 af[2], bfr[4];
#pragma unroll
      for (int i = 0; i < 2; i++) {
        const int row = wm * 32 + i * 16 + fr;
        af[i] = *(const bf16x8*)(sA + row * 512 + (((ks * 4 + fq) ^ (row & 7)) << 4));
      }
#pragma unroll
      for (int j = 0; j < 4; j++) {
        const int row = wn * 64 + j * 16 + fr;
        bfr[j] = *(const bf16x8*)(sB + row * 512 + (((ks * 4 + fq) ^ (row & 7)) << 4));
      }
#pragma unroll
      for (int i = 0; i < 2; i++)
#pragma unroll
        for (int j = 0; j < 4; j++) ay[i][j] = __builtin_amdgcn_mfma_f32_16x16x32_bf16(bfr[j], af[i], ay[i][j], 0, 0, 0);
    }
#pragma unroll
    for (int i = 0; i < 2; i++)
#pragma unroll
      for (int j = 0; j < 4; j++) {
        tot[i][j][0] += __uint_as_float(gv[i][j].x << 16) * ay[i][j][0];
        tot[i][j][1] += __uint_as_float(gv[i][j].x & 0xffff0000u) * ay[i][j][1];
        tot[i][j][2] += __uint_as_float(gv[i][j].y << 16) * ay[i][j][2];
        tot[i][j][3] += __uint_as_float(gv[i][j].y & 0xffff0000u) * ay[i][j][3];
      }
    if (k == 3) {
#pragma unroll
      for (int i = 0; i < 2; i++)
#pragma unroll
        for (int j = 0; j < 4; j++) {
          uint2 ov;
          ov.x = pack2(tot[i][j][0], tot[i][j][1]); ov.y = pack2(tot[i][j][2], tot[i][j][3]);
          *(uint2*)(ACC + (size_t)(r0 + i * 16) * DM + c0 + j * 16) = ov;
        }
      zero_acc<2>(tot);
    }
  }
  __syncthreads();
#undef YP_TILE
}

#define S2_BUF 10816
#define S2_D 0
#define S2_U 2048
#define S2_P 4096
#define S2_K 6144
#define S2_DQ 8192
#define S2_V 10240
#define S2_C1 10752
#define S2_C2 10784
#define S2_ST (2 * S2_BUF)
#define S2_YB (S2_ST + 8192)

__device__ __forceinline__ float red16(float x) {
  x += dppf<0xB1>(x);
  x += dppf<0x4E>(x);
  x += dppf<0x141>(x);
  x += dppf<0x140>(x);
  return x;
}
__device__ __forceinline__ void wave_lds_sync() {
  asm volatile("s_waitcnt lgkmcnt(0)" ::: "memory");
  __builtin_amdgcn_wave_barrier();
}

template <int MIX>
__device__ __forceinline__ void scan2_item(const Params& p, int l, int b, int h, int dir, int rq, float* sm) {
  constexpr int EPL = (MIX == 2) ? 2 : 4;
  constexpr int VOFF = (MIX == 2) ? 64 : 128;
  const int tid = TIDX, lane = tid & 63, w = tid >> 6, fr = lane & 15, fq = lane >> 4;
  const bool producer = w >= 4;
  const int pw = w & 3;
  const u16* P = (const u16*)(p.ws + OFF_BIG);
  u16* YS = (u16*)(p.ws + OFF_YS);
  float* BC = (float*)(p.ws + OFF_BC);
  float* ST = sm + S2_ST + pw * 2048;
  float s[EPL];
#pragma unroll
  for (int i = 0; i < EPL; i++) s[i] = 0.f;

  bf16x8 bw2[4], ba2[4];
  float cst[5][4];
  float cw[3][7];
  float muv[4];
  int colv[4];
#pragma unroll
  for (int i = 0; i < 4; i++) { bw2[i] = bf16x8{0, 0, 0, 0, 0, 0, 0, 0}; ba2[i] = bw2[i]; muv[i] = 0.f; colv[i] = 0; }
  if (producer) {
    if (MIX == 0) {
#pragma unroll
      for (int nt = 0; nt < 4; nt++) {
        const int jch = h * 64 + nt * 16 + fr;
#pragma unroll
        for (int jj = 0; jj < 8; jj++) {
          bw2[nt][jj] = (short)f2bf(p.rwkv_w2[((size_t)(l * 2 + dir) * 32 + fq * 8 + jj) * 256 + jch]);
          ba2[nt][jj] = (short)f2bf(p.rwkv_a2[((size_t)(l * 2 + dir) * 32 + fq * 8 + jj) * 256 + jch]);
        }
        cst[0][nt] = p.rwkv_w0[(l * 2 + dir) * 256 + jch];
        cst[1][nt] = p.rwkv_a0[(l * 2 + dir) * 256 + jch];
        cst[2][nt] = p.rwkv_ka[l * 256 + jch];
        cst[3][nt] = p.rwkv_kk[l * 256 + jch];
        cst[4][nt] = p.rwkv_rk[l * 256 + jch];
      }
#pragma unroll
      for (int i = 0; i < 4; i++) {
        const int c = lane + 64 * i;
        colv[i] = i < 3 ? i * 256 + h * 64 + lane : (lane < 32 ? 768 + dir * 32 + lane : 832 + dir * 32 + (lane - 32));
        muv[i] = p.rwkv_mu[l * 960 + colv[i]];
        (void)c;
      }
    } else if (MIX == 1) {
#pragma unroll
      for (int i = 0; i < 3; i++) {
        colv[i] = PB + i * 256 + h * 64 + lane;
#pragma unroll
        for (int tp = 0; tp < 7; tp++) cw[i][tp] = p.gdn_conv[((size_t)l * 7 + tp) * 768 + i * 256 + h * 64 + lane];
      }
    } else {
#pragma unroll
      for (int nt = 0; nt < 2; nt++) {
#pragma unroll
        for (int jj = 0; jj < 8; jj++)
          bw2[nt][jj] = fq < 2 ? (short)f2bf(p.gla_gw2[((size_t)(l * 2 + dir) * 16 + fq * 8 + jj) * 128 + h * 32 + nt * 16 + fr]) : (short)0;
        cst[0][nt] = p.gla_gb[(l * 2 + dir) * 128 + h * 32 + nt * 16 + fr];
      }
      colv[0] = PC + h * 32 + lane;
      if (lane >= 32) colv[0] = PC + 128 + h * 32 + (lane - 32);
      colv[1] = PC + 256 + h * 64 + lane;
      colv[2] = PC + 512 + dir * 16 + (lane & 15);
    }
  }
  __syncthreads();

  for (int c = 0; c <= TPB / 32 + 1; c++) {
    if (producer) {
      if (c >= 2) {
        const int cc = c - 2;
        int seg_row0, t_lo;
        if (cc < 8) { seg_row0 = b * TPB; t_lo = dir == 0 ? cc * 32 : (LC - 32 - cc * 32); }
        else { seg_row0 = b * TPB + LC; t_lo = dir == 0 ? (cc - 8) * 32 : (SEQ - 32 - (cc - 8) * 32); }
        const float* yb = sm + S2_YB + (cc & 1) * 512;
        const int t2 = tid - 256;
#pragma unroll
        for (int i = 0; i < 2; i++) {
          const int idx = t2 + i * 256, tt = idx >> 4, e = idx & 15;
          YS[(size_t)(seg_row0 + t_lo + tt) * YST + dir * 768 + MIX * 256 + h * 64 + rq * 16 + e] = f2bf(yb[idx]);
        }
      }
      if (c < TPB / 32) {
        int seg_row0, seg_len, t_lo;
        if (c < 8) { seg_row0 = b * TPB; seg_len = LC; t_lo = dir == 0 ? c * 32 : (LC - 32 - c * 32); }
        else { seg_row0 = b * TPB + LC; seg_len = SEQ; t_lo = dir == 0 ? (c - 8) * 32 : (SEQ - 32 - (c - 8) * 32); }
        const u16* Pseg = P + (size_t)seg_row0 * PST;
        float* B = sm + (c & 1) * S2_BUF;
        const int t0 = t_lo + pw * 8;
        if (MIX == 0) {
          float raw[10][4];
#pragma unroll
          for (int rr = 0; rr < 10; rr++) {
            const int t = t0 - 1 + rr;
            const float okf = (t >= 0 && t < seg_len) ? 1.f : 0.f;
            const int tc = min(max(t, 0), seg_len - 1);
#pragma unroll
            for (int i = 0; i < 4; i++) raw[rr][i] = bf2f(Pseg[(size_t)tc * PST + PA + colv[i]]) * okf;
          }
#pragma unroll
          for (int j = 0; j < 8; j++)
#pragma unroll
            for (int i = 0; i < 4; i++) {
              float xm = raw[j + 1][i] + (0.5f * (raw[j][i] + raw[j + 2][i]) - raw[j + 1][i]) * muv[i];
              if (i == 3 && lane < 32) xm = tanh_fast(xm);
              ST[j * 256 + lane + 64 * i] = xm;
            }
        } else if (MIX == 1) {
          float raw[14][3];
#pragma unroll
          for (int rr = 0; rr < 14; rr++) {
            const int t = t0 - 3 + rr;
            const float okf = (t >= 0 && t < seg_len) ? 1.f : 0.f;
            const int tc = min(max(t, 0), seg_len - 1);
#pragma unroll
            for (int i = 0; i < 3; i++) raw[rr][i] = bf2f(Pseg[(size_t)tc * PST + colv[i]]) * okf;
          }
#pragma unroll
          for (int j = 0; j < 8; j++)
#pragma unroll
            for (int i = 0; i < 3; i++) {
              float a = 0.f;
#pragma unroll
              for (int tp = 0; tp < 7; tp++) a += raw[j + tp][i] * cw[i][tp];
              ST[j * 256 + lane + 64 * i] = siluf(a);
            }
          if (lane < 8) {
            const u16* pp = Pseg + (size_t)(t0 + lane) * PST + PB;
            float bx = bf2f(pp[768 + dir * 4 + h]);
            float ax = bf2f(pp[776 + dir * 4 + h]);
            float ld = -__expf(p.gdn_a_log[(l * 2 + dir) * 4 + h]) * softplusf(ax + p.gdn_dt_bias[(l * 2 + dir) * 4 + h]);
            ST[lane * 256 + 192] = sigm(bx);
            ST[lane * 256 + 193] = __expf(ld);
          }
        } else {
          u16 raw[8][3];
#pragma unroll
          for (int j = 0; j < 8; j++) {
            const u16* pp = Pseg + (size_t)(t0 + j) * PST;
#pragma unroll
            for (int i = 0; i < 3; i++) raw[j][i] = pp[colv[i]];
          }
          const float qs = lane < 32 ? 0.17677669529663687f : 1.f;
#pragma unroll
          for (int j = 0; j < 8; j++) {
            ST[j * 256 + lane] = bf2f(raw[j][0]) * qs;
            ST[j * 256 + 64 + lane] = bf2f(raw[j][1]);
            if (lane < 16) ST[j * 256 + 128 + lane] = bf2f(raw[j][2]);
          }
        }
        wave_lds_sync();
        const bool vl = fq < 2;
        if (MIX == 0) {
          bf16x8 aw, aa;
#pragma unroll
          for (int jj = 0; jj < 8; jj++) {
            aw[jj] = fr < 8 ? (short)f2bf(ST[fr * 256 + 192 + fq * 8 + jj]) : (short)0;
            aa[jj] = fr < 8 ? (short)f2bf(ST[fr * 256 + 224 + fq * 8 + jj]) : (short)0;
          }
          f32x4 accw[4], acca[4];
#pragma unroll
          for (int nt = 0; nt < 4; nt++) {
            accw[nt] = __builtin_amdgcn_mfma_f32_16x16x32_bf16(aw, bw2[nt], f32x4{0.f, 0.f, 0.f, 0.f}, 0, 0, 0);
            acca[nt] = __builtin_amdgcn_mfma_f32_16x16x32_bf16(aa, ba2[nt], f32x4{0.f, 0.f, 0.f, 0.f}, 0, 0, 0);
          }
#pragma unroll
          for (int r = 0; r < 4; r++) {
            const int j = (fq & 1) * 4 + r, tt = pw * 8 + j;
            float kkx[4], av[4], kdv[4], rv[4], dec[4];
            float ss = 0.f;
#pragma unroll
            for (int nt = 0; nt < 4; nt++) {
              const int n = nt * 16 + fr;
              rv[nt] = ST[j * 256 + n];
              const float kx = ST[j * 256 + 64 + n];
              dec[nt] = __expf(-0.6065306597126334f * sigm(cst[0][nt] + accw[nt][r]));
              av[nt] = sigm(cst[1][nt] + acca[nt][r]);
              kdv[nt] = kx * (1.f + (av[nt] - 1.f) * cst[2][nt]);
              kkx[nt] = kx * cst[3][nt];
              ss += kkx[nt] * kkx[nt];
            }
            ss = red16(ss);
            const float rs = rsq(ss + 1e-6f);
            float c1 = 0.f, c2 = 0.f, bc = 0.f;
#pragma unroll
            for (int nt = 0; nt < 4; nt++) {
              const int n = nt * 16 + fr;
              const float kk = kkx[nt] * rs;
              if (vl) {
                B[S2_D + tt * 64 + n] = dec[nt];
                B[S2_U + tt * 64 + n] = kk;
                B[S2_P + tt * 64 + n] = -kk * av[nt];
                B[S2_K + tt * 64 + n] = kdv[nt];
                B[S2_DQ + tt * 64 + n] = dec[nt] * rv[nt];
              }
              c1 += -kk * av[nt] * rv[nt];
              c2 += kdv[nt] * rv[nt];
              bc += rv[nt] * kdv[nt] * cst[4][nt];
            }
            c1 = red16(c1); c2 = red16(c2); bc = red16(bc);
            if (vl && fr == 0) {
              B[S2_C1 + tt] = c1;
              B[S2_C2 + tt] = c2;
              if (rq == 0) BC[(size_t)(seg_row0 + t_lo + tt) * 8 + h * 2 + dir] = bc;
            }
          }
        } else if (MIX == 1) {
#pragma unroll
          for (int r = 0; r < 4; r++) {
            const int j = (fq & 1) * 4 + r, tt = pw * 8 + j;
            float qv[4], kv[4];
            float sq = 0.f, sk = 0.f;
#pragma unroll
            for (int nt = 0; nt < 4; nt++) {
              const int n = nt * 16 + fr;
              qv[nt] = ST[j * 256 + n];
              kv[nt] = ST[j * 256 + 64 + n];
              sq += qv[nt] * qv[nt];
              sk += kv[nt] * kv[nt];
            }
            sq = red16(sq); sk = red16(sk);
            const float rq_ = rsq(sq + 1e-6f) * 0.125f, rk_ = rsq(sk + 1e-6f);
            const float beta = ST[j * 256 + 192], alpha = ST[j * 256 + 193];
            float dkq = 0.f;
#pragma unroll
            for (int nt = 0; nt < 4; nt++) {
              const int n = nt * 16 + fr;
              const float qn = qv[nt] * rq_, kn = kv[nt] * rk_;
              if (vl) {
                B[S2_D + tt * 64 + n] = alpha;
                B[S2_U + tt * 64 + n] = kn;
                B[S2_P + tt * 64 + n] = -alpha * beta * kn;
                B[S2_K + tt * 64 + n] = beta * kn;
                B[S2_DQ + tt * 64 + n] = alpha * qn;
              }
              dkq += kn * qn;
            }
            dkq = red16(dkq);
            if (vl && fr == 0) {
              B[S2_C1 + tt] = -alpha * beta * dkq;
              B[S2_C2 + tt] = beta * dkq;
            }
          }
        } else {
          bf16x8 ag;
#pragma unroll
          for (int jj = 0; jj < 8; jj++) ag[jj] = (fr < 8 && fq < 2) ? (short)f2bf(ST[fr * 256 + 128 + fq * 8 + jj]) : (short)0;
          f32x4 accg[2];
#pragma unroll
          for (int nt = 0; nt < 2; nt++) accg[nt] = __builtin_amdgcn_mfma_f32_16x16x32_bf16(ag, bw2[nt], f32x4{0.f, 0.f, 0.f, 0.f}, 0, 0, 0);
#pragma unroll
          for (int r = 0; r < 4; r++) {
            const int j = (fq & 1) * 4 + r, tt = pw * 8 + j;
            float dkq = 0.f;
#pragma unroll
            for (int nt = 0; nt < 2; nt++) {
              const int n = nt * 16 + fr;
              const float lg = cst[0][nt] + accg[nt][r];
              const float ls = fminf(lg, 0.f) - __logf(1.f + __expf(-fabsf(lg)));
              const float alpha = __expf(ls * (1.f / 16.f));
              const float qv = ST[j * 256 + n], kv = ST[j * 256 + 32 + n];
              if (vl) {
                B[S2_D + tt * 64 + n] = alpha;
                B[S2_K + tt * 64 + n] = kv;
                B[S2_DQ + tt * 64 + n] = alpha * qv;
              }
              dkq += kv * qv;
            }
            dkq = red16(dkq);
            if (vl && fr == 0) B[S2_C2 + tt] = dkq;
          }
        }
#pragma unroll
        for (int i = 0; i < 2; i++) {
          const int idx = lane + 64 * i, j = idx >> 4, e = idx & 15;
          B[S2_V + (pw * 8 + j) * 16 + e] = ST[j * 256 + VOFF + rq * 16 + e];
        }
      }
    } else if (c >= 1 && c <= TPB / 32) {
      const float* B = sm + ((c - 1) & 1) * S2_BUF;
      float* yb = sm + S2_YB + ((c - 1) & 1) * 512;
      const int rl = w * 4 + fq;
      const int dtt = dir ? -1 : 1;
      int tt = dir ? 31 : 0;
      float dv[EPL], kv[EPL], qv[EPL], uv[EPL], pv[EPL], vv, c1v, c2v;
      float dn[EPL], kn[EPL], qn[EPL], un[EPL], pn[EPL], vn, c1n, c2n;
#define S2_LOAD(D_, K_, Q_, U_, P_, V_, C1_, C2_, T_)                                   \
  do {                                                                                  \
    const int o_ = (T_) * 64 + fr * EPL;                                                \
    if (EPL == 4) {                                                                     \
      float4 t4 = *(const float4*)(B + S2_D + o_);                                      \
      D_[0] = t4.x; D_[1] = t4.y; D_[2] = t4.z; D_[3] = t4.w;                           \
      t4 = *(const float4*)(B + S2_K + o_);                                             \
      K_[0] = t4.x; K_[1] = t4.y; K_[2] = t4.z; K_[3] = t4.w;                           \
      t4 = *(const float4*)(B + S2_DQ + o_);                                            \
      Q_[0] = t4.x; Q_[1] = t4.y; Q_[2] = t4.z; Q_[3] = t4.w;                           \
      t4 = *(const float4*)(B + S2_U + o_);                                             \
      U_[0] = t4.x; U_[1] = t4.y; U_[2] = t4.z; U_[3] = t4.w;                           \
      t4 = *(const float4*)(B + S2_P + o_);                                             \
      P_[0] = t4.x; P_[1] = t4.y; P_[2] = t4.z; P_[3] = t4.w;                           \
      C1_ = B[S2_C1 + (T_)];                                                            \
    } else {                                                                            \
      float2 t2 = *(const float2*)(B + S2_D + o_);                                      \
      D_[0] = t2.x; D_[1] = t2.y;                                                       \
      t2 = *(const float2*)(B + S2_K + o_);                                             \
      K_[0] = t2.x; K_[1] = t2.y;                                                       \
      t2 = *(const float2*)(B + S2_DQ + o_);                                            \
      Q_[0] = t2.x; Q_[1] = t2.y;                                                       \
      U_[0] = U_[1] = P_[0] = P_[1] = 0.f; C1_ = 0.f;                                   \
    }                                                                                   \
    V_ = B[S2_V + (T_) * 16 + rl];                                                      \
    C2_ = B[S2_C2 + (T_)];                                                              \
  } while (0)
#define S2_STEP(D_, K_, Q_, U_, P_, V_, C1_, C2_, T_)                                   \
  do {                                                                                  \
    float sq = 0.f, sa = 0.f;                                                           \
    _Pragma("unroll") for (int i = 0; i < EPL; i++) sq += s[i] * Q_[i];                 \
    if (MIX != 2) {                                                                     \
      _Pragma("unroll") for (int i = 0; i < EPL; i++) sa += s[i] * U_[i];               \
      sa = red16(sa);                                                                   \
    }                                                                                   \
    sq = red16(sq);                                                                     \
    float y = sq + V_ * C2_;                                                            \
    if (MIX != 2) y += sa * C1_;                                                        \
    _Pragma("unroll") for (int i = 0; i < EPL; i++) {                                   \
      float t = s[i] * D_[i] + V_ * K_[i];                                              \
      if (MIX != 2) t += sa * P_[i];                                                    \
      s[i] = t;                                                                         \
    }                                                                                   \
    yb[(T_) * 16 + rl] = y;                                                             \
  } while (0)
      S2_LOAD(dv, kv, qv, uv, pv, vv, c1v, c2v, tt);
#pragma unroll 1
      for (int st = 0; st < 32; st += 2) {
        const int t1 = tt + dtt;
        S2_LOAD(dn, kn, qn, un, pn, vn, c1n, c2n, t1);
        S2_STEP(dv, kv, qv, uv, pv, vv, c1v, c2v, tt);
        const int t2 = st + 2 < 32 ? t1 + dtt : t1;
        S2_LOAD(dv, kv, qv, uv, pv, vv, c1v, c2v, t2);
        S2_STEP(dn, kn, qn, un, pn, vn, c1n, c2n, t1);
        tt = t2;
      }
#undef S2_LOAD
#undef S2_STEP
    }
    __syncthreads();
  }
}

#define S3_SUB 12800
#define S3_GM 0
#define S3_KVT 9216
#define S3_QB 10240
#define S3_QV 11392
#define S3_VT 11520
#define S3_WC 12544
#define S3_STB (8 * S3_SUB)
#define S3_END (S3_STB + 4 * 2304)

__device__ __forceinline__ float rlane(float x, int l) { return __int_as_float(__builtin_amdgcn_readlane(__float_as_int(x), l)); }
__device__ __forceinline__ float wave_sum(float x) {
  x = red16(x);
  return (rlane(x, 0) + rlane(x, 16)) + (rlane(x, 32) + rlane(x, 48));
}
__device__ __forceinline__ float clampe(float x) { return fminf(fmaxf(x, -80.f), 80.f); }
__device__ __forceinline__ uint4 pack8(const float (&v)[8]) {
  return make_uint4(pack2(v[0], v[1]), pack2(v[2], v[3]), pack2(v[4], v[5]), pack2(v[6], v[7]));
}
__device__ __forceinline__ bf16x8 ld_frag(const void* p) { return *(const bf16x8*)p; }
__device__ __forceinline__ bf16x8 zfrag() { return bf16x8{0, 0, 0, 0, 0, 0, 0, 0}; }

__device__ __forceinline__ void chunk_geom(int c, int dir, int b, int& seg_row0, int& seg_len, int& t_lo) {
  if (c < 8) { seg_row0 = b * TPB; seg_len = LC; t_lo = dir == 0 ? c * 32 : (LC - 32 - c * 32); }
  else { seg_row0 = b * TPB + LC; seg_len = SEQ; t_lo = dir == 0 ? (c - 8) * 32 : (SEQ - 32 - (c - 8) * 32); }
}
template <int MIX>
__device__ __forceinline__ void fetch_raw(const u16* P, int c, int dir, int b, int h, int pw, int lane, const int (&colv)[4], unsigned (&rawq)[14][2]) {
  int seg_row0, seg_len, t_lo;
  chunk_geom(c, dir, b, seg_row0, seg_len, t_lo);
  const u16* Pseg = P + (size_t)seg_row0 * PST;
  const int t0 = t_lo + pw * 8;
  if (MIX == 0) {
#pragma unroll
    for (int rr = 0; rr < 10; rr++) {
      const int tc = min(max(t0 - 1 + rr, 0), seg_len - 1);
#pragma unroll
      for (int i = 0; i < 2; i++)
        rawq[rr][i] = (unsigned)Pseg[(size_t)tc * PST + PA + colv[2 * i]] | ((unsigned)Pseg[(size_t)tc * PST + PA + colv[2 * i + 1]] << 16);
    }
  } else if (MIX == 1) {
#pragma unroll
    for (int rr = 0; rr < 14; rr++) {
      const int tc = min(max(t0 - 3 + rr, 0), seg_len - 1);
      rawq[rr][0] = (unsigned)Pseg[(size_t)tc * PST + colv[0]] | ((unsigned)Pseg[(size_t)tc * PST + colv[1]] << 16);
      rawq[rr][1] = (rawq[rr][1] & 0xffff0000u) | (unsigned)Pseg[(size_t)tc * PST + colv[2]];
    }
    const u16* pp = Pseg + (size_t)(t0 + (lane & 7)) * PST + PB;
    rawq[0][1] = (rawq[0][1] & 0xffffu) | ((unsigned)pp[768 + dir * 4 + h] << 16);
    rawq[1][1] = (rawq[1][1] & 0xffffu) | ((unsigned)pp[776 + dir * 4 + h] << 16);
  } else {
#pragma unroll
    for (int j = 0; j < 8; j++) {
      const u16* pp = Pseg + (size_t)(t0 + j) * PST;
      rawq[j][0] = (unsigned)pp[colv[0]] | ((unsigned)pp[colv[1]] << 16);
      rawq[j][1] = (unsigned)pp[colv[2]];
    }
  }
}

template <int MIX>
__device__ __forceinline__ void scan3_item(const Params& p, int l, int b, int h, int dir, unsigned char* smb) {
  constexpr int VOFF = (MIX == 2) ? 64 : 128;
  constexpr bool DELTA = (MIX != 2);
  const int tid = TIDX, lane = tid & 63, w = tid >> 6, fr = lane & 15, fq = lane >> 4;
  const bool producer = true;
  const int pw = w & 3, half = w >> 2;
  const u16* P = (const u16*)(p.ws + OFF_BIG);
  u16* YS = (u16*)(p.ws + OFF_YS);
  float* BC = (float*)(p.ws + OFF_BC);
  float* ST = (float*)(smb + w * S3_SUB + S3_GM);
  unsigned char* STBY = smb + w * S3_SUB + S3_GM;
  const f32x4 z4 = f32x4{0.f, 0.f, 0.f, 0.f};
  f32x4 st[4];
#pragma unroll
  for (int i = 0; i < 4; i++) st[i] = z4;

  bf16x8 bw2[4], ba2[4];
  float cw[3][7];
  float muv[4];
  int colv[4];
  float c_w0 = 0.f, c_a0 = 0.f, c_ka = 0.f, c_kk = 0.f, c_rk = 0.f, c_gb = 0.f;
#pragma unroll
  for (int i = 0; i < 4; i++) { bw2[i] = zfrag(); ba2[i] = zfrag(); muv[i] = 0.f; colv[i] = 0; }
  if (producer) {
    if (MIX == 0) {
      {
        float tw[4][8], ta[4][8];
#pragma unroll
        for (int nt = 0; nt < 4; nt++)
#pragma unroll
          for (int jj = 0; jj < 8; jj++) {
            tw[nt][jj] = p.rwkv_w2[((size_t)(l * 2 + dir) * 32 + fq * 8 + jj) * 256 + h * 64 + nt * 16 + fr];
            ta[nt][jj] = p.rwkv_a2[((size_t)(l * 2 + dir) * 32 + fq * 8 + jj) * 256 + h * 64 + nt * 16 + fr];
          }
#pragma unroll
        for (int nt = 0; nt < 4; nt++)
#pragma unroll
          for (int jj = 0; jj < 8; jj++) { bw2[nt][jj] = (short)f2bf(tw[nt][jj]); ba2[nt][jj] = (short)f2bf(ta[nt][jj]); }
      }
      const int jl = h * 64 + lane;
      c_w0 = p.rwkv_w0[(l * 2 + dir) * 256 + jl];
      c_a0 = p.rwkv_a0[(l * 2 + dir) * 256 + jl];
      c_ka = p.rwkv_ka[l * 256 + jl];
      c_kk = p.rwkv_kk[l * 256 + jl];
      c_rk = p.rwkv_rk[l * 256 + jl];
#pragma unroll
      for (int i = 0; i < 4; i++) {
        colv[i] = i < 3 ? i * 256 + h * 64 + lane : (lane < 32 ? 768 + dir * 32 + lane : 832 + dir * 32 + (lane - 32));
        muv[i] = p.rwkv_mu[l * 960 + colv[i]];
      }
    } else if (MIX == 1) {
#pragma unroll
      for (int i = 0; i < 3; i++) {
        colv[i] = PB + i * 256 + h * 64 + lane;
#pragma unroll
        for (int tp = 0; tp < 7; tp++) cw[i][tp] = p.gdn_conv[((size_t)l * 7 + tp) * 768 + i * 256 + h * 64 + lane];
      }
    } else {
      {
        float tg[2][8];
#pragma unroll
        for (int nt = 0; nt < 2; nt++)
#pragma unroll
          for (int jj = 0; jj < 8; jj++) tg[nt][jj] = p.gla_gw2[((size_t)(l * 2 + dir) * 16 + (fq & 1) * 8 + jj) * 128 + h * 32 + nt * 16 + fr];
#pragma unroll
        for (int nt = 0; nt < 2; nt++)
#pragma unroll
          for (int jj = 0; jj < 8; jj++) bw2[nt][jj] = fq < 2 ? (short)f2bf(tg[nt][jj]) : (short)0;
      }
      c_gb = p.gla_gb[(l * 2 + dir) * 128 + h * 32 + (lane & 31)];
      colv[0] = PC + h * 32 + lane;
      if (lane >= 32) colv[0] = PC + 128 + h * 32 + (lane - 32);
      colv[1] = PC + 256 + h * 64 + lane;
      colv[2] = PC + 512 + dir * 16 + (lane & 15);
    }
  }
  __syncthreads();
  unsigned rawq[14][2];
#pragma unroll
  for (int i = 0; i < 14; i++) { rawq[i][0] = 0u; rawq[i][1] = 0u; }
  fetch_raw<MIX>(P, half, dir, b, h, pw, lane, colv, rawq);
#define RAWP(r_, i_) ((u16)((rawq[r_][(i_) >> 1] >> (((i_) & 1) * 16)) & 0xffffu))

  for (int it = 0; it < TPB / 64; it++) {
    {
      {
        const int c = it * 2 + half;
        int seg_row0, seg_len, t_lo;
        chunk_geom(c, dir, b, seg_row0, seg_len, t_lo);
        unsigned char* SB = smb + w * S3_SUB;
        const int t0 = t_lo + pw * 8;
        if (MIX == 0) {
          float raw[10][4];
#pragma unroll
          for (int rr = 0; rr < 10; rr++) {
            const int t = t0 - 1 + rr;
            const float okf = (t >= 0 && t < seg_len) ? 1.f : 0.f;
#pragma unroll
            for (int i = 0; i < 4; i++) raw[rr][i] = bf2f(RAWP(rr, i)) * okf;
          }
#pragma unroll
          for (int j = 0; j < 8; j++)
#pragma unroll
            for (int i = 0; i < 4; i++) {
              float xm = raw[j + 1][i] + (0.5f * (raw[j][i] + raw[j + 2][i]) - raw[j + 1][i]) * muv[i];
              if (i == 3 && lane < 32) xm = tanh_fast(xm);
              ST[j * 256 + lane + 64 * i] = xm;
            }
        } else if (MIX == 1) {
          float raw[14][3];
#pragma unroll
          for (int rr = 0; rr < 14; rr++) {
            const int t = t0 - 3 + rr;
            const float okf = (t >= 0 && t < seg_len) ? 1.f : 0.f;
#pragma unroll
            for (int i = 0; i < 3; i++) raw[rr][i] = bf2f(RAWP(rr, i)) * okf;
          }
#pragma unroll
          for (int j = 0; j < 8; j++)
#pragma unroll
            for (int i = 0; i < 3; i++) {
              float a = 0.f;
#pragma unroll
              for (int tp = 0; tp < 7; tp++) a += raw[j + tp][i] * cw[i][tp];
              ST[j * 256 + lane + 64 * i] = siluf(a);
            }
          if (lane < 8) {
            float bx = bf2f(RAWP(0, 3));
            float ax = bf2f(RAWP(1, 3));
            float ld = -__expf(p.gdn_a_log[(l * 2 + dir) * 4 + h]) * softplusf(ax + p.gdn_dt_bias[(l * 2 + dir) * 4 + h]);
            ST[lane * 256 + 192] = sigm(bx);
            ST[lane * 256 + 193] = ld;
          }
        } else {
          const float qs = lane < 32 ? 0.17677669529663687f : 1.f;
#pragma unroll
          for (int j = 0; j < 8; j++) {
            ST[j * 256 + lane] = bf2f(RAWP(j, 0)) * qs;
            ST[j * 256 + 64 + lane] = bf2f(RAWP(j, 1));
            if (lane < 16) ST[j * 256 + 128 + lane] = bf2f(RAWP(j, 2));
          }
        }
        wave_lds_sync();
        {
          float vv[8];
#pragma unroll
          for (int i = 0; i < 8; i++) vv[i] = ST[(dir ? 7 - i : i) * 256 + VOFF + lane];
          *(uint4*)(SB + S3_VT + lane * 16) = pack8(vv);
        }
        if (MIX == 0) {
          bf16x8 aw, aa;
#pragma unroll
          for (int jj = 0; jj < 8; jj++) {
            aw[jj] = fr < 8 ? (short)f2bf(ST[fr * 256 + 192 + fq * 8 + jj]) : (short)0;
            aa[jj] = fr < 8 ? (short)f2bf(ST[fr * 256 + 224 + fq * 8 + jj]) : (short)0;
          }
          f32x4 accw[4], acca[4];
#pragma unroll
          for (int nt = 0; nt < 4; nt++) {
            accw[nt] = __builtin_amdgcn_mfma_f32_16x16x32_bf16(aw, bw2[nt], z4, 0, 0, 0);
            acca[nt] = __builtin_amdgcn_mfma_f32_16x16x32_bf16(aa, ba2[nt], z4, 0, 0, 0);
          }
          wave_lds_sync();
          if (fq < 2) {
#pragma unroll
            for (int nt = 0; nt < 4; nt++)
#pragma unroll
              for (int r = 0; r < 4; r++) {
                ST[(fq * 4 + r) * 256 + 128 + nt * 16 + fr] = accw[nt][r];
                ST[(fq * 4 + r) * 256 + 192 + nt * 16 + fr] = acca[nt][r];
              }
          }
          wave_lds_sync();
        } else if (MIX == 2) {
          bf16x8 ag;
#pragma unroll
          for (int jj = 0; jj < 8; jj++) ag[jj] = (fr < 8 && fq < 2) ? (short)f2bf(ST[fr * 256 + 128 + fq * 8 + jj]) : (short)0;
          f32x4 accg[2];
#pragma unroll
          for (int nt = 0; nt < 2; nt++) accg[nt] = __builtin_amdgcn_mfma_f32_16x16x32_bf16(ag, bw2[nt], z4, 0, 0, 0);
          if (fq < 2) {
#pragma unroll
            for (int nt = 0; nt < 2; nt++)
#pragma unroll
              for (int r = 0; r < 4; r++) ST[(fq * 4 + r) * 256 + 192 + nt * 16 + fr] = accg[nt][r];
          }
          wave_lds_sync();
        }
        float logd[8], kap[8], bb[8], kp[8], qq[8];
        if (MIX == 0) {
          float a8[8], p1[8], p2[8];
#pragma unroll
          for (int i = 0; i < 8; i++) {
            const float* row = ST + (dir ? 7 - i : i) * 256;
            const float r_ = row[lane], k_ = row[64 + lane];
            const float sg = sigm(c_w0 + row[128 + lane]);
            a8[i] = sigm(c_a0 + row[192 + lane]);
            kp[i] = k_ * (1.f + (a8[i] - 1.f) * c_ka);
            kap[i] = k_ * c_kk;
            qq[i] = r_;
            logd[i] = -0.6065306597126334f * sg;
            p1[i] = kap[i] * kap[i];
            p2[i] = r_ * kp[i] * c_rk;
          }
#pragma unroll
          for (int i = 0; i < 8; i++) { p1[i] = red16(p1[i]); p2[i] = red16(p2[i]); }
#pragma unroll
          for (int i = 0; i < 8; i++) {
            const float ss = (rlane(p1[i], 0) + rlane(p1[i], 16)) + (rlane(p1[i], 32) + rlane(p1[i], 48));
            const float bc = (rlane(p2[i], 0) + rlane(p2[i], 16)) + (rlane(p2[i], 32) + rlane(p2[i], 48));
            kap[i] *= rsq(ss + 1e-6f);
            bb[i] = kap[i] * a8[i];
            if (lane == 0) BC[(size_t)(seg_row0 + t0 + (dir ? 7 - i : i)) * 8 + h * 2 + dir] = bc;
          }
        } else {
#pragma unroll
        for (int i = 0; i < 8; i++) {
          const int j = dir ? 7 - i : i;
          const float* row = ST + j * 256;
          if (MIX == 1) {
            const float q_ = row[lane], k_ = row[64 + lane];
            const float sq = wave_sum(q_ * q_), sk = wave_sum(k_ * k_);
            const float qn = q_ * rsq(sq + 1e-6f) * 0.125f, kn = k_ * rsq(sk + 1e-6f);
            const float beta = row[192], ld = row[193];
            const float alpha = __expf(ld);
            logd[i] = ld;
            kap[i] = kn; bb[i] = alpha * beta * kn; kp[i] = beta * kn; qq[i] = qn;
          } else {
            const int n = lane & 31;
            const float lg = c_gb + row[192 + n];
            const float ls = fminf(lg, 0.f) - __logf(1.f + __expf(-fabsf(lg)));
            logd[i] = ls * (1.f / 16.f);
            kap[i] = 0.f; bb[i] = 0.f;
            kp[i] = lane < 32 ? row[32 + n] : 0.f;
            qq[i] = lane < 32 ? row[n] : 0.f;
          }
        }
        }
        wave_lds_sync();
        float kt[8], qt[8], bck[8], kck[8];
        {
          float L[8];
          float run = 0.f;
#pragma unroll
          for (int i = 0; i < 8; i++) { run += logd[i]; L[i] = run; }
          const float Lr = L[3], L7 = L[7];
          float prevE = __expf(clampe(-Lr)), prevT = 1.f;
          u16* OPA = (u16*)STBY;
#pragma unroll
          for (int i = 0; i < 8; i++) {
            const float eI = __expf(clampe(L[i] - Lr)), eInv = __expf(clampe(Lr - L[i]));
            const float tI = __expf(L[i]), eEnd = __expf(L7 - L[i]);
            if (DELTA) {
              OPA[0 * 576 + i * 72 + lane] = f2bf(kap[i] * prevE);
              OPA[1 * 576 + i * 72 + lane] = f2bf(bb[i] * eInv);
            }
            OPA[2 * 576 + i * 72 + lane] = f2bf(kp[i] * eInv);
            OPA[3 * 576 + i * 72 + lane] = f2bf(qq[i] * eI);
            kt[i] = kap[i] * prevT; qt[i] = qq[i] * tI;
            bck[i] = bb[i] * eEnd; kck[i] = kp[i] * eEnd;
            prevE = eI; prevT = tI;
          }
          *(float*)(SB + S3_WC + lane * 4) = __expf(L7);
        }
        wave_lds_sync();
        f32x4 accA = z4, accBm = z4, accQb = z4, accQk = z4;
        {
          const u16* OPA = (const u16*)STBY;
          const int ro = (fr & 7) * 72 + fq * 8;
#pragma unroll
          for (int ks = 0; ks < 2; ks++) {
            const bf16x8 fk = ld_frag(OPA + 2 * 576 + ro + ks * 32), fqh = ld_frag(OPA + 3 * 576 + ro + ks * 32);
            accQk = __builtin_amdgcn_mfma_f32_16x16x32_bf16(fqh, fk, accQk, 0, 0, 0);
            if (DELTA) {
              const bf16x8 fka = ld_frag(OPA + 0 * 576 + ro + ks * 32), fb = ld_frag(OPA + 1 * 576 + ro + ks * 32);
              accA = __builtin_amdgcn_mfma_f32_16x16x32_bf16(fka, fb, accA, 0, 0, 0);
              accBm = __builtin_amdgcn_mfma_f32_16x16x32_bf16(fka, fk, accBm, 0, 0, 0);
              accQb = __builtin_amdgcn_mfma_f32_16x16x32_bf16(fqh, fb, accQb, 0, 0, 0);
            }
          }
#pragma unroll
          for (int r = 0; r < 4; r++) {
            const int i = fq * 4 + r;
            const bool ok = fq < 2 && fr < 8;
            if (!(ok && fr < i)) { accA[r] = 0.f; accBm[r] = 0.f; }
            if (!(ok && fr <= i)) { accQb[r] = 0.f; accQk[r] = 0.f; }
          }
        }
        float bmc[8], qkc[8];
#pragma unroll
        for (int m = 0; m < 4; m++) {
          bmc[m] = accBm[m]; qkc[m] = accQk[m];
          bmc[m + 4] = __shfl(accBm[m], (lane & 15) + 16);
          qkc[m + 4] = __shfl(accQk[m], (lane & 15) + 16);
        }
        float kbar[8], qbar[8], Kv[8], TB[8], Qv[8];
        if (DELTA) {
          float t[8];
#pragma unroll
          for (int i = 0; i < 8; i++) {
            float ti = (lane == i) ? 1.f : 0.f;
#pragma unroll
            for (int m = 0; m < i; m++) ti -= rlane(accA[i & 3], (i >> 2) * 16 + m) * t[m];
            t[i] = ti;
          }
#pragma unroll
          for (int i = 0; i < 8; i++) {
            float tb = 0.f, kb = 0.f;
#pragma unroll
            for (int m = 0; m <= i; m++) {
              const float tim = rlane(t[i], m);
              tb += tim * bmc[m];
              kb += tim * kt[m];
            }
            TB[i] = tb; kbar[i] = kb;
            float qv = qkc[i], qb = qt[i];
#pragma unroll
            for (int m = 0; m <= i; m++) {
              const float qbim = rlane(accQb[i & 3], (i >> 2) * 16 + m);
              qv -= qbim * TB[m];
              qb -= qbim * kbar[m];
            }
            Qv[i] = qv; qbar[i] = qb;
          }
#pragma unroll
          for (int j = 0; j < 8; j++) Kv[j] = kck[j];
#pragma unroll
          for (int i = 1; i < 8; i++)
#pragma unroll
            for (int j = 0; j < i; j++) Kv[j] -= rlane(TB[i], j) * bck[i];
        } else {
#pragma unroll
          for (int i = 0; i < 8; i++) { Qv[i] = qkc[i]; qbar[i] = qt[i]; Kv[i] = kck[i]; kbar[i] = 0.f; TB[i] = 0.f; }
        }
        *(uint4*)(SB + S3_KVT + lane * 16) = pack8(Kv);
#pragma unroll
        for (int i = 0; i < 8; i++) ((u16*)(SB + S3_QB))[i * 72 + lane] = f2bf(qbar[i]);
        if (lane < 8) {
#pragma unroll
          for (int i = 0; i < 8; i++) ((u16*)(SB + S3_QV))[i * 8 + lane] = f2bf(Qv[i]);
        }
        if (DELTA) {
          float nk[8];
#pragma unroll
          for (int i = 0; i < 8; i++) nk[i] = -kbar[i];
          *(uint4*)(STBY + 4608 + lane * 16) = pack8(bck);
          *(uint4*)(STBY + 5632 + lane * 16) = pack8(nk);
          wave_lds_sync();
          bf16x8 fa[4], fb[4];
#pragma unroll
          for (int x = 0; x < 4; x++) {
            fa[x] = fq == 0 ? ld_frag(STBY + 5632 + (x * 16 + fr) * 16) : zfrag();
            fb[x] = fq == 0 ? ld_frag(STBY + 4608 + (x * 16 + fr) * 16) : zfrag();
          }
#pragma unroll
          for (int nt = 0; nt < 4; nt++)
#pragma unroll
            for (int mt = 0; mt < 4; mt++) {
              const f32x4 g = __builtin_amdgcn_mfma_f32_16x16x32_bf16(fa[mt], fb[nt], z4, 0, 0, 0);
              uint2 gv;
              gv.x = pack2(g[0], g[1]); gv.y = pack2(g[2], g[3]);
              *(uint2*)(SB + S3_GM + ((nt * 16 + fr) * 72 + mt * 16 + fq * 4) * 2) = gv;
            }
        }
      }
    }
    fetch_raw<MIX>(P, min(it + 1, TPB / 64 - 1) * 2 + half, dir, b, h, pw, lane, colv, rawq);
    __syncthreads();
    if (w < 4) {
      unsigned char* STB = smb + S3_STB + w * 2304;
#pragma unroll 2
      for (int kk = 0; kk < 8; kk++) {
        const int cc = it * 2 + (kk >> 2), k = kk & 3;
        int seg_row0, t_lo;
        if (cc < 8) { seg_row0 = b * TPB; t_lo = dir == 0 ? cc * 32 : (LC - 32 - cc * 32); }
        else { seg_row0 = b * TPB + LC; t_lo = dir == 0 ? (cc - 8) * 32 : (SEQ - 32 - (cc - 8) * 32); }
        const int sc = dir ? 3 - k : k;
        const unsigned char* SB = smb + ((kk >> 2) * 4 + sc) * S3_SUB;
#pragma unroll
        for (int nt = 0; nt < 4; nt++) {
          uint2 sv;
          sv.x = pack2(st[nt][0], st[nt][1]); sv.y = pack2(st[nt][2], st[nt][3]);
          *(uint2*)(STB + (fr * 72 + nt * 16 + fq * 4) * 2) = sv;
        }
        wave_lds_sync();
        const bf16x8 bs0 = ld_frag(STB + (fr * 72 + fq * 8) * 2), bs1 = ld_frag(STB + (fr * 72 + 32 + fq * 8) * 2);
        const bf16x8 bv = fq == 0 ? ld_frag(SB + S3_VT + (w * 16 + fr) * 16) : zfrag();
        const bf16x8 aq0 = ld_frag(SB + S3_QB + ((fr & 7) * 72 + fq * 8) * 2), aq1 = ld_frag(SB + S3_QB + ((fr & 7) * 72 + 32 + fq * 8) * 2);
        const bf16x8 aqv = fq == 0 ? ld_frag(SB + S3_QV + (fr & 7) * 16) : zfrag();
        f32x4 accY = __builtin_amdgcn_mfma_f32_16x16x32_bf16(aq0, bs0, z4, 0, 0, 0);
        accY = __builtin_amdgcn_mfma_f32_16x16x32_bf16(aq1, bs1, accY, 0, 0, 0);
        accY = __builtin_amdgcn_mfma_f32_16x16x32_bf16(aqv, bv, accY, 0, 0, 0);
        if (fq < 2) {
#pragma unroll
          for (int r = 0; r < 4; r++) {
            const int i = fq * 4 + r, j = dir ? 7 - i : i;
            YS[(size_t)(seg_row0 + t_lo + sc * 8 + j) * YST + dir * 768 + MIX * 256 + h * 64 + w * 16 + fr] = f2bf(accY[r]);
          }
        }
#pragma unroll
        for (int nt = 0; nt < 4; nt++) {
          f32x4 an = z4;
          if (DELTA) {
            const bf16x8 g0 = ld_frag(SB + S3_GM + ((nt * 16 + fr) * 72 + fq * 8) * 2), g1 = ld_frag(SB + S3_GM + ((nt * 16 + fr) * 72 + 32 + fq * 8) * 2);
            an = __builtin_amdgcn_mfma_f32_16x16x32_bf16(g0, bs0, an, 0, 0, 0);
            an = __builtin_amdgcn_mfma_f32_16x16x32_bf16(g1, bs1, an, 0, 0, 0);
          }
          const bf16x8 akv = fq == 0 ? ld_frag(SB + S3_KVT + (nt * 16 + fr) * 16) : zfrag();
          an = __builtin_amdgcn_mfma_f32_16x16x32_bf16(akv, bv, an, 0, 0, 0);
          const float4 wc = *(const float4*)(SB + S3_WC + (nt * 16 + fq * 4) * 4);
          st[nt][0] = st[nt][0] * wc.x + an[0];
          st[nt][1] = st[nt][1] * wc.y + an[1];
          st[nt][2] = st[nt][2] * wc.z + an[2];
          st[nt][3] = st[nt][3] * wc.w + an[3];
        }
      }
    }
    __syncthreads();
  }
}

__device__ __forceinline__ void attn_item(const Params& p, int l, int b, int qb, int hk, bool isctx, unsigned char* smem) {
  u16* KS = (u16*)smem;
  u16* VT = KS + 64 * LDT;
  u16* PL = VT + 64 * LDT;
  float2* ROPE = (float2*)(PL + 8 * 32 * LDT);
  const int tid = TIDX, lane = tid & 63, w = tid >> 6, fr = lane & 15, fq = lane >> 4;
  const u16* P = (const u16*)(p.ws + OFF_BIG);
  u16* Y = (u16*)(p.ws + OFF_YS);
  const int qh = hk * 2 + (w >> 2);
  const int tb = qb * 128 + (w & 3) * 32;
  const int qrow0 = b * TPB + (isctx ? 0 : LC);
  __syncthreads();
  for (int i = tid; i < 1024; i += NTHR) {
    int pos = i >> 4, fi = i & 15;
    float inv = powf(10000.f, -(float)fi / 16.f);
    float sn, cs;
    sincosf((float)pos * inv, &sn, &cs);
    ROPE[i] = make_float2(cs, sn);
  }
  __syncthreads();
  bf16x8 qf[2][2];
#pragma unroll
  for (int mi = 0; mi < 2; mi++)
#pragma unroll
    for (int ks = 0; ks < 2; ks++) {
      const int tq = tb + mi * 16 + fr;
      const u16* qp = P + (size_t)(qrow0 + tq) * PST + PD + qh * 64 + ks * 32;
      uint4 own = *(const uint4*)(qp + fq * 8);
      uint4 par = *(const uint4*)(qp + (fq ^ 2) * 8);
      const unsigned ow[4] = {own.x, own.y, own.z, own.w};
      const unsigned pw[4] = {par.x, par.y, par.z, par.w};
      const int pos = ks == 0 ? (tq >> 6) : (tq & 63);
      bf16x8 f;
#pragma unroll
      for (int jj = 0; jj < 8; jj++) {
        float xo = bf2f((u16)((ow[jj >> 1] >> ((jj & 1) * 16)) & 0xffff));
        float xp = bf2f((u16)((pw[jj >> 1] >> ((jj & 1) * 16)) & 0xffff));
        float v = xo;
        if (!isctx) {
          float2 cs = ROPE[pos * 16 + (fq & 1) * 8 + jj];
          v = fq < 2 ? xo * cs.x - xp * cs.y : xp * cs.y + xo * cs.x;
        }
        f[jj] = (short)f2bf(v * 0.125f);
      }
      qf[mi][ks] = f;
    }
  f32x4 oacc[2][4];
#pragma unroll
  for (int mi = 0; mi < 2; mi++)
#pragma unroll
    for (int nd = 0; nd < 4; nd++) oacc[mi][nd] = f32x4{0.f, 0.f, 0.f, 0.f};
  float mrow[2][4], lrow[2][4];
#pragma unroll
  for (int mi = 0; mi < 2; mi++)
#pragma unroll
    for (int r = 0; r < 4; r++) { mrow[mi][r] = -1e30f; lrow[mi][r] = 0.f; }

  const int q0 = qb * 128;
  const int band_lo = isctx ? 0 : max(0, q0 - 128), band_hi = isctx ? 0 : min(SEQ, q0 + 256);
  const int ntile = 4 + (band_hi - band_lo) / 64;
  u16* pl = PL + w * 32 * LDT;
  for (int tl = 0; tl < ntile; tl++) {
    const bool band = tl >= 4;
    const int k0 = band ? band_lo + (tl - 4) * 64 : tl * 64;
    __syncthreads();
    {
      const int key = tid >> 3, kc = tid & 7;
      const int kpos = k0 + key;
      const u16* kp = P + (size_t)(b * TPB + (band ? LC : 0) + kpos) * PST + PD + 256 + hk * 64;
      uint4 own = *(const uint4*)(kp + kc * 8);
      uint4 vv = *(const uint4*)(kp + 128 + kc * 8);
      uint4 par = *(const uint4*)(kp + (kc ^ 2) * 8);
      if (band) {
        const unsigned ow[4] = {own.x, own.y, own.z, own.w};
        const unsigned pw[4] = {par.x, par.y, par.z, par.w};
        const int pos = kc < 4 ? (kpos >> 6) : (kpos & 63);
        unsigned res[4];
#pragma unroll
        for (int jj = 0; jj < 8; jj += 2) {
          float v2[2];
#pragma unroll
          for (int e = 0; e < 2; e++) {
            float xo = bf2f((u16)((ow[jj >> 1] >> (e * 16)) & 0xffff));
            float xp = bf2f((u16)((pw[jj >> 1] >> (e * 16)) & 0xffff));
            float2 cs = ROPE[pos * 16 + (kc & 1) * 8 + jj + e];
            v2[e] = (kc & 2) == 0 ? xo * cs.x - xp * cs.y : xp * cs.y + xo * cs.x;
          }
          res[jj >> 1] = pack2(v2[0], v2[1]);
        }
        own = make_uint4(res[0], res[1], res[2], res[3]);
      }
      *(uint4*)(KS + key * LDT + kc * 8) = own;
      const unsigned vw[4] = {vv.x, vv.y, vv.z, vv.w};
#pragma unroll
      for (int jj = 0; jj < 8; jj++) VT[(kc * 8 + jj) * LDT + key] = (u16)((vw[jj >> 1] >> ((jj & 1) * 16)) & 0xffff);
    }
    __syncthreads();
    f32x4 sc[2][4];
#pragma unroll
    for (int mi = 0; mi < 2; mi++)
#pragma unroll
      for (int nj = 0; nj < 4; nj++) sc[mi][nj] = f32x4{0.f, 0.f, 0.f, 0.f};
#pragma unroll
    for (int ks = 0; ks < 2; ks++) {
      bf16x8 kf[4];
#pragma unroll
      for (int nj = 0; nj < 4; nj++) kf[nj] = *(const bf16x8*)(KS + (nj * 16 + fr) * LDT + ks * 32 + fq * 8);
#pragma unroll
      for (int mi = 0; mi < 2; mi++)
#pragma unroll
        for (int nj = 0; nj < 4; nj++) sc[mi][nj] = __builtin_amdgcn_mfma_f32_16x16x32_bf16(qf[mi][ks], kf[nj], sc[mi][nj], 0, 0, 0);
    }
#pragma unroll
    for (int mi = 0; mi < 2; mi++)
#pragma unroll
      for (int r = 0; r < 4; r++) {
        const int qpos = tb + mi * 16 + fq * 4 + r;
        float mx = -1e30f;
#pragma unroll
        for (int nj = 0; nj < 4; nj++) {
          float v = sc[mi][nj][r];
          if (band) {
            int d = qpos - (k0 + nj * 16 + fr);
            if (d > 128 || d < -128) v = -1e30f;
          }
          sc[mi][nj][r] = v;
          mx = fmaxf(mx, v);
        }
        mx = fmaxf(mx, __shfl_xor(mx, 1));
        mx = fmaxf(mx, __shfl_xor(mx, 2));
        mx = fmaxf(mx, __shfl_xor(mx, 4));
        mx = fmaxf(mx, __shfl_xor(mx, 8));
        const float mnew = fmaxf(mrow[mi][r], mx);
        const float alpha = __expf(mrow[mi][r] - mnew);
        mrow[mi][r] = mnew;
        float ls = 0.f;
#pragma unroll
        for (int nj = 0; nj < 4; nj++) {
          float pe = __expf(sc[mi][nj][r] - mnew);
          ls += pe;
          pl[(mi * 16 + fq * 4 + r) * LDT + nj * 16 + fr] = f2bf(pe);
        }
        lrow[mi][r] = lrow[mi][r] * alpha + ls;
#pragma unroll
        for (int nd = 0; nd < 4; nd++) oacc[mi][nd][r] *= alpha;
      }
    asm volatile("s_waitcnt lgkmcnt(0)" ::: "memory");
    __builtin_amdgcn_wave_barrier();
#pragma unroll
    for (int ks = 0; ks < 2; ks++) {
      bf16x8 pf[2], vf[4];
#pragma unroll
      for (int mi = 0; mi < 2; mi++) pf[mi] = *(const bf16x8*)(pl + (mi * 16 + fr) * LDT + ks * 32 + fq * 8);
#pragma unroll
      for (int nd = 0; nd < 4; nd++) vf[nd] = *(const bf16x8*)(VT + (nd * 16 + fr) * LDT + ks * 32 + fq * 8);
#pragma unroll
      for (int mi = 0; mi < 2; mi++)
#pragma unroll
        for (int nd = 0; nd < 4; nd++) oacc[mi][nd] = __builtin_amdgcn_mfma_f32_16x16x32_bf16(pf[mi], vf[nd], oacc[mi][nd], 0, 0, 0);
    }
    asm volatile("s_waitcnt lgkmcnt(0)" ::: "memory");
    __builtin_amdgcn_wave_barrier();
  }
  const float sink = p.attn_sink[l * 4 + qh];
#pragma unroll
  for (int mi = 0; mi < 2; mi++)
#pragma unroll
    for (int r = 0; r < 4; r++) {
      float ls = lrow[mi][r];
      ls += __shfl_xor(ls, 1);
      ls += __shfl_xor(ls, 2);
      ls += __shfl_xor(ls, 4);
      ls += __shfl_xor(ls, 8);
      ls += __expf(sink - mrow[mi][r]);
      const float inv = 1.f / ls;
      const int tq = tb + mi * 16 + fq * 4 + r;
#pragma unroll
      for (int nd = 0; nd < 4; nd++) Y[(size_t)(qrow0 + tq) * YST + 1536 + qh * 64 + nd * 16 + fr] = f2bf(oacc[mi][nd][r] * inv);
    }
}

#ifndef SCAN3_MASK
#define SCAN3_MASK 7
#endif
__device__ __forceinline__ void phase_mix(const Params& p, int l, unsigned char* smem) {
  float* sm = (float*)smem;
  const int G = gridDim.x;
  for (int it = blockIdx.x; it < 192; it += G) {
    const int mix = it >> 6, rem = it & 63, b = rem >> 3, h = (rem >> 1) & 3, dir = rem & 1;
    if (mix == 0 && (SCAN3_MASK & 1)) scan3_item<0>(p, l, b, h, dir, smem);
    else if (mix == 1 && (SCAN3_MASK & 2)) scan3_item<1>(p, l, b, h, dir, smem);
    else if (mix == 2 && (SCAN3_MASK & 4)) scan3_item<2>(p, l, b, h, dir, smem);
  }
  if (SCAN3_MASK != 7) {
    for (int it = blockIdx.x; it < 768; it += G) {
      const int mix = it >> 8, rem = it & 255, b = rem >> 5, h = (rem >> 3) & 3, dir = (rem >> 2) & 1, rq = rem & 3;
      if (mix == 0 && !(SCAN3_MASK & 1)) scan2_item<0>(p, l, b, h, dir, rq, sm);
      else if (mix == 1 && !(SCAN3_MASK & 2)) scan2_item<1>(p, l, b, h, dir, rq, sm);
      else if (mix == 2 && !(SCAN3_MASK & 4)) scan2_item<2>(p, l, b, h, dir, rq, sm);
    }
  }
  __syncthreads();
  {
    const int nfree = G > 192 ? G - 192 : G, fidx = G > 192 ? (int)blockIdx.x - 192 : (int)blockIdx.x;
    if (fidx >= 0)
      for (int it = 832 + fidx; it < 4480; it += nfree) conv_item(p, l, it, (float*)smem);
    __syncthreads();
  }
  unsigned* ctr = (unsigned*)(p.ws + OFF_CTR) + l * 16;
  volatile int* slot = (volatile int*)(smem + 131072 - 16);
  for (;;) {
    if (TIDX == 0) *slot = (int)atomicAdd(ctr, 1u);
    __syncthreads();
    const int it = *slot;
    __syncthreads();
    if (it >= (l == 0 ? 544 : 512)) break;
    if (it < 512) {
      int b = it >> 6, qb = (it >> 1) & 31, hk = it & 1;
      attn_item(p, l, b, qb, hk, false, smem);
    } else {
      int r = it - 512, b = r >> 2, qb = (r >> 1) & 1, hk = r & 1;
      attn_item(p, l, b, qb, hk, true, smem);
    }
  }
}

#define POST_DECL(PFX) uint2 PFX##ya0, PFX##ya1, PFX##ya2, PFX##yc0, PFX##yc1, PFX##yc2, PFX##vp, PFX##vc, PFX##vn, PFX##gb, PFX##gc; \
  u16 PFX##xp, PFX##xc, PFX##xn; float2 PFX##bc
#define POST_LOAD(PFX, R_)                                                                         \
  do {                                                                                             \
    const int r_ = (R_);                                                                           \
    const int b_ = r_ / TPB, t_ = r_ - b_ * TPB;                                                   \
    const bool hp_ = (t_ != 0) && (t_ != LC), hn_ = (t_ != LC - 1) && (t_ != TPB - 1);            \
    const u16* ys_ = YSc + (size_t)r_ * YST;                                                       \
    const u16* pr_ = Pc + (size_t)r_ * PST;                                                        \
    const u16* pp_ = pr_ - (hp_ ? PST : 0);                                                        \
    const u16* pn_ = pr_ + (hn_ ? PST : 0);                                                        \
    PFX##ya0 = *(const uint2*)(ys_ + j0); PFX##ya1 = *(const uint2*)(ys_ + 256 + j0); PFX##ya2 = *(const uint2*)(ys_ + 512 + j0); \
    PFX##yc0 = *(const uint2*)(ys_ + 768 + j0); PFX##yc1 = *(const uint2*)(ys_ + 1024 + j0); PFX##yc2 = *(const uint2*)(ys_ + 1280 + j0); \
    PFX##vp = *(const uint2*)(pp_ + PA + 512 + j0);                                                \
    PFX##vc = *(const uint2*)(pr_ + PA + 512 + j0);                                                \
    PFX##vn = *(const uint2*)(pn_ + PA + 512 + j0);                                                \
    PFX##gb = *(const uint2*)(pr_ + PB + 784 + j0);                                                \
    PFX##gc = *(const uint2*)(pr_ + PC + 544 + j0);                                                \
    PFX##xp = pp_[PA + 896 + lane]; PFX##xc = pr_[PA + 896 + lane]; PFX##xn = pn_[PA + 896 + lane]; \
    PFX##bc = *(const float2*)(BCc + (size_t)r_ * 8 + (lane >> 4) * 2);                            \
  } while (0)
__device__ __forceinline__ void unpack4(uint2 v, float (&o)[4]) {
  o[0] = __uint_as_float(v.x << 16); o[1] = __uint_as_float(v.x & 0xffff0000u);
  o[2] = __uint_as_float(v.y << 16); o[3] = __uint_as_float(v.y & 0xffff0000u);
}

__device__ __forceinline__ void phase_post(const Params& p, int l, float* g2s) {
  const int lane = TIDX & 63, wv = TIDX >> 6;
  u16* YS = (u16*)(p.ws + OFF_YS);
  const int j0 = lane * 4;
  {
    const float4* src = (const float4*)(p.rwkv_g2 + (size_t)l * 64 * 256);
    for (int i = TIDX; i < 64 * 256 / 4; i += NTHR) ((float4*)g2s)[i] = src[i];
  }
  float mu_v[4], lng[4], lnb[4], ngb[4], ngc[4];
#pragma unroll
  for (int i = 0; i < 4; i++) {
    mu_v[i] = p.rwkv_mu[l * 960 + 512 + j0 + i];
    lng[i] = p.rwkv_ln_g[l * 256 + j0 + i];
    lnb[i] = p.rwkv_ln_b[l * 256 + j0 + i];
    ngb[i] = p.gdn_norm_g[l * 64 + (lane & 15) * 4 + i];
    ngc[i] = p.gla_norm_g[l * 64 + (lane & 15) * 4 + i];
  }
  const float mu_x = p.rwkv_mu[l * 960 + 896 + lane];
  __syncthreads();
  const int stride = gridDim.x * 8;
  int r = blockIdx.x * 8 + wv;
  const u16* Pc = (const u16*)(p.ws + OFF_BIG);
  const u16* YSc = (const u16*)(p.ws + OFF_YS);
  const float* BCc = (const float*)(p.ws + OFF_BC);
  POST_DECL(cur_);
  POST_DECL(nxt_);
  POST_LOAD(cur_, r);
  for (; r < NROWS; r += stride) {
    const int rn = r + stride < NROWS ? r + stride : r;
    POST_LOAD(nxt_, rn);
    const int b = r / TPB, t = r - b * TPB;
    const float pmul = ((t != 0) && (t != LC)) ? 1.f : 0.f, nmul = ((t != LC - 1) && (t != TPB - 1)) ? 1.f : 0.f;
    if (!(l == 1 && t < LC)) {
    float y[3][4];
    {
      float a4[4], c4[4];
      unpack4(cur_ya0, a4); unpack4(cur_yc0, c4);
#pragma unroll
      for (int i = 0; i < 4; i++) y[0][i] = a4[i] + c4[i];
      unpack4(cur_ya1, a4); unpack4(cur_yc1, c4);
#pragma unroll
      for (int i = 0; i < 4; i++) y[1][i] = a4[i] + c4[i];
      unpack4(cur_ya2, a4); unpack4(cur_yc2, c4);
#pragma unroll
      for (int i = 0; i < 4; i++) y[2][i] = a4[i] + c4[i];
    }
    float o[3][4];
    {
      float sum = y[0][0] + y[0][1] + y[0][2] + y[0][3];
      sum = red16(sum);
      const float mean = sum * (1.f / 64.f);
      float vs = 0.f;
#pragma unroll
      for (int i = 0; i < 4; i++) { float d = y[0][i] - mean; vs += d * d; }
      vs = red16(vs);
      const float rstd = rsq(vs * (1.f / 64.f) + 64e-5f);
      const float pv = bf2f(cur_xc), ppv = bf2f(cur_xp) * pmul, pnv = bf2f(cur_xn) * nmul;
      const float sg = sigm(pv + (0.5f * (ppv + pnv) - pv) * mu_x);
      float gate[4] = {0.f, 0.f, 0.f, 0.f};
      const float* g2 = g2s + j0;
#pragma unroll 8
      for (int i = 0; i < 64; i++) {
        const float si = __int_as_float(__builtin_amdgcn_readlane(__float_as_int(sg), i));
        const float4 gw = *(const float4*)(g2 + i * 256);
        gate[0] += si * gw.x; gate[1] += si * gw.y; gate[2] += si * gw.z; gate[3] += si * gw.w;
      }
      const float bcs = cur_bc.x + cur_bc.y;
      float vc4[4], vp4[4], vn4[4];
      unpack4(cur_vc, vc4); unpack4(cur_vp, vp4); unpack4(cur_vn, vn4);
#pragma unroll
      for (int i = 0; i < 4; i++) {
        const float v = vc4[i] + (0.5f * (vp4[i] * pmul + vn4[i] * nmul) - vc4[i]) * mu_v[i];
        const float yn = (y[0][i] - mean) * rstd * lng[i] + lnb[i];
        o[0][i] = (yn + bcs * v) * gate[i];
      }
    }
#pragma unroll
    for (int m = 1; m < 3; m++) {
      float ss = y[m][0] * y[m][0] + y[m][1] * y[m][1] + y[m][2] * y[m][2] + y[m][3] * y[m][3];
      ss = red16(ss);
      const float inv = rsq(ss * (1.f / 64.f) + 1e-6f);
      float g4[4];
      unpack4(m == 1 ? cur_gb : cur_gc, g4);
#pragma unroll
      for (int i = 0; i < 4; i++) o[m][i] = y[m][i] * inv * (m == 1 ? ngb[i] : ngc[i]) * siluf(g4[i]);
    }
    u16* ys = YS + (size_t)r * YST;
#pragma unroll
    for (int m = 0; m < 3; m++) {
      uint2 ov;
      ov.x = pack2(o[m][0], o[m][1]);
      ov.y = pack2(o[m][2], o[m][3]);
      *(uint2*)(ys + m * 256 + j0) = ov;
    }
    }
    cur_ya0 = nxt_ya0; cur_ya1 = nxt_ya1; cur_ya2 = nxt_ya2; cur_yc0 = nxt_yc0; cur_yc1 = nxt_yc1; cur_yc2 = nxt_yc2;
    cur_vp = nxt_vp; cur_vc = nxt_vc; cur_vn = nxt_vn; cur_gb = nxt_gb; cur_gc = nxt_gc;
    cur_xp = nxt_xp; cur_xc = nxt_xc; cur_xn = nxt_xn; cur_bc = nxt_bc;
  }
}

#define XB_TMO      128
#define XB_XCNT(j)  (256  + 64 * (j))
#define XB_XSUB(j)  (1280 + 64 * (j))
#define XB_XGEN(j)  (2304 + 64 * (j))
#define XB_TOP      3328
#define XB_TOPGEN   3392
#define XCD_BAR_WORDS 3456
#define XB_SPIN_CAP (1u << 18)
#define LAS __attribute__((address_space(3)))

__device__ __forceinline__ unsigned xb_ld(unsigned* p)              { return __hip_atomic_load(p, __ATOMIC_RELAXED, __HIP_MEMORY_SCOPE_AGENT); }
__device__ __forceinline__ unsigned xb_add(unsigned* p, unsigned v) { return __hip_atomic_fetch_add(p, v, __ATOMIC_RELAXED, __HIP_MEMORY_SCOPE_AGENT); }
__device__ __forceinline__ unsigned xb_xcc_id() { return (unsigned)__builtin_amdgcn_s_getreg((3 << 11) | 20) & 0xFu; }
#define XB_SPIN(cond, bar) do { unsigned _sp = 0; while (cond) { __builtin_amdgcn_s_sleep(1); \
    if ((++_sp & 255u) == 0u) { if (xb_ld(&(bar)[XB_TMO])) break; if (_sp > XB_SPIN_CAP) { atomicAdd(&(bar)[XB_TMO], 1u); break; } } } } while (0)

struct XcdBarrier {
    unsigned* bar; unsigned x;
    volatile LAS unsigned* st;
};

__device__ __forceinline__ XcdBarrier xcd_barrier_post(unsigned* bar, volatile LAS unsigned* st) {
    XcdBarrier b; b.bar = bar; b.x = xb_xcc_id(); b.st = st;
    if (threadIdx.x == 0) (void)xb_add(&bar[XB_XCNT(b.x)], 1u);
    return b;
}
__device__ __forceinline__ void xcd_barrier_complete(unsigned* bar, unsigned x, unsigned& nloc, unsigned& nx) {
    const unsigned G = gridDim.x * gridDim.y * gridDim.z;
    unsigned sum, cnt, mine, sp = 0u;
    for (;;) {
        sum = 0u; cnt = 0u; mine = 0u;
#pragma unroll
        for (unsigned j = 0; j < 16; ++j) { const unsigned c = xb_ld(&bar[XB_XCNT(j)]); sum += c; cnt += (c > 0u) ? 1u : 0u; mine = (j == x) ? c : mine; }
        if (sum == G) break;
        __builtin_amdgcn_s_sleep(1);
        if ((++sp & 255u) == 0u) { if (xb_ld(&bar[XB_TMO])) break; if (sp > XB_SPIN_CAP) { atomicAdd(&bar[XB_TMO], 1u); break; } }
    }
    nloc = mine > 0u ? mine : 1u; nx = cnt > 0u ? cnt : 1u;
}

__device__ __forceinline__ void xcd_barrier(const XcdBarrier& b) {
    asm volatile("s_waitcnt vmcnt(0)" ::: "memory");
    __syncthreads();
    if (threadIdx.x == 0) {
        unsigned* bar = b.bar;
        __builtin_amdgcn_s_waitcnt(0);
        unsigned nloc = b.st[0], nx = b.st[1];
        if (nloc == 0u) { xcd_barrier_complete(bar, b.x, nloc, nx); b.st[0] = nloc; b.st[1] = nx; }
        const unsigned old = xb_add(&bar[XB_XSUB(b.x)], 1u);
        const unsigned gen = old / nloc;
        if (old + 1u == (gen + 1u) * nloc) {
            __builtin_amdgcn_fence(__ATOMIC_RELEASE, "agent");
            asm volatile("s_waitcnt vmcnt(0)" ::: "memory");
            const unsigned og = xb_add(&bar[XB_TOP], 1u);
            const unsigned tg = og / nx;
            if (og + 1u == (tg + 1u) * nx) xb_add(&bar[XB_TOPGEN], 1u);
            else XB_SPIN(xb_ld(&bar[XB_TOPGEN]) == tg, bar);
            __builtin_amdgcn_fence(__ATOMIC_ACQUIRE, "agent");
            xb_add(&bar[XB_XGEN(b.x)], 1u);
            asm volatile("s_waitcnt vmcnt(0)" ::: "memory");
        } else {
            XB_SPIN(xb_ld(&bar[XB_XGEN(b.x)]) == gen, bar);
            __builtin_amdgcn_fence(__ATOMIC_ACQUIRE, "agent");
            asm volatile("s_waitcnt vmcnt(0)" ::: "memory");
        }
    }
    __syncthreads();
}

#if defined(SKIPS)
#define EN(k) (SKIPS != (k))
#elif !defined(ONLYS)
#define EN(k) 1
#else
#define EN(k) (ONLYS == (k))
#endif
__device__ __forceinline__ void run_phase(const Params& p, int ph, unsigned char* smem) {
  if (ph == 0) { if (EN(10)) phase_init0(p, (float*)smem); return; }
  if (ph == 1) { if (EN(11)) phase_init1(p); return; }
  int l = 0, s = 10;
  if (ph >= 3) { l = (ph - 3) / 10; s = (ph - 3) - l * 10; }
  unsigned char* wl = p.ws + OFF_W;
  PG8_LAS unsigned char* lds = (PG8_LAS unsigned char*)smem;
  pg8::StaticOrder S;
  if (s == 10 || s == 6 || s == 9) {
    if (EN(5)) rowpass(p, l, s == 10 ? 0 : (s == 6 ? 1 : 2));
    if (s == 9 && l == 0) {
      __syncthreads();
      for (int it = blockIdx.x; it < 832; it += gridDim.x) conv_item(p, 1, it, (float*)smem);
    }
  } else if (s == 0 || s == 3 || s == 5 || s == 8) {
    pg8::Gemm g; EpiBf E;
    g.M = NROWS; E.bias = nullptr; E.act = 0;
    if (s == 0) { g.A = (const u16*)(p.ws + OFF_H); g.lda = DM; g.Bt = (const u16*)(wl + OW_IN); g.K = DM; g.N = PST; E.O = (u16*)(p.ws + OFF_BIG); E.ldc = PST; }
    else if (s == 3) {
      g.A = (const u16*)(p.ws + OFF_H); g.lda = DM; g.Bt = (const u16*)(wl + OW_G); g.K = DM; g.N = 4096;
      E.O = (u16*)(p.ws + OFF_BIG); E.ldc = 4096; E.bias = p.gate_b + (size_t)l * 4096; E.act = 1;
    }
    else if (s == 5) { g.A = (const u16*)(p.ws + OFF_H); g.lda = DM; g.Bt = (const u16*)(wl + OW_O); g.K = DM; g.N = DM; E.O = (u16*)(p.ws + OFF_BIG); E.ldc = DM; }
    else { g.A = (const u16*)(p.ws + OFF_BIG); g.lda = FH; g.Bt = (const u16*)(wl + OW_2); g.K = FH; g.N = DM; E.O = (u16*)(p.ws + OFF_YS); E.ldc = DM; }
    if (l == 1 && s != 0) S.init(NBATCH * SEQ, g.N, gridDim.x, blockIdx.x, 1);
    else S.init(g.M, g.N, gridDim.x, blockIdx.x);
    if (EN(0)) pg8::gemm_phase<EpiBf, pg8::StaticOrder, false>(lds, g, S, E, nullptr);
  } else if (s == 4) {
    if (EN(3)) phase_ypart(p, l, smem);
  } else if (s == 1) {
    if (EN(1)) phase_mix(p, l, smem);
  } else if (s == 2) {
    if (EN(2)) phase_post(p, l, (float*)smem);
  } else {
    pg8::Gemm g; EpiSwiglu E;
    g.M = NROWS; g.N = 2 * FH; g.K = DM; g.lda = DM; g.A = (const u16*)(p.ws + OFF_H); g.Bt = (const u16*)(wl + OW_1);
    E.O = (u16*)(p.ws + OFF_BIG);
    if (l == 1) S.init(NBATCH * SEQ, g.N, gridDim.x, blockIdx.x, 1);
    else S.init(g.M, g.N, gridDim.x, blockIdx.x);
    if (EN(6)) pg8::gemm_phase<EpiSwiglu, pg8::StaticOrder, false>(lds, g, S, E, nullptr);
  }
}

__global__ void __launch_bounds__(NTHR) hybrid_flow_mega(Params p, int ph0, int ph1) {
  __shared__ __attribute__((aligned(16))) unsigned char smem[131072];
  __shared__ __attribute__((aligned(16))) unsigned xbw[4];
  cg::grid_group grid = cg::this_grid();
  XcdBarrier xb;
  xb.bar = (unsigned*)(p.ws + OFF_XBAR); xb.x = 0u; xb.st = (volatile LAS unsigned*)xbw;
  for (int ph = ph0; ph < ph1; ph++) {
    run_phase(p, ph, smem);
#ifdef DUPMASK
    {
      int sidx = ph >= 3 ? (ph - 3) % 10 : 12 + ph;
      if ((DUPMASK >> sidx) & 1) { __syncthreads(); run_phase(p, ph, smem); }
    }
#endif
    if (ph + 1 < ph1) {
      if (ph == ph0) {
        grid.sync();
        if (threadIdx.x < 4) xbw[threadIdx.x] = 0u;
        __syncthreads();
        xb = xcd_barrier_post((unsigned*)(p.ws + OFF_XBAR), (volatile LAS unsigned*)xbw);
      } else {
        xcd_barrier(xb);
      }
    }
  }
  if (ph1 - ph0 > 2 && threadIdx.x == 0 && xb_ld(&xb.bar[XB_TMO]) != 0u) p.out[blockIdx.x] = __int_as_float(0x7fc00000);
}

extern "C" void kernel_launch(void* const* d_in, const int* in_sizes, int n_in, void* d_out, int out_size, void* d_ws,
                              size_t ws_size, hipStream_t stream) {
  Params p{};
  const float** pp = (const float**)&p;
  for (int i = 0; i < 32; i++) pp[i] = (const float*)d_in[i];
  p.out = (float*)d_out;
  p.ws = (unsigned char*)d_ws;
  static int grid_blocks = 0;
  if (!grid_blocks) {
    int dev = 0, cus = 0, per_cu = 0;
    hipGetDevice(&dev);
    hipDeviceGetAttribute(&cus, hipDeviceAttributeMultiprocessorCount, dev);
    hipOccupancyMaxActiveBlocksPerMultiprocessor(&per_cu, hybrid_flow_mega, NTHR, 0);
    if (per_cu < 1) per_cu = 1;
    grid_blocks = cus * per_cu;
  }
#ifdef MULTI_LAUNCH
  for (int ph = 0; ph < NPHASE; ph++) {
    hipLaunchKernelGGL(hybrid_flow_mega, dim3(grid_blocks), dim3(NTHR), 0, stream, p, ph, ph + 1);
  }
#else
  int ph0 = 0, ph1 = NPHASE;
  void* args[] = {&p, &ph0, &ph1};
  hipError_t e = hipLaunchCooperativeKernel((void*)hybrid_flow_mega, dim3(grid_blocks), dim3(NTHR), args, 0, stream);
  if (e != hipSuccess) fprintf(stderr, "cooperative launch failed: %s (grid %d)\n", hipGetErrorString(e), grid_blocks);
#endif
}
```

```cpp
#include <hip/hip_runtime.h>
#include <hip/hip_cooperative_groups.h>
#include <cstdio>
namespace cg = cooperative_groups;

typedef unsigned short u16;
using bf16x8 = __attribute__((ext_vector_type(8))) short;
using f32x4 = __attribute__((ext_vector_type(4))) float;

#define DM 1024
#define NBATCH 8
#define SEQ 4096
#define LC 256
#define TPB 4352
#define NROWS 34816
#define PST 3328
#define YST 1792
#define FH 2816
#define INW 7408
#define NTHR 512
#define PA 0
#define PB 960
#define PC 2000
#define PD 2800
#define NPHASE 23
#define SCAN3_MASK 7

struct Params {
  const float *x, *c, *ctx, *c_ctx, *ada_w, *ada_b, *norm_g, *w_in, *gate_b, *w_branch, *w_out,
      *rwkv_mu, *rwkv_w0, *rwkv_w2, *rwkv_a0, *rwkv_a2, *rwkv_g2, *rwkv_kk, *rwkv_ka, *rwkv_rk, *rwkv_ln_g,
      *rwkv_ln_b, *gdn_conv, *gdn_a_log, *gdn_dt_bias, *gdn_norm_g, *gla_gw2, *gla_gb, *gla_norm_g, *attn_sink,
      *ffn_w1, *ffn_w2;
  float* out;
  unsigned char* ws;
};

constexpr size_t SZ_WL = 36700160;
constexpr size_t OW_IN = 0;
constexpr size_t OW_G = OW_IN + (size_t)PST * 1024 * 2;
constexpr size_t OW_B = OW_G + (size_t)4096 * 1024 * 2;
constexpr size_t OW_O = OW_B + (size_t)4 * 1024 * 256 * 2;
constexpr size_t OW_1 = OW_O + (size_t)1024 * 1024 * 2;
constexpr size_t OW_2 = OW_1 + (size_t)5632 * 1024 * 2;
static_assert(OW_2 + (size_t)1024 * FH * 2 == SZ_WL, "weights size");
constexpr size_t SZ_ACT = (size_t)NROWS * DM * 2;
constexpr size_t OFF_W = 0;
constexpr size_t OFF_XC = OFF_W + SZ_WL;
constexpr size_t OFF_MODP = OFF_XC + (size_t)NBATCH * LC * DM * 4;
constexpr size_t OFF_MOD = OFF_MODP + (size_t)2 * 8 * 9 * 6144 * 4;
constexpr size_t OFF_BC = OFF_MOD + (size_t)2 * 9 * 6144 * 4;
constexpr size_t OFF_H = OFF_BC + (size_t)NROWS * 8 * 4;
constexpr size_t OFF_YS = OFF_H + SZ_ACT;
constexpr size_t OFF_BIG = OFF_YS + (size_t)NROWS * YST * 2;
constexpr size_t OFF_CTR = OFF_BIG + (size_t)NROWS * 4096 * 2;
constexpr size_t OFF_XBAR = OFF_CTR + 256;
constexpr size_t WS_END = OFF_XBAR + 3456 * 4;
static_assert(WS_END <= (size_t)536870912, "ws too large");

__device__ __forceinline__ int launder_tid() { int t = threadIdx.x; asm volatile("" : "+v"(t)); return t; }
#define TIDX (launder_tid())
typedef float f32x2_t __attribute__((ext_vector_type(2)));
typedef __bf16 bf16x2_t __attribute__((ext_vector_type(2)));
__device__ __forceinline__ unsigned pack2(float a, float b) {
  const f32x2_t v = {a, b};
  const bf16x2_t r = __builtin_convertvector(v, bf16x2_t);
  return __builtin_bit_cast(unsigned, r);
}
__device__ __forceinline__ u16 f2bf(float f) { return (u16)(pack2(f, 0.f) & 0xffffu); }
__device__ __forceinline__ float bf2f(u16 h) { return __uint_as_float(((unsigned)h) << 16); }
__device__ __forceinline__ float sigm(float x) { return __builtin_amdgcn_rcpf(1.f + __expf(-x)); }
__device__ __forceinline__ float siluf(float x) { return x * __builtin_amdgcn_rcpf(1.f + __expf(-x)); }
__device__ __forceinline__ float rsq(float x) { return __builtin_amdgcn_rsqf(x); }
__device__ __forceinline__ float softplusf(float x) { return fmaxf(x, 0.f) + __logf(1.f + __expf(-fabsf(x))); }
__device__ __forceinline__ float tanh_fast(float x) { return 1.f - 2.f * __builtin_amdgcn_rcpf(1.f + __expf(2.f * x)); }
__device__ __forceinline__ float wsum(float v) {
#pragma unroll
  for (int o = 32; o > 0; o >>= 1) v += __shfl_xor(v, o);
  return v;
}
template <int CTRL>
__device__ __forceinline__ float dppf(float x) {
  return __int_as_float(__builtin_amdgcn_update_dpp(__float_as_int(x), __float_as_int(x), CTRL, 0xf, 0xf, false));
}
__device__ __forceinline__ float red8(float x) {
  x += dppf<0xB1>(x);
  x += dppf<0x4E>(x);
  x += dppf<0x141>(x);
  return x;
}
__device__ __forceinline__ const float* xin_row(const Params& p, int r) {
  int b = r / TPB, t = r - b * TPB;
  return t < LC ? p.ctx + ((size_t)(b * LC + t)) * DM : p.x + ((size_t)(b * SEQ + t - LC)) * DM;
}
__device__ __forceinline__ float* x_row(const Params& p, int r) {
  int b = r / TPB, t = r - b * TPB;
  return t < LC ? (float*)(p.ws + OFF_XC) + ((size_t)(b * LC + t)) * DM : p.out + ((size_t)(b * SEQ + t - LC)) * DM;
}
__device__ __forceinline__ int mod_row(int r) {
  int b = r / TPB, t = r - b * TPB;
  return t < LC ? 8 : b;
}

struct MapId { int lim, off; __device__ int operator()(int n) const { return n < lim ? n + off : -1; } };
struct MapW1 { __device__ int operator()(int n) const { int q = n >> 3, s = n & 7; return s < 4 ? q * 4 + s : FH + q * 4 + (s - 4); } };

template <class Map>
__device__ __forceinline__ void conv_tile(const float* __restrict__ src, int ld, u16* __restrict__ dst, int K, int n0,
                                          int k0, Map map, float* tile) {
  const int tid = TIDX;
  const int nn = tid & 63, kr = tid >> 6;
  const int sc = map(n0 + nn);
  float tv[8];
  const int scc = sc >= 0 ? sc : 0;
  const float scm = sc >= 0 ? 1.f : 0.f;
#pragma unroll
  for (int ps = 0; ps < 8; ps++) tv[ps] = src[(size_t)(k0 + ps * 8 + kr) * ld + scc];
#pragma unroll
  for (int ps = 0; ps < 8; ps++) tile[(ps * 8 + kr) * 65 + nn] = tv[ps] * scm;
  __syncthreads();
  const int n2 = tid >> 3, kc = tid & 7;
  uint4 o;
  o.x = pack2(tile[(kc * 8 + 0) * 65 + n2], tile[(kc * 8 + 1) * 65 + n2]);
  o.y = pack2(tile[(kc * 8 + 2) * 65 + n2], tile[(kc * 8 + 3) * 65 + n2]);
  o.z = pack2(tile[(kc * 8 + 4) * 65 + n2], tile[(kc * 8 + 5) * 65 + n2]);
  o.w = pack2(tile[(kc * 8 + 6) * 65 + n2], tile[(kc * 8 + 7) * 65 + n2]);
  *(uint4*)(dst + (size_t)(n0 + n2) * K + k0 + kc * 8) = o;
  __syncthreads();
}

__device__ __forceinline__ void conv_item(const Params& p, int l, int rem, float* sm) {
      u16* wl = (u16*)(p.ws + OFF_W);
      if (rem < 832) {
        int nt = rem >> 4, kt = rem & 15;
        conv_tile(p.w_in + (size_t)l * DM * INW, INW, (u16*)((char*)wl + OW_IN), 1024, nt * 64, kt * 64, MapId{3312, 0}, sm);
      } else if (rem < 832 + 1024) {
        rem -= 832;
        int nt = rem >> 4, kt = rem & 15;
        conv_tile(p.w_in + (size_t)l * DM * INW, INW, (u16*)((char*)wl + OW_G), 1024, nt * 64, kt * 64, MapId{4096, 3312}, sm);
      } else if (rem < 1856 + 256) {
        rem -= 1856;
        int br = rem >> 6, r2 = rem & 63, nt = r2 >> 2, kt = r2 & 3;
        conv_tile(p.w_branch + ((size_t)(l * 4 + br)) * 256 * DM, DM, (u16*)((char*)wl + OW_B) + (size_t)br * 1024 * 256, 256,
                  nt * 64, kt * 64, MapId{1024, 0}, sm);
      } else if (rem < 2112 + 256) {
        rem -= 2112;
        int nt = rem >> 4, kt = rem & 15;
        conv_tile(p.w_out + (size_t)l * DM * DM, DM, (u16*)((char*)wl + OW_O), 1024, nt * 64, kt * 64, MapId{1024, 0}, sm);
      } else if (rem < 2368 + 1408) {
        rem -= 2368;
        int nt = rem >> 4, kt = rem & 15;
        conv_tile(p.ffn_w1 + (size_t)l * DM * 5632, 5632, (u16*)((char*)wl + OW_1), 1024, nt * 64, kt * 64, MapW1{}, sm);
      } else {
        rem -= 3776;
        int nt = rem / 44, kt = rem - nt * 44;
        conv_tile(p.ffn_w2 + (size_t)l * FH * DM, DM, (u16*)((char*)wl + OW_2), FH, nt * 64, kt * 64, MapId{1024, 0}, sm);
      }
}

__device__ __forceinline__ void phase_init0(const Params& p, float* sm) {
  const int tid = TIDX;
  if (blockIdx.x == 0) {
    if (tid < 64) ((unsigned*)(p.ws + OFF_CTR))[tid] = 0u;
    for (int i = tid; i < 3456; i += NTHR) ((unsigned*)(p.ws + OFF_XBAR))[i] = 0u;
  }
  constexpr int NMOD = 192, NCONV = 832;
  for (int it = blockIdx.x; it < NMOD + NCONV; it += gridDim.x) {
    if (it < NMOD) {
      int l = it / 96, rem = it - l * 96, cc = rem >> 3, ks = rem & 7;
      for (int i = tid; i < 9 * 128; i += NTHR) {
        int r = i >> 7, k = i & 127;
        float v = r < 8 ? p.c[r * DM + ks * 128 + k] : p.c_ctx[ks * 128 + k];
        sm[i] = siluf(v);
      }
      __syncthreads();
      const int n = cc * 512 + tid;
      const float* w = p.ada_w + ((size_t)l * DM + ks * 128) * 6144 + n;
      float acc[9];
#pragma unroll
      for (int r = 0; r < 9; r++) acc[r] = 0.f;
#pragma unroll 1
      for (int k0 = 0; k0 < 128; k0 += 16) {
        float wv[16];
#pragma unroll
        for (int kk = 0; kk < 16; kk++) wv[kk] = w[(size_t)(k0 + kk) * 6144];
#pragma unroll
        for (int kk = 0; kk < 16; kk++)
#pragma unroll
          for (int r = 0; r < 9; r++) acc[r] += sm[r * 128 + k0 + kk] * wv[kk];
      }
      float* mp = (float*)(p.ws + OFF_MODP) + ((size_t)(l * 8 + ks) * 9) * 6144 + n;
#pragma unroll
      for (int r = 0; r < 9; r++) mp[(size_t)r * 6144] = acc[r];
      __syncthreads();
    } else {
      conv_item(p, 0, it - NMOD, sm);
    }
  }
}

__device__ __forceinline__ void phase_init1(const Params& p) {
  const float* mp = (const float*)(p.ws + OFF_MODP);
  float* mo = (float*)(p.ws + OFF_MOD);
  for (int i = blockIdx.x * NTHR + TIDX; i < 2 * 9 * 6144; i += gridDim.x * NTHR) {
    int l = i / (9 * 6144), rem = i - l * 9 * 6144, r = rem / 6144, n = rem - r * 6144;
    float s = p.ada_b[l * 6144 + n];
#pragma unroll
    for (int ks = 0; ks < 8; ks++) s += mp[((size_t)((l * 8 + ks) * 9 + r)) * 6144 + n];
    mo[i] = s;
  }
}

__device__ __forceinline__ void rowpass(const Params& p, int l, int mode) {
  const int lane = TIDX & 63, wv = TIDX >> 6;
  const float* MOD = (const float*)(p.ws + OFF_MOD);
  u16* H = (u16*)(p.ws + OFF_H);
  const bool do_norm = !(mode == 2 && l == 1);
  const int ln = (mode == 2) ? (l == 1 ? l : l + 1) : l;
  const int ni = (mode == 1) ? 2 : 0, sho = (mode == 1) ? 3072 : 0, sco = (mode == 1) ? 4096 : 1024;
  for (int r = blockIdx.x * 8 + wv; r < NROWS; r += gridDim.x * 8) {
    const int mr = mod_row(r);
    if (l == 1 && mode != 0 && mr == 8) continue;
    const float* modl = MOD + ((size_t)(l * 9 + mr)) * 6144;
    const float* modn = MOD + ((size_t)(ln * 9 + mr)) * 6144;
    const float* ng2 = p.norm_g + (size_t)(ln * 4 + ni) * DM;
    const float* xs = (mode == 0 || (mode == 1 && l == 0)) ? xin_row(p, r) : (const float*)x_row(p, r);
    float4 xo[4], n2[4], sc4[4], sh4[4];
#pragma unroll
    for (int i = 0; i < 4; i++) {
      const int col = i * 256 + lane * 4;
      xo[i] = *(const float4*)(xs + col);
      n2[i] = *(const float4*)(ng2 + col);
      sc4[i] = *(const float4*)(modn + sco + col);
      sh4[i] = *(const float4*)(modn + sho + col);
    }
    float xv[16];
    if (mode == 0) {
#pragma unroll
      for (int i = 0; i < 4; i++) { xv[i * 4 + 0] = xo[i].x; xv[i * 4 + 1] = xo[i].y; xv[i * 4 + 2] = xo[i].z; xv[i * 4 + 3] = xo[i].w; }
    } else {
      const u16* src = (const u16*)(p.ws + (mode == 1 ? OFF_BIG : OFF_YS)) + (size_t)r * DM;
      const float* ng = p.norm_g + (size_t)(l * 4 + (mode == 1 ? 1 : 3)) * DM;
      const float* gt = modl + (mode == 1 ? 2048 : 5120);
      uint2 sv[4];
      float4 g4[4], n4[4];
#pragma unroll
      for (int i = 0; i < 4; i++) {
        const int col = i * 256 + lane * 4;
        sv[i] = *(const uint2*)(src + col);
        g4[i] = *(const float4*)(gt + col);
        n4[i] = *(const float4*)(ng + col);
      }
      float ov[16];
      float ss = 0.f;
#pragma unroll
      for (int i = 0; i < 4; i++) {
        ov[i * 4 + 0] = __uint_as_float(sv[i].x << 16); ov[i * 4 + 1] = __uint_as_float(sv[i].x & 0xffff0000u);
        ov[i * 4 + 2] = __uint_as_float(sv[i].y << 16); ov[i * 4 + 3] = __uint_as_float(sv[i].y & 0xffff0000u);
      }
#pragma unroll
      for (int i = 0; i < 16; i++) ss += ov[i] * ov[i];
      ss = wsum(ss);
      const float inv = rsq(ss * (1.f / 1024.f) + 1e-6f);
      float* xd = x_row(p, r);
#pragma unroll
      for (int i = 0; i < 4; i++) {
        xv[i * 4 + 0] = xo[i].x + g4[i].x * (ov[i * 4 + 0] * inv * n4[i].x);
        xv[i * 4 + 1] = xo[i].y + g4[i].y * (ov[i * 4 + 1] * inv * n4[i].y);
        xv[i * 4 + 2] = xo[i].z + g4[i].z * (ov[i * 4 + 2] * inv * n4[i].z);
        xv[i * 4 + 3] = xo[i].w + g4[i].w * (ov[i * 4 + 3] * inv * n4[i].w);
      }
#pragma unroll
      for (int i = 0; i < 4; i++)
        *(float4*)(xd + i * 256 + lane * 4) = make_float4(xv[i * 4 + 0], xv[i * 4 + 1], xv[i * 4 + 2], xv[i * 4 + 3]);
    }
    if (!do_norm) continue;
    float ss2 = 0.f;
#pragma unroll
    for (int i = 0; i < 16; i++) ss2 += xv[i] * xv[i];
    ss2 = wsum(ss2);
    const float inv2 = rsq(ss2 * (1.f / 1024.f) + 1e-6f);
#pragma unroll
    for (int i = 0; i < 4; i++) {
      const int col = i * 256 + lane * 4;
      float h0 = xv[i * 4 + 0] * inv2 * n2[i].x * (1.f + sc4[i].x) + sh4[i].x;
      float h1 = xv[i * 4 + 1] * inv2 * n2[i].y * (1.f + sc4[i].y) + sh4[i].y;
      float h2 = xv[i * 4 + 2] * inv2 * n2[i].z * (1.f + sc4[i].z) + sh4[i].z;
      float h3 = xv[i * 4 + 3] * inv2 * n2[i].w * (1.f + sc4[i].w) + sh4[i].w;
      uint2 o;
      o.x = pack2(h0, h1);
      o.y = pack2(h2, h3);
      *(uint2*)(H + (size_t)r * DM + col) = o;
    }
  }
}

#define LDT 72
namespace pg8 {
#define PG8_LAS __attribute__((address_space(3)))
typedef unsigned short bf16_t;
typedef short bf16x8 __attribute__((ext_vector_type(8)));
typedef float f32x4 __attribute__((ext_vector_type(4)));
typedef unsigned u32x4 __attribute__((ext_vector_type(4)));
constexpr int BM = 256, BK = 64, HALF = 128, HTB = HALF * BK * 2  , STAGE_BYTES = 8 * HTB, NXCD = 8, WGM = 8;

__host__ __device__ __forceinline__ int lds_byte(int r, int c) { const int st = (r >> 4) * 2 + (c >> 5), rr = r & 15, cc = c & 31, ob = rr * 64 + cc * 2; return st * 1024 + (ob ^ (((ob >> 9) & 1) << 5)); }
__host__ __device__ __forceinline__ void stage_rc(int b, int& R, int& C) { const int st = b / 1024, sb = b % 1024, swz = sb ^ (((sb >> 9) & 1) << 5); R = (st >> 1) * 16 + swz / 64; C = (st & 1) * 32 + (swz % 64) / 2; }
__host__ __device__ __forceinline__ int perm32(int rho) { const int n = rho >> 4, i = rho & 15; return 8 * (i >> 2) + 4 * n + (i & 3); }

struct Unit { int pm, pn; };
struct Gemm { const bf16_t* A; const bf16_t* Bt; int M, N, K, lda; };
struct StaticOrder {
    int nM, nN, nwg, G, c, skip;
    __host__ __device__ void init(int M, int N, int G_, int c_, int skip_ = 0) { nM = M / BM; nN = N / BM; nwg = nM * nN; G = G_; c = c_; skip = skip_; }
    __host__ __device__ bool next(int i, Unit& u) const {
        const long L = (long)i * G + c; if (L >= nwg) return false;
        int wgid = (int)L; { const int q = nwg / NXCD, r = nwg % NXCD, xcd = wgid % NXCD, off = wgid / NXCD; wgid = (xcd < r ? xcd * (q + 1) : r * (q + 1) + (xcd - r) * q) + off; }
        const int nig = WGM * nN, gid = wgid / nig, fm = gid * WGM, gsz = (nM - fm) < WGM ? (nM - fm) : WGM;
        u.pm = fm + ((wgid % nig) % gsz); u.pn = (wgid % nig) / gsz;
        if (skip) u.pm = (u.pm >> 4) * 17 + 1 + (u.pm & 15);
        return true;
    }
    __device__ __forceinline__ void a_ready(const Unit&) const {}
    __device__ __forceinline__ void done(const Unit&) const {}
};
__device__ __forceinline__ unsigned cvt_pk_bf16(float lo, float hi) { unsigned r; asm volatile("v_cvt_pk_bf16_f32 %0, %1, %2" : "=v"(r) : "v"(lo), "v"(hi)); return r; }
template <class Epi, class Sched, bool STAMP = false>
__device__ __forceinline__ void gemm_phase(PG8_LAS unsigned char* lds, const Gemm g, const Sched& S, const Epi& E, unsigned long long* stamps) {
    const int tid = TIDX, wid = __builtin_amdgcn_readfirstlane(tid >> 6), lane = tid & 63, wr = wid >> 2, wc = wid & 3, fr = lane & 15, fq = lane >> 4;
    const int K = g.K, nt = K / BK;
    int ts_lo = 0, ts_hi = 0, nts = 0; const unsigned long long rt_entry = STAMP ? (unsigned long long)wall_clock64() : 0ull;
#define PG8_STAMP() do { if (STAMP && wid == 0 && nts < 64) { const unsigned long long _c = (unsigned long long)clock64(); \
        ts_lo = (lane == nts) ? (int)(unsigned)_c : ts_lo; ts_hi = (lane == nts) ? (int)(unsigned)(_c >> 32) : ts_hi; ++nts; } } while (0)
    PG8_STAMP();
    unsigned voffA[2], voffB[2];
#pragma unroll
    for (int i = 0; i < 2; ++i) { int R, C; stage_rc(tid * 16 + i * 8192, R, C); const int Rb = Epi::PERM ? ((R & ~31) + perm32(R & 31)) : R;
        voffA[i] = (unsigned)(R * g.lda + C) * 2u; voffB[i] = (unsigned)(Rb * K + C) * 2u; }
    const size_t kstep = (size_t)(BK * 2);
    const size_t hstepB = (size_t)HALF * K * 2, hstepA = (size_t)HALF * g.lda * 2;
    const size_t tstepB = 2 * hstepB, tstepA = 2 * hstepA;
    const unsigned ldsw = (unsigned)wid * 1024u;
    const int aoff = lds_byte(wr * 64 + fr, fq * 8), boff = lds_byte(wc * 32 + fr, fq * 8);
#define PG8_SA(b, h) (((b) * 2 + (h)) * HTB)
#define PG8_SB(b, h) ((4 + (b) * 2 + (h)) * HTB)
#define PG8_STAGE(bufoff, gbase, voff) do { _Pragma("unroll") for (int _i = 0; _i < 2; ++_i) \
        __builtin_amdgcn_global_load_lds((const unsigned*)((const char*)(gbase) + (voff)[_i]), (PG8_LAS unsigned*)(lds + (bufoff) + ldsw + _i * 8192), 16, 0, 0); } while (0)
#define PG8_LDA(dst, b, h) do { _Pragma("unroll") for (int m = 0; m < 4; ++m) _Pragma("unroll") for (int k = 0; k < 2; ++k) dst[m][k] = *(const PG8_LAS bf16x8*)(lds + PG8_SA(b, h) + aoff + m * 2048 + k * 1024); } while (0)
#define PG8_LDB(dst, b, h) do { _Pragma("unroll") for (int n = 0; n < 2; ++n) _Pragma("unroll") for (int k = 0; k < 2; ++k) dst[n][k] = *(const PG8_LAS bf16x8*)(lds + PG8_SB(b, h) + boff + n * 2048 + k * 1024); } while (0)
#define PG8_MMA(ai, bj, At, Bt) do { __builtin_amdgcn_s_setprio(1); _Pragma("unroll") for (int m = 0; m < 4; ++m) _Pragma("unroll") for (int n = 0; n < 2; ++n) _Pragma("unroll") for (int k = 0; k < 2; ++k) \
        acc[ai][bj][m][n] = __builtin_amdgcn_mfma_f32_16x16x32_bf16(Bt[n][k], At[m][k], acc[ai][bj][m][n], 0, 0, 0); __builtin_amdgcn_s_setprio(0); } while (0)
#define PG8_WAIT_V(n) asm volatile("s_waitcnt vmcnt(" #n ")" ::: "memory")
#define PG8_WAIT_L(n) asm volatile("s_waitcnt lgkmcnt(" #n ")" ::: "memory")
#define PG8_BAR __builtin_amdgcn_s_barrier()
#define PG8_SCHED __builtin_amdgcn_sched_barrier(0)
    Unit cur, nxt; int ui = 0;
    if (!S.next(0, cur)) return;
    f32x4 acc[2][2][4][2];
#pragma unroll
    for (int a = 0; a < 2; ++a)
#pragma unroll
        for (int b = 0; b < 2; ++b)
#pragma unroll
            for (int m = 0; m < 4; ++m)
#pragma unroll
                for (int n = 0; n < 2; ++n) acc[a][b][m][n] = (f32x4){0.f, 0.f, 0.f, 0.f};
    bf16x8 At[4][2], B0[2][2], B1[2][2];
    const char* cA = (const char*)g.A + (size_t)cur.pm * tstepA; const char* cB = (const char*)g.Bt + (size_t)cur.pn * tstepB;
    S.a_ready(cur);
    PG8_STAGE(PG8_SB(0, 0), cB, voffB); PG8_STAGE(PG8_SA(0, 0), cA, voffA); PG8_STAGE(PG8_SB(0, 1), cB + hstepB, voffB); PG8_STAGE(PG8_SA(0, 1), cA + hstepA, voffA);
    if (wr == 1) PG8_BAR;
    PG8_WAIT_V(4); PG8_BAR;
    PG8_STAGE(PG8_SB(1, 0), cB + kstep, voffB); PG8_STAGE(PG8_SA(1, 0), cA + kstep, voffA); PG8_STAGE(PG8_SB(1, 1), cB + hstepB + kstep, voffB);
    PG8_WAIT_V(6); PG8_BAR;
    PG8_STAMP();
    for (;;) {
        const bool has_next = S.next(ui + 1, nxt);
        const char* nA = has_next ? (const char*)g.A + (size_t)nxt.pm * tstepA : cA; const char* nB = has_next ? (const char*)g.Bt + (size_t)nxt.pn * tstepB : cB;
        for (int t = 0; t < nt; t += 2) {
            const bool last = (t == nt - 2);
            const char* a1 = cA + (size_t)(t + 1) * kstep;
            const char* a2 = last ? nA : cA + (size_t)(t + 2) * kstep; const char* b2 = last ? nB : cB + (size_t)(t + 2) * kstep;
            const char* a3 = a2 + kstep; const char* b3 = b2 + kstep;
            if (last && has_next) S.a_ready(nxt);
            PG8_LDB(B0, 0, 0); PG8_SCHED; PG8_LDA(At, 0, 0); PG8_STAGE(PG8_SA(1, 1), a1 + hstepA, voffA);
            PG8_WAIT_L(8); PG8_BAR; PG8_WAIT_L(0); PG8_MMA(0, 0, At, B0); PG8_BAR; PG8_SCHED;
            PG8_LDB(B1, 0, 1); PG8_STAGE(PG8_SB(0, 0), b2, voffB);
            PG8_BAR; PG8_WAIT_L(0); PG8_MMA(0, 1, At, B1); PG8_BAR;
            PG8_LDA(At, 0, 1); PG8_STAGE(PG8_SA(0, 0), a2, voffA);
            PG8_BAR; PG8_WAIT_L(0); PG8_MMA(1, 0, At, B0); PG8_BAR; PG8_SCHED;
            PG8_STAGE(PG8_SB(0, 1), b2 + hstepB, voffB);
            PG8_WAIT_V(6); PG8_BAR; PG8_MMA(1, 1, At, B1); PG8_BAR;
            PG8_LDB(B0, 1, 0); PG8_SCHED; PG8_LDA(At, 1, 0); PG8_STAGE(PG8_SA(0, 1), a2 + hstepA, voffA);
            PG8_WAIT_L(8); PG8_BAR; PG8_WAIT_L(0); PG8_MMA(0, 0, At, B0); PG8_BAR; PG8_SCHED;
            PG8_LDB(B1, 1, 1); PG8_STAGE(PG8_SB(1, 0), b3, voffB);
            PG8_BAR; PG8_WAIT_L(0); PG8_MMA(0, 1, At, B1); PG8_BAR;
            PG8_LDA(At, 1, 1); PG8_STAGE(PG8_SA(1, 0), a3, voffA);
            PG8_BAR; PG8_WAIT_L(0); PG8_MMA(1, 0, At, B0); PG8_BAR; PG8_SCHED;
            PG8_STAGE(PG8_SB(1, 1), b3 + hstepB, voffB);
            PG8_WAIT_V(6); PG8_BAR; PG8_MMA(1, 1, At, B1); PG8_BAR;
        }
        PG8_STAMP();
        if constexpr (!Epi::AFTER_DRAIN) { E(acc, cur, wr, wc, fr, fq); S.done(cur); }
        PG8_STAMP();
        if (!has_next) break;
#pragma unroll
        for (int a = 0; a < 2; ++a)
#pragma unroll
            for (int b = 0; b < 2; ++b)
#pragma unroll
                for (int m = 0; m < 4; ++m)
#pragma unroll
                    for (int n = 0; n < 2; ++n) acc[a][b][m][n] = (f32x4){0.f, 0.f, 0.f, 0.f};
        cur = nxt; cA = nA; cB = nB; ++ui;
    }
    PG8_WAIT_V(0);
    if (wr == 0) PG8_BAR;
    PG8_BAR;
    if constexpr (Epi::AFTER_DRAIN) { E.fused(acc, cur, wr, wc, fr, fq, lds, wid, lane); S.done(cur); }
    PG8_STAMP();
    if (STAMP && wid == 0) { stamps[lane] = lane < nts ? (((unsigned long long)(unsigned)ts_hi << 32) | (unsigned)ts_lo) : 0ull;
        if (lane == 62) stamps[62] = rt_entry; if (lane == 63) stamps[63] = (unsigned long long)wall_clock64(); }
#undef PG8_STAMP
#undef PG8_SA
#undef PG8_SB
#undef PG8_STAGE
#undef PG8_LDA
#undef PG8_LDB
#undef PG8_MMA
#undef PG8_WAIT_V
#undef PG8_WAIT_L
#undef PG8_BAR
#undef PG8_SCHED
}
}

struct EpiBf {
  static constexpr bool PERM = true, AFTER_DRAIN = false;
  u16* O; int ldc; const float* bias; int act;
  __device__ __forceinline__ void operator()(const f32x4 (&acc)[2][2][4][2], const pg8::Unit& u, int wr, int wc, int fr, int fq) const {
    const int row0 = u.pm * 256 + wr * 64 + fr, col0 = u.pn * 256 + wc * 32 + 8 * fq;
    f32x4 bv[2][2];
#pragma unroll
    for (int bj = 0; bj < 2; ++bj)
#pragma unroll
      for (int n = 0; n < 2; ++n) bv[bj][n] = bias ? *(const f32x4*)(bias + col0 + bj * 128 + 4 * n) : f32x4{0.f, 0.f, 0.f, 0.f};
#pragma unroll
    for (int ai = 0; ai < 2; ++ai)
#pragma unroll
      for (int m = 0; m < 4; ++m) {
        u16* rowp = O + (size_t)(row0 + ai * 128 + m * 16) * ldc + col0;
#pragma unroll
        for (int bj = 0; bj < 2; ++bj) {
          f32x4 v0 = acc[ai][bj][m][0] + bv[bj][0], v1 = acc[ai][bj][m][1] + bv[bj][1];
          if (act == 1) {
#pragma unroll
            for (int j = 0; j < 4; ++j) { v0[j] = sigm(v0[j]); v1[j] = sigm(v1[j]); }
          }
          uint4 wv;
          wv.x = pack2(v0[0], v0[1]); wv.y = pack2(v0[2], v0[3]); wv.z = pack2(v1[0], v1[1]); wv.w = pack2(v1[2], v1[3]);
          *(uint4*)(rowp + bj * 128) = wv;
        }
      }
  }
};
struct EpiSwiglu {
  static constexpr bool PERM = true, AFTER_DRAIN = false;
  u16* O;
  __device__ __forceinline__ void operator()(const f32x4 (&acc)[2][2][4][2], const pg8::Unit& u, int wr, int wc, int fr, int fq) const {
    const int row0 = u.pm * 256 + wr * 64 + fr, col0 = u.pn * 128 + wc * 16 + 4 * fq;
#pragma unroll
    for (int ai = 0; ai < 2; ++ai)
#pragma unroll
      for (int m = 0; m < 4; ++m) {
        u16* rowp = O + (size_t)(row0 + ai * 128 + m * 16) * FH + col0;
#pragma unroll
        for (int bj = 0; bj < 2; ++bj) {
          const f32x4 g = acc[ai][bj][m][0], up = acc[ai][bj][m][1];
          uint2 wv;
          wv.x = pack2(siluf(g[0]) * up[0], siluf(g[1]) * up[1]);
          wv.y = pack2(siluf(g[2]) * up[2], siluf(g[3]) * up[3]);
          *(uint2*)(rowp + bj * 64) = wv;
        }
      }
  }
};
struct EpiGateAcc {
  static constexpr bool PERM = true, AFTER_DRAIN = false;
  u16* ACC; const u16* G; int gcol; unsigned amask;
  __device__ __forceinline__ void operator()(const f32x4 (&acc)[2][2][4][2], const pg8::Unit& u, int wr, int wc, int fr, int fq) const {
    unsigned pk[2][2][4][4];
#pragma unroll
    for (int ai = 0; ai < 2; ++ai)
#pragma unroll
      for (int bj = 0; bj < 2; ++bj)
#pragma unroll
        for (int m = 0; m < 4; ++m) {
          pk[ai][bj][m][0] = pack2(acc[ai][bj][m][0][0], acc[ai][bj][m][0][1]);
          pk[ai][bj][m][1] = pack2(acc[ai][bj][m][0][2], acc[ai][bj][m][0][3]);
          pk[ai][bj][m][2] = pack2(acc[ai][bj][m][1][0], acc[ai][bj][m][1][1]);
          pk[ai][bj][m][3] = pack2(acc[ai][bj][m][1][2], acc[ai][bj][m][1][3]);
        }
    asm volatile("" ::: "memory");
    const int row0 = u.pm * 256 + wr * 64 + fr, col0 = u.pn * 256 + wc * 32 + 8 * fq;
#pragma unroll
    for (int ai = 0; ai < 2; ++ai)
#pragma unroll
      for (int m = 0; m < 4; ++m) {
        const size_t row = (size_t)(row0 + ai * 128 + m * 16);
#pragma unroll
        for (int bj = 0; bj < 2; ++bj) {
          const int col = col0 + bj * 128;
          const uint4 gv = *(const uint4*)(G + row * 2048 + gcol + col);
          const uint4 av = *(const uint4*)(ACC + row * DM + col);
          const unsigned gw[4] = {gv.x, gv.y, gv.z, gv.w};
          const unsigned aw[4] = {av.x & amask, av.y & amask, av.z & amask, av.w & amask};
          unsigned ow[4];
#pragma unroll
          for (int q = 0; q < 4; ++q) {
            const unsigned pv = pk[ai][bj][m][q];
            const float lo = __uint_as_float(aw[q] << 16) + __uint_as_float(gw[q] << 16) * __uint_as_float(pv << 16);
            const float hi = __uint_as_float(aw[q] & 0xffff0000u) + __uint_as_float(gw[q] & 0xffff0000u) * __uint_as_float(pv & 0xffff0000u);
            ow[q] = pack2(lo, hi);
          }
          *(uint4*)(ACC + row * DM + col) = make_uint4(ow[0], ow[1], ow[2], ow[3]);
        }
        asm volatile("" ::: "memory");
      }
  }
};

template <int MI>
__device__ __forceinline__ void gemm_loop(const u16* __restrict__ A, int lda, const u16* __restrict__ Bt, int ldb, int K,
                                          f32x4 (&acc)[MI][4], u16* sA, u16* sB) {
  constexpr int BMT = MI * 64;
  const int tid = TIDX, lane = tid & 63, w = tid >> 6, wm = w >> 1, wn = w & 1, fr = lane & 15, fq = lane >> 4;
  uint4 ra[MI], rb[2];
  const u16* ga = A + (size_t)(tid >> 3) * lda + (tid & 7) * 8;
  const u16* gb = Bt + (size_t)(tid >> 3) * ldb + (tid & 7) * 8;
  const int so = (tid >> 3) * LDT + (tid & 7) * 8;
#pragma unroll
  for (int i = 0; i < MI; i++) ra[i] = *(const uint4*)(ga + (size_t)(i * 64) * lda);
#pragma unroll
  for (int i = 0; i < 2; i++) rb[i] = *(const uint4*)(gb + (size_t)(i * 64) * ldb);
#pragma unroll
  for (int i = 0; i < MI; i++) *(uint4*)(sA + so + i * 64 * LDT) = ra[i];
#pragma unroll
  for (int i = 0; i < 2; i++) *(uint4*)(sB + so + i * 64 * LDT) = rb[i];
  __syncthreads();
  const int nk = K >> 6;
  for (int kt = 0; kt < nk; kt++) {
    const bool more = kt + 1 < nk;
    if (more) {
#pragma unroll
      for (int i = 0; i < MI; i++) ra[i] = *(const uint4*)(ga + (size_t)(i * 64) * lda + (kt + 1) * 64);
#pragma unroll
      for (int i = 0; i < 2; i++) rb[i] = *(const uint4*)(gb + (size_t)(i * 64) * ldb + (kt + 1) * 64);
    }
    const u16* a = sA + (kt & 1) * BMT * LDT + (wm * (MI * 16) + fr) * LDT + fq * 8;
    const u16* b = sB + (kt & 1) * 128 * LDT + (wn * 64 + fr) * LDT + fq * 8;
#pragma unroll
    for (int ks = 0; ks < 2; ks++) {
      bf16x8 af[MI], bfr[4];
#pragma unroll
      for (int i = 0; i < MI; i++) af[i] = *(const bf16x8*)(a + i * 16 * LDT + ks * 32);
#pragma unroll
      for (int j = 0; j < 4; j++) bfr[j] = *(const bf16x8*)(b + j * 16 * LDT + ks * 32);
#pragma unroll
      for (int i = 0; i < MI; i++)
#pragma unroll
        for (int j = 0; j < 4; j++) acc[i][j] = __builtin_amdgcn_mfma_f32_16x16x32_bf16(bfr[j], af[i], acc[i][j], 0, 0, 0);
    }
    if (more) {
      u16* da = sA + ((kt + 1) & 1) * BMT * LDT + so;
      u16* db = sB + ((kt + 1) & 1) * 128 * LDT + so;
#pragma unroll
      for (int i = 0; i < MI; i++) *(uint4*)(da + i * 64 * LDT) = ra[i];
#pragma unroll
      for (int i = 0; i < 2; i++) *(uint4*)(db + i * 64 * LDT) = rb[i];
    }
    __syncthreads();
  }
}

template <int MI>
__device__ __forceinline__ void zero_acc(f32x4 (&acc)[MI][4]) {
#pragma unroll
  for (int i = 0; i < MI; i++)
#pragma unroll
    for (int j = 0; j < 4; j++) acc[i][j] = f32x4{0.f, 0.f, 0.f, 0.f};
}


typedef unsigned u32x4v __attribute__((ext_vector_type(4)));
__device__ __forceinline__ void yp_issue(const u16* __restrict__ A, const u16* __restrict__ B, u32x4v (&ra)[8], u32x4v (&rb)[8], int tid) {
#pragma unroll
  for (int i = 0; i < 8; i++) {
    const int c = tid + i * NTHR, row = c >> 5, ch = c & 31;
    ra[i] = *(const u32x4v*)(A + (size_t)row * YST + ch * 8);
    rb[i] = *(const u32x4v*)(B + (size_t)row * 256 + ch * 8);
  }
}
__device__ __forceinline__ void yp_stage(unsigned char* sA, unsigned char* sB, const u32x4v (&ra)[8], const u32x4v (&rb)[8], int tid) {
#pragma unroll
  for (int i = 0; i < 8; i++) {
    const int c = tid + i * NTHR, row = c >> 5, ch = c & 31;
    const int off = row * 512 + ((ch ^ (row & 7)) << 4);
    *(u32x4v*)(sA + off) = ra[i];
    *(u32x4v*)(sB + off) = rb[i];
  }
}
__device__ __forceinline__ void phase_ypart(const Params& p, int l, unsigned char* smem) {
  unsigned char* sA = smem;
  unsigned char* sB = smem + 65536;
  const int tid = TIDX, lane = tid & 63, w = tid >> 6, wm = w >> 1, wn = w & 1, fr = lane & 15, fq = lane >> 4;
  const u16* Y = (const u16*)(p.ws + OFF_YS);
  const u16* Wb = (const u16*)(p.ws + OFF_W + OW_B);
  const u16* G = (const u16*)(p.ws + OFF_BIG);
  u16* ACC = (u16*)(p.ws + OFF_H);
  constexpr int NT = 8;
  const int ntiles = (NROWS / 128) * NT;
  const int G_ = gridDim.x;
  const bool xmap = (G_ == 256);
  const int xj = blockIdx.x >> 3, xx = blockIdx.x & 7;
  const bool skipc = (l == 1);
  const int nrt = skipc ? 256 : 272;
  const int ntl = nrt * NT;
  const int nmine = xmap ? (xj < nrt ? (nrt - 1 - xj) / 32 + 1 : 0)
                         : (((int)blockIdx.x < ntl) ? (ntl - 1 - (int)blockIdx.x) / G_ + 1 : 0);
  if (nmine == 0) return;
#define YP_TILE(Q_, MT_, NT_)                                                        \
  do {                                                                               \
    if (xmap) { const int s_ = (Q_) * 32 + xj; MT_ = (s_ >> 3) * 8 + xx; NT_ = s_ & 7; } \
    else { const int t_ = blockIdx.x + (Q_) * G_; MT_ = t_ / NT; NT_ = t_ - MT_ * NT; }  \
    if (skipc) MT_ = (MT_ >> 5) * 34 + 2 + (MT_ & 31);                                   \
  } while (0)
  u32x4v ra[8], rb[8];
  {
    int mt, nt;
    YP_TILE(0, mt, nt);
    yp_issue(Y + (size_t)mt * 128 * YST, Wb + ((size_t)nt * 128) * 256, ra, rb, tid);
  }
  f32x4 tot[2][4];
  zero_acc<2>(tot);
  for (int qi = 0; qi < 4 * nmine; qi++) {
    const int q = qi >> 2, k = qi & 3;
    int mt, nt;
    YP_TILE(q, mt, nt);
    const int r0 = mt * 128 + wm * 32 + fr, c0 = nt * 128 + wn * 64 + fq * 4;
    __syncthreads();
    yp_stage(sA, sB, ra, rb, tid);
    __syncthreads();
    {
      const int qn = qi + 1 < 4 * nmine ? qi + 1 : qi;
      int mtn, ntn;
      YP_TILE(qn >> 2, mtn, ntn);
      const int brn = qn & 3, ycn = brn < 3 ? brn * 256 : 1536;
      yp_issue(Y + (size_t)mtn * 128 * YST + ycn, Wb + ((size_t)brn * 1024 + ntn * 128) * 256, ra, rb, tid);
    }
    uint2 gv[2][4];
#pragma unroll
    for (int i = 0; i < 2; i++)
#pragma unroll
      for (int j = 0; j < 4; j++) gv[i][j] = *(const uint2*)(G + (size_t)(r0 + i * 16) * 4096 + k * 1024 + c0 + j * 16);
    f32x4 ay[2][4];
    zero_acc<2>(ay);
#pragma unroll 2
    for (int ks = 0; ks < 8; ks++) {
      bf16x8 af[2], bfr[4];
#pragma unroll
      for (int i = 0; i < 2; i++) {
        const int row = wm * 32 + i * 16 + fr;
        af[i] = *(const bf16x8*)(sA + row * 512 + (((ks * 4 + fq) ^ (row & 7)) << 4));
      }
#pragma unroll
      for (int j = 0; j < 4; j++) {
        const int row = wn * 64 + j * 16 + fr;
        bfr[j] = *(const bf16x8*)(sB + row * 512 + (((ks * 4 + fq) ^ (row & 7)) << 4));
      }
#pragma unroll
      for (int i = 0; i < 2; i++)
#pragma unroll
        for (int j = 0; j < 4; j++) ay[i][j] = __builtin_amdgcn_mfma_f32_16x16x32_bf16(bfr[j], af[i], ay[i][j], 0, 0, 0);
    }
#pragma unroll
    for (int i = 0; i < 2; i++)
#pragma unroll
      for (int j = 0; j < 4; j++) {
        tot[i][j][0] += __uint_as_float(gv[i][j].x << 16) * ay[i][j][0];
        tot[i][j][1] += __uint_as_float(gv[i][j].x & 0xffff0000u) * ay[i][j][1];
        tot[i][j][2] += __uint_as_float(gv[i][j].y << 16) * ay[i][j][2];
        tot[i][j][3] += __uint_as_float(gv[i][j].y & 0xffff0000u) * ay[i][j][3];
      }
    if (k == 3) {
#pragma unroll
      for (int i = 0; i < 2; i++)
#pragma unroll
        for (int j = 0; j < 4; j++) {
          uint2 ov;
          ov.x = pack2(tot[i][j][0], tot[i][j][1]); ov.y = pack2(tot[i][j][2], tot[i][j][3]);
          *(uint2*)(ACC + (size_t)(r0 + i * 16) * DM + c0 + j * 16) = ov;
        }
      zero_acc<2>(tot);
    }
  }
  __syncthreads();
#undef YP_TILE
}

#define S2_BUF 10816
#define S2_D 0
#define S2_U 2048
#define S2_P 4096
#define S2_K 6144
#define S2_DQ 8192
#define S2_V 10240
#define S2_C1 10752
#define S2_C2 10784
#define S2_ST (2 * S2_BUF)
#define S2_YB (S2_ST + 8192)

__device__ __forceinline__ float red16(float x) {
  x += dppf<0xB1>(x);
  x += dppf<0x4E>(x);
  x += dppf<0x141>(x);
  x += dppf<0x140>(x);
  return x;
}
__device__ __forceinline__ void wave_lds_sync() {
  asm volatile("s_waitcnt lgkmcnt(0)" ::: "memory");
  __builtin_amdgcn_wave_barrier();
}

template <int MIX>
__device__ __forceinline__ void scan2_item(const Params& p, int l, int b, int h, int dir, int rq, float* sm) {
  constexpr int EPL = (MIX == 2) ? 2 : 4;
  constexpr int VOFF = (MIX == 2) ? 64 : 128;
  const int tid = TIDX, lane = tid & 63, w = tid >> 6, fr = lane & 15, fq = lane >> 4;
  const bool producer = w >= 4;
  const int pw = w & 3;
  const u16* P = (const u16*)(p.ws + OFF_BIG);
  u16* YS = (u16*)(p.ws + OFF_YS);
  float* BC = (float*)(p.ws + OFF_BC);
  float* ST = sm + S2_ST + pw * 2048;
  float s[EPL];
#pragma unroll
  for (int i = 0; i < EPL; i++) s[i] = 0.f;

  bf16x8 bw2[4], ba2[4];
  float cst[5][4];
  float cw[3][7];
  float muv[4];
  int colv[4];
#pragma unroll
  for (int i = 0; i < 4; i++) { bw2[i] = bf16x8{0, 0, 0, 0, 0, 0, 0, 0}; ba2[i] = bw2[i]; muv[i] = 0.f; colv[i] = 0; }
  if (producer) {
    if (MIX == 0) {
#pragma unroll
      for (int nt = 0; nt < 4; nt++) {
        const int jch = h * 64 + nt * 16 + fr;
#pragma unroll
        for (int jj = 0; jj < 8; jj++) {
          bw2[nt][jj] = (short)f2bf(p.rwkv_w2[((size_t)(l * 2 + dir) * 32 + fq * 8 + jj) * 256 + jch]);
          ba2[nt][jj] = (short)f2bf(p.rwkv_a2[((size_t)(l * 2 + dir) * 32 + fq * 8 + jj) * 256 + jch]);
        }
        cst[0][nt] = p.rwkv_w0[(l * 2 + dir) * 256 + jch];
        cst[1][nt] = p.rwkv_a0[(l * 2 + dir) * 256 + jch];
        cst[2][nt] = p.rwkv_ka[l * 256 + jch];
        cst[3][nt] = p.rwkv_kk[l * 256 + jch];
        cst[4][nt] = p.rwkv_rk[l * 256 + jch];
      }
#pragma unroll
      for (int i = 0; i < 4; i++) {
        const int c = lane + 64 * i;
        colv[i] = i < 3 ? i * 256 + h * 64 + lane : (lane < 32 ? 768 + dir * 32 + lane : 832 + dir * 32 + (lane - 32));
        muv[i] = p.rwkv_mu[l * 960 + colv[i]];
        (void)c;
      }
    } else if (MIX == 1) {
#pragma unroll
      for (int i = 0; i < 3; i++) {
        colv[i] = PB + i * 256 + h * 64 + lane;
#pragma unroll
        for (int tp = 0; tp < 7; tp++) cw[i][tp] = p.gdn_conv[((size_t)l * 7 + tp) * 768 + i * 256 + h * 64 + lane];
      }
    } else {
#pragma unroll
      for (int nt = 0; nt < 2; nt++) {
#pragma unroll
        for (int jj = 0; jj < 8; jj++)
          bw2[nt][jj] = fq < 2 ? (short)f2bf(p.gla_gw2[((size_t)(l * 2 + dir) * 16 + fq * 8 + jj) * 128 + h * 32 + nt * 16 + fr]) : (short)0;
        cst[0][nt] = p.gla_gb[(l * 2 + dir) * 128 + h * 32 + nt * 16 + fr];
      }
      colv[0] = PC + h * 32 + lane;
      if (lane >= 32) colv[0] = PC + 128 + h * 32 + (lane - 32);
      colv[1] = PC + 256 + h * 64 + lane;
      colv[2] = PC + 512 + dir * 16 + (lane & 15);
    }
  }
  __syncthreads();

  for (int c = 0; c <= TPB / 32 + 1; c++) {
    if (producer) {
      if (c >= 2) {
        const int cc = c - 2;
        int seg_row0, t_lo;
        if (cc < 8) { seg_row0 = b * TPB; t_lo = dir == 0 ? cc * 32 : (LC - 32 - cc * 32); }
        else { seg_row0 = b * TPB + LC; t_lo = dir == 0 ? (cc - 8) * 32 : (SEQ - 32 - (cc - 8) * 32); }
        const float* yb = sm + S2_YB + (cc & 1) * 512;
        const int t2 = tid - 256;
#pragma unroll
        for (int i = 0; i < 2; i++) {
          const int idx = t2 + i * 256, tt = idx >> 4, e = idx & 15;
          YS[(size_t)(seg_row0 + t_lo + tt) * YST + dir * 768 + MIX * 256 + h * 64 + rq * 16 + e] = f2bf(yb[idx]);
        }
      }
      if (c < TPB / 32) {
        int seg_row0, seg_len, t_lo;
        if (c < 8) { seg_row0 = b * TPB; seg_len = LC; t_lo = dir == 0 ? c * 32 : (LC - 32 - c * 32); }
        else { seg_row0 = b * TPB + LC; seg_len = SEQ; t_lo = dir == 0 ? (c - 8) * 32 : (SEQ - 32 - (c - 8) * 32); }
        const u16* Pseg = P + (size_t)seg_row0 * PST;
        float* B = sm + (c & 1) * S2_BUF;
        const int t0 = t_lo + pw * 8;
        if (MIX == 0) {
          float raw[10][4];
#pragma unroll
          for (int rr = 0; rr < 10; rr++) {
            const int t = t0 - 1 + rr;
            const float okf = (t >= 0 && t < seg_len) ? 1.f : 0.f;
            const int tc = min(max(t, 0), seg_len - 1);
#pragma unroll
            for (int i = 0; i < 4; i++) raw[rr][i] = bf2f(Pseg[(size_t)tc * PST + PA + colv[i]]) * okf;
          }
#pragma unroll
          for (int j = 0; j < 8; j++)
#pragma unroll
            for (int i = 0; i < 4; i++) {
              float xm = raw[j + 1][i] + (0.5f * (raw[j][i] + raw[j + 2][i]) - raw[j + 1][i]) * muv[i];
              if (i == 3 && lane < 32) xm = tanh_fast(xm);
              ST[j * 256 + lane + 64 * i] = xm;
            }
        } else if (MIX == 1) {
          float raw[14][3];
#pragma unroll
          for (int rr = 0; rr < 14; rr++) {
            const int t = t0 - 3 + rr;
            const float okf = (t >= 0 && t < seg_len) ? 1.f : 0.f;
            const int tc = min(max(t, 0), seg_len - 1);
#pragma unroll
            for (int i = 0; i < 3; i++) raw[rr][i] = bf2f(Pseg[(size_t)tc * PST + colv[i]]) * okf;
          }
#pragma unroll
          for (int j = 0; j < 8; j++)
#pragma unroll
            for (int i = 0; i < 3; i++) {
              float a = 0.f;
#pragma unroll
              for (int tp = 0; tp < 7; tp++) a += raw[j + tp][i] * cw[i][tp];
              ST[j * 256 + lane + 64 * i] = siluf(a);
            }
          if (lane < 8) {
            const u16* pp = Pseg + (size_t)(t0 + lane) * PST + PB;
            float bx = bf2f(pp[768 + dir * 4 + h]);
            float ax = bf2f(pp[776 + dir * 4 + h]);
            float ld = -__expf(p.gdn_a_log[(l * 2 + dir) * 4 + h]) * softplusf(ax + p.gdn_dt_bias[(l * 2 + dir) * 4 + h]);
            ST[lane * 256 + 192] = sigm(bx);
            ST[lane * 256 + 193] = __expf(ld);
          }
        } else {
          u16 raw[8][3];
#pragma unroll
          for (int j = 0; j < 8; j++) {
            const u16* pp = Pseg + (size_t)(t0 + j) * PST;
#pragma unroll
            for (int i = 0; i < 3; i++) raw[j][i] = pp[colv[i]];
          }
          const float qs = lane < 32 ? 0.17677669529663687f : 1.f;
#pragma unroll
          for (int j = 0; j < 8; j++) {
            ST[j * 256 + lane] = bf2f(raw[j][0]) * qs;
            ST[j * 256 + 64 + lane] = bf2f(raw[j][1]);
            if (lane < 16) ST[j * 256 + 128 + lane] = bf2f(raw[j][2]);
          }
        }
        wave_lds_sync();
        const bool vl = fq < 2;
        if (MIX == 0) {
          bf16x8 aw, aa;
#pragma unroll
          for (int jj = 0; jj < 8; jj++) {
            aw[jj] = fr < 8 ? (short)f2bf(ST[fr * 256 + 192 + fq * 8 + jj]) : (short)0;
            aa[jj] = fr < 8 ? (short)f2bf(ST[fr * 256 + 224 + fq * 8 + jj]) : (short)0;
          }
          f32x4 accw[4], acca[4];
#pragma unroll
          for (int nt = 0; nt < 4; nt++) {
            accw[nt] = __builtin_amdgcn_mfma_f32_16x16x32_bf16(aw, bw2[nt], f32x4{0.f, 0.f, 0.f, 0.f}, 0, 0, 0);
            acca[nt] = __builtin_amdgcn_mfma_f32_16x16x32_bf16(aa, ba2[nt], f32x4{0.f, 0.f, 0.f, 0.f}, 0, 0, 0);
          }
#pragma unroll
          for (int r = 0; r < 4; r++) {
            const int j = (fq & 1) * 4 + r, tt = pw * 8 + j;
            float kkx[4], av[4], kdv[4], rv[4], dec[4];
            float ss = 0.f;
#pragma unroll
            for (int nt = 0; nt < 4; nt++) {
              const int n = nt * 16 + fr;
              rv[nt] = ST[j * 256 + n];
              const float kx = ST[j * 256 + 64 + n];
              dec[nt] = __expf(-0.6065306597126334f * sigm(cst[0][nt] + accw[nt][r]));
              av[nt] = sigm(cst[1][nt] + acca[nt][r]);
              kdv[nt] = kx * (1.f + (av[nt] - 1.f) * cst[2][nt]);
              kkx[nt] = kx * cst[3][nt];
              ss += kkx[nt] * kkx[nt];
            }
            ss = red16(ss);
            const float rs = rsq(ss + 1e-6f);
            float c1 = 0.f, c2 = 0.f, bc = 0.f;
#pragma unroll
            for (int nt = 0; nt < 4; nt++) {
              const int n = nt * 16 + fr;
              const float kk = kkx[nt] * rs;
              if (vl) {
                B[S2_D + tt * 64 + n] = dec[nt];
                B[S2_U + tt * 64 + n] = kk;
                B[S2_P + tt * 64 + n] = -kk * av[nt];
                B[S2_K + tt * 64 + n] = kdv[nt];
                B[S2_DQ + tt * 64 + n] = dec[nt] * rv[nt];
              }
              c1 += -kk * av[nt] * rv[nt];
              c2 += kdv[nt] * rv[nt];
              bc += rv[nt] * kdv[nt] * cst[4][nt];
            }
            c1 = red16(c1); c2 = red16(c2); bc = red16(bc);
            if (vl && fr == 0) {
              B[S2_C1 + tt] = c1;
              B[S2_C2 + tt] = c2;
              if (rq == 0) BC[(size_t)(seg_row0 + t_lo + tt) * 8 + h * 2 + dir] = bc;
            }
          }
        } else if (MIX == 1) {
#pragma unroll
          for (int r = 0; r < 4; r++) {
            const int j = (fq & 1) * 4 + r, tt = pw * 8 + j;
            float qv[4], kv[4];
            float sq = 0.f, sk = 0.f;
#pragma unroll
            for (int nt = 0; nt < 4; nt++) {
              const int n = nt * 16 + fr;
              qv[nt] = ST[j * 256 + n];
              kv[nt] = ST[j * 256 + 64 + n];
              sq += qv[nt] * qv[nt];
              sk += kv[nt] * kv[nt];
            }
            sq = red16(sq); sk = red16(sk);
            const float rq_ = rsq(sq + 1e-6f) * 0.125f, rk_ = rsq(sk + 1e-6f);
            const float beta = ST[j * 256 + 192], alpha = ST[j * 256 + 193];
            float dkq = 0.f;
#pragma unroll
            for (int nt = 0; nt < 4; nt++) {
              const int n = nt * 16 + fr;
              const float qn = qv[nt] * rq_, kn = kv[nt] * rk_;
              if (vl) {
                B[S2_D + tt * 64 + n] = alpha;
                B[S2_U + tt * 64 + n] = kn;
                B[S2_P + tt * 64 + n] = -alpha * beta * kn;
                B[S2_K + tt * 64 + n] = beta * kn;
                B[S2_DQ + tt * 64 + n] = alpha * qn;
              }
              dkq += kn * qn;
            }
            dkq = red16(dkq);
            if (vl && fr == 0) {
              B[S2_C1 + tt] = -alpha * beta * dkq;
              B[S2_C2 + tt] = beta * dkq;
            }
          }
        } else {
          bf16x8 ag;
#pragma unroll
          for (int jj = 0; jj < 8; jj++) ag[jj] = (fr < 8 && fq < 2) ? (short)f2bf(ST[fr * 256 + 128 + fq * 8 + jj]) : (short)0;
          f32x4 accg[2];
#pragma unroll
          for (int nt = 0; nt < 2; nt++) accg[nt] = __builtin_amdgcn_mfma_f32_16x16x32_bf16(ag, bw2[nt], f32x4{0.f, 0.f, 0.f, 0.f}, 0, 0, 0);
#pragma unroll
          for (int r = 0; r < 4; r++) {
            const int j = (fq & 1) * 4 + r, tt = pw * 8 + j;
            float dkq = 0.f;
#pragma unroll
            for (int nt = 0; nt < 2; nt++) {
              const int n = nt * 16 + fr;
              const float lg = cst[0][nt] + accg[nt][r];
              const float ls = fminf(lg, 0.f) - __logf(1.f + __expf(-fabsf(lg)));
              const float alpha = __expf(ls * (1.f / 16.f));
              const float qv = ST[j * 256 + n], kv = ST[j * 256 + 32 + n];
              if (vl) {
                B[S2_D + tt * 64 + n] = alpha;
                B[S2_K + tt * 64 + n] = kv;
                B[S2_DQ + tt * 64 + n] = alpha * qv;
              }
              dkq += kv * qv;
            }
            dkq = red16(dkq);
            if (vl && fr == 0) B[S2_C2 + tt] = dkq;
          }
        }
#pragma unroll
        for (int i = 0; i < 2; i++) {
          const int idx = lane + 64 * i, j = idx >> 4, e = idx & 15;
          B[S2_V + (pw * 8 + j) * 16 + e] = ST[j * 256 + VOFF + rq * 16 + e];
        }
      }
    } else if (c >= 1 && c <= TPB / 32) {
      const float* B = sm + ((c - 1) & 1) * S2_BUF;
      float* yb = sm + S2_YB + ((c - 1) & 1) * 512;
      const int rl = w * 4 + fq;
      const int dtt = dir ? -1 : 1;
      int tt = dir ? 31 : 0;
      float dv[EPL], kv[EPL], qv[EPL], uv[EPL], pv[EPL], vv, c1v, c2v;
      float dn[EPL], kn[EPL], qn[EPL], un[EPL], pn[EPL], vn, c1n, c2n;
#define S2_LOAD(D_, K_, Q_, U_, P_, V_, C1_, C2_, T_)                                   \
  do {                                                                                  \
    const int o_ = (T_) * 64 + fr * EPL;                                                \
    if (EPL == 4) {                                                                     \
      float4 t4 = *(const float4*)(B + S2_D + o_);                                      \
      D_[0] = t4.x; D_[1] = t4.y; D_[2] = t4.z; D_[3] = t4.w;                           \
      t4 = *(const float4*)(B + S2_K + o_);                                             \
      K_[0] = t4.x; K_[1] = t4.y; K_[2] = t4.z; K_[3] = t4.w;                           \
      t4 = *(const float4*)(B + S2_DQ + o_);                                            \
      Q_[0] = t4.x; Q_[1] = t4.y; Q_[2] = t4.z; Q_[3] = t4.w;                           \
      t4 = *(const float4*)(B + S2_U + o_);                                             \
      U_[0] = t4.x; U_[1] = t4.y; U_[2] = t4.z; U_[3] = t4.w;                           \
      t4 = *(const float4*)(B + S2_P + o_);                                             \
      P_[0] = t4.x; P_[1] = t4.y; P_[2] = t4.z; P_[3] = t4.w;                           \
      C1_ = B[S2_C1 + (T_)];                                                            \
    } else {                                                                            \
      float2 t2 = *(const float2*)(B + S2_D + o_);                                      \
      D_[0] = t2.x; D_[1] = t2.y;                                                       \
      t2 = *(const float2*)(B + S2_K + o_);                                             \
      K_[0] = t2.x; K_[1] = t2.y;                                                       \
      t2 = *(const float2*)(B + S2_DQ + o_);                                            \
      Q_[0] = t2.x; Q_[1] = t2.y;                                                       \
      U_[0] = U_[1] = P_[0] = P_[1] = 0.f; C1_ = 0.f;                                   \
    }                                                                                   \
    V_ = B[S2_V + (T_) * 16 + rl];                                                      \
    C2_ = B[S2_C2 + (T_)];                                                              \
  } while (0)
#define S2_STEP(D_, K_, Q_, U_, P_, V_, C1_, C2_, T_)                                   \
  do {                                                                                  \
    float sq = 0.f, sa = 0.f;                                                           \
    _Pragma("unroll") for (int i = 0; i < EPL; i++) sq += s[i] * Q_[i];                 \
    if (MIX != 2) {                                                                     \
      _Pragma("unroll") for (int i = 0; i < EPL; i++) sa += s[i] * U_[i];               \
      sa = red16(sa);                                                                   \
    }                                                                                   \
    sq = red16(sq);                                                                     \
    float y = sq + V_ * C2_;                                                            \
    if (MIX != 2) y += sa * C1_;                                                        \
    _Pragma("unroll") for (int i = 0; i < EPL; i++) {                                   \
      float t = s[i] * D_[i] + V_ * K_[i];                                              \
      if (MIX != 2) t += sa * P_[i];                                                    \
      s[i] = t;                                                                         \
    }                                                                                   \
    yb[(T_) * 16 + rl] = y;                                                             \
  } while (0)
      S2_LOAD(dv, kv, qv, uv, pv, vv, c1v, c2v, tt);
#pragma unroll 1
      for (int st = 0; st < 32; st += 2) {
        const int t1 = tt + dtt;
        S2_LOAD(dn, kn, qn, un, pn, vn, c1n, c2n, t1);
        S2_STEP(dv, kv, qv, uv, pv, vv, c1v, c2v, tt);
        const int t2 = st + 2 < 32 ? t1 + dtt : t1;
        S2_LOAD(dv, kv, qv, uv, pv, vv, c1v, c2v, t2);
        S2_STEP(dn, kn, qn, un, pn, vn, c1n, c2n, t1);
        tt = t2;
      }
#undef S2_LOAD
#undef S2_STEP
    }
    __syncthreads();
  }
}

#define S3_SUB 12800
#define S3_GM 0
#define S3_KVT 9216
#define S3_QB 10240
#define S3_QV 11392
#define S3_VT 11520
#define S3_WC 12544
#define S3_STB (8 * S3_SUB)
#define S3_END (S3_STB + 4 * 2304)

__device__ __forceinline__ float rlane(float x, int l) { return __int_as_float(__builtin_amdgcn_readlane(__float_as_int(x), l)); }
__device__ __forceinline__ float wave_sum(float x) {
  x = red16(x);
  return (rlane(x, 0) + rlane(x, 16)) + (rlane(x, 32) + rlane(x, 48));
}
__device__ __forceinline__ float clampe(float x) { return fminf(fmaxf(x, -80.f), 80.f); }
__device__ __forceinline__ uint4 pack8(const float (&v)[8]) {
  return make_uint4(pack2(v[0], v[1]), pack2(v[2], v[3]), pack2(v[4], v[5]), pack2(v[6], v[7]));
}
__device__ __forceinline__ bf16x8 ld_frag(const void* p) { return *(const bf16x8*)p; }
__device__ __forceinline__ bf16x8 zfrag() { return bf16x8{0, 0, 0, 0, 0, 0, 0, 0}; }

__device__ __forceinline__ void chunk_geom(int c, int dir, int b, int& seg_row0, int& seg_len, int& t_lo) {
  if (c < 8) { seg_row0 = b * TPB; seg_len = LC; t_lo = dir == 0 ? c * 32 : (LC - 32 - c * 32); }
  else { seg_row0 = b * TPB + LC; seg_len = SEQ; t_lo = dir == 0 ? (c - 8) * 32 : (SEQ - 32 - (c - 8) * 32); }
}
template <int MIX>
__device__ __forceinline__ void fetch_raw(const u16* P, int c, int dir, int b, int h, int pw, int lane, const int (&colv)[4], unsigned (&rawq)[14][2]) {
  int seg_row0, seg_len, t_lo;
  chunk_geom(c, dir, b, seg_row0, seg_len, t_lo);
  const u16* Pseg = P + (size_t)seg_row0 * PST;
  const int t0 = t_lo + pw * 8;
  if (MIX == 0) {
#pragma unroll
    for (int rr = 0; rr < 10; rr++) {
      const int tc = min(max(t0 - 1 + rr, 0), seg_len - 1);
#pragma unroll
      for (int i = 0; i < 2; i++)
        rawq[rr][i] = (unsigned)Pseg[(size_t)tc * PST + PA + colv[2 * i]] | ((unsigned)Pseg[(size_t)tc * PST + PA + colv[2 * i + 1]] << 16);
    }
  } else if (MIX == 1) {
#pragma unroll
    for (int rr = 0; rr < 14; rr++) {
      const int tc = min(max(t0 - 3 + rr, 0), seg_len - 1);
      rawq[rr][0] = (unsigned)Pseg[(size_t)tc * PST + colv[0]] | ((unsigned)Pseg[(size_t)tc * PST + colv[1]] << 16);
      rawq[rr][1] = (rawq[rr][1] & 0xffff0000u) | (unsigned)Pseg[(size_t)tc * PST + colv[2]];
    }
    const u16* pp = Pseg + (size_t)(t0 + (lane & 7)) * PST + PB;
    rawq[0][1] = (rawq[0][1] & 0xffffu) | ((unsigned)pp[768 + dir * 4 + h] << 16);
    rawq[1][1] = (rawq[1][1] & 0xffffu) | ((unsigned)pp[776 + dir * 4 + h] << 16);
  } else {
#pragma unroll
    for (int j = 0; j < 8; j++) {
      const u16* pp = Pseg + (size_t)(t0 + j) * PST;
      rawq[j][0] = (unsigned)pp[colv[0]] | ((unsigned)pp[colv[1]] << 16);
      rawq[j][1] = (unsigned)pp[colv[2]];
    }
  }
}

template <int MIX>
__device__ __forceinline__ void scan3_item(const Params& p, int l, int b, int h, int dir, unsigned char* smb) {
  constexpr int VOFF = (MIX == 2) ? 64 : 128;
  constexpr bool DELTA = (MIX != 2);
  const int tid = TIDX, lane = tid & 63, w = tid >> 6, fr = lane & 15, fq = lane >> 4;
  const bool producer = true;
  const int pw = w & 3, half = w >> 2;
  const u16* P = (const u16*)(p.ws + OFF_BIG);
  u16* YS = (u16*)(p.ws + OFF_YS);
  float* BC = (float*)(p.ws + OFF_BC);
  float* ST = (float*)(smb + w * S3_SUB + S3_GM);
  unsigned char* STBY = smb + w * S3_SUB + S3_GM;
  const f32x4 z4 = f32x4{0.f, 0.f, 0.f, 0.f};
  f32x4 st[4];
#pragma unroll
  for (int i = 0; i < 4; i++) st[i] = z4;

  bf16x8 bw2[4], ba2[4];
  float cw[3][7];
  float muv[4];
  int colv[4];
  float c_w0 = 0.f, c_a0 = 0.f, c_ka = 0.f, c_kk = 0.f, c_rk = 0.f, c_gb = 0.f;
#pragma unroll
  for (int i = 0; i < 4; i++) { bw2[i] = zfrag(); ba2[i] = zfrag(); muv[i] = 0.f; colv[i] = 0; }
  if (producer) {
    if (MIX == 0) {
      {
        float tw[4][8], ta[4][8];
#pragma unroll
        for (int nt = 0; nt < 4; nt++)
#pragma unroll
          for (int jj = 0; jj < 8; jj++) {
            tw[nt][jj] = p.rwkv_w2[((size_t)(l * 2 + dir) * 32 + fq * 8 + jj) * 256 + h * 64 + nt * 16 + fr];
            ta[nt][jj] = p.rwkv_a2[((size_t)(l * 2 + dir) * 32 + fq * 8 + jj) * 256 + h * 64 + nt * 16 + fr];
          }
#pragma unroll
        for (int nt = 0; nt < 4; nt++)
#pragma unroll
          for (int jj = 0; jj < 8; jj++) { bw2[nt][jj] = (short)f2bf(tw[nt][jj]); ba2[nt][jj] = (short)f2bf(ta[nt][jj]); }
      }
      const int jl = h * 64 + lane;
      c_w0 = p.rwkv_w0[(l * 2 + dir) * 256 + jl];
      c_a0 = p.rwkv_a0[(l * 2 + dir) * 256 + jl];
      c_ka = p.rwkv_ka[l * 256 + jl];
      c_kk = p.rwkv_kk[l * 256 + jl];
      c_rk = p.rwkv_rk[l * 256 + jl];
#pragma unroll
      for (int i = 0; i < 4; i++) {
        colv[i] = i < 3 ? i * 256 + h * 64 + lane : (lane < 32 ? 768 + dir * 32 + lane : 832 + dir * 32 + (lane - 32));
        muv[i] = p.rwkv_mu[l * 960 + colv[i]];
      }
    } else if (MIX == 1) {
#pragma unroll
      for (int i = 0; i < 3; i++) {
        colv[i] = PB + i * 256 + h * 64 + lane;
#pragma unroll
        for (int tp = 0; tp < 7; tp++) cw[i][tp] = p.gdn_conv[((size_t)l * 7 + tp) * 768 + i * 256 + h * 64 + lane];
      }
    } else {
      {
        float tg[2][8];
#pragma unroll
        for (int nt = 0; nt < 2; nt++)
#pragma unroll
          for (int jj = 0; jj < 8; jj++) tg[nt][jj] = p.gla_gw2[((size_t)(l * 2 + dir) * 16 + (fq & 1) * 8 + jj) * 128 + h * 32 + nt * 16 + fr];
#pragma unroll
        for (int nt = 0; nt < 2; nt++)
#pragma unroll
          for (int jj = 0; jj < 8; jj++) bw2[nt][jj] = fq < 2 ? (short)f2bf(tg[nt][jj]) : (short)0;
      }
      c_gb = p.gla_gb[(l * 2 + dir) * 128 + h * 32 + (lane & 31)];
      colv[0] = PC + h * 32 + lane;
      if (lane >= 32) colv[0] = PC + 128 + h * 32 + (lane - 32);
      colv[1] = PC + 256 + h * 64 + lane;
      colv[2] = PC + 512 + dir * 16 + (lane & 15);
    }
  }
  __syncthreads();
  unsigned rawq[14][2];
#pragma unroll
  for (int i = 0; i < 14; i++) { rawq[i][0] = 0u; rawq[i][1] = 0u; }
  fetch_raw<MIX>(P, half, dir, b, h, pw, lane, colv, rawq);
#define RAWP(r_, i_) ((u16)((rawq[r_][(i_) >> 1] >> (((i_) & 1) * 16)) & 0xffffu))

  for (int it = 0; it < TPB / 64; it++) {
    {
      {
        const int c = it * 2 + half;
        int seg_row0, seg_len, t_lo;
        chunk_geom(c, dir, b, seg_row0, seg_len, t_lo);
        unsigned char* SB = smb + w * S3_SUB;
        const int t0 = t_lo + pw * 8;
        if (MIX == 0) {
          float raw[10][4];
#pragma unroll
          for (int rr = 0; rr < 10; rr++) {
            const int t = t0 - 1 + rr;
            const float okf = (t >= 0 && t < seg_len) ? 1.f : 0.f;
#pragma unroll
            for (int i = 0; i < 4; i++) raw[rr][i] = bf2f(RAWP(rr, i)) * okf;
          }
#pragma unroll
          for (int j = 0; j < 8; j++)
#pragma unroll
            for (int i = 0; i < 4; i++) {
              float xm = raw[j + 1][i] + (0.5f * (raw[j][i] + raw[j + 2][i]) - raw[j + 1][i]) * muv[i];
              if (i == 3 && lane < 32) xm = tanh_fast(xm);
              ST[j * 256 + lane + 64 * i] = xm;
            }
        } else if (MIX == 1) {
          float raw[14][3];
#pragma unroll
          for (int rr = 0; rr < 14; rr++) {
            const int t = t0 - 3 + rr;
            const float okf = (t >= 0 && t < seg_len) ? 1.f : 0.f;
#pragma unroll
            for (int i = 0; i < 3; i++) raw[rr][i] = bf2f(RAWP(rr, i)) * okf;
          }
#pragma unroll
          for (int j = 0; j < 8; j++)
#pragma unroll
            for (int i = 0; i < 3; i++) {
              float a = 0.f;
#pragma unroll
              for (int tp = 0; tp < 7; tp++) a += raw[j + tp][i] * cw[i][tp];
              ST[j * 256 + lane + 64 * i] = siluf(a);
            }
          if (lane < 8) {
            float bx = bf2f(RAWP(0, 3));
            float ax = bf2f(RAWP(1, 3));
            float ld = -__expf(p.gdn_a_log[(l * 2 + dir) * 4 + h]) * softplusf(ax + p.gdn_dt_bias[(l * 2 + dir) * 4 + h]);
            ST[lane * 256 + 192] = sigm(bx);
            ST[lane * 256 + 193] = ld;
          }
        } else {
          const float qs = lane < 32 ? 0.17677669529663687f : 1.f;
#pragma unroll
          for (int j = 0; j < 8; j++) {
            ST[j * 256 + lane] = bf2f(RAWP(j, 0)) * qs;
            ST[j * 256 + 64 + lane] = bf2f(RAWP(j, 1));
            if (lane < 16) ST[j * 256 + 128 + lane] = bf2f(RAWP(j, 2));
          }
        }
        wave_lds_sync();
        {
          float vv[8];
#pragma unroll
          for (int i = 0; i < 8; i++) vv[i] = ST[(dir ? 7 - i : i) * 256 + VOFF + lane];
          *(uint4*)(SB + S3_VT + lane * 16) = pack8(vv);
        }
        if (MIX == 0) {
          bf16x8 aw, aa;
#pragma unroll
          for (int jj = 0; jj < 8; jj++) {
            aw[jj] = fr < 8 ? (short)f2bf(ST[fr * 256 + 192 + fq * 8 + jj]) : (short)0;
            aa[jj] = fr < 8 ? (short)f2bf(ST[fr * 256 + 224 + fq * 8 + jj]) : (short)0;
          }
          f32x4 accw[4], acca[4];
#pragma unroll
          for (int nt = 0; nt < 4; nt++) {
            accw[nt] = __builtin_amdgcn_mfma_f32_16x16x32_bf16(aw, bw2[nt], z4, 0, 0, 0);
            acca[nt] = __builtin_amdgcn_mfma_f32_16x16x32_bf16(aa, ba2[nt], z4, 0, 0, 0);
          }
          wave_lds_sync();
          if (fq < 2) {
#pragma unroll
            for (int nt = 0; nt < 4; nt++)
#pragma unroll
              for (int r = 0; r < 4; r++) {
                ST[(fq * 4 + r) * 256 + 128 + nt * 16 + fr] = accw[nt][r];
                ST[(fq * 4 + r) * 256 + 192 + nt * 16 + fr] = acca[nt][r];
              }
          }
          wave_lds_sync();
        } else if (MIX == 2) {
          bf16x8 ag;
#pragma unroll
          for (int jj = 0; jj < 8; jj++) ag[jj] = (fr < 8 && fq < 2) ? (short)f2bf(ST[fr * 256 + 128 + fq * 8 + jj]) : (short)0;
          f32x4 accg[2];
#pragma unroll
          for (int nt = 0; nt < 2; nt++) accg[nt] = __builtin_amdgcn_mfma_f32_16x16x32_bf16(ag, bw2[nt], z4, 0, 0, 0);
          if (fq < 2) {
#pragma unroll
            for (int nt = 0; nt < 2; nt++)
#pragma unroll
              for (int r = 0; r < 4; r++) ST[(fq * 4 + r) * 256 + 192 + nt * 16 + fr] = accg[nt][r];
          }
          wave_lds_sync();
        }
        float logd[8], kap[8], bb[8], kp[8], qq[8];
        if (MIX == 0) {
          float a8[8], p1[8], p2[8];
#pragma unroll
          for (int i = 0; i < 8; i++) {
            const float* row = ST + (dir ? 7 - i : i) * 256;
            const float r_ = row[lane], k_ = row[64 + lane];
            const float sg = sigm(c_w0 + row[128 + lane]);
            a8[i] = sigm(c_a0 + row[192 + lane]);
            kp[i] = k_ * (1.f + (a8[i] - 1.f) * c_ka);
            kap[i] = k_ * c_kk;
            qq[i] = r_;
            logd[i] = -0.6065306597126334f * sg;
            p1[i] = kap[i] * kap[i];
            p2[i] = r_ * kp[i] * c_rk;
          }
#pragma unroll
          for (int i = 0; i < 8; i++) { p1[i] = red16(p1[i]); p2[i] = red16(p2[i]); }
#pragma unroll
          for (int i = 0; i < 8; i++) {
            const float ss = (rlane(p1[i], 0) + rlane(p1[i], 16)) + (rlane(p1[i], 32) + rlane(p1[i], 48));
            const float bc = (rlane(p2[i], 0) + rlane(p2[i], 16)) + (rlane(p2[i], 32) + rlane(p2[i], 48));
            kap[i] *= rsq(ss + 1e-6f);
            bb[i] = kap[i] * a8[i];
            if (lane == 0) BC[(size_t)(seg_row0 + t0 + (dir ? 7 - i : i)) * 8 + h * 2 + dir] = bc;
          }
        } else {
#pragma unroll
        for (int i = 0; i < 8; i++) {
          const int j = dir ? 7 - i : i;
          const float* row = ST + j * 256;
          if (MIX == 1) {
            const float q_ = row[lane], k_ = row[64 + lane];
            const float sq = wave_sum(q_ * q_), sk = wave_sum(k_ * k_);
            const float qn = q_ * rsq(sq + 1e-6f) * 0.125f, kn = k_ * rsq(sk + 1e-6f);
            const float beta = row[192], ld = row[193];
            const float alpha = __expf(ld);
            logd[i] = ld;
            kap[i] = kn; bb[i] = alpha * beta * kn; kp[i] = beta * kn; qq[i] = qn;
          } else {
            const int n = lane & 31;
            const float lg = c_gb + row[192 + n];
            const float ls = fminf(lg, 0.f) - __logf(1.f + __expf(-fabsf(lg)));
            logd[i] = ls * (1.f / 16.f);
            kap[i] = 0.f; bb[i] = 0.f;
            kp[i] = lane < 32 ? row[32 + n] : 0.f;
            qq[i] = lane < 32 ? row[n] : 0.f;
          }
        }
        }
        wave_lds_sync();
        float kt[8], qt[8], bck[8], kck[8];
        {
          float L[8];
          float run = 0.f;
#pragma unroll
          for (int i = 0; i < 8; i++) { run += logd[i]; L[i] = run; }
          const float Lr = L[3], L7 = L[7];
          float prevE = __expf(clampe(-Lr)), prevT = 1.f;
          u16* OPA = (u16*)STBY;
#pragma unroll
          for (int i = 0; i < 8; i++) {
            const float eI = __expf(clampe(L[i] - Lr)), eInv = __expf(clampe(Lr - L[i]));
            const float tI = __expf(L[i]), eEnd = __expf(L7 - L[i]);
            if (DELTA) {
              OPA[0 * 576 + i * 72 + lane] = f2bf(kap[i] * prevE);
              OPA[1 * 576 + i * 72 + lane] = f2bf(bb[i] * eInv);
            }
            OPA[2 * 576 + i * 72 + lane] = f2bf(kp[i] * eInv);
            OPA[3 * 576 + i * 72 + lane] = f2bf(qq[i] * eI);
            kt[i] = kap[i] * prevT; qt[i] = qq[i] * tI;
            bck[i] = bb[i] * eEnd; kck[i] = kp[i] * eEnd;
            prevE = eI; prevT = tI;
          }
          *(float*)(SB + S3_WC + lane * 4) = __expf(L7);
        }
        wave_lds_sync();
        f32x4 accA = z4, accBm = z4, accQb = z4, accQk = z4;
        {
          const u16* OPA = (const u16*)STBY;
          const int ro = (fr & 7) * 72 + fq * 8;
#pragma unroll
          for (int ks = 0; ks < 2; ks++) {
            const bf16x8 fk = ld_frag(OPA + 2 * 576 + ro + ks * 32), fqh = ld_frag(OPA + 3 * 576 + ro + ks * 32);
            accQk = __builtin_amdgcn_mfma_f32_16x16x32_bf16(fqh, fk, accQk, 0, 0, 0);
            if (DELTA) {
              const bf16x8 fka = ld_frag(OPA + 0 * 576 + ro + ks * 32), fb = ld_frag(OPA + 1 * 576 + ro + ks * 32);
              accA = __builtin_amdgcn_mfma_f32_16x16x32_bf16(fka, fb, accA, 0, 0, 0);
              accBm = __builtin_amdgcn_mfma_f32_16x16x32_bf16(fka, fk, accBm, 0, 0, 0);
              accQb = __builtin_amdgcn_mfma_f32_16x16x32_bf16(fqh, fb, accQb, 0, 0, 0);
            }
          }
#pragma unroll
          for (int r = 0; r < 4; r++) {
            const int i = fq * 4 + r;
            const bool ok = fq < 2 && fr < 8;
            if (!(ok && fr < i)) { accA[r] = 0.f; accBm[r] = 0.f; }
            if (!(ok && fr <= i)) { accQb[r] = 0.f; accQk[r] = 0.f; }
          }
        }
        float bmc[8], qkc[8];
#pragma unroll
        for (int m = 0; m < 4; m++) {
          bmc[m] = accBm[m]; qkc[m] = accQk[m];
          bmc[m + 4] = __shfl(accBm[m], (lane & 15) + 16);
          qkc[m + 4] = __shfl(accQk[m], (lane & 15) + 16);
        }
        float kbar[8], qbar[8], Kv[8], TB[8], Qv[8];
        if (DELTA) {
          float t[8];
#pragma unroll
          for (int i = 0; i < 8; i++) {
            float ti = (lane == i) ? 1.f : 0.f;
#pragma unroll
            for (int m = 0; m < i; m++) ti -= rlane(accA[i & 3], (i >> 2) * 16 + m) * t[m];
            t[i] = ti;
          }
#pragma unroll
          for (int i = 0; i < 8; i++) {
            float tb = 0.f, kb = 0.f;
#pragma unroll
            for (int m = 0; m <= i; m++) {
              const float tim = rlane(t[i], m);
              tb += tim * bmc[m];
              kb += tim * kt[m];
            }
            TB[i] = tb; kbar[i] = kb;
            float qv = qkc[i], qb = qt[i];
#pragma unroll
            for (int m = 0; m <= i; m++) {
              const float qbim = rlane(accQb[i & 3], (i >> 2) * 16 + m);
              qv -= qbim * TB[m];
              qb -= qbim * kbar[m];
            }
            Qv[i] = qv; qbar[i] = qb;
          }
#pragma unroll
          for (int j = 0; j < 8; j++) Kv[j] = kck[j];
#pragma unroll
          for (int i = 1; i < 8; i++)
#pragma unroll
            for (int j = 0; j < i; j++) Kv[j] -= rlane(TB[i], j) * bck[i];
        } else {
#pragma unroll
          for (int i = 0; i < 8; i++) { Qv[i] = qkc[i]; qbar[i] = qt[i]; Kv[i] = kck[i]; kbar[i] = 0.f; TB[i] = 0.f; }
        }
        *(uint4*)(SB + S3_KVT + lane * 16) = pack8(Kv);
#pragma unroll
        for (int i = 0; i < 8; i++) ((u16*)(SB + S3_QB))[i * 72 + lane] = f2bf(qbar[i]);
        if (lane < 8) {
#pragma unroll
          for (int i = 0; i < 8; i++) ((u16*)(SB + S3_QV))[i * 8 + lane] = f2bf(Qv[i]);
        }
        if (DELTA) {
          float nk[8];
#pragma unroll
          for (int i = 0; i < 8; i++) nk[i] = -kbar[i];
          *(uint4*)(STBY + 4608 + lane * 16) = pack8(bck);
          *(uint4*)(STBY + 5632 + lane * 16) = pack8(nk);
          wave_lds_sync();
          bf16x8 fa[4], fb[4];
#pragma unroll
          for (int x = 0; x < 4; x++) {
            fa[x] = fq == 0 ? ld_frag(STBY + 5632 + (x * 16 + fr) * 16) : zfrag();
            fb[x] = fq == 0 ? ld_frag(STBY + 4608 + (x * 16 + fr) * 16) : zfrag();
          }
#pragma unroll
          for (int nt = 0; nt < 4; nt++)
#pragma unroll
            for (int mt = 0; mt < 4; mt++) {
              const f32x4 g = __builtin_amdgcn_mfma_f32_16x16x32_bf16(fa[mt], fb[nt], z4, 0, 0, 0);
              uint2 gv;
              gv.x = pack2(g[0], g[1]); gv.y = pack2(g[2], g[3]);
              *(uint2*)(SB + S3_GM + ((nt * 16 + fr) * 72 + mt * 16 + fq * 4) * 2) = gv;
            }
        }
      }
    }
    fetch_raw<MIX>(P, min(it + 1, TPB / 64 - 1) * 2 + half, dir, b, h, pw, lane, colv, rawq);
    __syncthreads();
    if (w < 4) {
      unsigned char* STB = smb + S3_STB + w * 2304;
#pragma unroll 2
      for (int kk = 0; kk < 8; kk++) {
        const int cc = it * 2 + (kk >> 2), k = kk & 3;
        int seg_row0, t_lo;
        if (cc < 8) { seg_row0 = b * TPB; t_lo = dir == 0 ? cc * 32 : (LC - 32 - cc * 32); }
        else { seg_row0 = b * TPB + LC; t_lo = dir == 0 ? (cc - 8) * 32 : (SEQ - 32 - (cc - 8) * 32); }
        const int sc = dir ? 3 - k : k;
        const unsigned char* SB = smb + ((kk >> 2) * 4 + sc) * S3_SUB;
#pragma unroll
        for (int nt = 0; nt < 4; nt++) {
          uint2 sv;
          sv.x = pack2(st[nt][0], st[nt][1]); sv.y = pack2(st[nt][2], st[nt][3]);
          *(uint2*)(STB + (fr * 72 + nt * 16 + fq * 4) * 2) = sv;
        }
        wave_lds_sync();
        const bf16x8 bs0 = ld_frag(STB + (fr * 72 + fq * 8) * 2), bs1 = ld_frag(STB + (fr * 72 + 32 + fq * 8) * 2);
        const bf16x8 bv = fq == 0 ? ld_frag(SB + S3_VT + (w * 16 + fr) * 16) : zfrag();
        const bf16x8 aq0 = ld_frag(SB + S3_QB + ((fr & 7) * 72 + fq * 8) * 2), aq1 = ld_frag(SB + S3_QB + ((fr & 7) * 72 + 32 + fq * 8) * 2);
        const bf16x8 aqv = fq == 0 ? ld_frag(SB + S3_QV + (fr & 7) * 16) : zfrag();
        f32x4 accY = __builtin_amdgcn_mfma_f32_16x16x32_bf16(aq0, bs0, z4, 0, 0, 0);
        accY = __builtin_amdgcn_mfma_f32_16x16x32_bf16(aq1, bs1, accY, 0, 0, 0);
        accY = __builtin_amdgcn_mfma_f32_16x16x32_bf16(aqv, bv, accY, 0, 0, 0);
        if (fq < 2) {
#pragma unroll
          for (int r = 0; r < 4; r++) {
            const int i = fq * 4 + r, j = dir ? 7 - i : i;
            YS[(size_t)(seg_row0 + t_lo + sc * 8 + j) * YST + dir * 768 + MIX * 256 + h * 64 + w * 16 + fr] = f2bf(accY[r]);
          }
        }
#pragma unroll
        for (int nt = 0; nt < 4; nt++) {
          f32x4 an = z4;
          if (DELTA) {
            const bf16x8 g0 = ld_frag(SB + S3_GM + ((nt * 16 + fr) * 72 + fq * 8) * 2), g1 = ld_frag(SB + S3_GM + ((nt * 16 + fr) * 72 + 32 + fq * 8) * 2);
            an = __builtin_amdgcn_mfma_f32_16x16x32_bf16(g0, bs0, an, 0, 0, 0);
            an = __builtin_amdgcn_mfma_f32_16x16x32_bf16(g1, bs1, an, 0, 0, 0);
          }
          const bf16x8 akv = fq == 0 ? ld_frag(SB + S3_KVT + (nt * 16 + fr) * 16) : zfrag();
          an = __builtin_amdgcn_mfma_f32_16x16x32_bf16(akv, bv, an, 0, 0, 0);
          const float4 wc = *(const float4*)(SB + S3_WC + (nt * 16 + fq * 4) * 4);
          st[nt][0] = st[nt][0] * wc.x + an[0];
          st[nt][1] = st[nt][1] * wc.y + an[1];
          st[nt][2] = st[nt][2] * wc.z + an[2];
          st[nt][3] = st[nt][3] * wc.w + an[3];
        }
      }
    }
    __syncthreads();
  }
}

__device__ __forceinline__ void attn_item(const Params& p, int l, int b, int qb, int hk, bool isctx, unsigned char* smem) {
  u16* KS = (u16*)smem;
  u16* VT = KS + 64 * LDT;
  u16* PL = VT + 64 * LDT;
  float2* ROPE = (float2*)(PL + 8 * 32 * LDT);
  const int tid = TIDX, lane = tid & 63, w = tid >> 6, fr = lane & 15, fq = lane >> 4;
  const u16* P = (const u16*)(p.ws + OFF_BIG);
  u16* Y = (u16*)(p.ws + OFF_YS);
  const int qh = hk * 2 + (w >> 2);
  const int tb = qb * 128 + (w & 3) * 32;
  const int qrow0 = b * TPB + (isctx ? 0 : LC);
  __syncthreads();
  for (int i = tid; i < 1024; i += NTHR) {
    int pos = i >> 4, fi = i & 15;
    float inv = powf(10000.f, -(float)fi / 16.f);
    float sn, cs;
    sincosf((float)pos * inv, &sn, &cs);
    ROPE[i] = make_float2(cs, sn);
  }
  __syncthreads();
  bf16x8 qf[2][2];
#pragma unroll
  for (int mi = 0; mi < 2; mi++)
#pragma unroll
    for (int ks = 0; ks < 2; ks++) {
      const int tq = tb + mi * 16 + fr;
      const u16* qp = P + (size_t)(qrow0 + tq) * PST + PD + qh * 64 + ks * 32;
      uint4 own = *(const uint4*)(qp + fq * 8);
      uint4 par = *(const uint4*)(qp + (fq ^ 2) * 8);
      const unsigned ow[4] = {own.x, own.y, own.z, own.w};
      const unsigned pw[4] = {par.x, par.y, par.z, par.w};
      const int pos = ks == 0 ? (tq >> 6) : (tq & 63);
      bf16x8 f;
#pragma unroll
      for (int jj = 0; jj < 8; jj++) {
        float xo = bf2f((u16)((ow[jj >> 1] >> ((jj & 1) * 16)) & 0xffff));
        float xp = bf2f((u16)((pw[jj >> 1] >> ((jj & 1) * 16)) & 0xffff));
        float v = xo;
        if (!isctx) {
          float2 cs = ROPE[pos * 16 + (fq & 1) * 8 + jj];
          v = fq < 2 ? xo * cs.x - xp * cs.y : xp * cs.y + xo * cs.x;
        }
        f[jj] = (short)f2bf(v * 0.125f);
      }
      qf[mi][ks] = f;
    }
  f32x4 oacc[2][4];
#pragma unroll
  for (int mi = 0; mi < 2; mi++)
#pragma unroll
    for (int nd = 0; nd < 4; nd++) oacc[mi][nd] = f32x4{0.f, 0.f, 0.f, 0.f};
  float mrow[2][4], lrow[2][4];
#pragma unroll
  for (int mi = 0; mi < 2; mi++)
#pragma unroll
    for (int r = 0; r < 4; r++) { mrow[mi][r] = -1e30f; lrow[mi][r] = 0.f; }

  const int q0 = qb * 128;
  const int band_lo = isctx ? 0 : max(0, q0 - 128), band_hi = isctx ? 0 : min(SEQ, q0 + 256);
  const int ntile = 4 + (band_hi - band_lo) / 64;
  u16* pl = PL + w * 32 * LDT;
  for (int tl = 0; tl < ntile; tl++) {
    const bool band = tl >= 4;
    const int k0 = band ? band_lo + (tl - 4) * 64 : tl * 64;
    __syncthreads();
    {
      const int key = tid >> 3, kc = tid & 7;
      const int kpos = k0 + key;
      const u16* kp = P + (size_t)(b * TPB + (band ? LC : 0) + kpos) * PST + PD + 256 + hk * 64;
      uint4 own = *(const uint4*)(kp + kc * 8);
      uint4 vv = *(const uint4*)(kp + 128 + kc * 8);
      uint4 par = *(const uint4*)(kp + (kc ^ 2) * 8);
      if (band) {
        const unsigned ow[4] = {own.x, own.y, own.z, own.w};
        const unsigned pw[4] = {par.x, par.y, par.z, par.w};
        const int pos = kc < 4 ? (kpos >> 6) : (kpos & 63);
        unsigned res[4];
#pragma unroll
        for (int jj = 0; jj < 8; jj += 2) {
          float v2[2];
#pragma unroll
          for (int e = 0; e < 2; e++) {
            float xo = bf2f((u16)((ow[jj >> 1] >> (e * 16)) & 0xffff));
            float xp = bf2f((u16)((pw[jj >> 1] >> (e * 16)) & 0xffff));
            float2 cs = ROPE[pos * 16 + (kc & 1) * 8 + jj + e];
            v2[e] = (kc & 2) == 0 ? xo * cs.x - xp * cs.y : xp * cs.y + xo * cs.x;
          }
          res[jj >> 1] = pack2(v2[0], v2[1]);
        }
        own = make_uint4(res[0], res[1], res[2], res[3]);
      }
      *(uint4*)(KS + key * LDT + kc * 8) = own;
      const unsigned vw[4] = {vv.x, vv.y, vv.z, vv.w};
#pragma unroll
      for (int jj = 0; jj < 8; jj++) VT[(kc * 8 + jj) * LDT + key] = (u16)((vw[jj >> 1] >> ((jj & 1) * 16)) & 0xffff);
    }
    __syncthreads();
    f32x4 sc[2][4];
#pragma unroll
    for (int mi = 0; mi < 2; mi++)
#pragma unroll
      for (int nj = 0; nj < 4; nj++) sc[mi][nj] = f32x4{0.f, 0.f, 0.f, 0.f};
#pragma unroll
    for (int ks = 0; ks < 2; ks++) {
      bf16x8 kf[4];
#pragma unroll
      for (int nj = 0; nj < 4; nj++) kf[nj] = *(const bf16x8*)(KS + (nj * 16 + fr) * LDT + ks * 32 + fq * 8);
#pragma unroll
      for (int mi = 0; mi < 2; mi++)
#pragma unroll
        for (int nj = 0; nj < 4; nj++) sc[mi][nj] = __builtin_amdgcn_mfma_f32_16x16x32_bf16(qf[mi][ks], kf[nj], sc[mi][nj], 0, 0, 0);
    }
#pragma unroll
    for (int mi = 0; mi < 2; mi++)
#pragma unroll
      for (int r = 0; r < 4; r++) {
        const int qpos = tb + mi * 16 + fq * 4 + r;
        float mx = -1e30f;
#pragma unroll
        for (int nj = 0; nj < 4; nj++) {
          float v = sc[mi][nj][r];
          if (band) {
            int d = qpos - (k0 + nj * 16 + fr);
            if (d > 128 || d < -128) v = -1e30f;
          }
          sc[mi][nj][r] = v;
          mx = fmaxf(mx, v);
        }
        mx = fmaxf(mx, __shfl_xor(mx, 1));
        mx = fmaxf(mx, __shfl_xor(mx, 2));
        mx = fmaxf(mx, __shfl_xor(mx, 4));
        mx = fmaxf(mx, __shfl_xor(mx, 8));
        const float mnew = fmaxf(mrow[mi][r], mx);
        const float alpha = __expf(mrow[mi][r] - mnew);
        mrow[mi][r] = mnew;
        float ls = 0.f;
#pragma unroll
        for (int nj = 0; nj < 4; nj++) {
          float pe = __expf(sc[mi][nj][r] - mnew);
          ls += pe;
          pl[(mi * 16 + fq * 4 + r) * LDT + nj * 16 + fr] = f2bf(pe);
        }
        lrow[mi][r] = lrow[mi][r] * alpha + ls;
#pragma unroll
        for (int nd = 0; nd < 4; nd++) oacc[mi][nd][r] *= alpha;
      }
    asm volatile("s_waitcnt lgkmcnt(0)" ::: "memory");
    __builtin_amdgcn_wave_barrier();
#pragma unroll
    for (int ks = 0; ks < 2; ks++) {
      bf16x8 pf[2], vf[4];
#pragma unroll
      for (int mi = 0; mi < 2; mi++) pf[mi] = *(const bf16x8*)(pl + (mi * 16 + fr) * LDT + ks * 32 + fq * 8);
#pragma unroll
      for (int nd = 0; nd < 4; nd++) vf[nd] = *(const bf16x8*)(VT + (nd * 16 + fr) * LDT + ks * 32 + fq * 8);
#pragma unroll
      for (int mi = 0; mi < 2; mi++)
#pragma unroll
        for (int nd = 0; nd < 4; nd++) oacc[mi][nd] = __builtin_amdgcn_mfma_f32_16x16x32_bf16(pf[mi], vf[nd], oacc[mi][nd], 0, 0, 0);
    }
    asm volatile("s_waitcnt lgkmcnt(0)" ::: "memory");
    __builtin_amdgcn_wave_barrier();
  }
  const float sink = p.attn_sink[l * 4 + qh];
#pragma unroll
  for (int mi = 0; mi < 2; mi++)
#pragma unroll
    for (int r = 0; r < 4; r++) {
      float ls = lrow[mi][r];
      ls += __shfl_xor(ls, 1);
      ls += __shfl_xor(ls, 2);
      ls += __shfl_xor(ls, 4);
      ls += __shfl_xor(ls, 8);
      ls += __expf(sink - mrow[mi][r]);
      const float inv = 1.f / ls;
      const int tq = tb + mi * 16 + fq * 4 + r;
#pragma unroll
      for (int nd = 0; nd < 4; nd++) Y[(size_t)(qrow0 + tq) * YST + 1536 + qh * 64 + nd * 16 + fr] = f2bf(oacc[mi][nd][r] * inv);
    }
}

#ifndef SCAN3_MASK
#define SCAN3_MASK 7
#endif
__device__ __forceinline__ void phase_mix(const Params& p, int l, unsigned char* smem) {
  float* sm = (float*)smem;
  const int G = gridDim.x;
  for (int it = blockIdx.x; it < 192; it += G) {
    const int mix = it >> 6, rem = it & 63, b = rem >> 3, h = (rem >> 1) & 3, dir = rem & 1;
    if (mix == 0 && (SCAN3_MASK & 1)) scan3_item<0>(p, l, b, h, dir, smem);
    else if (mix == 1 && (SCAN3_MASK & 2)) scan3_item<1>(p, l, b, h, dir, smem);
    else if (mix == 2 && (SCAN3_MASK & 4)) scan3_item<2>(p, l, b, h, dir, smem);
  }
  if (SCAN3_MASK != 7) {
    for (int it = blockIdx.x; it < 768; it += G) {
      const int mix = it >> 8, rem = it & 255, b = rem >> 5, h = (rem >> 3) & 3, dir = (rem >> 2) & 1, rq = rem & 3;
      if (mix == 0 && !(SCAN3_MASK & 1)) scan2_item<0>(p, l, b, h, dir, rq, sm);
      else if (mix == 1 && !(SCAN3_MASK & 2)) scan2_item<1>(p, l, b, h, dir, rq, sm);
      else if (mix == 2 && !(SCAN3_MASK & 4)) scan2_item<2>(p, l, b, h, dir, rq, sm);
    }
  }
  __syncthreads();
  {
    const bool spread = G >= 192;
    const int nconv = spread ? 64 : G, fidx = spread ? (int)blockIdx.x - 128 : (int)blockIdx.x;
    if (fidx >= 0 && fidx < nconv)
      for (int it = 832 + fidx; it < 4480; it += nconv) conv_item(p, l, it, (float*)smem);
    __syncthreads();
  }
  unsigned* ctr = (unsigned*)(p.ws + OFF_CTR) + l * 16;
  volatile int* slot = (volatile int*)(smem + 131072 - 16);
  for (;;) {
    if (TIDX == 0) *slot = (int)atomicAdd(ctr, 1u);
    __syncthreads();
    const int it = *slot;
    __syncthreads();
    if (it >= (l == 0 ? 544 : 512)) break;
    if (it < 512) {
      int b = it >> 6, qb = (it >> 1) & 31, hk = it & 1;
      attn_item(p, l, b, qb, hk, false, smem);
    } else {
      int r = it - 512, b = r >> 2, qb = (r >> 1) & 1, hk = r & 1;
      attn_item(p, l, b, qb, hk, true, smem);
    }
  }
}

#define POST_DECL(PFX) uint2 PFX##ya0, PFX##ya1, PFX##ya2, PFX##yc0, PFX##yc1, PFX##yc2, PFX##vp, PFX##vc, PFX##vn, PFX##gb, PFX##gc; \
  u16 PFX##xp, PFX##xc, PFX##xn; float2 PFX##bc
#define POST_LOAD(PFX, R_)                                                                         \
  do {                                                                                             \
    const int r_ = (R_);                                                                           \
    const int b_ = r_ / TPB, t_ = r_ - b_ * TPB;                                                   \
    const bool hp_ = (t_ != 0) && (t_ != LC), hn_ = (t_ != LC - 1) && (t_ != TPB - 1);            \
    const u16* ys_ = YSc + (size_t)r_ * YST;                                                       \
    const u16* pr_ = Pc + (size_t)r_ * PST;                                                        \
    const u16* pp_ = pr_ - (hp_ ? PST : 0);                                                        \
    const u16* pn_ = pr_ + (hn_ ? PST : 0);                                                        \
    PFX##ya0 = *(const uint2*)(ys_ + j0); PFX##ya1 = *(const uint2*)(ys_ + 256 + j0); PFX##ya2 = *(const uint2*)(ys_ + 512 + j0); \
    PFX##yc0 = *(const uint2*)(ys_ + 768 + j0); PFX##yc1 = *(const uint2*)(ys_ + 1024 + j0); PFX##yc2 = *(const uint2*)(ys_ + 1280 + j0); \
    PFX##vp = *(const uint2*)(pp_ + PA + 512 + j0);                                                \
    PFX##vc = *(const uint2*)(pr_ + PA + 512 + j0);                                                \
    PFX##vn = *(const uint2*)(pn_ + PA + 512 + j0);                                                \
    PFX##gb = *(const uint2*)(pr_ + PB + 784 + j0);                                                \
    PFX##gc = *(const uint2*)(pr_ + PC + 544 + j0);                                                \
    PFX##xp = pp_[PA + 896 + lane]; PFX##xc = pr_[PA + 896 + lane]; PFX##xn = pn_[PA + 896 + lane]; \
    PFX##bc = *(const float2*)(BCc + (size_t)r_ * 8 + (lane >> 4) * 2);                            \
  } while (0)
__device__ __forceinline__ void unpack4(uint2 v, float (&o)[4]) {
  o[0] = __uint_as_float(v.x << 16); o[1] = __uint_as_float(v.x & 0xffff0000u);
  o[2] = __uint_as_float(v.y << 16); o[3] = __uint_as_float(v.y & 0xffff0000u);
}

__device__ __forceinline__ void phase_post(const Params& p, int l, float* g2s) {
  const int lane = TIDX & 63, wv = TIDX >> 6;
  u16* YS = (u16*)(p.ws + OFF_YS);
  const int j0 = lane * 4;
  {
    const float4* src = (const float4*)(p.rwkv_g2 + (size_t)l * 64 * 256);
    for (int i = TIDX; i < 64 * 256 / 4; i += NTHR) ((float4*)g2s)[i] = src[i];
  }
  float mu_v[4], lng[4], lnb[4], ngb[4], ngc[4];
#pragma unroll
  for (int i = 0; i < 4; i++) {
    mu_v[i] = p.rwkv_mu[l * 960 + 512 + j0 + i];
    lng[i] = p.rwkv_ln_g[l * 256 + j0 + i];
    lnb[i] = p.rwkv_ln_b[l * 256 + j0 + i];
    ngb[i] = p.gdn_norm_g[l * 64 + (lane & 15) * 4 + i];
    ngc[i] = p.gla_norm_g[l * 64 + (lane & 15) * 4 + i];
  }
  const float mu_x = p.rwkv_mu[l * 960 + 896 + lane];
  __syncthreads();
  const int stride = gridDim.x * 8;
  int r = blockIdx.x * 8 + wv;
  const u16* Pc = (const u16*)(p.ws + OFF_BIG);
  const u16* YSc = (const u16*)(p.ws + OFF_YS);
  const float* BCc = (const float*)(p.ws + OFF_BC);
  POST_DECL(cur_);
  POST_DECL(nxt_);
  POST_LOAD(cur_, r);
  for (; r < NROWS; r += stride) {
    const int rn = r + stride < NROWS ? r + stride : r;
    POST_LOAD(nxt_, rn);
    const int b = r / TPB, t = r - b * TPB;
    const float pmul = ((t != 0) && (t != LC)) ? 1.f : 0.f, nmul = ((t != LC - 1) && (t != TPB - 1)) ? 1.f : 0.f;
    if (!(l == 1 && t < LC)) {
    float y[3][4];
    {
      float a4[4], c4[4];
      unpack4(cur_ya0, a4); unpack4(cur_yc0, c4);
#pragma unroll
      for (int i = 0; i < 4; i++) y[0][i] = a4[i] + c4[i];
      unpack4(cur_ya1, a4); unpack4(cur_yc1, c4);
#pragma unroll
      for (int i = 0; i < 4; i++) y[1][i] = a4[i] + c4[i];
      unpack4(cur_ya2, a4); unpack4(cur_yc2, c4);
#pragma unroll
      for (int i = 0; i < 4; i++) y[2][i] = a4[i] + c4[i];
    }
    float o[3][4];
    {
      float sum = y[0][0] + y[0][1] + y[0][2] + y[0][3];
      sum = red16(sum);
      const float mean = sum * (1.f / 64.f);
      float vs = 0.f;
#pragma unroll
      for (int i = 0; i < 4; i++) { float d = y[0][i] - mean; vs += d * d; }
      vs = red16(vs);
      const float rstd = rsq(vs * (1.f / 64.f) + 64e-5f);
      const float pv = bf2f(cur_xc), ppv = bf2f(cur_xp) * pmul, pnv = bf2f(cur_xn) * nmul;
      const float sg = sigm(pv + (0.5f * (ppv + pnv) - pv) * mu_x);
      float gate[4] = {0.f, 0.f, 0.f, 0.f};
      const float* g2 = g2s + j0;
#pragma unroll 8
      for (int i = 0; i < 64; i++) {
        const float si = __int_as_float(__builtin_amdgcn_readlane(__float_as_int(sg), i));
        const float4 gw = *(const float4*)(g2 + i * 256);
        gate[0] += si * gw.x; gate[1] += si * gw.y; gate[2] += si * gw.z; gate[3] += si * gw.w;
      }
      const float bcs = cur_bc.x + cur_bc.y;
      float vc4[4], vp4[4], vn4[4];
      unpack4(cur_vc, vc4); unpack4(cur_vp, vp4); unpack4(cur_vn, vn4);
#pragma unroll
      for (int i = 0; i < 4; i++) {
        const float v = vc4[i] + (0.5f * (vp4[i] * pmul + vn4[i] * nmul) - vc4[i]) * mu_v[i];
        const float yn = (y[0][i] - mean) * rstd * lng[i] + lnb[i];
        o[0][i] = (yn + bcs * v) * gate[i];
      }
    }
#pragma unroll
    for (int m = 1; m < 3; m++) {
      float ss = y[m][0] * y[m][0] + y[m][1] * y[m][1] + y[m][2] * y[m][2] + y[m][3] * y[m][3];
      ss = red16(ss);
      const float inv = rsq(ss * (1.f / 64.f) + 1e-6f);
      float g4[4];
      unpack4(m == 1 ? cur_gb : cur_gc, g4);
#pragma unroll
      for (int i = 0; i < 4; i++) o[m][i] = y[m][i] * inv * (m == 1 ? ngb[i] : ngc[i]) * siluf(g4[i]);
    }
    u16* ys = YS + (size_t)r * YST;
#pragma unroll
    for (int m = 0; m < 3; m++) {
      uint2 ov;
      ov.x = pack2(o[m][0], o[m][1]);
      ov.y = pack2(o[m][2], o[m][3]);
      *(uint2*)(ys + m * 256 + j0) = ov;
    }
    }
    cur_ya0 = nxt_ya0; cur_ya1 = nxt_ya1; cur_ya2 = nxt_ya2; cur_yc0 = nxt_yc0; cur_yc1 = nxt_yc1; cur_yc2 = nxt_yc2;
    cur_vp = nxt_vp; cur_vc = nxt_vc; cur_vn = nxt_vn; cur_gb = nxt_gb; cur_gc = nxt_gc;
    cur_xp = nxt_xp; cur_xc = nxt_xc; cur_xn = nxt_xn; cur_bc = nxt_bc;
  }
}

#define XB_TMO      128
#define XB_XCNT(j)  (256  + 64 * (j))
#define XB_XSUB(j)  (1280 + 64 * (j))
#define XB_XGEN(j)  (2304 + 64 * (j))
#define XB_TOP      3328
#define XB_TOPGEN   3392
#define XCD_BAR_WORDS 3456
#define XB_SPIN_CAP (1u << 18)
#define LAS __attribute__((address_space(3)))

__device__ __forceinline__ unsigned xb_ld(unsigned* p)              { return __hip_atomic_load(p, __ATOMIC_RELAXED, __HIP_MEMORY_SCOPE_AGENT); }
__device__ __forceinline__ unsigned xb_add(unsigned* p, unsigned v) { return __hip_atomic_fetch_add(p, v, __ATOMIC_RELAXED, __HIP_MEMORY_SCOPE_AGENT); }
__device__ __forceinline__ unsigned xb_xcc_id() { return (unsigned)__builtin_amdgcn_s_getreg((3 << 11) | 20) & 0xFu; }
#define XB_SPIN(cond, bar) do { unsigned _sp = 0; while (cond) { __builtin_amdgcn_s_sleep(1); \
    if ((++_sp & 255u) == 0u) { if (xb_ld(&(bar)[XB_TMO])) break; if (_sp > XB_SPIN_CAP) { atomicAdd(&(bar)[XB_TMO], 1u); break; } } } } while (0)

struct XcdBarrier {
    unsigned* bar; unsigned x;
    volatile LAS unsigned* st;
};

__device__ __forceinline__ XcdBarrier xcd_barrier_post(unsigned* bar, volatile LAS unsigned* st) {
    XcdBarrier b; b.bar = bar; b.x = xb_xcc_id(); b.st = st;
    if (threadIdx.x == 0) (void)xb_add(&bar[XB_XCNT(b.x)], 1u);
    return b;
}
__device__ __forceinline__ void xcd_barrier_complete(unsigned* bar, unsigned x, unsigned& nloc, unsigned& nx) {
    const unsigned G = gridDim.x * gridDim.y * gridDim.z;
    unsigned sum, cnt, mine, sp = 0u;
    for (;;) {
        sum = 0u; cnt = 0u; mine = 0u;
#pragma unroll
        for (unsigned j = 0; j < 16; ++j) { const unsigned c = xb_ld(&bar[XB_XCNT(j)]); sum += c; cnt += (c > 0u) ? 1u : 0u; mine = (j == x) ? c : mine; }
        if (sum == G) break;
        __builtin_amdgcn_s_sleep(1);
        if ((++sp & 255u) == 0u) { if (xb_ld(&bar[XB_TMO])) break; if (sp > XB_SPIN_CAP) { atomicAdd(&bar[XB_TMO], 1u); break; } }
    }
    nloc = mine > 0u ? mine : 1u; nx = cnt > 0u ? cnt : 1u;
}

__device__ __forceinline__ void xcd_barrier(const XcdBarrier& b) {
    asm volatile("s_waitcnt vmcnt(0)" ::: "memory");
    __syncthreads();
    if (threadIdx.x == 0) {
        unsigned* bar = b.bar;
        __builtin_amdgcn_s_waitcnt(0);
        unsigned nloc = b.st[0], nx = b.st[1];
        if (nloc == 0u) { xcd_barrier_complete(bar, b.x, nloc, nx); b.st[0] = nloc; b.st[1] = nx; }
        const unsigned old = xb_add(&bar[XB_XSUB(b.x)], 1u);
        const unsigned gen = old / nloc;
        if (old + 1u == (gen + 1u) * nloc) {
            __builtin_amdgcn_fence(__ATOMIC_RELEASE, "agent");
            asm volatile("s_waitcnt vmcnt(0)" ::: "memory");
            const unsigned og = xb_add(&bar[XB_TOP], 1u);
            const unsigned tg = og / nx;
            if (og + 1u == (tg + 1u) * nx) xb_add(&bar[XB_TOPGEN], 1u);
            else XB_SPIN(xb_ld(&bar[XB_TOPGEN]) == tg, bar);
            __builtin_amdgcn_fence(__ATOMIC_ACQUIRE, "agent");
            xb_add(&bar[XB_XGEN(b.x)], 1u);
            asm volatile("s_waitcnt vmcnt(0)" ::: "memory");
        } else {
            XB_SPIN(xb_ld(&bar[XB_XGEN(b.x)]) == gen, bar);
            __builtin_amdgcn_fence(__ATOMIC_ACQUIRE, "agent");
            asm volatile("s_waitcnt vmcnt(0)" ::: "memory");
        }
    }
    __syncthreads();
}

#if defined(SKIPS)
#define EN(k) (SKIPS != (k))
#elif !defined(ONLYS)
#define EN(k) 1
#else
#define EN(k) (ONLYS == (k))
#endif
__device__ __forceinline__ void run_phase(const Params& p, int ph, unsigned char* smem) {
  if (ph == 0) { if (EN(10)) phase_init0(p, (float*)smem); return; }
  if (ph == 1) { if (EN(11)) phase_init1(p); return; }
  int l = 0, s = 10;
  if (ph >= 3) { l = (ph - 3) / 10; s = (ph - 3) - l * 10; }
  unsigned char* wl = p.ws + OFF_W;
  PG8_LAS unsigned char* lds = (PG8_LAS unsigned char*)smem;
  pg8::StaticOrder S;
  if (s == 10 || s == 6 || s == 9) {
    if (EN(5)) rowpass(p, l, s == 10 ? 0 : (s == 6 ? 1 : 2));
    if (s == 9 && l == 0) {
      __syncthreads();
      for (int it = blockIdx.x; it < 832; it += gridDim.x) conv_item(p, 1, it, (float*)smem);
    }
  } else if (s == 0 || s == 3 || s == 5 || s == 8) {
    pg8::Gemm g; EpiBf E;
    g.M = NROWS; E.bias = nullptr; E.act = 0;
    if (s == 0) { g.A = (const u16*)(p.ws + OFF_H); g.lda = DM; g.Bt = (const u16*)(wl + OW_IN); g.K = DM; g.N = PST; E.O = (u16*)(p.ws + OFF_BIG); E.ldc = PST; }
    else if (s == 3) {
      g.A = (const u16*)(p.ws + OFF_H); g.lda = DM; g.Bt = (const u16*)(wl + OW_G); g.K = DM; g.N = 4096;
      E.O = (u16*)(p.ws + OFF_BIG); E.ldc = 4096; E.bias = p.gate_b + (size_t)l * 4096; E.act = 1;
    }
    else if (s == 5) { g.A = (const u16*)(p.ws + OFF_H); g.lda = DM; g.Bt = (const u16*)(wl + OW_O); g.K = DM; g.N = DM; E.O = (u16*)(p.ws + OFF_BIG); E.ldc = DM; }
    else { g.A = (const u16*)(p.ws + OFF_BIG); g.lda = FH; g.Bt = (const u16*)(wl + OW_2); g.K = FH; g.N = DM; E.O = (u16*)(p.ws + OFF_YS); E.ldc = DM; }
    if (l == 1 && s != 0) S.init(NBATCH * SEQ, g.N, gridDim.x, blockIdx.x, 1);
    else S.init(g.M, g.N, gridDim.x, blockIdx.x);
    if (EN(0)) pg8::gemm_phase<EpiBf, pg8::StaticOrder, false>(lds, g, S, E, nullptr);
  } else if (s == 4) {
    if (EN(3)) phase_ypart(p, l, smem);
  } else if (s == 1) {
    if (EN(1)) phase_mix(p, l, smem);
  } else if (s == 2) {
    if (EN(2)) phase_post(p, l, (float*)smem);
  } else {
    pg8::Gemm g; EpiSwiglu E;
    g.M = NROWS; g.N = 2 * FH; g.K = DM; g.lda = DM; g.A = (const u16*)(p.ws + OFF_H); g.Bt = (const u16*)(wl + OW_1);
    E.O = (u16*)(p.ws + OFF_BIG);
    if (l == 1) S.init(NBATCH * SEQ, g.N, gridDim.x, blockIdx.x, 1);
    else S.init(g.M, g.N, gridDim.x, blockIdx.x);
    if (EN(6)) pg8::gemm_phase<EpiSwiglu, pg8::StaticOrder, false>(lds, g, S, E, nullptr);
  }
}

__global__ void __launch_bounds__(NTHR) hybrid_flow_mega(Params p, int ph0, int ph1) {
  __shared__ __attribute__((aligned(16))) unsigned char smem[131072];
  __shared__ __attribute__((aligned(16))) unsigned xbw[4];
  cg::grid_group grid = cg::this_grid();
  XcdBarrier xb;
  xb.bar = (unsigned*)(p.ws + OFF_XBAR); xb.x = 0u; xb.st = (volatile LAS unsigned*)xbw;
  for (int ph = ph0; ph < ph1; ph++) {
    run_phase(p, ph, smem);
#ifdef DUPMASK
    {
      int sidx = ph >= 3 ? (ph - 3) % 10 : 12 + ph;
      if ((DUPMASK >> sidx) & 1) { __syncthreads(); run_phase(p, ph, smem); }
    }
#endif
    if (ph + 1 < ph1) {
      if (ph == ph0) {
        grid.sync();
        if (threadIdx.x < 4) xbw[threadIdx.x] = 0u;
        __syncthreads();
        xb = xcd_barrier_post((unsigned*)(p.ws + OFF_XBAR), (volatile LAS unsigned*)xbw);
      } else {
        xcd_barrier(xb);
      }
    }
  }
  if (ph1 - ph0 > 2 && threadIdx.x == 0 && xb_ld(&xb.bar[XB_TMO]) != 0u) p.out[blockIdx.x] = __int_as_float(0x7fc00000);
}

extern "C" void kernel_launch(void* const* d_in, const int* in_sizes, int n_in, void* d_out, int out_size, void* d_ws,
                              size_t ws_size, hipStream_t stream) {
  Params p{};
  const float** pp = (const float**)&p;
  for (int i = 0; i < 32; i++) pp[i] = (const float*)d_in[i];
  p.out = (float*)d_out;
  p.ws = (unsigned char*)d_ws;
  static int grid_blocks = 0;
  if (!grid_blocks) {
    int dev = 0, cus = 0, per_cu = 0;
    hipGetDevice(&dev);
    hipDeviceGetAttribute(&cus, hipDeviceAttributeMultiprocessorCount, dev);
    hipOccupancyMaxActiveBlocksPerMultiprocessor(&per_cu, hybrid_flow_mega, NTHR, 0);
    if (per_cu < 1) per_cu = 1;
    grid_blocks = cus * per_cu;
  }
#ifdef MULTI_LAUNCH
  for (int ph = 0; ph < NPHASE; ph++) {
    hipLaunchKernelGGL(hybrid_flow_mega, dim3(grid_blocks), dim3(NTHR), 0, stream, p, ph, ph + 1);
  }
#else
  int ph0 = 0, ph1 = NPHASE;
  void* args[] = {&p, &ph0, &ph1};
  hipError_t e = hipLaunchCooperativeKernel((void*)hybrid_flow_mega, dim3(grid_blocks), dim3(NTHR), args, 0, stream);
  if (e != hipSuccess) fprintf(stderr, "cooperative launch failed: %s (grid %d)\n", hipGetErrorString(e), grid_blocks);
#endif
}
```

```cpp
#include <hip/hip_runtime.h>
#include <hip/hip_cooperative_groups.h>
#include <cstdio>
namespace cg = cooperative_groups;

typedef unsigned short u16;
using bf16x8 = __attribute__((ext_vector_type(8))) short;
using f32x4 = __attribute__((ext_vector_type(4))) float;

#define DM 1024
#define NBATCH 8
#define SEQ 4096
#define LC 256
#define TPB 4352
#define NROWS 34816
#define PST 3328
#define YST 1792
#define FH 2816
#define INW 7408
#define NTHR 512
#define PA 0
#define PB 960
#define PC 2000
#define PD 2800
#define NPHASE 23
#define SCAN3_MASK 7

struct Params {
  const float *x, *c, *ctx, *c_ctx, *ada_w, *ada_b, *norm_g, *w_in, *gate_b, *w_branch, *w_out,
      *rwkv_mu, *rwkv_w0, *rwkv_w2, *rwkv_a0, *rwkv_a2, *rwkv_g2, *rwkv_kk, *rwkv_ka, *rwkv_rk, *rwkv_ln_g,
      *rwkv_ln_b, *gdn_conv, *gdn_a_log, *gdn_dt_bias, *gdn_norm_g, *gla_gw2, *gla_gb, *gla_norm_g, *attn_sink,
      *ffn_w1, *ffn_w2;
  float* out;
  unsigned char* ws;
};

constexpr size_t SZ_WL = 36700160;
constexpr size_t OW_IN = 0;
constexpr size_t OW_G = OW_IN + (size_t)PST * 1024 * 2;
constexpr size_t OW_B = OW_G + (size_t)4096 * 1024 * 2;
constexpr size_t OW_O = OW_B + (size_t)4 * 1024 * 256 * 2;
constexpr size_t OW_1 = OW_O + (size_t)1024 * 1024 * 2;
constexpr size_t OW_2 = OW_1 + (size_t)5632 * 1024 * 2;
static_assert(OW_2 + (size_t)1024 * FH * 2 == SZ_WL, "weights size");
constexpr size_t SZ_ACT = (size_t)NROWS * DM * 2;
constexpr size_t OFF_W = 0;
constexpr size_t OFF_XC = OFF_W + SZ_WL;
constexpr size_t OFF_MODP = OFF_XC + (size_t)NBATCH * LC * DM * 4;
constexpr size_t OFF_MOD = OFF_MODP + (size_t)2 * 8 * 9 * 6144 * 4;
constexpr size_t OFF_BC = OFF_MOD + (size_t)2 * 9 * 6144 * 4;
constexpr size_t OFF_H = OFF_BC + (size_t)NROWS * 8 * 4;
constexpr size_t OFF_YS = OFF_H + SZ_ACT;
constexpr size_t OFF_BIG = OFF_YS + (size_t)NROWS * YST * 2;
constexpr size_t OFF_CTR = OFF_BIG + (size_t)NROWS * 4096 * 2;
constexpr size_t OFF_XBAR = OFF_CTR + 256;
constexpr size_t WS_END = OFF_XBAR + 3456 * 4;
static_assert(WS_END <= (size_t)536870912, "ws too large");

__device__ __forceinline__ int launder_tid() { int t = threadIdx.x; asm volatile("" : "+v"(t)); return t; }
#define TIDX (launder_tid())
typedef float f32x2_t __attribute__((ext_vector_type(2)));
typedef __bf16 bf16x2_t __attribute__((ext_vector_type(2)));
__device__ __forceinline__ unsigned pack2(float a, float b) {
  const f32x2_t v = {a, b};
  const bf16x2_t r = __builtin_convertvector(v, bf16x2_t);
  return __builtin_bit_cast(unsigned, r);
}
__device__ __forceinline__ u16 f2bf(float f) { return (u16)(pack2(f, 0.f) & 0xffffu); }
__device__ __forceinline__ float bf2f(u16 h) { return __uint_as_float(((unsigned)h) << 16); }
__device__ __forceinline__ float sigm(float x) { return __builtin_amdgcn_rcpf(1.f + __expf(-x)); }
__device__ __forceinline__ float siluf(float x) { return x * __builtin_amdgcn_rcpf(1.f + __expf(-x)); }
__device__ __forceinline__ float rsq(float x) { return __builtin_amdgcn_rsqf(x); }
__device__ __forceinline__ float softplusf(float x) { return fmaxf(x, 0.f) + __logf(1.f + __expf(-fabsf(x))); }
__device__ __forceinline__ float tanh_fast(float x) { return 1.f - 2.f * __builtin_amdgcn_rcpf(1.f + __expf(2.f * x)); }
__device__ __forceinline__ float wsum(float v) {
#pragma unroll
  for (int o = 32; o > 0; o >>= 1) v += __shfl_xor(v, o);
  return v;
}
template <int CTRL>
__device__ __forceinline__ float dppf(float x) {
  return __int_as_float(__builtin_amdgcn_update_dpp(__float_as_int(x), __float_as_int(x), CTRL, 0xf, 0xf, false));
}
__device__ __forceinline__ float red8(float x) {
  x += dppf<0xB1>(x);
  x += dppf<0x4E>(x);
  x += dppf<0x141>(x);
  return x;
}
__device__ __forceinline__ const float* xin_row(const Params& p, int r) {
  int b = r / TPB, t = r - b * TPB;
  return t < LC ? p.ctx + ((size_t)(b * LC + t)) * DM : p.x + ((size_t)(b * SEQ + t - LC)) * DM;
}
__device__ __forceinline__ float* x_row(const Params& p, int r) {
  int b = r / TPB, t = r - b * TPB;
  return t < LC ? (float*)(p.ws + OFF_XC) + ((size_t)(b * LC + t)) * DM : p.out + ((size_t)(b * SEQ + t - LC)) * DM;
}
__device__ __forceinline__ int mod_row(int r) {
  int b = r / TPB, t = r - b * TPB;
  return t < LC ? 8 : b;
}

struct MapId { int lim, off; __device__ int operator()(int n) const { return n < lim ? n + off : -1; } };
struct MapW1 { __device__ int operator()(int n) const { int q = n >> 3, s = n & 7; return s < 4 ? q * 4 + s : FH + q * 4 + (s - 4); } };

template <class Map>
__device__ __forceinline__ void conv_tile(const float* __restrict__ src, int ld, u16* __restrict__ dst, int K, int n0,
                                          int k0, Map map, float* tile) {
  const int tid = TIDX;
  const int nn = tid & 63, kr = tid >> 6;
  const int sc = map(n0 + nn);
  float tv[8];
  const int scc = sc >= 0 ? sc : 0;
  const float scm = sc >= 0 ? 1.f : 0.f;
#pragma unroll
  for (int ps = 0; ps < 8; ps++) tv[ps] = src[(size_t)(k0 + ps * 8 + kr) * ld + scc];
#pragma unroll
  for (int ps = 0; ps < 8; ps++) tile[(ps * 8 + kr) * 65 + nn] = tv[ps] * scm;
  __syncthreads();
  const int n2 = tid >> 3, kc = tid & 7;
  uint4 o;
  o.x = pack2(tile[(kc * 8 + 0) * 65 + n2], tile[(kc * 8 + 1) * 65 + n2]);
  o.y = pack2(tile[(kc * 8 + 2) * 65 + n2], tile[(kc * 8 + 3) * 65 + n2]);
  o.z = pack2(tile[(kc * 8 + 4) * 65 + n2], tile[(kc * 8 + 5) * 65 + n2]);
  o.w = pack2(tile[(kc * 8 + 6) * 65 + n2], tile[(kc * 8 + 7) * 65 + n2]);
  *(uint4*)(dst + (size_t)(n0 + n2) * K + k0 + kc * 8) = o;
  __syncthreads();
}

__device__ __forceinline__ void conv_item(const Params& p, int l, int rem, float* sm) {
      u16* wl = (u16*)(p.ws + OFF_W);
      if (rem < 832) {
        int nt = rem >> 4, kt = rem & 15;
        conv_tile(p.w_in + (size_t)l * DM * INW, INW, (u16*)((char*)wl + OW_IN), 1024, nt * 64, kt * 64, MapId{3312, 0}, sm);
      } else if (rem < 832 + 1024) {
        rem -= 832;
        int nt = rem >> 4, kt = rem & 15;
        conv_tile(p.w_in + (size_t)l * DM * INW, INW, (u16*)((char*)wl + OW_G), 1024, nt * 64, kt * 64, MapId{4096, 3312}, sm);
      } else if (rem < 1856 + 256) {
        rem -= 1856;
        int br = rem >> 6, r2 = rem & 63, nt = r2 >> 2, kt = r2 & 3;
        conv_tile(p.w_branch + ((size_t)(l * 4 + br)) * 256 * DM, DM, (u16*)((char*)wl + OW_B) + (size_t)br * 1024 * 256, 256,
                  nt * 64, kt * 64, MapId{1024, 0}, sm);
      } else if (rem < 2112 + 256) {
        rem -= 2112;
        int nt = rem >> 4, kt = rem & 15;
        conv_tile(p.w_out + (size_t)l * DM * DM, DM, (u16*)((char*)wl + OW_O), 1024, nt * 64, kt * 64, MapId{1024, 0}, sm);
      } else if (rem < 2368 + 1408) {
        rem -= 2368;
        int nt = rem >> 4, kt = rem & 15;
        conv_tile(p.ffn_w1 + (size_t)l * DM * 5632, 5632, (u16*)((char*)wl + OW_1), 1024, nt * 64, kt * 64, MapW1{}, sm);
      } else {
        rem -= 3776;
        int nt = rem / 44, kt = rem - nt * 44;
        conv_tile(p.ffn_w2 + (size_t)l * FH * DM, DM, (u16*)((char*)wl + OW_2), FH, nt * 64, kt * 64, MapId{1024, 0}, sm);
      }
}

__device__ __forceinline__ void phase_init0(const Params& p, float* sm) {
  const int tid = TIDX;
  if (blockIdx.x == 0) {
    if (tid < 64) ((unsigned*)(p.ws + OFF_CTR))[tid] = 0u;
    for (int i = tid; i < 3456; i += NTHR) ((unsigned*)(p.ws + OFF_XBAR))[i] = 0u;
  }
  constexpr int NMOD = 192, NCONV = 832;
  for (int it = blockIdx.x; it < NMOD + NCONV; it += gridDim.x) {
    if (it < NMOD) {
      int l = it / 96, rem = it - l * 96, cc = rem >> 3, ks = rem & 7;
      for (int i = tid; i < 9 * 128; i += NTHR) {
        int r = i >> 7, k = i & 127;
        float v = r < 8 ? p.c[r * DM + ks * 128 + k] : p.c_ctx[ks * 128 + k];
        sm[i] = siluf(v);
      }
      __syncthreads();
      const int n = cc * 512 + tid;
      const float* w = p.ada_w + ((size_t)l * DM + ks * 128) * 6144 + n;
      float acc[9];
#pragma unroll
      for (int r = 0; r < 9; r++) acc[r] = 0.f;
#pragma unroll 1
      for (int k0 = 0; k0 < 128; k0 += 16) {
        float wv[16];
#pragma unroll
        for (int kk = 0; kk < 16; kk++) wv[kk] = w[(size_t)(k0 + kk) * 6144];
#pragma unroll
        for (int kk = 0; kk < 16; kk++)
#pragma unroll
          for (int r = 0; r < 9; r++) acc[r] += sm[r * 128 + k0 + kk] * wv[kk];
      }
      float* mp = (float*)(p.ws + OFF_MODP) + ((size_t)(l * 8 + ks) * 9) * 6144 + n;
#pragma unroll
      for (int r = 0; r < 9; r++) mp[(size_t)r * 6144] = acc[r];
      __syncthreads();
    } else {
      conv_item(p, 0, it - NMOD, sm);
    }
  }
}

__device__ __forceinline__ void phase_init1(const Params& p) {
  const float* mp = (const float*)(p.ws + OFF_MODP);
  float* mo = (float*)(p.ws + OFF_MOD);
  for (int i = blockIdx.x * NTHR + TIDX; i < 2 * 9 * 6144; i += gridDim.x * NTHR) {
    int l = i / (9 * 6144), rem = i - l * 9 * 6144, r = rem / 6144, n = rem - r * 6144;
    float s = p.ada_b[l * 6144 + n];
#pragma unroll
    for (int ks = 0; ks < 8; ks++) s += mp[((size_t)((l * 8 + ks) * 9 + r)) * 6144 + n];
    mo[i] = s;
  }
}

__device__ __forceinline__ void rowpass(const Params& p, int l, int mode) {
  const int lane = TIDX & 63, wv = TIDX >> 6;
  const float* MOD = (const float*)(p.ws + OFF_MOD);
  u16* H = (u16*)(p.ws + OFF_H);
  const bool do_norm = !(mode == 2 && l == 1);
  const int ln = (mode == 2) ? (l == 1 ? l : l + 1) : l;
  const int ni = (mode == 1) ? 2 : 0, sho = (mode == 1) ? 3072 : 0, sco = (mode == 1) ? 4096 : 1024;
  for (int r = blockIdx.x * 8 + wv; r < NROWS; r += gridDim.x * 8) {
    const int mr = mod_row(r);
    if (l == 1 && mode != 0 && mr == 8) continue;
    const float* modl = MOD + ((size_t)(l * 9 + mr)) * 6144;
    const float* modn = MOD + ((size_t)(ln * 9 + mr)) * 6144;
    const float* ng2 = p.norm_g + (size_t)(ln * 4 + ni) * DM;
    const float* xs = (mode == 0 || (mode == 1 && l == 0)) ? xin_row(p, r) : (const float*)x_row(p, r);
    float4 xo[4], n2[4], sc4[4], sh4[4];
#pragma unroll
    for (int i = 0; i < 4; i++) {
      const int col = i * 256 + lane * 4;
      xo[i] = *(const float4*)(xs + col);
      n2[i] = *(const float4*)(ng2 + col);
      sc4[i] = *(const float4*)(modn + sco + col);
      sh4[i] = *(const float4*)(modn + sho + col);
    }
    float xv[16];
    if (mode == 0) {
#pragma unroll
      for (int i = 0; i < 4; i++) { xv[i * 4 + 0] = xo[i].x; xv[i * 4 + 1] = xo[i].y; xv[i * 4 + 2] = xo[i].z; xv[i * 4 + 3] = xo[i].w; }
    } else {
      const u16* src = (const u16*)(p.ws + (mode == 1 ? OFF_BIG : OFF_YS)) + (size_t)r * DM;
      const float* ng = p.norm_g + (size_t)(l * 4 + (mode == 1 ? 1 : 3)) * DM;
      const float* gt = modl + (mode == 1 ? 2048 : 5120);
      uint2 sv[4];
      float4 g4[4], n4[4];
#pragma unroll
      for (int i = 0; i < 4; i++) {
        const int col = i * 256 + lane * 4;
        sv[i] = *(const uint2*)(src + col);
        g4[i] = *(const float4*)(gt + col);
        n4[i] = *(const float4*)(ng + col);
      }
      float ov[16];
      float ss = 0.f;
#pragma unroll
      for (int i = 0; i < 4; i++) {
        ov[i * 4 + 0] = __uint_as_float(sv[i].x << 16); ov[i * 4 + 1] = __uint_as_float(sv[i].x & 0xffff0000u);
        ov[i * 4 + 2] = __uint_as_float(sv[i].y << 16); ov[i * 4 + 3] = __uint_as_float(sv[i].y & 0xffff0000u);
      }
#pragma unroll
      for (int i = 0; i < 16; i++) ss += ov[i] * ov[i];
      ss = wsum(ss);
      const float inv = rsq(ss * (1.f / 1024.f) + 1e-6f);
      float* xd = x_row(p, r);
#pragma unroll
      for (int i = 0; i < 4; i++) {
        xv[i * 4 + 0] = xo[i].x + g4[i].x * (ov[i * 4 + 0] * inv * n4[i].x);
        xv[i * 4 + 1] = xo[i].y + g4[i].y * (ov[i * 4 + 1] * inv * n4[i].y);
        xv[i * 4 + 2] = xo[i].z + g4[i].z * (ov[i * 4 + 2] * inv * n4[i].z);
        xv[i * 4 + 3] = xo[i].w + g4[i].w * (ov[i * 4 + 3] * inv * n4[i].w);
      }
#pragma unroll
      for (int i = 0; i < 4; i++)
        *(float4*)(xd + i * 256 + lane * 4) = make_float4(xv[i * 4 + 0], xv[i * 4 + 1], xv[i * 4 + 2], xv[i * 4 + 3]);
    }
    if (!do_norm) continue;
    float ss2 = 0.f;
#pragma unroll
    for (int i = 0; i < 16; i++) ss2 += xv[i] * xv[i];
    ss2 = wsum(ss2);
    const float inv2 = rsq(ss2 * (1.f / 1024.f) + 1e-6f);
#pragma unroll
    for (int i = 0; i < 4; i++) {
      const int col = i * 256 + lane * 4;
      float h0 = xv[i * 4 + 0] * inv2 * n2[i].x * (1.f + sc4[i].x) + sh4[i].x;
      float h1 = xv[i * 4 + 1] * inv2 * n2[i].y * (1.f + sc4[i].y) + sh4[i].y;
      float h2 = xv[i * 4 + 2] * inv2 * n2[i].z * (1.f + sc4[i].z) + sh4[i].z;
      float h3 = xv[i * 4 + 3] * inv2 * n2[i].w * (1.f + sc4[i].w) + sh4[i].w;
      uint2 o;
      o.x = pack2(h0, h1);
      o.y = pack2(h2, h3);
      *(uint2*)(H + (size_t)r * DM + col) = o;
    }
  }
}

#define LDT 72
namespace pg8 {
#define PG8_LAS __attribute__((address_space(3)))
typedef unsigned short bf16_t;
typedef short bf16x8 __attribute__((ext_vector_type(8)));
typedef float f32x4 __attribute__((ext_vector_type(4)));
typedef unsigned u32x4 __attribute__((ext_vector_type(4)));
constexpr int BM = 256, BK = 64, HALF = 128, HTB = HALF * BK * 2  , STAGE_BYTES = 8 * HTB, NXCD = 8, WGM = 8;

__host__ __device__ __forceinline__ int lds_byte(int r, int c) { const int st = (r >> 4) * 2 + (c >> 5), rr = r & 15, cc = c & 31, ob = rr * 64 + cc * 2; return st * 1024 + (ob ^ (((ob >> 9) & 1) << 5)); }
__host__ __device__ __forceinline__ void stage_rc(int b, int& R, int& C) { const int st = b / 1024, sb = b % 1024, swz = sb ^ (((sb >> 9) & 1) << 5); R = (st >> 1) * 16 + swz / 64; C = (st & 1) * 32 + (swz % 64) / 2; }
__host__ __device__ __forceinline__ int perm32(int rho) { const int n = rho >> 4, i = rho & 15; return 8 * (i >> 2) + 4 * n + (i & 3); }

struct Unit { int pm, pn; };
struct Gemm { const bf16_t* A; const bf16_t* Bt; int M, N, K, lda; };
struct StaticOrder {
    int nM, nN, nwg, G, c, skip;
    __host__ __device__ void init(int M, int N, int G_, int c_, int skip_ = 0) { nM = M / BM; nN = N / BM; nwg = nM * nN; G = G_; c = c_; skip = skip_; }
    __host__ __device__ bool next(int i, Unit& u) const {
        const long L = (long)i * G + c; if (L >= nwg) return false;
        int wgid = (int)L; { const int q = nwg / NXCD, r = nwg % NXCD, xcd = wgid % NXCD, off = wgid / NXCD; wgid = (xcd < r ? xcd * (q + 1) : r * (q + 1) + (xcd - r) * q) + off; }
        const int nig = WGM * nN, gid = wgid / nig, fm = gid * WGM, gsz = (nM - fm) < WGM ? (nM - fm) : WGM;
        u.pm = fm + ((wgid % nig) % gsz); u.pn = (wgid % nig) / gsz;
        if (skip) u.pm = (u.pm >> 4) * 17 + 1 + (u.pm & 15);
        return true;
    }
    __device__ __forceinline__ void a_ready(const Unit&) const {}
    __device__ __forceinline__ void done(const Unit&) const {}
};
__device__ __forceinline__ unsigned cvt_pk_bf16(float lo, float hi) { unsigned r; asm volatile("v_cvt_pk_bf16_f32 %0, %1, %2" : "=v"(r) : "v"(lo), "v"(hi)); return r; }
template <class Epi, class Sched, bool STAMP = false>
__device__ __forceinline__ void gemm_phase(PG8_LAS unsigned char* lds, const Gemm g, const Sched& S, const Epi& E, unsigned long long* stamps) {
    const int tid = TIDX, wid = __builtin_amdgcn_readfirstlane(tid >> 6), lane = tid & 63, wr = wid >> 2, wc = wid & 3, fr = lane & 15, fq = lane >> 4;
    const int K = g.K, nt = K / BK;
    int ts_lo = 0, ts_hi = 0, nts = 0; const unsigned long long rt_entry = STAMP ? (unsigned long long)wall_clock64() : 0ull;
#define PG8_STAMP() do { if (STAMP && wid == 0 && nts < 64) { const unsigned long long _c = (unsigned long long)clock64(); \
        ts_lo = (lane == nts) ? (int)(unsigned)_c : ts_lo; ts_hi = (lane == nts) ? (int)(unsigned)(_c >> 32) : ts_hi; ++nts; } } while (0)
    PG8_STAMP();
    unsigned voffA[2], voffB[2];
#pragma unroll
    for (int i = 0; i < 2; ++i) { int R, C; stage_rc(tid * 16 + i * 8192, R, C); const int Rb = Epi::PERM ? ((R & ~31) + perm32(R & 31)) : R;
        voffA[i] = (unsigned)(R * g.lda + C) * 2u; voffB[i] = (unsigned)(Rb * K + C) * 2u; }
    const size_t kstep = (size_t)(BK * 2);
    const size_t hstepB = (size_t)HALF * K * 2, hstepA = (size_t)HALF * g.lda * 2;
    const size_t tstepB = 2 * hstepB, tstepA = 2 * hstepA;
    const unsigned ldsw = (unsigned)wid * 1024u;
    const int aoff = lds_byte(wr * 64 + fr, fq * 8), boff = lds_byte(wc * 32 + fr, fq * 8);
#define PG8_SA(b, h) (((b) * 2 + (h)) * HTB)
#define PG8_SB(b, h) ((4 + (b) * 2 + (h)) * HTB)
#define PG8_STAGE(bufoff, gbase, voff) do { _Pragma("unroll") for (int _i = 0; _i < 2; ++_i) \
        __builtin_amdgcn_global_load_lds((const unsigned*)((const char*)(gbase) + (voff)[_i]), (PG8_LAS unsigned*)(lds + (bufoff) + ldsw + _i * 8192), 16, 0, 0); } while (0)
#define PG8_LDA(dst, b, h) do { _Pragma("unroll") for (int m = 0; m < 4; ++m) _Pragma("unroll") for (int k = 0; k < 2; ++k) dst[m][k] = *(const PG8_LAS bf16x8*)(lds + PG8_SA(b, h) + aoff + m * 2048 + k * 1024); } while (0)
#define PG8_LDB(dst, b, h) do { _Pragma("unroll") for (int n = 0; n < 2; ++n) _Pragma("unroll") for (int k = 0; k < 2; ++k) dst[n][k] = *(const PG8_LAS bf16x8*)(lds + PG8_SB(b, h) + boff + n * 2048 + k * 1024); } while (0)
#define PG8_MMA(ai, bj, At, Bt) do { __builtin_amdgcn_s_setprio(1); _Pragma("unroll") for (int m = 0; m < 4; ++m) _Pragma("unroll") for (int n = 0; n < 2; ++n) _Pragma("unroll") for (int k = 0; k < 2; ++k) \
        acc[ai][bj][m][n] = __builtin_amdgcn_mfma_f32_16x16x32_bf16(Bt[n][k], At[m][k], acc[ai][bj][m][n], 0, 0, 0); __builtin_amdgcn_s_setprio(0); } while (0)
#define PG8_WAIT_V(n) asm volatile("s_waitcnt vmcnt(" #n ")" ::: "memory")
#define PG8_WAIT_L(n) asm volatile("s_waitcnt lgkmcnt(" #n ")" ::: "memory")
#define PG8_BAR __builtin_amdgcn_s_barrier()
#define PG8_SCHED __builtin_amdgcn_sched_barrier(0)
    Unit cur, nxt; int ui = 0;
    if (!S.next(0, cur)) return;
    f32x4 acc[2][2][4][2];
#pragma unroll
    for (int a = 0; a < 2; ++a)
#pragma unroll
        for (int b = 0; b < 2; ++b)
#pragma unroll
            for (int m = 0; m < 4; ++m)
#pragma unroll
                for (int n = 0; n < 2; ++n) acc[a][b][m][n] = (f32x4){0.f, 0.f, 0.f, 0.f};
    bf16x8 At[4][2], B0[2][2], B1[2][2];
    const char* cA = (const char*)g.A + (size_t)cur.pm * tstepA; const char* cB = (const char*)g.Bt + (size_t)cur.pn * tstepB;
    S.a_ready(cur);
    PG8_STAGE(PG8_SB(0, 0), cB, voffB); PG8_STAGE(PG8_SA(0, 0), cA, voffA); PG8_STAGE(PG8_SB(0, 1), cB + hstepB, voffB); PG8_STAGE(PG8_SA(0, 1), cA + hstepA, voffA);
    if (wr == 1) PG8_BAR;
    PG8_WAIT_V(4); PG8_BAR;
    PG8_STAGE(PG8_SB(1, 0), cB + kstep, voffB); PG8_STAGE(PG8_SA(1, 0), cA + kstep, voffA); PG8_STAGE(PG8_SB(1, 1), cB + hstepB + kstep, voffB);
    PG8_WAIT_V(6); PG8_BAR;
    PG8_STAMP();
    for (;;) {
        const bool has_next = S.next(ui + 1, nxt);
        const char* nA = has_next ? (const char*)g.A + (size_t)nxt.pm * tstepA : cA; const char* nB = has_next ? (const char*)g.Bt + (size_t)nxt.pn * tstepB : cB;
        for (int t = 0; t < nt; t += 2) {
            const bool last = (t == nt - 2);
            const char* a1 = cA + (size_t)(t + 1) * kstep;
            const char* a2 = last ? nA : cA + (size_t)(t + 2) * kstep; const char* b2 = last ? nB : cB + (size_t)(t + 2) * kstep;
            const char* a3 = a2 + kstep; const char* b3 = b2 + kstep;
            if (last && has_next) S.a_ready(nxt);
            PG8_LDB(B0, 0, 0); PG8_SCHED; PG8_LDA(At, 0, 0); PG8_STAGE(PG8_SA(1, 1), a1 + hstepA, voffA);
            PG8_WAIT_L(8); PG8_BAR; PG8_WAIT_L(0); PG8_MMA(0, 0, At, B0); PG8_BAR; PG8_SCHED;
            PG8_LDB(B1, 0, 1); PG8_STAGE(PG8_SB(0, 0), b2, voffB);
            PG8_BAR; PG8_WAIT_L(0); PG8_MMA(0, 1, At, B1); PG8_BAR;
            PG8_LDA(At, 0, 1); PG8_STAGE(PG8_SA(0, 0), a2, voffA);
            PG8_BAR; PG8_WAIT_L(0); PG8_MMA(1, 0, At, B0); PG8_BAR; PG8_SCHED;
            PG8_STAGE(PG8_SB(0, 1), b2 + hstepB, voffB);
            PG8_WAIT_V(6); PG8_BAR; PG8_MMA(1, 1, At, B1); PG8_BAR;
            PG8_LDB(B0, 1, 0); PG8_SCHED; PG8_LDA(At, 1, 0); PG8_STAGE(PG8_SA(0, 1), a2 + hstepA, voffA);
            PG8_WAIT_L(8); PG8_BAR; PG8_WAIT_L(0); PG8_MMA(0, 0, At, B0); PG8_BAR; PG8_SCHED;
            PG8_LDB(B1, 1, 1); PG8_STAGE(PG8_SB(1, 0), b3, voffB);
            PG8_BAR; PG8_WAIT_L(0); PG8_MMA(0, 1, At, B1); PG8_BAR;
            PG8_LDA(At, 1, 1); PG8_STAGE(PG8_SA(1, 0), a3, voffA);
            PG8_BAR; PG8_WAIT_L(0); PG8_MMA(1, 0, At, B0); PG8_BAR; PG8_SCHED;
            PG8_STAGE(PG8_SB(1, 1), b3 + hstepB, voffB);
            PG8_WAIT_V(6); PG8_BAR; PG8_MMA(1, 1, At, B1); PG8_BAR;
        }
        PG8_STAMP();
        if constexpr (!Epi::AFTER_DRAIN) { E(acc, cur, wr, wc, fr, fq); S.done(cur); }
        PG8_STAMP();
        if (!has_next) break;
#pragma unroll
        for (int a = 0; a < 2; ++a)
#pragma unroll
            for (int b = 0; b < 2; ++b)
#pragma unroll
                for (int m = 0; m < 4; ++m)
#pragma unroll
                    for (int n = 0; n < 2; ++n) acc[a][b][m][n] = (f32x4){0.f, 0.f, 0.f, 0.f};
        cur = nxt; cA = nA; cB = nB; ++ui;
    }
    PG8_WAIT_V(0);
    if (wr == 0) PG8_BAR;
    PG8_BAR;
    if constexpr (Epi::AFTER_DRAIN) { E.fused(acc, cur, wr, wc, fr, fq, lds, wid, lane); S.done(cur); }
    PG8_STAMP();
    if (STAMP && wid == 0) { stamps[lane] = lane < nts ? (((unsigned long long)(unsigned)ts_hi << 32) | (unsigned)ts_lo) : 0ull;
        if (lane == 62) stamps[62] = rt_entry; if (lane == 63) stamps[63] = (unsigned long long)wall_clock64(); }
#undef PG8_STAMP
#undef PG8_SA
#undef PG8_SB
#undef PG8_STAGE
#undef PG8_LDA
#undef PG8_LDB
#undef PG8_MMA
#undef PG8_WAIT_V
#undef PG8_WAIT_L
#undef PG8_BAR
#undef PG8_SCHED
}
}

struct EpiBf {
  static constexpr bool PERM = true, AFTER_DRAIN = false;
  u16* O; int ldc; const float* bias; int act;
  __device__ __forceinline__ void operator()(const f32x4 (&acc)[2][2][4][2], const pg8::Unit& u, int wr, int wc, int fr, int fq) const {
    const int row0 = u.pm * 256 + wr * 64 + fr, col0 = u.pn * 256 + wc * 32 + 8 * fq;
    f32x4 bv[2][2];
#pragma unroll
    for (int bj = 0; bj < 2; ++bj)
#pragma unroll
      for (int n = 0; n < 2; ++n) bv[bj][n] = bias ? *(const f32x4*)(bias + col0 + bj * 128 + 4 * n) : f32x4{0.f, 0.f, 0.f, 0.f};
#pragma unroll
    for (int ai = 0; ai < 2; ++ai)
#pragma unroll
      for (int m = 0; m < 4; ++m) {
        u16* rowp = O + (size_t)(row0 + ai * 128 + m * 16) * ldc + col0;
#pragma unroll
        for (int bj = 0; bj < 2; ++bj) {
          f32x4 v0 = acc[ai][bj][m][0] + bv[bj][0], v1 = acc[ai][bj][m][1] + bv[bj][1];
          if (act == 1) {
#pragma unroll
            for (int j = 0; j < 4; ++j) { v0[j] = sigm(v0[j]); v1[j] = sigm(v1[j]); }
          }
          uint4 wv;
          wv.x = pack2(v0[0], v0[1]); wv.y = pack2(v0[2], v0[3]); wv.z = pack2(v1[0], v1[1]); wv.w = pack2(v1[2], v1[3]);
          *(uint4*)(rowp + bj * 128) = wv;
        }
      }
  }
};
struct EpiSwiglu {
  static constexpr bool PERM = true, AFTER_DRAIN = false;
  u16* O;
  __device__ __forceinline__ void operator()(const f32x4 (&acc)[2][2][4][2], const pg8::Unit& u, int wr, int wc, int fr, int fq) const {
    const int row0 = u.pm * 256 + wr * 64 + fr, col0 = u.pn * 128 + wc * 16 + 4 * fq;
#pragma unroll
    for (int ai = 0; ai < 2; ++ai)
#pragma unroll
      for (int m = 0; m < 4; ++m) {
        u16* rowp = O + (size_t)(row0 + ai * 128 + m * 16) * FH + col0;
#pragma unroll
        for (int bj = 0; bj < 2; ++bj) {
          const f32x4 g = acc[ai][bj][m][0], up = acc[ai][bj][m][1];
          uint2 wv;
          wv.x = pack2(siluf(g[0]) * up[0], siluf(g[1]) * up[1]);
          wv.y = pack2(siluf(g[2]) * up[2], siluf(g[3]) * up[3]);
          *(uint2*)(rowp + bj * 64) = wv;
        }
      }
  }
};
struct EpiGateAcc {
  static constexpr bool PERM = true, AFTER_DRAIN = false;
  u16* ACC; const u16* G; int gcol; unsigned amask;
  __device__ __forceinline__ void operator()(const f32x4 (&acc)[2][2][4][2], const pg8::Unit& u, int wr, int wc, int fr, int fq) const {
    unsigned pk[2][2][4][4];
#pragma unroll
    for (int ai = 0; ai < 2; ++ai)
#pragma unroll
      for (int bj = 0; bj < 2; ++bj)
#pragma unroll
        for (int m = 0; m < 4; ++m) {
          pk[ai][bj][m][0] = pack2(acc[ai][bj][m][0][0], acc[ai][bj][m][0][1]);
          pk[ai][bj][m][1] = pack2(acc[ai][bj][m][0][2], acc[ai][bj][m][0][3]);
          pk[ai][bj][m][2] = pack2(acc[ai][bj][m][1][0], acc[ai][bj][m][1][1]);
          pk[ai][bj][m][3] = pack2(acc[ai][bj][m][1][2], acc[ai][bj][m][1][3]);
        }
    asm volatile("" ::: "memory");
    const int row0 = u.pm * 256 + wr * 64 + fr, col0 = u.pn * 256 + wc * 32 + 8 * fq;
#pragma unroll
    for (int ai = 0; ai < 2; ++ai)
#pragma unroll
      for (int m = 0; m < 4; ++m) {
        const size_t row = (size_t)(row0 + ai * 128 + m * 16);
#pragma unroll
        for (int bj = 0; bj < 2; ++bj) {
          const int col = col0 + bj * 128;
          const uint4 gv = *(const uint4*)(G + row * 2048 + gcol + col);
          const uint4 av = *(const uint4*)(ACC + row * DM + col);
          const unsigned gw[4] = {gv.x, gv.y, gv.z, gv.w};
          const unsigned aw[4] = {av.x & amask, av.y & amask, av.z & amask, av.w & amask};
          unsigned ow[4];
#pragma unroll
          for (int q = 0; q < 4; ++q) {
            const unsigned pv = pk[ai][bj][m][q];
            const float lo = __uint_as_float(aw[q] << 16) + __uint_as_float(gw[q] << 16) * __uint_as_float(pv << 16);
            const float hi = __uint_as_float(aw[q] & 0xffff0000u) + __uint_as_float(gw[q] & 0xffff0000u) * __uint_as_float(pv & 0xffff0000u);
            ow[q] = pack2(lo, hi);
          }
          *(uint4*)(ACC + row * DM + col) = make_uint4(ow[0], ow[1], ow[2], ow[3]);
        }
        asm volatile("" ::: "memory");
      }
  }
};

template <int MI>
__device__ __forceinline__ void gemm_loop(const u16* __restrict__ A, int lda, const u16* __restrict__ Bt, int ldb, int K,
                                          f32x4 (&acc)[MI][4], u16* sA, u16* sB) {
  constexpr int BMT = MI * 64;
  const int tid = TIDX, lane = tid & 63, w = tid >> 6, wm = w >> 1, wn = w & 1, fr = lane & 15, fq = lane >> 4;
  uint4 ra[MI], rb[2];
  const u16* ga = A + (size_t)(tid >> 3) * lda + (tid & 7) * 8;
  const u16* gb = Bt + (size_t)(tid >> 3) * ldb + (tid & 7) * 8;
  const int so = (tid >> 3) * LDT + (tid & 7) * 8;
#pragma unroll
  for (int i = 0; i < MI; i++) ra[i] = *(const uint4*)(ga + (size_t)(i * 64) * lda);
#pragma unroll
  for (int i = 0; i < 2; i++) rb[i] = *(const uint4*)(gb + (size_t)(i * 64) * ldb);
#pragma unroll
  for (int i = 0; i < MI; i++) *(uint4*)(sA + so + i * 64 * LDT) = ra[i];
#pragma unroll
  for (int i = 0; i < 2; i++) *(uint4*)(sB + so + i * 64 * LDT) = rb[i];
  __syncthreads();
  const int nk = K >> 6;
  for (int kt = 0; kt < nk; kt++) {
    const bool more = kt + 1 < nk;
    if (more) {
#pragma unroll
      for (int i = 0; i < MI; i++) ra[i] = *(const uint4*)(ga + (size_t)(i * 64) * lda + (kt + 1) * 64);
#pragma unroll
      for (int i = 0; i < 2; i++) rb[i] = *(const uint4*)(gb + (size_t)(i * 64) * ldb + (kt + 1) * 64);
    }
    const u16* a = sA + (kt & 1) * BMT * LDT + (wm * (MI * 16) + fr) * LDT + fq * 8;
    const u16* b = sB + (kt & 1) * 128 * LDT + (wn * 64 + fr) * LDT + fq * 8;
#pragma unroll
    for (int ks = 0; ks < 2; ks++) {
      bf16x8 af[MI], bfr[4];
#pragma unroll
      for (int i = 0; i < MI; i++) af[i] = *(const bf16x8*)(a + i * 16 * LDT + ks * 32);
#pragma unroll
      for (int j = 0; j < 4; j++) bfr[j] = *(const bf16x8*)(b + j * 16 * LDT + ks * 32);
#pragma unroll
      for (int i = 0; i < MI; i++)
#pragma unroll
        for (int j = 0; j < 4; j++) acc[i][j] = __builtin_amdgcn_mfma_f32_16x16x32_bf16(bfr[j], af[i], acc[i][j], 0, 0, 0);
    }
    if (more) {
      u16* da = sA + ((kt + 1) & 1) * BMT * LDT + so;
      u16* db = sB + ((kt + 1) & 1) * 128 * LDT + so;
#pragma unroll
      for (int i = 0; i < MI; i++) *(uint4*)(da + i * 64 * LDT) = ra[i];
#pragma unroll
      for (int i = 0; i < 2; i++) *(uint4*)(db + i * 64 * LDT) = rb[i];
    }
    __syncthreads();
  }
}

template <int MI>
__device__ __forceinline__ void zero_acc(f32x4 (&acc)[MI][4]) {
#pragma unroll
  for (int i = 0; i < MI; i++)
#pragma unroll
    for (int j = 0; j < 4; j++) acc[i][j] = f32x4{0.f, 0.f, 0.f, 0.f};
}


typedef unsigned u32x4v __attribute__((ext_vector_type(4)));
__device__ __forceinline__ void yp_issue(const u16* __restrict__ A, const u16* __restrict__ B, u32x4v (&ra)[8], u32x4v (&rb)[8], int tid) {
#pragma unroll
  for (int i = 0; i < 8; i++) {
    const int c = tid + i * NTHR, row = c >> 5, ch = c & 31;
    ra[i] = *(const u32x4v*)(A + (size_t)row * YST + ch * 8);
    rb[i] = *(const u32x4v*)(B + (size_t)row * 256 + ch * 8);
  }
}
__device__ __forceinline__ void yp_stage(unsigned char* sA, unsigned char* sB, const u32x4v (&ra)[8], const u32x4v (&rb)[8], int tid) {
#pragma unroll
  for (int i = 0; i < 8; i++) {
    const int c = tid + i * NTHR, row = c >> 5, ch = c & 31;
    const int off = row * 512 + ((ch ^ (row & 7)) << 4);
    *(u32x4v*)(sA + off) = ra[i];
    *(u32x4v*)(sB + off) = rb[i];
  }
}
__device__ __forceinline__ void phase_ypart(const Params& p, int l, unsigned char* smem) {
  unsigned char* sA = smem;
  unsigned char* sB = smem + 65536;
  const int tid = TIDX, lane = tid & 63, w = tid >> 6, wm = w >> 1, wn = w & 1, fr = lane & 15, fq = lane >> 4;
  const u16* Y = (const u16*)(p.ws + OFF_YS);
  const u16* Wb = (const u16*)(p.ws + OFF_W + OW_B);
  const u16* G = (const u16*)(p.ws + OFF_BIG);
  u16* ACC = (u16*)(p.ws + OFF_H);
  constexpr int NT = 8;
  const int ntiles = (NROWS / 128) * NT;
  const int G_ = gridDim.x;
  const bool xmap = (G_ == 256);
  const int xj = blockIdx.x >> 3, xx = blockIdx.x & 7;
  const bool skipc = (l == 1);
  const int nrt = skipc ? 256 : 272;
  const int ntl = nrt * NT;
  const int nmine = xmap ? (xj < nrt ? (nrt - 1 - xj) / 32 + 1 : 0)
                         : (((int)blockIdx.x < ntl) ? (ntl - 1 - (int)blockIdx.x) / G_ + 1 : 0);
  if (nmine == 0) return;
#define YP_TILE(Q_, MT_, NT_)                                                        \
  do {                                                                               \
    if (xmap) { const int s_ = (Q_) * 32 + xj; MT_ = (s_ >> 3) * 8 + xx; NT_ = s_ & 7; } \
    else { const int t_ = blockIdx.x + (Q_) * G_; MT_ = t_ / NT; NT_ = t_ - MT_ * NT; }  \
    if (skipc) MT_ = (MT_ >> 5) * 34 + 2 + (MT_ & 31);                                   \
  } while (0)
  u32x4v ra[8], rb[8];
  {
    int mt, nt;
    YP_TILE(0, mt, nt);
    yp_issue(Y + (size_t)mt * 128 * YST, Wb + ((size_t)nt * 128) * 256, ra, rb, tid);
  }
  f32x4 tot[2][4];
  zero_acc<2>(tot);
  for (int qi = 0; qi < 4 * nmine; qi++) {
    const int q = qi >> 2, k = qi & 3;
    int mt, nt;
    YP_TILE(q, mt, nt);
    const int r0 = mt * 128 + wm * 32 + fr, c0 = nt * 128 + wn * 64 + fq * 4;
    __syncthreads();
    yp_stage(sA, sB, ra, rb, tid);
    __syncthreads();
    {
      const int qn = qi + 1 < 4 * nmine ? qi + 1 : qi;
      int mtn, ntn;
      YP_TILE(qn >> 2, mtn, ntn);
      const int brn = qn & 3, ycn = brn < 3 ? brn * 256 : 1536;
      yp_issue(Y + (size_t)mtn * 128 * YST + ycn, Wb + ((size_t)brn * 1024 + ntn * 128) * 256, ra, rb, tid);
    }
    uint2 gv[2][4];
#pragma unroll
    for (int i = 0; i < 2; i++)
#pragma unroll
      for (int j = 0; j < 4; j++) gv[i][j] = *(const uint2*)(G + (size_t)(r0 + i * 16) * 4096 + k * 1024 + c0 + j * 16);
    f32x4 ay[2][4];
    zero_acc<2>(ay);
#pragma unroll 2
    for (int ks = 0; ks < 8; ks++) {
      bf16x8 af[2], bfr[4];
#pragma unroll
      for (int i = 0; i < 2; i++) {
        const int row = wm * 32 + i * 16 + fr;
        af[i] = *(const bf16x8*)(sA + row * 512 + (((ks * 4 + fq) ^ (row & 7)) << 4));
      }
#pragma unroll
      for (int j = 0; j < 4; j++) {
        const int row = wn * 64 + j * 16 + fr;
        bfr[j] = *(const bf16x8*)(sB + row * 512 + (((ks * 4 + fq) ^ (row & 7)) << 4));
      }
#pragma unroll
      for (int i = 0; i < 2; i++)
#pragma unroll
        for (int j = 0; j < 4; j++) ay[i][j] = __builtin_amdgcn_mfma_f32_16x16x32_bf16(bfr[j], af[i], ay[i][j], 0, 0, 0);
    }
#pragma unroll
    for (int i = 0; i < 2; i++)
#pragma unroll
      for (int j = 0; j < 4; j++) {
        tot[i][j][0] += __uint_as_float(gv[i][j].x << 16) * ay[i][j][0];
        tot[i][j][1] += __uint_as_float(gv[i][j].x & 0xffff0000u) * ay[i][j][1];
        tot[i][j][2] += __uint_as_float(gv[i][j].y << 16) * ay[i][j][2];
        tot[i][j][3] += __uint_as_float(gv[i][j].y & 0xffff0000u) * ay[i][j][3];
      }
    if (k == 3) {
#pragma unroll
      for (int i = 0; i < 2; i++)
#pragma unroll
        for (int j = 0; j < 4; j++) {
          uint2 ov;
          ov.x = pack2(tot[i][j][0], tot[i][j][1]); ov.y = pack2(tot[i][j][2], tot[i][j][3]);
          *(uint2*)(ACC + (size_t)(r0 + i * 16) * DM + c0 + j * 16) = ov;
        }
      zero_acc<2>(tot);
    }
  }
  __syncthreads();
#undef YP_TILE
}

#define S2_BUF 10816
#define S2_D 0
#define S2_U 2048
#define S2_P 4096
#define S2_K 6144
#define S2_DQ 8192
#define S2_V 10240
#define S2_C1 10752
#define S2_C2 10784
#define S2_ST (2 * S2_BUF)
#define S2_YB (S2_ST + 8192)

__device__ __forceinline__ float red16(float x) {
  x += dppf<0xB1>(x);
  x += dppf<0x4E>(x);
  x += dppf<0x141>(x);
  x += dppf<0x140>(x);
  return x;
}
__device__ __forceinline__ void wave_lds_sync() {
  asm volatile("s_waitcnt lgkmcnt(0)" ::: "memory");
  __builtin_amdgcn_wave_barrier();
}

template <int MIX>
__device__ __forceinline__ void scan2_item(const Params& p, int l, int b, int h, int dir, int rq, float* sm) {
  constexpr int EPL = (MIX == 2) ? 2 : 4;
  constexpr int VOFF = (MIX == 2) ? 64 : 128;
  const int tid = TIDX, lane = tid & 63, w = tid >> 6, fr = lane & 15, fq = lane >> 4;
  const bool producer = w >= 4;
  const int pw = w & 3;
  const u16* P = (const u16*)(p.ws + OFF_BIG);
  u16* YS = (u16*)(p.ws + OFF_YS);
  float* BC = (float*)(p.ws + OFF_BC);
  float* ST = sm + S2_ST + pw * 2048;
  float s[EPL];
#pragma unroll
  for (int i = 0; i < EPL; i++) s[i] = 0.f;

  bf16x8 bw2[4], ba2[4];
  float cst[5][4];
  float cw[3][7];
  float muv[4];
  int colv[4];
#pragma unroll
  for (int i = 0; i < 4; i++) { bw2[i] = bf16x8{0, 0, 0, 0, 0, 0, 0, 0}; ba2[i] = bw2[i]; muv[i] = 0.f; colv[i] = 0; }
  if (producer) {
    if (MIX == 0) {
#pragma unroll
      for (int nt = 0; nt < 4; nt++) {
        const int jch = h * 64 + nt * 16 + fr;
#pragma unroll
        for (int jj = 0; jj < 8; jj++) {
          bw2[nt][jj] = (short)f2bf(p.rwkv_w2[((size_t)(l * 2 + dir) * 32 + fq * 8 + jj) * 256 + jch]);
          ba2[nt][jj] = (short)f2bf(p.rwkv_a2[((size_t)(l * 2 + dir) * 32 + fq * 8 + jj) * 256 + jch]);
        }
        cst[0][nt] = p.rwkv_w0[(l * 2 + dir) * 256 + jch];
        cst[1][nt] = p.rwkv_a0[(l * 2 + dir) * 256 + jch];
        cst[2][nt] = p.rwkv_ka[l * 256 + jch];
        cst[3][nt] = p.rwkv_kk[l * 256 + jch];
        cst[4][nt] = p.rwkv_rk[l * 256 + jch];
      }
#pragma unroll
      for (int i = 0; i < 4; i++) {
        const int c = lane + 64 * i;
        colv[i] = i < 3 ? i * 256 + h * 64 + lane : (lane < 32 ? 768 + dir * 32 + lane : 832 + dir * 32 + (lane - 32));
        muv[i] = p.rwkv_mu[l * 960 + colv[i]];
        (void)c;
      }
    } else if (MIX == 1) {
#pragma unroll
      for (int i = 0; i < 3; i++) {
        colv[i] = PB + i * 256 + h * 64 + lane;
#pragma unroll
        for (int tp = 0; tp < 7; tp++) cw[i][tp] = p.gdn_conv[((size_t)l * 7 + tp) * 768 + i * 256 + h * 64 + lane];
      }
    } else {
#pragma unroll
      for (int nt = 0; nt < 2; nt++) {
#pragma unroll
        for (int jj = 0; jj < 8; jj++)
          bw2[nt][jj] = fq < 2 ? (short)f2bf(p.gla_gw2[((size_t)(l * 2 + dir) * 16 + fq * 8 + jj) * 128 + h * 32 + nt * 16 + fr]) : (short)0;
        cst[0][nt] = p.gla_gb[(l * 2 + dir) * 128 + h * 32 + nt * 16 + fr];
      }
      colv[0] = PC + h * 32 + lane;
      if (lane >= 32) colv[0] = PC + 128 + h * 32 + (lane - 32);
      colv[1] = PC + 256 + h * 64 + lane;
      colv[2] = PC + 512 + dir * 16 + (lane & 15);
    }
  }
  __syncthreads();

  for (int c = 0; c <= TPB / 32 + 1; c++) {
    if (producer) {
      if (c >= 2) {
        const int cc = c - 2;
        int seg_row0, t_lo;
        if (cc < 8) { seg_row0 = b * TPB; t_lo = dir == 0 ? cc * 32 : (LC - 32 - cc * 32); }
        else { seg_row0 = b * TPB + LC; t_lo = dir == 0 ? (cc - 8) * 32 : (SEQ - 32 - (cc - 8) * 32); }
        const float* yb = sm + S2_YB + (cc & 1) * 512;
        const int t2 = tid - 256;
#pragma unroll
        for (int i = 0; i < 2; i++) {
          const int idx = t2 + i * 256, tt = idx >> 4, e = idx & 15;
          YS[(size_t)(seg_row0 + t_lo + tt) * YST + dir * 768 + MIX * 256 + h * 64 + rq * 16 + e] = f2bf(yb[idx]);
        }
      }
      if (c < TPB / 32) {
        int seg_row0, seg_len, t_lo;
        if (c < 8) { seg_row0 = b * TPB; seg_len = LC; t_lo = dir == 0 ? c * 32 : (LC - 32 - c * 32); }
        else { seg_row0 = b * TPB + LC; seg_len = SEQ; t_lo = dir == 0 ? (c - 8) * 32 : (SEQ - 32 - (c - 8) * 32); }
        const u16* Pseg = P + (size_t)seg_row0 * PST;
        float* B = sm + (c & 1) * S2_BUF;
        const int t0 = t_lo + pw * 8;
        if (MIX == 0) {
          float raw[10][4];
#pragma unroll
          for (int rr = 0; rr < 10; rr++) {
            const int t = t0 - 1 + rr;
            const float okf = (t >= 0 && t < seg_len) ? 1.f : 0.f;
            const int tc = min(max(t, 0), seg_len - 1);
#pragma unroll
            for (int i = 0; i < 4; i++) raw[rr][i] = bf2f(Pseg[(size_t)tc * PST + PA + colv[i]]) * okf;
          }
#pragma unroll
          for (int j = 0; j < 8; j++)
#pragma unroll
            for (int i = 0; i < 4; i++) {
              float xm = raw[j + 1][i] + (0.5f * (raw[j][i] + raw[j + 2][i]) - raw[j + 1][i]) * muv[i];
              if (i == 3 && lane < 32) xm = tanh_fast(xm);
              ST[j * 256 + lane + 64 * i] = xm;
            }
        } else if (MIX == 1) {
          float raw[14][3];
#pragma unroll
          for (int rr = 0; rr < 14; rr++) {
            const int t = t0 - 3 + rr;
            const float okf = (t >= 0 && t < seg_len) ? 1.f : 0.f;
            const int tc = min(max(t, 0), seg_len - 1);
#pragma unroll
            for (int i = 0; i < 3; i++) raw[rr][i] = bf2f(Pseg[(size_t)tc * PST + colv[i]]) * okf;
          }
#pragma unroll
          for (int j = 0; j < 8; j++)
#pragma unroll
            for (int i = 0; i < 3; i++) {
              float a = 0.f;
#pragma unroll
              for (int tp = 0; tp < 7; tp++) a += raw[j + tp][i] * cw[i][tp];
              ST[j * 256 + lane + 64 * i] = siluf(a);
            }
          if (lane < 8) {
            const u16* pp = Pseg + (size_t)(t0 + lane) * PST + PB;
            float bx = bf2f(pp[768 + dir * 4 + h]);
            float ax = bf2f(pp[776 + dir * 4 + h]);
            float ld = -__expf(p.gdn_a_log[(l * 2 + dir) * 4 + h]) * softplusf(ax + p.gdn_dt_bias[(l * 2 + dir) * 4 + h]);
            ST[lane * 256 + 192] = sigm(bx);
            ST[lane * 256 + 193] = __expf(ld);
          }
        } else {
          u16 raw[8][3];
#pragma unroll
          for (int j = 0; j < 8; j++) {
            const u16* pp = Pseg + (size_t)(t0 + j) * PST;
#pragma unroll
            for (int i = 0; i < 3; i++) raw[j][i] = pp[colv[i]];
          }
          const float qs = lane < 32 ? 0.17677669529663687f : 1.f;
#pragma unroll
          for (int j = 0; j < 8; j++) {
            ST[j * 256 + lane] = bf2f(raw[j][0]) * qs;
            ST[j * 256 + 64 + lane] = bf2f(raw[j][1]);
            if (lane < 16) ST[j * 256 + 128 + lane] = bf2f(raw[j][2]);
          }
        }
        wave_lds_sync();
        const bool vl = fq < 2;
        if (MIX == 0) {
          bf16x8 aw, aa;
#pragma unroll
          for (int jj = 0; jj < 8; jj++) {
            aw[jj] = fr < 8 ? (short)f2bf(ST[fr * 256 + 192 + fq * 8 + jj]) : (short)0;
            aa[jj] = fr < 8 ? (short)f2bf(ST[fr * 256 + 224 + fq * 8 + jj]) : (short)0;
          }
          f32x4 accw[4], acca[4];
#pragma unroll
          for (int nt = 0; nt < 4; nt++) {
            accw[nt] = __builtin_amdgcn_mfma_f32_16x16x32_bf16(aw, bw2[nt], f32x4{0.f, 0.f, 0.f, 0.f}, 0, 0, 0);
            acca[nt] = __builtin_amdgcn_mfma_f32_16x16x32_bf16(aa, ba2[nt], f32x4{0.f, 0.f, 0.f, 0.f}, 0, 0, 0);
          }
#pragma unroll
          for (int r = 0; r < 4; r++) {
            const int j = (fq & 1) * 4 + r, tt = pw * 8 + j;
            float kkx[4], av[4], kdv[4], rv[4], dec[4];
            float ss = 0.f;
#pragma unroll
            for (int nt = 0; nt < 4; nt++) {
              const int n = nt * 16 + fr;
              rv[nt] = ST[j * 256 + n];
              const float kx = ST[j * 256 + 64 + n];
              dec[nt] = __expf(-0.6065306597126334f * sigm(cst[0][nt] + accw[nt][r]));
              av[nt] = sigm(cst[1][nt] + acca[nt][r]);
              kdv[nt] = kx * (1.f + (av[nt] - 1.f) * cst[2][nt]);
              kkx[nt] = kx * cst[3][nt];
              ss += kkx[nt] * kkx[nt];
            }
            ss = red16(ss);
            const float rs = rsq(ss + 1e-6f);
            float c1 = 0.f, c2 = 0.f, bc = 0.f;
#pragma unroll
            for (int nt = 0; nt < 4; nt++) {
              const int n = nt * 16 + fr;
              const float kk = kkx[nt] * rs;
              if (vl) {
                B[S2_D + tt * 64 + n] = dec[nt];
                B[S2_U + tt * 64 + n] = kk;
                B[S2_P + tt * 64 + n] = -kk * av[nt];
                B[S2_K + tt * 64 + n] = kdv[nt];
                B[S2_DQ + tt * 64 + n] = dec[nt] * rv[nt];
              }
              c1 += -kk * av[nt] * rv[nt];
              c2 += kdv[nt] * rv[nt];
              bc += rv[nt] * kdv[nt] * cst[4][nt];
            }
            c1 = red16(c1); c2 = red16(c2); bc = red16(bc);
            if (vl && fr == 0) {
              B[S2_C1 + tt] = c1;
              B[S2_C2 + tt] = c2;
              if (rq == 0) BC[(size_t)(seg_row0 + t_lo + tt) * 8 + h * 2 + dir] = bc;
            }
          }
        } else if (MIX == 1) {
#pragma unroll
          for (int r = 0; r < 4; r++) {
            const int j = (fq & 1) * 4 + r, tt = pw * 8 + j;
            float qv[4], kv[4];
            float sq = 0.f, sk = 0.f;
#pragma unroll
            for (int nt = 0; nt < 4; nt++) {
              const int n = nt * 16 + fr;
              qv[nt] = ST[j * 256 + n];
              kv[nt] = ST[j * 256 + 64 + n];
              sq += qv[nt] * qv[nt];
              sk += kv[nt] * kv[nt];
            }
            sq = red16(sq); sk = red16(sk);
            const float rq_ = rsq(sq + 1e-6f) * 0.125f, rk_ = rsq(sk + 1e-6f);
            const float beta = ST[j * 256 + 192], alpha = ST[j * 256 + 193];
            float dkq = 0.f;
#pragma unroll
            for (int nt = 0; nt < 4; nt++) {
              const int n = nt * 16 + fr;
              const float qn = qv[nt] * rq_, kn = kv[nt] * rk_;
              if (vl) {
                B[S2_D + tt * 64 + n] = alpha;
                B[S2_U + tt * 64 + n] = kn;
                B[S2_P + tt * 64 + n] = -alpha * beta * kn;
                B[S2_K + tt * 64 + n] = beta * kn;
                B[S2_DQ + tt * 64 + n] = alpha * qn;
              }
              dkq += kn * qn;
            }
            dkq = red16(dkq);
            if (vl && fr == 0) {
              B[S2_C1 + tt] = -alpha * beta * dkq;
              B[S2_C2 + tt] = beta * dkq;
            }
          }
        } else {
          bf16x8 ag;
#pragma unroll
          for (int jj = 0; jj < 8; jj++) ag[jj] = (fr < 8 && fq < 2) ? (short)f2bf(ST[fr * 256 + 128 + fq * 8 + jj]) : (short)0;
          f32x4 accg[2];
#pragma unroll
          for (int nt = 0; nt < 2; nt++) accg[nt] = __builtin_amdgcn_mfma_f32_16x16x32_bf16(ag, bw2[nt], f32x4{0.f, 0.f, 0.f, 0.f}, 0, 0, 0);
#pragma unroll
          for (int r = 0; r < 4; r++) {
            const int j = (fq & 1) * 4 + r, tt = pw * 8 + j;
            float dkq = 0.f;
#pragma unroll
            for (int nt = 0; nt < 2; nt++) {
              const int n = nt * 16 + fr;
              const float lg = cst[0][nt] + accg[nt][r];
              const float ls = fminf(lg, 0.f) - __logf(1.f + __expf(-fabsf(lg)));
              const float alpha = __expf(ls * (1.f / 16.f));
              const float qv = ST[j * 256 + n], kv = ST[j * 256 + 32 + n];
              if (vl) {
                B[S2_D + tt * 64 + n] = alpha;
                B[S2_K + tt * 64 + n] = kv;
                B[S2_DQ + tt * 64 + n] = alpha * qv;
              }
              dkq += kv * qv;
            }
            dkq = red16(dkq);
            if (vl && fr == 0) B[S2_C2 + tt] = dkq;
          }
        }
#pragma unroll
        for (int i = 0; i < 2; i++) {
          const int idx = lane + 64 * i, j = idx >> 4, e = idx & 15;
          B[S2_V + (pw * 8 + j) * 16 + e] = ST[j * 256 + VOFF + rq * 16 + e];
        }
      }
    } else if (c >= 1 && c <= TPB / 32) {
      const float* B = sm + ((c - 1) & 1) * S2_BUF;
      float* yb = sm + S2_YB + ((c - 1) & 1) * 512;
      const int rl = w * 4 + fq;
      const int dtt = dir ? -1 : 1;
      int tt = dir ? 31 : 0;
      float dv[EPL], kv[EPL], qv[EPL], uv[EPL], pv[EPL], vv, c1v, c2v;
      float dn[EPL], kn[EPL], qn[EPL], un[EPL], pn[EPL], vn, c1n, c2n;
#define S2_LOAD(D_, K_, Q_, U_, P_, V_, C1_, C2_, T_)                                   \
  do {                                                                                  \
    const int o_ = (T_) * 64 + fr * EPL;                                                \
    if (EPL == 4) {                                                                     \
      float4 t4 = *(const float4*)(B + S2_D + o_);                                      \
      D_[0] = t4.x; D_[1] = t4.y; D_[2] = t4.z; D_[3] = t4.w;                           \
      t4 = *(const float4*)(B + S2_K + o_);                                             \
      K_[0] = t4.x; K_[1] = t4.y; K_[2] = t4.z; K_[3] = t4.w;                           \
      t4 = *(const float4*)(B + S2_DQ + o_);                                            \
      Q_[0] = t4.x; Q_[1] = t4.y; Q_[2] = t4.z; Q_[3] = t4.w;                           \
      t4 = *(const float4*)(B + S2_U + o_);                                             \
      U_[0] = t4.x; U_[1] = t4.y; U_[2] = t4.z; U_[3] = t4.w;                           \
      t4 = *(const float4*)(B + S2_P + o_);                                             \
      P_[0] = t4.x; P_[1] = t4.y; P_[2] = t4.z; P_[3] = t4.w;                           \
      C1_ = B[S2_C1 + (T_)];                                                            \
    } else {                                                                            \
      float2 t2 = *(const float2*)(B + S2_D + o_);                                      \
      D_[0] = t2.x; D_[1] = t2.y;                                                       \
      t2 = *(const float2*)(B + S2_K + o_);                                             \
      K_[0] = t2.x; K_[1] = t2.y;                                                       \
      t2 = *(const float2*)(B + S2_DQ + o_);                                            \
      Q_[0] = t2.x; Q_[1] = t2.y;                                                       \
      U_[0] = U_[1] = P_[0] = P_[1] = 0.f; C1_ = 0.f;                                   \
    }                                                                                   \
    V_ = B[S2_V + (T_) * 16 + rl];                                                      \
    C2_ = B[S2_C2 + (T_)];                                                              \
  } while (0)
#define S2_STEP(D_, K_, Q_, U_, P_, V_, C1_, C2_, T_)                                   \
  do {                                                                                  \
    float sq = 0.f, sa = 0.f;                                                           \
    _Pragma("unroll") for (int i = 0; i < EPL; i++) sq += s[i] * Q_[i];                 \
    if (MIX != 2) {                                                                     \
      _Pragma("unroll") for (int i = 0; i < EPL; i++) sa += s[i] * U_[i];               \
      sa = red16(sa);                                                                   \
    }                                                                                   \
    sq = red16(sq);                                                                     \
    float y = sq + V_ * C2_;                                                            \
    if (MIX != 2) y += sa * C1_;                                                        \
    _Pragma("unroll") for (int i = 0; i < EPL; i++) {                                   \
      float t = s[i] * D_[i] + V_ * K_[i];                                              \
      if (MIX != 2) t += sa * P_[i];                                                    \
      s[i] = t;                                                                         \
    }                                                                                   \
    yb[(T_) * 16 + rl] = y;                                                             \
  } while (0)
      S2_LOAD(dv, kv, qv, uv, pv, vv, c1v, c2v, tt);
#pragma unroll 1
      for (int st = 0; st < 32; st += 2) {
        const int t1 = tt + dtt;
        S2_LOAD(dn, kn, qn, un, pn, vn, c1n, c2n, t1);
        S2_STEP(dv, kv, qv, uv, pv, vv, c1v, c2v, tt);
        const int t2 = st + 2 < 32 ? t1 + dtt : t1;
        S2_LOAD(dv, kv, qv, uv, pv, vv, c1v, c2v, t2);
        S2_STEP(dn, kn, qn, un, pn, vn, c1n, c2n, t1);
        tt = t2;
      }
#undef S2_LOAD
#undef S2_STEP
    }
    __syncthreads();
  }
}

#define S3_SUB 12800
#define S3_GM 0
#define S3_KVT 9216
#define S3_QB 10240
#define S3_QV 11392
#define S3_VT 11520
#define S3_WC 12544
#define S3_STB (8 * S3_SUB)
#define S3_END (S3_STB + 4 * 2304)

__device__ __forceinline__ float rlane(float x, int l) { return __int_as_float(__builtin_amdgcn_readlane(__float_as_int(x), l)); }
__device__ __forceinline__ float wave_sum(float x) {
  x = red16(x);
  return (rlane(x, 0) + rlane(x, 16)) + (rlane(x, 32) + rlane(x, 48));
}
__device__ __forceinline__ float clampe(float x) { return fminf(fmaxf(x, -80.f), 80.f); }
__device__ __forceinline__ uint4 pack8(const float (&v)[8]) {
  return make_uint4(pack2(v[0], v[1]), pack2(v[2], v[3]), pack2(v[4], v[5]), pack2(v[6], v[7]));
}
__device__ __forceinline__ bf16x8 ld_frag(const void* p) { return *(const bf16x8*)p; }
__device__ __forceinline__ bf16x8 zfrag() { return bf16x8{0, 0, 0, 0, 0, 0, 0, 0}; }

__device__ __forceinline__ void chunk_geom(int c, int dir, int b, int& seg_row0, int& seg_len, int& t_lo) {
  if (c < 8) { seg_row0 = b * TPB; seg_len = LC; t_lo = dir == 0 ? c * 32 : (LC - 32 - c * 32); }
  else { seg_row0 = b * TPB + LC; seg_len = SEQ; t_lo = dir == 0 ? (c - 8) * 32 : (SEQ - 32 - (c - 8) * 32); }
}
template <int MIX>
__device__ __forceinline__ void fetch_raw(const u16* P, int c, int dir, int b, int h, int pw, int lane, const int (&colv)[4], unsigned (&rawq)[14][2]) {
  int seg_row0, seg_len, t_lo;
  chunk_geom(c, dir, b, seg_row0, seg_len, t_lo);
  const u16* Pseg = P + (size_t)seg_row0 * PST;
  const int t0 = t_lo + pw * 8;
  if (MIX == 0) {
#pragma unroll
    for (int rr = 0; rr < 10; rr++) {
      const int tc = min(max(t0 - 1 + rr, 0), seg_len - 1);
#pragma unroll
      for (int i = 0; i < 2; i++)
        rawq[rr][i] = (unsigned)Pseg[(size_t)tc * PST + PA + colv[2 * i]] | ((unsigned)Pseg[(size_t)tc * PST + PA + colv[2 * i + 1]] << 16);
    }
  } else if (MIX == 1) {
#pragma unroll
    for (int rr = 0; rr < 14; rr++) {
      const int tc = min(max(t0 - 3 + rr, 0), seg_len - 1);
      rawq[rr][0] = (unsigned)Pseg[(size_t)tc * PST + colv[0]] | ((unsigned)Pseg[(size_t)tc * PST + colv[1]] << 16);
      rawq[rr][1] = (rawq[rr][1] & 0xffff0000u) | (unsigned)Pseg[(size_t)tc * PST + colv[2]];
    }
    const u16* pp = Pseg + (size_t)(t0 + (lane & 7)) * PST + PB;
    rawq[0][1] = (rawq[0][1] & 0xffffu) | ((unsigned)pp[768 + dir * 4 + h] << 16);
    rawq[1][1] = (rawq[1][1] & 0xffffu) | ((unsigned)pp[776 + dir * 4 + h] << 16);
  } else {
#pragma unroll
    for (int j = 0; j < 8; j++) {
      const u16* pp = Pseg + (size_t)(t0 + j) * PST;
      rawq[j][0] = (unsigned)pp[colv[0]] | ((unsigned)pp[colv[1]] << 16);
      rawq[j][1] = (unsigned)pp[colv[2]];
    }
  }
}

template <int MIX>
__device__ __forceinline__ void scan3_item(const Params& p, int l, int b, int h, int dir, unsigned char* smb) {
  constexpr int VOFF = (MIX == 2) ? 64 : 128;
  constexpr bool DELTA = (MIX != 2);
  const int tid = TIDX, lane = tid & 63, w = tid >> 6, fr = lane & 15, fq = lane >> 4;
  const bool producer = true;
  const int pw = w & 3, half = w >> 2;
  const u16* P = (const u16*)(p.ws + OFF_BIG);
  u16* YS = (u16*)(p.ws + OFF_YS);
  float* BC = (float*)(p.ws + OFF_BC);
  float* ST = (float*)(smb + w * S3_SUB + S3_GM);
  unsigned char* STBY = smb + w * S3_SUB + S3_GM;
  const f32x4 z4 = f32x4{0.f, 0.f, 0.f, 0.f};
  f32x4 st[4];
#pragma unroll
  for (int i = 0; i < 4; i++) st[i] = z4;

  bf16x8 bw2[4], ba2[4];
  float cw[3][7];
  float muv[4];
  int colv[4];
  float c_w0 = 0.f, c_a0 = 0.f, c_ka = 0.f, c_kk = 0.f, c_rk = 0.f, c_gb = 0.f;
#pragma unroll
  for (int i = 0; i < 4; i++) { bw2[i] = zfrag(); ba2[i] = zfrag(); muv[i] = 0.f; colv[i] = 0; }
  if (producer) {
    if (MIX == 0) {
      {
        float tw[4][8], ta[4][8];
#pragma unroll
        for (int nt = 0; nt < 4; nt++)
#pragma unroll
          for (int jj = 0; jj < 8; jj++) {
            tw[nt][jj] = p.rwkv_w2[((size_t)(l * 2 + dir) * 32 + fq * 8 + jj) * 256 + h * 64 + nt * 16 + fr];
            ta[nt][jj] = p.rwkv_a2[((size_t)(l * 2 + dir) * 32 + fq * 8 + jj) * 256 + h * 64 + nt * 16 + fr];
          }
#pragma unroll
        for (int nt = 0; nt < 4; nt++)
#pragma unroll
          for (int jj = 0; jj < 8; jj++) { bw2[nt][jj] = (short)f2bf(tw[nt][jj]); ba2[nt][jj] = (short)f2bf(ta[nt][jj]); }
      }
      const int jl = h * 64 + lane;
      c_w0 = p.rwkv_w0[(l * 2 + dir) * 256 + jl];
      c_a0 = p.rwkv_a0[(l * 2 + dir) * 256 + jl];
      c_ka = p.rwkv_ka[l * 256 + jl];
      c_kk = p.rwkv_kk[l * 256 + jl];
      c_rk = p.rwkv_rk[l * 256 + jl];
#pragma unroll
      for (int i = 0; i < 4; i++) {
        colv[i] = i < 3 ? i * 256 + h * 64 + lane : (lane < 32 ? 768 + dir * 32 + lane : 832 + dir * 32 + (lane - 32));
        muv[i] = p.rwkv_mu[l * 960 + colv[i]];
      }
    } else if (MIX == 1) {
#pragma unroll
      for (int i = 0; i < 3; i++) {
        colv[i] = PB + i * 256 + h * 64 + lane;
#pragma unroll
        for (int tp = 0; tp < 7; tp++) cw[i][tp] = p.gdn_conv[((size_t)l * 7 + tp) * 768 + i * 256 + h * 64 + lane];
      }
    } else {
      {
        float tg[2][8];
#pragma unroll
        for (int nt = 0; nt < 2; nt++)
#pragma unroll
          for (int jj = 0; jj < 8; jj++) tg[nt][jj] = p.gla_gw2[((size_t)(l * 2 + dir) * 16 + (fq & 1) * 8 + jj) * 128 + h * 32 + nt * 16 + fr];
#pragma unroll
        for (int nt = 0; nt < 2; nt++)
#pragma unroll
          for (int jj = 0; jj < 8; jj++) bw2[nt][jj] = fq < 2 ? (short)f2bf(tg[nt][jj]) : (short)0;
      }
      c_gb = p.gla_gb[(l * 2 + dir) * 128 + h * 32 + (lane & 31)];
      colv[0] = PC + h * 32 + lane;
      if (lane >= 32) colv[0] = PC + 128 + h * 32 + (lane - 32);
      colv[1] = PC + 256 + h * 64 + lane;
      colv[2] = PC + 512 + dir * 16 + (lane & 15);
    }
  }
  __syncthreads();
  unsigned rawq[14][2];
#pragma unroll
  for (int i = 0; i < 14; i++) { rawq[i][0] = 0u; rawq[i][1] = 0u; }
  fetch_raw<MIX>(P, half, dir, b, h, pw, lane, colv, rawq);
#define RAWP(r_, i_) ((u16)((rawq[r_][(i_) >> 1] >> (((i_) & 1) * 16)) & 0xffffu))

  for (int it = 0; it < TPB / 64; it++) {
    {
      {
        const int c = it * 2 + half;
        int seg_row0, seg_len, t_lo;
        chunk_geom(c, dir, b, seg_row0, seg_len, t_lo);
        unsigned char* SB = smb + w * S3_SUB;
        const int t0 = t_lo + pw * 8;
        if (MIX == 0) {
          float raw[10][4];
#pragma unroll
          for (int rr = 0; rr < 10; rr++) {
            const int t = t0 - 1 + rr;
            const float okf = (t >= 0 && t < seg_len) ? 1.f : 0.f;
#pragma unroll
            for (int i = 0; i < 4; i++) raw[rr][i] = bf2f(RAWP(rr, i)) * okf;
          }
#pragma unroll
          for (int j = 0; j < 8; j++)
#pragma unroll
            for (int i = 0; i < 4; i++) {
              float xm = raw[j + 1][i] + (0.5f * (raw[j][i] + raw[j + 2][i]) - raw[j + 1][i]) * muv[i];
              if (i == 3 && lane < 32) xm = tanh_fast(xm);
              ST[j * 256 + lane + 64 * i] = xm;
            }
        } else if (MIX == 1) {
          float raw[14][3];
#pragma unroll
          for (int rr = 0; rr < 14; rr++) {
            const int t = t0 - 3 + rr;
            const float okf = (t >= 0 && t < seg_len) ? 1.f : 0.f;
#pragma unroll
            for (int i = 0; i < 3; i++) raw[rr][i] = bf2f(RAWP(rr, i)) * okf;
          }
#pragma unroll
          for (int j = 0; j < 8; j++)
#pragma unroll
            for (int i = 0; i < 3; i++) {
              float a = 0.f;
#pragma unroll
              for (int tp = 0; tp < 7; tp++) a += raw[j + tp][i] * cw[i][tp];
              ST[j * 256 + lane + 64 * i] = siluf(a);
            }
          if (lane < 8) {
            float bx = bf2f(RAWP(0, 3));
            float ax = bf2f(RAWP(1, 3));
            float ld = -__expf(p.gdn_a_log[(l * 2 + dir) * 4 + h]) * softplusf(ax + p.gdn_dt_bias[(l * 2 + dir) * 4 + h]);
            ST[lane * 256 + 192] = sigm(bx);
            ST[lane * 256 + 193] = ld;
          }
        } else {
          const float qs = lane < 32 ? 0.17677669529663687f : 1.f;
#pragma unroll
          for (int j = 0; j < 8; j++) {
            ST[j * 256 + lane] = bf2f(RAWP(j, 0)) * qs;
            ST[j * 256 + 64 + lane] = bf2f(RAWP(j, 1));
            if (lane < 16) ST[j * 256 + 128 + lane] = bf2f(RAWP(j, 2));
          }
        }
        wave_lds_sync();
        {
          float vv[8];
#pragma unroll
          for (int i = 0; i < 8; i++) vv[i] = ST[(dir ? 7 - i : i) * 256 + VOFF + lane];
          *(uint4*)(SB + S3_VT + lane * 16) = pack8(vv);
        }
        if (MIX == 0) {
          bf16x8 aw, aa;
#pragma unroll
          for (int jj = 0; jj < 8; jj++) {
            aw[jj] = fr < 8 ? (short)f2bf(ST[fr * 256 + 192 + fq * 8 + jj]) : (short)0;
            aa[jj] = fr < 8 ? (short)f2bf(ST[fr * 256 + 224 + fq * 8 + jj]) : (short)0;
          }
          f32x4 accw[4], acca[4];
#pragma unroll
          for (int nt = 0; nt < 4; nt++) {
            accw[nt] = __builtin_amdgcn_mfma_f32_16x16x32_bf16(aw, bw2[nt], z4, 0, 0, 0);
            acca[nt] = __builtin_amdgcn_mfma_f32_16x16x32_bf16(aa, ba2[nt], z4, 0, 0, 0);
          }
          wave_lds_sync();
          if (fq < 2) {
#pragma unroll
            for (int nt = 0; nt < 4; nt++)
#pragma unroll
              for (int r = 0; r < 4; r++) {
                ST[(fq * 4 + r) * 256 + 128 + nt * 16 + fr] = accw[nt][r];
                ST[(fq * 4 + r) * 256 + 192 + nt * 16 + fr] = acca[nt][r];
              }
          }
          wave_lds_sync();
        } else if (MIX == 2) {
          bf16x8 ag;
#pragma unroll
          for (int jj = 0; jj < 8; jj++) ag[jj] = (fr < 8 && fq < 2) ? (short)f2bf(ST[fr * 256 + 128 + fq * 8 + jj]) : (short)0;
          f32x4 accg[2];
#pragma unroll
          for (int nt = 0; nt < 2; nt++) accg[nt] = __builtin_amdgcn_mfma_f32_16x16x32_bf16(ag, bw2[nt], z4, 0, 0, 0);
          if (fq < 2) {
#pragma unroll
            for (int nt = 0; nt < 2; nt++)
#pragma unroll
              for (int r = 0; r < 4; r++) ST[(fq * 4 + r) * 256 + 192 + nt * 16 + fr] = accg[nt][r];
          }
          wave_lds_sync();
        }
        float logd[8], kap[8], bb[8], kp[8], qq[8];
        if (MIX == 0) {
          float a8[8], p1[8], p2[8];
#pragma unroll
          for (int i = 0; i < 8; i++) {
            const float* row = ST + (dir ? 7 - i : i) * 256;
            const float r_ = row[lane], k_ = row[64 + lane];
            const float sg = sigm(c_w0 + row[128 + lane]);
            a8[i] = sigm(c_a0 + row[192 + lane]);
            kp[i] = k_ * (1.f + (a8[i] - 1.f) * c_ka);
            kap[i] = k_ * c_kk;
            qq[i] = r_;
            logd[i] = -0.6065306597126334f * sg;
            p1[i] = kap[i] * kap[i];
            p2[i] = r_ * kp[i] * c_rk;
          }
#pragma unroll
          for (int i = 0; i < 8; i++) { p1[i] = red16(p1[i]); p2[i] = red16(p2[i]); }
#pragma unroll
          for (int i = 0; i < 8; i++) {
            const float ss = (rlane(p1[i], 0) + rlane(p1[i], 16)) + (rlane(p1[i], 32) + rlane(p1[i], 48));
            const float bc = (rlane(p2[i], 0) + rlane(p2[i], 16)) + (rlane(p2[i], 32) + rlane(p2[i], 48));
            kap[i] *= rsq(ss + 1e-6f);
            bb[i] = kap[i] * a8[i];
            if (lane == 0) BC[(size_t)(seg_row0 + t0 + (dir ? 7 - i : i)) * 8 + h * 2 + dir] = bc;
          }
        } else {
#pragma unroll
        for (int i = 0; i < 8; i++) {
          const int j = dir ? 7 - i : i;
          const float* row = ST + j * 256;
          if (MIX == 1) {
            const float q_ = row[lane], k_ = row[64 + lane];
            const float sq = wave_sum(q_ * q_), sk = wave_sum(k_ * k_);
            const float qn = q_ * rsq(sq + 1e-6f) * 0.125f, kn = k_ * rsq(sk + 1e-6f);
            const float beta = row[192], ld = row[193];
            const float alpha = __expf(ld);
            logd[i] = ld;
            kap[i] = kn; bb[i] = alpha * beta * kn; kp[i] = beta * kn; qq[i] = qn;
          } else {
            const int n = lane & 31;
            const float lg = c_gb + row[192 + n];
            const float ls = fminf(lg, 0.f) - __logf(1.f + __expf(-fabsf(lg)));
            logd[i] = ls * (1.f / 16.f);
            kap[i] = 0.f; bb[i] = 0.f;
            kp[i] = lane < 32 ? row[32 + n] : 0.f;
            qq[i] = lane < 32 ? row[n] : 0.f;
          }
        }
        }
        wave_lds_sync();
        float kt[8], qt[8], bck[8], kck[8];
        {
          float L[8];
          float run = 0.f;
#pragma unroll
          for (int i = 0; i < 8; i++) { run += logd[i]; L[i] = run; }
          const float Lr = L[3], L7 = L[7];
          float prevE = __expf(clampe(-Lr)), prevT = 1.f;
          u16* OPA = (u16*)STBY;
#pragma unroll
          for (int i = 0; i < 8; i++) {
            const float eI = __expf(clampe(L[i] - Lr)), eInv = __expf(clampe(Lr - L[i]));
            const float tI = __expf(L[i]), eEnd = __expf(L7 - L[i]);
            if (DELTA) {
              OPA[0 * 576 + i * 72 + lane] = f2bf(kap[i] * prevE);
              OPA[1 * 576 + i * 72 + lane] = f2bf(bb[i] * eInv);
            }
            OPA[2 * 576 + i * 72 + lane] = f2bf(kp[i] * eInv);
            OPA[3 * 576 + i * 72 + lane] = f2bf(qq[i] * eI);
            kt[i] = kap[i] * prevT; qt[i] = qq[i] * tI;
            bck[i] = bb[i] * eEnd; kck[i] = kp[i] * eEnd;
            prevE = eI; prevT = tI;
          }
          *(float*)(SB + S3_WC + lane * 4) = __expf(L7);
        }
        wave_lds_sync();
        f32x4 accA = z4, accBm = z4, accQb = z4, accQk = z4;
        {
          const u16* OPA = (const u16*)STBY;
          const int ro = (fr & 7) * 72 + fq * 8;
#pragma unroll
          for (int ks = 0; ks < 2; ks++) {
            const bf16x8 fk = ld_frag(OPA + 2 * 576 + ro + ks * 32), fqh = ld_frag(OPA + 3 * 576 + ro + ks * 32);
            accQk = __builtin_amdgcn_mfma_f32_16x16x32_bf16(fqh, fk, accQk, 0, 0, 0);
            if (DELTA) {
              const bf16x8 fka = ld_frag(OPA + 0 * 576 + ro + ks * 32), fb = ld_frag(OPA + 1 * 576 + ro + ks * 32);
              accA = __builtin_amdgcn_mfma_f32_16x16x32_bf16(fka, fb, accA, 0, 0, 0);
              accBm = __builtin_amdgcn_mfma_f32_16x16x32_bf16(fka, fk, accBm, 0, 0, 0);
              accQb = __builtin_amdgcn_mfma_f32_16x16x32_bf16(fqh, fb, accQb, 0, 0, 0);
            }
          }
#pragma unroll
          for (int r = 0; r < 4; r++) {
            const int i = fq * 4 + r;
            const bool ok = fq < 2 && fr < 8;
            if (!(ok && fr < i)) { accA[r] = 0.f; accBm[r] = 0.f; }
            if (!(ok && fr <= i)) { accQb[r] = 0.f; accQk[r] = 0.f; }
          }
        }
        float bmc[8], qkc[8];
#pragma unroll
        for (int m = 0; m < 4; m++) {
          bmc[m] = accBm[m]; qkc[m] = accQk[m];
          bmc[m + 4] = __shfl(accBm[m], (lane & 15) + 16);
          qkc[m + 4] = __shfl(accQk[m], (lane & 15) + 16);
        }
        float kbar[8], qbar[8], Kv[8], TB[8], Qv[8];
        if (DELTA) {
          float t[8];
#pragma unroll
          for (int i = 0; i < 8; i++) {
            float ti = (lane == i) ? 1.f : 0.f;
#pragma unroll
            for (int m = 0; m < i; m++) ti -= rlane(accA[i & 3], (i >> 2) * 16 + m) * t[m];
            t[i] = ti;
          }
#pragma unroll
          for (int i = 0; i < 8; i++) {
            float tb = 0.f, kb = 0.f;
#pragma unroll
            for (int m = 0; m <= i; m++) {
              const float tim = rlane(t[i], m);
              tb += tim * bmc[m];
              kb += tim * kt[m];
            }
            TB[i] = tb; kbar[i] = kb;
            float qv = qkc[i], qb = qt[i];
#pragma unroll
            for (int m = 0; m <= i; m++) {
              const float qbim = rlane(accQb[i & 3], (i >> 2) * 16 + m);
              qv -= qbim * TB[m];
              qb -= qbim * kbar[m];
            }
            Qv[i] = qv; qbar[i] = qb;
          }
#pragma unroll
          for (int j = 0; j < 8; j++) Kv[j] = kck[j];
#pragma unroll
          for (int i = 1; i < 8; i++)
#pragma unroll
            for (int j = 0; j < i; j++) Kv[j] -= rlane(TB[i], j) * bck[i];
        } else {
#pragma unroll
          for (int i = 0; i < 8; i++) { Qv[i] = qkc[i]; qbar[i] = qt[i]; Kv[i] = kck[i]; kbar[i] = 0.f; TB[i] = 0.f; }
        }
        *(uint4*)(SB + S3_KVT + lane * 16) = pack8(Kv);
#pragma unroll
        for (int i = 0; i < 8; i++) ((u16*)(SB + S3_QB))[i * 72 + lane] = f2bf(qbar[i]);
        if (lane < 8) {
#pragma unroll
          for (int i = 0; i < 8; i++) ((u16*)(SB + S3_QV))[i * 8 + lane] = f2bf(Qv[i]);
        }
        if (DELTA) {
          float nk[8];
#pragma unroll
          for (int i = 0; i < 8; i++) nk[i] = -kbar[i];
          *(uint4*)(STBY + 4608 + lane * 16) = pack8(bck);
          *(uint4*)(STBY + 5632 + lane * 16) = pack8(nk);
          wave_lds_sync();
          bf16x8 fa[4], fb[4];
#pragma unroll
          for (int x = 0; x < 4; x++) {
            fa[x] = fq == 0 ? ld_frag(STBY + 5632 + (x * 16 + fr) * 16) : zfrag();
            fb[x] = fq == 0 ? ld_frag(STBY + 4608 + (x * 16 + fr) * 16) : zfrag();
          }
#pragma unroll
          for (int nt = 0; nt < 4; nt++)
#pragma unroll
            for (int mt = 0; mt < 4; mt++) {
              const f32x4 g = __builtin_amdgcn_mfma_f32_16x16x32_bf16(fa[mt], fb[nt], z4, 0, 0, 0);
              uint2 gv;
              gv.x = pack2(g[0], g[1]); gv.y = pack2(g[2], g[3]);
              *(uint2*)(SB + S3_GM + ((nt * 16 + fr) * 72 + mt * 16 + fq * 4) * 2) = gv;
            }
        }
      }
    }
    fetch_raw<MIX>(P, min(it + 1, TPB / 64 - 1) * 2 + half, dir, b, h, pw, lane, colv, rawq);
    __syncthreads();
    if (w < 4) {
      unsigned char* STB = smb + S3_STB + w * 2304;
#pragma unroll 2
      for (int kk = 0; kk < 8; kk++) {
        const int cc = it * 2 + (kk >> 2), k = kk & 3;
        int seg_row0, t_lo;
        if (cc < 8) { seg_row0 = b * TPB; t_lo = dir == 0 ? cc * 32 : (LC - 32 - cc * 32); }
        else { seg_row0 = b * TPB + LC; t_lo = dir == 0 ? (cc - 8) * 32 : (SEQ - 32 - (cc - 8) * 32); }
        const int sc = dir ? 3 - k : k;
        const unsigned char* SB = smb + ((kk >> 2) * 4 + sc) * S3_SUB;
        const bf16x8 bs0 = __builtin_bit_cast(bf16x8, u32x4v{pack2(st[0][0], st[0][1]), pack2(st[0][2], st[0][3]), pack2(st[1][0], st[1][1]), pack2(st[1][2], st[1][3])});
        const bf16x8 bs1 = __builtin_bit_cast(bf16x8, u32x4v{pack2(st[2][0], st[2][1]), pack2(st[2][2], st[2][3]), pack2(st[3][0], st[3][1]), pack2(st[3][2], st[3][3])});
#define LDP(BASE_, ROW_, KS_) ([&]() -> bf16x8 {                                                                   \
          const uint2 lo_ = *(const uint2*)((BASE_) + ((ROW_) * 72 + (KS_) * 32 + fq * 4) * 2);                      \
          const uint2 hi_ = *(const uint2*)((BASE_) + ((ROW_) * 72 + (KS_) * 32 + 16 + fq * 4) * 2);                 \
          return __builtin_bit_cast(bf16x8, u32x4v{lo_.x, lo_.y, hi_.x, hi_.y}); }())
        const bf16x8 bv = fq == 0 ? ld_frag(SB + S3_VT + (w * 16 + fr) * 16) : zfrag();
        const bf16x8 aq0 = LDP(SB + S3_QB, (fr & 7), 0), aq1 = LDP(SB + S3_QB, (fr & 7), 1);
        const bf16x8 aqv = fq == 0 ? ld_frag(SB + S3_QV + (fr & 7) * 16) : zfrag();
        f32x4 accY = __builtin_amdgcn_mfma_f32_16x16x32_bf16(aq0, bs0, z4, 0, 0, 0);
        accY = __builtin_amdgcn_mfma_f32_16x16x32_bf16(aq1, bs1, accY, 0, 0, 0);
        accY = __builtin_amdgcn_mfma_f32_16x16x32_bf16(aqv, bv, accY, 0, 0, 0);
        if (fq < 2) {
#pragma unroll
          for (int r = 0; r < 4; r++) {
            const int i = fq * 4 + r, j = dir ? 7 - i : i;
            YS[(size_t)(seg_row0 + t_lo + sc * 8 + j) * YST + dir * 768 + MIX * 256 + h * 64 + w * 16 + fr] = f2bf(accY[r]);
          }
        }
#pragma unroll
        for (int nt = 0; nt < 4; nt++) {
          f32x4 an = z4;
          if (DELTA) {
            const bf16x8 g0 = LDP(SB + S3_GM, (nt * 16 + fr), 0), g1 = LDP(SB + S3_GM, (nt * 16 + fr), 1);
            an = __builtin_amdgcn_mfma_f32_16x16x32_bf16(g0, bs0, an, 0, 0, 0);
            an = __builtin_amdgcn_mfma_f32_16x16x32_bf16(g1, bs1, an, 0, 0, 0);
          }
          const bf16x8 akv = fq == 0 ? ld_frag(SB + S3_KVT + (nt * 16 + fr) * 16) : zfrag();
          an = __builtin_amdgcn_mfma_f32_16x16x32_bf16(akv, bv, an, 0, 0, 0);
          const float4 wc = *(const float4*)(SB + S3_WC + (nt * 16 + fq * 4) * 4);
          st[nt][0] = st[nt][0] * wc.x + an[0];
          st[nt][1] = st[nt][1] * wc.y + an[1];
          st[nt][2] = st[nt][2] * wc.z + an[2];
          st[nt][3] = st[nt][3] * wc.w + an[3];
        }
#undef LDP
      }
    }
    __syncthreads();
  }
}

__device__ __forceinline__ void attn_item(const Params& p, int l, int b, int qb, int hk, bool isctx, unsigned char* smem) {
  u16* KS = (u16*)smem;
  u16* VT = KS + 64 * LDT;
  u16* PL = VT + 64 * LDT;
  float2* ROPE = (float2*)(PL + 8 * 32 * LDT);
  const int tid = TIDX, lane = tid & 63, w = tid >> 6, fr = lane & 15, fq = lane >> 4;
  const u16* P = (const u16*)(p.ws + OFF_BIG);
  u16* Y = (u16*)(p.ws + OFF_YS);
  const int qh = hk * 2 + (w >> 2);
  const int tb = qb * 128 + (w & 3) * 32;
  const int qrow0 = b * TPB + (isctx ? 0 : LC);
  __syncthreads();
  for (int i = tid; i < 1024; i += NTHR) {
    int pos = i >> 4, fi = i & 15;
    float inv = powf(10000.f, -(float)fi / 16.f);
    float sn, cs;
    sincosf((float)pos * inv, &sn, &cs);
    ROPE[i] = make_float2(cs, sn);
  }
  __syncthreads();
  bf16x8 qf[2][2];
#pragma unroll
  for (int mi = 0; mi < 2; mi++)
#pragma unroll
    for (int ks = 0; ks < 2; ks++) {
      const int tq = tb + mi * 16 + fr;
      const u16* qp = P + (size_t)(qrow0 + tq) * PST + PD + qh * 64 + ks * 32;
      uint4 own = *(const uint4*)(qp + fq * 8);
      uint4 par = *(const uint4*)(qp + (fq ^ 2) * 8);
      const unsigned ow[4] = {own.x, own.y, own.z, own.w};
      const unsigned pw[4] = {par.x, par.y, par.z, par.w};
      const int pos = ks == 0 ? (tq >> 6) : (tq & 63);
      bf16x8 f;
#pragma unroll
      for (int jj = 0; jj < 8; jj++) {
        float xo = bf2f((u16)((ow[jj >> 1] >> ((jj & 1) * 16)) & 0xffff));
        float xp = bf2f((u16)((pw[jj >> 1] >> ((jj & 1) * 16)) & 0xffff));
        float v = xo;
        if (!isctx) {
          float2 cs = ROPE[pos * 16 + (fq & 1) * 8 + jj];
          v = fq < 2 ? xo * cs.x - xp * cs.y : xp * cs.y + xo * cs.x;
        }
        f[jj] = (short)f2bf(v * 0.125f);
      }
      qf[mi][ks] = f;
    }
  f32x4 oacc[2][4];
#pragma unroll
  for (int mi = 0; mi < 2; mi++)
#pragma unroll
    for (int nd = 0; nd < 4; nd++) oacc[mi][nd] = f32x4{0.f, 0.f, 0.f, 0.f};
  float mrow[2][4], lrow[2][4];
#pragma unroll
  for (int mi = 0; mi < 2; mi++)
#pragma unroll
    for (int r = 0; r < 4; r++) { mrow[mi][r] = -1e30f; lrow[mi][r] = 0.f; }

  const int q0 = qb * 128;
  const int band_lo = isctx ? 0 : max(0, q0 - 128), band_hi = isctx ? 0 : min(SEQ, q0 + 256);
  const int ntile = 4 + (band_hi - band_lo) / 64;
  u16* pl = PL + w * 32 * LDT;
  for (int tl = 0; tl < ntile; tl++) {
    const bool band = tl >= 4;
    const int k0 = band ? band_lo + (tl - 4) * 64 : tl * 64;
    __syncthreads();
    {
      const int key = tid >> 3, kc = tid & 7;
      const int kpos = k0 + key;
      const u16* kp = P + (size_t)(b * TPB + (band ? LC : 0) + kpos) * PST + PD + 256 + hk * 64;
      uint4 own = *(const uint4*)(kp + kc * 8);
      uint4 vv = *(const uint4*)(kp + 128 + kc * 8);
      uint4 par = *(const uint4*)(kp + (kc ^ 2) * 8);
      if (band) {
        const unsigned ow[4] = {own.x, own.y, own.z, own.w};
        const unsigned pw[4] = {par.x, par.y, par.z, par.w};
        const int pos = kc < 4 ? (kpos >> 6) : (kpos & 63);
        unsigned res[4];
#pragma unroll
        for (int jj = 0; jj < 8; jj += 2) {
          float v2[2];
#pragma unroll
          for (int e = 0; e < 2; e++) {
            float xo = bf2f((u16)((ow[jj >> 1] >> (e * 16)) & 0xffff));
            float xp = bf2f((u16)((pw[jj >> 1] >> (e * 16)) & 0xffff));
            float2 cs = ROPE[pos * 16 + (kc & 1) * 8 + jj + e];
            v2[e] = (kc & 2) == 0 ? xo * cs.x - xp * cs.y : xp * cs.y + xo * cs.x;
          }
          res[jj >> 1] = pack2(v2[0], v2[1]);
        }
        own = make_uint4(res[0], res[1], res[2], res[3]);
      }
      *(uint4*)(KS + key * LDT + kc * 8) = own;
      const unsigned vw[4] = {vv.x, vv.y, vv.z, vv.w};
#pragma unroll
      for (int jj = 0; jj < 8; jj++) VT[(kc * 8 + jj) * LDT + key] = (u16)((vw[jj >> 1] >> ((jj & 1) * 16)) & 0xffff);
    }
    __syncthreads();
    f32x4 sc[2][4];
#pragma unroll
    for (int mi = 0; mi < 2; mi++)
#pragma unroll
      for (int nj = 0; nj < 4; nj++) sc[mi][nj] = f32x4{0.f, 0.f, 0.f, 0.f};
#pragma unroll
    for (int ks = 0; ks < 2; ks++) {
      bf16x8 kf[4];
#pragma unroll
      for (int nj = 0; nj < 4; nj++) kf[nj] = *(const bf16x8*)(KS + (nj * 16 + fr) * LDT + ks * 32 + fq * 8);
#pragma unroll
      for (int mi = 0; mi < 2; mi++)
#pragma unroll
        for (int nj = 0; nj < 4; nj++) sc[mi][nj] = __builtin_amdgcn_mfma_f32_16x16x32_bf16(qf[mi][ks], kf[nj], sc[mi][nj], 0, 0, 0);
    }
#pragma unroll
    for (int mi = 0; mi < 2; mi++)
#pragma unroll
      for (int r = 0; r < 4; r++) {
        const int qpos = tb + mi * 16 + fq * 4 + r;
        float mx = -1e30f;
#pragma unroll
        for (int nj = 0; nj < 4; nj++) {
          float v = sc[mi][nj][r];
          if (band) {
            int d = qpos - (k0 + nj * 16 + fr);
            if (d > 128 || d < -128) v = -1e30f;
          }
          sc[mi][nj][r] = v;
          mx = fmaxf(mx, v);
        }
        mx = fmaxf(mx, __shfl_xor(mx, 1));
        mx = fmaxf(mx, __shfl_xor(mx, 2));
        mx = fmaxf(mx, __shfl_xor(mx, 4));
        mx = fmaxf(mx, __shfl_xor(mx, 8));
        const float mnew = fmaxf(mrow[mi][r], mx);
        const float alpha = __expf(mrow[mi][r] - mnew);
        mrow[mi][r] = mnew;
        float ls = 0.f;
#pragma unroll
        for (int nj = 0; nj < 4; nj++) {
          float pe = __expf(sc[mi][nj][r] - mnew);
          ls += pe;
          pl[(mi * 16 + fq * 4 + r) * LDT + nj * 16 + fr] = f2bf(pe);
        }
        lrow[mi][r] = lrow[mi][r] * alpha + ls;
#pragma unroll
        for (int nd = 0; nd < 4; nd++) oacc[mi][nd][r] *= alpha;
      }
    asm volatile("s_waitcnt lgkmcnt(0)" ::: "memory");
    __builtin_amdgcn_wave_barrier();
#pragma unroll
    for (int ks = 0; ks < 2; ks++) {
      bf16x8 pf[2], vf[4];
#pragma unroll
      for (int mi = 0; mi < 2; mi++) pf[mi] = *(const bf16x8*)(pl + (mi * 16 + fr) * LDT + ks * 32 + fq * 8);
#pragma unroll
      for (int nd = 0; nd < 4; nd++) vf[nd] = *(const bf16x8*)(VT + (nd * 16 + fr) * LDT + ks * 32 + fq * 8);
#pragma unroll
      for (int mi = 0; mi < 2; mi++)
#pragma unroll
        for (int nd = 0; nd < 4; nd++) oacc[mi][nd] = __builtin_amdgcn_mfma_f32_16x16x32_bf16(pf[mi], vf[nd], oacc[mi][nd], 0, 0, 0);
    }
    asm volatile("s_waitcnt lgkmcnt(0)" ::: "memory");
    __builtin_amdgcn_wave_barrier();
  }
  const float sink = p.attn_sink[l * 4 + qh];
#pragma unroll
  for (int mi = 0; mi < 2; mi++)
#pragma unroll
    for (int r = 0; r < 4; r++) {
      float ls = lrow[mi][r];
      ls += __shfl_xor(ls, 1);
      ls += __shfl_xor(ls, 2);
      ls += __shfl_xor(ls, 4);
      ls += __shfl_xor(ls, 8);
      ls += __expf(sink - mrow[mi][r]);
      const float inv = 1.f / ls;
      const int tq = tb + mi * 16 + fq * 4 + r;
#pragma unroll
      for (int nd = 0; nd < 4; nd++) Y[(size_t)(qrow0 + tq) * YST + 1536 + qh * 64 + nd * 16 + fr] = f2bf(oacc[mi][nd][r] * inv);
    }
}

#ifndef SCAN3_MASK
#define SCAN3_MASK 7
#endif
__device__ __forceinline__ void phase_mix(const Params& p, int l, unsigned char* smem) {
  float* sm = (float*)smem;
  const int G = gridDim.x;
  for (int it = blockIdx.x; it < 192; it += G) {
    const int mix = it >> 6, rem = it & 63, b = rem >> 3, h = (rem >> 1) & 3, dir = rem & 1;
    if (mix == 0 && (SCAN3_MASK & 1)) scan3_item<0>(p, l, b, h, dir, smem);
    else if (mix == 1 && (SCAN3_MASK & 2)) scan3_item<1>(p, l, b, h, dir, smem);
    else if (mix == 2 && (SCAN3_MASK & 4)) scan3_item<2>(p, l, b, h, dir, smem);
  }
  if (SCAN3_MASK != 7) {
    for (int it = blockIdx.x; it < 768; it += G) {
      const int mix = it >> 8, rem = it & 255, b = rem >> 5, h = (rem >> 3) & 3, dir = (rem >> 2) & 1, rq = rem & 3;
      if (mix == 0 && !(SCAN3_MASK & 1)) scan2_item<0>(p, l, b, h, dir, rq, sm);
      else if (mix == 1 && !(SCAN3_MASK & 2)) scan2_item<1>(p, l, b, h, dir, rq, sm);
      else if (mix == 2 && !(SCAN3_MASK & 4)) scan2_item<2>(p, l, b, h, dir, rq, sm);
    }
  }
  __syncthreads();
  {
    const bool spread = G >= 192;
    const int nconv = spread ? 64 : G, fidx = spread ? (int)blockIdx.x - 128 : (int)blockIdx.x;
    if (fidx >= 0 && fidx < nconv)
      for (int it = 832 + fidx; it < 4480; it += nconv) conv_item(p, l, it, (float*)smem);
    __syncthreads();
  }
  unsigned* ctr = (unsigned*)(p.ws + OFF_CTR) + l * 16;
  volatile int* slot = (volatile int*)(smem + 131072 - 16);
  for (;;) {
    if (TIDX == 0) *slot = (int)atomicAdd(ctr, 1u);
    __syncthreads();
    const int it = *slot;
    __syncthreads();
    if (it >= (l == 0 ? 544 : 512)) break;
    if (it < 512) {
      int b = it >> 6, qb = (it >> 1) & 31, hk = it & 1;
      attn_item(p, l, b, qb, hk, false, smem);
    } else {
      int r = it - 512, b = r >> 2, qb = (r >> 1) & 1, hk = r & 1;
      attn_item(p, l, b, qb, hk, true, smem);
    }
  }
}

#define POST_DECL(PFX) uint2 PFX##ya0, PFX##ya1, PFX##ya2, PFX##yc0, PFX##yc1, PFX##yc2, PFX##vp, PFX##vc, PFX##vn, PFX##gb, PFX##gc; \
  u16 PFX##xp, PFX##xc, PFX##xn; float2 PFX##bc
#define POST_LOAD(PFX, R_)                                                                         \
  do {                                                                                             \
    const int r_ = (R_);                                                                           \
    const int b_ = r_ / TPB, t_ = r_ - b_ * TPB;                                                   \
    const bool hp_ = (t_ != 0) && (t_ != LC), hn_ = (t_ != LC - 1) && (t_ != TPB - 1);            \
    const u16* ys_ = YSc + (size_t)r_ * YST;                                                       \
    const u16* pr_ = Pc + (size_t)r_ * PST;                                                        \
    const u16* pp_ = pr_ - (hp_ ? PST : 0);                                                        \
    const u16* pn_ = pr_ + (hn_ ? PST : 0);                                                        \
    PFX##ya0 = *(const uint2*)(ys_ + j0); PFX##ya1 = *(const uint2*)(ys_ + 256 + j0); PFX##ya2 = *(const uint2*)(ys_ + 512 + j0); \
    PFX##yc0 = *(const uint2*)(ys_ + 768 + j0); PFX##yc1 = *(const uint2*)(ys_ + 1024 + j0); PFX##yc2 = *(const uint2*)(ys_ + 1280 + j0); \
    PFX##vp = *(const uint2*)(pp_ + PA + 512 + j0);                                                \
    PFX##vc = *(const uint2*)(pr_ + PA + 512 + j0);                                                \
    PFX##vn = *(const uint2*)(pn_ + PA + 512 + j0);                                                \
    PFX##gb = *(const uint2*)(pr_ + PB + 784 + j0);                                                \
    PFX##gc = *(const uint2*)(pr_ + PC + 544 + j0);                                                \
    PFX##xp = pp_[PA + 896 + lane]; PFX##xc = pr_[PA + 896 + lane]; PFX##xn = pn_[PA + 896 + lane]; \
    PFX##bc = *(const float2*)(BCc + (size_t)r_ * 8 + (lane >> 4) * 2);                            \
  } while (0)
__device__ __forceinline__ void unpack4(uint2 v, float (&o)[4]) {
  o[0] = __uint_as_float(v.x << 16); o[1] = __uint_as_float(v.x & 0xffff0000u);
  o[2] = __uint_as_float(v.y << 16); o[3] = __uint_as_float(v.y & 0xffff0000u);
}

__device__ __forceinline__ void phase_post(const Params& p, int l, float* g2s) {
  const int lane = TIDX & 63, wv = TIDX >> 6;
  u16* YS = (u16*)(p.ws + OFF_YS);
  const int j0 = lane * 4;
  {
    const float4* src = (const float4*)(p.rwkv_g2 + (size_t)l * 64 * 256);
    for (int i = TIDX; i < 64 * 256 / 4; i += NTHR) ((float4*)g2s)[i] = src[i];
  }
  float mu_v[4], lng[4], lnb[4], ngb[4], ngc[4];
#pragma unroll
  for (int i = 0; i < 4; i++) {
    mu_v[i] = p.rwkv_mu[l * 960 + 512 + j0 + i];
    lng[i] = p.rwkv_ln_g[l * 256 + j0 + i];
    lnb[i] = p.rwkv_ln_b[l * 256 + j0 + i];
    ngb[i] = p.gdn_norm_g[l * 64 + (lane & 15) * 4 + i];
    ngc[i] = p.gla_norm_g[l * 64 + (lane & 15) * 4 + i];
  }
  const float mu_x = p.rwkv_mu[l * 960 + 896 + lane];
  __syncthreads();
  const int stride = gridDim.x * 8;
  int r = blockIdx.x * 8 + wv;
  const u16* Pc = (const u16*)(p.ws + OFF_BIG);
  const u16* YSc = (const u16*)(p.ws + OFF_YS);
  const float* BCc = (const float*)(p.ws + OFF_BC);
  POST_DECL(cur_);
  POST_DECL(nxt_);
  POST_LOAD(cur_, r);
  for (; r < NROWS; r += stride) {
    const int rn = r + stride < NROWS ? r + stride : r;
    POST_LOAD(nxt_, rn);
    const int b = r / TPB, t = r - b * TPB;
    const float pmul = ((t != 0) && (t != LC)) ? 1.f : 0.f, nmul = ((t != LC - 1) && (t != TPB - 1)) ? 1.f : 0.f;
    if (!(l == 1 && t < LC)) {
    float y[3][4];
    {
      float a4[4], c4[4];
      unpack4(cur_ya0, a4); unpack4(cur_yc0, c4);
#pragma unroll
      for (int i = 0; i < 4; i++) y[0][i] = a4[i] + c4[i];
      unpack4(cur_ya1, a4); unpack4(cur_yc1, c4);
#pragma unroll
      for (int i = 0; i < 4; i++) y[1][i] = a4[i] + c4[i];
      unpack4(cur_ya2, a4); unpack4(cur_yc2, c4);
#pragma unroll
      for (int i = 0; i < 4; i++) y[2][i] = a4[i] + c4[i];
    }
    float o[3][4];
    {
      float sum = y[0][0] + y[0][1] + y[0][2] + y[0][3];
      sum = red16(sum);
      const float mean = sum * (1.f / 64.f);
      float vs = 0.f;
#pragma unroll
      for (int i = 0; i < 4; i++) { float d = y[0][i] - mean; vs += d * d; }
      vs = red16(vs);
      const float rstd = rsq(vs * (1.f / 64.f) + 64e-5f);
      const float pv = bf2f(cur_xc), ppv = bf2f(cur_xp) * pmul, pnv = bf2f(cur_xn) * nmul;
      const float sg = sigm(pv + (0.5f * (ppv + pnv) - pv) * mu_x);
      float gate[4] = {0.f, 0.f, 0.f, 0.f};
      const float* g2 = g2s + j0;
#pragma unroll 8
      for (int i = 0; i < 64; i++) {
        const float si = __int_as_float(__builtin_amdgcn_readlane(__float_as_int(sg), i));
        const float4 gw = *(const float4*)(g2 + i * 256);
        gate[0] += si * gw.x; gate[1] += si * gw.y; gate[2] += si * gw.z; gate[3] += si * gw.w;
      }
      const float bcs = cur_bc.x + cur_bc.y;
      float vc4[4], vp4[4], vn4[4];
      unpack4(cur_vc, vc4); unpack4(cur_vp, vp4); unpack4(cur_vn, vn4);
#pragma unroll
      for (int i = 0; i < 4; i++) {
        const float v = vc4[i] + (0.5f * (vp4[i] * pmul + vn4[i] * nmul) - vc4[i]) * mu_v[i];
        const float yn = (y[0][i] - mean) * rstd * lng[i] + lnb[i];
        o[0][i] = (yn + bcs * v) * gate[i];
      }
    }
#pragma unroll
    for (int m = 1; m < 3; m++) {
      float ss = y[m][0] * y[m][0] + y[m][1] * y[m][1] + y[m][2] * y[m][2] + y[m][3] * y[m][3];
      ss = red16(ss);
      const float inv = rsq(ss * (1.f / 64.f) + 1e-6f);
      float g4[4];
      unpack4(m == 1 ? cur_gb : cur_gc, g4);
#pragma unroll
      for (int i = 0; i < 4; i++) o[m][i] = y[m][i] * inv * (m == 1 ? ngb[i] : ngc[i]) * siluf(g4[i]);
    }
    u16* ys = YS + (size_t)r * YST;
#pragma unroll
    for (int m = 0; m < 3; m++) {
      uint2 ov;
      ov.x = pack2(o[m][0], o[m][1]);
      ov.y = pack2(o[m][2], o[m][3]);
      *(uint2*)(ys + m * 256 + j0) = ov;
    }
    }
    cur_ya0 = nxt_ya0; cur_ya1 = nxt_ya1; cur_ya2 = nxt_ya2; cur_yc0 = nxt_yc0; cur_yc1 = nxt_yc1; cur_yc2 = nxt_yc2;
    cur_vp = nxt_vp; cur_vc = nxt_vc; cur_vn = nxt_vn; cur_gb = nxt_gb; cur_gc = nxt_gc;
    cur_xp = nxt_xp; cur_xc = nxt_xc; cur_xn = nxt_xn; cur_bc = nxt_bc;
  }
}

#define XB_TMO      128
#define XB_XCNT(j)  (256  + 64 * (j))
#define XB_XSUB(j)  (1280 + 64 * (j))
#define XB_XGEN(j)  (2304 + 64 * (j))
#define XB_TOP      3328
#define XB_TOPGEN   3392
#define XCD_BAR_WORDS 3456
#define XB_SPIN_CAP (1u << 18)
#define LAS __attribute__((address_space(3)))

__device__ __forceinline__ unsigned xb_ld(unsigned* p)              { return __hip_atomic_load(p, __ATOMIC_RELAXED, __HIP_MEMORY_SCOPE_AGENT); }
__device__ __forceinline__ unsigned xb_add(unsigned* p, unsigned v) { return __hip_atomic_fetch_add(p, v, __ATOMIC_RELAXED, __HIP_MEMORY_SCOPE_AGENT); }
__device__ __forceinline__ unsigned xb_xcc_id() { return (unsigned)__builtin_amdgcn_s_getreg((3 << 11) | 20) & 0xFu; }
#define XB_SPIN(cond, bar) do { unsigned _sp = 0; while (cond) { __builtin_amdgcn_s_sleep(1); \
    if ((++_sp & 255u) == 0u) { if (xb_ld(&(bar)[XB_TMO])) break; if (_sp > XB_SPIN_CAP) { atomicAdd(&(bar)[XB_TMO], 1u); break; } } } } while (0)

struct XcdBarrier {
    unsigned* bar; unsigned x;
    volatile LAS unsigned* st;
};

__device__ __forceinline__ XcdBarrier xcd_barrier_post(unsigned* bar, volatile LAS unsigned* st) {
    XcdBarrier b; b.bar = bar; b.x = xb_xcc_id(); b.st = st;
    if (threadIdx.x == 0) (void)xb_add(&bar[XB_XCNT(b.x)], 1u);
    return b;
}
__device__ __forceinline__ void xcd_barrier_complete(unsigned* bar, unsigned x, unsigned& nloc, unsigned& nx) {
    const unsigned G = gridDim.x * gridDim.y * gridDim.z;
    unsigned sum, cnt, mine, sp = 0u;
    for (;;) {
        sum = 0u; cnt = 0u; mine = 0u;
#pragma unroll
        for (unsigned j = 0; j < 16; ++j) { const unsigned c = xb_ld(&bar[XB_XCNT(j)]); sum += c; cnt += (c > 0u) ? 1u : 0u; mine = (j == x) ? c : mine; }
        if (sum == G) break;
        __builtin_amdgcn_s_sleep(1);
        if ((++sp & 255u) == 0u) { if (xb_ld(&bar[XB_TMO])) break; if (sp > XB_SPIN_CAP) { atomicAdd(&bar[XB_TMO], 1u); break; } }
    }
    nloc = mine > 0u ? mine : 1u; nx = cnt > 0u ? cnt : 1u;
}

__device__ __forceinline__ void xcd_barrier(const XcdBarrier& b) {
    asm volatile("s_waitcnt vmcnt(0)" ::: "memory");
    __syncthreads();
    if (threadIdx.x == 0) {
        unsigned* bar = b.bar;
        __builtin_amdgcn_s_waitcnt(0);
        unsigned nloc = b.st[0], nx = b.st[1];
        if (nloc == 0u) { xcd_barrier_complete(bar, b.x, nloc, nx); b.st[0] = nloc; b.st[1] = nx; }
        const unsigned old = xb_add(&bar[XB_XSUB(b.x)], 1u);
        const unsigned gen = old / nloc;
        if (old + 1u == (gen + 1u) * nloc) {
            __builtin_amdgcn_fence(__ATOMIC_RELEASE, "agent");
            asm volatile("s_waitcnt vmcnt(0)" ::: "memory");
            const unsigned og = xb_add(&bar[XB_TOP], 1u);
            const unsigned tg = og / nx;
            if (og + 1u == (tg + 1u) * nx) xb_add(&bar[XB_TOPGEN], 1u);
            else XB_SPIN(xb_ld(&bar[XB_TOPGEN]) == tg, bar);
            __builtin_amdgcn_fence(__ATOMIC_ACQUIRE, "agent");
            xb_add(&bar[XB_XGEN(b.x)], 1u);
            asm volatile("s_waitcnt vmcnt(0)" ::: "memory");
        } else {
            XB_SPIN(xb_ld(&bar[XB_XGEN(b.x)]) == gen, bar);
            __builtin_amdgcn_fence(__ATOMIC_ACQUIRE, "agent");
            asm volatile("s_waitcnt vmcnt(0)" ::: "memory");
        }
    }
    __syncthreads();
}

#if defined(SKIPS)
#define EN(k) (SKIPS != (k))
#elif !defined(ONLYS)
#define EN(k) 1
#else
#define EN(k) (ONLYS == (k))
#endif
__device__ __forceinline__ void run_phase(const Params& p, int ph, unsigned char* smem) {
  if (ph == 0) { if (EN(10)) phase_init0(p, (float*)smem); return; }
  if (ph == 1) { if (EN(11)) phase_init1(p); return; }
  int l = 0, s = 10;
  if (ph >= 3) { l = (ph - 3) / 10; s = (ph - 3) - l * 10; }
  unsigned char* wl = p.ws + OFF_W;
  PG8_LAS unsigned char* lds = (PG8_LAS unsigned char*)smem;
  pg8::StaticOrder S;
  if (s == 10 || s == 6 || s == 9) {
    if (EN(5)) rowpass(p, l, s == 10 ? 0 : (s == 6 ? 1 : 2));
    if (s == 9 && l == 0) {
      __syncthreads();
      for (int it = blockIdx.x; it < 832; it += gridDim.x) conv_item(p, 1, it, (float*)smem);
    }
  } else if (s == 0 || s == 3 || s == 5 || s == 8) {
    pg8::Gemm g; EpiBf E;
    g.M = NROWS; E.bias = nullptr; E.act = 0;
    if (s == 0) { g.A = (const u16*)(p.ws + OFF_H); g.lda = DM; g.Bt = (const u16*)(wl + OW_IN); g.K = DM; g.N = PST; E.O = (u16*)(p.ws + OFF_BIG); E.ldc = PST; }
    else if (s == 3) {
      g.A = (const u16*)(p.ws + OFF_H); g.lda = DM; g.Bt = (const u16*)(wl + OW_G); g.K = DM; g.N = 4096;
      E.O = (u16*)(p.ws + OFF_BIG); E.ldc = 4096; E.bias = p.gate_b + (size_t)l * 4096; E.act = 1;
    }
    else if (s == 5) { g.A = (const u16*)(p.ws + OFF_H); g.lda = DM; g.Bt = (const u16*)(wl + OW_O); g.K = DM; g.N = DM; E.O = (u16*)(p.ws + OFF_BIG); E.ldc = DM; }
    else { g.A = (const u16*)(p.ws + OFF_BIG); g.lda = FH; g.Bt = (const u16*)(wl + OW_2); g.K = FH; g.N = DM; E.O = (u16*)(p.ws + OFF_YS); E.ldc = DM; }
    if (l == 1 && s != 0) S.init(NBATCH * SEQ, g.N, gridDim.x, blockIdx.x, 1);
    else S.init(g.M, g.N, gridDim.x, blockIdx.x);
    if (EN(0)) pg8::gemm_phase<EpiBf, pg8::StaticOrder, false>(lds, g, S, E, nullptr);
  } else if (s == 4) {
    if (EN(3)) phase_ypart(p, l, smem);
  } else if (s == 1) {
    if (EN(1)) phase_mix(p, l, smem);
  } else if (s == 2) {
    if (EN(2)) phase_post(p, l, (float*)smem);
  } else {
    pg8::Gemm g; EpiSwiglu E;
    g.M = NROWS; g.N = 2 * FH; g.K = DM; g.lda = DM; g.A = (const u16*)(p.ws + OFF_H); g.Bt = (const u16*)(wl + OW_1);
    E.O = (u16*)(p.ws + OFF_BIG);
    if (l == 1) S.init(NBATCH * SEQ, g.N, gridDim.x, blockIdx.x, 1);
    else S.init(g.M, g.N, gridDim.x, blockIdx.x);
    if (EN(6)) pg8::gemm_phase<EpiSwiglu, pg8::StaticOrder, false>(lds, g, S, E, nullptr);
  }
}

__global__ void __launch_bounds__(NTHR) hybrid_flow_mega(Params p, int ph0, int ph1) {
  __shared__ __attribute__((aligned(16))) unsigned char smem[131072];
  __shared__ __attribute__((aligned(16))) unsigned xbw[4];
  cg::grid_group grid = cg::this_grid();
  XcdBarrier xb;
  xb.bar = (unsigned*)(p.ws + OFF_XBAR); xb.x = 0u; xb.st = (volatile LAS unsigned*)xbw;
  for (int ph = ph0; ph < ph1; ph++) {
    run_phase(p, ph, smem);
#ifdef DUPMASK
    {
      int sidx = ph >= 3 ? (ph - 3) % 10 : 12 + ph;
      if ((DUPMASK >> sidx) & 1) { __syncthreads(); run_phase(p, ph, smem); }
    }
#endif
    if (ph + 1 < ph1) {
      if (ph == ph0) {
        grid.sync();
        if (threadIdx.x < 4) xbw[threadIdx.x] = 0u;
        __syncthreads();
        xb = xcd_barrier_post((unsigned*)(p.ws + OFF_XBAR), (volatile LAS unsigned*)xbw);
      } else {
        xcd_barrier(xb);
      }
    }
  }
  if (ph1 - ph0 > 2 && threadIdx.x == 0 && xb_ld(&xb.bar[XB_TMO]) != 0u) p.out[blockIdx.x] = __int_as_float(0x7fc00000);
}

extern "C" void kernel_launch(void* const* d_in, const int* in_sizes, int n_in, void* d_out, int out_size, void* d_ws,
                              size_t ws_size, hipStream_t stream) {
  Params p{};
  const float** pp = (const float**)&p;
  for (int i = 0; i < 32; i++) pp[i] = (const float*)d_in[i];
  p.out = (float*)d_out;
  p.ws = (unsigned char*)d_ws;
  static int grid_blocks = 0;
  if (!grid_blocks) {
    int dev = 0, cus = 0, per_cu = 0;
    hipGetDevice(&dev);
    hipDeviceGetAttribute(&cus, hipDeviceAttributeMultiprocessorCount, dev);
    hipOccupancyMaxActiveBlocksPerMultiprocessor(&per_cu, hybrid_flow_mega, NTHR, 0);
    if (per_cu < 1) per_cu = 1;
    grid_blocks = cus * per_cu;
  }
#ifdef MULTI_LAUNCH
  for (int ph = 0; ph < NPHASE; ph++) {
    hipLaunchKernelGGL(hybrid_flow_mega, dim3(grid_blocks), dim3(NTHR), 0, stream, p, ph, ph + 1);
  }
#else
  int ph0 = 0, ph1 = NPHASE;
  void* args[] = {&p, &ph0, &ph1};
  hipError_t e = hipLaunchCooperativeKernel((void*)hybrid_flow_mega, dim3(grid_blocks), dim3(NTHR), args, 0, stream);
  if (e != hipSuccess) fprintf(stderr, "cooperative launch failed: %s (grid %d)\n", hipGetErrorString(e), grid_blocks);
#endif
}
```

```cpp
#include <hip/hip_runtime.h>
#include <hip/hip_cooperative_groups.h>
#include <cstdio>
namespace cg = cooperative_groups;

typedef unsigned short u16;
using bf16x8 = __attribute__((ext_vector_type(8))) short;
using f32x4 = __attribute__((ext_vector_type(4))) float;

#define DM 1024
#define NBATCH 8
#define SEQ 4096
#define LC 256
#define TPB 4352
#define NROWS 34816
#define PST 3328
#define YST 1792
#define FH 2816
#define INW 7408
#define NTHR 512
#define PA 0
#define PB 960
#define PC 2000
#define PD 2800
#define NPHASE 23
#define SCAN3_MASK 7

struct Params {
  const float *x, *c, *ctx, *c_ctx, *ada_w, *ada_b, *norm_g, *w_in, *gate_b, *w_branch, *w_out,
      *rwkv_mu, *rwkv_w0, *rwkv_w2, *rwkv_a0, *rwkv_a2, *rwkv_g2, *rwkv_kk, *rwkv_ka, *rwkv_rk, *rwkv_ln_g,
      *rwkv_ln_b, *gdn_conv, *gdn_a_log, *gdn_dt_bias, *gdn_norm_g, *gla_gw2, *gla_gb, *gla_norm_g, *attn_sink,
      *ffn_w1, *ffn_w2;
  float* out;
  unsigned char* ws;
};

constexpr size_t SZ_WL = 36700160;
constexpr size_t OW_IN = 0;
constexpr size_t OW_G = OW_IN + (size_t)PST * 1024 * 2;
constexpr size_t OW_B = OW_G + (size_t)4096 * 1024 * 2;
constexpr size_t OW_O = OW_B + (size_t)4 * 1024 * 256 * 2;
constexpr size_t OW_1 = OW_O + (size_t)1024 * 1024 * 2;
constexpr size_t OW_2 = OW_1 + (size_t)5632 * 1024 * 2;
static_assert(OW_2 + (size_t)1024 * FH * 2 == SZ_WL, "weights size");
constexpr size_t SZ_ACT = (size_t)NROWS * DM * 2;
constexpr size_t OFF_W = 0;
constexpr size_t OFF_XC = OFF_W + SZ_WL;
constexpr size_t OFF_MODP = OFF_XC + (size_t)NBATCH * LC * DM * 4;
constexpr size_t OFF_MOD = OFF_MODP + (size_t)2 * 8 * 9 * 6144 * 4;
constexpr size_t OFF_BC = OFF_MOD + (size_t)2 * 9 * 6144 * 4;
constexpr size_t OFF_H = OFF_BC + (size_t)NROWS * 8 * 4;
constexpr size_t OFF_YS = OFF_H + SZ_ACT;
constexpr size_t OFF_BIG = OFF_YS + (size_t)NROWS * YST * 2;
constexpr size_t OFF_CTR = OFF_BIG + (size_t)NROWS * 4096 * 2;
constexpr size_t OFF_XBAR = OFF_CTR + 256;
constexpr size_t WS_END = OFF_XBAR + 3456 * 4;
static_assert(WS_END <= (size_t)536870912, "ws too large");

__device__ __forceinline__ int launder_tid() { int t = threadIdx.x; asm volatile("" : "+v"(t)); return t; }
#define TIDX (launder_tid())
typedef float f32x2_t __attribute__((ext_vector_type(2)));
typedef __bf16 bf16x2_t __attribute__((ext_vector_type(2)));
__device__ __forceinline__ unsigned pack2(float a, float b) {
  const f32x2_t v = {a, b};
  const bf16x2_t r = __builtin_convertvector(v, bf16x2_t);
  return __builtin_bit_cast(unsigned, r);
}
__device__ __forceinline__ u16 f2bf(float f) { return (u16)(pack2(f, 0.f) & 0xffffu); }
__device__ __forceinline__ float bf2f(u16 h) { return __uint_as_float(((unsigned)h) << 16); }
__device__ __forceinline__ float sigm(float x) { return __builtin_amdgcn_rcpf(1.f + __expf(-x)); }
__device__ __forceinline__ float siluf(float x) { return x * __builtin_amdgcn_rcpf(1.f + __expf(-x)); }
__device__ __forceinline__ float rsq(float x) { return __builtin_amdgcn_rsqf(x); }
__device__ __forceinline__ float softplusf(float x) { return fmaxf(x, 0.f) + __logf(1.f + __expf(-fabsf(x))); }
__device__ __forceinline__ float tanh_fast(float x) { return 1.f - 2.f * __builtin_amdgcn_rcpf(1.f + __expf(2.f * x)); }
__device__ __forceinline__ float wsum(float v) {
#pragma unroll
  for (int o = 32; o > 0; o >>= 1) v += __shfl_xor(v, o);
  return v;
}
template <int CTRL>
__device__ __forceinline__ float dppf(float x) {
  return __int_as_float(__builtin_amdgcn_update_dpp(__float_as_int(x), __float_as_int(x), CTRL, 0xf, 0xf, false));
}
__device__ __forceinline__ float red8(float x) {
  x += dppf<0xB1>(x);
  x += dppf<0x4E>(x);
  x += dppf<0x141>(x);
  return x;
}
__device__ __forceinline__ const float* xin_row(const Params& p, int r) {
  int b = r / TPB, t = r - b * TPB;
  return t < LC ? p.ctx + ((size_t)(b * LC + t)) * DM : p.x + ((size_t)(b * SEQ + t - LC)) * DM;
}
__device__ __forceinline__ float* x_row(const Params& p, int r) {
  int b = r / TPB, t = r - b * TPB;
  return t < LC ? (float*)(p.ws + OFF_XC) + ((size_t)(b * LC + t)) * DM : p.out + ((size_t)(b * SEQ + t - LC)) * DM;
}
__device__ __forceinline__ int mod_row(int r) {
  int b = r / TPB, t = r - b * TPB;
  return t < LC ? 8 : b;
}

struct MapId { int lim, off; __device__ int operator()(int n) const { return n < lim ? n + off : -1; } };
struct MapW1 { __device__ int operator()(int n) const { int q = n >> 3, s = n & 7; return s < 4 ? q * 4 + s : FH + q * 4 + (s - 4); } };

template <class Map>
__device__ __forceinline__ void conv_tile(const float* __restrict__ src, int ld, u16* __restrict__ dst, int K, int n0,
                                          int k0, Map map, float* tile) {
  const int tid = TIDX;
  const int nn = tid & 63, kr = tid >> 6;
  const int sc = map(n0 + nn);
  float tv[8];
  const int scc = sc >= 0 ? sc : 0;
  const float scm = sc >= 0 ? 1.f : 0.f;
#pragma unroll
  for (int ps = 0; ps < 8; ps++) tv[ps] = src[(size_t)(k0 + ps * 8 + kr) * ld + scc];
#pragma unroll
  for (int ps = 0; ps < 8; ps++) tile[(ps * 8 + kr) * 65 + nn] = tv[ps] * scm;
  __syncthreads();
  const int n2 = tid >> 3, kc = tid & 7;
  uint4 o;
  o.x = pack2(tile[(kc * 8 + 0) * 65 + n2], tile[(kc * 8 + 1) * 65 + n2]);
  o.y = pack2(tile[(kc * 8 + 2) * 65 + n2], tile[(kc * 8 + 3) * 65 + n2]);
  o.z = pack2(tile[(kc * 8 + 4) * 65 + n2], tile[(kc * 8 + 5) * 65 + n2]);
  o.w = pack2(tile[(kc * 8 + 6) * 65 + n2], tile[(kc * 8 + 7) * 65 + n2]);
  *(uint4*)(dst + (size_t)(n0 + n2) * K + k0 + kc * 8) = o;
  __syncthreads();
}

__device__ __forceinline__ void conv_item(const Params& p, int l, int rem, float* sm) {
      u16* wl = (u16*)(p.ws + OFF_W);
      if (rem < 832) {
        int nt = rem >> 4, kt = rem & 15;
        conv_tile(p.w_in + (size_t)l * DM * INW, INW, (u16*)((char*)wl + OW_IN), 1024, nt * 64, kt * 64, MapId{3312, 0}, sm);
      } else if (rem < 832 + 1024) {
        rem -= 832;
        int nt = rem >> 4, kt = rem & 15;
        conv_tile(p.w_in + (size_t)l * DM * INW, INW, (u16*)((char*)wl + OW_G), 1024, nt * 64, kt * 64, MapId{4096, 3312}, sm);
      } else if (rem < 1856 + 256) {
        rem -= 1856;
        int br = rem >> 6, r2 = rem & 63, nt = r2 >> 2, kt = r2 & 3;
        conv_tile(p.w_branch + ((size_t)(l * 4 + br)) * 256 * DM, DM, (u16*)((char*)wl + OW_B) + (size_t)br * 1024 * 256, 256,
                  nt * 64, kt * 64, MapId{1024, 0}, sm);
      } else if (rem < 2112 + 256) {
        rem -= 2112;
        int nt = rem >> 4, kt = rem & 15;
        conv_tile(p.w_out + (size_t)l * DM * DM, DM, (u16*)((char*)wl + OW_O), 1024, nt * 64, kt * 64, MapId{1024, 0}, sm);
      } else if (rem < 2368 + 1408) {
        rem -= 2368;
        int nt = rem >> 4, kt = rem & 15;
        conv_tile(p.ffn_w1 + (size_t)l * DM * 5632, 5632, (u16*)((char*)wl + OW_1), 1024, nt * 64, kt * 64, MapW1{}, sm);
      } else {
        rem -= 3776;
        int nt = rem / 44, kt = rem - nt * 44;
        conv_tile(p.ffn_w2 + (size_t)l * FH * DM, DM, (u16*)((char*)wl + OW_2), FH, nt * 64, kt * 64, MapId{1024, 0}, sm);
      }
}

__device__ __forceinline__ void phase_init0(const Params& p, float* sm) {
  const int tid = TIDX;
  if (blockIdx.x == 0) {
    if (tid < 64) ((unsigned*)(p.ws + OFF_CTR))[tid] = 0u;
    for (int i = tid; i < 3456; i += NTHR) ((unsigned*)(p.ws + OFF_XBAR))[i] = 0u;
  }
  constexpr int NMOD = 192, NCONV = 832;
  for (int it = blockIdx.x; it < NMOD + NCONV; it += gridDim.x) {
    if (it < NMOD) {
      int l = it / 96, rem = it - l * 96, cc = rem >> 3, ks = rem & 7;
      for (int i = tid; i < 9 * 128; i += NTHR) {
        int r = i >> 7, k = i & 127;
        float v = r < 8 ? p.c[r * DM + ks * 128 + k] : p.c_ctx[ks * 128 + k];
        sm[i] = siluf(v);
      }
      __syncthreads();
      const int n = cc * 512 + tid;
      const float* w = p.ada_w + ((size_t)l * DM + ks * 128) * 6144 + n;
      float acc[9];
#pragma unroll
      for (int r = 0; r < 9; r++) acc[r] = 0.f;
#pragma unroll 1
      for (int k0 = 0; k0 < 128; k0 += 16) {
        float wv[16];
#pragma unroll
        for (int kk = 0; kk < 16; kk++) wv[kk] = w[(size_t)(k0 + kk) * 6144];
#pragma unroll
        for (int kk = 0; kk < 16; kk++)
#pragma unroll
          for (int r = 0; r < 9; r++) acc[r] += sm[r * 128 + k0 + kk] * wv[kk];
      }
      float* mp = (float*)(p.ws + OFF_MODP) + ((size_t)(l * 8 + ks) * 9) * 6144 + n;
#pragma unroll
      for (int r = 0; r < 9; r++) mp[(size_t)r * 6144] = acc[r];
      __syncthreads();
    } else {
      conv_item(p, 0, it - NMOD, sm);
    }
  }
}

__device__ __forceinline__ void phase_init1(const Params& p) {
  const float* mp = (const float*)(p.ws + OFF_MODP);
  float* mo = (float*)(p.ws + OFF_MOD);
  for (int i = blockIdx.x * NTHR + TIDX; i < 2 * 9 * 6144; i += gridDim.x * NTHR) {
    int l = i / (9 * 6144), rem = i - l * 9 * 6144, r = rem / 6144, n = rem - r * 6144;
    float s = p.ada_b[l * 6144 + n];
#pragma unroll
    for (int ks = 0; ks < 8; ks++) s += mp[((size_t)((l * 8 + ks) * 9 + r)) * 6144 + n];
    mo[i] = s;
  }
}

__device__ __forceinline__ void rowpass(const Params& p, int l, int mode) {
  const int lane = TIDX & 63, wv = TIDX >> 6;
  const float* MOD = (const float*)(p.ws + OFF_MOD);
  u16* H = (u16*)(p.ws + OFF_H);
  const bool do_norm = !(mode == 2 && l == 1);
  const int ln = (mode == 2) ? (l == 1 ? l : l + 1) : l;
  const int ni = (mode == 1) ? 2 : 0, sho = (mode == 1) ? 3072 : 0, sco = (mode == 1) ? 4096 : 1024;
  for (int r = blockIdx.x * 8 + wv; r < NROWS; r += gridDim.x * 8) {
    const int mr = mod_row(r);
    if (l == 1 && mode != 0 && mr == 8) continue;
    const float* modl = MOD + ((size_t)(l * 9 + mr)) * 6144;
    const float* modn = MOD + ((size_t)(ln * 9 + mr)) * 6144;
    const float* ng2 = p.norm_g + (size_t)(ln * 4 + ni) * DM;
    const float* xs = (mode == 0 || (mode == 1 && l == 0)) ? xin_row(p, r) : (const float*)x_row(p, r);
    float4 xo[4], n2[4], sc4[4], sh4[4];
#pragma unroll
    for (int i = 0; i < 4; i++) {
      const int col = i * 256 + lane * 4;
      xo[i] = *(const float4*)(xs + col);
      n2[i] = *(const float4*)(ng2 + col);
      sc4[i] = *(const float4*)(modn + sco + col);
      sh4[i] = *(const float4*)(modn + sho + col);
    }
    float xv[16];
    if (mode == 0) {
#pragma unroll
      for (int i = 0; i < 4; i++) { xv[i * 4 + 0] = xo[i].x; xv[i * 4 + 1] = xo[i].y; xv[i * 4 + 2] = xo[i].z; xv[i * 4 + 3] = xo[i].w; }
    } else {
      const u16* src = (const u16*)(p.ws + (mode == 1 ? OFF_BIG : OFF_YS)) + (size_t)r * DM;
      const float* ng = p.norm_g + (size_t)(l * 4 + (mode == 1 ? 1 : 3)) * DM;
      const float* gt = modl + (mode == 1 ? 2048 : 5120);
      uint2 sv[4];
      float4 g4[4], n4[4];
#pragma unroll
      for (int i = 0; i < 4; i++) {
        const int col = i * 256 + lane * 4;
        sv[i] = *(const uint2*)(src + col);
        g4[i] = *(const float4*)(gt + col);
        n4[i] = *(const float4*)(ng + col);
      }
      float ov[16];
      float ss = 0.f;
#pragma unroll
      for (int i = 0; i < 4; i++) {
        ov[i * 4 + 0] = __uint_as_float(sv[i].x << 16); ov[i * 4 + 1] = __uint_as_float(sv[i].x & 0xffff0000u);
        ov[i * 4 + 2] = __uint_as_float(sv[i].y << 16); ov[i * 4 + 3] = __uint_as_float(sv[i].y & 0xffff0000u);
      }
#pragma unroll
      for (int i = 0; i < 16; i++) ss += ov[i] * ov[i];
      ss = wsum(ss);
      const float inv = rsq(ss * (1.f / 1024.f) + 1e-6f);
      float* xd = x_row(p, r);
#pragma unroll
      for (int i = 0; i < 4; i++) {
        xv[i * 4 + 0] = xo[i].x + g4[i].x * (ov[i * 4 + 0] * inv * n4[i].x);
        xv[i * 4 + 1] = xo[i].y + g4[i].y * (ov[i * 4 + 1] * inv * n4[i].y);
        xv[i * 4 + 2] = xo[i].z + g4[i].z * (ov[i * 4 + 2] * inv * n4[i].z);
        xv[i * 4 + 3] = xo[i].w + g4[i].w * (ov[i * 4 + 3] * inv * n4[i].w);
      }
#pragma unroll
      for (int i = 0; i < 4; i++)
        *(float4*)(xd + i * 256 + lane * 4) = make_float4(xv[i * 4 + 0], xv[i * 4 + 1], xv[i * 4 + 2], xv[i * 4 + 3]);
    }
    if (!do_norm) continue;
    float ss2 = 0.f;
#pragma unroll
    for (int i = 0; i < 16; i++) ss2 += xv[i] * xv[i];
    ss2 = wsum(ss2);
    const float inv2 = rsq(ss2 * (1.f / 1024.f) + 1e-6f);
#pragma unroll
    for (int i = 0; i < 4; i++) {
      const int col = i * 256 + lane * 4;
      float h0 = xv[i * 4 + 0] * inv2 * n2[i].x * (1.f + sc4[i].x) + sh4[i].x;
      float h1 = xv[i * 4 + 1] * inv2 * n2[i].y * (1.f + sc4[i].y) + sh4[i].y;
      float h2 = xv[i * 4 + 2] * inv2 * n2[i].z * (1.f + sc4[i].z) + sh4[i].z;
      float h3 = xv[i * 4 + 3] * inv2 * n2[i].w * (1.f + sc4[i].w) + sh4[i].w;
      uint2 o;
      o.x = pack2(h0, h1);
      o.y = pack2(h2, h3);
      *(uint2*)(H + (size_t)r * DM + col) = o;
    }
  }
}

#define LDT 72
namespace pg8 {
#define PG8_LAS __attribute__((address_space(3)))
typedef unsigned short bf16_t;
typedef short bf16x8 __attribute__((ext_vector_type(8)));
typedef float f32x4 __attribute__((ext_vector_type(4)));
typedef unsigned u32x4 __attribute__((ext_vector_type(4)));
constexpr int BM = 256, BK = 64, HALF = 128, HTB = HALF * BK * 2  , STAGE_BYTES = 8 * HTB, NXCD = 8, WGM = 8;

__host__ __device__ __forceinline__ int lds_byte(int r, int c) { const int st = (r >> 4) * 2 + (c >> 5), rr = r & 15, cc = c & 31, ob = rr * 64 + cc * 2; return st * 1024 + (ob ^ (((ob >> 9) & 1) << 5)); }
__host__ __device__ __forceinline__ void stage_rc(int b, int& R, int& C) { const int st = b / 1024, sb = b % 1024, swz = sb ^ (((sb >> 9) & 1) << 5); R = (st >> 1) * 16 + swz / 64; C = (st & 1) * 32 + (swz % 64) / 2; }
__host__ __device__ __forceinline__ int perm32(int rho) { const int n = rho >> 4, i = rho & 15; return 8 * (i >> 2) + 4 * n + (i & 3); }

struct Unit { int pm, pn; };
struct Gemm { const bf16_t* A; const bf16_t* Bt; int M, N, K, lda; };
struct StaticOrder {
    int nM, nN, nwg, G, c, skip;
    __host__ __device__ void init(int M, int N, int G_, int c_, int skip_ = 0) { nM = M / BM; nN = N / BM; nwg = nM * nN; G = G_; c = c_; skip = skip_; }
    __host__ __device__ bool next(int i, Unit& u) const {
        const long L = (long)i * G + c; if (L >= nwg) return false;
        int wgid = (int)L; { const int q = nwg / NXCD, r = nwg % NXCD, xcd = wgid % NXCD, off = wgid / NXCD; wgid = (xcd < r ? xcd * (q + 1) : r * (q + 1) + (xcd - r) * q) + off; }
        const int nig = WGM * nN, gid = wgid / nig, fm = gid * WGM, gsz = (nM - fm) < WGM ? (nM - fm) : WGM;
        u.pm = fm + ((wgid % nig) % gsz); u.pn = (wgid % nig) / gsz;
        if (skip) u.pm = (u.pm >> 4) * 17 + 1 + (u.pm & 15);
        return true;
    }
    __device__ __forceinline__ void a_ready(const Unit&) const {}
    __device__ __forceinline__ void done(const Unit&) const {}
};
__device__ __forceinline__ unsigned cvt_pk_bf16(float lo, float hi) { unsigned r; asm volatile("v_cvt_pk_bf16_f32 %0, %1, %2" : "=v"(r) : "v"(lo), "v"(hi)); return r; }
template <class Epi, class Sched, bool STAMP = false>
__device__ __forceinline__ void gemm_phase(PG8_LAS unsigned char* lds, const Gemm g, const Sched& S, const Epi& E, unsigned long long* stamps) {
    const int tid = TIDX, wid = __builtin_amdgcn_readfirstlane(tid >> 6), lane = tid & 63, wr = wid >> 2, wc = wid & 3, fr = lane & 15, fq = lane >> 4;
    const int K = g.K, nt = K / BK;
    int ts_lo = 0, ts_hi = 0, nts = 0; const unsigned long long rt_entry = STAMP ? (unsigned long long)wall_clock64() : 0ull;
#define PG8_STAMP() do { if (STAMP && wid == 0 && nts < 64) { const unsigned long long _c = (unsigned long long)clock64(); \
        ts_lo = (lane == nts) ? (int)(unsigned)_c : ts_lo; ts_hi = (lane == nts) ? (int)(unsigned)(_c >> 32) : ts_hi; ++nts; } } while (0)
    PG8_STAMP();
    unsigned voffA[2], voffB[2];
#pragma unroll
    for (int i = 0; i < 2; ++i) { int R, C; stage_rc(tid * 16 + i * 8192, R, C); const int Rb = Epi::PERM ? ((R & ~31) + perm32(R & 31)) : R;
        voffA[i] = (unsigned)(R * g.lda + C) * 2u; voffB[i] = (unsigned)(Rb * K + C) * 2u; }
    const size_t kstep = (size_t)(BK * 2);
    const size_t hstepB = (size_t)HALF * K * 2, hstepA = (size_t)HALF * g.lda * 2;
    const size_t tstepB = 2 * hstepB, tstepA = 2 * hstepA;
    const unsigned ldsw = (unsigned)wid * 1024u;
    const int aoff = lds_byte(wr * 64 + fr, fq * 8), boff = lds_byte(wc * 32 + fr, fq * 8);
#define PG8_SA(b, h) (((b) * 2 + (h)) * HTB)
#define PG8_SB(b, h) ((4 + (b) * 2 + (h)) * HTB)
#define PG8_STAGE(bufoff, gbase, voff) do { _Pragma("unroll") for (int _i = 0; _i < 2; ++_i) \
        __builtin_amdgcn_global_load_lds((const unsigned*)((const char*)(gbase) + (voff)[_i]), (PG8_LAS unsigned*)(lds + (bufoff) + ldsw + _i * 8192), 16, 0, 0); } while (0)
#define PG8_LDA(dst, b, h) do { _Pragma("unroll") for (int m = 0; m < 4; ++m) _Pragma("unroll") for (int k = 0; k < 2; ++k) dst[m][k] = *(const PG8_LAS bf16x8*)(lds + PG8_SA(b, h) + aoff + m * 2048 + k * 1024); } while (0)
#define PG8_LDB(dst, b, h) do { _Pragma("unroll") for (int n = 0; n < 2; ++n) _Pragma("unroll") for (int k = 0; k < 2; ++k) dst[n][k] = *(const PG8_LAS bf16x8*)(lds + PG8_SB(b, h) + boff + n * 2048 + k * 1024); } while (0)
#define PG8_MMA(ai, bj, At, Bt) do { __builtin_amdgcn_s_setprio(1); _Pragma("unroll") for (int m = 0; m < 4; ++m) _Pragma("unroll") for (int n = 0; n < 2; ++n) _Pragma("unroll") for (int k = 0; k < 2; ++k) \
        acc[ai][bj][m][n] = __builtin_amdgcn_mfma_f32_16x16x32_bf16(Bt[n][k], At[m][k], acc[ai][bj][m][n], 0, 0, 0); __builtin_amdgcn_s_setprio(0); } while (0)
#define PG8_WAIT_V(n) asm volatile("s_waitcnt vmcnt(" #n ")" ::: "memory")
#define PG8_WAIT_L(n) asm volatile("s_waitcnt lgkmcnt(" #n ")" ::: "memory")
#define PG8_BAR __builtin_amdgcn_s_barrier()
#define PG8_SCHED __builtin_amdgcn_sched_barrier(0)
    Unit cur, nxt; int ui = 0;
    if (!S.next(0, cur)) return;
    f32x4 acc[2][2][4][2];
#pragma unroll
    for (int a = 0; a < 2; ++a)
#pragma unroll
        for (int b = 0; b < 2; ++b)
#pragma unroll
            for (int m = 0; m < 4; ++m)
#pragma unroll
                for (int n = 0; n < 2; ++n) acc[a][b][m][n] = (f32x4){0.f, 0.f, 0.f, 0.f};
    bf16x8 At[4][2], B0[2][2], B1[2][2];
    const char* cA = (const char*)g.A + (size_t)cur.pm * tstepA; const char* cB = (const char*)g.Bt + (size_t)cur.pn * tstepB;
    S.a_ready(cur);
    PG8_STAGE(PG8_SB(0, 0), cB, voffB); PG8_STAGE(PG8_SA(0, 0), cA, voffA); PG8_STAGE(PG8_SB(0, 1), cB + hstepB, voffB); PG8_STAGE(PG8_SA(0, 1), cA + hstepA, voffA);
    if (wr == 1) PG8_BAR;
    PG8_WAIT_V(4); PG8_BAR;
    PG8_STAGE(PG8_SB(1, 0), cB + kstep, voffB); PG8_STAGE(PG8_SA(1, 0), cA + kstep, voffA); PG8_STAGE(PG8_SB(1, 1), cB + hstepB + kstep, voffB);
    PG8_WAIT_V(6); PG8_BAR;
    PG8_STAMP();
    for (;;) {
        const bool has_next = S.next(ui + 1, nxt);
        const char* nA = has_next ? (const char*)g.A + (size_t)nxt.pm * tstepA : cA; const char* nB = has_next ? (const char*)g.Bt + (size_t)nxt.pn * tstepB : cB;
        for (int t = 0; t < nt; t += 2) {
            const bool last = (t == nt - 2);
            const char* a1 = cA + (size_t)(t + 1) * kstep;
            const char* a2 = last ? nA : cA + (size_t)(t + 2) * kstep; const char* b2 = last ? nB : cB + (size_t)(t + 2) * kstep;
            const char* a3 = a2 + kstep; const char* b3 = b2 + kstep;
            if (last && has_next) S.a_ready(nxt);
            PG8_LDB(B0, 0, 0); PG8_SCHED; PG8_LDA(At, 0, 0); PG8_STAGE(PG8_SA(1, 1), a1 + hstepA, voffA);
            PG8_WAIT_L(8); PG8_BAR; PG8_WAIT_L(0); PG8_MMA(0, 0, At, B0); PG8_BAR; PG8_SCHED;
            PG8_LDB(B1, 0, 1); PG8_STAGE(PG8_SB(0, 0), b2, voffB);
            PG8_BAR; PG8_WAIT_L(0); PG8_MMA(0, 1, At, B1); PG8_BAR;
            PG8_LDA(At, 0, 1); PG8_STAGE(PG8_SA(0, 0), a2, voffA);
            PG8_BAR; PG8_WAIT_L(0); PG8_MMA(1, 0, At, B0); PG8_BAR; PG8_SCHED;
            PG8_STAGE(PG8_SB(0, 1), b2 + hstepB, voffB);
            PG8_WAIT_V(6); PG8_BAR; PG8_MMA(1, 1, At, B1); PG8_BAR;
            PG8_LDB(B0, 1, 0); PG8_SCHED; PG8_LDA(At, 1, 0); PG8_STAGE(PG8_SA(0, 1), a2 + hstepA, voffA);
            PG8_WAIT_L(8); PG8_BAR; PG8_WAIT_L(0); PG8_MMA(0, 0, At, B0); PG8_BAR; PG8_SCHED;
            PG8_LDB(B1, 1, 1); PG8_STAGE(PG8_SB(1, 0), b3, voffB);
            PG8_BAR; PG8_WAIT_L(0); PG8_MMA(0, 1, At, B1); PG8_BAR;
            PG8_LDA(At, 1, 1); PG8_STAGE(PG8_SA(1, 0), a3, voffA);
            PG8_BAR; PG8_WAIT_L(0); PG8_MMA(1, 0, At, B0); PG8_BAR; PG8_SCHED;
            PG8_STAGE(PG8_SB(1, 1), b3 + hstepB, voffB);
            PG8_WAIT_V(6); PG8_BAR; PG8_MMA(1, 1, At, B1); PG8_BAR;
        }
        PG8_STAMP();
        if constexpr (!Epi::AFTER_DRAIN) { E(acc, cur, wr, wc, fr, fq); S.done(cur); }
        PG8_STAMP();
        if (!has_next) break;
#pragma unroll
        for (int a = 0; a < 2; ++a)
#pragma unroll
            for (int b = 0; b < 2; ++b)
#pragma unroll
                for (int m = 0; m < 4; ++m)
#pragma unroll
                    for (int n = 0; n < 2; ++n) acc[a][b][m][n] = (f32x4){0.f, 0.f, 0.f, 0.f};
        cur = nxt; cA = nA; cB = nB; ++ui;
    }
    PG8_WAIT_V(0);
    if (wr == 0) PG8_BAR;
    PG8_BAR;
    if constexpr (Epi::AFTER_DRAIN) { E.fused(acc, cur, wr, wc, fr, fq, lds, wid, lane); S.done(cur); }
    PG8_STAMP();
    if (STAMP && wid == 0) { stamps[lane] = lane < nts ? (((unsigned long long)(unsigned)ts_hi << 32) | (unsigned)ts_lo) : 0ull;
        if (lane == 62) stamps[62] = rt_entry; if (lane == 63) stamps[63] = (unsigned long long)wall_clock64(); }
#undef PG8_STAMP
#undef PG8_SA
#undef PG8_SB
#undef PG8_STAGE
#undef PG8_LDA
#undef PG8_LDB
#undef PG8_MMA
#undef PG8_WAIT_V
#undef PG8_WAIT_L
#undef PG8_BAR
#undef PG8_SCHED
}
}

struct EpiBf {
  static constexpr bool PERM = true, AFTER_DRAIN = false;
  u16* O; int ldc; const float* bias; int act;
  __device__ __forceinline__ void operator()(const f32x4 (&acc)[2][2][4][2], const pg8::Unit& u, int wr, int wc, int fr, int fq) const {
    const int row0 = u.pm * 256 + wr * 64 + fr, col0 = u.pn * 256 + wc * 32 + 8 * fq;
    f32x4 bv[2][2];
#pragma unroll
    for (int bj = 0; bj < 2; ++bj)
#pragma unroll
      for (int n = 0; n < 2; ++n) bv[bj][n] = bias ? *(const f32x4*)(bias + col0 + bj * 128 + 4 * n) : f32x4{0.f, 0.f, 0.f, 0.f};
#pragma unroll
    for (int ai = 0; ai < 2; ++ai)
#pragma unroll
      for (int m = 0; m < 4; ++m) {
        u16* rowp = O + (size_t)(row0 + ai * 128 + m * 16) * ldc + col0;
#pragma unroll
        for (int bj = 0; bj < 2; ++bj) {
          f32x4 v0 = acc[ai][bj][m][0] + bv[bj][0], v1 = acc[ai][bj][m][1] + bv[bj][1];
          if (act == 1) {
#pragma unroll
            for (int j = 0; j < 4; ++j) { v0[j] = sigm(v0[j]); v1[j] = sigm(v1[j]); }
          }
          uint4 wv;
          wv.x = pack2(v0[0], v0[1]); wv.y = pack2(v0[2], v0[3]); wv.z = pack2(v1[0], v1[1]); wv.w = pack2(v1[2], v1[3]);
          *(uint4*)(rowp + bj * 128) = wv;
        }
      }
  }
};
struct EpiSwiglu {
  static constexpr bool PERM = true, AFTER_DRAIN = false;
  u16* O;
  __device__ __forceinline__ void operator()(const f32x4 (&acc)[2][2][4][2], const pg8::Unit& u, int wr, int wc, int fr, int fq) const {
    const int row0 = u.pm * 256 + wr * 64 + fr, col0 = u.pn * 128 + wc * 16 + 4 * fq;
#pragma unroll
    for (int ai = 0; ai < 2; ++ai)
#pragma unroll
      for (int m = 0; m < 4; ++m) {
        u16* rowp = O + (size_t)(row0 + ai * 128 + m * 16) * FH + col0;
#pragma unroll
        for (int bj = 0; bj < 2; ++bj) {
          const f32x4 g = acc[ai][bj][m][0], up = acc[ai][bj][m][1];
          uint2 wv;
          wv.x = pack2(siluf(g[0]) * up[0], siluf(g[1]) * up[1]);
          wv.y = pack2(siluf(g[2]) * up[2], siluf(g[3]) * up[3]);
          *(uint2*)(rowp + bj * 64) = wv;
        }
      }
  }
};
struct EpiGateAcc {
  static constexpr bool PERM = true, AFTER_DRAIN = false;
  u16* ACC; const u16* G; int gcol; unsigned amask;
  __device__ __forceinline__ void operator()(const f32x4 (&acc)[2][2][4][2], const pg8::Unit& u, int wr, int wc, int fr, int fq) const {
    unsigned pk[2][2][4][4];
#pragma unroll
    for (int ai = 0; ai < 2; ++ai)
#pragma unroll
      for (int bj = 0; bj < 2; ++bj)
#pragma unroll
        for (int m = 0; m < 4; ++m) {
          pk[ai][bj][m][0] = pack2(acc[ai][bj][m][0][0], acc[ai][bj][m][0][1]);
          pk[ai][bj][m][1] = pack2(acc[ai][bj][m][0][2], acc[ai][bj][m][0][3]);
          pk[ai][bj][m][2] = pack2(acc[ai][bj][m][1][0], acc[ai][bj][m][1][1]);
          pk[ai][bj][m][3] = pack2(acc[ai][bj][m][1][2], acc[ai][bj][m][1][3]);
        }
    asm volatile("" ::: "memory");
    const int row0 = u.pm * 256 + wr * 64 + fr, col0 = u.pn * 256 + wc * 32 + 8 * fq;
#pragma unroll
    for (int ai = 0; ai < 2; ++ai)
#pragma unroll
      for (int m = 0; m < 4; ++m) {
        const size_t row = (size_t)(row0 + ai * 128 + m * 16);
#pragma unroll
        for (int bj = 0; bj < 2; ++bj) {
          const int col = col0 + bj * 128;
          const uint4 gv = *(const uint4*)(G + row * 2048 + gcol + col);
          const uint4 av = *(const uint4*)(ACC + row * DM + col);
          const unsigned gw[4] = {gv.x, gv.y, gv.z, gv.w};
          const unsigned aw[4] = {av.x & amask, av.y & amask, av.z & amask, av.w & amask};
          unsigned ow[4];
#pragma unroll
          for (int q = 0; q < 4; ++q) {
            const unsigned pv = pk[ai][bj][m][q];
            const float lo = __uint_as_float(aw[q] << 16) + __uint_as_float(gw[q] << 16) * __uint_as_float(pv << 16);
            const float hi = __uint_as_float(aw[q] & 0xffff0000u) + __uint_as_float(gw[q] & 0xffff0000u) * __uint_as_float(pv & 0xffff0000u);
            ow[q] = pack2(lo, hi);
          }
          *(uint4*)(ACC + row * DM + col) = make_uint4(ow[0], ow[1], ow[2], ow[3]);
        }
        asm volatile("" ::: "memory");
      }
  }
};

template <int MI>
__device__ __forceinline__ void gemm_loop(const u16* __restrict__ A, int lda, const u16* __restrict__ Bt, int ldb, int K,
                                          f32x4 (&acc)[MI][4], u16* sA, u16* sB) {
  constexpr int BMT = MI * 64;
  const int tid = TIDX, lane = tid & 63, w = tid >> 6, wm = w >> 1, wn = w & 1, fr = lane & 15, fq = lane >> 4;
  uint4 ra[MI], rb[2];
  const u16* ga = A + (size_t)(tid >> 3) * lda + (tid & 7) * 8;
  const u16* gb = Bt + (size_t)(tid >> 3) * ldb + (tid & 7) * 8;
  const int so = (tid >> 3) * LDT + (tid & 7) * 8;
#pragma unroll
  for (int i = 0; i < MI; i++) ra[i] = *(const uint4*)(ga + (size_t)(i * 64) * lda);
#pragma unroll
  for (int i = 0; i < 2; i++) rb[i] = *(const uint4*)(gb + (size_t)(i * 64) * ldb);
#pragma unroll
  for (int i = 0; i < MI; i++) *(uint4*)(sA + so + i * 64 * LDT) = ra[i];
#pragma unroll
  for (int i = 0; i < 2; i++) *(uint4*)(sB + so + i * 64 * LDT) = rb[i];
  __syncthreads();
  const int nk = K >> 6;
  for (int kt = 0; kt < nk; kt++) {
    const bool more = kt + 1 < nk;
    if (more) {
#pragma unroll
      for (int i = 0; i < MI; i++) ra[i] = *(const uint4*)(ga + (size_t)(i * 64) * lda + (kt + 1) * 64);
#pragma unroll
      for (int i = 0; i < 2; i++) rb[i] = *(const uint4*)(gb + (size_t)(i * 64) * ldb + (kt + 1) * 64);
    }
    const u16* a = sA + (kt & 1) * BMT * LDT + (wm * (MI * 16) + fr) * LDT + fq * 8;
    const u16* b = sB + (kt & 1) * 128 * LDT + (wn * 64 + fr) * LDT + fq * 8;
#pragma unroll
    for (int ks = 0; ks < 2; ks++) {
      bf16x8 af[MI], bfr[4];
#pragma unroll
      for (int i = 0; i < MI; i++) af[i] = *(const bf16x8*)(a + i * 16 * LDT + ks * 32);
#pragma unroll
      for (int j = 0; j < 4; j++) bfr[j] = *(const bf16x8*)(b + j * 16 * LDT + ks * 32);
#pragma unroll
      for (int i = 0; i < MI; i++)
#pragma unroll
        for (int j = 0; j < 4; j++) acc[i][j] = __builtin_amdgcn_mfma_f32_16x16x32_bf16(bfr[j], af[i], acc[i][j], 0, 0, 0);
    }
    if (more) {
      u16* da = sA + ((kt + 1) & 1) * BMT * LDT + so;
      u16* db = sB + ((kt + 1) & 1) * 128 * LDT + so;
#pragma unroll
      for (int i = 0; i < MI; i++) *(uint4*)(da + i * 64 * LDT) = ra[i];
#pragma unroll
      for (int i = 0; i < 2; i++) *(uint4*)(db + i * 64 * LDT) = rb[i];
    }
    __syncthreads();
  }
}

template <int MI>
__device__ __forceinline__ void zero_acc(f32x4 (&acc)[MI][4]) {
#pragma unroll
  for (int i = 0; i < MI; i++)
#pragma unroll
    for (int j = 0; j < 4; j++) acc[i][j] = f32x4{0.f, 0.f, 0.f, 0.f};
}


typedef unsigned u32x4v __attribute__((ext_vector_type(4)));
__device__ __forceinline__ void yp_issue(const u16* __restrict__ A, const u16* __restrict__ B, u32x4v (&ra)[8], u32x4v (&rb)[8], int tid) {
#pragma unroll
  for (int i = 0; i < 8; i++) {
    const int c = tid + i * NTHR, row = c >> 5, ch = c & 31;
    ra[i] = *(const u32x4v*)(A + (size_t)row * YST + ch * 8);
    rb[i] = *(const u32x4v*)(B + (size_t)row * 256 + ch * 8);
  }
}
__device__ __forceinline__ void yp_stage(unsigned char* sA, unsigned char* sB, const u32x4v (&ra)[8], const u32x4v (&rb)[8], int tid) {
#pragma unroll
  for (int i = 0; i < 8; i++) {
    const int c = tid + i * NTHR, row = c >> 5, ch = c & 31;
    const int off = row * 512 + ((ch ^ (row & 7)) << 4);
    *(u32x4v*)(sA + off) = ra[i];
    *(u32x4v*)(sB + off) = rb[i];
  }
}
__device__ __forceinline__ void phase_ypart(const Params& p, int l, unsigned char* smem) {
  unsigned char* sA = smem;
  unsigned char* sB = smem + 65536;
  const int tid = TIDX, lane = tid & 63, w = tid >> 6, wm = w >> 1, wn = w & 1, fr = lane & 15, fq = lane >> 4;
  const u16* Y = (const u16*)(p.ws + OFF_YS);
  const u16* Wb = (const u16*)(p.ws + OFF_W + OW_B);
  const u16* G = (const u16*)(p.ws + OFF_BIG);
  u16* ACC = (u16*)(p.ws + OFF_H);
  constexpr int NT = 8;
  const int ntiles = (NROWS / 128) * NT;
  const int G_ = gridDim.x;
  const bool xmap = (G_ == 256);
  const int xj = blockIdx.x >> 3, xx = blockIdx.x & 7;
  const bool skipc = (l == 1);
  const int nrt = skipc ? 256 : 272;
  const int ntl = nrt * NT;
  const int nmine = xmap ? (xj < nrt ? (nrt - 1 - xj) / 32 + 1 : 0)
                         : (((int)blockIdx.x < ntl) ? (ntl - 1 - (int)blockIdx.x) / G_ + 1 : 0);
  if (nmine == 0) return;
#define YP_TILE(Q_, MT_, NT_)                                                        \
  do {                                                                               \
    if (xmap) { const int s_ = (Q_) * 32 + xj; MT_ = (s_ >> 3) * 8 + xx; NT_ = s_ & 7; } \
    else { const int t_ = blockIdx.x + (Q_) * G_; MT_ = t_ / NT; NT_ = t_ - MT_ * NT; }  \
    if (skipc) MT_ = (MT_ >> 5) * 34 + 2 + (MT_ & 31);                                   \
  } while (0)
  u32x4v ra[8], rb[8];
  {
    int mt, nt;
    YP_TILE(0, mt, nt);
    yp_issue(Y + (size_t)mt * 128 * YST, Wb + ((size_t)nt * 128) * 256, ra, rb, tid);
  }
  f32x4 tot[2][4];
  zero_acc<2>(tot);
  for (int qi = 0; qi < 4 * nmine; qi++) {
    const int q = qi >> 2, k = qi & 3;
    int mt, nt;
    YP_TILE(q, mt, nt);
    const int r0 = mt * 128 + wm * 32 + fr, c0 = nt * 128 + wn * 64 + fq * 4;
    __syncthreads();
    yp_stage(sA, sB, ra, rb, tid);
    __syncthreads();
    {
      const int qn = qi + 1 < 4 * nmine ? qi + 1 : qi;
      int mtn, ntn;
      YP_TILE(qn >> 2, mtn, ntn);
      const int brn = qn & 3, ycn = brn < 3 ? brn * 256 : 1536;
      yp_issue(Y + (size_t)mtn * 128 * YST + ycn, Wb + ((size_t)brn * 1024 + ntn * 128) * 256, ra, rb, tid);
    }
    uint2 gv[2][4];
#pragma unroll
    for (int i = 0; i < 2; i++)
#pragma unroll
      for (int j = 0; j < 4; j++) gv[i][j] = *(const uint2*)(G + (size_t)(r0 + i * 16) * 4096 + k * 1024 + c0 + j * 16);
    f32x4 ay[2][4];
    zero_acc<2>(ay);
#pragma unroll 2
    for (int ks = 0; ks < 8; ks++) {
      bf16x8 af[2], bfr[4];
#pragma unroll
      for (int i = 0; i < 2; i++) {
        const int row = wm * 32 + i * 16 + fr;
        af[i] = *(const bf16x8*)(sA + row * 512 + (((ks * 4 + fq) ^ (row & 7)) << 4));
      }
#pragma unroll
      for (int j = 0; j < 4; j++) {
        const int row = wn * 64 + j * 16 + fr;
        bfr[j] = *(const bf16x8*)(sB + row * 512 + (((ks * 4 + fq) ^ (row & 7)) << 4));
      }
#pragma unroll
      for (int i = 0; i < 2; i++)
#pragma unroll
        for (int j = 0; j < 4; j++) ay[i][j] = __builtin_amdgcn_mfma_f32_16x16x32_bf16(bfr[j], af[i], ay[i][j], 0, 0, 0);
    }
#pragma unroll
    for (int i = 0; i < 2; i++)
#pragma unroll
      for (int j = 0; j < 4; j++) {
        tot[i][j][0] += __uint_as_float(gv[i][j].x << 16) * ay[i][j][0];
        tot[i][j][1] += __uint_as_float(gv[i][j].x & 0xffff0000u) * ay[i][j][1];
        tot[i][j][2] += __uint_as_float(gv[i][j].y << 16) * ay[i][j][2];
        tot[i][j][3] += __uint_as_float(gv[i][j].y & 0xffff0000u) * ay[i][j][3];
      }
    if (k == 3) {
#pragma unroll
      for (int i = 0; i < 2; i++)
#pragma unroll
        for (int j = 0; j < 4; j++) {
          uint2 ov;
          ov.x = pack2(tot[i][j][0], tot[i][j][1]); ov.y = pack2(tot[i][j][2], tot[i][j][3]);
          *(uint2*)(ACC + (size_t)(r0 + i * 16) * DM + c0 + j * 16) = ov;
        }
      zero_acc<2>(tot);
    }
  }
  __syncthreads();
#undef YP_TILE
}

#define S2_BUF 10816
#define S2_D 0
#define S2_U 2048
#define S2_P 4096
#define S2_K 6144
#define S2_DQ 8192
#define S2_V 10240
#define S2_C1 10752
#define S2_C2 10784
#define S2_ST (2 * S2_BUF)
#define S2_YB (S2_ST + 8192)

__device__ __forceinline__ float red16(float x) {
  x += dppf<0xB1>(x);
  x += dppf<0x4E>(x);
  x += dppf<0x141>(x);
  x += dppf<0x140>(x);
  return x;
}
__device__ __forceinline__ void wave_lds_sync() {
  asm volatile("s_waitcnt lgkmcnt(0)" ::: "memory");
  __builtin_amdgcn_wave_barrier();
}

template <int MIX>
__device__ __forceinline__ void scan2_item(const Params& p, int l, int b, int h, int dir, int rq, float* sm) {
  constexpr int EPL = (MIX == 2) ? 2 : 4;
  constexpr int VOFF = (MIX == 2) ? 64 : 128;
  const int tid = TIDX, lane = tid & 63, w = tid >> 6, fr = lane & 15, fq = lane >> 4;
  const bool producer = w >= 4;
  const int pw = w & 3;
  const u16* P = (const u16*)(p.ws + OFF_BIG);
  u16* YS = (u16*)(p.ws + OFF_YS);
  float* BC = (float*)(p.ws + OFF_BC);
  float* ST = sm + S2_ST + pw * 2048;
  float s[EPL];
#pragma unroll
  for (int i = 0; i < EPL; i++) s[i] = 0.f;

  bf16x8 bw2[4], ba2[4];
  float cst[5][4];
  float cw[3][7];
  float muv[4];
  int colv[4];
#pragma unroll
  for (int i = 0; i < 4; i++) { bw2[i] = bf16x8{0, 0, 0, 0, 0, 0, 0, 0}; ba2[i] = bw2[i]; muv[i] = 0.f; colv[i] = 0; }
  if (producer) {
    if (MIX == 0) {
#pragma unroll
      for (int nt = 0; nt < 4; nt++) {
        const int jch = h * 64 + nt * 16 + fr;
#pragma unroll
        for (int jj = 0; jj < 8; jj++) {
          bw2[nt][jj] = (short)f2bf(p.rwkv_w2[((size_t)(l * 2 + dir) * 32 + fq * 8 + jj) * 256 + jch]);
          ba2[nt][jj] = (short)f2bf(p.rwkv_a2[((size_t)(l * 2 + dir) * 32 + fq * 8 + jj) * 256 + jch]);
        }
        cst[0][nt] = p.rwkv_w0[(l * 2 + dir) * 256 + jch];
        cst[1][nt] = p.rwkv_a0[(l * 2 + dir) * 256 + jch];
        cst[2][nt] = p.rwkv_ka[l * 256 + jch];
        cst[3][nt] = p.rwkv_kk[l * 256 + jch];
        cst[4][nt] = p.rwkv_rk[l * 256 + jch];
      }
#pragma unroll
      for (int i = 0; i < 4; i++) {
        const int c = lane + 64 * i;
        colv[i] = i < 3 ? i * 256 + h * 64 + lane : (lane < 32 ? 768 + dir * 32 + lane : 832 + dir * 32 + (lane - 32));
        muv[i] = p.rwkv_mu[l * 960 + colv[i]];
        (void)c;
      }
    } else if (MIX == 1) {
#pragma unroll
      for (int i = 0; i < 3; i++) {
        colv[i] = PB + i * 256 + h * 64 + lane;
#pragma unroll
        for (int tp = 0; tp < 7; tp++) cw[i][tp] = p.gdn_conv[((size_t)l * 7 + tp) * 768 + i * 256 + h * 64 + lane];
      }
    } else {
#pragma unroll
      for (int nt = 0; nt < 2; nt++) {
#pragma unroll
        for (int jj = 0; jj < 8; jj++)
          bw2[nt][jj] = fq < 2 ? (short)f2bf(p.gla_gw2[((size_t)(l * 2 + dir) * 16 + fq * 8 + jj) * 128 + h * 32 + nt * 16 + fr]) : (short)0;
        cst[0][nt] = p.gla_gb[(l * 2 + dir) * 128 + h * 32 + nt * 16 + fr];
      }
      colv[0] = PC + h * 32 + lane;
      if (lane >= 32) colv[0] = PC + 128 + h * 32 + (lane - 32);
      colv[1] = PC + 256 + h * 64 + lane;
      colv[2] = PC + 512 + dir * 16 + (lane & 15);
    }
  }
  __syncthreads();

  for (int c = 0; c <= TPB / 32 + 1; c++) {
    if (producer) {
      if (c >= 2) {
        const int cc = c - 2;
        int seg_row0, t_lo;
        if (cc < 8) { seg_row0 = b * TPB; t_lo = dir == 0 ? cc * 32 : (LC - 32 - cc * 32); }
        else { seg_row0 = b * TPB + LC; t_lo = dir == 0 ? (cc - 8) * 32 : (SEQ - 32 - (cc - 8) * 32); }
        const float* yb = sm + S2_YB + (cc & 1) * 512;
        const int t2 = tid - 256;
#pragma unroll
        for (int i = 0; i < 2; i++) {
          const int idx = t2 + i * 256, tt = idx >> 4, e = idx & 15;
          YS[(size_t)(seg_row0 + t_lo + tt) * YST + dir * 768 + MIX * 256 + h * 64 + rq * 16 + e] = f2bf(yb[idx]);
        }
      }
      if (c < TPB / 32) {
        int seg_row0, seg_len, t_lo;
        if (c < 8) { seg_row0 = b * TPB; seg_len = LC; t_lo = dir == 0 ? c * 32 : (LC - 32 - c * 32); }
        else { seg_row0 = b * TPB + LC; seg_len = SEQ; t_lo = dir == 0 ? (c - 8) * 32 : (SEQ - 32 - (c - 8) * 32); }
        const u16* Pseg = P + (size_t)seg_row0 * PST;
        float* B = sm + (c & 1) * S2_BUF;
        const int t0 = t_lo + pw * 8;
        if (MIX == 0) {
          float raw[10][4];
#pragma unroll
          for (int rr = 0; rr < 10; rr++) {
            const int t = t0 - 1 + rr;
            const float okf = (t >= 0 && t < seg_len) ? 1.f : 0.f;
            const int tc = min(max(t, 0), seg_len - 1);
#pragma unroll
            for (int i = 0; i < 4; i++) raw[rr][i] = bf2f(Pseg[(size_t)tc * PST + PA + colv[i]]) * okf;
          }
#pragma unroll
          for (int j = 0; j < 8; j++)
#pragma unroll
            for (int i = 0; i < 4; i++) {
              float xm = raw[j + 1][i] + (0.5f * (raw[j][i] + raw[j + 2][i]) - raw[j + 1][i]) * muv[i];
              if (i == 3 && lane < 32) xm = tanh_fast(xm);
              ST[j * 256 + lane + 64 * i] = xm;
            }
        } else if (MIX == 1) {
          float raw[14][3];
#pragma unroll
          for (int rr = 0; rr < 14; rr++) {
            const int t = t0 - 3 + rr;
            const float okf = (t >= 0 && t < seg_len) ? 1.f : 0.f;
            const int tc = min(max(t, 0), seg_len - 1);
#pragma unroll
            for (int i = 0; i < 3; i++) raw[rr][i] = bf2f(Pseg[(size_t)tc * PST + colv[i]]) * okf;
          }
#pragma unroll
          for (int j = 0; j < 8; j++)
#pragma unroll
            for (int i = 0; i < 3; i++) {
              float a = 0.f;
#pragma unroll
              for (int tp = 0; tp < 7; tp++) a += raw[j + tp][i] * cw[i][tp];
              ST[j * 256 + lane + 64 * i] = siluf(a);
            }
          if (lane < 8) {
            const u16* pp = Pseg + (size_t)(t0 + lane) * PST + PB;
            float bx = bf2f(pp[768 + dir * 4 + h]);
            float ax = bf2f(pp[776 + dir * 4 + h]);
            float ld = -__expf(p.gdn_a_log[(l * 2 + dir) * 4 + h]) * softplusf(ax + p.gdn_dt_bias[(l * 2 + dir) * 4 + h]);
            ST[lane * 256 + 192] = sigm(bx);
            ST[lane * 256 + 193] = __expf(ld);
          }
        } else {
          u16 raw[8][3];
#pragma unroll
          for (int j = 0; j < 8; j++) {
            const u16* pp = Pseg + (size_t)(t0 + j) * PST;
#pragma unroll
            for (int i = 0; i < 3; i++) raw[j][i] = pp[colv[i]];
          }
          const float qs = lane < 32 ? 0.17677669529663687f : 1.f;
#pragma unroll
          for (int j = 0; j < 8; j++) {
            ST[j * 256 + lane] = bf2f(raw[j][0]) * qs;
            ST[j * 256 + 64 + lane] = bf2f(raw[j][1]);
            if (lane < 16) ST[j * 256 + 128 + lane] = bf2f(raw[j][2]);
          }
        }
        wave_lds_sync();
        const bool vl = fq < 2;
        if (MIX == 0) {
          bf16x8 aw, aa;
#pragma unroll
          for (int jj = 0; jj < 8; jj++) {
            aw[jj] = fr < 8 ? (short)f2bf(ST[fr * 256 + 192 + fq * 8 + jj]) : (short)0;
            aa[jj] = fr < 8 ? (short)f2bf(ST[fr * 256 + 224 + fq * 8 + jj]) : (short)0;
          }
          f32x4 accw[4], acca[4];
#pragma unroll
          for (int nt = 0; nt < 4; nt++) {
            accw[nt] = __builtin_amdgcn_mfma_f32_16x16x32_bf16(aw, bw2[nt], f32x4{0.f, 0.f, 0.f, 0.f}, 0, 0, 0);
            acca[nt] = __builtin_amdgcn_mfma_f32_16x16x32_bf16(aa, ba2[nt], f32x4{0.f, 0.f, 0.f, 0.f}, 0, 0, 0);
          }
#pragma unroll
          for (int r = 0; r < 4; r++) {
            const int j = (fq & 1) * 4 + r, tt = pw * 8 + j;
            float kkx[4], av[4], kdv[4], rv[4], dec[4];
            float ss = 0.f;
#pragma unroll
            for (int nt = 0; nt < 4; nt++) {
              const int n = nt * 16 + fr;
              rv[nt] = ST[j * 256 + n];
              const float kx = ST[j * 256 + 64 + n];
              dec[nt] = __expf(-0.6065306597126334f * sigm(cst[0][nt] + accw[nt][r]));
              av[nt] = sigm(cst[1][nt] + acca[nt][r]);
              kdv[nt] = kx * (1.f + (av[nt] - 1.f) * cst[2][nt]);
              kkx[nt] = kx * cst[3][nt];
              ss += kkx[nt] * kkx[nt];
            }
            ss = red16(ss);
            const float rs = rsq(ss + 1e-6f);
            float c1 = 0.f, c2 = 0.f, bc = 0.f;
#pragma unroll
            for (int nt = 0; nt < 4; nt++) {
              const int n = nt * 16 + fr;
              const float kk = kkx[nt] * rs;
              if (vl) {
                B[S2_D + tt * 64 + n] = dec[nt];
                B[S2_U + tt * 64 + n] = kk;
                B[S2_P + tt * 64 + n] = -kk * av[nt];
                B[S2_K + tt * 64 + n] = kdv[nt];
                B[S2_DQ + tt * 64 + n] = dec[nt] * rv[nt];
              }
              c1 += -kk * av[nt] * rv[nt];
              c2 += kdv[nt] * rv[nt];
              bc += rv[nt] * kdv[nt] * cst[4][nt];
            }
            c1 = red16(c1); c2 = red16(c2); bc = red16(bc);
            if (vl && fr == 0) {
              B[S2_C1 + tt] = c1;
              B[S2_C2 + tt] = c2;
              if (rq == 0) BC[(size_t)(seg_row0 + t_lo + tt) * 8 + h * 2 + dir] = bc;
            }
          }
        } else if (MIX == 1) {
#pragma unroll
          for (int r = 0; r < 4; r++) {
            const int j = (fq & 1) * 4 + r, tt = pw * 8 + j;
            float qv[4], kv[4];
            float sq = 0.f, sk = 0.f;
#pragma unroll
            for (int nt = 0; nt < 4; nt++) {
              const int n = nt * 16 + fr;
              qv[nt] = ST[j * 256 + n];
              kv[nt] = ST[j * 256 + 64 + n];
              sq += qv[nt] * qv[nt];
              sk += kv[nt] * kv[nt];
            }
            sq = red16(sq); sk = red16(sk);
            const float rq_ = rsq(sq + 1e-6f) * 0.125f, rk_ = rsq(sk + 1e-6f);
            const float beta = ST[j * 256 + 192], alpha = ST[j * 256 + 193];
            float dkq = 0.f;
#pragma unroll
            for (int nt = 0; nt < 4; nt++) {
              const int n = nt * 16 + fr;
              const float qn = qv[nt] * rq_, kn = kv[nt] * rk_;
              if (vl) {
                B[S2_D + tt * 64 + n] = alpha;
                B[S2_U + tt * 64 + n] = kn;
                B[S2_P + tt * 64 + n] = -alpha * beta * kn;
                B[S2_K + tt * 64 + n] = beta * kn;
                B[S2_DQ + tt * 64 + n] = alpha * qn;
              }
              dkq += kn * qn;
            }
            dkq = red16(dkq);
            if (vl && fr == 0) {
              B[S2_C1 + tt] = -alpha * beta * dkq;
              B[S2_C2 + tt] = beta * dkq;
            }
          }
        } else {
          bf16x8 ag;
#pragma unroll
          for (int jj = 0; jj < 8; jj++) ag[jj] = (fr < 8 && fq < 2) ? (short)f2bf(ST[fr * 256 + 128 + fq * 8 + jj]) : (short)0;
          f32x4 accg[2];
#pragma unroll
          for (int nt = 0; nt < 2; nt++) accg[nt] = __builtin_amdgcn_mfma_f32_16x16x32_bf16(ag, bw2[nt], f32x4{0.f, 0.f, 0.f, 0.f}, 0, 0, 0);
#pragma unroll
          for (int r = 0; r < 4; r++) {
            const int j = (fq & 1) * 4 + r, tt = pw * 8 + j;
            float dkq = 0.f;
#pragma unroll
            for (int nt = 0; nt < 2; nt++) {
              const int n = nt * 16 + fr;
              const float lg = cst[0][nt] + accg[nt][r];
              const float ls = fminf(lg, 0.f) - __logf(1.f + __expf(-fabsf(lg)));
              const float alpha = __expf(ls * (1.f / 16.f));
              const float qv = ST[j * 256 + n], kv = ST[j * 256 + 32 + n];
              if (vl) {
                B[S2_D + tt * 64 + n] = alpha;
                B[S2_K + tt * 64 + n] = kv;
                B[S2_DQ + tt * 64 + n] = alpha * qv;
              }
              dkq += kv * qv;
            }
            dkq = red16(dkq);
            if (vl && fr == 0) B[S2_C2 + tt] = dkq;
          }
        }
#pragma unroll
        for (int i = 0; i < 2; i++) {
          const int idx = lane + 64 * i, j = idx >> 4, e = idx & 15;
          B[S2_V + (pw * 8 + j) * 16 + e] = ST[j * 256 + VOFF + rq * 16 + e];
        }
      }
    } else if (c >= 1 && c <= TPB / 32) {
      const float* B = sm + ((c - 1) & 1) * S2_BUF;
      float* yb = sm + S2_YB + ((c - 1) & 1) * 512;
      const int rl = w * 4 + fq;
      const int dtt = dir ? -1 : 1;
      int tt = dir ? 31 : 0;
      float dv[EPL], kv[EPL], qv[EPL], uv[EPL], pv[EPL], vv, c1v, c2v;
      float dn[EPL], kn[EPL], qn[EPL], un[EPL], pn[EPL], vn, c1n, c2n;
#define S2_LOAD(D_, K_, Q_, U_, P_, V_, C1_, C2_, T_)                                   \
  do {                                                                                  \
    const int o_ = (T_) * 64 + fr * EPL;                                                \
    if (EPL == 4) {                                                                     \
      float4 t4 = *(const float4*)(B + S2_D + o_);                                      \
      D_[0] = t4.x; D_[1] = t4.y; D_[2] = t4.z; D_[3] = t4.w;                           \
      t4 = *(const float4*)(B + S2_K + o_);                                             \
      K_[0] = t4.x; K_[1] = t4.y; K_[2] = t4.z; K_[3] = t4.w;                           \
      t4 = *(const float4*)(B + S2_DQ + o_);                                            \
      Q_[0] = t4.x; Q_[1] = t4.y; Q_[2] = t4.z; Q_[3] = t4.w;                           \
      t4 = *(const float4*)(B + S2_U + o_);                                             \
      U_[0] = t4.x; U_[1] = t4.y; U_[2] = t4.z; U_[3] = t4.w;                           \
      t4 = *(const float4*)(B + S2_P + o_);                                             \
      P_[0] = t4.x; P_[1] = t4.y; P_[2] = t4.z; P_[3] = t4.w;                           \
      C1_ = B[S2_C1 + (T_)];                                                            \
    } else {                                                                            \
      float2 t2 = *(const float2*)(B + S2_D + o_);                                      \
      D_[0] = t2.x; D_[1] = t2.y;                                                       \
      t2 = *(const float2*)(B + S2_K + o_);                                             \
      K_[0] = t2.x; K_[1] = t2.y;                                                       \
      t2 = *(const float2*)(B + S2_DQ + o_);                                            \
      Q_[0] = t2.x; Q_[1] = t2.y;                                                       \
      U_[0] = U_[1] = P_[0] = P_[1] = 0.f; C1_ = 0.f;                                   \
    }                                                                                   \
    V_ = B[S2_V + (T_) * 16 + rl];                                                      \
    C2_ = B[S2_C2 + (T_)];                                                              \
  } while (0)
#define S2_STEP(D_, K_, Q_, U_, P_, V_, C1_, C2_, T_)                                   \
  do {                                                                                  \
    float sq = 0.f, sa = 0.f;                                                           \
    _Pragma("unroll") for (int i = 0; i < EPL; i++) sq += s[i] * Q_[i];                 \
    if (MIX != 2) {                                                                     \
      _Pragma("unroll") for (int i = 0; i < EPL; i++) sa += s[i] * U_[i];               \
      sa = red16(sa);                                                                   \
    }                                                                                   \
    sq = red16(sq);                                                                     \
    float y = sq + V_ * C2_;                                                            \
    if (MIX != 2) y += sa * C1_;                                                        \
    _Pragma("unroll") for (int i = 0; i < EPL; i++) {                                   \
      float t = s[i] * D_[i] + V_ * K_[i];                                              \
      if (MIX != 2) t += sa * P_[i];                                                    \
      s[i] = t;                                                                         \
    }                                                                                   \
    yb[(T_) * 16 + rl] = y;                                                             \
  } while (0)
      S2_LOAD(dv, kv, qv, uv, pv, vv, c1v, c2v, tt);
#pragma unroll 1
      for (int st = 0; st < 32; st += 2) {
        const int t1 = tt + dtt;
        S2_LOAD(dn, kn, qn, un, pn, vn, c1n, c2n, t1);
        S2_STEP(dv, kv, qv, uv, pv, vv, c1v, c2v, tt);
        const int t2 = st + 2 < 32 ? t1 + dtt : t1;
        S2_LOAD(dv, kv, qv, uv, pv, vv, c1v, c2v, t2);
        S2_STEP(dn, kn, qn, un, pn, vn, c1n, c2n, t1);
        tt = t2;
      }
#undef S2_LOAD
#undef S2_STEP
    }
    __syncthreads();
  }
}

#define S3_SUB 12800
#define S3_GM 0
#define S3_KVT 9216
#define S3_QB 10240
#define S3_QV 11392
#define S3_VT 11520
#define S3_WC 12544
#define S3_KB (S3_GM + 0)
#define S3_BT (S3_GM + 2048)
#define S3_STB (8 * S3_SUB)
#define S3_END (S3_STB + 4 * 2304)

__device__ __forceinline__ float rlane(float x, int l) { return __int_as_float(__builtin_amdgcn_readlane(__float_as_int(x), l)); }
__device__ __forceinline__ float wave_sum(float x) {
  x = red16(x);
  return (rlane(x, 0) + rlane(x, 16)) + (rlane(x, 32) + rlane(x, 48));
}
__device__ __forceinline__ float clampe(float x) { return fminf(fmaxf(x, -80.f), 80.f); }
__device__ __forceinline__ uint4 pack8(const float (&v)[8]) {
  return make_uint4(pack2(v[0], v[1]), pack2(v[2], v[3]), pack2(v[4], v[5]), pack2(v[6], v[7]));
}
__device__ __forceinline__ bf16x8 ld_frag(const void* p) { return *(const bf16x8*)p; }
__device__ __forceinline__ bf16x8 zfrag() { return bf16x8{0, 0, 0, 0, 0, 0, 0, 0}; }

__device__ __forceinline__ void chunk_geom(int c, int dir, int b, int& seg_row0, int& seg_len, int& t_lo) {
  if (c < 8) { seg_row0 = b * TPB; seg_len = LC; t_lo = dir == 0 ? c * 32 : (LC - 32 - c * 32); }
  else { seg_row0 = b * TPB + LC; seg_len = SEQ; t_lo = dir == 0 ? (c - 8) * 32 : (SEQ - 32 - (c - 8) * 32); }
}
template <int MIX>
__device__ __forceinline__ void fetch_raw(const u16* P, int c, int dir, int b, int h, int pw, int lane, const int (&colv)[4], unsigned (&rawq)[14][2]) {
  int seg_row0, seg_len, t_lo;
  chunk_geom(c, dir, b, seg_row0, seg_len, t_lo);
  const u16* Pseg = P + (size_t)seg_row0 * PST;
  const int t0 = t_lo + pw * 8;
  if (MIX == 0) {
#pragma unroll
    for (int rr = 0; rr < 10; rr++) {
      const int tc = min(max(t0 - 1 + rr, 0), seg_len - 1);
#pragma unroll
      for (int i = 0; i < 2; i++)
        rawq[rr][i] = (unsigned)Pseg[(size_t)tc * PST + PA + colv[2 * i]] | ((unsigned)Pseg[(size_t)tc * PST + PA + colv[2 * i + 1]] << 16);
    }
  } else if (MIX == 1) {
#pragma unroll
    for (int rr = 0; rr < 14; rr++) {
      const int tc = min(max(t0 - 3 + rr, 0), seg_len - 1);
      rawq[rr][0] = (unsigned)Pseg[(size_t)tc * PST + colv[0]] | ((unsigned)Pseg[(size_t)tc * PST + colv[1]] << 16);
      rawq[rr][1] = (rawq[rr][1] & 0xffff0000u) | (unsigned)Pseg[(size_t)tc * PST + colv[2]];
    }
    const u16* pp = Pseg + (size_t)(t0 + (lane & 7)) * PST + PB;
    rawq[0][1] = (rawq[0][1] & 0xffffu) | ((unsigned)pp[768 + dir * 4 + h] << 16);
    rawq[1][1] = (rawq[1][1] & 0xffffu) | ((unsigned)pp[776 + dir * 4 + h] << 16);
  } else {
#pragma unroll
    for (int j = 0; j < 8; j++) {
      const u16* pp = Pseg + (size_t)(t0 + j) * PST;
      rawq[j][0] = (unsigned)pp[colv[0]] | ((unsigned)pp[colv[1]] << 16);
      rawq[j][1] = (unsigned)pp[colv[2]];
    }
  }
}

template <int MIX>
__device__ __forceinline__ void scan3_item(const Params& p, int l, int b, int h, int dir, unsigned char* smb) {
  constexpr int VOFF = (MIX == 2) ? 64 : 128;
  constexpr bool DELTA = (MIX != 2);
  const int tid = TIDX, lane = tid & 63, w = tid >> 6, fr = lane & 15, fq = lane >> 4;
  const bool producer = true;
  const int pw = w & 3, half = w >> 2;
  const u16* P = (const u16*)(p.ws + OFF_BIG);
  u16* YS = (u16*)(p.ws + OFF_YS);
  float* BC = (float*)(p.ws + OFF_BC);
  float* ST = (float*)(smb + w * S3_SUB + S3_GM);
  unsigned char* STBY = smb + w * S3_SUB + S3_GM;
  const f32x4 z4 = f32x4{0.f, 0.f, 0.f, 0.f};
  f32x4 st[4];
#pragma unroll
  for (int i = 0; i < 4; i++) st[i] = z4;

  bf16x8 bw2[4], ba2[4];
  float cw[3][7];
  float muv[4];
  int colv[4];
  float c_w0 = 0.f, c_a0 = 0.f, c_ka = 0.f, c_kk = 0.f, c_rk = 0.f, c_gb = 0.f;
#pragma unroll
  for (int i = 0; i < 4; i++) { bw2[i] = zfrag(); ba2[i] = zfrag(); muv[i] = 0.f; colv[i] = 0; }
  if (producer) {
    if (MIX == 0) {
      {
        float tw[4][8], ta[4][8];
#pragma unroll
        for (int nt = 0; nt < 4; nt++)
#pragma unroll
          for (int jj = 0; jj < 8; jj++) {
            tw[nt][jj] = p.rwkv_w2[((size_t)(l * 2 + dir) * 32 + fq * 8 + jj) * 256 + h * 64 + nt * 16 + fr];
            ta[nt][jj] = p.rwkv_a2[((size_t)(l * 2 + dir) * 32 + fq * 8 + jj) * 256 + h * 64 + nt * 16 + fr];
          }
#pragma unroll
        for (int nt = 0; nt < 4; nt++)
#pragma unroll
          for (int jj = 0; jj < 8; jj++) { bw2[nt][jj] = (short)f2bf(tw[nt][jj]); ba2[nt][jj] = (short)f2bf(ta[nt][jj]); }
      }
      const int jl = h * 64 + lane;
      c_w0 = p.rwkv_w0[(l * 2 + dir) * 256 + jl];
      c_a0 = p.rwkv_a0[(l * 2 + dir) * 256 + jl];
      c_ka = p.rwkv_ka[l * 256 + jl];
      c_kk = p.rwkv_kk[l * 256 + jl];
      c_rk = p.rwkv_rk[l * 256 + jl];
#pragma unroll
      for (int i = 0; i < 4; i++) {
        colv[i] = i < 3 ? i * 256 + h * 64 + lane : (lane < 32 ? 768 + dir * 32 + lane : 832 + dir * 32 + (lane - 32));
        muv[i] = p.rwkv_mu[l * 960 + colv[i]];
      }
    } else if (MIX == 1) {
#pragma unroll
      for (int i = 0; i < 3; i++) {
        colv[i] = PB + i * 256 + h * 64 + lane;
#pragma unroll
        for (int tp = 0; tp < 7; tp++) cw[i][tp] = p.gdn_conv[((size_t)l * 7 + tp) * 768 + i * 256 + h * 64 + lane];
      }
    } else {
      {
        float tg[2][8];
#pragma unroll
        for (int nt = 0; nt < 2; nt++)
#pragma unroll
          for (int jj = 0; jj < 8; jj++) tg[nt][jj] = p.gla_gw2[((size_t)(l * 2 + dir) * 16 + (fq & 1) * 8 + jj) * 128 + h * 32 + nt * 16 + fr];
#pragma unroll
        for (int nt = 0; nt < 2; nt++)
#pragma unroll
          for (int jj = 0; jj < 8; jj++) bw2[nt][jj] = fq < 2 ? (short)f2bf(tg[nt][jj]) : (short)0;
      }
      c_gb = p.gla_gb[(l * 2 + dir) * 128 + h * 32 + (lane & 31)];
      colv[0] = PC + h * 32 + lane;
      if (lane >= 32) colv[0] = PC + 128 + h * 32 + (lane - 32);
      colv[1] = PC + 256 + h * 64 + lane;
      colv[2] = PC + 512 + dir * 16 + (lane & 15);
    }
  }
  __syncthreads();
  unsigned rawq[14][2];
#pragma unroll
  for (int i = 0; i < 14; i++) { rawq[i][0] = 0u; rawq[i][1] = 0u; }
  fetch_raw<MIX>(P, half, dir, b, h, pw, lane, colv, rawq);
#define RAWP(r_, i_) ((u16)((rawq[r_][(i_) >> 1] >> (((i_) & 1) * 16)) & 0xffffu))

  for (int it = 0; it < TPB / 64; it++) {
    {
      {
        const int c = it * 2 + half;
        int seg_row0, seg_len, t_lo;
        chunk_geom(c, dir, b, seg_row0, seg_len, t_lo);
        unsigned char* SB = smb + w * S3_SUB;
        const int t0 = t_lo + pw * 8;
        if (MIX == 0) {
          float raw[10][4];
#pragma unroll
          for (int rr = 0; rr < 10; rr++) {
            const int t = t0 - 1 + rr;
            const float okf = (t >= 0 && t < seg_len) ? 1.f : 0.f;
#pragma unroll
            for (int i = 0; i < 4; i++) raw[rr][i] = bf2f(RAWP(rr, i)) * okf;
          }
#pragma unroll
          for (int j = 0; j < 8; j++)
#pragma unroll
            for (int i = 0; i < 4; i++) {
              float xm = raw[j + 1][i] + (0.5f * (raw[j][i] + raw[j + 2][i]) - raw[j + 1][i]) * muv[i];
              if (i == 3 && lane < 32) xm = tanh_fast(xm);
              ST[j * 256 + lane + 64 * i] = xm;
            }
        } else if (MIX == 1) {
          float raw[14][3];
#pragma unroll
          for (int rr = 0; rr < 14; rr++) {
            const int t = t0 - 3 + rr;
            const float okf = (t >= 0 && t < seg_len) ? 1.f : 0.f;
#pragma unroll
            for (int i = 0; i < 3; i++) raw[rr][i] = bf2f(RAWP(rr, i)) * okf;
          }
#pragma unroll
          for (int j = 0; j < 8; j++)
#pragma unroll
            for (int i = 0; i < 3; i++) {
              float a = 0.f;
#pragma unroll
              for (int tp = 0; tp < 7; tp++) a += raw[j + tp][i] * cw[i][tp];
              ST[j * 256 + lane + 64 * i] = siluf(a);
            }
          if (lane < 8) {
            float bx = bf2f(RAWP(0, 3));
            float ax = bf2f(RAWP(1, 3));
            float ld = -__expf(p.gdn_a_log[(l * 2 + dir) * 4 + h]) * softplusf(ax + p.gdn_dt_bias[(l * 2 + dir) * 4 + h]);
            ST[lane * 256 + 192] = sigm(bx);
            ST[lane * 256 + 193] = ld;
          }
        } else {
          const float qs = lane < 32 ? 0.17677669529663687f : 1.f;
#pragma unroll
          for (int j = 0; j < 8; j++) {
            ST[j * 256 + lane] = bf2f(RAWP(j, 0)) * qs;
            ST[j * 256 + 64 + lane] = bf2f(RAWP(j, 1));
            if (lane < 16) ST[j * 256 + 128 + lane] = bf2f(RAWP(j, 2));
          }
        }
        wave_lds_sync();
        {
          float vv[8];
#pragma unroll
          for (int i = 0; i < 8; i++) vv[i] = ST[(dir ? 7 - i : i) * 256 + VOFF + lane];
          *(uint4*)(SB + S3_VT + lane * 16) = pack8(vv);
        }
        if (MIX == 0) {
          bf16x8 aw, aa;
#pragma unroll
          for (int jj = 0; jj < 8; jj++) {
            aw[jj] = fr < 8 ? (short)f2bf(ST[fr * 256 + 192 + fq * 8 + jj]) : (short)0;
            aa[jj] = fr < 8 ? (short)f2bf(ST[fr * 256 + 224 + fq * 8 + jj]) : (short)0;
          }
          f32x4 accw[4], acca[4];
#pragma unroll
          for (int nt = 0; nt < 4; nt++) {
            accw[nt] = __builtin_amdgcn_mfma_f32_16x16x32_bf16(aw, bw2[nt], z4, 0, 0, 0);
            acca[nt] = __builtin_amdgcn_mfma_f32_16x16x32_bf16(aa, ba2[nt], z4, 0, 0, 0);
          }
          wave_lds_sync();
          if (fq < 2) {
#pragma unroll
            for (int nt = 0; nt < 4; nt++)
#pragma unroll
              for (int r = 0; r < 4; r++) {
                ST[(fq * 4 + r) * 256 + 128 + nt * 16 + fr] = accw[nt][r];
                ST[(fq * 4 + r) * 256 + 192 + nt * 16 + fr] = acca[nt][r];
              }
          }
          wave_lds_sync();
        } else if (MIX == 2) {
          bf16x8 ag;
#pragma unroll
          for (int jj = 0; jj < 8; jj++) ag[jj] = (fr < 8 && fq < 2) ? (short)f2bf(ST[fr * 256 + 128 + fq * 8 + jj]) : (short)0;
          f32x4 accg[2];
#pragma unroll
          for (int nt = 0; nt < 2; nt++) accg[nt] = __builtin_amdgcn_mfma_f32_16x16x32_bf16(ag, bw2[nt], z4, 0, 0, 0);
          if (fq < 2) {
#pragma unroll
            for (int nt = 0; nt < 2; nt++)
#pragma unroll
              for (int r = 0; r < 4; r++) ST[(fq * 4 + r) * 256 + 192 + nt * 16 + fr] = accg[nt][r];
          }
          wave_lds_sync();
        }
        float logd[8], kap[8], bb[8], kp[8], qq[8];
        if (MIX == 0) {
          float a8[8], p1[8], p2[8];
#pragma unroll
          for (int i = 0; i < 8; i++) {
            const float* row = ST + (dir ? 7 - i : i) * 256;
            const float r_ = row[lane], k_ = row[64 + lane];
            const float sg = sigm(c_w0 + row[128 + lane]);
            a8[i] = sigm(c_a0 + row[192 + lane]);
            kp[i] = k_ * (1.f + (a8[i] - 1.f) * c_ka);
            kap[i] = k_ * c_kk;
            qq[i] = r_;
            logd[i] = -0.6065306597126334f * sg;
            p1[i] = kap[i] * kap[i];
            p2[i] = r_ * kp[i] * c_rk;
          }
#pragma unroll
          for (int i = 0; i < 8; i++) { p1[i] = red16(p1[i]); p2[i] = red16(p2[i]); }
#pragma unroll
          for (int i = 0; i < 8; i++) {
            const float ss = (rlane(p1[i], 0) + rlane(p1[i], 16)) + (rlane(p1[i], 32) + rlane(p1[i], 48));
            const float bc = (rlane(p2[i], 0) + rlane(p2[i], 16)) + (rlane(p2[i], 32) + rlane(p2[i], 48));
            kap[i] *= rsq(ss + 1e-6f);
            bb[i] = kap[i] * a8[i];
            if (lane == 0) BC[(size_t)(seg_row0 + t0 + (dir ? 7 - i : i)) * 8 + h * 2 + dir] = bc;
          }
        } else {
#pragma unroll
        for (int i = 0; i < 8; i++) {
          const int j = dir ? 7 - i : i;
          const float* row = ST + j * 256;
          if (MIX == 1) {
            const float q_ = row[lane], k_ = row[64 + lane];
            const float sq = wave_sum(q_ * q_), sk = wave_sum(k_ * k_);
            const float qn = q_ * rsq(sq + 1e-6f) * 0.125f, kn = k_ * rsq(sk + 1e-6f);
            const float beta = row[192], ld = row[193];
            const float alpha = __expf(ld);
            logd[i] = ld;
            kap[i] = kn; bb[i] = alpha * beta * kn; kp[i] = beta * kn; qq[i] = qn;
          } else {
            const int n = lane & 31;
            const float lg = c_gb + row[192 + n];
            const float ls = fminf(lg, 0.f) - __logf(1.f + __expf(-fabsf(lg)));
            logd[i] = ls * (1.f / 16.f);
            kap[i] = 0.f; bb[i] = 0.f;
            kp[i] = lane < 32 ? row[32 + n] : 0.f;
            qq[i] = lane < 32 ? row[n] : 0.f;
          }
        }
        }
        wave_lds_sync();
        float kt[8], qt[8], bck[8], kck[8];
        {
          float L[8];
          float run = 0.f;
#pragma unroll
          for (int i = 0; i < 8; i++) { run += logd[i]; L[i] = run; }
          const float Lr = L[3], L7 = L[7];
          float prevE = __expf(clampe(-Lr)), prevT = 1.f;
          u16* OPA = (u16*)STBY;
#pragma unroll
          for (int i = 0; i < 8; i++) {
            const float eI = __expf(clampe(L[i] - Lr)), eInv = __expf(clampe(Lr - L[i]));
            const float tI = __expf(L[i]), eEnd = __expf(L7 - L[i]);
            if (DELTA) {
              OPA[0 * 576 + i * 72 + lane] = f2bf(kap[i] * prevE);
              OPA[1 * 576 + i * 72 + lane] = f2bf(bb[i] * eInv);
            }
            OPA[2 * 576 + i * 72 + lane] = f2bf(kp[i] * eInv);
            OPA[3 * 576 + i * 72 + lane] = f2bf(qq[i] * eI);
            kt[i] = kap[i] * prevT; qt[i] = qq[i] * tI;
            bck[i] = bb[i] * eEnd; kck[i] = kp[i] * eEnd;
            prevE = eI; prevT = tI;
          }
          *(float*)(SB + S3_WC + lane * 4) = __expf(L7);
        }
        wave_lds_sync();
        f32x4 accA = z4, accBm = z4, accQb = z4, accQk = z4;
        {
          const u16* OPA = (const u16*)STBY;
          const int ro = (fr & 7) * 72 + fq * 8;
#pragma unroll
          for (int ks = 0; ks < 2; ks++) {
            const bf16x8 fk = ld_frag(OPA + 2 * 576 + ro + ks * 32), fqh = ld_frag(OPA + 3 * 576 + ro + ks * 32);
            accQk = __builtin_amdgcn_mfma_f32_16x16x32_bf16(fqh, fk, accQk, 0, 0, 0);
            if (DELTA) {
              const bf16x8 fka = ld_frag(OPA + 0 * 576 + ro + ks * 32), fb = ld_frag(OPA + 1 * 576 + ro + ks * 32);
              accA = __builtin_amdgcn_mfma_f32_16x16x32_bf16(fka, fb, accA, 0, 0, 0);
              accBm = __builtin_amdgcn_mfma_f32_16x16x32_bf16(fka, fk, accBm, 0, 0, 0);
              accQb = __builtin_amdgcn_mfma_f32_16x16x32_bf16(fqh, fb, accQb, 0, 0, 0);
            }
          }
#pragma unroll
          for (int r = 0; r < 4; r++) {
            const int i = fq * 4 + r;
            const bool ok = fq < 2 && fr < 8;
            if (!(ok && fr < i)) { accA[r] = 0.f; accBm[r] = 0.f; }
            if (!(ok && fr <= i)) { accQb[r] = 0.f; accQk[r] = 0.f; }
          }
        }
        float bmc[8], qkc[8];
#pragma unroll
        for (int m = 0; m < 4; m++) {
          bmc[m] = accBm[m]; qkc[m] = accQk[m];
          bmc[m + 4] = __shfl(accBm[m], (lane & 15) + 16);
          qkc[m + 4] = __shfl(accQk[m], (lane & 15) + 16);
        }
        float kbar[8], qbar[8], Kv[8], TB[8], Qv[8];
        if (DELTA) {
          float t[8];
#pragma unroll
          for (int i = 0; i < 8; i++) {
            float ti = (lane == i) ? 1.f : 0.f;
#pragma unroll
            for (int m = 0; m < i; m++) ti -= rlane(accA[i & 3], (i >> 2) * 16 + m) * t[m];
            t[i] = ti;
          }
#pragma unroll
          for (int i = 0; i < 8; i++) {
            float tb = 0.f, kb = 0.f;
#pragma unroll
            for (int m = 0; m <= i; m++) {
              const float tim = rlane(t[i], m);
              tb += tim * bmc[m];
              kb += tim * kt[m];
            }
            TB[i] = tb; kbar[i] = kb;
            float qv = qkc[i], qb = qt[i];
#pragma unroll
            for (int m = 0; m <= i; m++) {
              const float qbim = rlane(accQb[i & 3], (i >> 2) * 16 + m);
              qv -= qbim * TB[m];
              qb -= qbim * kbar[m];
            }
            Qv[i] = qv; qbar[i] = qb;
          }
#pragma unroll
          for (int j = 0; j < 8; j++) Kv[j] = kck[j];
#pragma unroll
          for (int i = 1; i < 8; i++)
#pragma unroll
            for (int j = 0; j < i; j++) Kv[j] -= rlane(TB[i], j) * bck[i];
        } else {
#pragma unroll
          for (int i = 0; i < 8; i++) { Qv[i] = qkc[i]; qbar[i] = qt[i]; Kv[i] = kck[i]; kbar[i] = 0.f; TB[i] = 0.f; }
        }
        *(uint4*)(SB + S3_KVT + lane * 16) = pack8(Kv);
#pragma unroll
        for (int i = 0; i < 8; i++) ((u16*)(SB + S3_QB))[i * 72 + lane] = f2bf(qbar[i]);
        if (lane < 8) {
#pragma unroll
          for (int i = 0; i < 8; i++) ((u16*)(SB + S3_QV))[i * 8 + lane] = f2bf(Qv[i]);
        }
        if (DELTA) {
#pragma unroll
          for (int i = 0; i < 8; i++) ((u16*)(SB + S3_KB))[i * 72 + lane] = f2bf(-kbar[i]);
          *(uint4*)(SB + S3_BT + lane * 16) = pack8(bck);
        }
      }
    }
    fetch_raw<MIX>(P, min(it + 1, TPB / 64 - 1) * 2 + half, dir, b, h, pw, lane, colv, rawq);
    __syncthreads();
    if (w < 4) {
      unsigned char* STB = smb + S3_STB + w * 2304;
#pragma unroll 2
      for (int kk = 0; kk < 8; kk++) {
        const int cc = it * 2 + (kk >> 2), k = kk & 3;
        int seg_row0, t_lo;
        if (cc < 8) { seg_row0 = b * TPB; t_lo = dir == 0 ? cc * 32 : (LC - 32 - cc * 32); }
        else { seg_row0 = b * TPB + LC; t_lo = dir == 0 ? (cc - 8) * 32 : (SEQ - 32 - (cc - 8) * 32); }
        const int sc = dir ? 3 - k : k;
        const unsigned char* SB = smb + ((kk >> 2) * 4 + sc) * S3_SUB;
        const bf16x8 bs0 = __builtin_bit_cast(bf16x8, u32x4v{pack2(st[0][0], st[0][1]), pack2(st[0][2], st[0][3]), pack2(st[1][0], st[1][1]), pack2(st[1][2], st[1][3])});
        const bf16x8 bs1 = __builtin_bit_cast(bf16x8, u32x4v{pack2(st[2][0], st[2][1]), pack2(st[2][2], st[2][3]), pack2(st[3][0], st[3][1]), pack2(st[3][2], st[3][3])});
#define LDP(BASE_, ROW_, KS_) ([&]() -> bf16x8 {                                                                   \
          const uint2 lo_ = *(const uint2*)((BASE_) + ((ROW_) * 72 + (KS_) * 32 + fq * 4) * 2);                      \
          const uint2 hi_ = *(const uint2*)((BASE_) + ((ROW_) * 72 + (KS_) * 32 + 16 + fq * 4) * 2);                 \
          return __builtin_bit_cast(bf16x8, u32x4v{lo_.x, lo_.y, hi_.x, hi_.y}); }())
        const bf16x8 bv = fq == 0 ? ld_frag(SB + S3_VT + (w * 16 + fr) * 16) : zfrag();
        const bf16x8 aq0 = LDP(SB + S3_QB, (fr & 7), 0), aq1 = LDP(SB + S3_QB, (fr & 7), 1);
        const bf16x8 aqv = fq == 0 ? ld_frag(SB + S3_QV + (fr & 7) * 16) : zfrag();
        bf16x8 brv = zfrag();
        if (DELTA) {
          const bf16x8 ak0 = LDP(SB + S3_KB, (fr & 7), 0), ak1 = LDP(SB + S3_KB, (fr & 7), 1);
          f32x4 accR = __builtin_amdgcn_mfma_f32_16x16x32_bf16(ak0, bs0, z4, 0, 0, 0);
          accR = __builtin_amdgcn_mfma_f32_16x16x32_bf16(ak1, bs1, accR, 0, 0, 0);
          const uint2 vv2 = *(const uint2*)(SB + S3_VT + (w * 16 + fr) * 16 + (fq & 1) * 8);
          const u32x4v t4 = {pack2(accR[0], accR[1]), pack2(accR[2], accR[3]), vv2.x, vv2.y};
          brv = fq < 2 ? __builtin_bit_cast(bf16x8, t4) : zfrag();
        }
        f32x4 accY = __builtin_amdgcn_mfma_f32_16x16x32_bf16(aq0, bs0, z4, 0, 0, 0);
        accY = __builtin_amdgcn_mfma_f32_16x16x32_bf16(aq1, bs1, accY, 0, 0, 0);
        accY = __builtin_amdgcn_mfma_f32_16x16x32_bf16(aqv, bv, accY, 0, 0, 0);
        if (fq < 2) {
#pragma unroll
          for (int r = 0; r < 4; r++) {
            const int i = fq * 4 + r, j = dir ? 7 - i : i;
            YS[(size_t)(seg_row0 + t_lo + sc * 8 + j) * YST + dir * 768 + MIX * 256 + h * 64 + w * 16 + fr] = f2bf(accY[r]);
          }
        }
#pragma unroll
        for (int nt = 0; nt < 4; nt++) {
          f32x4 an;
          if (DELTA) {
            const uint2 b2 = *(const uint2*)(SB + S3_BT + (nt * 16 + fr) * 16 + (fq & 1) * 8);
            const uint2 k2 = *(const uint2*)(SB + S3_KVT + (nt * 16 + fr) * 16 + (fq & 1) * 8);
            const u32x4v a4 = {b2.x, b2.y, k2.x, k2.y};
            const bf16x8 am = fq < 2 ? __builtin_bit_cast(bf16x8, a4) : zfrag();
            an = __builtin_amdgcn_mfma_f32_16x16x32_bf16(am, brv, z4, 0, 0, 0);
          } else {
            const bf16x8 akv = fq == 0 ? ld_frag(SB + S3_KVT + (nt * 16 + fr) * 16) : zfrag();
            an = __builtin_amdgcn_mfma_f32_16x16x32_bf16(akv, bv, z4, 0, 0, 0);
          }
          const float4 wc = *(const float4*)(SB + S3_WC + (nt * 16 + fq * 4) * 4);
          st[nt][0] = st[nt][0] * wc.x + an[0];
          st[nt][1] = st[nt][1] * wc.y + an[1];
          st[nt][2] = st[nt][2] * wc.z + an[2];
          st[nt][3] = st[nt][3] * wc.w + an[3];
        }
#undef LDP
      }
    }
    __syncthreads();
  }
}

__device__ __forceinline__ void attn_item(const Params& p, int l, int b, int qb, int hk, bool isctx, unsigned char* smem) {
  u16* KS = (u16*)smem;
  u16* VT = KS + 64 * LDT;
  u16* PL = VT + 64 * LDT;
  float2* ROPE = (float2*)(PL + 8 * 32 * LDT);
  const int tid = TIDX, lane = tid & 63, w = tid >> 6, fr = lane & 15, fq = lane >> 4;
  const u16* P = (const u16*)(p.ws + OFF_BIG);
  u16* Y = (u16*)(p.ws + OFF_YS);
  const int qh = hk * 2 + (w >> 2);
  const int tb = qb * 128 + (w & 3) * 32;
  const int qrow0 = b * TPB + (isctx ? 0 : LC);
  __syncthreads();
  for (int i = tid; i < 1024; i += NTHR) {
    int pos = i >> 4, fi = i & 15;
    float inv = powf(10000.f, -(float)fi / 16.f);
    float sn, cs;
    sincosf((float)pos * inv, &sn, &cs);
    ROPE[i] = make_float2(cs, sn);
  }
  __syncthreads();
  bf16x8 qf[2][2];
#pragma unroll
  for (int mi = 0; mi < 2; mi++)
#pragma unroll
    for (int ks = 0; ks < 2; ks++) {
      const int tq = tb + mi * 16 + fr;
      const u16* qp = P + (size_t)(qrow0 + tq) * PST + PD + qh * 64 + ks * 32;
      uint4 own = *(const uint4*)(qp + fq * 8);
      uint4 par = *(const uint4*)(qp + (fq ^ 2) * 8);
      const unsigned ow[4] = {own.x, own.y, own.z, own.w};
      const unsigned pw[4] = {par.x, par.y, par.z, par.w};
      const int pos = ks == 0 ? (tq >> 6) : (tq & 63);
      bf16x8 f;
#pragma unroll
      for (int jj = 0; jj < 8; jj++) {
        float xo = bf2f((u16)((ow[jj >> 1] >> ((jj & 1) * 16)) & 0xffff));
        float xp = bf2f((u16)((pw[jj >> 1] >> ((jj & 1) * 16)) & 0xffff));
        float v = xo;
        if (!isctx) {
          float2 cs = ROPE[pos * 16 + (fq & 1) * 8 + jj];
          v = fq < 2 ? xo * cs.x - xp * cs.y : xp * cs.y + xo * cs.x;
        }
        f[jj] = (short)f2bf(v * 0.125f);
      }
      qf[mi][ks] = f;
    }
  f32x4 oacc[2][4];
#pragma unroll
  for (int mi = 0; mi < 2; mi++)
#pragma unroll
    for (int nd = 0; nd < 4; nd++) oacc[mi][nd] = f32x4{0.f, 0.f, 0.f, 0.f};
  float mrow[2][4], lrow[2][4];
#pragma unroll
  for (int mi = 0; mi < 2; mi++)
#pragma unroll
    for (int r = 0; r < 4; r++) { mrow[mi][r] = -1e30f; lrow[mi][r] = 0.f; }

  const int q0 = qb * 128;
  const int band_lo = isctx ? 0 : max(0, q0 - 128), band_hi = isctx ? 0 : min(SEQ, q0 + 256);
  const int ntile = 4 + (band_hi - band_lo) / 64;
  u16* pl = PL + w * 32 * LDT;
  for (int tl = 0; tl < ntile; tl++) {
    const bool band = tl >= 4;
    const int k0 = band ? band_lo + (tl - 4) * 64 : tl * 64;
    __syncthreads();
    {
      const int key = tid >> 3, kc = tid & 7;
      const int kpos = k0 + key;
      const u16* kp = P + (size_t)(b * TPB + (band ? LC : 0) + kpos) * PST + PD + 256 + hk * 64;
      uint4 own = *(const uint4*)(kp + kc * 8);
      uint4 vv = *(const uint4*)(kp + 128 + kc * 8);
      uint4 par = *(const uint4*)(kp + (kc ^ 2) * 8);
      if (band) {
        const unsigned ow[4] = {own.x, own.y, own.z, own.w};
        const unsigned pw[4] = {par.x, par.y, par.z, par.w};
        const int pos = kc < 4 ? (kpos >> 6) : (kpos & 63);
        unsigned res[4];
#pragma unroll
        for (int jj = 0; jj < 8; jj += 2) {
          float v2[2];
#pragma unroll
          for (int e = 0; e < 2; e++) {
            float xo = bf2f((u16)((ow[jj >> 1] >> (e * 16)) & 0xffff));
            float xp = bf2f((u16)((pw[jj >> 1] >> (e * 16)) & 0xffff));
            float2 cs = ROPE[pos * 16 + (kc & 1) * 8 + jj + e];
            v2[e] = (kc & 2) == 0 ? xo * cs.x - xp * cs.y : xp * cs.y + xo * cs.x;
          }
          res[jj >> 1] = pack2(v2[0], v2[1]);
        }
        own = make_uint4(res[0], res[1], res[2], res[3]);
      }
      *(uint4*)(KS + key * LDT + kc * 8) = own;
      const unsigned vw[4] = {vv.x, vv.y, vv.z, vv.w};
#pragma unroll
      for (int jj = 0; jj < 8; jj++) VT[(kc * 8 + jj) * LDT + key] = (u16)((vw[jj >> 1] >> ((jj & 1) * 16)) & 0xffff);
    }
    __syncthreads();
    f32x4 sc[2][4];
#pragma unroll
    for (int mi = 0; mi < 2; mi++)
#pragma unroll
      for (int nj = 0; nj < 4; nj++) sc[mi][nj] = f32x4{0.f, 0.f, 0.f, 0.f};
#pragma unroll
    for (int ks = 0; ks < 2; ks++) {
      bf16x8 kf[4];
#pragma unroll
      for (int nj = 0; nj < 4; nj++) kf[nj] = *(const bf16x8*)(KS + (nj * 16 + fr) * LDT + ks * 32 + fq * 8);
#pragma unroll
      for (int mi = 0; mi < 2; mi++)
#pragma unroll
        for (int nj = 0; nj < 4; nj++) sc[mi][nj] = __builtin_amdgcn_mfma_f32_16x16x32_bf16(qf[mi][ks], kf[nj], sc[mi][nj], 0, 0, 0);
    }
#pragma unroll
    for (int mi = 0; mi < 2; mi++)
#pragma unroll
      for (int r = 0; r < 4; r++) {
        const int qpos = tb + mi * 16 + fq * 4 + r;
        float mx = -1e30f;
#pragma unroll
        for (int nj = 0; nj < 4; nj++) {
          float v = sc[mi][nj][r];
          if (band) {
            int d = qpos - (k0 + nj * 16 + fr);
            if (d > 128 || d < -128) v = -1e30f;
          }
          sc[mi][nj][r] = v;
          mx = fmaxf(mx, v);
        }
        mx = fmaxf(mx, __shfl_xor(mx, 1));
        mx = fmaxf(mx, __shfl_xor(mx, 2));
        mx = fmaxf(mx, __shfl_xor(mx, 4));
        mx = fmaxf(mx, __shfl_xor(mx, 8));
        const float mnew = fmaxf(mrow[mi][r], mx);
        const float alpha = __expf(mrow[mi][r] - mnew);
        mrow[mi][r] = mnew;
        float ls = 0.f;
#pragma unroll
        for (int nj = 0; nj < 4; nj++) {
          float pe = __expf(sc[mi][nj][r] - mnew);
          ls += pe;
          pl[(mi * 16 + fq * 4 + r) * LDT + nj * 16 + fr] = f2bf(pe);
        }
        lrow[mi][r] = lrow[mi][r] * alpha + ls;
#pragma unroll
        for (int nd = 0; nd < 4; nd++) oacc[mi][nd][r] *= alpha;
      }
    asm volatile("s_waitcnt lgkmcnt(0)" ::: "memory");
    __builtin_amdgcn_wave_barrier();
#pragma unroll
    for (int ks = 0; ks < 2; ks++) {
      bf16x8 pf[2], vf[4];
#pragma unroll
      for (int mi = 0; mi < 2; mi++) pf[mi] = *(const bf16x8*)(pl + (mi * 16 + fr) * LDT + ks * 32 + fq * 8);
#pragma unroll
      for (int nd = 0; nd < 4; nd++) vf[nd] = *(const bf16x8*)(VT + (nd * 16 + fr) * LDT + ks * 32 + fq * 8);
#pragma unroll
      for (int mi = 0; mi < 2; mi++)
#pragma unroll
        for (int nd = 0; nd < 4; nd++) oacc[mi][nd] = __builtin_amdgcn_mfma_f32_16x16x32_bf16(pf[mi], vf[nd], oacc[mi][nd], 0, 0, 0);
    }
    asm volatile("s_waitcnt lgkmcnt(0)" ::: "memory");
    __builtin_amdgcn_wave_barrier();
  }
  const float sink = p.attn_sink[l * 4 + qh];
#pragma unroll
  for (int mi = 0; mi < 2; mi++)
#pragma unroll
    for (int r = 0; r < 4; r++) {
      float ls = lrow[mi][r];
      ls += __shfl_xor(ls, 1);
      ls += __shfl_xor(ls, 2);
      ls += __shfl_xor(ls, 4);
      ls += __shfl_xor(ls, 8);
      ls += __expf(sink - mrow[mi][r]);
      const float inv = 1.f / ls;
      const int tq = tb + mi * 16 + fq * 4 + r;
#pragma unroll
      for (int nd = 0; nd < 4; nd++) Y[(size_t)(qrow0 + tq) * YST + 1536 + qh * 64 + nd * 16 + fr] = f2bf(oacc[mi][nd][r] * inv);
    }
}

#ifndef SCAN3_MASK
#define SCAN3_MASK 7
#endif
__device__ __forceinline__ void phase_mix(const Params& p, int l, unsigned char* smem) {
  float* sm = (float*)smem;
  const int G = gridDim.x;
  for (int it = blockIdx.x; it < 192; it += G) {
    const int mix = it >> 6, rem = it & 63, b = rem >> 3, h = (rem >> 1) & 3, dir = rem & 1;
    if (mix == 0 && (SCAN3_MASK & 1)) scan3_item<0>(p, l, b, h, dir, smem);
    else if (mix == 1 && (SCAN3_MASK & 2)) scan3_item<1>(p, l, b, h, dir, smem);
    else if (mix == 2 && (SCAN3_MASK & 4)) scan3_item<2>(p, l, b, h, dir, smem);
  }
  if (SCAN3_MASK != 7) {
    for (int it = blockIdx.x; it < 768; it += G) {
      const int mix = it >> 8, rem = it & 255, b = rem >> 5, h = (rem >> 3) & 3, dir = (rem >> 2) & 1, rq = rem & 3;
      if (mix == 0 && !(SCAN3_MASK & 1)) scan2_item<0>(p, l, b, h, dir, rq, sm);
      else if (mix == 1 && !(SCAN3_MASK & 2)) scan2_item<1>(p, l, b, h, dir, rq, sm);
      else if (mix == 2 && !(SCAN3_MASK & 4)) scan2_item<2>(p, l, b, h, dir, rq, sm);
    }
  }
  __syncthreads();
  {
    const bool spread = G >= 192;
    const int nconv = spread ? 64 : G, fidx = spread ? (int)blockIdx.x - 128 : (int)blockIdx.x;
    if (fidx >= 0 && fidx < nconv)
      for (int it = 832 + fidx; it < 4480; it += nconv) conv_item(p, l, it, (float*)smem);
    __syncthreads();
  }
  unsigned* ctr = (unsigned*)(p.ws + OFF_CTR) + l * 16;
  volatile int* slot = (volatile int*)(smem + 131072 - 16);
  for (;;) {
    if (TIDX == 0) *slot = (int)atomicAdd(ctr, 1u);
    __syncthreads();
    const int it = *slot;
    __syncthreads();
    if (it >= (l == 0 ? 544 : 512)) break;
    if (it < 512) {
      int b = it >> 6, qb = (it >> 1) & 31, hk = it & 1;
      attn_item(p, l, b, qb, hk, false, smem);
    } else {
      int r = it - 512, b = r >> 2, qb = (r >> 1) & 1, hk = r & 1;
      attn_item(p, l, b, qb, hk, true, smem);
    }
  }
}

#define POST_DECL(PFX) uint2 PFX##ya0, PFX##ya1, PFX##ya2, PFX##yc0, PFX##yc1, PFX##yc2, PFX##vp, PFX##vc, PFX##vn, PFX##gb, PFX##gc; \
  u16 PFX##xp, PFX##xc, PFX##xn; float2 PFX##bc
#define POST_LOAD(PFX, R_)                                                                         \
  do {                                                                                             \
    const int r_ = (R_);                                                                           \
    const int b_ = r_ / TPB, t_ = r_ - b_ * TPB;                                                   \
    const bool hp_ = (t_ != 0) && (t_ != LC), hn_ = (t_ != LC - 1) && (t_ != TPB - 1);            \
    const u16* ys_ = YSc + (size_t)r_ * YST;                                                       \
    const u16* pr_ = Pc + (size_t)r_ * PST;                                                        \
    const u16* pp_ = pr_ - (hp_ ? PST : 0);                                                        \
    const u16* pn_ = pr_ + (hn_ ? PST : 0);                                                        \
    PFX##ya0 = *(const uint2*)(ys_ + j0); PFX##ya1 = *(const uint2*)(ys_ + 256 + j0); PFX##ya2 = *(const uint2*)(ys_ + 512 + j0); \
    PFX##yc0 = *(const uint2*)(ys_ + 768 + j0); PFX##yc1 = *(const uint2*)(ys_ + 1024 + j0); PFX##yc2 = *(const uint2*)(ys_ + 1280 + j0); \
    PFX##vp = *(const uint2*)(pp_ + PA + 512 + j0);                                                \
    PFX##vc = *(const uint2*)(pr_ + PA + 512 + j0);                                                \
    PFX##vn = *(const uint2*)(pn_ + PA + 512 + j0);                                                \
    PFX##gb = *(const uint2*)(pr_ + PB + 784 + j0);                                                \
    PFX##gc = *(const uint2*)(pr_ + PC + 544 + j0);                                                \
    PFX##xp = pp_[PA + 896 + lane]; PFX##xc = pr_[PA + 896 + lane]; PFX##xn = pn_[PA + 896 + lane]; \
    PFX##bc = *(const float2*)(BCc + (size_t)r_ * 8 + (lane >> 4) * 2);                            \
  } while (0)
__device__ __forceinline__ void unpack4(uint2 v, float (&o)[4]) {
  o[0] = __uint_as_float(v.x << 16); o[1] = __uint_as_float(v.x & 0xffff0000u);
  o[2] = __uint_as_float(v.y << 16); o[3] = __uint_as_float(v.y & 0xffff0000u);
}

__device__ __forceinline__ void phase_post(const Params& p, int l, float* g2s) {
  const int lane = TIDX & 63, wv = TIDX >> 6;
  u16* YS = (u16*)(p.ws + OFF_YS);
  const int j0 = lane * 4;
  {
    const float4* src = (const float4*)(p.rwkv_g2 + (size_t)l * 64 * 256);
    for (int i = TIDX; i < 64 * 256 / 4; i += NTHR) ((float4*)g2s)[i] = src[i];
  }
  float mu_v[4], lng[4], lnb[4], ngb[4], ngc[4];
#pragma unroll
  for (int i = 0; i < 4; i++) {
    mu_v[i] = p.rwkv_mu[l * 960 + 512 + j0 + i];
    lng[i] = p.rwkv_ln_g[l * 256 + j0 + i];
    lnb[i] = p.rwkv_ln_b[l * 256 + j0 + i];
    ngb[i] = p.gdn_norm_g[l * 64 + (lane & 15) * 4 + i];
    ngc[i] = p.gla_norm_g[l * 64 + (lane & 15) * 4 + i];
  }
  const float mu_x = p.rwkv_mu[l * 960 + 896 + lane];
  __syncthreads();
  const int stride = gridDim.x * 8;
  int r = blockIdx.x * 8 + wv;
  const u16* Pc = (const u16*)(p.ws + OFF_BIG);
  const u16* YSc = (const u16*)(p.ws + OFF_YS);
  const float* BCc = (const float*)(p.ws + OFF_BC);
  POST_DECL(cur_);
  POST_DECL(nxt_);
  POST_LOAD(cur_, r);
  for (; r < NROWS; r += stride) {
    const int rn = r + stride < NROWS ? r + stride : r;
    POST_LOAD(nxt_, rn);
    const int b = r / TPB, t = r - b * TPB;
    const float pmul = ((t != 0) && (t != LC)) ? 1.f : 0.f, nmul = ((t != LC - 1) && (t != TPB - 1)) ? 1.f : 0.f;
    if (!(l == 1 && t < LC)) {
    float y[3][4];
    {
      float a4[4], c4[4];
      unpack4(cur_ya0, a4); unpack4(cur_yc0, c4);
#pragma unroll
      for (int i = 0; i < 4; i++) y[0][i] = a4[i] + c4[i];
      unpack4(cur_ya1, a4); unpack4(cur_yc1, c4);
#pragma unroll
      for (int i = 0; i < 4; i++) y[1][i] = a4[i] + c4[i];
      unpack4(cur_ya2, a4); unpack4(cur_yc2, c4);
#pragma unroll
      for (int i = 0; i < 4; i++) y[2][i] = a4[i] + c4[i];
    }
    float o[3][4];
    {
      float sum = y[0][0] + y[0][1] + y[0][2] + y[0][3];
      sum = red16(sum);
      const float mean = sum * (1.f / 64.f);
      float vs = 0.f;
#pragma unroll
      for (int i = 0; i < 4; i++) { float d = y[0][i] - mean; vs += d * d; }
      vs = red16(vs);
      const float rstd = rsq(vs * (1.f / 64.f) + 64e-5f);
      const float pv = bf2f(cur_xc), ppv = bf2f(cur_xp) * pmul, pnv = bf2f(cur_xn) * nmul;
      const float sg = sigm(pv + (0.5f * (ppv + pnv) - pv) * mu_x);
      float gate[4] = {0.f, 0.f, 0.f, 0.f};
      const float* g2 = g2s + j0;
#pragma unroll 8
      for (int i = 0; i < 64; i++) {
        const float si = __int_as_float(__builtin_amdgcn_readlane(__float_as_int(sg), i));
        const float4 gw = *(const float4*)(g2 + i * 256);
        gate[0] += si * gw.x; gate[1] += si * gw.y; gate[2] += si * gw.z; gate[3] += si * gw.w;
      }
      const float bcs = cur_bc.x + cur_bc.y;
      float vc4[4], vp4[4], vn4[4];
      unpack4(cur_vc, vc4); unpack4(cur_vp, vp4); unpack4(cur_vn, vn4);
#pragma unroll
      for (int i = 0; i < 4; i++) {
        const float v = vc4[i] + (0.5f * (vp4[i] * pmul + vn4[i] * nmul) - vc4[i]) * mu_v[i];
        const float yn = (y[0][i] - mean) * rstd * lng[i] + lnb[i];
        o[0][i] = (yn + bcs * v) * gate[i];
      }
    }
#pragma unroll
    for (int m = 1; m < 3; m++) {
      float ss = y[m][0] * y[m][0] + y[m][1] * y[m][1] + y[m][2] * y[m][2] + y[m][3] * y[m][3];
      ss = red16(ss);
      const float inv = rsq(ss * (1.f / 64.f) + 1e-6f);
      float g4[4];
      unpack4(m == 1 ? cur_gb : cur_gc, g4);
#pragma unroll
      for (int i = 0; i < 4; i++) o[m][i] = y[m][i] * inv * (m == 1 ? ngb[i] : ngc[i]) * siluf(g4[i]);
    }
    u16* ys = YS + (size_t)r * YST;
#pragma unroll
    for (int m = 0; m < 3; m++) {
      uint2 ov;
      ov.x = pack2(o[m][0], o[m][1]);
      ov.y = pack2(o[m][2], o[m][3]);
      *(uint2*)(ys + m * 256 + j0) = ov;
    }
    }
    cur_ya0 = nxt_ya0; cur_ya1 = nxt_ya1; cur_ya2 = nxt_ya2; cur_yc0 = nxt_yc0; cur_yc1 = nxt_yc1; cur_yc2 = nxt_yc2;
    cur_vp = nxt_vp; cur_vc = nxt_vc; cur_vn = nxt_vn; cur_gb = nxt_gb; cur_gc = nxt_gc;
    cur_xp = nxt_xp; cur_xc = nxt_xc; cur_xn = nxt_xn; cur_bc = nxt_bc;
  }
}

#define XB_TMO      128
#define XB_XCNT(j)  (256  + 64 * (j))
#define XB_XSUB(j)  (1280 + 64 * (j))
#define XB_XGEN(j)  (2304 + 64 * (j))
#define XB_TOP      3328
#define XB_TOPGEN   3392
#define XCD_BAR_WORDS 3456
#define XB_SPIN_CAP (1u << 18)
#define LAS __attribute__((address_space(3)))

__device__ __forceinline__ unsigned xb_ld(unsigned* p)              { return __hip_atomic_load(p, __ATOMIC_RELAXED, __HIP_MEMORY_SCOPE_AGENT); }
__device__ __forceinline__ unsigned xb_add(unsigned* p, unsigned v) { return __hip_atomic_fetch_add(p, v, __ATOMIC_RELAXED, __HIP_MEMORY_SCOPE_AGENT); }
__device__ __forceinline__ unsigned xb_xcc_id() { return (unsigned)__builtin_amdgcn_s_getreg((3 << 11) | 20) & 0xFu; }
#define XB_SPIN(cond, bar) do { unsigned _sp = 0; while (cond) { __builtin_amdgcn_s_sleep(1); \
    if ((++_sp & 255u) == 0u) { if (xb_ld(&(bar)[XB_TMO])) break; if (_sp > XB_SPIN_CAP) { atomicAdd(&(bar)[XB_TMO], 1u); break; } } } } while (0)

struct XcdBarrier {
    unsigned* bar; unsigned x;
    volatile LAS unsigned* st;
};

__device__ __forceinline__ XcdBarrier xcd_barrier_post(unsigned* bar, volatile LAS unsigned* st) {
    XcdBarrier b; b.bar = bar; b.x = xb_xcc_id(); b.st = st;
    if (threadIdx.x == 0) (void)xb_add(&bar[XB_XCNT(b.x)], 1u);
    return b;
}
__device__ __forceinline__ void xcd_barrier_complete(unsigned* bar, unsigned x, unsigned& nloc, unsigned& nx) {
    const unsigned G = gridDim.x * gridDim.y * gridDim.z;
    unsigned sum, cnt, mine, sp = 0u;
    for (;;) {
        sum = 0u; cnt = 0u; mine = 0u;
#pragma unroll
        for (unsigned j = 0; j < 16; ++j) { const unsigned c = xb_ld(&bar[XB_XCNT(j)]); sum += c; cnt += (c > 0u) ? 1u : 0u; mine = (j == x) ? c : mine; }
        if (sum == G) break;
        __builtin_amdgcn_s_sleep(1);
        if ((++sp & 255u) == 0u) { if (xb_ld(&bar[XB_TMO])) break; if (sp > XB_SPIN_CAP) { atomicAdd(&bar[XB_TMO], 1u); break; } }
    }
    nloc = mine > 0u ? mine : 1u; nx = cnt > 0u ? cnt : 1u;
}

__device__ __forceinline__ void xcd_barrier(const XcdBarrier& b) {
    asm volatile("s_waitcnt vmcnt(0)" ::: "memory");
    __syncthreads();
    if (threadIdx.x == 0) {
        unsigned* bar = b.bar;
        __builtin_amdgcn_s_waitcnt(0);
        unsigned nloc = b.st[0], nx = b.st[1];
        if (nloc == 0u) { xcd_barrier_complete(bar, b.x, nloc, nx); b.st[0] = nloc; b.st[1] = nx; }
        const unsigned old = xb_add(&bar[XB_XSUB(b.x)], 1u);
        const unsigned gen = old / nloc;
        if (old + 1u == (gen + 1u) * nloc) {
            __builtin_amdgcn_fence(__ATOMIC_RELEASE, "agent");
            asm volatile("s_waitcnt vmcnt(0)" ::: "memory");
            const unsigned og = xb_add(&bar[XB_TOP], 1u);
            const unsigned tg = og / nx;
            if (og + 1u == (tg + 1u) * nx) xb_add(&bar[XB_TOPGEN], 1u);
            else XB_SPIN(xb_ld(&bar[XB_TOPGEN]) == tg, bar);
            __builtin_amdgcn_fence(__ATOMIC_ACQUIRE, "agent");
            xb_add(&bar[XB_XGEN(b.x)], 1u);
            asm volatile("s_waitcnt vmcnt(0)" ::: "memory");
        } else {
            XB_SPIN(xb_ld(&bar[XB_XGEN(b.x)]) == gen, bar);
            __builtin_amdgcn_fence(__ATOMIC_ACQUIRE, "agent");
            asm volatile("s_waitcnt vmcnt(0)" ::: "memory");
        }
    }
    __syncthreads();
}

#if defined(SKIPS)
#define EN(k) (SKIPS != (k))
#elif !defined(ONLYS)
#define EN(k) 1
#else
#define EN(k) (ONLYS == (k))
#endif
__device__ __forceinline__ void run_phase(const Params& p, int ph, unsigned char* smem) {
  if (ph == 0) { if (EN(10)) phase_init0(p, (float*)smem); return; }
  if (ph == 1) { if (EN(11)) phase_init1(p); return; }
  int l = 0, s = 10;
  if (ph >= 3) { l = (ph - 3) / 10; s = (ph - 3) - l * 10; }
  unsigned char* wl = p.ws + OFF_W;
  PG8_LAS unsigned char* lds = (PG8_LAS unsigned char*)smem;
  pg8::StaticOrder S;
  if (s == 10 || s == 6 || s == 9) {
    if (EN(5)) rowpass(p, l, s == 10 ? 0 : (s == 6 ? 1 : 2));
    if (s == 9 && l == 0) {
      __syncthreads();
      for (int it = blockIdx.x; it < 832; it += gridDim.x) conv_item(p, 1, it, (float*)smem);
    }
  } else if (s == 0 || s == 3 || s == 5 || s == 8) {
    pg8::Gemm g; EpiBf E;
    g.M = NROWS; E.bias = nullptr; E.act = 0;
    if (s == 0) { g.A = (const u16*)(p.ws + OFF_H); g.lda = DM; g.Bt = (const u16*)(wl + OW_IN); g.K = DM; g.N = PST; E.O = (u16*)(p.ws + OFF_BIG); E.ldc = PST; }
    else if (s == 3) {
      g.A = (const u16*)(p.ws + OFF_H); g.lda = DM; g.Bt = (const u16*)(wl + OW_G); g.K = DM; g.N = 4096;
      E.O = (u16*)(p.ws + OFF_BIG); E.ldc = 4096; E.bias = p.gate_b + (size_t)l * 4096; E.act = 1;
    }
    else if (s == 5) { g.A = (const u16*)(p.ws + OFF_H); g.lda = DM; g.Bt = (const u16*)(wl + OW_O); g.K = DM; g.N = DM; E.O = (u16*)(p.ws + OFF_BIG); E.ldc = DM; }
    else { g.A = (const u16*)(p.ws + OFF_BIG); g.lda = FH; g.Bt = (const u16*)(wl + OW_2); g.K = FH; g.N = DM; E.O = (u16*)(p.ws + OFF_YS); E.ldc = DM; }
    if (l == 1 && s != 0) S.init(NBATCH * SEQ, g.N, gridDim.x, blockIdx.x, 1);
    else S.init(g.M, g.N, gridDim.x, blockIdx.x);
    if (EN(0)) pg8::gemm_phase<EpiBf, pg8::StaticOrder, false>(lds, g, S, E, nullptr);
  } else if (s == 4) {
    if (EN(3)) phase_ypart(p, l, smem);
  } else if (s == 1) {
    if (EN(1)) phase_mix(p, l, smem);
  } else if (s == 2) {
    if (EN(2)) phase_post(p, l, (float*)smem);
  } else {
    pg8::Gemm g; EpiSwiglu E;
    g.M = NROWS; g.N = 2 * FH; g.K = DM; g.lda = DM; g.A = (const u16*)(p.ws + OFF_H); g.Bt = (const u16*)(wl + OW_1);
    E.O = (u16*)(p.ws + OFF_BIG);
    if (l == 1) S.init(NBATCH * SEQ, g.N, gridDim.x, blockIdx.x, 1);
    else S.init(g.M, g.N, gridDim.x, blockIdx.x);
    if (EN(6)) pg8::gemm_phase<EpiSwiglu, pg8::StaticOrder, false>(lds, g, S, E, nullptr);
  }
}

__global__ void __launch_bounds__(NTHR) hybrid_flow_mega(Params p, int ph0, int ph1) {
  __shared__ __attribute__((aligned(16))) unsigned char smem[131072];
  __shared__ __attribute__((aligned(16))) unsigned xbw[4];
  cg::grid_group grid = cg::this_grid();
  XcdBarrier xb;
  xb.bar = (unsigned*)(p.ws + OFF_XBAR); xb.x = 0u; xb.st = (volatile LAS unsigned*)xbw;
  for (int ph = ph0; ph < ph1; ph++) {
    run_phase(p, ph, smem);
#ifdef DUPMASK
    {
      int sidx = ph >= 3 ? (ph - 3) % 10 : 12 + ph;
      if ((DUPMASK >> sidx) & 1) { __syncthreads(); run_phase(p, ph, smem); }
    }
#endif
    if (ph + 1 < ph1) {
      if (ph == ph0) {
        grid.sync();
        if (threadIdx.x < 4) xbw[threadIdx.x] = 0u;
        __syncthreads();
        xb = xcd_barrier_post((unsigned*)(p.ws + OFF_XBAR), (volatile LAS unsigned*)xbw);
      } else {
        xcd_barrier(xb);
      }
    }
  }
  if (ph1 - ph0 > 2 && threadIdx.x == 0 && xb_ld(&xb.bar[XB_TMO]) != 0u) p.out[blockIdx.x] = __int_as_float(0x7fc00000);
}

extern "C" void kernel_launch(void* const* d_in, const int* in_sizes, int n_in, void* d_out, int out_size, void* d_ws,
                              size_t ws_size, hipStream_t stream) {
  Params p{};
  const float** pp = (const float**)&p;
  for (int i = 0; i < 32; i++) pp[i] = (const float*)d_in[i];
  p.out = (float*)d_out;
  p.ws = (unsigned char*)d_ws;
  static int grid_blocks = 0;
  if (!grid_blocks) {
    int dev = 0, cus = 0, per_cu = 0;
    hipGetDevice(&dev);
    hipDeviceGetAttribute(&cus, hipDeviceAttributeMultiprocessorCount, dev);
    hipOccupancyMaxActiveBlocksPerMultiprocessor(&per_cu, hybrid_flow_mega, NTHR, 0);
    if (per_cu < 1) per_cu = 1;
    grid_blocks = cus * per_cu;
  }
#ifdef MULTI_LAUNCH
  for (int ph = 0; ph < NPHASE; ph++) {
    hipLaunchKernelGGL(hybrid_flow_mega, dim3(grid_blocks), dim3(NTHR), 0, stream, p, ph, ph + 1);
  }
#else
  int ph0 = 0, ph1 = NPHASE;
  void* args[] = {&p, &ph0, &ph1};
  hipError_t e = hipLaunchCooperativeKernel((void*)hybrid_flow_mega, dim3(grid_blocks), dim3(NTHR), args, 0, stream);
  if (e != hipSuccess) fprintf(stderr, "cooperative launch failed: %s (grid %d)\n", hipGetErrorString(e), grid_blocks);
#endif
}
```

```cpp
#include <hip/hip_runtime.h>
#include <hip/hip_cooperative_groups.h>
#include <cstdio>
namespace cg = cooperative_groups;

typedef unsigned short u16;
using bf16x8 = __attribute__((ext_vector_type(8))) short;
using f32x4 = __attribute__((ext_vector_type(4))) float;

#define DM 1024
#define NBATCH 8
#define SEQ 4096
#define LC 256
#define TPB 4352
#define NROWS 34816
#define PST 3328
#define YST 1792
#define FH 2816
#define INW 7408
#define NTHR 512
#define PA 0
#define PB 960
#define PC 2000
#define PD 2800
#define NPHASE 23
#define SCAN3_MASK 7

struct Params {
  const float *x, *c, *ctx, *c_ctx, *ada_w, *ada_b, *norm_g, *w_in, *gate_b, *w_branch, *w_out,
      *rwkv_mu, *rwkv_w0, *rwkv_w2, *rwkv_a0, *rwkv_a2, *rwkv_g2, *rwkv_kk, *rwkv_ka, *rwkv_rk, *rwkv_ln_g,
      *rwkv_ln_b, *gdn_conv, *gdn_a_log, *gdn_dt_bias, *gdn_norm_g, *gla_gw2, *gla_gb, *gla_norm_g, *attn_sink,
      *ffn_w1, *ffn_w2;
  float* out;
  unsigned char* ws;
};

constexpr size_t SZ_WL = 36700160;
constexpr size_t OW_IN = 0;
constexpr size_t OW_G = OW_IN + (size_t)PST * 1024 * 2;
constexpr size_t OW_B = OW_G + (size_t)4096 * 1024 * 2;
constexpr size_t OW_O = OW_B + (size_t)4 * 1024 * 256 * 2;
constexpr size_t OW_1 = OW_O + (size_t)1024 * 1024 * 2;
constexpr size_t OW_2 = OW_1 + (size_t)5632 * 1024 * 2;
static_assert(OW_2 + (size_t)1024 * FH * 2 == SZ_WL, "weights size");
constexpr size_t SZ_ACT = (size_t)NROWS * DM * 2;
constexpr size_t OFF_W = 0;
constexpr size_t OFF_XC = OFF_W + SZ_WL;
constexpr size_t OFF_MODP = OFF_XC + (size_t)NBATCH * LC * DM * 4;
constexpr size_t OFF_MOD = OFF_MODP + (size_t)2 * 8 * 9 * 6144 * 4;
constexpr size_t OFF_BC = OFF_MOD + (size_t)2 * 9 * 6144 * 4;
constexpr size_t OFF_H = OFF_BC + (size_t)NROWS * 8 * 4;
constexpr size_t OFF_YS = OFF_H + SZ_ACT;
constexpr size_t OFF_BIG = OFF_YS + (size_t)NROWS * YST * 2;
constexpr size_t OFF_CTR = OFF_BIG + (size_t)NROWS * 4096 * 2;
constexpr size_t OFF_XBAR = OFF_CTR + 256;
constexpr size_t WS_END = OFF_XBAR + 3456 * 4;
static_assert(WS_END <= (size_t)536870912, "ws too large");

__device__ __forceinline__ int launder_tid() { int t = threadIdx.x; asm volatile("" : "+v"(t)); return t; }
#define TIDX (launder_tid())
typedef float f32x2_t __attribute__((ext_vector_type(2)));
typedef __bf16 bf16x2_t __attribute__((ext_vector_type(2)));
__device__ __forceinline__ unsigned pack2(float a, float b) {
  const f32x2_t v = {a, b};
  const bf16x2_t r = __builtin_convertvector(v, bf16x2_t);
  return __builtin_bit_cast(unsigned, r);
}
__device__ __forceinline__ u16 f2bf(float f) { return (u16)(pack2(f, 0.f) & 0xffffu); }
__device__ __forceinline__ float bf2f(u16 h) { return __uint_as_float(((unsigned)h) << 16); }
__device__ __forceinline__ float sigm(float x) { return __builtin_amdgcn_rcpf(1.f + __expf(-x)); }
__device__ __forceinline__ float siluf(float x) { return x * __builtin_amdgcn_rcpf(1.f + __expf(-x)); }
__device__ __forceinline__ float rsq(float x) { return __builtin_amdgcn_rsqf(x); }
__device__ __forceinline__ float softplusf(float x) { return fmaxf(x, 0.f) + __logf(1.f + __expf(-fabsf(x))); }
__device__ __forceinline__ float tanh_fast(float x) { return 1.f - 2.f * __builtin_amdgcn_rcpf(1.f + __expf(2.f * x)); }
__device__ __forceinline__ float wsum(float v) {
#pragma unroll
  for (int o = 32; o > 0; o >>= 1) v += __shfl_xor(v, o);
  return v;
}
template <int CTRL>
__device__ __forceinline__ float dppf(float x) {
  return __int_as_float(__builtin_amdgcn_update_dpp(__float_as_int(x), __float_as_int(x), CTRL, 0xf, 0xf, false));
}
__device__ __forceinline__ float red8(float x) {
  x += dppf<0xB1>(x);
  x += dppf<0x4E>(x);
  x += dppf<0x141>(x);
  return x;
}
__device__ __forceinline__ const float* xin_row(const Params& p, int r) {
  int b = r / TPB, t = r - b * TPB;
  return t < LC ? p.ctx + ((size_t)(b * LC + t)) * DM : p.x + ((size_t)(b * SEQ + t - LC)) * DM;
}
__device__ __forceinline__ float* x_row(const Params& p, int r) {
  int b = r / TPB, t = r - b * TPB;
  return t < LC ? (float*)(p.ws + OFF_XC) + ((size_t)(b * LC + t)) * DM : p.out + ((size_t)(b * SEQ + t - LC)) * DM;
}
__device__ __forceinline__ int mod_row(int r) {
  int b = r / TPB, t = r - b * TPB;
  return t < LC ? 8 : b;
}

struct MapId { int lim, off; __device__ int operator()(int n) const { return n < lim ? n + off : -1; } };
struct MapW1 { __device__ int operator()(int n) const { int q = n >> 3, s = n & 7; return s < 4 ? q * 4 + s : FH + q * 4 + (s - 4); } };

template <class Map>
__device__ __forceinline__ void conv_tile(const float* __restrict__ src, int ld, u16* __restrict__ dst, int K, int n0,
                                          int k0, Map map, float* tile) {
  const int tid = TIDX;
  const int nn = tid & 63, kr = tid >> 6;
  const int sc = map(n0 + nn);
  float tv[8];
  const int scc = sc >= 0 ? sc : 0;
  const float scm = sc >= 0 ? 1.f : 0.f;
#pragma unroll
  for (int ps = 0; ps < 8; ps++) tv[ps] = src[(size_t)(k0 + ps * 8 + kr) * ld + scc];
#pragma unroll
  for (int ps = 0; ps < 8; ps++) tile[(ps * 8 + kr) * 65 + nn] = tv[ps] * scm;
  __syncthreads();
  const int n2 = tid >> 3, kc = tid & 7;
  uint4 o;
  o.x = pack2(tile[(kc * 8 + 0) * 65 + n2], tile[(kc * 8 + 1) * 65 + n2]);
  o.y = pack2(tile[(kc * 8 + 2) * 65 + n2], tile[(kc * 8 + 3) * 65 + n2]);
  o.z = pack2(tile[(kc * 8 + 4) * 65 + n2], tile[(kc * 8 + 5) * 65 + n2]);
  o.w = pack2(tile[(kc * 8 + 6) * 65 + n2], tile[(kc * 8 + 7) * 65 + n2]);
  *(uint4*)(dst + (size_t)(n0 + n2) * K + k0 + kc * 8) = o;
  __syncthreads();
}

__device__ __forceinline__ void conv_item(const Params& p, int l, int rem, float* sm) {
      u16* wl = (u16*)(p.ws + OFF_W);
      if (rem < 832) {
        int nt = rem >> 4, kt = rem & 15;
        conv_tile(p.w_in + (size_t)l * DM * INW, INW, (u16*)((char*)wl + OW_IN), 1024, nt * 64, kt * 64, MapId{3312, 0}, sm);
      } else if (rem < 832 + 1024) {
        rem -= 832;
        int nt = rem >> 4, kt = rem & 15;
        conv_tile(p.w_in + (size_t)l * DM * INW, INW, (u16*)((char*)wl + OW_G), 1024, nt * 64, kt * 64, MapId{4096, 3312}, sm);
      } else if (rem < 1856 + 256) {
        rem -= 1856;
        int br = rem >> 6, r2 = rem & 63, nt = r2 >> 2, kt = r2 & 3;
        conv_tile(p.w_branch + ((size_t)(l * 4 + br)) * 256 * DM, DM, (u16*)((char*)wl + OW_B) + (size_t)br * 1024 * 256, 256,
                  nt * 64, kt * 64, MapId{1024, 0}, sm);
      } else if (rem < 2112 + 256) {
        rem -= 2112;
        int nt = rem >> 4, kt = rem & 15;
        conv_tile(p.w_out + (size_t)l * DM * DM, DM, (u16*)((char*)wl + OW_O), 1024, nt * 64, kt * 64, MapId{1024, 0}, sm);
      } else if (rem < 2368 + 1408) {
        rem -= 2368;
        int nt = rem >> 4, kt = rem & 15;
        conv_tile(p.ffn_w1 + (size_t)l * DM * 5632, 5632, (u16*)((char*)wl + OW_1), 1024, nt * 64, kt * 64, MapW1{}, sm);
      } else {
        rem -= 3776;
        int nt = rem / 44, kt = rem - nt * 44;
        conv_tile(p.ffn_w2 + (size_t)l * FH * DM, DM, (u16*)((char*)wl + OW_2), FH, nt * 64, kt * 64, MapId{1024, 0}, sm);
      }
}

__device__ __forceinline__ void phase_init0(const Params& p, float* sm) {
  const int tid = TIDX;
  if (blockIdx.x == 0) {
    if (tid < 64) ((unsigned*)(p.ws + OFF_CTR))[tid] = 0u;
    for (int i = tid; i < 3456; i += NTHR) ((unsigned*)(p.ws + OFF_XBAR))[i] = 0u;
  }
  constexpr int NMOD = 192, NCONV = 832;
  for (int it = blockIdx.x; it < NMOD + NCONV; it += gridDim.x) {
    if (it < NMOD) {
      int l = it / 96, rem = it - l * 96, cc = rem >> 3, ks = rem & 7;
      for (int i = tid; i < 9 * 128; i += NTHR) {
        int r = i >> 7, k = i & 127;
        float v = r < 8 ? p.c[r * DM + ks * 128 + k] : p.c_ctx[ks * 128 + k];
        sm[i] = siluf(v);
      }
      __syncthreads();
      const int n = cc * 512 + tid;
      const float* w = p.ada_w + ((size_t)l * DM + ks * 128) * 6144 + n;
      float acc[9];
#pragma unroll
      for (int r = 0; r < 9; r++) acc[r] = 0.f;
#pragma unroll 1
      for (int k0 = 0; k0 < 128; k0 += 16) {
        float wv[16];
#pragma unroll
        for (int kk = 0; kk < 16; kk++) wv[kk] = w[(size_t)(k0 + kk) * 6144];
#pragma unroll
        for (int kk = 0; kk < 16; kk++)
#pragma unroll
          for (int r = 0; r < 9; r++) acc[r] += sm[r * 128 + k0 + kk] * wv[kk];
      }
      float* mp = (float*)(p.ws + OFF_MODP) + ((size_t)(l * 8 + ks) * 9) * 6144 + n;
#pragma unroll
      for (int r = 0; r < 9; r++) mp[(size_t)r * 6144] = acc[r];
      __syncthreads();
    } else {
      conv_item(p, 0, it - NMOD, sm);
    }
  }
}

__device__ __forceinline__ void phase_init1(const Params& p) {
  const float* mp = (const float*)(p.ws + OFF_MODP);
  float* mo = (float*)(p.ws + OFF_MOD);
  for (int i = blockIdx.x * NTHR + TIDX; i < 2 * 9 * 6144; i += gridDim.x * NTHR) {
    int l = i / (9 * 6144), rem = i - l * 9 * 6144, r = rem / 6144, n = rem - r * 6144;
    float s = p.ada_b[l * 6144 + n];
#pragma unroll
    for (int ks = 0; ks < 8; ks++) s += mp[((size_t)((l * 8 + ks) * 9 + r)) * 6144 + n];
    mo[i] = s;
  }
}

__device__ __forceinline__ void rowpass(const Params& p, int l, int mode) {
  const int lane = TIDX & 63, wv = TIDX >> 6;
  const float* MOD = (const float*)(p.ws + OFF_MOD);
  u16* H = (u16*)(p.ws + OFF_H);
  const bool do_norm = !(mode == 2 && l == 1);
  const int ln = (mode == 2) ? (l == 1 ? l : l + 1) : l;
  const int ni = (mode == 1) ? 2 : 0, sho = (mode == 1) ? 3072 : 0, sco = (mode == 1) ? 4096 : 1024;
  for (int r = blockIdx.x * 8 + wv; r < NROWS; r += gridDim.x * 8) {
    const int mr = mod_row(r);
    if (l == 1 && mode != 0 && mr == 8) continue;
    const float* modl = MOD + ((size_t)(l * 9 + mr)) * 6144;
    const float* modn = MOD + ((size_t)(ln * 9 + mr)) * 6144;
    const float* ng2 = p.norm_g + (size_t)(ln * 4 + ni) * DM;
    const float* xs = (mode == 0 || (mode == 1 && l == 0)) ? xin_row(p, r) : (const float*)x_row(p, r);
    float4 xo[4], n2[4], sc4[4], sh4[4];
#pragma unroll
    for (int i = 0; i < 4; i++) {
      const int col = i * 256 + lane * 4;
      xo[i] = *(const float4*)(xs + col);
      n2[i] = *(const float4*)(ng2 + col);
      sc4[i] = *(const float4*)(modn + sco + col);
      sh4[i] = *(const float4*)(modn + sho + col);
    }
    float xv[16];
    if (mode == 0) {
#pragma unroll
      for (int i = 0; i < 4; i++) { xv[i * 4 + 0] = xo[i].x; xv[i * 4 + 1] = xo[i].y; xv[i * 4 + 2] = xo[i].z; xv[i * 4 + 3] = xo[i].w; }
    } else {
      const u16* src = (const u16*)(p.ws + (mode == 1 ? OFF_BIG : OFF_YS)) + (size_t)r * DM;
      const float* ng = p.norm_g + (size_t)(l * 4 + (mode == 1 ? 1 : 3)) * DM;
      const float* gt = modl + (mode == 1 ? 2048 : 5120);
      uint2 sv[4];
      float4 g4[4], n4[4];
#pragma unroll
      for (int i = 0; i < 4; i++) {
        const int col = i * 256 + lane * 4;
        sv[i] = *(const uint2*)(src + col);
        g4[i] = *(const float4*)(gt + col);
        n4[i] = *(const float4*)(ng + col);
      }
      float ov[16];
      float ss = 0.f;
#pragma unroll
      for (int i = 0; i < 4; i++) {
        ov[i * 4 + 0] = __uint_as_float(sv[i].x << 16); ov[i * 4 + 1] = __uint_as_float(sv[i].x & 0xffff0000u);
        ov[i * 4 + 2] = __uint_as_float(sv[i].y << 16); ov[i * 4 + 3] = __uint_as_float(sv[i].y & 0xffff0000u);
      }
#pragma unroll
      for (int i = 0; i < 16; i++) ss += ov[i] * ov[i];
      ss = wsum(ss);
      const float inv = rsq(ss * (1.f / 1024.f) + 1e-6f);
      float* xd = x_row(p, r);
#pragma unroll
      for (int i = 0; i < 4; i++) {
        xv[i * 4 + 0] = xo[i].x + g4[i].x * (ov[i * 4 + 0] * inv * n4[i].x);
        xv[i * 4 + 1] = xo[i].y + g4[i].y * (ov[i * 4 + 1] * inv * n4[i].y);
        xv[i * 4 + 2] = xo[i].z + g4[i].z * (ov[i * 4 + 2] * inv * n4[i].z);
        xv[i * 4 + 3] = xo[i].w + g4[i].w * (ov[i * 4 + 3] * inv * n4[i].w);
      }
#pragma unroll
      for (int i = 0; i < 4; i++)
        *(float4*)(xd + i * 256 + lane * 4) = make_float4(xv[i * 4 + 0], xv[i * 4 + 1], xv[i * 4 + 2], xv[i * 4 + 3]);
    }
    if (!do_norm) continue;
    float ss2 = 0.f;
#pragma unroll
    for (int i = 0; i < 16; i++) ss2 += xv[i] * xv[i];
    ss2 = wsum(ss2);
    const float inv2 = rsq(ss2 * (1.f / 1024.f) + 1e-6f);
#pragma unroll
    for (int i = 0; i < 4; i++) {
      const int col = i * 256 + lane * 4;
      float h0 = xv[i * 4 + 0] * inv2 * n2[i].x * (1.f + sc4[i].x) + sh4[i].x;
      float h1 = xv[i * 4 + 1] * inv2 * n2[i].y * (1.f + sc4[i].y) + sh4[i].y;
      float h2 = xv[i * 4 + 2] * inv2 * n2[i].z * (1.f + sc4[i].z) + sh4[i].z;
      float h3 = xv[i * 4 + 3] * inv2 * n2[i].w * (1.f + sc4[i].w) + sh4[i].w;
      uint2 o;
      o.x = pack2(h0, h1);
      o.y = pack2(h2, h3);
      *(uint2*)(H + (size_t)r * DM + col) = o;
    }
  }
}

#define LDT 72
namespace pg8 {
#define PG8_LAS __attribute__((address_space(3)))
typedef unsigned short bf16_t;
typedef short bf16x8 __attribute__((ext_vector_type(8)));
typedef float f32x4 __attribute__((ext_vector_type(4)));
typedef unsigned u32x4 __attribute__((ext_vector_type(4)));
constexpr int BM = 256, BK = 64, HALF = 128, HTB = HALF * BK * 2  , STAGE_BYTES = 8 * HTB, NXCD = 8, WGM = 8;

__host__ __device__ __forceinline__ int lds_byte(int r, int c) { const int st = (r >> 4) * 2 + (c >> 5), rr = r & 15, cc = c & 31, ob = rr * 64 + cc * 2; return st * 1024 + (ob ^ (((ob >> 9) & 1) << 5)); }
__host__ __device__ __forceinline__ void stage_rc(int b, int& R, int& C) { const int st = b / 1024, sb = b % 1024, swz = sb ^ (((sb >> 9) & 1) << 5); R = (st >> 1) * 16 + swz / 64; C = (st & 1) * 32 + (swz % 64) / 2; }
__host__ __device__ __forceinline__ int perm32(int rho) { const int n = rho >> 4, i = rho & 15; return 8 * (i >> 2) + 4 * n + (i & 3); }

struct Unit { int pm, pn; };
struct Gemm { const bf16_t* A; const bf16_t* Bt; int M, N, K, lda; };
struct StaticOrder {
    int nM, nN, nwg, G, c, skip;
    __host__ __device__ void init(int M, int N, int G_, int c_, int skip_ = 0) { nM = M / BM; nN = N / BM; nwg = nM * nN; G = G_; c = c_; skip = skip_; }
    __host__ __device__ bool next(int i, Unit& u) const {
        const long L = (long)i * G + c; if (L >= nwg) return false;
        int wgid = (int)L; { const int q = nwg / NXCD, r = nwg % NXCD, xcd = wgid % NXCD, off = wgid / NXCD; wgid = (xcd < r ? xcd * (q + 1) : r * (q + 1) + (xcd - r) * q) + off; }
        const int nig = WGM * nN, gid = wgid / nig, fm = gid * WGM, gsz = (nM - fm) < WGM ? (nM - fm) : WGM;
        u.pm = fm + ((wgid % nig) % gsz); u.pn = (wgid % nig) / gsz;
        if (skip) u.pm = (u.pm >> 4) * 17 + 1 + (u.pm & 15);
        return true;
    }
    __device__ __forceinline__ void a_ready(const Unit&) const {}
    __device__ __forceinline__ void done(const Unit&) const {}
};
__device__ __forceinline__ unsigned cvt_pk_bf16(float lo, float hi) { unsigned r; asm volatile("v_cvt_pk_bf16_f32 %0, %1, %2" : "=v"(r) : "v"(lo), "v"(hi)); return r; }
template <class Epi, class Sched, bool STAMP = false>
__device__ __forceinline__ void gemm_phase(PG8_LAS unsigned char* lds, const Gemm g, const Sched& S, const Epi& E, unsigned long long* stamps) {
    const int tid = TIDX, wid = __builtin_amdgcn_readfirstlane(tid >> 6), lane = tid & 63, wr = wid >> 2, wc = wid & 3, fr = lane & 15, fq = lane >> 4;
    const int K = g.K, nt = K / BK;
    int ts_lo = 0, ts_hi = 0, nts = 0; const unsigned long long rt_entry = STAMP ? (unsigned long long)wall_clock64() : 0ull;
#define PG8_STAMP() do { if (STAMP && wid == 0 && nts < 64) { const unsigned long long _c = (unsigned long long)clock64(); \
        ts_lo = (lane == nts) ? (int)(unsigned)_c : ts_lo; ts_hi = (lane == nts) ? (int)(unsigned)(_c >> 32) : ts_hi; ++nts; } } while (0)
    PG8_STAMP();
    unsigned voffA[2], voffB[2];
#pragma unroll
    for (int i = 0; i < 2; ++i) { int R, C; stage_rc(tid * 16 + i * 8192, R, C); const int Rb = Epi::PERM ? ((R & ~31) + perm32(R & 31)) : R;
        voffA[i] = (unsigned)(R * g.lda + C) * 2u; voffB[i] = (unsigned)(Rb * K + C) * 2u; }
    const size_t kstep = (size_t)(BK * 2);
    const size_t hstepB = (size_t)HALF * K * 2, hstepA = (size_t)HALF * g.lda * 2;
    const size_t tstepB = 2 * hstepB, tstepA = 2 * hstepA;
    const unsigned ldsw = (unsigned)wid * 1024u;
    const int aoff = lds_byte(wr * 64 + fr, fq * 8), boff = lds_byte(wc * 32 + fr, fq * 8);
#define PG8_SA(b, h) (((b) * 2 + (h)) * HTB)
#define PG8_SB(b, h) ((4 + (b) * 2 + (h)) * HTB)
#define PG8_STAGE(bufoff, gbase, voff) do { _Pragma("unroll") for (int _i = 0; _i < 2; ++_i) \
        __builtin_amdgcn_global_load_lds((const unsigned*)((const char*)(gbase) + (voff)[_i]), (PG8_LAS unsigned*)(lds + (bufoff) + ldsw + _i * 8192), 16, 0, 0); } while (0)
#define PG8_LDA(dst, b, h) do { _Pragma("unroll") for (int m = 0; m < 4; ++m) _Pragma("unroll") for (int k = 0; k < 2; ++k) dst[m][k] = *(const PG8_LAS bf16x8*)(lds + PG8_SA(b, h) + aoff + m * 2048 + k * 1024); } while (0)
#define PG8_LDB(dst, b, h) do { _Pragma("unroll") for (int n = 0; n < 2; ++n) _Pragma("unroll") for (int k = 0; k < 2; ++k) dst[n][k] = *(const PG8_LAS bf16x8*)(lds + PG8_SB(b, h) + boff + n * 2048 + k * 1024); } while (0)
#define PG8_MMA(ai, bj, At, Bt) do { __builtin_amdgcn_s_setprio(1); _Pragma("unroll") for (int m = 0; m < 4; ++m) _Pragma("unroll") for (int n = 0; n < 2; ++n) _Pragma("unroll") for (int k = 0; k < 2; ++k) \
        acc[ai][bj][m][n] = __builtin_amdgcn_mfma_f32_16x16x32_bf16(Bt[n][k], At[m][k], acc[ai][bj][m][n], 0, 0, 0); __builtin_amdgcn_s_setprio(0); } while (0)
#define PG8_WAIT_V(n) asm volatile("s_waitcnt vmcnt(" #n ")" ::: "memory")
#define PG8_WAIT_L(n) asm volatile("s_waitcnt lgkmcnt(" #n ")" ::: "memory")
#define PG8_BAR __builtin_amdgcn_s_barrier()
#define PG8_SCHED __builtin_amdgcn_sched_barrier(0)
    Unit cur, nxt; int ui = 0;
    if (!S.next(0, cur)) return;
    f32x4 acc[2][2][4][2];
#pragma unroll
    for (int a = 0; a < 2; ++a)
#pragma unroll
        for (int b = 0; b < 2; ++b)
#pragma unroll
            for (int m = 0; m < 4; ++m)
#pragma unroll
                for (int n = 0; n < 2; ++n) acc[a][b][m][n] = (f32x4){0.f, 0.f, 0.f, 0.f};
    bf16x8 At[4][2], B0[2][2], B1[2][2];
    const char* cA = (const char*)g.A + (size_t)cur.pm * tstepA; const char* cB = (const char*)g.Bt + (size_t)cur.pn * tstepB;
    S.a_ready(cur);
    PG8_STAGE(PG8_SB(0, 0), cB, voffB); PG8_STAGE(PG8_SA(0, 0), cA, voffA); PG8_STAGE(PG8_SB(0, 1), cB + hstepB, voffB); PG8_STAGE(PG8_SA(0, 1), cA + hstepA, voffA);
    if (wr == 1) PG8_BAR;
    PG8_WAIT_V(4); PG8_BAR;
    PG8_STAGE(PG8_SB(1, 0), cB + kstep, voffB); PG8_STAGE(PG8_SA(1, 0), cA + kstep, voffA); PG8_STAGE(PG8_SB(1, 1), cB + hstepB + kstep, voffB);
    PG8_WAIT_V(6); PG8_BAR;
    PG8_STAMP();
    for (;;) {
        const bool has_next = S.next(ui + 1, nxt);
        const char* nA = has_next ? (const char*)g.A + (size_t)nxt.pm * tstepA : cA; const char* nB = has_next ? (const char*)g.Bt + (size_t)nxt.pn * tstepB : cB;
        for (int t = 0; t < nt; t += 2) {
            const bool last = (t == nt - 2);
            const char* a1 = cA + (size_t)(t + 1) * kstep;
            const char* a2 = last ? nA : cA + (size_t)(t + 2) * kstep; const char* b2 = last ? nB : cB + (size_t)(t + 2) * kstep;
            const char* a3 = a2 + kstep; const char* b3 = b2 + kstep;
            if (last && has_next) S.a_ready(nxt);
            PG8_LDB(B0, 0, 0); PG8_SCHED; PG8_LDA(At, 0, 0); PG8_STAGE(PG8_SA(1, 1), a1 + hstepA, voffA);
            PG8_WAIT_L(8); PG8_BAR; PG8_WAIT_L(0); PG8_MMA(0, 0, At, B0); PG8_BAR; PG8_SCHED;
            PG8_LDB(B1, 0, 1); PG8_STAGE(PG8_SB(0, 0), b2, voffB);
            PG8_BAR; PG8_WAIT_L(0); PG8_MMA(0, 1, At, B1); PG8_BAR;
            PG8_LDA(At, 0, 1); PG8_STAGE(PG8_SA(0, 0), a2, voffA);
            PG8_BAR; PG8_WAIT_L(0); PG8_MMA(1, 0, At, B0); PG8_BAR; PG8_SCHED;
            PG8_STAGE(PG8_SB(0, 1), b2 + hstepB, voffB);
            PG8_WAIT_V(6); PG8_BAR; PG8_MMA(1, 1, At, B1); PG8_BAR;
            PG8_LDB(B0, 1, 0); PG8_SCHED; PG8_LDA(At, 1, 0); PG8_STAGE(PG8_SA(0, 1), a2 + hstepA, voffA);
            PG8_WAIT_L(8); PG8_BAR; PG8_WAIT_L(0); PG8_MMA(0, 0, At, B0); PG8_BAR; PG8_SCHED;
            PG8_LDB(B1, 1, 1); PG8_STAGE(PG8_SB(1, 0), b3, voffB);
            PG8_BAR; PG8_WAIT_L(0); PG8_MMA(0, 1, At, B1); PG8_BAR;
            PG8_LDA(At, 1, 1); PG8_STAGE(PG8_SA(1, 0), a3, voffA);
            PG8_BAR; PG8_WAIT_L(0); PG8_MMA(1, 0, At, B0); PG8_BAR; PG8_SCHED;
            PG8_STAGE(PG8_SB(1, 1), b3 + hstepB, voffB);
            PG8_WAIT_V(6); PG8_BAR; PG8_MMA(1, 1, At, B1); PG8_BAR;
        }
        PG8_STAMP();
        if constexpr (!Epi::AFTER_DRAIN) { E(acc, cur, wr, wc, fr, fq); S.done(cur); }
        PG8_STAMP();
        if (!has_next) break;
#pragma unroll
        for (int a = 0; a < 2; ++a)
#pragma unroll
            for (int b = 0; b < 2; ++b)
#pragma unroll
                for (int m = 0; m < 4; ++m)
#pragma unroll
                    for (int n = 0; n < 2; ++n) acc[a][b][m][n] = (f32x4){0.f, 0.f, 0.f, 0.f};
        cur = nxt; cA = nA; cB = nB; ++ui;
    }
    PG8_WAIT_V(0);
    if (wr == 0) PG8_BAR;
    PG8_BAR;
    if constexpr (Epi::AFTER_DRAIN) { E.fused(acc, cur, wr, wc, fr, fq, lds, wid, lane); S.done(cur); }
    PG8_STAMP();
    if (STAMP && wid == 0) { stamps[lane] = lane < nts ? (((unsigned long long)(unsigned)ts_hi << 32) | (unsigned)ts_lo) : 0ull;
        if (lane == 62) stamps[62] = rt_entry; if (lane == 63) stamps[63] = (unsigned long long)wall_clock64(); }
#undef PG8_STAMP
#undef PG8_SA
#undef PG8_SB
#undef PG8_STAGE
#undef PG8_LDA
#undef PG8_LDB
#undef PG8_MMA
#undef PG8_WAIT_V
#undef PG8_WAIT_L
#undef PG8_BAR
#undef PG8_SCHED
}
}

struct EpiBf {
  static constexpr bool PERM = true, AFTER_DRAIN = false;
  u16* O; int ldc; const float* bias; int act;
  __device__ __forceinline__ void operator()(const f32x4 (&acc)[2][2][4][2], const pg8::Unit& u, int wr, int wc, int fr, int fq) const {
    const int row0 = u.pm * 256 + wr * 64 + fr, col0 = u.pn * 256 + wc * 32 + 8 * fq;
    f32x4 bv[2][2];
#pragma unroll
    for (int bj = 0; bj < 2; ++bj)
#pragma unroll
      for (int n = 0; n < 2; ++n) bv[bj][n] = bias ? *(const f32x4*)(bias + col0 + bj * 128 + 4 * n) : f32x4{0.f, 0.f, 0.f, 0.f};
#pragma unroll
    for (int ai = 0; ai < 2; ++ai)
#pragma unroll
      for (int m = 0; m < 4; ++m) {
        u16* rowp = O + (size_t)(row0 + ai * 128 + m * 16) * ldc + col0;
#pragma unroll
        for (int bj = 0; bj < 2; ++bj) {
          f32x4 v0 = acc[ai][bj][m][0] + bv[bj][0], v1 = acc[ai][bj][m][1] + bv[bj][1];
          if (act == 1) {
#pragma unroll
            for (int j = 0; j < 4; ++j) { v0[j] = sigm(v0[j]); v1[j] = sigm(v1[j]); }
          }
          uint4 wv;
          wv.x = pack2(v0[0], v0[1]); wv.y = pack2(v0[2], v0[3]); wv.z = pack2(v1[0], v1[1]); wv.w = pack2(v1[2], v1[3]);
          *(uint4*)(rowp + bj * 128) = wv;
        }
      }
  }
};
struct EpiSwiglu {
  static constexpr bool PERM = true, AFTER_DRAIN = false;
  u16* O;
  __device__ __forceinline__ void operator()(const f32x4 (&acc)[2][2][4][2], const pg8::Unit& u, int wr, int wc, int fr, int fq) const {
    const int row0 = u.pm * 256 + wr * 64 + fr, col0 = u.pn * 128 + wc * 16 + 4 * fq;
#pragma unroll
    for (int ai = 0; ai < 2; ++ai)
#pragma unroll
      for (int m = 0; m < 4; ++m) {
        u16* rowp = O + (size_t)(row0 + ai * 128 + m * 16) * FH + col0;
#pragma unroll
        for (int bj = 0; bj < 2; ++bj) {
          const f32x4 g = acc[ai][bj][m][0], up = acc[ai][bj][m][1];
          uint2 wv;
          wv.x = pack2(siluf(g[0]) * up[0], siluf(g[1]) * up[1]);
          wv.y = pack2(siluf(g[2]) * up[2], siluf(g[3]) * up[3]);
          *(uint2*)(rowp + bj * 64) = wv;
        }
      }
  }
};
struct EpiGateAcc {
  static constexpr bool PERM = true, AFTER_DRAIN = false;
  u16* ACC; const u16* G; int gcol; unsigned amask;
  __device__ __forceinline__ void operator()(const f32x4 (&acc)[2][2][4][2], const pg8::Unit& u, int wr, int wc, int fr, int fq) const {
    unsigned pk[2][2][4][4];
#pragma unroll
    for (int ai = 0; ai < 2; ++ai)
#pragma unroll
      for (int bj = 0; bj < 2; ++bj)
#pragma unroll
        for (int m = 0; m < 4; ++m) {
          pk[ai][bj][m][0] = pack2(acc[ai][bj][m][0][0], acc[ai][bj][m][0][1]);
          pk[ai][bj][m][1] = pack2(acc[ai][bj][m][0][2], acc[ai][bj][m][0][3]);
          pk[ai][bj][m][2] = pack2(acc[ai][bj][m][1][0], acc[ai][bj][m][1][1]);
          pk[ai][bj][m][3] = pack2(acc[ai][bj][m][1][2], acc[ai][bj][m][1][3]);
        }
    asm volatile("" ::: "memory");
    const int row0 = u.pm * 256 + wr * 64 + fr, col0 = u.pn * 256 + wc * 32 + 8 * fq;
#pragma unroll
    for (int ai = 0; ai < 2; ++ai)
#pragma unroll
      for (int m = 0; m < 4; ++m) {
        const size_t row = (size_t)(row0 + ai * 128 + m * 16);
#pragma unroll
        for (int bj = 0; bj < 2; ++bj) {
          const int col = col0 + bj * 128;
          const uint4 gv = *(const uint4*)(G + row * 2048 + gcol + col);
          const uint4 av = *(const uint4*)(ACC + row * DM + col);
          const unsigned gw[4] = {gv.x, gv.y, gv.z, gv.w};
          const unsigned aw[4] = {av.x & amask, av.y & amask, av.z & amask, av.w & amask};
          unsigned ow[4];
#pragma unroll
          for (int q = 0; q < 4; ++q) {
            const unsigned pv = pk[ai][bj][m][q];
            const float lo = __uint_as_float(aw[q] << 16) + __uint_as_float(gw[q] << 16) * __uint_as_float(pv << 16);
            const float hi = __uint_as_float(aw[q] & 0xffff0000u) + __uint_as_float(gw[q] & 0xffff0000u) * __uint_as_float(pv & 0xffff0000u);
            ow[q] = pack2(lo, hi);
          }
          *(uint4*)(ACC + row * DM + col) = make_uint4(ow[0], ow[1], ow[2], ow[3]);
        }
        asm volatile("" ::: "memory");
      }
  }
};

template <int MI>
__device__ __forceinline__ void gemm_loop(const u16* __restrict__ A, int lda, const u16* __restrict__ Bt, int ldb, int K,
                                          f32x4 (&acc)[MI][4], u16* sA, u16* sB) {
  constexpr int BMT = MI * 64;
  const int tid = TIDX, lane = tid & 63, w = tid >> 6, wm = w >> 1, wn = w & 1, fr = lane & 15, fq = lane >> 4;
  uint4 ra[MI], rb[2];
  const u16* ga = A + (size_t)(tid >> 3) * lda + (tid & 7) * 8;
  const u16* gb = Bt + (size_t)(tid >> 3) * ldb + (tid & 7) * 8;
  const int so = (tid >> 3) * LDT + (tid & 7) * 8;
#pragma unroll
  for (int i = 0; i < MI; i++) ra[i] = *(const uint4*)(ga + (size_t)(i * 64) * lda);
#pragma unroll
  for (int i = 0; i < 2; i++) rb[i] = *(const uint4*)(gb + (size_t)(i * 64) * ldb);
#pragma unroll
  for (int i = 0; i < MI; i++) *(uint4*)(sA + so + i * 64 * LDT) = ra[i];
#pragma unroll
  for (int i = 0; i < 2; i++) *(uint4*)(sB + so + i * 64 * LDT) = rb[i];
  __syncthreads();
  const int nk = K >> 6;
  for (int kt = 0; kt < nk; kt++) {
    const bool more = kt + 1 < nk;
    if (more) {
#pragma unroll
      for (int i = 0; i < MI; i++) ra[i] = *(const uint4*)(ga + (size_t)(i * 64) * lda + (kt + 1) * 64);
#pragma unroll
      for (int i = 0; i < 2; i++) rb[i] = *(const uint4*)(gb + (size_t)(i * 64) * ldb + (kt + 1) * 64);
    }
    const u16* a = sA + (kt & 1) * BMT * LDT + (wm * (MI * 16) + fr) * LDT + fq * 8;
    const u16* b = sB + (kt & 1) * 128 * LDT + (wn * 64 + fr) * LDT + fq * 8;
#pragma unroll
    for (int ks = 0; ks < 2; ks++) {
      bf16x8 af[MI], bfr[4];
#pragma unroll
      for (int i = 0; i < MI; i++) af[i] = *(const bf16x8*)(a + i * 16 * LDT + ks * 32);
#pragma unroll
      for (int j = 0; j < 4; j++) bfr[j] = *(const bf16x8*)(b + j * 16 * LDT + ks * 32);
#pragma unroll
      for (int i = 0; i < MI; i++)
#pragma unroll
        for (int j = 0; j < 4; j++) acc[i][j] = __builtin_amdgcn_mfma_f32_16x16x32_bf16(bfr[j], af[i], acc[i][j], 0, 0, 0);
    }
    if (more) {
      u16* da = sA + ((kt + 1) & 1) * BMT * LDT + so;
      u16* db = sB + ((kt + 1) & 1) * 128 * LDT + so;
#pragma unroll
      for (int i = 0; i < MI; i++) *(uint4*)(da + i * 64 * LDT) = ra[i];
#pragma unroll
      for (int i = 0; i < 2; i++) *(uint4*)(db + i * 64 * LDT) = rb[i];
    }
    __syncthreads();
  }
}

template <int MI>
__device__ __forceinline__ void zero_acc(f32x4 (&acc)[MI][4]) {
#pragma unroll
  for (int i = 0; i < MI; i++)
#pragma unroll
    for (int j = 0; j < 4; j++) acc[i][j] = f32x4{0.f, 0.f, 0.f, 0.f};
}


typedef unsigned u32x4v __attribute__((ext_vector_type(4)));
__device__ __forceinline__ void yp_issue(const u16* __restrict__ A, const u16* __restrict__ B, u32x4v (&ra)[8], u32x4v (&rb)[8], int tid) {
#pragma unroll
  for (int i = 0; i < 8; i++) {
    const int c = tid + i * NTHR, row = c >> 5, ch = c & 31;
    ra[i] = *(const u32x4v*)(A + (size_t)row * YST + ch * 8);
    rb[i] = *(const u32x4v*)(B + (size_t)row * 256 + ch * 8);
  }
}
__device__ __forceinline__ void yp_stage(unsigned char* sA, unsigned char* sB, const u32x4v (&ra)[8], const u32x4v (&rb)[8], int tid) {
#pragma unroll
  for (int i = 0; i < 8; i++) {
    const int c = tid + i * NTHR, row = c >> 5, ch = c & 31;
    const int off = row * 512 + ((ch ^ (row & 7)) << 4);
    *(u32x4v*)(sA + off) = ra[i];
    *(u32x4v*)(sB + off) = rb[i];
  }
}
__device__ __forceinline__ void phase_ypart(const Params& p, int l, unsigned char* smem) {
  unsigned char* sA = smem;
  unsigned char* sB = smem + 65536;
  const int tid = TIDX, lane = tid & 63, w = tid >> 6, wm = w >> 1, wn = w & 1, fr = lane & 15, fq = lane >> 4;
  const u16* Y = (const u16*)(p.ws + OFF_YS);
  const u16* Wb = (const u16*)(p.ws + OFF_W + OW_B);
  const u16* G = (const u16*)(p.ws + OFF_BIG);
  u16* ACC = (u16*)(p.ws + OFF_H);
  constexpr int NT = 8;
  const int ntiles = (NROWS / 128) * NT;
  const int G_ = gridDim.x;
  const bool xmap = (G_ == 256);
  const int xj = blockIdx.x >> 3, xx = blockIdx.x & 7;
  const bool skipc = (l == 1);
  const int nrt = skipc ? 256 : 272;
  const int ntl = nrt * NT;
  const int nmine = xmap ? (xj < nrt ? (nrt - 1 - xj) / 32 + 1 : 0)
                         : (((int)blockIdx.x < ntl) ? (ntl - 1 - (int)blockIdx.x) / G_ + 1 : 0);
  if (nmine == 0) return;
#define YP_TILE(Q_, MT_, NT_)                                                        \
  do {                                                                               \
    if (xmap) { const int s_ = (Q_) * 32 + xj; MT_ = (s_ >> 3) * 8 + xx; NT_ = s_ & 7; } \
    else { const int t_ = blockIdx.x + (Q_) * G_; MT_ = t_ / NT; NT_ = t_ - MT_ * NT; }  \
    if (skipc) MT_ = (MT_ >> 5) * 34 + 2 + (MT_ & 31);                                   \
  } while (0)
  u32x4v ra[8], rb[8];
  {
    int mt, nt;
    YP_TILE(0, mt, nt);
    yp_issue(Y + (size_t)mt * 128 * YST, Wb + ((size_t)nt * 128) * 256, ra, rb, tid);
  }
  f32x4 tot[2][4];
  zero_acc<2>(tot);
  for (int qi = 0; qi < 4 * nmine; qi++) {
    const int q = qi >> 2, k = qi & 3;
    int mt, nt;
    YP_TILE(q, mt, nt);
    const int r0 = mt * 128 + wm * 32 + fr, c0 = nt * 128 + wn * 64 + fq * 4;
    __syncthreads();
    yp_stage(sA, sB, ra, rb, tid);
    __syncthreads();
    {
      const int qn = qi + 1 < 4 * nmine ? qi + 1 : qi;
      int mtn, ntn;
      YP_TILE(qn >> 2, mtn, ntn);
      const int brn = qn & 3, ycn = brn < 3 ? brn * 256 : 1536;
      yp_issue(Y + (size_t)mtn * 128 * YST + ycn, Wb + ((size_t)brn * 1024 + ntn * 128) * 256, ra, rb, tid);
    }
    uint2 gv[2][4];
#pragma unroll
    for (int i = 0; i < 2; i++)
#pragma unroll
      for (int j = 0; j < 4; j++) gv[i][j] = *(const uint2*)(G + (size_t)(r0 + i * 16) * 4096 + k * 1024 + c0 + j * 16);
    f32x4 ay[2][4];
    zero_acc<2>(ay);
#pragma unroll 2
    for (int ks = 0; ks < 8; ks++) {
      bf16x8 af[2], bfr[4];
#pragma unroll
      for (int i = 0; i < 2; i++) {
        const int row = wm * 32 + i * 16 + fr;
        af[i] = *(const bf16x8*)(sA + row * 512 + (((ks * 4 + fq) ^ (row & 7)) << 4));
      }
#pragma unroll
      for (int j = 0; j < 4; j++) {
        const int row = wn * 64 + j * 16 + fr;
        bfr[j] = *(const bf16x8*)(sB + row * 512 + (((ks * 4 + fq) ^ (row & 7)) << 4));
      }
#pragma unroll
      for (int i = 0; i < 2; i++)
#pragma unroll
        for (int j = 0; j < 4; j++) ay[i][j] = __builtin_amdgcn_mfma_f32_16x16x32_bf16(bfr[j], af[i], ay[i][j], 0, 0, 0);
    }
#pragma unroll
    for (int i = 0; i < 2; i++)
#pragma unroll
      for (int j = 0; j < 4; j++) {
        tot[i][j][0] += __uint_as_float(gv[i][j].x << 16) * ay[i][j][0];
        tot[i][j][1] += __uint_as_float(gv[i][j].x & 0xffff0000u) * ay[i][j][1];
        tot[i][j][2] += __uint_as_float(gv[i][j].y << 16) * ay[i][j][2];
        tot[i][j][3] += __uint_as_float(gv[i][j].y & 0xffff0000u) * ay[i][j][3];
      }
    if (k == 3) {
#pragma unroll
      for (int i = 0; i < 2; i++)
#pragma unroll
        for (int j = 0; j < 4; j++) {
          uint2 ov;
          ov.x = pack2(tot[i][j][0], tot[i][j][1]); ov.y = pack2(tot[i][j][2], tot[i][j][3]);
          *(uint2*)(ACC + (size_t)(r0 + i * 16) * DM + c0 + j * 16) = ov;
        }
      zero_acc<2>(tot);
    }
  }
  __syncthreads();
#undef YP_TILE
}

#define S2_BUF 10816
#define S2_D 0
#define S2_U 2048
#define S2_P 4096
#define S2_K 6144
#define S2_DQ 8192
#define S2_V 10240
#define S2_C1 10752
#define S2_C2 10784
#define S2_ST (2 * S2_BUF)
#define S2_YB (S2_ST + 8192)

__device__ __forceinline__ float red16(float x) {
  x += dppf<0xB1>(x);
  x += dppf<0x4E>(x);
  x += dppf<0x141>(x);
  x += dppf<0x140>(x);
  return x;
}
__device__ __forceinline__ void wave_lds_sync() {
  asm volatile("s_waitcnt lgkmcnt(0)" ::: "memory");
  __builtin_amdgcn_wave_barrier();
}

template <int MIX>
__device__ __forceinline__ void scan2_item(const Params& p, int l, int b, int h, int dir, int rq, float* sm) {
  constexpr int EPL = (MIX == 2) ? 2 : 4;
  constexpr int VOFF = (MIX == 2) ? 64 : 128;
  const int tid = TIDX, lane = tid & 63, w = tid >> 6, fr = lane & 15, fq = lane >> 4;
  const bool producer = w >= 4;
  const int pw = w & 3;
  const u16* P = (const u16*)(p.ws + OFF_BIG);
  u16* YS = (u16*)(p.ws + OFF_YS);
  float* BC = (float*)(p.ws + OFF_BC);
  float* ST = sm + S2_ST + pw * 2048;
  float s[EPL];
#pragma unroll
  for (int i = 0; i < EPL; i++) s[i] = 0.f;

  bf16x8 bw2[4], ba2[4];
  float cst[5][4];
  float cw[3][7];
  float muv[4];
  int colv[4];
#pragma unroll
  for (int i = 0; i < 4; i++) { bw2[i] = bf16x8{0, 0, 0, 0, 0, 0, 0, 0}; ba2[i] = bw2[i]; muv[i] = 0.f; colv[i] = 0; }
  if (producer) {
    if (MIX == 0) {
#pragma unroll
      for (int nt = 0; nt < 4; nt++) {
        const int jch = h * 64 + nt * 16 + fr;
#pragma unroll
        for (int jj = 0; jj < 8; jj++) {
          bw2[nt][jj] = (short)f2bf(p.rwkv_w2[((size_t)(l * 2 + dir) * 32 + fq * 8 + jj) * 256 + jch]);
          ba2[nt][jj] = (short)f2bf(p.rwkv_a2[((size_t)(l * 2 + dir) * 32 + fq * 8 + jj) * 256 + jch]);
        }
        cst[0][nt] = p.rwkv_w0[(l * 2 + dir) * 256 + jch];
        cst[1][nt] = p.rwkv_a0[(l * 2 + dir) * 256 + jch];
        cst[2][nt] = p.rwkv_ka[l * 256 + jch];
        cst[3][nt] = p.rwkv_kk[l * 256 + jch];
        cst[4][nt] = p.rwkv_rk[l * 256 + jch];
      }
#pragma unroll
      for (int i = 0; i < 4; i++) {
        const int c = lane + 64 * i;
        colv[i] = i < 3 ? i * 256 + h * 64 + lane : (lane < 32 ? 768 + dir * 32 + lane : 832 + dir * 32 + (lane - 32));
        muv[i] = p.rwkv_mu[l * 960 + colv[i]];
        (void)c;
      }
    } else if (MIX == 1) {
#pragma unroll
      for (int i = 0; i < 3; i++) {
        colv[i] = PB + i * 256 + h * 64 + lane;
#pragma unroll
        for (int tp = 0; tp < 7; tp++) cw[i][tp] = p.gdn_conv[((size_t)l * 7 + tp) * 768 + i * 256 + h * 64 + lane];
      }
    } else {
#pragma unroll
      for (int nt = 0; nt < 2; nt++) {
#pragma unroll
        for (int jj = 0; jj < 8; jj++)
          bw2[nt][jj] = fq < 2 ? (short)f2bf(p.gla_gw2[((size_t)(l * 2 + dir) * 16 + fq * 8 + jj) * 128 + h * 32 + nt * 16 + fr]) : (short)0;
        cst[0][nt] = p.gla_gb[(l * 2 + dir) * 128 + h * 32 + nt * 16 + fr];
      }
      colv[0] = PC + h * 32 + lane;
      if (lane >= 32) colv[0] = PC + 128 + h * 32 + (lane - 32);
      colv[1] = PC + 256 + h * 64 + lane;
      colv[2] = PC + 512 + dir * 16 + (lane & 15);
    }
  }
  __syncthreads();

  for (int c = 0; c <= TPB / 32 + 1; c++) {
    if (producer) {
      if (c >= 2) {
        const int cc = c - 2;
        int seg_row0, t_lo;
        if (cc < 8) { seg_row0 = b * TPB; t_lo = dir == 0 ? cc * 32 : (LC - 32 - cc * 32); }
        else { seg_row0 = b * TPB + LC; t_lo = dir == 0 ? (cc - 8) * 32 : (SEQ - 32 - (cc - 8) * 32); }
        const float* yb = sm + S2_YB + (cc & 1) * 512;
        const int t2 = tid - 256;
#pragma unroll
        for (int i = 0; i < 2; i++) {
          const int idx = t2 + i * 256, tt = idx >> 4, e = idx & 15;
          YS[(size_t)(seg_row0 + t_lo + tt) * YST + dir * 768 + MIX * 256 + h * 64 + rq * 16 + e] = f2bf(yb[idx]);
        }
      }
      if (c < TPB / 32) {
        int seg_row0, seg_len, t_lo;
        if (c < 8) { seg_row0 = b * TPB; seg_len = LC; t_lo = dir == 0 ? c * 32 : (LC - 32 - c * 32); }
        else { seg_row0 = b * TPB + LC; seg_len = SEQ; t_lo = dir == 0 ? (c - 8) * 32 : (SEQ - 32 - (c - 8) * 32); }
        const u16* Pseg = P + (size_t)seg_row0 * PST;
        float* B = sm + (c & 1) * S2_BUF;
        const int t0 = t_lo + pw * 8;
        if (MIX == 0) {
          float raw[10][4];
#pragma unroll
          for (int rr = 0; rr < 10; rr++) {
            const int t = t0 - 1 + rr;
            const float okf = (t >= 0 && t < seg_len) ? 1.f : 0.f;
            const int tc = min(max(t, 0), seg_len - 1);
#pragma unroll
            for (int i = 0; i < 4; i++) raw[rr][i] = bf2f(Pseg[(size_t)tc * PST + PA + colv[i]]) * okf;
          }
#pragma unroll
          for (int j = 0; j < 8; j++)
#pragma unroll
            for (int i = 0; i < 4; i++) {
              float xm = raw[j + 1][i] + (0.5f * (raw[j][i] + raw[j + 2][i]) - raw[j + 1][i]) * muv[i];
              if (i == 3 && lane < 32) xm = tanh_fast(xm);
              ST[j * 256 + lane + 64 * i] = xm;
            }
        } else if (MIX == 1) {
          float raw[14][3];
#pragma unroll
          for (int rr = 0; rr < 14; rr++) {
            const int t = t0 - 3 + rr;
            const float okf = (t >= 0 && t < seg_len) ? 1.f : 0.f;
            const int tc = min(max(t, 0), seg_len - 1);
#pragma unroll
            for (int i = 0; i < 3; i++) raw[rr][i] = bf2f(Pseg[(size_t)tc * PST + colv[i]]) * okf;
          }
#pragma unroll
          for (int j = 0; j < 8; j++)
#pragma unroll
            for (int i = 0; i < 3; i++) {
              float a = 0.f;
#pragma unroll
              for (int tp = 0; tp < 7; tp++) a += raw[j + tp][i] * cw[i][tp];
              ST[j * 256 + lane + 64 * i] = siluf(a);
            }
          if (lane < 8) {
            const u16* pp = Pseg + (size_t)(t0 + lane) * PST + PB;
            float bx = bf2f(pp[768 + dir * 4 + h]);
            float ax = bf2f(pp[776 + dir * 4 + h]);
            float ld = -__expf(p.gdn_a_log[(l * 2 + dir) * 4 + h]) * softplusf(ax + p.gdn_dt_bias[(l * 2 + dir) * 4 + h]);
            ST[lane * 256 + 192] = sigm(bx);
            ST[lane * 256 + 193] = __expf(ld);
          }
        } else {
          u16 raw[8][3];
#pragma unroll
          for (int j = 0; j < 8; j++) {
            const u16* pp = Pseg + (size_t)(t0 + j) * PST;
#pragma unroll
            for (int i = 0; i < 3; i++) raw[j][i] = pp[colv[i]];
          }
          const float qs = lane < 32 ? 0.17677669529663687f : 1.f;
#pragma unroll
          for (int j = 0; j < 8; j++) {
            ST[j * 256 + lane] = bf2f(raw[j][0]) * qs;
            ST[j * 256 + 64 + lane] = bf2f(raw[j][1]);
            if (lane < 16) ST[j * 256 + 128 + lane] = bf2f(raw[j][2]);
          }
        }
        wave_lds_sync();
        const bool vl = fq < 2;
        if (MIX == 0) {
          bf16x8 aw, aa;
#pragma unroll
          for (int jj = 0; jj < 8; jj++) {
            aw[jj] = fr < 8 ? (short)f2bf(ST[fr * 256 + 192 + fq * 8 + jj]) : (short)0;
            aa[jj] = fr < 8 ? (short)f2bf(ST[fr * 256 + 224 + fq * 8 + jj]) : (short)0;
          }
          f32x4 accw[4], acca[4];
#pragma unroll
          for (int nt = 0; nt < 4; nt++) {
            accw[nt] = __builtin_amdgcn_mfma_f32_16x16x32_bf16(aw, bw2[nt], f32x4{0.f, 0.f, 0.f, 0.f}, 0, 0, 0);
            acca[nt] = __builtin_amdgcn_mfma_f32_16x16x32_bf16(aa, ba2[nt], f32x4{0.f, 0.f, 0.f, 0.f}, 0, 0, 0);
          }
#pragma unroll
          for (int r = 0; r < 4; r++) {
            const int j = (fq & 1) * 4 + r, tt = pw * 8 + j;
            float kkx[4], av[4], kdv[4], rv[4], dec[4];
            float ss = 0.f;
#pragma unroll
            for (int nt = 0; nt < 4; nt++) {
              const int n = nt * 16 + fr;
              rv[nt] = ST[j * 256 + n];
              const float kx = ST[j * 256 + 64 + n];
              dec[nt] = __expf(-0.6065306597126334f * sigm(cst[0][nt] + accw[nt][r]));
              av[nt] = sigm(cst[1][nt] + acca[nt][r]);
              kdv[nt] = kx * (1.f + (av[nt] - 1.f) * cst[2][nt]);
              kkx[nt] = kx * cst[3][nt];
              ss += kkx[nt] * kkx[nt];
            }
            ss = red16(ss);
            const float rs = rsq(ss + 1e-6f);
            float c1 = 0.f, c2 = 0.f, bc = 0.f;
#pragma unroll
            for (int nt = 0; nt < 4; nt++) {
              const int n = nt * 16 + fr;
              const float kk = kkx[nt] * rs;
              if (vl) {
                B[S2_D + tt * 64 + n] = dec[nt];
                B[S2_U + tt * 64 + n] = kk;
                B[S2_P + tt * 64 + n] = -kk * av[nt];
                B[S2_K + tt * 64 + n] = kdv[nt];
                B[S2_DQ + tt * 64 + n] = dec[nt] * rv[nt];
              }
              c1 += -kk * av[nt] * rv[nt];
              c2 += kdv[nt] * rv[nt];
              bc += rv[nt] * kdv[nt] * cst[4][nt];
            }
            c1 = red16(c1); c2 = red16(c2); bc = red16(bc);
            if (vl && fr == 0) {
              B[S2_C1 + tt] = c1;
              B[S2_C2 + tt] = c2;
              if (rq == 0) BC[(size_t)(seg_row0 + t_lo + tt) * 8 + h * 2 + dir] = bc;
            }
          }
        } else if (MIX == 1) {
#pragma unroll
          for (int r = 0; r < 4; r++) {
            const int j = (fq & 1) * 4 + r, tt = pw * 8 + j;
            float qv[4], kv[4];
            float sq = 0.f, sk = 0.f;
#pragma unroll
            for (int nt = 0; nt < 4; nt++) {
              const int n = nt * 16 + fr;
              qv[nt] = ST[j * 256 + n];
              kv[nt] = ST[j * 256 + 64 + n];
              sq += qv[nt] * qv[nt];
              sk += kv[nt] * kv[nt];
            }
            sq = red16(sq); sk = red16(sk);
            const float rq_ = rsq(sq + 1e-6f) * 0.125f, rk_ = rsq(sk + 1e-6f);
            const float beta = ST[j * 256 + 192], alpha = ST[j * 256 + 193];
            float dkq = 0.f;
#pragma unroll
            for (int nt = 0; nt < 4; nt++) {
              const int n = nt * 16 + fr;
              const float qn = qv[nt] * rq_, kn = kv[nt] * rk_;
              if (vl) {
                B[S2_D + tt * 64 + n] = alpha;
                B[S2_U + tt * 64 + n] = kn;
                B[S2_P + tt * 64 + n] = -alpha * beta * kn;
                B[S2_K + tt * 64 + n] = beta * kn;
                B[S2_DQ + tt * 64 + n] = alpha * qn;
              }
              dkq += kn * qn;
            }
            dkq = red16(dkq);
            if (vl && fr == 0) {
              B[S2_C1 + tt] = -alpha * beta * dkq;
              B[S2_C2 + tt] = beta * dkq;
            }
          }
        } else {
          bf16x8 ag;
#pragma unroll
          for (int jj = 0; jj < 8; jj++) ag[jj] = (fr < 8 && fq < 2) ? (short)f2bf(ST[fr * 256 + 128 + fq * 8 + jj]) : (short)0;
          f32x4 accg[2];
#pragma unroll
          for (int nt = 0; nt < 2; nt++) accg[nt] = __builtin_amdgcn_mfma_f32_16x16x32_bf16(ag, bw2[nt], f32x4{0.f, 0.f, 0.f, 0.f}, 0, 0, 0);
#pragma unroll
          for (int r = 0; r < 4; r++) {
            const int j = (fq & 1) * 4 + r, tt = pw * 8 + j;
            float dkq = 0.f;
#pragma unroll
            for (int nt = 0; nt < 2; nt++) {
              const int n = nt * 16 + fr;
              const float lg = cst[0][nt] + accg[nt][r];
              const float ls = fminf(lg, 0.f) - __logf(1.f + __expf(-fabsf(lg)));
              const float alpha = __expf(ls * (1.f / 16.f));
              const float qv = ST[j * 256 + n], kv = ST[j * 256 + 32 + n];
              if (vl) {
                B[S2_D + tt * 64 + n] = alpha;
                B[S2_K + tt * 64 + n] = kv;
                B[S2_DQ + tt * 64 + n] = alpha * qv;
              }
              dkq += kv * qv;
            }
            dkq = red16(dkq);
            if (vl && fr == 0) B[S2_C2 + tt] = dkq;
          }
        }
#pragma unroll
        for (int i = 0; i < 2; i++) {
          const int idx = lane + 64 * i, j = idx >> 4, e = idx & 15;
          B[S2_V + (pw * 8 + j) * 16 + e] = ST[j * 256 + VOFF + rq * 16 + e];
        }
      }
    } else if (c >= 1 && c <= TPB / 32) {
      const float* B = sm + ((c - 1) & 1) * S2_BUF;
      float* yb = sm + S2_YB + ((c - 1) & 1) * 512;
      const int rl = w * 4 + fq;
      const int dtt = dir ? -1 : 1;
      int tt = dir ? 31 : 0;
      float dv[EPL], kv[EPL], qv[EPL], uv[EPL], pv[EPL], vv, c1v, c2v;
      float dn[EPL], kn[EPL], qn[EPL], un[EPL], pn[EPL], vn, c1n, c2n;
#define S2_LOAD(D_, K_, Q_, U_, P_, V_, C1_, C2_, T_)                                   \
  do {                                                                                  \
    const int o_ = (T_) * 64 + fr * EPL;                                                \
    if (EPL == 4) {                                                                     \
      float4 t4 = *(const float4*)(B + S2_D + o_);                                      \
      D_[0] = t4.x; D_[1] = t4.y; D_[2] = t4.z; D_[3] = t4.w;                           \
      t4 = *(const float4*)(B + S2_K + o_);                                             \
      K_[0] = t4.x; K_[1] = t4.y; K_[2] = t4.z; K_[3] = t4.w;                           \
      t4 = *(const float4*)(B + S2_DQ + o_);                                            \
      Q_[0] = t4.x; Q_[1] = t4.y; Q_[2] = t4.z; Q_[3] = t4.w;                           \
      t4 = *(const float4*)(B + S2_U + o_);                                             \
      U_[0] = t4.x; U_[1] = t4.y; U_[2] = t4.z; U_[3] = t4.w;                           \
      t4 = *(const float4*)(B + S2_P + o_);                                             \
      P_[0] = t4.x; P_[1] = t4.y; P_[2] = t4.z; P_[3] = t4.w;                           \
      C1_ = B[S2_C1 + (T_)];                                                            \
    } else {                                                                            \
      float2 t2 = *(const float2*)(B + S2_D + o_);                                      \
      D_[0] = t2.x; D_[1] = t2.y;                                                       \
      t2 = *(const float2*)(B + S2_K + o_);                                             \
      K_[0] = t2.x; K_[1] = t2.y;                                                       \
      t2 = *(const float2*)(B + S2_DQ + o_);                                            \
      Q_[0] = t2.x; Q_[1] = t2.y;                                                       \
      U_[0] = U_[1] = P_[0] = P_[1] = 0.f; C1_ = 0.f;                                   \
    }                                                                                   \
    V_ = B[S2_V + (T_) * 16 + rl];                                                      \
    C2_ = B[S2_C2 + (T_)];                                                              \
  } while (0)
#define S2_STEP(D_, K_, Q_, U_, P_, V_, C1_, C2_, T_)                                   \
  do {                                                                                  \
    float sq = 0.f, sa = 0.f;                                                           \
    _Pragma("unroll") for (int i = 0; i < EPL; i++) sq += s[i] * Q_[i];                 \
    if (MIX != 2) {                                                                     \
      _Pragma("unroll") for (int i = 0; i < EPL; i++) sa += s[i] * U_[i];               \
      sa = red16(sa);                                                                   \
    }                                                                                   \
    sq = red16(sq);                                                                     \
    float y = sq + V_ * C2_;                                                            \
    if (MIX != 2) y += sa * C1_;                                                        \
    _Pragma("unroll") for (int i = 0; i < EPL; i++) {                                   \
      float t = s[i] * D_[i] + V_ * K_[i];                                              \
      if (MIX != 2) t += sa * P_[i];                                                    \
      s[i] = t;                                                                         \
    }                                                                                   \
    yb[(T_) * 16 + rl] = y;                                                             \
  } while (0)
      S2_LOAD(dv, kv, qv, uv, pv, vv, c1v, c2v, tt);
#pragma unroll 1
      for (int st = 0; st < 32; st += 2) {
        const int t1 = tt + dtt;
        S2_LOAD(dn, kn, qn, un, pn, vn, c1n, c2n, t1);
        S2_STEP(dv, kv, qv, uv, pv, vv, c1v, c2v, tt);
        const int t2 = st + 2 < 32 ? t1 + dtt : t1;
        S2_LOAD(dv, kv, qv, uv, pv, vv, c1v, c2v, t2);
        S2_STEP(dn, kn, qn, un, pn, vn, c1n, c2n, t1);
        tt = t2;
      }
#undef S2_LOAD
#undef S2_STEP
    }
    __syncthreads();
  }
}

#define S3_SUB 12800
#define S3_GM 0
#define S3_KVT 9216
#define S3_QB 10240
#define S3_QV 11392
#define S3_VT 11520
#define S3_WC 12544
#define S3_TB S3_QV
#define S3_QBM (S3_GM + 3072)
#define S3_QKM (S3_GM + 3200)
#define S3_KB (S3_GM + 0)
#define S3_BT (S3_GM + 2048)
#define S3_STB (8 * S3_SUB)
#define S3_END (S3_STB + 4 * 2304)

__device__ __forceinline__ float rlane(float x, int l) { return __int_as_float(__builtin_amdgcn_readlane(__float_as_int(x), l)); }
__device__ __forceinline__ float wave_sum(float x) {
  x = red16(x);
  return (rlane(x, 0) + rlane(x, 16)) + (rlane(x, 32) + rlane(x, 48));
}
__device__ __forceinline__ float clampe(float x) { return fminf(fmaxf(x, -80.f), 80.f); }
__device__ __forceinline__ uint4 pack8(const float (&v)[8]) {
  return make_uint4(pack2(v[0], v[1]), pack2(v[2], v[3]), pack2(v[4], v[5]), pack2(v[6], v[7]));
}
__device__ __forceinline__ bf16x8 ld_frag(const void* p) { return *(const bf16x8*)p; }
__device__ __forceinline__ bf16x8 zfrag() { return bf16x8{0, 0, 0, 0, 0, 0, 0, 0}; }

__device__ __forceinline__ void chunk_geom(int c, int dir, int b, int& seg_row0, int& seg_len, int& t_lo) {
  if (c < 8) { seg_row0 = b * TPB; seg_len = LC; t_lo = dir == 0 ? c * 32 : (LC - 32 - c * 32); }
  else { seg_row0 = b * TPB + LC; seg_len = SEQ; t_lo = dir == 0 ? (c - 8) * 32 : (SEQ - 32 - (c - 8) * 32); }
}
template <int MIX>
__device__ __forceinline__ void fetch_raw(const u16* P, int c, int dir, int b, int h, int pw, int lane, const int (&colv)[4], unsigned (&rawq)[14][2]) {
  int seg_row0, seg_len, t_lo;
  chunk_geom(c, dir, b, seg_row0, seg_len, t_lo);
  const u16* Pseg = P + (size_t)seg_row0 * PST;
  const int t0 = t_lo + pw * 8;
  if (MIX == 0) {
#pragma unroll
    for (int rr = 0; rr < 10; rr++) {
      const int tc = min(max(t0 - 1 + rr, 0), seg_len - 1);
#pragma unroll
      for (int i = 0; i < 2; i++)
        rawq[rr][i] = (unsigned)Pseg[(size_t)tc * PST + PA + colv[2 * i]] | ((unsigned)Pseg[(size_t)tc * PST + PA + colv[2 * i + 1]] << 16);
    }
  } else if (MIX == 1) {
#pragma unroll
    for (int rr = 0; rr < 14; rr++) {
      const int tc = min(max(t0 - 3 + rr, 0), seg_len - 1);
      rawq[rr][0] = (unsigned)Pseg[(size_t)tc * PST + colv[0]] | ((unsigned)Pseg[(size_t)tc * PST + colv[1]] << 16);
      rawq[rr][1] = (rawq[rr][1] & 0xffff0000u) | (unsigned)Pseg[(size_t)tc * PST + colv[2]];
    }
    const u16* pp = Pseg + (size_t)(t0 + (lane & 7)) * PST + PB;
    rawq[0][1] = (rawq[0][1] & 0xffffu) | ((unsigned)pp[768 + dir * 4 + h] << 16);
    rawq[1][1] = (rawq[1][1] & 0xffffu) | ((unsigned)pp[776 + dir * 4 + h] << 16);
  } else {
#pragma unroll
    for (int j = 0; j < 8; j++) {
      const u16* pp = Pseg + (size_t)(t0 + j) * PST;
      rawq[j][0] = (unsigned)pp[colv[0]] | ((unsigned)pp[colv[1]] << 16);
      rawq[j][1] = (unsigned)pp[colv[2]];
    }
  }
}

template <int MIX>
__device__ __forceinline__ void scan3_item(const Params& p, int l, int b, int h, int dir, unsigned char* smb) {
  constexpr int VOFF = (MIX == 2) ? 64 : 128;
  constexpr bool DELTA = (MIX != 2);
  const int tid = TIDX, lane = tid & 63, w = tid >> 6, fr = lane & 15, fq = lane >> 4;
  const bool producer = true;
  const int pw = w & 3, half = w >> 2;
  const u16* P = (const u16*)(p.ws + OFF_BIG);
  u16* YS = (u16*)(p.ws + OFF_YS);
  float* BC = (float*)(p.ws + OFF_BC);
  float* ST = (float*)(smb + w * S3_SUB + S3_GM);
  unsigned char* STBY = smb + w * S3_SUB + S3_GM;
  const f32x4 z4 = f32x4{0.f, 0.f, 0.f, 0.f};
  f32x4 st[4];
#pragma unroll
  for (int i = 0; i < 4; i++) st[i] = z4;

  bf16x8 bw2[4], ba2[4];
  float cw[3][7];
  float muv[4];
  int colv[4];
  float c_w0 = 0.f, c_a0 = 0.f, c_ka = 0.f, c_kk = 0.f, c_rk = 0.f, c_gb = 0.f;
#pragma unroll
  for (int i = 0; i < 4; i++) { bw2[i] = zfrag(); ba2[i] = zfrag(); muv[i] = 0.f; colv[i] = 0; }
  if (producer) {
    if (MIX == 0) {
      {
        float tw[4][8], ta[4][8];
#pragma unroll
        for (int nt = 0; nt < 4; nt++)
#pragma unroll
          for (int jj = 0; jj < 8; jj++) {
            tw[nt][jj] = p.rwkv_w2[((size_t)(l * 2 + dir) * 32 + fq * 8 + jj) * 256 + h * 64 + nt * 16 + fr];
            ta[nt][jj] = p.rwkv_a2[((size_t)(l * 2 + dir) * 32 + fq * 8 + jj) * 256 + h * 64 + nt * 16 + fr];
          }
#pragma unroll
        for (int nt = 0; nt < 4; nt++)
#pragma unroll
          for (int jj = 0; jj < 8; jj++) { bw2[nt][jj] = (short)f2bf(tw[nt][jj]); ba2[nt][jj] = (short)f2bf(ta[nt][jj]); }
      }
      const int jl = h * 64 + lane;
      c_w0 = p.rwkv_w0[(l * 2 + dir) * 256 + jl];
      c_a0 = p.rwkv_a0[(l * 2 + dir) * 256 + jl];
      c_ka = p.rwkv_ka[l * 256 + jl];
      c_kk = p.rwkv_kk[l * 256 + jl];
      c_rk = p.rwkv_rk[l * 256 + jl];
#pragma unroll
      for (int i = 0; i < 4; i++) {
        colv[i] = i < 3 ? i * 256 + h * 64 + lane : (lane < 32 ? 768 + dir * 32 + lane : 832 + dir * 32 + (lane - 32));
        muv[i] = p.rwkv_mu[l * 960 + colv[i]];
      }
    } else if (MIX == 1) {
#pragma unroll
      for (int i = 0; i < 3; i++) {
        colv[i] = PB + i * 256 + h * 64 + lane;
#pragma unroll
        for (int tp = 0; tp < 7; tp++) cw[i][tp] = p.gdn_conv[((size_t)l * 7 + tp) * 768 + i * 256 + h * 64 + lane];
      }
    } else {
      {
        float tg[2][8];
#pragma unroll
        for (int nt = 0; nt < 2; nt++)
#pragma unroll
          for (int jj = 0; jj < 8; jj++) tg[nt][jj] = p.gla_gw2[((size_t)(l * 2 + dir) * 16 + (fq & 1) * 8 + jj) * 128 + h * 32 + nt * 16 + fr];
#pragma unroll
        for (int nt = 0; nt < 2; nt++)
#pragma unroll
          for (int jj = 0; jj < 8; jj++) bw2[nt][jj] = fq < 2 ? (short)f2bf(tg[nt][jj]) : (short)0;
      }
      c_gb = p.gla_gb[(l * 2 + dir) * 128 + h * 32 + (lane & 31)];
      colv[0] = PC + h * 32 + lane;
      if (lane >= 32) colv[0] = PC + 128 + h * 32 + (lane - 32);
      colv[1] = PC + 256 + h * 64 + lane;
      colv[2] = PC + 512 + dir * 16 + (lane & 15);
    }
  }
  __syncthreads();
  unsigned rawq[14][2];
#pragma unroll
  for (int i = 0; i < 14; i++) { rawq[i][0] = 0u; rawq[i][1] = 0u; }
  fetch_raw<MIX>(P, half, dir, b, h, pw, lane, colv, rawq);
#define RAWP(r_, i_) ((u16)((rawq[r_][(i_) >> 1] >> (((i_) & 1) * 16)) & 0xffffu))

  for (int it = 0; it < TPB / 64; it++) {
    {
      {
        const int c = it * 2 + half;
        int seg_row0, seg_len, t_lo;
        chunk_geom(c, dir, b, seg_row0, seg_len, t_lo);
        unsigned char* SB = smb + w * S3_SUB;
        const int t0 = t_lo + pw * 8;
        if (MIX == 0) {
          float raw[10][4];
#pragma unroll
          for (int rr = 0; rr < 10; rr++) {
            const int t = t0 - 1 + rr;
            const float okf = (t >= 0 && t < seg_len) ? 1.f : 0.f;
#pragma unroll
            for (int i = 0; i < 4; i++) raw[rr][i] = bf2f(RAWP(rr, i)) * okf;
          }
#pragma unroll
          for (int j = 0; j < 8; j++)
#pragma unroll
            for (int i = 0; i < 4; i++) {
              float xm = raw[j + 1][i] + (0.5f * (raw[j][i] + raw[j + 2][i]) - raw[j + 1][i]) * muv[i];
              if (i == 3 && lane < 32) xm = tanh_fast(xm);
              ST[j * 256 + lane + 64 * i] = xm;
            }
        } else if (MIX == 1) {
          float raw[14][3];
#pragma unroll
          for (int rr = 0; rr < 14; rr++) {
            const int t = t0 - 3 + rr;
            const float okf = (t >= 0 && t < seg_len) ? 1.f : 0.f;
#pragma unroll
            for (int i = 0; i < 3; i++) raw[rr][i] = bf2f(RAWP(rr, i)) * okf;
          }
#pragma unroll
          for (int j = 0; j < 8; j++)
#pragma unroll
            for (int i = 0; i < 3; i++) {
              float a = 0.f;
#pragma unroll
              for (int tp = 0; tp < 7; tp++) a += raw[j + tp][i] * cw[i][tp];
              ST[j * 256 + lane + 64 * i] = siluf(a);
            }
          if (lane < 8) {
            float bx = bf2f(RAWP(0, 3));
            float ax = bf2f(RAWP(1, 3));
            float ld = -__expf(p.gdn_a_log[(l * 2 + dir) * 4 + h]) * softplusf(ax + p.gdn_dt_bias[(l * 2 + dir) * 4 + h]);
            ST[lane * 256 + 192] = sigm(bx);
            ST[lane * 256 + 193] = ld;
          }
        } else {
          const float qs = lane < 32 ? 0.17677669529663687f : 1.f;
#pragma unroll
          for (int j = 0; j < 8; j++) {
            ST[j * 256 + lane] = bf2f(RAWP(j, 0)) * qs;
            ST[j * 256 + 64 + lane] = bf2f(RAWP(j, 1));
            if (lane < 16) ST[j * 256 + 128 + lane] = bf2f(RAWP(j, 2));
          }
        }
        wave_lds_sync();
        {
          float vv[8];
#pragma unroll
          for (int i = 0; i < 8; i++) vv[i] = ST[(dir ? 7 - i : i) * 256 + VOFF + lane];
          *(uint4*)(SB + S3_VT + lane * 16) = pack8(vv);
        }
        if (MIX == 0) {
          bf16x8 aw, aa;
#pragma unroll
          for (int jj = 0; jj < 8; jj++) {
            aw[jj] = fr < 8 ? (short)f2bf(ST[fr * 256 + 192 + fq * 8 + jj]) : (short)0;
            aa[jj] = fr < 8 ? (short)f2bf(ST[fr * 256 + 224 + fq * 8 + jj]) : (short)0;
          }
          f32x4 accw[4], acca[4];
#pragma unroll
          for (int nt = 0; nt < 4; nt++) {
            accw[nt] = __builtin_amdgcn_mfma_f32_16x16x32_bf16(aw, bw2[nt], z4, 0, 0, 0);
            acca[nt] = __builtin_amdgcn_mfma_f32_16x16x32_bf16(aa, ba2[nt], z4, 0, 0, 0);
          }
          wave_lds_sync();
          if (fq < 2) {
#pragma unroll
            for (int nt = 0; nt < 4; nt++)
#pragma unroll
              for (int r = 0; r < 4; r++) {
                ST[(fq * 4 + r) * 256 + 128 + nt * 16 + fr] = accw[nt][r];
                ST[(fq * 4 + r) * 256 + 192 + nt * 16 + fr] = acca[nt][r];
              }
          }
          wave_lds_sync();
        } else if (MIX == 2) {
          bf16x8 ag;
#pragma unroll
          for (int jj = 0; jj < 8; jj++) ag[jj] = (fr < 8 && fq < 2) ? (short)f2bf(ST[fr * 256 + 128 + fq * 8 + jj]) : (short)0;
          f32x4 accg[2];
#pragma unroll
          for (int nt = 0; nt < 2; nt++) accg[nt] = __builtin_amdgcn_mfma_f32_16x16x32_bf16(ag, bw2[nt], z4, 0, 0, 0);
          if (fq < 2) {
#pragma unroll
            for (int nt = 0; nt < 2; nt++)
#pragma unroll
              for (int r = 0; r < 4; r++) ST[(fq * 4 + r) * 256 + 192 + nt * 16 + fr] = accg[nt][r];
          }
          wave_lds_sync();
        }
        float logd[8], kap[8], bb[8], kp[8], qq[8];
        if (MIX == 0) {
          float a8[8], p1[8], p2[8];
#pragma unroll
          for (int i = 0; i < 8; i++) {
            const float* row = ST + (dir ? 7 - i : i) * 256;
            const float r_ = row[lane], k_ = row[64 + lane];
            const float sg = sigm(c_w0 + row[128 + lane]);
            a8[i] = sigm(c_a0 + row[192 + lane]);
            kp[i] = k_ * (1.f + (a8[i] - 1.f) * c_ka);
            kap[i] = k_ * c_kk;
            qq[i] = r_;
            logd[i] = -0.6065306597126334f * sg;
            p1[i] = kap[i] * kap[i];
            p2[i] = r_ * kp[i] * c_rk;
          }
#pragma unroll
          for (int i = 0; i < 8; i++) { p1[i] = red16(p1[i]); p2[i] = red16(p2[i]); }
#pragma unroll
          for (int i = 0; i < 8; i++) {
            const float ss = (rlane(p1[i], 0) + rlane(p1[i], 16)) + (rlane(p1[i], 32) + rlane(p1[i], 48));
            const float bc = (rlane(p2[i], 0) + rlane(p2[i], 16)) + (rlane(p2[i], 32) + rlane(p2[i], 48));
            kap[i] *= rsq(ss + 1e-6f);
            bb[i] = kap[i] * a8[i];
            if (lane == 0) BC[(size_t)(seg_row0 + t0 + (dir ? 7 - i : i)) * 8 + h * 2 + dir] = bc;
          }
        } else {
#pragma unroll
        for (int i = 0; i < 8; i++) {
          const int j = dir ? 7 - i : i;
          const float* row = ST + j * 256;
          if (MIX == 1) {
            const float q_ = row[lane], k_ = row[64 + lane];
            const float sq = wave_sum(q_ * q_), sk = wave_sum(k_ * k_);
            const float qn = q_ * rsq(sq + 1e-6f) * 0.125f, kn = k_ * rsq(sk + 1e-6f);
            const float beta = row[192], ld = row[193];
            const float alpha = __expf(ld);
            logd[i] = ld;
            kap[i] = kn; bb[i] = alpha * beta * kn; kp[i] = beta * kn; qq[i] = qn;
          } else {
            const int n = lane & 31;
            const float lg = c_gb + row[192 + n];
            const float ls = fminf(lg, 0.f) - __logf(1.f + __expf(-fabsf(lg)));
            logd[i] = ls * (1.f / 16.f);
            kap[i] = 0.f; bb[i] = 0.f;
            kp[i] = lane < 32 ? row[32 + n] : 0.f;
            qq[i] = lane < 32 ? row[n] : 0.f;
          }
        }
        }
        wave_lds_sync();
        float kt[8], qt[8], bck[8], kck[8];
        {
          float L[8];
          float run = 0.f;
#pragma unroll
          for (int i = 0; i < 8; i++) { run += logd[i]; L[i] = run; }
          const float Lr = L[3], L7 = L[7];
          float prevE = __expf(clampe(-Lr)), prevT = 1.f;
          u16* OPA = (u16*)STBY;
#pragma unroll
          for (int i = 0; i < 8; i++) {
            const float eI = __expf(clampe(L[i] - Lr)), eInv = __expf(clampe(Lr - L[i]));
            const float tI = __expf(L[i]), eEnd = __expf(L7 - L[i]);
            if (DELTA) {
              OPA[0 * 576 + i * 72 + lane] = f2bf(kap[i] * prevE);
              OPA[1 * 576 + i * 72 + lane] = f2bf(bb[i] * eInv);
            }
            OPA[2 * 576 + i * 72 + lane] = f2bf(kp[i] * eInv);
            OPA[3 * 576 + i * 72 + lane] = f2bf(qq[i] * eI);
            kt[i] = kap[i] * prevT; qt[i] = qq[i] * tI;
            bck[i] = bb[i] * eEnd; kck[i] = kp[i] * eEnd;
            prevE = eI; prevT = tI;
          }
          *(float*)(SB + S3_WC + lane * 4) = __expf(L7);
        }
        wave_lds_sync();
        f32x4 accA = z4, accBm = z4, accQb = z4, accQk = z4;
        {
          const u16* OPA = (const u16*)STBY;
          const int ro = (fr & 7) * 72 + fq * 8;
#pragma unroll
          for (int ks = 0; ks < 2; ks++) {
            const bf16x8 fk = ld_frag(OPA + 2 * 576 + ro + ks * 32), fqh = ld_frag(OPA + 3 * 576 + ro + ks * 32);
            accQk = __builtin_amdgcn_mfma_f32_16x16x32_bf16(fqh, fk, accQk, 0, 0, 0);
            if (DELTA) {
              const bf16x8 fka = ld_frag(OPA + 0 * 576 + ro + ks * 32), fb = ld_frag(OPA + 1 * 576 + ro + ks * 32);
              accA = __builtin_amdgcn_mfma_f32_16x16x32_bf16(fka, fb, accA, 0, 0, 0);
              accBm = __builtin_amdgcn_mfma_f32_16x16x32_bf16(fka, fk, accBm, 0, 0, 0);
              accQb = __builtin_amdgcn_mfma_f32_16x16x32_bf16(fqh, fb, accQb, 0, 0, 0);
            }
          }
#pragma unroll
          for (int r = 0; r < 4; r++) {
            const int i = fq * 4 + r;
            const bool ok = fq < 2 && fr < 8;
            if (!(ok && fr < i)) { accA[r] = 0.f; accBm[r] = 0.f; }
            if (!(ok && fr <= i)) { accQb[r] = 0.f; accQk[r] = 0.f; }
          }
        }
        *(uint4*)(SB + S3_KVT + lane * 16) = pack8(kck);
#pragma unroll
        for (int i = 0; i < 8; i++) ((u16*)(SB + S3_QB))[i * 72 + lane] = f2bf(qt[i]);
        if (fq < 2 && fr < 8) {
#pragma unroll
          for (int r = 0; r < 4; r++) {
            ((u16*)(SB + S3_QKM))[(fq * 4 + r) * 8 + fr] = f2bf(accQk[r]);
            if (DELTA) ((u16*)(SB + S3_QBM))[(fq * 4 + r) * 8 + fr] = f2bf(accQb[r]);
          }
        }
        if (DELTA) {
          float bmc[8];
#pragma unroll
          for (int m = 0; m < 4; m++) { bmc[m] = accBm[m]; bmc[m + 4] = __shfl(accBm[m], (lane & 15) + 16); }
          float t[8];
#pragma unroll
          for (int i = 0; i < 8; i++) {
            float ti = (lane == i) ? 1.f : 0.f;
#pragma unroll
            for (int m = 0; m < i; m++) ti -= rlane(accA[i & 3], (i >> 2) * 16 + m) * t[m];
            t[i] = ti;
          }
          float kbar[8], TB[8];
#pragma unroll
          for (int i = 0; i < 8; i++) {
            float tb = 0.f, kb = 0.f;
#pragma unroll
            for (int m = 0; m <= i; m++) {
              const float tim = rlane(t[i], m);
              tb += tim * bmc[m];
              kb += tim * kt[m];
            }
            TB[i] = tb; kbar[i] = kb;
          }
#pragma unroll
          for (int i = 0; i < 8; i++) ((u16*)(SB + S3_KB))[i * 72 + lane] = f2bf(-kbar[i]);
          *(uint4*)(SB + S3_BT + lane * 16) = pack8(bck);
          if (lane < 8) {
#pragma unroll
            for (int i = 0; i < 8; i++) ((u16*)(SB + S3_TB))[i * 8 + lane] = f2bf(-TB[i]);
          }
        }
      }
    }
    fetch_raw<MIX>(P, min(it + 1, TPB / 64 - 1) * 2 + half, dir, b, h, pw, lane, colv, rawq);
    __syncthreads();
    if (w < 4) {
      unsigned char* STB = smb + S3_STB + w * 2304;
#pragma unroll 2
      for (int kk = 0; kk < 8; kk++) {
        const int cc = it * 2 + (kk >> 2), k = kk & 3;
        int seg_row0, t_lo;
        if (cc < 8) { seg_row0 = b * TPB; t_lo = dir == 0 ? cc * 32 : (LC - 32 - cc * 32); }
        else { seg_row0 = b * TPB + LC; t_lo = dir == 0 ? (cc - 8) * 32 : (SEQ - 32 - (cc - 8) * 32); }
        const int sc = dir ? 3 - k : k;
        const unsigned char* SB = smb + ((kk >> 2) * 4 + sc) * S3_SUB;
        const bf16x8 bs0 = __builtin_bit_cast(bf16x8, u32x4v{pack2(st[0][0], st[0][1]), pack2(st[0][2], st[0][3]), pack2(st[1][0], st[1][1]), pack2(st[1][2], st[1][3])});
        const bf16x8 bs1 = __builtin_bit_cast(bf16x8, u32x4v{pack2(st[2][0], st[2][1]), pack2(st[2][2], st[2][3]), pack2(st[3][0], st[3][1]), pack2(st[3][2], st[3][3])});
#define LDP(BASE_, ROW_, KS_) ([&]() -> bf16x8 {                                                                   \
          const uint2 lo_ = *(const uint2*)((BASE_) + ((ROW_) * 72 + (KS_) * 32 + fq * 4) * 2);                      \
          const uint2 hi_ = *(const uint2*)((BASE_) + ((ROW_) * 72 + (KS_) * 32 + 16 + fq * 4) * 2);                 \
          return __builtin_bit_cast(bf16x8, u32x4v{lo_.x, lo_.y, hi_.x, hi_.y}); }())
        const bf16x8 bv = fq == 0 ? ld_frag(SB + S3_VT + (w * 16 + fr) * 16) : zfrag();
        const bf16x8 aq0 = LDP(SB + S3_QB, (fr & 7), 0), aq1 = LDP(SB + S3_QB, (fr & 7), 1);
        const bf16x8 aqk = fq == 0 ? ld_frag(SB + S3_QKM + (fr & 7) * 16) : zfrag();
        bf16x8 brv = zfrag();
        if (DELTA) {
          const bf16x8 ak0 = LDP(SB + S3_KB, (fr & 7), 0), ak1 = LDP(SB + S3_KB, (fr & 7), 1);
          const bf16x8 atb = fq == 0 ? ld_frag(SB + S3_TB + (fr & 7) * 16) : zfrag();
          f32x4 accR = __builtin_amdgcn_mfma_f32_16x16x32_bf16(ak0, bs0, z4, 0, 0, 0);
          accR = __builtin_amdgcn_mfma_f32_16x16x32_bf16(ak1, bs1, accR, 0, 0, 0);
          accR = __builtin_amdgcn_mfma_f32_16x16x32_bf16(atb, bv, accR, 0, 0, 0);
          const uint2 vv2 = *(const uint2*)(SB + S3_VT + (w * 16 + fr) * 16 + (fq & 1) * 8);
          const u32x4v t4 = {pack2(accR[0], accR[1]), pack2(accR[2], accR[3]), vv2.x, vv2.y};
          brv = fq < 2 ? __builtin_bit_cast(bf16x8, t4) : zfrag();
        }
        f32x4 accY = __builtin_amdgcn_mfma_f32_16x16x32_bf16(aq0, bs0, z4, 0, 0, 0);
        accY = __builtin_amdgcn_mfma_f32_16x16x32_bf16(aq1, bs1, accY, 0, 0, 0);
        if (DELTA) {
          const uint2 qb2 = *(const uint2*)(SB + S3_QBM + (fr & 7) * 16 + (fq & 1) * 8);
          const uint2 qk2 = *(const uint2*)(SB + S3_QKM + (fr & 7) * 16 + (fq & 1) * 8);
          const u32x4v q4 = {qb2.x, qb2.y, qk2.x, qk2.y};
          const bf16x8 aqm = fq < 2 ? __builtin_bit_cast(bf16x8, q4) : zfrag();
          accY = __builtin_amdgcn_mfma_f32_16x16x32_bf16(aqm, brv, accY, 0, 0, 0);
        } else {
          accY = __builtin_amdgcn_mfma_f32_16x16x32_bf16(aqk, bv, accY, 0, 0, 0);
        }
        if (fq < 2) {
#pragma unroll
          for (int r = 0; r < 4; r++) {
            const int i = fq * 4 + r, j = dir ? 7 - i : i;
            YS[(size_t)(seg_row0 + t_lo + sc * 8 + j) * YST + dir * 768 + MIX * 256 + h * 64 + w * 16 + fr] = f2bf(accY[r]);
          }
        }
#pragma unroll
        for (int nt = 0; nt < 4; nt++) {
          f32x4 an;
          if (DELTA) {
            const uint2 b2 = *(const uint2*)(SB + S3_BT + (nt * 16 + fr) * 16 + (fq & 1) * 8);
            const uint2 k2 = *(const uint2*)(SB + S3_KVT + (nt * 16 + fr) * 16 + (fq & 1) * 8);
            const u32x4v a4 = {b2.x, b2.y, k2.x, k2.y};
            const bf16x8 am = fq < 2 ? __builtin_bit_cast(bf16x8, a4) : zfrag();
            an = __builtin_amdgcn_mfma_f32_16x16x32_bf16(am, brv, z4, 0, 0, 0);
          } else {
            const bf16x8 akv = fq == 0 ? ld_frag(SB + S3_KVT + (nt * 16 + fr) * 16) : zfrag();
            an = __builtin_amdgcn_mfma_f32_16x16x32_bf16(akv, bv, z4, 0, 0, 0);
          }
          const float4 wc = *(const float4*)(SB + S3_WC + (nt * 16 + fq * 4) * 4);
          st[nt][0] = st[nt][0] * wc.x + an[0];
          st[nt][1] = st[nt][1] * wc.y + an[1];
          st[nt][2] = st[nt][2] * wc.z + an[2];
          st[nt][3] = st[nt][3] * wc.w + an[3];
        }
#undef LDP
      }
    }
    __syncthreads();
  }
}

__device__ __forceinline__ void attn_item(const Params& p, int l, int b, int qb, int hk, bool isctx, unsigned char* smem) {
  u16* KS = (u16*)smem;
  u16* VT = KS + 64 * LDT;
  u16* PL = VT + 64 * LDT;
  float2* ROPE = (float2*)(PL + 8 * 32 * LDT);
  const int tid = TIDX, lane = tid & 63, w = tid >> 6, fr = lane & 15, fq = lane >> 4;
  const u16* P = (const u16*)(p.ws + OFF_BIG);
  u16* Y = (u16*)(p.ws + OFF_YS);
  const int qh = hk * 2 + (w >> 2);
  const int tb = qb * 128 + (w & 3) * 32;
  const int qrow0 = b * TPB + (isctx ? 0 : LC);
  __syncthreads();
  for (int i = tid; i < 1024; i += NTHR) {
    int pos = i >> 4, fi = i & 15;
    float inv = powf(10000.f, -(float)fi / 16.f);
    float sn, cs;
    sincosf((float)pos * inv, &sn, &cs);
    ROPE[i] = make_float2(cs, sn);
  }
  __syncthreads();
  bf16x8 qf[2][2];
#pragma unroll
  for (int mi = 0; mi < 2; mi++)
#pragma unroll
    for (int ks = 0; ks < 2; ks++) {
      const int tq = tb + mi * 16 + fr;
      const u16* qp = P + (size_t)(qrow0 + tq) * PST + PD + qh * 64 + ks * 32;
      uint4 own = *(const uint4*)(qp + fq * 8);
      uint4 par = *(const uint4*)(qp + (fq ^ 2) * 8);
      const unsigned ow[4] = {own.x, own.y, own.z, own.w};
      const unsigned pw[4] = {par.x, par.y, par.z, par.w};
      const int pos = ks == 0 ? (tq >> 6) : (tq & 63);
      bf16x8 f;
#pragma unroll
      for (int jj = 0; jj < 8; jj++) {
        float xo = bf2f((u16)((ow[jj >> 1] >> ((jj & 1) * 16)) & 0xffff));
        float xp = bf2f((u16)((pw[jj >> 1] >> ((jj & 1) * 16)) & 0xffff));
        float v = xo;
        if (!isctx) {
          float2 cs = ROPE[pos * 16 + (fq & 1) * 8 + jj];
          v = fq < 2 ? xo * cs.x - xp * cs.y : xp * cs.y + xo * cs.x;
        }
        f[jj] = (short)f2bf(v * 0.125f);
      }
      qf[mi][ks] = f;
    }
  f32x4 oacc[2][4];
#pragma unroll
  for (int mi = 0; mi < 2; mi++)
#pragma unroll
    for (int nd = 0; nd < 4; nd++) oacc[mi][nd] = f32x4{0.f, 0.f, 0.f, 0.f};
  float mrow[2][4], lrow[2][4];
#pragma unroll
  for (int mi = 0; mi < 2; mi++)
#pragma unroll
    for (int r = 0; r < 4; r++) { mrow[mi][r] = -1e30f; lrow[mi][r] = 0.f; }

  const int q0 = qb * 128;
  const int band_lo = isctx ? 0 : max(0, q0 - 128), band_hi = isctx ? 0 : min(SEQ, q0 + 256);
  const int ntile = 4 + (band_hi - band_lo) / 64;
  u16* pl = PL + w * 32 * LDT;
  for (int tl = 0; tl < ntile; tl++) {
    const bool band = tl >= 4;
    const int k0 = band ? band_lo + (tl - 4) * 64 : tl * 64;
    __syncthreads();
    {
      const int key = tid >> 3, kc = tid & 7;
      const int kpos = k0 + key;
      const u16* kp = P + (size_t)(b * TPB + (band ? LC : 0) + kpos) * PST + PD + 256 + hk * 64;
      uint4 own = *(const uint4*)(kp + kc * 8);
      uint4 vv = *(const uint4*)(kp + 128 + kc * 8);
      uint4 par = *(const uint4*)(kp + (kc ^ 2) * 8);
      if (band) {
        const unsigned ow[4] = {own.x, own.y, own.z, own.w};
        const unsigned pw[4] = {par.x, par.y, par.z, par.w};
        const int pos = kc < 4 ? (kpos >> 6) : (kpos & 63);
        unsigned res[4];
#pragma unroll
        for (int jj = 0; jj < 8; jj += 2) {
          float v2[2];
#pragma unroll
          for (int e = 0; e < 2; e++) {
            float xo = bf2f((u16)((ow[jj >> 1] >> (e * 16)) & 0xffff));
            float xp = bf2f((u16)((pw[jj >> 1] >> (e * 16)) & 0xffff));
            float2 cs = ROPE[pos * 16 + (kc & 1) * 8 + jj + e];
            v2[e] = (kc & 2) == 0 ? xo * cs.x - xp * cs.y : xp * cs.y + xo * cs.x;
          }
          res[jj >> 1] = pack2(v2[0], v2[1]);
        }
        own = make_uint4(res[0], res[1], res[2], res[3]);
      }
      *(uint4*)(KS + key * LDT + kc * 8) = own;
      const unsigned vw[4] = {vv.x, vv.y, vv.z, vv.w};
#pragma unroll
      for (int jj = 0; jj < 8; jj++) VT[(kc * 8 + jj) * LDT + key] = (u16)((vw[jj >> 1] >> ((jj & 1) * 16)) & 0xffff);
    }
    __syncthreads();
    f32x4 sc[2][4];
#pragma unroll
    for (int mi = 0; mi < 2; mi++)
#pragma unroll
      for (int nj = 0; nj < 4; nj++) sc[mi][nj] = f32x4{0.f, 0.f, 0.f, 0.f};
#pragma unroll
    for (int ks = 0; ks < 2; ks++) {
      bf16x8 kf[4];
#pragma unroll
      for (int nj = 0; nj < 4; nj++) kf[nj] = *(const bf16x8*)(KS + (nj * 16 + fr) * LDT + ks * 32 + fq * 8);
#pragma unroll
      for (int mi = 0; mi < 2; mi++)
#pragma unroll
        for (int nj = 0; nj < 4; nj++) sc[mi][nj] = __builtin_amdgcn_mfma_f32_16x16x32_bf16(qf[mi][ks], kf[nj], sc[mi][nj], 0, 0, 0);
    }
#pragma unroll
    for (int mi = 0; mi < 2; mi++)
#pragma unroll
      for (int r = 0; r < 4; r++) {
        const int qpos = tb + mi * 16 + fq * 4 + r;
        float mx = -1e30f;
#pragma unroll
        for (int nj = 0; nj < 4; nj++) {
          float v = sc[mi][nj][r];
          if (band) {
            int d = qpos - (k0 + nj * 16 + fr);
            if (d > 128 || d < -128) v = -1e30f;
          }
          sc[mi][nj][r] = v;
          mx = fmaxf(mx, v);
        }
        mx = fmaxf(mx, __shfl_xor(mx, 1));
        mx = fmaxf(mx, __shfl_xor(mx, 2));
        mx = fmaxf(mx, __shfl_xor(mx, 4));
        mx = fmaxf(mx, __shfl_xor(mx, 8));
        const float mnew = fmaxf(mrow[mi][r], mx);
        const float alpha = __expf(mrow[mi][r] - mnew);
        mrow[mi][r] = mnew;
        float ls = 0.f;
#pragma unroll
        for (int nj = 0; nj < 4; nj++) {
          float pe = __expf(sc[mi][nj][r] - mnew);
          ls += pe;
          pl[(mi * 16 + fq * 4 + r) * LDT + nj * 16 + fr] = f2bf(pe);
        }
        lrow[mi][r] = lrow[mi][r] * alpha + ls;
#pragma unroll
        for (int nd = 0; nd < 4; nd++) oacc[mi][nd][r] *= alpha;
      }
    asm volatile("s_waitcnt lgkmcnt(0)" ::: "memory");
    __builtin_amdgcn_wave_barrier();
#pragma unroll
    for (int ks = 0; ks < 2; ks++) {
      bf16x8 pf[2], vf[4];
#pragma unroll
      for (int mi = 0; mi < 2; mi++) pf[mi] = *(const bf16x8*)(pl + (mi * 16 + fr) * LDT + ks * 32 + fq * 8);
#pragma unroll
      for (int nd = 0; nd < 4; nd++) vf[nd] = *(const bf16x8*)(VT + (nd * 16 + fr) * LDT + ks * 32 + fq * 8);
#pragma unroll
      for (int mi = 0; mi < 2; mi++)
#pragma unroll
        for (int nd = 0; nd < 4; nd++) oacc[mi][nd] = __builtin_amdgcn_mfma_f32_16x16x32_bf16(pf[mi], vf[nd], oacc[mi][nd], 0, 0, 0);
    }
    asm volatile("s_waitcnt lgkmcnt(0)" ::: "memory");
    __builtin_amdgcn_wave_barrier();
  }
  const float sink = p.attn_sink[l * 4 + qh];
#pragma unroll
  for (int mi = 0; mi < 2; mi++)
#pragma unroll
    for (int r = 0; r < 4; r++) {
      float ls = lrow[mi][r];
      ls += __shfl_xor(ls, 1);
      ls += __shfl_xor(ls, 2);
      ls += __shfl_xor(ls, 4);
      ls += __shfl_xor(ls, 8);
      ls += __expf(sink - mrow[mi][r]);
      const float inv = 1.f / ls;
      const int tq = tb + mi * 16 + fq * 4 + r;
#pragma unroll
      for (int nd = 0; nd < 4; nd++) Y[(size_t)(qrow0 + tq) * YST + 1536 + qh * 64 + nd * 16 + fr] = f2bf(oacc[mi][nd][r] * inv);
    }
}

#ifndef SCAN3_MASK
#define SCAN3_MASK 7
#endif
__device__ __forceinline__ void phase_mix(const Params& p, int l, unsigned char* smem) {
  float* sm = (float*)smem;
  const int G = gridDim.x;
  for (int it = blockIdx.x; it < 192; it += G) {
    const int mix = it >> 6, rem = it & 63, b = rem >> 3, h = (rem >> 1) & 3, dir = rem & 1;
    if (mix == 0 && (SCAN3_MASK & 1)) scan3_item<0>(p, l, b, h, dir, smem);
    else if (mix == 1 && (SCAN3_MASK & 2)) scan3_item<1>(p, l, b, h, dir, smem);
    else if (mix == 2 && (SCAN3_MASK & 4)) scan3_item<2>(p, l, b, h, dir, smem);
  }
  if (SCAN3_MASK != 7) {
    for (int it = blockIdx.x; it < 768; it += G) {
      const int mix = it >> 8, rem = it & 255, b = rem >> 5, h = (rem >> 3) & 3, dir = (rem >> 2) & 1, rq = rem & 3;
      if (mix == 0 && !(SCAN3_MASK & 1)) scan2_item<0>(p, l, b, h, dir, rq, sm);
      else if (mix == 1 && !(SCAN3_MASK & 2)) scan2_item<1>(p, l, b, h, dir, rq, sm);
      else if (mix == 2 && !(SCAN3_MASK & 4)) scan2_item<2>(p, l, b, h, dir, rq, sm);
    }
  }
  __syncthreads();
  {
    const bool spread = G >= 192;
    const int nconv = spread ? 64 : G, fidx = spread ? (int)blockIdx.x - 128 : (int)blockIdx.x;
    if (fidx >= 0 && fidx < nconv)
      for (int it = 832 + fidx; it < 4480; it += nconv) conv_item(p, l, it, (float*)smem);
    __syncthreads();
  }
  unsigned* ctr = (unsigned*)(p.ws + OFF_CTR) + l * 16;
  volatile int* slot = (volatile int*)(smem + 131072 - 16);
  for (;;) {
    if (TIDX == 0) *slot = (int)atomicAdd(ctr, 1u);
    __syncthreads();
    const int it = *slot;
    __syncthreads();
    if (it >= (l == 0 ? 544 : 512)) break;
    if (it < 512) {
      int b = it >> 6, qb = (it >> 1) & 31, hk = it & 1;
      attn_item(p, l, b, qb, hk, false, smem);
    } else {
      int r = it - 512, b = r >> 2, qb = (r >> 1) & 1, hk = r & 1;
      attn_item(p, l, b, qb, hk, true, smem);
    }
  }
}

#define POST_DECL(PFX) uint2 PFX##ya0, PFX##ya1, PFX##ya2, PFX##yc0, PFX##yc1, PFX##yc2, PFX##vp, PFX##vc, PFX##vn, PFX##gb, PFX##gc; \
  u16 PFX##xp, PFX##xc, PFX##xn; float2 PFX##bc
#define POST_LOAD(PFX, R_)                                                                         \
  do {                                                                                             \
    const int r_ = (R_);                                                                           \
    const int b_ = r_ / TPB, t_ = r_ - b_ * TPB;                                                   \
    const bool hp_ = (t_ != 0) && (t_ != LC), hn_ = (t_ != LC - 1) && (t_ != TPB - 1);            \
    const u16* ys_ = YSc + (size_t)r_ * YST;                                                       \
    const u16* pr_ = Pc + (size_t)r_ * PST;                                                        \
    const u16* pp_ = pr_ - (hp_ ? PST : 0);                                                        \
    const u16* pn_ = pr_ + (hn_ ? PST : 0);                                                        \
    PFX##ya0 = *(const uint2*)(ys_ + j0); PFX##ya1 = *(const uint2*)(ys_ + 256 + j0); PFX##ya2 = *(const uint2*)(ys_ + 512 + j0); \
    PFX##yc0 = *(const uint2*)(ys_ + 768 + j0); PFX##yc1 = *(const uint2*)(ys_ + 1024 + j0); PFX##yc2 = *(const uint2*)(ys_ + 1280 + j0); \
    PFX##vp = *(const uint2*)(pp_ + PA + 512 + j0);                                                \
    PFX##vc = *(const uint2*)(pr_ + PA + 512 + j0);                                                \
    PFX##vn = *(const uint2*)(pn_ + PA + 512 + j0);                                                \
    PFX##gb = *(const uint2*)(pr_ + PB + 784 + j0);                                                \
    PFX##gc = *(const uint2*)(pr_ + PC + 544 + j0);                                                \
    PFX##xp = pp_[PA + 896 + lane]; PFX##xc = pr_[PA + 896 + lane]; PFX##xn = pn_[PA + 896 + lane]; \
    PFX##bc = *(const float2*)(BCc + (size_t)r_ * 8 + (lane >> 4) * 2);                            \
  } while (0)
__device__ __forceinline__ void unpack4(uint2 v, float (&o)[4]) {
  o[0] = __uint_as_float(v.x << 16); o[1] = __uint_as_float(v.x & 0xffff0000u);
  o[2] = __uint_as_float(v.y << 16); o[3] = __uint_as_float(v.y & 0xffff0000u);
}

__device__ __forceinline__ void phase_post(const Params& p, int l, float* g2s) {
  const int lane = TIDX & 63, wv = TIDX >> 6;
  u16* YS = (u16*)(p.ws + OFF_YS);
  const int j0 = lane * 4;
  {
    const float4* src = (const float4*)(p.rwkv_g2 + (size_t)l * 64 * 256);
    for (int i = TIDX; i < 64 * 256 / 4; i += NTHR) ((float4*)g2s)[i] = src[i];
  }
  float mu_v[4], lng[4], lnb[4], ngb[4], ngc[4];
#pragma unroll
  for (int i = 0; i < 4; i++) {
    mu_v[i] = p.rwkv_mu[l * 960 + 512 + j0 + i];
    lng[i] = p.rwkv_ln_g[l * 256 + j0 + i];
    lnb[i] = p.rwkv_ln_b[l * 256 + j0 + i];
    ngb[i] = p.gdn_norm_g[l * 64 + (lane & 15) * 4 + i];
    ngc[i] = p.gla_norm_g[l * 64 + (lane & 15) * 4 + i];
  }
  const float mu_x = p.rwkv_mu[l * 960 + 896 + lane];
  __syncthreads();
  const int stride = gridDim.x * 8;
  int r = blockIdx.x * 8 + wv;
  const u16* Pc = (const u16*)(p.ws + OFF_BIG);
  const u16* YSc = (const u16*)(p.ws + OFF_YS);
  const float* BCc = (const float*)(p.ws + OFF_BC);
  POST_DECL(cur_);
  POST_DECL(nxt_);
  POST_LOAD(cur_, r);
  for (; r < NROWS; r += stride) {
    const int rn = r + stride < NROWS ? r + stride : r;
    POST_LOAD(nxt_, rn);
    const int b = r / TPB, t = r - b * TPB;
    const float pmul = ((t != 0) && (t != LC)) ? 1.f : 0.f, nmul = ((t != LC - 1) && (t != TPB - 1)) ? 1.f : 0.f;
    if (!(l == 1 && t < LC)) {
    float y[3][4];
    {
      float a4[4], c4[4];
      unpack4(cur_ya0, a4); unpack4(cur_yc0, c4);
#pragma unroll
      for (int i = 0; i < 4; i++) y[0][i] = a4[i] + c4[i];
      unpack4(cur_ya1, a4); unpack4(cur_yc1, c4);
#pragma unroll
      for (int i = 0; i < 4; i++) y[1][i] = a4[i] + c4[i];
      unpack4(cur_ya2, a4); unpack4(cur_yc2, c4);
#pragma unroll
      for (int i = 0; i < 4; i++) y[2][i] = a4[i] + c4[i];
    }
    float o[3][4];
    {
      float sum = y[0][0] + y[0][1] + y[0][2] + y[0][3];
      sum = red16(sum);
      const float mean = sum * (1.f / 64.f);
      float vs = 0.f;
#pragma unroll
      for (int i = 0; i < 4; i++) { float d = y[0][i] - mean; vs += d * d; }
      vs = red16(vs);
      const float rstd = rsq(vs * (1.f / 64.f) + 64e-5f);
      const float pv = bf2f(cur_xc), ppv = bf2f(cur_xp) * pmul, pnv = bf2f(cur_xn) * nmul;
      const float sg = sigm(pv + (0.5f * (ppv + pnv) - pv) * mu_x);
      float gate[4] = {0.f, 0.f, 0.f, 0.f};
      const float* g2 = g2s + j0;
#pragma unroll 8
      for (int i = 0; i < 64; i++) {
        const float si = __int_as_float(__builtin_amdgcn_readlane(__float_as_int(sg), i));
        const float4 gw = *(const float4*)(g2 + i * 256);
        gate[0] += si * gw.x; gate[1] += si * gw.y; gate[2] += si * gw.z; gate[3] += si * gw.w;
      }
      const float bcs = cur_bc.x + cur_bc.y;
      float vc4[4], vp4[4], vn4[4];
      unpack4(cur_vc, vc4); unpack4(cur_vp, vp4); unpack4(cur_vn, vn4);
#pragma unroll
      for (int i = 0; i < 4; i++) {
        const float v = vc4[i] + (0.5f * (vp4[i] * pmul + vn4[i] * nmul) - vc4[i]) * mu_v[i];
        const float yn = (y[0][i] - mean) * rstd * lng[i] + lnb[i];
        o[0][i] = (yn + bcs * v) * gate[i];
      }
    }
#pragma unroll
    for (int m = 1; m < 3; m++) {
      float ss = y[m][0] * y[m][0] + y[m][1] * y[m][1] + y[m][2] * y[m][2] + y[m][3] * y[m][3];
      ss = red16(ss);
      const float inv = rsq(ss * (1.f / 64.f) + 1e-6f);
      float g4[4];
      unpack4(m == 1 ? cur_gb : cur_gc, g4);
#pragma unroll
      for (int i = 0; i < 4; i++) o[m][i] = y[m][i] * inv * (m == 1 ? ngb[i] : ngc[i]) * siluf(g4[i]);
    }
    u16* ys = YS + (size_t)r * YST;
#pragma unroll
    for (int m = 0; m < 3; m++) {
      uint2 ov;
      ov.x = pack2(o[m][0], o[m][1]);
      ov.y = pack2(o[m][2], o[m][3]);
      *(uint2*)(ys + m * 256 + j0) = ov;
    }
    }
    cur_ya0 = nxt_ya0; cur_ya1 = nxt_ya1; cur_ya2 = nxt_ya2; cur_yc0 = nxt_yc0; cur_yc1 = nxt_yc1; cur_yc2 = nxt_yc2;
    cur_vp = nxt_vp; cur_vc = nxt_vc; cur_vn = nxt_vn; cur_gb = nxt_gb; cur_gc = nxt_gc;
    cur_xp = nxt_xp; cur_xc = nxt_xc; cur_xn = nxt_xn; cur_bc = nxt_bc;
  }
}

#define XB_TMO      128
#define XB_XCNT(j)  (256  + 64 * (j))
#define XB_XSUB(j)  (1280 + 64 * (j))
#define XB_XGEN(j)  (2304 + 64 * (j))
#define XB_TOP      3328
#define XB_TOPGEN   3392
#define XCD_BAR_WORDS 3456
#define XB_SPIN_CAP (1u << 18)
#define LAS __attribute__((address_space(3)))

__device__ __forceinline__ unsigned xb_ld(unsigned* p)              { return __hip_atomic_load(p, __ATOMIC_RELAXED, __HIP_MEMORY_SCOPE_AGENT); }
__device__ __forceinline__ unsigned xb_add(unsigned* p, unsigned v) { return __hip_atomic_fetch_add(p, v, __ATOMIC_RELAXED, __HIP_MEMORY_SCOPE_AGENT); }
__device__ __forceinline__ unsigned xb_xcc_id() { return (unsigned)__builtin_amdgcn_s_getreg((3 << 11) | 20) & 0xFu; }
#define XB_SPIN(cond, bar) do { unsigned _sp = 0; while (cond) { __builtin_amdgcn_s_sleep(1); \
    if ((++_sp & 255u) == 0u) { if (xb_ld(&(bar)[XB_TMO])) break; if (_sp > XB_SPIN_CAP) { atomicAdd(&(bar)[XB_TMO], 1u); break; } } } } while (0)

struct XcdBarrier {
    unsigned* bar; unsigned x;
    volatile LAS unsigned* st;
};

__device__ __forceinline__ XcdBarrier xcd_barrier_post(unsigned* bar, volatile LAS unsigned* st) {
    XcdBarrier b; b.bar = bar; b.x = xb_xcc_id(); b.st = st;
    if (threadIdx.x == 0) (void)xb_add(&bar[XB_XCNT(b.x)], 1u);
    return b;
}
__device__ __forceinline__ void xcd_barrier_complete(unsigned* bar, unsigned x, unsigned& nloc, unsigned& nx) {
    const unsigned G = gridDim.x * gridDim.y * gridDim.z;
    unsigned sum, cnt, mine, sp = 0u;
    for (;;) {
        sum = 0u; cnt = 0u; mine = 0u;
#pragma unroll
        for (unsigned j = 0; j < 16; ++j) { const unsigned c = xb_ld(&bar[XB_XCNT(j)]); sum += c; cnt += (c > 0u) ? 1u : 0u; mine = (j == x) ? c : mine; }
        if (sum == G) break;
        __builtin_amdgcn_s_sleep(1);
        if ((++sp & 255u) == 0u) { if (xb_ld(&bar[XB_TMO])) break; if (sp > XB_SPIN_CAP) { atomicAdd(&bar[XB_TMO], 1u); break; } }
    }
    nloc = mine > 0u ? mine : 1u; nx = cnt > 0u ? cnt : 1u;
}

__device__ __forceinline__ void xcd_barrier(const XcdBarrier& b) {
    asm volatile("s_waitcnt vmcnt(0)" ::: "memory");
    __syncthreads();
    if (threadIdx.x == 0) {
        unsigned* bar = b.bar;
        __builtin_amdgcn_s_waitcnt(0);
        unsigned nloc = b.st[0], nx = b.st[1];
        if (nloc == 0u) { xcd_barrier_complete(bar, b.x, nloc, nx); b.st[0] = nloc; b.st[1] = nx; }
        const unsigned old = xb_add(&bar[XB_XSUB(b.x)], 1u);
        const unsigned gen = old / nloc;
        if (old + 1u == (gen + 1u) * nloc) {
            __builtin_amdgcn_fence(__ATOMIC_RELEASE, "agent");
            asm volatile("s_waitcnt vmcnt(0)" ::: "memory");
            const unsigned og = xb_add(&bar[XB_TOP], 1u);
            const unsigned tg = og / nx;
            if (og + 1u == (tg + 1u) * nx) xb_add(&bar[XB_TOPGEN], 1u);
            else XB_SPIN(xb_ld(&bar[XB_TOPGEN]) == tg, bar);
            __builtin_amdgcn_fence(__ATOMIC_ACQUIRE, "agent");
            xb_add(&bar[XB_XGEN(b.x)], 1u);
            asm volatile("s_waitcnt vmcnt(0)" ::: "memory");
        } else {
            XB_SPIN(xb_ld(&bar[XB_XGEN(b.x)]) == gen, bar);
            __builtin_amdgcn_fence(__ATOMIC_ACQUIRE, "agent");
            asm volatile("s_waitcnt vmcnt(0)" ::: "memory");
        }
    }
    __syncthreads();
}

#if defined(SKIPS)
#define EN(k) (SKIPS != (k))
#elif !defined(ONLYS)
#define EN(k) 1
#else
#define EN(k) (ONLYS == (k))
#endif
__device__ __forceinline__ void run_phase(const Params& p, int ph, unsigned char* smem) {
  if (ph == 0) { if (EN(10)) phase_init0(p, (float*)smem); return; }
  if (ph == 1) { if (EN(11)) phase_init1(p); return; }
  int l = 0, s = 10;
  if (ph >= 3) { l = (ph - 3) / 10; s = (ph - 3) - l * 10; }
  unsigned char* wl = p.ws + OFF_W;
  PG8_LAS unsigned char* lds = (PG8_LAS unsigned char*)smem;
  pg8::StaticOrder S;
  if (s == 10 || s == 6 || s == 9) {
    if (EN(5)) rowpass(p, l, s == 10 ? 0 : (s == 6 ? 1 : 2));
    if (s == 9 && l == 0) {
      __syncthreads();
      for (int it = blockIdx.x; it < 832; it += gridDim.x) conv_item(p, 1, it, (float*)smem);
    }
  } else if (s == 0 || s == 3 || s == 5 || s == 8) {
    pg8::Gemm g; EpiBf E;
    g.M = NROWS; E.bias = nullptr; E.act = 0;
    if (s == 0) { g.A = (const u16*)(p.ws + OFF_H); g.lda = DM; g.Bt = (const u16*)(wl + OW_IN); g.K = DM; g.N = PST; E.O = (u16*)(p.ws + OFF_BIG); E.ldc = PST; }
    else if (s == 3) {
      g.A = (const u16*)(p.ws + OFF_H); g.lda = DM; g.Bt = (const u16*)(wl + OW_G); g.K = DM; g.N = 4096;
      E.O = (u16*)(p.ws + OFF_BIG); E.ldc = 4096; E.bias = p.gate_b + (size_t)l * 4096; E.act = 1;
    }
    else if (s == 5) { g.A = (const u16*)(p.ws + OFF_H); g.lda = DM; g.Bt = (const u16*)(wl + OW_O); g.K = DM; g.N = DM; E.O = (u16*)(p.ws + OFF_BIG); E.ldc = DM; }
    else { g.A = (const u16*)(p.ws + OFF_BIG); g.lda = FH; g.Bt = (const u16*)(wl + OW_2); g.K = FH; g.N = DM; E.O = (u16*)(p.ws + OFF_YS); E.ldc = DM; }
    if (l == 1 && s != 0) S.init(NBATCH * SEQ, g.N, gridDim.x, blockIdx.x, 1);
    else S.init(g.M, g.N, gridDim.x, blockIdx.x);
    if (EN(0)) pg8::gemm_phase<EpiBf, pg8::StaticOrder, false>(lds, g, S, E, nullptr);
  } else if (s == 4) {
    if (EN(3)) phase_ypart(p, l, smem);
  } else if (s == 1) {
    if (EN(1)) phase_mix(p, l, smem);
  } else if (s == 2) {
    if (EN(2)) phase_post(p, l, (float*)smem);
  } else {
    pg8::Gemm g; EpiSwiglu E;
    g.M = NROWS; g.N = 2 * FH; g.K = DM; g.lda = DM; g.A = (const u16*)(p.ws + OFF_H); g.Bt = (const u16*)(wl + OW_1);
    E.O = (u16*)(p.ws + OFF_BIG);
    if (l == 1) S.init(NBATCH * SEQ, g.N, gridDim.x, blockIdx.x, 1);
    else S.init(g.M, g.N, gridDim.x, blockIdx.x);
    if (EN(6)) pg8::gemm_phase<EpiSwiglu, pg8::StaticOrder, false>(lds, g, S, E, nullptr);
  }
}

__global__ void __launch_bounds__(NTHR) hybrid_flow_mega(Params p, int ph0, int ph1) {
  __shared__ __attribute__((aligned(16))) unsigned char smem[131072];
  __shared__ __attribute__((aligned(16))) unsigned xbw[4];
  cg::grid_group grid = cg::this_grid();
  XcdBarrier xb;
  xb.bar = (unsigned*)(p.ws + OFF_XBAR); xb.x = 0u; xb.st = (volatile LAS unsigned*)xbw;
  for (int ph = ph0; ph < ph1; ph++) {
    run_phase(p, ph, smem);
#ifdef DUPMASK
    {
      int sidx = ph >= 3 ? (ph - 3) % 10 : 12 + ph;
      if ((DUPMASK >> sidx) & 1) { __syncthreads(); run_phase(p, ph, smem); }
    }
#endif
    if (ph + 1 < ph1) {
      if (ph == ph0) {
        grid.sync();
        if (threadIdx.x < 4) xbw[threadIdx.x] = 0u;
        __syncthreads();
        xb = xcd_barrier_post((unsigned*)(p.ws + OFF_XBAR), (volatile LAS unsigned*)xbw);
      } else {
        xcd_barrier(xb);
      }
    }
  }
  if (ph1 - ph0 > 2 && threadIdx.x == 0 && xb_ld(&xb.bar[XB_TMO]) != 0u) p.out[blockIdx.x] = __int_as_float(0x7fc00000);
}

extern "C" void kernel_launch(void* const* d_in, const int* in_sizes, int n_in, void* d_out, int out_size, void* d_ws,
                              size_t ws_size, hipStream_t stream) {
  Params p{};
  const float** pp = (const float**)&p;
  for (int i = 0; i < 32; i++) pp[i] = (const float*)d_in[i];
  p.out = (float*)d_out;
  p.ws = (unsigned char*)d_ws;
  static int grid_blocks = 0;
  if (!grid_blocks) {
    int dev = 0, cus = 0, per_cu = 0;
    hipGetDevice(&dev);
    hipDeviceGetAttribute(&cus, hipDeviceAttributeMultiprocessorCount, dev);
    hipOccupancyMaxActiveBlocksPerMultiprocessor(&per_cu, hybrid_flow_mega, NTHR, 0);
    if (per_cu < 1) per_cu = 1;
    grid_blocks = cus * per_cu;
  }
#ifdef MULTI_LAUNCH
  for (int ph = 0; ph < NPHASE; ph++) {
    hipLaunchKernelGGL(hybrid_flow_mega, dim3(grid_blocks), dim3(NTHR), 0, stream, p, ph, ph + 1);
  }
#else
  int ph0 = 0, ph1 = NPHASE;
  void* args[] = {&p, &ph0, &ph1};
  hipError_t e = hipLaunchCooperativeKernel((void*)hybrid_flow_mega, dim3(grid_blocks), dim3(NTHR), args, 0, stream);
  if (e != hipSuccess) fprintf(stderr, "cooperative launch failed: %s (grid %d)\n", hipGetErrorString(e), grid_blocks);
#endif
}
```

```cpp
#include <hip/hip_runtime.h>
#include <hip/hip_cooperative_groups.h>
#include <cstdio>
namespace cg = cooperative_groups;

typedef unsigned short u16;
using bf16x8 = __attribute__((ext_vector_type(8))) short;
using f32x4 = __attribute__((ext_vector_type(4))) float;

#define DM 1024
#define NBATCH 8
#define SEQ 4096
#define LC 256
#define TPB 4352
#define NROWS 34816
#define PST 3328
#define YST 1792
#define FH 2816
#define INW 7408
#define NTHR 512
#define PA 0
#define PB 960
#define PC 2000
#define PD 2800
#define NPHASE 23
#define SCAN3_MASK 7

struct Params {
  const float *x, *c, *ctx, *c_ctx, *ada_w, *ada_b, *norm_g, *w_in, *gate_b, *w_branch, *w_out,
      *rwkv_mu, *rwkv_w0, *rwkv_w2, *rwkv_a0, *rwkv_a2, *rwkv_g2, *rwkv_kk, *rwkv_ka, *rwkv_rk, *rwkv_ln_g,
      *rwkv_ln_b, *gdn_conv, *gdn_a_log, *gdn_dt_bias, *gdn_norm_g, *gla_gw2, *gla_gb, *gla_norm_g, *attn_sink,
      *ffn_w1, *ffn_w2;
  float* out;
  unsigned char* ws;
};

constexpr size_t SZ_WL = 36700160;
constexpr size_t OW_IN = 0;
constexpr size_t OW_G = OW_IN + (size_t)PST * 1024 * 2;
constexpr size_t OW_B = OW_G + (size_t)4096 * 1024 * 2;
constexpr size_t OW_O = OW_B + (size_t)4 * 1024 * 256 * 2;
constexpr size_t OW_1 = OW_O + (size_t)1024 * 1024 * 2;
constexpr size_t OW_2 = OW_1 + (size_t)5632 * 1024 * 2;
static_assert(OW_2 + (size_t)1024 * FH * 2 == SZ_WL, "weights size");
constexpr size_t SZ_ACT = (size_t)NROWS * DM * 2;
constexpr size_t OFF_W = 0;
constexpr size_t OFF_XC = OFF_W + SZ_WL;
constexpr size_t OFF_MODP = OFF_XC + (size_t)NBATCH * LC * DM * 4;
constexpr size_t OFF_MOD = OFF_MODP + (size_t)2 * 8 * 9 * 6144 * 4;
constexpr size_t OFF_BC = OFF_MOD + (size_t)2 * 9 * 6144 * 4;
constexpr size_t OFF_H = OFF_BC + (size_t)NROWS * 8 * 4;
constexpr size_t OFF_YS = OFF_H + SZ_ACT;
constexpr size_t OFF_BIG = OFF_YS + (size_t)NROWS * YST * 2;
constexpr size_t OFF_CTR = OFF_BIG + (size_t)NROWS * 4096 * 2;
constexpr size_t OFF_XBAR = OFF_CTR + 256;
constexpr size_t WS_END = OFF_XBAR + 3456 * 4;
static_assert(WS_END <= (size_t)536870912, "ws too large");

__device__ __forceinline__ int launder_tid() { int t = threadIdx.x; asm volatile("" : "+v"(t)); return t; }
#define TIDX (launder_tid())
typedef float f32x2_t __attribute__((ext_vector_type(2)));
typedef __bf16 bf16x2_t __attribute__((ext_vector_type(2)));
__device__ __forceinline__ unsigned pack2(float a, float b) {
  const f32x2_t v = {a, b};
  const bf16x2_t r = __builtin_convertvector(v, bf16x2_t);
  return __builtin_bit_cast(unsigned, r);
}
__device__ __forceinline__ u16 f2bf(float f) { return (u16)(pack2(f, 0.f) & 0xffffu); }
__device__ __forceinline__ float bf2f(u16 h) { return __uint_as_float(((unsigned)h) << 16); }
__device__ __forceinline__ float sigm(float x) { return __builtin_amdgcn_rcpf(1.f + __expf(-x)); }
__device__ __forceinline__ float siluf(float x) { return x * __builtin_amdgcn_rcpf(1.f + __expf(-x)); }
__device__ __forceinline__ float rsq(float x) { return __builtin_amdgcn_rsqf(x); }
__device__ __forceinline__ float softplusf(float x) { return fmaxf(x, 0.f) + __logf(1.f + __expf(-fabsf(x))); }
__device__ __forceinline__ float tanh_fast(float x) { return 1.f - 2.f * __builtin_amdgcn_rcpf(1.f + __expf(2.f * x)); }
__device__ __forceinline__ float wsum(float v) {
#pragma unroll
  for (int o = 32; o > 0; o >>= 1) v += __shfl_xor(v, o);
  return v;
}
template <int CTRL>
__device__ __forceinline__ float dppf(float x) {
  return __int_as_float(__builtin_amdgcn_update_dpp(__float_as_int(x), __float_as_int(x), CTRL, 0xf, 0xf, false));
}
__device__ __forceinline__ float red8(float x) {
  x += dppf<0xB1>(x);
  x += dppf<0x4E>(x);
  x += dppf<0x141>(x);
  return x;
}
__device__ __forceinline__ const float* xin_row(const Params& p, int r) {
  int b = r / TPB, t = r - b * TPB;
  return t < LC ? p.ctx + ((size_t)(b * LC + t)) * DM : p.x + ((size_t)(b * SEQ + t - LC)) * DM;
}
__device__ __forceinline__ float* x_row(const Params& p, int r) {
  int b = r / TPB, t = r - b * TPB;
  return t < LC ? (float*)(p.ws + OFF_XC) + ((size_t)(b * LC + t)) * DM : p.out + ((size_t)(b * SEQ + t - LC)) * DM;
}
__device__ __forceinline__ int mod_row(int r) {
  int b = r / TPB, t = r - b * TPB;
  return t < LC ? 8 : b;
}

struct MapId { int lim, off; __device__ int operator()(int n) const { return n < lim ? n + off : -1; } };
struct MapW1 { __device__ int operator()(int n) const { int q = n >> 3, s = n & 7; return s < 4 ? q * 4 + s : FH + q * 4 + (s - 4); } };

template <class Map>
__device__ __forceinline__ void conv_tile(const float* __restrict__ src, int ld, u16* __restrict__ dst, int K, int n0,
                                          int k0, Map map, float* tile) {
  const int tid = TIDX;
  const int nn = tid & 63, kr = tid >> 6;
  const int sc = map(n0 + nn);
  float tv[8];
  const int scc = sc >= 0 ? sc : 0;
  const float scm = sc >= 0 ? 1.f : 0.f;
#pragma unroll
  for (int ps = 0; ps < 8; ps++) tv[ps] = src[(size_t)(k0 + ps * 8 + kr) * ld + scc];
#pragma unroll
  for (int ps = 0; ps < 8; ps++) tile[(ps * 8 + kr) * 65 + nn] = tv[ps] * scm;
  __syncthreads();
  const int n2 = tid >> 3, kc = tid & 7;
  uint4 o;
  o.x = pack2(tile[(kc * 8 + 0) * 65 + n2], tile[(kc * 8 + 1) * 65 + n2]);
  o.y = pack2(tile[(kc * 8 + 2) * 65 + n2], tile[(kc * 8 + 3) * 65 + n2]);
  o.z = pack2(tile[(kc * 8 + 4) * 65 + n2], tile[(kc * 8 + 5) * 65 + n2]);
  o.w = pack2(tile[(kc * 8 + 6) * 65 + n2], tile[(kc * 8 + 7) * 65 + n2]);
  *(uint4*)(dst + (size_t)(n0 + n2) * K + k0 + kc * 8) = o;
  __syncthreads();
}

__device__ __forceinline__ void conv_item(const Params& p, int l, int rem, float* sm) {
      u16* wl = (u16*)(p.ws + OFF_W);
      if (rem < 832) {
        int nt = rem >> 4, kt = rem & 15;
        conv_tile(p.w_in + (size_t)l * DM * INW, INW, (u16*)((char*)wl + OW_IN), 1024, nt * 64, kt * 64, MapId{3312, 0}, sm);
      } else if (rem < 832 + 1024) {
        rem -= 832;
        int nt = rem >> 4, kt = rem & 15;
        conv_tile(p.w_in + (size_t)l * DM * INW, INW, (u16*)((char*)wl + OW_G), 1024, nt * 64, kt * 64, MapId{4096, 3312}, sm);
      } else if (rem < 1856 + 256) {
        rem -= 1856;
        int br = rem >> 6, r2 = rem & 63, nt = r2 >> 2, kt = r2 & 3;
        conv_tile(p.w_branch + ((size_t)(l * 4 + br)) * 256 * DM, DM, (u16*)((char*)wl + OW_B) + (size_t)br * 1024 * 256, 256,
                  nt * 64, kt * 64, MapId{1024, 0}, sm);
      } else if (rem < 2112 + 256) {
        rem -= 2112;
        int nt = rem >> 4, kt = rem & 15;
        conv_tile(p.w_out + (size_t)l * DM * DM, DM, (u16*)((char*)wl + OW_O), 1024, nt * 64, kt * 64, MapId{1024, 0}, sm);
      } else if (rem < 2368 + 1408) {
        rem -= 2368;
        int nt = rem >> 4, kt = rem & 15;
        conv_tile(p.ffn_w1 + (size_t)l * DM * 5632, 5632, (u16*)((char*)wl + OW_1), 1024, nt * 64, kt * 64, MapW1{}, sm);
      } else {
        rem -= 3776;
        int nt = rem / 44, kt = rem - nt * 44;
        conv_tile(p.ffn_w2 + (size_t)l * FH * DM, DM, (u16*)((char*)wl + OW_2), FH, nt * 64, kt * 64, MapId{1024, 0}, sm);
      }
}

__device__ __forceinline__ void phase_init0(const Params& p, float* sm) {
  const int tid = TIDX;
  if (blockIdx.x == 0) {
    if (tid < 64) ((unsigned*)(p.ws + OFF_CTR))[tid] = 0u;
    for (int i = tid; i < 3456; i += NTHR) ((unsigned*)(p.ws + OFF_XBAR))[i] = 0u;
  }
  constexpr int NMOD = 192, NCONV = 832;
  for (int it = blockIdx.x; it < NMOD + NCONV; it += gridDim.x) {
    if (it < NMOD) {
      int l = it / 96, rem = it - l * 96, cc = rem >> 3, ks = rem & 7;
      for (int i = tid; i < 9 * 128; i += NTHR) {
        int r = i >> 7, k = i & 127;
        float v = r < 8 ? p.c[r * DM + ks * 128 + k] : p.c_ctx[ks * 128 + k];
        sm[i] = siluf(v);
      }
      __syncthreads();
      const int n = cc * 512 + tid;
      const float* w = p.ada_w + ((size_t)l * DM + ks * 128) * 6144 + n;
      float acc[9];
#pragma unroll
      for (int r = 0; r < 9; r++) acc[r] = 0.f;
#pragma unroll 1
      for (int k0 = 0; k0 < 128; k0 += 16) {
        float wv[16];
#pragma unroll
        for (int kk = 0; kk < 16; kk++) wv[kk] = w[(size_t)(k0 + kk) * 6144];
#pragma unroll
        for (int kk = 0; kk < 16; kk++)
#pragma unroll
          for (int r = 0; r < 9; r++) acc[r] += sm[r * 128 + k0 + kk] * wv[kk];
      }
      float* mp = (float*)(p.ws + OFF_MODP) + ((size_t)(l * 8 + ks) * 9) * 6144 + n;
#pragma unroll
      for (int r = 0; r < 9; r++) mp[(size_t)r * 6144] = acc[r];
      __syncthreads();
    } else {
      conv_item(p, 0, it - NMOD, sm);
    }
  }
}

__device__ __forceinline__ void phase_init1(const Params& p) {
  const float* mp = (const float*)(p.ws + OFF_MODP);
  float* mo = (float*)(p.ws + OFF_MOD);
  for (int i = blockIdx.x * NTHR + TIDX; i < 2 * 9 * 6144; i += gridDim.x * NTHR) {
    int l = i / (9 * 6144), rem = i - l * 9 * 6144, r = rem / 6144, n = rem - r * 6144;
    float s = p.ada_b[l * 6144 + n];
#pragma unroll
    for (int ks = 0; ks < 8; ks++) s += mp[((size_t)((l * 8 + ks) * 9 + r)) * 6144 + n];
    mo[i] = s;
  }
}

__device__ __forceinline__ void rowpass(const Params& p, int l, int mode) {
  const int lane = TIDX & 63, wv = TIDX >> 6;
  const float* MOD = (const float*)(p.ws + OFF_MOD);
  u16* H = (u16*)(p.ws + OFF_H);
  const bool do_norm = !(mode == 2 && l == 1);
  const int ln = (mode == 2) ? (l == 1 ? l : l + 1) : l;
  const int ni = (mode == 1) ? 2 : 0, sho = (mode == 1) ? 3072 : 0, sco = (mode == 1) ? 4096 : 1024;
  for (int r = blockIdx.x * 8 + wv; r < NROWS; r += gridDim.x * 8) {
    const int mr = mod_row(r);
    if (l == 1 && mode != 0 && mr == 8) continue;
    const float* modl = MOD + ((size_t)(l * 9 + mr)) * 6144;
    const float* modn = MOD + ((size_t)(ln * 9 + mr)) * 6144;
    const float* ng2 = p.norm_g + (size_t)(ln * 4 + ni) * DM;
    const float* xs = (mode == 0 || (mode == 1 && l == 0)) ? xin_row(p, r) : (const float*)x_row(p, r);
    float4 xo[4], n2[4], sc4[4], sh4[4];
#pragma unroll
    for (int i = 0; i < 4; i++) {
      const int col = i * 256 + lane * 4;
      xo[i] = *(const float4*)(xs + col);
      n2[i] = *(const float4*)(ng2 + col);
      sc4[i] = *(const float4*)(modn + sco + col);
      sh4[i] = *(const float4*)(modn + sho + col);
    }
    float xv[16];
    if (mode == 0) {
#pragma unroll
      for (int i = 0; i < 4; i++) { xv[i * 4 + 0] = xo[i].x; xv[i * 4 + 1] = xo[i].y; xv[i * 4 + 2] = xo[i].z; xv[i * 4 + 3] = xo[i].w; }
    } else {
      const u16* src = (const u16*)(p.ws + (mode == 1 ? OFF_BIG : OFF_YS)) + (size_t)r * DM;
      const float* ng = p.norm_g + (size_t)(l * 4 + (mode == 1 ? 1 : 3)) * DM;
      const float* gt = modl + (mode == 1 ? 2048 : 5120);
      uint2 sv[4];
      float4 g4[4], n4[4];
#pragma unroll
      for (int i = 0; i < 4; i++) {
        const int col = i * 256 + lane * 4;
        sv[i] = *(const uint2*)(src + col);
        g4[i] = *(const float4*)(gt + col);
        n4[i] = *(const float4*)(ng + col);
      }
      float ov[16];
      float ss = 0.f;
#pragma unroll
      for (int i = 0; i < 4; i++) {
        ov[i * 4 + 0] = __uint_as_float(sv[i].x << 16); ov[i * 4 + 1] = __uint_as_float(sv[i].x & 0xffff0000u);
        ov[i * 4 + 2] = __uint_as_float(sv[i].y << 16); ov[i * 4 + 3] = __uint_as_float(sv[i].y & 0xffff0000u);
      }
#pragma unroll
      for (int i = 0; i < 16; i++) ss += ov[i] * ov[i];
      ss = wsum(ss);
      const float inv = rsq(ss * (1.f / 1024.f) + 1e-6f);
      float* xd = x_row(p, r);
#pragma unroll
      for (int i = 0; i < 4; i++) {
        xv[i * 4 + 0] = xo[i].x + g4[i].x * (ov[i * 4 + 0] * inv * n4[i].x);
        xv[i * 4 + 1] = xo[i].y + g4[i].y * (ov[i * 4 + 1] * inv * n4[i].y);
        xv[i * 4 + 2] = xo[i].z + g4[i].z * (ov[i * 4 + 2] * inv * n4[i].z);
        xv[i * 4 + 3] = xo[i].w + g4[i].w * (ov[i * 4 + 3] * inv * n4[i].w);
      }
#pragma unroll
      for (int i = 0; i < 4; i++)
        *(float4*)(xd + i * 256 + lane * 4) = make_float4(xv[i * 4 + 0], xv[i * 4 + 1], xv[i * 4 + 2], xv[i * 4 + 3]);
    }
    if (!do_norm) continue;
    float ss2 = 0.f;
#pragma unroll
    for (int i = 0; i < 16; i++) ss2 += xv[i] * xv[i];
    ss2 = wsum(ss2);
    const float inv2 = rsq(ss2 * (1.f / 1024.f) + 1e-6f);
#pragma unroll
    for (int i = 0; i < 4; i++) {
      const int col = i * 256 + lane * 4;
      float h0 = xv[i * 4 + 0] * inv2 * n2[i].x * (1.f + sc4[i].x) + sh4[i].x;
      float h1 = xv[i * 4 + 1] * inv2 * n2[i].y * (1.f + sc4[i].y) + sh4[i].y;
      float h2 = xv[i * 4 + 2] * inv2 * n2[i].z * (1.f + sc4[i].z) + sh4[i].z;
      float h3 = xv[i * 4 + 3] * inv2 * n2[i].w * (1.f + sc4[i].w) + sh4[i].w;
      uint2 o;
      o.x = pack2(h0, h1);
      o.y = pack2(h2, h3);
      *(uint2*)(H + (size_t)r * DM + col) = o;
    }
  }
}

#define LDT 72
namespace pg8 {
#define PG8_LAS __attribute__((address_space(3)))
typedef unsigned short bf16_t;
typedef short bf16x8 __attribute__((ext_vector_type(8)));
typedef float f32x4 __attribute__((ext_vector_type(4)));
typedef unsigned u32x4 __attribute__((ext_vector_type(4)));
constexpr int BM = 256, BK = 64, HALF = 128, HTB = HALF * BK * 2  , STAGE_BYTES = 8 * HTB, NXCD = 8, WGM = 8;

__host__ __device__ __forceinline__ int lds_byte(int r, int c) { const int st = (r >> 4) * 2 + (c >> 5), rr = r & 15, cc = c & 31, ob = rr * 64 + cc * 2; return st * 1024 + (ob ^ (((ob >> 9) & 1) << 5)); }
__host__ __device__ __forceinline__ void stage_rc(int b, int& R, int& C) { const int st = b / 1024, sb = b % 1024, swz = sb ^ (((sb >> 9) & 1) << 5); R = (st >> 1) * 16 + swz / 64; C = (st & 1) * 32 + (swz % 64) / 2; }
__host__ __device__ __forceinline__ int perm32(int rho) { const int n = rho >> 4, i = rho & 15; return 8 * (i >> 2) + 4 * n + (i & 3); }

struct Unit { int pm, pn; };
struct Gemm { const bf16_t* A; const bf16_t* Bt; int M, N, K, lda; };
struct StaticOrder {
    int nM, nN, nwg, G, c, skip;
    __host__ __device__ void init(int M, int N, int G_, int c_, int skip_ = 0) { nM = M / BM; nN = N / BM; nwg = nM * nN; G = G_; c = c_; skip = skip_; }
    __host__ __device__ bool next(int i, Unit& u) const {
        const long L = (long)i * G + c; if (L >= nwg) return false;
        int wgid = (int)L; { const int q = nwg / NXCD, r = nwg % NXCD, xcd = wgid % NXCD, off = wgid / NXCD; wgid = (xcd < r ? xcd * (q + 1) : r * (q + 1) + (xcd - r) * q) + off; }
        const int nig = WGM * nN, gid = wgid / nig, fm = gid * WGM, gsz = (nM - fm) < WGM ? (nM - fm) : WGM;
        u.pm = fm + ((wgid % nig) % gsz); u.pn = (wgid % nig) / gsz;
        if (skip) u.pm = (u.pm >> 4) * 17 + 1 + (u.pm & 15);
        return true;
    }
    __device__ __forceinline__ void a_ready(const Unit&) const {}
    __device__ __forceinline__ void done(const Unit&) const {}
};
__device__ __forceinline__ unsigned cvt_pk_bf16(float lo, float hi) { unsigned r; asm volatile("v_cvt_pk_bf16_f32 %0, %1, %2" : "=v"(r) : "v"(lo), "v"(hi)); return r; }
template <class Epi, class Sched, bool STAMP = false>
__device__ __forceinline__ void gemm_phase(PG8_LAS unsigned char* lds, const Gemm g, const Sched& S, const Epi& E, unsigned long long* stamps) {
    const int tid = TIDX, wid = __builtin_amdgcn_readfirstlane(tid >> 6), lane = tid & 63, wr = wid >> 2, wc = wid & 3, fr = lane & 15, fq = lane >> 4;
    const int K = g.K, nt = K / BK;
    int ts_lo = 0, ts_hi = 0, nts = 0; const unsigned long long rt_entry = STAMP ? (unsigned long long)wall_clock64() : 0ull;
#define PG8_STAMP() do { if (STAMP && wid == 0 && nts < 64) { const unsigned long long _c = (unsigned long long)clock64(); \
        ts_lo = (lane == nts) ? (int)(unsigned)_c : ts_lo; ts_hi = (lane == nts) ? (int)(unsigned)(_c >> 32) : ts_hi; ++nts; } } while (0)
    PG8_STAMP();
    unsigned voffA[2], voffB[2];
#pragma unroll
    for (int i = 0; i < 2; ++i) { int R, C; stage_rc(tid * 16 + i * 8192, R, C); const int Rb = Epi::PERM ? ((R & ~31) + perm32(R & 31)) : R;
        voffA[i] = (unsigned)(R * g.lda + C) * 2u; voffB[i] = (unsigned)(Rb * K + C) * 2u; }
    const size_t kstep = (size_t)(BK * 2);
    const size_t hstepB = (size_t)HALF * K * 2, hstepA = (size_t)HALF * g.lda * 2;
    const size_t tstepB = 2 * hstepB, tstepA = 2 * hstepA;
    const unsigned ldsw = (unsigned)wid * 1024u;
    const int aoff = lds_byte(wr * 64 + fr, fq * 8), boff = lds_byte(wc * 32 + fr, fq * 8);
#define PG8_SA(b, h) (((b) * 2 + (h)) * HTB)
#define PG8_SB(b, h) ((4 + (b) * 2 + (h)) * HTB)
#define PG8_STAGE(bufoff, gbase, voff) do { _Pragma("unroll") for (int _i = 0; _i < 2; ++_i) \
        __builtin_amdgcn_global_load_lds((const unsigned*)((const char*)(gbase) + (voff)[_i]), (PG8_LAS unsigned*)(lds + (bufoff) + ldsw + _i * 8192), 16, 0, 0); } while (0)
#define PG8_LDA(dst, b, h) do { _Pragma("unroll") for (int m = 0; m < 4; ++m) _Pragma("unroll") for (int k = 0; k < 2; ++k) dst[m][k] = *(const PG8_LAS bf16x8*)(lds + PG8_SA(b, h) + aoff + m * 2048 + k * 1024); } while (0)
#define PG8_LDB(dst, b, h) do { _Pragma("unroll") for (int n = 0; n < 2; ++n) _Pragma("unroll") for (int k = 0; k < 2; ++k) dst[n][k] = *(const PG8_LAS bf16x8*)(lds + PG8_SB(b, h) + boff + n * 2048 + k * 1024); } while (0)
#define PG8_MMA(ai, bj, At, Bt) do { __builtin_amdgcn_s_setprio(1); _Pragma("unroll") for (int m = 0; m < 4; ++m) _Pragma("unroll") for (int n = 0; n < 2; ++n) _Pragma("unroll") for (int k = 0; k < 2; ++k) \
        acc[ai][bj][m][n] = __builtin_amdgcn_mfma_f32_16x16x32_bf16(Bt[n][k], At[m][k], acc[ai][bj][m][n], 0, 0, 0); __builtin_amdgcn_s_setprio(0); } while (0)
#define PG8_WAIT_V(n) asm volatile("s_waitcnt vmcnt(" #n ")" ::: "memory")
#define PG8_WAIT_L(n) asm volatile("s_waitcnt lgkmcnt(" #n ")" ::: "memory")
#define PG8_BAR __builtin_amdgcn_s_barrier()
#define PG8_SCHED __builtin_amdgcn_sched_barrier(0)
    Unit cur, nxt; int ui = 0;
    if (!S.next(0, cur)) return;
    f32x4 acc[2][2][4][2];
#pragma unroll
    for (int a = 0; a < 2; ++a)
#pragma unroll
        for (int b = 0; b < 2; ++b)
#pragma unroll
            for (int m = 0; m < 4; ++m)
#pragma unroll
                for (int n = 0; n < 2; ++n) acc[a][b][m][n] = (f32x4){0.f, 0.f, 0.f, 0.f};
    bf16x8 At[4][2], B0[2][2], B1[2][2];
    const char* cA = (const char*)g.A + (size_t)cur.pm * tstepA; const char* cB = (const char*)g.Bt + (size_t)cur.pn * tstepB;
    S.a_ready(cur);
    PG8_STAGE(PG8_SB(0, 0), cB, voffB); PG8_STAGE(PG8_SA(0, 0), cA, voffA); PG8_STAGE(PG8_SB(0, 1), cB + hstepB, voffB); PG8_STAGE(PG8_SA(0, 1), cA + hstepA, voffA);
    if (wr == 1) PG8_BAR;
    PG8_WAIT_V(4); PG8_BAR;
    PG8_STAGE(PG8_SB(1, 0), cB + kstep, voffB); PG8_STAGE(PG8_SA(1, 0), cA + kstep, voffA); PG8_STAGE(PG8_SB(1, 1), cB + hstepB + kstep, voffB);
    PG8_WAIT_V(6); PG8_BAR;
    PG8_STAMP();
    for (;;) {
        const bool has_next = S.next(ui + 1, nxt);
        const char* nA = has_next ? (const char*)g.A + (size_t)nxt.pm * tstepA : cA; const char* nB = has_next ? (const char*)g.Bt + (size_t)nxt.pn * tstepB : cB;
        for (int t = 0; t < nt; t += 2) {
            const bool last = (t == nt - 2);
            const char* a1 = cA + (size_t)(t + 1) * kstep;
            const char* a2 = last ? nA : cA + (size_t)(t + 2) * kstep; const char* b2 = last ? nB : cB + (size_t)(t + 2) * kstep;
            const char* a3 = a2 + kstep; const char* b3 = b2 + kstep;
            if (last && has_next) S.a_ready(nxt);
            PG8_LDB(B0, 0, 0); PG8_SCHED; PG8_LDA(At, 0, 0); PG8_STAGE(PG8_SA(1, 1), a1 + hstepA, voffA);
            PG8_WAIT_L(8); PG8_BAR; PG8_WAIT_L(0); PG8_MMA(0, 0, At, B0); PG8_BAR; PG8_SCHED;
            PG8_LDB(B1, 0, 1); PG8_STAGE(PG8_SB(0, 0), b2, voffB);
            PG8_BAR; PG8_WAIT_L(0); PG8_MMA(0, 1, At, B1); PG8_BAR;
            PG8_LDA(At, 0, 1); PG8_STAGE(PG8_SA(0, 0), a2, voffA);
            PG8_BAR; PG8_WAIT_L(0); PG8_MMA(1, 0, At, B0); PG8_BAR; PG8_SCHED;
            PG8_STAGE(PG8_SB(0, 1), b2 + hstepB, voffB);
            PG8_WAIT_V(6); PG8_BAR; PG8_MMA(1, 1, At, B1); PG8_BAR;
            PG8_LDB(B0, 1, 0); PG8_SCHED; PG8_LDA(At, 1, 0); PG8_STAGE(PG8_SA(0, 1), a2 + hstepA, voffA);
            PG8_WAIT_L(8); PG8_BAR; PG8_WAIT_L(0); PG8_MMA(0, 0, At, B0); PG8_BAR; PG8_SCHED;
            PG8_LDB(B1, 1, 1); PG8_STAGE(PG8_SB(1, 0), b3, voffB);
            PG8_BAR; PG8_WAIT_L(0); PG8_MMA(0, 1, At, B1); PG8_BAR;
            PG8_LDA(At, 1, 1); PG8_STAGE(PG8_SA(1, 0), a3, voffA);
            PG8_BAR; PG8_WAIT_L(0); PG8_MMA(1, 0, At, B0); PG8_BAR; PG8_SCHED;
            PG8_STAGE(PG8_SB(1, 1), b3 + hstepB, voffB);
            PG8_WAIT_V(6); PG8_BAR; PG8_MMA(1, 1, At, B1); PG8_BAR;
        }
        PG8_STAMP();
        if constexpr (!Epi::AFTER_DRAIN) { E(acc, cur, wr, wc, fr, fq); S.done(cur); }
        PG8_STAMP();
        if (!has_next) break;
#pragma unroll
        for (int a = 0; a < 2; ++a)
#pragma unroll
            for (int b = 0; b < 2; ++b)
#pragma unroll
                for (int m = 0; m < 4; ++m)
#pragma unroll
                    for (int n = 0; n < 2; ++n) acc[a][b][m][n] = (f32x4){0.f, 0.f, 0.f, 0.f};
        cur = nxt; cA = nA; cB = nB; ++ui;
    }
    PG8_WAIT_V(0);
    if (wr == 0) PG8_BAR;
    PG8_BAR;
    if constexpr (Epi::AFTER_DRAIN) { E.fused(acc, cur, wr, wc, fr, fq, lds, wid, lane); S.done(cur); }
    PG8_STAMP();
    if (STAMP && wid == 0) { stamps[lane] = lane < nts ? (((unsigned long long)(unsigned)ts_hi << 32) | (unsigned)ts_lo) : 0ull;
        if (lane == 62) stamps[62] = rt_entry; if (lane == 63) stamps[63] = (unsigned long long)wall_clock64(); }
#undef PG8_STAMP
#undef PG8_SA
#undef PG8_SB
#undef PG8_STAGE
#undef PG8_LDA
#undef PG8_LDB
#undef PG8_MMA
#undef PG8_WAIT_V
#undef PG8_WAIT_L
#undef PG8_BAR
#undef PG8_SCHED
}
}

struct EpiBf {
  static constexpr bool PERM = true, AFTER_DRAIN = false;
  u16* O; int ldc; const float* bias; int act;
  __device__ __forceinline__ void operator()(const f32x4 (&acc)[2][2][4][2], const pg8::Unit& u, int wr, int wc, int fr, int fq) const {
    const int row0 = u.pm * 256 + wr * 64 + fr, col0 = u.pn * 256 + wc * 32 + 8 * fq;
    f32x4 bv[2][2];
#pragma unroll
    for (int bj = 0; bj < 2; ++bj)
#pragma unroll
      for (int n = 0; n < 2; ++n) bv[bj][n] = bias ? *(const f32x4*)(bias + col0 + bj * 128 + 4 * n) : f32x4{0.f, 0.f, 0.f, 0.f};
#pragma unroll
    for (int ai = 0; ai < 2; ++ai)
#pragma unroll
      for (int m = 0; m < 4; ++m) {
        u16* rowp = O + (size_t)(row0 + ai * 128 + m * 16) * ldc + col0;
#pragma unroll
        for (int bj = 0; bj < 2; ++bj) {
          f32x4 v0 = acc[ai][bj][m][0] + bv[bj][0], v1 = acc[ai][bj][m][1] + bv[bj][1];
          if (act == 1) {
#pragma unroll
            for (int j = 0; j < 4; ++j) { v0[j] = sigm(v0[j]); v1[j] = sigm(v1[j]); }
          }
          uint4 wv;
          wv.x = pack2(v0[0], v0[1]); wv.y = pack2(v0[2], v0[3]); wv.z = pack2(v1[0], v1[1]); wv.w = pack2(v1[2], v1[3]);
          *(uint4*)(rowp + bj * 128) = wv;
        }
      }
  }
};
struct EpiSwiglu {
  static constexpr bool PERM = true, AFTER_DRAIN = false;
  u16* O;
  __device__ __forceinline__ void operator()(const f32x4 (&acc)[2][2][4][2], const pg8::Unit& u, int wr, int wc, int fr, int fq) const {
    const int row0 = u.pm * 256 + wr * 64 + fr, col0 = u.pn * 128 + wc * 16 + 4 * fq;
#pragma unroll
    for (int ai = 0; ai < 2; ++ai)
#pragma unroll
      for (int m = 0; m < 4; ++m) {
        u16* rowp = O + (size_t)(row0 + ai * 128 + m * 16) * FH + col0;
#pragma unroll
        for (int bj = 0; bj < 2; ++bj) {
          const f32x4 g = acc[ai][bj][m][0], up = acc[ai][bj][m][1];
          uint2 wv;
          wv.x = pack2(siluf(g[0]) * up[0], siluf(g[1]) * up[1]);
          wv.y = pack2(siluf(g[2]) * up[2], siluf(g[3]) * up[3]);
          *(uint2*)(rowp + bj * 64) = wv;
        }
      }
  }
};
struct EpiGateAcc {
  static constexpr bool PERM = true, AFTER_DRAIN = false;
  u16* ACC; const u16* G; int gcol; unsigned amask;
  __device__ __forceinline__ void operator()(const f32x4 (&acc)[2][2][4][2], const pg8::Unit& u, int wr, int wc, int fr, int fq) const {
    unsigned pk[2][2][4][4];
#pragma unroll
    for (int ai = 0; ai < 2; ++ai)
#pragma unroll
      for (int bj = 0; bj < 2; ++bj)
#pragma unroll
        for (int m = 0; m < 4; ++m) {
          pk[ai][bj][m][0] = pack2(acc[ai][bj][m][0][0], acc[ai][bj][m][0][1]);
          pk[ai][bj][m][1] = pack2(acc[ai][bj][m][0][2], acc[ai][bj][m][0][3]);
          pk[ai][bj][m][2] = pack2(acc[ai][bj][m][1][0], acc[ai][bj][m][1][1]);
          pk[ai][bj][m][3] = pack2(acc[ai][bj][m][1][2], acc[ai][bj][m][1][3]);
        }
    asm volatile("" ::: "memory");
    const int row0 = u.pm * 256 + wr * 64 + fr, col0 = u.pn * 256 + wc * 32 + 8 * fq;
#pragma unroll
    for (int ai = 0; ai < 2; ++ai)
#pragma unroll
      for (int m = 0; m < 4; ++m) {
        const size_t row = (size_t)(row0 + ai * 128 + m * 16);
#pragma unroll
        for (int bj = 0; bj < 2; ++bj) {
          const int col = col0 + bj * 128;
          const uint4 gv = *(const uint4*)(G + row * 2048 + gcol + col);
          const uint4 av = *(const uint4*)(ACC + row * DM + col);
          const unsigned gw[4] = {gv.x, gv.y, gv.z, gv.w};
          const unsigned aw[4] = {av.x & amask, av.y & amask, av.z & amask, av.w & amask};
          unsigned ow[4];
#pragma unroll
          for (int q = 0; q < 4; ++q) {
            const unsigned pv = pk[ai][bj][m][q];
            const float lo = __uint_as_float(aw[q] << 16) + __uint_as_float(gw[q] << 16) * __uint_as_float(pv << 16);
            const float hi = __uint_as_float(aw[q] & 0xffff0000u) + __uint_as_float(gw[q] & 0xffff0000u) * __uint_as_float(pv & 0xffff0000u);
            ow[q] = pack2(lo, hi);
          }
          *(uint4*)(ACC + row * DM + col) = make_uint4(ow[0], ow[1], ow[2], ow[3]);
        }
        asm volatile("" ::: "memory");
      }
  }
};

template <int MI>
__device__ __forceinline__ void gemm_loop(const u16* __restrict__ A, int lda, const u16* __restrict__ Bt, int ldb, int K,
                                          f32x4 (&acc)[MI][4], u16* sA, u16* sB) {
  constexpr int BMT = MI * 64;
  const int tid = TIDX, lane = tid & 63, w = tid >> 6, wm = w >> 1, wn = w & 1, fr = lane & 15, fq = lane >> 4;
  uint4 ra[MI], rb[2];
  const u16* ga = A + (size_t)(tid >> 3) * lda + (tid & 7) * 8;
  const u16* gb = Bt + (size_t)(tid >> 3) * ldb + (tid & 7) * 8;
  const int so = (tid >> 3) * LDT + (tid & 7) * 8;
#pragma unroll
  for (int i = 0; i < MI; i++) ra[i] = *(const uint4*)(ga + (size_t)(i * 64) * lda);
#pragma unroll
  for (int i = 0; i < 2; i++) rb[i] = *(const uint4*)(gb + (size_t)(i * 64) * ldb);
#pragma unroll
  for (int i = 0; i < MI; i++) *(uint4*)(sA + so + i * 64 * LDT) = ra[i];
#pragma unroll
  for (int i = 0; i < 2; i++) *(uint4*)(sB + so + i * 64 * LDT) = rb[i];
  __syncthreads();
  const int nk = K >> 6;
  for (int kt = 0; kt < nk; kt++) {
    const bool more = kt + 1 < nk;
    if (more) {
#pragma unroll
      for (int i = 0; i < MI; i++) ra[i] = *(const uint4*)(ga + (size_t)(i * 64) * lda + (kt + 1) * 64);
#pragma unroll
      for (int i = 0; i < 2; i++) rb[i] = *(const uint4*)(gb + (size_t)(i * 64) * ldb + (kt + 1) * 64);
    }
    const u16* a = sA + (kt & 1) * BMT * LDT + (wm * (MI * 16) + fr) * LDT + fq * 8;
    const u16* b = sB + (kt & 1) * 128 * LDT + (wn * 64 + fr) * LDT + fq * 8;
#pragma unroll
    for (int ks = 0; ks < 2; ks++) {
      bf16x8 af[MI], bfr[4];
#pragma unroll
      for (int i = 0; i < MI; i++) af[i] = *(const bf16x8*)(a + i * 16 * LDT + ks * 32);
#pragma unroll
      for (int j = 0; j < 4; j++) bfr[j] = *(const bf16x8*)(b + j * 16 * LDT + ks * 32);
#pragma unroll
      for (int i = 0; i < MI; i++)
#pragma unroll
        for (int j = 0; j < 4; j++) acc[i][j] = __builtin_amdgcn_mfma_f32_16x16x32_bf16(bfr[j], af[i], acc[i][j], 0, 0, 0);
    }
    if (more) {
      u16* da = sA + ((kt + 1) & 1) * BMT * LDT + so;
      u16* db = sB + ((kt + 1) & 1) * 128 * LDT + so;
#pragma unroll
      for (int i = 0; i < MI; i++) *(uint4*)(da + i * 64 * LDT) = ra[i];
#pragma unroll
      for (int i = 0; i < 2; i++) *(uint4*)(db + i * 64 * LDT) = rb[i];
    }
    __syncthreads();
  }
}

template <int MI>
__device__ __forceinline__ void zero_acc(f32x4 (&acc)[MI][4]) {
#pragma unroll
  for (int i = 0; i < MI; i++)
#pragma unroll
    for (int j = 0; j < 4; j++) acc[i][j] = f32x4{0.f, 0.f, 0.f, 0.f};
}


typedef unsigned u32x4v __attribute__((ext_vector_type(4)));
__device__ __forceinline__ void yp_issue(const u16* __restrict__ A, const u16* __restrict__ B, u32x4v (&ra)[8], u32x4v (&rb)[8], int tid) {
#pragma unroll
  for (int i = 0; i < 8; i++) {
    const int c = tid + i * NTHR, row = c >> 5, ch = c & 31;
    ra[i] = *(const u32x4v*)(A + (size_t)row * YST + ch * 8);
    rb[i] = *(const u32x4v*)(B + (size_t)row * 256 + ch * 8);
  }
}
__device__ __forceinline__ void yp_stage(unsigned char* sA, unsigned char* sB, const u32x4v (&ra)[8], const u32x4v (&rb)[8], int tid) {
#pragma unroll
  for (int i = 0; i < 8; i++) {
    const int c = tid + i * NTHR, row = c >> 5, ch = c & 31;
    const int off = row * 512 + ((ch ^ (row & 7)) << 4);
    *(u32x4v*)(sA + off) = ra[i];
    *(u32x4v*)(sB + off) = rb[i];
  }
}
__device__ __forceinline__ void phase_ypart(const Params& p, int l, unsigned char* smem) {
  unsigned char* sA = smem;
  unsigned char* sB = smem + 65536;
  const int tid = TIDX, lane = tid & 63, w = tid >> 6, wm = w >> 1, wn = w & 1, fr = lane & 15, fq = lane >> 4;
  const u16* Y = (const u16*)(p.ws + OFF_YS);
  const u16* Wb = (const u16*)(p.ws + OFF_W + OW_B);
  const u16* G = (const u16*)(p.ws + OFF_BIG);
  u16* ACC = (u16*)(p.ws + OFF_H);
  constexpr int NT = 8;
  const int ntiles = (NROWS / 128) * NT;
  const int G_ = gridDim.x;
  const bool xmap = (G_ == 256);
  const int xj = blockIdx.x >> 3, xx = blockIdx.x & 7;
  const bool skipc = (l == 1);
  const int nrt = skipc ? 256 : 272;
  const int ntl = nrt * NT;
  const int nmine = xmap ? (xj < nrt ? (nrt - 1 - xj) / 32 + 1 : 0)
                         : (((int)blockIdx.x < ntl) ? (ntl - 1 - (int)blockIdx.x) / G_ + 1 : 0);
  if (nmine == 0) return;
#define YP_TILE(Q_, MT_, NT_)                                                        \
  do {                                                                               \
    if (xmap) { const int s_ = (Q_) * 32 + xj; MT_ = (s_ >> 3) * 8 + xx; NT_ = s_ & 7; } \
    else { const int t_ = blockIdx.x + (Q_) * G_; MT_ = t_ / NT; NT_ = t_ - MT_ * NT; }  \
    if (skipc) MT_ = (MT_ >> 5) * 34 + 2 + (MT_ & 31);                                   \
  } while (0)
  u32x4v ra[8], rb[8];
  {
    int mt, nt;
    YP_TILE(0, mt, nt);
    yp_issue(Y + (size_t)mt * 128 * YST, Wb + ((size_t)nt * 128) * 256, ra, rb, tid);
  }
  f32x4 tot[2][4];
  zero_acc<2>(tot);
  for (int qi = 0; qi < 4 * nmine; qi++) {
    const int q = qi >> 2, k = qi & 3;
    int mt, nt;
    YP_TILE(q, mt, nt);
    const int r0 = mt * 128 + wm * 32 + fr, c0 = nt * 128 + wn * 64 + fq * 4;
    __syncthreads();
    yp_stage(sA, sB, ra, rb, tid);
    __syncthreads();
    {
      const int qn = qi + 1 < 4 * nmine ? qi + 1 : qi;
      int mtn, ntn;
      YP_TILE(qn >> 2, mtn, ntn);
      const int brn = qn & 3, ycn = brn < 3 ? brn * 256 : 1536;
      yp_issue(Y + (size_t)mtn * 128 * YST + ycn, Wb + ((size_t)brn * 1024 + ntn * 128) * 256, ra, rb, tid);
    }
    uint2 gv[2][4];
#pragma unroll
    for (int i = 0; i < 2; i++)
#pragma unroll
      for (int j = 0; j < 4; j++) gv[i][j] = *(const uint2*)(G + (size_t)(r0 + i * 16) * 4096 + k * 1024 + c0 + j * 16);
    f32x4 ay[2][4];
    zero_acc<2>(ay);
#pragma unroll 2
    for (int ks = 0; ks < 8; ks++) {
      bf16x8 af[2], bfr[4];
#pragma unroll
      for (int i = 0; i < 2; i++) {
        const int row = wm * 32 + i * 16 + fr;
        af[i] = *(const bf16x8*)(sA + row * 512 + (((ks * 4 + fq) ^ (row & 7)) << 4));
      }
#pragma unroll
      for (int j = 0; j < 4; j++) {
        const int row = wn * 64 + j * 16 + fr;
        bfr[j] = *(const bf16x8*)(sB + row * 512 + (((ks * 4 + fq) ^ (row & 7)) << 4));
      }
#pragma unroll
      for (int i = 0; i < 2; i++)
#pragma unroll
        for (int j = 0; j < 4; j++) ay[i][j] = __builtin_amdgcn_mfma_f32_16x16x32_bf16(bfr[j], af[i], ay[i][j], 0, 0, 0);
    }
#pragma unroll
    for (int i = 0; i < 2; i++)
#pragma unroll
      for (int j = 0; j < 4; j++) {
        tot[i][j][0] += __uint_as_float(gv[i][j].x << 16) * ay[i][j][0];
        tot[i][j][1] += __uint_as_float(gv[i][j].x & 0xffff0000u) * ay[i][j][1];
        tot[i][j][2] += __uint_as_float(gv[i][j].y << 16) * ay[i][j][2];
        tot[i][j][3] += __uint_as_float(gv[i][j].y & 0xffff0000u) * ay[i][j][3];
      }
    if (k == 3) {
#pragma unroll
      for (int i = 0; i < 2; i++)
#pragma unroll
        for (int j = 0; j < 4; j++) {
          uint2 ov;
          ov.x = pack2(tot[i][j][0], tot[i][j][1]); ov.y = pack2(tot[i][j][2], tot[i][j][3]);
          *(uint2*)(ACC + (size_t)(r0 + i * 16) * DM + c0 + j * 16) = ov;
        }
      zero_acc<2>(tot);
    }
  }
  __syncthreads();
#undef YP_TILE
}

#define S2_BUF 10816
#define S2_D 0
#define S2_U 2048
#define S2_P 4096
#define S2_K 6144
#define S2_DQ 8192
#define S2_V 10240
#define S2_C1 10752
#define S2_C2 10784
#define S2_ST (2 * S2_BUF)
#define S2_YB (S2_ST + 8192)

__device__ __forceinline__ float red16(float x) {
  x += dppf<0xB1>(x);
  x += dppf<0x4E>(x);
  x += dppf<0x141>(x);
  x += dppf<0x140>(x);
  return x;
}
__device__ __forceinline__ void wave_lds_sync() {
  asm volatile("s_waitcnt lgkmcnt(0)" ::: "memory");
  __builtin_amdgcn_wave_barrier();
}

template <int MIX>
__device__ __forceinline__ void scan2_item(const Params& p, int l, int b, int h, int dir, int rq, float* sm) {
  constexpr int EPL = (MIX == 2) ? 2 : 4;
  constexpr int VOFF = (MIX == 2) ? 64 : 128;
  const int tid = TIDX, lane = tid & 63, w = tid >> 6, fr = lane & 15, fq = lane >> 4;
  const bool producer = w >= 4;
  const int pw = w & 3;
  const u16* P = (const u16*)(p.ws + OFF_BIG);
  u16* YS = (u16*)(p.ws + OFF_YS);
  float* BC = (float*)(p.ws + OFF_BC);
  float* ST = sm + S2_ST + pw * 2048;
  float s[EPL];
#pragma unroll
  for (int i = 0; i < EPL; i++) s[i] = 0.f;

  bf16x8 bw2[4], ba2[4];
  float cst[5][4];
  float cw[3][7];
  float muv[4];
  int colv[4];
#pragma unroll
  for (int i = 0; i < 4; i++) { bw2[i] = bf16x8{0, 0, 0, 0, 0, 0, 0, 0}; ba2[i] = bw2[i]; muv[i] = 0.f; colv[i] = 0; }
  if (producer) {
    if (MIX == 0) {
#pragma unroll
      for (int nt = 0; nt < 4; nt++) {
        const int jch = h * 64 + nt * 16 + fr;
#pragma unroll
        for (int jj = 0; jj < 8; jj++) {
          bw2[nt][jj] = (short)f2bf(p.rwkv_w2[((size_t)(l * 2 + dir) * 32 + fq * 8 + jj) * 256 + jch]);
          ba2[nt][jj] = (short)f2bf(p.rwkv_a2[((size_t)(l * 2 + dir) * 32 + fq * 8 + jj) * 256 + jch]);
        }
        cst[0][nt] = p.rwkv_w0[(l * 2 + dir) * 256 + jch];
        cst[1][nt] = p.rwkv_a0[(l * 2 + dir) * 256 + jch];
        cst[2][nt] = p.rwkv_ka[l * 256 + jch];
        cst[3][nt] = p.rwkv_kk[l * 256 + jch];
        cst[4][nt] = p.rwkv_rk[l * 256 + jch];
      }
#pragma unroll
      for (int i = 0; i < 4; i++) {
        const int c = lane + 64 * i;
        colv[i] = i < 3 ? i * 256 + h * 64 + lane : (lane < 32 ? 768 + dir * 32 + lane : 832 + dir * 32 + (lane - 32));
        muv[i] = p.rwkv_mu[l * 960 + colv[i]];
        (void)c;
      }
    } else if (MIX == 1) {
#pragma unroll
      for (int i = 0; i < 3; i++) {
        colv[i] = PB + i * 256 + h * 64 + lane;
#pragma unroll
        for (int tp = 0; tp < 7; tp++) cw[i][tp] = p.gdn_conv[((size_t)l * 7 + tp) * 768 + i * 256 + h * 64 + lane];
      }
    } else {
#pragma unroll
      for (int nt = 0; nt < 2; nt++) {
#pragma unroll
        for (int jj = 0; jj < 8; jj++)
          bw2[nt][jj] = fq < 2 ? (short)f2bf(p.gla_gw2[((size_t)(l * 2 + dir) * 16 + fq * 8 + jj) * 128 + h * 32 + nt * 16 + fr]) : (short)0;
        cst[0][nt] = p.gla_gb[(l * 2 + dir) * 128 + h * 32 + nt * 16 + fr];
      }
      colv[0] = PC + h * 32 + lane;
      if (lane >= 32) colv[0] = PC + 128 + h * 32 + (lane - 32);
      colv[1] = PC + 256 + h * 64 + lane;
      colv[2] = PC + 512 + dir * 16 + (lane & 15);
    }
  }
  __syncthreads();

  for (int c = 0; c <= TPB / 32 + 1; c++) {
    if (producer) {
      if (c >= 2) {
        const int cc = c - 2;
        int seg_row0, t_lo;
        if (cc < 8) { seg_row0 = b * TPB; t_lo = dir == 0 ? cc * 32 : (LC - 32 - cc * 32); }
        else { seg_row0 = b * TPB + LC; t_lo = dir == 0 ? (cc - 8) * 32 : (SEQ - 32 - (cc - 8) * 32); }
        const float* yb = sm + S2_YB + (cc & 1) * 512;
        const int t2 = tid - 256;
#pragma unroll
        for (int i = 0; i < 2; i++) {
          const int idx = t2 + i * 256, tt = idx >> 4, e = idx & 15;
          YS[(size_t)(seg_row0 + t_lo + tt) * YST + dir * 768 + MIX * 256 + h * 64 + rq * 16 + e] = f2bf(yb[idx]);
        }
      }
      if (c < TPB / 32) {
        int seg_row0, seg_len, t_lo;
        if (c < 8) { seg_row0 = b * TPB; seg_len = LC; t_lo = dir == 0 ? c * 32 : (LC - 32 - c * 32); }
        else { seg_row0 = b * TPB + LC; seg_len = SEQ; t_lo = dir == 0 ? (c - 8) * 32 : (SEQ - 32 - (c - 8) * 32); }
        const u16* Pseg = P + (size_t)seg_row0 * PST;
        float* B = sm + (c & 1) * S2_BUF;
        const int t0 = t_lo + pw * 8;
        if (MIX == 0) {
          float raw[10][4];
#pragma unroll
          for (int rr = 0; rr < 10; rr++) {
            const int t = t0 - 1 + rr;
            const float okf = (t >= 0 && t < seg_len) ? 1.f : 0.f;
            const int tc = min(max(t, 0), seg_len - 1);
#pragma unroll
            for (int i = 0; i < 4; i++) raw[rr][i] = bf2f(Pseg[(size_t)tc * PST + PA + colv[i]]) * okf;
          }
#pragma unroll
          for (int j = 0; j < 8; j++)
#pragma unroll
            for (int i = 0; i < 4; i++) {
              float xm = raw[j + 1][i] + (0.5f * (raw[j][i] + raw[j + 2][i]) - raw[j + 1][i]) * muv[i];
              if (i == 3 && lane < 32) xm = tanh_fast(xm);
              ST[j * 256 + lane + 64 * i] = xm;
            }
        } else if (MIX == 1) {
          float raw[14][3];
#pragma unroll
          for (int rr = 0; rr < 14; rr++) {
            const int t = t0 - 3 + rr;
            const float okf = (t >= 0 && t < seg_len) ? 1.f : 0.f;
            const int tc = min(max(t, 0), seg_len - 1);
#pragma unroll
            for (int i = 0; i < 3; i++) raw[rr][i] = bf2f(Pseg[(size_t)tc * PST + colv[i]]) * okf;
          }
#pragma unroll
          for (int j = 0; j < 8; j++)
#pragma unroll
            for (int i = 0; i < 3; i++) {
              float a = 0.f;
#pragma unroll
              for (int tp = 0; tp < 7; tp++) a += raw[j + tp][i] * cw[i][tp];
              ST[j * 256 + lane + 64 * i] = siluf(a);
            }
          if (lane < 8) {
            const u16* pp = Pseg + (size_t)(t0 + lane) * PST + PB;
            float bx = bf2f(pp[768 + dir * 4 + h]);
            float ax = bf2f(pp[776 + dir * 4 + h]);
            float ld = -__expf(p.gdn_a_log[(l * 2 + dir) * 4 + h]) * softplusf(ax + p.gdn_dt_bias[(l * 2 + dir) * 4 + h]);
            ST[lane * 256 + 192] = sigm(bx);
            ST[lane * 256 + 193] = __expf(ld);
          }
        } else {
          u16 raw[8][3];
#pragma unroll
          for (int j = 0; j < 8; j++) {
            const u16* pp = Pseg + (size_t)(t0 + j) * PST;
#pragma unroll
            for (int i = 0; i < 3; i++) raw[j][i] = pp[colv[i]];
          }
          const float qs = lane < 32 ? 0.17677669529663687f : 1.f;
#pragma unroll
          for (int j = 0; j < 8; j++) {
            ST[j * 256 + lane] = bf2f(raw[j][0]) * qs;
            ST[j * 256 + 64 + lane] = bf2f(raw[j][1]);
            if (lane < 16) ST[j * 256 + 128 + lane] = bf2f(raw[j][2]);
          }
        }
        wave_lds_sync();
        const bool vl = fq < 2;
        if (MIX == 0) {
          bf16x8 aw, aa;
#pragma unroll
          for (int jj = 0; jj < 8; jj++) {
            aw[jj] = fr < 8 ? (short)f2bf(ST[fr * 256 + 192 + fq * 8 + jj]) : (short)0;
            aa[jj] = fr < 8 ? (short)f2bf(ST[fr * 256 + 224 + fq * 8 + jj]) : (short)0;
          }
          f32x4 accw[4], acca[4];
#pragma unroll
          for (int nt = 0; nt < 4; nt++) {
            accw[nt] = __builtin_amdgcn_mfma_f32_16x16x32_bf16(aw, bw2[nt], f32x4{0.f, 0.f, 0.f, 0.f}, 0, 0, 0);
            acca[nt] = __builtin_amdgcn_mfma_f32_16x16x32_bf16(aa, ba2[nt], f32x4{0.f, 0.f, 0.f, 0.f}, 0, 0, 0);
          }
#pragma unroll
          for (int r = 0; r < 4; r++) {
            const int j = (fq & 1) * 4 + r, tt = pw * 8 + j;
            float kkx[4], av[4], kdv[4], rv[4], dec[4];
            float ss = 0.f;
#pragma unroll
            for (int nt = 0; nt < 4; nt++) {
              const int n = nt * 16 + fr;
              rv[nt] = ST[j * 256 + n];
              const float kx = ST[j * 256 + 64 + n];
              dec[nt] = __expf(-0.6065306597126334f * sigm(cst[0][nt] + accw[nt][r]));
              av[nt] = sigm(cst[1][nt] + acca[nt][r]);
              kdv[nt] = kx * (1.f + (av[nt] - 1.f) * cst[2][nt]);
              kkx[nt] = kx * cst[3][nt];
              ss += kkx[nt] * kkx[nt];
            }
            ss = red16(ss);
            const float rs = rsq(ss + 1e-6f);
            float c1 = 0.f, c2 = 0.f, bc = 0.f;
#pragma unroll
            for (int nt = 0; nt < 4; nt++) {
              const int n = nt * 16 + fr;
              const float kk = kkx[nt] * rs;
              if (vl) {
                B[S2_D + tt * 64 + n] = dec[nt];
                B[S2_U + tt * 64 + n] = kk;
                B[S2_P + tt * 64 + n] = -kk * av[nt];
                B[S2_K + tt * 64 + n] = kdv[nt];
                B[S2_DQ + tt * 64 + n] = dec[nt] * rv[nt];
              }
              c1 += -kk * av[nt] * rv[nt];
              c2 += kdv[nt] * rv[nt];
              bc += rv[nt] * kdv[nt] * cst[4][nt];
            }
            c1 = red16(c1); c2 = red16(c2); bc = red16(bc);
            if (vl && fr == 0) {
              B[S2_C1 + tt] = c1;
              B[S2_C2 + tt] = c2;
              if (rq == 0) BC[(size_t)(seg_row0 + t_lo + tt) * 8 + h * 2 + dir] = bc;
            }
          }
        } else if (MIX == 1) {
#pragma unroll
          for (int r = 0; r < 4; r++) {
            const int j = (fq & 1) * 4 + r, tt = pw * 8 + j;
            float qv[4], kv[4];
            float sq = 0.f, sk = 0.f;
#pragma unroll
            for (int nt = 0; nt < 4; nt++) {
              const int n = nt * 16 + fr;
              qv[nt] = ST[j * 256 + n];
              kv[nt] = ST[j * 256 + 64 + n];
              sq += qv[nt] * qv[nt];
              sk += kv[nt] * kv[nt];
            }
            sq = red16(sq); sk = red16(sk);
            const float rq_ = rsq(sq + 1e-6f) * 0.125f, rk_ = rsq(sk + 1e-6f);
            const float beta = ST[j * 256 + 192], alpha = ST[j * 256 + 193];
            float dkq = 0.f;
#pragma unroll
            for (int nt = 0; nt < 4; nt++) {
              const int n = nt * 16 + fr;
              const float qn = qv[nt] * rq_, kn = kv[nt] * rk_;
              if (vl) {
                B[S2_D + tt * 64 + n] = alpha;
                B[S2_U + tt * 64 + n] = kn;
                B[S2_P + tt * 64 + n] = -alpha * beta * kn;
                B[S2_K + tt * 64 + n] = beta * kn;
                B[S2_DQ + tt * 64 + n] = alpha * qn;
              }
              dkq += kn * qn;
            }
            dkq = red16(dkq);
            if (vl && fr == 0) {
              B[S2_C1 + tt] = -alpha * beta * dkq;
              B[S2_C2 + tt] = beta * dkq;
            }
          }
        } else {
          bf16x8 ag;
#pragma unroll
          for (int jj = 0; jj < 8; jj++) ag[jj] = (fr < 8 && fq < 2) ? (short)f2bf(ST[fr * 256 + 128 + fq * 8 + jj]) : (short)0;
          f32x4 accg[2];
#pragma unroll
          for (int nt = 0; nt < 2; nt++) accg[nt] = __builtin_amdgcn_mfma_f32_16x16x32_bf16(ag, bw2[nt], f32x4{0.f, 0.f, 0.f, 0.f}, 0, 0, 0);
#pragma unroll
          for (int r = 0; r < 4; r++) {
            const int j = (fq & 1) * 4 + r, tt = pw * 8 + j;
            float dkq = 0.f;
#pragma unroll
            for (int nt = 0; nt < 2; nt++) {
              const int n = nt * 16 + fr;
              const float lg = cst[0][nt] + accg[nt][r];
              const float ls = fminf(lg, 0.f) - __logf(1.f + __expf(-fabsf(lg)));
              const float alpha = __expf(ls * (1.f / 16.f));
              const float qv = ST[j * 256 + n], kv = ST[j * 256 + 32 + n];
              if (vl) {
                B[S2_D + tt * 64 + n] = alpha;
                B[S2_K + tt * 64 + n] = kv;
                B[S2_DQ + tt * 64 + n] = alpha * qv;
              }
              dkq += kv * qv;
            }
            dkq = red16(dkq);
            if (vl && fr == 0) B[S2_C2 + tt] = dkq;
          }
        }
#pragma unroll
        for (int i = 0; i < 2; i++) {
          const int idx = lane + 64 * i, j = idx >> 4, e = idx & 15;
          B[S2_V + (pw * 8 + j) * 16 + e] = ST[j * 256 + VOFF + rq * 16 + e];
        }
      }
    } else if (c >= 1 && c <= TPB / 32) {
      const float* B = sm + ((c - 1) & 1) * S2_BUF;
      float* yb = sm + S2_YB + ((c - 1) & 1) * 512;
      const int rl = w * 4 + fq;
      const int dtt = dir ? -1 : 1;
      int tt = dir ? 31 : 0;
      float dv[EPL], kv[EPL], qv[EPL], uv[EPL], pv[EPL], vv, c1v, c2v;
      float dn[EPL], kn[EPL], qn[EPL], un[EPL], pn[EPL], vn, c1n, c2n;
#define S2_LOAD(D_, K_, Q_, U_, P_, V_, C1_, C2_, T_)                                   \
  do {                                                                                  \
    const int o_ = (T_) * 64 + fr * EPL;                                                \
    if (EPL == 4) {                                                                     \
      float4 t4 = *(const float4*)(B + S2_D + o_);                                      \
      D_[0] = t4.x; D_[1] = t4.y; D_[2] = t4.z; D_[3] = t4.w;                           \
      t4 = *(const float4*)(B + S2_K + o_);                                             \
      K_[0] = t4.x; K_[1] = t4.y; K_[2] = t4.z; K_[3] = t4.w;                           \
      t4 = *(const float4*)(B + S2_DQ + o_);                                            \
      Q_[0] = t4.x; Q_[1] = t4.y; Q_[2] = t4.z; Q_[3] = t4.w;                           \
      t4 = *(const float4*)(B + S2_U + o_);                                             \
      U_[0] = t4.x; U_[1] = t4.y; U_[2] = t4.z; U_[3] = t4.w;                           \
      t4 = *(const float4*)(B + S2_P + o_);                                             \
      P_[0] = t4.x; P_[1] = t4.y; P_[2] = t4.z; P_[3] = t4.w;                           \
      C1_ = B[S2_C1 + (T_)];                                                            \
    } else {                                                                            \
      float2 t2 = *(const float2*)(B + S2_D + o_);                                      \
      D_[0] = t2.x; D_[1] = t2.y;                                                       \
      t2 = *(const float2*)(B + S2_K + o_);                                             \
      K_[0] = t2.x; K_[1] = t2.y;                                                       \
      t2 = *(const float2*)(B + S2_DQ + o_);                                            \
      Q_[0] = t2.x; Q_[1] = t2.y;                                                       \
      U_[0] = U_[1] = P_[0] = P_[1] = 0.f; C1_ = 0.f;                                   \
    }                                                                                   \
    V_ = B[S2_V + (T_) * 16 + rl];                                                      \
    C2_ = B[S2_C2 + (T_)];                                                              \
  } while (0)
#define S2_STEP(D_, K_, Q_, U_, P_, V_, C1_, C2_, T_)                                   \
  do {                                                                                  \
    float sq = 0.f, sa = 0.f;                                                           \
    _Pragma("unroll") for (int i = 0; i < EPL; i++) sq += s[i] * Q_[i];                 \
    if (MIX != 2) {                                                                     \
      _Pragma("unroll") for (int i = 0; i < EPL; i++) sa += s[i] * U_[i];               \
      sa = red16(sa);                                                                   \
    }                                                                                   \
    sq = red16(sq);                                                                     \
    float y = sq + V_ * C2_;                                                            \
    if (MIX != 2) y += sa * C1_;                                                        \
    _Pragma("unroll") for (int i = 0; i < EPL; i++) {                                   \
      float t = s[i] * D_[i] + V_ * K_[i];                                              \
      if (MIX != 2) t += sa * P_[i];                                                    \
      s[i] = t;                                                                         \
    }                                                                                   \
    yb[(T_) * 16 + rl] = y;                                                             \
  } while (0)
      S2_LOAD(dv, kv, qv, uv, pv, vv, c1v, c2v, tt);
#pragma unroll 1
      for (int st = 0; st < 32; st += 2) {
        const int t1 = tt + dtt;
        S2_LOAD(dn, kn, qn, un, pn, vn, c1n, c2n, t1);
        S2_STEP(dv, kv, qv, uv, pv, vv, c1v, c2v, tt);
        const int t2 = st + 2 < 32 ? t1 + dtt : t1;
        S2_LOAD(dv, kv, qv, uv, pv, vv, c1v, c2v, t2);
        S2_STEP(dn, kn, qn, un, pn, vn, c1n, c2n, t1);
        tt = t2;
      }
#undef S2_LOAD
#undef S2_STEP
    }
    __syncthreads();
  }
}

#define S3_SUB 12800
#define S3_GM 0
#define S3_KVT 9216
#define S3_QB 10240
#define S3_QV 11392
#define S3_VT 11520
#define S3_WC 12544
#define S3_TB S3_QV
#define S3_QBM (S3_GM + 3072)
#define S3_QKM (S3_GM + 3200)
#define S3_KB (S3_GM + 0)
#define S3_BT (S3_GM + 2048)
#define S3_STB (8 * S3_SUB)
#define S3_END (S3_STB + 4 * 2304)

__device__ __forceinline__ float rlane(float x, int l) { return __int_as_float(__builtin_amdgcn_readlane(__float_as_int(x), l)); }
__device__ __forceinline__ float wave_sum(float x) {
  x = red16(x);
  return (rlane(x, 0) + rlane(x, 16)) + (rlane(x, 32) + rlane(x, 48));
}
__device__ __forceinline__ float clampe(float x) { return fminf(fmaxf(x, -80.f), 80.f); }
__device__ __forceinline__ uint4 pack8(const float (&v)[8]) {
  return make_uint4(pack2(v[0], v[1]), pack2(v[2], v[3]), pack2(v[4], v[5]), pack2(v[6], v[7]));
}
__device__ __forceinline__ bf16x8 ld_frag(const void* p) { return *(const bf16x8*)p; }
__device__ __forceinline__ bf16x8 zfrag() { return bf16x8{0, 0, 0, 0, 0, 0, 0, 0}; }

__device__ __forceinline__ void chunk_geom(int c, int dir, int b, int& seg_row0, int& seg_len, int& t_lo) {
  if (c < 8) { seg_row0 = b * TPB; seg_len = LC; t_lo = dir == 0 ? c * 32 : (LC - 32 - c * 32); }
  else { seg_row0 = b * TPB + LC; seg_len = SEQ; t_lo = dir == 0 ? (c - 8) * 32 : (SEQ - 32 - (c - 8) * 32); }
}
template <int MIX>
__device__ __forceinline__ void fetch_raw(const u16* P, int c, int dir, int b, int h, int pw, int lane, const int (&colv)[4], unsigned (&rawq)[14][2]) {
  int seg_row0, seg_len, t_lo;
  chunk_geom(c, dir, b, seg_row0, seg_len, t_lo);
  const u16* Pseg = P + (size_t)seg_row0 * PST;
  const int t0 = t_lo + pw * 8;
  if (MIX == 0) {
#pragma unroll
    for (int rr = 0; rr < 10; rr++) {
      const int tc = min(max(t0 - 1 + rr, 0), seg_len - 1);
#pragma unroll
      for (int i = 0; i < 2; i++)
        rawq[rr][i] = (unsigned)Pseg[(size_t)tc * PST + PA + colv[2 * i]] | ((unsigned)Pseg[(size_t)tc * PST + PA + colv[2 * i + 1]] << 16);
    }
  } else if (MIX == 1) {
#pragma unroll
    for (int rr = 0; rr < 14; rr++) {
      const int tc = min(max(t0 - 3 + rr, 0), seg_len - 1);
      rawq[rr][0] = (unsigned)Pseg[(size_t)tc * PST + colv[0]] | ((unsigned)Pseg[(size_t)tc * PST + colv[1]] << 16);
      rawq[rr][1] = (rawq[rr][1] & 0xffff0000u) | (unsigned)Pseg[(size_t)tc * PST + colv[2]];
    }
    const u16* pp = Pseg + (size_t)(t0 + (lane & 7)) * PST + PB;
    rawq[0][1] = (rawq[0][1] & 0xffffu) | ((unsigned)pp[768 + dir * 4 + h] << 16);
    rawq[1][1] = (rawq[1][1] & 0xffffu) | ((unsigned)pp[776 + dir * 4 + h] << 16);
  } else {
#pragma unroll
    for (int j = 0; j < 8; j++) {
      const u16* pp = Pseg + (size_t)(t0 + j) * PST;
      rawq[j][0] = (unsigned)pp[colv[0]] | ((unsigned)pp[colv[1]] << 16);
      rawq[j][1] = (unsigned)pp[colv[2]];
    }
  }
}

template <int MIX>
__device__ __forceinline__ void scan3_item(const Params& p, int l, int b, int h, int dir, unsigned char* smb) {
  constexpr int VOFF = (MIX == 2) ? 64 : 128;
  constexpr bool DELTA = (MIX != 2);
  const int tid = TIDX, lane = tid & 63, w = tid >> 6, fr = lane & 15, fq = lane >> 4;
  const bool producer = true;
  const int pw = w & 3, half = w >> 2;
  const u16* P = (const u16*)(p.ws + OFF_BIG);
  u16* YS = (u16*)(p.ws + OFF_YS);
  float* BC = (float*)(p.ws + OFF_BC);
  float* ST = (float*)(smb + w * S3_SUB + S3_GM);
  unsigned char* STBY = smb + w * S3_SUB + S3_GM;
  const f32x4 z4 = f32x4{0.f, 0.f, 0.f, 0.f};
  f32x4 st[4];
#pragma unroll
  for (int i = 0; i < 4; i++) st[i] = z4;

  bf16x8 bw2[4], ba2[4];
  float cw[3][7];
  float muv[4];
  int colv[4];
  float c_w0 = 0.f, c_a0 = 0.f, c_ka = 0.f, c_kk = 0.f, c_rk = 0.f, c_gb = 0.f;
#pragma unroll
  for (int i = 0; i < 4; i++) { bw2[i] = zfrag(); ba2[i] = zfrag(); muv[i] = 0.f; colv[i] = 0; }
  if (producer) {
    if (MIX == 0) {
      {
        float tw[4][8], ta[4][8];
#pragma unroll
        for (int nt = 0; nt < 4; nt++)
#pragma unroll
          for (int jj = 0; jj < 8; jj++) {
            tw[nt][jj] = p.rwkv_w2[((size_t)(l * 2 + dir) * 32 + fq * 8 + jj) * 256 + h * 64 + nt * 16 + fr];
            ta[nt][jj] = p.rwkv_a2[((size_t)(l * 2 + dir) * 32 + fq * 8 + jj) * 256 + h * 64 + nt * 16 + fr];
          }
#pragma unroll
        for (int nt = 0; nt < 4; nt++)
#pragma unroll
          for (int jj = 0; jj < 8; jj++) { bw2[nt][jj] = (short)f2bf(tw[nt][jj]); ba2[nt][jj] = (short)f2bf(ta[nt][jj]); }
      }
      const int jl = h * 64 + lane;
      c_w0 = p.rwkv_w0[(l * 2 + dir) * 256 + jl];
      c_a0 = p.rwkv_a0[(l * 2 + dir) * 256 + jl];
      c_ka = p.rwkv_ka[l * 256 + jl];
      c_kk = p.rwkv_kk[l * 256 + jl];
      c_rk = p.rwkv_rk[l * 256 + jl];
#pragma unroll
      for (int i = 0; i < 4; i++) {
        colv[i] = i < 3 ? i * 256 + h * 64 + lane : (lane < 32 ? 768 + dir * 32 + lane : 832 + dir * 32 + (lane - 32));
        muv[i] = p.rwkv_mu[l * 960 + colv[i]];
      }
    } else if (MIX == 1) {
#pragma unroll
      for (int i = 0; i < 3; i++) {
        colv[i] = PB + i * 256 + h * 64 + lane;
#pragma unroll
        for (int tp = 0; tp < 7; tp++) cw[i][tp] = p.gdn_conv[((size_t)l * 7 + tp) * 768 + i * 256 + h * 64 + lane];
      }
    } else {
      {
        float tg[2][8];
#pragma unroll
        for (int nt = 0; nt < 2; nt++)
#pragma unroll
          for (int jj = 0; jj < 8; jj++) tg[nt][jj] = p.gla_gw2[((size_t)(l * 2 + dir) * 16 + (fq & 1) * 8 + jj) * 128 + h * 32 + nt * 16 + fr];
#pragma unroll
        for (int nt = 0; nt < 2; nt++)
#pragma unroll
          for (int jj = 0; jj < 8; jj++) bw2[nt][jj] = fq < 2 ? (short)f2bf(tg[nt][jj]) : (short)0;
      }
      c_gb = p.gla_gb[(l * 2 + dir) * 128 + h * 32 + (lane & 31)];
      colv[0] = PC + h * 32 + lane;
      if (lane >= 32) colv[0] = PC + 128 + h * 32 + (lane - 32);
      colv[1] = PC + 256 + h * 64 + lane;
      colv[2] = PC + 512 + dir * 16 + (lane & 15);
    }
  }
  __syncthreads();
  unsigned rawq[14][2];
#pragma unroll
  for (int i = 0; i < 14; i++) { rawq[i][0] = 0u; rawq[i][1] = 0u; }
  fetch_raw<MIX>(P, half, dir, b, h, pw, lane, colv, rawq);
#define RAWP(r_, i_) ((u16)((rawq[r_][(i_) >> 1] >> (((i_) & 1) * 16)) & 0xffffu))

  for (int it = 0; it < TPB / 64; it++) {
    {
      {
        const int c = it * 2 + half;
        int seg_row0, seg_len, t_lo;
        chunk_geom(c, dir, b, seg_row0, seg_len, t_lo);
        unsigned char* SB = smb + w * S3_SUB;
        const int t0 = t_lo + pw * 8;
        if (MIX == 0) {
          float raw[10][4];
#pragma unroll
          for (int rr = 0; rr < 10; rr++) {
            const int t = t0 - 1 + rr;
            const float okf = (t >= 0 && t < seg_len) ? 1.f : 0.f;
#pragma unroll
            for (int i = 0; i < 4; i++) raw[rr][i] = bf2f(RAWP(rr, i)) * okf;
          }
#pragma unroll
          for (int j = 0; j < 8; j++)
#pragma unroll
            for (int i = 0; i < 4; i++) {
              float xm = raw[j + 1][i] + (0.5f * (raw[j][i] + raw[j + 2][i]) - raw[j + 1][i]) * muv[i];
              if (i == 3 && lane < 32) xm = tanh_fast(xm);
              ST[j * 256 + lane + 64 * i] = xm;
            }
        } else if (MIX == 1) {
          float raw[14][3];
#pragma unroll
          for (int rr = 0; rr < 14; rr++) {
            const int t = t0 - 3 + rr;
            const float okf = (t >= 0 && t < seg_len) ? 1.f : 0.f;
#pragma unroll
            for (int i = 0; i < 3; i++) raw[rr][i] = bf2f(RAWP(rr, i)) * okf;
          }
#pragma unroll
          for (int j = 0; j < 8; j++)
#pragma unroll
            for (int i = 0; i < 3; i++) {
              float a = 0.f;
#pragma unroll
              for (int tp = 0; tp < 7; tp++) a += raw[j + tp][i] * cw[i][tp];
              ST[j * 256 + lane + 64 * i] = siluf(a);
            }
          if (lane < 8) {
            float bx = bf2f(RAWP(0, 3));
            float ax = bf2f(RAWP(1, 3));
            float ld = -__expf(p.gdn_a_log[(l * 2 + dir) * 4 + h]) * softplusf(ax + p.gdn_dt_bias[(l * 2 + dir) * 4 + h]);
            ST[lane * 256 + 192] = sigm(bx);
            ST[lane * 256 + 193] = ld;
          }
        } else {
          const float qs = lane < 32 ? 0.17677669529663687f : 1.f;
#pragma unroll
          for (int j = 0; j < 8; j++) {
            ST[j * 256 + lane] = bf2f(RAWP(j, 0)) * qs;
            ST[j * 256 + 64 + lane] = bf2f(RAWP(j, 1));
            if (lane < 16) ST[j * 256 + 128 + lane] = bf2f(RAWP(j, 2));
          }
        }
        wave_lds_sync();
        {
          float vv[8];
#pragma unroll
          for (int i = 0; i < 8; i++) vv[i] = ST[(dir ? 7 - i : i) * 256 + VOFF + lane];
          *(uint4*)(SB + S3_VT + lane * 16) = pack8(vv);
        }
        if (MIX == 0) {
          bf16x8 aw, aa;
#pragma unroll
          for (int jj = 0; jj < 8; jj++) {
            aw[jj] = fr < 8 ? (short)f2bf(ST[fr * 256 + 192 + fq * 8 + jj]) : (short)0;
            aa[jj] = fr < 8 ? (short)f2bf(ST[fr * 256 + 224 + fq * 8 + jj]) : (short)0;
          }
          f32x4 accw[4], acca[4];
#pragma unroll
          for (int nt = 0; nt < 4; nt++) {
            accw[nt] = __builtin_amdgcn_mfma_f32_16x16x32_bf16(aw, bw2[nt], z4, 0, 0, 0);
            acca[nt] = __builtin_amdgcn_mfma_f32_16x16x32_bf16(aa, ba2[nt], z4, 0, 0, 0);
          }
          wave_lds_sync();
          if (fq < 2) {
#pragma unroll
            for (int nt = 0; nt < 4; nt++)
#pragma unroll
              for (int r = 0; r < 4; r++) {
                ST[(fq * 4 + r) * 256 + 128 + nt * 16 + fr] = accw[nt][r];
                ST[(fq * 4 + r) * 256 + 192 + nt * 16 + fr] = acca[nt][r];
              }
          }
          wave_lds_sync();
        } else if (MIX == 2) {
          bf16x8 ag;
#pragma unroll
          for (int jj = 0; jj < 8; jj++) ag[jj] = (fr < 8 && fq < 2) ? (short)f2bf(ST[fr * 256 + 128 + fq * 8 + jj]) : (short)0;
          f32x4 accg[2];
#pragma unroll
          for (int nt = 0; nt < 2; nt++) accg[nt] = __builtin_amdgcn_mfma_f32_16x16x32_bf16(ag, bw2[nt], z4, 0, 0, 0);
          if (fq < 2) {
#pragma unroll
            for (int nt = 0; nt < 2; nt++)
#pragma unroll
              for (int r = 0; r < 4; r++) ST[(fq * 4 + r) * 256 + 192 + nt * 16 + fr] = accg[nt][r];
          }
          wave_lds_sync();
        }
        float logd[8], kap[8], bb[8], kp[8], qq[8];
        if (MIX == 0) {
          float a8[8], p1[8], p2[8];
#pragma unroll
          for (int i = 0; i < 8; i++) {
            const float* row = ST + (dir ? 7 - i : i) * 256;
            const float r_ = row[lane], k_ = row[64 + lane];
            const float sg = sigm(c_w0 + row[128 + lane]);
            a8[i] = sigm(c_a0 + row[192 + lane]);
            kp[i] = k_ * (1.f + (a8[i] - 1.f) * c_ka);
            kap[i] = k_ * c_kk;
            qq[i] = r_;
            logd[i] = -0.6065306597126334f * sg;
            p1[i] = kap[i] * kap[i];
            p2[i] = r_ * kp[i] * c_rk;
          }
#pragma unroll
          for (int i = 0; i < 8; i++) { p1[i] = red16(p1[i]); p2[i] = red16(p2[i]); }
#pragma unroll
          for (int i = 0; i < 8; i++) {
            const float ss = (rlane(p1[i], 0) + rlane(p1[i], 16)) + (rlane(p1[i], 32) + rlane(p1[i], 48));
            const float bc = (rlane(p2[i], 0) + rlane(p2[i], 16)) + (rlane(p2[i], 32) + rlane(p2[i], 48));
            kap[i] *= rsq(ss + 1e-6f);
            bb[i] = kap[i] * a8[i];
            if (lane == 0) BC[(size_t)(seg_row0 + t0 + (dir ? 7 - i : i)) * 8 + h * 2 + dir] = bc;
          }
        } else {
#pragma unroll
        for (int i = 0; i < 8; i++) {
          const int j = dir ? 7 - i : i;
          const float* row = ST + j * 256;
          if (MIX == 1) {
            const float q_ = row[lane], k_ = row[64 + lane];
            const float sq = wave_sum(q_ * q_), sk = wave_sum(k_ * k_);
            const float qn = q_ * rsq(sq + 1e-6f) * 0.125f, kn = k_ * rsq(sk + 1e-6f);
            const float beta = row[192], ld = row[193];
            const float alpha = __expf(ld);
            logd[i] = ld;
            kap[i] = kn; bb[i] = alpha * beta * kn; kp[i] = beta * kn; qq[i] = qn;
          } else {
            const int n = lane & 31;
            const float lg = c_gb + row[192 + n];
            const float ls = fminf(lg, 0.f) - __logf(1.f + __expf(-fabsf(lg)));
            logd[i] = ls * (1.f / 16.f);
            kap[i] = 0.f; bb[i] = 0.f;
            kp[i] = lane < 32 ? row[32 + n] : 0.f;
            qq[i] = lane < 32 ? row[n] : 0.f;
          }
        }
        }
        wave_lds_sync();
        float kt[8], qt[8], bck[8], kck[8];
        {
          float L[8];
          float run = 0.f;
#pragma unroll
          for (int i = 0; i < 8; i++) { run += logd[i]; L[i] = run; }
          const float Lr = L[3], L7 = L[7];
          float prevE = __expf(clampe(-Lr)), prevT = 1.f;
          u16* OPA = (u16*)STBY;
#pragma unroll
          for (int i = 0; i < 8; i++) {
            const float eI = __expf(clampe(L[i] - Lr)), eInv = __expf(clampe(Lr - L[i]));
            const float tI = __expf(L[i]), eEnd = __expf(L7 - L[i]);
            if (DELTA) {
              OPA[0 * 576 + i * 72 + lane] = f2bf(kap[i] * prevE);
              OPA[1 * 576 + i * 72 + lane] = f2bf(bb[i] * eInv);
            }
            OPA[2 * 576 + i * 72 + lane] = f2bf(kp[i] * eInv);
            OPA[3 * 576 + i * 72 + lane] = f2bf(qq[i] * eI);
            kt[i] = kap[i] * prevT; qt[i] = qq[i] * tI;
            bck[i] = bb[i] * eEnd; kck[i] = kp[i] * eEnd;
            prevE = eI; prevT = tI;
          }
          *(float*)(SB + S3_WC + lane * 4) = __expf(L7);
        }
        wave_lds_sync();
        f32x4 accA = z4, accBm = z4, accQb = z4, accQk = z4;
        {
          const u16* OPA = (const u16*)STBY;
          const int ro = (fr & 7) * 72 + fq * 8;
#pragma unroll
          for (int ks = 0; ks < 2; ks++) {
            const bf16x8 fk = ld_frag(OPA + 2 * 576 + ro + ks * 32), fqh = ld_frag(OPA + 3 * 576 + ro + ks * 32);
            accQk = __builtin_amdgcn_mfma_f32_16x16x32_bf16(fqh, fk, accQk, 0, 0, 0);
            if (DELTA) {
              const bf16x8 fka = ld_frag(OPA + 0 * 576 + ro + ks * 32), fb = ld_frag(OPA + 1 * 576 + ro + ks * 32);
              accA = __builtin_amdgcn_mfma_f32_16x16x32_bf16(fka, fb, accA, 0, 0, 0);
              accBm = __builtin_amdgcn_mfma_f32_16x16x32_bf16(fka, fk, accBm, 0, 0, 0);
              accQb = __builtin_amdgcn_mfma_f32_16x16x32_bf16(fqh, fb, accQb, 0, 0, 0);
            }
          }
#pragma unroll
          for (int r = 0; r < 4; r++) {
            const int i = fq * 4 + r;
            const bool ok = fq < 2 && fr < 8;
            if (!(ok && fr < i)) { accA[r] = 0.f; accBm[r] = 0.f; }
            if (!(ok && fr <= i)) { accQb[r] = 0.f; accQk[r] = 0.f; }
          }
        }
        *(uint4*)(SB + S3_KVT + lane * 16) = pack8(kck);
#pragma unroll
        for (int i = 0; i < 8; i++) ((u16*)(SB + S3_QB))[i * 72 + lane] = f2bf(qt[i]);
        if (fq < 2 && fr < 8) {
#pragma unroll
          for (int r = 0; r < 4; r++) {
            ((u16*)(SB + S3_QKM))[(fq * 4 + r) * 8 + fr] = f2bf(accQk[r]);
            if (DELTA) ((u16*)(SB + S3_QBM))[(fq * 4 + r) * 8 + fr] = f2bf(accQb[r]);
          }
        }
        if (DELTA) {
          float bmc[8];
#pragma unroll
          for (int m = 0; m < 4; m++) { bmc[m] = accBm[m]; bmc[m + 4] = __shfl(accBm[m], (lane & 15) + 16); }
          float t[8];
#pragma unroll
          for (int i = 0; i < 8; i++) {
            float ti = (lane == i) ? 1.f : 0.f;
#pragma unroll
            for (int m = 0; m < i; m++) ti -= rlane(accA[i & 3], (i >> 2) * 16 + m) * t[m];
            t[i] = ti;
          }
          float kbar[8], TB[8];
#pragma unroll
          for (int i = 0; i < 8; i++) {
            float tb = 0.f, kb = 0.f;
#pragma unroll
            for (int m = 0; m <= i; m++) {
              const float tim = rlane(t[i], m);
              tb += tim * bmc[m];
              kb += tim * kt[m];
            }
            TB[i] = tb; kbar[i] = kb;
          }
#pragma unroll
          for (int i = 0; i < 8; i++) ((u16*)(SB + S3_KB))[i * 72 + lane] = f2bf(-kbar[i]);
          *(uint4*)(SB + S3_BT + lane * 16) = pack8(bck);
          if (lane < 8) {
#pragma unroll
            for (int i = 0; i < 8; i++) ((u16*)(SB + S3_TB))[i * 8 + lane] = f2bf(-TB[i]);
          }
        }
      }
    }
    fetch_raw<MIX>(P, min(it + 1, TPB / 64 - 1) * 2 + half, dir, b, h, pw, lane, colv, rawq);
    __syncthreads();
    if (w < 4) {
      unsigned char* STB = smb + S3_STB + w * 2304;
#pragma unroll
      for (int kk = 0; kk < 8; kk++) {
        const int cc = it * 2 + (kk >> 2), k = kk & 3;
        int seg_row0, t_lo;
        if (cc < 8) { seg_row0 = b * TPB; t_lo = dir == 0 ? cc * 32 : (LC - 32 - cc * 32); }
        else { seg_row0 = b * TPB + LC; t_lo = dir == 0 ? (cc - 8) * 32 : (SEQ - 32 - (cc - 8) * 32); }
        const int sc = dir ? 3 - k : k;
        const unsigned char* SB = smb + ((kk >> 2) * 4 + sc) * S3_SUB;
        const bf16x8 bs0 = __builtin_bit_cast(bf16x8, u32x4v{pack2(st[0][0], st[0][1]), pack2(st[0][2], st[0][3]), pack2(st[1][0], st[1][1]), pack2(st[1][2], st[1][3])});
        const bf16x8 bs1 = __builtin_bit_cast(bf16x8, u32x4v{pack2(st[2][0], st[2][1]), pack2(st[2][2], st[2][3]), pack2(st[3][0], st[3][1]), pack2(st[3][2], st[3][3])});
#define LDP(BASE_, ROW_, KS_) ([&]() -> bf16x8 {                                                                   \
          const uint2 lo_ = *(const uint2*)((BASE_) + ((ROW_) * 72 + (KS_) * 32 + fq * 4) * 2);                      \
          const uint2 hi_ = *(const uint2*)((BASE_) + ((ROW_) * 72 + (KS_) * 32 + 16 + fq * 4) * 2);                 \
          return __builtin_bit_cast(bf16x8, u32x4v{lo_.x, lo_.y, hi_.x, hi_.y}); }())
        const bf16x8 bv = fq == 0 ? ld_frag(SB + S3_VT + (w * 16 + fr) * 16) : zfrag();
        const bf16x8 aq0 = LDP(SB + S3_QB, (fr & 7), 0), aq1 = LDP(SB + S3_QB, (fr & 7), 1);
        const bf16x8 aqk = fq == 0 ? ld_frag(SB + S3_QKM + (fr & 7) * 16) : zfrag();
        bf16x8 brv = zfrag();
        if (DELTA) {
          const bf16x8 ak0 = LDP(SB + S3_KB, (fr & 7), 0), ak1 = LDP(SB + S3_KB, (fr & 7), 1);
          const bf16x8 atb = fq == 0 ? ld_frag(SB + S3_TB + (fr & 7) * 16) : zfrag();
          f32x4 accR = __builtin_amdgcn_mfma_f32_16x16x32_bf16(ak0, bs0, z4, 0, 0, 0);
          accR = __builtin_amdgcn_mfma_f32_16x16x32_bf16(ak1, bs1, accR, 0, 0, 0);
          accR = __builtin_amdgcn_mfma_f32_16x16x32_bf16(atb, bv, accR, 0, 0, 0);
          const uint2 vv2 = *(const uint2*)(SB + S3_VT + (w * 16 + fr) * 16 + (fq & 1) * 8);
          const u32x4v t4 = {pack2(accR[0], accR[1]), pack2(accR[2], accR[3]), vv2.x, vv2.y};
          brv = fq < 2 ? __builtin_bit_cast(bf16x8, t4) : zfrag();
        }
        f32x4 accY = __builtin_amdgcn_mfma_f32_16x16x32_bf16(aq0, bs0, z4, 0, 0, 0);
        accY = __builtin_amdgcn_mfma_f32_16x16x32_bf16(aq1, bs1, accY, 0, 0, 0);
        if (DELTA) {
          const uint2 qb2 = *(const uint2*)(SB + S3_QBM + (fr & 7) * 16 + (fq & 1) * 8);
          const uint2 qk2 = *(const uint2*)(SB + S3_QKM + (fr & 7) * 16 + (fq & 1) * 8);
          const u32x4v q4 = {qb2.x, qb2.y, qk2.x, qk2.y};
          const bf16x8 aqm = fq < 2 ? __builtin_bit_cast(bf16x8, q4) : zfrag();
          accY = __builtin_amdgcn_mfma_f32_16x16x32_bf16(aqm, brv, accY, 0, 0, 0);
        } else {
          accY = __builtin_amdgcn_mfma_f32_16x16x32_bf16(aqk, bv, accY, 0, 0, 0);
        }
        if (fq < 2) {
#pragma unroll
          for (int r = 0; r < 4; r++) {
            const int i = fq * 4 + r, j = dir ? 7 - i : i;
            YS[(size_t)(seg_row0 + t_lo + sc * 8 + j) * YST + dir * 768 + MIX * 256 + h * 64 + w * 16 + fr] = f2bf(accY[r]);
          }
        }
#pragma unroll
        for (int nt = 0; nt < 4; nt++) {
          f32x4 an;
          if (DELTA) {
            const uint2 b2 = *(const uint2*)(SB + S3_BT + (nt * 16 + fr) * 16 + (fq & 1) * 8);
            const uint2 k2 = *(const uint2*)(SB + S3_KVT + (nt * 16 + fr) * 16 + (fq & 1) * 8);
            const u32x4v a4 = {b2.x, b2.y, k2.x, k2.y};
            const bf16x8 am = fq < 2 ? __builtin_bit_cast(bf16x8, a4) : zfrag();
            an = __builtin_amdgcn_mfma_f32_16x16x32_bf16(am, brv, z4, 0, 0, 0);
          } else {
            const bf16x8 akv = fq == 0 ? ld_frag(SB + S3_KVT + (nt * 16 + fr) * 16) : zfrag();
            an = __builtin_amdgcn_mfma_f32_16x16x32_bf16(akv, bv, z4, 0, 0, 0);
          }
          const float4 wc = *(const float4*)(SB + S3_WC + (nt * 16 + fq * 4) * 4);
          st[nt][0] = st[nt][0] * wc.x + an[0];
          st[nt][1] = st[nt][1] * wc.y + an[1];
          st[nt][2] = st[nt][2] * wc.z + an[2];
          st[nt][3] = st[nt][3] * wc.w + an[3];
        }
#undef LDP
      }
    }
    __syncthreads();
  }
}

__device__ __forceinline__ void attn_item(const Params& p, int l, int b, int qb, int hk, bool isctx, unsigned char* smem) {
  u16* KS = (u16*)smem;
  u16* VT = KS + 64 * LDT;
  u16* PL = VT + 64 * LDT;
  float2* ROPE = (float2*)(PL + 8 * 32 * LDT);
  const int tid = TIDX, lane = tid & 63, w = tid >> 6, fr = lane & 15, fq = lane >> 4;
  const u16* P = (const u16*)(p.ws + OFF_BIG);
  u16* Y = (u16*)(p.ws + OFF_YS);
  const int qh = hk * 2 + (w >> 2);
  const int tb = qb * 128 + (w & 3) * 32;
  const int qrow0 = b * TPB + (isctx ? 0 : LC);
  __syncthreads();
  for (int i = tid; i < 1024; i += NTHR) {
    int pos = i >> 4, fi = i & 15;
    float inv = powf(10000.f, -(float)fi / 16.f);
    float sn, cs;
    sincosf((float)pos * inv, &sn, &cs);
    ROPE[i] = make_float2(cs, sn);
  }
  __syncthreads();
  bf16x8 qf[2][2];
#pragma unroll
  for (int mi = 0; mi < 2; mi++)
#pragma unroll
    for (int ks = 0; ks < 2; ks++) {
      const int tq = tb + mi * 16 + fr;
      const u16* qp = P + (size_t)(qrow0 + tq) * PST + PD + qh * 64 + ks * 32;
      uint4 own = *(const uint4*)(qp + fq * 8);
      uint4 par = *(const uint4*)(qp + (fq ^ 2) * 8);
      const unsigned ow[4] = {own.x, own.y, own.z, own.w};
      const unsigned pw[4] = {par.x, par.y, par.z, par.w};
      const int pos = ks == 0 ? (tq >> 6) : (tq & 63);
      bf16x8 f;
#pragma unroll
      for (int jj = 0; jj < 8; jj++) {
        float xo = bf2f((u16)((ow[jj >> 1] >> ((jj & 1) * 16)) & 0xffff));
        float xp = bf2f((u16)((pw[jj >> 1] >> ((jj & 1) * 16)) & 0xffff));
        float v = xo;
        if (!isctx) {
          float2 cs = ROPE[pos * 16 + (fq & 1) * 8 + jj];
          v = fq < 2 ? xo * cs.x - xp * cs.y : xp * cs.y + xo * cs.x;
        }
        f[jj] = (short)f2bf(v * 0.125f);
      }
      qf[mi][ks] = f;
    }
  f32x4 oacc[2][4];
#pragma unroll
  for (int mi = 0; mi < 2; mi++)
#pragma unroll
    for (int nd = 0; nd < 4; nd++) oacc[mi][nd] = f32x4{0.f, 0.f, 0.f, 0.f};
  float mrow[2][4], lrow[2][4];
#pragma unroll
  for (int mi = 0; mi < 2; mi++)
#pragma unroll
    for (int r = 0; r < 4; r++) { mrow[mi][r] = -1e30f; lrow[mi][r] = 0.f; }

  const int q0 = qb * 128;
  const int band_lo = isctx ? 0 : max(0, q0 - 128), band_hi = isctx ? 0 : min(SEQ, q0 + 256);
  const int ntile = 4 + (band_hi - band_lo) / 64;
  u16* pl = PL + w * 32 * LDT;
  for (int tl = 0; tl < ntile; tl++) {
    const bool band = tl >= 4;
    const int k0 = band ? band_lo + (tl - 4) * 64 : tl * 64;
    __syncthreads();
    {
      const int key = tid >> 3, kc = tid & 7;
      const int kpos = k0 + key;
      const u16* kp = P + (size_t)(b * TPB + (band ? LC : 0) + kpos) * PST + PD + 256 + hk * 64;
      uint4 own = *(const uint4*)(kp + kc * 8);
      uint4 vv = *(const uint4*)(kp + 128 + kc * 8);
      uint4 par = *(const uint4*)(kp + (kc ^ 2) * 8);
      if (band) {
        const unsigned ow[4] = {own.x, own.y, own.z, own.w};
        const unsigned pw[4] = {par.x, par.y, par.z, par.w};
        const int pos = kc < 4 ? (kpos >> 6) : (kpos & 63);
        unsigned res[4];
#pragma unroll
        for (int jj = 0; jj < 8; jj += 2) {
          float v2[2];
#pragma unroll
          for (int e = 0; e < 2; e++) {
            float xo = bf2f((u16)((ow[jj >> 1] >> (e * 16)) & 0xffff));
            float xp = bf2f((u16)((pw[jj >> 1] >> (e * 16)) & 0xffff));
            float2 cs = ROPE[pos * 16 + (kc & 1) * 8 + jj + e];
            v2[e] = (kc & 2) == 0 ? xo * cs.x - xp * cs.y : xp * cs.y + xo * cs.x;
          }
          res[jj >> 1] = pack2(v2[0], v2[1]);
        }
        own = make_uint4(res[0], res[1], res[2], res[3]);
      }
      *(uint4*)(KS + key * LDT + kc * 8) = own;
      const unsigned vw[4] = {vv.x, vv.y, vv.z, vv.w};
#pragma unroll
      for (int jj = 0; jj < 8; jj++) VT[(kc * 8 + jj) * LDT + key] = (u16)((vw[jj >> 1] >> ((jj & 1) * 16)) & 0xffff);
    }
    __syncthreads();
    f32x4 sc[2][4];
#pragma unroll
    for (int mi = 0; mi < 2; mi++)
#pragma unroll
      for (int nj = 0; nj < 4; nj++) sc[mi][nj] = f32x4{0.f, 0.f, 0.f, 0.f};
#pragma unroll
    for (int ks = 0; ks < 2; ks++) {
      bf16x8 kf[4];
#pragma unroll
      for (int nj = 0; nj < 4; nj++) kf[nj] = *(const bf16x8*)(KS + (nj * 16 + fr) * LDT + ks * 32 + fq * 8);
#pragma unroll
      for (int mi = 0; mi < 2; mi++)
#pragma unroll
        for (int nj = 0; nj < 4; nj++) sc[mi][nj] = __builtin_amdgcn_mfma_f32_16x16x32_bf16(qf[mi][ks], kf[nj], sc[mi][nj], 0, 0, 0);
    }
#pragma unroll
    for (int mi = 0; mi < 2; mi++)
#pragma unroll
      for (int r = 0; r < 4; r++) {
        const int qpos = tb + mi * 16 + fq * 4 + r;
        float mx = -1e30f;
#pragma unroll
        for (int nj = 0; nj < 4; nj++) {
          float v = sc[mi][nj][r];
          if (band) {
            int d = qpos - (k0 + nj * 16 + fr);
            if (d > 128 || d < -128) v = -1e30f;
          }
          sc[mi][nj][r] = v;
          mx = fmaxf(mx, v);
        }
        mx = fmaxf(mx, __shfl_xor(mx, 1));
        mx = fmaxf(mx, __shfl_xor(mx, 2));
        mx = fmaxf(mx, __shfl_xor(mx, 4));
        mx = fmaxf(mx, __shfl_xor(mx, 8));
        const float mnew = fmaxf(mrow[mi][r], mx);
        const float alpha = __expf(mrow[mi][r] - mnew);
        mrow[mi][r] = mnew;
        float ls = 0.f;
#pragma unroll
        for (int nj = 0; nj < 4; nj++) {
          float pe = __expf(sc[mi][nj][r] - mnew);
          ls += pe;
          pl[(mi * 16 + fq * 4 + r) * LDT + nj * 16 + fr] = f2bf(pe);
        }
        lrow[mi][r] = lrow[mi][r] * alpha + ls;
#pragma unroll
        for (int nd = 0; nd < 4; nd++) oacc[mi][nd][r] *= alpha;
      }
    asm volatile("s_waitcnt lgkmcnt(0)" ::: "memory");
    __builtin_amdgcn_wave_barrier();
#pragma unroll
    for (int ks = 0; ks < 2; ks++) {
      bf16x8 pf[2], vf[4];
#pragma unroll
      for (int mi = 0; mi < 2; mi++) pf[mi] = *(const bf16x8*)(pl + (mi * 16 + fr) * LDT + ks * 32 + fq * 8);
#pragma unroll
      for (int nd = 0; nd < 4; nd++) vf[nd] = *(const bf16x8*)(VT + (nd * 16 + fr) * LDT + ks * 32 + fq * 8);
#pragma unroll
      for (int mi = 0; mi < 2; mi++)
#pragma unroll
        for (int nd = 0; nd < 4; nd++) oacc[mi][nd] = __builtin_amdgcn_mfma_f32_16x16x32_bf16(pf[mi], vf[nd], oacc[mi][nd], 0, 0, 0);
    }
    asm volatile("s_waitcnt lgkmcnt(0)" ::: "memory");
    __builtin_amdgcn_wave_barrier();
  }
  const float sink = p.attn_sink[l * 4 + qh];
#pragma unroll
  for (int mi = 0; mi < 2; mi++)
#pragma unroll
    for (int r = 0; r < 4; r++) {
      float ls = lrow[mi][r];
      ls += __shfl_xor(ls, 1);
      ls += __shfl_xor(ls, 2);
      ls += __shfl_xor(ls, 4);
      ls += __shfl_xor(ls, 8);
      ls += __expf(sink - mrow[mi][r]);
      const float inv = 1.f / ls;
      const int tq = tb + mi * 16 + fq * 4 + r;
#pragma unroll
      for (int nd = 0; nd < 4; nd++) Y[(size_t)(qrow0 + tq) * YST + 1536 + qh * 64 + nd * 16 + fr] = f2bf(oacc[mi][nd][r] * inv);
    }
}

#ifndef SCAN3_MASK
#define SCAN3_MASK 7
#endif
__device__ __forceinline__ void phase_mix(const Params& p, int l, unsigned char* smem) {
  float* sm = (float*)smem;
  const int G = gridDim.x;
  for (int it = blockIdx.x; it < 192; it += G) {
    const int mix = it >> 6, rem = it & 63, b = rem >> 3, h = (rem >> 1) & 3, dir = rem & 1;
    if (mix == 0 && (SCAN3_MASK & 1)) scan3_item<0>(p, l, b, h, dir, smem);
    else if (mix == 1 && (SCAN3_MASK & 2)) scan3_item<1>(p, l, b, h, dir, smem);
    else if (mix == 2 && (SCAN3_MASK & 4)) scan3_item<2>(p, l, b, h, dir, smem);
  }
  if (SCAN3_MASK != 7) {
    for (int it = blockIdx.x; it < 768; it += G) {
      const int mix = it >> 8, rem = it & 255, b = rem >> 5, h = (rem >> 3) & 3, dir = (rem >> 2) & 1, rq = rem & 3;
      if (mix == 0 && !(SCAN3_MASK & 1)) scan2_item<0>(p, l, b, h, dir, rq, sm);
      else if (mix == 1 && !(SCAN3_MASK & 2)) scan2_item<1>(p, l, b, h, dir, rq, sm);
      else if (mix == 2 && !(SCAN3_MASK & 4)) scan2_item<2>(p, l, b, h, dir, rq, sm);
    }
  }
  __syncthreads();
  {
    const bool spread = G >= 192;
    const int nconv = spread ? 64 : G, fidx = spread ? (int)blockIdx.x - 128 : (int)blockIdx.x;
    if (fidx >= 0 && fidx < nconv)
      for (int it = 832 + fidx; it < 4480; it += nconv) conv_item(p, l, it, (float*)smem);
    __syncthreads();
  }
  unsigned* ctr = (unsigned*)(p.ws + OFF_CTR) + l * 16;
  volatile int* slot = (volatile int*)(smem + 131072 - 16);
  for (;;) {
    if (TIDX == 0) *slot = (int)atomicAdd(ctr, 1u);
    __syncthreads();
    const int it = *slot;
    __syncthreads();
    if (it >= (l == 0 ? 544 : 512)) break;
    if (it < 512) {
      int b = it >> 6, qb = (it >> 1) & 31, hk = it & 1;
      attn_item(p, l, b, qb, hk, false, smem);
    } else {
      int r = it - 512, b = r >> 2, qb = (r >> 1) & 1, hk = r & 1;
      attn_item(p, l, b, qb, hk, true, smem);
    }
  }
}

#define POST_DECL(PFX) uint2 PFX##ya0, PFX##ya1, PFX##ya2, PFX##yc0, PFX##yc1, PFX##yc2, PFX##vp, PFX##vc, PFX##vn, PFX##gb, PFX##gc; \
  u16 PFX##xp, PFX##xc, PFX##xn; float2 PFX##bc
#define POST_LOAD(PFX, R_)                                                                         \
  do {                                                                                             \
    const int r_ = (R_);                                                                           \
    const int b_ = r_ / TPB, t_ = r_ - b_ * TPB;                                                   \
    const bool hp_ = (t_ != 0) && (t_ != LC), hn_ = (t_ != LC - 1) && (t_ != TPB - 1);            \
    const u16* ys_ = YSc + (size_t)r_ * YST;                                                       \
    const u16* pr_ = Pc + (size_t)r_ * PST;                                                        \
    const u16* pp_ = pr_ - (hp_ ? PST : 0);                                                        \
    const u16* pn_ = pr_ + (hn_ ? PST : 0);                                                        \
    PFX##ya0 = *(const uint2*)(ys_ + j0); PFX##ya1 = *(const uint2*)(ys_ + 256 + j0); PFX##ya2 = *(const uint2*)(ys_ + 512 + j0); \
    PFX##yc0 = *(const uint2*)(ys_ + 768 + j0); PFX##yc1 = *(const uint2*)(ys_ + 1024 + j0); PFX##yc2 = *(const uint2*)(ys_ + 1280 + j0); \
    PFX##vp = *(const uint2*)(pp_ + PA + 512 + j0);                                                \
    PFX##vc = *(const uint2*)(pr_ + PA + 512 + j0);                                                \
    PFX##vn = *(const uint2*)(pn_ + PA + 512 + j0);                                                \
    PFX##gb = *(const uint2*)(pr_ + PB + 784 + j0);                                                \
    PFX##gc = *(const uint2*)(pr_ + PC + 544 + j0);                                                \
    PFX##xp = pp_[PA + 896 + lane]; PFX##xc = pr_[PA + 896 + lane]; PFX##xn = pn_[PA + 896 + lane]; \
    PFX##bc = *(const float2*)(BCc + (size_t)r_ * 8 + (lane >> 4) * 2);                            \
  } while (0)
__device__ __forceinline__ void unpack4(uint2 v, float (&o)[4]) {
  o[0] = __uint_as_float(v.x << 16); o[1] = __uint_as_float(v.x & 0xffff0000u);
  o[2] = __uint_as_float(v.y << 16); o[3] = __uint_as_float(v.y & 0xffff0000u);
}

__device__ __forceinline__ void phase_post(const Params& p, int l, float* g2s) {
  const int lane = TIDX & 63, wv = TIDX >> 6;
  u16* YS = (u16*)(p.ws + OFF_YS);
  const int j0 = lane * 4;
  {
    const float4* src = (const float4*)(p.rwkv_g2 + (size_t)l * 64 * 256);
    for (int i = TIDX; i < 64 * 256 / 4; i += NTHR) ((float4*)g2s)[i] = src[i];
  }
  float mu_v[4], lng[4], lnb[4], ngb[4], ngc[4];
#pragma unroll
  for (int i = 0; i < 4; i++) {
    mu_v[i] = p.rwkv_mu[l * 960 + 512 + j0 + i];
    lng[i] = p.rwkv_ln_g[l * 256 + j0 + i];
    lnb[i] = p.rwkv_ln_b[l * 256 + j0 + i];
    ngb[i] = p.gdn_norm_g[l * 64 + (lane & 15) * 4 + i];
    ngc[i] = p.gla_norm_g[l * 64 + (lane & 15) * 4 + i];
  }
  const float mu_x = p.rwkv_mu[l * 960 + 896 + lane];
  __syncthreads();
  const int stride = gridDim.x * 8;
  int r = blockIdx.x * 8 + wv;
  const u16* Pc = (const u16*)(p.ws + OFF_BIG);
  const u16* YSc = (const u16*)(p.ws + OFF_YS);
  const float* BCc = (const float*)(p.ws + OFF_BC);
  POST_DECL(cur_);
  POST_DECL(nxt_);
  POST_LOAD(cur_, r);
  for (; r < NROWS; r += stride) {
    const int rn = r + stride < NROWS ? r + stride : r;
    POST_LOAD(nxt_, rn);
    const int b = r / TPB, t = r - b * TPB;
    const float pmul = ((t != 0) && (t != LC)) ? 1.f : 0.f, nmul = ((t != LC - 1) && (t != TPB - 1)) ? 1.f : 0.f;
    if (!(l == 1 && t < LC)) {
    float y[3][4];
    {
      float a4[4], c4[4];
      unpack4(cur_ya0, a4); unpack4(cur_yc0, c4);
#pragma unroll
      for (int i = 0; i < 4; i++) y[0][i] = a4[i] + c4[i];
      unpack4(cur_ya1, a4); unpack4(cur_yc1, c4);
#pragma unroll
      for (int i = 0; i < 4; i++) y[1][i] = a4[i] + c4[i];
      unpack4(cur_ya2, a4); unpack4(cur_yc2, c4);
#pragma unroll
      for (int i = 0; i < 4; i++) y[2][i] = a4[i] + c4[i];
    }
    float o[3][4];
    {
      float sum = y[0][0] + y[0][1] + y[0][2] + y[0][3];
      sum = red16(sum);
      const float mean = sum * (1.f / 64.f);
      float vs = 0.f;
#pragma unroll
      for (int i = 0; i < 4; i++) { float d = y[0][i] - mean; vs += d * d; }
      vs = red16(vs);
      const float rstd = rsq(vs * (1.f / 64.f) + 64e-5f);
      const float pv = bf2f(cur_xc), ppv = bf2f(cur_xp) * pmul, pnv = bf2f(cur_xn) * nmul;
      const float sg = sigm(pv + (0.5f * (ppv + pnv) - pv) * mu_x);
      float gate[4] = {0.f, 0.f, 0.f, 0.f};
      const float* g2 = g2s + j0;
#pragma unroll 8
      for (int i = 0; i < 64; i++) {
        const float si = __int_as_float(__builtin_amdgcn_readlane(__float_as_int(sg), i));
        const float4 gw = *(const float4*)(g2 + i * 256);
        gate[0] += si * gw.x; gate[1] += si * gw.y; gate[2] += si * gw.z; gate[3] += si * gw.w;
      }
      const float bcs = cur_bc.x + cur_bc.y;
      float vc4[4], vp4[4], vn4[4];
      unpack4(cur_vc, vc4); unpack4(cur_vp, vp4); unpack4(cur_vn, vn4);
#pragma unroll
      for (int i = 0; i < 4; i++) {
        const float v = vc4[i] + (0.5f * (vp4[i] * pmul + vn4[i] * nmul) - vc4[i]) * mu_v[i];
        const float yn = (y[0][i] - mean) * rstd * lng[i] + lnb[i];
        o[0][i] = (yn + bcs * v) * gate[i];
      }
    }
#pragma unroll
    for (int m = 1; m < 3; m++) {
      float ss = y[m][0] * y[m][0] + y[m][1] * y[m][1] + y[m][2] * y[m][2] + y[m][3] * y[m][3];
      ss = red16(ss);
      const float inv = rsq(ss * (1.f / 64.f) + 1e-6f);
      float g4[4];
      unpack4(m == 1 ? cur_gb : cur_gc, g4);
#pragma unroll
      for (int i = 0; i < 4; i++) o[m][i] = y[m][i] * inv * (m == 1 ? ngb[i] : ngc[i]) * siluf(g4[i]);
    }
    u16* ys = YS + (size_t)r * YST;
#pragma unroll
    for (int m = 0; m < 3; m++) {
      uint2 ov;
      ov.x = pack2(o[m][0], o[m][1]);
      ov.y = pack2(o[m][2], o[m][3]);
      *(uint2*)(ys + m * 256 + j0) = ov;
    }
    }
    cur_ya0 = nxt_ya0; cur_ya1 = nxt_ya1; cur_ya2 = nxt_ya2; cur_yc0 = nxt_yc0; cur_yc1 = nxt_yc1; cur_yc2 = nxt_yc2;
    cur_vp = nxt_vp; cur_vc = nxt_vc; cur_vn = nxt_vn; cur_gb = nxt_gb; cur_gc = nxt_gc;
    cur_xp = nxt_xp; cur_xc = nxt_xc; cur_xn = nxt_xn; cur_bc = nxt_bc;
  }
}

#define XB_TMO      128
#define XB_XCNT(j)  (256  + 64 * (j))
#define XB_XSUB(j)  (1280 + 64 * (j))
#define XB_XGEN(j)  (2304 + 64 * (j))
#define XB_TOP      3328
#define XB_TOPGEN   3392
#define XCD_BAR_WORDS 3456
#define XB_SPIN_CAP (1u << 18)
#define LAS __attribute__((address_space(3)))

__device__ __forceinline__ unsigned xb_ld(unsigned* p)              { return __hip_atomic_load(p, __ATOMIC_RELAXED, __HIP_MEMORY_SCOPE_AGENT); }
__device__ __forceinline__ unsigned xb_add(unsigned* p, unsigned v) { return __hip_atomic_fetch_add(p, v, __ATOMIC_RELAXED, __HIP_MEMORY_SCOPE_AGENT); }
__device__ __forceinline__ unsigned xb_xcc_id() { return (unsigned)__builtin_amdgcn_s_getreg((3 << 11) | 20) & 0xFu; }
#define XB_SPIN(cond, bar) do { unsigned _sp = 0; while (cond) { __builtin_amdgcn_s_sleep(1); \
    if ((++_sp & 255u) == 0u) { if (xb_ld(&(bar)[XB_TMO])) break; if (_sp > XB_SPIN_CAP) { atomicAdd(&(bar)[XB_TMO], 1u); break; } } } } while (0)

struct XcdBarrier {
    unsigned* bar; unsigned x;
    volatile LAS unsigned* st;
};

__device__ __forceinline__ XcdBarrier xcd_barrier_post(unsigned* bar, volatile LAS unsigned* st) {
    XcdBarrier b; b.bar = bar; b.x = xb_xcc_id(); b.st = st;
    if (threadIdx.x == 0) (void)xb_add(&bar[XB_XCNT(b.x)], 1u);
    return b;
}
__device__ __forceinline__ void xcd_barrier_complete(unsigned* bar, unsigned x, unsigned& nloc, unsigned& nx) {
    const unsigned G = gridDim.x * gridDim.y * gridDim.z;
    unsigned sum, cnt, mine, sp = 0u;
    for (;;) {
        sum = 0u; cnt = 0u; mine = 0u;
#pragma unroll
        for (unsigned j = 0; j < 16; ++j) { const unsigned c = xb_ld(&bar[XB_XCNT(j)]); sum += c; cnt += (c > 0u) ? 1u : 0u; mine = (j == x) ? c : mine; }
        if (sum == G) break;
        __builtin_amdgcn_s_sleep(1);
        if ((++sp & 255u) == 0u) { if (xb_ld(&bar[XB_TMO])) break; if (sp > XB_SPIN_CAP) { atomicAdd(&bar[XB_TMO], 1u); break; } }
    }
    nloc = mine > 0u ? mine : 1u; nx = cnt > 0u ? cnt : 1u;
}

__device__ __forceinline__ void xcd_barrier(const XcdBarrier& b) {
    asm volatile("s_waitcnt vmcnt(0)" ::: "memory");
    __syncthreads();
    if (threadIdx.x == 0) {
        unsigned* bar = b.bar;
        __builtin_amdgcn_s_waitcnt(0);
        unsigned nloc = b.st[0], nx = b.st[1];
        if (nloc == 0u) { xcd_barrier_complete(bar, b.x, nloc, nx); b.st[0] = nloc; b.st[1] = nx; }
        const unsigned old = xb_add(&bar[XB_XSUB(b.x)], 1u);
        const unsigned gen = old / nloc;
        if (old + 1u == (gen + 1u) * nloc) {
            __builtin_amdgcn_fence(__ATOMIC_RELEASE, "agent");
            asm volatile("s_waitcnt vmcnt(0)" ::: "memory");
            const unsigned og = xb_add(&bar[XB_TOP], 1u);
            const unsigned tg = og / nx;
            if (og + 1u == (tg + 1u) * nx) xb_add(&bar[XB_TOPGEN], 1u);
            else XB_SPIN(xb_ld(&bar[XB_TOPGEN]) == tg, bar);
            __builtin_amdgcn_fence(__ATOMIC_ACQUIRE, "agent");
            xb_add(&bar[XB_XGEN(b.x)], 1u);
            asm volatile("s_waitcnt vmcnt(0)" ::: "memory");
        } else {
            XB_SPIN(xb_ld(&bar[XB_XGEN(b.x)]) == gen, bar);
            __builtin_amdgcn_fence(__ATOMIC_ACQUIRE, "agent");
            asm volatile("s_waitcnt vmcnt(0)" ::: "memory");
        }
    }
    __syncthreads();
}

#if defined(SKIPS)
#define EN(k) (SKIPS != (k))
#elif !defined(ONLYS)
#define EN(k) 1
#else
#define EN(k) (ONLYS == (k))
#endif
__device__ __forceinline__ void run_phase(const Params& p, int ph, unsigned char* smem) {
  if (ph == 0) { if (EN(10)) phase_init0(p, (float*)smem); return; }
  if (ph == 1) { if (EN(11)) phase_init1(p); return; }
  int l = 0, s = 10;
  if (ph >= 3) { l = (ph - 3) / 10; s = (ph - 3) - l * 10; }
  unsigned char* wl = p.ws + OFF_W;
  PG8_LAS unsigned char* lds = (PG8_LAS unsigned char*)smem;
  pg8::StaticOrder S;
  if (s == 10 || s == 6 || s == 9) {
    if (EN(5)) rowpass(p, l, s == 10 ? 0 : (s == 6 ? 1 : 2));
    if (s == 9 && l == 0) {
      __syncthreads();
      for (int it = blockIdx.x; it < 832; it += gridDim.x) conv_item(p, 1, it, (float*)smem);
    }
  } else if (s == 0 || s == 3 || s == 5 || s == 8) {
    pg8::Gemm g; EpiBf E;
    g.M = NROWS; E.bias = nullptr; E.act = 0;
    if (s == 0) { g.A = (const u16*)(p.ws + OFF_H); g.lda = DM; g.Bt = (const u16*)(wl + OW_IN); g.K = DM; g.N = PST; E.O = (u16*)(p.ws + OFF_BIG); E.ldc = PST; }
    else if (s == 3) {
      g.A = (const u16*)(p.ws + OFF_H); g.lda = DM; g.Bt = (const u16*)(wl + OW_G); g.K = DM; g.N = 4096;
      E.O = (u16*)(p.ws + OFF_BIG); E.ldc = 4096; E.bias = p.gate_b + (size_t)l * 4096; E.act = 1;
    }
    else if (s == 5) { g.A = (const u16*)(p.ws + OFF_H); g.lda = DM; g.Bt = (const u16*)(wl + OW_O); g.K = DM; g.N = DM; E.O = (u16*)(p.ws + OFF_BIG); E.ldc = DM; }
    else { g.A = (const u16*)(p.ws + OFF_BIG); g.lda = FH; g.Bt = (const u16*)(wl + OW_2); g.K = FH; g.N = DM; E.O = (u16*)(p.ws + OFF_YS); E.ldc = DM; }
    if (l == 1 && s != 0) S.init(NBATCH * SEQ, g.N, gridDim.x, blockIdx.x, 1);
    else S.init(g.M, g.N, gridDim.x, blockIdx.x);
    if (EN(0)) pg8::gemm_phase<EpiBf, pg8::StaticOrder, false>(lds, g, S, E, nullptr);
  } else if (s == 4) {
    if (EN(3)) phase_ypart(p, l, smem);
  } else if (s == 1) {
    if (EN(1)) phase_mix(p, l, smem);
  } else if (s == 2) {
    if (EN(2)) phase_post(p, l, (float*)smem);
  } else {
    pg8::Gemm g; EpiSwiglu E;
    g.M = NROWS; g.N = 2 * FH; g.K = DM; g.lda = DM; g.A = (const u16*)(p.ws + OFF_H); g.Bt = (const u16*)(wl + OW_1);
    E.O = (u16*)(p.ws + OFF_BIG);
    if (l == 1) S.init(NBATCH * SEQ, g.N, gridDim.x, blockIdx.x, 1);
    else S.init(g.M, g.N, gridDim.x, blockIdx.x);
    if (EN(6)) pg8::gemm_phase<EpiSwiglu, pg8::StaticOrder, false>(lds, g, S, E, nullptr);
  }
}

__global__ void __launch_bounds__(NTHR) hybrid_flow_mega(Params p, int ph0, int ph1) {
  __shared__ __attribute__((aligned(16))) unsigned char smem[131072];
  __shared__ __attribute__((aligned(16))) unsigned xbw[4];
  cg::grid_group grid = cg::this_grid();
  XcdBarrier xb;
  xb.bar = (unsigned*)(p.ws + OFF_XBAR); xb.x = 0u; xb.st = (volatile LAS unsigned*)xbw;
  for (int ph = ph0; ph < ph1; ph++) {
    run_phase(p, ph, smem);
#ifdef DUPMASK
    {
      int sidx = ph >= 3 ? (ph - 3) % 10 : 12 + ph;
      if ((DUPMASK >> sidx) & 1) { __syncthreads(); run_phase(p, ph, smem); }
    }
#endif
    if (ph + 1 < ph1) {
      if (ph == ph0) {
        grid.sync();
        if (threadIdx.x < 4) xbw[threadIdx.x] = 0u;
        __syncthreads();
        xb = xcd_barrier_post((unsigned*)(p.ws + OFF_XBAR), (volatile LAS unsigned*)xbw);
      } else {
        xcd_barrier(xb);
      }
    }
  }
  if (ph1 - ph0 > 2 && threadIdx.x == 0 && xb_ld(&xb.bar[XB_TMO]) != 0u) p.out[blockIdx.x] = __int_as_float(0x7fc00000);
}

extern "C" void kernel_launch(void* const* d_in, const int* in_sizes, int n_in, void* d_out, int out_size, void* d_ws,
                              size_t ws_size, hipStream_t stream) {
  Params p{};
  const float** pp = (const float**)&p;
  for (int i = 0; i < 32; i++) pp[i] = (const float*)d_in[i];
  p.out = (float*)d_out;
  p.ws = (unsigned char*)d_ws;
  static int grid_blocks = 0;
  if (!grid_blocks) {
    int dev = 0, cus = 0, per_cu = 0;
    hipGetDevice(&dev);
    hipDeviceGetAttribute(&cus, hipDeviceAttributeMultiprocessorCount, dev);
    hipOccupancyMaxActiveBlocksPerMultiprocessor(&per_cu, hybrid_flow_mega, NTHR, 0);
    if (per_cu < 1) per_cu = 1;
    grid_blocks = cus * per_cu;
  }
#ifdef MULTI_LAUNCH
  for (int ph = 0; ph < NPHASE; ph++) {
    hipLaunchKernelGGL(hybrid_flow_mega, dim3(grid_blocks), dim3(NTHR), 0, stream, p, ph, ph + 1);
  }
#else
  int ph0 = 0, ph1 = NPHASE;
  void* args[] = {&p, &ph0, &ph1};
  hipError_t e = hipLaunchCooperativeKernel((void*)hybrid_flow_mega, dim3(grid_blocks), dim3(NTHR), args, 0, stream);
  if (e != hipSuccess) fprintf(stderr, "cooperative launch failed: %s (grid %d)\n", hipGetErrorString(e), grid_blocks);
#endif
}
```

```cpp
#include <hip/hip_runtime.h>
#include <hip/hip_cooperative_groups.h>
#include <cstdio>
namespace cg = cooperative_groups;

typedef unsigned short u16;
using bf16x8 = __attribute__((ext_vector_type(8))) short;
using f32x4 = __attribute__((ext_vector_type(4))) float;

#define DM 1024
#define NBATCH 8
#define SEQ 4096
#define LC 256
#define TPB 4352
#define NROWS 34816
#define PST 3328
#define YST 1792
#define FH 2816
#define INW 7408
#define NTHR 512
#define PA 0
#define PB 960
#define PC 2000
#define PD 2800
#define NPHASE 23
#define SCAN3_MASK 7

struct Params {
  const float *x, *c, *ctx, *c_ctx, *ada_w, *ada_b, *norm_g, *w_in, *gate_b, *w_branch, *w_out,
      *rwkv_mu, *rwkv_w0, *rwkv_w2, *rwkv_a0, *rwkv_a2, *rwkv_g2, *rwkv_kk, *rwkv_ka, *rwkv_rk, *rwkv_ln_g,
      *rwkv_ln_b, *gdn_conv, *gdn_a_log, *gdn_dt_bias, *gdn_norm_g, *gla_gw2, *gla_gb, *gla_norm_g, *attn_sink,
      *ffn_w1, *ffn_w2;
  float* out;
  unsigned char* ws;
};

constexpr size_t SZ_WL = 36700160;
constexpr size_t OW_IN = 0;
constexpr size_t OW_G = OW_IN + (size_t)PST * 1024 * 2;
constexpr size_t OW_B = OW_G + (size_t)4096 * 1024 * 2;
constexpr size_t OW_O = OW_B + (size_t)4 * 1024 * 256 * 2;
constexpr size_t OW_1 = OW_O + (size_t)1024 * 1024 * 2;
constexpr size_t OW_2 = OW_1 + (size_t)5632 * 1024 * 2;
static_assert(OW_2 + (size_t)1024 * FH * 2 == SZ_WL, "weights size");
constexpr size_t SZ_ACT = (size_t)NROWS * DM * 2;
constexpr size_t OFF_W = 0;
constexpr size_t OFF_XC = OFF_W + SZ_WL;
constexpr size_t OFF_MODP = OFF_XC + (size_t)NBATCH * LC * DM * 4;
constexpr size_t OFF_MOD = OFF_MODP + (size_t)2 * 8 * 9 * 6144 * 4;
constexpr size_t OFF_BC = OFF_MOD + (size_t)2 * 9 * 6144 * 4;
constexpr size_t OFF_H = OFF_BC + (size_t)NROWS * 8 * 4;
constexpr size_t OFF_YS = OFF_H + SZ_ACT;
constexpr size_t OFF_BIG = OFF_YS + (size_t)NROWS * YST * 2;
constexpr size_t OFF_CTR = OFF_BIG + (size_t)NROWS * 4096 * 2;
constexpr size_t OFF_XBAR = OFF_CTR + 256;
constexpr size_t WS_END = OFF_XBAR + 3456 * 4;
static_assert(WS_END <= (size_t)536870912, "ws too large");

__device__ __forceinline__ int launder_tid() { int t = threadIdx.x; asm volatile("" : "+v"(t)); return t; }
#define TIDX (launder_tid())
typedef float f32x2_t __attribute__((ext_vector_type(2)));
typedef __bf16 bf16x2_t __attribute__((ext_vector_type(2)));
__device__ __forceinline__ unsigned pack2(float a, float b) {
  const f32x2_t v = {a, b};
  const bf16x2_t r = __builtin_convertvector(v, bf16x2_t);
  return __builtin_bit_cast(unsigned, r);
}
__device__ __forceinline__ u16 f2bf(float f) { return (u16)(pack2(f, 0.f) & 0xffffu); }
__device__ __forceinline__ float bf2f(u16 h) { return __uint_as_float(((unsigned)h) << 16); }
__device__ __forceinline__ float sigm(float x) { return __builtin_amdgcn_rcpf(1.f + __expf(-x)); }
__device__ __forceinline__ float siluf(float x) { return x * __builtin_amdgcn_rcpf(1.f + __expf(-x)); }
__device__ __forceinline__ float rsq(float x) { return __builtin_amdgcn_rsqf(x); }
__device__ __forceinline__ float softplusf(float x) { return fmaxf(x, 0.f) + __logf(1.f + __expf(-fabsf(x))); }
__device__ __forceinline__ float tanh_fast(float x) { return 1.f - 2.f * __builtin_amdgcn_rcpf(1.f + __expf(2.f * x)); }
__device__ __forceinline__ float wsum(float v) {
#pragma unroll
  for (int o = 32; o > 0; o >>= 1) v += __shfl_xor(v, o);
  return v;
}
template <int CTRL>
__device__ __forceinline__ float dppf(float x) {
  return __int_as_float(__builtin_amdgcn_update_dpp(__float_as_int(x), __float_as_int(x), CTRL, 0xf, 0xf, false));
}
__device__ __forceinline__ float red8(float x) {
  x += dppf<0xB1>(x);
  x += dppf<0x4E>(x);
  x += dppf<0x141>(x);
  return x;
}
__device__ __forceinline__ const float* xin_row(const Params& p, int r) {
  int b = r / TPB, t = r - b * TPB;
  return t < LC ? p.ctx + ((size_t)(b * LC + t)) * DM : p.x + ((size_t)(b * SEQ + t - LC)) * DM;
}
__device__ __forceinline__ float* x_row(const Params& p, int r) {
  int b = r / TPB, t = r - b * TPB;
  return t < LC ? (float*)(p.ws + OFF_XC) + ((size_t)(b * LC + t)) * DM : p.out + ((size_t)(b * SEQ + t - LC)) * DM;
}
__device__ __forceinline__ int mod_row(int r) {
  int b = r / TPB, t = r - b * TPB;
  return t < LC ? 8 : b;
}

struct MapId { int lim, off; __device__ int operator()(int n) const { return n < lim ? n + off : -1; } };
struct MapW1 { __device__ int operator()(int n) const { int q = n >> 3, s = n & 7; return s < 4 ? q * 4 + s : FH + q * 4 + (s - 4); } };

template <class Map>
__device__ __forceinline__ void conv_tile(const float* __restrict__ src, int ld, u16* __restrict__ dst, int K, int n0,
                                          int k0, Map map, float* tile) {
  const int tid = TIDX;
  const int nn = tid & 63, kr = tid >> 6;
  const int sc = map(n0 + nn);
  float tv[8];
  const int scc = sc >= 0 ? sc : 0;
  const float scm = sc >= 0 ? 1.f : 0.f;
#pragma unroll
  for (int ps = 0; ps < 8; ps++) tv[ps] = src[(size_t)(k0 + ps * 8 + kr) * ld + scc];
#pragma unroll
  for (int ps = 0; ps < 8; ps++) tile[(ps * 8 + kr) * 65 + nn] = tv[ps] * scm;
  __syncthreads();
  const int n2 = tid >> 3, kc = tid & 7;
  uint4 o;
  o.x = pack2(tile[(kc * 8 + 0) * 65 + n2], tile[(kc * 8 + 1) * 65 + n2]);
  o.y = pack2(tile[(kc * 8 + 2) * 65 + n2], tile[(kc * 8 + 3) * 65 + n2]);
  o.z = pack2(tile[(kc * 8 + 4) * 65 + n2], tile[(kc * 8 + 5) * 65 + n2]);
  o.w = pack2(tile[(kc * 8 + 6) * 65 + n2], tile[(kc * 8 + 7) * 65 + n2]);
  *(uint4*)(dst + (size_t)(n0 + n2) * K + k0 + kc * 8) = o;
  __syncthreads();
}

__device__ __forceinline__ void conv_item(const Params& p, int l, int rem, float* sm) {
      u16* wl = (u16*)(p.ws + OFF_W);
      if (rem < 832) {
        int nt = rem >> 4, kt = rem & 15;
        conv_tile(p.w_in + (size_t)l * DM * INW, INW, (u16*)((char*)wl + OW_IN), 1024, nt * 64, kt * 64, MapId{3312, 0}, sm);
      } else if (rem < 832 + 1024) {
        rem -= 832;
        int nt = rem >> 4, kt = rem & 15;
        conv_tile(p.w_in + (size_t)l * DM * INW, INW, (u16*)((char*)wl + OW_G), 1024, nt * 64, kt * 64, MapId{4096, 3312}, sm);
      } else if (rem < 1856 + 256) {
        rem -= 1856;
        int br = rem >> 6, r2 = rem & 63, nt = r2 >> 2, kt = r2 & 3;
        conv_tile(p.w_branch + ((size_t)(l * 4 + br)) * 256 * DM, DM, (u16*)((char*)wl + OW_B) + (size_t)br * 1024 * 256, 256,
                  nt * 64, kt * 64, MapId{1024, 0}, sm);
      } else if (rem < 2112 + 256) {
        rem -= 2112;
        int nt = rem >> 4, kt = rem & 15;
        conv_tile(p.w_out + (size_t)l * DM * DM, DM, (u16*)((char*)wl + OW_O), 1024, nt * 64, kt * 64, MapId{1024, 0}, sm);
      } else if (rem < 2368 + 1408) {
        rem -= 2368;
        int nt = rem >> 4, kt = rem & 15;
        conv_tile(p.ffn_w1 + (size_t)l * DM * 5632, 5632, (u16*)((char*)wl + OW_1), 1024, nt * 64, kt * 64, MapW1{}, sm);
      } else {
        rem -= 3776;
        int nt = rem / 44, kt = rem - nt * 44;
        conv_tile(p.ffn_w2 + (size_t)l * FH * DM, DM, (u16*)((char*)wl + OW_2), FH, nt * 64, kt * 64, MapId{1024, 0}, sm);
      }
}

__device__ __forceinline__ void phase_init0(const Params& p, float* sm) {
  const int tid = TIDX;
  if (blockIdx.x == 0) {
    if (tid < 64) ((unsigned*)(p.ws + OFF_CTR))[tid] = 0u;
    for (int i = tid; i < 3456; i += NTHR) ((unsigned*)(p.ws + OFF_XBAR))[i] = 0u;
  }
  constexpr int NMOD = 192, NCONV = 832;
  for (int it = blockIdx.x; it < NMOD + NCONV; it += gridDim.x) {
    if (it < NMOD) {
      int l = it / 96, rem = it - l * 96, cc = rem >> 3, ks = rem & 7;
      for (int i = tid; i < 9 * 128; i += NTHR) {
        int r = i >> 7, k = i & 127;
        float v = r < 8 ? p.c[r * DM + ks * 128 + k] : p.c_ctx[ks * 128 + k];
        sm[i] = siluf(v);
      }
      __syncthreads();
      const int n = cc * 512 + tid;
      const float* w = p.ada_w + ((size_t)l * DM + ks * 128) * 6144 + n;
      float acc[9];
#pragma unroll
      for (int r = 0; r < 9; r++) acc[r] = 0.f;
#pragma unroll 1
      for (int k0 = 0; k0 < 128; k0 += 16) {
        float wv[16];
#pragma unroll
        for (int kk = 0; kk < 16; kk++) wv[kk] = w[(size_t)(k0 + kk) * 6144];
#pragma unroll
        for (int kk = 0; kk < 16; kk++)
#pragma unroll
          for (int r = 0; r < 9; r++) acc[r] += sm[r * 128 + k0 + kk] * wv[kk];
      }
      float* mp = (float*)(p.ws + OFF_MODP) + ((size_t)(l * 8 + ks) * 9) * 6144 + n;
#pragma unroll
      for (int r = 0; r < 9; r++) mp[(size_t)r * 6144] = acc[r];
      __syncthreads();
    } else {
      conv_item(p, 0, it - NMOD, sm);
    }
  }
}

__device__ __forceinline__ void phase_init1(const Params& p) {
  const float* mp = (const float*)(p.ws + OFF_MODP);
  float* mo = (float*)(p.ws + OFF_MOD);
  for (int i = blockIdx.x * NTHR + TIDX; i < 2 * 9 * 6144; i += gridDim.x * NTHR) {
    int l = i / (9 * 6144), rem = i - l * 9 * 6144, r = rem / 6144, n = rem - r * 6144;
    float s = p.ada_b[l * 6144 + n];
#pragma unroll
    for (int ks = 0; ks < 8; ks++) s += mp[((size_t)((l * 8 + ks) * 9 + r)) * 6144 + n];
    mo[i] = s;
  }
}

__device__ __forceinline__ void rowpass(const Params& p, int l, int mode) {
  const int lane = TIDX & 63, wv = TIDX >> 6;
  const float* MOD = (const float*)(p.ws + OFF_MOD);
  u16* H = (u16*)(p.ws + OFF_H);
  const bool do_norm = !(mode == 2 && l == 1);
  const int ln = (mode == 2) ? (l == 1 ? l : l + 1) : l;
  const int ni = (mode == 1) ? 2 : 0, sho = (mode == 1) ? 3072 : 0, sco = (mode == 1) ? 4096 : 1024;
  for (int r = blockIdx.x * 8 + wv; r < NROWS; r += gridDim.x * 8) {
    const int mr = mod_row(r);
    if (l == 1 && mode != 0 && mr == 8) continue;
    const float* modl = MOD + ((size_t)(l * 9 + mr)) * 6144;
    const float* modn = MOD + ((size_t)(ln * 9 + mr)) * 6144;
    const float* ng2 = p.norm_g + (size_t)(ln * 4 + ni) * DM;
    const float* xs = (mode == 0 || (mode == 1 && l == 0)) ? xin_row(p, r) : (const float*)x_row(p, r);
    float4 xo[4], n2[4], sc4[4], sh4[4];
#pragma unroll
    for (int i = 0; i < 4; i++) {
      const int col = i * 256 + lane * 4;
      xo[i] = *(const float4*)(xs + col);
      n2[i] = *(const float4*)(ng2 + col);
      sc4[i] = *(const float4*)(modn + sco + col);
      sh4[i] = *(const float4*)(modn + sho + col);
    }
    float xv[16];
    if (mode == 0) {
#pragma unroll
      for (int i = 0; i < 4; i++) { xv[i * 4 + 0] = xo[i].x; xv[i * 4 + 1] = xo[i].y; xv[i * 4 + 2] = xo[i].z; xv[i * 4 + 3] = xo[i].w; }
    } else {
      const u16* src = (const u16*)(p.ws + (mode == 1 ? OFF_BIG : OFF_YS)) + (size_t)r * DM;
      const float* ng = p.norm_g + (size_t)(l * 4 + (mode == 1 ? 1 : 3)) * DM;
      const float* gt = modl + (mode == 1 ? 2048 : 5120);
      uint2 sv[4];
      float4 g4[4], n4[4];
#pragma unroll
      for (int i = 0; i < 4; i++) {
        const int col = i * 256 + lane * 4;
        sv[i] = *(const uint2*)(src + col);
        g4[i] = *(const float4*)(gt + col);
        n4[i] = *(const float4*)(ng + col);
      }
      float ov[16];
      float ss = 0.f;
#pragma unroll
      for (int i = 0; i < 4; i++) {
        ov[i * 4 + 0] = __uint_as_float(sv[i].x << 16); ov[i * 4 + 1] = __uint_as_float(sv[i].x & 0xffff0000u);
        ov[i * 4 + 2] = __uint_as_float(sv[i].y << 16); ov[i * 4 + 3] = __uint_as_float(sv[i].y & 0xffff0000u);
      }
#pragma unroll
      for (int i = 0; i < 16; i++) ss += ov[i] * ov[i];
      ss = wsum(ss);
      const float inv = rsq(ss * (1.f / 1024.f) + 1e-6f);
      float* xd = x_row(p, r);
#pragma unroll
      for (int i = 0; i < 4; i++) {
        xv[i * 4 + 0] = xo[i].x + g4[i].x * (ov[i * 4 + 0] * inv * n4[i].x);
        xv[i * 4 + 1] = xo[i].y + g4[i].y * (ov[i * 4 + 1] * inv * n4[i].y);
        xv[i * 4 + 2] = xo[i].z + g4[i].z * (ov[i * 4 + 2] * inv * n4[i].z);
        xv[i * 4 + 3] = xo[i].w + g4[i].w * (ov[i * 4 + 3] * inv * n4[i].w);
      }
#pragma unroll
      for (int i = 0; i < 4; i++)
        *(float4*)(xd + i * 256 + lane * 4) = make_float4(xv[i * 4 + 0], xv[i * 4 + 1], xv[i * 4 + 2], xv[i * 4 + 3]);
    }
    if (!do_norm) continue;
    float ss2 = 0.f;
#pragma unroll
    for (int i = 0; i < 16; i++) ss2 += xv[i] * xv[i];
    ss2 = wsum(ss2);
    const float inv2 = rsq(ss2 * (1.f / 1024.f) + 1e-6f);
#pragma unroll
    for (int i = 0; i < 4; i++) {
      const int col = i * 256 + lane * 4;
      float h0 = xv[i * 4 + 0] * inv2 * n2[i].x * (1.f + sc4[i].x) + sh4[i].x;
      float h1 = xv[i * 4 + 1] * inv2 * n2[i].y * (1.f + sc4[i].y) + sh4[i].y;
      float h2 = xv[i * 4 + 2] * inv2 * n2[i].z * (1.f + sc4[i].z) + sh4[i].z;
      float h3 = xv[i * 4 + 3] * inv2 * n2[i].w * (1.f + sc4[i].w) + sh4[i].w;
      uint2 o;
      o.x = pack2(h0, h1);
      o.y = pack2(h2, h3);
      *(uint2*)(H + (size_t)r * DM + col) = o;
    }
  }
}

#define LDT 72
namespace pg8 {
#define PG8_LAS __attribute__((address_space(3)))
typedef unsigned short bf16_t;
typedef short bf16x8 __attribute__((ext_vector_type(8)));
typedef float f32x4 __attribute__((ext_vector_type(4)));
typedef unsigned u32x4 __attribute__((ext_vector_type(4)));
constexpr int BM = 256, BK = 64, HALF = 128, HTB = HALF * BK * 2  , STAGE_BYTES = 8 * HTB, NXCD = 8, WGM = 8;

__host__ __device__ __forceinline__ int lds_byte(int r, int c) { const int st = (r >> 4) * 2 + (c >> 5), rr = r & 15, cc = c & 31, ob = rr * 64 + cc * 2; return st * 1024 + (ob ^ (((ob >> 9) & 1) << 5)); }
__host__ __device__ __forceinline__ void stage_rc(int b, int& R, int& C) { const int st = b / 1024, sb = b % 1024, swz = sb ^ (((sb >> 9) & 1) << 5); R = (st >> 1) * 16 + swz / 64; C = (st & 1) * 32 + (swz % 64) / 2; }
__host__ __device__ __forceinline__ int perm32(int rho) { const int n = rho >> 4, i = rho & 15; return 8 * (i >> 2) + 4 * n + (i & 3); }

struct Unit { int pm, pn; };
struct Gemm { const bf16_t* A; const bf16_t* Bt; int M, N, K, lda; };
struct StaticOrder {
    int nM, nN, nwg, G, c, skip;
    __host__ __device__ void init(int M, int N, int G_, int c_, int skip_ = 0) { nM = M / BM; nN = N / BM; nwg = nM * nN; G = G_; c = c_; skip = skip_; }
    __host__ __device__ bool next(int i, Unit& u) const {
        const long L = (long)i * G + c; if (L >= nwg) return false;
        int wgid = (int)L; { const int q = nwg / NXCD, r = nwg % NXCD, xcd = wgid % NXCD, off = wgid / NXCD; wgid = (xcd < r ? xcd * (q + 1) : r * (q + 1) + (xcd - r) * q) + off; }
        const int nig = WGM * nN, gid = wgid / nig, fm = gid * WGM, gsz = (nM - fm) < WGM ? (nM - fm) : WGM;
        u.pm = fm + ((wgid % nig) % gsz); u.pn = (wgid % nig) / gsz;
        if (skip) u.pm = (u.pm >> 4) * 17 + 1 + (u.pm & 15);
        return true;
    }
    __device__ __forceinline__ void a_ready(const Unit&) const {}
    __device__ __forceinline__ void done(const Unit&) const {}
};
__device__ __forceinline__ unsigned cvt_pk_bf16(float lo, float hi) { unsigned r; asm volatile("v_cvt_pk_bf16_f32 %0, %1, %2" : "=v"(r) : "v"(lo), "v"(hi)); return r; }
template <class Epi, class Sched, bool STAMP = false>
__device__ __forceinline__ void gemm_phase(PG8_LAS unsigned char* lds, const Gemm g, const Sched& S, const Epi& E, unsigned long long* stamps) {
    const int tid = TIDX, wid = __builtin_amdgcn_readfirstlane(tid >> 6), lane = tid & 63, wr = wid >> 2, wc = wid & 3, fr = lane & 15, fq = lane >> 4;
    const int K = g.K, nt = K / BK;
    int ts_lo = 0, ts_hi = 0, nts = 0; const unsigned long long rt_entry = STAMP ? (unsigned long long)wall_clock64() : 0ull;
#define PG8_STAMP() do { if (STAMP && wid == 0 && nts < 64) { const unsigned long long _c = (unsigned long long)clock64(); \
        ts_lo = (lane == nts) ? (int)(unsigned)_c : ts_lo; ts_hi = (lane == nts) ? (int)(unsigned)(_c >> 32) : ts_hi; ++nts; } } while (0)
    PG8_STAMP();
    unsigned voffA[2], voffB[2];
#pragma unroll
    for (int i = 0; i < 2; ++i) { int R, C; stage_rc(tid * 16 + i * 8192, R, C); const int Rb = Epi::PERM ? ((R & ~31) + perm32(R & 31)) : R;
        voffA[i] = (unsigned)(R * g.lda + C) * 2u; voffB[i] = (unsigned)(Rb * K + C) * 2u; }
    const size_t kstep = (size_t)(BK * 2);
    const size_t hstepB = (size_t)HALF * K * 2, hstepA = (size_t)HALF * g.lda * 2;
    const size_t tstepB = 2 * hstepB, tstepA = 2 * hstepA;
    const unsigned ldsw = (unsigned)wid * 1024u;
    const int aoff = lds_byte(wr * 64 + fr, fq * 8), boff = lds_byte(wc * 32 + fr, fq * 8);
#define PG8_SA(b, h) (((b) * 2 + (h)) * HTB)
#define PG8_SB(b, h) ((4 + (b) * 2 + (h)) * HTB)
#define PG8_STAGE(bufoff, gbase, voff) do { _Pragma("unroll") for (int _i = 0; _i < 2; ++_i) \
        __builtin_amdgcn_global_load_lds((const unsigned*)((const char*)(gbase) + (voff)[_i]), (PG8_LAS unsigned*)(lds + (bufoff) + ldsw + _i * 8192), 16, 0, 0); } while (0)
#define PG8_LDA(dst, b, h) do { _Pragma("unroll") for (int m = 0; m < 4; ++m) _Pragma("unroll") for (int k = 0; k < 2; ++k) dst[m][k] = *(const PG8_LAS bf16x8*)(lds + PG8_SA(b, h) + aoff + m * 2048 + k * 1024); } while (0)
#define PG8_LDB(dst, b, h) do { _Pragma("unroll") for (int n = 0; n < 2; ++n) _Pragma("unroll") for (int k = 0; k < 2; ++k) dst[n][k] = *(const PG8_LAS bf16x8*)(lds + PG8_SB(b, h) + boff + n * 2048 + k * 1024); } while (0)
#define PG8_MMA(ai, bj, At, Bt) do { __builtin_amdgcn_s_setprio(1); _Pragma("unroll") for (int m = 0; m < 4; ++m) _Pragma("unroll") for (int n = 0; n < 2; ++n) _Pragma("unroll") for (int k = 0; k < 2; ++k) \
        acc[ai][bj][m][n] = __builtin_amdgcn_mfma_f32_16x16x32_bf16(Bt[n][k], At[m][k], acc[ai][bj][m][n], 0, 0, 0); __builtin_amdgcn_s_setprio(0); } while (0)
#define PG8_WAIT_V(n) asm volatile("s_waitcnt vmcnt(" #n ")" ::: "memory")
#define PG8_WAIT_L(n) asm volatile("s_waitcnt lgkmcnt(" #n ")" ::: "memory")
#define PG8_BAR __builtin_amdgcn_s_barrier()
#define PG8_SCHED __builtin_amdgcn_sched_barrier(0)
    Unit cur, nxt; int ui = 0;
    if (!S.next(0, cur)) return;
    f32x4 acc[2][2][4][2];
#pragma unroll
    for (int a = 0; a < 2; ++a)
#pragma unroll
        for (int b = 0; b < 2; ++b)
#pragma unroll
            for (int m = 0; m < 4; ++m)
#pragma unroll
                for (int n = 0; n < 2; ++n) acc[a][b][m][n] = (f32x4){0.f, 0.f, 0.f, 0.f};
    bf16x8 At[4][2], B0[2][2], B1[2][2];
    const char* cA = (const char*)g.A + (size_t)cur.pm * tstepA; const char* cB = (const char*)g.Bt + (size_t)cur.pn * tstepB;
    S.a_ready(cur);
    PG8_STAGE(PG8_SB(0, 0), cB, voffB); PG8_STAGE(PG8_SA(0, 0), cA, voffA); PG8_STAGE(PG8_SB(0, 1), cB + hstepB, voffB); PG8_STAGE(PG8_SA(0, 1), cA + hstepA, voffA);
    if (wr == 1) PG8_BAR;
    PG8_WAIT_V(4); PG8_BAR;
    PG8_STAGE(PG8_SB(1, 0), cB + kstep, voffB); PG8_STAGE(PG8_SA(1, 0), cA + kstep, voffA); PG8_STAGE(PG8_SB(1, 1), cB + hstepB + kstep, voffB);
    PG8_WAIT_V(6); PG8_BAR;
    PG8_STAMP();
    for (;;) {
        const bool has_next = S.next(ui + 1, nxt);
        const char* nA = has_next ? (const char*)g.A + (size_t)nxt.pm * tstepA : cA; const char* nB = has_next ? (const char*)g.Bt + (size_t)nxt.pn * tstepB : cB;
        for (int t = 0; t < nt; t += 2) {
            const bool last = (t == nt - 2);
            const char* a1 = cA + (size_t)(t + 1) * kstep;
            const char* a2 = last ? nA : cA + (size_t)(t + 2) * kstep; const char* b2 = last ? nB : cB + (size_t)(t + 2) * kstep;
            const char* a3 = a2 + kstep; const char* b3 = b2 + kstep;
            if (last && has_next) S.a_ready(nxt);
            PG8_LDB(B0, 0, 0); PG8_SCHED; PG8_LDA(At, 0, 0); PG8_STAGE(PG8_SA(1, 1), a1 + hstepA, voffA);
            PG8_WAIT_L(8); PG8_BAR; PG8_WAIT_L(0); PG8_MMA(0, 0, At, B0); PG8_BAR; PG8_SCHED;
            PG8_LDB(B1, 0, 1); PG8_STAGE(PG8_SB(0, 0), b2, voffB);
            PG8_BAR; PG8_WAIT_L(0); PG8_MMA(0, 1, At, B1); PG8_BAR;
            PG8_LDA(At, 0, 1); PG8_STAGE(PG8_SA(0, 0), a2, voffA);
            PG8_BAR; PG8_WAIT_L(0); PG8_MMA(1, 0, At, B0); PG8_BAR; PG8_SCHED;
            PG8_STAGE(PG8_SB(0, 1), b2 + hstepB, voffB);
            PG8_WAIT_V(6); PG8_BAR; PG8_MMA(1, 1, At, B1); PG8_BAR;
            PG8_LDB(B0, 1, 0); PG8_SCHED; PG8_LDA(At, 1, 0); PG8_STAGE(PG8_SA(0, 1), a2 + hstepA, voffA);
            PG8_WAIT_L(8); PG8_BAR; PG8_WAIT_L(0); PG8_MMA(0, 0, At, B0); PG8_BAR; PG8_SCHED;
            PG8_LDB(B1, 1, 1); PG8_STAGE(PG8_SB(1, 0), b3, voffB);
            PG8_BAR; PG8_WAIT_L(0); PG8_MMA(0, 1, At, B1); PG8_BAR;
            PG8_LDA(At, 1, 1); PG8_STAGE(PG8_SA(1, 0), a3, voffA);
            PG8_BAR; PG8_WAIT_L(0); PG8_MMA(1, 0, At, B0); PG8_BAR; PG8_SCHED;
            PG8_STAGE(PG8_SB(1, 1), b3 + hstepB, voffB);
            PG8_WAIT_V(6); PG8_BAR; PG8_MMA(1, 1, At, B1); PG8_BAR;
        }
        PG8_STAMP();
        if constexpr (!Epi::AFTER_DRAIN) { E(acc, cur, wr, wc, fr, fq); S.done(cur); }
        PG8_STAMP();
        if (!has_next) break;
#pragma unroll
        for (int a = 0; a < 2; ++a)
#pragma unroll
            for (int b = 0; b < 2; ++b)
#pragma unroll
                for (int m = 0; m < 4; ++m)
#pragma unroll
                    for (int n = 0; n < 2; ++n) acc[a][b][m][n] = (f32x4){0.f, 0.f, 0.f, 0.f};
        cur = nxt; cA = nA; cB = nB; ++ui;
    }
    PG8_WAIT_V(0);
    if (wr == 0) PG8_BAR;
    PG8_BAR;
    if constexpr (Epi::AFTER_DRAIN) { E.fused(acc, cur, wr, wc, fr, fq, lds, wid, lane); S.done(cur); }
    PG8_STAMP();
    if (STAMP && wid == 0) { stamps[lane] = lane < nts ? (((unsigned long long)(unsigned)ts_hi << 32) | (unsigned)ts_lo) : 0ull;
        if (lane == 62) stamps[62] = rt_entry; if (lane == 63) stamps[63] = (unsigned long long)wall_clock64(); }
#undef PG8_STAMP
#undef PG8_SA
#undef PG8_SB
#undef PG8_STAGE
#undef PG8_LDA
#undef PG8_LDB
#undef PG8_MMA
#undef PG8_WAIT_V
#undef PG8_WAIT_L
#undef PG8_BAR
#undef PG8_SCHED
}
}

struct EpiBf {
  static constexpr bool PERM = true, AFTER_DRAIN = false;
  u16* O; int ldc; const float* bias; int act;
  __device__ __forceinline__ void operator()(const f32x4 (&acc)[2][2][4][2], const pg8::Unit& u, int wr, int wc, int fr, int fq) const {
    const int row0 = u.pm * 256 + wr * 64 + fr, col0 = u.pn * 256 + wc * 32 + 8 * fq;
    f32x4 bv[2][2];
#pragma unroll
    for (int bj = 0; bj < 2; ++bj)
#pragma unroll
      for (int n = 0; n < 2; ++n) bv[bj][n] = bias ? *(const f32x4*)(bias + col0 + bj * 128 + 4 * n) : f32x4{0.f, 0.f, 0.f, 0.f};
#pragma unroll
    for (int ai = 0; ai < 2; ++ai)
#pragma unroll
      for (int m = 0; m < 4; ++m) {
        u16* rowp = O + (size_t)(row0 + ai * 128 + m * 16) * ldc + col0;
#pragma unroll
        for (int bj = 0; bj < 2; ++bj) {
          f32x4 v0 = acc[ai][bj][m][0] + bv[bj][0], v1 = acc[ai][bj][m][1] + bv[bj][1];
          if (act == 1) {
#pragma unroll
            for (int j = 0; j < 4; ++j) { v0[j] = sigm(v0[j]); v1[j] = sigm(v1[j]); }
          }
          uint4 wv;
          wv.x = pack2(v0[0], v0[1]); wv.y = pack2(v0[2], v0[3]); wv.z = pack2(v1[0], v1[1]); wv.w = pack2(v1[2], v1[3]);
          *(uint4*)(rowp + bj * 128) = wv;
        }
      }
  }
};
struct EpiSwiglu {
  static constexpr bool PERM = true, AFTER_DRAIN = false;
  u16* O;
  __device__ __forceinline__ void operator()(const f32x4 (&acc)[2][2][4][2], const pg8::Unit& u, int wr, int wc, int fr, int fq) const {
    const int row0 = u.pm * 256 + wr * 64 + fr, col0 = u.pn * 128 + wc * 16 + 4 * fq;
#pragma unroll
    for (int ai = 0; ai < 2; ++ai)
#pragma unroll
      for (int m = 0; m < 4; ++m) {
        u16* rowp = O + (size_t)(row0 + ai * 128 + m * 16) * FH + col0;
#pragma unroll
        for (int bj = 0; bj < 2; ++bj) {
          const f32x4 g = acc[ai][bj][m][0], up = acc[ai][bj][m][1];
          uint2 wv;
          wv.x = pack2(siluf(g[0]) * up[0], siluf(g[1]) * up[1]);
          wv.y = pack2(siluf(g[2]) * up[2], siluf(g[3]) * up[3]);
          *(uint2*)(rowp + bj * 64) = wv;
        }
      }
  }
};
struct EpiGateAcc {
  static constexpr bool PERM = true, AFTER_DRAIN = false;
  u16* ACC; const u16* G; int gcol; unsigned amask;
  __device__ __forceinline__ void operator()(const f32x4 (&acc)[2][2][4][2], const pg8::Unit& u, int wr, int wc, int fr, int fq) const {
    unsigned pk[2][2][4][4];
#pragma unroll
    for (int ai = 0; ai < 2; ++ai)
#pragma unroll
      for (int bj = 0; bj < 2; ++bj)
#pragma unroll
        for (int m = 0; m < 4; ++m) {
          pk[ai][bj][m][0] = pack2(acc[ai][bj][m][0][0], acc[ai][bj][m][0][1]);
          pk[ai][bj][m][1] = pack2(acc[ai][bj][m][0][2], acc[ai][bj][m][0][3]);
          pk[ai][bj][m][2] = pack2(acc[ai][bj][m][1][0], acc[ai][bj][m][1][1]);
          pk[ai][bj][m][3] = pack2(acc[ai][bj][m][1][2], acc[ai][bj][m][1][3]);
        }
    asm volatile("" ::: "memory");
    const int row0 = u.pm * 256 + wr * 64 + fr, col0 = u.pn * 256 + wc * 32 + 8 * fq;
#pragma unroll
    for (int ai = 0; ai < 2; ++ai)
#pragma unroll
      for (int m = 0; m < 4; ++m) {
        const size_t row = (size_t)(row0 + ai * 128 + m * 16);
#pragma unroll
        for (int bj = 0; bj < 2; ++bj) {
          const int col = col0 + bj * 128;
          const uint4 gv = *(const uint4*)(G + row * 2048 + gcol + col);
          const uint4 av = *(const uint4*)(ACC + row * DM + col);
          const unsigned gw[4] = {gv.x, gv.y, gv.z, gv.w};
          const unsigned aw[4] = {av.x & amask, av.y & amask, av.z & amask, av.w & amask};
          unsigned ow[4];
#pragma unroll
          for (int q = 0; q < 4; ++q) {
            const unsigned pv = pk[ai][bj][m][q];
            const float lo = __uint_as_float(aw[q] << 16) + __uint_as_float(gw[q] << 16) * __uint_as_float(pv << 16);
            const float hi = __uint_as_float(aw[q] & 0xffff0000u) + __uint_as_float(gw[q] & 0xffff0000u) * __uint_as_float(pv & 0xffff0000u);
            ow[q] = pack2(lo, hi);
          }
          *(uint4*)(ACC + row * DM + col) = make_uint4(ow[0], ow[1], ow[2], ow[3]);
        }
        asm volatile("" ::: "memory");
      }
  }
};

template <int MI>
__device__ __forceinline__ void gemm_loop(const u16* __restrict__ A, int lda, const u16* __restrict__ Bt, int ldb, int K,
                                          f32x4 (&acc)[MI][4], u16* sA, u16* sB) {
  constexpr int BMT = MI * 64;
  const int tid = TIDX, lane = tid & 63, w = tid >> 6, wm = w >> 1, wn = w & 1, fr = lane & 15, fq = lane >> 4;
  uint4 ra[MI], rb[2];
  const u16* ga = A + (size_t)(tid >> 3) * lda + (tid & 7) * 8;
  const u16* gb = Bt + (size_t)(tid >> 3) * ldb + (tid & 7) * 8;
  const int so = (tid >> 3) * LDT + (tid & 7) * 8;
#pragma unroll
  for (int i = 0; i < MI; i++) ra[i] = *(const uint4*)(ga + (size_t)(i * 64) * lda);
#pragma unroll
  for (int i = 0; i < 2; i++) rb[i] = *(const uint4*)(gb + (size_t)(i * 64) * ldb);
#pragma unroll
  for (int i = 0; i < MI; i++) *(uint4*)(sA + so + i * 64 * LDT) = ra[i];
#pragma unroll
  for (int i = 0; i < 2; i++) *(uint4*)(sB + so + i * 64 * LDT) = rb[i];
  __syncthreads();
  const int nk = K >> 6;
  for (int kt = 0; kt < nk; kt++) {
    const bool more = kt + 1 < nk;
    if (more) {
#pragma unroll
      for (int i = 0; i < MI; i++) ra[i] = *(const uint4*)(ga + (size_t)(i * 64) * lda + (kt + 1) * 64);
#pragma unroll
      for (int i = 0; i < 2; i++) rb[i] = *(const uint4*)(gb + (size_t)(i * 64) * ldb + (kt + 1) * 64);
    }
    const u16* a = sA + (kt & 1) * BMT * LDT + (wm * (MI * 16) + fr) * LDT + fq * 8;
    const u16* b = sB + (kt & 1) * 128 * LDT + (wn * 64 + fr) * LDT + fq * 8;
#pragma unroll
    for (int ks = 0; ks < 2; ks++) {
      bf16x8 af[MI], bfr[4];
#pragma unroll
      for (int i = 0; i < MI; i++) af[i] = *(const bf16x8*)(a + i * 16 * LDT + ks * 32);
#pragma unroll
      for (int j = 0; j < 4; j++) bfr[j] = *(const bf16x8*)(b + j * 16 * LDT + ks * 32);
#pragma unroll
      for (int i = 0; i < MI; i++)
#pragma unroll
        for (int j = 0; j < 4; j++) acc[i][j] = __builtin_amdgcn_mfma_f32_16x16x32_bf16(bfr[j], af[i], acc[i][j], 0, 0, 0);
    }
    if (more) {
      u16* da = sA + ((kt + 1) & 1) * BMT * LDT + so;
      u16* db = sB + ((kt + 1) & 1) * 128 * LDT + so;
#pragma unroll
      for (int i = 0; i < MI; i++) *(uint4*)(da + i * 64 * LDT) = ra[i];
#pragma unroll
      for (int i = 0; i < 2; i++) *(uint4*)(db + i * 64 * LDT) = rb[i];
    }
    __syncthreads();
  }
}

template <int MI>
__device__ __forceinline__ void zero_acc(f32x4 (&acc)[MI][4]) {
#pragma unroll
  for (int i = 0; i < MI; i++)
#pragma unroll
    for (int j = 0; j < 4; j++) acc[i][j] = f32x4{0.f, 0.f, 0.f, 0.f};
}


typedef unsigned u32x4v __attribute__((ext_vector_type(4)));
__device__ __forceinline__ void yp_issue(const u16* __restrict__ A, const u16* __restrict__ B, u32x4v (&ra)[8], u32x4v (&rb)[8], int tid) {
#pragma unroll
  for (int i = 0; i < 8; i++) {
    const int c = tid + i * NTHR, row = c >> 5, ch = c & 31;
    ra[i] = *(const u32x4v*)(A + (size_t)row * YST + ch * 8);
    rb[i] = *(const u32x4v*)(B + (size_t)row * 256 + ch * 8);
  }
}
__device__ __forceinline__ void yp_stage(unsigned char* sA, unsigned char* sB, const u32x4v (&ra)[8], const u32x4v (&rb)[8], int tid) {
#pragma unroll
  for (int i = 0; i < 8; i++) {
    const int c = tid + i * NTHR, row = c >> 5, ch = c & 31;
    const int off = row * 512 + ((ch ^ (row & 7)) << 4);
    *(u32x4v*)(sA + off) = ra[i];
    *(u32x4v*)(sB + off) = rb[i];
  }
}
__device__ __forceinline__ void phase_ypart(const Params& p, int l, unsigned char* smem) {
  unsigned char* sA = smem;
  unsigned char* sB = smem + 65536;
  const int tid = TIDX, lane = tid & 63, w = tid >> 6, wm = w >> 1, wn = w & 1, fr = lane & 15, fq = lane >> 4;
  const u16* Y = (const u16*)(p.ws + OFF_YS);
  const u16* Wb = (const u16*)(p.ws + OFF_W + OW_B);
  const u16* G = (const u16*)(p.ws + OFF_BIG);
  u16* ACC = (u16*)(p.ws + OFF_H);
  constexpr int NT = 8;
  const int ntiles = (NROWS / 128) * NT;
  const int G_ = gridDim.x;
  const bool xmap = (G_ == 256);
  const int xj = blockIdx.x >> 3, xx = blockIdx.x & 7;
  const bool skipc = (l == 1);
  const int nrt = skipc ? 256 : 272;
  const int ntl = nrt * NT;
  const int nmine = xmap ? (xj < nrt ? (nrt - 1 - xj) / 32 + 1 : 0)
                         : (((int)blockIdx.x < ntl) ? (ntl - 1 - (int)blockIdx.x) / G_ + 1 : 0);
  if (nmine == 0) return;
#define YP_TILE(Q_, MT_, NT_)                                                        \
  do {                                                                               \
    if (xmap) { const int s_ = (Q_) * 32 + xj; MT_ = (s_ >> 3) * 8 + xx; NT_ = s_ & 7; } \
    else { const int t_ = blockIdx.x + (Q_) * G_; MT_ = t_ / NT; NT_ = t_ - MT_ * NT; }  \
    if (skipc) MT_ = (MT_ >> 5) * 34 + 2 + (MT_ & 31);                                   \
  } while (0)
  u32x4v ra[8], rb[8];
  {
    int mt, nt;
    YP_TILE(0, mt, nt);
    yp_issue(Y + (size_t)mt * 128 * YST, Wb + ((size_t)nt * 128) * 256, ra, rb, tid);
  }
  f32x4 tot[2][4];
  zero_acc<2>(tot);
  for (int qi = 0; qi < 4 * nmine; qi++) {
    const int q = qi >> 2, k = qi & 3;
    int mt, nt;
    YP_TILE(q, mt, nt);
    const int r0 = mt * 128 + wm * 32 + fr, c0 = nt * 128 + wn * 64 + fq * 4;
    uint2 gv[2][4];
#pragma unroll
    for (int i = 0; i < 2; i++)
#pragma unroll
      for (int j = 0; j < 4; j++) gv[i][j] = *(const uint2*)(G + (size_t)(r0 + i * 16) * 4096 + k * 1024 + c0 + j * 16);
    __syncthreads();
    yp_stage(sA, sB, ra, rb, tid);
    __syncthreads();
    {
      const int qn = qi + 1 < 4 * nmine ? qi + 1 : qi;
      int mtn, ntn;
      YP_TILE(qn >> 2, mtn, ntn);
      const int brn = qn & 3, ycn = brn < 3 ? brn * 256 : 1536;
      yp_issue(Y + (size_t)mtn * 128 * YST + ycn, Wb + ((size_t)brn * 1024 + ntn * 128) * 256, ra, rb, tid);
    }
    f32x4 ay[2][4];
    zero_acc<2>(ay);
#pragma unroll 2
    for (int ks = 0; ks < 8; ks++) {
      bf16x8 af[2], bfr[4];
#pragma unroll
      for (int i = 0; i < 2; i++) {
        const int row = wm * 32 + i * 16 + fr;
        af[i] = *(const bf16x8*)(sA + row * 512 + (((ks * 4 + fq) ^ (row & 7)) << 4));
      }
#pragma unroll
      for (int j = 0; j < 4; j++) {
        const int row = wn * 64 + j * 16 + fr;
        bfr[j] = *(const bf16x8*)(sB + row * 512 + (((ks * 4 + fq) ^ (row & 7)) << 4));
      }
#pragma unroll
      for (int i = 0; i < 2; i++)
#pragma unroll
        for (int j = 0; j < 4; j++) ay[i][j] = __builtin_amdgcn_mfma_f32_16x16x32_bf16(bfr[j], af[i], ay[i][j], 0, 0, 0);
    }
#pragma unroll
    for (int i = 0; i < 2; i++)
#pragma unroll
      for (int j = 0; j < 4; j++) {
        tot[i][j][0] += __uint_as_float(gv[i][j].x << 16) * ay[i][j][0];
        tot[i][j][1] += __uint_as_float(gv[i][j].x & 0xffff0000u) * ay[i][j][1];
        tot[i][j][2] += __uint_as_float(gv[i][j].y << 16) * ay[i][j][2];
        tot[i][j][3] += __uint_as_float(gv[i][j].y & 0xffff0000u) * ay[i][j][3];
      }
    if (k == 3) {
#pragma unroll
      for (int i = 0; i < 2; i++)
#pragma unroll
        for (int j = 0; j < 4; j++) {
          uint2 ov;
          ov.x = pack2(tot[i][j][0], tot[i][j][1]); ov.y = pack2(tot[i][j][2], tot[i][j][3]);
          *(uint2*)(ACC + (size_t)(r0 + i * 16) * DM + c0 + j * 16) = ov;
        }
      zero_acc<2>(tot);
    }
  }
  __syncthreads();
#undef YP_TILE
}

#define S2_BUF 10816
#define S2_D 0
#define S2_U 2048
#define S2_P 4096
#define S2_K 6144
#define S2_DQ 8192
#define S2_V 10240
#define S2_C1 10752
#define S2_C2 10784
#define S2_ST (2 * S2_BUF)
#define S2_YB (S2_ST + 8192)

__device__ __forceinline__ float red16(float x) {
  x += dppf<0xB1>(x);
  x += dppf<0x4E>(x);
  x += dppf<0x141>(x);
  x += dppf<0x140>(x);
  return x;
}
__device__ __forceinline__ void wave_lds_sync() {
  asm volatile("s_waitcnt lgkmcnt(0)" ::: "memory");
  __builtin_amdgcn_wave_barrier();
}

template <int MIX>
__device__ __forceinline__ void scan2_item(const Params& p, int l, int b, int h, int dir, int rq, float* sm) {
  constexpr int EPL = (MIX == 2) ? 2 : 4;
  constexpr int VOFF = (MIX == 2) ? 64 : 128;
  const int tid = TIDX, lane = tid & 63, w = tid >> 6, fr = lane & 15, fq = lane >> 4;
  const bool producer = w >= 4;
  const int pw = w & 3;
  const u16* P = (const u16*)(p.ws + OFF_BIG);
  u16* YS = (u16*)(p.ws + OFF_YS);
  float* BC = (float*)(p.ws + OFF_BC);
  float* ST = sm + S2_ST + pw * 2048;
  float s[EPL];
#pragma unroll
  for (int i = 0; i < EPL; i++) s[i] = 0.f;

  bf16x8 bw2[4], ba2[4];
  float cst[5][4];
  float cw[3][7];
  float muv[4];
  int colv[4];
#pragma unroll
  for (int i = 0; i < 4; i++) { bw2[i] = bf16x8{0, 0, 0, 0, 0, 0, 0, 0}; ba2[i] = bw2[i]; muv[i] = 0.f; colv[i] = 0; }
  if (producer) {
    if (MIX == 0) {
#pragma unroll
      for (int nt = 0; nt < 4; nt++) {
        const int jch = h * 64 + nt * 16 + fr;
#pragma unroll
        for (int jj = 0; jj < 8; jj++) {
          bw2[nt][jj] = (short)f2bf(p.rwkv_w2[((size_t)(l * 2 + dir) * 32 + fq * 8 + jj) * 256 + jch]);
          ba2[nt][jj] = (short)f2bf(p.rwkv_a2[((size_t)(l * 2 + dir) * 32 + fq * 8 + jj) * 256 + jch]);
        }
        cst[0][nt] = p.rwkv_w0[(l * 2 + dir) * 256 + jch];
        cst[1][nt] = p.rwkv_a0[(l * 2 + dir) * 256 + jch];
        cst[2][nt] = p.rwkv_ka[l * 256 + jch];
        cst[3][nt] = p.rwkv_kk[l * 256 + jch];
        cst[4][nt] = p.rwkv_rk[l * 256 + jch];
      }
#pragma unroll
      for (int i = 0; i < 4; i++) {
        const int c = lane + 64 * i;
        colv[i] = i < 3 ? i * 256 + h * 64 + lane : (lane < 32 ? 768 + dir * 32 + lane : 832 + dir * 32 + (lane - 32));
        muv[i] = p.rwkv_mu[l * 960 + colv[i]];
        (void)c;
      }
    } else if (MIX == 1) {
#pragma unroll
      for (int i = 0; i < 3; i++) {
        colv[i] = PB + i * 256 + h * 64 + lane;
#pragma unroll
        for (int tp = 0; tp < 7; tp++) cw[i][tp] = p.gdn_conv[((size_t)l * 7 + tp) * 768 + i * 256 + h * 64 + lane];
      }
    } else {
#pragma unroll
      for (int nt = 0; nt < 2; nt++) {
#pragma unroll
        for (int jj = 0; jj < 8; jj++)
          bw2[nt][jj] = fq < 2 ? (short)f2bf(p.gla_gw2[((size_t)(l * 2 + dir) * 16 + fq * 8 + jj) * 128 + h * 32 + nt * 16 + fr]) : (short)0;
        cst[0][nt] = p.gla_gb[(l * 2 + dir) * 128 + h * 32 + nt * 16 + fr];
      }
      colv[0] = PC + h * 32 + lane;
      if (lane >= 32) colv[0] = PC + 128 + h * 32 + (lane - 32);
      colv[1] = PC + 256 + h * 64 + lane;
      colv[2] = PC + 512 + dir * 16 + (lane & 15);
    }
  }
  __syncthreads();

  for (int c = 0; c <= TPB / 32 + 1; c++) {
    if (producer) {
      if (c >= 2) {
        const int cc = c - 2;
        int seg_row0, t_lo;
        if (cc < 8) { seg_row0 = b * TPB; t_lo = dir == 0 ? cc * 32 : (LC - 32 - cc * 32); }
        else { seg_row0 = b * TPB + LC; t_lo = dir == 0 ? (cc - 8) * 32 : (SEQ - 32 - (cc - 8) * 32); }
        const float* yb = sm + S2_YB + (cc & 1) * 512;
        const int t2 = tid - 256;
#pragma unroll
        for (int i = 0; i < 2; i++) {
          const int idx = t2 + i * 256, tt = idx >> 4, e = idx & 15;
          YS[(size_t)(seg_row0 + t_lo + tt) * YST + dir * 768 + MIX * 256 + h * 64 + rq * 16 + e] = f2bf(yb[idx]);
        }
      }
      if (c < TPB / 32) {
        int seg_row0, seg_len, t_lo;
        if (c < 8) { seg_row0 = b * TPB; seg_len = LC; t_lo = dir == 0 ? c * 32 : (LC - 32 - c * 32); }
        else { seg_row0 = b * TPB + LC; seg_len = SEQ; t_lo = dir == 0 ? (c - 8) * 32 : (SEQ - 32 - (c - 8) * 32); }
        const u16* Pseg = P + (size_t)seg_row0 * PST;
        float* B = sm + (c & 1) * S2_BUF;
        const int t0 = t_lo + pw * 8;
        if (MIX == 0) {
          float raw[10][4];
#pragma unroll
          for (int rr = 0; rr < 10; rr++) {
            const int t = t0 - 1 + rr;
            const float okf = (t >= 0 && t < seg_len) ? 1.f : 0.f;
            const int tc = min(max(t, 0), seg_len - 1);
#pragma unroll
            for (int i = 0; i < 4; i++) raw[rr][i] = bf2f(Pseg[(size_t)tc * PST + PA + colv[i]]) * okf;
          }
#pragma unroll
          for (int j = 0; j < 8; j++)
#pragma unroll
            for (int i = 0; i < 4; i++) {
              float xm = raw[j + 1][i] + (0.5f * (raw[j][i] + raw[j + 2][i]) - raw[j + 1][i]) * muv[i];
              if (i == 3 && lane < 32) xm = tanh_fast(xm);
              ST[j * 256 + lane + 64 * i] = xm;
            }
        } else if (MIX == 1) {
          float raw[14][3];
#pragma unroll
          for (int rr = 0; rr < 14; rr++) {
            const int t = t0 - 3 + rr;
            const float okf = (t >= 0 && t < seg_len) ? 1.f : 0.f;
            const int tc = min(max(t, 0), seg_len - 1);
#pragma unroll
            for (int i = 0; i < 3; i++) raw[rr][i] = bf2f(Pseg[(size_t)tc * PST + colv[i]]) * okf;
          }
#pragma unroll
          for (int j = 0; j < 8; j++)
#pragma unroll
            for (int i = 0; i < 3; i++) {
              float a = 0.f;
#pragma unroll
              for (int tp = 0; tp < 7; tp++) a += raw[j + tp][i] * cw[i][tp];
              ST[j * 256 + lane + 64 * i] = siluf(a);
            }
          if (lane < 8) {
            const u16* pp = Pseg + (size_t)(t0 + lane) * PST + PB;
            float bx = bf2f(pp[768 + dir * 4 + h]);
            float ax = bf2f(pp[776 + dir * 4 + h]);
            float ld = -__expf(p.gdn_a_log[(l * 2 + dir) * 4 + h]) * softplusf(ax + p.gdn_dt_bias[(l * 2 + dir) * 4 + h]);
            ST[lane * 256 + 192] = sigm(bx);
            ST[lane * 256 + 193] = __expf(ld);
          }
        } else {
          u16 raw[8][3];
#pragma unroll
          for (int j = 0; j < 8; j++) {
            const u16* pp = Pseg + (size_t)(t0 + j) * PST;
#pragma unroll
            for (int i = 0; i < 3; i++) raw[j][i] = pp[colv[i]];
          }
          const float qs = lane < 32 ? 0.17677669529663687f : 1.f;
#pragma unroll
          for (int j = 0; j < 8; j++) {
            ST[j * 256 + lane] = bf2f(raw[j][0]) * qs;
            ST[j * 256 + 64 + lane] = bf2f(raw[j][1]);
            if (lane < 16) ST[j * 256 + 128 + lane] = bf2f(raw[j][2]);
          }
        }
        wave_lds_sync();
        const bool vl = fq < 2;
        if (MIX == 0) {
          bf16x8 aw, aa;
#pragma unroll
          for (int jj = 0; jj < 8; jj++) {
            aw[jj] = fr < 8 ? (short)f2bf(ST[fr * 256 + 192 + fq * 8 + jj]) : (short)0;
            aa[jj] = fr < 8 ? (short)f2bf(ST[fr * 256 + 224 + fq * 8 + jj]) : (short)0;
          }
          f32x4 accw[4], acca[4];
#pragma unroll
          for (int nt = 0; nt < 4; nt++) {
            accw[nt] = __builtin_amdgcn_mfma_f32_16x16x32_bf16(aw, bw2[nt], f32x4{0.f, 0.f, 0.f, 0.f}, 0, 0, 0);
            acca[nt] = __builtin_amdgcn_mfma_f32_16x16x32_bf16(aa, ba2[nt], f32x4{0.f, 0.f, 0.f, 0.f}, 0, 0, 0);
          }
#pragma unroll
          for (int r = 0; r < 4; r++) {
            const int j = (fq & 1) * 4 + r, tt = pw * 8 + j;
            float kkx[4], av[4], kdv[4], rv[4], dec[4];
            float ss = 0.f;
#pragma unroll
            for (int nt = 0; nt < 4; nt++) {
              const int n = nt * 16 + fr;
              rv[nt] = ST[j * 256 + n];
              const float kx = ST[j * 256 + 64 + n];
              dec[nt] = __expf(-0.6065306597126334f * sigm(cst[0][nt] + accw[nt][r]));
              av[nt] = sigm(cst[1][nt] + acca[nt][r]);
              kdv[nt] = kx * (1.f + (av[nt] - 1.f) * cst[2][nt]);
              kkx[nt] = kx * cst[3][nt];
              ss += kkx[nt] * kkx[nt];
            }
            ss = red16(ss);
            const float rs = rsq(ss + 1e-6f);
            float c1 = 0.f, c2 = 0.f, bc = 0.f;
#pragma unroll
            for (int nt = 0; nt < 4; nt++) {
              const int n = nt * 16 + fr;
              const float kk = kkx[nt] * rs;
              if (vl) {
                B[S2_D + tt * 64 + n] = dec[nt];
                B[S2_U + tt * 64 + n] = kk;
                B[S2_P + tt * 64 + n] = -kk * av[nt];
                B[S2_K + tt * 64 + n] = kdv[nt];
                B[S2_DQ + tt * 64 + n] = dec[nt] * rv[nt];
              }
              c1 += -kk * av[nt] * rv[nt];
              c2 += kdv[nt] * rv[nt];
              bc += rv[nt] * kdv[nt] * cst[4][nt];
            }
            c1 = red16(c1); c2 = red16(c2); bc = red16(bc);
            if (vl && fr == 0) {
              B[S2_C1 + tt] = c1;
              B[S2_C2 + tt] = c2;
              if (rq == 0) BC[(size_t)(seg_row0 + t_lo + tt) * 8 + h * 2 + dir] = bc;
            }
          }
        } else if (MIX == 1) {
#pragma unroll
          for (int r = 0; r < 4; r++) {
            const int j = (fq & 1) * 4 + r, tt = pw * 8 + j;
            float qv[4], kv[4];
            float sq = 0.f, sk = 0.f;
#pragma unroll
            for (int nt = 0; nt < 4; nt++) {
              const int n = nt * 16 + fr;
              qv[nt] = ST[j * 256 + n];
              kv[nt] = ST[j * 256 + 64 + n];
              sq += qv[nt] * qv[nt];
              sk += kv[nt] * kv[nt];
            }
            sq = red16(sq); sk = red16(sk);
            const float rq_ = rsq(sq + 1e-6f) * 0.125f, rk_ = rsq(sk + 1e-6f);
            const float beta = ST[j * 256 + 192], alpha = ST[j * 256 + 193];
            float dkq = 0.f;
#pragma unroll
            for (int nt = 0; nt < 4; nt++) {
              const int n = nt * 16 + fr;
              const float qn = qv[nt] * rq_, kn = kv[nt] * rk_;
              if (vl) {
                B[S2_D + tt * 64 + n] = alpha;
                B[S2_U + tt * 64 + n] = kn;
                B[S2_P + tt * 64 + n] = -alpha * beta * kn;
                B[S2_K + tt * 64 + n] = beta * kn;
                B[S2_DQ + tt * 64 + n] = alpha * qn;
              }
              dkq += kn * qn;
            }
            dkq = red16(dkq);
            if (vl && fr == 0) {
              B[S2_C1 + tt] = -alpha * beta * dkq;
              B[S2_C2 + tt] = beta * dkq;
            }
          }
        } else {
          bf16x8 ag;
#pragma unroll
          for (int jj = 0; jj < 8; jj++) ag[jj] = (fr < 8 && fq < 2) ? (short)f2bf(ST[fr * 256 + 128 + fq * 8 + jj]) : (short)0;
          f32x4 accg[2];
#pragma unroll
          for (int nt = 0; nt < 2; nt++) accg[nt] = __builtin_amdgcn_mfma_f32_16x16x32_bf16(ag, bw2[nt], f32x4{0.f, 0.f, 0.f, 0.f}, 0, 0, 0);
#pragma unroll
          for (int r = 0; r < 4; r++) {
            const int j = (fq & 1) * 4 + r, tt = pw * 8 + j;
            float dkq = 0.f;
#pragma unroll
            for (int nt = 0; nt < 2; nt++) {
              const int n = nt * 16 + fr;
              const float lg = cst[0][nt] + accg[nt][r];
              const float ls = fminf(lg, 0.f) - __logf(1.f + __expf(-fabsf(lg)));
              const float alpha = __expf(ls * (1.f / 16.f));
              const float qv = ST[j * 256 + n], kv = ST[j * 256 + 32 + n];
              if (vl) {
                B[S2_D + tt * 64 + n] = alpha;
                B[S2_K + tt * 64 + n] = kv;
                B[S2_DQ + tt * 64 + n] = alpha * qv;
              }
              dkq += kv * qv;
            }
            dkq = red16(dkq);
            if (vl && fr == 0) B[S2_C2 + tt] = dkq;
          }
        }
#pragma unroll
        for (int i = 0; i < 2; i++) {
          const int idx = lane + 64 * i, j = idx >> 4, e = idx & 15;
          B[S2_V + (pw * 8 + j) * 16 + e] = ST[j * 256 + VOFF + rq * 16 + e];
        }
      }
    } else if (c >= 1 && c <= TPB / 32) {
      const float* B = sm + ((c - 1) & 1) * S2_BUF;
      float* yb = sm + S2_YB + ((c - 1) & 1) * 512;
      const int rl = w * 4 + fq;
      const int dtt = dir ? -1 : 1;
      int tt = dir ? 31 : 0;
      float dv[EPL], kv[EPL], qv[EPL], uv[EPL], pv[EPL], vv, c1v, c2v;
      float dn[EPL], kn[EPL], qn[EPL], un[EPL], pn[EPL], vn, c1n, c2n;
#define S2_LOAD(D_, K_, Q_, U_, P_, V_, C1_, C2_, T_)                                   \
  do {                                                                                  \
    const int o_ = (T_) * 64 + fr * EPL;                                                \
    if (EPL == 4) {                                                                     \
      float4 t4 = *(const float4*)(B + S2_D + o_);                                      \
      D_[0] = t4.x; D_[1] = t4.y; D_[2] = t4.z; D_[3] = t4.w;                           \
      t4 = *(const float4*)(B + S2_K + o_);                                             \
      K_[0] = t4.x; K_[1] = t4.y; K_[2] = t4.z; K_[3] = t4.w;                           \
      t4 = *(const float4*)(B + S2_DQ + o_);                                            \
      Q_[0] = t4.x; Q_[1] = t4.y; Q_[2] = t4.z; Q_[3] = t4.w;                           \
      t4 = *(const float4*)(B + S2_U + o_);                                             \
      U_[0] = t4.x; U_[1] = t4.y; U_[2] = t4.z; U_[3] = t4.w;                           \
      t4 = *(const float4*)(B + S2_P + o_);                                             \
      P_[0] = t4.x; P_[1] = t4.y; P_[2] = t4.z; P_[3] = t4.w;                           \
      C1_ = B[S2_C1 + (T_)];                                                            \
    } else {                                                                            \
      float2 t2 = *(const float2*)(B + S2_D + o_);                                      \
      D_[0] = t2.x; D_[1] = t2.y;                                                       \
      t2 = *(const float2*)(B + S2_K + o_);                                             \
      K_[0] = t2.x; K_[1] = t2.y;                                                       \
      t2 = *(const float2*)(B + S2_DQ + o_);                                            \
      Q_[0] = t2.x; Q_[1] = t2.y;                                                       \
      U_[0] = U_[1] = P_[0] = P_[1] = 0.f; C1_ = 0.f;                                   \
    }                                                                                   \
    V_ = B[S2_V + (T_) * 16 + rl];                                                      \
    C2_ = B[S2_C2 + (T_)];                                                              \
  } while (0)
#define S2_STEP(D_, K_, Q_, U_, P_, V_, C1_, C2_, T_)                                   \
  do {                                                                                  \
    float sq = 0.f, sa = 0.f;                                                           \
    _Pragma("unroll") for (int i = 0; i < EPL; i++) sq += s[i] * Q_[i];                 \
    if (MIX != 2) {                                                                     \
      _Pragma("unroll") for (int i = 0; i < EPL; i++) sa += s[i] * U_[i];               \
      sa = red16(sa);                                                                   \
    }                                                                                   \
    sq = red16(sq);                                                                     \
    float y = sq + V_ * C2_;                                                            \
    if (MIX != 2) y += sa * C1_;                                                        \
    _Pragma("unroll") for (int i = 0; i < EPL; i++) {                                   \
      float t = s[i] * D_[i] + V_ * K_[i];                                              \
      if (MIX != 2) t += sa * P_[i];                                                    \
      s[i] = t;                                                                         \
    }                                                                                   \
    yb[(T_) * 16 + rl] = y;                                                             \
  } while (0)
      S2_LOAD(dv, kv, qv, uv, pv, vv, c1v, c2v, tt);
#pragma unroll 1
      for (int st = 0; st < 32; st += 2) {
        const int t1 = tt + dtt;
        S2_LOAD(dn, kn, qn, un, pn, vn, c1n, c2n, t1);
        S2_STEP(dv, kv, qv, uv, pv, vv, c1v, c2v, tt);
        const int t2 = st + 2 < 32 ? t1 + dtt : t1;
        S2_LOAD(dv, kv, qv, uv, pv, vv, c1v, c2v, t2);
        S2_STEP(dn, kn, qn, un, pn, vn, c1n, c2n, t1);
        tt = t2;
      }
#undef S2_LOAD
#undef S2_STEP
    }
    __syncthreads();
  }
}

#define S3_SUB 12800
#define S3_GM 0
#define S3_KVT 9216
#define S3_QB 10240
#define S3_QV 11392
#define S3_VT 11520
#define S3_WC 12544
#define S3_TB S3_QV
#define S3_QBM (S3_GM + 3072)
#define S3_QKM (S3_GM + 3200)
#define S3_KB (S3_GM + 0)
#define S3_BT (S3_GM + 2048)
#define S3_STB (8 * S3_SUB)
#define S3_END (S3_STB + 4 * 2304)

__device__ __forceinline__ float rlane(float x, int l) { return __int_as_float(__builtin_amdgcn_readlane(__float_as_int(x), l)); }
__device__ __forceinline__ float wave_sum(float x) {
  x = red16(x);
  return (rlane(x, 0) + rlane(x, 16)) + (rlane(x, 32) + rlane(x, 48));
}
__device__ __forceinline__ float clampe(float x) { return fminf(fmaxf(x, -80.f), 80.f); }
__device__ __forceinline__ uint4 pack8(const float (&v)[8]) {
  return make_uint4(pack2(v[0], v[1]), pack2(v[2], v[3]), pack2(v[4], v[5]), pack2(v[6], v[7]));
}
__device__ __forceinline__ bf16x8 ld_frag(const void* p) { return *(const bf16x8*)p; }
__device__ __forceinline__ bf16x8 zfrag() { return bf16x8{0, 0, 0, 0, 0, 0, 0, 0}; }

__device__ __forceinline__ void chunk_geom(int c, int dir, int b, int& seg_row0, int& seg_len, int& t_lo) {
  if (c < 8) { seg_row0 = b * TPB; seg_len = LC; t_lo = dir == 0 ? c * 32 : (LC - 32 - c * 32); }
  else { seg_row0 = b * TPB + LC; seg_len = SEQ; t_lo = dir == 0 ? (c - 8) * 32 : (SEQ - 32 - (c - 8) * 32); }
}
template <int MIX>
__device__ __forceinline__ void fetch_raw(const u16* P, int c, int dir, int b, int h, int pw, int lane, const int (&colv)[4], unsigned (&rawq)[14][2]) {
  int seg_row0, seg_len, t_lo;
  chunk_geom(c, dir, b, seg_row0, seg_len, t_lo);
  const u16* Pseg = P + (size_t)seg_row0 * PST;
  const int t0 = t_lo + pw * 8;
  if (MIX == 0) {
#pragma unroll
    for (int rr = 0; rr < 10; rr++) {
      const int tc = min(max(t0 - 1 + rr, 0), seg_len - 1);
#pragma unroll
      for (int i = 0; i < 2; i++)
        rawq[rr][i] = (unsigned)Pseg[(size_t)tc * PST + PA + colv[2 * i]] | ((unsigned)Pseg[(size_t)tc * PST + PA + colv[2 * i + 1]] << 16);
    }
  } else if (MIX == 1) {
#pragma unroll
    for (int rr = 0; rr < 14; rr++) {
      const int tc = min(max(t0 - 3 + rr, 0), seg_len - 1);
      rawq[rr][0] = (unsigned)Pseg[(size_t)tc * PST + colv[0]] | ((unsigned)Pseg[(size_t)tc * PST + colv[1]] << 16);
      rawq[rr][1] = (rawq[rr][1] & 0xffff0000u) | (unsigned)Pseg[(size_t)tc * PST + colv[2]];
    }
    const u16* pp = Pseg + (size_t)(t0 + (lane & 7)) * PST + PB;
    rawq[0][1] = (rawq[0][1] & 0xffffu) | ((unsigned)pp[768 + dir * 4 + h] << 16);
    rawq[1][1] = (rawq[1][1] & 0xffffu) | ((unsigned)pp[776 + dir * 4 + h] << 16);
  } else {
#pragma unroll
    for (int j = 0; j < 8; j++) {
      const u16* pp = Pseg + (size_t)(t0 + j) * PST;
      rawq[j][0] = (unsigned)pp[colv[0]] | ((unsigned)pp[colv[1]] << 16);
      rawq[j][1] = (unsigned)pp[colv[2]];
    }
  }
}

template <int MIX>
__device__ __forceinline__ void scan3_item(const Params& p, int l, int b, int h, int dir, unsigned char* smb) {
  constexpr int VOFF = (MIX == 2) ? 64 : 128;
  constexpr bool DELTA = (MIX != 2);
  const int tid = TIDX, lane = tid & 63, w = tid >> 6, fr = lane & 15, fq = lane >> 4;
  const bool producer = true;
  const int pw = w & 3, half = w >> 2;
  const u16* P = (const u16*)(p.ws + OFF_BIG);
  u16* YS = (u16*)(p.ws + OFF_YS);
  float* BC = (float*)(p.ws + OFF_BC);
  float* ST = (float*)(smb + w * S3_SUB + S3_GM);
  unsigned char* STBY = smb + w * S3_SUB + S3_GM;
  const f32x4 z4 = f32x4{0.f, 0.f, 0.f, 0.f};
  f32x4 st[4];
#pragma unroll
  for (int i = 0; i < 4; i++) st[i] = z4;

  bf16x8 bw2[4], ba2[4];
  float cw[3][7];
  float muv[4];
  int colv[4];
  float c_w0 = 0.f, c_a0 = 0.f, c_ka = 0.f, c_kk = 0.f, c_rk = 0.f, c_gb = 0.f;
#pragma unroll
  for (int i = 0; i < 4; i++) { bw2[i] = zfrag(); ba2[i] = zfrag(); muv[i] = 0.f; colv[i] = 0; }
  if (producer) {
    if (MIX == 0) {
      {
        float tw[4][8], ta[4][8];
#pragma unroll
        for (int nt = 0; nt < 4; nt++)
#pragma unroll
          for (int jj = 0; jj < 8; jj++) {
            tw[nt][jj] = p.rwkv_w2[((size_t)(l * 2 + dir) * 32 + fq * 8 + jj) * 256 + h * 64 + nt * 16 + fr];
            ta[nt][jj] = p.rwkv_a2[((size_t)(l * 2 + dir) * 32 + fq * 8 + jj) * 256 + h * 64 + nt * 16 + fr];
          }
#pragma unroll
        for (int nt = 0; nt < 4; nt++)
#pragma unroll
          for (int jj = 0; jj < 8; jj++) { bw2[nt][jj] = (short)f2bf(tw[nt][jj]); ba2[nt][jj] = (short)f2bf(ta[nt][jj]); }
      }
      const int jl = h * 64 + lane;
      c_w0 = p.rwkv_w0[(l * 2 + dir) * 256 + jl];
      c_a0 = p.rwkv_a0[(l * 2 + dir) * 256 + jl];
      c_ka = p.rwkv_ka[l * 256 + jl];
      c_kk = p.rwkv_kk[l * 256 + jl];
      c_rk = p.rwkv_rk[l * 256 + jl];
#pragma unroll
      for (int i = 0; i < 4; i++) {
        colv[i] = i < 3 ? i * 256 + h * 64 + lane : (lane < 32 ? 768 + dir * 32 + lane : 832 + dir * 32 + (lane - 32));
        muv[i] = p.rwkv_mu[l * 960 + colv[i]];
      }
    } else if (MIX == 1) {
#pragma unroll
      for (int i = 0; i < 3; i++) {
        colv[i] = PB + i * 256 + h * 64 + lane;
#pragma unroll
        for (int tp = 0; tp < 7; tp++) cw[i][tp] = p.gdn_conv[((size_t)l * 7 + tp) * 768 + i * 256 + h * 64 + lane];
      }
    } else {
      {
        float tg[2][8];
#pragma unroll
        for (int nt = 0; nt < 2; nt++)
#pragma unroll
          for (int jj = 0; jj < 8; jj++) tg[nt][jj] = p.gla_gw2[((size_t)(l * 2 + dir) * 16 + (fq & 1) * 8 + jj) * 128 + h * 32 + nt * 16 + fr];
#pragma unroll
        for (int nt = 0; nt < 2; nt++)
#pragma unroll
          for (int jj = 0; jj < 8; jj++) bw2[nt][jj] = fq < 2 ? (short)f2bf(tg[nt][jj]) : (short)0;
      }
      c_gb = p.gla_gb[(l * 2 + dir) * 128 + h * 32 + (lane & 31)];
      colv[0] = PC + h * 32 + lane;
      if (lane >= 32) colv[0] = PC + 128 + h * 32 + (lane - 32);
      colv[1] = PC + 256 + h * 64 + lane;
      colv[2] = PC + 512 + dir * 16 + (lane & 15);
    }
  }
  __syncthreads();
  unsigned rawq[14][2];
#pragma unroll
  for (int i = 0; i < 14; i++) { rawq[i][0] = 0u; rawq[i][1] = 0u; }
  fetch_raw<MIX>(P, half, dir, b, h, pw, lane, colv, rawq);
#define RAWP(r_, i_) ((u16)((rawq[r_][(i_) >> 1] >> (((i_) & 1) * 16)) & 0xffffu))

  for (int it = 0; it < TPB / 64; it++) {
    {
      {
        const int c = it * 2 + half;
        int seg_row0, seg_len, t_lo;
        chunk_geom(c, dir, b, seg_row0, seg_len, t_lo);
        unsigned char* SB = smb + w * S3_SUB;
        const int t0 = t_lo + pw * 8;
        if (MIX == 0) {
          float raw[10][4];
#pragma unroll
          for (int rr = 0; rr < 10; rr++) {
            const int t = t0 - 1 + rr;
            const float okf = (t >= 0 && t < seg_len) ? 1.f : 0.f;
#pragma unroll
            for (int i = 0; i < 4; i++) raw[rr][i] = bf2f(RAWP(rr, i)) * okf;
          }
#pragma unroll
          for (int j = 0; j < 8; j++)
#pragma unroll
            for (int i = 0; i < 4; i++) {
              float xm = raw[j + 1][i] + (0.5f * (raw[j][i] + raw[j + 2][i]) - raw[j + 1][i]) * muv[i];
              if (i == 3 && lane < 32) xm = tanh_fast(xm);
              ST[j * 256 + lane + 64 * i] = xm;
            }
        } else if (MIX == 1) {
          float raw[14][3];
#pragma unroll
          for (int rr = 0; rr < 14; rr++) {
            const int t = t0 - 3 + rr;
            const float okf = (t >= 0 && t < seg_len) ? 1.f : 0.f;
#pragma unroll
            for (int i = 0; i < 3; i++) raw[rr][i] = bf2f(RAWP(rr, i)) * okf;
          }
#pragma unroll
          for (int j = 0; j < 8; j++)
#pragma unroll
            for (int i = 0; i < 3; i++) {
              float a = 0.f;
#pragma unroll
              for (int tp = 0; tp < 7; tp++) a += raw[j + tp][i] * cw[i][tp];
              ST[j * 256 + lane + 64 * i] = siluf(a);
            }
          if (lane < 8) {
            float bx = bf2f(RAWP(0, 3));
            float ax = bf2f(RAWP(1, 3));
            float ld = -__expf(p.gdn_a_log[(l * 2 + dir) * 4 + h]) * softplusf(ax + p.gdn_dt_bias[(l * 2 + dir) * 4 + h]);
            ST[lane * 256 + 192] = sigm(bx);
            ST[lane * 256 + 193] = ld;
          }
        } else {
          const float qs = lane < 32 ? 0.17677669529663687f : 1.f;
#pragma unroll
          for (int j = 0; j < 8; j++) {
            ST[j * 256 + lane] = bf2f(RAWP(j, 0)) * qs;
            ST[j * 256 + 64 + lane] = bf2f(RAWP(j, 1));
            if (lane < 16) ST[j * 256 + 128 + lane] = bf2f(RAWP(j, 2));
          }
        }
        wave_lds_sync();
        {
          float vv[8];
#pragma unroll
          for (int i = 0; i < 8; i++) vv[i] = ST[(dir ? 7 - i : i) * 256 + VOFF + lane];
          *(uint4*)(SB + S3_VT + lane * 16) = pack8(vv);
        }
        if (MIX == 0) {
          bf16x8 aw, aa;
#pragma unroll
          for (int jj = 0; jj < 8; jj++) {
            aw[jj] = fr < 8 ? (short)f2bf(ST[fr * 256 + 192 + fq * 8 + jj]) : (short)0;
            aa[jj] = fr < 8 ? (short)f2bf(ST[fr * 256 + 224 + fq * 8 + jj]) : (short)0;
          }
          f32x4 accw[4], acca[4];
#pragma unroll
          for (int nt = 0; nt < 4; nt++) {
            accw[nt] = __builtin_amdgcn_mfma_f32_16x16x32_bf16(aw, bw2[nt], z4, 0, 0, 0);
            acca[nt] = __builtin_amdgcn_mfma_f32_16x16x32_bf16(aa, ba2[nt], z4, 0, 0, 0);
          }
          wave_lds_sync();
          if (fq < 2) {
#pragma unroll
            for (int nt = 0; nt < 4; nt++)
#pragma unroll
              for (int r = 0; r < 4; r++) {
                ST[(fq * 4 + r) * 256 + 128 + nt * 16 + fr] = accw[nt][r];
                ST[(fq * 4 + r) * 256 + 192 + nt * 16 + fr] = acca[nt][r];
              }
          }
          wave_lds_sync();
        } else if (MIX == 2) {
          bf16x8 ag;
#pragma unroll
          for (int jj = 0; jj < 8; jj++) ag[jj] = (fr < 8 && fq < 2) ? (short)f2bf(ST[fr * 256 + 128 + fq * 8 + jj]) : (short)0;
          f32x4 accg[2];
#pragma unroll
          for (int nt = 0; nt < 2; nt++) accg[nt] = __builtin_amdgcn_mfma_f32_16x16x32_bf16(ag, bw2[nt], z4, 0, 0, 0);
          if (fq < 2) {
#pragma unroll
            for (int nt = 0; nt < 2; nt++)
#pragma unroll
              for (int r = 0; r < 4; r++) ST[(fq * 4 + r) * 256 + 192 + nt * 16 + fr] = accg[nt][r];
          }
          wave_lds_sync();
        }
        float logd[8], kap[8], bb[8], kp[8], qq[8];
        if (MIX == 0) {
          float a8[8], p1[8], p2[8];
#pragma unroll
          for (int i = 0; i < 8; i++) {
            const float* row = ST + (dir ? 7 - i : i) * 256;
            const float r_ = row[lane], k_ = row[64 + lane];
            const float sg = sigm(c_w0 + row[128 + lane]);
            a8[i] = sigm(c_a0 + row[192 + lane]);
            kp[i] = k_ * (1.f + (a8[i] - 1.f) * c_ka);
            kap[i] = k_ * c_kk;
            qq[i] = r_;
            logd[i] = -0.6065306597126334f * sg;
            p1[i] = kap[i] * kap[i];
            p2[i] = r_ * kp[i] * c_rk;
          }
#pragma unroll
          for (int i = 0; i < 8; i++) { p1[i] = red16(p1[i]); p2[i] = red16(p2[i]); }
#pragma unroll
          for (int i = 0; i < 8; i++) {
            const float ss = (rlane(p1[i], 0) + rlane(p1[i], 16)) + (rlane(p1[i], 32) + rlane(p1[i], 48));
            const float bc = (rlane(p2[i], 0) + rlane(p2[i], 16)) + (rlane(p2[i], 32) + rlane(p2[i], 48));
            kap[i] *= rsq(ss + 1e-6f);
            bb[i] = kap[i] * a8[i];
            if (lane == 0) BC[(size_t)(seg_row0 + t0 + (dir ? 7 - i : i)) * 8 + h * 2 + dir] = bc;
          }
        } else {
#pragma unroll
        for (int i = 0; i < 8; i++) {
          const int j = dir ? 7 - i : i;
          const float* row = ST + j * 256;
          if (MIX == 1) {
            const float q_ = row[lane], k_ = row[64 + lane];
            const float sq = wave_sum(q_ * q_), sk = wave_sum(k_ * k_);
            const float qn = q_ * rsq(sq + 1e-6f) * 0.125f, kn = k_ * rsq(sk + 1e-6f);
            const float beta = row[192], ld = row[193];
            const float alpha = __expf(ld);
            logd[i] = ld;
            kap[i] = kn; bb[i] = alpha * beta * kn; kp[i] = beta * kn; qq[i] = qn;
          } else {
            const int n = lane & 31;
            const float lg = c_gb + row[192 + n];
            const float ls = fminf(lg, 0.f) - __logf(1.f + __expf(-fabsf(lg)));
            logd[i] = ls * (1.f / 16.f);
            kap[i] = 0.f; bb[i] = 0.f;
            kp[i] = lane < 32 ? row[32 + n] : 0.f;
            qq[i] = lane < 32 ? row[n] : 0.f;
          }
        }
        }
        wave_lds_sync();
        float kt[8], qt[8], bck[8], kck[8];
        {
          float L[8];
          float run = 0.f;
#pragma unroll
          for (int i = 0; i < 8; i++) { run += logd[i]; L[i] = run; }
          const float Lr = L[3], L7 = L[7];
          float prevE = __expf(clampe(-Lr)), prevT = 1.f;
          u16* OPA = (u16*)STBY;
#pragma unroll
          for (int i = 0; i < 8; i++) {
            const float eI = __expf(clampe(L[i] - Lr)), eInv = __expf(clampe(Lr - L[i]));
            const float tI = __expf(L[i]), eEnd = __expf(L7 - L[i]);
            if (DELTA) {
              OPA[0 * 576 + i * 72 + lane] = f2bf(kap[i] * prevE);
              OPA[1 * 576 + i * 72 + lane] = f2bf(bb[i] * eInv);
            }
            OPA[2 * 576 + i * 72 + lane] = f2bf(kp[i] * eInv);
            OPA[3 * 576 + i * 72 + lane] = f2bf(qq[i] * eI);
            kt[i] = kap[i] * prevT; qt[i] = qq[i] * tI;
            bck[i] = bb[i] * eEnd; kck[i] = kp[i] * eEnd;
            prevE = eI; prevT = tI;
          }
          *(float*)(SB + S3_WC + lane * 4) = __expf(L7);
        }
        wave_lds_sync();
        f32x4 accA = z4, accBm = z4, accQb = z4, accQk = z4;
        {
          const u16* OPA = (const u16*)STBY;
          const int ro = (fr & 7) * 72 + fq * 8;
#pragma unroll
          for (int ks = 0; ks < 2; ks++) {
            const bf16x8 fk = ld_frag(OPA + 2 * 576 + ro + ks * 32), fqh = ld_frag(OPA + 3 * 576 + ro + ks * 32);
            accQk = __builtin_amdgcn_mfma_f32_16x16x32_bf16(fqh, fk, accQk, 0, 0, 0);
            if (DELTA) {
              const bf16x8 fka = ld_frag(OPA + 0 * 576 + ro + ks * 32), fb = ld_frag(OPA + 1 * 576 + ro + ks * 32);
              accA = __builtin_amdgcn_mfma_f32_16x16x32_bf16(fka, fb, accA, 0, 0, 0);
              accBm = __builtin_amdgcn_mfma_f32_16x16x32_bf16(fka, fk, accBm, 0, 0, 0);
              accQb = __builtin_amdgcn_mfma_f32_16x16x32_bf16(fqh, fb, accQb, 0, 0, 0);
            }
          }
#pragma unroll
          for (int r = 0; r < 4; r++) {
            const int i = fq * 4 + r;
            const bool ok = fq < 2 && fr < 8;
            if (!(ok && fr < i)) { accA[r] = 0.f; accBm[r] = 0.f; }
            if (!(ok && fr <= i)) { accQb[r] = 0.f; accQk[r] = 0.f; }
          }
        }
        *(uint4*)(SB + S3_KVT + lane * 16) = pack8(kck);
#pragma unroll
        for (int i = 0; i < 8; i++) ((u16*)(SB + S3_QB))[i * 72 + lane] = f2bf(qt[i]);
        if (fq < 2 && fr < 8) {
#pragma unroll
          for (int r = 0; r < 4; r++) {
            ((u16*)(SB + S3_QKM))[(fq * 4 + r) * 8 + fr] = f2bf(accQk[r]);
            if (DELTA) ((u16*)(SB + S3_QBM))[(fq * 4 + r) * 8 + fr] = f2bf(accQb[r]);
          }
        }
        if (DELTA) {
          float bmc[8];
#pragma unroll
          for (int m = 0; m < 4; m++) { bmc[m] = accBm[m]; bmc[m + 4] = __shfl(accBm[m], (lane & 15) + 16); }
          float t[8];
#pragma unroll
          for (int i = 0; i < 8; i++) {
            float ti = (lane == i) ? 1.f : 0.f;
#pragma unroll
            for (int m = 0; m < i; m++) ti -= rlane(accA[i & 3], (i >> 2) * 16 + m) * t[m];
            t[i] = ti;
          }
          float kbar[8], TB[8];
#pragma unroll
          for (int i = 0; i < 8; i++) {
            float tb = 0.f, kb = 0.f;
#pragma unroll
            for (int m = 0; m <= i; m++) {
              const float tim = rlane(t[i], m);
              tb += tim * bmc[m];
              kb += tim * kt[m];
            }
            TB[i] = tb; kbar[i] = kb;
          }
#pragma unroll
          for (int i = 0; i < 8; i++) ((u16*)(SB + S3_KB))[i * 72 + lane] = f2bf(-kbar[i]);
          *(uint4*)(SB + S3_BT + lane * 16) = pack8(bck);
          if (lane < 8) {
#pragma unroll
            for (int i = 0; i < 8; i++) ((u16*)(SB + S3_TB))[i * 8 + lane] = f2bf(-TB[i]);
          }
        }
      }
    }
    fetch_raw<MIX>(P, min(it + 1, TPB / 64 - 1) * 2 + half, dir, b, h, pw, lane, colv, rawq);
    __syncthreads();
    if (w < 4) {
      unsigned char* STB = smb + S3_STB + w * 2304;
#pragma unroll
      for (int kk = 0; kk < 8; kk++) {
        const int cc = it * 2 + (kk >> 2), k = kk & 3;
        int seg_row0, t_lo;
        if (cc < 8) { seg_row0 = b * TPB; t_lo = dir == 0 ? cc * 32 : (LC - 32 - cc * 32); }
        else { seg_row0 = b * TPB + LC; t_lo = dir == 0 ? (cc - 8) * 32 : (SEQ - 32 - (cc - 8) * 32); }
        const int sc = dir ? 3 - k : k;
        const unsigned char* SB = smb + ((kk >> 2) * 4 + sc) * S3_SUB;
        const bf16x8 bs0 = __builtin_bit_cast(bf16x8, u32x4v{pack2(st[0][0], st[0][1]), pack2(st[0][2], st[0][3]), pack2(st[1][0], st[1][1]), pack2(st[1][2], st[1][3])});
        const bf16x8 bs1 = __builtin_bit_cast(bf16x8, u32x4v{pack2(st[2][0], st[2][1]), pack2(st[2][2], st[2][3]), pack2(st[3][0], st[3][1]), pack2(st[3][2], st[3][3])});
#define LDP(BASE_, ROW_, KS_) ([&]() -> bf16x8 {                                                                   \
          const uint2 lo_ = *(const uint2*)((BASE_) + ((ROW_) * 72 + (KS_) * 32 + fq * 4) * 2);                      \
          const uint2 hi_ = *(const uint2*)((BASE_) + ((ROW_) * 72 + (KS_) * 32 + 16 + fq * 4) * 2);                 \
          return __builtin_bit_cast(bf16x8, u32x4v{lo_.x, lo_.y, hi_.x, hi_.y}); }())
        const bf16x8 bv = fq == 0 ? ld_frag(SB + S3_VT + (w * 16 + fr) * 16) : zfrag();
        const bf16x8 aq0 = LDP(SB + S3_QB, (fr & 7), 0), aq1 = LDP(SB + S3_QB, (fr & 7), 1);
        const bf16x8 aqk = fq == 0 ? ld_frag(SB + S3_QKM + (fr & 7) * 16) : zfrag();
        bf16x8 brv = zfrag();
        if (DELTA) {
          const bf16x8 ak0 = LDP(SB + S3_KB, (fr & 7), 0), ak1 = LDP(SB + S3_KB, (fr & 7), 1);
          const bf16x8 atb = fq == 0 ? ld_frag(SB + S3_TB + (fr & 7) * 16) : zfrag();
          f32x4 accR = __builtin_amdgcn_mfma_f32_16x16x32_bf16(ak0, bs0, z4, 0, 0, 0);
          accR = __builtin_amdgcn_mfma_f32_16x16x32_bf16(ak1, bs1, accR, 0, 0, 0);
          accR = __builtin_amdgcn_mfma_f32_16x16x32_bf16(atb, bv, accR, 0, 0, 0);
          const uint2 vv2 = *(const uint2*)(SB + S3_VT + (w * 16 + fr) * 16 + (fq & 1) * 8);
          const u32x4v t4 = {pack2(accR[0], accR[1]), pack2(accR[2], accR[3]), vv2.x, vv2.y};
          brv = fq < 2 ? __builtin_bit_cast(bf16x8, t4) : zfrag();
        }
        f32x4 accY = __builtin_amdgcn_mfma_f32_16x16x32_bf16(aq0, bs0, z4, 0, 0, 0);
        accY = __builtin_amdgcn_mfma_f32_16x16x32_bf16(aq1, bs1, accY, 0, 0, 0);
        if (DELTA) {
          const uint2 qb2 = *(const uint2*)(SB + S3_QBM + (fr & 7) * 16 + (fq & 1) * 8);
          const uint2 qk2 = *(const uint2*)(SB + S3_QKM + (fr & 7) * 16 + (fq & 1) * 8);
          const u32x4v q4 = {qb2.x, qb2.y, qk2.x, qk2.y};
          const bf16x8 aqm = fq < 2 ? __builtin_bit_cast(bf16x8, q4) : zfrag();
          accY = __builtin_amdgcn_mfma_f32_16x16x32_bf16(aqm, brv, accY, 0, 0, 0);
        } else {
          accY = __builtin_amdgcn_mfma_f32_16x16x32_bf16(aqk, bv, accY, 0, 0, 0);
        }
        if (fq < 2) {
#pragma unroll
          for (int r = 0; r < 4; r++) {
            const int i = fq * 4 + r, j = dir ? 7 - i : i;
            YS[(size_t)(seg_row0 + t_lo + sc * 8 + j) * YST + dir * 768 + MIX * 256 + h * 64 + w * 16 + fr] = f2bf(accY[r]);
          }
        }
#pragma unroll
        for (int nt = 0; nt < 4; nt++) {
          f32x4 an;
          if (DELTA) {
            const uint2 b2 = *(const uint2*)(SB + S3_BT + (nt * 16 + fr) * 16 + (fq & 1) * 8);
            const uint2 k2 = *(const uint2*)(SB + S3_KVT + (nt * 16 + fr) * 16 + (fq & 1) * 8);
            const u32x4v a4 = {b2.x, b2.y, k2.x, k2.y};
            const bf16x8 am = fq < 2 ? __builtin_bit_cast(bf16x8, a4) : zfrag();
            an = __builtin_amdgcn_mfma_f32_16x16x32_bf16(am, brv, z4, 0, 0, 0);
          } else {
            const bf16x8 akv = fq == 0 ? ld_frag(SB + S3_KVT + (nt * 16 + fr) * 16) : zfrag();
            an = __builtin_amdgcn_mfma_f32_16x16x32_bf16(akv, bv, z4, 0, 0, 0);
          }
          const float4 wc = *(const float4*)(SB + S3_WC + (nt * 16 + fq * 4) * 4);
          st[nt][0] = st[nt][0] * wc.x + an[0];
          st[nt][1] = st[nt][1] * wc.y + an[1];
          st[nt][2] = st[nt][2] * wc.z + an[2];
          st[nt][3] = st[nt][3] * wc.w + an[3];
        }
#undef LDP
      }
    }
    __syncthreads();
  }
}

__device__ __forceinline__ void attn_item(const Params& p, int l, int b, int qb, int hk, bool isctx, unsigned char* smem) {
  u16* KS = (u16*)smem;
  u16* VT = KS + 64 * LDT;
  u16* PL = VT + 64 * LDT;
  float2* ROPE = (float2*)(PL + 8 * 32 * LDT);
  const int tid = TIDX, lane = tid & 63, w = tid >> 6, fr = lane & 15, fq = lane >> 4;
  const u16* P = (const u16*)(p.ws + OFF_BIG);
  u16* Y = (u16*)(p.ws + OFF_YS);
  const int qh = hk * 2 + (w >> 2);
  const int tb = qb * 128 + (w & 3) * 32;
  const int qrow0 = b * TPB + (isctx ? 0 : LC);
  __syncthreads();
  for (int i = tid; i < 1024; i += NTHR) {
    int pos = i >> 4, fi = i & 15;
    float inv = powf(10000.f, -(float)fi / 16.f);
    float sn, cs;
    sincosf((float)pos * inv, &sn, &cs);
    ROPE[i] = make_float2(cs, sn);
  }
  __syncthreads();
  bf16x8 qf[2][2];
#pragma unroll
  for (int mi = 0; mi < 2; mi++)
#pragma unroll
    for (int ks = 0; ks < 2; ks++) {
      const int tq = tb + mi * 16 + fr;
      const u16* qp = P + (size_t)(qrow0 + tq) * PST + PD + qh * 64 + ks * 32;
      uint4 own = *(const uint4*)(qp + fq * 8);
      uint4 par = *(const uint4*)(qp + (fq ^ 2) * 8);
      const unsigned ow[4] = {own.x, own.y, own.z, own.w};
      const unsigned pw[4] = {par.x, par.y, par.z, par.w};
      const int pos = ks == 0 ? (tq >> 6) : (tq & 63);
      bf16x8 f;
#pragma unroll
      for (int jj = 0; jj < 8; jj++) {
        float xo = bf2f((u16)((ow[jj >> 1] >> ((jj & 1) * 16)) & 0xffff));
        float xp = bf2f((u16)((pw[jj >> 1] >> ((jj & 1) * 16)) & 0xffff));
        float v = xo;
        if (!isctx) {
          float2 cs = ROPE[pos * 16 + (fq & 1) * 8 + jj];
          v = fq < 2 ? xo * cs.x - xp * cs.y : xp * cs.y + xo * cs.x;
        }
        f[jj] = (short)f2bf(v * 0.125f);
      }
      qf[mi][ks] = f;
    }
  f32x4 oacc[2][4];
#pragma unroll
  for (int mi = 0; mi < 2; mi++)
#pragma unroll
    for (int nd = 0; nd < 4; nd++) oacc[mi][nd] = f32x4{0.f, 0.f, 0.f, 0.f};
  float mrow[2][4], lrow[2][4];
#pragma unroll
  for (int mi = 0; mi < 2; mi++)
#pragma unroll
    for (int r = 0; r < 4; r++) { mrow[mi][r] = -1e30f; lrow[mi][r] = 0.f; }

  const int q0 = qb * 128;
  const int band_lo = isctx ? 0 : max(0, q0 - 128), band_hi = isctx ? 0 : min(SEQ, q0 + 256);
  const int ntile = 4 + (band_hi - band_lo) / 64;
  u16* pl = PL + w * 32 * LDT;
  for (int tl = 0; tl < ntile; tl++) {
    const bool band = tl >= 4;
    const int k0 = band ? band_lo + (tl - 4) * 64 : tl * 64;
    __syncthreads();
    {
      const int key = tid >> 3, kc = tid & 7;
      const int kpos = k0 + key;
      const u16* kp = P + (size_t)(b * TPB + (band ? LC : 0) + kpos) * PST + PD + 256 + hk * 64;
      uint4 own = *(const uint4*)(kp + kc * 8);
      uint4 vv = *(const uint4*)(kp + 128 + kc * 8);
      uint4 par = *(const uint4*)(kp + (kc ^ 2) * 8);
      if (band) {
        const unsigned ow[4] = {own.x, own.y, own.z, own.w};
        const unsigned pw[4] = {par.x, par.y, par.z, par.w};
        const int pos = kc < 4 ? (kpos >> 6) : (kpos & 63);
        unsigned res[4];
#pragma unroll
        for (int jj = 0; jj < 8; jj += 2) {
          float v2[2];
#pragma unroll
          for (int e = 0; e < 2; e++) {
            float xo = bf2f((u16)((ow[jj >> 1] >> (e * 16)) & 0xffff));
            float xp = bf2f((u16)((pw[jj >> 1] >> (e * 16)) & 0xffff));
            float2 cs = ROPE[pos * 16 + (kc & 1) * 8 + jj + e];
            v2[e] = (kc & 2) == 0 ? xo * cs.x - xp * cs.y : xp * cs.y + xo * cs.x;
          }
          res[jj >> 1] = pack2(v2[0], v2[1]);
        }
        own = make_uint4(res[0], res[1], res[2], res[3]);
      }
      *(uint4*)(KS + key * LDT + kc * 8) = own;
      const unsigned vw[4] = {vv.x, vv.y, vv.z, vv.w};
#pragma unroll
      for (int jj = 0; jj < 8; jj++) VT[(kc * 8 + jj) * LDT + key] = (u16)((vw[jj >> 1] >> ((jj & 1) * 16)) & 0xffff);
    }
    __syncthreads();
    f32x4 sc[2][4];
#pragma unroll
    for (int mi = 0; mi < 2; mi++)
#pragma unroll
      for (int nj = 0; nj < 4; nj++) sc[mi][nj] = f32x4{0.f, 0.f, 0.f, 0.f};
#pragma unroll
    for (int ks = 0; ks < 2; ks++) {
      bf16x8 kf[4];
#pragma unroll
      for (int nj = 0; nj < 4; nj++) kf[nj] = *(const bf16x8*)(KS + (nj * 16 + fr) * LDT + ks * 32 + fq * 8);
#pragma unroll
      for (int mi = 0; mi < 2; mi++)
#pragma unroll
        for (int nj = 0; nj < 4; nj++) sc[mi][nj] = __builtin_amdgcn_mfma_f32_16x16x32_bf16(qf[mi][ks], kf[nj], sc[mi][nj], 0, 0, 0);
    }
#pragma unroll
    for (int mi = 0; mi < 2; mi++)
#pragma unroll
      for (int r = 0; r < 4; r++) {
        const int qpos = tb + mi * 16 + fq * 4 + r;
        float mx = -1e30f;
#pragma unroll
        for (int nj = 0; nj < 4; nj++) {
          float v = sc[mi][nj][r];
          if (band) {
            int d = qpos - (k0 + nj * 16 + fr);
            if (d > 128 || d < -128) v = -1e30f;
          }
          sc[mi][nj][r] = v;
          mx = fmaxf(mx, v);
        }
        mx = fmaxf(mx, __shfl_xor(mx, 1));
        mx = fmaxf(mx, __shfl_xor(mx, 2));
        mx = fmaxf(mx, __shfl_xor(mx, 4));
        mx = fmaxf(mx, __shfl_xor(mx, 8));
        const float mnew = fmaxf(mrow[mi][r], mx);
        const float alpha = __expf(mrow[mi][r] - mnew);
        mrow[mi][r] = mnew;
        float ls = 0.f;
#pragma unroll
        for (int nj = 0; nj < 4; nj++) {
          float pe = __expf(sc[mi][nj][r] - mnew);
          ls += pe;
          pl[(mi * 16 + fq * 4 + r) * LDT + nj * 16 + fr] = f2bf(pe);
        }
        lrow[mi][r] = lrow[mi][r] * alpha + ls;
#pragma unroll
        for (int nd = 0; nd < 4; nd++) oacc[mi][nd][r] *= alpha;
      }
    asm volatile("s_waitcnt lgkmcnt(0)" ::: "memory");
    __builtin_amdgcn_wave_barrier();
#pragma unroll
    for (int ks = 0; ks < 2; ks++) {
      bf16x8 pf[2], vf[4];
#pragma unroll
      for (int mi = 0; mi < 2; mi++) pf[mi] = *(const bf16x8*)(pl + (mi * 16 + fr) * LDT + ks * 32 + fq * 8);
#pragma unroll
      for (int nd = 0; nd < 4; nd++) vf[nd] = *(const bf16x8*)(VT + (nd * 16 + fr) * LDT + ks * 32 + fq * 8);
#pragma unroll
      for (int mi = 0; mi < 2; mi++)
#pragma unroll
        for (int nd = 0; nd < 4; nd++) oacc[mi][nd] = __builtin_amdgcn_mfma_f32_16x16x32_bf16(pf[mi], vf[nd], oacc[mi][nd], 0, 0, 0);
    }
    asm volatile("s_waitcnt lgkmcnt(0)" ::: "memory");
    __builtin_amdgcn_wave_barrier();
  }
  const float sink = p.attn_sink[l * 4 + qh];
#pragma unroll
  for (int mi = 0; mi < 2; mi++)
#pragma unroll
    for (int r = 0; r < 4; r++) {
      float ls = lrow[mi][r];
      ls += __shfl_xor(ls, 1);
      ls += __shfl_xor(ls, 2);
      ls += __shfl_xor(ls, 4);
      ls += __shfl_xor(ls, 8);
      ls += __expf(sink - mrow[mi][r]);
      const float inv = 1.f / ls;
      const int tq = tb + mi * 16 + fq * 4 + r;
#pragma unroll
      for (int nd = 0; nd < 4; nd++) Y[(size_t)(qrow0 + tq) * YST + 1536 + qh * 64 + nd * 16 + fr] = f2bf(oacc[mi][nd][r] * inv);
    }
}

#ifndef SCAN3_MASK
#define SCAN3_MASK 7
#endif
__device__ __forceinline__ void phase_mix(const Params& p, int l, unsigned char* smem) {
  float* sm = (float*)smem;
  const int G = gridDim.x;
  for (int it = blockIdx.x; it < 192; it += G) {
    const int mix = it >> 6, rem = it & 63, b = rem >> 3, h = (rem >> 1) & 3, dir = rem & 1;
    if (mix == 0 && (SCAN3_MASK & 1)) scan3_item<0>(p, l, b, h, dir, smem);
    else if (mix == 1 && (SCAN3_MASK & 2)) scan3_item<1>(p, l, b, h, dir, smem);
    else if (mix == 2 && (SCAN3_MASK & 4)) scan3_item<2>(p, l, b, h, dir, smem);
  }
  if (SCAN3_MASK != 7) {
    for (int it = blockIdx.x; it < 768; it += G) {
      const int mix = it >> 8, rem = it & 255, b = rem >> 5, h = (rem >> 3) & 3, dir = (rem >> 2) & 1, rq = rem & 3;
      if (mix == 0 && !(SCAN3_MASK & 1)) scan2_item<0>(p, l, b, h, dir, rq, sm);
      else if (mix == 1 && !(SCAN3_MASK & 2)) scan2_item<1>(p, l, b, h, dir, rq, sm);
      else if (mix == 2 && !(SCAN3_MASK & 4)) scan2_item<2>(p, l, b, h, dir, rq, sm);
    }
  }
  __syncthreads();
  {
    const bool spread = G >= 192;
    const int nconv = spread ? 64 : G, fidx = spread ? (int)blockIdx.x - 128 : (int)blockIdx.x;
    if (fidx >= 0 && fidx < nconv)
      for (int it = 832 + fidx; it < 4480; it += nconv) conv_item(p, l, it, (float*)smem);
    __syncthreads();
  }
  unsigned* ctr = (unsigned*)(p.ws + OFF_CTR) + l * 16;
  volatile int* slot = (volatile int*)(smem + 131072 - 16);
  for (;;) {
    if (TIDX == 0) *slot = (int)atomicAdd(ctr, 1u);
    __syncthreads();
    const int it = *slot;
    __syncthreads();
    if (it >= (l == 0 ? 544 : 512)) break;
    if (it < 512) {
      int b = it >> 6, qb = (it >> 1) & 31, hk = it & 1;
      attn_item(p, l, b, qb, hk, false, smem);
    } else {
      int r = it - 512, b = r >> 2, qb = (r >> 1) & 1, hk = r & 1;
      attn_item(p, l, b, qb, hk, true, smem);
    }
  }
}

#define POST_DECL(PFX) uint2 PFX##ya0, PFX##ya1, PFX##ya2, PFX##yc0, PFX##yc1, PFX##yc2, PFX##vp, PFX##vc, PFX##vn, PFX##gb, PFX##gc; \
  u16 PFX##xp, PFX##xc, PFX##xn; float2 PFX##bc
#define POST_LOAD(PFX, R_)                                                                         \
  do {                                                                                             \
    const int r_ = (R_);                                                                           \
    const int b_ = r_ / TPB, t_ = r_ - b_ * TPB;                                                   \
    const bool hp_ = (t_ != 0) && (t_ != LC), hn_ = (t_ != LC - 1) && (t_ != TPB - 1);            \
    const u16* ys_ = YSc + (size_t)r_ * YST;                                                       \
    const u16* pr_ = Pc + (size_t)r_ * PST;                                                        \
    const u16* pp_ = pr_ - (hp_ ? PST : 0);                                                        \
    const u16* pn_ = pr_ + (hn_ ? PST : 0);                                                        \
    PFX##ya0 = *(const uint2*)(ys_ + j0); PFX##ya1 = *(const uint2*)(ys_ + 256 + j0); PFX##ya2 = *(const uint2*)(ys_ + 512 + j0); \
    PFX##yc0 = *(const uint2*)(ys_ + 768 + j0); PFX##yc1 = *(const uint2*)(ys_ + 1024 + j0); PFX##yc2 = *(const uint2*)(ys_ + 1280 + j0); \
    PFX##vp = *(const uint2*)(pp_ + PA + 512 + j0);                                                \
    PFX##vc = *(const uint2*)(pr_ + PA + 512 + j0);                                                \
    PFX##vn = *(const uint2*)(pn_ + PA + 512 + j0);                                                \
    PFX##gb = *(const uint2*)(pr_ + PB + 784 + j0);                                                \
    PFX##gc = *(const uint2*)(pr_ + PC + 544 + j0);                                                \
    PFX##xp = pp_[PA + 896 + lane]; PFX##xc = pr_[PA + 896 + lane]; PFX##xn = pn_[PA + 896 + lane]; \
    PFX##bc = *(const float2*)(BCc + (size_t)r_ * 8 + (lane >> 4) * 2);                            \
  } while (0)
__device__ __forceinline__ void unpack4(uint2 v, float (&o)[4]) {
  o[0] = __uint_as_float(v.x << 16); o[1] = __uint_as_float(v.x & 0xffff0000u);
  o[2] = __uint_as_float(v.y << 16); o[3] = __uint_as_float(v.y & 0xffff0000u);
}

__device__ __forceinline__ void phase_post(const Params& p, int l, float* g2s) {
  const int lane = TIDX & 63, wv = TIDX >> 6;
  u16* YS = (u16*)(p.ws + OFF_YS);
  const int j0 = lane * 4;
  {
    const float4* src = (const float4*)(p.rwkv_g2 + (size_t)l * 64 * 256);
    for (int i = TIDX; i < 64 * 256 / 4; i += NTHR) ((float4*)g2s)[i] = src[i];
  }
  float mu_v[4], lng[4], lnb[4], ngb[4], ngc[4];
#pragma unroll
  for (int i = 0; i < 4; i++) {
    mu_v[i] = p.rwkv_mu[l * 960 + 512 + j0 + i];
    lng[i] = p.rwkv_ln_g[l * 256 + j0 + i];
    lnb[i] = p.rwkv_ln_b[l * 256 + j0 + i];
    ngb[i] = p.gdn_norm_g[l * 64 + (lane & 15) * 4 + i];
    ngc[i] = p.gla_norm_g[l * 64 + (lane & 15) * 4 + i];
  }
  const float mu_x = p.rwkv_mu[l * 960 + 896 + lane];
  __syncthreads();
  const int stride = gridDim.x * 8;
  int r = blockIdx.x * 8 + wv;
  const u16* Pc = (const u16*)(p.ws + OFF_BIG);
  const u16* YSc = (const u16*)(p.ws + OFF_YS);
  const float* BCc = (const float*)(p.ws + OFF_BC);
  POST_DECL(cur_);
  POST_DECL(nxt_);
  POST_LOAD(cur_, r);
  for (; r < NROWS; r += stride) {
    const int rn = r + stride < NROWS ? r + stride : r;
    POST_LOAD(nxt_, rn);
    const int b = r / TPB, t = r - b * TPB;
    const float pmul = ((t != 0) && (t != LC)) ? 1.f : 0.f, nmul = ((t != LC - 1) && (t != TPB - 1)) ? 1.f : 0.f;
    if (!(l == 1 && t < LC)) {
    float y[3][4];
    {
      float a4[4], c4[4];
      unpack4(cur_ya0, a4); unpack4(cur_yc0, c4);
#pragma unroll
      for (int i = 0; i < 4; i++) y[0][i] = a4[i] + c4[i];
      unpack4(cur_ya1, a4); unpack4(cur_yc1, c4);
#pragma unroll
      for (int i = 0; i < 4; i++) y[1][i] = a4[i] + c4[i];
      unpack4(cur_ya2, a4); unpack4(cur_yc2, c4);
#pragma unroll
      for (int i = 0; i < 4; i++) y[2][i] = a4[i] + c4[i];
    }
    float o[3][4];
    {
      float sum = y[0][0] + y[0][1] + y[0][2] + y[0][3];
      sum = red16(sum);
      const float mean = sum * (1.f / 64.f);
      float vs = 0.f;
#pragma unroll
      for (int i = 0; i < 4; i++) { float d = y[0][i] - mean; vs += d * d; }
      vs = red16(vs);
      const float rstd = rsq(vs * (1.f / 64.f) + 64e-5f);
      const float pv = bf2f(cur_xc), ppv = bf2f(cur_xp) * pmul, pnv = bf2f(cur_xn) * nmul;
      const float sg = sigm(pv + (0.5f * (ppv + pnv) - pv) * mu_x);
      float gate[4] = {0.f, 0.f, 0.f, 0.f};
      const float* g2 = g2s + j0;
#pragma unroll 8
      for (int i = 0; i < 64; i++) {
        const float si = __int_as_float(__builtin_amdgcn_readlane(__float_as_int(sg), i));
        const float4 gw = *(const float4*)(g2 + i * 256);
        gate[0] += si * gw.x; gate[1] += si * gw.y; gate[2] += si * gw.z; gate[3] += si * gw.w;
      }
      const float bcs = cur_bc.x + cur_bc.y;
      float vc4[4], vp4[4], vn4[4];
      unpack4(cur_vc, vc4); unpack4(cur_vp, vp4); unpack4(cur_vn, vn4);
#pragma unroll
      for (int i = 0; i < 4; i++) {
        const float v = vc4[i] + (0.5f * (vp4[i] * pmul + vn4[i] * nmul) - vc4[i]) * mu_v[i];
        const float yn = (y[0][i] - mean) * rstd * lng[i] + lnb[i];
        o[0][i] = (yn + bcs * v) * gate[i];
      }
    }
#pragma unroll
    for (int m = 1; m < 3; m++) {
      float ss = y[m][0] * y[m][0] + y[m][1] * y[m][1] + y[m][2] * y[m][2] + y[m][3] * y[m][3];
      ss = red16(ss);
      const float inv = rsq(ss * (1.f / 64.f) + 1e-6f);
      float g4[4];
      unpack4(m == 1 ? cur_gb : cur_gc, g4);
#pragma unroll
      for (int i = 0; i < 4; i++) o[m][i] = y[m][i] * inv * (m == 1 ? ngb[i] : ngc[i]) * siluf(g4[i]);
    }
    u16* ys = YS + (size_t)r * YST;
#pragma unroll
    for (int m = 0; m < 3; m++) {
      uint2 ov;
      ov.x = pack2(o[m][0], o[m][1]);
      ov.y = pack2(o[m][2], o[m][3]);
      *(uint2*)(ys + m * 256 + j0) = ov;
    }
    }
    cur_ya0 = nxt_ya0; cur_ya1 = nxt_ya1; cur_ya2 = nxt_ya2; cur_yc0 = nxt_yc0; cur_yc1 = nxt_yc1; cur_yc2 = nxt_yc2;
    cur_vp = nxt_vp; cur_vc = nxt_vc; cur_vn = nxt_vn; cur_gb = nxt_gb; cur_gc = nxt_gc;
    cur_xp = nxt_xp; cur_xc = nxt_xc; cur_xn = nxt_xn; cur_bc = nxt_bc;
  }
}

#define XB_TMO      128
#define XB_XCNT(j)  (256  + 64 * (j))
#define XB_XSUB(j)  (1280 + 64 * (j))
#define XB_XGEN(j)  (2304 + 64 * (j))
#define XB_TOP      3328
#define XB_TOPGEN   3392
#define XCD_BAR_WORDS 3456
#define XB_SPIN_CAP (1u << 18)
#define LAS __attribute__((address_space(3)))

__device__ __forceinline__ unsigned xb_ld(unsigned* p)              { return __hip_atomic_load(p, __ATOMIC_RELAXED, __HIP_MEMORY_SCOPE_AGENT); }
__device__ __forceinline__ unsigned xb_add(unsigned* p, unsigned v) { return __hip_atomic_fetch_add(p, v, __ATOMIC_RELAXED, __HIP_MEMORY_SCOPE_AGENT); }
__device__ __forceinline__ unsigned xb_xcc_id() { return (unsigned)__builtin_amdgcn_s_getreg((3 << 11) | 20) & 0xFu; }
#define XB_SPIN(cond, bar) do { unsigned _sp = 0; while (cond) { __builtin_amdgcn_s_sleep(1); \
    if ((++_sp & 255u) == 0u) { if (xb_ld(&(bar)[XB_TMO])) break; if (_sp > XB_SPIN_CAP) { atomicAdd(&(bar)[XB_TMO], 1u); break; } } } } while (0)

struct XcdBarrier {
    unsigned* bar; unsigned x;
    volatile LAS unsigned* st;
};

__device__ __forceinline__ XcdBarrier xcd_barrier_post(unsigned* bar, volatile LAS unsigned* st) {
    XcdBarrier b; b.bar = bar; b.x = xb_xcc_id(); b.st = st;
    if (threadIdx.x == 0) (void)xb_add(&bar[XB_XCNT(b.x)], 1u);
    return b;
}
__device__ __forceinline__ void xcd_barrier_complete(unsigned* bar, unsigned x, unsigned& nloc, unsigned& nx) {
    const unsigned G = gridDim.x * gridDim.y * gridDim.z;
    unsigned sum, cnt, mine, sp = 0u;
    for (;;) {
        sum = 0u; cnt = 0u; mine = 0u;
#pragma unroll
        for (unsigned j = 0; j < 16; ++j) { const unsigned c = xb_ld(&bar[XB_XCNT(j)]); sum += c; cnt += (c > 0u) ? 1u : 0u; mine = (j == x) ? c : mine; }
        if (sum == G) break;
        __builtin_amdgcn_s_sleep(1);
        if ((++sp & 255u) == 0u) { if (xb_ld(&bar[XB_TMO])) break; if (sp > XB_SPIN_CAP) { atomicAdd(&bar[XB_TMO], 1u); break; } }
    }
    nloc = mine > 0u ? mine : 1u; nx = cnt > 0u ? cnt : 1u;
}

__device__ __forceinline__ void xcd_barrier(const XcdBarrier& b) {
    asm volatile("s_waitcnt vmcnt(0)" ::: "memory");
    __syncthreads();
    if (threadIdx.x == 0) {
        unsigned* bar = b.bar;
        __builtin_amdgcn_s_waitcnt(0);
        unsigned nloc = b.st[0], nx = b.st[1];
        if (nloc == 0u) { xcd_barrier_complete(bar, b.x, nloc, nx); b.st[0] = nloc; b.st[1] = nx; }
        const unsigned old = xb_add(&bar[XB_XSUB(b.x)], 1u);
        const unsigned gen = old / nloc;
        if (old + 1u == (gen + 1u) * nloc) {
            __builtin_amdgcn_fence(__ATOMIC_RELEASE, "agent");
            asm volatile("s_waitcnt vmcnt(0)" ::: "memory");
            const unsigned og = xb_add(&bar[XB_TOP], 1u);
            const unsigned tg = og / nx;
            if (og + 1u == (tg + 1u) * nx) xb_add(&bar[XB_TOPGEN], 1u);
            else XB_SPIN(xb_ld(&bar[XB_TOPGEN]) == tg, bar);
            __builtin_amdgcn_fence(__ATOMIC_ACQUIRE, "agent");
            xb_add(&bar[XB_XGEN(b.x)], 1u);
            asm volatile("s_waitcnt vmcnt(0)" ::: "memory");
        } else {
            XB_SPIN(xb_ld(&bar[XB_XGEN(b.x)]) == gen, bar);
            __builtin_amdgcn_fence(__ATOMIC_ACQUIRE, "agent");
            asm volatile("s_waitcnt vmcnt(0)" ::: "memory");
        }
    }
    __syncthreads();
}

#if defined(SKIPS)
#define EN(k) (SKIPS != (k))
#elif !defined(ONLYS)
#define EN(k) 1
#else
#define EN(k) (ONLYS == (k))
#endif
__device__ __forceinline__ void run_phase(const Params& p, int ph, unsigned char* smem) {
  if (ph == 0) { if (EN(10)) phase_init0(p, (float*)smem); return; }
  if (ph == 1) { if (EN(11)) phase_init1(p); return; }
  int l = 0, s = 10;
  if (ph >= 3) { l = (ph - 3) / 10; s = (ph - 3) - l * 10; }
  unsigned char* wl = p.ws + OFF_W;
  PG8_LAS unsigned char* lds = (PG8_LAS unsigned char*)smem;
  pg8::StaticOrder S;
  if (s == 10 || s == 6 || s == 9) {
    if (EN(5)) rowpass(p, l, s == 10 ? 0 : (s == 6 ? 1 : 2));
    if (s == 9 && l == 0) {
      __syncthreads();
      for (int it = blockIdx.x; it < 832; it += gridDim.x) conv_item(p, 1, it, (float*)smem);
    }
  } else if (s == 0 || s == 3 || s == 5 || s == 8) {
    pg8::Gemm g; EpiBf E;
    g.M = NROWS; E.bias = nullptr; E.act = 0;
    if (s == 0) { g.A = (const u16*)(p.ws + OFF_H); g.lda = DM; g.Bt = (const u16*)(wl + OW_IN); g.K = DM; g.N = PST; E.O = (u16*)(p.ws + OFF_BIG); E.ldc = PST; }
    else if (s == 3) {
      g.A = (const u16*)(p.ws + OFF_H); g.lda = DM; g.Bt = (const u16*)(wl + OW_G); g.K = DM; g.N = 4096;
      E.O = (u16*)(p.ws + OFF_BIG); E.ldc = 4096; E.bias = p.gate_b + (size_t)l * 4096; E.act = 1;
    }
    else if (s == 5) { g.A = (const u16*)(p.ws + OFF_H); g.lda = DM; g.Bt = (const u16*)(wl + OW_O); g.K = DM; g.N = DM; E.O = (u16*)(p.ws + OFF_BIG); E.ldc = DM; }
    else { g.A = (const u16*)(p.ws + OFF_BIG); g.lda = FH; g.Bt = (const u16*)(wl + OW_2); g.K = FH; g.N = DM; E.O = (u16*)(p.ws + OFF_YS); E.ldc = DM; }
    if (l == 1 && s != 0) S.init(NBATCH * SEQ, g.N, gridDim.x, blockIdx.x, 1);
    else S.init(g.M, g.N, gridDim.x, blockIdx.x);
    if (EN(0)) pg8::gemm_phase<EpiBf, pg8::StaticOrder, false>(lds, g, S, E, nullptr);
  } else if (s == 4) {
    if (EN(3)) phase_ypart(p, l, smem);
  } else if (s == 1) {
    if (EN(1)) phase_mix(p, l, smem);
  } else if (s == 2) {
    if (EN(2)) phase_post(p, l, (float*)smem);
  } else {
    pg8::Gemm g; EpiSwiglu E;
    g.M = NROWS; g.N = 2 * FH; g.K = DM; g.lda = DM; g.A = (const u16*)(p.ws + OFF_H); g.Bt = (const u16*)(wl + OW_1);
    E.O = (u16*)(p.ws + OFF_BIG);
    if (l == 1) S.init(NBATCH * SEQ, g.N, gridDim.x, blockIdx.x, 1);
    else S.init(g.M, g.N, gridDim.x, blockIdx.x);
    if (EN(6)) pg8::gemm_phase<EpiSwiglu, pg8::StaticOrder, false>(lds, g, S, E, nullptr);
  }
}

__global__ void __launch_bounds__(NTHR) hybrid_flow_mega(Params p, int ph0, int ph1) {
  __shared__ __attribute__((aligned(16))) unsigned char smem[131072];
  __shared__ __attribute__((aligned(16))) unsigned xbw[4];
  cg::grid_group grid = cg::this_grid();
  XcdBarrier xb;
  xb.bar = (unsigned*)(p.ws + OFF_XBAR); xb.x = 0u; xb.st = (volatile LAS unsigned*)xbw;
  for (int ph = ph0; ph < ph1; ph++) {
    run_phase(p, ph, smem);
#ifdef DUPMASK
    {
      int sidx = ph >= 3 ? (ph - 3) % 10 : 12 + ph;
      if ((DUPMASK >> sidx) & 1) { __syncthreads(); run_phase(p, ph, smem); }
    }
#endif
    if (ph + 1 < ph1) {
      if (ph == ph0) {
        grid.sync();
        if (threadIdx.x < 4) xbw[threadIdx.x] = 0u;
        __syncthreads();
        xb = xcd_barrier_post((unsigned*)(p.ws + OFF_XBAR), (volatile LAS unsigned*)xbw);
      } else {
        xcd_barrier(xb);
      }
    }
  }
  if (ph1 - ph0 > 2 && threadIdx.x == 0 && xb_ld(&xb.bar[XB_TMO]) != 0u) p.out[blockIdx.x] = __int_as_float(0x7fc00000);
}

extern "C" void kernel_launch(void* const* d_in, const int* in_sizes, int n_in, void* d_out, int out_size, void* d_ws,
                              size_t ws_size, hipStream_t stream) {
  Params p{};
  const float** pp = (const float**)&p;
  for (int i = 0; i < 32; i++) pp[i] = (const float*)d_in[i];
  p.out = (float*)d_out;
  p.ws = (unsigned char*)d_ws;
  static int grid_blocks = 0;
  if (!grid_blocks) {
    int dev = 0, cus = 0, per_cu = 0;
    hipGetDevice(&dev);
    hipDeviceGetAttribute(&cus, hipDeviceAttributeMultiprocessorCount, dev);
    hipOccupancyMaxActiveBlocksPerMultiprocessor(&per_cu, hybrid_flow_mega, NTHR, 0);
    if (per_cu < 1) per_cu = 1;
    grid_blocks = cus * per_cu;
  }
#ifdef MULTI_LAUNCH
  for (int ph = 0; ph < NPHASE; ph++) {
    hipLaunchKernelGGL(hybrid_flow_mega, dim3(grid_blocks), dim3(NTHR), 0, stream, p, ph, ph + 1);
  }
#else
  int ph0 = 0, ph1 = NPHASE;
  void* args[] = {&p, &ph0, &ph1};
  hipError_t e = hipLaunchCooperativeKernel((void*)hybrid_flow_mega, dim3(grid_blocks), dim3(NTHR), args, 0, stream);
  if (e != hipSuccess) fprintf(stderr, "cooperative launch failed: %s (grid %d)\n", hipGetErrorString(e), grid_blocks);
#endif
}
```

```cpp
#include <hip/hip_runtime.h>
#include <hip/hip_cooperative_groups.h>
#include <cstdio>
namespace cg = cooperative_groups;

typedef unsigned short u16;
using bf16x8 = __attribute__((ext_vector_type(8))) short;
using f32x4 = __attribute__((ext_vector_type(4))) float;

#define DM 1024
#define NBATCH 8
#define SEQ 4096
#define LC 256
#define TPB 4352
#define NROWS 34816
#define PST 3328
#define YST 1792
#define FH 2816
#define INW 7408
#define NTHR 512
#define PA 0
#define PB 960
#define PC 2000
#define PD 2800
#define NPHASE 23
#define SCAN3_MASK 7

struct Params {
  const float *x, *c, *ctx, *c_ctx, *ada_w, *ada_b, *norm_g, *w_in, *gate_b, *w_branch, *w_out,
      *rwkv_mu, *rwkv_w0, *rwkv_w2, *rwkv_a0, *rwkv_a2, *rwkv_g2, *rwkv_kk, *rwkv_ka, *rwkv_rk, *rwkv_ln_g,
      *rwkv_ln_b, *gdn_conv, *gdn_a_log, *gdn_dt_bias, *gdn_norm_g, *gla_gw2, *gla_gb, *gla_norm_g, *attn_sink,
      *ffn_w1, *ffn_w2;
  float* out;
  unsigned char* ws;
};

constexpr size_t SZ_WL = 36700160;
constexpr size_t OW_IN = 0;
constexpr size_t OW_G = OW_IN + (size_t)PST * 1024 * 2;
constexpr size_t OW_B = OW_G + (size_t)4096 * 1024 * 2;
constexpr size_t OW_O = OW_B + (size_t)4 * 1024 * 256 * 2;
constexpr size_t OW_1 = OW_O + (size_t)1024 * 1024 * 2;
constexpr size_t OW_2 = OW_1 + (size_t)5632 * 1024 * 2;
static_assert(OW_2 + (size_t)1024 * FH * 2 == SZ_WL, "weights size");
constexpr size_t SZ_ACT = (size_t)NROWS * DM * 2;
constexpr size_t OFF_W = 0;
constexpr size_t OFF_XC = OFF_W + SZ_WL;
constexpr size_t OFF_MODP = OFF_XC + (size_t)NBATCH * LC * DM * 4;
constexpr size_t OFF_MOD = OFF_MODP + (size_t)2 * 8 * 9 * 6144 * 4;
constexpr size_t OFF_BC = OFF_MOD + (size_t)2 * 9 * 6144 * 4;
constexpr size_t OFF_H = OFF_BC + (size_t)NROWS * 8 * 4;
constexpr size_t OFF_YS = OFF_H + SZ_ACT;
constexpr size_t OFF_BIG = OFF_YS + (size_t)NROWS * YST * 2;
constexpr size_t OFF_CTR = OFF_BIG + (size_t)NROWS * 4096 * 2;
constexpr size_t OFF_XBAR = OFF_CTR + 256;
constexpr size_t WS_END = OFF_XBAR + 3456 * 4;
static_assert(WS_END <= (size_t)536870912, "ws too large");

__device__ __forceinline__ int launder_tid() { int t = threadIdx.x; asm volatile("" : "+v"(t)); return t; }
#define TIDX (launder_tid())
typedef float f32x2_t __attribute__((ext_vector_type(2)));
typedef __bf16 bf16x2_t __attribute__((ext_vector_type(2)));
__device__ __forceinline__ unsigned pack2(float a, float b) {
  const f32x2_t v = {a, b};
  const bf16x2_t r = __builtin_convertvector(v, bf16x2_t);
  return __builtin_bit_cast(unsigned, r);
}
__device__ __forceinline__ u16 f2bf(float f) { return (u16)(pack2(f, 0.f) & 0xffffu); }
__device__ __forceinline__ float bf2f(u16 h) { return __uint_as_float(((unsigned)h) << 16); }
__device__ __forceinline__ float sigm(float x) { return __builtin_amdgcn_rcpf(1.f + __expf(-x)); }
__device__ __forceinline__ float siluf(float x) { return x * __builtin_amdgcn_rcpf(1.f + __expf(-x)); }
__device__ __forceinline__ float rsq(float x) { return __builtin_amdgcn_rsqf(x); }
__device__ __forceinline__ float softplusf(float x) { return fmaxf(x, 0.f) + __logf(1.f + __expf(-fabsf(x))); }
__device__ __forceinline__ float tanh_fast(float x) { return 1.f - 2.f * __builtin_amdgcn_rcpf(1.f + __expf(2.f * x)); }
__device__ __forceinline__ float wsum(float v) {
#pragma unroll
  for (int o = 32; o > 0; o >>= 1) v += __shfl_xor(v, o);
  return v;
}
template <int CTRL>
__device__ __forceinline__ float dppf(float x) {
  return __int_as_float(__builtin_amdgcn_update_dpp(__float_as_int(x), __float_as_int(x), CTRL, 0xf, 0xf, false));
}
__device__ __forceinline__ float red8(float x) {
  x += dppf<0xB1>(x);
  x += dppf<0x4E>(x);
  x += dppf<0x141>(x);
  return x;
}
__device__ __forceinline__ const float* xin_row(const Params& p, int r) {
  int b = r / TPB, t = r - b * TPB;
  return t < LC ? p.ctx + ((size_t)(b * LC + t)) * DM : p.x + ((size_t)(b * SEQ + t - LC)) * DM;
}
__device__ __forceinline__ float* x_row(const Params& p, int r) {
  int b = r / TPB, t = r - b * TPB;
  return t < LC ? (float*)(p.ws + OFF_XC) + ((size_t)(b * LC + t)) * DM : p.out + ((size_t)(b * SEQ + t - LC)) * DM;
}
__device__ __forceinline__ int mod_row(int r) {
  int b = r / TPB, t = r - b * TPB;
  return t < LC ? 8 : b;
}

struct MapId { int lim, off; __device__ int operator()(int n) const { return n < lim ? n + off : -1; } };
struct MapW1 { __device__ int operator()(int n) const { int q = n >> 3, s = n & 7; return s < 4 ? q * 4 + s : FH + q * 4 + (s - 4); } };

template <class Map>
__device__ __forceinline__ void conv_tile(const float* __restrict__ src, int ld, u16* __restrict__ dst, int K, int n0,
                                          int k0, Map map, float* tile) {
  const int tid = TIDX;
  const int nn = tid & 63, kr = tid >> 6;
  const int sc = map(n0 + nn);
  float tv[8];
  const int scc = sc >= 0 ? sc : 0;
  const float scm = sc >= 0 ? 1.f : 0.f;
#pragma unroll
  for (int ps = 0; ps < 8; ps++) tv[ps] = src[(size_t)(k0 + ps * 8 + kr) * ld + scc];
#pragma unroll
  for (int ps = 0; ps < 8; ps++) tile[(ps * 8 + kr) * 65 + nn] = tv[ps] * scm;
  __syncthreads();
  const int n2 = tid >> 3, kc = tid & 7;
  uint4 o;
  o.x = pack2(tile[(kc * 8 + 0) * 65 + n2], tile[(kc * 8 + 1) * 65 + n2]);
  o.y = pack2(tile[(kc * 8 + 2) * 65 + n2], tile[(kc * 8 + 3) * 65 + n2]);
  o.z = pack2(tile[(kc * 8 + 4) * 65 + n2], tile[(kc * 8 + 5) * 65 + n2]);
  o.w = pack2(tile[(kc * 8 + 6) * 65 + n2], tile[(kc * 8 + 7) * 65 + n2]);
  *(uint4*)(dst + (size_t)(n0 + n2) * K + k0 + kc * 8) = o;
  __syncthreads();
}

__device__ __forceinline__ void conv_item(const Params& p, int l, int rem, float* sm) {
      u16* wl = (u16*)(p.ws + OFF_W);
      if (rem < 832) {
        int nt = rem >> 4, kt = rem & 15;
        conv_tile(p.w_in + (size_t)l * DM * INW, INW, (u16*)((char*)wl + OW_IN), 1024, nt * 64, kt * 64, MapId{3312, 0}, sm);
      } else if (rem < 832 + 1024) {
        rem -= 832;
        int nt = rem >> 4, kt = rem & 15;
        conv_tile(p.w_in + (size_t)l * DM * INW, INW, (u16*)((char*)wl + OW_G), 1024, nt * 64, kt * 64, MapId{4096, 3312}, sm);
      } else if (rem < 1856 + 256) {
        rem -= 1856;
        int br = rem >> 6, r2 = rem & 63, nt = r2 >> 2, kt = r2 & 3;
        conv_tile(p.w_branch + ((size_t)(l * 4 + br)) * 256 * DM, DM, (u16*)((char*)wl + OW_B) + (size_t)br * 1024 * 256, 256,
                  nt * 64, kt * 64, MapId{1024, 0}, sm);
      } else if (rem < 2112 + 256) {
        rem -= 2112;
        int nt = rem >> 4, kt = rem & 15;
        conv_tile(p.w_out + (size_t)l * DM * DM, DM, (u16*)((char*)wl + OW_O), 1024, nt * 64, kt * 64, MapId{1024, 0}, sm);
      } else if (rem < 2368 + 1408) {
        rem -= 2368;
        int nt = rem >> 4, kt = rem & 15;
        conv_tile(p.ffn_w1 + (size_t)l * DM * 5632, 5632, (u16*)((char*)wl + OW_1), 1024, nt * 64, kt * 64, MapW1{}, sm);
      } else {
        rem -= 3776;
        int nt = rem / 44, kt = rem - nt * 44;
        conv_tile(p.ffn_w2 + (size_t)l * FH * DM, DM, (u16*)((char*)wl + OW_2), FH, nt * 64, kt * 64, MapId{1024, 0}, sm);
      }
}

__device__ __forceinline__ void phase_init0(const Params& p, float* sm) {
  const int tid = TIDX;
  if (blockIdx.x == 0) {
    if (tid < 64) ((unsigned*)(p.ws + OFF_CTR))[tid] = 0u;
    for (int i = tid; i < 3456; i += NTHR) ((unsigned*)(p.ws + OFF_XBAR))[i] = 0u;
  }
  constexpr int NMOD = 192, NCONV = 832;
  for (int it = blockIdx.x; it < NMOD + NCONV; it += gridDim.x) {
    if (it < NMOD) {
      int l = it / 96, rem = it - l * 96, cc = rem >> 3, ks = rem & 7;
      for (int i = tid; i < 9 * 128; i += NTHR) {
        int r = i >> 7, k = i & 127;
        float v = r < 8 ? p.c[r * DM + ks * 128 + k] : p.c_ctx[ks * 128 + k];
        sm[i] = siluf(v);
      }
      __syncthreads();
      const int n = cc * 512 + tid;
      const float* w = p.ada_w + ((size_t)l * DM + ks * 128) * 6144 + n;
      float acc[9];
#pragma unroll
      for (int r = 0; r < 9; r++) acc[r] = 0.f;
#pragma unroll 1
      for (int k0 = 0; k0 < 128; k0 += 16) {
        float wv[16];
#pragma unroll
        for (int kk = 0; kk < 16; kk++) wv[kk] = w[(size_t)(k0 + kk) * 6144];
#pragma unroll
        for (int kk = 0; kk < 16; kk++)
#pragma unroll
          for (int r = 0; r < 9; r++) acc[r] += sm[r * 128 + k0 + kk] * wv[kk];
      }
      float* mp = (float*)(p.ws + OFF_MODP) + ((size_t)(l * 8 + ks) * 9) * 6144 + n;
#pragma unroll
      for (int r = 0; r < 9; r++) mp[(size_t)r * 6144] = acc[r];
      __syncthreads();
    } else {
      conv_item(p, 0, it - NMOD, sm);
    }
  }
}

__device__ __forceinline__ void phase_init1(const Params& p) {
  const float* mp = (const float*)(p.ws + OFF_MODP);
  float* mo = (float*)(p.ws + OFF_MOD);
  for (int i = blockIdx.x * NTHR + TIDX; i < 2 * 9 * 6144; i += gridDim.x * NTHR) {
    int l = i / (9 * 6144), rem = i - l * 9 * 6144, r = rem / 6144, n = rem - r * 6144;
    float s = p.ada_b[l * 6144 + n];
#pragma unroll
    for (int ks = 0; ks < 8; ks++) s += mp[((size_t)((l * 8 + ks) * 9 + r)) * 6144 + n];
    mo[i] = s;
  }
}

__device__ __forceinline__ void rowpass(const Params& p, int l, int mode) {
  const int lane = TIDX & 63, wv = __builtin_amdgcn_readfirstlane(TIDX >> 6);
  const float* MOD = (const float*)(p.ws + OFF_MOD);
  u16* H = (u16*)(p.ws + OFF_H);
  const bool do_norm = !(mode == 2 && l == 1);
  const int ln = (mode == 2) ? (l == 1 ? l : l + 1) : l;
  const int ni = (mode == 1) ? 2 : 0, sho = (mode == 1) ? 3072 : 0, sco = (mode == 1) ? 4096 : 1024;
  for (int r = blockIdx.x * 8 + wv; r < NROWS; r += gridDim.x * 8) {
    const int mr = mod_row(r);
    if (l == 1 && mode != 0 && mr == 8) continue;
    const float* modl = MOD + ((size_t)(l * 9 + mr)) * 6144;
    const float* modn = MOD + ((size_t)(ln * 9 + mr)) * 6144;
    const float* ng2 = p.norm_g + (size_t)(ln * 4 + ni) * DM;
    const float* xs = (mode == 0 || (mode == 1 && l == 0)) ? xin_row(p, r) : (const float*)x_row(p, r);
    float4 xo[4], n2[4], sc4[4], sh4[4];
#pragma unroll
    for (int i = 0; i < 4; i++) {
      const int col = i * 256 + lane * 4;
      xo[i] = *(const float4*)(xs + col);
      n2[i] = *(const float4*)(ng2 + col);
      sc4[i] = *(const float4*)(modn + sco + col);
      sh4[i] = *(const float4*)(modn + sho + col);
    }
    float xv[16];
    if (mode == 0) {
#pragma unroll
      for (int i = 0; i < 4; i++) { xv[i * 4 + 0] = xo[i].x; xv[i * 4 + 1] = xo[i].y; xv[i * 4 + 2] = xo[i].z; xv[i * 4 + 3] = xo[i].w; }
    } else {
      const u16* src = (const u16*)(p.ws + (mode == 1 ? OFF_BIG : OFF_YS)) + (size_t)r * DM;
      const float* ng = p.norm_g + (size_t)(l * 4 + (mode == 1 ? 1 : 3)) * DM;
      const float* gt = modl + (mode == 1 ? 2048 : 5120);
      uint2 sv[4];
      float4 g4[4], n4[4];
#pragma unroll
      for (int i = 0; i < 4; i++) {
        const int col = i * 256 + lane * 4;
        sv[i] = *(const uint2*)(src + col);
        g4[i] = *(const float4*)(gt + col);
        n4[i] = *(const float4*)(ng + col);
      }
      float ov[16];
      float ss = 0.f;
#pragma unroll
      for (int i = 0; i < 4; i++) {
        ov[i * 4 + 0] = __uint_as_float(sv[i].x << 16); ov[i * 4 + 1] = __uint_as_float(sv[i].x & 0xffff0000u);
        ov[i * 4 + 2] = __uint_as_float(sv[i].y << 16); ov[i * 4 + 3] = __uint_as_float(sv[i].y & 0xffff0000u);
      }
#pragma unroll
      for (int i = 0; i < 16; i++) ss += ov[i] * ov[i];
      ss = wsum(ss);
      const float inv = rsq(ss * (1.f / 1024.f) + 1e-6f);
      float* xd = x_row(p, r);
#pragma unroll
      for (int i = 0; i < 4; i++) {
        xv[i * 4 + 0] = xo[i].x + g4[i].x * (ov[i * 4 + 0] * inv * n4[i].x);
        xv[i * 4 + 1] = xo[i].y + g4[i].y * (ov[i * 4 + 1] * inv * n4[i].y);
        xv[i * 4 + 2] = xo[i].z + g4[i].z * (ov[i * 4 + 2] * inv * n4[i].z);
        xv[i * 4 + 3] = xo[i].w + g4[i].w * (ov[i * 4 + 3] * inv * n4[i].w);
      }
#pragma unroll
      for (int i = 0; i < 4; i++)
        *(float4*)(xd + i * 256 + lane * 4) = make_float4(xv[i * 4 + 0], xv[i * 4 + 1], xv[i * 4 + 2], xv[i * 4 + 3]);
    }
    if (!do_norm) continue;
    float ss2 = 0.f;
#pragma unroll
    for (int i = 0; i < 16; i++) ss2 += xv[i] * xv[i];
    ss2 = wsum(ss2);
    const float inv2 = rsq(ss2 * (1.f / 1024.f) + 1e-6f);
#pragma unroll
    for (int i = 0; i < 4; i++) {
      const int col = i * 256 + lane * 4;
      float h0 = xv[i * 4 + 0] * inv2 * n2[i].x * (1.f + sc4[i].x) + sh4[i].x;
      float h1 = xv[i * 4 + 1] * inv2 * n2[i].y * (1.f + sc4[i].y) + sh4[i].y;
      float h2 = xv[i * 4 + 2] * inv2 * n2[i].z * (1.f + sc4[i].z) + sh4[i].z;
      float h3 = xv[i * 4 + 3] * inv2 * n2[i].w * (1.f + sc4[i].w) + sh4[i].w;
      uint2 o;
      o.x = pack2(h0, h1);
      o.y = pack2(h2, h3);
      *(uint2*)(H + (size_t)r * DM + col) = o;
    }
  }
}

#define LDT 72
namespace pg8 {
#define PG8_LAS __attribute__((address_space(3)))
typedef unsigned short bf16_t;
typedef short bf16x8 __attribute__((ext_vector_type(8)));
typedef float f32x4 __attribute__((ext_vector_type(4)));
typedef unsigned u32x4 __attribute__((ext_vector_type(4)));
constexpr int BM = 256, BK = 64, HALF = 128, HTB = HALF * BK * 2  , STAGE_BYTES = 8 * HTB, NXCD = 8, WGM = 8;

__host__ __device__ __forceinline__ int lds_byte(int r, int c) { const int st = (r >> 4) * 2 + (c >> 5), rr = r & 15, cc = c & 31, ob = rr * 64 + cc * 2; return st * 1024 + (ob ^ (((ob >> 9) & 1) << 5)); }
__host__ __device__ __forceinline__ void stage_rc(int b, int& R, int& C) { const int st = b / 1024, sb = b % 1024, swz = sb ^ (((sb >> 9) & 1) << 5); R = (st >> 1) * 16 + swz / 64; C = (st & 1) * 32 + (swz % 64) / 2; }
__host__ __device__ __forceinline__ int perm32(int rho) { const int n = rho >> 4, i = rho & 15; return 8 * (i >> 2) + 4 * n + (i & 3); }

struct Unit { int pm, pn; };
struct Gemm { const bf16_t* A; const bf16_t* Bt; int M, N, K, lda; };
struct StaticOrder {
    int nM, nN, nwg, G, c, skip;
    __host__ __device__ void init(int M, int N, int G_, int c_, int skip_ = 0) { nM = M / BM; nN = N / BM; nwg = nM * nN; G = G_; c = c_; skip = skip_; }
    __host__ __device__ bool next(int i, Unit& u) const {
        const long L = (long)i * G + c; if (L >= nwg) return false;
        int wgid = (int)L; { const int q = nwg / NXCD, r = nwg % NXCD, xcd = wgid % NXCD, off = wgid / NXCD; wgid = (xcd < r ? xcd * (q + 1) : r * (q + 1) + (xcd - r) * q) + off; }
        const int nig = WGM * nN, gid = wgid / nig, fm = gid * WGM, gsz = (nM - fm) < WGM ? (nM - fm) : WGM;
        u.pm = fm + ((wgid % nig) % gsz); u.pn = (wgid % nig) / gsz;
        if (skip) u.pm = (u.pm >> 4) * 17 + 1 + (u.pm & 15);
        return true;
    }
    __device__ __forceinline__ void a_ready(const Unit&) const {}
    __device__ __forceinline__ void done(const Unit&) const {}
};
__device__ __forceinline__ unsigned cvt_pk_bf16(float lo, float hi) { unsigned r; asm volatile("v_cvt_pk_bf16_f32 %0, %1, %2" : "=v"(r) : "v"(lo), "v"(hi)); return r; }
template <class Epi, class Sched, bool STAMP = false>
__device__ __forceinline__ void gemm_phase(PG8_LAS unsigned char* lds, const Gemm g, const Sched& S, const Epi& E, unsigned long long* stamps) {
    const int tid = TIDX, wid = __builtin_amdgcn_readfirstlane(tid >> 6), lane = tid & 63, wr = wid >> 2, wc = wid & 3, fr = lane & 15, fq = lane >> 4;
    const int K = g.K, nt = K / BK;
    int ts_lo = 0, ts_hi = 0, nts = 0; const unsigned long long rt_entry = STAMP ? (unsigned long long)wall_clock64() : 0ull;
#define PG8_STAMP() do { if (STAMP && wid == 0 && nts < 64) { const unsigned long long _c = (unsigned long long)clock64(); \
        ts_lo = (lane == nts) ? (int)(unsigned)_c : ts_lo; ts_hi = (lane == nts) ? (int)(unsigned)(_c >> 32) : ts_hi; ++nts; } } while (0)
    PG8_STAMP();
    unsigned voffA[2], voffB[2];
#pragma unroll
    for (int i = 0; i < 2; ++i) { int R, C; stage_rc(tid * 16 + i * 8192, R, C); const int Rb = Epi::PERM ? ((R & ~31) + perm32(R & 31)) : R;
        voffA[i] = (unsigned)(R * g.lda + C) * 2u; voffB[i] = (unsigned)(Rb * K + C) * 2u; }
    const size_t kstep = (size_t)(BK * 2);
    const size_t hstepB = (size_t)HALF * K * 2, hstepA = (size_t)HALF * g.lda * 2;
    const size_t tstepB = 2 * hstepB, tstepA = 2 * hstepA;
    const unsigned ldsw = (unsigned)wid * 1024u;
    const int aoff = lds_byte(wr * 64 + fr, fq * 8), boff = lds_byte(wc * 32 + fr, fq * 8);
#define PG8_SA(b, h) (((b) * 2 + (h)) * HTB)
#define PG8_SB(b, h) ((4 + (b) * 2 + (h)) * HTB)
#define PG8_STAGE(bufoff, gbase, voff) do { _Pragma("unroll") for (int _i = 0; _i < 2; ++_i) \
        __builtin_amdgcn_global_load_lds((const unsigned*)((const char*)(gbase) + (voff)[_i]), (PG8_LAS unsigned*)(lds + (bufoff) + ldsw + _i * 8192), 16, 0, 0); } while (0)
#define PG8_LDA(dst, b, h) do { _Pragma("unroll") for (int m = 0; m < 4; ++m) _Pragma("unroll") for (int k = 0; k < 2; ++k) dst[m][k] = *(const PG8_LAS bf16x8*)(lds + PG8_SA(b, h) + aoff + m * 2048 + k * 1024); } while (0)
#define PG8_LDB(dst, b, h) do { _Pragma("unroll") for (int n = 0; n < 2; ++n) _Pragma("unroll") for (int k = 0; k < 2; ++k) dst[n][k] = *(const PG8_LAS bf16x8*)(lds + PG8_SB(b, h) + boff + n * 2048 + k * 1024); } while (0)
#define PG8_MMA(ai, bj, At, Bt) do { __builtin_amdgcn_s_setprio(1); _Pragma("unroll") for (int m = 0; m < 4; ++m) _Pragma("unroll") for (int n = 0; n < 2; ++n) _Pragma("unroll") for (int k = 0; k < 2; ++k) \
        acc[ai][bj][m][n] = __builtin_amdgcn_mfma_f32_16x16x32_bf16(Bt[n][k], At[m][k], acc[ai][bj][m][n], 0, 0, 0); __builtin_amdgcn_s_setprio(0); } while (0)
#define PG8_WAIT_V(n) asm volatile("s_waitcnt vmcnt(" #n ")" ::: "memory")
#define PG8_WAIT_L(n) asm volatile("s_waitcnt lgkmcnt(" #n ")" ::: "memory")
#define PG8_BAR __builtin_amdgcn_s_barrier()
#define PG8_SCHED __builtin_amdgcn_sched_barrier(0)
    Unit cur, nxt; int ui = 0;
    if (!S.next(0, cur)) return;
    f32x4 acc[2][2][4][2];
#pragma unroll
    for (int a = 0; a < 2; ++a)
#pragma unroll
        for (int b = 0; b < 2; ++b)
#pragma unroll
            for (int m = 0; m < 4; ++m)
#pragma unroll
                for (int n = 0; n < 2; ++n) acc[a][b][m][n] = (f32x4){0.f, 0.f, 0.f, 0.f};
    bf16x8 At[4][2], B0[2][2], B1[2][2];
    const char* cA = (const char*)g.A + (size_t)cur.pm * tstepA; const char* cB = (const char*)g.Bt + (size_t)cur.pn * tstepB;
    S.a_ready(cur);
    PG8_STAGE(PG8_SB(0, 0), cB, voffB); PG8_STAGE(PG8_SA(0, 0), cA, voffA); PG8_STAGE(PG8_SB(0, 1), cB + hstepB, voffB); PG8_STAGE(PG8_SA(0, 1), cA + hstepA, voffA);
    if (wr == 1) PG8_BAR;
    PG8_WAIT_V(4); PG8_BAR;
    PG8_STAGE(PG8_SB(1, 0), cB + kstep, voffB); PG8_STAGE(PG8_SA(1, 0), cA + kstep, voffA); PG8_STAGE(PG8_SB(1, 1), cB + hstepB + kstep, voffB);
    PG8_WAIT_V(6); PG8_BAR;
    PG8_STAMP();
    for (;;) {
        const bool has_next = S.next(ui + 1, nxt);
        const char* nA = has_next ? (const char*)g.A + (size_t)nxt.pm * tstepA : cA; const char* nB = has_next ? (const char*)g.Bt + (size_t)nxt.pn * tstepB : cB;
        for (int t = 0; t < nt; t += 2) {
            const bool last = (t == nt - 2);
            const char* a1 = cA + (size_t)(t + 1) * kstep;
            const char* a2 = last ? nA : cA + (size_t)(t + 2) * kstep; const char* b2 = last ? nB : cB + (size_t)(t + 2) * kstep;
            const char* a3 = a2 + kstep; const char* b3 = b2 + kstep;
            if (last && has_next) S.a_ready(nxt);
            PG8_LDB(B0, 0, 0); PG8_SCHED; PG8_LDA(At, 0, 0); PG8_STAGE(PG8_SA(1, 1), a1 + hstepA, voffA);
            PG8_WAIT_L(8); PG8_BAR; PG8_WAIT_L(0); PG8_MMA(0, 0, At, B0); PG8_BAR; PG8_SCHED;
            PG8_LDB(B1, 0, 1); PG8_STAGE(PG8_SB(0, 0), b2, voffB);
            PG8_BAR; PG8_WAIT_L(0); PG8_MMA(0, 1, At, B1); PG8_BAR;
            PG8_LDA(At, 0, 1); PG8_STAGE(PG8_SA(0, 0), a2, voffA);
            PG8_BAR; PG8_WAIT_L(0); PG8_MMA(1, 0, At, B0); PG8_BAR; PG8_SCHED;
            PG8_STAGE(PG8_SB(0, 1), b2 + hstepB, voffB);
            PG8_WAIT_V(6); PG8_BAR; PG8_MMA(1, 1, At, B1); PG8_BAR;
            PG8_LDB(B0, 1, 0); PG8_SCHED; PG8_LDA(At, 1, 0); PG8_STAGE(PG8_SA(0, 1), a2 + hstepA, voffA);
            PG8_WAIT_L(8); PG8_BAR; PG8_WAIT_L(0); PG8_MMA(0, 0, At, B0); PG8_BAR; PG8_SCHED;
            PG8_LDB(B1, 1, 1); PG8_STAGE(PG8_SB(1, 0), b3, voffB);
            PG8_BAR; PG8_WAIT_L(0); PG8_MMA(0, 1, At, B1); PG8_BAR;
            PG8_LDA(At, 1, 1); PG8_STAGE(PG8_SA(1, 0), a3, voffA);
            PG8_BAR; PG8_WAIT_L(0); PG8_MMA(1, 0, At, B0); PG8_BAR; PG8_SCHED;
            PG8_STAGE(PG8_SB(1, 1), b3 + hstepB, voffB);
            PG8_WAIT_V(6); PG8_BAR; PG8_MMA(1, 1, At, B1); PG8_BAR;
        }
        PG8_STAMP();
        if constexpr (!Epi::AFTER_DRAIN) { E(acc, cur, wr, wc, fr, fq); S.done(cur); }
        PG8_STAMP();
        if (!has_next) break;
#pragma unroll
        for (int a = 0; a < 2; ++a)
#pragma unroll
            for (int b = 0; b < 2; ++b)
#pragma unroll
                for (int m = 0; m < 4; ++m)
#pragma unroll
                    for (int n = 0; n < 2; ++n) acc[a][b][m][n] = (f32x4){0.f, 0.f, 0.f, 0.f};
        cur = nxt; cA = nA; cB = nB; ++ui;
    }
    PG8_WAIT_V(0);
    if (wr == 0) PG8_BAR;
    PG8_BAR;
    if constexpr (Epi::AFTER_DRAIN) { E.fused(acc, cur, wr, wc, fr, fq, lds, wid, lane); S.done(cur); }
    PG8_STAMP();
    if (STAMP && wid == 0) { stamps[lane] = lane < nts ? (((unsigned long long)(unsigned)ts_hi << 32) | (unsigned)ts_lo) : 0ull;
        if (lane == 62) stamps[62] = rt_entry; if (lane == 63) stamps[63] = (unsigned long long)wall_clock64(); }
#undef PG8_STAMP
#undef PG8_SA
#undef PG8_SB
#undef PG8_STAGE
#undef PG8_LDA
#undef PG8_LDB
#undef PG8_MMA
#undef PG8_WAIT_V
#undef PG8_WAIT_L
#undef PG8_BAR
#undef PG8_SCHED
}
}

struct EpiBf {
  static constexpr bool PERM = true, AFTER_DRAIN = false;
  u16* O; int ldc; const float* bias; int act;
  __device__ __forceinline__ void operator()(const f32x4 (&acc)[2][2][4][2], const pg8::Unit& u, int wr, int wc, int fr, int fq) const {
    const int row0 = u.pm * 256 + wr * 64 + fr, col0 = u.pn * 256 + wc * 32 + 8 * fq;
    f32x4 bv[2][2];
#pragma unroll
    for (int bj = 0; bj < 2; ++bj)
#pragma unroll
      for (int n = 0; n < 2; ++n) bv[bj][n] = bias ? *(const f32x4*)(bias + col0 + bj * 128 + 4 * n) : f32x4{0.f, 0.f, 0.f, 0.f};
#pragma unroll
    for (int ai = 0; ai < 2; ++ai)
#pragma unroll
      for (int m = 0; m < 4; ++m) {
        u16* rowp = O + (size_t)(row0 + ai * 128 + m * 16) * ldc + col0;
#pragma unroll
        for (int bj = 0; bj < 2; ++bj) {
          f32x4 v0 = acc[ai][bj][m][0] + bv[bj][0], v1 = acc[ai][bj][m][1] + bv[bj][1];
          if (act == 1) {
#pragma unroll
            for (int j = 0; j < 4; ++j) { v0[j] = sigm(v0[j]); v1[j] = sigm(v1[j]); }
          }
          uint4 wv;
          wv.x = pack2(v0[0], v0[1]); wv.y = pack2(v0[2], v0[3]); wv.z = pack2(v1[0], v1[1]); wv.w = pack2(v1[2], v1[3]);
          *(uint4*)(rowp + bj * 128) = wv;
        }
      }
  }
};
struct EpiSwiglu {
  static constexpr bool PERM = true, AFTER_DRAIN = false;
  u16* O;
  __device__ __forceinline__ void operator()(const f32x4 (&acc)[2][2][4][2], const pg8::Unit& u, int wr, int wc, int fr, int fq) const {
    const int row0 = u.pm * 256 + wr * 64 + fr, col0 = u.pn * 128 + wc * 16 + 4 * fq;
#pragma unroll
    for (int ai = 0; ai < 2; ++ai)
#pragma unroll
      for (int m = 0; m < 4; ++m) {
        u16* rowp = O + (size_t)(row0 + ai * 128 + m * 16) * FH + col0;
#pragma unroll
        for (int bj = 0; bj < 2; ++bj) {
          const f32x4 g = acc[ai][bj][m][0], up = acc[ai][bj][m][1];
          uint2 wv;
          wv.x = pack2(siluf(g[0]) * up[0], siluf(g[1]) * up[1]);
          wv.y = pack2(siluf(g[2]) * up[2], siluf(g[3]) * up[3]);
          *(uint2*)(rowp + bj * 64) = wv;
        }
      }
  }
};
struct EpiGateAcc {
  static constexpr bool PERM = true, AFTER_DRAIN = false;
  u16* ACC; const u16* G; int gcol; unsigned amask;
  __device__ __forceinline__ void operator()(const f32x4 (&acc)[2][2][4][2], const pg8::Unit& u, int wr, int wc, int fr, int fq) const {
    unsigned pk[2][2][4][4];
#pragma unroll
    for (int ai = 0; ai < 2; ++ai)
#pragma unroll
      for (int bj = 0; bj < 2; ++bj)
#pragma unroll
        for (int m = 0; m < 4; ++m) {
          pk[ai][bj][m][0] = pack2(acc[ai][bj][m][0][0], acc[ai][bj][m][0][1]);
          pk[ai][bj][m][1] = pack2(acc[ai][bj][m][0][2], acc[ai][bj][m][0][3]);
          pk[ai][bj][m][2] = pack2(acc[ai][bj][m][1][0], acc[ai][bj][m][1][1]);
          pk[ai][bj][m][3] = pack2(acc[ai][bj][m][1][2], acc[ai][bj][m][1][3]);
        }
    asm volatile("" ::: "memory");
    const int row0 = u.pm * 256 + wr * 64 + fr, col0 = u.pn * 256 + wc * 32 + 8 * fq;
#pragma unroll
    for (int ai = 0; ai < 2; ++ai)
#pragma unroll
      for (int m = 0; m < 4; ++m) {
        const size_t row = (size_t)(row0 + ai * 128 + m * 16);
#pragma unroll
        for (int bj = 0; bj < 2; ++bj) {
          const int col = col0 + bj * 128;
          const uint4 gv = *(const uint4*)(G + row * 2048 + gcol + col);
          const uint4 av = *(const uint4*)(ACC + row * DM + col);
          const unsigned gw[4] = {gv.x, gv.y, gv.z, gv.w};
          const unsigned aw[4] = {av.x & amask, av.y & amask, av.z & amask, av.w & amask};
          unsigned ow[4];
#pragma unroll
          for (int q = 0; q < 4; ++q) {
            const unsigned pv = pk[ai][bj][m][q];
            const float lo = __uint_as_float(aw[q] << 16) + __uint_as_float(gw[q] << 16) * __uint_as_float(pv << 16);
            const float hi = __uint_as_float(aw[q] & 0xffff0000u) + __uint_as_float(gw[q] & 0xffff0000u) * __uint_as_float(pv & 0xffff0000u);
            ow[q] = pack2(lo, hi);
          }
          *(uint4*)(ACC + row * DM + col) = make_uint4(ow[0], ow[1], ow[2], ow[3]);
        }
        asm volatile("" ::: "memory");
      }
  }
};

template <int MI>
__device__ __forceinline__ void gemm_loop(const u16* __restrict__ A, int lda, const u16* __restrict__ Bt, int ldb, int K,
                                          f32x4 (&acc)[MI][4], u16* sA, u16* sB) {
  constexpr int BMT = MI * 64;
  const int tid = TIDX, lane = tid & 63, w = tid >> 6, wm = w >> 1, wn = w & 1, fr = lane & 15, fq = lane >> 4;
  uint4 ra[MI], rb[2];
  const u16* ga = A + (size_t)(tid >> 3) * lda + (tid & 7) * 8;
  const u16* gb = Bt + (size_t)(tid >> 3) * ldb + (tid & 7) * 8;
  const int so = (tid >> 3) * LDT + (tid & 7) * 8;
#pragma unroll
  for (int i = 0; i < MI; i++) ra[i] = *(const uint4*)(ga + (size_t)(i * 64) * lda);
#pragma unroll
  for (int i = 0; i < 2; i++) rb[i] = *(const uint4*)(gb + (size_t)(i * 64) * ldb);
#pragma unroll
  for (int i = 0; i < MI; i++) *(uint4*)(sA + so + i * 64 * LDT) = ra[i];
#pragma unroll
  for (int i = 0; i < 2; i++) *(uint4*)(sB + so + i * 64 * LDT) = rb[i];
  __syncthreads();
  const int nk = K >> 6;
  for (int kt = 0; kt < nk; kt++) {
    const bool more = kt + 1 < nk;
    if (more) {
#pragma unroll
      for (int i = 0; i < MI; i++) ra[i] = *(const uint4*)(ga + (size_t)(i * 64) * lda + (kt + 1) * 64);
#pragma unroll
      for (int i = 0; i < 2; i++) rb[i] = *(const uint4*)(gb + (size_t)(i * 64) * ldb + (kt + 1) * 64);
    }
    const u16* a = sA + (kt & 1) * BMT * LDT + (wm * (MI * 16) + fr) * LDT + fq * 8;
    const u16* b = sB + (kt & 1) * 128 * LDT + (wn * 64 + fr) * LDT + fq * 8;
#pragma unroll
    for (int ks = 0; ks < 2; ks++) {
      bf16x8 af[MI], bfr[4];
#pragma unroll
      for (int i = 0; i < MI; i++) af[i] = *(const bf16x8*)(a + i * 16 * LDT + ks * 32);
#pragma unroll
      for (int j = 0; j < 4; j++) bfr[j] = *(const bf16x8*)(b + j * 16 * LDT + ks * 32);
#pragma unroll
      for (int i = 0; i < MI; i++)
#pragma unroll
        for (int j = 0; j < 4; j++) acc[i][j] = __builtin_amdgcn_mfma_f32_16x16x32_bf16(bfr[j], af[i], acc[i][j], 0, 0, 0);
    }
    if (more) {
      u16* da = sA + ((kt + 1) & 1) * BMT * LDT + so;
      u16* db = sB + ((kt + 1) & 1) * 128 * LDT + so;
#pragma unroll
      for (int i = 0; i < MI; i++) *(uint4*)(da + i * 64 * LDT) = ra[i];
#pragma unroll
      for (int i = 0; i < 2; i++) *(uint4*)(db + i * 64 * LDT) = rb[i];
    }
    __syncthreads();
  }
}

template <int MI>
__device__ __forceinline__ void zero_acc(f32x4 (&acc)[MI][4]) {
#pragma unroll
  for (int i = 0; i < MI; i++)
#pragma unroll
    for (int j = 0; j < 4; j++) acc[i][j] = f32x4{0.f, 0.f, 0.f, 0.f};
}


typedef unsigned u32x4v __attribute__((ext_vector_type(4)));
__device__ __forceinline__ void yp_issue(const u16* __restrict__ A, const u16* __restrict__ B, u32x4v (&ra)[8], u32x4v (&rb)[8], int tid) {
#pragma unroll
  for (int i = 0; i < 8; i++) {
    const int c = tid + i * NTHR, row = c >> 5, ch = c & 31;
    ra[i] = *(const u32x4v*)(A + (size_t)row * YST + ch * 8);
    rb[i] = *(const u32x4v*)(B + (size_t)row * 256 + ch * 8);
  }
}
__device__ __forceinline__ void yp_stage(unsigned char* sA, unsigned char* sB, const u32x4v (&ra)[8], const u32x4v (&rb)[8], int tid) {
#pragma unroll
  for (int i = 0; i < 8; i++) {
    const int c = tid + i * NTHR, row = c >> 5, ch = c & 31;
    const int off = row * 512 + ((ch ^ (row & 7)) << 4);
    *(u32x4v*)(sA + off) = ra[i];
    *(u32x4v*)(sB + off) = rb[i];
  }
}
__device__ __forceinline__ void phase_ypart(const Params& p, int l, unsigned char* smem) {
  unsigned char* sA = smem;
  unsigned char* sB = smem + 65536;
  const int tid = TIDX, lane = tid & 63, w = tid >> 6, wm = w >> 1, wn = w & 1, fr = lane & 15, fq = lane >> 4;
  const u16* Y = (const u16*)(p.ws + OFF_YS);
  const u16* Wb = (const u16*)(p.ws + OFF_W + OW_B);
  const u16* G = (const u16*)(p.ws + OFF_BIG);
  u16* ACC = (u16*)(p.ws + OFF_H);
  constexpr int NT = 8;
  const int ntiles = (NROWS / 128) * NT;
  const int G_ = gridDim.x;
  const bool xmap = (G_ == 256);
  const int xj = blockIdx.x >> 3, xx = blockIdx.x & 7;
  const bool skipc = (l == 1);
  const int nrt = skipc ? 256 : 272;
  const int ntl = nrt * NT;
  const int nmine = xmap ? (xj < nrt ? (nrt - 1 - xj) / 32 + 1 : 0)
                         : (((int)blockIdx.x < ntl) ? (ntl - 1 - (int)blockIdx.x) / G_ + 1 : 0);
  if (nmine == 0) return;
#define YP_TILE(Q_, MT_, NT_)                                                        \
  do {                                                                               \
    if (xmap) { const int s_ = (Q_) * 32 + xj; MT_ = (s_ >> 3) * 8 + xx; NT_ = s_ & 7; } \
    else { const int t_ = blockIdx.x + (Q_) * G_; MT_ = t_ / NT; NT_ = t_ - MT_ * NT; }  \
    if (skipc) MT_ = (MT_ >> 5) * 34 + 2 + (MT_ & 31);                                   \
  } while (0)
  u32x4v ra[8], rb[8];
  {
    int mt, nt;
    YP_TILE(0, mt, nt);
    yp_issue(Y + (size_t)mt * 128 * YST, Wb + ((size_t)nt * 128) * 256, ra, rb, tid);
  }
  f32x4 tot[2][4];
  zero_acc<2>(tot);
  for (int qi = 0; qi < 4 * nmine; qi++) {
    const int q = qi >> 2, k = qi & 3;
    int mt, nt;
    YP_TILE(q, mt, nt);
    const int r0 = mt * 128 + wm * 32 + fr, c0 = nt * 128 + wn * 64 + fq * 4;
    uint2 gv[2][4];
#pragma unroll
    for (int i = 0; i < 2; i++)
#pragma unroll
      for (int j = 0; j < 4; j++) gv[i][j] = *(const uint2*)(G + (size_t)(r0 + i * 16) * 4096 + k * 1024 + c0 + j * 16);
    __syncthreads();
    yp_stage(sA, sB, ra, rb, tid);
    __syncthreads();
    {
      const int qn = qi + 1 < 4 * nmine ? qi + 1 : qi;
      int mtn, ntn;
      YP_TILE(qn >> 2, mtn, ntn);
      const int brn = qn & 3, ycn = brn < 3 ? brn * 256 : 1536;
      yp_issue(Y + (size_t)mtn * 128 * YST + ycn, Wb + ((size_t)brn * 1024 + ntn * 128) * 256, ra, rb, tid);
    }
    f32x4 ay[2][4];
    zero_acc<2>(ay);
#pragma unroll 2
    for (int ks = 0; ks < 8; ks++) {
      bf16x8 af[2], bfr[4];
#pragma unroll
      for (int i = 0; i < 2; i++) {
        const int row = wm * 32 + i * 16 + fr;
        af[i] = *(const bf16x8*)(sA + row * 512 + (((ks * 4 + fq) ^ (row & 7)) << 4));
      }
#pragma unroll
      for (int j = 0; j < 4; j++) {
        const int row = wn * 64 + j * 16 + fr;
        bfr[j] = *(const bf16x8*)(sB + row * 512 + (((ks * 4 + fq) ^ (row & 7)) << 4));
      }
#pragma unroll
      for (int i = 0; i < 2; i++)
#pragma unroll
        for (int j = 0; j < 4; j++) ay[i][j] = __builtin_amdgcn_mfma_f32_16x16x32_bf16(bfr[j], af[i], ay[i][j], 0, 0, 0);
    }
#pragma unroll
    for (int i = 0; i < 2; i++)
#pragma unroll
      for (int j = 0; j < 4; j++) {
        tot[i][j][0] += __uint_as_float(gv[i][j].x << 16) * ay[i][j][0];
        tot[i][j][1] += __uint_as_float(gv[i][j].x & 0xffff0000u) * ay[i][j][1];
        tot[i][j][2] += __uint_as_float(gv[i][j].y << 16) * ay[i][j][2];
        tot[i][j][3] += __uint_as_float(gv[i][j].y & 0xffff0000u) * ay[i][j][3];
      }
    if (k == 3) {
#pragma unroll
      for (int i = 0; i < 2; i++)
#pragma unroll
        for (int j = 0; j < 4; j++) {
          uint2 ov;
          ov.x = pack2(tot[i][j][0], tot[i][j][1]); ov.y = pack2(tot[i][j][2], tot[i][j][3]);
          *(uint2*)(ACC + (size_t)(r0 + i * 16) * DM + c0 + j * 16) = ov;
        }
      zero_acc<2>(tot);
    }
  }
  __syncthreads();
#undef YP_TILE
}

#define S2_BUF 10816
#define S2_D 0
#define S2_U 2048
#define S2_P 4096
#define S2_K 6144
#define S2_DQ 8192
#define S2_V 10240
#define S2_C1 10752
#define S2_C2 10784
#define S2_ST (2 * S2_BUF)
#define S2_YB (S2_ST + 8192)

__device__ __forceinline__ float red16(float x) {
  x += dppf<0xB1>(x);
  x += dppf<0x4E>(x);
  x += dppf<0x141>(x);
  x += dppf<0x140>(x);
  return x;
}
__device__ __forceinline__ void wave_lds_sync() {
  asm volatile("s_waitcnt lgkmcnt(0)" ::: "memory");
  __builtin_amdgcn_wave_barrier();
}

template <int MIX>
__device__ __forceinline__ void scan2_item(const Params& p, int l, int b, int h, int dir, int rq, float* sm) {
  constexpr int EPL = (MIX == 2) ? 2 : 4;
  constexpr int VOFF = (MIX == 2) ? 64 : 128;
  const int tid = TIDX, lane = tid & 63, w = tid >> 6, fr = lane & 15, fq = lane >> 4;
  const bool producer = w >= 4;
  const int pw = w & 3;
  const u16* P = (const u16*)(p.ws + OFF_BIG);
  u16* YS = (u16*)(p.ws + OFF_YS);
  float* BC = (float*)(p.ws + OFF_BC);
  float* ST = sm + S2_ST + pw * 2048;
  float s[EPL];
#pragma unroll
  for (int i = 0; i < EPL; i++) s[i] = 0.f;

  bf16x8 bw2[4], ba2[4];
  float cst[5][4];
  float cw[3][7];
  float muv[4];
  int colv[4];
#pragma unroll
  for (int i = 0; i < 4; i++) { bw2[i] = bf16x8{0, 0, 0, 0, 0, 0, 0, 0}; ba2[i] = bw2[i]; muv[i] = 0.f; colv[i] = 0; }
  if (producer) {
    if (MIX == 0) {
#pragma unroll
      for (int nt = 0; nt < 4; nt++) {
        const int jch = h * 64 + nt * 16 + fr;
#pragma unroll
        for (int jj = 0; jj < 8; jj++) {
          bw2[nt][jj] = (short)f2bf(p.rwkv_w2[((size_t)(l * 2 + dir) * 32 + fq * 8 + jj) * 256 + jch]);
          ba2[nt][jj] = (short)f2bf(p.rwkv_a2[((size_t)(l * 2 + dir) * 32 + fq * 8 + jj) * 256 + jch]);
        }
        cst[0][nt] = p.rwkv_w0[(l * 2 + dir) * 256 + jch];
        cst[1][nt] = p.rwkv_a0[(l * 2 + dir) * 256 + jch];
        cst[2][nt] = p.rwkv_ka[l * 256 + jch];
        cst[3][nt] = p.rwkv_kk[l * 256 + jch];
        cst[4][nt] = p.rwkv_rk[l * 256 + jch];
      }
#pragma unroll
      for (int i = 0; i < 4; i++) {
        const int c = lane + 64 * i;
        colv[i] = i < 3 ? i * 256 + h * 64 + lane : (lane < 32 ? 768 + dir * 32 + lane : 832 + dir * 32 + (lane - 32));
        muv[i] = p.rwkv_mu[l * 960 + colv[i]];
        (void)c;
      }
    } else if (MIX == 1) {
#pragma unroll
      for (int i = 0; i < 3; i++) {
        colv[i] = PB + i * 256 + h * 64 + lane;
#pragma unroll
        for (int tp = 0; tp < 7; tp++) cw[i][tp] = p.gdn_conv[((size_t)l * 7 + tp) * 768 + i * 256 + h * 64 + lane];
      }
    } else {
#pragma unroll
      for (int nt = 0; nt < 2; nt++) {
#pragma unroll
        for (int jj = 0; jj < 8; jj++)
          bw2[nt][jj] = fq < 2 ? (short)f2bf(p.gla_gw2[((size_t)(l * 2 + dir) * 16 + fq * 8 + jj) * 128 + h * 32 + nt * 16 + fr]) : (short)0;
        cst[0][nt] = p.gla_gb[(l * 2 + dir) * 128 + h * 32 + nt * 16 + fr];
      }
      colv[0] = PC + h * 32 + lane;
      if (lane >= 32) colv[0] = PC + 128 + h * 32 + (lane - 32);
      colv[1] = PC + 256 + h * 64 + lane;
      colv[2] = PC + 512 + dir * 16 + (lane & 15);
    }
  }
  __syncthreads();

  for (int c = 0; c <= TPB / 32 + 1; c++) {
    if (producer) {
      if (c >= 2) {
        const int cc = c - 2;
        int seg_row0, t_lo;
        if (cc < 8) { seg_row0 = b * TPB; t_lo = dir == 0 ? cc * 32 : (LC - 32 - cc * 32); }
        else { seg_row0 = b * TPB + LC; t_lo = dir == 0 ? (cc - 8) * 32 : (SEQ - 32 - (cc - 8) * 32); }
        const float* yb = sm + S2_YB + (cc & 1) * 512;
        const int t2 = tid - 256;
#pragma unroll
        for (int i = 0; i < 2; i++) {
          const int idx = t2 + i * 256, tt = idx >> 4, e = idx & 15;
          YS[(size_t)(seg_row0 + t_lo + tt) * YST + dir * 768 + MIX * 256 + h * 64 + rq * 16 + e] = f2bf(yb[idx]);
        }
      }
      if (c < TPB / 32) {
        int seg_row0, seg_len, t_lo;
        if (c < 8) { seg_row0 = b * TPB; seg_len = LC; t_lo = dir == 0 ? c * 32 : (LC - 32 - c * 32); }
        else { seg_row0 = b * TPB + LC; seg_len = SEQ; t_lo = dir == 0 ? (c - 8) * 32 : (SEQ - 32 - (c - 8) * 32); }
        const u16* Pseg = P + (size_t)seg_row0 * PST;
        float* B = sm + (c & 1) * S2_BUF;
        const int t0 = t_lo + pw * 8;
        if (MIX == 0) {
          float raw[10][4];
#pragma unroll
          for (int rr = 0; rr < 10; rr++) {
            const int t = t0 - 1 + rr;
            const float okf = (t >= 0 && t < seg_len) ? 1.f : 0.f;
            const int tc = min(max(t, 0), seg_len - 1);
#pragma unroll
            for (int i = 0; i < 4; i++) raw[rr][i] = bf2f(Pseg[(size_t)tc * PST + PA + colv[i]]) * okf;
          }
#pragma unroll
          for (int j = 0; j < 8; j++)
#pragma unroll
            for (int i = 0; i < 4; i++) {
              float xm = raw[j + 1][i] + (0.5f * (raw[j][i] + raw[j + 2][i]) - raw[j + 1][i]) * muv[i];
              if (i == 3 && lane < 32) xm = tanh_fast(xm);
              ST[j * 256 + lane + 64 * i] = xm;
            }
        } else if (MIX == 1) {
          float raw[14][3];
#pragma unroll
          for (int rr = 0; rr < 14; rr++) {
            const int t = t0 - 3 + rr;
            const float okf = (t >= 0 && t < seg_len) ? 1.f : 0.f;
            const int tc = min(max(t, 0), seg_len - 1);
#pragma unroll
            for (int i = 0; i < 3; i++) raw[rr][i] = bf2f(Pseg[(size_t)tc * PST + colv[i]]) * okf;
          }
#pragma unroll
          for (int j = 0; j < 8; j++)
#pragma unroll
            for (int i = 0; i < 3; i++) {
              float a = 0.f;
#pragma unroll
              for (int tp = 0; tp < 7; tp++) a += raw[j + tp][i] * cw[i][tp];
              ST[j * 256 + lane + 64 * i] = siluf(a);
            }
          if (lane < 8) {
            const u16* pp = Pseg + (size_t)(t0 + lane) * PST + PB;
            float bx = bf2f(pp[768 + dir * 4 + h]);
            float ax = bf2f(pp[776 + dir * 4 + h]);
            float ld = -__expf(p.gdn_a_log[(l * 2 + dir) * 4 + h]) * softplusf(ax + p.gdn_dt_bias[(l * 2 + dir) * 4 + h]);
            ST[lane * 256 + 192] = sigm(bx);
            ST[lane * 256 + 193] = __expf(ld);
          }
        } else {
          u16 raw[8][3];
#pragma unroll
          for (int j = 0; j < 8; j++) {
            const u16* pp = Pseg + (size_t)(t0 + j) * PST;
#pragma unroll
            for (int i = 0; i < 3; i++) raw[j][i] = pp[colv[i]];
          }
          const float qs = lane < 32 ? 0.17677669529663687f : 1.f;
#pragma unroll
          for (int j = 0; j < 8; j++) {
            ST[j * 256 + lane] = bf2f(raw[j][0]) * qs;
            ST[j * 256 + 64 + lane] = bf2f(raw[j][1]);
            if (lane < 16) ST[j * 256 + 128 + lane] = bf2f(raw[j][2]);
          }
        }
        wave_lds_sync();
        const bool vl = fq < 2;
        if (MIX == 0) {
          bf16x8 aw, aa;
#pragma unroll
          for (int jj = 0; jj < 8; jj++) {
            aw[jj] = fr < 8 ? (short)f2bf(ST[fr * 256 + 192 + fq * 8 + jj]) : (short)0;
            aa[jj] = fr < 8 ? (short)f2bf(ST[fr * 256 + 224 + fq * 8 + jj]) : (short)0;
          }
          f32x4 accw[4], acca[4];
#pragma unroll
          for (int nt = 0; nt < 4; nt++) {
            accw[nt] = __builtin_amdgcn_mfma_f32_16x16x32_bf16(aw, bw2[nt], f32x4{0.f, 0.f, 0.f, 0.f}, 0, 0, 0);
            acca[nt] = __builtin_amdgcn_mfma_f32_16x16x32_bf16(aa, ba2[nt], f32x4{0.f, 0.f, 0.f, 0.f}, 0, 0, 0);
          }
#pragma unroll
          for (int r = 0; r < 4; r++) {
            const int j = (fq & 1) * 4 + r, tt = pw * 8 + j;
            float kkx[4], av[4], kdv[4], rv[4], dec[4];
            float ss = 0.f;
#pragma unroll
            for (int nt = 0; nt < 4; nt++) {
              const int n = nt * 16 + fr;
              rv[nt] = ST[j * 256 + n];
              const float kx = ST[j * 256 + 64 + n];
              dec[nt] = __expf(-0.6065306597126334f * sigm(cst[0][nt] + accw[nt][r]));
              av[nt] = sigm(cst[1][nt] + acca[nt][r]);
              kdv[nt] = kx * (1.f + (av[nt] - 1.f) * cst[2][nt]);
              kkx[nt] = kx * cst[3][nt];
              ss += kkx[nt] * kkx[nt];
            }
            ss = red16(ss);
            const float rs = rsq(ss + 1e-6f);
            float c1 = 0.f, c2 = 0.f, bc = 0.f;
#pragma unroll
            for (int nt = 0; nt < 4; nt++) {
              const int n = nt * 16 + fr;
              const float kk = kkx[nt] * rs;
              if (vl) {
                B[S2_D + tt * 64 + n] = dec[nt];
                B[S2_U + tt * 64 + n] = kk;
                B[S2_P + tt * 64 + n] = -kk * av[nt];
                B[S2_K + tt * 64 + n] = kdv[nt];
                B[S2_DQ + tt * 64 + n] = dec[nt] * rv[nt];
              }
              c1 += -kk * av[nt] * rv[nt];
              c2 += kdv[nt] * rv[nt];
              bc += rv[nt] * kdv[nt] * cst[4][nt];
            }
            c1 = red16(c1); c2 = red16(c2); bc = red16(bc);
            if (vl && fr == 0) {
              B[S2_C1 + tt] = c1;
              B[S2_C2 + tt] = c2;
              if (rq == 0) BC[(size_t)(seg_row0 + t_lo + tt) * 8 + h * 2 + dir] = bc;
            }
          }
        } else if (MIX == 1) {
#pragma unroll
          for (int r = 0; r < 4; r++) {
            const int j = (fq & 1) * 4 + r, tt = pw * 8 + j;
            float qv[4], kv[4];
            float sq = 0.f, sk = 0.f;
#pragma unroll
            for (int nt = 0; nt < 4; nt++) {
              const int n = nt * 16 + fr;
              qv[nt] = ST[j * 256 + n];
              kv[nt] = ST[j * 256 + 64 + n];
              sq += qv[nt] * qv[nt];
              sk += kv[nt] * kv[nt];
            }
            sq = red16(sq); sk = red16(sk);
            const float rq_ = rsq(sq + 1e-6f) * 0.125f, rk_ = rsq(sk + 1e-6f);
            const float beta = ST[j * 256 + 192], alpha = ST[j * 256 + 193];
            float dkq = 0.f;
#pragma unroll
            for (int nt = 0; nt < 4; nt++) {
              const int n = nt * 16 + fr;
              const float qn = qv[nt] * rq_, kn = kv[nt] * rk_;
              if (vl) {
                B[S2_D + tt * 64 + n] = alpha;
                B[S2_U + tt * 64 + n] = kn;
                B[S2_P + tt * 64 + n] = -alpha * beta * kn;
                B[S2_K + tt * 64 + n] = beta * kn;
                B[S2_DQ + tt * 64 + n] = alpha * qn;
              }
              dkq += kn * qn;
            }
            dkq = red16(dkq);
            if (vl && fr == 0) {
              B[S2_C1 + tt] = -alpha * beta * dkq;
              B[S2_C2 + tt] = beta * dkq;
            }
          }
        } else {
          bf16x8 ag;
#pragma unroll
          for (int jj = 0; jj < 8; jj++) ag[jj] = (fr < 8 && fq < 2) ? (short)f2bf(ST[fr * 256 + 128 + fq * 8 + jj]) : (short)0;
          f32x4 accg[2];
#pragma unroll
          for (int nt = 0; nt < 2; nt++) accg[nt] = __builtin_amdgcn_mfma_f32_16x16x32_bf16(ag, bw2[nt], f32x4{0.f, 0.f, 0.f, 0.f}, 0, 0, 0);
#pragma unroll
          for (int r = 0; r < 4; r++) {
            const int j = (fq & 1) * 4 + r, tt = pw * 8 + j;
            float dkq = 0.f;
#pragma unroll
            for (int nt = 0; nt < 2; nt++) {
              const int n = nt * 16 + fr;
              const float lg = cst[0][nt] + accg[nt][r];
              const float ls = fminf(lg, 0.f) - __logf(1.f + __expf(-fabsf(lg)));
              const float alpha = __expf(ls * (1.f / 16.f));
              const float qv = ST[j * 256 + n], kv = ST[j * 256 + 32 + n];
              if (vl) {
                B[S2_D + tt * 64 + n] = alpha;
                B[S2_K + tt * 64 + n] = kv;
                B[S2_DQ + tt * 64 + n] = alpha * qv;
              }
              dkq += kv * qv;
            }
            dkq = red16(dkq);
            if (vl && fr == 0) B[S2_C2 + tt] = dkq;
          }
        }
#pragma unroll
        for (int i = 0; i < 2; i++) {
          const int idx = lane + 64 * i, j = idx >> 4, e = idx & 15;
          B[S2_V + (pw * 8 + j) * 16 + e] = ST[j * 256 + VOFF + rq * 16 + e];
        }
      }
    } else if (c >= 1 && c <= TPB / 32) {
      const float* B = sm + ((c - 1) & 1) * S2_BUF;
      float* yb = sm + S2_YB + ((c - 1) & 1) * 512;
      const int rl = w * 4 + fq;
      const int dtt = dir ? -1 : 1;
      int tt = dir ? 31 : 0;
      float dv[EPL], kv[EPL], qv[EPL], uv[EPL], pv[EPL], vv, c1v, c2v;
      float dn[EPL], kn[EPL], qn[EPL], un[EPL], pn[EPL], vn, c1n, c2n;
#define S2_LOAD(D_, K_, Q_, U_, P_, V_, C1_, C2_, T_)                                   \
  do {                                                                                  \
    const int o_ = (T_) * 64 + fr * EPL;                                                \
    if (EPL == 4) {                                                                     \
      float4 t4 = *(const float4*)(B + S2_D + o_);                                      \
      D_[0] = t4.x; D_[1] = t4.y; D_[2] = t4.z; D_[3] = t4.w;                           \
      t4 = *(const float4*)(B + S2_K + o_);                                             \
      K_[0] = t4.x; K_[1] = t4.y; K_[2] = t4.z; K_[3] = t4.w;                           \
      t4 = *(const float4*)(B + S2_DQ + o_);                                            \
      Q_[0] = t4.x; Q_[1] = t4.y; Q_[2] = t4.z; Q_[3] = t4.w;                           \
      t4 = *(const float4*)(B + S2_U + o_);                                             \
      U_[0] = t4.x; U_[1] = t4.y; U_[2] = t4.z; U_[3] = t4.w;                           \
      t4 = *(const float4*)(B + S2_P + o_);                                             \
      P_[0] = t4.x; P_[1] = t4.y; P_[2] = t4.z; P_[3] = t4.w;                           \
      C1_ = B[S2_C1 + (T_)];                                                            \
    } else {                                                                            \
      float2 t2 = *(const float2*)(B + S2_D + o_);                                      \
      D_[0] = t2.x; D_[1] = t2.y;                                                       \
      t2 = *(const float2*)(B + S2_K + o_);                                             \
      K_[0] = t2.x; K_[1] = t2.y;                                                       \
      t2 = *(const float2*)(B + S2_DQ + o_);                                            \
      Q_[0] = t2.x; Q_[1] = t2.y;                                                       \
      U_[0] = U_[1] = P_[0] = P_[1] = 0.f; C1_ = 0.f;                                   \
    }                                                                                   \
    V_ = B[S2_V + (T_) * 16 + rl];                                                      \
    C2_ = B[S2_C2 + (T_)];                                                              \
  } while (0)
#define S2_STEP(D_, K_, Q_, U_, P_, V_, C1_, C2_, T_)                                   \
  do {                                                                                  \
    float sq = 0.f, sa = 0.f;                                                           \
    _Pragma("unroll") for (int i = 0; i < EPL; i++) sq += s[i] * Q_[i];                 \
    if (MIX != 2) {                                                                     \
      _Pragma("unroll") for (int i = 0; i < EPL; i++) sa += s[i] * U_[i];               \
      sa = red16(sa);                                                                   \
    }                                                                                   \
    sq = red16(sq);                                                                     \
    float y = sq + V_ * C2_;                                                            \
    if (MIX != 2) y += sa * C1_;                                                        \
    _Pragma("unroll") for (int i = 0; i < EPL; i++) {                                   \
      float t = s[i] * D_[i] + V_ * K_[i];                                              \
      if (MIX != 2) t += sa * P_[i];                                                    \
      s[i] = t;                                                                         \
    }                                                                                   \
    yb[(T_) * 16 + rl] = y;                                                             \
  } while (0)
      S2_LOAD(dv, kv, qv, uv, pv, vv, c1v, c2v, tt);
#pragma unroll 1
      for (int st = 0; st < 32; st += 2) {
        const int t1 = tt + dtt;
        S2_LOAD(dn, kn, qn, un, pn, vn, c1n, c2n, t1);
        S2_STEP(dv, kv, qv, uv, pv, vv, c1v, c2v, tt);
        const int t2 = st + 2 < 32 ? t1 + dtt : t1;
        S2_LOAD(dv, kv, qv, uv, pv, vv, c1v, c2v, t2);
        S2_STEP(dn, kn, qn, un, pn, vn, c1n, c2n, t1);
        tt = t2;
      }
#undef S2_LOAD
#undef S2_STEP
    }
    __syncthreads();
  }
}

#define S3_SUB 12800
#define S3_GM 0
#define S3_KVT 9216
#define S3_QB 10240
#define S3_QV 11392
#define S3_VT 11520
#define S3_WC 12544
#define S3_TB S3_QV
#define S3_QBM (S3_GM + 3072)
#define S3_QKM (S3_GM + 3200)
#define S3_KB (S3_GM + 0)
#define S3_BT (S3_GM + 2048)
#define S3_STB (8 * S3_SUB)
#define S3_END (S3_STB + 4 * 2304)

__device__ __forceinline__ float rlane(float x, int l) { return __int_as_float(__builtin_amdgcn_readlane(__float_as_int(x), l)); }
__device__ __forceinline__ float wave_sum(float x) {
  x = red16(x);
  return (rlane(x, 0) + rlane(x, 16)) + (rlane(x, 32) + rlane(x, 48));
}
__device__ __forceinline__ float clampe(float x) { return fminf(fmaxf(x, -80.f), 80.f); }
__device__ __forceinline__ uint4 pack8(const float (&v)[8]) {
  return make_uint4(pack2(v[0], v[1]), pack2(v[2], v[3]), pack2(v[4], v[5]), pack2(v[6], v[7]));
}
__device__ __forceinline__ bf16x8 ld_frag(const void* p) { return *(const bf16x8*)p; }
__device__ __forceinline__ bf16x8 zfrag() { return bf16x8{0, 0, 0, 0, 0, 0, 0, 0}; }

__device__ __forceinline__ void chunk_geom(int c, int dir, int b, int& seg_row0, int& seg_len, int& t_lo) {
  if (c < 8) { seg_row0 = b * TPB; seg_len = LC; t_lo = dir == 0 ? c * 32 : (LC - 32 - c * 32); }
  else { seg_row0 = b * TPB + LC; seg_len = SEQ; t_lo = dir == 0 ? (c - 8) * 32 : (SEQ - 32 - (c - 8) * 32); }
}
template <int MIX>
__device__ __forceinline__ void fetch_raw(const u16* P, int c, int dir, int b, int h, int pw, int lane, const int (&colv)[4], unsigned (&rawq)[14][2]) {
  int seg_row0, seg_len, t_lo;
  chunk_geom(c, dir, b, seg_row0, seg_len, t_lo);
  const u16* Pseg = P + (size_t)seg_row0 * PST;
  const int t0 = t_lo + pw * 8;
  if (MIX == 0) {
#pragma unroll
    for (int rr = 0; rr < 10; rr++) {
      const int tc = min(max(t0 - 1 + rr, 0), seg_len - 1);
#pragma unroll
      for (int i = 0; i < 2; i++)
        rawq[rr][i] = (unsigned)Pseg[(size_t)tc * PST + PA + colv[2 * i]] | ((unsigned)Pseg[(size_t)tc * PST + PA + colv[2 * i + 1]] << 16);
    }
  } else if (MIX == 1) {
#pragma unroll
    for (int rr = 0; rr < 14; rr++) {
      const int tc = min(max(t0 - 3 + rr, 0), seg_len - 1);
      rawq[rr][0] = (unsigned)Pseg[(size_t)tc * PST + colv[0]] | ((unsigned)Pseg[(size_t)tc * PST + colv[1]] << 16);
      rawq[rr][1] = (rawq[rr][1] & 0xffff0000u) | (unsigned)Pseg[(size_t)tc * PST + colv[2]];
    }
    const u16* pp = Pseg + (size_t)(t0 + (lane & 7)) * PST + PB;
    rawq[0][1] = (rawq[0][1] & 0xffffu) | ((unsigned)pp[768 + dir * 4 + h] << 16);
    rawq[1][1] = (rawq[1][1] & 0xffffu) | ((unsigned)pp[776 + dir * 4 + h] << 16);
  } else {
#pragma unroll
    for (int j = 0; j < 8; j++) {
      const u16* pp = Pseg + (size_t)(t0 + j) * PST;
      rawq[j][0] = (unsigned)pp[colv[0]] | ((unsigned)pp[colv[1]] << 16);
      rawq[j][1] = (unsigned)pp[colv[2]];
    }
  }
}

template <int MIX>
__device__ __forceinline__ void scan3_item(const Params& p, int l, int b, int h, int dir, unsigned char* smb) {
  constexpr int VOFF = (MIX == 2) ? 64 : 128;
  constexpr bool DELTA = (MIX != 2);
  const int tid = TIDX, lane = tid & 63, w = __builtin_amdgcn_readfirstlane(tid >> 6), fr = lane & 15, fq = lane >> 4;
  const bool producer = true;
  const int pw = w & 3, half = w >> 2;
  const u16* P = (const u16*)(p.ws + OFF_BIG);
  u16* YS = (u16*)(p.ws + OFF_YS);
  float* BC = (float*)(p.ws + OFF_BC);
  float* ST = (float*)(smb + w * S3_SUB + S3_GM);
  unsigned char* STBY = smb + w * S3_SUB + S3_GM;
  const f32x4 z4 = f32x4{0.f, 0.f, 0.f, 0.f};
  f32x4 st[4];
#pragma unroll
  for (int i = 0; i < 4; i++) st[i] = z4;

  bf16x8 bw2[4], ba2[4];
  float cw[3][7];
  float muv[4];
  int colv[4];
  float c_w0 = 0.f, c_a0 = 0.f, c_ka = 0.f, c_kk = 0.f, c_rk = 0.f, c_gb = 0.f;
#pragma unroll
  for (int i = 0; i < 4; i++) { bw2[i] = zfrag(); ba2[i] = zfrag(); muv[i] = 0.f; colv[i] = 0; }
  if (producer) {
    if (MIX == 0) {
      {
        float tw[4][8], ta[4][8];
#pragma unroll
        for (int nt = 0; nt < 4; nt++)
#pragma unroll
          for (int jj = 0; jj < 8; jj++) {
            tw[nt][jj] = p.rwkv_w2[((size_t)(l * 2 + dir) * 32 + fq * 8 + jj) * 256 + h * 64 + nt * 16 + fr];
            ta[nt][jj] = p.rwkv_a2[((size_t)(l * 2 + dir) * 32 + fq * 8 + jj) * 256 + h * 64 + nt * 16 + fr];
          }
#pragma unroll
        for (int nt = 0; nt < 4; nt++)
#pragma unroll
          for (int jj = 0; jj < 8; jj++) { bw2[nt][jj] = (short)f2bf(tw[nt][jj]); ba2[nt][jj] = (short)f2bf(ta[nt][jj]); }
      }
      const int jl = h * 64 + lane;
      c_w0 = p.rwkv_w0[(l * 2 + dir) * 256 + jl];
      c_a0 = p.rwkv_a0[(l * 2 + dir) * 256 + jl];
      c_ka = p.rwkv_ka[l * 256 + jl];
      c_kk = p.rwkv_kk[l * 256 + jl];
      c_rk = p.rwkv_rk[l * 256 + jl];
#pragma unroll
      for (int i = 0; i < 4; i++) {
        colv[i] = i < 3 ? i * 256 + h * 64 + lane : (lane < 32 ? 768 + dir * 32 + lane : 832 + dir * 32 + (lane - 32));
        muv[i] = p.rwkv_mu[l * 960 + colv[i]];
      }
    } else if (MIX == 1) {
#pragma unroll
      for (int i = 0; i < 3; i++) {
        colv[i] = PB + i * 256 + h * 64 + lane;
#pragma unroll
        for (int tp = 0; tp < 7; tp++) cw[i][tp] = p.gdn_conv[((size_t)l * 7 + tp) * 768 + i * 256 + h * 64 + lane];
      }
    } else {
      {
        float tg[2][8];
#pragma unroll
        for (int nt = 0; nt < 2; nt++)
#pragma unroll
          for (int jj = 0; jj < 8; jj++) tg[nt][jj] = p.gla_gw2[((size_t)(l * 2 + dir) * 16 + (fq & 1) * 8 + jj) * 128 + h * 32 + nt * 16 + fr];
#pragma unroll
        for (int nt = 0; nt < 2; nt++)
#pragma unroll
          for (int jj = 0; jj < 8; jj++) bw2[nt][jj] = fq < 2 ? (short)f2bf(tg[nt][jj]) : (short)0;
      }
      c_gb = p.gla_gb[(l * 2 + dir) * 128 + h * 32 + (lane & 31)];
      colv[0] = PC + h * 32 + lane;
      if (lane >= 32) colv[0] = PC + 128 + h * 32 + (lane - 32);
      colv[1] = PC + 256 + h * 64 + lane;
      colv[2] = PC + 512 + dir * 16 + (lane & 15);
    }
  }
  __syncthreads();
  unsigned rawq[14][2];
#pragma unroll
  for (int i = 0; i < 14; i++) { rawq[i][0] = 0u; rawq[i][1] = 0u; }
  fetch_raw<MIX>(P, half, dir, b, h, pw, lane, colv, rawq);
#define RAWP(r_, i_) ((u16)((rawq[r_][(i_) >> 1] >> (((i_) & 1) * 16)) & 0xffffu))

  for (int it = 0; it < TPB / 64; it++) {
    {
      {
        const int c = it * 2 + half;
        int seg_row0, seg_len, t_lo;
        chunk_geom(c, dir, b, seg_row0, seg_len, t_lo);
        unsigned char* SB = smb + w * S3_SUB;
        const int t0 = t_lo + pw * 8;
        if (MIX == 0) {
          float raw[10][4];
#pragma unroll
          for (int rr = 0; rr < 10; rr++) {
            const int t = t0 - 1 + rr;
            const float okf = (t >= 0 && t < seg_len) ? 1.f : 0.f;
#pragma unroll
            for (int i = 0; i < 4; i++) raw[rr][i] = bf2f(RAWP(rr, i)) * okf;
          }
#pragma unroll
          for (int j = 0; j < 8; j++)
#pragma unroll
            for (int i = 0; i < 4; i++) {
              float xm = raw[j + 1][i] + (0.5f * (raw[j][i] + raw[j + 2][i]) - raw[j + 1][i]) * muv[i];
              if (i == 3 && lane < 32) xm = tanh_fast(xm);
              ST[j * 256 + lane + 64 * i] = xm;
            }
        } else if (MIX == 1) {
          float raw[14][3];
#pragma unroll
          for (int rr = 0; rr < 14; rr++) {
            const int t = t0 - 3 + rr;
            const float okf = (t >= 0 && t < seg_len) ? 1.f : 0.f;
#pragma unroll
            for (int i = 0; i < 3; i++) raw[rr][i] = bf2f(RAWP(rr, i)) * okf;
          }
#pragma unroll
          for (int j = 0; j < 8; j++)
#pragma unroll
            for (int i = 0; i < 3; i++) {
              float a = 0.f;
#pragma unroll
              for (int tp = 0; tp < 7; tp++) a += raw[j + tp][i] * cw[i][tp];
              ST[j * 256 + lane + 64 * i] = siluf(a);
            }
          if (lane < 8) {
            float bx = bf2f(RAWP(0, 3));
            float ax = bf2f(RAWP(1, 3));
            float ld = -__expf(p.gdn_a_log[(l * 2 + dir) * 4 + h]) * softplusf(ax + p.gdn_dt_bias[(l * 2 + dir) * 4 + h]);
            ST[lane * 256 + 192] = sigm(bx);
            ST[lane * 256 + 193] = ld;
          }
        } else {
          const float qs = lane < 32 ? 0.17677669529663687f : 1.f;
#pragma unroll
          for (int j = 0; j < 8; j++) {
            ST[j * 256 + lane] = bf2f(RAWP(j, 0)) * qs;
            ST[j * 256 + 64 + lane] = bf2f(RAWP(j, 1));
            if (lane < 16) ST[j * 256 + 128 + lane] = bf2f(RAWP(j, 2));
          }
        }
        wave_lds_sync();
        {
          float vv[8];
#pragma unroll
          for (int i = 0; i < 8; i++) vv[i] = ST[(dir ? 7 - i : i) * 256 + VOFF + lane];
          *(uint4*)(SB + S3_VT + lane * 16) = pack8(vv);
        }
        if (MIX == 0) {
          bf16x8 aw, aa;
#pragma unroll
          for (int jj = 0; jj < 8; jj++) {
            aw[jj] = fr < 8 ? (short)f2bf(ST[fr * 256 + 192 + fq * 8 + jj]) : (short)0;
            aa[jj] = fr < 8 ? (short)f2bf(ST[fr * 256 + 224 + fq * 8 + jj]) : (short)0;
          }
          f32x4 accw[4], acca[4];
#pragma unroll
          for (int nt = 0; nt < 4; nt++) {
            accw[nt] = __builtin_amdgcn_mfma_f32_16x16x32_bf16(aw, bw2[nt], z4, 0, 0, 0);
            acca[nt] = __builtin_amdgcn_mfma_f32_16x16x32_bf16(aa, ba2[nt], z4, 0, 0, 0);
          }
          wave_lds_sync();
          if (fq < 2) {
#pragma unroll
            for (int nt = 0; nt < 4; nt++)
#pragma unroll
              for (int r = 0; r < 4; r++) {
                ST[(fq * 4 + r) * 256 + 128 + nt * 16 + fr] = accw[nt][r];
                ST[(fq * 4 + r) * 256 + 192 + nt * 16 + fr] = acca[nt][r];
              }
          }
          wave_lds_sync();
        } else if (MIX == 2) {
          bf16x8 ag;
#pragma unroll
          for (int jj = 0; jj < 8; jj++) ag[jj] = (fr < 8 && fq < 2) ? (short)f2bf(ST[fr * 256 + 128 + fq * 8 + jj]) : (short)0;
          f32x4 accg[2];
#pragma unroll
          for (int nt = 0; nt < 2; nt++) accg[nt] = __builtin_amdgcn_mfma_f32_16x16x32_bf16(ag, bw2[nt], z4, 0, 0, 0);
          if (fq < 2) {
#pragma unroll
            for (int nt = 0; nt < 2; nt++)
#pragma unroll
              for (int r = 0; r < 4; r++) ST[(fq * 4 + r) * 256 + 192 + nt * 16 + fr] = accg[nt][r];
          }
          wave_lds_sync();
        }
        float logd[8], kap[8], bb[8], kp[8], qq[8];
        if (MIX == 0) {
          float a8[8], p1[8], p2[8];
#pragma unroll
          for (int i = 0; i < 8; i++) {
            const float* row = ST + (dir ? 7 - i : i) * 256;
            const float r_ = row[lane], k_ = row[64 + lane];
            const float sg = sigm(c_w0 + row[128 + lane]);
            a8[i] = sigm(c_a0 + row[192 + lane]);
            kp[i] = k_ * (1.f + (a8[i] - 1.f) * c_ka);
            kap[i] = k_ * c_kk;
            qq[i] = r_;
            logd[i] = -0.6065306597126334f * sg;
            p1[i] = kap[i] * kap[i];
            p2[i] = r_ * kp[i] * c_rk;
          }
#pragma unroll
          for (int i = 0; i < 8; i++) { p1[i] = red16(p1[i]); p2[i] = red16(p2[i]); }
#pragma unroll
          for (int i = 0; i < 8; i++) {
            const float ss = (rlane(p1[i], 0) + rlane(p1[i], 16)) + (rlane(p1[i], 32) + rlane(p1[i], 48));
            const float bc = (rlane(p2[i], 0) + rlane(p2[i], 16)) + (rlane(p2[i], 32) + rlane(p2[i], 48));
            kap[i] *= rsq(ss + 1e-6f);
            bb[i] = kap[i] * a8[i];
            if (lane == 0) BC[(size_t)(seg_row0 + t0 + (dir ? 7 - i : i)) * 8 + h * 2 + dir] = bc;
          }
        } else {
#pragma unroll
        for (int i = 0; i < 8; i++) {
          const int j = dir ? 7 - i : i;
          const float* row = ST + j * 256;
          if (MIX == 1) {
            const float q_ = row[lane], k_ = row[64 + lane];
            const float sq = wave_sum(q_ * q_), sk = wave_sum(k_ * k_);
            const float qn = q_ * rsq(sq + 1e-6f) * 0.125f, kn = k_ * rsq(sk + 1e-6f);
            const float beta = row[192], ld = row[193];
            const float alpha = __expf(ld);
            logd[i] = ld;
            kap[i] = kn; bb[i] = alpha * beta * kn; kp[i] = beta * kn; qq[i] = qn;
          } else {
            const int n = lane & 31;
            const float lg = c_gb + row[192 + n];
            const float ls = fminf(lg, 0.f) - __logf(1.f + __expf(-fabsf(lg)));
            logd[i] = ls * (1.f / 16.f);
            kap[i] = 0.f; bb[i] = 0.f;
            kp[i] = lane < 32 ? row[32 + n] : 0.f;
            qq[i] = lane < 32 ? row[n] : 0.f;
          }
        }
        }
        wave_lds_sync();
        float kt[8], qt[8], bck[8], kck[8];
        {
          float L[8];
          float run = 0.f;
#pragma unroll
          for (int i = 0; i < 8; i++) { run += logd[i]; L[i] = run; }
          const float Lr = L[3], L7 = L[7];
          float prevE = __expf(clampe(-Lr)), prevT = 1.f;
          u16* OPA = (u16*)STBY;
#pragma unroll
          for (int i = 0; i < 8; i++) {
            const float eI = __expf(clampe(L[i] - Lr)), eInv = __expf(clampe(Lr - L[i]));
            const float tI = __expf(L[i]), eEnd = __expf(L7 - L[i]);
            if (DELTA) {
              OPA[0 * 576 + i * 72 + lane] = f2bf(kap[i] * prevE);
              OPA[1 * 576 + i * 72 + lane] = f2bf(bb[i] * eInv);
            }
            OPA[2 * 576 + i * 72 + lane] = f2bf(kp[i] * eInv);
            OPA[3 * 576 + i * 72 + lane] = f2bf(qq[i] * eI);
            kt[i] = kap[i] * prevT; qt[i] = qq[i] * tI;
            bck[i] = bb[i] * eEnd; kck[i] = kp[i] * eEnd;
            prevE = eI; prevT = tI;
          }
          *(float*)(SB + S3_WC + lane * 4) = __expf(L7);
        }
        wave_lds_sync();
        f32x4 accA = z4, accBm = z4, accQb = z4, accQk = z4;
        {
          const u16* OPA = (const u16*)STBY;
          const int ro = (fr & 7) * 72 + fq * 8;
#pragma unroll
          for (int ks = 0; ks < 2; ks++) {
            const bf16x8 fk = ld_frag(OPA + 2 * 576 + ro + ks * 32), fqh = ld_frag(OPA + 3 * 576 + ro + ks * 32);
            accQk = __builtin_amdgcn_mfma_f32_16x16x32_bf16(fqh, fk, accQk, 0, 0, 0);
            if (DELTA) {
              const bf16x8 fka = ld_frag(OPA + 0 * 576 + ro + ks * 32), fb = ld_frag(OPA + 1 * 576 + ro + ks * 32);
              accA = __builtin_amdgcn_mfma_f32_16x16x32_bf16(fka, fb, accA, 0, 0, 0);
              accBm = __builtin_amdgcn_mfma_f32_16x16x32_bf16(fka, fk, accBm, 0, 0, 0);
              accQb = __builtin_amdgcn_mfma_f32_16x16x32_bf16(fqh, fb, accQb, 0, 0, 0);
            }
          }
#pragma unroll
          for (int r = 0; r < 4; r++) {
            const int i = fq * 4 + r;
            const bool ok = fq < 2 && fr < 8;
            if (!(ok && fr < i)) { accA[r] = 0.f; accBm[r] = 0.f; }
            if (!(ok && fr <= i)) { accQb[r] = 0.f; accQk[r] = 0.f; }
          }
        }
        *(uint4*)(SB + S3_KVT + lane * 16) = pack8(kck);
#pragma unroll
        for (int i = 0; i < 8; i++) ((u16*)(SB + S3_QB))[i * 72 + lane] = f2bf(qt[i]);
        if (fq < 2 && fr < 8) {
#pragma unroll
          for (int r = 0; r < 4; r++) {
            ((u16*)(SB + S3_QKM))[(fq * 4 + r) * 8 + fr] = f2bf(accQk[r]);
            if (DELTA) ((u16*)(SB + S3_QBM))[(fq * 4 + r) * 8 + fr] = f2bf(accQb[r]);
          }
        }
        if (DELTA) {
          float bmc[8];
#pragma unroll
          for (int m = 0; m < 4; m++) { bmc[m] = accBm[m]; bmc[m + 4] = __shfl(accBm[m], (lane & 15) + 16); }
          float t[8];
#pragma unroll
          for (int i = 0; i < 8; i++) {
            float ti = (lane == i) ? 1.f : 0.f;
#pragma unroll
            for (int m = 0; m < i; m++) ti -= rlane(accA[i & 3], (i >> 2) * 16 + m) * t[m];
            t[i] = ti;
          }
          float kbar[8], TB[8];
#pragma unroll
          for (int i = 0; i < 8; i++) {
            float tb = 0.f, kb = 0.f;
#pragma unroll
            for (int m = 0; m <= i; m++) {
              const float tim = rlane(t[i], m);
              tb += tim * bmc[m];
              kb += tim * kt[m];
            }
            TB[i] = tb; kbar[i] = kb;
          }
#pragma unroll
          for (int i = 0; i < 8; i++) ((u16*)(SB + S3_KB))[i * 72 + lane] = f2bf(-kbar[i]);
          *(uint4*)(SB + S3_BT + lane * 16) = pack8(bck);
          if (lane < 8) {
#pragma unroll
            for (int i = 0; i < 8; i++) ((u16*)(SB + S3_TB))[i * 8 + lane] = f2bf(-TB[i]);
          }
        }
      }
    }
    fetch_raw<MIX>(P, min(it + 1, TPB / 64 - 1) * 2 + half, dir, b, h, pw, lane, colv, rawq);
    __syncthreads();
    if (w < 4) {
      unsigned char* STB = smb + S3_STB + w * 2304;
#pragma unroll
      for (int kk = 0; kk < 8; kk++) {
        const int cc = it * 2 + (kk >> 2), k = kk & 3;
        int seg_row0, t_lo;
        if (cc < 8) { seg_row0 = b * TPB; t_lo = dir == 0 ? cc * 32 : (LC - 32 - cc * 32); }
        else { seg_row0 = b * TPB + LC; t_lo = dir == 0 ? (cc - 8) * 32 : (SEQ - 32 - (cc - 8) * 32); }
        const int sc = dir ? 3 - k : k;
        const unsigned char* SB = smb + ((kk >> 2) * 4 + sc) * S3_SUB;
        const bf16x8 bs0 = __builtin_bit_cast(bf16x8, u32x4v{pack2(st[0][0], st[0][1]), pack2(st[0][2], st[0][3]), pack2(st[1][0], st[1][1]), pack2(st[1][2], st[1][3])});
        const bf16x8 bs1 = __builtin_bit_cast(bf16x8, u32x4v{pack2(st[2][0], st[2][1]), pack2(st[2][2], st[2][3]), pack2(st[3][0], st[3][1]), pack2(st[3][2], st[3][3])});
#define LDP(BASE_, ROW_, KS_) ([&]() -> bf16x8 {                                                                   \
          const uint2 lo_ = *(const uint2*)((BASE_) + ((ROW_) * 72 + (KS_) * 32 + fq * 4) * 2);                      \
          const uint2 hi_ = *(const uint2*)((BASE_) + ((ROW_) * 72 + (KS_) * 32 + 16 + fq * 4) * 2);                 \
          return __builtin_bit_cast(bf16x8, u32x4v{lo_.x, lo_.y, hi_.x, hi_.y}); }())
        const bf16x8 bv = fq == 0 ? ld_frag(SB + S3_VT + (w * 16 + fr) * 16) : zfrag();
        const bf16x8 aq0 = LDP(SB + S3_QB, (fr & 7), 0), aq1 = LDP(SB + S3_QB, (fr & 7), 1);
        const bf16x8 aqk = fq == 0 ? ld_frag(SB + S3_QKM + (fr & 7) * 16) : zfrag();
        bf16x8 brv = zfrag();
        if (DELTA) {
          const bf16x8 ak0 = LDP(SB + S3_KB, (fr & 7), 0), ak1 = LDP(SB + S3_KB, (fr & 7), 1);
          const bf16x8 atb = fq == 0 ? ld_frag(SB + S3_TB + (fr & 7) * 16) : zfrag();
          f32x4 accR = __builtin_amdgcn_mfma_f32_16x16x32_bf16(ak0, bs0, z4, 0, 0, 0);
          accR = __builtin_amdgcn_mfma_f32_16x16x32_bf16(ak1, bs1, accR, 0, 0, 0);
          accR = __builtin_amdgcn_mfma_f32_16x16x32_bf16(atb, bv, accR, 0, 0, 0);
          const uint2 vv2 = *(const uint2*)(SB + S3_VT + (w * 16 + fr) * 16 + (fq & 1) * 8);
          const u32x4v t4 = {pack2(accR[0], accR[1]), pack2(accR[2], accR[3]), vv2.x, vv2.y};
          brv = fq < 2 ? __builtin_bit_cast(bf16x8, t4) : zfrag();
        }
        f32x4 accY = __builtin_amdgcn_mfma_f32_16x16x32_bf16(aq0, bs0, z4, 0, 0, 0);
        accY = __builtin_amdgcn_mfma_f32_16x16x32_bf16(aq1, bs1, accY, 0, 0, 0);
        if (DELTA) {
          const uint2 qb2 = *(const uint2*)(SB + S3_QBM + (fr & 7) * 16 + (fq & 1) * 8);
          const uint2 qk2 = *(const uint2*)(SB + S3_QKM + (fr & 7) * 16 + (fq & 1) * 8);
          const u32x4v q4 = {qb2.x, qb2.y, qk2.x, qk2.y};
          const bf16x8 aqm = fq < 2 ? __builtin_bit_cast(bf16x8, q4) : zfrag();
          accY = __builtin_amdgcn_mfma_f32_16x16x32_bf16(aqm, brv, accY, 0, 0, 0);
        } else {
          accY = __builtin_amdgcn_mfma_f32_16x16x32_bf16(aqk, bv, accY, 0, 0, 0);
        }
        if (fq < 2) {
#pragma unroll
          for (int r = 0; r < 4; r++) {
            const int i = fq * 4 + r, j = dir ? 7 - i : i;
            YS[(size_t)(seg_row0 + t_lo + sc * 8 + j) * YST + dir * 768 + MIX * 256 + h * 64 + w * 16 + fr] = f2bf(accY[r]);
          }
        }
#pragma unroll
        for (int nt = 0; nt < 4; nt++) {
          f32x4 an;
          if (DELTA) {
            const uint2 b2 = *(const uint2*)(SB + S3_BT + (nt * 16 + fr) * 16 + (fq & 1) * 8);
            const uint2 k2 = *(const uint2*)(SB + S3_KVT + (nt * 16 + fr) * 16 + (fq & 1) * 8);
            const u32x4v a4 = {b2.x, b2.y, k2.x, k2.y};
            const bf16x8 am = fq < 2 ? __builtin_bit_cast(bf16x8, a4) : zfrag();
            an = __builtin_amdgcn_mfma_f32_16x16x32_bf16(am, brv, z4, 0, 0, 0);
          } else {
            const bf16x8 akv = fq == 0 ? ld_frag(SB + S3_KVT + (nt * 16 + fr) * 16) : zfrag();
            an = __builtin_amdgcn_mfma_f32_16x16x32_bf16(akv, bv, z4, 0, 0, 0);
          }
          const float4 wc = *(const float4*)(SB + S3_WC + (nt * 16 + fq * 4) * 4);
          st[nt][0] = st[nt][0] * wc.x + an[0];
          st[nt][1] = st[nt][1] * wc.y + an[1];
          st[nt][2] = st[nt][2] * wc.z + an[2];
          st[nt][3] = st[nt][3] * wc.w + an[3];
        }
#undef LDP
      }
    }
    __syncthreads();
  }
}

__device__ __forceinline__ void attn_item(const Params& p, int l, int b, int qb, int hk, bool isctx, unsigned char* smem) {
  u16* KS = (u16*)smem;
  u16* VT = KS + 64 * LDT;
  u16* PL = VT + 64 * LDT;
  float2* ROPE = (float2*)(PL + 8 * 32 * LDT);
  const int tid = TIDX, lane = tid & 63, w = tid >> 6, fr = lane & 15, fq = lane >> 4;
  const u16* P = (const u16*)(p.ws + OFF_BIG);
  u16* Y = (u16*)(p.ws + OFF_YS);
  const int qh = hk * 2 + (w >> 2);
  const int tb = qb * 128 + (w & 3) * 32;
  const int qrow0 = b * TPB + (isctx ? 0 : LC);
  __syncthreads();
  for (int i = tid; i < 1024; i += NTHR) {
    int pos = i >> 4, fi = i & 15;
    float inv = powf(10000.f, -(float)fi / 16.f);
    float sn, cs;
    sincosf((float)pos * inv, &sn, &cs);
    ROPE[i] = make_float2(cs, sn);
  }
  __syncthreads();
  bf16x8 qf[2][2];
#pragma unroll
  for (int mi = 0; mi < 2; mi++)
#pragma unroll
    for (int ks = 0; ks < 2; ks++) {
      const int tq = tb + mi * 16 + fr;
      const u16* qp = P + (size_t)(qrow0 + tq) * PST + PD + qh * 64 + ks * 32;
      uint4 own = *(const uint4*)(qp + fq * 8);
      uint4 par = *(const uint4*)(qp + (fq ^ 2) * 8);
      const unsigned ow[4] = {own.x, own.y, own.z, own.w};
      const unsigned pw[4] = {par.x, par.y, par.z, par.w};
      const int pos = ks == 0 ? (tq >> 6) : (tq & 63);
      bf16x8 f;
#pragma unroll
      for (int jj = 0; jj < 8; jj++) {
        float xo = bf2f((u16)((ow[jj >> 1] >> ((jj & 1) * 16)) & 0xffff));
        float xp = bf2f((u16)((pw[jj >> 1] >> ((jj & 1) * 16)) & 0xffff));
        float v = xo;
        if (!isctx) {
          float2 cs = ROPE[pos * 16 + (fq & 1) * 8 + jj];
          v = fq < 2 ? xo * cs.x - xp * cs.y : xp * cs.y + xo * cs.x;
        }
        f[jj] = (short)f2bf(v * 0.125f);
      }
      qf[mi][ks] = f;
    }
  f32x4 oacc[2][4];
#pragma unroll
  for (int mi = 0; mi < 2; mi++)
#pragma unroll
    for (int nd = 0; nd < 4; nd++) oacc[mi][nd] = f32x4{0.f, 0.f, 0.f, 0.f};
  float mrow[2][4], lrow[2][4];
#pragma unroll
  for (int mi = 0; mi < 2; mi++)
#pragma unroll
    for (int r = 0; r < 4; r++) { mrow[mi][r] = -1e30f; lrow[mi][r] = 0.f; }

  const int q0 = qb * 128;
  const int band_lo = isctx ? 0 : max(0, q0 - 128), band_hi = isctx ? 0 : min(SEQ, q0 + 256);
  const int ntile = 4 + (band_hi - band_lo) / 64;
  u16* pl = PL + w * 32 * LDT;
  for (int tl = 0; tl < ntile; tl++) {
    const bool band = tl >= 4;
    const int k0 = band ? band_lo + (tl - 4) * 64 : tl * 64;
    __syncthreads();
    {
      const int key = tid >> 3, kc = tid & 7;
      const int kpos = k0 + key;
      const u16* kp = P + (size_t)(b * TPB + (band ? LC : 0) + kpos) * PST + PD + 256 + hk * 64;
      uint4 own = *(const uint4*)(kp + kc * 8);
      uint4 vv = *(const uint4*)(kp + 128 + kc * 8);
      uint4 par = *(const uint4*)(kp + (kc ^ 2) * 8);
      if (band) {
        const unsigned ow[4] = {own.x, own.y, own.z, own.w};
        const unsigned pw[4] = {par.x, par.y, par.z, par.w};
        const int pos = kc < 4 ? (kpos >> 6) : (kpos & 63);
        unsigned res[4];
#pragma unroll
        for (int jj = 0; jj < 8; jj += 2) {
          float v2[2];
#pragma unroll
          for (int e = 0; e < 2; e++) {
            float xo = bf2f((u16)((ow[jj >> 1] >> (e * 16)) & 0xffff));
            float xp = bf2f((u16)((pw[jj >> 1] >> (e * 16)) & 0xffff));
            float2 cs = ROPE[pos * 16 + (kc & 1) * 8 + jj + e];
            v2[e] = (kc & 2) == 0 ? xo * cs.x - xp * cs.y : xp * cs.y + xo * cs.x;
          }
          res[jj >> 1] = pack2(v2[0], v2[1]);
        }
        own = make_uint4(res[0], res[1], res[2], res[3]);
      }
      *(uint4*)(KS + key * LDT + kc * 8) = own;
      const unsigned vw[4] = {vv.x, vv.y, vv.z, vv.w};
#pragma unroll
      for (int jj = 0; jj < 8; jj++) VT[(kc * 8 + jj) * LDT + key] = (u16)((vw[jj >> 1] >> ((jj & 1) * 16)) & 0xffff);
    }
    __syncthreads();
    f32x4 sc[2][4];
#pragma unroll
    for (int mi = 0; mi < 2; mi++)
#pragma unroll
      for (int nj = 0; nj < 4; nj++) sc[mi][nj] = f32x4{0.f, 0.f, 0.f, 0.f};
#pragma unroll
    for (int ks = 0; ks < 2; ks++) {
      bf16x8 kf[4];
#pragma unroll
      for (int nj = 0; nj < 4; nj++) kf[nj] = *(const bf16x8*)(KS + (nj * 16 + fr) * LDT + ks * 32 + fq * 8);
#pragma unroll
      for (int mi = 0; mi < 2; mi++)
#pragma unroll
        for (int nj = 0; nj < 4; nj++) sc[mi][nj] = __builtin_amdgcn_mfma_f32_16x16x32_bf16(qf[mi][ks], kf[nj], sc[mi][nj], 0, 0, 0);
    }
#pragma unroll
    for (int mi = 0; mi < 2; mi++)
#pragma unroll
      for (int r = 0; r < 4; r++) {
        const int qpos = tb + mi * 16 + fq * 4 + r;
        float mx = -1e30f;
#pragma unroll
        for (int nj = 0; nj < 4; nj++) {
          float v = sc[mi][nj][r];
          if (band) {
            int d = qpos - (k0 + nj * 16 + fr);
            if (d > 128 || d < -128) v = -1e30f;
          }
          sc[mi][nj][r] = v;
          mx = fmaxf(mx, v);
        }
        mx = fmaxf(mx, __shfl_xor(mx, 1));
        mx = fmaxf(mx, __shfl_xor(mx, 2));
        mx = fmaxf(mx, __shfl_xor(mx, 4));
        mx = fmaxf(mx, __shfl_xor(mx, 8));
        const float mnew = fmaxf(mrow[mi][r], mx);
        const float alpha = __expf(mrow[mi][r] - mnew);
        mrow[mi][r] = mnew;
        float ls = 0.f;
#pragma unroll
        for (int nj = 0; nj < 4; nj++) {
          float pe = __expf(sc[mi][nj][r] - mnew);
          ls += pe;
          pl[(mi * 16 + fq * 4 + r) * LDT + nj * 16 + fr] = f2bf(pe);
        }
        lrow[mi][r] = lrow[mi][r] * alpha + ls;
#pragma unroll
        for (int nd = 0; nd < 4; nd++) oacc[mi][nd][r] *= alpha;
      }
    asm volatile("s_waitcnt lgkmcnt(0)" ::: "memory");
    __builtin_amdgcn_wave_barrier();
#pragma unroll
    for (int ks = 0; ks < 2; ks++) {
      bf16x8 pf[2], vf[4];
#pragma unroll
      for (int mi = 0; mi < 2; mi++) pf[mi] = *(const bf16x8*)(pl + (mi * 16 + fr) * LDT + ks * 32 + fq * 8);
#pragma unroll
      for (int nd = 0; nd < 4; nd++) vf[nd] = *(const bf16x8*)(VT + (nd * 16 + fr) * LDT + ks * 32 + fq * 8);
#pragma unroll
      for (int mi = 0; mi < 2; mi++)
#pragma unroll
        for (int nd = 0; nd < 4; nd++) oacc[mi][nd] = __builtin_amdgcn_mfma_f32_16x16x32_bf16(pf[mi], vf[nd], oacc[mi][nd], 0, 0, 0);
    }
    asm volatile("s_waitcnt lgkmcnt(0)" ::: "memory");
    __builtin_amdgcn_wave_barrier();
  }
  const float sink = p.attn_sink[l * 4 + qh];
#pragma unroll
  for (int mi = 0; mi < 2; mi++)
#pragma unroll
    for (int r = 0; r < 4; r++) {
      float ls = lrow[mi][r];
      ls += __shfl_xor(ls, 1);
      ls += __shfl_xor(ls, 2);
      ls += __shfl_xor(ls, 4);
      ls += __shfl_xor(ls, 8);
      ls += __expf(sink - mrow[mi][r]);
      const float inv = 1.f / ls;
      const int tq = tb + mi * 16 + fq * 4 + r;
#pragma unroll
      for (int nd = 0; nd < 4; nd++) Y[(size_t)(qrow0 + tq) * YST + 1536 + qh * 64 + nd * 16 + fr] = f2bf(oacc[mi][nd][r] * inv);
    }
}

#ifndef SCAN3_MASK
#define SCAN3_MASK 7
#endif
__device__ __forceinline__ void phase_mix(const Params& p, int l, unsigned char* smem) {
  float* sm = (float*)smem;
  const int G = gridDim.x;
  for (int it = blockIdx.x; it < 192; it += G) {
    const int mix = it >> 6, rem = it & 63, b = rem >> 3, h = (rem >> 1) & 3, dir = rem & 1;
    if (mix == 0 && (SCAN3_MASK & 1)) scan3_item<0>(p, l, b, h, dir, smem);
    else if (mix == 1 && (SCAN3_MASK & 2)) scan3_item<1>(p, l, b, h, dir, smem);
    else if (mix == 2 && (SCAN3_MASK & 4)) scan3_item<2>(p, l, b, h, dir, smem);
  }
  if (SCAN3_MASK != 7) {
    for (int it = blockIdx.x; it < 768; it += G) {
      const int mix = it >> 8, rem = it & 255, b = rem >> 5, h = (rem >> 3) & 3, dir = (rem >> 2) & 1, rq = rem & 3;
      if (mix == 0 && !(SCAN3_MASK & 1)) scan2_item<0>(p, l, b, h, dir, rq, sm);
      else if (mix == 1 && !(SCAN3_MASK & 2)) scan2_item<1>(p, l, b, h, dir, rq, sm);
      else if (mix == 2 && !(SCAN3_MASK & 4)) scan2_item<2>(p, l, b, h, dir, rq, sm);
    }
  }
  __syncthreads();
  {
    const bool spread = G >= 192;
    const int nconv = spread ? 64 : G, fidx = spread ? (int)blockIdx.x - 128 : (int)blockIdx.x;
    if (fidx >= 0 && fidx < nconv)
      for (int it = 832 + fidx; it < 4480; it += nconv) conv_item(p, l, it, (float*)smem);
    __syncthreads();
  }
  unsigned* ctr = (unsigned*)(p.ws + OFF_CTR) + l * 16;
  volatile int* slot = (volatile int*)(smem + 131072 - 16);
  for (;;) {
    if (TIDX == 0) *slot = (int)atomicAdd(ctr, 1u);
    __syncthreads();
    const int it = *slot;
    __syncthreads();
    if (it >= (l == 0 ? 544 : 512)) break;
    if (it < 512) {
      int b = it >> 6, qb = (it >> 1) & 31, hk = it & 1;
      attn_item(p, l, b, qb, hk, false, smem);
    } else {
      int r = it - 512, b = r >> 2, qb = (r >> 1) & 1, hk = r & 1;
      attn_item(p, l, b, qb, hk, true, smem);
    }
  }
}

#define POST_DECL(PFX) uint2 PFX##ya0, PFX##ya1, PFX##ya2, PFX##yc0, PFX##yc1, PFX##yc2, PFX##vp, PFX##vc, PFX##vn, PFX##gb, PFX##gc; \
  u16 PFX##xp, PFX##xc, PFX##xn; float2 PFX##bc
#define POST_LOAD(PFX, R_)                                                                         \
  do {                                                                                             \
    const int r_ = (R_);                                                                           \
    const int b_ = r_ / TPB, t_ = r_ - b_ * TPB;                                                   \
    const bool hp_ = (t_ != 0) && (t_ != LC), hn_ = (t_ != LC - 1) && (t_ != TPB - 1);            \
    const u16* ys_ = YSc + (size_t)r_ * YST;                                                       \
    const u16* pr_ = Pc + (size_t)r_ * PST;                                                        \
    const u16* pp_ = pr_ - (hp_ ? PST : 0);                                                        \
    const u16* pn_ = pr_ + (hn_ ? PST : 0);                                                        \
    PFX##ya0 = *(const uint2*)(ys_ + j0); PFX##ya1 = *(const uint2*)(ys_ + 256 + j0); PFX##ya2 = *(const uint2*)(ys_ + 512 + j0); \
    PFX##yc0 = *(const uint2*)(ys_ + 768 + j0); PFX##yc1 = *(const uint2*)(ys_ + 1024 + j0); PFX##yc2 = *(const uint2*)(ys_ + 1280 + j0); \
    PFX##vp = *(const uint2*)(pp_ + PA + 512 + j0);                                                \
    PFX##vc = *(const uint2*)(pr_ + PA + 512 + j0);                                                \
    PFX##vn = *(const uint2*)(pn_ + PA + 512 + j0);                                                \
    PFX##gb = *(const uint2*)(pr_ + PB + 784 + j0);                                                \
    PFX##gc = *(const uint2*)(pr_ + PC + 544 + j0);                                                \
    PFX##xp = pp_[PA + 896 + lane]; PFX##xc = pr_[PA + 896 + lane]; PFX##xn = pn_[PA + 896 + lane]; \
    PFX##bc = *(const float2*)(BCc + (size_t)r_ * 8 + (lane >> 4) * 2);                            \
  } while (0)
__device__ __forceinline__ void unpack4(uint2 v, float (&o)[4]) {
  o[0] = __uint_as_float(v.x << 16); o[1] = __uint_as_float(v.x & 0xffff0000u);
  o[2] = __uint_as_float(v.y << 16); o[3] = __uint_as_float(v.y & 0xffff0000u);
}

__device__ __forceinline__ void phase_post(const Params& p, int l, float* g2s) {
  const int lane = TIDX & 63, wv = __builtin_amdgcn_readfirstlane(TIDX >> 6);
  u16* YS = (u16*)(p.ws + OFF_YS);
  const int j0 = lane * 4;
  {
    const float4* src = (const float4*)(p.rwkv_g2 + (size_t)l * 64 * 256);
    for (int i = TIDX; i < 64 * 256 / 4; i += NTHR) ((float4*)g2s)[i] = src[i];
  }
  float mu_v[4], lng[4], lnb[4], ngb[4], ngc[4];
#pragma unroll
  for (int i = 0; i < 4; i++) {
    mu_v[i] = p.rwkv_mu[l * 960 + 512 + j0 + i];
    lng[i] = p.rwkv_ln_g[l * 256 + j0 + i];
    lnb[i] = p.rwkv_ln_b[l * 256 + j0 + i];
    ngb[i] = p.gdn_norm_g[l * 64 + (lane & 15) * 4 + i];
    ngc[i] = p.gla_norm_g[l * 64 + (lane & 15) * 4 + i];
  }
  const float mu_x = p.rwkv_mu[l * 960 + 896 + lane];
  __syncthreads();
  const int stride = gridDim.x * 8;
  int r = blockIdx.x * 8 + wv;
  const u16* Pc = (const u16*)(p.ws + OFF_BIG);
  const u16* YSc = (const u16*)(p.ws + OFF_YS);
  const float* BCc = (const float*)(p.ws + OFF_BC);
  POST_DECL(cur_);
  POST_DECL(nxt_);
  POST_LOAD(cur_, r);
  for (; r < NROWS; r += stride) {
    const int rn = r + stride < NROWS ? r + stride : r;
    POST_LOAD(nxt_, rn);
    const int b = r / TPB, t = r - b * TPB;
    const float pmul = ((t != 0) && (t != LC)) ? 1.f : 0.f, nmul = ((t != LC - 1) && (t != TPB - 1)) ? 1.f : 0.f;
    if (!(l == 1 && t < LC)) {
    float y[3][4];
    {
      float a4[4], c4[4];
      unpack4(cur_ya0, a4); unpack4(cur_yc0, c4);
#pragma unroll
      for (int i = 0; i < 4; i++) y[0][i] = a4[i] + c4[i];
      unpack4(cur_ya1, a4); unpack4(cur_yc1, c4);
#pragma unroll
      for (int i = 0; i < 4; i++) y[1][i] = a4[i] + c4[i];
      unpack4(cur_ya2, a4); unpack4(cur_yc2, c4);
#pragma unroll
      for (int i = 0; i < 4; i++) y[2][i] = a4[i] + c4[i];
    }
    float o[3][4];
    {
      float sum = y[0][0] + y[0][1] + y[0][2] + y[0][3];
      sum = red16(sum);
      const float mean = sum * (1.f / 64.f);
      float vs = 0.f;
#pragma unroll
      for (int i = 0; i < 4; i++) { float d = y[0][i] - mean; vs += d * d; }
      vs = red16(vs);
      const float rstd = rsq(vs * (1.f / 64.f) + 64e-5f);
      const float pv = bf2f(cur_xc), ppv = bf2f(cur_xp) * pmul, pnv = bf2f(cur_xn) * nmul;
      const float sg = sigm(pv + (0.5f * (ppv + pnv) - pv) * mu_x);
      float gate[4] = {0.f, 0.f, 0.f, 0.f};
      const float* g2 = g2s + j0;
#pragma unroll 8
      for (int i = 0; i < 64; i++) {
        const float si = __int_as_float(__builtin_amdgcn_readlane(__float_as_int(sg), i));
        const float4 gw = *(const float4*)(g2 + i * 256);
        gate[0] += si * gw.x; gate[1] += si * gw.y; gate[2] += si * gw.z; gate[3] += si * gw.w;
      }
      const float bcs = cur_bc.x + cur_bc.y;
      float vc4[4], vp4[4], vn4[4];
      unpack4(cur_vc, vc4); unpack4(cur_vp, vp4); unpack4(cur_vn, vn4);
#pragma unroll
      for (int i = 0; i < 4; i++) {
        const float v = vc4[i] + (0.5f * (vp4[i] * pmul + vn4[i] * nmul) - vc4[i]) * mu_v[i];
        const float yn = (y[0][i] - mean) * rstd * lng[i] + lnb[i];
        o[0][i] = (yn + bcs * v) * gate[i];
      }
    }
#pragma unroll
    for (int m = 1; m < 3; m++) {
      float ss = y[m][0] * y[m][0] + y[m][1] * y[m][1] + y[m][2] * y[m][2] + y[m][3] * y[m][3];
      ss = red16(ss);
      const float inv = rsq(ss * (1.f / 64.f) + 1e-6f);
      float g4[4];
      unpack4(m == 1 ? cur_gb : cur_gc, g4);
#pragma unroll
      for (int i = 0; i < 4; i++) o[m][i] = y[m][i] * inv * (m == 1 ? ngb[i] : ngc[i]) * siluf(g4[i]);
    }
    u16* ys = YS + (size_t)r * YST;
#pragma unroll
    for (int m = 0; m < 3; m++) {
      uint2 ov;
      ov.x = pack2(o[m][0], o[m][1]);
      ov.y = pack2(o[m][2], o[m][3]);
      *(uint2*)(ys + m * 256 + j0) = ov;
    }
    }
    cur_ya0 = nxt_ya0; cur_ya1 = nxt_ya1; cur_ya2 = nxt_ya2; cur_yc0 = nxt_yc0; cur_yc1 = nxt_yc1; cur_yc2 = nxt_yc2;
    cur_vp = nxt_vp; cur_vc = nxt_vc; cur_vn = nxt_vn; cur_gb = nxt_gb; cur_gc = nxt_gc;
    cur_xp = nxt_xp; cur_xc = nxt_xc; cur_xn = nxt_xn; cur_bc = nxt_bc;
  }
}

#define XB_TMO      128
#define XB_XCNT(j)  (256  + 64 * (j))
#define XB_XSUB(j)  (1280 + 64 * (j))
#define XB_XGEN(j)  (2304 + 64 * (j))
#define XB_TOP      3328
#define XB_TOPGEN   3392
#define XCD_BAR_WORDS 3456
#define XB_SPIN_CAP (1u << 18)
#define LAS __attribute__((address_space(3)))

__device__ __forceinline__ unsigned xb_ld(unsigned* p)              { return __hip_atomic_load(p, __ATOMIC_RELAXED, __HIP_MEMORY_SCOPE_AGENT); }
__device__ __forceinline__ unsigned xb_add(unsigned* p, unsigned v) { return __hip_atomic_fetch_add(p, v, __ATOMIC_RELAXED, __HIP_MEMORY_SCOPE_AGENT); }
__device__ __forceinline__ unsigned xb_xcc_id() { return (unsigned)__builtin_amdgcn_s_getreg((3 << 11) | 20) & 0xFu; }
#define XB_SPIN(cond, bar) do { unsigned _sp = 0; while (cond) { __builtin_amdgcn_s_sleep(1); \
    if ((++_sp & 255u) == 0u) { if (xb_ld(&(bar)[XB_TMO])) break; if (_sp > XB_SPIN_CAP) { atomicAdd(&(bar)[XB_TMO], 1u); break; } } } } while (0)

struct XcdBarrier {
    unsigned* bar; unsigned x;
    volatile LAS unsigned* st;
};

__device__ __forceinline__ XcdBarrier xcd_barrier_post(unsigned* bar, volatile LAS unsigned* st) {
    XcdBarrier b; b.bar = bar; b.x = xb_xcc_id(); b.st = st;
    if (threadIdx.x == 0) (void)xb_add(&bar[XB_XCNT(b.x)], 1u);
    return b;
}
__device__ __forceinline__ void xcd_barrier_complete(unsigned* bar, unsigned x, unsigned& nloc, unsigned& nx) {
    const unsigned G = gridDim.x * gridDim.y * gridDim.z;
    unsigned sum, cnt, mine, sp = 0u;
    for (;;) {
        sum = 0u; cnt = 0u; mine = 0u;
#pragma unroll
        for (unsigned j = 0; j < 16; ++j) { const unsigned c = xb_ld(&bar[XB_XCNT(j)]); sum += c; cnt += (c > 0u) ? 1u : 0u; mine = (j == x) ? c : mine; }
        if (sum == G) break;
        __builtin_amdgcn_s_sleep(1);
        if ((++sp & 255u) == 0u) { if (xb_ld(&bar[XB_TMO])) break; if (sp > XB_SPIN_CAP) { atomicAdd(&bar[XB_TMO], 1u); break; } }
    }
    nloc = mine > 0u ? mine : 1u; nx = cnt > 0u ? cnt : 1u;
}

__device__ __forceinline__ void xcd_barrier(const XcdBarrier& b) {
    asm volatile("s_waitcnt vmcnt(0)" ::: "memory");
    __syncthreads();
    if (threadIdx.x == 0) {
        unsigned* bar = b.bar;
        __builtin_amdgcn_s_waitcnt(0);
        unsigned nloc = b.st[0], nx = b.st[1];
        if (nloc == 0u) { xcd_barrier_complete(bar, b.x, nloc, nx); b.st[0] = nloc; b.st[1] = nx; }
        const unsigned old = xb_add(&bar[XB_XSUB(b.x)], 1u);
        const unsigned gen = old / nloc;
        if (old + 1u == (gen + 1u) * nloc) {
            __builtin_amdgcn_fence(__ATOMIC_RELEASE, "agent");
            asm volatile("s_waitcnt vmcnt(0)" ::: "memory");
            const unsigned og = xb_add(&bar[XB_TOP], 1u);
            const unsigned tg = og / nx;
            if (og + 1u == (tg + 1u) * nx) xb_add(&bar[XB_TOPGEN], 1u);
            else XB_SPIN(xb_ld(&bar[XB_TOPGEN]) == tg, bar);
            __builtin_amdgcn_fence(__ATOMIC_ACQUIRE, "agent");
            xb_add(&bar[XB_XGEN(b.x)], 1u);
            asm volatile("s_waitcnt vmcnt(0)" ::: "memory");
        } else {
            XB_SPIN(xb_ld(&bar[XB_XGEN(b.x)]) == gen, bar);
            __builtin_amdgcn_fence(__ATOMIC_ACQUIRE, "agent");
            asm volatile("s_waitcnt vmcnt(0)" ::: "memory");
        }
    }
    __syncthreads();
}

#if defined(SKIPS)
#define EN(k) (SKIPS != (k))
#elif !defined(ONLYS)
#define EN(k) 1
#else
#define EN(k) (ONLYS == (k))
#endif
__device__ __forceinline__ void run_phase(const Params& p, int ph, unsigned char* smem) {
  if (ph == 0) { if (EN(10)) phase_init0(p, (float*)smem); return; }
  if (ph == 1) { if (EN(11)) phase_init1(p); return; }
  int l = 0, s = 10;
  if (ph >= 3) { l = (ph - 3) / 10; s = (ph - 3) - l * 10; }
  unsigned char* wl = p.ws + OFF_W;
  PG8_LAS unsigned char* lds = (PG8_LAS unsigned char*)smem;
  pg8::StaticOrder S;
  if (s == 10 || s == 6 || s == 9) {
    if (EN(5)) rowpass(p, l, s == 10 ? 0 : (s == 6 ? 1 : 2));
    if (s == 9 && l == 0) {
      __syncthreads();
      for (int it = blockIdx.x; it < 832; it += gridDim.x) conv_item(p, 1, it, (float*)smem);
    }
  } else if (s == 0 || s == 3 || s == 5 || s == 8) {
    pg8::Gemm g; EpiBf E;
    g.M = NROWS; E.bias = nullptr; E.act = 0;
    if (s == 0) { g.A = (const u16*)(p.ws + OFF_H); g.lda = DM; g.Bt = (const u16*)(wl + OW_IN); g.K = DM; g.N = PST; E.O = (u16*)(p.ws + OFF_BIG); E.ldc = PST; }
    else if (s == 3) {
      g.A = (const u16*)(p.ws + OFF_H); g.lda = DM; g.Bt = (const u16*)(wl + OW_G); g.K = DM; g.N = 4096;
      E.O = (u16*)(p.ws + OFF_BIG); E.ldc = 4096; E.bias = p.gate_b + (size_t)l * 4096; E.act = 1;
    }
    else if (s == 5) { g.A = (const u16*)(p.ws + OFF_H); g.lda = DM; g.Bt = (const u16*)(wl + OW_O); g.K = DM; g.N = DM; E.O = (u16*)(p.ws + OFF_BIG); E.ldc = DM; }
    else { g.A = (const u16*)(p.ws + OFF_BIG); g.lda = FH; g.Bt = (const u16*)(wl + OW_2); g.K = FH; g.N = DM; E.O = (u16*)(p.ws + OFF_YS); E.ldc = DM; }
    if (l == 1 && s != 0) S.init(NBATCH * SEQ, g.N, gridDim.x, blockIdx.x, 1);
    else S.init(g.M, g.N, gridDim.x, blockIdx.x);
    if (EN(0)) pg8::gemm_phase<EpiBf, pg8::StaticOrder, false>(lds, g, S, E, nullptr);
  } else if (s == 4) {
    if (EN(3)) phase_ypart(p, l, smem);
  } else if (s == 1) {
    if (EN(1)) phase_mix(p, l, smem);
  } else if (s == 2) {
    if (EN(2)) phase_post(p, l, (float*)smem);
  } else {
    pg8::Gemm g; EpiSwiglu E;
    g.M = NROWS; g.N = 2 * FH; g.K = DM; g.lda = DM; g.A = (const u16*)(p.ws + OFF_H); g.Bt = (const u16*)(wl + OW_1);
    E.O = (u16*)(p.ws + OFF_BIG);
    if (l == 1) S.init(NBATCH * SEQ, g.N, gridDim.x, blockIdx.x, 1);
    else S.init(g.M, g.N, gridDim.x, blockIdx.x);
    if (EN(6)) pg8::gemm_phase<EpiSwiglu, pg8::StaticOrder, false>(lds, g, S, E, nullptr);
  }
}

__global__ void __launch_bounds__(NTHR) hybrid_flow_mega(Params p, int ph0, int ph1) {
  __shared__ __attribute__((aligned(16))) unsigned char smem[131072];
  __shared__ __attribute__((aligned(16))) unsigned xbw[4];
  cg::grid_group grid = cg::this_grid();
  XcdBarrier xb;
  xb.bar = (unsigned*)(p.ws + OFF_XBAR); xb.x = 0u; xb.st = (volatile LAS unsigned*)xbw;
  for (int ph = ph0; ph < ph1; ph++) {
    run_phase(p, ph, smem);
#ifdef DUPMASK
    {
      int sidx = ph >= 3 ? (ph - 3) % 10 : 12 + ph;
      if ((DUPMASK >> sidx) & 1) { __syncthreads(); run_phase(p, ph, smem); }
    }
#endif
    if (ph + 1 < ph1) {
      if (ph == ph0) {
        grid.sync();
        if (threadIdx.x < 4) xbw[threadIdx.x] = 0u;
        __syncthreads();
        xb = xcd_barrier_post((unsigned*)(p.ws + OFF_XBAR), (volatile LAS unsigned*)xbw);
      } else {
        xcd_barrier(xb);
      }
    }
  }
  if (ph1 - ph0 > 2 && threadIdx.x == 0 && xb_ld(&xb.bar[XB_TMO]) != 0u) p.out[blockIdx.x] = __int_as_float(0x7fc00000);
}

extern "C" void kernel_launch(void* const* d_in, const int* in_sizes, int n_in, void* d_out, int out_size, void* d_ws,
                              size_t ws_size, hipStream_t stream) {
  Params p{};
  const float** pp = (const float**)&p;
  for (int i = 0; i < 32; i++) pp[i] = (const float*)d_in[i];
  p.out = (float*)d_out;
  p.ws = (unsigned char*)d_ws;
  static int grid_blocks = 0;
  if (!grid_blocks) {
    int dev = 0, cus = 0, per_cu = 0;
    hipGetDevice(&dev);
    hipDeviceGetAttribute(&cus, hipDeviceAttributeMultiprocessorCount, dev);
    hipOccupancyMaxActiveBlocksPerMultiprocessor(&per_cu, hybrid_flow_mega, NTHR, 0);
    if (per_cu < 1) per_cu = 1;
    grid_blocks = cus * per_cu;
  }
#ifdef MULTI_LAUNCH
  for (int ph = 0; ph < NPHASE; ph++) {
    hipLaunchKernelGGL(hybrid_flow_mega, dim3(grid_blocks), dim3(NTHR), 0, stream, p, ph, ph + 1);
  }
#else
  int ph0 = 0, ph1 = NPHASE;
  void* args[] = {&p, &ph0, &ph1};
  hipError_t e = hipLaunchCooperativeKernel((void*)hybrid_flow_mega, dim3(grid_blocks), dim3(NTHR), args, 0, stream);
  if (e != hipSuccess) fprintf(stderr, "cooperative launch failed: %s (grid %d)\n", hipGetErrorString(e), grid_blocks);
#endif
}
```

```cpp
#include <hip/hip_runtime.h>
#include <hip/hip_cooperative_groups.h>
#include <cstdio>
namespace cg = cooperative_groups;

typedef unsigned short u16;
using bf16x8 = __attribute__((ext_vector_type(8))) short;
using f32x4 = __attribute__((ext_vector_type(4))) float;

#define DM 1024
#define NBATCH 8
#define SEQ 4096
#define LC 256
#define TPB 4352
#define NROWS 34816
#define PST 3328
#define YST 1792
#define FH 2816
#define INW 7408
#define NTHR 512
#define PA 0
#define PB 960
#define PC 2000
#define PD 2800
#define NPHASE 23
#define SCAN3_MASK 7

struct Params {
  const float *x, *c, *ctx, *c_ctx, *ada_w, *ada_b, *norm_g, *w_in, *gate_b, *w_branch, *w_out,
      *rwkv_mu, *rwkv_w0, *rwkv_w2, *rwkv_a0, *rwkv_a2, *rwkv_g2, *rwkv_kk, *rwkv_ka, *rwkv_rk, *rwkv_ln_g,
      *rwkv_ln_b, *gdn_conv, *gdn_a_log, *gdn_dt_bias, *gdn_norm_g, *gla_gw2, *gla_gb, *gla_norm_g, *attn_sink,
      *ffn_w1, *ffn_w2;
  float* out;
  unsigned char* ws;
};

constexpr size_t SZ_WL = 36700160;
constexpr size_t OW_IN = 0;
constexpr size_t OW_G = OW_IN + (size_t)PST * 1024 * 2;
constexpr size_t OW_B = OW_G + (size_t)4096 * 1024 * 2;
constexpr size_t OW_O = OW_B + (size_t)4 * 1024 * 256 * 2;
constexpr size_t OW_1 = OW_O + (size_t)1024 * 1024 * 2;
constexpr size_t OW_2 = OW_1 + (size_t)5632 * 1024 * 2;
static_assert(OW_2 + (size_t)1024 * FH * 2 == SZ_WL, "weights size");
constexpr size_t SZ_ACT = (size_t)NROWS * DM * 2;
constexpr size_t OFF_W = 0;
constexpr size_t OFF_XC = OFF_W + SZ_WL;
constexpr size_t OFF_MODP = OFF_XC + (size_t)NBATCH * LC * DM * 4;
constexpr size_t OFF_MOD = OFF_MODP + (size_t)2 * 8 * 9 * 6144 * 4;
constexpr size_t OFF_BC = OFF_MOD + (size_t)2 * 9 * 6144 * 4;
constexpr size_t OFF_H = OFF_BC + (size_t)NROWS * 8 * 4;
constexpr size_t OFF_YS = OFF_H + SZ_ACT;
constexpr size_t OFF_BIG = OFF_YS + (size_t)NROWS * YST * 2;
constexpr size_t OFF_CTR = OFF_BIG + (size_t)NROWS * 4096 * 2;
constexpr size_t OFF_XBAR = OFF_CTR + 256;
constexpr size_t WS_END = OFF_XBAR + 3456 * 4;
static_assert(WS_END <= (size_t)536870912, "ws too large");

__device__ __forceinline__ int launder_tid() { int t = threadIdx.x; asm volatile("" : "+v"(t)); return t; }
#define TIDX (launder_tid())
typedef float f32x2_t __attribute__((ext_vector_type(2)));
typedef __bf16 bf16x2_t __attribute__((ext_vector_type(2)));
__device__ __forceinline__ unsigned pack2(float a, float b) {
  const f32x2_t v = {a, b};
  const bf16x2_t r = __builtin_convertvector(v, bf16x2_t);
  return __builtin_bit_cast(unsigned, r);
}
__device__ __forceinline__ u16 f2bf(float f) { return (u16)(pack2(f, 0.f) & 0xffffu); }
__device__ __forceinline__ float bf2f(u16 h) { return __uint_as_float(((unsigned)h) << 16); }
__device__ __forceinline__ float sigm(float x) { return __builtin_amdgcn_rcpf(1.f + __expf(-x)); }
__device__ __forceinline__ float siluf(float x) { return x * __builtin_amdgcn_rcpf(1.f + __expf(-x)); }
__device__ __forceinline__ float rsq(float x) { return __builtin_amdgcn_rsqf(x); }
__device__ __forceinline__ float softplusf(float x) { return fmaxf(x, 0.f) + __logf(1.f + __expf(-fabsf(x))); }
__device__ __forceinline__ float tanh_fast(float x) { return 1.f - 2.f * __builtin_amdgcn_rcpf(1.f + __expf(2.f * x)); }
__device__ __forceinline__ float wsum(float v) {
#pragma unroll
  for (int o = 32; o > 0; o >>= 1) v += __shfl_xor(v, o);
  return v;
}
template <int CTRL>
__device__ __forceinline__ float dppf(float x) {
  return __int_as_float(__builtin_amdgcn_update_dpp(__float_as_int(x), __float_as_int(x), CTRL, 0xf, 0xf, false));
}
__device__ __forceinline__ float red8(float x) {
  x += dppf<0xB1>(x);
  x += dppf<0x4E>(x);
  x += dppf<0x141>(x);
  return x;
}
__device__ __forceinline__ const float* xin_row(const Params& p, int r) {
  int b = r / TPB, t = r - b * TPB;
  return t < LC ? p.ctx + ((size_t)(b * LC + t)) * DM : p.x + ((size_t)(b * SEQ + t - LC)) * DM;
}
__device__ __forceinline__ float* x_row(const Params& p, int r) {
  int b = r / TPB, t = r - b * TPB;
  return t < LC ? (float*)(p.ws + OFF_XC) + ((size_t)(b * LC + t)) * DM : p.out + ((size_t)(b * SEQ + t - LC)) * DM;
}
__device__ __forceinline__ int mod_row(int r) {
  int b = r / TPB, t = r - b * TPB;
  return t < LC ? 8 : b;
}

struct MapId { int lim, off; __device__ int operator()(int n) const { return n < lim ? n + off : -1; } };
struct MapW1 { __device__ int operator()(int n) const { int q = n >> 3, s = n & 7; return s < 4 ? q * 4 + s : FH + q * 4 + (s - 4); } };

template <class Map>
__device__ __forceinline__ void conv_tile(const float* __restrict__ src, int ld, u16* __restrict__ dst, int K, int n0,
                                          int k0, Map map, float* tile) {
  const int tid = TIDX;
  const int nn = tid & 63, kr = tid >> 6;
  const int sc = map(n0 + nn);
  float tv[8];
  const int scc = sc >= 0 ? sc : 0;
  const float scm = sc >= 0 ? 1.f : 0.f;
#pragma unroll
  for (int ps = 0; ps < 8; ps++) tv[ps] = src[(size_t)(k0 + ps * 8 + kr) * ld + scc];
#pragma unroll
  for (int ps = 0; ps < 8; ps++) tile[(ps * 8 + kr) * 65 + nn] = tv[ps] * scm;
  __syncthreads();
  const int n2 = tid >> 3, kc = tid & 7;
  uint4 o;
  o.x = pack2(tile[(kc * 8 + 0) * 65 + n2], tile[(kc * 8 + 1) * 65 + n2]);
  o.y = pack2(tile[(kc * 8 + 2) * 65 + n2], tile[(kc * 8 + 3) * 65 + n2]);
  o.z = pack2(tile[(kc * 8 + 4) * 65 + n2], tile[(kc * 8 + 5) * 65 + n2]);
  o.w = pack2(tile[(kc * 8 + 6) * 65 + n2], tile[(kc * 8 + 7) * 65 + n2]);
  *(uint4*)(dst + (size_t)(n0 + n2) * K + k0 + kc * 8) = o;
  __syncthreads();
}

__device__ __forceinline__ void conv_item(const Params& p, int l, int rem, float* sm) {
      u16* wl = (u16*)(p.ws + OFF_W);
      if (rem < 832) {
        int nt = rem >> 4, kt = rem & 15;
        conv_tile(p.w_in + (size_t)l * DM * INW, INW, (u16*)((char*)wl + OW_IN), 1024, nt * 64, kt * 64, MapId{3312, 0}, sm);
      } else if (rem < 832 + 1024) {
        rem -= 832;
        int nt = rem >> 4, kt = rem & 15;
        conv_tile(p.w_in + (size_t)l * DM * INW, INW, (u16*)((char*)wl + OW_G), 1024, nt * 64, kt * 64, MapId{4096, 3312}, sm);
      } else if (rem < 1856 + 256) {
        rem -= 1856;
        int br = rem >> 6, r2 = rem & 63, nt = r2 >> 2, kt = r2 & 3;
        conv_tile(p.w_branch + ((size_t)(l * 4 + br)) * 256 * DM, DM, (u16*)((char*)wl + OW_B) + (size_t)br * 1024 * 256, 256,
                  nt * 64, kt * 64, MapId{1024, 0}, sm);
      } else if (rem < 2112 + 256) {
        rem -= 2112;
        int nt = rem >> 4, kt = rem & 15;
        conv_tile(p.w_out + (size_t)l * DM * DM, DM, (u16*)((char*)wl + OW_O), 1024, nt * 64, kt * 64, MapId{1024, 0}, sm);
      } else if (rem < 2368 + 1408) {
        rem -= 2368;
        int nt = rem >> 4, kt = rem & 15;
        conv_tile(p.ffn_w1 + (size_t)l * DM * 5632, 5632, (u16*)((char*)wl + OW_1), 1024, nt * 64, kt * 64, MapW1{}, sm);
      } else {
        rem -= 3776;
        int nt = rem / 44, kt = rem - nt * 44;
        conv_tile(p.ffn_w2 + (size_t)l * FH * DM, DM, (u16*)((char*)wl + OW_2), FH, nt * 64, kt * 64, MapId{1024, 0}, sm);
      }
}

__device__ __forceinline__ void phase_init0(const Params& p, float* sm) {
  const int tid = TIDX;
  if (blockIdx.x == 0) {
    if (tid < 64) ((unsigned*)(p.ws + OFF_CTR))[tid] = 0u;
    for (int i = tid; i < 3456; i += NTHR) ((unsigned*)(p.ws + OFF_XBAR))[i] = 0u;
  }
  constexpr int NMOD = 192, NCONV = 832;
  for (int it = blockIdx.x; it < NMOD + NCONV; it += gridDim.x) {
    if (it < NMOD) {
      int l = it / 96, rem = it - l * 96, cc = rem >> 3, ks = rem & 7;
      for (int i = tid; i < 9 * 128; i += NTHR) {
        int r = i >> 7, k = i & 127;
        float v = r < 8 ? p.c[r * DM + ks * 128 + k] : p.c_ctx[ks * 128 + k];
        sm[i] = siluf(v);
      }
      __syncthreads();
      const int n = cc * 512 + tid;
      const float* w = p.ada_w + ((size_t)l * DM + ks * 128) * 6144 + n;
      float acc[9];
#pragma unroll
      for (int r = 0; r < 9; r++) acc[r] = 0.f;
#pragma unroll 1
      for (int k0 = 0; k0 < 128; k0 += 16) {
        float wv[16];
#pragma unroll
        for (int kk = 0; kk < 16; kk++) wv[kk] = w[(size_t)(k0 + kk) * 6144];
#pragma unroll
        for (int kk = 0; kk < 16; kk++)
#pragma unroll
          for (int r = 0; r < 9; r++) acc[r] += sm[r * 128 + k0 + kk] * wv[kk];
      }
      float* mp = (float*)(p.ws + OFF_MODP) + ((size_t)(l * 8 + ks) * 9) * 6144 + n;
#pragma unroll
      for (int r = 0; r < 9; r++) mp[(size_t)r * 6144] = acc[r];
      __syncthreads();
    } else {
      conv_item(p, 0, it - NMOD, sm);
    }
  }
}

__device__ __forceinline__ void phase_init1(const Params& p) {
  const float* mp = (const float*)(p.ws + OFF_MODP);
  float* mo = (float*)(p.ws + OFF_MOD);
  for (int i = blockIdx.x * NTHR + TIDX; i < 2 * 9 * 6144; i += gridDim.x * NTHR) {
    int l = i / (9 * 6144), rem = i - l * 9 * 6144, r = rem / 6144, n = rem - r * 6144;
    float s = p.ada_b[l * 6144 + n];
#pragma unroll
    for (int ks = 0; ks < 8; ks++) s += mp[((size_t)((l * 8 + ks) * 9 + r)) * 6144 + n];
    mo[i] = s;
  }
}

__device__ __forceinline__ void rowpass(const Params& p, int l, int mode) {
  const int lane = TIDX & 63, wv = __builtin_amdgcn_readfirstlane(TIDX >> 6);
  const float* MOD = (const float*)(p.ws + OFF_MOD);
  u16* H = (u16*)(p.ws + OFF_H);
  const bool do_norm = !(mode == 2 && l == 1);
  const int ln = (mode == 2) ? (l == 1 ? l : l + 1) : l;
  const int ni = (mode == 1) ? 2 : 0, sho = (mode == 1) ? 3072 : 0, sco = (mode == 1) ? 4096 : 1024;
  for (int r = blockIdx.x * 8 + wv; r < NROWS; r += gridDim.x * 8) {
    const int mr = mod_row(r);
    if (l == 1 && mode != 0 && mr == 8) continue;
    const float* modl = MOD + ((size_t)(l * 9 + mr)) * 6144;
    const float* modn = MOD + ((size_t)(ln * 9 + mr)) * 6144;
    const float* ng2 = p.norm_g + (size_t)(ln * 4 + ni) * DM;
    const float* xs = (mode == 0 || (mode == 1 && l == 0)) ? xin_row(p, r) : (const float*)x_row(p, r);
    float4 xo[4], n2[4], sc4[4], sh4[4];
#pragma unroll
    for (int i = 0; i < 4; i++) {
      const int col = i * 256 + lane * 4;
      xo[i] = *(const float4*)(xs + col);
      n2[i] = *(const float4*)(ng2 + col);
      sc4[i] = *(const float4*)(modn + sco + col);
      sh4[i] = *(const float4*)(modn + sho + col);
    }
    float xv[16];
    if (mode == 0) {
#pragma unroll
      for (int i = 0; i < 4; i++) { xv[i * 4 + 0] = xo[i].x; xv[i * 4 + 1] = xo[i].y; xv[i * 4 + 2] = xo[i].z; xv[i * 4 + 3] = xo[i].w; }
    } else {
      const u16* src = (const u16*)(p.ws + (mode == 1 ? OFF_BIG : OFF_YS)) + (size_t)r * DM;
      const float* ng = p.norm_g + (size_t)(l * 4 + (mode == 1 ? 1 : 3)) * DM;
      const float* gt = modl + (mode == 1 ? 2048 : 5120);
      uint2 sv[4];
      float4 g4[4], n4[4];
#pragma unroll
      for (int i = 0; i < 4; i++) {
        const int col = i * 256 + lane * 4;
        sv[i] = *(const uint2*)(src + col);
        g4[i] = *(const float4*)(gt + col);
        n4[i] = *(const float4*)(ng + col);
      }
      float ov[16];
      float ss = 0.f;
#pragma unroll
      for (int i = 0; i < 4; i++) {
        ov[i * 4 + 0] = __uint_as_float(sv[i].x << 16); ov[i * 4 + 1] = __uint_as_float(sv[i].x & 0xffff0000u);
        ov[i * 4 + 2] = __uint_as_float(sv[i].y << 16); ov[i * 4 + 3] = __uint_as_float(sv[i].y & 0xffff0000u);
      }
#pragma unroll
      for (int i = 0; i < 16; i++) ss += ov[i] * ov[i];
      ss = wsum(ss);
      const float inv = rsq(ss * (1.f / 1024.f) + 1e-6f);
      float* xd = x_row(p, r);
#pragma unroll
      for (int i = 0; i < 4; i++) {
        xv[i * 4 + 0] = xo[i].x + g4[i].x * (ov[i * 4 + 0] * inv * n4[i].x);
        xv[i * 4 + 1] = xo[i].y + g4[i].y * (ov[i * 4 + 1] * inv * n4[i].y);
        xv[i * 4 + 2] = xo[i].z + g4[i].z * (ov[i * 4 + 2] * inv * n4[i].z);
        xv[i * 4 + 3] = xo[i].w + g4[i].w * (ov[i * 4 + 3] * inv * n4[i].w);
      }
#pragma unroll
      for (int i = 0; i < 4; i++)
        *(float4*)(xd + i * 256 + lane * 4) = make_float4(xv[i * 4 + 0], xv[i * 4 + 1], xv[i * 4 + 2], xv[i * 4 + 3]);
    }
    if (!do_norm) continue;
    float ss2 = 0.f;
#pragma unroll
    for (int i = 0; i < 16; i++) ss2 += xv[i] * xv[i];
    ss2 = wsum(ss2);
    const float inv2 = rsq(ss2 * (1.f / 1024.f) + 1e-6f);
#pragma unroll
    for (int i = 0; i < 4; i++) {
      const int col = i * 256 + lane * 4;
      float h0 = xv[i * 4 + 0] * inv2 * n2[i].x * (1.f + sc4[i].x) + sh4[i].x;
      float h1 = xv[i * 4 + 1] * inv2 * n2[i].y * (1.f + sc4[i].y) + sh4[i].y;
      float h2 = xv[i * 4 + 2] * inv2 * n2[i].z * (1.f + sc4[i].z) + sh4[i].z;
      float h3 = xv[i * 4 + 3] * inv2 * n2[i].w * (1.f + sc4[i].w) + sh4[i].w;
      uint2 o;
      o.x = pack2(h0, h1);
      o.y = pack2(h2, h3);
      *(uint2*)(H + (size_t)r * DM + col) = o;
    }
  }
}

#define LDT 72
namespace pg8 {
#define PG8_LAS __attribute__((address_space(3)))
typedef unsigned short bf16_t;
typedef short bf16x8 __attribute__((ext_vector_type(8)));
typedef float f32x4 __attribute__((ext_vector_type(4)));
typedef unsigned u32x4 __attribute__((ext_vector_type(4)));
constexpr int BM = 256, BK = 64, HALF = 128, HTB = HALF * BK * 2  , STAGE_BYTES = 8 * HTB, NXCD = 8, WGM = 8;

__host__ __device__ __forceinline__ int lds_byte(int r, int c) { const int st = (r >> 4) * 2 + (c >> 5), rr = r & 15, cc = c & 31, ob = rr * 64 + cc * 2; return st * 1024 + (ob ^ (((ob >> 9) & 1) << 5)); }
__host__ __device__ __forceinline__ void stage_rc(int b, int& R, int& C) { const int st = b / 1024, sb = b % 1024, swz = sb ^ (((sb >> 9) & 1) << 5); R = (st >> 1) * 16 + swz / 64; C = (st & 1) * 32 + (swz % 64) / 2; }
__host__ __device__ __forceinline__ int perm32(int rho) { const int n = rho >> 4, i = rho & 15; return 8 * (i >> 2) + 4 * n + (i & 3); }

struct Unit { int pm, pn; };
struct Gemm { const bf16_t* A; const bf16_t* Bt; int M, N, K, lda; };
struct StaticOrder {
    int nM, nN, nwg, G, c, skip;
    __host__ __device__ void init(int M, int N, int G_, int c_, int skip_ = 0) { nM = M / BM; nN = N / BM; nwg = nM * nN; G = G_; c = c_; skip = skip_; }
    __host__ __device__ bool next(int i, Unit& u) const {
        const long L = (long)i * G + c; if (L >= nwg) return false;
        int wgid = (int)L; { const int q = nwg / NXCD, r = nwg % NXCD, xcd = wgid % NXCD, off = wgid / NXCD; wgid = (xcd < r ? xcd * (q + 1) : r * (q + 1) + (xcd - r) * q) + off; }
        const int nig = WGM * nN, gid = wgid / nig, fm = gid * WGM, gsz = (nM - fm) < WGM ? (nM - fm) : WGM;
        u.pm = fm + ((wgid % nig) % gsz); u.pn = (wgid % nig) / gsz;
        if (skip) u.pm = (u.pm >> 4) * 17 + 1 + (u.pm & 15);
        return true;
    }
    __device__ __forceinline__ void a_ready(const Unit&) const {}
    __device__ __forceinline__ void done(const Unit&) const {}
};
__device__ __forceinline__ unsigned cvt_pk_bf16(float lo, float hi) { unsigned r; asm volatile("v_cvt_pk_bf16_f32 %0, %1, %2" : "=v"(r) : "v"(lo), "v"(hi)); return r; }
template <class Epi, class Sched, bool STAMP = false>
__device__ __forceinline__ void gemm_phase(PG8_LAS unsigned char* lds, const Gemm g, const Sched& S, const Epi& E, unsigned long long* stamps) {
    const int tid = TIDX, wid = __builtin_amdgcn_readfirstlane(tid >> 6), lane = tid & 63, wr = wid >> 2, wc = wid & 3, fr = lane & 15, fq = lane >> 4;
    const int K = g.K, nt = K / BK;
    int ts_lo = 0, ts_hi = 0, nts = 0; const unsigned long long rt_entry = STAMP ? (unsigned long long)wall_clock64() : 0ull;
#define PG8_STAMP() do { if (STAMP && wid == 0 && nts < 64) { const unsigned long long _c = (unsigned long long)clock64(); \
        ts_lo = (lane == nts) ? (int)(unsigned)_c : ts_lo; ts_hi = (lane == nts) ? (int)(unsigned)(_c >> 32) : ts_hi; ++nts; } } while (0)
    PG8_STAMP();
    unsigned voffA[2], voffB[2];
#pragma unroll
    for (int i = 0; i < 2; ++i) { int R, C; stage_rc(tid * 16 + i * 8192, R, C); const int Rb = Epi::PERM ? ((R & ~31) + perm32(R & 31)) : R;
        voffA[i] = (unsigned)(R * g.lda + C) * 2u; voffB[i] = (unsigned)(Rb * K + C) * 2u; }
    const size_t kstep = (size_t)(BK * 2);
    const size_t hstepB = (size_t)HALF * K * 2, hstepA = (size_t)HALF * g.lda * 2;
    const size_t tstepB = 2 * hstepB, tstepA = 2 * hstepA;
    const unsigned ldsw = (unsigned)wid * 1024u;
    const int aoff = lds_byte(wr * 64 + fr, fq * 8), boff = lds_byte(wc * 32 + fr, fq * 8);
#define PG8_SA(b, h) (((b) * 2 + (h)) * HTB)
#define PG8_SB(b, h) ((4 + (b) * 2 + (h)) * HTB)
#define PG8_STAGE(bufoff, gbase, voff) do { _Pragma("unroll") for (int _i = 0; _i < 2; ++_i) \
        __builtin_amdgcn_global_load_lds((const unsigned*)((const char*)(gbase) + (voff)[_i]), (PG8_LAS unsigned*)(lds + (bufoff) + ldsw + _i * 8192), 16, 0, 0); } while (0)
#define PG8_LDA(dst, b, h) do { _Pragma("unroll") for (int m = 0; m < 4; ++m) _Pragma("unroll") for (int k = 0; k < 2; ++k) dst[m][k] = *(const PG8_LAS bf16x8*)(lds + PG8_SA(b, h) + aoff + m * 2048 + k * 1024); } while (0)
#define PG8_LDB(dst, b, h) do { _Pragma("unroll") for (int n = 0; n < 2; ++n) _Pragma("unroll") for (int k = 0; k < 2; ++k) dst[n][k] = *(const PG8_LAS bf16x8*)(lds + PG8_SB(b, h) + boff + n * 2048 + k * 1024); } while (0)
#define PG8_MMA(ai, bj, At, Bt) do { __builtin_amdgcn_s_setprio(1); _Pragma("unroll") for (int m = 0; m < 4; ++m) _Pragma("unroll") for (int n = 0; n < 2; ++n) _Pragma("unroll") for (int k = 0; k < 2; ++k) \
        acc[ai][bj][m][n] = __builtin_amdgcn_mfma_f32_16x16x32_bf16(Bt[n][k], At[m][k], acc[ai][bj][m][n], 0, 0, 0); __builtin_amdgcn_s_setprio(0); } while (0)
#define PG8_WAIT_V(n) asm volatile("s_waitcnt vmcnt(" #n ")" ::: "memory")
#define PG8_WAIT_L(n) asm volatile("s_waitcnt lgkmcnt(" #n ")" ::: "memory")
#define PG8_BAR __builtin_amdgcn_s_barrier()
#define PG8_SCHED __builtin_amdgcn_sched_barrier(0)
    Unit cur, nxt; int ui = 0;
    if (!S.next(0, cur)) return;
    f32x4 acc[2][2][4][2];
#pragma unroll
    for (int a = 0; a < 2; ++a)
#pragma unroll
        for (int b = 0; b < 2; ++b)
#pragma unroll
            for (int m = 0; m < 4; ++m)
#pragma unroll
                for (int n = 0; n < 2; ++n) acc[a][b][m][n] = (f32x4){0.f, 0.f, 0.f, 0.f};
    bf16x8 At[4][2], B0[2][2], B1[2][2];
    const char* cA = (const char*)g.A + (size_t)cur.pm * tstepA; const char* cB = (const char*)g.Bt + (size_t)cur.pn * tstepB;
    S.a_ready(cur);
    PG8_STAGE(PG8_SB(0, 0), cB, voffB); PG8_STAGE(PG8_SA(0, 0), cA, voffA); PG8_STAGE(PG8_SB(0, 1), cB + hstepB, voffB); PG8_STAGE(PG8_SA(0, 1), cA + hstepA, voffA);
    if (wr == 1) PG8_BAR;
    PG8_WAIT_V(4); PG8_BAR;
    PG8_STAGE(PG8_SB(1, 0), cB + kstep, voffB); PG8_STAGE(PG8_SA(1, 0), cA + kstep, voffA); PG8_STAGE(PG8_SB(1, 1), cB + hstepB + kstep, voffB);
    PG8_WAIT_V(6); PG8_BAR;
    PG8_STAMP();
    for (;;) {
        const bool has_next = S.next(ui + 1, nxt);
        const char* nA = has_next ? (const char*)g.A + (size_t)nxt.pm * tstepA : cA; const char* nB = has_next ? (const char*)g.Bt + (size_t)nxt.pn * tstepB : cB;
        for (int t = 0; t < nt; t += 2) {
            const bool last = (t == nt - 2);
            const char* a1 = cA + (size_t)(t + 1) * kstep;
            const char* a2 = last ? nA : cA + (size_t)(t + 2) * kstep; const char* b2 = last ? nB : cB + (size_t)(t + 2) * kstep;
            const char* a3 = a2 + kstep; const char* b3 = b2 + kstep;
            if (last && has_next) S.a_ready(nxt);
            PG8_LDB(B0, 0, 0); PG8_SCHED; PG8_LDA(At, 0, 0); PG8_STAGE(PG8_SA(1, 1), a1 + hstepA, voffA);
            PG8_WAIT_L(8); PG8_BAR; PG8_WAIT_L(0); PG8_MMA(0, 0, At, B0); PG8_BAR; PG8_SCHED;
            PG8_LDB(B1, 0, 1); PG8_STAGE(PG8_SB(0, 0), b2, voffB);
            PG8_BAR; PG8_WAIT_L(0); PG8_MMA(0, 1, At, B1); PG8_BAR;
            PG8_LDA(At, 0, 1); PG8_STAGE(PG8_SA(0, 0), a2, voffA);
            PG8_BAR; PG8_WAIT_L(0); PG8_MMA(1, 0, At, B0); PG8_BAR; PG8_SCHED;
            PG8_STAGE(PG8_SB(0, 1), b2 + hstepB, voffB);
            PG8_WAIT_V(6); PG8_BAR; PG8_MMA(1, 1, At, B1); PG8_BAR;
            PG8_LDB(B0, 1, 0); PG8_SCHED; PG8_LDA(At, 1, 0); PG8_STAGE(PG8_SA(0, 1), a2 + hstepA, voffA);
            PG8_WAIT_L(8); PG8_BAR; PG8_WAIT_L(0); PG8_MMA(0, 0, At, B0); PG8_BAR; PG8_SCHED;
            PG8_LDB(B1, 1, 1); PG8_STAGE(PG8_SB(1, 0), b3, voffB);
            PG8_BAR; PG8_WAIT_L(0); PG8_MMA(0, 1, At, B1); PG8_BAR;
            PG8_LDA(At, 1, 1); PG8_STAGE(PG8_SA(1, 0), a3, voffA);
            PG8_BAR; PG8_WAIT_L(0); PG8_MMA(1, 0, At, B0); PG8_BAR; PG8_SCHED;
            PG8_STAGE(PG8_SB(1, 1), b3 + hstepB, voffB);
            PG8_WAIT_V(6); PG8_BAR; PG8_MMA(1, 1, At, B1); PG8_BAR;
        }
        PG8_STAMP();
        if constexpr (!Epi::AFTER_DRAIN) { E(acc, cur, wr, wc, fr, fq); S.done(cur); }
        PG8_STAMP();
        if (!has_next) break;
#pragma unroll
        for (int a = 0; a < 2; ++a)
#pragma unroll
            for (int b = 0; b < 2; ++b)
#pragma unroll
                for (int m = 0; m < 4; ++m)
#pragma unroll
                    for (int n = 0; n < 2; ++n) acc[a][b][m][n] = (f32x4){0.f, 0.f, 0.f, 0.f};
        cur = nxt; cA = nA; cB = nB; ++ui;
    }
    PG8_WAIT_V(0);
    if (wr == 0) PG8_BAR;
    PG8_BAR;
    if constexpr (Epi::AFTER_DRAIN) { E.fused(acc, cur, wr, wc, fr, fq, lds, wid, lane); S.done(cur); }
    PG8_STAMP();
    if (STAMP && wid == 0) { stamps[lane] = lane < nts ? (((unsigned long long)(unsigned)ts_hi << 32) | (unsigned)ts_lo) : 0ull;
        if (lane == 62) stamps[62] = rt_entry; if (lane == 63) stamps[63] = (unsigned long long)wall_clock64(); }
#undef PG8_STAMP
#undef PG8_SA
#undef PG8_SB
#undef PG8_STAGE
#undef PG8_LDA
#undef PG8_LDB
#undef PG8_MMA
#undef PG8_WAIT_V
#undef PG8_WAIT_L
#undef PG8_BAR
#undef PG8_SCHED
}
}

struct EpiBf {
  static constexpr bool PERM = true, AFTER_DRAIN = false;
  u16* O; int ldc; const float* bias; int act;
  __device__ __forceinline__ void operator()(const f32x4 (&acc)[2][2][4][2], const pg8::Unit& u, int wr, int wc, int fr, int fq) const {
    const int row0 = u.pm * 256 + wr * 64 + fr, col0 = u.pn * 256 + wc * 32 + 8 * fq;
    f32x4 bv[2][2];
#pragma unroll
    for (int bj = 0; bj < 2; ++bj)
#pragma unroll
      for (int n = 0; n < 2; ++n) bv[bj][n] = bias ? *(const f32x4*)(bias + col0 + bj * 128 + 4 * n) : f32x4{0.f, 0.f, 0.f, 0.f};
#pragma unroll
    for (int ai = 0; ai < 2; ++ai)
#pragma unroll
      for (int m = 0; m < 4; ++m) {
        u16* rowp = O + (size_t)(row0 + ai * 128 + m * 16) * ldc + col0;
#pragma unroll
        for (int bj = 0; bj < 2; ++bj) {
          f32x4 v0 = acc[ai][bj][m][0] + bv[bj][0], v1 = acc[ai][bj][m][1] + bv[bj][1];
          if (act == 1) {
#pragma unroll
            for (int j = 0; j < 4; ++j) { v0[j] = sigm(v0[j]); v1[j] = sigm(v1[j]); }
          }
          uint4 wv;
          wv.x = pack2(v0[0], v0[1]); wv.y = pack2(v0[2], v0[3]); wv.z = pack2(v1[0], v1[1]); wv.w = pack2(v1[2], v1[3]);
          *(uint4*)(rowp + bj * 128) = wv;
        }
      }
  }
};
struct EpiSwiglu {
  static constexpr bool PERM = true, AFTER_DRAIN = false;
  u16* O;
  __device__ __forceinline__ void operator()(const f32x4 (&acc)[2][2][4][2], const pg8::Unit& u, int wr, int wc, int fr, int fq) const {
    const int row0 = u.pm * 256 + wr * 64 + fr, col0 = u.pn * 128 + wc * 16 + 4 * fq;
#pragma unroll
    for (int ai = 0; ai < 2; ++ai)
#pragma unroll
      for (int m = 0; m < 4; ++m) {
        u16* rowp = O + (size_t)(row0 + ai * 128 + m * 16) * FH + col0;
#pragma unroll
        for (int bj = 0; bj < 2; ++bj) {
          const f32x4 g = acc[ai][bj][m][0], up = acc[ai][bj][m][1];
          uint2 wv;
          wv.x = pack2(siluf(g[0]) * up[0], siluf(g[1]) * up[1]);
          wv.y = pack2(siluf(g[2]) * up[2], siluf(g[3]) * up[3]);
          *(uint2*)(rowp + bj * 64) = wv;
        }
      }
  }
};
struct EpiGateAcc {
  static constexpr bool PERM = true, AFTER_DRAIN = false;
  u16* ACC; const u16* G; int gcol; unsigned amask;
  __device__ __forceinline__ void operator()(const f32x4 (&acc)[2][2][4][2], const pg8::Unit& u, int wr, int wc, int fr, int fq) const {
    unsigned pk[2][2][4][4];
#pragma unroll
    for (int ai = 0; ai < 2; ++ai)
#pragma unroll
      for (int bj = 0; bj < 2; ++bj)
#pragma unroll
        for (int m = 0; m < 4; ++m) {
          pk[ai][bj][m][0] = pack2(acc[ai][bj][m][0][0], acc[ai][bj][m][0][1]);
          pk[ai][bj][m][1] = pack2(acc[ai][bj][m][0][2], acc[ai][bj][m][0][3]);
          pk[ai][bj][m][2] = pack2(acc[ai][bj][m][1][0], acc[ai][bj][m][1][1]);
          pk[ai][bj][m][3] = pack2(acc[ai][bj][m][1][2], acc[ai][bj][m][1][3]);
        }
    asm volatile("" ::: "memory");
    const int row0 = u.pm * 256 + wr * 64 + fr, col0 = u.pn * 256 + wc * 32 + 8 * fq;
#pragma unroll
    for (int ai = 0; ai < 2; ++ai)
#pragma unroll
      for (int m = 0; m < 4; ++m) {
        const size_t row = (size_t)(row0 + ai * 128 + m * 16);
#pragma unroll
        for (int bj = 0; bj < 2; ++bj) {
          const int col = col0 + bj * 128;
          const uint4 gv = *(const uint4*)(G + row * 2048 + gcol + col);
          const uint4 av = *(const uint4*)(ACC + row * DM + col);
          const unsigned gw[4] = {gv.x, gv.y, gv.z, gv.w};
          const unsigned aw[4] = {av.x & amask, av.y & amask, av.z & amask, av.w & amask};
          unsigned ow[4];
#pragma unroll
          for (int q = 0; q < 4; ++q) {
            const unsigned pv = pk[ai][bj][m][q];
            const float lo = __uint_as_float(aw[q] << 16) + __uint_as_float(gw[q] << 16) * __uint_as_float(pv << 16);
            const float hi = __uint_as_float(aw[q] & 0xffff0000u) + __uint_as_float(gw[q] & 0xffff0000u) * __uint_as_float(pv & 0xffff0000u);
            ow[q] = pack2(lo, hi);
          }
          *(uint4*)(ACC + row * DM + col) = make_uint4(ow[0], ow[1], ow[2], ow[3]);
        }
        asm volatile("" ::: "memory");
      }
  }
};

template <int MI>
__device__ __forceinline__ void gemm_loop(const u16* __restrict__ A, int lda, const u16* __restrict__ Bt, int ldb, int K,
                                          f32x4 (&acc)[MI][4], u16* sA, u16* sB) {
  constexpr int BMT = MI * 64;
  const int tid = TIDX, lane = tid & 63, w = tid >> 6, wm = w >> 1, wn = w & 1, fr = lane & 15, fq = lane >> 4;
  uint4 ra[MI], rb[2];
  const u16* ga = A + (size_t)(tid >> 3) * lda + (tid & 7) * 8;
  const u16* gb = Bt + (size_t)(tid >> 3) * ldb + (tid & 7) * 8;
  const int so = (tid >> 3) * LDT + (tid & 7) * 8;
#pragma unroll
  for (int i = 0; i < MI; i++) ra[i] = *(const uint4*)(ga + (size_t)(i * 64) * lda);
#pragma unroll
  for (int i = 0; i < 2; i++) rb[i] = *(const uint4*)(gb + (size_t)(i * 64) * ldb);
#pragma unroll
  for (int i = 0; i < MI; i++) *(uint4*)(sA + so + i * 64 * LDT) = ra[i];
#pragma unroll
  for (int i = 0; i < 2; i++) *(uint4*)(sB + so + i * 64 * LDT) = rb[i];
  __syncthreads();
  const int nk = K >> 6;
  for (int kt = 0; kt < nk; kt++) {
    const bool more = kt + 1 < nk;
    if (more) {
#pragma unroll
      for (int i = 0; i < MI; i++) ra[i] = *(const uint4*)(ga + (size_t)(i * 64) * lda + (kt + 1) * 64);
#pragma unroll
      for (int i = 0; i < 2; i++) rb[i] = *(const uint4*)(gb + (size_t)(i * 64) * ldb + (kt + 1) * 64);
    }
    const u16* a = sA + (kt & 1) * BMT * LDT + (wm * (MI * 16) + fr) * LDT + fq * 8;
    const u16* b = sB + (kt & 1) * 128 * LDT + (wn * 64 + fr) * LDT + fq * 8;
#pragma unroll
    for (int ks = 0; ks < 2; ks++) {
      bf16x8 af[MI], bfr[4];
#pragma unroll
      for (int i = 0; i < MI; i++) af[i] = *(const bf16x8*)(a + i * 16 * LDT + ks * 32);
#pragma unroll
      for (int j = 0; j < 4; j++) bfr[j] = *(const bf16x8*)(b + j * 16 * LDT + ks * 32);
#pragma unroll
      for (int i = 0; i < MI; i++)
#pragma unroll
        for (int j = 0; j < 4; j++) acc[i][j] = __builtin_amdgcn_mfma_f32_16x16x32_bf16(bfr[j], af[i], acc[i][j], 0, 0, 0);
    }
    if (more) {
      u16* da = sA + ((kt + 1) & 1) * BMT * LDT + so;
      u16* db = sB + ((kt + 1) & 1) * 128 * LDT + so;
#pragma unroll
      for (int i = 0; i < MI; i++) *(uint4*)(da + i * 64 * LDT) = ra[i];
#pragma unroll
      for (int i = 0; i < 2; i++) *(uint4*)(db + i * 64 * LDT) = rb[i];
    }
    __syncthreads();
  }
}

template <int MI>
__device__ __forceinline__ void zero_acc(f32x4 (&acc)[MI][4]) {
#pragma unroll
  for (int i = 0; i < MI; i++)
#pragma unroll
    for (int j = 0; j < 4; j++) acc[i][j] = f32x4{0.f, 0.f, 0.f, 0.f};
}


typedef unsigned u32x4v __attribute__((ext_vector_type(4)));
__device__ __forceinline__ void yp_issue(const u16* __restrict__ A, const u16* __restrict__ B, u32x4v (&ra)[8], u32x4v (&rb)[8], int tid) {
#pragma unroll
  for (int i = 0; i < 8; i++) {
    const int c = tid + i * NTHR, row = c >> 5, ch = c & 31;
    ra[i] = *(const u32x4v*)(A + (size_t)row * YST + ch * 8);
    rb[i] = *(const u32x4v*)(B + (size_t)row * 256 + ch * 8);
  }
}
__device__ __forceinline__ void yp_stage(unsigned char* sA, unsigned char* sB, const u32x4v (&ra)[8], const u32x4v (&rb)[8], int tid) {
#pragma unroll
  for (int i = 0; i < 8; i++) {
    const int c = tid + i * NTHR, row = c >> 5, ch = c & 31;
    const int off = row * 512 + ((ch ^ (row & 7)) << 4);
    *(u32x4v*)(sA + off) = ra[i];
    *(u32x4v*)(sB + off) = rb[i];
  }
}
__device__ __forceinline__ void phase_ypart(const Params& p, int l, unsigned char* smem) {
  unsigned char* sA = smem;
  unsigned char* sB = smem + 65536;
  const int tid = TIDX, lane = tid & 63, w = tid >> 6, wm = w >> 1, wn = w & 1, fr = lane & 15, fq = lane >> 4;
  const u16* Y = (const u16*)(p.ws + OFF_YS);
  const u16* Wb = (const u16*)(p.ws + OFF_W + OW_B);
  const u16* G = (const u16*)(p.ws + OFF_BIG);
  u16* ACC = (u16*)(p.ws + OFF_H);
  constexpr int NT = 8;
  const int ntiles = (NROWS / 128) * NT;
  const int G_ = gridDim.x;
  const bool xmap = (G_ == 256);
  const int xj = blockIdx.x >> 3, xx = blockIdx.x & 7;
  const bool skipc = (l == 1);
  const int nrt = skipc ? 256 : 272;
  const int ntl = nrt * NT;
  const int nmine = xmap ? (xj < nrt ? (nrt - 1 - xj) / 32 + 1 : 0)
                         : (((int)blockIdx.x < ntl) ? (ntl - 1 - (int)blockIdx.x) / G_ + 1 : 0);
  if (nmine == 0) return;
#define YP_TILE(Q_, MT_, NT_)                                                        \
  do {                                                                               \
    if (xmap) { const int s_ = (Q_) * 32 + xj; MT_ = (s_ >> 3) * 8 + xx; NT_ = s_ & 7; } \
    else { const int t_ = blockIdx.x + (Q_) * G_; MT_ = t_ / NT; NT_ = t_ - MT_ * NT; }  \
    if (skipc) MT_ = (MT_ >> 5) * 34 + 2 + (MT_ & 31);                                   \
  } while (0)
  u32x4v ra[8], rb[8];
  {
    int mt, nt;
    YP_TILE(0, mt, nt);
    yp_issue(Y + (size_t)mt * 128 * YST, Wb + ((size_t)nt * 128) * 256, ra, rb, tid);
  }
  f32x4 tot[2][4];
  zero_acc<2>(tot);
  for (int qi = 0; qi < 4 * nmine; qi++) {
    const int q = qi >> 2, k = qi & 3;
    int mt, nt;
    YP_TILE(q, mt, nt);
    const int r0 = mt * 128 + wm * 32 + fr, c0 = nt * 128 + wn * 64 + fq * 4;
    uint2 gv[2][4];
#pragma unroll
    for (int i = 0; i < 2; i++)
#pragma unroll
      for (int j = 0; j < 4; j++) gv[i][j] = *(const uint2*)(G + (size_t)(r0 + i * 16) * 4096 + k * 1024 + c0 + j * 16);
    __syncthreads();
    yp_stage(sA, sB, ra, rb, tid);
    __syncthreads();
    {
      const int qn = qi + 1 < 4 * nmine ? qi + 1 : qi;
      int mtn, ntn;
      YP_TILE(qn >> 2, mtn, ntn);
      const int brn = qn & 3, ycn = brn < 3 ? brn * 256 : 1536;
      yp_issue(Y + (size_t)mtn * 128 * YST + ycn, Wb + ((size_t)brn * 1024 + ntn * 128) * 256, ra, rb, tid);
    }
    f32x4 ay[2][4];
    zero_acc<2>(ay);
#pragma unroll 2
    for (int ks = 0; ks < 8; ks++) {
      bf16x8 af[2], bfr[4];
#pragma unroll
      for (int i = 0; i < 2; i++) {
        const int row = wm * 32 + i * 16 + fr;
        af[i] = *(const bf16x8*)(sA + row * 512 + (((ks * 4 + fq) ^ (row & 7)) << 4));
      }
#pragma unroll
      for (int j = 0; j < 4; j++) {
        const int row = wn * 64 + j * 16 + fr;
        bfr[j] = *(const bf16x8*)(sB + row * 512 + (((ks * 4 + fq) ^ (row & 7)) << 4));
      }
#pragma unroll
      for (int i = 0; i < 2; i++)
#pragma unroll
        for (int j = 0; j < 4; j++) ay[i][j] = __builtin_amdgcn_mfma_f32_16x16x32_bf16(bfr[j], af[i], ay[i][j], 0, 0, 0);
    }
#pragma unroll
    for (int i = 0; i < 2; i++)
#pragma unroll
      for (int j = 0; j < 4; j++) {
        tot[i][j][0] += __uint_as_float(gv[i][j].x << 16) * ay[i][j][0];
        tot[i][j][1] += __uint_as_float(gv[i][j].x & 0xffff0000u) * ay[i][j][1];
        tot[i][j][2] += __uint_as_float(gv[i][j].y << 16) * ay[i][j][2];
        tot[i][j][3] += __uint_as_float(gv[i][j].y & 0xffff0000u) * ay[i][j][3];
      }
    if (k == 3) {
#pragma unroll
      for (int i = 0; i < 2; i++)
#pragma unroll
        for (int j = 0; j < 4; j++) {
          uint2 ov;
          ov.x = pack2(tot[i][j][0], tot[i][j][1]); ov.y = pack2(tot[i][j][2], tot[i][j][3]);
          *(uint2*)(ACC + (size_t)(r0 + i * 16) * DM + c0 + j * 16) = ov;
        }
      zero_acc<2>(tot);
    }
  }
  __syncthreads();
#undef YP_TILE
}

#define S2_BUF 10816
#define S2_D 0
#define S2_U 2048
#define S2_P 4096
#define S2_K 6144
#define S2_DQ 8192
#define S2_V 10240
#define S2_C1 10752
#define S2_C2 10784
#define S2_ST (2 * S2_BUF)
#define S2_YB (S2_ST + 8192)

__device__ __forceinline__ float red16(float x) {
  x += dppf<0xB1>(x);
  x += dppf<0x4E>(x);
  x += dppf<0x141>(x);
  x += dppf<0x140>(x);
  return x;
}
__device__ __forceinline__ void wave_lds_sync() {
  asm volatile("s_waitcnt lgkmcnt(0)" ::: "memory");
  __builtin_amdgcn_wave_barrier();
}

template <int MIX>
__device__ __forceinline__ void scan2_item(const Params& p, int l, int b, int h, int dir, int rq, float* sm) {
  constexpr int EPL = (MIX == 2) ? 2 : 4;
  constexpr int VOFF = (MIX == 2) ? 64 : 128;
  const int tid = TIDX, lane = tid & 63, w = tid >> 6, fr = lane & 15, fq = lane >> 4;
  const bool producer = w >= 4;
  const int pw = w & 3;
  const u16* P = (const u16*)(p.ws + OFF_BIG);
  u16* YS = (u16*)(p.ws + OFF_YS);
  float* BC = (float*)(p.ws + OFF_BC);
  float* ST = sm + S2_ST + pw * 2048;
  float s[EPL];
#pragma unroll
  for (int i = 0; i < EPL; i++) s[i] = 0.f;

  bf16x8 bw2[4], ba2[4];
  float cst[5][4];
  float cw[3][7];
  float muv[4];
  int colv[4];
#pragma unroll
  for (int i = 0; i < 4; i++) { bw2[i] = bf16x8{0, 0, 0, 0, 0, 0, 0, 0}; ba2[i] = bw2[i]; muv[i] = 0.f; colv[i] = 0; }
  if (producer) {
    if (MIX == 0) {
#pragma unroll
      for (int nt = 0; nt < 4; nt++) {
        const int jch = h * 64 + nt * 16 + fr;
#pragma unroll
        for (int jj = 0; jj < 8; jj++) {
          bw2[nt][jj] = (short)f2bf(p.rwkv_w2[((size_t)(l * 2 + dir) * 32 + fq * 8 + jj) * 256 + jch]);
          ba2[nt][jj] = (short)f2bf(p.rwkv_a2[((size_t)(l * 2 + dir) * 32 + fq * 8 + jj) * 256 + jch]);
        }
        cst[0][nt] = p.rwkv_w0[(l * 2 + dir) * 256 + jch];
        cst[1][nt] = p.rwkv_a0[(l * 2 + dir) * 256 + jch];
        cst[2][nt] = p.rwkv_ka[l * 256 + jch];
        cst[3][nt] = p.rwkv_kk[l * 256 + jch];
        cst[4][nt] = p.rwkv_rk[l * 256 + jch];
      }
#pragma unroll
      for (int i = 0; i < 4; i++) {
        const int c = lane + 64 * i;
        colv[i] = i < 3 ? i * 256 + h * 64 + lane : (lane < 32 ? 768 + dir * 32 + lane : 832 + dir * 32 + (lane - 32));
        muv[i] = p.rwkv_mu[l * 960 + colv[i]];
        (void)c;
      }
    } else if (MIX == 1) {
#pragma unroll
      for (int i = 0; i < 3; i++) {
        colv[i] = PB + i * 256 + h * 64 + lane;
#pragma unroll
        for (int tp = 0; tp < 7; tp++) cw[i][tp] = p.gdn_conv[((size_t)l * 7 + tp) * 768 + i * 256 + h * 64 + lane];
      }
    } else {
#pragma unroll
      for (int nt = 0; nt < 2; nt++) {
#pragma unroll
        for (int jj = 0; jj < 8; jj++)
          bw2[nt][jj] = fq < 2 ? (short)f2bf(p.gla_gw2[((size_t)(l * 2 + dir) * 16 + fq * 8 + jj) * 128 + h * 32 + nt * 16 + fr]) : (short)0;
        cst[0][nt] = p.gla_gb[(l * 2 + dir) * 128 + h * 32 + nt * 16 + fr];
      }
      colv[0] = PC + h * 32 + lane;
      if (lane >= 32) colv[0] = PC + 128 + h * 32 + (lane - 32);
      colv[1] = PC + 256 + h * 64 + lane;
      colv[2] = PC + 512 + dir * 16 + (lane & 15);
    }
  }
  __syncthreads();

  for (int c = 0; c <= TPB / 32 + 1; c++) {
    if (producer) {
      if (c >= 2) {
        const int cc = c - 2;
        int seg_row0, t_lo;
        if (cc < 8) { seg_row0 = b * TPB; t_lo = dir == 0 ? cc * 32 : (LC - 32 - cc * 32); }
        else { seg_row0 = b * TPB + LC; t_lo = dir == 0 ? (cc - 8) * 32 : (SEQ - 32 - (cc - 8) * 32); }
        const float* yb = sm + S2_YB + (cc & 1) * 512;
        const int t2 = tid - 256;
#pragma unroll
        for (int i = 0; i < 2; i++) {
          const int idx = t2 + i * 256, tt = idx >> 4, e = idx & 15;
          YS[(size_t)(seg_row0 + t_lo + tt) * YST + dir * 768 + MIX * 256 + h * 64 + rq * 16 + e] = f2bf(yb[idx]);
        }
      }
      if (c < TPB / 32) {
        int seg_row0, seg_len, t_lo;
        if (c < 8) { seg_row0 = b * TPB; seg_len = LC; t_lo = dir == 0 ? c * 32 : (LC - 32 - c * 32); }
        else { seg_row0 = b * TPB + LC; seg_len = SEQ; t_lo = dir == 0 ? (c - 8) * 32 : (SEQ - 32 - (c - 8) * 32); }
        const u16* Pseg = P + (size_t)seg_row0 * PST;
        float* B = sm + (c & 1) * S2_BUF;
        const int t0 = t_lo + pw * 8;
        if (MIX == 0) {
          float raw[10][4];
#pragma unroll
          for (int rr = 0; rr < 10; rr++) {
            const int t = t0 - 1 + rr;
            const float okf = (t >= 0 && t < seg_len) ? 1.f : 0.f;
            const int tc = min(max(t, 0), seg_len - 1);
#pragma unroll
            for (int i = 0; i < 4; i++) raw[rr][i] = bf2f(Pseg[(size_t)tc * PST + PA + colv[i]]) * okf;
          }
#pragma unroll
          for (int j = 0; j < 8; j++)
#pragma unroll
            for (int i = 0; i < 4; i++) {
              float xm = raw[j + 1][i] + (0.5f * (raw[j][i] + raw[j + 2][i]) - raw[j + 1][i]) * muv[i];
              if (i == 3 && lane < 32) xm = tanh_fast(xm);
              ST[j * 256 + lane + 64 * i] = xm;
            }
        } else if (MIX == 1) {
          float raw[14][3];
#pragma unroll
          for (int rr = 0; rr < 14; rr++) {
            const int t = t0 - 3 + rr;
            const float okf = (t >= 0 && t < seg_len) ? 1.f : 0.f;
            const int tc = min(max(t, 0), seg_len - 1);
#pragma unroll
            for (int i = 0; i < 3; i++) raw[rr][i] = bf2f(Pseg[(size_t)tc * PST + colv[i]]) * okf;
          }
#pragma unroll
          for (int j = 0; j < 8; j++)
#pragma unroll
            for (int i = 0; i < 3; i++) {
              float a = 0.f;
#pragma unroll
              for (int tp = 0; tp < 7; tp++) a += raw[j + tp][i] * cw[i][tp];
              ST[j * 256 + lane + 64 * i] = siluf(a);
            }
          if (lane < 8) {
            const u16* pp = Pseg + (size_t)(t0 + lane) * PST + PB;
            float bx = bf2f(pp[768 + dir * 4 + h]);
            float ax = bf2f(pp[776 + dir * 4 + h]);
            float ld = -__expf(p.gdn_a_log[(l * 2 + dir) * 4 + h]) * softplusf(ax + p.gdn_dt_bias[(l * 2 + dir) * 4 + h]);
            ST[lane * 256 + 192] = sigm(bx);
            ST[lane * 256 + 193] = __expf(ld);
          }
        } else {
          u16 raw[8][3];
#pragma unroll
          for (int j = 0; j < 8; j++) {
            const u16* pp = Pseg + (size_t)(t0 + j) * PST;
#pragma unroll
            for (int i = 0; i < 3; i++) raw[j][i] = pp[colv[i]];
          }
          const float qs = lane < 32 ? 0.17677669529663687f : 1.f;
#pragma unroll
          for (int j = 0; j < 8; j++) {
            ST[j * 256 + lane] = bf2f(raw[j][0]) * qs;
            ST[j * 256 + 64 + lane] = bf2f(raw[j][1]);
            if (lane < 16) ST[j * 256 + 128 + lane] = bf2f(raw[j][2]);
          }
        }
        wave_lds_sync();
        const bool vl = fq < 2;
        if (MIX == 0) {
          bf16x8 aw, aa;
#pragma unroll
          for (int jj = 0; jj < 8; jj++) {
            aw[jj] = fr < 8 ? (short)f2bf(ST[fr * 256 + 192 + fq * 8 + jj]) : (short)0;
            aa[jj] = fr < 8 ? (short)f2bf(ST[fr * 256 + 224 + fq * 8 + jj]) : (short)0;
          }
          f32x4 accw[4], acca[4];
#pragma unroll
          for (int nt = 0; nt < 4; nt++) {
            accw[nt] = __builtin_amdgcn_mfma_f32_16x16x32_bf16(aw, bw2[nt], f32x4{0.f, 0.f, 0.f, 0.f}, 0, 0, 0);
            acca[nt] = __builtin_amdgcn_mfma_f32_16x16x32_bf16(aa, ba2[nt], f32x4{0.f, 0.f, 0.f, 0.f}, 0, 0, 0);
          }
#pragma unroll
          for (int r = 0; r < 4; r++) {
            const int j = (fq & 1) * 4 + r, tt = pw * 8 + j;
            float kkx[4], av[4], kdv[4], rv[4], dec[4];
            float ss = 0.f;
#pragma unroll
            for (int nt = 0; nt < 4; nt++) {
              const int n = nt * 16 + fr;
              rv[nt] = ST[j * 256 + n];
              const float kx = ST[j * 256 + 64 + n];
              dec[nt] = __expf(-0.6065306597126334f * sigm(cst[0][nt] + accw[nt][r]));
              av[nt] = sigm(cst[1][nt] + acca[nt][r]);
              kdv[nt] = kx * (1.f + (av[nt] - 1.f) * cst[2][nt]);
              kkx[nt] = kx * cst[3][nt];
              ss += kkx[nt] * kkx[nt];
            }
            ss = red16(ss);
            const float rs = rsq(ss + 1e-6f);
            float c1 = 0.f, c2 = 0.f, bc = 0.f;
#pragma unroll
            for (int nt = 0; nt < 4; nt++) {
              const int n = nt * 16 + fr;
              const float kk = kkx[nt] * rs;
              if (vl) {
                B[S2_D + tt * 64 + n] = dec[nt];
                B[S2_U + tt * 64 + n] = kk;
                B[S2_P + tt * 64 + n] = -kk * av[nt];
                B[S2_K + tt * 64 + n] = kdv[nt];
                B[S2_DQ + tt * 64 + n] = dec[nt] * rv[nt];
              }
              c1 += -kk * av[nt] * rv[nt];
              c2 += kdv[nt] * rv[nt];
              bc += rv[nt] * kdv[nt] * cst[4][nt];
            }
            c1 = red16(c1); c2 = red16(c2); bc = red16(bc);
            if (vl && fr == 0) {
              B[S2_C1 + tt] = c1;
              B[S2_C2 + tt] = c2;
              if (rq == 0) BC[(size_t)(seg_row0 + t_lo + tt) * 8 + h * 2 + dir] = bc;
            }
          }
        } else if (MIX == 1) {
#pragma unroll
          for (int r = 0; r < 4; r++) {
            const int j = (fq & 1) * 4 + r, tt = pw * 8 + j;
            float qv[4], kv[4];
            float sq = 0.f, sk = 0.f;
#pragma unroll
            for (int nt = 0; nt < 4; nt++) {
              const int n = nt * 16 + fr;
              qv[nt] = ST[j * 256 + n];
              kv[nt] = ST[j * 256 + 64 + n];
              sq += qv[nt] * qv[nt];
              sk += kv[nt] * kv[nt];
            }
            sq = red16(sq); sk = red16(sk);
            const float rq_ = rsq(sq + 1e-6f) * 0.125f, rk_ = rsq(sk + 1e-6f);
            const float beta = ST[j * 256 + 192], alpha = ST[j * 256 + 193];
            float dkq = 0.f;
#pragma unroll
            for (int nt = 0; nt < 4; nt++) {
              const int n = nt * 16 + fr;
              const float qn = qv[nt] * rq_, kn = kv[nt] * rk_;
              if (vl) {
                B[S2_D + tt * 64 + n] = alpha;
                B[S2_U + tt * 64 + n] = kn;
                B[S2_P + tt * 64 + n] = -alpha * beta * kn;
                B[S2_K + tt * 64 + n] = beta * kn;
                B[S2_DQ + tt * 64 + n] = alpha * qn;
              }
              dkq += kn * qn;
            }
            dkq = red16(dkq);
            if (vl && fr == 0) {
              B[S2_C1 + tt] = -alpha * beta * dkq;
              B[S2_C2 + tt] = beta * dkq;
            }
          }
        } else {
          bf16x8 ag;
#pragma unroll
          for (int jj = 0; jj < 8; jj++) ag[jj] = (fr < 8 && fq < 2) ? (short)f2bf(ST[fr * 256 + 128 + fq * 8 + jj]) : (short)0;
          f32x4 accg[2];
#pragma unroll
          for (int nt = 0; nt < 2; nt++) accg[nt] = __builtin_amdgcn_mfma_f32_16x16x32_bf16(ag, bw2[nt], f32x4{0.f, 0.f, 0.f, 0.f}, 0, 0, 0);
#pragma unroll
          for (int r = 0; r < 4; r++) {
            const int j = (fq & 1) * 4 + r, tt = pw * 8 + j;
            float dkq = 0.f;
#pragma unroll
            for (int nt = 0; nt < 2; nt++) {
              const int n = nt * 16 + fr;
              const float lg = cst[0][nt] + accg[nt][r];
              const float ls = fminf(lg, 0.f) - __logf(1.f + __expf(-fabsf(lg)));
              const float alpha = __expf(ls * (1.f / 16.f));
              const float qv = ST[j * 256 + n], kv = ST[j * 256 + 32 + n];
              if (vl) {
                B[S2_D + tt * 64 + n] = alpha;
                B[S2_K + tt * 64 + n] = kv;
                B[S2_DQ + tt * 64 + n] = alpha * qv;
              }
              dkq += kv * qv;
            }
            dkq = red16(dkq);
            if (vl && fr == 0) B[S2_C2 + tt] = dkq;
          }
        }
#pragma unroll
        for (int i = 0; i < 2; i++) {
          const int idx = lane + 64 * i, j = idx >> 4, e = idx & 15;
          B[S2_V + (pw * 8 + j) * 16 + e] = ST[j * 256 + VOFF + rq * 16 + e];
        }
      }
    } else if (c >= 1 && c <= TPB / 32) {
      const float* B = sm + ((c - 1) & 1) * S2_BUF;
      float* yb = sm + S2_YB + ((c - 1) & 1) * 512;
      const int rl = w * 4 + fq;
      const int dtt = dir ? -1 : 1;
      int tt = dir ? 31 : 0;
      float dv[EPL], kv[EPL], qv[EPL], uv[EPL], pv[EPL], vv, c1v, c2v;
      float dn[EPL], kn[EPL], qn[EPL], un[EPL], pn[EPL], vn, c1n, c2n;
#define S2_LOAD(D_, K_, Q_, U_, P_, V_, C1_, C2_, T_)                                   \
  do {                                                                                  \
    const int o_ = (T_) * 64 + fr * EPL;                                                \
    if (EPL == 4) {                                                                     \
      float4 t4 = *(const float4*)(B + S2_D + o_);                                      \
      D_[0] = t4.x; D_[1] = t4.y; D_[2] = t4.z; D_[3] = t4.w;                           \
      t4 = *(const float4*)(B + S2_K + o_);                                             \
      K_[0] = t4.x; K_[1] = t4.y; K_[2] = t4.z; K_[3] = t4.w;                           \
      t4 = *(const float4*)(B + S2_DQ + o_);                                            \
      Q_[0] = t4.x; Q_[1] = t4.y; Q_[2] = t4.z; Q_[3] = t4.w;                           \
      t4 = *(const float4*)(B + S2_U + o_);                                             \
      U_[0] = t4.x; U_[1] = t4.y; U_[2] = t4.z; U_[3] = t4.w;                           \
      t4 = *(const float4*)(B + S2_P + o_);                                             \
      P_[0] = t4.x; P_[1] = t4.y; P_[2] = t4.z; P_[3] = t4.w;                           \
      C1_ = B[S2_C1 + (T_)];                                                            \
    } else {                                                                            \
      float2 t2 = *(const float2*)(B + S2_D + o_);                                      \
      D_[0] = t2.x; D_[1] = t2.y;                                                       \
      t2 = *(const float2*)(B + S2_K + o_);                                             \
      K_[0] = t2.x; K_[1] = t2.y;                                                       \
      t2 = *(const float2*)(B + S2_DQ + o_);                                            \
      Q_[0] = t2.x; Q_[1] = t2.y;                                                       \
      U_[0] = U_[1] = P_[0] = P_[1] = 0.f; C1_ = 0.f;                                   \
    }                                                                                   \
    V_ = B[S2_V + (T_) * 16 + rl];                                                      \
    C2_ = B[S2_C2 + (T_)];                                                              \
  } while (0)
#define S2_STEP(D_, K_, Q_, U_, P_, V_, C1_, C2_, T_)                                   \
  do {                                                                                  \
    float sq = 0.f, sa = 0.f;                                                           \
    _Pragma("unroll") for (int i = 0; i < EPL; i++) sq += s[i] * Q_[i];                 \
    if (MIX != 2) {                                                                     \
      _Pragma("unroll") for (int i = 0; i < EPL; i++) sa += s[i] * U_[i];               \
      sa = red16(sa);                                                                   \
    }                                                                                   \
    sq = red16(sq);                                                                     \
    float y = sq + V_ * C2_;                                                            \
    if (MIX != 2) y += sa * C1_;                                                        \
    _Pragma("unroll") for (int i = 0; i < EPL; i++) {                                   \
      float t = s[i] * D_[i] + V_ * K_[i];                                              \
      if (MIX != 2) t += sa * P_[i];                                                    \
      s[i] = t;                                                                         \
    }                                                                                   \
    yb[(T_) * 16 + rl] = y;                                                             \
  } while (0)
      S2_LOAD(dv, kv, qv, uv, pv, vv, c1v, c2v, tt);
#pragma unroll 1
      for (int st = 0; st < 32; st += 2) {
        const int t1 = tt + dtt;
        S2_LOAD(dn, kn, qn, un, pn, vn, c1n, c2n, t1);
        S2_STEP(dv, kv, qv, uv, pv, vv, c1v, c2v, tt);
        const int t2 = st + 2 < 32 ? t1 + dtt : t1;
        S2_LOAD(dv, kv, qv, uv, pv, vv, c1v, c2v, t2);
        S2_STEP(dn, kn, qn, un, pn, vn, c1n, c2n, t1);
        tt = t2;
      }
#undef S2_LOAD
#undef S2_STEP
    }
    __syncthreads();
  }
}

#define S3_SUB 12800
#define S3_GM 0
#define S3_KVT 9216
#define S3_QB 10240
#define S3_QV 11392
#define S3_VT 11520
#define S3_WC 12544
#define S3_TB S3_QV
#define S3_TM (S3_GM + 3328)
#define S3_QBM (S3_GM + 3072)
#define S3_QKM (S3_GM + 3200)
#define S3_KB (S3_GM + 0)
#define S3_BT (S3_GM + 2048)
#define S3_STB (8 * S3_SUB)
#define S3_END (S3_STB + 4 * 2304)

__device__ __forceinline__ float rlane(float x, int l) { return __int_as_float(__builtin_amdgcn_readlane(__float_as_int(x), l)); }
__device__ __forceinline__ float wave_sum(float x) {
  x = red16(x);
  return (rlane(x, 0) + rlane(x, 16)) + (rlane(x, 32) + rlane(x, 48));
}
__device__ __forceinline__ float clampe(float x) { return fminf(fmaxf(x, -80.f), 80.f); }
__device__ __forceinline__ uint4 pack8(const float (&v)[8]) {
  return make_uint4(pack2(v[0], v[1]), pack2(v[2], v[3]), pack2(v[4], v[5]), pack2(v[6], v[7]));
}
__device__ __forceinline__ bf16x8 ld_frag(const void* p) { return *(const bf16x8*)p; }
__device__ __forceinline__ bf16x8 zfrag() { return bf16x8{0, 0, 0, 0, 0, 0, 0, 0}; }

__device__ __forceinline__ void chunk_geom(int c, int dir, int b, int& seg_row0, int& seg_len, int& t_lo) {
  if (c < 8) { seg_row0 = b * TPB; seg_len = LC; t_lo = dir == 0 ? c * 32 : (LC - 32 - c * 32); }
  else { seg_row0 = b * TPB + LC; seg_len = SEQ; t_lo = dir == 0 ? (c - 8) * 32 : (SEQ - 32 - (c - 8) * 32); }
}
template <int MIX>
__device__ __forceinline__ void fetch_raw(const u16* P, int c, int dir, int b, int h, int pw, int lane, const int (&colv)[4], unsigned (&rawq)[14][2]) {
  int seg_row0, seg_len, t_lo;
  chunk_geom(c, dir, b, seg_row0, seg_len, t_lo);
  const u16* Pseg = P + (size_t)seg_row0 * PST;
  const int t0 = t_lo + pw * 8;
  if (MIX == 0) {
#pragma unroll
    for (int rr = 0; rr < 10; rr++) {
      const int tc = min(max(t0 - 1 + rr, 0), seg_len - 1);
#pragma unroll
      for (int i = 0; i < 2; i++)
        rawq[rr][i] = (unsigned)Pseg[(size_t)tc * PST + PA + colv[2 * i]] | ((unsigned)Pseg[(size_t)tc * PST + PA + colv[2 * i + 1]] << 16);
    }
  } else if (MIX == 1) {
#pragma unroll
    for (int rr = 0; rr < 14; rr++) {
      const int tc = min(max(t0 - 3 + rr, 0), seg_len - 1);
      rawq[rr][0] = (unsigned)Pseg[(size_t)tc * PST + colv[0]] | ((unsigned)Pseg[(size_t)tc * PST + colv[1]] << 16);
      rawq[rr][1] = (rawq[rr][1] & 0xffff0000u) | (unsigned)Pseg[(size_t)tc * PST + colv[2]];
    }
    const u16* pp = Pseg + (size_t)(t0 + (lane & 7)) * PST + PB;
    rawq[0][1] = (rawq[0][1] & 0xffffu) | ((unsigned)pp[768 + dir * 4 + h] << 16);
    rawq[1][1] = (rawq[1][1] & 0xffffu) | ((unsigned)pp[776 + dir * 4 + h] << 16);
  } else {
#pragma unroll
    for (int j = 0; j < 8; j++) {
      const u16* pp = Pseg + (size_t)(t0 + j) * PST;
      rawq[j][0] = (unsigned)pp[colv[0]] | ((unsigned)pp[colv[1]] << 16);
      rawq[j][1] = (unsigned)pp[colv[2]];
    }
  }
}

template <int MIX>
__device__ __forceinline__ void scan3_item(const Params& p, int l, int b, int h, int dir, unsigned char* smb) {
  constexpr int VOFF = (MIX == 2) ? 64 : 128;
  constexpr bool DELTA = (MIX != 2);
  const int tid = TIDX, lane = tid & 63, w = __builtin_amdgcn_readfirstlane(tid >> 6), fr = lane & 15, fq = lane >> 4;
  const bool producer = true;
  const int pw = w & 3, half = w >> 2;
  const u16* P = (const u16*)(p.ws + OFF_BIG);
  u16* YS = (u16*)(p.ws + OFF_YS);
  float* BC = (float*)(p.ws + OFF_BC);
  float* ST = (float*)(smb + w * S3_SUB + S3_GM);
  unsigned char* STBY = smb + w * S3_SUB + S3_GM;
  const f32x4 z4 = f32x4{0.f, 0.f, 0.f, 0.f};
  f32x4 st[4];
#pragma unroll
  for (int i = 0; i < 4; i++) st[i] = z4;

  bf16x8 bw2[4], ba2[4];
  float cw[3][7];
  float muv[4];
  int colv[4];
  float c_w0 = 0.f, c_a0 = 0.f, c_ka = 0.f, c_kk = 0.f, c_rk = 0.f, c_gb = 0.f;
#pragma unroll
  for (int i = 0; i < 4; i++) { bw2[i] = zfrag(); ba2[i] = zfrag(); muv[i] = 0.f; colv[i] = 0; }
  if (producer) {
    if (MIX == 0) {
      {
        float tw[4][8], ta[4][8];
#pragma unroll
        for (int nt = 0; nt < 4; nt++)
#pragma unroll
          for (int jj = 0; jj < 8; jj++) {
            tw[nt][jj] = p.rwkv_w2[((size_t)(l * 2 + dir) * 32 + fq * 8 + jj) * 256 + h * 64 + nt * 16 + fr];
            ta[nt][jj] = p.rwkv_a2[((size_t)(l * 2 + dir) * 32 + fq * 8 + jj) * 256 + h * 64 + nt * 16 + fr];
          }
#pragma unroll
        for (int nt = 0; nt < 4; nt++)
#pragma unroll
          for (int jj = 0; jj < 8; jj++) { bw2[nt][jj] = (short)f2bf(tw[nt][jj]); ba2[nt][jj] = (short)f2bf(ta[nt][jj]); }
      }
      const int jl = h * 64 + lane;
      c_w0 = p.rwkv_w0[(l * 2 + dir) * 256 + jl];
      c_a0 = p.rwkv_a0[(l * 2 + dir) * 256 + jl];
      c_ka = p.rwkv_ka[l * 256 + jl];
      c_kk = p.rwkv_kk[l * 256 + jl];
      c_rk = p.rwkv_rk[l * 256 + jl];
#pragma unroll
      for (int i = 0; i < 4; i++) {
        colv[i] = i < 3 ? i * 256 + h * 64 + lane : (lane < 32 ? 768 + dir * 32 + lane : 832 + dir * 32 + (lane - 32));
        muv[i] = p.rwkv_mu[l * 960 + colv[i]];
      }
    } else if (MIX == 1) {
#pragma unroll
      for (int i = 0; i < 3; i++) {
        colv[i] = PB + i * 256 + h * 64 + lane;
#pragma unroll
        for (int tp = 0; tp < 7; tp++) cw[i][tp] = p.gdn_conv[((size_t)l * 7 + tp) * 768 + i * 256 + h * 64 + lane];
      }
    } else {
      {
        float tg[2][8];
#pragma unroll
        for (int nt = 0; nt < 2; nt++)
#pragma unroll
          for (int jj = 0; jj < 8; jj++) tg[nt][jj] = p.gla_gw2[((size_t)(l * 2 + dir) * 16 + (fq & 1) * 8 + jj) * 128 + h * 32 + nt * 16 + fr];
#pragma unroll
        for (int nt = 0; nt < 2; nt++)
#pragma unroll
          for (int jj = 0; jj < 8; jj++) bw2[nt][jj] = fq < 2 ? (short)f2bf(tg[nt][jj]) : (short)0;
      }
      c_gb = p.gla_gb[(l * 2 + dir) * 128 + h * 32 + (lane & 31)];
      colv[0] = PC + h * 32 + lane;
      if (lane >= 32) colv[0] = PC + 128 + h * 32 + (lane - 32);
      colv[1] = PC + 256 + h * 64 + lane;
      colv[2] = PC + 512 + dir * 16 + (lane & 15);
    }
  }
  __syncthreads();
  unsigned rawq[14][2];
#pragma unroll
  for (int i = 0; i < 14; i++) { rawq[i][0] = 0u; rawq[i][1] = 0u; }
  fetch_raw<MIX>(P, half, dir, b, h, pw, lane, colv, rawq);
#define RAWP(r_, i_) ((u16)((rawq[r_][(i_) >> 1] >> (((i_) & 1) * 16)) & 0xffffu))

  for (int it = 0; it < TPB / 64; it++) {
    {
      {
        const int c = it * 2 + half;
        int seg_row0, seg_len, t_lo;
        chunk_geom(c, dir, b, seg_row0, seg_len, t_lo);
        unsigned char* SB = smb + w * S3_SUB;
        const int t0 = t_lo + pw * 8;
        if (MIX == 0) {
          float raw[10][4];
#pragma unroll
          for (int rr = 0; rr < 10; rr++) {
            const int t = t0 - 1 + rr;
            const float okf = (t >= 0 && t < seg_len) ? 1.f : 0.f;
#pragma unroll
            for (int i = 0; i < 4; i++) raw[rr][i] = bf2f(RAWP(rr, i)) * okf;
          }
#pragma unroll
          for (int j = 0; j < 8; j++)
#pragma unroll
            for (int i = 0; i < 4; i++) {
              float xm = raw[j + 1][i] + (0.5f * (raw[j][i] + raw[j + 2][i]) - raw[j + 1][i]) * muv[i];
              if (i == 3 && lane < 32) xm = tanh_fast(xm);
              ST[j * 256 + lane + 64 * i] = xm;
            }
        } else if (MIX == 1) {
          float raw[14][3];
#pragma unroll
          for (int rr = 0; rr < 14; rr++) {
            const int t = t0 - 3 + rr;
            const float okf = (t >= 0 && t < seg_len) ? 1.f : 0.f;
#pragma unroll
            for (int i = 0; i < 3; i++) raw[rr][i] = bf2f(RAWP(rr, i)) * okf;
          }
#pragma unroll
          for (int j = 0; j < 8; j++)
#pragma unroll
            for (int i = 0; i < 3; i++) {
              float a = 0.f;
#pragma unroll
              for (int tp = 0; tp < 7; tp++) a += raw[j + tp][i] * cw[i][tp];
              ST[j * 256 + lane + 64 * i] = siluf(a);
            }
          if (lane < 8) {
            float bx = bf2f(RAWP(0, 3));
            float ax = bf2f(RAWP(1, 3));
            float ld = -__expf(p.gdn_a_log[(l * 2 + dir) * 4 + h]) * softplusf(ax + p.gdn_dt_bias[(l * 2 + dir) * 4 + h]);
            ST[lane * 256 + 192] = sigm(bx);
            ST[lane * 256 + 193] = ld;
          }
        } else {
          const float qs = lane < 32 ? 0.17677669529663687f : 1.f;
#pragma unroll
          for (int j = 0; j < 8; j++) {
            ST[j * 256 + lane] = bf2f(RAWP(j, 0)) * qs;
            ST[j * 256 + 64 + lane] = bf2f(RAWP(j, 1));
            if (lane < 16) ST[j * 256 + 128 + lane] = bf2f(RAWP(j, 2));
          }
        }
        wave_lds_sync();
        {
          float vv[8];
#pragma unroll
          for (int i = 0; i < 8; i++) vv[i] = ST[(dir ? 7 - i : i) * 256 + VOFF + lane];
          *(uint4*)(SB + S3_VT + lane * 16) = pack8(vv);
        }
        if (MIX == 0) {
          bf16x8 aw, aa;
#pragma unroll
          for (int jj = 0; jj < 8; jj++) {
            aw[jj] = fr < 8 ? (short)f2bf(ST[fr * 256 + 192 + fq * 8 + jj]) : (short)0;
            aa[jj] = fr < 8 ? (short)f2bf(ST[fr * 256 + 224 + fq * 8 + jj]) : (short)0;
          }
          f32x4 accw[4], acca[4];
#pragma unroll
          for (int nt = 0; nt < 4; nt++) {
            accw[nt] = __builtin_amdgcn_mfma_f32_16x16x32_bf16(aw, bw2[nt], z4, 0, 0, 0);
            acca[nt] = __builtin_amdgcn_mfma_f32_16x16x32_bf16(aa, ba2[nt], z4, 0, 0, 0);
          }
          wave_lds_sync();
          if (fq < 2) {
#pragma unroll
            for (int nt = 0; nt < 4; nt++)
#pragma unroll
              for (int r = 0; r < 4; r++) {
                ST[(fq * 4 + r) * 256 + 128 + nt * 16 + fr] = accw[nt][r];
                ST[(fq * 4 + r) * 256 + 192 + nt * 16 + fr] = acca[nt][r];
              }
          }
          wave_lds_sync();
        } else if (MIX == 2) {
          bf16x8 ag;
#pragma unroll
          for (int jj = 0; jj < 8; jj++) ag[jj] = (fr < 8 && fq < 2) ? (short)f2bf(ST[fr * 256 + 128 + fq * 8 + jj]) : (short)0;
          f32x4 accg[2];
#pragma unroll
          for (int nt = 0; nt < 2; nt++) accg[nt] = __builtin_amdgcn_mfma_f32_16x16x32_bf16(ag, bw2[nt], z4, 0, 0, 0);
          if (fq < 2) {
#pragma unroll
            for (int nt = 0; nt < 2; nt++)
#pragma unroll
              for (int r = 0; r < 4; r++) ST[(fq * 4 + r) * 256 + 192 + nt * 16 + fr] = accg[nt][r];
          }
          wave_lds_sync();
        }
        float logd[8], kap[8], bb[8], kp[8], qq[8];
        if (MIX == 0) {
          float a8[8], p1[8], p2[8];
#pragma unroll
          for (int i = 0; i < 8; i++) {
            const float* row = ST + (dir ? 7 - i : i) * 256;
            const float r_ = row[lane], k_ = row[64 + lane];
            const float sg = sigm(c_w0 + row[128 + lane]);
            a8[i] = sigm(c_a0 + row[192 + lane]);
            kp[i] = k_ * (1.f + (a8[i] - 1.f) * c_ka);
            kap[i] = k_ * c_kk;
            qq[i] = r_;
            logd[i] = -0.6065306597126334f * sg;
            p1[i] = kap[i] * kap[i];
            p2[i] = r_ * kp[i] * c_rk;
          }
#pragma unroll
          for (int i = 0; i < 8; i++) { p1[i] = red16(p1[i]); p2[i] = red16(p2[i]); }
#pragma unroll
          for (int i = 0; i < 8; i++) {
            const float ss = (rlane(p1[i], 0) + rlane(p1[i], 16)) + (rlane(p1[i], 32) + rlane(p1[i], 48));
            const float bc = (rlane(p2[i], 0) + rlane(p2[i], 16)) + (rlane(p2[i], 32) + rlane(p2[i], 48));
            kap[i] *= rsq(ss + 1e-6f);
            bb[i] = kap[i] * a8[i];
            if (lane == 0) BC[(size_t)(seg_row0 + t0 + (dir ? 7 - i : i)) * 8 + h * 2 + dir] = bc;
          }
        } else {
#pragma unroll
        for (int i = 0; i < 8; i++) {
          const int j = dir ? 7 - i : i;
          const float* row = ST + j * 256;
          if (MIX == 1) {
            const float q_ = row[lane], k_ = row[64 + lane];
            const float sq = wave_sum(q_ * q_), sk = wave_sum(k_ * k_);
            const float qn = q_ * rsq(sq + 1e-6f) * 0.125f, kn = k_ * rsq(sk + 1e-6f);
            const float beta = row[192], ld = row[193];
            const float alpha = __expf(ld);
            logd[i] = ld;
            kap[i] = kn; bb[i] = alpha * beta * kn; kp[i] = beta * kn; qq[i] = qn;
          } else {
            const int n = lane & 31;
            const float lg = c_gb + row[192 + n];
            const float ls = fminf(lg, 0.f) - __logf(1.f + __expf(-fabsf(lg)));
            logd[i] = ls * (1.f / 16.f);
            kap[i] = 0.f; bb[i] = 0.f;
            kp[i] = lane < 32 ? row[32 + n] : 0.f;
            qq[i] = lane < 32 ? row[n] : 0.f;
          }
        }
        }
        wave_lds_sync();
        float kt[8], qt[8], bck[8], kck[8];
        {
          float L[8];
          float run = 0.f;
#pragma unroll
          for (int i = 0; i < 8; i++) { run += logd[i]; L[i] = run; }
          const float Lr = L[3], L7 = L[7];
          float prevE = __expf(clampe(-Lr)), prevT = 1.f;
          u16* OPA = (u16*)STBY;
#pragma unroll
          for (int i = 0; i < 8; i++) {
            const float eI = __expf(clampe(L[i] - Lr)), eInv = __expf(clampe(Lr - L[i]));
            const float tI = __expf(L[i]), eEnd = __expf(L7 - L[i]);
            if (DELTA) {
              OPA[0 * 576 + i * 72 + lane] = f2bf(kap[i] * prevE);
              OPA[1 * 576 + i * 72 + lane] = f2bf(bb[i] * eInv);
            }
            OPA[2 * 576 + i * 72 + lane] = f2bf(kp[i] * eInv);
            OPA[3 * 576 + i * 72 + lane] = f2bf(qq[i] * eI);
            kt[i] = kap[i] * prevT; qt[i] = qq[i] * tI;
            bck[i] = bb[i] * eEnd; kck[i] = kp[i] * eEnd;
            prevE = eI; prevT = tI;
          }
          *(float*)(SB + S3_WC + lane * 4) = __expf(L7);
        }
        wave_lds_sync();
        f32x4 accA = z4, accBm = z4, accQb = z4, accQk = z4;
        {
          const u16* OPA = (const u16*)STBY;
          const int ro = (fr & 7) * 72 + fq * 8;
#pragma unroll
          for (int ks = 0; ks < 2; ks++) {
            const bf16x8 fk = ld_frag(OPA + 2 * 576 + ro + ks * 32), fqh = ld_frag(OPA + 3 * 576 + ro + ks * 32);
            accQk = __builtin_amdgcn_mfma_f32_16x16x32_bf16(fqh, fk, accQk, 0, 0, 0);
            if (DELTA) {
              const bf16x8 fka = ld_frag(OPA + 0 * 576 + ro + ks * 32), fb = ld_frag(OPA + 1 * 576 + ro + ks * 32);
              accA = __builtin_amdgcn_mfma_f32_16x16x32_bf16(fka, fb, accA, 0, 0, 0);
              accBm = __builtin_amdgcn_mfma_f32_16x16x32_bf16(fka, fk, accBm, 0, 0, 0);
              accQb = __builtin_amdgcn_mfma_f32_16x16x32_bf16(fqh, fb, accQb, 0, 0, 0);
            }
          }
#pragma unroll
          for (int r = 0; r < 4; r++) {
            const int i = fq * 4 + r;
            const bool ok = fq < 2 && fr < 8;
            if (!(ok && fr < i)) { accA[r] = 0.f; accBm[r] = 0.f; }
            if (!(ok && fr <= i)) { accQb[r] = 0.f; accQk[r] = 0.f; }
          }
        }
        *(uint4*)(SB + S3_KVT + lane * 16) = pack8(kck);
#pragma unroll
        for (int i = 0; i < 8; i++) ((u16*)(SB + S3_QB))[i * 72 + lane] = f2bf(qt[i]);
        if (fq < 2 && fr < 8) {
#pragma unroll
          for (int r = 0; r < 4; r++) {
            ((u16*)(SB + S3_QKM))[(fq * 4 + r) * 8 + fr] = f2bf(accQk[r]);
            if (DELTA) ((u16*)(SB + S3_QBM))[(fq * 4 + r) * 8 + fr] = f2bf(accQb[r]);
          }
        }
        if (DELTA) {
          float t[8];
#pragma unroll
          for (int i = 0; i < 8; i++) {
            float ti = (lane == i) ? 1.f : 0.f;
#pragma unroll
            for (int m = 0; m < i; m++) ti -= rlane(accA[i & 3], (i >> 2) * 16 + m) * t[m];
            t[i] = ti;
          }
#pragma unroll
          for (int i = 0; i < 8; i++) ((u16*)(SB + S3_KB))[i * 72 + lane] = f2bf(-kt[i]);
          *(uint4*)(SB + S3_BT + lane * 16) = pack8(bck);
          if (fq < 2 && fr < 8) {
#pragma unroll
            for (int r = 0; r < 4; r++) ((u16*)(SB + S3_TB))[(fq * 4 + r) * 8 + fr] = f2bf(-accBm[r]);
          }
          if (lane < 8) {
#pragma unroll
            for (int i = 0; i < 8; i++) ((u16*)(SB + S3_TM))[i * 8 + lane] = f2bf(t[i]);
          }
        }
      }
    }
    fetch_raw<MIX>(P, min(it + 1, TPB / 64 - 1) * 2 + half, dir, b, h, pw, lane, colv, rawq);
    __syncthreads();
    if (w < 4) {
      unsigned char* STB = smb + S3_STB + w * 2304;
#pragma unroll
      for (int kk = 0; kk < 8; kk++) {
        const int cc = it * 2 + (kk >> 2), k = kk & 3;
        int seg_row0, t_lo;
        if (cc < 8) { seg_row0 = b * TPB; t_lo = dir == 0 ? cc * 32 : (LC - 32 - cc * 32); }
        else { seg_row0 = b * TPB + LC; t_lo = dir == 0 ? (cc - 8) * 32 : (SEQ - 32 - (cc - 8) * 32); }
        const int sc = dir ? 3 - k : k;
        const unsigned char* SB = smb + ((kk >> 2) * 4 + sc) * S3_SUB;
        const bf16x8 bs0 = __builtin_bit_cast(bf16x8, u32x4v{pack2(st[0][0], st[0][1]), pack2(st[0][2], st[0][3]), pack2(st[1][0], st[1][1]), pack2(st[1][2], st[1][3])});
        const bf16x8 bs1 = __builtin_bit_cast(bf16x8, u32x4v{pack2(st[2][0], st[2][1]), pack2(st[2][2], st[2][3]), pack2(st[3][0], st[3][1]), pack2(st[3][2], st[3][3])});
#define LDP(BASE_, ROW_, KS_) ([&]() -> bf16x8 {                                                                   \
          const uint2 lo_ = *(const uint2*)((BASE_) + ((ROW_) * 72 + (KS_) * 32 + fq * 4) * 2);                      \
          const uint2 hi_ = *(const uint2*)((BASE_) + ((ROW_) * 72 + (KS_) * 32 + 16 + fq * 4) * 2);                 \
          return __builtin_bit_cast(bf16x8, u32x4v{lo_.x, lo_.y, hi_.x, hi_.y}); }())
        const bf16x8 bv = fq == 0 ? ld_frag(SB + S3_VT + (w * 16 + fr) * 16) : zfrag();
        const bf16x8 aq0 = LDP(SB + S3_QB, (fr & 7), 0), aq1 = LDP(SB + S3_QB, (fr & 7), 1);
        const bf16x8 aqk = fq == 0 ? ld_frag(SB + S3_QKM + (fr & 7) * 16) : zfrag();
        bf16x8 brv = zfrag();
        if (DELTA) {
          const bf16x8 ak0 = LDP(SB + S3_KB, (fr & 7), 0), ak1 = LDP(SB + S3_KB, (fr & 7), 1);
          const bf16x8 atb = fq == 0 ? ld_frag(SB + S3_TB + (fr & 7) * 16) : zfrag();
          f32x4 accR = __builtin_amdgcn_mfma_f32_16x16x32_bf16(ak0, bs0, z4, 0, 0, 0);
          accR = __builtin_amdgcn_mfma_f32_16x16x32_bf16(ak1, bs1, accR, 0, 0, 0);
          accR = __builtin_amdgcn_mfma_f32_16x16x32_bf16(atb, bv, accR, 0, 0, 0);
          {
            const uint2 t2 = *(const uint2*)(SB + S3_TM + (fr & 7) * 16 + (fq & 1) * 8);
            const u32x4v ta4 = {t2.x, t2.y, 0u, 0u};
            const u32x4v rb4 = {pack2(accR[0], accR[1]), pack2(accR[2], accR[3]), 0u, 0u};
            const bf16x8 at = fq < 2 ? __builtin_bit_cast(bf16x8, ta4) : zfrag();
            const bf16x8 br = fq < 2 ? __builtin_bit_cast(bf16x8, rb4) : zfrag();
            accR = __builtin_amdgcn_mfma_f32_16x16x32_bf16(at, br, z4, 0, 0, 0);
          }
          const uint2 vv2 = *(const uint2*)(SB + S3_VT + (w * 16 + fr) * 16 + (fq & 1) * 8);
          const u32x4v t4 = {pack2(accR[0], accR[1]), pack2(accR[2], accR[3]), vv2.x, vv2.y};
          brv = fq < 2 ? __builtin_bit_cast(bf16x8, t4) : zfrag();
        }
        f32x4 accY = __builtin_amdgcn_mfma_f32_16x16x32_bf16(aq0, bs0, z4, 0, 0, 0);
        accY = __builtin_amdgcn_mfma_f32_16x16x32_bf16(aq1, bs1, accY, 0, 0, 0);
        if (DELTA) {
          const uint2 qb2 = *(const uint2*)(SB + S3_QBM + (fr & 7) * 16 + (fq & 1) * 8);
          const uint2 qk2 = *(const uint2*)(SB + S3_QKM + (fr & 7) * 16 + (fq & 1) * 8);
          const u32x4v q4 = {qb2.x, qb2.y, qk2.x, qk2.y};
          const bf16x8 aqm = fq < 2 ? __builtin_bit_cast(bf16x8, q4) : zfrag();
          accY = __builtin_amdgcn_mfma_f32_16x16x32_bf16(aqm, brv, accY, 0, 0, 0);
        } else {
          accY = __builtin_amdgcn_mfma_f32_16x16x32_bf16(aqk, bv, accY, 0, 0, 0);
        }
        if (fq < 2) {
#pragma unroll
          for (int r = 0; r < 4; r++) {
            const int i = fq * 4 + r, j = dir ? 7 - i : i;
            YS[(size_t)(seg_row0 + t_lo + sc * 8 + j) * YST + dir * 768 + MIX * 256 + h * 64 + w * 16 + fr] = f2bf(accY[r]);
          }
        }
#pragma unroll
        for (int nt = 0; nt < 4; nt++) {
          f32x4 an;
          if (DELTA) {
            const uint2 b2 = *(const uint2*)(SB + S3_BT + (nt * 16 + fr) * 16 + (fq & 1) * 8);
            const uint2 k2 = *(const uint2*)(SB + S3_KVT + (nt * 16 + fr) * 16 + (fq & 1) * 8);
            const u32x4v a4 = {b2.x, b2.y, k2.x, k2.y};
            const bf16x8 am = fq < 2 ? __builtin_bit_cast(bf16x8, a4) : zfrag();
            an = __builtin_amdgcn_mfma_f32_16x16x32_bf16(am, brv, z4, 0, 0, 0);
          } else {
            const bf16x8 akv = fq == 0 ? ld_frag(SB + S3_KVT + (nt * 16 + fr) * 16) : zfrag();
            an = __builtin_amdgcn_mfma_f32_16x16x32_bf16(akv, bv, z4, 0, 0, 0);
          }
          const float4 wc = *(const float4*)(SB + S3_WC + (nt * 16 + fq * 4) * 4);
          st[nt][0] = st[nt][0] * wc.x + an[0];
          st[nt][1] = st[nt][1] * wc.y + an[1];
          st[nt][2] = st[nt][2] * wc.z + an[2];
          st[nt][3] = st[nt][3] * wc.w + an[3];
        }
#undef LDP
      }
    }
    __syncthreads();
  }
}

__device__ __forceinline__ void attn_item(const Params& p, int l, int b, int qb, int hk, bool isctx, unsigned char* smem) {
  u16* KS = (u16*)smem;
  u16* VT = KS + 64 * LDT;
  u16* PL = VT + 64 * LDT;
  float2* ROPE = (float2*)(PL + 8 * 32 * LDT);
  const int tid = TIDX, lane = tid & 63, w = tid >> 6, fr = lane & 15, fq = lane >> 4;
  const u16* P = (const u16*)(p.ws + OFF_BIG);
  u16* Y = (u16*)(p.ws + OFF_YS);
  const int qh = hk * 2 + (w >> 2);
  const int tb = qb * 128 + (w & 3) * 32;
  const int qrow0 = b * TPB + (isctx ? 0 : LC);
  __syncthreads();
  for (int i = tid; i < 1024; i += NTHR) {
    int pos = i >> 4, fi = i & 15;
    float inv = powf(10000.f, -(float)fi / 16.f);
    float sn, cs;
    sincosf((float)pos * inv, &sn, &cs);
    ROPE[i] = make_float2(cs, sn);
  }
  __syncthreads();
  bf16x8 qf[2][2];
#pragma unroll
  for (int mi = 0; mi < 2; mi++)
#pragma unroll
    for (int ks = 0; ks < 2; ks++) {
      const int tq = tb + mi * 16 + fr;
      const u16* qp = P + (size_t)(qrow0 + tq) * PST + PD + qh * 64 + ks * 32;
      uint4 own = *(const uint4*)(qp + fq * 8);
      uint4 par = *(const uint4*)(qp + (fq ^ 2) * 8);
      const unsigned ow[4] = {own.x, own.y, own.z, own.w};
      const unsigned pw[4] = {par.x, par.y, par.z, par.w};
      const int pos = ks == 0 ? (tq >> 6) : (tq & 63);
      bf16x8 f;
#pragma unroll
      for (int jj = 0; jj < 8; jj++) {
        float xo = bf2f((u16)((ow[jj >> 1] >> ((jj & 1) * 16)) & 0xffff));
        float xp = bf2f((u16)((pw[jj >> 1] >> ((jj & 1) * 16)) & 0xffff));
        float v = xo;
        if (!isctx) {
          float2 cs = ROPE[pos * 16 + (fq & 1) * 8 + jj];
          v = fq < 2 ? xo * cs.x - xp * cs.y : xp * cs.y + xo * cs.x;
        }
        f[jj] = (short)f2bf(v * 0.125f);
      }
      qf[mi][ks] = f;
    }
  f32x4 oacc[2][4];
#pragma unroll
  for (int mi = 0; mi < 2; mi++)
#pragma unroll
    for (int nd = 0; nd < 4; nd++) oacc[mi][nd] = f32x4{0.f, 0.f, 0.f, 0.f};
  float mrow[2][4], lrow[2][4];
#pragma unroll
  for (int mi = 0; mi < 2; mi++)
#pragma unroll
    for (int r = 0; r < 4; r++) { mrow[mi][r] = -1e30f; lrow[mi][r] = 0.f; }

  const int q0 = qb * 128;
  const int band_lo = isctx ? 0 : max(0, q0 - 128), band_hi = isctx ? 0 : min(SEQ, q0 + 256);
  const int ntile = 4 + (band_hi - band_lo) / 64;
  u16* pl = PL + w * 32 * LDT;
  for (int tl = 0; tl < ntile; tl++) {
    const bool band = tl >= 4;
    const int k0 = band ? band_lo + (tl - 4) * 64 : tl * 64;
    __syncthreads();
    {
      const int key = tid >> 3, kc = tid & 7;
      const int kpos = k0 + key;
      const u16* kp = P + (size_t)(b * TPB + (band ? LC : 0) + kpos) * PST + PD + 256 + hk * 64;
      uint4 own = *(const uint4*)(kp + kc * 8);
      uint4 vv = *(const uint4*)(kp + 128 + kc * 8);
      uint4 par = *(const uint4*)(kp + (kc ^ 2) * 8);
      if (band) {
        const unsigned ow[4] = {own.x, own.y, own.z, own.w};
        const unsigned pw[4] = {par.x, par.y, par.z, par.w};
        const int pos = kc < 4 ? (kpos >> 6) : (kpos & 63);
        unsigned res[4];
#pragma unroll
        for (int jj = 0; jj < 8; jj += 2) {
          float v2[2];
#pragma unroll
          for (int e = 0; e < 2; e++) {
            float xo = bf2f((u16)((ow[jj >> 1] >> (e * 16)) & 0xffff));
            float xp = bf2f((u16)((pw[jj >> 1] >> (e * 16)) & 0xffff));
            float2 cs = ROPE[pos * 16 + (kc & 1) * 8 + jj + e];
            v2[e] = (kc & 2) == 0 ? xo * cs.x - xp * cs.y : xp * cs.y + xo * cs.x;
          }
          res[jj >> 1] = pack2(v2[0], v2[1]);
        }
        own = make_uint4(res[0], res[1], res[2], res[3]);
      }
      *(uint4*)(KS + key * LDT + kc * 8) = own;
      const unsigned vw[4] = {vv.x, vv.y, vv.z, vv.w};
#pragma unroll
      for (int jj = 0; jj < 8; jj++) VT[(kc * 8 + jj) * LDT + key] = (u16)((vw[jj >> 1] >> ((jj & 1) * 16)) & 0xffff);
    }
    __syncthreads();
    f32x4 sc[2][4];
#pragma unroll
    for (int mi = 0; mi < 2; mi++)
#pragma unroll
      for (int nj = 0; nj < 4; nj++) sc[mi][nj] = f32x4{0.f, 0.f, 0.f, 0.f};
#pragma unroll
    for (int ks = 0; ks < 2; ks++) {
      bf16x8 kf[4];
#pragma unroll
      for (int nj = 0; nj < 4; nj++) kf[nj] = *(const bf16x8*)(KS + (nj * 16 + fr) * LDT + ks * 32 + fq * 8);
#pragma unroll
      for (int mi = 0; mi < 2; mi++)
#pragma unroll
        for (int nj = 0; nj < 4; nj++) sc[mi][nj] = __builtin_amdgcn_mfma_f32_16x16x32_bf16(qf[mi][ks], kf[nj], sc[mi][nj], 0, 0, 0);
    }
#pragma unroll
    for (int mi = 0; mi < 2; mi++)
#pragma unroll
      for (int r = 0; r < 4; r++) {
        const int qpos = tb + mi * 16 + fq * 4 + r;
        float mx = -1e30f;
#pragma unroll
        for (int nj = 0; nj < 4; nj++) {
          float v = sc[mi][nj][r];
          if (band) {
            int d = qpos - (k0 + nj * 16 + fr);
            if (d > 128 || d < -128) v = -1e30f;
          }
          sc[mi][nj][r] = v;
          mx = fmaxf(mx, v);
        }
        mx = fmaxf(mx, __shfl_xor(mx, 1));
        mx = fmaxf(mx, __shfl_xor(mx, 2));
        mx = fmaxf(mx, __shfl_xor(mx, 4));
        mx = fmaxf(mx, __shfl_xor(mx, 8));
        const float mnew = fmaxf(mrow[mi][r], mx);
        const float alpha = __expf(mrow[mi][r] - mnew);
        mrow[mi][r] = mnew;
        float ls = 0.f;
#pragma unroll
        for (int nj = 0; nj < 4; nj++) {
          float pe = __expf(sc[mi][nj][r] - mnew);
          ls += pe;
          pl[(mi * 16 + fq * 4 + r) * LDT + nj * 16 + fr] = f2bf(pe);
        }
        lrow[mi][r] = lrow[mi][r] * alpha + ls;
#pragma unroll
        for (int nd = 0; nd < 4; nd++) oacc[mi][nd][r] *= alpha;
      }
    asm volatile("s_waitcnt lgkmcnt(0)" ::: "memory");
    __builtin_amdgcn_wave_barrier();
#pragma unroll
    for (int ks = 0; ks < 2; ks++) {
      bf16x8 pf[2], vf[4];
#pragma unroll
      for (int mi = 0; mi < 2; mi++) pf[mi] = *(const bf16x8*)(pl + (mi * 16 + fr) * LDT + ks * 32 + fq * 8);
#pragma unroll
      for (int nd = 0; nd < 4; nd++) vf[nd] = *(const bf16x8*)(VT + (nd * 16 + fr) * LDT + ks * 32 + fq * 8);
#pragma unroll
      for (int mi = 0; mi < 2; mi++)
#pragma unroll
        for (int nd = 0; nd < 4; nd++) oacc[mi][nd] = __builtin_amdgcn_mfma_f32_16x16x32_bf16(pf[mi], vf[nd], oacc[mi][nd], 0, 0, 0);
    }
    asm volatile("s_waitcnt lgkmcnt(0)" ::: "memory");
    __builtin_amdgcn_wave_barrier();
  }
  const float sink = p.attn_sink[l * 4 + qh];
#pragma unroll
  for (int mi = 0; mi < 2; mi++)
#pragma unroll
    for (int r = 0; r < 4; r++) {
      float ls = lrow[mi][r];
      ls += __shfl_xor(ls, 1);
      ls += __shfl_xor(ls, 2);
      ls += __shfl_xor(ls, 4);
      ls += __shfl_xor(ls, 8);
      ls += __expf(sink - mrow[mi][r]);
      const float inv = 1.f / ls;
      const int tq = tb + mi * 16 + fq * 4 + r;
#pragma unroll
      for (int nd = 0; nd < 4; nd++) Y[(size_t)(qrow0 + tq) * YST + 1536 + qh * 64 + nd * 16 + fr] = f2bf(oacc[mi][nd][r] * inv);
    }
}

#ifndef SCAN3_MASK
#define SCAN3_MASK 7
#endif
__device__ __forceinline__ void phase_mix(const Params& p, int l, unsigned char* smem) {
  float* sm = (float*)smem;
  const int G = gridDim.x;
  for (int it = blockIdx.x; it < 192; it += G) {
    const int mix = it >> 6, rem = it & 63, b = rem >> 3, h = (rem >> 1) & 3, dir = rem & 1;
    if (mix == 0 && (SCAN3_MASK & 1)) scan3_item<0>(p, l, b, h, dir, smem);
    else if (mix == 1 && (SCAN3_MASK & 2)) scan3_item<1>(p, l, b, h, dir, smem);
    else if (mix == 2 && (SCAN3_MASK & 4)) scan3_item<2>(p, l, b, h, dir, smem);
  }
  if (SCAN3_MASK != 7) {
    for (int it = blockIdx.x; it < 768; it += G) {
      const int mix = it >> 8, rem = it & 255, b = rem >> 5, h = (rem >> 3) & 3, dir = (rem >> 2) & 1, rq = rem & 3;
      if (mix == 0 && !(SCAN3_MASK & 1)) scan2_item<0>(p, l, b, h, dir, rq, sm);
      else if (mix == 1 && !(SCAN3_MASK & 2)) scan2_item<1>(p, l, b, h, dir, rq, sm);
      else if (mix == 2 && !(SCAN3_MASK & 4)) scan2_item<2>(p, l, b, h, dir, rq, sm);
    }
  }
  __syncthreads();
  {
    const bool spread = G >= 192;
    const int nconv = spread ? 64 : G, fidx = spread ? (int)blockIdx.x - 128 : (int)blockIdx.x;
    if (fidx >= 0 && fidx < nconv)
      for (int it = 832 + fidx; it < 4480; it += nconv) conv_item(p, l, it, (float*)smem);
    __syncthreads();
  }
  unsigned* ctr = (unsigned*)(p.ws + OFF_CTR) + l * 16;
  volatile int* slot = (volatile int*)(smem + 131072 - 16);
  for (;;) {
    if (TIDX == 0) *slot = (int)atomicAdd(ctr, 1u);
    __syncthreads();
    const int it = *slot;
    __syncthreads();
    if (it >= (l == 0 ? 544 : 512)) break;
    if (it < 512) {
      int b = it >> 6, qb = (it >> 1) & 31, hk = it & 1;
      attn_item(p, l, b, qb, hk, false, smem);
    } else {
      int r = it - 512, b = r >> 2, qb = (r >> 1) & 1, hk = r & 1;
      attn_item(p, l, b, qb, hk, true, smem);
    }
  }
}

#define POST_DECL(PFX) uint2 PFX##ya0, PFX##ya1, PFX##ya2, PFX##yc0, PFX##yc1, PFX##yc2, PFX##vp, PFX##vc, PFX##vn, PFX##gb, PFX##gc; \
  u16 PFX##xp, PFX##xc, PFX##xn; float2 PFX##bc
#define POST_LOAD(PFX, R_)                                                                         \
  do {                                                                                             \
    const int r_ = (R_);                                                                           \
    const int b_ = r_ / TPB, t_ = r_ - b_ * TPB;                                                   \
    const bool hp_ = (t_ != 0) && (t_ != LC), hn_ = (t_ != LC - 1) && (t_ != TPB - 1);            \
    const u16* ys_ = YSc + (size_t)r_ * YST;                                                       \
    const u16* pr_ = Pc + (size_t)r_ * PST;                                                        \
    const u16* pp_ = pr_ - (hp_ ? PST : 0);                                                        \
    const u16* pn_ = pr_ + (hn_ ? PST : 0);                                                        \
    PFX##ya0 = *(const uint2*)(ys_ + j0); PFX##ya1 = *(const uint2*)(ys_ + 256 + j0); PFX##ya2 = *(const uint2*)(ys_ + 512 + j0); \
    PFX##yc0 = *(const uint2*)(ys_ + 768 + j0); PFX##yc1 = *(const uint2*)(ys_ + 1024 + j0); PFX##yc2 = *(const uint2*)(ys_ + 1280 + j0); \
    PFX##vp = *(const uint2*)(pp_ + PA + 512 + j0);                                                \
    PFX##vc = *(const uint2*)(pr_ + PA + 512 + j0);                                                \
    PFX##vn = *(const uint2*)(pn_ + PA + 512 + j0);                                                \
    PFX##gb = *(const uint2*)(pr_ + PB + 784 + j0);                                                \
    PFX##gc = *(const uint2*)(pr_ + PC + 544 + j0);                                                \
    PFX##xp = pp_[PA + 896 + lane]; PFX##xc = pr_[PA + 896 + lane]; PFX##xn = pn_[PA + 896 + lane]; \
    PFX##bc = *(const float2*)(BCc + (size_t)r_ * 8 + (lane >> 4) * 2);                            \
  } while (0)
__device__ __forceinline__ void unpack4(uint2 v, float (&o)[4]) {
  o[0] = __uint_as_float(v.x << 16); o[1] = __uint_as_float(v.x & 0xffff0000u);
  o[2] = __uint_as_float(v.y << 16); o[3] = __uint_as_float(v.y & 0xffff0000u);
}

__device__ __forceinline__ void phase_post(const Params& p, int l, float* g2s) {
  const int lane = TIDX & 63, wv = __builtin_amdgcn_readfirstlane(TIDX >> 6);
  u16* YS = (u16*)(p.ws + OFF_YS);
  const int j0 = lane * 4;
  {
    const float4* src = (const float4*)(p.rwkv_g2 + (size_t)l * 64 * 256);
    for (int i = TIDX; i < 64 * 256 / 4; i += NTHR) ((float4*)g2s)[i] = src[i];
  }
  float mu_v[4], lng[4], lnb[4], ngb[4], ngc[4];
#pragma unroll
  for (int i = 0; i < 4; i++) {
    mu_v[i] = p.rwkv_mu[l * 960 + 512 + j0 + i];
    lng[i] = p.rwkv_ln_g[l * 256 + j0 + i];
    lnb[i] = p.rwkv_ln_b[l * 256 + j0 + i];
    ngb[i] = p.gdn_norm_g[l * 64 + (lane & 15) * 4 + i];
    ngc[i] = p.gla_norm_g[l * 64 + (lane & 15) * 4 + i];
  }
  const float mu_x = p.rwkv_mu[l * 960 + 896 + lane];
  __syncthreads();
  const int stride = gridDim.x * 8;
  int r = blockIdx.x * 8 + wv;
  const u16* Pc = (const u16*)(p.ws + OFF_BIG);
  const u16* YSc = (const u16*)(p.ws + OFF_YS);
  const float* BCc = (const float*)(p.ws + OFF_BC);
  POST_DECL(cur_);
  POST_DECL(nxt_);
  POST_LOAD(cur_, r);
  for (; r < NROWS; r += stride) {
    const int rn = r + stride < NROWS ? r + stride : r;
    POST_LOAD(nxt_, rn);
    const int b = r / TPB, t = r - b * TPB;
    const float pmul = ((t != 0) && (t != LC)) ? 1.f : 0.f, nmul = ((t != LC - 1) && (t != TPB - 1)) ? 1.f : 0.f;
    if (!(l == 1 && t < LC)) {
    float y[3][4];
    {
      float a4[4], c4[4];
      unpack4(cur_ya0, a4); unpack4(cur_yc0, c4);
#pragma unroll
      for (int i = 0; i < 4; i++) y[0][i] = a4[i] + c4[i];
      unpack4(cur_ya1, a4); unpack4(cur_yc1, c4);
#pragma unroll
      for (int i = 0; i < 4; i++) y[1][i] = a4[i] + c4[i];
      unpack4(cur_ya2, a4); unpack4(cur_yc2, c4);
#pragma unroll
      for (int i = 0; i < 4; i++) y[2][i] = a4[i] + c4[i];
    }
    float o[3][4];
    {
      float sum = y[0][0] + y[0][1] + y[0][2] + y[0][3];
      sum = red16(sum);
      const float mean = sum * (1.f / 64.f);
      float vs = 0.f;
#pragma unroll
      for (int i = 0; i < 4; i++) { float d = y[0][i] - mean; vs += d * d; }
      vs = red16(vs);
      const float rstd = rsq(vs * (1.f / 64.f) + 64e-5f);
      const float pv = bf2f(cur_xc), ppv = bf2f(cur_xp) * pmul, pnv = bf2f(cur_xn) * nmul;
      const float sg = sigm(pv + (0.5f * (ppv + pnv) - pv) * mu_x);
      float gate[4] = {0.f, 0.f, 0.f, 0.f};
      const float* g2 = g2s + j0;
#pragma unroll 8
      for (int i = 0; i < 64; i++) {
        const float si = __int_as_float(__builtin_amdgcn_readlane(__float_as_int(sg), i));
        const float4 gw = *(const float4*)(g2 + i * 256);
        gate[0] += si * gw.x; gate[1] += si * gw.y; gate[2] += si * gw.z; gate[3] += si * gw.w;
      }
      const float bcs = cur_bc.x + cur_bc.y;
      float vc4[4], vp4[4], vn4[4];
      unpack4(cur_vc, vc4); unpack4(cur_vp, vp4); unpack4(cur_vn, vn4);
#pragma unroll
      for (int i = 0; i < 4; i++) {
        const float v = vc4[i] + (0.5f * (vp4[i] * pmul + vn4[i] * nmul) - vc4[i]) * mu_v[i];
        const float yn = (y[0][i] - mean) * rstd * lng[i] + lnb[i];
        o[0][i] = (yn + bcs * v) * gate[i];
      }
    }
#pragma unroll
    for (int m = 1; m < 3; m++) {
      float ss = y[m][0] * y[m][0] + y[m][1] * y[m][1] + y[m][2] * y[m][2] + y[m][3] * y[m][3];
      ss = red16(ss);
      const float inv = rsq(ss * (1.f / 64.f) + 1e-6f);
      float g4[4];
      unpack4(m == 1 ? cur_gb : cur_gc, g4);
#pragma unroll
      for (int i = 0; i < 4; i++) o[m][i] = y[m][i] * inv * (m == 1 ? ngb[i] : ngc[i]) * siluf(g4[i]);
    }
    u16* ys = YS + (size_t)r * YST;
#pragma unroll
    for (int m = 0; m < 3; m++) {
      uint2 ov;
      ov.x = pack2(o[m][0], o[m][1]);
      ov.y = pack2(o[m][2], o[m][3]);
      *(uint2*)(ys + m * 256 + j0) = ov;
    }
    }
    cur_ya0 = nxt_ya0; cur_ya1 = nxt_ya1; cur_ya2 = nxt_ya2; cur_yc0 = nxt_yc0; cur_yc1 = nxt_yc1; cur_yc2 = nxt_yc2;
    cur_vp = nxt_vp; cur_vc = nxt_vc; cur_vn = nxt_vn; cur_gb = nxt_gb; cur_gc = nxt_gc;
    cur_xp = nxt_xp; cur_xc = nxt_xc; cur_xn = nxt_xn; cur_bc = nxt_bc;
  }
}

#define XB_TMO      128
#define XB_XCNT(j)  (256  + 64 * (j))
#define XB_XSUB(j)  (1280 + 64 * (j))
#define XB_XGEN(j)  (2304 + 64 * (j))
#define XB_TOP      3328
#define XB_TOPGEN   3392
#define XCD_BAR_WORDS 3456
#define XB_SPIN_CAP (1u << 18)
#define LAS __attribute__((address_space(3)))

__device__ __forceinline__ unsigned xb_ld(unsigned* p)              { return __hip_atomic_load(p, __ATOMIC_RELAXED, __HIP_MEMORY_SCOPE_AGENT); }
__device__ __forceinline__ unsigned xb_add(unsigned* p, unsigned v) { return __hip_atomic_fetch_add(p, v, __ATOMIC_RELAXED, __HIP_MEMORY_SCOPE_AGENT); }
__device__ __forceinline__ unsigned xb_xcc_id() { return (unsigned)__builtin_amdgcn_s_getreg((3 << 11) | 20) & 0xFu; }
#define XB_SPIN(cond, bar) do { unsigned _sp = 0; while (cond) { __builtin_amdgcn_s_sleep(1); \
    if ((++_sp & 255u) == 0u) { if (xb_ld(&(bar)[XB_TMO])) break; if (_sp > XB_SPIN_CAP) { atomicAdd(&(bar)[XB_TMO], 1u); break; } } } } while (0)

struct XcdBarrier {
    unsigned* bar; unsigned x;
    volatile LAS unsigned* st;
};

__device__ __forceinline__ XcdBarrier xcd_barrier_post(unsigned* bar, volatile LAS unsigned* st) {
    XcdBarrier b; b.bar = bar; b.x = xb_xcc_id(); b.st = st;
    if (threadIdx.x == 0) (void)xb_add(&bar[XB_XCNT(b.x)], 1u);
    return b;
}
__device__ __forceinline__ void xcd_barrier_complete(unsigned* bar, unsigned x, unsigned& nloc, unsigned& nx) {
    const unsigned G = gridDim.x * gridDim.y * gridDim.z;
    unsigned sum, cnt, mine, sp = 0u;
    for (;;) {
        sum = 0u; cnt = 0u; mine = 0u;
#pragma unroll
        for (unsigned j = 0; j < 16; ++j) { const unsigned c = xb_ld(&bar[XB_XCNT(j)]); sum += c; cnt += (c > 0u) ? 1u : 0u; mine = (j == x) ? c : mine; }
        if (sum == G) break;
        __builtin_amdgcn_s_sleep(1);
        if ((++sp & 255u) == 0u) { if (xb_ld(&bar[XB_TMO])) break; if (sp > XB_SPIN_CAP) { atomicAdd(&bar[XB_TMO], 1u); break; } }
    }
    nloc = mine > 0u ? mine : 1u; nx = cnt > 0u ? cnt : 1u;
}

__device__ __forceinline__ void xcd_barrier(const XcdBarrier& b) {
    asm volatile("s_waitcnt vmcnt(0)" ::: "memory");
    __syncthreads();
    if (threadIdx.x == 0) {
        unsigned* bar = b.bar;
        __builtin_amdgcn_s_waitcnt(0);
        unsigned nloc = b.st[0], nx = b.st[1];
        if (nloc == 0u) { xcd_barrier_complete(bar, b.x, nloc, nx); b.st[0] = nloc; b.st[1] = nx; }
        const unsigned old = xb_add(&bar[XB_XSUB(b.x)], 1u);
        const unsigned gen = old / nloc;
        if (old + 1u == (gen + 1u) * nloc) {
            __builtin_amdgcn_fence(__ATOMIC_RELEASE, "agent");
            asm volatile("s_waitcnt vmcnt(0)" ::: "memory");
            const unsigned og = xb_add(&bar[XB_TOP], 1u);
            const unsigned tg = og / nx;
            if (og + 1u == (tg + 1u) * nx) xb_add(&bar[XB_TOPGEN], 1u);
            else XB_SPIN(xb_ld(&bar[XB_TOPGEN]) == tg, bar);
            __builtin_amdgcn_fence(__ATOMIC_ACQUIRE, "agent");
            xb_add(&bar[XB_XGEN(b.x)], 1u);
            asm volatile("s_waitcnt vmcnt(0)" ::: "memory");
        } else {
            XB_SPIN(xb_ld(&bar[XB_XGEN(b.x)]) == gen, bar);
            __builtin_amdgcn_fence(__ATOMIC_ACQUIRE, "agent");
            asm volatile("s_waitcnt vmcnt(0)" ::: "memory");
        }
    }
    __syncthreads();
}

#if defined(SKIPS)
#define EN(k) (SKIPS != (k))
#elif !defined(ONLYS)
#define EN(k) 1
#else
#define EN(k) (ONLYS == (k))
#endif
__device__ __forceinline__ void run_phase(const Params& p, int ph, unsigned char* smem) {
  if (ph == 0) { if (EN(10)) phase_init0(p, (float*)smem); return; }
  if (ph == 1) { if (EN(11)) phase_init1(p); return; }
  int l = 0, s = 10;
  if (ph >= 3) { l = (ph - 3) / 10; s = (ph - 3) - l * 10; }
  unsigned char* wl = p.ws + OFF_W;
  PG8_LAS unsigned char* lds = (PG8_LAS unsigned char*)smem;
  pg8::StaticOrder S;
  if (s == 10 || s == 6 || s == 9) {
    if (EN(5)) rowpass(p, l, s == 10 ? 0 : (s == 6 ? 1 : 2));
    if (s == 9 && l == 0) {
      __syncthreads();
      for (int it = blockIdx.x; it < 832; it += gridDim.x) conv_item(p, 1, it, (float*)smem);
    }
  } else if (s == 0 || s == 3 || s == 5 || s == 8) {
    pg8::Gemm g; EpiBf E;
    g.M = NROWS; E.bias = nullptr; E.act = 0;
    if (s == 0) { g.A = (const u16*)(p.ws + OFF_H); g.lda = DM; g.Bt = (const u16*)(wl + OW_IN); g.K = DM; g.N = PST; E.O = (u16*)(p.ws + OFF_BIG); E.ldc = PST; }
    else if (s == 3) {
      g.A = (const u16*)(p.ws + OFF_H); g.lda = DM; g.Bt = (const u16*)(wl + OW_G); g.K = DM; g.N = 4096;
      E.O = (u16*)(p.ws + OFF_BIG); E.ldc = 4096; E.bias = p.gate_b + (size_t)l * 4096; E.act = 1;
    }
    else if (s == 5) { g.A = (const u16*)(p.ws + OFF_H); g.lda = DM; g.Bt = (const u16*)(wl + OW_O); g.K = DM; g.N = DM; E.O = (u16*)(p.ws + OFF_BIG); E.ldc = DM; }
    else { g.A = (const u16*)(p.ws + OFF_BIG); g.lda = FH; g.Bt = (const u16*)(wl + OW_2); g.K = FH; g.N = DM; E.O = (u16*)(p.ws + OFF_YS); E.ldc = DM; }
    if (l == 1 && s != 0) S.init(NBATCH * SEQ, g.N, gridDim.x, blockIdx.x, 1);
    else S.init(g.M, g.N, gridDim.x, blockIdx.x);
    if (EN(0)) pg8::gemm_phase<EpiBf, pg8::StaticOrder, false>(lds, g, S, E, nullptr);
  } else if (s == 4) {
    if (EN(3)) phase_ypart(p, l, smem);
  } else if (s == 1) {
    if (EN(1)) phase_mix(p, l, smem);
  } else if (s == 2) {
    if (EN(2)) phase_post(p, l, (float*)smem);
  } else {
    pg8::Gemm g; EpiSwiglu E;
    g.M = NROWS; g.N = 2 * FH; g.K = DM; g.lda = DM; g.A = (const u16*)(p.ws + OFF_H); g.Bt = (const u16*)(wl + OW_1);
    E.O = (u16*)(p.ws + OFF_BIG);
    if (l == 1) S.init(NBATCH * SEQ, g.N, gridDim.x, blockIdx.x, 1);
    else S.init(g.M, g.N, gridDim.x, blockIdx.x);
    if (EN(6)) pg8::gemm_phase<EpiSwiglu, pg8::StaticOrder, false>(lds, g, S, E, nullptr);
  }
}

__global__ void __launch_bounds__(NTHR) hybrid_flow_mega(Params p, int ph0, int ph1) {
  __shared__ __attribute__((aligned(16))) unsigned char smem[131072];
  __shared__ __attribute__((aligned(16))) unsigned xbw[4];
  cg::grid_group grid = cg::this_grid();
  XcdBarrier xb;
  xb.bar = (unsigned*)(p.ws + OFF_XBAR); xb.x = 0u; xb.st = (volatile LAS unsigned*)xbw;
  for (int ph = ph0; ph < ph1; ph++) {
    run_phase(p, ph, smem);
#ifdef DUPMASK
    {
      int sidx = ph >= 3 ? (ph - 3) % 10 : 12 + ph;
      if ((DUPMASK >> sidx) & 1) { __syncthreads(); run_phase(p, ph, smem); }
    }
#endif
    if (ph + 1 < ph1) {
      if (ph == ph0) {
        grid.sync();
        if (threadIdx.x < 4) xbw[threadIdx.x] = 0u;
        __syncthreads();
        xb = xcd_barrier_post((unsigned*)(p.ws + OFF_XBAR), (volatile LAS unsigned*)xbw);
      } else {
        xcd_barrier(xb);
      }
    }
  }
  if (ph1 - ph0 > 2 && threadIdx.x == 0 && xb_ld(&xb.bar[XB_TMO]) != 0u) p.out[blockIdx.x] = __int_as_float(0x7fc00000);
}

extern "C" void kernel_launch(void* const* d_in, const int* in_sizes, int n_in, void* d_out, int out_size, void* d_ws,
                              size_t ws_size, hipStream_t stream) {
  Params p{};
  const float** pp = (const float**)&p;
  for (int i = 0; i < 32; i++) pp[i] = (const float*)d_in[i];
  p.out = (float*)d_out;
  p.ws = (unsigned char*)d_ws;
  static int grid_blocks = 0;
  if (!grid_blocks) {
    int dev = 0, cus = 0, per_cu = 0;
    hipGetDevice(&dev);
    hipDeviceGetAttribute(&cus, hipDeviceAttributeMultiprocessorCount, dev);
    hipOccupancyMaxActiveBlocksPerMultiprocessor(&per_cu, hybrid_flow_mega, NTHR, 0);
    if (per_cu < 1) per_cu = 1;
    grid_blocks = cus * per_cu;
  }
#ifdef MULTI_LAUNCH
  for (int ph = 0; ph < NPHASE; ph++) {
    hipLaunchKernelGGL(hybrid_flow_mega, dim3(grid_blocks), dim3(NTHR), 0, stream, p, ph, ph + 1);
  }
#else
  int ph0 = 0, ph1 = NPHASE;
  void* args[] = {&p, &ph0, &ph1};
  hipError_t e = hipLaunchCooperativeKernel((void*)hybrid_flow_mega, dim3(grid_blocks), dim3(NTHR), args, 0, stream);
  if (e != hipSuccess) fprintf(stderr, "cooperative launch failed: %s (grid %d)\n", hipGetErrorString(e), grid_blocks);
#endif
}
```

```cpp
#include <hip/hip_runtime.h>
#include <hip/hip_cooperative_groups.h>
#include <cstdio>
namespace cg = cooperative_groups;

typedef unsigned short u16;
using bf16x8 = __attribute__((ext_vector_type(8))) short;
using f32x4 = __attribute__((ext_vector_type(4))) float;

#define DM 1024
#define NBATCH 8
#define SEQ 4096
#define LC 256
#define TPB 4352
#define NROWS 34816
#define PST 3328
#define YST 1792
#define FH 2816
#define INW 7408
#define NTHR 512
#define PA 0
#define PB 960
#define PC 2000
#define PD 2800
#define NPHASE 23
#define SCAN3_MASK 7

struct Params {
  const float *x, *c, *ctx, *c_ctx, *ada_w, *ada_b, *norm_g, *w_in, *gate_b, *w_branch, *w_out,
      *rwkv_mu, *rwkv_w0, *rwkv_w2, *rwkv_a0, *rwkv_a2, *rwkv_g2, *rwkv_kk, *rwkv_ka, *rwkv_rk, *rwkv_ln_g,
      *rwkv_ln_b, *gdn_conv, *gdn_a_log, *gdn_dt_bias, *gdn_norm_g, *gla_gw2, *gla_gb, *gla_norm_g, *attn_sink,
      *ffn_w1, *ffn_w2;
  float* out;
  unsigned char* ws;
};

constexpr size_t SZ_WL = 36700160;
constexpr size_t OW_IN = 0;
constexpr size_t OW_G = OW_IN + (size_t)PST * 1024 * 2;
constexpr size_t OW_B = OW_G + (size_t)4096 * 1024 * 2;
constexpr size_t OW_O = OW_B + (size_t)4 * 1024 * 256 * 2;
constexpr size_t OW_1 = OW_O + (size_t)1024 * 1024 * 2;
constexpr size_t OW_2 = OW_1 + (size_t)5632 * 1024 * 2;
static_assert(OW_2 + (size_t)1024 * FH * 2 == SZ_WL, "weights size");
constexpr size_t SZ_ACT = (size_t)NROWS * DM * 2;
constexpr size_t OFF_W = 0;
constexpr size_t OFF_XC = OFF_W + SZ_WL;
constexpr size_t OFF_MODP = OFF_XC + (size_t)NBATCH * LC * DM * 4;
constexpr size_t OFF_MOD = OFF_MODP + (size_t)2 * 8 * 9 * 6144 * 4;
constexpr size_t OFF_BC = OFF_MOD + (size_t)2 * 9 * 6144 * 4;
constexpr size_t OFF_H = OFF_BC + (size_t)NROWS * 8 * 4;
constexpr size_t OFF_YS = OFF_H + SZ_ACT;
constexpr size_t OFF_BIG = OFF_YS + (size_t)NROWS * YST * 2;
constexpr size_t OFF_CTR = OFF_BIG + (size_t)NROWS * 4096 * 2;
constexpr size_t OFF_XBAR = OFF_CTR + 256;
constexpr size_t WS_END = OFF_XBAR + 3456 * 4;
static_assert(WS_END <= (size_t)536870912, "ws too large");

__device__ __forceinline__ int launder_tid() { int t = threadIdx.x; asm volatile("" : "+v"(t)); return t; }
#define TIDX (launder_tid())
typedef float f32x2_t __attribute__((ext_vector_type(2)));
typedef __bf16 bf16x2_t __attribute__((ext_vector_type(2)));
__device__ __forceinline__ unsigned pack2(float a, float b) {
  const f32x2_t v = {a, b};
  const bf16x2_t r = __builtin_convertvector(v, bf16x2_t);
  return __builtin_bit_cast(unsigned, r);
}
__device__ __forceinline__ u16 f2bf(float f) { return (u16)(pack2(f, 0.f) & 0xffffu); }
__device__ __forceinline__ float bf2f(u16 h) { return __uint_as_float(((unsigned)h) << 16); }
__device__ __forceinline__ float sigm(float x) { return __builtin_amdgcn_rcpf(1.f + __expf(-x)); }
__device__ __forceinline__ float siluf(float x) { return x * __builtin_amdgcn_rcpf(1.f + __expf(-x)); }
__device__ __forceinline__ float rsq(float x) { return __builtin_amdgcn_rsqf(x); }
__device__ __forceinline__ float softplusf(float x) { return fmaxf(x, 0.f) + __logf(1.f + __expf(-fabsf(x))); }
__device__ __forceinline__ float tanh_fast(float x) { return 1.f - 2.f * __builtin_amdgcn_rcpf(1.f + __expf(2.f * x)); }
__device__ __forceinline__ float wsum(float v) {
#pragma unroll
  for (int o = 32; o > 0; o >>= 1) v += __shfl_xor(v, o);
  return v;
}
template <int CTRL>
__device__ __forceinline__ float dppf(float x) {
  return __int_as_float(__builtin_amdgcn_update_dpp(__float_as_int(x), __float_as_int(x), CTRL, 0xf, 0xf, false));
}
__device__ __forceinline__ float red8(float x) {
  x += dppf<0xB1>(x);
  x += dppf<0x4E>(x);
  x += dppf<0x141>(x);
  return x;
}
__device__ __forceinline__ const float* xin_row(const Params& p, int r) {
  int b = r / TPB, t = r - b * TPB;
  return t < LC ? p.ctx + ((size_t)(b * LC + t)) * DM : p.x + ((size_t)(b * SEQ + t - LC)) * DM;
}
__device__ __forceinline__ float* x_row(const Params& p, int r) {
  int b = r / TPB, t = r - b * TPB;
  return t < LC ? (float*)(p.ws + OFF_XC) + ((size_t)(b * LC + t)) * DM : p.out + ((size_t)(b * SEQ + t - LC)) * DM;
}
__device__ __forceinline__ int mod_row(int r) {
  int b = r / TPB, t = r - b * TPB;
  return t < LC ? 8 : b;
}

struct MapId { int lim, off; __device__ int operator()(int n) const { return n < lim ? n + off : -1; } };
struct MapW1 { __device__ int operator()(int n) const { int q = n >> 3, s = n & 7; return s < 4 ? q * 4 + s : FH + q * 4 + (s - 4); } };

template <class Map>
__device__ __forceinline__ void conv_tile(const float* __restrict__ src, int ld, u16* __restrict__ dst, int K, int n0,
                                          int k0, Map map, float* tile) {
  const int tid = TIDX;
  const int nn = tid & 63, kr = tid >> 6;
  const int sc = map(n0 + nn);
  float tv[8];
  const int scc = sc >= 0 ? sc : 0;
  const float scm = sc >= 0 ? 1.f : 0.f;
#pragma unroll
  for (int ps = 0; ps < 8; ps++) tv[ps] = src[(size_t)(k0 + ps * 8 + kr) * ld + scc];
#pragma unroll
  for (int ps = 0; ps < 8; ps++) tile[(ps * 8 + kr) * 65 + nn] = tv[ps] * scm;
  __syncthreads();
  const int n2 = tid >> 3, kc = tid & 7;
  uint4 o;
  o.x = pack2(tile[(kc * 8 + 0) * 65 + n2], tile[(kc * 8 + 1) * 65 + n2]);
  o.y = pack2(tile[(kc * 8 + 2) * 65 + n2], tile[(kc * 8 + 3) * 65 + n2]);
  o.z = pack2(tile[(kc * 8 + 4) * 65 + n2], tile[(kc * 8 + 5) * 65 + n2]);
  o.w = pack2(tile[(kc * 8 + 6) * 65 + n2], tile[(kc * 8 + 7) * 65 + n2]);
  *(uint4*)(dst + (size_t)(n0 + n2) * K + k0 + kc * 8) = o;
  __syncthreads();
}

__device__ __forceinline__ void conv_item(const Params& p, int l, int rem, float* sm) {
      u16* wl = (u16*)(p.ws + OFF_W);
      if (rem < 832) {
        int nt = rem >> 4, kt = rem & 15;
        conv_tile(p.w_in + (size_t)l * DM * INW, INW, (u16*)((char*)wl + OW_IN), 1024, nt * 64, kt * 64, MapId{3312, 0}, sm);
      } else if (rem < 832 + 1024) {
        rem -= 832;
        int nt = rem >> 4, kt = rem & 15;
        conv_tile(p.w_in + (size_t)l * DM * INW, INW, (u16*)((char*)wl + OW_G), 1024, nt * 64, kt * 64, MapId{4096, 3312}, sm);
      } else if (rem < 1856 + 256) {
        rem -= 1856;
        int br = rem >> 6, r2 = rem & 63, nt = r2 >> 2, kt = r2 & 3;
        conv_tile(p.w_branch + ((size_t)(l * 4 + br)) * 256 * DM, DM, (u16*)((char*)wl + OW_B) + (size_t)br * 1024 * 256, 256,
                  nt * 64, kt * 64, MapId{1024, 0}, sm);
      } else if (rem < 2112 + 256) {
        rem -= 2112;
        int nt = rem >> 4, kt = rem & 15;
        conv_tile(p.w_out + (size_t)l * DM * DM, DM, (u16*)((char*)wl + OW_O), 1024, nt * 64, kt * 64, MapId{1024, 0}, sm);
      } else if (rem < 2368 + 1408) {
        rem -= 2368;
        int nt = rem >> 4, kt = rem & 15;
        conv_tile(p.ffn_w1 + (size_t)l * DM * 5632, 5632, (u16*)((char*)wl + OW_1), 1024, nt * 64, kt * 64, MapW1{}, sm);
      } else {
        rem -= 3776;
        int nt = rem / 44, kt = rem - nt * 44;
        conv_tile(p.ffn_w2 + (size_t)l * FH * DM, DM, (u16*)((char*)wl + OW_2), FH, nt * 64, kt * 64, MapId{1024, 0}, sm);
      }
}

__device__ __forceinline__ void phase_init0(const Params& p, float* sm) {
  const int tid = TIDX;
  if (blockIdx.x == 0) {
    if (tid < 64) ((unsigned*)(p.ws + OFF_CTR))[tid] = 0u;
    for (int i = tid; i < 3456; i += NTHR) ((unsigned*)(p.ws + OFF_XBAR))[i] = 0u;
  }
  constexpr int NMOD = 192, NCONV = 832;
  for (int it = blockIdx.x; it < NMOD + NCONV; it += gridDim.x) {
    if (it < NMOD) {
      int l = it / 96, rem = it - l * 96, cc = rem >> 3, ks = rem & 7;
      for (int i = tid; i < 9 * 128; i += NTHR) {
        int r = i >> 7, k = i & 127;
        float v = r < 8 ? p.c[r * DM + ks * 128 + k] : p.c_ctx[ks * 128 + k];
        sm[i] = siluf(v);
      }
      __syncthreads();
      const int n = cc * 512 + tid;
      const float* w = p.ada_w + ((size_t)l * DM + ks * 128) * 6144 + n;
      float acc[9];
#pragma unroll
      for (int r = 0; r < 9; r++) acc[r] = 0.f;
#pragma unroll 1
      for (int k0 = 0; k0 < 128; k0 += 16) {
        float wv[16];
#pragma unroll
        for (int kk = 0; kk < 16; kk++) wv[kk] = w[(size_t)(k0 + kk) * 6144];
#pragma unroll
        for (int kk = 0; kk < 16; kk++)
#pragma unroll
          for (int r = 0; r < 9; r++) acc[r] += sm[r * 128 + k0 + kk] * wv[kk];
      }
      float* mp = (float*)(p.ws + OFF_MODP) + ((size_t)(l * 8 + ks) * 9) * 6144 + n;
#pragma unroll
      for (int r = 0; r < 9; r++) mp[(size_t)r * 6144] = acc[r];
      __syncthreads();
    } else {
      conv_item(p, 0, it - NMOD, sm);
    }
  }
}

__device__ __forceinline__ void phase_init1(const Params& p) {
  const float* mp = (const float*)(p.ws + OFF_MODP);
  float* mo = (float*)(p.ws + OFF_MOD);
  for (int i = blockIdx.x * NTHR + TIDX; i < 2 * 9 * 6144; i += gridDim.x * NTHR) {
    int l = i / (9 * 6144), rem = i - l * 9 * 6144, r = rem / 6144, n = rem - r * 6144;
    float s = p.ada_b[l * 6144 + n];
#pragma unroll
    for (int ks = 0; ks < 8; ks++) s += mp[((size_t)((l * 8 + ks) * 9 + r)) * 6144 + n];
    mo[i] = s;
  }
}

__device__ __forceinline__ void rowpass(const Params& p, int l, int mode) {
  const int lane = TIDX & 63, wv = __builtin_amdgcn_readfirstlane(TIDX >> 6);
  const float* MOD = (const float*)(p.ws + OFF_MOD);
  u16* H = (u16*)(p.ws + OFF_H);
  const bool do_norm = !(mode == 2 && l == 1);
  const int ln = (mode == 2) ? (l == 1 ? l : l + 1) : l;
  const int ni = (mode == 1) ? 2 : 0, sho = (mode == 1) ? 3072 : 0, sco = (mode == 1) ? 4096 : 1024;
  for (int r = blockIdx.x * 8 + wv; r < NROWS; r += gridDim.x * 8) {
    const int mr = mod_row(r);
    if (l == 1 && mode != 0 && mr == 8) continue;
    const float* modl = MOD + ((size_t)(l * 9 + mr)) * 6144;
    const float* modn = MOD + ((size_t)(ln * 9 + mr)) * 6144;
    const float* ng2 = p.norm_g + (size_t)(ln * 4 + ni) * DM;
    const float* xs = (mode == 0 || (mode == 1 && l == 0)) ? xin_row(p, r) : (const float*)x_row(p, r);
    float4 xo[4], n2[4], sc4[4], sh4[4];
#pragma unroll
    for (int i = 0; i < 4; i++) {
      const int col = i * 256 + lane * 4;
      xo[i] = *(const float4*)(xs + col);
      n2[i] = *(const float4*)(ng2 + col);
      sc4[i] = *(const float4*)(modn + sco + col);
      sh4[i] = *(const float4*)(modn + sho + col);
    }
    float xv[16];
    if (mode == 0) {
#pragma unroll
      for (int i = 0; i < 4; i++) { xv[i * 4 + 0] = xo[i].x; xv[i * 4 + 1] = xo[i].y; xv[i * 4 + 2] = xo[i].z; xv[i * 4 + 3] = xo[i].w; }
    } else {
      const u16* src = (const u16*)(p.ws + (mode == 1 ? OFF_BIG : OFF_YS)) + (size_t)r * DM;
      const float* ng = p.norm_g + (size_t)(l * 4 + (mode == 1 ? 1 : 3)) * DM;
      const float* gt = modl + (mode == 1 ? 2048 : 5120);
      uint2 sv[4];
      float4 g4[4], n4[4];
#pragma unroll
      for (int i = 0; i < 4; i++) {
        const int col = i * 256 + lane * 4;
        sv[i] = *(const uint2*)(src + col);
        g4[i] = *(const float4*)(gt + col);
        n4[i] = *(const float4*)(ng + col);
      }
      float ov[16];
      float ss = 0.f;
#pragma unroll
      for (int i = 0; i < 4; i++) {
        ov[i * 4 + 0] = __uint_as_float(sv[i].x << 16); ov[i * 4 + 1] = __uint_as_float(sv[i].x & 0xffff0000u);
        ov[i * 4 + 2] = __uint_as_float(sv[i].y << 16); ov[i * 4 + 3] = __uint_as_float(sv[i].y & 0xffff0000u);
      }
#pragma unroll
      for (int i = 0; i < 16; i++) ss += ov[i] * ov[i];
      ss = wsum(ss);
      const float inv = rsq(ss * (1.f / 1024.f) + 1e-6f);
      float* xd = x_row(p, r);
#pragma unroll
      for (int i = 0; i < 4; i++) {
        xv[i * 4 + 0] = xo[i].x + g4[i].x * (ov[i * 4 + 0] * inv * n4[i].x);
        xv[i * 4 + 1] = xo[i].y + g4[i].y * (ov[i * 4 + 1] * inv * n4[i].y);
        xv[i * 4 + 2] = xo[i].z + g4[i].z * (ov[i * 4 + 2] * inv * n4[i].z);
        xv[i * 4 + 3] = xo[i].w + g4[i].w * (ov[i * 4 + 3] * inv * n4[i].w);
      }
#pragma unroll
      for (int i = 0; i < 4; i++)
        *(float4*)(xd + i * 256 + lane * 4) = make_float4(xv[i * 4 + 0], xv[i * 4 + 1], xv[i * 4 + 2], xv[i * 4 + 3]);
    }
    if (!do_norm) continue;
    float ss2 = 0.f;
#pragma unroll
    for (int i = 0; i < 16; i++) ss2 += xv[i] * xv[i];
    ss2 = wsum(ss2);
    const float inv2 = rsq(ss2 * (1.f / 1024.f) + 1e-6f);
#pragma unroll
    for (int i = 0; i < 4; i++) {
      const int col = i * 256 + lane * 4;
      float h0 = xv[i * 4 + 0] * inv2 * n2[i].x * (1.f + sc4[i].x) + sh4[i].x;
      float h1 = xv[i * 4 + 1] * inv2 * n2[i].y * (1.f + sc4[i].y) + sh4[i].y;
      float h2 = xv[i * 4 + 2] * inv2 * n2[i].z * (1.f + sc4[i].z) + sh4[i].z;
      float h3 = xv[i * 4 + 3] * inv2 * n2[i].w * (1.f + sc4[i].w) + sh4[i].w;
      uint2 o;
      o.x = pack2(h0, h1);
      o.y = pack2(h2, h3);
      *(uint2*)(H + (size_t)r * DM + col) = o;
    }
  }
}

#define LDT 72
namespace pg8 {
#define PG8_LAS __attribute__((address_space(3)))
typedef unsigned short bf16_t;
typedef short bf16x8 __attribute__((ext_vector_type(8)));
typedef float f32x4 __attribute__((ext_vector_type(4)));
typedef unsigned u32x4 __attribute__((ext_vector_type(4)));
constexpr int BM = 256, BK = 64, HALF = 128, HTB = HALF * BK * 2  , STAGE_BYTES = 8 * HTB, NXCD = 8, WGM = 8;

__host__ __device__ __forceinline__ int lds_byte(int r, int c) { const int st = (r >> 4) * 2 + (c >> 5), rr = r & 15, cc = c & 31, ob = rr * 64 + cc * 2; return st * 1024 + (ob ^ (((ob >> 9) & 1) << 5)); }
__host__ __device__ __forceinline__ void stage_rc(int b, int& R, int& C) { const int st = b / 1024, sb = b % 1024, swz = sb ^ (((sb >> 9) & 1) << 5); R = (st >> 1) * 16 + swz / 64; C = (st & 1) * 32 + (swz % 64) / 2; }
__host__ __device__ __forceinline__ int perm32(int rho) { const int n = rho >> 4, i = rho & 15; return 8 * (i >> 2) + 4 * n + (i & 3); }

struct Unit { int pm, pn; };
struct Gemm { const bf16_t* A; const bf16_t* Bt; int M, N, K, lda; };
struct StaticOrder {
    int nM, nN, nwg, G, c, skip;
    __host__ __device__ void init(int M, int N, int G_, int c_, int skip_ = 0) { nM = M / BM; nN = N / BM; nwg = nM * nN; G = G_; c = c_; skip = skip_; }
    __host__ __device__ bool next(int i, Unit& u) const {
        const long L = (long)i * G + c; if (L >= nwg) return false;
        int wgid = (int)L; { const int q = nwg / NXCD, r = nwg % NXCD, xcd = wgid % NXCD, off = wgid / NXCD; wgid = (xcd < r ? xcd * (q + 1) : r * (q + 1) + (xcd - r) * q) + off; }
        const int nig = WGM * nN, gid = wgid / nig, fm = gid * WGM, gsz = (nM - fm) < WGM ? (nM - fm) : WGM;
        u.pm = fm + ((wgid % nig) % gsz); u.pn = (wgid % nig) / gsz;
        if (skip) u.pm = (u.pm >> 4) * 17 + 1 + (u.pm & 15);
        return true;
    }
    __device__ __forceinline__ void a_ready(const Unit&) const {}
    __device__ __forceinline__ void done(const Unit&) const {}
};
__device__ __forceinline__ unsigned cvt_pk_bf16(float lo, float hi) { unsigned r; asm volatile("v_cvt_pk_bf16_f32 %0, %1, %2" : "=v"(r) : "v"(lo), "v"(hi)); return r; }
template <class Epi, class Sched, bool STAMP = false>
__device__ __forceinline__ void gemm_phase(PG8_LAS unsigned char* lds, const Gemm g, const Sched& S, const Epi& E, unsigned long long* stamps) {
    const int tid = TIDX, wid = __builtin_amdgcn_readfirstlane(tid >> 6), lane = tid & 63, wr = wid >> 2, wc = wid & 3, fr = lane & 15, fq = lane >> 4;
    const int K = g.K, nt = K / BK;
    int ts_lo = 0, ts_hi = 0, nts = 0; const unsigned long long rt_entry = STAMP ? (unsigned long long)wall_clock64() : 0ull;
#define PG8_STAMP() do { if (STAMP && wid == 0 && nts < 64) { const unsigned long long _c = (unsigned long long)clock64(); \
        ts_lo = (lane == nts) ? (int)(unsigned)_c : ts_lo; ts_hi = (lane == nts) ? (int)(unsigned)(_c >> 32) : ts_hi; ++nts; } } while (0)
    PG8_STAMP();
    unsigned voffA[2], voffB[2];
#pragma unroll
    for (int i = 0; i < 2; ++i) { int R, C; stage_rc(tid * 16 + i * 8192, R, C); const int Rb = Epi::PERM ? ((R & ~31) + perm32(R & 31)) : R;
        voffA[i] = (unsigned)(R * g.lda + C) * 2u; voffB[i] = (unsigned)(Rb * K + C) * 2u; }
    const size_t kstep = (size_t)(BK * 2);
    const size_t hstepB = (size_t)HALF * K * 2, hstepA = (size_t)HALF * g.lda * 2;
    const size_t tstepB = 2 * hstepB, tstepA = 2 * hstepA;
    const unsigned ldsw = (unsigned)wid * 1024u;
    const int aoff = lds_byte(wr * 64 + fr, fq * 8), boff = lds_byte(wc * 32 + fr, fq * 8);
#define PG8_SA(b, h) (((b) * 2 + (h)) * HTB)
#define PG8_SB(b, h) ((4 + (b) * 2 + (h)) * HTB)
#define PG8_STAGE(bufoff, gbase, voff) do { _Pragma("unroll") for (int _i = 0; _i < 2; ++_i) \
        __builtin_amdgcn_global_load_lds((const unsigned*)((const char*)(gbase) + (voff)[_i]), (PG8_LAS unsigned*)(lds + (bufoff) + ldsw + _i * 8192), 16, 0, 0); } while (0)
#define PG8_LDA(dst, b, h) do { _Pragma("unroll") for (int m = 0; m < 4; ++m) _Pragma("unroll") for (int k = 0; k < 2; ++k) dst[m][k] = *(const PG8_LAS bf16x8*)(lds + PG8_SA(b, h) + aoff + m * 2048 + k * 1024); } while (0)
#define PG8_LDB(dst, b, h) do { _Pragma("unroll") for (int n = 0; n < 2; ++n) _Pragma("unroll") for (int k = 0; k < 2; ++k) dst[n][k] = *(const PG8_LAS bf16x8*)(lds + PG8_SB(b, h) + boff + n * 2048 + k * 1024); } while (0)
#define PG8_MMA(ai, bj, At, Bt) do { __builtin_amdgcn_s_setprio(1); _Pragma("unroll") for (int m = 0; m < 4; ++m) _Pragma("unroll") for (int n = 0; n < 2; ++n) _Pragma("unroll") for (int k = 0; k < 2; ++k) \
        acc[ai][bj][m][n] = __builtin_amdgcn_mfma_f32_16x16x32_bf16(Bt[n][k], At[m][k], acc[ai][bj][m][n], 0, 0, 0); __builtin_amdgcn_s_setprio(0); } while (0)
#define PG8_WAIT_V(n) asm volatile("s_waitcnt vmcnt(" #n ")" ::: "memory")
#define PG8_WAIT_L(n) asm volatile("s_waitcnt lgkmcnt(" #n ")" ::: "memory")
#define PG8_BAR __builtin_amdgcn_s_barrier()
#define PG8_SCHED __builtin_amdgcn_sched_barrier(0)
    Unit cur, nxt; int ui = 0;
    if (!S.next(0, cur)) return;
    f32x4 acc[2][2][4][2];
#pragma unroll
    for (int a = 0; a < 2; ++a)
#pragma unroll
        for (int b = 0; b < 2; ++b)
#pragma unroll
            for (int m = 0; m < 4; ++m)
#pragma unroll
                for (int n = 0; n < 2; ++n) acc[a][b][m][n] = (f32x4){0.f, 0.f, 0.f, 0.f};
    bf16x8 At[4][2], B0[2][2], B1[2][2];
    const char* cA = (const char*)g.A + (size_t)cur.pm * tstepA; const char* cB = (const char*)g.Bt + (size_t)cur.pn * tstepB;
    S.a_ready(cur);
    PG8_STAGE(PG8_SB(0, 0), cB, voffB); PG8_STAGE(PG8_SA(0, 0), cA, voffA); PG8_STAGE(PG8_SB(0, 1), cB + hstepB, voffB); PG8_STAGE(PG8_SA(0, 1), cA + hstepA, voffA);
    if (wr == 1) PG8_BAR;
    PG8_WAIT_V(4); PG8_BAR;
    PG8_STAGE(PG8_SB(1, 0), cB + kstep, voffB); PG8_STAGE(PG8_SA(1, 0), cA + kstep, voffA); PG8_STAGE(PG8_SB(1, 1), cB + hstepB + kstep, voffB);
    PG8_WAIT_V(6); PG8_BAR;
    PG8_STAMP();
    for (;;) {
        const bool has_next = S.next(ui + 1, nxt);
        const char* nA = has_next ? (const char*)g.A + (size_t)nxt.pm * tstepA : cA; const char* nB = has_next ? (const char*)g.Bt + (size_t)nxt.pn * tstepB : cB;
        for (int t = 0; t < nt; t += 2) {
            const bool last = (t == nt - 2);
            const char* a1 = cA + (size_t)(t + 1) * kstep;
            const char* a2 = last ? nA : cA + (size_t)(t + 2) * kstep; const char* b2 = last ? nB : cB + (size_t)(t + 2) * kstep;
            const char* a3 = a2 + kstep; const char* b3 = b2 + kstep;
            if (last && has_next) S.a_ready(nxt);
            PG8_LDB(B0, 0, 0); PG8_SCHED; PG8_LDA(At, 0, 0); PG8_STAGE(PG8_SA(1, 1), a1 + hstepA, voffA);
            PG8_WAIT_L(8); PG8_BAR; PG8_WAIT_L(0); PG8_MMA(0, 0, At, B0); PG8_BAR; PG8_SCHED;
            PG8_LDB(B1, 0, 1); PG8_STAGE(PG8_SB(0, 0), b2, voffB);
            PG8_BAR; PG8_WAIT_L(0); PG8_MMA(0, 1, At, B1); PG8_BAR;
            PG8_LDA(At, 0, 1); PG8_STAGE(PG8_SA(0, 0), a2, voffA);
            PG8_BAR; PG8_WAIT_L(0); PG8_MMA(1, 0, At, B0); PG8_BAR; PG8_SCHED;
            PG8_STAGE(PG8_SB(0, 1), b2 + hstepB, voffB);
            PG8_WAIT_V(6); PG8_BAR; PG8_MMA(1, 1, At, B1); PG8_BAR;
            PG8_LDB(B0, 1, 0); PG8_SCHED; PG8_LDA(At, 1, 0); PG8_STAGE(PG8_SA(0, 1), a2 + hstepA, voffA);
            PG8_WAIT_L(8); PG8_BAR; PG8_WAIT_L(0); PG8_MMA(0, 0, At, B0); PG8_BAR; PG8_SCHED;
            PG8_LDB(B1, 1, 1); PG8_STAGE(PG8_SB(1, 0), b3, voffB);
            PG8_BAR; PG8_WAIT_L(0); PG8_MMA(0, 1, At, B1); PG8_BAR;
            PG8_LDA(At, 1, 1); PG8_STAGE(PG8_SA(1, 0), a3, voffA);
            PG8_BAR; PG8_WAIT_L(0); PG8_MMA(1, 0, At, B0); PG8_BAR; PG8_SCHED;
            PG8_STAGE(PG8_SB(1, 1), b3 + hstepB, voffB);
            PG8_WAIT_V(6); PG8_BAR; PG8_MMA(1, 1, At, B1); PG8_BAR;
        }
        PG8_STAMP();
        if constexpr (!Epi::AFTER_DRAIN) { E(acc, cur, wr, wc, fr, fq); S.done(cur); }
        PG8_STAMP();
        if (!has_next) break;
#pragma unroll
        for (int a = 0; a < 2; ++a)
#pragma unroll
            for (int b = 0; b < 2; ++b)
#pragma unroll
                for (int m = 0; m < 4; ++m)
#pragma unroll
                    for (int n = 0; n < 2; ++n) acc[a][b][m][n] = (f32x4){0.f, 0.f, 0.f, 0.f};
        cur = nxt; cA = nA; cB = nB; ++ui;
    }
    PG8_WAIT_V(0);
    if (wr == 0) PG8_BAR;
    PG8_BAR;
    if constexpr (Epi::AFTER_DRAIN) { E.fused(acc, cur, wr, wc, fr, fq, lds, wid, lane); S.done(cur); }
    PG8_STAMP();
    if (STAMP && wid == 0) { stamps[lane] = lane < nts ? (((unsigned long long)(unsigned)ts_hi << 32) | (unsigned)ts_lo) : 0ull;
        if (lane == 62) stamps[62] = rt_entry; if (lane == 63) stamps[63] = (unsigned long long)wall_clock64(); }
#undef PG8_STAMP
#undef PG8_SA
#undef PG8_SB
#undef PG8_STAGE
#undef PG8_LDA
#undef PG8_LDB
#undef PG8_MMA
#undef PG8_WAIT_V
#undef PG8_WAIT_L
#undef PG8_BAR
#undef PG8_SCHED
}
}

struct EpiBf {
  static constexpr bool PERM = true, AFTER_DRAIN = false;
  u16* O; int ldc; const float* bias; int act;
  __device__ __forceinline__ void operator()(const f32x4 (&acc)[2][2][4][2], const pg8::Unit& u, int wr, int wc, int fr, int fq) const {
    const int row0 = u.pm * 256 + wr * 64 + fr, col0 = u.pn * 256 + wc * 32 + 8 * fq;
    f32x4 bv[2][2];
#pragma unroll
    for (int bj = 0; bj < 2; ++bj)
#pragma unroll
      for (int n = 0; n < 2; ++n) bv[bj][n] = bias ? *(const f32x4*)(bias + col0 + bj * 128 + 4 * n) : f32x4{0.f, 0.f, 0.f, 0.f};
#pragma unroll
    for (int ai = 0; ai < 2; ++ai)
#pragma unroll
      for (int m = 0; m < 4; ++m) {
        u16* rowp = O + (size_t)(row0 + ai * 128 + m * 16) * ldc + col0;
#pragma unroll
        for (int bj = 0; bj < 2; ++bj) {
          f32x4 v0 = acc[ai][bj][m][0] + bv[bj][0], v1 = acc[ai][bj][m][1] + bv[bj][1];
          if (act == 1) {
#pragma unroll
            for (int j = 0; j < 4; ++j) { v0[j] = sigm(v0[j]); v1[j] = sigm(v1[j]); }
          }
          uint4 wv;
          wv.x = pack2(v0[0], v0[1]); wv.y = pack2(v0[2], v0[3]); wv.z = pack2(v1[0], v1[1]); wv.w = pack2(v1[2], v1[3]);
          *(uint4*)(rowp + bj * 128) = wv;
        }
      }
  }
};
struct EpiSwiglu {
  static constexpr bool PERM = true, AFTER_DRAIN = false;
  u16* O;
  __device__ __forceinline__ void operator()(const f32x4 (&acc)[2][2][4][2], const pg8::Unit& u, int wr, int wc, int fr, int fq) const {
    const int row0 = u.pm * 256 + wr * 64 + fr, col0 = u.pn * 128 + wc * 16 + 4 * fq;
#pragma unroll
    for (int ai = 0; ai < 2; ++ai)
#pragma unroll
      for (int m = 0; m < 4; ++m) {
        u16* rowp = O + (size_t)(row0 + ai * 128 + m * 16) * FH + col0;
#pragma unroll
        for (int bj = 0; bj < 2; ++bj) {
          const f32x4 g = acc[ai][bj][m][0], up = acc[ai][bj][m][1];
          uint2 wv;
          wv.x = pack2(siluf(g[0]) * up[0], siluf(g[1]) * up[1]);
          wv.y = pack2(siluf(g[2]) * up[2], siluf(g[3]) * up[3]);
          *(uint2*)(rowp + bj * 64) = wv;
        }
      }
  }
};
struct EpiGateAcc {
  static constexpr bool PERM = true, AFTER_DRAIN = false;
  u16* ACC; const u16* G; int gcol; unsigned amask;
  __device__ __forceinline__ void operator()(const f32x4 (&acc)[2][2][4][2], const pg8::Unit& u, int wr, int wc, int fr, int fq) const {
    unsigned pk[2][2][4][4];
#pragma unroll
    for (int ai = 0; ai < 2; ++ai)
#pragma unroll
      for (int bj = 0; bj < 2; ++bj)
#pragma unroll
        for (int m = 0; m < 4; ++m) {
          pk[ai][bj][m][0] = pack2(acc[ai][bj][m][0][0], acc[ai][bj][m][0][1]);
          pk[ai][bj][m][1] = pack2(acc[ai][bj][m][0][2], acc[ai][bj][m][0][3]);
          pk[ai][bj][m][2] = pack2(acc[ai][bj][m][1][0], acc[ai][bj][m][1][1]);
          pk[ai][bj][m][3] = pack2(acc[ai][bj][m][1][2], acc[ai][bj][m][1][3]);
        }
    asm volatile("" ::: "memory");
    const int row0 = u.pm * 256 + wr * 64 + fr, col0 = u.pn * 256 + wc * 32 + 8 * fq;
#pragma unroll
    for (int ai = 0; ai < 2; ++ai)
#pragma unroll
      for (int m = 0; m < 4; ++m) {
        const size_t row = (size_t)(row0 + ai * 128 + m * 16);
#pragma unroll
        for (int bj = 0; bj < 2; ++bj) {
          const int col = col0 + bj * 128;
          const uint4 gv = *(const uint4*)(G + row * 2048 + gcol + col);
          const uint4 av = *(const uint4*)(ACC + row * DM + col);
          const unsigned gw[4] = {gv.x, gv.y, gv.z, gv.w};
          const unsigned aw[4] = {av.x & amask, av.y & amask, av.z & amask, av.w & amask};
          unsigned ow[4];
#pragma unroll
          for (int q = 0; q < 4; ++q) {
            const unsigned pv = pk[ai][bj][m][q];
            const float lo = __uint_as_float(aw[q] << 16) + __uint_as_float(gw[q] << 16) * __uint_as_float(pv << 16);
            const float hi = __uint_as_float(aw[q] & 0xffff0000u) + __uint_as_float(gw[q] & 0xffff0000u) * __uint_as_float(pv & 0xffff0000u);
            ow[q] = pack2(lo, hi);
          }
          *(uint4*)(ACC + row * DM + col) = make_uint4(ow[0], ow[1], ow[2], ow[3]);
        }
        asm volatile("" ::: "memory");
      }
  }
};

template <int MI>
__device__ __forceinline__ void gemm_loop(const u16* __restrict__ A, int lda, const u16* __restrict__ Bt, int ldb, int K,
                                          f32x4 (&acc)[MI][4], u16* sA, u16* sB) {
  constexpr int BMT = MI * 64;
  const int tid = TIDX, lane = tid & 63, w = tid >> 6, wm = w >> 1, wn = w & 1, fr = lane & 15, fq = lane >> 4;
  uint4 ra[MI], rb[2];
  const u16* ga = A + (size_t)(tid >> 3) * lda + (tid & 7) * 8;
  const u16* gb = Bt + (size_t)(tid >> 3) * ldb + (tid & 7) * 8;
  const int so = (tid >> 3) * LDT + (tid & 7) * 8;
#pragma unroll
  for (int i = 0; i < MI; i++) ra[i] = *(const uint4*)(ga + (size_t)(i * 64) * lda);
#pragma unroll
  for (int i = 0; i < 2; i++) rb[i] = *(const uint4*)(gb + (size_t)(i * 64) * ldb);
#pragma unroll
  for (int i = 0; i < MI; i++) *(uint4*)(sA + so + i * 64 * LDT) = ra[i];
#pragma unroll
  for (int i = 0; i < 2; i++) *(uint4*)(sB + so + i * 64 * LDT) = rb[i];
  __syncthreads();
  const int nk = K >> 6;
  for (int kt = 0; kt < nk; kt++) {
    const bool more = kt + 1 < nk;
    if (more) {
#pragma unroll
      for (int i = 0; i < MI; i++) ra[i] = *(const uint4*)(ga + (size_t)(i * 64) * lda + (kt + 1) * 64);
#pragma unroll
      for (int i = 0; i < 2; i++) rb[i] = *(const uint4*)(gb + (size_t)(i * 64) * ldb + (kt + 1) * 64);
    }
    const u16* a = sA + (kt & 1) * BMT * LDT + (wm * (MI * 16) + fr) * LDT + fq * 8;
    const u16* b = sB + (kt & 1) * 128 * LDT + (wn * 64 + fr) * LDT + fq * 8;
#pragma unroll
    for (int ks = 0; ks < 2; ks++) {
      bf16x8 af[MI], bfr[4];
#pragma unroll
      for (int i = 0; i < MI; i++) af[i] = *(const bf16x8*)(a + i * 16 * LDT + ks * 32);
#pragma unroll
      for (int j = 0; j < 4; j++) bfr[j] = *(const bf16x8*)(b + j * 16 * LDT + ks * 32);
#pragma unroll
      for (int i = 0; i < MI; i++)
#pragma unroll
        for (int j = 0; j < 4; j++) acc[i][j] = __builtin_amdgcn_mfma_f32_16x16x32_bf16(bfr[j], af[i], acc[i][j], 0, 0, 0);
    }
    if (more) {
      u16* da = sA + ((kt + 1) & 1) * BMT * LDT + so;
      u16* db = sB + ((kt + 1) & 1) * 128 * LDT + so;
#pragma unroll
      for (int i = 0; i < MI; i++) *(uint4*)(da + i * 64 * LDT) = ra[i];
#pragma unroll
      for (int i = 0; i < 2; i++) *(uint4*)(db + i * 64 * LDT) = rb[i];
    }
    __syncthreads();
  }
}

template <int MI>
__device__ __forceinline__ void zero_acc(f32x4 (&acc)[MI][4]) {
#pragma unroll
  for (int i = 0; i < MI; i++)
#pragma unroll
    for (int j = 0; j < 4; j++) acc[i][j] = f32x4{0.f, 0.f, 0.f, 0.f};
}


typedef unsigned u32x4v __attribute__((ext_vector_type(4)));
__device__ __forceinline__ void yp_issue(const u16* __restrict__ A, const u16* __restrict__ B, u32x4v (&ra)[8], u32x4v (&rb)[8], int tid) {
#pragma unroll
  for (int i = 0; i < 8; i++) {
    const int c = tid + i * NTHR, row = c >> 5, ch = c & 31;
    ra[i] = *(const u32x4v*)(A + (size_t)row * YST + ch * 8);
    rb[i] = *(const u32x4v*)(B + (size_t)row * 256 + ch * 8);
  }
}
__device__ __forceinline__ void yp_stage(unsigned char* sA, unsigned char* sB, const u32x4v (&ra)[8], const u32x4v (&rb)[8], int tid) {
#pragma unroll
  for (int i = 0; i < 8; i++) {
    const int c = tid + i * NTHR, row = c >> 5, ch = c & 31;
    const int off = row * 512 + ((ch ^ (row & 7)) << 4);
    *(u32x4v*)(sA + off) = ra[i];
    *(u32x4v*)(sB + off) = rb[i];
  }
}
__device__ __forceinline__ void phase_ypart(const Params& p, int l, unsigned char* smem) {
  unsigned char* sA = smem;
  unsigned char* sB = smem + 65536;
  const int tid = TIDX, lane = tid & 63, w = tid >> 6, wm = w >> 1, wn = w & 1, fr = lane & 15, fq = lane >> 4;
  const u16* Y = (const u16*)(p.ws + OFF_YS);
  const u16* Wb = (const u16*)(p.ws + OFF_W + OW_B);
  const u16* G = (const u16*)(p.ws + OFF_BIG);
  u16* ACC = (u16*)(p.ws + OFF_H);
  constexpr int NT = 8;
  const int ntiles = (NROWS / 128) * NT;
  const int G_ = gridDim.x;
  const bool xmap = (G_ == 256);
  const int xj = blockIdx.x >> 3, xx = blockIdx.x & 7;
  const bool skipc = (l == 1);
  const int nrt = skipc ? 256 : 272;
  const int ntl = nrt * NT;
  const int nmine = xmap ? (xj < nrt ? (nrt - 1 - xj) / 32 + 1 : 0)
                         : (((int)blockIdx.x < ntl) ? (ntl - 1 - (int)blockIdx.x) / G_ + 1 : 0);
  if (nmine == 0) return;
#define YP_TILE(Q_, MT_, NT_)                                                        \
  do {                                                                               \
    if (xmap) { const int s_ = (Q_) * 32 + xj; MT_ = (s_ >> 3) * 8 + xx; NT_ = s_ & 7; } \
    else { const int t_ = blockIdx.x + (Q_) * G_; MT_ = t_ / NT; NT_ = t_ - MT_ * NT; }  \
    if (skipc) MT_ = (MT_ >> 5) * 34 + 2 + (MT_ & 31);                                   \
  } while (0)
  u32x4v ra[8], rb[8];
  {
    int mt, nt;
    YP_TILE(0, mt, nt);
    yp_issue(Y + (size_t)mt * 128 * YST, Wb + ((size_t)nt * 128) * 256, ra, rb, tid);
  }
  f32x4 tot[2][4];
  zero_acc<2>(tot);
  for (int qi = 0; qi < 4 * nmine; qi++) {
    const int q = qi >> 2, k = qi & 3;
    int mt, nt;
    YP_TILE(q, mt, nt);
    const int r0 = mt * 128 + wm * 32 + fr, c0 = nt * 128 + wn * 64 + fq * 4;
    uint2 gv[2][4];
#pragma unroll
    for (int i = 0; i < 2; i++)
#pragma unroll
      for (int j = 0; j < 4; j++) gv[i][j] = *(const uint2*)(G + (size_t)(r0 + i * 16) * 4096 + k * 1024 + c0 + j * 16);
    __syncthreads();
    yp_stage(sA, sB, ra, rb, tid);
    __syncthreads();
    {
      const int qn = qi + 1 < 4 * nmine ? qi + 1 : qi;
      int mtn, ntn;
      YP_TILE(qn >> 2, mtn, ntn);
      const int brn = qn & 3, ycn = brn < 3 ? brn * 256 : 1536;
      yp_issue(Y + (size_t)mtn * 128 * YST + ycn, Wb + ((size_t)brn * 1024 + ntn * 128) * 256, ra, rb, tid);
    }
    f32x4 ay[2][4];
    zero_acc<2>(ay);
#pragma unroll 2
    for (int ks = 0; ks < 8; ks++) {
      bf16x8 af[2], bfr[4];
#pragma unroll
      for (int i = 0; i < 2; i++) {
        const int row = wm * 32 + i * 16 + fr;
        af[i] = *(const bf16x8*)(sA + row * 512 + (((ks * 4 + fq) ^ (row & 7)) << 4));
      }
#pragma unroll
      for (int j = 0; j < 4; j++) {
        const int row = wn * 64 + j * 16 + fr;
        bfr[j] = *(const bf16x8*)(sB + row * 512 + (((ks * 4 + fq) ^ (row & 7)) << 4));
      }
#pragma unroll
      for (int i = 0; i < 2; i++)
#pragma unroll
        for (int j = 0; j < 4; j++) ay[i][j] = __builtin_amdgcn_mfma_f32_16x16x32_bf16(bfr[j], af[i], ay[i][j], 0, 0, 0);
    }
#pragma unroll
    for (int i = 0; i < 2; i++)
#pragma unroll
      for (int j = 0; j < 4; j++) {
        tot[i][j][0] += __uint_as_float(gv[i][j].x << 16) * ay[i][j][0];
        tot[i][j][1] += __uint_as_float(gv[i][j].x & 0xffff0000u) * ay[i][j][1];
        tot[i][j][2] += __uint_as_float(gv[i][j].y << 16) * ay[i][j][2];
        tot[i][j][3] += __uint_as_float(gv[i][j].y & 0xffff0000u) * ay[i][j][3];
      }
    if (k == 3) {
#pragma unroll
      for (int i = 0; i < 2; i++)
#pragma unroll
        for (int j = 0; j < 4; j++) {
          uint2 ov;
          ov.x = pack2(tot[i][j][0], tot[i][j][1]); ov.y = pack2(tot[i][j][2], tot[i][j][3]);
          *(uint2*)(ACC + (size_t)(r0 + i * 16) * DM + c0 + j * 16) = ov;
        }
      zero_acc<2>(tot);
    }
  }
  __syncthreads();
#undef YP_TILE
}

#define S2_BUF 10816
#define S2_D 0
#define S2_U 2048
#define S2_P 4096
#define S2_K 6144
#define S2_DQ 8192
#define S2_V 10240
#define S2_C1 10752
#define S2_C2 10784
#define S2_ST (2 * S2_BUF)
#define S2_YB (S2_ST + 8192)

__device__ __forceinline__ float red16(float x) {
  x += dppf<0xB1>(x);
  x += dppf<0x4E>(x);
  x += dppf<0x141>(x);
  x += dppf<0x140>(x);
  return x;
}
__device__ __forceinline__ void wave_lds_sync() {
  asm volatile("s_waitcnt lgkmcnt(0)" ::: "memory");
  __builtin_amdgcn_wave_barrier();
}

template <int MIX>
__device__ __forceinline__ void scan2_item(const Params& p, int l, int b, int h, int dir, int rq, float* sm) {
  constexpr int EPL = (MIX == 2) ? 2 : 4;
  constexpr int VOFF = (MIX == 2) ? 64 : 128;
  const int tid = TIDX, lane = tid & 63, w = tid >> 6, fr = lane & 15, fq = lane >> 4;
  const bool producer = w >= 4;
  const int pw = w & 3;
  const u16* P = (const u16*)(p.ws + OFF_BIG);
  u16* YS = (u16*)(p.ws + OFF_YS);
  float* BC = (float*)(p.ws + OFF_BC);
  float* ST = sm + S2_ST + pw * 2048;
  float s[EPL];
#pragma unroll
  for (int i = 0; i < EPL; i++) s[i] = 0.f;

  bf16x8 bw2[4], ba2[4];
  float cst[5][4];
  float cw[3][7];
  float muv[4];
  int colv[4];
#pragma unroll
  for (int i = 0; i < 4; i++) { bw2[i] = bf16x8{0, 0, 0, 0, 0, 0, 0, 0}; ba2[i] = bw2[i]; muv[i] = 0.f; colv[i] = 0; }
  if (producer) {
    if (MIX == 0) {
#pragma unroll
      for (int nt = 0; nt < 4; nt++) {
        const int jch = h * 64 + nt * 16 + fr;
#pragma unroll
        for (int jj = 0; jj < 8; jj++) {
          bw2[nt][jj] = (short)f2bf(p.rwkv_w2[((size_t)(l * 2 + dir) * 32 + fq * 8 + jj) * 256 + jch]);
          ba2[nt][jj] = (short)f2bf(p.rwkv_a2[((size_t)(l * 2 + dir) * 32 + fq * 8 + jj) * 256 + jch]);
        }
        cst[0][nt] = p.rwkv_w0[(l * 2 + dir) * 256 + jch];
        cst[1][nt] = p.rwkv_a0[(l * 2 + dir) * 256 + jch];
        cst[2][nt] = p.rwkv_ka[l * 256 + jch];
        cst[3][nt] = p.rwkv_kk[l * 256 + jch];
        cst[4][nt] = p.rwkv_rk[l * 256 + jch];
      }
#pragma unroll
      for (int i = 0; i < 4; i++) {
        const int c = lane + 64 * i;
        colv[i] = i < 3 ? i * 256 + h * 64 + lane : (lane < 32 ? 768 + dir * 32 + lane : 832 + dir * 32 + (lane - 32));
        muv[i] = p.rwkv_mu[l * 960 + colv[i]];
        (void)c;
      }
    } else if (MIX == 1) {
#pragma unroll
      for (int i = 0; i < 3; i++) {
        colv[i] = PB + i * 256 + h * 64 + lane;
#pragma unroll
        for (int tp = 0; tp < 7; tp++) cw[i][tp] = p.gdn_conv[((size_t)l * 7 + tp) * 768 + i * 256 + h * 64 + lane];
      }
    } else {
#pragma unroll
      for (int nt = 0; nt < 2; nt++) {
#pragma unroll
        for (int jj = 0; jj < 8; jj++)
          bw2[nt][jj] = fq < 2 ? (short)f2bf(p.gla_gw2[((size_t)(l * 2 + dir) * 16 + fq * 8 + jj) * 128 + h * 32 + nt * 16 + fr]) : (short)0;
        cst[0][nt] = p.gla_gb[(l * 2 + dir) * 128 + h * 32 + nt * 16 + fr];
      }
      colv[0] = PC + h * 32 + lane;
      if (lane >= 32) colv[0] = PC + 128 + h * 32 + (lane - 32);
      colv[1] = PC + 256 + h * 64 + lane;
      colv[2] = PC + 512 + dir * 16 + (lane & 15);
    }
  }
  __syncthreads();

  for (int c = 0; c <= TPB / 32 + 1; c++) {
    if (producer) {
      if (c >= 2) {
        const int cc = c - 2;
        int seg_row0, t_lo;
        if (cc < 8) { seg_row0 = b * TPB; t_lo = dir == 0 ? cc * 32 : (LC - 32 - cc * 32); }
        else { seg_row0 = b * TPB + LC; t_lo = dir == 0 ? (cc - 8) * 32 : (SEQ - 32 - (cc - 8) * 32); }
        const float* yb = sm + S2_YB + (cc & 1) * 512;
        const int t2 = tid - 256;
#pragma unroll
        for (int i = 0; i < 2; i++) {
          const int idx = t2 + i * 256, tt = idx >> 4, e = idx & 15;
          YS[(size_t)(seg_row0 + t_lo + tt) * YST + dir * 768 + MIX * 256 + h * 64 + rq * 16 + e] = f2bf(yb[idx]);
        }
      }
      if (c < TPB / 32) {
        int seg_row0, seg_len, t_lo;
        if (c < 8) { seg_row0 = b * TPB; seg_len = LC; t_lo = dir == 0 ? c * 32 : (LC - 32 - c * 32); }
        else { seg_row0 = b * TPB + LC; seg_len = SEQ; t_lo = dir == 0 ? (c - 8) * 32 : (SEQ - 32 - (c - 8) * 32); }
        const u16* Pseg = P + (size_t)seg_row0 * PST;
        float* B = sm + (c & 1) * S2_BUF;
        const int t0 = t_lo + pw * 8;
        if (MIX == 0) {
          float raw[10][4];
#pragma unroll
          for (int rr = 0; rr < 10; rr++) {
            const int t = t0 - 1 + rr;
            const float okf = (t >= 0 && t < seg_len) ? 1.f : 0.f;
            const int tc = min(max(t, 0), seg_len - 1);
#pragma unroll
            for (int i = 0; i < 4; i++) raw[rr][i] = bf2f(Pseg[(size_t)tc * PST + PA + colv[i]]) * okf;
          }
#pragma unroll
          for (int j = 0; j < 8; j++)
#pragma unroll
            for (int i = 0; i < 4; i++) {
              float xm = raw[j + 1][i] + (0.5f * (raw[j][i] + raw[j + 2][i]) - raw[j + 1][i]) * muv[i];
              if (i == 3 && lane < 32) xm = tanh_fast(xm);
              ST[j * 256 + lane + 64 * i] = xm;
            }
        } else if (MIX == 1) {
          float raw[14][3];
#pragma unroll
          for (int rr = 0; rr < 14; rr++) {
            const int t = t0 - 3 + rr;
            const float okf = (t >= 0 && t < seg_len) ? 1.f : 0.f;
            const int tc = min(max(t, 0), seg_len - 1);
#pragma unroll
            for (int i = 0; i < 3; i++) raw[rr][i] = bf2f(Pseg[(size_t)tc * PST + colv[i]]) * okf;
          }
#pragma unroll
          for (int j = 0; j < 8; j++)
#pragma unroll
            for (int i = 0; i < 3; i++) {
              float a = 0.f;
#pragma unroll
              for (int tp = 0; tp < 7; tp++) a += raw[j + tp][i] * cw[i][tp];
              ST[j * 256 + lane + 64 * i] = siluf(a);
            }
          if (lane < 8) {
            const u16* pp = Pseg + (size_t)(t0 + lane) * PST + PB;
            float bx = bf2f(pp[768 + dir * 4 + h]);
            float ax = bf2f(pp[776 + dir * 4 + h]);
            float ld = -__expf(p.gdn_a_log[(l * 2 + dir) * 4 + h]) * softplusf(ax + p.gdn_dt_bias[(l * 2 + dir) * 4 + h]);
            ST[lane * 256 + 192] = sigm(bx);
            ST[lane * 256 + 193] = __expf(ld);
          }
        } else {
          u16 raw[8][3];
#pragma unroll
          for (int j = 0; j < 8; j++) {
            const u16* pp = Pseg + (size_t)(t0 + j) * PST;
#pragma unroll
            for (int i = 0; i < 3; i++) raw[j][i] = pp[colv[i]];
          }
          const float qs = lane < 32 ? 0.17677669529663687f : 1.f;
#pragma unroll
          for (int j = 0; j < 8; j++) {
            ST[j * 256 + lane] = bf2f(raw[j][0]) * qs;
            ST[j * 256 + 64 + lane] = bf2f(raw[j][1]);
            if (lane < 16) ST[j * 256 + 128 + lane] = bf2f(raw[j][2]);
          }
        }
        wave_lds_sync();
        const bool vl = fq < 2;
        if (MIX == 0) {
          bf16x8 aw, aa;
#pragma unroll
          for (int jj = 0; jj < 8; jj++) {
            aw[jj] = fr < 8 ? (short)f2bf(ST[fr * 256 + 192 + fq * 8 + jj]) : (short)0;
            aa[jj] = fr < 8 ? (short)f2bf(ST[fr * 256 + 224 + fq * 8 + jj]) : (short)0;
          }
          f32x4 accw[4], acca[4];
#pragma unroll
          for (int nt = 0; nt < 4; nt++) {
            accw[nt] = __builtin_amdgcn_mfma_f32_16x16x32_bf16(aw, bw2[nt], f32x4{0.f, 0.f, 0.f, 0.f}, 0, 0, 0);
            acca[nt] = __builtin_amdgcn_mfma_f32_16x16x32_bf16(aa, ba2[nt], f32x4{0.f, 0.f, 0.f, 0.f}, 0, 0, 0);
          }
#pragma unroll
          for (int r = 0; r < 4; r++) {
            const int j = (fq & 1) * 4 + r, tt = pw * 8 + j;
            float kkx[4], av[4], kdv[4], rv[4], dec[4];
            float ss = 0.f;
#pragma unroll
            for (int nt = 0; nt < 4; nt++) {
              const int n = nt * 16 + fr;
              rv[nt] = ST[j * 256 + n];
              const float kx = ST[j * 256 + 64 + n];
              dec[nt] = __expf(-0.6065306597126334f * sigm(cst[0][nt] + accw[nt][r]));
              av[nt] = sigm(cst[1][nt] + acca[nt][r]);
              kdv[nt] = kx * (1.f + (av[nt] - 1.f) * cst[2][nt]);
              kkx[nt] = kx * cst[3][nt];
              ss += kkx[nt] * kkx[nt];
            }
            ss = red16(ss);
            const float rs = rsq(ss + 1e-6f);
            float c1 = 0.f, c2 = 0.f, bc = 0.f;
#pragma unroll
            for (int nt = 0; nt < 4; nt++) {
              const int n = nt * 16 + fr;
              const float kk = kkx[nt] * rs;
              if (vl) {
                B[S2_D + tt * 64 + n] = dec[nt];
                B[S2_U + tt * 64 + n] = kk;
                B[S2_P + tt * 64 + n] = -kk * av[nt];
                B[S2_K + tt * 64 + n] = kdv[nt];
                B[S2_DQ + tt * 64 + n] = dec[nt] * rv[nt];
              }
              c1 += -kk * av[nt] * rv[nt];
              c2 += kdv[nt] * rv[nt];
              bc += rv[nt] * kdv[nt] * cst[4][nt];
            }
            c1 = red16(c1); c2 = red16(c2); bc = red16(bc);
            if (vl && fr == 0) {
              B[S2_C1 + tt] = c1;
              B[S2_C2 + tt] = c2;
              if (rq == 0) BC[(size_t)(seg_row0 + t_lo + tt) * 8 + h * 2 + dir] = bc;
            }
          }
        } else if (MIX == 1) {
#pragma unroll
          for (int r = 0; r < 4; r++) {
            const int j = (fq & 1) * 4 + r, tt = pw * 8 + j;
            float qv[4], kv[4];
            float sq = 0.f, sk = 0.f;
#pragma unroll
            for (int nt = 0; nt < 4; nt++) {
              const int n = nt * 16 + fr;
              qv[nt] = ST[j * 256 + n];
              kv[nt] = ST[j * 256 + 64 + n];
              sq += qv[nt] * qv[nt];
              sk += kv[nt] * kv[nt];
            }
            sq = red16(sq); sk = red16(sk);
            const float rq_ = rsq(sq + 1e-6f) * 0.125f, rk_ = rsq(sk + 1e-6f);
            const float beta = ST[j * 256 + 192], alpha = ST[j * 256 + 193];
            float dkq = 0.f;
#pragma unroll
            for (int nt = 0; nt < 4; nt++) {
              const int n = nt * 16 + fr;
              const float qn = qv[nt] * rq_, kn = kv[nt] * rk_;
              if (vl) {
                B[S2_D + tt * 64 + n] = alpha;
                B[S2_U + tt * 64 + n] = kn;
                B[S2_P + tt * 64 + n] = -alpha * beta * kn;
                B[S2_K + tt * 64 + n] = beta * kn;
                B[S2_DQ + tt * 64 + n] = alpha * qn;
              }
              dkq += kn * qn;
            }
            dkq = red16(dkq);
            if (vl && fr == 0) {
              B[S2_C1 + tt] = -alpha * beta * dkq;
              B[S2_C2 + tt] = beta * dkq;
            }
          }
        } else {
          bf16x8 ag;
#pragma unroll
          for (int jj = 0; jj < 8; jj++) ag[jj] = (fr < 8 && fq < 2) ? (short)f2bf(ST[fr * 256 + 128 + fq * 8 + jj]) : (short)0;
          f32x4 accg[2];
#pragma unroll
          for (int nt = 0; nt < 2; nt++) accg[nt] = __builtin_amdgcn_mfma_f32_16x16x32_bf16(ag, bw2[nt], f32x4{0.f, 0.f, 0.f, 0.f}, 0, 0, 0);
#pragma unroll
          for (int r = 0; r < 4; r++) {
            const int j = (fq & 1) * 4 + r, tt = pw * 8 + j;
            float dkq = 0.f;
#pragma unroll
            for (int nt = 0; nt < 2; nt++) {
              const int n = nt * 16 + fr;
              const float lg = cst[0][nt] + accg[nt][r];
              const float ls = fminf(lg, 0.f) - __logf(1.f + __expf(-fabsf(lg)));
              const float alpha = __expf(ls * (1.f / 16.f));
              const float qv = ST[j * 256 + n], kv = ST[j * 256 + 32 + n];
              if (vl) {
                B[S2_D + tt * 64 + n] = alpha;
                B[S2_K + tt * 64 + n] = kv;
                B[S2_DQ + tt * 64 + n] = alpha * qv;
              }
              dkq += kv * qv;
            }
            dkq = red16(dkq);
            if (vl && fr == 0) B[S2_C2 + tt] = dkq;
          }
        }
#pragma unroll
        for (int i = 0; i < 2; i++) {
          const int idx = lane + 64 * i, j = idx >> 4, e = idx & 15;
          B[S2_V + (pw * 8 + j) * 16 + e] = ST[j * 256 + VOFF + rq * 16 + e];
        }
      }
    } else if (c >= 1 && c <= TPB / 32) {
      const float* B = sm + ((c - 1) & 1) * S2_BUF;
      float* yb = sm + S2_YB + ((c - 1) & 1) * 512;
      const int rl = w * 4 + fq;
      const int dtt = dir ? -1 : 1;
      int tt = dir ? 31 : 0;
      float dv[EPL], kv[EPL], qv[EPL], uv[EPL], pv[EPL], vv, c1v, c2v;
      float dn[EPL], kn[EPL], qn[EPL], un[EPL], pn[EPL], vn, c1n, c2n;
#define S2_LOAD(D_, K_, Q_, U_, P_, V_, C1_, C2_, T_)                                   \
  do {                                                                                  \
    const int o_ = (T_) * 64 + fr * EPL;                                                \
    if (EPL == 4) {                                                                     \
      float4 t4 = *(const float4*)(B + S2_D + o_);                                      \
      D_[0] = t4.x; D_[1] = t4.y; D_[2] = t4.z; D_[3] = t4.w;                           \
      t4 = *(const float4*)(B + S2_K + o_);                                             \
      K_[0] = t4.x; K_[1] = t4.y; K_[2] = t4.z; K_[3] = t4.w;                           \
      t4 = *(const float4*)(B + S2_DQ + o_);                                            \
      Q_[0] = t4.x; Q_[1] = t4.y; Q_[2] = t4.z; Q_[3] = t4.w;                           \
      t4 = *(const float4*)(B + S2_U + o_);                                             \
      U_[0] = t4.x; U_[1] = t4.y; U_[2] = t4.z; U_[3] = t4.w;                           \
      t4 = *(const float4*)(B + S2_P + o_);                                             \
      P_[0] = t4.x; P_[1] = t4.y; P_[2] = t4.z; P_[3] = t4.w;                           \
      C1_ = B[S2_C1 + (T_)];                                                            \
    } else {                                                                            \
      float2 t2 = *(const float2*)(B + S2_D + o_);                                      \
      D_[0] = t2.x; D_[1] = t2.y;                                                       \
      t2 = *(const float2*)(B + S2_K + o_);                                             \
      K_[0] = t2.x; K_[1] = t2.y;                                                       \
      t2 = *(const float2*)(B + S2_DQ + o_);                                            \
      Q_[0] = t2.x; Q_[1] = t2.y;                                                       \
      U_[0] = U_[1] = P_[0] = P_[1] = 0.f; C1_ = 0.f;                                   \
    }                                                                                   \
    V_ = B[S2_V + (T_) * 16 + rl];                                                      \
    C2_ = B[S2_C2 + (T_)];                                                              \
  } while (0)
#define S2_STEP(D_, K_, Q_, U_, P_, V_, C1_, C2_, T_)                                   \
  do {                                                                                  \
    float sq = 0.f, sa = 0.f;                                                           \
    _Pragma("unroll") for (int i = 0; i < EPL; i++) sq += s[i] * Q_[i];                 \
    if (MIX != 2) {                                                                     \
      _Pragma("unroll") for (int i = 0; i < EPL; i++) sa += s[i] * U_[i];               \
      sa = red16(sa);                                                                   \
    }                                                                                   \
    sq = red16(sq);                                                                     \
    float y = sq + V_ * C2_;                                                            \
    if (MIX != 2) y += sa * C1_;                                                        \
    _Pragma("unroll") for (int i = 0; i < EPL; i++) {                                   \
      float t = s[i] * D_[i] + V_ * K_[i];                                              \
      if (MIX != 2) t += sa * P_[i];                                                    \
      s[i] = t;                                                                         \
    }                                                                                   \
    yb[(T_) * 16 + rl] = y;                                                             \
  } while (0)
      S2_LOAD(dv, kv, qv, uv, pv, vv, c1v, c2v, tt);
#pragma unroll 1
      for (int st = 0; st < 32; st += 2) {
        const int t1 = tt + dtt;
        S2_LOAD(dn, kn, qn, un, pn, vn, c1n, c2n, t1);
        S2_STEP(dv, kv, qv, uv, pv, vv, c1v, c2v, tt);
        const int t2 = st + 2 < 32 ? t1 + dtt : t1;
        S2_LOAD(dv, kv, qv, uv, pv, vv, c1v, c2v, t2);
        S2_STEP(dn, kn, qn, un, pn, vn, c1n, c2n, t1);
        tt = t2;
      }
#undef S2_LOAD
#undef S2_STEP
    }
    __syncthreads();
  }
}

#define S3_SUB 12800
#define S3_GM 0
#define S3_KVT 9216
#define S3_QB 10240
#define S3_QV 11392
#define S3_VT 11520
#define S3_WC 12544
#define S3_TB S3_QV
#define S3_TM (S3_GM + 3328)
#define S3_QBM (S3_GM + 3072)
#define S3_QKM (S3_GM + 3200)
#define S3_KB (S3_GM + 0)
#define S3_BT (S3_GM + 2048)
#define S3_STB (8 * S3_SUB)
#define S3_END (S3_STB + 4 * 2304)

__device__ __forceinline__ float rlane(float x, int l) { return __int_as_float(__builtin_amdgcn_readlane(__float_as_int(x), l)); }
__device__ __forceinline__ float wave_sum(float x) {
  x = red16(x);
  return (rlane(x, 0) + rlane(x, 16)) + (rlane(x, 32) + rlane(x, 48));
}
__device__ __forceinline__ float clampe(float x) { return fminf(fmaxf(x, -80.f), 80.f); }
__device__ __forceinline__ uint4 pack8(const float (&v)[8]) {
  return make_uint4(pack2(v[0], v[1]), pack2(v[2], v[3]), pack2(v[4], v[5]), pack2(v[6], v[7]));
}
__device__ __forceinline__ bf16x8 ld_frag(const void* p) { return *(const bf16x8*)p; }
__device__ __forceinline__ bf16x8 zfrag() { return bf16x8{0, 0, 0, 0, 0, 0, 0, 0}; }

__device__ __forceinline__ void chunk_geom(int c, int dir, int b, int& seg_row0, int& seg_len, int& t_lo) {
  if (c < 8) { seg_row0 = b * TPB; seg_len = LC; t_lo = dir == 0 ? c * 32 : (LC - 32 - c * 32); }
  else { seg_row0 = b * TPB + LC; seg_len = SEQ; t_lo = dir == 0 ? (c - 8) * 32 : (SEQ - 32 - (c - 8) * 32); }
}
template <int MIX>
__device__ __forceinline__ void fetch_raw(const u16* P, int c, int dir, int b, int h, int pw, int lane, const int (&colv)[4], unsigned (&rawq)[14][2]) {
  int seg_row0, seg_len, t_lo;
  chunk_geom(c, dir, b, seg_row0, seg_len, t_lo);
  const u16* Pseg = P + (size_t)seg_row0 * PST;
  const int t0 = t_lo + pw * 8;
  if (MIX == 0) {
#pragma unroll
    for (int rr = 0; rr < 10; rr++) {
      const int tc = min(max(t0 - 1 + rr, 0), seg_len - 1);
#pragma unroll
      for (int i = 0; i < 2; i++)
        rawq[rr][i] = (unsigned)Pseg[(size_t)tc * PST + PA + colv[2 * i]] | ((unsigned)Pseg[(size_t)tc * PST + PA + colv[2 * i + 1]] << 16);
    }
  } else if (MIX == 1) {
#pragma unroll
    for (int rr = 0; rr < 14; rr++) {
      const int tc = min(max(t0 - 3 + rr, 0), seg_len - 1);
      rawq[rr][0] = (unsigned)Pseg[(size_t)tc * PST + colv[0]] | ((unsigned)Pseg[(size_t)tc * PST + colv[1]] << 16);
      rawq[rr][1] = (rawq[rr][1] & 0xffff0000u) | (unsigned)Pseg[(size_t)tc * PST + colv[2]];
    }
    const u16* pp = Pseg + (size_t)(t0 + (lane & 7)) * PST + PB;
    rawq[0][1] = (rawq[0][1] & 0xffffu) | ((unsigned)pp[768 + dir * 4 + h] << 16);
    rawq[1][1] = (rawq[1][1] & 0xffffu) | ((unsigned)pp[776 + dir * 4 + h] << 16);
  } else {
#pragma unroll
    for (int j = 0; j < 8; j++) {
      const u16* pp = Pseg + (size_t)(t0 + j) * PST;
      rawq[j][0] = (unsigned)pp[colv[0]] | ((unsigned)pp[colv[1]] << 16);
      rawq[j][1] = (unsigned)pp[colv[2]];
    }
  }
}

template <int MIX>
__device__ __forceinline__ void scan3_item(const Params& p, int l, int b, int h, int dir, unsigned char* smb) {
  constexpr int VOFF = (MIX == 2) ? 64 : 128;
  constexpr bool DELTA = (MIX != 2);
  const int tid = TIDX, lane = tid & 63, w = __builtin_amdgcn_readfirstlane(tid >> 6), fr = lane & 15, fq = lane >> 4;
  const bool producer = true;
  const int pw = w & 3, half = w >> 2;
  const u16* P = (const u16*)(p.ws + OFF_BIG);
  u16* YS = (u16*)(p.ws + OFF_YS);
  float* BC = (float*)(p.ws + OFF_BC);
  float* ST = (float*)(smb + w * S3_SUB + S3_GM);
  unsigned char* STBY = smb + w * S3_SUB + S3_GM;
  const f32x4 z4 = f32x4{0.f, 0.f, 0.f, 0.f};
  f32x4 st[4];
#pragma unroll
  for (int i = 0; i < 4; i++) st[i] = z4;

  bf16x8 bw2[4], ba2[4];
  float cw[3][7];
  float muv[4];
  int colv[4];
  float c_w0 = 0.f, c_a0 = 0.f, c_ka = 0.f, c_kk = 0.f, c_rk = 0.f, c_gb = 0.f;
#pragma unroll
  for (int i = 0; i < 4; i++) { bw2[i] = zfrag(); ba2[i] = zfrag(); muv[i] = 0.f; colv[i] = 0; }
  if (producer) {
    if (MIX == 0) {
      {
        float tw[4][8], ta[4][8];
#pragma unroll
        for (int nt = 0; nt < 4; nt++)
#pragma unroll
          for (int jj = 0; jj < 8; jj++) {
            tw[nt][jj] = p.rwkv_w2[((size_t)(l * 2 + dir) * 32 + fq * 8 + jj) * 256 + h * 64 + nt * 16 + fr];
            ta[nt][jj] = p.rwkv_a2[((size_t)(l * 2 + dir) * 32 + fq * 8 + jj) * 256 + h * 64 + nt * 16 + fr];
          }
#pragma unroll
        for (int nt = 0; nt < 4; nt++)
#pragma unroll
          for (int jj = 0; jj < 8; jj++) { bw2[nt][jj] = (short)f2bf(tw[nt][jj]); ba2[nt][jj] = (short)f2bf(ta[nt][jj]); }
      }
      const int jl = h * 64 + lane;
      c_w0 = p.rwkv_w0[(l * 2 + dir) * 256 + jl];
      c_a0 = p.rwkv_a0[(l * 2 + dir) * 256 + jl];
      c_ka = p.rwkv_ka[l * 256 + jl];
      c_kk = p.rwkv_kk[l * 256 + jl];
      c_rk = p.rwkv_rk[l * 256 + jl];
#pragma unroll
      for (int i = 0; i < 4; i++) {
        colv[i] = i < 3 ? i * 256 + h * 64 + lane : (lane < 32 ? 768 + dir * 32 + lane : 832 + dir * 32 + (lane - 32));
        muv[i] = p.rwkv_mu[l * 960 + colv[i]];
      }
    } else if (MIX == 1) {
#pragma unroll
      for (int i = 0; i < 3; i++) {
        colv[i] = PB + i * 256 + h * 64 + lane;
#pragma unroll
        for (int tp = 0; tp < 7; tp++) cw[i][tp] = p.gdn_conv[((size_t)l * 7 + tp) * 768 + i * 256 + h * 64 + lane];
      }
    } else {
      {
        float tg[2][8];
#pragma unroll
        for (int nt = 0; nt < 2; nt++)
#pragma unroll
          for (int jj = 0; jj < 8; jj++) tg[nt][jj] = p.gla_gw2[((size_t)(l * 2 + dir) * 16 + (fq & 1) * 8 + jj) * 128 + h * 32 + nt * 16 + fr];
#pragma unroll
        for (int nt = 0; nt < 2; nt++)
#pragma unroll
          for (int jj = 0; jj < 8; jj++) bw2[nt][jj] = fq < 2 ? (short)f2bf(tg[nt][jj]) : (short)0;
      }
      c_gb = p.gla_gb[(l * 2 + dir) * 128 + h * 32 + (lane & 31)];
      colv[0] = PC + h * 32 + lane;
      if (lane >= 32) colv[0] = PC + 128 + h * 32 + (lane - 32);
      colv[1] = PC + 256 + h * 64 + lane;
      colv[2] = PC + 512 + dir * 16 + (lane & 15);
    }
  }
  __syncthreads();
  unsigned rawq[14][2];
#pragma unroll
  for (int i = 0; i < 14; i++) { rawq[i][0] = 0u; rawq[i][1] = 0u; }
  fetch_raw<MIX>(P, half, dir, b, h, pw, lane, colv, rawq);
#define RAWP(r_, i_) ((u16)((rawq[r_][(i_) >> 1] >> (((i_) & 1) * 16)) & 0xffffu))

  for (int it = 0; it < TPB / 64; it++) {
    {
      {
        const int c = it * 2 + half;
        int seg_row0, seg_len, t_lo;
        chunk_geom(c, dir, b, seg_row0, seg_len, t_lo);
        unsigned char* SB = smb + w * S3_SUB;
        const int t0 = t_lo + pw * 8;
        if (MIX == 0) {
          float raw[10][4];
#pragma unroll
          for (int rr = 0; rr < 10; rr++) {
            const int t = t0 - 1 + rr;
            const float okf = (t >= 0 && t < seg_len) ? 1.f : 0.f;
#pragma unroll
            for (int i = 0; i < 4; i++) raw[rr][i] = bf2f(RAWP(rr, i)) * okf;
          }
#pragma unroll
          for (int j = 0; j < 8; j++)
#pragma unroll
            for (int i = 0; i < 4; i++) {
              float xm = raw[j + 1][i] + (0.5f * (raw[j][i] + raw[j + 2][i]) - raw[j + 1][i]) * muv[i];
              if (i == 3 && lane < 32) xm = tanh_fast(xm);
              ST[j * 256 + lane + 64 * i] = xm;
            }
        } else if (MIX == 1) {
          float raw[14][3];
#pragma unroll
          for (int rr = 0; rr < 14; rr++) {
            const int t = t0 - 3 + rr;
            const float okf = (t >= 0 && t < seg_len) ? 1.f : 0.f;
#pragma unroll
            for (int i = 0; i < 3; i++) raw[rr][i] = bf2f(RAWP(rr, i)) * okf;
          }
#pragma unroll
          for (int j = 0; j < 8; j++)
#pragma unroll
            for (int i = 0; i < 3; i++) {
              float a = 0.f;
#pragma unroll
              for (int tp = 0; tp < 7; tp++) a += raw[j + tp][i] * cw[i][tp];
              ST[j * 256 + lane + 64 * i] = siluf(a);
            }
          if (lane < 8) {
            float bx = bf2f(RAWP(0, 3));
            float ax = bf2f(RAWP(1, 3));
            float ld = -__expf(p.gdn_a_log[(l * 2 + dir) * 4 + h]) * softplusf(ax + p.gdn_dt_bias[(l * 2 + dir) * 4 + h]);
            ST[lane * 256 + 192] = sigm(bx);
            ST[lane * 256 + 193] = ld;
          }
        } else {
          const float qs = lane < 32 ? 0.17677669529663687f : 1.f;
#pragma unroll
          for (int j = 0; j < 8; j++) {
            ST[j * 256 + lane] = bf2f(RAWP(j, 0)) * qs;
            ST[j * 256 + 64 + lane] = bf2f(RAWP(j, 1));
            if (lane < 16) ST[j * 256 + 128 + lane] = bf2f(RAWP(j, 2));
          }
        }
        wave_lds_sync();
        {
          float vv[8];
#pragma unroll
          for (int i = 0; i < 8; i++) vv[i] = ST[(dir ? 7 - i : i) * 256 + VOFF + lane];
          *(uint4*)(SB + S3_VT + lane * 16) = pack8(vv);
        }
        if (MIX == 0) {
          bf16x8 aw, aa;
#pragma unroll
          for (int jj = 0; jj < 8; jj++) {
            aw[jj] = fr < 8 ? (short)f2bf(ST[fr * 256 + 192 + fq * 8 + jj]) : (short)0;
            aa[jj] = fr < 8 ? (short)f2bf(ST[fr * 256 + 224 + fq * 8 + jj]) : (short)0;
          }
          f32x4 accw[4], acca[4];
#pragma unroll
          for (int nt = 0; nt < 4; nt++) {
            accw[nt] = __builtin_amdgcn_mfma_f32_16x16x32_bf16(aw, bw2[nt], z4, 0, 0, 0);
            acca[nt] = __builtin_amdgcn_mfma_f32_16x16x32_bf16(aa, ba2[nt], z4, 0, 0, 0);
          }
          wave_lds_sync();
          if (fq < 2) {
#pragma unroll
            for (int nt = 0; nt < 4; nt++)
#pragma unroll
              for (int r = 0; r < 4; r++) {
                ST[(fq * 4 + r) * 256 + 128 + nt * 16 + fr] = accw[nt][r];
                ST[(fq * 4 + r) * 256 + 192 + nt * 16 + fr] = acca[nt][r];
              }
          }
          wave_lds_sync();
        } else if (MIX == 2) {
          bf16x8 ag;
#pragma unroll
          for (int jj = 0; jj < 8; jj++) ag[jj] = (fr < 8 && fq < 2) ? (short)f2bf(ST[fr * 256 + 128 + fq * 8 + jj]) : (short)0;
          f32x4 accg[2];
#pragma unroll
          for (int nt = 0; nt < 2; nt++) accg[nt] = __builtin_amdgcn_mfma_f32_16x16x32_bf16(ag, bw2[nt], z4, 0, 0, 0);
          if (fq < 2) {
#pragma unroll
            for (int nt = 0; nt < 2; nt++)
#pragma unroll
              for (int r = 0; r < 4; r++) ST[(fq * 4 + r) * 256 + 192 + nt * 16 + fr] = accg[nt][r];
          }
          wave_lds_sync();
        }
        float logd[8], kap[8], bb[8], kp[8], qq[8];
        if (MIX == 0) {
          float a8[8], p1[8];
#pragma unroll
          for (int i = 0; i < 8; i++) {
            const float* row = ST + (dir ? 7 - i : i) * 256;
            const float r_ = row[lane], k_ = row[64 + lane];
            const float sg = sigm(c_w0 + row[128 + lane]);
            a8[i] = sigm(c_a0 + row[192 + lane]);
            kp[i] = k_ * (1.f + (a8[i] - 1.f) * c_ka);
            kap[i] = k_ * c_kk;
            qq[i] = r_;
            logd[i] = -0.6065306597126334f * sg;
            p1[i] = kap[i] * kap[i];
          }
#pragma unroll
          for (int i = 0; i < 8; i++) p1[i] = red16(p1[i]);
#pragma unroll
          for (int i = 0; i < 8; i++) {
            const float ss = (rlane(p1[i], 0) + rlane(p1[i], 16)) + (rlane(p1[i], 32) + rlane(p1[i], 48));
            kap[i] *= rsq(ss + 1e-6f);
            bb[i] = kap[i] * a8[i];
          }
        } else {
#pragma unroll
        for (int i = 0; i < 8; i++) {
          const int j = dir ? 7 - i : i;
          const float* row = ST + j * 256;
          if (MIX == 1) {
            const float q_ = row[lane], k_ = row[64 + lane];
            const float sq = wave_sum(q_ * q_), sk = wave_sum(k_ * k_);
            const float qn = q_ * rsq(sq + 1e-6f) * 0.125f, kn = k_ * rsq(sk + 1e-6f);
            const float beta = row[192], ld = row[193];
            const float alpha = __expf(ld);
            logd[i] = ld;
            kap[i] = kn; bb[i] = alpha * beta * kn; kp[i] = beta * kn; qq[i] = qn;
          } else {
            const int n = lane & 31;
            const float lg = c_gb + row[192 + n];
            const float ls = fminf(lg, 0.f) - __logf(1.f + __expf(-fabsf(lg)));
            logd[i] = ls * (1.f / 16.f);
            kap[i] = 0.f; bb[i] = 0.f;
            kp[i] = lane < 32 ? row[32 + n] : 0.f;
            qq[i] = lane < 32 ? row[n] : 0.f;
          }
        }
        }
        wave_lds_sync();
        float kt[8], qt[8], bck[8], kck[8];
        {
          float L[8];
          float run = 0.f;
#pragma unroll
          for (int i = 0; i < 8; i++) { run += logd[i]; L[i] = run; }
          const float Lr = L[3], L7 = L[7];
          float prevE = __expf(clampe(-Lr)), prevT = 1.f;
          u16* OPA = (u16*)STBY;
#pragma unroll
          for (int i = 0; i < 8; i++) {
            const float eI = __expf(clampe(L[i] - Lr)), eInv = __expf(clampe(Lr - L[i]));
            const float tI = __expf(L[i]), eEnd = __expf(L7 - L[i]);
            if (DELTA) {
              OPA[0 * 576 + i * 72 + lane] = f2bf(kap[i] * prevE);
              OPA[1 * 576 + i * 72 + lane] = f2bf(bb[i] * eInv);
            }
            OPA[2 * 576 + i * 72 + lane] = f2bf(kp[i] * eInv);
            OPA[3 * 576 + i * 72 + lane] = f2bf(qq[i] * eI);
            if (MIX == 0) OPA[4 * 576 + i * 72 + lane] = f2bf(qq[i] * eI * c_rk);
            kt[i] = kap[i] * prevT; qt[i] = qq[i] * tI;
            bck[i] = bb[i] * eEnd; kck[i] = kp[i] * eEnd;
            prevE = eI; prevT = tI;
          }
          *(float*)(SB + S3_WC + lane * 4) = __expf(L7);
        }
        wave_lds_sync();
        f32x4 accA = z4, accBm = z4, accQb = z4, accQk = z4, accBC = z4;
        {
          const u16* OPA = (const u16*)STBY;
          const int ro = (fr & 7) * 72 + fq * 8;
#pragma unroll
          for (int ks = 0; ks < 2; ks++) {
            const bf16x8 fk = ld_frag(OPA + 2 * 576 + ro + ks * 32), fqh = ld_frag(OPA + 3 * 576 + ro + ks * 32);
            accQk = __builtin_amdgcn_mfma_f32_16x16x32_bf16(fqh, fk, accQk, 0, 0, 0);
            if (MIX == 0) accBC = __builtin_amdgcn_mfma_f32_16x16x32_bf16(ld_frag(OPA + 4 * 576 + ro + ks * 32), fk, accBC, 0, 0, 0);
            if (DELTA) {
              const bf16x8 fka = ld_frag(OPA + 0 * 576 + ro + ks * 32), fb = ld_frag(OPA + 1 * 576 + ro + ks * 32);
              accA = __builtin_amdgcn_mfma_f32_16x16x32_bf16(fka, fb, accA, 0, 0, 0);
              accBm = __builtin_amdgcn_mfma_f32_16x16x32_bf16(fka, fk, accBm, 0, 0, 0);
              accQb = __builtin_amdgcn_mfma_f32_16x16x32_bf16(fqh, fb, accQb, 0, 0, 0);
            }
          }
#pragma unroll
          for (int r = 0; r < 4; r++) {
            const int i = fq * 4 + r;
            const bool ok = fq < 2 && fr < 8;
            if (!(ok && fr < i)) { accA[r] = 0.f; accBm[r] = 0.f; }
            if (!(ok && fr <= i)) { accQb[r] = 0.f; accQk[r] = 0.f; }
          }
          if (MIX == 0 && fq < 2 && fr < 8 && (fr >> 2) == fq) {
            const int r = fr & 3;
            const float bcv = r == 0 ? accBC[0] : (r == 1 ? accBC[1] : (r == 2 ? accBC[2] : accBC[3]));
            BC[(size_t)(seg_row0 + t0 + (dir ? 7 - fr : fr)) * 8 + h * 2 + dir] = bcv;
          }
        }
        *(uint4*)(SB + S3_KVT + lane * 16) = pack8(kck);
#pragma unroll
        for (int i = 0; i < 8; i++) ((u16*)(SB + S3_QB))[i * 72 + lane] = f2bf(qt[i]);
        if (fq < 2 && fr < 8) {
#pragma unroll
          for (int r = 0; r < 4; r++) {
            ((u16*)(SB + S3_QKM))[(fq * 4 + r) * 8 + fr] = f2bf(accQk[r]);
            if (DELTA) ((u16*)(SB + S3_QBM))[(fq * 4 + r) * 8 + fr] = f2bf(accQb[r]);
          }
        }
        if (DELTA) {
          float t[8];
#pragma unroll
          for (int i = 0; i < 8; i++) {
            float ti = (lane == i) ? 1.f : 0.f;
#pragma unroll
            for (int m = 0; m < i; m++) ti -= rlane(accA[i & 3], (i >> 2) * 16 + m) * t[m];
            t[i] = ti;
          }
#pragma unroll
          for (int i = 0; i < 8; i++) ((u16*)(SB + S3_KB))[i * 72 + lane] = f2bf(-kt[i]);
          *(uint4*)(SB + S3_BT + lane * 16) = pack8(bck);
          if (fq < 2 && fr < 8) {
#pragma unroll
            for (int r = 0; r < 4; r++) ((u16*)(SB + S3_TB))[(fq * 4 + r) * 8 + fr] = f2bf(-accBm[r]);
          }
          if (lane < 8) {
#pragma unroll
            for (int i = 0; i < 8; i++) ((u16*)(SB + S3_TM))[i * 8 + lane] = f2bf(t[i]);
          }
        }
      }
    }
    fetch_raw<MIX>(P, min(it + 1, TPB / 64 - 1) * 2 + half, dir, b, h, pw, lane, colv, rawq);
    __syncthreads();
    if (w < 4) {
      unsigned char* STB = smb + S3_STB + w * 2304;
#pragma unroll
      for (int kk = 0; kk < 8; kk++) {
        const int cc = it * 2 + (kk >> 2), k = kk & 3;
        int seg_row0, t_lo;
        if (cc < 8) { seg_row0 = b * TPB; t_lo = dir == 0 ? cc * 32 : (LC - 32 - cc * 32); }
        else { seg_row0 = b * TPB + LC; t_lo = dir == 0 ? (cc - 8) * 32 : (SEQ - 32 - (cc - 8) * 32); }
        const int sc = dir ? 3 - k : k;
        const unsigned char* SB = smb + ((kk >> 2) * 4 + sc) * S3_SUB;
        const bf16x8 bs0 = __builtin_bit_cast(bf16x8, u32x4v{pack2(st[0][0], st[0][1]), pack2(st[0][2], st[0][3]), pack2(st[1][0], st[1][1]), pack2(st[1][2], st[1][3])});
        const bf16x8 bs1 = __builtin_bit_cast(bf16x8, u32x4v{pack2(st[2][0], st[2][1]), pack2(st[2][2], st[2][3]), pack2(st[3][0], st[3][1]), pack2(st[3][2], st[3][3])});
#define LDP(BASE_, ROW_, KS_) ([&]() -> bf16x8 {                                                                   \
          const uint2 lo_ = *(const uint2*)((BASE_) + ((ROW_) * 72 + (KS_) * 32 + fq * 4) * 2);                      \
          const uint2 hi_ = *(const uint2*)((BASE_) + ((ROW_) * 72 + (KS_) * 32 + 16 + fq * 4) * 2);                 \
          return __builtin_bit_cast(bf16x8, u32x4v{lo_.x, lo_.y, hi_.x, hi_.y}); }())
        const bf16x8 bv = fq == 0 ? ld_frag(SB + S3_VT + (w * 16 + fr) * 16) : zfrag();
        const bf16x8 aq0 = LDP(SB + S3_QB, (fr & 7), 0), aq1 = LDP(SB + S3_QB, (fr & 7), 1);
        const bf16x8 aqk = fq == 0 ? ld_frag(SB + S3_QKM + (fr & 7) * 16) : zfrag();
        bf16x8 brv = zfrag();
        if (DELTA) {
          const bf16x8 ak0 = LDP(SB + S3_KB, (fr & 7), 0), ak1 = LDP(SB + S3_KB, (fr & 7), 1);
          const bf16x8 atb = fq == 0 ? ld_frag(SB + S3_TB + (fr & 7) * 16) : zfrag();
          f32x4 accR = __builtin_amdgcn_mfma_f32_16x16x32_bf16(ak0, bs0, z4, 0, 0, 0);
          accR = __builtin_amdgcn_mfma_f32_16x16x32_bf16(ak1, bs1, accR, 0, 0, 0);
          accR = __builtin_amdgcn_mfma_f32_16x16x32_bf16(atb, bv, accR, 0, 0, 0);
          {
            const uint2 t2 = *(const uint2*)(SB + S3_TM + (fr & 7) * 16 + (fq & 1) * 8);
            const u32x4v ta4 = {t2.x, t2.y, 0u, 0u};
            const u32x4v rb4 = {pack2(accR[0], accR[1]), pack2(accR[2], accR[3]), 0u, 0u};
            const bf16x8 at = fq < 2 ? __builtin_bit_cast(bf16x8, ta4) : zfrag();
            const bf16x8 br = fq < 2 ? __builtin_bit_cast(bf16x8, rb4) : zfrag();
            accR = __builtin_amdgcn_mfma_f32_16x16x32_bf16(at, br, z4, 0, 0, 0);
          }
          const uint2 vv2 = *(const uint2*)(SB + S3_VT + (w * 16 + fr) * 16 + (fq & 1) * 8);
          const u32x4v t4 = {pack2(accR[0], accR[1]), pack2(accR[2], accR[3]), vv2.x, vv2.y};
          brv = fq < 2 ? __builtin_bit_cast(bf16x8, t4) : zfrag();
        }
        f32x4 accY = __builtin_amdgcn_mfma_f32_16x16x32_bf16(aq0, bs0, z4, 0, 0, 0);
        accY = __builtin_amdgcn_mfma_f32_16x16x32_bf16(aq1, bs1, accY, 0, 0, 0);
        if (DELTA) {
          const uint2 qb2 = *(const uint2*)(SB + S3_QBM + (fr & 7) * 16 + (fq & 1) * 8);
          const uint2 qk2 = *(const uint2*)(SB + S3_QKM + (fr & 7) * 16 + (fq & 1) * 8);
          const u32x4v q4 = {qb2.x, qb2.y, qk2.x, qk2.y};
          const bf16x8 aqm = fq < 2 ? __builtin_bit_cast(bf16x8, q4) : zfrag();
          accY = __builtin_amdgcn_mfma_f32_16x16x32_bf16(aqm, brv, accY, 0, 0, 0);
        } else {
          accY = __builtin_amdgcn_mfma_f32_16x16x32_bf16(aqk, bv, accY, 0, 0, 0);
        }
        if (fq < 2) {
#pragma unroll
          for (int r = 0; r < 4; r++) {
            const int i = fq * 4 + r, j = dir ? 7 - i : i;
            YS[(size_t)(seg_row0 + t_lo + sc * 8 + j) * YST + dir * 768 + MIX * 256 + h * 64 + w * 16 + fr] = f2bf(accY[r]);
          }
        }
#pragma unroll
        for (int nt = 0; nt < 4; nt++) {
          f32x4 an;
          if (DELTA) {
            const uint2 b2 = *(const uint2*)(SB + S3_BT + (nt * 16 + fr) * 16 + (fq & 1) * 8);
            const uint2 k2 = *(const uint2*)(SB + S3_KVT + (nt * 16 + fr) * 16 + (fq & 1) * 8);
            const u32x4v a4 = {b2.x, b2.y, k2.x, k2.y};
            const bf16x8 am = fq < 2 ? __builtin_bit_cast(bf16x8, a4) : zfrag();
            an = __builtin_amdgcn_mfma_f32_16x16x32_bf16(am, brv, z4, 0, 0, 0);
          } else {
            const bf16x8 akv = fq == 0 ? ld_frag(SB + S3_KVT + (nt * 16 + fr) * 16) : zfrag();
            an = __builtin_amdgcn_mfma_f32_16x16x32_bf16(akv, bv, z4, 0, 0, 0);
          }
          const float4 wc = *(const float4*)(SB + S3_WC + (nt * 16 + fq * 4) * 4);
          st[nt][0] = st[nt][0] * wc.x + an[0];
          st[nt][1] = st[nt][1] * wc.y + an[1];
          st[nt][2] = st[nt][2] * wc.z + an[2];
          st[nt][3] = st[nt][3] * wc.w + an[3];
        }
#undef LDP
      }
    }
    __syncthreads();
  }
}

__device__ __forceinline__ void attn_item(const Params& p, int l, int b, int qb, int hk, bool isctx, unsigned char* smem) {
  u16* KS = (u16*)smem;
  u16* VT = KS + 64 * LDT;
  u16* PL = VT + 64 * LDT;
  float2* ROPE = (float2*)(PL + 8 * 32 * LDT);
  const int tid = TIDX, lane = tid & 63, w = tid >> 6, fr = lane & 15, fq = lane >> 4;
  const u16* P = (const u16*)(p.ws + OFF_BIG);
  u16* Y = (u16*)(p.ws + OFF_YS);
  const int qh = hk * 2 + (w >> 2);
  const int tb = qb * 128 + (w & 3) * 32;
  const int qrow0 = b * TPB + (isctx ? 0 : LC);
  __syncthreads();
  for (int i = tid; i < 1024; i += NTHR) {
    int pos = i >> 4, fi = i & 15;
    float inv = powf(10000.f, -(float)fi / 16.f);
    float sn, cs;
    sincosf((float)pos * inv, &sn, &cs);
    ROPE[i] = make_float2(cs, sn);
  }
  __syncthreads();
  bf16x8 qf[2][2];
#pragma unroll
  for (int mi = 0; mi < 2; mi++)
#pragma unroll
    for (int ks = 0; ks < 2; ks++) {
      const int tq = tb + mi * 16 + fr;
      const u16* qp = P + (size_t)(qrow0 + tq) * PST + PD + qh * 64 + ks * 32;
      uint4 own = *(const uint4*)(qp + fq * 8);
      uint4 par = *(const uint4*)(qp + (fq ^ 2) * 8);
      const unsigned ow[4] = {own.x, own.y, own.z, own.w};
      const unsigned pw[4] = {par.x, par.y, par.z, par.w};
      const int pos = ks == 0 ? (tq >> 6) : (tq & 63);
      bf16x8 f;
#pragma unroll
      for (int jj = 0; jj < 8; jj++) {
        float xo = bf2f((u16)((ow[jj >> 1] >> ((jj & 1) * 16)) & 0xffff));
        float xp = bf2f((u16)((pw[jj >> 1] >> ((jj & 1) * 16)) & 0xffff));
        float v = xo;
        if (!isctx) {
          float2 cs = ROPE[pos * 16 + (fq & 1) * 8 + jj];
          v = fq < 2 ? xo * cs.x - xp * cs.y : xp * cs.y + xo * cs.x;
        }
        f[jj] = (short)f2bf(v * 0.125f);
      }
      qf[mi][ks] = f;
    }
  f32x4 oacc[2][4];
#pragma unroll
  for (int mi = 0; mi < 2; mi++)
#pragma unroll
    for (int nd = 0; nd < 4; nd++) oacc[mi][nd] = f32x4{0.f, 0.f, 0.f, 0.f};
  float mrow[2][4], lrow[2][4];
#pragma unroll
  for (int mi = 0; mi < 2; mi++)
#pragma unroll
    for (int r = 0; r < 4; r++) { mrow[mi][r] = -1e30f; lrow[mi][r] = 0.f; }

  const int q0 = qb * 128;
  const int band_lo = isctx ? 0 : max(0, q0 - 128), band_hi = isctx ? 0 : min(SEQ, q0 + 256);
  const int ntile = 4 + (band_hi - band_lo) / 64;
  u16* pl = PL + w * 32 * LDT;
  for (int tl = 0; tl < ntile; tl++) {
    const bool band = tl >= 4;
    const int k0 = band ? band_lo + (tl - 4) * 64 : tl * 64;
    __syncthreads();
    {
      const int key = tid >> 3, kc = tid & 7;
      const int kpos = k0 + key;
      const u16* kp = P + (size_t)(b * TPB + (band ? LC : 0) + kpos) * PST + PD + 256 + hk * 64;
      uint4 own = *(const uint4*)(kp + kc * 8);
      uint4 vv = *(const uint4*)(kp + 128 + kc * 8);
      uint4 par = *(const uint4*)(kp + (kc ^ 2) * 8);
      if (band) {
        const unsigned ow[4] = {own.x, own.y, own.z, own.w};
        const unsigned pw[4] = {par.x, par.y, par.z, par.w};
        const int pos = kc < 4 ? (kpos >> 6) : (kpos & 63);
        unsigned res[4];
#pragma unroll
        for (int jj = 0; jj < 8; jj += 2) {
          float v2[2];
#pragma unroll
          for (int e = 0; e < 2; e++) {
            float xo = bf2f((u16)((ow[jj >> 1] >> (e * 16)) & 0xffff));
            float xp = bf2f((u16)((pw[jj >> 1] >> (e * 16)) & 0xffff));
            float2 cs = ROPE[pos * 16 + (kc & 1) * 8 + jj + e];
            v2[e] = (kc & 2) == 0 ? xo * cs.x - xp * cs.y : xp * cs.y + xo * cs.x;
          }
          res[jj >> 1] = pack2(v2[0], v2[1]);
        }
        own = make_uint4(res[0], res[1], res[2], res[3]);
      }
      *(uint4*)(KS + key * LDT + kc * 8) = own;
      const unsigned vw[4] = {vv.x, vv.y, vv.z, vv.w};
#pragma unroll
      for (int jj = 0; jj < 8; jj++) VT[(kc * 8 + jj) * LDT + key] = (u16)((vw[jj >> 1] >> ((jj & 1) * 16)) & 0xffff);
    }
    __syncthreads();
    f32x4 sc[2][4];
#pragma unroll
    for (int mi = 0; mi < 2; mi++)
#pragma unroll
      for (int nj = 0; nj < 4; nj++) sc[mi][nj] = f32x4{0.f, 0.f, 0.f, 0.f};
#pragma unroll
    for (int ks = 0; ks < 2; ks++) {
      bf16x8 kf[4];
#pragma unroll
      for (int nj = 0; nj < 4; nj++) kf[nj] = *(const bf16x8*)(KS + (nj * 16 + fr) * LDT + ks * 32 + fq * 8);
#pragma unroll
      for (int mi = 0; mi < 2; mi++)
#pragma unroll
        for (int nj = 0; nj < 4; nj++) sc[mi][nj] = __builtin_amdgcn_mfma_f32_16x16x32_bf16(qf[mi][ks], kf[nj], sc[mi][nj], 0, 0, 0);
    }
#pragma unroll
    for (int mi = 0; mi < 2; mi++)
#pragma unroll
      for (int r = 0; r < 4; r++) {
        const int qpos = tb + mi * 16 + fq * 4 + r;
        float mx = -1e30f;
#pragma unroll
        for (int nj = 0; nj < 4; nj++) {
          float v = sc[mi][nj][r];
          if (band) {
            int d = qpos - (k0 + nj * 16 + fr);
            if (d > 128 || d < -128) v = -1e30f;
          }
          sc[mi][nj][r] = v;
          mx = fmaxf(mx, v);
        }
        mx = fmaxf(mx, __shfl_xor(mx, 1));
        mx = fmaxf(mx, __shfl_xor(mx, 2));
        mx = fmaxf(mx, __shfl_xor(mx, 4));
        mx = fmaxf(mx, __shfl_xor(mx, 8));
        const float mnew = fmaxf(mrow[mi][r], mx);
        const float alpha = __expf(mrow[mi][r] - mnew);
        mrow[mi][r] = mnew;
        float ls = 0.f;
#pragma unroll
        for (int nj = 0; nj < 4; nj++) {
          float pe = __expf(sc[mi][nj][r] - mnew);
          ls += pe;
          pl[(mi * 16 + fq * 4 + r) * LDT + nj * 16 + fr] = f2bf(pe);
        }
        lrow[mi][r] = lrow[mi][r] * alpha + ls;
#pragma unroll
        for (int nd = 0; nd < 4; nd++) oacc[mi][nd][r] *= alpha;
      }
    asm volatile("s_waitcnt lgkmcnt(0)" ::: "memory");
    __builtin_amdgcn_wave_barrier();
#pragma unroll
    for (int ks = 0; ks < 2; ks++) {
      bf16x8 pf[2], vf[4];
#pragma unroll
      for (int mi = 0; mi < 2; mi++) pf[mi] = *(const bf16x8*)(pl + (mi * 16 + fr) * LDT + ks * 32 + fq * 8);
#pragma unroll
      for (int nd = 0; nd < 4; nd++) vf[nd] = *(const bf16x8*)(VT + (nd * 16 + fr) * LDT + ks * 32 + fq * 8);
#pragma unroll
      for (int mi = 0; mi < 2; mi++)
#pragma unroll
        for (int nd = 0; nd < 4; nd++) oacc[mi][nd] = __builtin_amdgcn_mfma_f32_16x16x32_bf16(pf[mi], vf[nd], oacc[mi][nd], 0, 0, 0);
    }
    asm volatile("s_waitcnt lgkmcnt(0)" ::: "memory");
    __builtin_amdgcn_wave_barrier();
  }
  const float sink = p.attn_sink[l * 4 + qh];
#pragma unroll
  for (int mi = 0; mi < 2; mi++)
#pragma unroll
    for (int r = 0; r < 4; r++) {
      float ls = lrow[mi][r];
      ls += __shfl_xor(ls, 1);
      ls += __shfl_xor(ls, 2);
      ls += __shfl_xor(ls, 4);
      ls += __shfl_xor(ls, 8);
      ls += __expf(sink - mrow[mi][r]);
      const float inv = 1.f / ls;
      const int tq = tb + mi * 16 + fq * 4 + r;
#pragma unroll
      for (int nd = 0; nd < 4; nd++) Y[(size_t)(qrow0 + tq) * YST + 1536 + qh * 64 + nd * 16 + fr] = f2bf(oacc[mi][nd][r] * inv);
    }
}

#ifndef SCAN3_MASK
#define SCAN3_MASK 7
#endif
__device__ __forceinline__ void phase_mix(const Params& p, int l, unsigned char* smem) {
  float* sm = (float*)smem;
  const int G = gridDim.x;
  for (int it = blockIdx.x; it < 192; it += G) {
    const int mix = it >> 6, rem = it & 63, b = rem >> 3, h = (rem >> 1) & 3, dir = rem & 1;
    if (mix == 0 && (SCAN3_MASK & 1)) scan3_item<0>(p, l, b, h, dir, smem);
    else if (mix == 1 && (SCAN3_MASK & 2)) scan3_item<1>(p, l, b, h, dir, smem);
    else if (mix == 2 && (SCAN3_MASK & 4)) scan3_item<2>(p, l, b, h, dir, smem);
  }
  if (SCAN3_MASK != 7) {
    for (int it = blockIdx.x; it < 768; it += G) {
      const int mix = it >> 8, rem = it & 255, b = rem >> 5, h = (rem >> 3) & 3, dir = (rem >> 2) & 1, rq = rem & 3;
      if (mix == 0 && !(SCAN3_MASK & 1)) scan2_item<0>(p, l, b, h, dir, rq, sm);
      else if (mix == 1 && !(SCAN3_MASK & 2)) scan2_item<1>(p, l, b, h, dir, rq, sm);
      else if (mix == 2 && !(SCAN3_MASK & 4)) scan2_item<2>(p, l, b, h, dir, rq, sm);
    }
  }
  __syncthreads();
  {
    const bool spread = G >= 192;
    const int nconv = spread ? 64 : G, fidx = spread ? (int)blockIdx.x - 128 : (int)blockIdx.x;
    if (fidx >= 0 && fidx < nconv)
      for (int it = 832 + fidx; it < 4480; it += nconv) conv_item(p, l, it, (float*)smem);
    __syncthreads();
  }
  unsigned* ctr = (unsigned*)(p.ws + OFF_CTR) + l * 16;
  volatile int* slot = (volatile int*)(smem + 131072 - 16);
  for (;;) {
    if (TIDX == 0) *slot = (int)atomicAdd(ctr, 1u);
    __syncthreads();
    const int it = *slot;
    __syncthreads();
    if (it >= (l == 0 ? 544 : 512)) break;
    if (it < 512) {
      int b = it >> 6, qb = (it >> 1) & 31, hk = it & 1;
      attn_item(p, l, b, qb, hk, false, smem);
    } else {
      int r = it - 512, b = r >> 2, qb = (r >> 1) & 1, hk = r & 1;
      attn_item(p, l, b, qb, hk, true, smem);
    }
  }
}

#define POST_DECL(PFX) uint2 PFX##ya0, PFX##ya1, PFX##ya2, PFX##yc0, PFX##yc1, PFX##yc2, PFX##vp, PFX##vc, PFX##vn, PFX##gb, PFX##gc; \
  u16 PFX##xp, PFX##xc, PFX##xn; float2 PFX##bc
#define POST_LOAD(PFX, R_)                                                                         \
  do {                                                                                             \
    const int r_ = (R_);                                                                           \
    const int b_ = r_ / TPB, t_ = r_ - b_ * TPB;                                                   \
    const bool hp_ = (t_ != 0) && (t_ != LC), hn_ = (t_ != LC - 1) && (t_ != TPB - 1);            \
    const u16* ys_ = YSc + (size_t)r_ * YST;                                                       \
    const u16* pr_ = Pc + (size_t)r_ * PST;                                                        \
    const u16* pp_ = pr_ - (hp_ ? PST : 0);                                                        \
    const u16* pn_ = pr_ + (hn_ ? PST : 0);                                                        \
    PFX##ya0 = *(const uint2*)(ys_ + j0); PFX##ya1 = *(const uint2*)(ys_ + 256 + j0); PFX##ya2 = *(const uint2*)(ys_ + 512 + j0); \
    PFX##yc0 = *(const uint2*)(ys_ + 768 + j0); PFX##yc1 = *(const uint2*)(ys_ + 1024 + j0); PFX##yc2 = *(const uint2*)(ys_ + 1280 + j0); \
    PFX##vp = *(const uint2*)(pp_ + PA + 512 + j0);                                                \
    PFX##vc = *(const uint2*)(pr_ + PA + 512 + j0);                                                \
    PFX##vn = *(const uint2*)(pn_ + PA + 512 + j0);                                                \
    PFX##gb = *(const uint2*)(pr_ + PB + 784 + j0);                                                \
    PFX##gc = *(const uint2*)(pr_ + PC + 544 + j0);                                                \
    PFX##xp = pp_[PA + 896 + lane]; PFX##xc = pr_[PA + 896 + lane]; PFX##xn = pn_[PA + 896 + lane]; \
    PFX##bc = *(const float2*)(BCc + (size_t)r_ * 8 + (lane >> 4) * 2);                            \
  } while (0)
__device__ __forceinline__ void unpack4(uint2 v, float (&o)[4]) {
  o[0] = __uint_as_float(v.x << 16); o[1] = __uint_as_float(v.x & 0xffff0000u);
  o[2] = __uint_as_float(v.y << 16); o[3] = __uint_as_float(v.y & 0xffff0000u);
}

__device__ __forceinline__ void phase_post(const Params& p, int l, float* g2s) {
  const int lane = TIDX & 63, wv = __builtin_amdgcn_readfirstlane(TIDX >> 6);
  u16* YS = (u16*)(p.ws + OFF_YS);
  const int j0 = lane * 4;
  {
    const float4* src = (const float4*)(p.rwkv_g2 + (size_t)l * 64 * 256);
    for (int i = TIDX; i < 64 * 256 / 4; i += NTHR) ((float4*)g2s)[i] = src[i];
  }
  float mu_v[4], lng[4], lnb[4], ngb[4], ngc[4];
#pragma unroll
  for (int i = 0; i < 4; i++) {
    mu_v[i] = p.rwkv_mu[l * 960 + 512 + j0 + i];
    lng[i] = p.rwkv_ln_g[l * 256 + j0 + i];
    lnb[i] = p.rwkv_ln_b[l * 256 + j0 + i];
    ngb[i] = p.gdn_norm_g[l * 64 + (lane & 15) * 4 + i];
    ngc[i] = p.gla_norm_g[l * 64 + (lane & 15) * 4 + i];
  }
  const float mu_x = p.rwkv_mu[l * 960 + 896 + lane];
  __syncthreads();
  const int stride = gridDim.x * 8;
  int r = blockIdx.x * 8 + wv;
  const u16* Pc = (const u16*)(p.ws + OFF_BIG);
  const u16* YSc = (const u16*)(p.ws + OFF_YS);
  const float* BCc = (const float*)(p.ws + OFF_BC);
  POST_DECL(cur_);
  POST_DECL(nxt_);
  POST_LOAD(cur_, r);
  for (; r < NROWS; r += stride) {
    const int rn = r + stride < NROWS ? r + stride : r;
    POST_LOAD(nxt_, rn);
    const int b = r / TPB, t = r - b * TPB;
    const float pmul = ((t != 0) && (t != LC)) ? 1.f : 0.f, nmul = ((t != LC - 1) && (t != TPB - 1)) ? 1.f : 0.f;
    if (!(l == 1 && t < LC)) {
    float y[3][4];
    {
      float a4[4], c4[4];
      unpack4(cur_ya0, a4); unpack4(cur_yc0, c4);
#pragma unroll
      for (int i = 0; i < 4; i++) y[0][i] = a4[i] + c4[i];
      unpack4(cur_ya1, a4); unpack4(cur_yc1, c4);
#pragma unroll
      for (int i = 0; i < 4; i++) y[1][i] = a4[i] + c4[i];
      unpack4(cur_ya2, a4); unpack4(cur_yc2, c4);
#pragma unroll
      for (int i = 0; i < 4; i++) y[2][i] = a4[i] + c4[i];
    }
    float o[3][4];
    {
      float sum = y[0][0] + y[0][1] + y[0][2] + y[0][3];
      sum = red16(sum);
      const float mean = sum * (1.f / 64.f);
      float vs = 0.f;
#pragma unroll
      for (int i = 0; i < 4; i++) { float d = y[0][i] - mean; vs += d * d; }
      vs = red16(vs);
      const float rstd = rsq(vs * (1.f / 64.f) + 64e-5f);
      const float pv = bf2f(cur_xc), ppv = bf2f(cur_xp) * pmul, pnv = bf2f(cur_xn) * nmul;
      const float sg = sigm(pv + (0.5f * (ppv + pnv) - pv) * mu_x);
      float gate[4] = {0.f, 0.f, 0.f, 0.f};
      const float* g2 = g2s + j0;
#pragma unroll 8
      for (int i = 0; i < 64; i++) {
        const float si = __int_as_float(__builtin_amdgcn_readlane(__float_as_int(sg), i));
        const float4 gw = *(const float4*)(g2 + i * 256);
        gate[0] += si * gw.x; gate[1] += si * gw.y; gate[2] += si * gw.z; gate[3] += si * gw.w;
      }
      const float bcs = cur_bc.x + cur_bc.y;
      float vc4[4], vp4[4], vn4[4];
      unpack4(cur_vc, vc4); unpack4(cur_vp, vp4); unpack4(cur_vn, vn4);
#pragma unroll
      for (int i = 0; i < 4; i++) {
        const float v = vc4[i] + (0.5f * (vp4[i] * pmul + vn4[i] * nmul) - vc4[i]) * mu_v[i];
        const float yn = (y[0][i] - mean) * rstd * lng[i] + lnb[i];
        o[0][i] = (yn + bcs * v) * gate[i];
      }
    }
#pragma unroll
    for (int m = 1; m < 3; m++) {
      float ss = y[m][0] * y[m][0] + y[m][1] * y[m][1] + y[m][2] * y[m][2] + y[m][3] * y[m][3];
      ss = red16(ss);
      const float inv = rsq(ss * (1.f / 64.f) + 1e-6f);
      float g4[4];
      unpack4(m == 1 ? cur_gb : cur_gc, g4);
#pragma unroll
      for (int i = 0; i < 4; i++) o[m][i] = y[m][i] * inv * (m == 1 ? ngb[i] : ngc[i]) * siluf(g4[i]);
    }
    u16* ys = YS + (size_t)r * YST;
#pragma unroll
    for (int m = 0; m < 3; m++) {
      uint2 ov;
      ov.x = pack2(o[m][0], o[m][1]);
      ov.y = pack2(o[m][2], o[m][3]);
      *(uint2*)(ys + m * 256 + j0) = ov;
    }
    }
    cur_ya0 = nxt_ya0; cur_ya1 = nxt_ya1; cur_ya2 = nxt_ya2; cur_yc0 = nxt_yc0; cur_yc1 = nxt_yc1; cur_yc2 = nxt_yc2;
    cur_vp = nxt_vp; cur_vc = nxt_vc; cur_vn = nxt_vn; cur_gb = nxt_gb; cur_gc = nxt_gc;
    cur_xp = nxt_xp; cur_xc = nxt_xc; cur_xn = nxt_xn; cur_bc = nxt_bc;
  }
}

#define XB_TMO      128
#define XB_XCNT(j)  (256  + 64 * (j))
#define XB_XSUB(j)  (1280 + 64 * (j))
#define XB_XGEN(j)  (2304 + 64 * (j))
#define XB_TOP      3328
#define XB_TOPGEN   3392
#define XCD_BAR_WORDS 3456
#define XB_SPIN_CAP (1u << 18)
#define LAS __attribute__((address_space(3)))

__device__ __forceinline__ unsigned xb_ld(unsigned* p)              { return __hip_atomic_load(p, __ATOMIC_RELAXED, __HIP_MEMORY_SCOPE_AGENT); }
__device__ __forceinline__ unsigned xb_add(unsigned* p, unsigned v) { return __hip_atomic_fetch_add(p, v, __ATOMIC_RELAXED, __HIP_MEMORY_SCOPE_AGENT); }
__device__ __forceinline__ unsigned xb_xcc_id() { return (unsigned)__builtin_amdgcn_s_getreg((3 << 11) | 20) & 0xFu; }
#define XB_SPIN(cond, bar) do { unsigned _sp = 0; while (cond) { __builtin_amdgcn_s_sleep(1); \
    if ((++_sp & 255u) == 0u) { if (xb_ld(&(bar)[XB_TMO])) break; if (_sp > XB_SPIN_CAP) { atomicAdd(&(bar)[XB_TMO], 1u); break; } } } } while (0)

struct XcdBarrier {
    unsigned* bar; unsigned x;
    volatile LAS unsigned* st;
};

__device__ __forceinline__ XcdBarrier xcd_barrier_post(unsigned* bar, volatile LAS unsigned* st) {
    XcdBarrier b; b.bar = bar; b.x = xb_xcc_id(); b.st = st;
    if (threadIdx.x == 0) (void)xb_add(&bar[XB_XCNT(b.x)], 1u);
    return b;
}
__device__ __forceinline__ void xcd_barrier_complete(unsigned* bar, unsigned x, unsigned& nloc, unsigned& nx) {
    const unsigned G = gridDim.x * gridDim.y * gridDim.z;
    unsigned sum, cnt, mine, sp = 0u;
    for (;;) {
        sum = 0u; cnt = 0u; mine = 0u;
#pragma unroll
        for (unsigned j = 0; j < 16; ++j) { const unsigned c = xb_ld(&bar[XB_XCNT(j)]); sum += c; cnt += (c > 0u) ? 1u : 0u; mine = (j == x) ? c : mine; }
        if (sum == G) break;
        __builtin_amdgcn_s_sleep(1);
        if ((++sp & 255u) == 0u) { if (xb_ld(&bar[XB_TMO])) break; if (sp > XB_SPIN_CAP) { atomicAdd(&bar[XB_TMO], 1u); break; } }
    }
    nloc = mine > 0u ? mine : 1u; nx = cnt > 0u ? cnt : 1u;
}

__device__ __forceinline__ void xcd_barrier(const XcdBarrier& b) {
    asm volatile("s_waitcnt vmcnt(0)" ::: "memory");
    __syncthreads();
    if (threadIdx.x == 0) {
        unsigned* bar = b.bar;
        __builtin_amdgcn_s_waitcnt(0);
        unsigned nloc = b.st[0], nx = b.st[1];
        if (nloc == 0u) { xcd_barrier_complete(bar, b.x, nloc, nx); b.st[0] = nloc; b.st[1] = nx; }
        const unsigned old = xb_add(&bar[XB_XSUB(b.x)], 1u);
        const unsigned gen = old / nloc;
        if (old + 1u == (gen + 1u) * nloc) {
            __builtin_amdgcn_fence(__ATOMIC_RELEASE, "agent");
            asm volatile("s_waitcnt vmcnt(0)" ::: "memory");
            const unsigned og = xb_add(&bar[XB_TOP], 1u);
            const unsigned tg = og / nx;
            if (og + 1u == (tg + 1u) * nx) xb_add(&bar[XB_TOPGEN], 1u);
            else XB_SPIN(xb_ld(&bar[XB_TOPGEN]) == tg, bar);
            __builtin_amdgcn_fence(__ATOMIC_ACQUIRE, "agent");
            xb_add(&bar[XB_XGEN(b.x)], 1u);
            asm volatile("s_waitcnt vmcnt(0)" ::: "memory");
        } else {
            XB_SPIN(xb_ld(&bar[XB_XGEN(b.x)]) == gen, bar);
            __builtin_amdgcn_fence(__ATOMIC_ACQUIRE, "agent");
            asm volatile("s_waitcnt vmcnt(0)" ::: "memory");
        }
    }
    __syncthreads();
}

#if defined(SKIPS)
#define EN(k) (SKIPS != (k))
#elif !defined(ONLYS)
#define EN(k) 1
#else
#define EN(k) (ONLYS == (k))
#endif
__device__ __forceinline__ void run_phase(const Params& p, int ph, unsigned char* smem) {
  if (ph == 0) { if (EN(10)) phase_init0(p, (float*)smem); return; }
  if (ph == 1) { if (EN(11)) phase_init1(p); return; }
  int l = 0, s = 10;
  if (ph >= 3) { l = (ph - 3) / 10; s = (ph - 3) - l * 10; }
  unsigned char* wl = p.ws + OFF_W;
  PG8_LAS unsigned char* lds = (PG8_LAS unsigned char*)smem;
  pg8::StaticOrder S;
  if (s == 10 || s == 6 || s == 9) {
    if (EN(5)) rowpass(p, l, s == 10 ? 0 : (s == 6 ? 1 : 2));
    if (s == 9 && l == 0) {
      __syncthreads();
      for (int it = blockIdx.x; it < 832; it += gridDim.x) conv_item(p, 1, it, (float*)smem);
    }
  } else if (s == 0 || s == 3 || s == 5 || s == 8) {
    pg8::Gemm g; EpiBf E;
    g.M = NROWS; E.bias = nullptr; E.act = 0;
    if (s == 0) { g.A = (const u16*)(p.ws + OFF_H); g.lda = DM; g.Bt = (const u16*)(wl + OW_IN); g.K = DM; g.N = PST; E.O = (u16*)(p.ws + OFF_BIG); E.ldc = PST; }
    else if (s == 3) {
      g.A = (const u16*)(p.ws + OFF_H); g.lda = DM; g.Bt = (const u16*)(wl + OW_G); g.K = DM; g.N = 4096;
      E.O = (u16*)(p.ws + OFF_BIG); E.ldc = 4096; E.bias = p.gate_b + (size_t)l * 4096; E.act = 1;
    }
    else if (s == 5) { g.A = (const u16*)(p.ws + OFF_H); g.lda = DM; g.Bt = (const u16*)(wl + OW_O); g.K = DM; g.N = DM; E.O = (u16*)(p.ws + OFF_BIG); E.ldc = DM; }
    else { g.A = (const u16*)(p.ws + OFF_BIG); g.lda = FH; g.Bt = (const u16*)(wl + OW_2); g.K = FH; g.N = DM; E.O = (u16*)(p.ws + OFF_YS); E.ldc = DM; }
    if (l == 1 && s != 0) S.init(NBATCH * SEQ, g.N, gridDim.x, blockIdx.x, 1);
    else S.init(g.M, g.N, gridDim.x, blockIdx.x);
    if (EN(0)) pg8::gemm_phase<EpiBf, pg8::StaticOrder, false>(lds, g, S, E, nullptr);
  } else if (s == 4) {
    if (EN(3)) phase_ypart(p, l, smem);
  } else if (s == 1) {
    if (EN(1)) phase_mix(p, l, smem);
  } else if (s == 2) {
    if (EN(2)) phase_post(p, l, (float*)smem);
  } else {
    pg8::Gemm g; EpiSwiglu E;
    g.M = NROWS; g.N = 2 * FH; g.K = DM; g.lda = DM; g.A = (const u16*)(p.ws + OFF_H); g.Bt = (const u16*)(wl + OW_1);
    E.O = (u16*)(p.ws + OFF_BIG);
    if (l == 1) S.init(NBATCH * SEQ, g.N, gridDim.x, blockIdx.x, 1);
    else S.init(g.M, g.N, gridDim.x, blockIdx.x);
    if (EN(6)) pg8::gemm_phase<EpiSwiglu, pg8::StaticOrder, false>(lds, g, S, E, nullptr);
  }
}

__global__ void __launch_bounds__(NTHR) hybrid_flow_mega(Params p, int ph0, int ph1) {
  __shared__ __attribute__((aligned(16))) unsigned char smem[131072];
  __shared__ __attribute__((aligned(16))) unsigned xbw[4];
  cg::grid_group grid = cg::this_grid();
  XcdBarrier xb;
  xb.bar = (unsigned*)(p.ws + OFF_XBAR); xb.x = 0u; xb.st = (volatile LAS unsigned*)xbw;
  for (int ph = ph0; ph < ph1; ph++) {
    run_phase(p, ph, smem);
#ifdef DUPMASK
    {
      int sidx = ph >= 3 ? (ph - 3) % 10 : 12 + ph;
      if ((DUPMASK >> sidx) & 1) { __syncthreads(); run_phase(p, ph, smem); }
    }
#endif
    if (ph + 1 < ph1) {
      if (ph == ph0) {
        grid.sync();
        if (threadIdx.x < 4) xbw[threadIdx.x] = 0u;
        __syncthreads();
        xb = xcd_barrier_post((unsigned*)(p.ws + OFF_XBAR), (volatile LAS unsigned*)xbw);
      } else {
        xcd_barrier(xb);
      }
    }
  }
  if (ph1 - ph0 > 2 && threadIdx.x == 0 && xb_ld(&xb.bar[XB_TMO]) != 0u) p.out[blockIdx.x] = __int_as_float(0x7fc00000);
}

extern "C" void kernel_launch(void* const* d_in, const int* in_sizes, int n_in, void* d_out, int out_size, void* d_ws,
                              size_t ws_size, hipStream_t stream) {
  Params p{};
  const float** pp = (const float**)&p;
  for (int i = 0; i < 32; i++) pp[i] = (const float*)d_in[i];
  p.out = (float*)d_out;
  p.ws = (unsigned char*)d_ws;
  static int grid_blocks = 0;
  if (!grid_blocks) {
    int dev = 0, cus = 0, per_cu = 0;
    hipGetDevice(&dev);
    hipDeviceGetAttribute(&cus, hipDeviceAttributeMultiprocessorCount, dev);
    hipOccupancyMaxActiveBlocksPerMultiprocessor(&per_cu, hybrid_flow_mega, NTHR, 0);
    if (per_cu < 1) per_cu = 1;
    grid_blocks = cus * per_cu;
  }
#ifdef MULTI_LAUNCH
  for (int ph = 0; ph < NPHASE; ph++) {
    hipLaunchKernelGGL(hybrid_flow_mega, dim3(grid_blocks), dim3(NTHR), 0, stream, p, ph, ph + 1);
  }
#else
  int ph0 = 0, ph1 = NPHASE;
  void* args[] = {&p, &ph0, &ph1};
  hipError_t e = hipLaunchCooperativeKernel((void*)hybrid_flow_mega, dim3(grid_blocks), dim3(NTHR), args, 0, stream);
  if (e != hipSuccess) fprintf(stderr, "cooperative launch failed: %s (grid %d)\n", hipGetErrorString(e), grid_blocks);
#endif
}
```

```cpp
#include <hip/hip_runtime.h>
#include <hip/hip_cooperative_groups.h>
#include <cstdio>
namespace cg = cooperative_groups;

typedef unsigned short u16;
using bf16x8 = __attribute__((ext_vector_type(8))) short;
using f32x4 = __attribute__((ext_vector_type(4))) float;

#define DM 1024
#define NBATCH 8
#define SEQ 4096
#define LC 256
#define TPB 4352
#define NROWS 34816
#define PST 3328
#define YST 1792
#define FH 2816
#define INW 7408
#define NTHR 512
#define PA 0
#define PB 960
#define PC 2000
#define PD 2800
#define NPHASE 23
#define SCAN3_MASK 7

struct Params {
  const float *x, *c, *ctx, *c_ctx, *ada_w, *ada_b, *norm_g, *w_in, *gate_b, *w_branch, *w_out,
      *rwkv_mu, *rwkv_w0, *rwkv_w2, *rwkv_a0, *rwkv_a2, *rwkv_g2, *rwkv_kk, *rwkv_ka, *rwkv_rk, *rwkv_ln_g,
      *rwkv_ln_b, *gdn_conv, *gdn_a_log, *gdn_dt_bias, *gdn_norm_g, *gla_gw2, *gla_gb, *gla_norm_g, *attn_sink,
      *ffn_w1, *ffn_w2;
  float* out;
  unsigned char* ws;
};

constexpr size_t SZ_WL = 36700160;
constexpr size_t OW_IN = 0;
constexpr size_t OW_G = OW_IN + (size_t)PST * 1024 * 2;
constexpr size_t OW_B = OW_G + (size_t)4096 * 1024 * 2;
constexpr size_t OW_O = OW_B + (size_t)4 * 1024 * 256 * 2;
constexpr size_t OW_1 = OW_O + (size_t)1024 * 1024 * 2;
constexpr size_t OW_2 = OW_1 + (size_t)5632 * 1024 * 2;
static_assert(OW_2 + (size_t)1024 * FH * 2 == SZ_WL, "weights size");
constexpr size_t SZ_ACT = (size_t)NROWS * DM * 2;
constexpr size_t OFF_W = 0;
constexpr size_t OFF_XC = OFF_W + SZ_WL;
constexpr size_t OFF_MODP = OFF_XC + (size_t)NBATCH * LC * DM * 4;
constexpr size_t OFF_MOD = OFF_MODP + (size_t)2 * 8 * 9 * 6144 * 4;
constexpr size_t OFF_BC = OFF_MOD + (size_t)2 * 9 * 6144 * 4;
constexpr size_t OFF_H = OFF_BC + (size_t)NROWS * 8 * 4;
constexpr size_t OFF_YS = OFF_H + SZ_ACT;
constexpr size_t OFF_BIG = OFF_YS + (size_t)NROWS * YST * 2;
constexpr size_t OFF_CTR = OFF_BIG + (size_t)NROWS * 4096 * 2;
constexpr size_t OFF_XBAR = OFF_CTR + 256;
constexpr size_t WS_END = OFF_XBAR + 3456 * 4;
static_assert(WS_END <= (size_t)536870912, "ws too large");

__device__ __forceinline__ int launder_tid() { int t = threadIdx.x; asm volatile("" : "+v"(t)); return t; }
#define TIDX (launder_tid())
typedef float f32x2_t __attribute__((ext_vector_type(2)));
typedef __bf16 bf16x2_t __attribute__((ext_vector_type(2)));
__device__ __forceinline__ unsigned pack2(float a, float b) {
  const f32x2_t v = {a, b};
  const bf16x2_t r = __builtin_convertvector(v, bf16x2_t);
  return __builtin_bit_cast(unsigned, r);
}
__device__ __forceinline__ u16 f2bf(float f) { return (u16)(pack2(f, 0.f) & 0xffffu); }
__device__ __forceinline__ float bf2f(u16 h) { return __uint_as_float(((unsigned)h) << 16); }
__device__ __forceinline__ float sigm(float x) { return __builtin_amdgcn_rcpf(1.f + __expf(-x)); }
__device__ __forceinline__ float siluf(float x) { return x * __builtin_amdgcn_rcpf(1.f + __expf(-x)); }
__device__ __forceinline__ float rsq(float x) { return __builtin_amdgcn_rsqf(x); }
__device__ __forceinline__ float softplusf(float x) { return fmaxf(x, 0.f) + __logf(1.f + __expf(-fabsf(x))); }
__device__ __forceinline__ float tanh_fast(float x) { return 1.f - 2.f * __builtin_amdgcn_rcpf(1.f + __expf(2.f * x)); }
__device__ __forceinline__ float wsum(float v) {
#pragma unroll
  for (int o = 32; o > 0; o >>= 1) v += __shfl_xor(v, o);
  return v;
}
template <int CTRL>
__device__ __forceinline__ float dppf(float x) {
  return __int_as_float(__builtin_amdgcn_update_dpp(__float_as_int(x), __float_as_int(x), CTRL, 0xf, 0xf, false));
}
__device__ __forceinline__ float red8(float x) {
  x += dppf<0xB1>(x);
  x += dppf<0x4E>(x);
  x += dppf<0x141>(x);
  return x;
}
__device__ __forceinline__ const float* xin_row(const Params& p, int r) {
  int b = r / TPB, t = r - b * TPB;
  return t < LC ? p.ctx + ((size_t)(b * LC + t)) * DM : p.x + ((size_t)(b * SEQ + t - LC)) * DM;
}
__device__ __forceinline__ float* x_row(const Params& p, int r) {
  int b = r / TPB, t = r - b * TPB;
  return t < LC ? (float*)(p.ws + OFF_XC) + ((size_t)(b * LC + t)) * DM : p.out + ((size_t)(b * SEQ + t - LC)) * DM;
}
__device__ __forceinline__ int mod_row(int r) {
  int b = r / TPB, t = r - b * TPB;
  return t < LC ? 8 : b;
}

struct MapId { int lim, off; __device__ int operator()(int n) const { return n < lim ? n + off : -1; } };
struct MapW1 { __device__ int operator()(int n) const { int q = n >> 3, s = n & 7; return s < 4 ? q * 4 + s : FH + q * 4 + (s - 4); } };

template <class Map>
__device__ __forceinline__ void conv_tile(const float* __restrict__ src, int ld, u16* __restrict__ dst, int K, int n0,
                                          int k0, Map map, float* tile) {
  const int tid = TIDX;
  const int nn = tid & 63, kr = tid >> 6;
  const int sc = map(n0 + nn);
  float tv[8];
  const int scc = sc >= 0 ? sc : 0;
  const float scm = sc >= 0 ? 1.f : 0.f;
#pragma unroll
  for (int ps = 0; ps < 8; ps++) tv[ps] = src[(size_t)(k0 + ps * 8 + kr) * ld + scc];
#pragma unroll
  for (int ps = 0; ps < 8; ps++) tile[(ps * 8 + kr) * 65 + nn] = tv[ps] * scm;
  __syncthreads();
  const int n2 = tid >> 3, kc = tid & 7;
  uint4 o;
  o.x = pack2(tile[(kc * 8 + 0) * 65 + n2], tile[(kc * 8 + 1) * 65 + n2]);
  o.y = pack2(tile[(kc * 8 + 2) * 65 + n2], tile[(kc * 8 + 3) * 65 + n2]);
  o.z = pack2(tile[(kc * 8 + 4) * 65 + n2], tile[(kc * 8 + 5) * 65 + n2]);
  o.w = pack2(tile[(kc * 8 + 6) * 65 + n2], tile[(kc * 8 + 7) * 65 + n2]);
  *(uint4*)(dst + (size_t)(n0 + n2) * K + k0 + kc * 8) = o;
  __syncthreads();
}

__device__ __forceinline__ void conv_item(const Params& p, int l, int rem, float* sm) {
      u16* wl = (u16*)(p.ws + OFF_W);
      if (rem < 832) {
        int nt = rem >> 4, kt = rem & 15;
        conv_tile(p.w_in + (size_t)l * DM * INW, INW, (u16*)((char*)wl + OW_IN), 1024, nt * 64, kt * 64, MapId{3312, 0}, sm);
      } else if (rem < 832 + 1024) {
        rem -= 832;
        int nt = rem >> 4, kt = rem & 15;
        conv_tile(p.w_in + (size_t)l * DM * INW, INW, (u16*)((char*)wl + OW_G), 1024, nt * 64, kt * 64, MapId{4096, 3312}, sm);
      } else if (rem < 1856 + 256) {
        rem -= 1856;
        int br = rem >> 6, r2 = rem & 63, nt = r2 >> 2, kt = r2 & 3;
        conv_tile(p.w_branch + ((size_t)(l * 4 + br)) * 256 * DM, DM, (u16*)((char*)wl + OW_B) + (size_t)br * 1024 * 256, 256,
                  nt * 64, kt * 64, MapId{1024, 0}, sm);
      } else if (rem < 2112 + 256) {
        rem -= 2112;
        int nt = rem >> 4, kt = rem & 15;
        conv_tile(p.w_out + (size_t)l * DM * DM, DM, (u16*)((char*)wl + OW_O), 1024, nt * 64, kt * 64, MapId{1024, 0}, sm);
      } else if (rem < 2368 + 1408) {
        rem -= 2368;
        int nt = rem >> 4, kt = rem & 15;
        conv_tile(p.ffn_w1 + (size_t)l * DM * 5632, 5632, (u16*)((char*)wl + OW_1), 1024, nt * 64, kt * 64, MapW1{}, sm);
      } else {
        rem -= 3776;
        int nt = rem / 44, kt = rem - nt * 44;
        conv_tile(p.ffn_w2 + (size_t)l * FH * DM, DM, (u16*)((char*)wl + OW_2), FH, nt * 64, kt * 64, MapId{1024, 0}, sm);
      }
}

__device__ __forceinline__ void phase_init0(const Params& p, float* sm) {
  const int tid = TIDX;
  if (blockIdx.x == 0) {
    if (tid < 64) ((unsigned*)(p.ws + OFF_CTR))[tid] = 0u;
    for (int i = tid; i < 3456; i += NTHR) ((unsigned*)(p.ws + OFF_XBAR))[i] = 0u;
  }
  constexpr int NMOD = 192, NCONV = 832;
  for (int it = blockIdx.x; it < NMOD + NCONV; it += gridDim.x) {
    if (it < NMOD) {
      int l = it / 96, rem = it - l * 96, cc = rem >> 3, ks = rem & 7;
      for (int i = tid; i < 9 * 128; i += NTHR) {
        int r = i >> 7, k = i & 127;
        float v = r < 8 ? p.c[r * DM + ks * 128 + k] : p.c_ctx[ks * 128 + k];
        sm[i] = siluf(v);
      }
      __syncthreads();
      const int n = cc * 512 + tid;
      const float* w = p.ada_w + ((size_t)l * DM + ks * 128) * 6144 + n;
      float acc[9];
#pragma unroll
      for (int r = 0; r < 9; r++) acc[r] = 0.f;
#pragma unroll 1
      for (int k0 = 0; k0 < 128; k0 += 16) {
        float wv[16];
#pragma unroll
        for (int kk = 0; kk < 16; kk++) wv[kk] = w[(size_t)(k0 + kk) * 6144];
#pragma unroll
        for (int kk = 0; kk < 16; kk++)
#pragma unroll
          for (int r = 0; r < 9; r++) acc[r] += sm[r * 128 + k0 + kk] * wv[kk];
      }
      float* mp = (float*)(p.ws + OFF_MODP) + ((size_t)(l * 8 + ks) * 9) * 6144 + n;
#pragma unroll
      for (int r = 0; r < 9; r++) mp[(size_t)r * 6144] = acc[r];
      __syncthreads();
    } else {
      conv_item(p, 0, it - NMOD, sm);
    }
  }
}

__device__ __forceinline__ void phase_init1(const Params& p) {
  const float* mp = (const float*)(p.ws + OFF_MODP);
  float* mo = (float*)(p.ws + OFF_MOD);
  for (int i = blockIdx.x * NTHR + TIDX; i < 2 * 9 * 6144; i += gridDim.x * NTHR) {
    int l = i / (9 * 6144), rem = i - l * 9 * 6144, r = rem / 6144, n = rem - r * 6144;
    float s = p.ada_b[l * 6144 + n];
#pragma unroll
    for (int ks = 0; ks < 8; ks++) s += mp[((size_t)((l * 8 + ks) * 9 + r)) * 6144 + n];
    mo[i] = s;
  }
}

__device__ __forceinline__ void rowpass(const Params& p, int l, int mode) {
  const int lane = TIDX & 63, wv = __builtin_amdgcn_readfirstlane(TIDX >> 6);
  const float* MOD = (const float*)(p.ws + OFF_MOD);
  u16* H = (u16*)(p.ws + OFF_H);
  const bool do_norm = !(mode == 2 && l == 1);
  const int ln = (mode == 2) ? (l == 1 ? l : l + 1) : l;
  const int ni = (mode == 1) ? 2 : 0, sho = (mode == 1) ? 3072 : 0, sco = (mode == 1) ? 4096 : 1024;
  for (int r = blockIdx.x * 8 + wv; r < NROWS; r += gridDim.x * 8) {
    const int mr = mod_row(r);
    if (l == 1 && mode != 0 && mr == 8) continue;
    const float* modl = MOD + ((size_t)(l * 9 + mr)) * 6144;
    const float* modn = MOD + ((size_t)(ln * 9 + mr)) * 6144;
    const float* ng2 = p.norm_g + (size_t)(ln * 4 + ni) * DM;
    const float* xs = (mode == 0 || (mode == 1 && l == 0)) ? xin_row(p, r) : (const float*)x_row(p, r);
    float4 xo[4], n2[4], sc4[4], sh4[4];
#pragma unroll
    for (int i = 0; i < 4; i++) {
      const int col = i * 256 + lane * 4;
      xo[i] = *(const float4*)(xs + col);
      n2[i] = *(const float4*)(ng2 + col);
      sc4[i] = *(const float4*)(modn + sco + col);
      sh4[i] = *(const float4*)(modn + sho + col);
    }
    float xv[16];
    if (mode == 0) {
#pragma unroll
      for (int i = 0; i < 4; i++) { xv[i * 4 + 0] = xo[i].x; xv[i * 4 + 1] = xo[i].y; xv[i * 4 + 2] = xo[i].z; xv[i * 4 + 3] = xo[i].w; }
    } else {
      const u16* src = (const u16*)(p.ws + (mode == 1 ? OFF_BIG : OFF_YS)) + (size_t)r * DM;
      const float* ng = p.norm_g + (size_t)(l * 4 + (mode == 1 ? 1 : 3)) * DM;
      const float* gt = modl + (mode == 1 ? 2048 : 5120);
      uint2 sv[4];
      float4 g4[4], n4[4];
#pragma unroll
      for (int i = 0; i < 4; i++) {
        const int col = i * 256 + lane * 4;
        sv[i] = *(const uint2*)(src + col);
        g4[i] = *(const float4*)(gt + col);
        n4[i] = *(const float4*)(ng + col);
      }
      float ov[16];
      float ss = 0.f;
#pragma unroll
      for (int i = 0; i < 4; i++) {
        ov[i * 4 + 0] = __uint_as_float(sv[i].x << 16); ov[i * 4 + 1] = __uint_as_float(sv[i].x & 0xffff0000u);
        ov[i * 4 + 2] = __uint_as_float(sv[i].y << 16); ov[i * 4 + 3] = __uint_as_float(sv[i].y & 0xffff0000u);
      }
#pragma unroll
      for (int i = 0; i < 16; i++) ss += ov[i] * ov[i];
      ss = wsum(ss);
      const float inv = rsq(ss * (1.f / 1024.f) + 1e-6f);
      float* xd = x_row(p, r);
#pragma unroll
      for (int i = 0; i < 4; i++) {
        xv[i * 4 + 0] = xo[i].x + g4[i].x * (ov[i * 4 + 0] * inv * n4[i].x);
        xv[i * 4 + 1] = xo[i].y + g4[i].y * (ov[i * 4 + 1] * inv * n4[i].y);
        xv[i * 4 + 2] = xo[i].z + g4[i].z * (ov[i * 4 + 2] * inv * n4[i].z);
        xv[i * 4 + 3] = xo[i].w + g4[i].w * (ov[i * 4 + 3] * inv * n4[i].w);
      }
#pragma unroll
      for (int i = 0; i < 4; i++)
        *(float4*)(xd + i * 256 + lane * 4) = make_float4(xv[i * 4 + 0], xv[i * 4 + 1], xv[i * 4 + 2], xv[i * 4 + 3]);
    }
    if (!do_norm) continue;
    float ss2 = 0.f;
#pragma unroll
    for (int i = 0; i < 16; i++) ss2 += xv[i] * xv[i];
    ss2 = wsum(ss2);
    const float inv2 = rsq(ss2 * (1.f / 1024.f) + 1e-6f);
#pragma unroll
    for (int i = 0; i < 4; i++) {
      const int col = i * 256 + lane * 4;
      float h0 = xv[i * 4 + 0] * inv2 * n2[i].x * (1.f + sc4[i].x) + sh4[i].x;
      float h1 = xv[i * 4 + 1] * inv2 * n2[i].y * (1.f + sc4[i].y) + sh4[i].y;
      float h2 = xv[i * 4 + 2] * inv2 * n2[i].z * (1.f + sc4[i].z) + sh4[i].z;
      float h3 = xv[i * 4 + 3] * inv2 * n2[i].w * (1.f + sc4[i].w) + sh4[i].w;
      uint2 o;
      o.x = pack2(h0, h1);
      o.y = pack2(h2, h3);
      *(uint2*)(H + (size_t)r * DM + col) = o;
    }
  }
}

#define LDT 72
namespace pg8 {
#define PG8_LAS __attribute__((address_space(3)))
typedef unsigned short bf16_t;
typedef short bf16x8 __attribute__((ext_vector_type(8)));
typedef float f32x4 __attribute__((ext_vector_type(4)));
typedef unsigned u32x4 __attribute__((ext_vector_type(4)));
constexpr int BM = 256, BK = 64, HALF = 128, HTB = HALF * BK * 2  , STAGE_BYTES = 8 * HTB, NXCD = 8, WGM = 8;

__host__ __device__ __forceinline__ int lds_byte(int r, int c) { const int st = (r >> 4) * 2 + (c >> 5), rr = r & 15, cc = c & 31, ob = rr * 64 + cc * 2; return st * 1024 + (ob ^ (((ob >> 9) & 1) << 5)); }
__host__ __device__ __forceinline__ void stage_rc(int b, int& R, int& C) { const int st = b / 1024, sb = b % 1024, swz = sb ^ (((sb >> 9) & 1) << 5); R = (st >> 1) * 16 + swz / 64; C = (st & 1) * 32 + (swz % 64) / 2; }
__host__ __device__ __forceinline__ int perm32(int rho) { const int n = rho >> 4, i = rho & 15; return 8 * (i >> 2) + 4 * n + (i & 3); }

struct Unit { int pm, pn; };
struct Gemm { const bf16_t* A; const bf16_t* Bt; int M, N, K, lda; };
struct StaticOrder {
    int nM, nN, nwg, G, c, skip;
    __host__ __device__ void init(int M, int N, int G_, int c_, int skip_ = 0) { nM = M / BM; nN = N / BM; nwg = nM * nN; G = G_; c = c_; skip = skip_; }
    __host__ __device__ bool next(int i, Unit& u) const {
        const long L = (long)i * G + c; if (L >= nwg) return false;
        int wgid = (int)L; { const int q = nwg / NXCD, r = nwg % NXCD, xcd = wgid % NXCD, off = wgid / NXCD; wgid = (xcd < r ? xcd * (q + 1) : r * (q + 1) + (xcd - r) * q) + off; }
        const int nig = WGM * nN, gid = wgid / nig, fm = gid * WGM, gsz = (nM - fm) < WGM ? (nM - fm) : WGM;
        u.pm = fm + ((wgid % nig) % gsz); u.pn = (wgid % nig) / gsz;
        if (skip) u.pm = (u.pm >> 4) * 17 + 1 + (u.pm & 15);
        return true;
    }
    __device__ __forceinline__ void a_ready(const Unit&) const {}
    __device__ __forceinline__ void done(const Unit&) const {}
};
__device__ __forceinline__ unsigned cvt_pk_bf16(float lo, float hi) { unsigned r; asm volatile("v_cvt_pk_bf16_f32 %0, %1, %2" : "=v"(r) : "v"(lo), "v"(hi)); return r; }
template <class Epi, class Sched, bool STAMP = false>
__device__ __forceinline__ void gemm_phase(PG8_LAS unsigned char* lds, const Gemm g, const Sched& S, const Epi& E, unsigned long long* stamps) {
    const int tid = TIDX, wid = __builtin_amdgcn_readfirstlane(tid >> 6), lane = tid & 63, wr = wid >> 2, wc = wid & 3, fr = lane & 15, fq = lane >> 4;
    const int K = g.K, nt = K / BK;
    int ts_lo = 0, ts_hi = 0, nts = 0; const unsigned long long rt_entry = STAMP ? (unsigned long long)wall_clock64() : 0ull;
#define PG8_STAMP() do { if (STAMP && wid == 0 && nts < 64) { const unsigned long long _c = (unsigned long long)clock64(); \
        ts_lo = (lane == nts) ? (int)(unsigned)_c : ts_lo; ts_hi = (lane == nts) ? (int)(unsigned)(_c >> 32) : ts_hi; ++nts; } } while (0)
    PG8_STAMP();
    unsigned voffA[2], voffB[2];
#pragma unroll
    for (int i = 0; i < 2; ++i) { int R, C; stage_rc(tid * 16 + i * 8192, R, C); const int Rb = Epi::PERM ? ((R & ~31) + perm32(R & 31)) : R;
        voffA[i] = (unsigned)(R * g.lda + C) * 2u; voffB[i] = (unsigned)(Rb * K + C) * 2u; }
    const size_t kstep = (size_t)(BK * 2);
    const size_t hstepB = (size_t)HALF * K * 2, hstepA = (size_t)HALF * g.lda * 2;
    const size_t tstepB = 2 * hstepB, tstepA = 2 * hstepA;
    const unsigned ldsw = (unsigned)wid * 1024u;
    const int aoff = lds_byte(wr * 64 + fr, fq * 8), boff = lds_byte(wc * 32 + fr, fq * 8);
#define PG8_SA(b, h) (((b) * 2 + (h)) * HTB)
#define PG8_SB(b, h) ((4 + (b) * 2 + (h)) * HTB)
#define PG8_STAGE(bufoff, gbase, voff) do { _Pragma("unroll") for (int _i = 0; _i < 2; ++_i) \
        __builtin_amdgcn_global_load_lds((const unsigned*)((const char*)(gbase) + (voff)[_i]), (PG8_LAS unsigned*)(lds + (bufoff) + ldsw + _i * 8192), 16, 0, 0); } while (0)
#define PG8_LDA(dst, b, h) do { _Pragma("unroll") for (int m = 0; m < 4; ++m) _Pragma("unroll") for (int k = 0; k < 2; ++k) dst[m][k] = *(const PG8_LAS bf16x8*)(lds + PG8_SA(b, h) + aoff + m * 2048 + k * 1024); } while (0)
#define PG8_LDB(dst, b, h) do { _Pragma("unroll") for (int n = 0; n < 2; ++n) _Pragma("unroll") for (int k = 0; k < 2; ++k) dst[n][k] = *(const PG8_LAS bf16x8*)(lds + PG8_SB(b, h) + boff + n * 2048 + k * 1024); } while (0)
#define PG8_MMA(ai, bj, At, Bt) do { __builtin_amdgcn_s_setprio(1); _Pragma("unroll") for (int m = 0; m < 4; ++m) _Pragma("unroll") for (int n = 0; n < 2; ++n) _Pragma("unroll") for (int k = 0; k < 2; ++k) \
        acc[ai][bj][m][n] = __builtin_amdgcn_mfma_f32_16x16x32_bf16(Bt[n][k], At[m][k], acc[ai][bj][m][n], 0, 0, 0); __builtin_amdgcn_s_setprio(0); } while (0)
#define PG8_WAIT_V(n) asm volatile("s_waitcnt vmcnt(" #n ")" ::: "memory")
#define PG8_WAIT_L(n) asm volatile("s_waitcnt lgkmcnt(" #n ")" ::: "memory")
#define PG8_BAR __builtin_amdgcn_s_barrier()
#define PG8_SCHED __builtin_amdgcn_sched_barrier(0)
    Unit cur, nxt; int ui = 0;
    if (!S.next(0, cur)) return;
    f32x4 acc[2][2][4][2];
#pragma unroll
    for (int a = 0; a < 2; ++a)
#pragma unroll
        for (int b = 0; b < 2; ++b)
#pragma unroll
            for (int m = 0; m < 4; ++m)
#pragma unroll
                for (int n = 0; n < 2; ++n) acc[a][b][m][n] = (f32x4){0.f, 0.f, 0.f, 0.f};
    bf16x8 At[4][2], B0[2][2], B1[2][2];
    const char* cA = (const char*)g.A + (size_t)cur.pm * tstepA; const char* cB = (const char*)g.Bt + (size_t)cur.pn * tstepB;
    S.a_ready(cur);
    PG8_STAGE(PG8_SB(0, 0), cB, voffB); PG8_STAGE(PG8_SA(0, 0), cA, voffA); PG8_STAGE(PG8_SB(0, 1), cB + hstepB, voffB); PG8_STAGE(PG8_SA(0, 1), cA + hstepA, voffA);
    if (wr == 1) PG8_BAR;
    PG8_WAIT_V(4); PG8_BAR;
    PG8_STAGE(PG8_SB(1, 0), cB + kstep, voffB); PG8_STAGE(PG8_SA(1, 0), cA + kstep, voffA); PG8_STAGE(PG8_SB(1, 1), cB + hstepB + kstep, voffB);
    PG8_WAIT_V(6); PG8_BAR;
    PG8_STAMP();
    for (;;) {
        const bool has_next = S.next(ui + 1, nxt);
        const char* nA = has_next ? (const char*)g.A + (size_t)nxt.pm * tstepA : cA; const char* nB = has_next ? (const char*)g.Bt + (size_t)nxt.pn * tstepB : cB;
        for (int t = 0; t < nt; t += 2) {
            const bool last = (t == nt - 2);
            const char* a1 = cA + (size_t)(t + 1) * kstep;
            const char* a2 = last ? nA : cA + (size_t)(t + 2) * kstep; const char* b2 = last ? nB : cB + (size_t)(t + 2) * kstep;
            const char* a3 = a2 + kstep; const char* b3 = b2 + kstep;
            if (last && has_next) S.a_ready(nxt);
            PG8_LDB(B0, 0, 0); PG8_SCHED; PG8_LDA(At, 0, 0); PG8_STAGE(PG8_SA(1, 1), a1 + hstepA, voffA);
            PG8_WAIT_L(8); PG8_BAR; PG8_WAIT_L(0); PG8_MMA(0, 0, At, B0); PG8_BAR; PG8_SCHED;
            PG8_LDB(B1, 0, 1); PG8_STAGE(PG8_SB(0, 0), b2, voffB);
            PG8_BAR; PG8_WAIT_L(0); PG8_MMA(0, 1, At, B1); PG8_BAR;
            PG8_LDA(At, 0, 1); PG8_STAGE(PG8_SA(0, 0), a2, voffA);
            PG8_BAR; PG8_WAIT_L(0); PG8_MMA(1, 0, At, B0); PG8_BAR; PG8_SCHED;
            PG8_STAGE(PG8_SB(0, 1), b2 + hstepB, voffB);
            PG8_WAIT_V(6); PG8_BAR; PG8_MMA(1, 1, At, B1); PG8_BAR;
            PG8_LDB(B0, 1, 0); PG8_SCHED; PG8_LDA(At, 1, 0); PG8_STAGE(PG8_SA(0, 1), a2 + hstepA, voffA);
            PG8_WAIT_L(8); PG8_BAR; PG8_WAIT_L(0); PG8_MMA(0, 0, At, B0); PG8_BAR; PG8_SCHED;
            PG8_LDB(B1, 1, 1); PG8_STAGE(PG8_SB(1, 0), b3, voffB);
            PG8_BAR; PG8_WAIT_L(0); PG8_MMA(0, 1, At, B1); PG8_BAR;
            PG8_LDA(At, 1, 1); PG8_STAGE(PG8_SA(1, 0), a3, voffA);
            PG8_BAR; PG8_WAIT_L(0); PG8_MMA(1, 0, At, B0); PG8_BAR; PG8_SCHED;
            PG8_STAGE(PG8_SB(1, 1), b3 + hstepB, voffB);
            PG8_WAIT_V(6); PG8_BAR; PG8_MMA(1, 1, At, B1); PG8_BAR;
        }
        PG8_STAMP();
        if constexpr (!Epi::AFTER_DRAIN) { E(acc, cur, wr, wc, fr, fq); S.done(cur); }
        PG8_STAMP();
        if (!has_next) break;
#pragma unroll
        for (int a = 0; a < 2; ++a)
#pragma unroll
            for (int b = 0; b < 2; ++b)
#pragma unroll
                for (int m = 0; m < 4; ++m)
#pragma unroll
                    for (int n = 0; n < 2; ++n) acc[a][b][m][n] = (f32x4){0.f, 0.f, 0.f, 0.f};
        cur = nxt; cA = nA; cB = nB; ++ui;
    }
    PG8_WAIT_V(0);
    if (wr == 0) PG8_BAR;
    PG8_BAR;
    if constexpr (Epi::AFTER_DRAIN) { E.fused(acc, cur, wr, wc, fr, fq, lds, wid, lane); S.done(cur); }
    PG8_STAMP();
    if (STAMP && wid == 0) { stamps[lane] = lane < nts ? (((unsigned long long)(unsigned)ts_hi << 32) | (unsigned)ts_lo) : 0ull;
        if (lane == 62) stamps[62] = rt_entry; if (lane == 63) stamps[63] = (unsigned long long)wall_clock64(); }
#undef PG8_STAMP
#undef PG8_SA
#undef PG8_SB
#undef PG8_STAGE
#undef PG8_LDA
#undef PG8_LDB
#undef PG8_MMA
#undef PG8_WAIT_V
#undef PG8_WAIT_L
#undef PG8_BAR
#undef PG8_SCHED
}
}

struct EpiBf {
  static constexpr bool PERM = true, AFTER_DRAIN = false;
  u16* O; int ldc; const float* bias; int act;
  __device__ __forceinline__ void operator()(const f32x4 (&acc)[2][2][4][2], const pg8::Unit& u, int wr, int wc, int fr, int fq) const {
    const int row0 = u.pm * 256 + wr * 64 + fr, col0 = u.pn * 256 + wc * 32 + 8 * fq;
    f32x4 bv[2][2];
#pragma unroll
    for (int bj = 0; bj < 2; ++bj)
#pragma unroll
      for (int n = 0; n < 2; ++n) bv[bj][n] = bias ? *(const f32x4*)(bias + col0 + bj * 128 + 4 * n) : f32x4{0.f, 0.f, 0.f, 0.f};
#pragma unroll
    for (int ai = 0; ai < 2; ++ai)
#pragma unroll
      for (int m = 0; m < 4; ++m) {
        u16* rowp = O + (size_t)(row0 + ai * 128 + m * 16) * ldc + col0;
#pragma unroll
        for (int bj = 0; bj < 2; ++bj) {
          f32x4 v0 = acc[ai][bj][m][0] + bv[bj][0], v1 = acc[ai][bj][m][1] + bv[bj][1];
          if (act == 1) {
#pragma unroll
            for (int j = 0; j < 4; ++j) { v0[j] = sigm(v0[j]); v1[j] = sigm(v1[j]); }
          }
          uint4 wv;
          wv.x = pack2(v0[0], v0[1]); wv.y = pack2(v0[2], v0[3]); wv.z = pack2(v1[0], v1[1]); wv.w = pack2(v1[2], v1[3]);
          *(uint4*)(rowp + bj * 128) = wv;
        }
      }
  }
};
struct EpiSwiglu {
  static constexpr bool PERM = true, AFTER_DRAIN = false;
  u16* O;
  __device__ __forceinline__ void operator()(const f32x4 (&acc)[2][2][4][2], const pg8::Unit& u, int wr, int wc, int fr, int fq) const {
    const int row0 = u.pm * 256 + wr * 64 + fr, col0 = u.pn * 128 + wc * 16 + 4 * fq;
#pragma unroll
    for (int ai = 0; ai < 2; ++ai)
#pragma unroll
      for (int m = 0; m < 4; ++m) {
        u16* rowp = O + (size_t)(row0 + ai * 128 + m * 16) * FH + col0;
#pragma unroll
        for (int bj = 0; bj < 2; ++bj) {
          const f32x4 g = acc[ai][bj][m][0], up = acc[ai][bj][m][1];
          uint2 wv;
          wv.x = pack2(siluf(g[0]) * up[0], siluf(g[1]) * up[1]);
          wv.y = pack2(siluf(g[2]) * up[2], siluf(g[3]) * up[3]);
          *(uint2*)(rowp + bj * 64) = wv;
        }
      }
  }
};
struct EpiGateAcc {
  static constexpr bool PERM = true, AFTER_DRAIN = false;
  u16* ACC; const u16* G; int gcol; unsigned amask;
  __device__ __forceinline__ void operator()(const f32x4 (&acc)[2][2][4][2], const pg8::Unit& u, int wr, int wc, int fr, int fq) const {
    unsigned pk[2][2][4][4];
#pragma unroll
    for (int ai = 0; ai < 2; ++ai)
#pragma unroll
      for (int bj = 0; bj < 2; ++bj)
#pragma unroll
        for (int m = 0; m < 4; ++m) {
          pk[ai][bj][m][0] = pack2(acc[ai][bj][m][0][0], acc[ai][bj][m][0][1]);
          pk[ai][bj][m][1] = pack2(acc[ai][bj][m][0][2], acc[ai][bj][m][0][3]);
          pk[ai][bj][m][2] = pack2(acc[ai][bj][m][1][0], acc[ai][bj][m][1][1]);
          pk[ai][bj][m][3] = pack2(acc[ai][bj][m][1][2], acc[ai][bj][m][1][3]);
        }
    asm volatile("" ::: "memory");
    const int row0 = u.pm * 256 + wr * 64 + fr, col0 = u.pn * 256 + wc * 32 + 8 * fq;
#pragma unroll
    for (int ai = 0; ai < 2; ++ai)
#pragma unroll
      for (int m = 0; m < 4; ++m) {
        const size_t row = (size_t)(row0 + ai * 128 + m * 16);
#pragma unroll
        for (int bj = 0; bj < 2; ++bj) {
          const int col = col0 + bj * 128;
          const uint4 gv = *(const uint4*)(G + row * 2048 + gcol + col);
          const uint4 av = *(const uint4*)(ACC + row * DM + col);
          const unsigned gw[4] = {gv.x, gv.y, gv.z, gv.w};
          const unsigned aw[4] = {av.x & amask, av.y & amask, av.z & amask, av.w & amask};
          unsigned ow[4];
#pragma unroll
          for (int q = 0; q < 4; ++q) {
            const unsigned pv = pk[ai][bj][m][q];
            const float lo = __uint_as_float(aw[q] << 16) + __uint_as_float(gw[q] << 16) * __uint_as_float(pv << 16);
            const float hi = __uint_as_float(aw[q] & 0xffff0000u) + __uint_as_float(gw[q] & 0xffff0000u) * __uint_as_float(pv & 0xffff0000u);
            ow[q] = pack2(lo, hi);
          }
          *(uint4*)(ACC + row * DM + col) = make_uint4(ow[0], ow[1], ow[2], ow[3]);
        }
        asm volatile("" ::: "memory");
      }
  }
};

template <int MI>
__device__ __forceinline__ void gemm_loop(const u16* __restrict__ A, int lda, const u16* __restrict__ Bt, int ldb, int K,
                                          f32x4 (&acc)[MI][4], u16* sA, u16* sB) {
  constexpr int BMT = MI * 64;
  const int tid = TIDX, lane = tid & 63, w = tid >> 6, wm = w >> 1, wn = w & 1, fr = lane & 15, fq = lane >> 4;
  uint4 ra[MI], rb[2];
  const u16* ga = A + (size_t)(tid >> 3) * lda + (tid & 7) * 8;
  const u16* gb = Bt + (size_t)(tid >> 3) * ldb + (tid & 7) * 8;
  const int so = (tid >> 3) * LDT + (tid & 7) * 8;
#pragma unroll
  for (int i = 0; i < MI; i++) ra[i] = *(const uint4*)(ga + (size_t)(i * 64) * lda);
#pragma unroll
  for (int i = 0; i < 2; i++) rb[i] = *(const uint4*)(gb + (size_t)(i * 64) * ldb);
#pragma unroll
  for (int i = 0; i < MI; i++) *(uint4*)(sA + so + i * 64 * LDT) = ra[i];
#pragma unroll
  for (int i = 0; i < 2; i++) *(uint4*)(sB + so + i * 64 * LDT) = rb[i];
  __syncthreads();
  const int nk = K >> 6;
  for (int kt = 0; kt < nk; kt++) {
    const bool more = kt + 1 < nk;
    if (more) {
#pragma unroll
      for (int i = 0; i < MI; i++) ra[i] = *(const uint4*)(ga + (size_t)(i * 64) * lda + (kt + 1) * 64);
#pragma unroll
      for (int i = 0; i < 2; i++) rb[i] = *(const uint4*)(gb + (size_t)(i * 64) * ldb + (kt + 1) * 64);
    }
    const u16* a = sA + (kt & 1) * BMT * LDT + (wm * (MI * 16) + fr) * LDT + fq * 8;
    const u16* b = sB + (kt & 1) * 128 * LDT + (wn * 64 + fr) * LDT + fq * 8;
#pragma unroll
    for (int ks = 0; ks < 2; ks++) {
      bf16x8 af[MI], bfr[4];
#pragma unroll
      for (int i = 0; i < MI; i++) af[i] = *(const bf16x8*)(a + i * 16 * LDT + ks * 32);
#pragma unroll
      for (int j = 0; j < 4; j++) bfr[j] = *(const bf16x8*)(b + j * 16 * LDT + ks * 32);
#pragma unroll
      for (int i = 0; i < MI; i++)
#pragma unroll
        for (int j = 0; j < 4; j++) acc[i][j] = __builtin_amdgcn_mfma_f32_16x16x32_bf16(bfr[j], af[i], acc[i][j], 0, 0, 0);
    }
    if (more) {
      u16* da = sA + ((kt + 1) & 1) * BMT * LDT + so;
      u16* db = sB + ((kt + 1) & 1) * 128 * LDT + so;
#pragma unroll
      for (int i = 0; i < MI; i++) *(uint4*)(da + i * 64 * LDT) = ra[i];
#pragma unroll
      for (int i = 0; i < 2; i++) *(uint4*)(db + i * 64 * LDT) = rb[i];
    }
    __syncthreads();
  }
}

template <int MI>
__device__ __forceinline__ void zero_acc(f32x4 (&acc)[MI][4]) {
#pragma unroll
  for (int i = 0; i < MI; i++)
#pragma unroll
    for (int j = 0; j < 4; j++) acc[i][j] = f32x4{0.f, 0.f, 0.f, 0.f};
}


typedef unsigned u32x4v __attribute__((ext_vector_type(4)));
__device__ __forceinline__ void yp_issue(const u16* __restrict__ A, const u16* __restrict__ B, u32x4v (&ra)[8], u32x4v (&rb)[8], int tid) {
#pragma unroll
  for (int i = 0; i < 8; i++) {
    const int c = tid + i * NTHR, row = c >> 5, ch = c & 31;
    ra[i] = *(const u32x4v*)(A + (size_t)row * YST + ch * 8);
    rb[i] = *(const u32x4v*)(B + (size_t)row * 256 + ch * 8);
  }
}
__device__ __forceinline__ void yp_stage(unsigned char* sA, unsigned char* sB, const u32x4v (&ra)[8], const u32x4v (&rb)[8], int tid) {
#pragma unroll
  for (int i = 0; i < 8; i++) {
    const int c = tid + i * NTHR, row = c >> 5, ch = c & 31;
    const int off = row * 512 + ((ch ^ (row & 7)) << 4);
    *(u32x4v*)(sA + off) = ra[i];
    *(u32x4v*)(sB + off) = rb[i];
  }
}
__device__ __forceinline__ void phase_ypart(const Params& p, int l, unsigned char* smem) {
  unsigned char* sA = smem;
  unsigned char* sB = smem + 65536;
  const int tid = TIDX, lane = tid & 63, w = tid >> 6, wm = w >> 1, wn = w & 1, fr = lane & 15, fq = lane >> 4;
  const u16* Y = (const u16*)(p.ws + OFF_YS);
  const u16* Wb = (const u16*)(p.ws + OFF_W + OW_B);
  const u16* G = (const u16*)(p.ws + OFF_BIG);
  u16* ACC = (u16*)(p.ws + OFF_H);
  constexpr int NT = 8;
  const int ntiles = (NROWS / 128) * NT;
  const int G_ = gridDim.x;
  const bool xmap = (G_ == 256);
  const int xj = blockIdx.x >> 3, xx = blockIdx.x & 7;
  const bool skipc = (l == 1);
  const int nrt = skipc ? 256 : 272;
  const int ntl = nrt * NT;
  const int nmine = xmap ? (xj < nrt ? (nrt - 1 - xj) / 32 + 1 : 0)
                         : (((int)blockIdx.x < ntl) ? (ntl - 1 - (int)blockIdx.x) / G_ + 1 : 0);
  if (nmine == 0) return;
#define YP_TILE(Q_, MT_, NT_)                                                        \
  do {                                                                               \
    if (xmap) { const int s_ = (Q_) * 32 + xj; MT_ = (s_ >> 3) * 8 + xx; NT_ = s_ & 7; } \
    else { const int t_ = blockIdx.x + (Q_) * G_; MT_ = t_ / NT; NT_ = t_ - MT_ * NT; }  \
    if (skipc) MT_ = (MT_ >> 5) * 34 + 2 + (MT_ & 31);                                   \
  } while (0)
  u32x4v ra[8], rb[8];
  {
    int mt, nt;
    YP_TILE(0, mt, nt);
    yp_issue(Y + (size_t)mt * 128 * YST, Wb + ((size_t)nt * 128) * 256, ra, rb, tid);
  }
  f32x4 tot[2][4];
  zero_acc<2>(tot);
  for (int qi = 0; qi < 4 * nmine; qi++) {
    const int q = qi >> 2, k = qi & 3;
    int mt, nt;
    YP_TILE(q, mt, nt);
    const int r0 = mt * 128 + wm * 32 + fr, c0 = nt * 128 + wn * 64 + fq * 4;
    uint2 gv[2][4];
#pragma unroll
    for (int i = 0; i < 2; i++)
#pragma unroll
      for (int j = 0; j < 4; j++) gv[i][j] = *(const uint2*)(G + (size_t)(r0 + i * 16) * 4096 + k * 1024 + c0 + j * 16);
    __syncthreads();
    yp_stage(sA, sB, ra, rb, tid);
    __syncthreads();
    {
      const int qn = qi + 1 < 4 * nmine ? qi + 1 : qi;
      int mtn, ntn;
      YP_TILE(qn >> 2, mtn, ntn);
      const int brn = qn & 3, ycn = brn < 3 ? brn * 256 : 1536;
      yp_issue(Y + (size_t)mtn * 128 * YST + ycn, Wb + ((size_t)brn * 1024 + ntn * 128) * 256, ra, rb, tid);
    }
    f32x4 ay[2][4];
    zero_acc<2>(ay);
#pragma unroll 2
    for (int ks = 0; ks < 8; ks++) {
      bf16x8 af[2], bfr[4];
#pragma unroll
      for (int i = 0; i < 2; i++) {
        const int row = wm * 32 + i * 16 + fr;
        af[i] = *(const bf16x8*)(sA + row * 512 + (((ks * 4 + fq) ^ (row & 7)) << 4));
      }
#pragma unroll
      for (int j = 0; j < 4; j++) {
        const int row = wn * 64 + j * 16 + fr;
        bfr[j] = *(const bf16x8*)(sB + row * 512 + (((ks * 4 + fq) ^ (row & 7)) << 4));
      }
#pragma unroll
      for (int i = 0; i < 2; i++)
#pragma unroll
        for (int j = 0; j < 4; j++) ay[i][j] = __builtin_amdgcn_mfma_f32_16x16x32_bf16(bfr[j], af[i], ay[i][j], 0, 0, 0);
    }
#pragma unroll
    for (int i = 0; i < 2; i++)
#pragma unroll
      for (int j = 0; j < 4; j++) {
        tot[i][j][0] += __uint_as_float(gv[i][j].x << 16) * ay[i][j][0];
        tot[i][j][1] += __uint_as_float(gv[i][j].x & 0xffff0000u) * ay[i][j][1];
        tot[i][j][2] += __uint_as_float(gv[i][j].y << 16) * ay[i][j][2];
        tot[i][j][3] += __uint_as_float(gv[i][j].y & 0xffff0000u) * ay[i][j][3];
      }
    if (k == 3) {
#pragma unroll
      for (int i = 0; i < 2; i++)
#pragma unroll
        for (int j = 0; j < 4; j++) {
          uint2 ov;
          ov.x = pack2(tot[i][j][0], tot[i][j][1]); ov.y = pack2(tot[i][j][2], tot[i][j][3]);
          *(uint2*)(ACC + (size_t)(r0 + i * 16) * DM + c0 + j * 16) = ov;
        }
      zero_acc<2>(tot);
    }
  }
  __syncthreads();
#undef YP_TILE
}

#define S2_BUF 10816
#define S2_D 0
#define S2_U 2048
#define S2_P 4096
#define S2_K 6144
#define S2_DQ 8192
#define S2_V 10240
#define S2_C1 10752
#define S2_C2 10784
#define S2_ST (2 * S2_BUF)
#define S2_YB (S2_ST + 8192)

__device__ __forceinline__ float red16(float x) {
  x += dppf<0xB1>(x);
  x += dppf<0x4E>(x);
  x += dppf<0x141>(x);
  x += dppf<0x140>(x);
  return x;
}
__device__ __forceinline__ void wave_lds_sync() {
  asm volatile("s_waitcnt lgkmcnt(0)" ::: "memory");
  __builtin_amdgcn_wave_barrier();
}

template <int MIX>
__device__ __forceinline__ void scan2_item(const Params& p, int l, int b, int h, int dir, int rq, float* sm) {
  constexpr int EPL = (MIX == 2) ? 2 : 4;
  constexpr int VOFF = (MIX == 2) ? 64 : 128;
  const int tid = TIDX, lane = tid & 63, w = tid >> 6, fr = lane & 15, fq = lane >> 4;
  const bool producer = w >= 4;
  const int pw = w & 3;
  const u16* P = (const u16*)(p.ws + OFF_BIG);
  u16* YS = (u16*)(p.ws + OFF_YS);
  float* BC = (float*)(p.ws + OFF_BC);
  float* ST = sm + S2_ST + pw * 2048;
  float s[EPL];
#pragma unroll
  for (int i = 0; i < EPL; i++) s[i] = 0.f;

  bf16x8 bw2[4], ba2[4];
  float cst[5][4];
  float cw[3][7];
  float muv[4];
  int colv[4];
#pragma unroll
  for (int i = 0; i < 4; i++) { bw2[i] = bf16x8{0, 0, 0, 0, 0, 0, 0, 0}; ba2[i] = bw2[i]; muv[i] = 0.f; colv[i] = 0; }
  if (producer) {
    if (MIX == 0) {
#pragma unroll
      for (int nt = 0; nt < 4; nt++) {
        const int jch = h * 64 + nt * 16 + fr;
#pragma unroll
        for (int jj = 0; jj < 8; jj++) {
          bw2[nt][jj] = (short)f2bf(p.rwkv_w2[((size_t)(l * 2 + dir) * 32 + fq * 8 + jj) * 256 + jch]);
          ba2[nt][jj] = (short)f2bf(p.rwkv_a2[((size_t)(l * 2 + dir) * 32 + fq * 8 + jj) * 256 + jch]);
        }
        cst[0][nt] = p.rwkv_w0[(l * 2 + dir) * 256 + jch];
        cst[1][nt] = p.rwkv_a0[(l * 2 + dir) * 256 + jch];
        cst[2][nt] = p.rwkv_ka[l * 256 + jch];
        cst[3][nt] = p.rwkv_kk[l * 256 + jch];
        cst[4][nt] = p.rwkv_rk[l * 256 + jch];
      }
#pragma unroll
      for (int i = 0; i < 4; i++) {
        const int c = lane + 64 * i;
        colv[i] = i < 3 ? i * 256 + h * 64 + lane : (lane < 32 ? 768 + dir * 32 + lane : 832 + dir * 32 + (lane - 32));
        muv[i] = p.rwkv_mu[l * 960 + colv[i]];
        (void)c;
      }
    } else if (MIX == 1) {
#pragma unroll
      for (int i = 0; i < 3; i++) {
        colv[i] = PB + i * 256 + h * 64 + lane;
#pragma unroll
        for (int tp = 0; tp < 7; tp++) cw[i][tp] = p.gdn_conv[((size_t)l * 7 + tp) * 768 + i * 256 + h * 64 + lane];
      }
    } else {
#pragma unroll
      for (int nt = 0; nt < 2; nt++) {
#pragma unroll
        for (int jj = 0; jj < 8; jj++)
          bw2[nt][jj] = fq < 2 ? (short)f2bf(p.gla_gw2[((size_t)(l * 2 + dir) * 16 + fq * 8 + jj) * 128 + h * 32 + nt * 16 + fr]) : (short)0;
        cst[0][nt] = p.gla_gb[(l * 2 + dir) * 128 + h * 32 + nt * 16 + fr];
      }
      colv[0] = PC + h * 32 + lane;
      if (lane >= 32) colv[0] = PC + 128 + h * 32 + (lane - 32);
      colv[1] = PC + 256 + h * 64 + lane;
      colv[2] = PC + 512 + dir * 16 + (lane & 15);
    }
  }
  __syncthreads();

  for (int c = 0; c <= TPB / 32 + 1; c++) {
    if (producer) {
      if (c >= 2) {
        const int cc = c - 2;
        int seg_row0, t_lo;
        if (cc < 8) { seg_row0 = b * TPB; t_lo = dir == 0 ? cc * 32 : (LC - 32 - cc * 32); }
        else { seg_row0 = b * TPB + LC; t_lo = dir == 0 ? (cc - 8) * 32 : (SEQ - 32 - (cc - 8) * 32); }
        const float* yb = sm + S2_YB + (cc & 1) * 512;
        const int t2 = tid - 256;
#pragma unroll
        for (int i = 0; i < 2; i++) {
          const int idx = t2 + i * 256, tt = idx >> 4, e = idx & 15;
          YS[(size_t)(seg_row0 + t_lo + tt) * YST + dir * 768 + MIX * 256 + h * 64 + rq * 16 + e] = f2bf(yb[idx]);
        }
      }
      if (c < TPB / 32) {
        int seg_row0, seg_len, t_lo;
        if (c < 8) { seg_row0 = b * TPB; seg_len = LC; t_lo = dir == 0 ? c * 32 : (LC - 32 - c * 32); }
        else { seg_row0 = b * TPB + LC; seg_len = SEQ; t_lo = dir == 0 ? (c - 8) * 32 : (SEQ - 32 - (c - 8) * 32); }
        const u16* Pseg = P + (size_t)seg_row0 * PST;
        float* B = sm + (c & 1) * S2_BUF;
        const int t0 = t_lo + pw * 8;
        if (MIX == 0) {
          float raw[10][4];
#pragma unroll
          for (int rr = 0; rr < 10; rr++) {
            const int t = t0 - 1 + rr;
            const float okf = (t >= 0 && t < seg_len) ? 1.f : 0.f;
            const int tc = min(max(t, 0), seg_len - 1);
#pragma unroll
            for (int i = 0; i < 4; i++) raw[rr][i] = bf2f(Pseg[(size_t)tc * PST + PA + colv[i]]) * okf;
          }
#pragma unroll
          for (int j = 0; j < 8; j++)
#pragma unroll
            for (int i = 0; i < 4; i++) {
              float xm = raw[j + 1][i] + (0.5f * (raw[j][i] + raw[j + 2][i]) - raw[j + 1][i]) * muv[i];
              if (i == 3 && lane < 32) xm = tanh_fast(xm);
              ST[j * 256 + lane + 64 * i] = xm;
            }
        } else if (MIX == 1) {
          float raw[14][3];
#pragma unroll
          for (int rr = 0; rr < 14; rr++) {
            const int t = t0 - 3 + rr;
            const float okf = (t >= 0 && t < seg_len) ? 1.f : 0.f;
            const int tc = min(max(t, 0), seg_len - 1);
#pragma unroll
            for (int i = 0; i < 3; i++) raw[rr][i] = bf2f(Pseg[(size_t)tc * PST + colv[i]]) * okf;
          }
#pragma unroll
          for (int j = 0; j < 8; j++)
#pragma unroll
            for (int i = 0; i < 3; i++) {
              float a = 0.f;
#pragma unroll
              for (int tp = 0; tp < 7; tp++) a += raw[j + tp][i] * cw[i][tp];
              ST[j * 256 + lane + 64 * i] = siluf(a);
            }
          if (lane < 8) {
            const u16* pp = Pseg + (size_t)(t0 + lane) * PST + PB;
            float bx = bf2f(pp[768 + dir * 4 + h]);
            float ax = bf2f(pp[776 + dir * 4 + h]);
            float ld = -__expf(p.gdn_a_log[(l * 2 + dir) * 4 + h]) * softplusf(ax + p.gdn_dt_bias[(l * 2 + dir) * 4 + h]);
            ST[lane * 256 + 192] = sigm(bx);
            ST[lane * 256 + 193] = __expf(ld);
          }
        } else {
          u16 raw[8][3];
#pragma unroll
          for (int j = 0; j < 8; j++) {
            const u16* pp = Pseg + (size_t)(t0 + j) * PST;
#pragma unroll
            for (int i = 0; i < 3; i++) raw[j][i] = pp[colv[i]];
          }
          const float qs = lane < 32 ? 0.17677669529663687f : 1.f;
#pragma unroll
          for (int j = 0; j < 8; j++) {
            ST[j * 256 + lane] = bf2f(raw[j][0]) * qs;
            ST[j * 256 + 64 + lane] = bf2f(raw[j][1]);
            if (lane < 16) ST[j * 256 + 128 + lane] = bf2f(raw[j][2]);
          }
        }
        wave_lds_sync();
        const bool vl = fq < 2;
        if (MIX == 0) {
          bf16x8 aw, aa;
#pragma unroll
          for (int jj = 0; jj < 8; jj++) {
            aw[jj] = fr < 8 ? (short)f2bf(ST[fr * 256 + 192 + fq * 8 + jj]) : (short)0;
            aa[jj] = fr < 8 ? (short)f2bf(ST[fr * 256 + 224 + fq * 8 + jj]) : (short)0;
          }
          f32x4 accw[4], acca[4];
#pragma unroll
          for (int nt = 0; nt < 4; nt++) {
            accw[nt] = __builtin_amdgcn_mfma_f32_16x16x32_bf16(aw, bw2[nt], f32x4{0.f, 0.f, 0.f, 0.f}, 0, 0, 0);
            acca[nt] = __builtin_amdgcn_mfma_f32_16x16x32_bf16(aa, ba2[nt], f32x4{0.f, 0.f, 0.f, 0.f}, 0, 0, 0);
          }
#pragma unroll
          for (int r = 0; r < 4; r++) {
            const int j = (fq & 1) * 4 + r, tt = pw * 8 + j;
            float kkx[4], av[4], kdv[4], rv[4], dec[4];
            float ss = 0.f;
#pragma unroll
            for (int nt = 0; nt < 4; nt++) {
              const int n = nt * 16 + fr;
              rv[nt] = ST[j * 256 + n];
              const float kx = ST[j * 256 + 64 + n];
              dec[nt] = __expf(-0.6065306597126334f * sigm(cst[0][nt] + accw[nt][r]));
              av[nt] = sigm(cst[1][nt] + acca[nt][r]);
              kdv[nt] = kx * (1.f + (av[nt] - 1.f) * cst[2][nt]);
              kkx[nt] = kx * cst[3][nt];
              ss += kkx[nt] * kkx[nt];
            }
            ss = red16(ss);
            const float rs = rsq(ss + 1e-6f);
            float c1 = 0.f, c2 = 0.f, bc = 0.f;
#pragma unroll
            for (int nt = 0; nt < 4; nt++) {
              const int n = nt * 16 + fr;
              const float kk = kkx[nt] * rs;
              if (vl) {
                B[S2_D + tt * 64 + n] = dec[nt];
                B[S2_U + tt * 64 + n] = kk;
                B[S2_P + tt * 64 + n] = -kk * av[nt];
                B[S2_K + tt * 64 + n] = kdv[nt];
                B[S2_DQ + tt * 64 + n] = dec[nt] * rv[nt];
              }
              c1 += -kk * av[nt] * rv[nt];
              c2 += kdv[nt] * rv[nt];
              bc += rv[nt] * kdv[nt] * cst[4][nt];
            }
            c1 = red16(c1); c2 = red16(c2); bc = red16(bc);
            if (vl && fr == 0) {
              B[S2_C1 + tt] = c1;
              B[S2_C2 + tt] = c2;
              if (rq == 0) BC[(size_t)(seg_row0 + t_lo + tt) * 8 + h * 2 + dir] = bc;
            }
          }
        } else if (MIX == 1) {
#pragma unroll
          for (int r = 0; r < 4; r++) {
            const int j = (fq & 1) * 4 + r, tt = pw * 8 + j;
            float qv[4], kv[4];
            float sq = 0.f, sk = 0.f;
#pragma unroll
            for (int nt = 0; nt < 4; nt++) {
              const int n = nt * 16 + fr;
              qv[nt] = ST[j * 256 + n];
              kv[nt] = ST[j * 256 + 64 + n];
              sq += qv[nt] * qv[nt];
              sk += kv[nt] * kv[nt];
            }
            sq = red16(sq); sk = red16(sk);
            const float rq_ = rsq(sq + 1e-6f) * 0.125f, rk_ = rsq(sk + 1e-6f);
            const float beta = ST[j * 256 + 192], alpha = ST[j * 256 + 193];
            float dkq = 0.f;
#pragma unroll
            for (int nt = 0; nt < 4; nt++) {
              const int n = nt * 16 + fr;
              const float qn = qv[nt] * rq_, kn = kv[nt] * rk_;
              if (vl) {
                B[S2_D + tt * 64 + n] = alpha;
                B[S2_U + tt * 64 + n] = kn;
                B[S2_P + tt * 64 + n] = -alpha * beta * kn;
                B[S2_K + tt * 64 + n] = beta * kn;
                B[S2_DQ + tt * 64 + n] = alpha * qn;
              }
              dkq += kn * qn;
            }
            dkq = red16(dkq);
            if (vl && fr == 0) {
              B[S2_C1 + tt] = -alpha * beta * dkq;
              B[S2_C2 + tt] = beta * dkq;
            }
          }
        } else {
          bf16x8 ag;
#pragma unroll
          for (int jj = 0; jj < 8; jj++) ag[jj] = (fr < 8 && fq < 2) ? (short)f2bf(ST[fr * 256 + 128 + fq * 8 + jj]) : (short)0;
          f32x4 accg[2];
#pragma unroll
          for (int nt = 0; nt < 2; nt++) accg[nt] = __builtin_amdgcn_mfma_f32_16x16x32_bf16(ag, bw2[nt], f32x4{0.f, 0.f, 0.f, 0.f}, 0, 0, 0);
#pragma unroll
          for (int r = 0; r < 4; r++) {
            const int j = (fq & 1) * 4 + r, tt = pw * 8 + j;
            float dkq = 0.f;
#pragma unroll
            for (int nt = 0; nt < 2; nt++) {
              const int n = nt * 16 + fr;
              const float lg = cst[0][nt] + accg[nt][r];
              const float ls = fminf(lg, 0.f) - __logf(1.f + __expf(-fabsf(lg)));
              const float alpha = __expf(ls * (1.f / 16.f));
              const float qv = ST[j * 256 + n], kv = ST[j * 256 + 32 + n];
              if (vl) {
                B[S2_D + tt * 64 + n] = alpha;
                B[S2_K + tt * 64 + n] = kv;
                B[S2_DQ + tt * 64 + n] = alpha * qv;
              }
              dkq += kv * qv;
            }
            dkq = red16(dkq);
            if (vl && fr == 0) B[S2_C2 + tt] = dkq;
          }
        }
#pragma unroll
        for (int i = 0; i < 2; i++) {
          const int idx = lane + 64 * i, j = idx >> 4, e = idx & 15;
          B[S2_V + (pw * 8 + j) * 16 + e] = ST[j * 256 + VOFF + rq * 16 + e];
        }
      }
    } else if (c >= 1 && c <= TPB / 32) {
      const float* B = sm + ((c - 1) & 1) * S2_BUF;
      float* yb = sm + S2_YB + ((c - 1) & 1) * 512;
      const int rl = w * 4 + fq;
      const int dtt = dir ? -1 : 1;
      int tt = dir ? 31 : 0;
      float dv[EPL], kv[EPL], qv[EPL], uv[EPL], pv[EPL], vv, c1v, c2v;
      float dn[EPL], kn[EPL], qn[EPL], un[EPL], pn[EPL], vn, c1n, c2n;
#define S2_LOAD(D_, K_, Q_, U_, P_, V_, C1_, C2_, T_)                                   \
  do {                                                                                  \
    const int o_ = (T_) * 64 + fr * EPL;                                                \
    if (EPL == 4) {                                                                     \
      float4 t4 = *(const float4*)(B + S2_D + o_);                                      \
      D_[0] = t4.x; D_[1] = t4.y; D_[2] = t4.z; D_[3] = t4.w;                           \
      t4 = *(const float4*)(B + S2_K + o_);                                             \
      K_[0] = t4.x; K_[1] = t4.y; K_[2] = t4.z; K_[3] = t4.w;                           \
      t4 = *(const float4*)(B + S2_DQ + o_);                                            \
      Q_[0] = t4.x; Q_[1] = t4.y; Q_[2] = t4.z; Q_[3] = t4.w;                           \
      t4 = *(const float4*)(B + S2_U + o_);                                             \
      U_[0] = t4.x; U_[1] = t4.y; U_[2] = t4.z; U_[3] = t4.w;                           \
      t4 = *(const float4*)(B + S2_P + o_);                                             \
      P_[0] = t4.x; P_[1] = t4.y; P_[2] = t4.z; P_[3] = t4.w;                           \
      C1_ = B[S2_C1 + (T_)];                                                            \
    } else {                                                                            \
      float2 t2 = *(const float2*)(B + S2_D + o_);                                      \
      D_[0] = t2.x; D_[1] = t2.y;                                                       \
      t2 = *(const float2*)(B + S2_K + o_);                                             \
      K_[0] = t2.x; K_[1] = t2.y;                                                       \
      t2 = *(const float2*)(B + S2_DQ + o_);                                            \
      Q_[0] = t2.x; Q_[1] = t2.y;                                                       \
      U_[0] = U_[1] = P_[0] = P_[1] = 0.f; C1_ = 0.f;                                   \
    }                                                                                   \
    V_ = B[S2_V + (T_) * 16 + rl];                                                      \
    C2_ = B[S2_C2 + (T_)];                                                              \
  } while (0)
#define S2_STEP(D_, K_, Q_, U_, P_, V_, C1_, C2_, T_)                                   \
  do {                                                                                  \
    float sq = 0.f, sa = 0.f;                                                           \
    _Pragma("unroll") for (int i = 0; i < EPL; i++) sq += s[i] * Q_[i];                 \
    if (MIX != 2) {                                                                     \
      _Pragma("unroll") for (int i = 0; i < EPL; i++) sa += s[i] * U_[i];               \
      sa = red16(sa);                                                                   \
    }                                                                                   \
    sq = red16(sq);                                                                     \
    float y = sq + V_ * C2_;                                                            \
    if (MIX != 2) y += sa * C1_;                                                        \
    _Pragma("unroll") for (int i = 0; i < EPL; i++) {                                   \
      float t = s[i] * D_[i] + V_ * K_[i];                                              \
      if (MIX != 2) t += sa * P_[i];                                                    \
      s[i] = t;                                                                         \
    }                                                                                   \
    yb[(T_) * 16 + rl] = y;                                                             \
  } while (0)
      S2_LOAD(dv, kv, qv, uv, pv, vv, c1v, c2v, tt);
#pragma unroll 1
      for (int st = 0; st < 32; st += 2) {
        const int t1 = tt + dtt;
        S2_LOAD(dn, kn, qn, un, pn, vn, c1n, c2n, t1);
        S2_STEP(dv, kv, qv, uv, pv, vv, c1v, c2v, tt);
        const int t2 = st + 2 < 32 ? t1 + dtt : t1;
        S2_LOAD(dv, kv, qv, uv, pv, vv, c1v, c2v, t2);
        S2_STEP(dn, kn, qn, un, pn, vn, c1n, c2n, t1);
        tt = t2;
      }
#undef S2_LOAD
#undef S2_STEP
    }
    __syncthreads();
  }
}

#define S3_SUB 12800
#define S3_GM 0
#define S3_KVT 9216
#define S3_QB 10240
#define S3_QV 11392
#define S3_VT 11520
#define S3_WC 12544
#define S3_TB S3_QV
#define S3_TM (S3_GM + 3328)
#define S3_QBM (S3_GM + 3072)
#define S3_QKM (S3_GM + 3200)
#define S3_KB (S3_GM + 0)
#define S3_BT (S3_GM + 2048)
#define S3_STB (8 * S3_SUB)
#define S3_END (S3_STB + 4 * 2304)

__device__ __forceinline__ float rlane(float x, int l) { return __int_as_float(__builtin_amdgcn_readlane(__float_as_int(x), l)); }
__device__ __forceinline__ float wave_sum(float x) {
  x = red16(x);
  return (rlane(x, 0) + rlane(x, 16)) + (rlane(x, 32) + rlane(x, 48));
}
__device__ __forceinline__ float clampe(float x) { return fminf(fmaxf(x, -80.f), 80.f); }
__device__ __forceinline__ uint4 pack8(const float (&v)[8]) {
  return make_uint4(pack2(v[0], v[1]), pack2(v[2], v[3]), pack2(v[4], v[5]), pack2(v[6], v[7]));
}
__device__ __forceinline__ bf16x8 ld_frag(const void* p) { return *(const bf16x8*)p; }
__device__ __forceinline__ bf16x8 zfrag() { return bf16x8{0, 0, 0, 0, 0, 0, 0, 0}; }

__device__ __forceinline__ void chunk_geom(int c, int dir, int b, int& seg_row0, int& seg_len, int& t_lo) {
  if (c < 8) { seg_row0 = b * TPB; seg_len = LC; t_lo = dir == 0 ? c * 32 : (LC - 32 - c * 32); }
  else { seg_row0 = b * TPB + LC; seg_len = SEQ; t_lo = dir == 0 ? (c - 8) * 32 : (SEQ - 32 - (c - 8) * 32); }
}
template <int MIX>
__device__ __forceinline__ void fetch_raw(const u16* P, int c, int dir, int b, int h, int pw, int lane, const int (&colv)[4], unsigned (&rawq)[14][2]) {
  int seg_row0, seg_len, t_lo;
  chunk_geom(c, dir, b, seg_row0, seg_len, t_lo);
  const u16* Pseg = P + (size_t)seg_row0 * PST;
  const int t0 = t_lo + pw * 8;
  if (MIX == 0) {
#pragma unroll
    for (int rr = 0; rr < 10; rr++) {
      const int tc = min(max(t0 - 1 + rr, 0), seg_len - 1);
#pragma unroll
      for (int i = 0; i < 2; i++)
        rawq[rr][i] = (unsigned)Pseg[(size_t)tc * PST + PA + colv[2 * i]] | ((unsigned)Pseg[(size_t)tc * PST + PA + colv[2 * i + 1]] << 16);
    }
  } else if (MIX == 1) {
#pragma unroll
    for (int rr = 0; rr < 14; rr++) {
      const int tc = min(max(t0 - 3 + rr, 0), seg_len - 1);
      rawq[rr][0] = (unsigned)Pseg[(size_t)tc * PST + colv[0]] | ((unsigned)Pseg[(size_t)tc * PST + colv[1]] << 16);
      rawq[rr][1] = (rawq[rr][1] & 0xffff0000u) | (unsigned)Pseg[(size_t)tc * PST + colv[2]];
    }
    const u16* pp = Pseg + (size_t)(t0 + (lane & 7)) * PST + PB;
    rawq[0][1] = (rawq[0][1] & 0xffffu) | ((unsigned)pp[768 + dir * 4 + h] << 16);
    rawq[1][1] = (rawq[1][1] & 0xffffu) | ((unsigned)pp[776 + dir * 4 + h] << 16);
  } else {
#pragma unroll
    for (int j = 0; j < 8; j++) {
      const u16* pp = Pseg + (size_t)(t0 + j) * PST;
      rawq[j][0] = (unsigned)pp[colv[0]] | ((unsigned)pp[colv[1]] << 16);
      rawq[j][1] = (unsigned)pp[colv[2]];
    }
  }
}

template <int MIX>
__device__ __forceinline__ void scan3_item(const Params& p, int l, int b, int h, int dir, unsigned char* smb) {
  constexpr int VOFF = (MIX == 2) ? 64 : 128;
  constexpr bool DELTA = (MIX != 2);
  const int tid = TIDX, lane = tid & 63, w = __builtin_amdgcn_readfirstlane(tid >> 6), fr = lane & 15, fq = lane >> 4;
  const bool producer = true;
  const int pw = w & 3, half = w >> 2;
  const u16* P = (const u16*)(p.ws + OFF_BIG);
  u16* YS = (u16*)(p.ws + OFF_YS);
  float* BC = (float*)(p.ws + OFF_BC);
  float* ST = (float*)(smb + w * S3_SUB + S3_GM);
  unsigned char* STBY = smb + w * S3_SUB + S3_GM;
  const f32x4 z4 = f32x4{0.f, 0.f, 0.f, 0.f};
  f32x4 st[4];
#pragma unroll
  for (int i = 0; i < 4; i++) st[i] = z4;

  bf16x8 bw2[4], ba2[4];
  float cw[3][7];
  float muv[4];
  int colv[4];
  float c_w0 = 0.f, c_a0 = 0.f, c_ka = 0.f, c_kk = 0.f, c_rk = 0.f, c_gb = 0.f;
#pragma unroll
  for (int i = 0; i < 4; i++) { bw2[i] = zfrag(); ba2[i] = zfrag(); muv[i] = 0.f; colv[i] = 0; }
  if (producer) {
    if (MIX == 0) {
      {
        float tw[4][8], ta[4][8];
#pragma unroll
        for (int nt = 0; nt < 4; nt++)
#pragma unroll
          for (int jj = 0; jj < 8; jj++) {
            tw[nt][jj] = p.rwkv_w2[((size_t)(l * 2 + dir) * 32 + fq * 8 + jj) * 256 + h * 64 + nt * 16 + fr];
            ta[nt][jj] = p.rwkv_a2[((size_t)(l * 2 + dir) * 32 + fq * 8 + jj) * 256 + h * 64 + nt * 16 + fr];
          }
#pragma unroll
        for (int nt = 0; nt < 4; nt++)
#pragma unroll
          for (int jj = 0; jj < 8; jj++) { bw2[nt][jj] = (short)f2bf(tw[nt][jj]); ba2[nt][jj] = (short)f2bf(ta[nt][jj]); }
      }
      const int jl = h * 64 + lane;
      c_w0 = p.rwkv_w0[(l * 2 + dir) * 256 + jl];
      c_a0 = p.rwkv_a0[(l * 2 + dir) * 256 + jl];
      c_ka = p.rwkv_ka[l * 256 + jl];
      c_kk = p.rwkv_kk[l * 256 + jl];
      c_rk = p.rwkv_rk[l * 256 + jl];
#pragma unroll
      for (int i = 0; i < 4; i++) {
        colv[i] = i < 3 ? i * 256 + h * 64 + lane : (lane < 32 ? 768 + dir * 32 + lane : 832 + dir * 32 + (lane - 32));
        muv[i] = p.rwkv_mu[l * 960 + colv[i]];
      }
    } else if (MIX == 1) {
#pragma unroll
      for (int i = 0; i < 3; i++) {
        colv[i] = PB + i * 256 + h * 64 + lane;
#pragma unroll
        for (int tp = 0; tp < 7; tp++) cw[i][tp] = p.gdn_conv[((size_t)l * 7 + tp) * 768 + i * 256 + h * 64 + lane];
      }
    } else {
      {
        float tg[2][8];
#pragma unroll
        for (int nt = 0; nt < 2; nt++)
#pragma unroll
          for (int jj = 0; jj < 8; jj++) tg[nt][jj] = p.gla_gw2[((size_t)(l * 2 + dir) * 16 + (fq & 1) * 8 + jj) * 128 + h * 32 + nt * 16 + fr];
#pragma unroll
        for (int nt = 0; nt < 2; nt++)
#pragma unroll
          for (int jj = 0; jj < 8; jj++) bw2[nt][jj] = fq < 2 ? (short)f2bf(tg[nt][jj]) : (short)0;
      }
      c_gb = p.gla_gb[(l * 2 + dir) * 128 + h * 32 + (lane & 31)];
      colv[0] = PC + h * 32 + lane;
      if (lane >= 32) colv[0] = PC + 128 + h * 32 + (lane - 32);
      colv[1] = PC + 256 + h * 64 + lane;
      colv[2] = PC + 512 + dir * 16 + (lane & 15);
    }
  }
  __syncthreads();
  unsigned rawq[14][2];
#pragma unroll
  for (int i = 0; i < 14; i++) { rawq[i][0] = 0u; rawq[i][1] = 0u; }
  fetch_raw<MIX>(P, half, dir, b, h, pw, lane, colv, rawq);
#define RAWP(r_, i_) ((u16)((rawq[r_][(i_) >> 1] >> (((i_) & 1) * 16)) & 0xffffu))

  for (int it = 0; it < TPB / 64; it++) {
    {
      {
        const int c = it * 2 + half;
        int seg_row0, seg_len, t_lo;
        chunk_geom(c, dir, b, seg_row0, seg_len, t_lo);
        unsigned char* SB = smb + w * S3_SUB;
        const int t0 = t_lo + pw * 8;
        if (MIX == 0) {
          float raw[10][4];
#pragma unroll
          for (int rr = 0; rr < 10; rr++) {
            const int t = t0 - 1 + rr;
            const float okf = (t >= 0 && t < seg_len) ? 1.f : 0.f;
#pragma unroll
            for (int i = 0; i < 4; i++) raw[rr][i] = bf2f(RAWP(rr, i)) * okf;
          }
#pragma unroll
          for (int j = 0; j < 8; j++)
#pragma unroll
            for (int i = 0; i < 4; i++) {
              float xm = raw[j + 1][i] + (0.5f * (raw[j][i] + raw[j + 2][i]) - raw[j + 1][i]) * muv[i];
              if (i == 3 && lane < 32) xm = tanh_fast(xm);
              ST[j * 256 + lane + 64 * i] = xm;
            }
        } else if (MIX == 1) {
          float raw[14][3];
#pragma unroll
          for (int rr = 0; rr < 14; rr++) {
            const int t = t0 - 3 + rr;
            const float okf = (t >= 0 && t < seg_len) ? 1.f : 0.f;
#pragma unroll
            for (int i = 0; i < 3; i++) raw[rr][i] = bf2f(RAWP(rr, i)) * okf;
          }
#pragma unroll
          for (int j = 0; j < 8; j++)
#pragma unroll
            for (int i = 0; i < 3; i++) {
              float a = 0.f;
#pragma unroll
              for (int tp = 0; tp < 7; tp++) a += raw[j + tp][i] * cw[i][tp];
              ST[j * 256 + lane + 64 * i] = siluf(a);
            }
          if (lane < 8) {
            float bx = bf2f(RAWP(0, 3));
            float ax = bf2f(RAWP(1, 3));
            float ld = -__expf(p.gdn_a_log[(l * 2 + dir) * 4 + h]) * softplusf(ax + p.gdn_dt_bias[(l * 2 + dir) * 4 + h]);
            ST[lane * 256 + 192] = sigm(bx);
            ST[lane * 256 + 193] = ld;
          }
        } else {
          const float qs = lane < 32 ? 0.17677669529663687f : 1.f;
#pragma unroll
          for (int j = 0; j < 8; j++) {
            ST[j * 256 + lane] = bf2f(RAWP(j, 0)) * qs;
            ST[j * 256 + 64 + lane] = bf2f(RAWP(j, 1));
            if (lane < 16) ST[j * 256 + 128 + lane] = bf2f(RAWP(j, 2));
          }
        }
        wave_lds_sync();
        {
          float vv[8];
#pragma unroll
          for (int i = 0; i < 8; i++) vv[i] = ST[(dir ? 7 - i : i) * 256 + VOFF + lane];
          *(uint4*)(SB + S3_VT + lane * 16) = pack8(vv);
        }
        if (MIX == 0) {
          bf16x8 aw, aa;
#pragma unroll
          for (int jj = 0; jj < 8; jj++) {
            aw[jj] = fr < 8 ? (short)f2bf(ST[fr * 256 + 192 + fq * 8 + jj]) : (short)0;
            aa[jj] = fr < 8 ? (short)f2bf(ST[fr * 256 + 224 + fq * 8 + jj]) : (short)0;
          }
          f32x4 accw[4], acca[4];
#pragma unroll
          for (int nt = 0; nt < 4; nt++) {
            accw[nt] = __builtin_amdgcn_mfma_f32_16x16x32_bf16(aw, bw2[nt], z4, 0, 0, 0);
            acca[nt] = __builtin_amdgcn_mfma_f32_16x16x32_bf16(aa, ba2[nt], z4, 0, 0, 0);
          }
          wave_lds_sync();
          if (fq < 2) {
#pragma unroll
            for (int nt = 0; nt < 4; nt++)
#pragma unroll
              for (int r = 0; r < 4; r++) {
                ST[(fq * 4 + r) * 256 + 128 + nt * 16 + fr] = accw[nt][r];
                ST[(fq * 4 + r) * 256 + 192 + nt * 16 + fr] = acca[nt][r];
              }
          }
          wave_lds_sync();
        } else if (MIX == 2) {
          bf16x8 ag;
#pragma unroll
          for (int jj = 0; jj < 8; jj++) ag[jj] = (fr < 8 && fq < 2) ? (short)f2bf(ST[fr * 256 + 128 + fq * 8 + jj]) : (short)0;
          f32x4 accg[2];
#pragma unroll
          for (int nt = 0; nt < 2; nt++) accg[nt] = __builtin_amdgcn_mfma_f32_16x16x32_bf16(ag, bw2[nt], z4, 0, 0, 0);
          if (fq < 2) {
#pragma unroll
            for (int nt = 0; nt < 2; nt++)
#pragma unroll
              for (int r = 0; r < 4; r++) ST[(fq * 4 + r) * 256 + 192 + nt * 16 + fr] = accg[nt][r];
          }
          wave_lds_sync();
        }
        float logd[8], kap[8], bb[8], kp[8], qq[8];
        u16* XA1 = (u16*)(SB + 9216);
        u16* XA2 = (u16*)(SB + 10368);
        const int dlane_r = fr & 3;
        if (MIX == 0) {
          float a8[8];
#pragma unroll
          for (int i = 0; i < 8; i++) {
            const float* row = ST + (dir ? 7 - i : i) * 256;
            const float r_ = row[lane], k_ = row[64 + lane];
            const float sg = sigm(c_w0 + row[128 + lane]);
            a8[i] = sigm(c_a0 + row[192 + lane]);
            kp[i] = k_ * (1.f + (a8[i] - 1.f) * c_ka);
            kap[i] = k_ * c_kk;
            qq[i] = r_;
            logd[i] = -0.6065306597126334f * sg;
            XA1[i * 72 + lane] = f2bf(kap[i]);
          }
          wave_lds_sync();
          f32x4 accS = z4;
#pragma unroll
          for (int ks = 0; ks < 2; ks++) {
            const bf16x8 fx = ld_frag(XA1 + (fr & 7) * 72 + fq * 8 + ks * 32);
            accS = __builtin_amdgcn_mfma_f32_16x16x32_bf16(fx, fx, accS, 0, 0, 0);
          }
          const float dsel = dlane_r == 0 ? accS[0] : (dlane_r == 1 ? accS[1] : (dlane_r == 2 ? accS[2] : accS[3]));
#pragma unroll
          for (int i = 0; i < 8; i++) {
            const float ss = rlane(dsel, (i >> 2) * 16 + i);
            kap[i] *= rsq(ss + 1e-6f);
            bb[i] = kap[i] * a8[i];
          }
        } else if (MIX == 1) {
#pragma unroll
          for (int i = 0; i < 8; i++) {
            const float* row = ST + (dir ? 7 - i : i) * 256;
            qq[i] = row[lane]; kap[i] = row[64 + lane];
            kp[i] = row[192];
            logd[i] = row[193];
            XA1[i * 72 + lane] = f2bf(qq[i]);
            XA2[i * 72 + lane] = f2bf(kap[i]);
          }
          wave_lds_sync();
          f32x4 accSq = z4, accSk = z4;
#pragma unroll
          for (int ks = 0; ks < 2; ks++) {
            const bf16x8 fxq = ld_frag(XA1 + (fr & 7) * 72 + fq * 8 + ks * 32), fxk = ld_frag(XA2 + (fr & 7) * 72 + fq * 8 + ks * 32);
            accSq = __builtin_amdgcn_mfma_f32_16x16x32_bf16(fxq, fxq, accSq, 0, 0, 0);
            accSk = __builtin_amdgcn_mfma_f32_16x16x32_bf16(fxk, fxk, accSk, 0, 0, 0);
          }
          const float dq = dlane_r == 0 ? accSq[0] : (dlane_r == 1 ? accSq[1] : (dlane_r == 2 ? accSq[2] : accSq[3]));
          const float dk = dlane_r == 0 ? accSk[0] : (dlane_r == 1 ? accSk[1] : (dlane_r == 2 ? accSk[2] : accSk[3]));
#pragma unroll
          for (int i = 0; i < 8; i++) {
            const float sq = rlane(dq, (i >> 2) * 16 + i), sk = rlane(dk, (i >> 2) * 16 + i);
            const float beta = kp[i], alpha = __expf(logd[i]);
            const float qn = qq[i] * rsq(sq + 1e-6f) * 0.125f, kn = kap[i] * rsq(sk + 1e-6f);
            kap[i] = kn; bb[i] = alpha * beta * kn; kp[i] = beta * kn; qq[i] = qn;
          }
        } else {
#pragma unroll
          for (int i = 0; i < 8; i++) {
            const float* row = ST + (dir ? 7 - i : i) * 256;
            const int n = lane & 31;
            const float lg = c_gb + row[192 + n];
            const float ls = fminf(lg, 0.f) - __logf(1.f + __expf(-fabsf(lg)));
            logd[i] = ls * (1.f / 16.f);
            kap[i] = 0.f; bb[i] = 0.f;
            kp[i] = lane < 32 ? row[32 + n] : 0.f;
            qq[i] = lane < 32 ? row[n] : 0.f;
          }
        }
        wave_lds_sync();
        float kt[8], qt[8], bck[8], kck[8];
        {
          float L[8];
          float run = 0.f;
#pragma unroll
          for (int i = 0; i < 8; i++) { run += logd[i]; L[i] = run; }
          const float Lr = L[3], L7 = L[7];
          float prevE = __expf(clampe(-Lr)), prevT = 1.f;
          u16* OPA = (u16*)STBY;
#pragma unroll
          for (int i = 0; i < 8; i++) {
            const float eI = __expf(clampe(L[i] - Lr)), eInv = __expf(clampe(Lr - L[i]));
            const float tI = __expf(L[i]), eEnd = __expf(L7 - L[i]);
            if (DELTA) {
              OPA[0 * 576 + i * 72 + lane] = f2bf(kap[i] * prevE);
              OPA[1 * 576 + i * 72 + lane] = f2bf(bb[i] * eInv);
            }
            OPA[2 * 576 + i * 72 + lane] = f2bf(kp[i] * eInv);
            OPA[3 * 576 + i * 72 + lane] = f2bf(qq[i] * eI);
            if (MIX == 0) OPA[4 * 576 + i * 72 + lane] = f2bf(qq[i] * eI * c_rk);
            kt[i] = kap[i] * prevT; qt[i] = qq[i] * tI;
            bck[i] = bb[i] * eEnd; kck[i] = kp[i] * eEnd;
            prevE = eI; prevT = tI;
          }
          *(float*)(SB + S3_WC + lane * 4) = __expf(L7);
        }
        wave_lds_sync();
        f32x4 accA = z4, accBm = z4, accQb = z4, accQk = z4, accBC = z4;
        {
          const u16* OPA = (const u16*)STBY;
          const int ro = (fr & 7) * 72 + fq * 8;
#pragma unroll
          for (int ks = 0; ks < 2; ks++) {
            const bf16x8 fk = ld_frag(OPA + 2 * 576 + ro + ks * 32), fqh = ld_frag(OPA + 3 * 576 + ro + ks * 32);
            accQk = __builtin_amdgcn_mfma_f32_16x16x32_bf16(fqh, fk, accQk, 0, 0, 0);
            if (MIX == 0) accBC = __builtin_amdgcn_mfma_f32_16x16x32_bf16(ld_frag(OPA + 4 * 576 + ro + ks * 32), fk, accBC, 0, 0, 0);
            if (DELTA) {
              const bf16x8 fka = ld_frag(OPA + 0 * 576 + ro + ks * 32), fb = ld_frag(OPA + 1 * 576 + ro + ks * 32);
              accA = __builtin_amdgcn_mfma_f32_16x16x32_bf16(fka, fb, accA, 0, 0, 0);
              accBm = __builtin_amdgcn_mfma_f32_16x16x32_bf16(fka, fk, accBm, 0, 0, 0);
              accQb = __builtin_amdgcn_mfma_f32_16x16x32_bf16(fqh, fb, accQb, 0, 0, 0);
            }
          }
#pragma unroll
          for (int r = 0; r < 4; r++) {
            const int i = fq * 4 + r;
            const bool ok = fq < 2 && fr < 8;
            if (!(ok && fr < i)) { accA[r] = 0.f; accBm[r] = 0.f; }
            if (!(ok && fr <= i)) { accQb[r] = 0.f; accQk[r] = 0.f; }
          }
          if (MIX == 0 && fq < 2 && fr < 8 && (fr >> 2) == fq) {
            const int r = fr & 3;
            const float bcv = r == 0 ? accBC[0] : (r == 1 ? accBC[1] : (r == 2 ? accBC[2] : accBC[3]));
            BC[(size_t)(seg_row0 + t0 + (dir ? 7 - fr : fr)) * 8 + h * 2 + dir] = bcv;
          }
        }
        *(uint4*)(SB + S3_KVT + lane * 16) = pack8(kck);
#pragma unroll
        for (int i = 0; i < 8; i++) ((u16*)(SB + S3_QB))[i * 72 + lane] = f2bf(qt[i]);
        if (fq < 2 && fr < 8) {
#pragma unroll
          for (int r = 0; r < 4; r++) {
            ((u16*)(SB + S3_QKM))[(fq * 4 + r) * 8 + fr] = f2bf(accQk[r]);
            if (DELTA) ((u16*)(SB + S3_QBM))[(fq * 4 + r) * 8 + fr] = f2bf(accQb[r]);
          }
        }
        if (DELTA) {
          float t[8];
#pragma unroll
          for (int i = 0; i < 8; i++) {
            float ti = (lane == i) ? 1.f : 0.f;
#pragma unroll
            for (int m = 0; m < i; m++) ti -= rlane(accA[i & 3], (i >> 2) * 16 + m) * t[m];
            t[i] = ti;
          }
#pragma unroll
          for (int i = 0; i < 8; i++) ((u16*)(SB + S3_KB))[i * 72 + lane] = f2bf(-kt[i]);
          *(uint4*)(SB + S3_BT + lane * 16) = pack8(bck);
          if (fq < 2 && fr < 8) {
#pragma unroll
            for (int r = 0; r < 4; r++) ((u16*)(SB + S3_TB))[(fq * 4 + r) * 8 + fr] = f2bf(-accBm[r]);
          }
          if (lane < 8) {
#pragma unroll
            for (int i = 0; i < 8; i++) ((u16*)(SB + S3_TM))[i * 8 + lane] = f2bf(t[i]);
          }
        }
      }
    }
    fetch_raw<MIX>(P, min(it + 1, TPB / 64 - 1) * 2 + half, dir, b, h, pw, lane, colv, rawq);
    __syncthreads();
    if (w < 4) {
      unsigned char* STB = smb + S3_STB + w * 2304;
#pragma unroll
      for (int kk = 0; kk < 8; kk++) {
        const int cc = it * 2 + (kk >> 2), k = kk & 3;
        int seg_row0, t_lo;
        if (cc < 8) { seg_row0 = b * TPB; t_lo = dir == 0 ? cc * 32 : (LC - 32 - cc * 32); }
        else { seg_row0 = b * TPB + LC; t_lo = dir == 0 ? (cc - 8) * 32 : (SEQ - 32 - (cc - 8) * 32); }
        const int sc = dir ? 3 - k : k;
        const unsigned char* SB = smb + ((kk >> 2) * 4 + sc) * S3_SUB;
        const bf16x8 bs0 = __builtin_bit_cast(bf16x8, u32x4v{pack2(st[0][0], st[0][1]), pack2(st[0][2], st[0][3]), pack2(st[1][0], st[1][1]), pack2(st[1][2], st[1][3])});
        const bf16x8 bs1 = __builtin_bit_cast(bf16x8, u32x4v{pack2(st[2][0], st[2][1]), pack2(st[2][2], st[2][3]), pack2(st[3][0], st[3][1]), pack2(st[3][2], st[3][3])});
#define LDP(BASE_, ROW_, KS_) ([&]() -> bf16x8 {                                                                   \
          const uint2 lo_ = *(const uint2*)((BASE_) + ((ROW_) * 72 + (KS_) * 32 + fq * 4) * 2);                      \
          const uint2 hi_ = *(const uint2*)((BASE_) + ((ROW_) * 72 + (KS_) * 32 + 16 + fq * 4) * 2);                 \
          return __builtin_bit_cast(bf16x8, u32x4v{lo_.x, lo_.y, hi_.x, hi_.y}); }())
        const bf16x8 bv = fq == 0 ? ld_frag(SB + S3_VT + (w * 16 + fr) * 16) : zfrag();
        const bf16x8 aq0 = LDP(SB + S3_QB, (fr & 7), 0), aq1 = LDP(SB + S3_QB, (fr & 7), 1);
        const bf16x8 aqk = fq == 0 ? ld_frag(SB + S3_QKM + (fr & 7) * 16) : zfrag();
        bf16x8 brv = zfrag();
        if (DELTA) {
          const bf16x8 ak0 = LDP(SB + S3_KB, (fr & 7), 0), ak1 = LDP(SB + S3_KB, (fr & 7), 1);
          const bf16x8 atb = fq == 0 ? ld_frag(SB + S3_TB + (fr & 7) * 16) : zfrag();
          f32x4 accR = __builtin_amdgcn_mfma_f32_16x16x32_bf16(ak0, bs0, z4, 0, 0, 0);
          accR = __builtin_amdgcn_mfma_f32_16x16x32_bf16(ak1, bs1, accR, 0, 0, 0);
          accR = __builtin_amdgcn_mfma_f32_16x16x32_bf16(atb, bv, accR, 0, 0, 0);
          {
            const uint2 t2 = *(const uint2*)(SB + S3_TM + (fr & 7) * 16 + (fq & 1) * 8);
            const u32x4v ta4 = {t2.x, t2.y, 0u, 0u};
            const u32x4v rb4 = {pack2(accR[0], accR[1]), pack2(accR[2], accR[3]), 0u, 0u};
            const bf16x8 at = fq < 2 ? __builtin_bit_cast(bf16x8, ta4) : zfrag();
            const bf16x8 br = fq < 2 ? __builtin_bit_cast(bf16x8, rb4) : zfrag();
            accR = __builtin_amdgcn_mfma_f32_16x16x32_bf16(at, br, z4, 0, 0, 0);
          }
          const uint2 vv2 = *(const uint2*)(SB + S3_VT + (w * 16 + fr) * 16 + (fq & 1) * 8);
          const u32x4v t4 = {pack2(accR[0], accR[1]), pack2(accR[2], accR[3]), vv2.x, vv2.y};
          brv = fq < 2 ? __builtin_bit_cast(bf16x8, t4) : zfrag();
        }
        f32x4 accY = __builtin_amdgcn_mfma_f32_16x16x32_bf16(aq0, bs0, z4, 0, 0, 0);
        accY = __builtin_amdgcn_mfma_f32_16x16x32_bf16(aq1, bs1, accY, 0, 0, 0);
        if (DELTA) {
          const uint2 qb2 = *(const uint2*)(SB + S3_QBM + (fr & 7) * 16 + (fq & 1) * 8);
          const uint2 qk2 = *(const uint2*)(SB + S3_QKM + (fr & 7) * 16 + (fq & 1) * 8);
          const u32x4v q4 = {qb2.x, qb2.y, qk2.x, qk2.y};
          const bf16x8 aqm = fq < 2 ? __builtin_bit_cast(bf16x8, q4) : zfrag();
          accY = __builtin_amdgcn_mfma_f32_16x16x32_bf16(aqm, brv, accY, 0, 0, 0);
        } else {
          accY = __builtin_amdgcn_mfma_f32_16x16x32_bf16(aqk, bv, accY, 0, 0, 0);
        }
        if (fq < 2) {
#pragma unroll
          for (int r = 0; r < 4; r++) {
            const int i = fq * 4 + r, j = dir ? 7 - i : i;
            YS[(size_t)(seg_row0 + t_lo + sc * 8 + j) * YST + dir * 768 + MIX * 256 + h * 64 + w * 16 + fr] = f2bf(accY[r]);
          }
        }
#pragma unroll
        for (int nt = 0; nt < 4; nt++) {
          f32x4 an;
          if (DELTA) {
            const uint2 b2 = *(const uint2*)(SB + S3_BT + (nt * 16 + fr) * 16 + (fq & 1) * 8);
            const uint2 k2 = *(const uint2*)(SB + S3_KVT + (nt * 16 + fr) * 16 + (fq & 1) * 8);
            const u32x4v a4 = {b2.x, b2.y, k2.x, k2.y};
            const bf16x8 am = fq < 2 ? __builtin_bit_cast(bf16x8, a4) : zfrag();
            an = __builtin_amdgcn_mfma_f32_16x16x32_bf16(am, brv, z4, 0, 0, 0);
          } else {
            const bf16x8 akv = fq == 0 ? ld_frag(SB + S3_KVT + (nt * 16 + fr) * 16) : zfrag();
            an = __builtin_amdgcn_mfma_f32_16x16x32_bf16(akv, bv, z4, 0, 0, 0);
          }
          const float4 wc = *(const float4*)(SB + S3_WC + (nt * 16 + fq * 4) * 4);
          st[nt][0] = st[nt][0] * wc.x + an[0];
          st[nt][1] = st[nt][1] * wc.y + an[1];
          st[nt][2] = st[nt][2] * wc.z + an[2];
          st[nt][3] = st[nt][3] * wc.w + an[3];
        }
#undef LDP
      }
    }
    __syncthreads();
  }
}

__device__ __forceinline__ void attn_item(const Params& p, int l, int b, int qb, int hk, bool isctx, unsigned char* smem) {
  u16* KS = (u16*)smem;
  u16* VT = KS + 64 * LDT;
  u16* PL = VT + 64 * LDT;
  float2* ROPE = (float2*)(PL + 8 * 32 * LDT);
  const int tid = TIDX, lane = tid & 63, w = tid >> 6, fr = lane & 15, fq = lane >> 4;
  const u16* P = (const u16*)(p.ws + OFF_BIG);
  u16* Y = (u16*)(p.ws + OFF_YS);
  const int qh = hk * 2 + (w >> 2);
  const int tb = qb * 128 + (w & 3) * 32;
  const int qrow0 = b * TPB + (isctx ? 0 : LC);
  __syncthreads();
  for (int i = tid; i < 1024; i += NTHR) {
    int pos = i >> 4, fi = i & 15;
    float inv = powf(10000.f, -(float)fi / 16.f);
    float sn, cs;
    sincosf((float)pos * inv, &sn, &cs);
    ROPE[i] = make_float2(cs, sn);
  }
  __syncthreads();
  bf16x8 qf[2][2];
#pragma unroll
  for (int mi = 0; mi < 2; mi++)
#pragma unroll
    for (int ks = 0; ks < 2; ks++) {
      const int tq = tb + mi * 16 + fr;
      const u16* qp = P + (size_t)(qrow0 + tq) * PST + PD + qh * 64 + ks * 32;
      uint4 own = *(const uint4*)(qp + fq * 8);
      uint4 par = *(const uint4*)(qp + (fq ^ 2) * 8);
      const unsigned ow[4] = {own.x, own.y, own.z, own.w};
      const unsigned pw[4] = {par.x, par.y, par.z, par.w};
      const int pos = ks == 0 ? (tq >> 6) : (tq & 63);
      bf16x8 f;
#pragma unroll
      for (int jj = 0; jj < 8; jj++) {
        float xo = bf2f((u16)((ow[jj >> 1] >> ((jj & 1) * 16)) & 0xffff));
        float xp = bf2f((u16)((pw[jj >> 1] >> ((jj & 1) * 16)) & 0xffff));
        float v = xo;
        if (!isctx) {
          float2 cs = ROPE[pos * 16 + (fq & 1) * 8 + jj];
          v = fq < 2 ? xo * cs.x - xp * cs.y : xp * cs.y + xo * cs.x;
        }
        f[jj] = (short)f2bf(v * 0.125f);
      }
      qf[mi][ks] = f;
    }
  f32x4 oacc[2][4];
#pragma unroll
  for (int mi = 0; mi < 2; mi++)
#pragma unroll
    for (int nd = 0; nd < 4; nd++) oacc[mi][nd] = f32x4{0.f, 0.f, 0.f, 0.f};
  float mrow[2][4], lrow[2][4];
#pragma unroll
  for (int mi = 0; mi < 2; mi++)
#pragma unroll
    for (int r = 0; r < 4; r++) { mrow[mi][r] = -1e30f; lrow[mi][r] = 0.f; }

  const int q0 = qb * 128;
  const int band_lo = isctx ? 0 : max(0, q0 - 128), band_hi = isctx ? 0 : min(SEQ, q0 + 256);
  const int ntile = 4 + (band_hi - band_lo) / 64;
  u16* pl = PL + w * 32 * LDT;
  for (int tl = 0; tl < ntile; tl++) {
    const bool band = tl >= 4;
    const int k0 = band ? band_lo + (tl - 4) * 64 : tl * 64;
    __syncthreads();
    {
      const int key = tid >> 3, kc = tid & 7;
      const int kpos = k0 + key;
      const u16* kp = P + (size_t)(b * TPB + (band ? LC : 0) + kpos) * PST + PD + 256 + hk * 64;
      uint4 own = *(const uint4*)(kp + kc * 8);
      uint4 vv = *(const uint4*)(kp + 128 + kc * 8);
      uint4 par = *(const uint4*)(kp + (kc ^ 2) * 8);
      if (band) {
        const unsigned ow[4] = {own.x, own.y, own.z, own.w};
        const unsigned pw[4] = {par.x, par.y, par.z, par.w};
        const int pos = kc < 4 ? (kpos >> 6) : (kpos & 63);
        unsigned res[4];
#pragma unroll
        for (int jj = 0; jj < 8; jj += 2) {
          float v2[2];
#pragma unroll
          for (int e = 0; e < 2; e++) {
            float xo = bf2f((u16)((ow[jj >> 1] >> (e * 16)) & 0xffff));
            float xp = bf2f((u16)((pw[jj >> 1] >> (e * 16)) & 0xffff));
            float2 cs = ROPE[pos * 16 + (kc & 1) * 8 + jj + e];
            v2[e] = (kc & 2) == 0 ? xo * cs.x - xp * cs.y : xp * cs.y + xo * cs.x;
          }
          res[jj >> 1] = pack2(v2[0], v2[1]);
        }
        own = make_uint4(res[0], res[1], res[2], res[3]);
      }
      *(uint4*)(KS + key * LDT + kc * 8) = own;
      const unsigned vw[4] = {vv.x, vv.y, vv.z, vv.w};
#pragma unroll
      for (int jj = 0; jj < 8; jj++) VT[(kc * 8 + jj) * LDT + key] = (u16)((vw[jj >> 1] >> ((jj & 1) * 16)) & 0xffff);
    }
    __syncthreads();
    f32x4 sc[2][4];
#pragma unroll
    for (int mi = 0; mi < 2; mi++)
#pragma unroll
      for (int nj = 0; nj < 4; nj++) sc[mi][nj] = f32x4{0.f, 0.f, 0.f, 0.f};
#pragma unroll
    for (int ks = 0; ks < 2; ks++) {
      bf16x8 kf[4];
#pragma unroll
      for (int nj = 0; nj < 4; nj++) kf[nj] = *(const bf16x8*)(KS + (nj * 16 + fr) * LDT + ks * 32 + fq * 8);
#pragma unroll
      for (int mi = 0; mi < 2; mi++)
#pragma unroll
        for (int nj = 0; nj < 4; nj++) sc[mi][nj] = __builtin_amdgcn_mfma_f32_16x16x32_bf16(qf[mi][ks], kf[nj], sc[mi][nj], 0, 0, 0);
    }
#pragma unroll
    for (int mi = 0; mi < 2; mi++)
#pragma unroll
      for (int r = 0; r < 4; r++) {
        const int qpos = tb + mi * 16 + fq * 4 + r;
        float mx = -1e30f;
#pragma unroll
        for (int nj = 0; nj < 4; nj++) {
          float v = sc[mi][nj][r];
          if (band) {
            int d = qpos - (k0 + nj * 16 + fr);
            if (d > 128 || d < -128) v = -1e30f;
          }
          sc[mi][nj][r] = v;
          mx = fmaxf(mx, v);
        }
        mx = fmaxf(mx, __shfl_xor(mx, 1));
        mx = fmaxf(mx, __shfl_xor(mx, 2));
        mx = fmaxf(mx, __shfl_xor(mx, 4));
        mx = fmaxf(mx, __shfl_xor(mx, 8));
        const float mnew = fmaxf(mrow[mi][r], mx);
        const float alpha = __expf(mrow[mi][r] - mnew);
        mrow[mi][r] = mnew;
        float ls = 0.f;
#pragma unroll
        for (int nj = 0; nj < 4; nj++) {
          float pe = __expf(sc[mi][nj][r] - mnew);
          ls += pe;
          pl[(mi * 16 + fq * 4 + r) * LDT + nj * 16 + fr] = f2bf(pe);
        }
        lrow[mi][r] = lrow[mi][r] * alpha + ls;
#pragma unroll
        for (int nd = 0; nd < 4; nd++) oacc[mi][nd][r] *= alpha;
      }
    asm volatile("s_waitcnt lgkmcnt(0)" ::: "memory");
    __builtin_amdgcn_wave_barrier();
#pragma unroll
    for (int ks = 0; ks < 2; ks++) {
      bf16x8 pf[2], vf[4];
#pragma unroll
      for (int mi = 0; mi < 2; mi++) pf[mi] = *(const bf16x8*)(pl + (mi * 16 + fr) * LDT + ks * 32 + fq * 8);
#pragma unroll
      for (int nd = 0; nd < 4; nd++) vf[nd] = *(const bf16x8*)(VT + (nd * 16 + fr) * LDT + ks * 32 + fq * 8);
#pragma unroll
      for (int mi = 0; mi < 2; mi++)
#pragma unroll
        for (int nd = 0; nd < 4; nd++) oacc[mi][nd] = __builtin_amdgcn_mfma_f32_16x16x32_bf16(pf[mi], vf[nd], oacc[mi][nd], 0, 0, 0);
    }
    asm volatile("s_waitcnt lgkmcnt(0)" ::: "memory");
    __builtin_amdgcn_wave_barrier();
  }
  const float sink = p.attn_sink[l * 4 + qh];
#pragma unroll
  for (int mi = 0; mi < 2; mi++)
#pragma unroll
    for (int r = 0; r < 4; r++) {
      float ls = lrow[mi][r];
      ls += __shfl_xor(ls, 1);
      ls += __shfl_xor(ls, 2);
      ls += __shfl_xor(ls, 4);
      ls += __shfl_xor(ls, 8);
      ls += __expf(sink - mrow[mi][r]);
      const float inv = 1.f / ls;
      const int tq = tb + mi * 16 + fq * 4 + r;
#pragma unroll
      for (int nd = 0; nd < 4; nd++) Y[(size_t)(qrow0 + tq) * YST + 1536 + qh * 64 + nd * 16 + fr] = f2bf(oacc[mi][nd][r] * inv);
    }
}

#ifndef SCAN3_MASK
#define SCAN3_MASK 7
#endif
__device__ __forceinline__ void phase_mix(const Params& p, int l, unsigned char* smem) {
  float* sm = (float*)smem;
  const int G = gridDim.x;
  for (int it = blockIdx.x; it < 192; it += G) {
    const int mix = it >> 6, rem = it & 63, b = rem >> 3, h = (rem >> 1) & 3, dir = rem & 1;
    if (mix == 0 && (SCAN3_MASK & 1)) scan3_item<0>(p, l, b, h, dir, smem);
    else if (mix == 1 && (SCAN3_MASK & 2)) scan3_item<1>(p, l, b, h, dir, smem);
    else if (mix == 2 && (SCAN3_MASK & 4)) scan3_item<2>(p, l, b, h, dir, smem);
  }
  if (SCAN3_MASK != 7) {
    for (int it = blockIdx.x; it < 768; it += G) {
      const int mix = it >> 8, rem = it & 255, b = rem >> 5, h = (rem >> 3) & 3, dir = (rem >> 2) & 1, rq = rem & 3;
      if (mix == 0 && !(SCAN3_MASK & 1)) scan2_item<0>(p, l, b, h, dir, rq, sm);
      else if (mix == 1 && !(SCAN3_MASK & 2)) scan2_item<1>(p, l, b, h, dir, rq, sm);
      else if (mix == 2 && !(SCAN3_MASK & 4)) scan2_item<2>(p, l, b, h, dir, rq, sm);
    }
  }
  __syncthreads();
  {
    const bool spread = G >= 192;
    const int nconv = spread ? 64 : G, fidx = spread ? (int)blockIdx.x - 128 : (int)blockIdx.x;
    if (fidx >= 0 && fidx < nconv)
      for (int it = 832 + fidx; it < 4480; it += nconv) conv_item(p, l, it, (float*)smem);
    __syncthreads();
  }
  unsigned* ctr = (unsigned*)(p.ws + OFF_CTR) + l * 16;
  volatile int* slot = (volatile int*)(smem + 131072 - 16);
  for (;;) {
    if (TIDX == 0) *slot = (int)atomicAdd(ctr, 1u);
    __syncthreads();
    const int it = *slot;
    __syncthreads();
    if (it >= (l == 0 ? 544 : 512)) break;
    if (it < 512) {
      int b = it >> 6, qb = (it >> 1) & 31, hk = it & 1;
      attn_item(p, l, b, qb, hk, false, smem);
    } else {
      int r = it - 512, b = r >> 2, qb = (r >> 1) & 1, hk = r & 1;
      attn_item(p, l, b, qb, hk, true, smem);
    }
  }
}

#define POST_DECL(PFX) uint2 PFX##ya0, PFX##ya1, PFX##ya2, PFX##yc0, PFX##yc1, PFX##yc2, PFX##vp, PFX##vc, PFX##vn, PFX##gb, PFX##gc; \
  u16 PFX##xp, PFX##xc, PFX##xn; float2 PFX##bc
#define POST_LOAD(PFX, R_)                                                                         \
  do {                                                                                             \
    const int r_ = (R_);                                                                           \
    const int b_ = r_ / TPB, t_ = r_ - b_ * TPB;                                                   \
    const bool hp_ = (t_ != 0) && (t_ != LC), hn_ = (t_ != LC - 1) && (t_ != TPB - 1);            \
    const u16* ys_ = YSc + (size_t)r_ * YST;                                                       \
    const u16* pr_ = Pc + (size_t)r_ * PST;                                                        \
    const u16* pp_ = pr_ - (hp_ ? PST : 0);                                                        \
    const u16* pn_ = pr_ + (hn_ ? PST : 0);                                                        \
    PFX##ya0 = *(const uint2*)(ys_ + j0); PFX##ya1 = *(const uint2*)(ys_ + 256 + j0); PFX##ya2 = *(const uint2*)(ys_ + 512 + j0); \
    PFX##yc0 = *(const uint2*)(ys_ + 768 + j0); PFX##yc1 = *(const uint2*)(ys_ + 1024 + j0); PFX##yc2 = *(const uint2*)(ys_ + 1280 + j0); \
    PFX##vp = *(const uint2*)(pp_ + PA + 512 + j0);                                                \
    PFX##vc = *(const uint2*)(pr_ + PA + 512 + j0);                                                \
    PFX##vn = *(const uint2*)(pn_ + PA + 512 + j0);                                                \
    PFX##gb = *(const uint2*)(pr_ + PB + 784 + j0);                                                \
    PFX##gc = *(const uint2*)(pr_ + PC + 544 + j0);                                                \
    PFX##xp = pp_[PA + 896 + lane]; PFX##xc = pr_[PA + 896 + lane]; PFX##xn = pn_[PA + 896 + lane]; \
    PFX##bc = *(const float2*)(BCc + (size_t)r_ * 8 + (lane >> 4) * 2);                            \
  } while (0)
__device__ __forceinline__ void unpack4(uint2 v, float (&o)[4]) {
  o[0] = __uint_as_float(v.x << 16); o[1] = __uint_as_float(v.x & 0xffff0000u);
  o[2] = __uint_as_float(v.y << 16); o[3] = __uint_as_float(v.y & 0xffff0000u);
}

__device__ __forceinline__ void phase_post(const Params& p, int l, float* g2s) {
  const int lane = TIDX & 63, wv = __builtin_amdgcn_readfirstlane(TIDX >> 6);
  u16* YS = (u16*)(p.ws + OFF_YS);
  const int j0 = lane * 4;
  {
    const float4* src = (const float4*)(p.rwkv_g2 + (size_t)l * 64 * 256);
    for (int i = TIDX; i < 64 * 256 / 4; i += NTHR) ((float4*)g2s)[i] = src[i];
  }
  float mu_v[4], lng[4], lnb[4], ngb[4], ngc[4];
#pragma unroll
  for (int i = 0; i < 4; i++) {
    mu_v[i] = p.rwkv_mu[l * 960 + 512 + j0 + i];
    lng[i] = p.rwkv_ln_g[l * 256 + j0 + i];
    lnb[i] = p.rwkv_ln_b[l * 256 + j0 + i];
    ngb[i] = p.gdn_norm_g[l * 64 + (lane & 15) * 4 + i];
    ngc[i] = p.gla_norm_g[l * 64 + (lane & 15) * 4 + i];
  }
  const float mu_x = p.rwkv_mu[l * 960 + 896 + lane];
  __syncthreads();
  const int stride = gridDim.x * 8;
  int r = blockIdx.x * 8 + wv;
  const u16* Pc = (const u16*)(p.ws + OFF_BIG);
  const u16* YSc = (const u16*)(p.ws + OFF_YS);
  const float* BCc = (const float*)(p.ws + OFF_BC);
  POST_DECL(cur_);
  POST_DECL(nxt_);
  POST_LOAD(cur_, r);
  for (; r < NROWS; r += stride) {
    const int rn = r + stride < NROWS ? r + stride : r;
    POST_LOAD(nxt_, rn);
    const int b = r / TPB, t = r - b * TPB;
    const float pmul = ((t != 0) && (t != LC)) ? 1.f : 0.f, nmul = ((t != LC - 1) && (t != TPB - 1)) ? 1.f : 0.f;
    if (!(l == 1 && t < LC)) {
    float y[3][4];
    {
      float a4[4], c4[4];
      unpack4(cur_ya0, a4); unpack4(cur_yc0, c4);
#pragma unroll
      for (int i = 0; i < 4; i++) y[0][i] = a4[i] + c4[i];
      unpack4(cur_ya1, a4); unpack4(cur_yc1, c4);
#pragma unroll
      for (int i = 0; i < 4; i++) y[1][i] = a4[i] + c4[i];
      unpack4(cur_ya2, a4); unpack4(cur_yc2, c4);
#pragma unroll
      for (int i = 0; i < 4; i++) y[2][i] = a4[i] + c4[i];
    }
    float o[3][4];
    {
      float sum = y[0][0] + y[0][1] + y[0][2] + y[0][3];
      sum = red16(sum);
      const float mean = sum * (1.f / 64.f);
      float vs = 0.f;
#pragma unroll
      for (int i = 0; i < 4; i++) { float d = y[0][i] - mean; vs += d * d; }
      vs = red16(vs);
      const float rstd = rsq(vs * (1.f / 64.f) + 64e-5f);
      const float pv = bf2f(cur_xc), ppv = bf2f(cur_xp) * pmul, pnv = bf2f(cur_xn) * nmul;
      const float sg = sigm(pv + (0.5f * (ppv + pnv) - pv) * mu_x);
      float gate[4] = {0.f, 0.f, 0.f, 0.f};
      const float* g2 = g2s + j0;
#pragma unroll 8
      for (int i = 0; i < 64; i++) {
        const float si = __int_as_float(__builtin_amdgcn_readlane(__float_as_int(sg), i));
        const float4 gw = *(const float4*)(g2 + i * 256);
        gate[0] += si * gw.x; gate[1] += si * gw.y; gate[2] += si * gw.z; gate[3] += si * gw.w;
      }
      const float bcs = cur_bc.x + cur_bc.y;
      float vc4[4], vp4[4], vn4[4];
      unpack4(cur_vc, vc4); unpack4(cur_vp, vp4); unpack4(cur_vn, vn4);
#pragma unroll
      for (int i = 0; i < 4; i++) {
        const float v = vc4[i] + (0.5f * (vp4[i] * pmul + vn4[i] * nmul) - vc4[i]) * mu_v[i];
        const float yn = (y[0][i] - mean) * rstd * lng[i] + lnb[i];
        o[0][i] = (yn + bcs * v) * gate[i];
      }
    }
#pragma unroll
    for (int m = 1; m < 3; m++) {
      float ss = y[m][0] * y[m][0] + y[m][1] * y[m][1] + y[m][2] * y[m][2] + y[m][3] * y[m][3];
      ss = red16(ss);
      const float inv = rsq(ss * (1.f / 64.f) + 1e-6f);
      float g4[4];
      unpack4(m == 1 ? cur_gb : cur_gc, g4);
#pragma unroll
      for (int i = 0; i < 4; i++) o[m][i] = y[m][i] * inv * (m == 1 ? ngb[i] : ngc[i]) * siluf(g4[i]);
    }
    u16* ys = YS + (size_t)r * YST;
#pragma unroll
    for (int m = 0; m < 3; m++) {
      uint2 ov;
      ov.x = pack2(o[m][0], o[m][1]);
      ov.y = pack2(o[m][2], o[m][3]);
      *(uint2*)(ys + m * 256 + j0) = ov;
    }
    }
    cur_ya0 = nxt_ya0; cur_ya1 = nxt_ya1; cur_ya2 = nxt_ya2; cur_yc0 = nxt_yc0; cur_yc1 = nxt_yc1; cur_yc2 = nxt_yc2;
    cur_vp = nxt_vp; cur_vc = nxt_vc; cur_vn = nxt_vn; cur_gb = nxt_gb; cur_gc = nxt_gc;
    cur_xp = nxt_xp; cur_xc = nxt_xc; cur_xn = nxt_xn; cur_bc = nxt_bc;
  }
}

#define XB_TMO      128
#define XB_XCNT(j)  (256  + 64 * (j))
#define XB_XSUB(j)  (1280 + 64 * (j))
#define XB_XGEN(j)  (2304 + 64 * (j))
#define XB_TOP      3328
#define XB_TOPGEN   3392
#define XCD_BAR_WORDS 3456
#define XB_SPIN_CAP (1u << 18)
#define LAS __attribute__((address_space(3)))

__device__ __forceinline__ unsigned xb_ld(unsigned* p)              { return __hip_atomic_load(p, __ATOMIC_RELAXED, __HIP_MEMORY_SCOPE_AGENT); }
__device__ __forceinline__ unsigned xb_add(unsigned* p, unsigned v) { return __hip_atomic_fetch_add(p, v, __ATOMIC_RELAXED, __HIP_MEMORY_SCOPE_AGENT); }
__device__ __forceinline__ unsigned xb_xcc_id() { return (unsigned)__builtin_amdgcn_s_getreg((3 << 11) | 20) & 0xFu; }
#define XB_SPIN(cond, bar) do { unsigned _sp = 0; while (cond) { __builtin_amdgcn_s_sleep(1); \
    if ((++_sp & 255u) == 0u) { if (xb_ld(&(bar)[XB_TMO])) break; if (_sp > XB_SPIN_CAP) { atomicAdd(&(bar)[XB_TMO], 1u); break; } } } } while (0)

struct XcdBarrier {
    unsigned* bar; unsigned x;
    volatile LAS unsigned* st;
};

__device__ __forceinline__ XcdBarrier xcd_barrier_post(unsigned* bar, volatile LAS unsigned* st) {
    XcdBarrier b; b.bar = bar; b.x = xb_xcc_id(); b.st = st;
    if (threadIdx.x == 0) (void)xb_add(&bar[XB_XCNT(b.x)], 1u);
    return b;
}
__device__ __forceinline__ void xcd_barrier_complete(unsigned* bar, unsigned x, unsigned& nloc, unsigned& nx) {
    const unsigned G = gridDim.x * gridDim.y * gridDim.z;
    unsigned sum, cnt, mine, sp = 0u;
    for (;;) {
        sum = 0u; cnt = 0u; mine = 0u;
#pragma unroll
        for (unsigned j = 0; j < 16; ++j) { const unsigned c = xb_ld(&bar[XB_XCNT(j)]); sum += c; cnt += (c > 0u) ? 1u : 0u; mine = (j == x) ? c : mine; }
        if (sum == G) break;
        __builtin_amdgcn_s_sleep(1);
        if ((++sp & 255u) == 0u) { if (xb_ld(&bar[XB_TMO])) break; if (sp > XB_SPIN_CAP) { atomicAdd(&bar[XB_TMO], 1u); break; } }
    }
    nloc = mine > 0u ? mine : 1u; nx = cnt > 0u ? cnt : 1u;
}

__device__ __forceinline__ void xcd_barrier(const XcdBarrier& b) {
    asm volatile("s_waitcnt vmcnt(0)" ::: "memory");
    __syncthreads();
    if (threadIdx.x == 0) {
        unsigned* bar = b.bar;
        __builtin_amdgcn_s_waitcnt(0);
        unsigned nloc = b.st[0], nx = b.st[1];
        if (nloc == 0u) { xcd_barrier_complete(bar, b.x, nloc, nx); b.st[0] = nloc; b.st[1] = nx; }
        const unsigned old = xb_add(&bar[XB_XSUB(b.x)], 1u);
        const unsigned gen = old / nloc;
        if (old + 1u == (gen + 1u) * nloc) {
            __builtin_amdgcn_fence(__ATOMIC_RELEASE, "agent");
            asm volatile("s_waitcnt vmcnt(0)" ::: "memory");
            const unsigned og = xb_add(&bar[XB_TOP], 1u);
            const unsigned tg = og / nx;
            if (og + 1u == (tg + 1u) * nx) xb_add(&bar[XB_TOPGEN], 1u);
            else XB_SPIN(xb_ld(&bar[XB_TOPGEN]) == tg, bar);
            __builtin_amdgcn_fence(__ATOMIC_ACQUIRE, "agent");
            xb_add(&bar[XB_XGEN(b.x)], 1u);
            asm volatile("s_waitcnt vmcnt(0)" ::: "memory");
        } else {
            XB_SPIN(xb_ld(&bar[XB_XGEN(b.x)]) == gen, bar);
            __builtin_amdgcn_fence(__ATOMIC_ACQUIRE, "agent");
            asm volatile("s_waitcnt vmcnt(0)" ::: "memory");
        }
    }
    __syncthreads();
}

#if defined(SKIPS)
#define EN(k) (SKIPS != (k))
#elif !defined(ONLYS)
#define EN(k) 1
#else
#define EN(k) (ONLYS == (k))
#endif
__device__ __forceinline__ void run_phase(const Params& p, int ph, unsigned char* smem) {
  if (ph == 0) { if (EN(10)) phase_init0(p, (float*)smem); return; }
  if (ph == 1) { if (EN(11)) phase_init1(p); return; }
  int l = 0, s = 10;
  if (ph >= 3) { l = (ph - 3) / 10; s = (ph - 3) - l * 10; }
  unsigned char* wl = p.ws + OFF_W;
  PG8_LAS unsigned char* lds = (PG8_LAS unsigned char*)smem;
  pg8::StaticOrder S;
  if (s == 10 || s == 6 || s == 9) {
    if (EN(5)) rowpass(p, l, s == 10 ? 0 : (s == 6 ? 1 : 2));
    if (s == 9 && l == 0) {
      __syncthreads();
      for (int it = blockIdx.x; it < 832; it += gridDim.x) conv_item(p, 1, it, (float*)smem);
    }
  } else if (s == 0 || s == 3 || s == 5 || s == 8) {
    pg8::Gemm g; EpiBf E;
    g.M = NROWS; E.bias = nullptr; E.act = 0;
    if (s == 0) { g.A = (const u16*)(p.ws + OFF_H); g.lda = DM; g.Bt = (const u16*)(wl + OW_IN); g.K = DM; g.N = PST; E.O = (u16*)(p.ws + OFF_BIG); E.ldc = PST; }
    else if (s == 3) {
      g.A = (const u16*)(p.ws + OFF_H); g.lda = DM; g.Bt = (const u16*)(wl + OW_G); g.K = DM; g.N = 4096;
      E.O = (u16*)(p.ws + OFF_BIG); E.ldc = 4096; E.bias = p.gate_b + (size_t)l * 4096; E.act = 1;
    }
    else if (s == 5) { g.A = (const u16*)(p.ws + OFF_H); g.lda = DM; g.Bt = (const u16*)(wl + OW_O); g.K = DM; g.N = DM; E.O = (u16*)(p.ws + OFF_BIG); E.ldc = DM; }
    else { g.A = (const u16*)(p.ws + OFF_BIG); g.lda = FH; g.Bt = (const u16*)(wl + OW_2); g.K = FH; g.N = DM; E.O = (u16*)(p.ws + OFF_YS); E.ldc = DM; }
    if (l == 1 && s != 0) S.init(NBATCH * SEQ, g.N, gridDim.x, blockIdx.x, 1);
    else S.init(g.M, g.N, gridDim.x, blockIdx.x);
    if (EN(0)) pg8::gemm_phase<EpiBf, pg8::StaticOrder, false>(lds, g, S, E, nullptr);
  } else if (s == 4) {
    if (EN(3)) phase_ypart(p, l, smem);
  } else if (s == 1) {
    if (EN(1)) phase_mix(p, l, smem);
  } else if (s == 2) {
    if (EN(2)) phase_post(p, l, (float*)smem);
  } else {
    pg8::Gemm g; EpiSwiglu E;
    g.M = NROWS; g.N = 2 * FH; g.K = DM; g.lda = DM; g.A = (const u16*)(p.ws + OFF_H); g.Bt = (const u16*)(wl + OW_1);
    E.O = (u16*)(p.ws + OFF_BIG);
    if (l == 1) S.init(NBATCH * SEQ, g.N, gridDim.x, blockIdx.x, 1);
    else S.init(g.M, g.N, gridDim.x, blockIdx.x);
    if (EN(6)) pg8::gemm_phase<EpiSwiglu, pg8::StaticOrder, false>(lds, g, S, E, nullptr);
  }
}

__global__ void __launch_bounds__(NTHR) hybrid_flow_mega(Params p, int ph0, int ph1) {
  __shared__ __attribute__((aligned(16))) unsigned char smem[131072];
  __shared__ __attribute__((aligned(16))) unsigned xbw[4];
  cg::grid_group grid = cg::this_grid();
  XcdBarrier xb;
  xb.bar = (unsigned*)(p.ws + OFF_XBAR); xb.x = 0u; xb.st = (volatile LAS unsigned*)xbw;
  for (int ph = ph0; ph < ph1; ph++) {
    run_phase(p, ph, smem);
#ifdef DUPMASK
    {
      int sidx = ph >= 3 ? (ph - 3) % 10 : 12 + ph;
      if ((DUPMASK >> sidx) & 1) { __syncthreads(); run_phase(p, ph, smem); }
    }
#endif
    if (ph + 1 < ph1) {
      if (ph == ph0) {
        grid.sync();
        if (threadIdx.x < 4) xbw[threadIdx.x] = 0u;
        __syncthreads();
        xb = xcd_barrier_post((unsigned*)(p.ws + OFF_XBAR), (volatile LAS unsigned*)xbw);
      } else {
        xcd_barrier(xb);
      }
    }
  }
  if (ph1 - ph0 > 2 && threadIdx.x == 0 && xb_ld(&xb.bar[XB_TMO]) != 0u) p.out[blockIdx.x] = __int_as_float(0x7fc00000);
}

extern "C" void kernel_launch(void* const* d_in, const int* in_sizes, int n_in, void* d_out, int out_size, void* d_ws,
                              size_t ws_size, hipStream_t stream) {
  Params p{};
  const float** pp = (const float**)&p;
  for (int i = 0; i < 32; i++) pp[i] = (const float*)d_in[i];
  p.out = (float*)d_out;
  p.ws = (unsigned char*)d_ws;
  static int grid_blocks = 0;
  if (!grid_blocks) {
    int dev = 0, cus = 0, per_cu = 0;
    hipGetDevice(&dev);
    hipDeviceGetAttribute(&cus, hipDeviceAttributeMultiprocessorCount, dev);
    hipOccupancyMaxActiveBlocksPerMultiprocessor(&per_cu, hybrid_flow_mega, NTHR, 0);
    if (per_cu < 1) per_cu = 1;
    grid_blocks = cus * per_cu;
  }
#ifdef MULTI_LAUNCH
  for (int ph = 0; ph < NPHASE; ph++) {
    hipLaunchKernelGGL(hybrid_flow_mega, dim3(grid_blocks), dim3(NTHR), 0, stream, p, ph, ph + 1);
  }
#else
  int ph0 = 0, ph1 = NPHASE;
  void* args[] = {&p, &ph0, &ph1};
  hipError_t e = hipLaunchCooperativeKernel((void*)hybrid_flow_mega, dim3(grid_blocks), dim3(NTHR), args, 0, stream);
  if (e != hipSuccess) fprintf(stderr, "cooperative launch failed: %s (grid %d)\n", hipGetErrorString(e), grid_blocks);
#endif
}
```

```cpp
#include <hip/hip_runtime.h>
#include <hip/hip_cooperative_groups.h>
#include <cstdio>
namespace cg = cooperative_groups;

typedef unsigned short u16;
using bf16x8 = __attribute__((ext_vector_type(8))) short;
using f32x4 = __attribute__((ext_vector_type(4))) float;

#define DM 1024
#define NBATCH 8
#define SEQ 4096
#define LC 256
#define TPB 4352
#define NROWS 34816
#define PST 3328
#define YST 1792
#define FH 2816
#define INW 7408
#define NTHR 512
#define PA 0
#define PB 960
#define PC 2000
#define PD 2800
#define NPHASE 23
#define SCAN3_MASK 7

struct Params {
  const float *x, *c, *ctx, *c_ctx, *ada_w, *ada_b, *norm_g, *w_in, *gate_b, *w_branch, *w_out,
      *rwkv_mu, *rwkv_w0, *rwkv_w2, *rwkv_a0, *rwkv_a2, *rwkv_g2, *rwkv_kk, *rwkv_ka, *rwkv_rk, *rwkv_ln_g,
      *rwkv_ln_b, *gdn_conv, *gdn_a_log, *gdn_dt_bias, *gdn_norm_g, *gla_gw2, *gla_gb, *gla_norm_g, *attn_sink,
      *ffn_w1, *ffn_w2;
  float* out;
  unsigned char* ws;
};

constexpr size_t SZ_WL = 36700160;
constexpr size_t OW_IN = 0;
constexpr size_t OW_G = OW_IN + (size_t)PST * 1024 * 2;
constexpr size_t OW_B = OW_G + (size_t)4096 * 1024 * 2;
constexpr size_t OW_O = OW_B + (size_t)4 * 1024 * 256 * 2;
constexpr size_t OW_1 = OW_O + (size_t)1024 * 1024 * 2;
constexpr size_t OW_2 = OW_1 + (size_t)5632 * 1024 * 2;
static_assert(OW_2 + (size_t)1024 * FH * 2 == SZ_WL, "weights size");
constexpr size_t SZ_ACT = (size_t)NROWS * DM * 2;
constexpr size_t OFF_W = 0;
constexpr size_t OFF_XC = OFF_W + SZ_WL;
constexpr size_t OFF_MODP = OFF_XC + (size_t)NBATCH * LC * DM * 4;
constexpr size_t OFF_MOD = OFF_MODP + (size_t)2 * 8 * 9 * 6144 * 4;
constexpr size_t OFF_BC = OFF_MOD + (size_t)2 * 9 * 6144 * 4;
constexpr size_t OFF_H = OFF_BC + (size_t)NROWS * 8 * 4;
constexpr size_t OFF_YS = OFF_H + SZ_ACT;
constexpr size_t OFF_BIG = OFF_YS + (size_t)NROWS * YST * 2;
constexpr size_t OFF_CTR = OFF_BIG + (size_t)NROWS * 4096 * 2;
constexpr size_t OFF_XBAR = OFF_CTR + 256;
constexpr size_t WS_END = OFF_XBAR + 3456 * 4;
static_assert(WS_END <= (size_t)536870912, "ws too large");

__device__ __forceinline__ int launder_tid() { int t = threadIdx.x; asm volatile("" : "+v"(t)); return t; }
#define TIDX (launder_tid())
typedef float f32x2_t __attribute__((ext_vector_type(2)));
typedef __bf16 bf16x2_t __attribute__((ext_vector_type(2)));
__device__ __forceinline__ unsigned pack2(float a, float b) {
  const f32x2_t v = {a, b};
  const bf16x2_t r = __builtin_convertvector(v, bf16x2_t);
  return __builtin_bit_cast(unsigned, r);
}
__device__ __forceinline__ u16 f2bf(float f) { return (u16)(pack2(f, 0.f) & 0xffffu); }
__device__ __forceinline__ float bf2f(u16 h) { return __uint_as_float(((unsigned)h) << 16); }
__device__ __forceinline__ float sigm(float x) { return __builtin_amdgcn_rcpf(1.f + __expf(-x)); }
__device__ __forceinline__ float siluf(float x) { return x * __builtin_amdgcn_rcpf(1.f + __expf(-x)); }
__device__ __forceinline__ float rsq(float x) { return __builtin_amdgcn_rsqf(x); }
__device__ __forceinline__ float softplusf(float x) { return fmaxf(x, 0.f) + __logf(1.f + __expf(-fabsf(x))); }
__device__ __forceinline__ float tanh_fast(float x) { return 1.f - 2.f * __builtin_amdgcn_rcpf(1.f + __expf(2.f * x)); }
__device__ __forceinline__ float wsum(float v) {
#pragma unroll
  for (int o = 32; o > 0; o >>= 1) v += __shfl_xor(v, o);
  return v;
}
template <int CTRL>
__device__ __forceinline__ float dppf(float x) {
  return __int_as_float(__builtin_amdgcn_update_dpp(__float_as_int(x), __float_as_int(x), CTRL, 0xf, 0xf, false));
}
__device__ __forceinline__ float red8(float x) {
  x += dppf<0xB1>(x);
  x += dppf<0x4E>(x);
  x += dppf<0x141>(x);
  return x;
}
__device__ __forceinline__ const float* xin_row(const Params& p, int r) {
  int b = r / TPB, t = r - b * TPB;
  return t < LC ? p.ctx + ((size_t)(b * LC + t)) * DM : p.x + ((size_t)(b * SEQ + t - LC)) * DM;
}
__device__ __forceinline__ float* x_row(const Params& p, int r) {
  int b = r / TPB, t = r - b * TPB;
  return t < LC ? (float*)(p.ws + OFF_XC) + ((size_t)(b * LC + t)) * DM : p.out + ((size_t)(b * SEQ + t - LC)) * DM;
}
__device__ __forceinline__ int mod_row(int r) {
  int b = r / TPB, t = r - b * TPB;
  return t < LC ? 8 : b;
}

struct MapId { int lim, off; __device__ int operator()(int n) const { return n < lim ? n + off : -1; } };
struct MapW1 { __device__ int operator()(int n) const { int q = n >> 3, s = n & 7; return s < 4 ? q * 4 + s : FH + q * 4 + (s - 4); } };

template <class Map>
__device__ __forceinline__ void conv_tile(const float* __restrict__ src, int ld, u16* __restrict__ dst, int K, int n0,
                                          int k0, Map map, float* tile) {
  const int tid = TIDX;
  const int nn = tid & 63, kr = tid >> 6;
  const int sc = map(n0 + nn);
  float tv[8];
  const int scc = sc >= 0 ? sc : 0;
  const float scm = sc >= 0 ? 1.f : 0.f;
#pragma unroll
  for (int ps = 0; ps < 8; ps++) tv[ps] = src[(size_t)(k0 + ps * 8 + kr) * ld + scc];
#pragma unroll
  for (int ps = 0; ps < 8; ps++) tile[(ps * 8 + kr) * 65 + nn] = tv[ps] * scm;
  __syncthreads();
  const int n2 = tid >> 3, kc = tid & 7;
  uint4 o;
  o.x = pack2(tile[(kc * 8 + 0) * 65 + n2], tile[(kc * 8 + 1) * 65 + n2]);
  o.y = pack2(tile[(kc * 8 + 2) * 65 + n2], tile[(kc * 8 + 3) * 65 + n2]);
  o.z = pack2(tile[(kc * 8 + 4) * 65 + n2], tile[(kc * 8 + 5) * 65 + n2]);
  o.w = pack2(tile[(kc * 8 + 6) * 65 + n2], tile[(kc * 8 + 7) * 65 + n2]);
  *(uint4*)(dst + (size_t)(n0 + n2) * K + k0 + kc * 8) = o;
  __syncthreads();
}

__device__ __forceinline__ void conv_item(const Params& p, int l, int rem, float* sm) {
      u16* wl = (u16*)(p.ws + OFF_W);
      if (rem < 832) {
        int nt = rem >> 4, kt = rem & 15;
        conv_tile(p.w_in + (size_t)l * DM * INW, INW, (u16*)((char*)wl + OW_IN), 1024, nt * 64, kt * 64, MapId{3312, 0}, sm);
      } else if (rem < 832 + 1024) {
        rem -= 832;
        int nt = rem >> 4, kt = rem & 15;
        conv_tile(p.w_in + (size_t)l * DM * INW, INW, (u16*)((char*)wl + OW_G), 1024, nt * 64, kt * 64, MapId{4096, 3312}, sm);
      } else if (rem < 1856 + 256) {
        rem -= 1856;
        int br = rem >> 6, r2 = rem & 63, nt = r2 >> 2, kt = r2 & 3;
        conv_tile(p.w_branch + ((size_t)(l * 4 + br)) * 256 * DM, DM, (u16*)((char*)wl + OW_B) + (size_t)br * 1024 * 256, 256,
                  nt * 64, kt * 64, MapId{1024, 0}, sm);
      } else if (rem < 2112 + 256) {
        rem -= 2112;
        int nt = rem >> 4, kt = rem & 15;
        conv_tile(p.w_out + (size_t)l * DM * DM, DM, (u16*)((char*)wl + OW_O), 1024, nt * 64, kt * 64, MapId{1024, 0}, sm);
      } else if (rem < 2368 + 1408) {
        rem -= 2368;
        int nt = rem >> 4, kt = rem & 15;
        conv_tile(p.ffn_w1 + (size_t)l * DM * 5632, 5632, (u16*)((char*)wl + OW_1), 1024, nt * 64, kt * 64, MapW1{}, sm);
      } else {
        rem -= 3776;
        int nt = rem / 44, kt = rem - nt * 44;
        conv_tile(p.ffn_w2 + (size_t)l * FH * DM, DM, (u16*)((char*)wl + OW_2), FH, nt * 64, kt * 64, MapId{1024, 0}, sm);
      }
}

__device__ __forceinline__ void phase_init0(const Params& p, float* sm) {
  const int tid = TIDX;
  if (blockIdx.x == 0) {
    if (tid < 64) ((unsigned*)(p.ws + OFF_CTR))[tid] = 0u;
    for (int i = tid; i < 3456; i += NTHR) ((unsigned*)(p.ws + OFF_XBAR))[i] = 0u;
  }
  constexpr int NMOD = 192, NCONV = 832;
  for (int it = blockIdx.x; it < NMOD + NCONV; it += gridDim.x) {
    if (it < NMOD) {
      int l = it / 96, rem = it - l * 96, cc = rem >> 3, ks = rem & 7;
      for (int i = tid; i < 9 * 128; i += NTHR) {
        int r = i >> 7, k = i & 127;
        float v = r < 8 ? p.c[r * DM + ks * 128 + k] : p.c_ctx[ks * 128 + k];
        sm[i] = siluf(v);
      }
      __syncthreads();
      const int n = cc * 512 + tid;
      const float* w = p.ada_w + ((size_t)l * DM + ks * 128) * 6144 + n;
      float acc[9];
#pragma unroll
      for (int r = 0; r < 9; r++) acc[r] = 0.f;
#pragma unroll 1
      for (int k0 = 0; k0 < 128; k0 += 16) {
        float wv[16];
#pragma unroll
        for (int kk = 0; kk < 16; kk++) wv[kk] = w[(size_t)(k0 + kk) * 6144];
#pragma unroll
        for (int kk = 0; kk < 16; kk++)
#pragma unroll
          for (int r = 0; r < 9; r++) acc[r] += sm[r * 128 + k0 + kk] * wv[kk];
      }
      float* mp = (float*)(p.ws + OFF_MODP) + ((size_t)(l * 8 + ks) * 9) * 6144 + n;
#pragma unroll
      for (int r = 0; r < 9; r++) mp[(size_t)r * 6144] = acc[r];
      __syncthreads();
    } else {
      conv_item(p, 0, it - NMOD, sm);
    }
  }
}

__device__ __forceinline__ void phase_init1(const Params& p) {
  const float* mp = (const float*)(p.ws + OFF_MODP);
  float* mo = (float*)(p.ws + OFF_MOD);
  for (int i = blockIdx.x * NTHR + TIDX; i < 2 * 9 * 6144; i += gridDim.x * NTHR) {
    int l = i / (9 * 6144), rem = i - l * 9 * 6144, r = rem / 6144, n = rem - r * 6144;
    float s = p.ada_b[l * 6144 + n];
#pragma unroll
    for (int ks = 0; ks < 8; ks++) s += mp[((size_t)((l * 8 + ks) * 9 + r)) * 6144 + n];
    mo[i] = s;
  }
}

__device__ __forceinline__ void rowpass(const Params& p, int l, int mode) {
  const int lane = TIDX & 63, wv = __builtin_amdgcn_readfirstlane(TIDX >> 6);
  const float* MOD = (const float*)(p.ws + OFF_MOD);
  u16* H = (u16*)(p.ws + OFF_H);
  const bool do_norm = !(mode == 2 && l == 1);
  const int ln = (mode == 2) ? (l == 1 ? l : l + 1) : l;
  const int ni = (mode == 1) ? 2 : 0, sho = (mode == 1) ? 3072 : 0, sco = (mode == 1) ? 4096 : 1024;
  for (int r = blockIdx.x * 8 + wv; r < NROWS; r += gridDim.x * 8) {
    const int mr = mod_row(r);
    if (l == 1 && mode != 0 && mr == 8) continue;
    const float* modl = MOD + ((size_t)(l * 9 + mr)) * 6144;
    const float* modn = MOD + ((size_t)(ln * 9 + mr)) * 6144;
    const float* ng2 = p.norm_g + (size_t)(ln * 4 + ni) * DM;
    const float* xs = (mode == 0 || (mode == 1 && l == 0)) ? xin_row(p, r) : (const float*)x_row(p, r);
    float4 xo[4], n2[4], sc4[4], sh4[4];
#pragma unroll
    for (int i = 0; i < 4; i++) {
      const int col = i * 256 + lane * 4;
      xo[i] = *(const float4*)(xs + col);
      n2[i] = *(const float4*)(ng2 + col);
      sc4[i] = *(const float4*)(modn + sco + col);
      sh4[i] = *(const float4*)(modn + sho + col);
    }
    float xv[16];
    if (mode == 0) {
#pragma unroll
      for (int i = 0; i < 4; i++) { xv[i * 4 + 0] = xo[i].x; xv[i * 4 + 1] = xo[i].y; xv[i * 4 + 2] = xo[i].z; xv[i * 4 + 3] = xo[i].w; }
    } else {
      const u16* src = (const u16*)(p.ws + (mode == 1 ? OFF_BIG : OFF_YS)) + (size_t)r * DM;
      const float* ng = p.norm_g + (size_t)(l * 4 + (mode == 1 ? 1 : 3)) * DM;
      const float* gt = modl + (mode == 1 ? 2048 : 5120);
      uint2 sv[4];
      float4 g4[4], n4[4];
#pragma unroll
      for (int i = 0; i < 4; i++) {
        const int col = i * 256 + lane * 4;
        sv[i] = *(const uint2*)(src + col);
        g4[i] = *(const float4*)(gt + col);
        n4[i] = *(const float4*)(ng + col);
      }
      float ov[16];
      float ss = 0.f;
#pragma unroll
      for (int i = 0; i < 4; i++) {
        ov[i * 4 + 0] = __uint_as_float(sv[i].x << 16); ov[i * 4 + 1] = __uint_as_float(sv[i].x & 0xffff0000u);
        ov[i * 4 + 2] = __uint_as_float(sv[i].y << 16); ov[i * 4 + 3] = __uint_as_float(sv[i].y & 0xffff0000u);
      }
#pragma unroll
      for (int i = 0; i < 16; i++) ss += ov[i] * ov[i];
      ss = wsum(ss);
      const float inv = rsq(ss * (1.f / 1024.f) + 1e-6f);
      float* xd = x_row(p, r);
#pragma unroll
      for (int i = 0; i < 4; i++) {
        xv[i * 4 + 0] = xo[i].x + g4[i].x * (ov[i * 4 + 0] * inv * n4[i].x);
        xv[i * 4 + 1] = xo[i].y + g4[i].y * (ov[i * 4 + 1] * inv * n4[i].y);
        xv[i * 4 + 2] = xo[i].z + g4[i].z * (ov[i * 4 + 2] * inv * n4[i].z);
        xv[i * 4 + 3] = xo[i].w + g4[i].w * (ov[i * 4 + 3] * inv * n4[i].w);
      }
#pragma unroll
      for (int i = 0; i < 4; i++)
        *(float4*)(xd + i * 256 + lane * 4) = make_float4(xv[i * 4 + 0], xv[i * 4 + 1], xv[i * 4 + 2], xv[i * 4 + 3]);
    }
    if (!do_norm) continue;
    float ss2 = 0.f;
#pragma unroll
    for (int i = 0; i < 16; i++) ss2 += xv[i] * xv[i];
    ss2 = wsum(ss2);
    const float inv2 = rsq(ss2 * (1.f / 1024.f) + 1e-6f);
#pragma unroll
    for (int i = 0; i < 4; i++) {
      const int col = i * 256 + lane * 4;
      float h0 = xv[i * 4 + 0] * inv2 * n2[i].x * (1.f + sc4[i].x) + sh4[i].x;
      float h1 = xv[i * 4 + 1] * inv2 * n2[i].y * (1.f + sc4[i].y) + sh4[i].y;
      float h2 = xv[i * 4 + 2] * inv2 * n2[i].z * (1.f + sc4[i].z) + sh4[i].z;
      float h3 = xv[i * 4 + 3] * inv2 * n2[i].w * (1.f + sc4[i].w) + sh4[i].w;
      uint2 o;
      o.x = pack2(h0, h1);
      o.y = pack2(h2, h3);
      *(uint2*)(H + (size_t)r * DM + col) = o;
    }
  }
}

#define LDT 72
namespace pg8 {
#define PG8_LAS __attribute__((address_space(3)))
typedef unsigned short bf16_t;
typedef short bf16x8 __attribute__((ext_vector_type(8)));
typedef float f32x4 __attribute__((ext_vector_type(4)));
typedef unsigned u32x4 __attribute__((ext_vector_type(4)));
constexpr int BM = 256, BK = 64, HALF = 128, HTB = HALF * BK * 2  , STAGE_BYTES = 8 * HTB, NXCD = 8, WGM = 4;

__host__ __device__ __forceinline__ int lds_byte(int r, int c) { const int st = (r >> 4) * 2 + (c >> 5), rr = r & 15, cc = c & 31, ob = rr * 64 + cc * 2; return st * 1024 + (ob ^ (((ob >> 9) & 1) << 5)); }
__host__ __device__ __forceinline__ void stage_rc(int b, int& R, int& C) { const int st = b / 1024, sb = b % 1024, swz = sb ^ (((sb >> 9) & 1) << 5); R = (st >> 1) * 16 + swz / 64; C = (st & 1) * 32 + (swz % 64) / 2; }
__host__ __device__ __forceinline__ int perm32(int rho) { const int n = rho >> 4, i = rho & 15; return 8 * (i >> 2) + 4 * n + (i & 3); }

struct Unit { int pm, pn; };
struct Gemm { const bf16_t* A; const bf16_t* Bt; int M, N, K, lda; };
struct StaticOrder {
    int nM, nN, nwg, G, c, skip;
    __host__ __device__ void init(int M, int N, int G_, int c_, int skip_ = 0) { nM = M / BM; nN = N / BM; nwg = nM * nN; G = G_; c = c_; skip = skip_; }
    __host__ __device__ bool next(int i, Unit& u) const {
        const long L = (long)i * G + c; if (L >= nwg) return false;
        int wgid = (int)L; { const int q = nwg / NXCD, r = nwg % NXCD, xcd = wgid % NXCD, off = wgid / NXCD; wgid = (xcd < r ? xcd * (q + 1) : r * (q + 1) + (xcd - r) * q) + off; }
        const int nig = WGM * nN, gid = wgid / nig, fm = gid * WGM, gsz = (nM - fm) < WGM ? (nM - fm) : WGM;
        u.pm = fm + ((wgid % nig) % gsz); u.pn = (wgid % nig) / gsz;
        if (skip) u.pm = (u.pm >> 4) * 17 + 1 + (u.pm & 15);
        return true;
    }
    __device__ __forceinline__ void a_ready(const Unit&) const {}
    __device__ __forceinline__ void done(const Unit&) const {}
};
__device__ __forceinline__ unsigned cvt_pk_bf16(float lo, float hi) { unsigned r; asm volatile("v_cvt_pk_bf16_f32 %0, %1, %2" : "=v"(r) : "v"(lo), "v"(hi)); return r; }
template <class Epi, class Sched, bool STAMP = false>
__device__ __forceinline__ void gemm_phase(PG8_LAS unsigned char* lds, const Gemm g, const Sched& S, const Epi& E, unsigned long long* stamps) {
    const int tid = TIDX, wid = __builtin_amdgcn_readfirstlane(tid >> 6), lane = tid & 63, wr = wid >> 2, wc = wid & 3, fr = lane & 15, fq = lane >> 4;
    const int K = g.K, nt = K / BK;
    int ts_lo = 0, ts_hi = 0, nts = 0; const unsigned long long rt_entry = STAMP ? (unsigned long long)wall_clock64() : 0ull;
#define PG8_STAMP() do { if (STAMP && wid == 0 && nts < 64) { const unsigned long long _c = (unsigned long long)clock64(); \
        ts_lo = (lane == nts) ? (int)(unsigned)_c : ts_lo; ts_hi = (lane == nts) ? (int)(unsigned)(_c >> 32) : ts_hi; ++nts; } } while (0)
    PG8_STAMP();
    unsigned voffA[2], voffB[2];
#pragma unroll
    for (int i = 0; i < 2; ++i) { int R, C; stage_rc(tid * 16 + i * 8192, R, C); const int Rb = Epi::PERM ? ((R & ~31) + perm32(R & 31)) : R;
        voffA[i] = (unsigned)(R * g.lda + C) * 2u; voffB[i] = (unsigned)(Rb * K + C) * 2u; }
    const size_t kstep = (size_t)(BK * 2);
    const size_t hstepB = (size_t)HALF * K * 2, hstepA = (size_t)HALF * g.lda * 2;
    const size_t tstepB = 2 * hstepB, tstepA = 2 * hstepA;
    const unsigned ldsw = (unsigned)wid * 1024u;
    const int aoff = lds_byte(wr * 64 + fr, fq * 8), boff = lds_byte(wc * 32 + fr, fq * 8);
#define PG8_SA(b, h) (((b) * 2 + (h)) * HTB)
#define PG8_SB(b, h) ((4 + (b) * 2 + (h)) * HTB)
#define PG8_STAGE(bufoff, gbase, voff) do { _Pragma("unroll") for (int _i = 0; _i < 2; ++_i) \
        __builtin_amdgcn_global_load_lds((const unsigned*)((const char*)(gbase) + (voff)[_i]), (PG8_LAS unsigned*)(lds + (bufoff) + ldsw + _i * 8192), 16, 0, 0); } while (0)
#define PG8_LDA(dst, b, h) do { _Pragma("unroll") for (int m = 0; m < 4; ++m) _Pragma("unroll") for (int k = 0; k < 2; ++k) dst[m][k] = *(const PG8_LAS bf16x8*)(lds + PG8_SA(b, h) + aoff + m * 2048 + k * 1024); } while (0)
#define PG8_LDB(dst, b, h) do { _Pragma("unroll") for (int n = 0; n < 2; ++n) _Pragma("unroll") for (int k = 0; k < 2; ++k) dst[n][k] = *(const PG8_LAS bf16x8*)(lds + PG8_SB(b, h) + boff + n * 2048 + k * 1024); } while (0)
#define PG8_MMA(ai, bj, At, Bt) do { __builtin_amdgcn_s_setprio(1); _Pragma("unroll") for (int m = 0; m < 4; ++m) _Pragma("unroll") for (int n = 0; n < 2; ++n) _Pragma("unroll") for (int k = 0; k < 2; ++k) \
        acc[ai][bj][m][n] = __builtin_amdgcn_mfma_f32_16x16x32_bf16(Bt[n][k], At[m][k], acc[ai][bj][m][n], 0, 0, 0); __builtin_amdgcn_s_setprio(0); } while (0)
#define PG8_WAIT_V(n) asm volatile("s_waitcnt vmcnt(" #n ")" ::: "memory")
#define PG8_WAIT_L(n) asm volatile("s_waitcnt lgkmcnt(" #n ")" ::: "memory")
#define PG8_BAR __builtin_amdgcn_s_barrier()
#define PG8_SCHED __builtin_amdgcn_sched_barrier(0)
    Unit cur, nxt; int ui = 0;
    if (!S.next(0, cur)) return;
    f32x4 acc[2][2][4][2];
#pragma unroll
    for (int a = 0; a < 2; ++a)
#pragma unroll
        for (int b = 0; b < 2; ++b)
#pragma unroll
            for (int m = 0; m < 4; ++m)
#pragma unroll
                for (int n = 0; n < 2; ++n) acc[a][b][m][n] = (f32x4){0.f, 0.f, 0.f, 0.f};
    bf16x8 At[4][2], B0[2][2], B1[2][2];
    const char* cA = (const char*)g.A + (size_t)cur.pm * tstepA; const char* cB = (const char*)g.Bt + (size_t)cur.pn * tstepB;
    S.a_ready(cur);
    PG8_STAGE(PG8_SB(0, 0), cB, voffB); PG8_STAGE(PG8_SA(0, 0), cA, voffA); PG8_STAGE(PG8_SB(0, 1), cB + hstepB, voffB); PG8_STAGE(PG8_SA(0, 1), cA + hstepA, voffA);
    if (wr == 1) PG8_BAR;
    PG8_WAIT_V(4); PG8_BAR;
    PG8_STAGE(PG8_SB(1, 0), cB + kstep, voffB); PG8_STAGE(PG8_SA(1, 0), cA + kstep, voffA); PG8_STAGE(PG8_SB(1, 1), cB + hstepB + kstep, voffB);
    PG8_WAIT_V(6); PG8_BAR;
    PG8_STAMP();
    for (;;) {
        const bool has_next = S.next(ui + 1, nxt);
        const char* nA = has_next ? (const char*)g.A + (size_t)nxt.pm * tstepA : cA; const char* nB = has_next ? (const char*)g.Bt + (size_t)nxt.pn * tstepB : cB;
        for (int t = 0; t < nt; t += 2) {
            const bool last = (t == nt - 2);
            const char* a1 = cA + (size_t)(t + 1) * kstep;
            const char* a2 = last ? nA : cA + (size_t)(t + 2) * kstep; const char* b2 = last ? nB : cB + (size_t)(t + 2) * kstep;
            const char* a3 = a2 + kstep; const char* b3 = b2 + kstep;
            if (last && has_next) S.a_ready(nxt);
            PG8_LDB(B0, 0, 0); PG8_SCHED; PG8_LDA(At, 0, 0); PG8_STAGE(PG8_SA(1, 1), a1 + hstepA, voffA);
            PG8_WAIT_L(8); PG8_BAR; PG8_WAIT_L(0); PG8_MMA(0, 0, At, B0); PG8_BAR; PG8_SCHED;
            PG8_LDB(B1, 0, 1); PG8_STAGE(PG8_SB(0, 0), b2, voffB);
            PG8_BAR; PG8_WAIT_L(0); PG8_MMA(0, 1, At, B1); PG8_BAR;
            PG8_LDA(At, 0, 1); PG8_STAGE(PG8_SA(0, 0), a2, voffA);
            PG8_BAR; PG8_WAIT_L(0); PG8_MMA(1, 0, At, B0); PG8_BAR; PG8_SCHED;
            PG8_STAGE(PG8_SB(0, 1), b2 + hstepB, voffB);
            PG8_WAIT_V(6); PG8_BAR; PG8_MMA(1, 1, At, B1); PG8_BAR;
            PG8_LDB(B0, 1, 0); PG8_SCHED; PG8_LDA(At, 1, 0); PG8_STAGE(PG8_SA(0, 1), a2 + hstepA, voffA);
            PG8_WAIT_L(8); PG8_BAR; PG8_WAIT_L(0); PG8_MMA(0, 0, At, B0); PG8_BAR; PG8_SCHED;
            PG8_LDB(B1, 1, 1); PG8_STAGE(PG8_SB(1, 0), b3, voffB);
            PG8_BAR; PG8_WAIT_L(0); PG8_MMA(0, 1, At, B1); PG8_BAR;
            PG8_LDA(At, 1, 1); PG8_STAGE(PG8_SA(1, 0), a3, voffA);
            PG8_BAR; PG8_WAIT_L(0); PG8_MMA(1, 0, At, B0); PG8_BAR; PG8_SCHED;
            PG8_STAGE(PG8_SB(1, 1), b3 + hstepB, voffB);
            PG8_WAIT_V(6); PG8_BAR; PG8_MMA(1, 1, At, B1); PG8_BAR;
        }
        PG8_STAMP();
        if constexpr (!Epi::AFTER_DRAIN) { E(acc, cur, wr, wc, fr, fq); S.done(cur); }
        PG8_STAMP();
        if (!has_next) break;
#pragma unroll
        for (int a = 0; a < 2; ++a)
#pragma unroll
            for (int b = 0; b < 2; ++b)
#pragma unroll
                for (int m = 0; m < 4; ++m)
#pragma unroll
                    for (int n = 0; n < 2; ++n) acc[a][b][m][n] = (f32x4){0.f, 0.f, 0.f, 0.f};
        cur = nxt; cA = nA; cB = nB; ++ui;
    }
    PG8_WAIT_V(0);
    if (wr == 0) PG8_BAR;
    PG8_BAR;
    if constexpr (Epi::AFTER_DRAIN) { E.fused(acc, cur, wr, wc, fr, fq, lds, wid, lane); S.done(cur); }
    PG8_STAMP();
    if (STAMP && wid == 0) { stamps[lane] = lane < nts ? (((unsigned long long)(unsigned)ts_hi << 32) | (unsigned)ts_lo) : 0ull;
        if (lane == 62) stamps[62] = rt_entry; if (lane == 63) stamps[63] = (unsigned long long)wall_clock64(); }
#undef PG8_STAMP
#undef PG8_SA
#undef PG8_SB
#undef PG8_STAGE
#undef PG8_LDA
#undef PG8_LDB
#undef PG8_MMA
#undef PG8_WAIT_V
#undef PG8_WAIT_L
#undef PG8_BAR
#undef PG8_SCHED
}
}

struct EpiBf {
  static constexpr bool PERM = true, AFTER_DRAIN = false;
  u16* O; int ldc; const float* bias; int act;
  __device__ __forceinline__ void operator()(const f32x4 (&acc)[2][2][4][2], const pg8::Unit& u, int wr, int wc, int fr, int fq) const {
    const int row0 = u.pm * 256 + wr * 64 + fr, col0 = u.pn * 256 + wc * 32 + 8 * fq;
    f32x4 bv[2][2];
#pragma unroll
    for (int bj = 0; bj < 2; ++bj)
#pragma unroll
      for (int n = 0; n < 2; ++n) bv[bj][n] = bias ? *(const f32x4*)(bias + col0 + bj * 128 + 4 * n) : f32x4{0.f, 0.f, 0.f, 0.f};
#pragma unroll
    for (int ai = 0; ai < 2; ++ai)
#pragma unroll
      for (int m = 0; m < 4; ++m) {
        u16* rowp = O + (size_t)(row0 + ai * 128 + m * 16) * ldc + col0;
#pragma unroll
        for (int bj = 0; bj < 2; ++bj) {
          f32x4 v0 = acc[ai][bj][m][0] + bv[bj][0], v1 = acc[ai][bj][m][1] + bv[bj][1];
          if (act == 1) {
#pragma unroll
            for (int j = 0; j < 4; ++j) { v0[j] = sigm(v0[j]); v1[j] = sigm(v1[j]); }
          }
          uint4 wv;
          wv.x = pack2(v0[0], v0[1]); wv.y = pack2(v0[2], v0[3]); wv.z = pack2(v1[0], v1[1]); wv.w = pack2(v1[2], v1[3]);
          *(uint4*)(rowp + bj * 128) = wv;
        }
      }
  }
};
struct EpiSwiglu {
  static constexpr bool PERM = true, AFTER_DRAIN = false;
  u16* O;
  __device__ __forceinline__ void operator()(const f32x4 (&acc)[2][2][4][2], const pg8::Unit& u, int wr, int wc, int fr, int fq) const {
    const int row0 = u.pm * 256 + wr * 64 + fr, col0 = u.pn * 128 + wc * 16 + 4 * fq;
#pragma unroll
    for (int ai = 0; ai < 2; ++ai)
#pragma unroll
      for (int m = 0; m < 4; ++m) {
        u16* rowp = O + (size_t)(row0 + ai * 128 + m * 16) * FH + col0;
#pragma unroll
        for (int bj = 0; bj < 2; ++bj) {
          const f32x4 g = acc[ai][bj][m][0], up = acc[ai][bj][m][1];
          uint2 wv;
          wv.x = pack2(siluf(g[0]) * up[0], siluf(g[1]) * up[1]);
          wv.y = pack2(siluf(g[2]) * up[2], siluf(g[3]) * up[3]);
          *(uint2*)(rowp + bj * 64) = wv;
        }
      }
  }
};
struct EpiGateAcc {
  static constexpr bool PERM = true, AFTER_DRAIN = false;
  u16* ACC; const u16* G; int gcol; unsigned amask;
  __device__ __forceinline__ void operator()(const f32x4 (&acc)[2][2][4][2], const pg8::Unit& u, int wr, int wc, int fr, int fq) const {
    unsigned pk[2][2][4][4];
#pragma unroll
    for (int ai = 0; ai < 2; ++ai)
#pragma unroll
      for (int bj = 0; bj < 2; ++bj)
#pragma unroll
        for (int m = 0; m < 4; ++m) {
          pk[ai][bj][m][0] = pack2(acc[ai][bj][m][0][0], acc[ai][bj][m][0][1]);
          pk[ai][bj][m][1] = pack2(acc[ai][bj][m][0][2], acc[ai][bj][m][0][3]);
          pk[ai][bj][m][2] = pack2(acc[ai][bj][m][1][0], acc[ai][bj][m][1][1]);
          pk[ai][bj][m][3] = pack2(acc[ai][bj][m][1][2], acc[ai][bj][m][1][3]);
        }
    asm volatile("" ::: "memory");
    const int row0 = u.pm * 256 + wr * 64 + fr, col0 = u.pn * 256 + wc * 32 + 8 * fq;
#pragma unroll
    for (int ai = 0; ai < 2; ++ai)
#pragma unroll
      for (int m = 0; m < 4; ++m) {
        const size_t row = (size_t)(row0 + ai * 128 + m * 16);
#pragma unroll
        for (int bj = 0; bj < 2; ++bj) {
          const int col = col0 + bj * 128;
          const uint4 gv = *(const uint4*)(G + row * 2048 + gcol + col);
          const uint4 av = *(const uint4*)(ACC + row * DM + col);
          const unsigned gw[4] = {gv.x, gv.y, gv.z, gv.w};
          const unsigned aw[4] = {av.x & amask, av.y & amask, av.z & amask, av.w & amask};
          unsigned ow[4];
#pragma unroll
          for (int q = 0; q < 4; ++q) {
            const unsigned pv = pk[ai][bj][m][q];
            const float lo = __uint_as_float(aw[q] << 16) + __uint_as_float(gw[q] << 16) * __uint_as_float(pv << 16);
            const float hi = __uint_as_float(aw[q] & 0xffff0000u) + __uint_as_float(gw[q] & 0xffff0000u) * __uint_as_float(pv & 0xffff0000u);
            ow[q] = pack2(lo, hi);
          }
          *(uint4*)(ACC + row * DM + col) = make_uint4(ow[0], ow[1], ow[2], ow[3]);
        }
        asm volatile("" ::: "memory");
      }
  }
};

template <int MI>
__device__ __forceinline__ void gemm_loop(const u16* __restrict__ A, int lda, const u16* __restrict__ Bt, int ldb, int K,
                                          f32x4 (&acc)[MI][4], u16* sA, u16* sB) {
  constexpr int BMT = MI * 64;
  const int tid = TIDX, lane = tid & 63, w = tid >> 6, wm = w >> 1, wn = w & 1, fr = lane & 15, fq = lane >> 4;
  uint4 ra[MI], rb[2];
  const u16* ga = A + (size_t)(tid >> 3) * lda + (tid & 7) * 8;
  const u16* gb = Bt + (size_t)(tid >> 3) * ldb + (tid & 7) * 8;
  const int so = (tid >> 3) * LDT + (tid & 7) * 8;
#pragma unroll
  for (int i = 0; i < MI; i++) ra[i] = *(const uint4*)(ga + (size_t)(i * 64) * lda);
#pragma unroll
  for (int i = 0; i < 2; i++) rb[i] = *(const uint4*)(gb + (size_t)(i * 64) * ldb);
#pragma unroll
  for (int i = 0; i < MI; i++) *(uint4*)(sA + so + i * 64 * LDT) = ra[i];
#pragma unroll
  for (int i = 0; i < 2; i++) *(uint4*)(sB + so + i * 64 * LDT) = rb[i];
  __syncthreads();
  const int nk = K >> 6;
  for (int kt = 0; kt < nk; kt++) {
    const bool more = kt + 1 < nk;
    if (more) {
#pragma unroll
      for (int i = 0; i < MI; i++) ra[i] = *(const uint4*)(ga + (size_t)(i * 64) * lda + (kt + 1) * 64);
#pragma unroll
      for (int i = 0; i < 2; i++) rb[i] = *(const uint4*)(gb + (size_t)(i * 64) * ldb + (kt + 1) * 64);
    }
    const u16* a = sA + (kt & 1) * BMT * LDT + (wm * (MI * 16) + fr) * LDT + fq * 8;
    const u16* b = sB + (kt & 1) * 128 * LDT + (wn * 64 + fr) * LDT + fq * 8;
#pragma unroll
    for (int ks = 0; ks < 2; ks++) {
      bf16x8 af[MI], bfr[4];
#pragma unroll
      for (int i = 0; i < MI; i++) af[i] = *(const bf16x8*)(a + i * 16 * LDT + ks * 32);
#pragma unroll
      for (int j = 0; j < 4; j++) bfr[j] = *(const bf16x8*)(b + j * 16 * LDT + ks * 32);
#pragma unroll
      for (int i = 0; i < MI; i++)
#pragma unroll
        for (int j = 0; j < 4; j++) acc[i][j] = __builtin_amdgcn_mfma_f32_16x16x32_bf16(bfr[j], af[i], acc[i][j], 0, 0, 0);
    }
    if (more) {
      u16* da = sA + ((kt + 1) & 1) * BMT * LDT + so;
      u16* db = sB + ((kt + 1) & 1) * 128 * LDT + so;
#pragma unroll
      for (int i = 0; i < MI; i++) *(uint4*)(da + i * 64 * LDT) = ra[i];
#pragma unroll
      for (int i = 0; i < 2; i++) *(uint4*)(db + i * 64 * LDT) = rb[i];
    }
    __syncthreads();
  }
}

template <int MI>
__device__ __forceinline__ void zero_acc(f32x4 (&acc)[MI][4]) {
#pragma unroll
  for (int i = 0; i < MI; i++)
#pragma unroll
    for (int j = 0; j < 4; j++) acc[i][j] = f32x4{0.f, 0.f, 0.f, 0.f};
}


typedef unsigned u32x4v __attribute__((ext_vector_type(4)));
__device__ __forceinline__ void yp_issue(const u16* __restrict__ A, const u16* __restrict__ B, u32x4v (&ra)[8], u32x4v (&rb)[8], int tid) {
#pragma unroll
  for (int i = 0; i < 8; i++) {
    const int c = tid + i * NTHR, row = c >> 5, ch = c & 31;
    ra[i] = *(const u32x4v*)(A + (size_t)row * YST + ch * 8);
    rb[i] = *(const u32x4v*)(B + (size_t)row * 256 + ch * 8);
  }
}
__device__ __forceinline__ void yp_stage(unsigned char* sA, unsigned char* sB, const u32x4v (&ra)[8], const u32x4v (&rb)[8], int tid) {
#pragma unroll
  for (int i = 0; i < 8; i++) {
    const int c = tid + i * NTHR, row = c >> 5, ch = c & 31;
    const int off = row * 512 + ((ch ^ (row & 7)) << 4);
    *(u32x4v*)(sA + off) = ra[i];
    *(u32x4v*)(sB + off) = rb[i];
  }
}
__device__ __forceinline__ void phase_ypart(const Params& p, int l, unsigned char* smem) {
  unsigned char* sA = smem;
  unsigned char* sB = smem + 65536;
  const int tid = TIDX, lane = tid & 63, w = tid >> 6, wm = w >> 1, wn = w & 1, fr = lane & 15, fq = lane >> 4;
  const u16* Y = (const u16*)(p.ws + OFF_YS);
  const u16* Wb = (const u16*)(p.ws + OFF_W + OW_B);
  const u16* G = (const u16*)(p.ws + OFF_BIG);
  u16* ACC = (u16*)(p.ws + OFF_H);
  constexpr int NT = 8;
  const int ntiles = (NROWS / 128) * NT;
  const int G_ = gridDim.x;
  const bool xmap = (G_ == 256);
  const int xj = blockIdx.x >> 3, xx = blockIdx.x & 7;
  const bool skipc = (l == 1);
  const int nrt = skipc ? 256 : 272;
  const int ntl = nrt * NT;
  const int nmine = xmap ? (xj < nrt ? (nrt - 1 - xj) / 32 + 1 : 0)
                         : (((int)blockIdx.x < ntl) ? (ntl - 1 - (int)blockIdx.x) / G_ + 1 : 0);
  if (nmine == 0) return;
#define YP_TILE(Q_, MT_, NT_)                                                        \
  do {                                                                               \
    if (xmap) { const int s_ = (Q_) * 32 + xj; MT_ = (s_ >> 3) * 8 + xx; NT_ = s_ & 7; } \
    else { const int t_ = blockIdx.x + (Q_) * G_; MT_ = t_ / NT; NT_ = t_ - MT_ * NT; }  \
    if (skipc) MT_ = (MT_ >> 5) * 34 + 2 + (MT_ & 31);                                   \
  } while (0)
  u32x4v ra[8], rb[8];
  {
    int mt, nt;
    YP_TILE(0, mt, nt);
    yp_issue(Y + (size_t)mt * 128 * YST, Wb + ((size_t)nt * 128) * 256, ra, rb, tid);
  }
  f32x4 tot[2][4];
  zero_acc<2>(tot);
  for (int qi = 0; qi < 4 * nmine; qi++) {
    const int q = qi >> 2, k = qi & 3;
    int mt, nt;
    YP_TILE(q, mt, nt);
    const int r0 = mt * 128 + wm * 32 + fr, c0 = nt * 128 + wn * 64 + fq * 4;
    uint2 gv[2][4];
#pragma unroll
    for (int i = 0; i < 2; i++)
#pragma unroll
      for (int j = 0; j < 4; j++) gv[i][j] = *(const uint2*)(G + (size_t)(r0 + i * 16) * 4096 + k * 1024 + c0 + j * 16);
    __syncthreads();
    yp_stage(sA, sB, ra, rb, tid);
    __syncthreads();
    {
      const int qn = qi + 1 < 4 * nmine ? qi + 1 : qi;
      int mtn, ntn;
      YP_TILE(qn >> 2, mtn, ntn);
      const int brn = qn & 3, ycn = brn < 3 ? brn * 256 : 1536;
      yp_issue(Y + (size_t)mtn * 128 * YST + ycn, Wb + ((size_t)brn * 1024 + ntn * 128) * 256, ra, rb, tid);
    }
    f32x4 ay[2][4];
    zero_acc<2>(ay);
#pragma unroll 2
    for (int ks = 0; ks < 8; ks++) {
      bf16x8 af[2], bfr[4];
#pragma unroll
      for (int i = 0; i < 2; i++) {
        const int row = wm * 32 + i * 16 + fr;
        af[i] = *(const bf16x8*)(sA + row * 512 + (((ks * 4 + fq) ^ (row & 7)) << 4));
      }
#pragma unroll
      for (int j = 0; j < 4; j++) {
        const int row = wn * 64 + j * 16 + fr;
        bfr[j] = *(const bf16x8*)(sB + row * 512 + (((ks * 4 + fq) ^ (row & 7)) << 4));
      }
#pragma unroll
      for (int i = 0; i < 2; i++)
#pragma unroll
        for (int j = 0; j < 4; j++) ay[i][j] = __builtin_amdgcn_mfma_f32_16x16x32_bf16(bfr[j], af[i], ay[i][j], 0, 0, 0);
    }
#pragma unroll
    for (int i = 0; i < 2; i++)
#pragma unroll
      for (int j = 0; j < 4; j++) {
        tot[i][j][0] += __uint_as_float(gv[i][j].x << 16) * ay[i][j][0];
        tot[i][j][1] += __uint_as_float(gv[i][j].x & 0xffff0000u) * ay[i][j][1];
        tot[i][j][2] += __uint_as_float(gv[i][j].y << 16) * ay[i][j][2];
        tot[i][j][3] += __uint_as_float(gv[i][j].y & 0xffff0000u) * ay[i][j][3];
      }
    if (k == 3) {
#pragma unroll
      for (int i = 0; i < 2; i++)
#pragma unroll
        for (int j = 0; j < 4; j++) {
          uint2 ov;
          ov.x = pack2(tot[i][j][0], tot[i][j][1]); ov.y = pack2(tot[i][j][2], tot[i][j][3]);
          *(uint2*)(ACC + (size_t)(r0 + i * 16) * DM + c0 + j * 16) = ov;
        }
      zero_acc<2>(tot);
    }
  }
  __syncthreads();
#undef YP_TILE
}

#define S2_BUF 10816
#define S2_D 0
#define S2_U 2048
#define S2_P 4096
#define S2_K 6144
#define S2_DQ 8192
#define S2_V 10240
#define S2_C1 10752
#define S2_C2 10784
#define S2_ST (2 * S2_BUF)
#define S2_YB (S2_ST + 8192)

__device__ __forceinline__ float red16(float x) {
  x += dppf<0xB1>(x);
  x += dppf<0x4E>(x);
  x += dppf<0x141>(x);
  x += dppf<0x140>(x);
  return x;
}
__device__ __forceinline__ void wave_lds_sync() {
  asm volatile("s_waitcnt lgkmcnt(0)" ::: "memory");
  __builtin_amdgcn_wave_barrier();
}

template <int MIX>
__device__ __forceinline__ void scan2_item(const Params& p, int l, int b, int h, int dir, int rq, float* sm) {
  constexpr int EPL = (MIX == 2) ? 2 : 4;
  constexpr int VOFF = (MIX == 2) ? 64 : 128;
  const int tid = TIDX, lane = tid & 63, w = tid >> 6, fr = lane & 15, fq = lane >> 4;
  const bool producer = w >= 4;
  const int pw = w & 3;
  const u16* P = (const u16*)(p.ws + OFF_BIG);
  u16* YS = (u16*)(p.ws + OFF_YS);
  float* BC = (float*)(p.ws + OFF_BC);
  float* ST = sm + S2_ST + pw * 2048;
  float s[EPL];
#pragma unroll
  for (int i = 0; i < EPL; i++) s[i] = 0.f;

  bf16x8 bw2[4], ba2[4];
  float cst[5][4];
  float cw[3][7];
  float muv[4];
  int colv[4];
#pragma unroll
  for (int i = 0; i < 4; i++) { bw2[i] = bf16x8{0, 0, 0, 0, 0, 0, 0, 0}; ba2[i] = bw2[i]; muv[i] = 0.f; colv[i] = 0; }
  if (producer) {
    if (MIX == 0) {
#pragma unroll
      for (int nt = 0; nt < 4; nt++) {
        const int jch = h * 64 + nt * 16 + fr;
#pragma unroll
        for (int jj = 0; jj < 8; jj++) {
          bw2[nt][jj] = (short)f2bf(p.rwkv_w2[((size_t)(l * 2 + dir) * 32 + fq * 8 + jj) * 256 + jch]);
          ba2[nt][jj] = (short)f2bf(p.rwkv_a2[((size_t)(l * 2 + dir) * 32 + fq * 8 + jj) * 256 + jch]);
        }
        cst[0][nt] = p.rwkv_w0[(l * 2 + dir) * 256 + jch];
        cst[1][nt] = p.rwkv_a0[(l * 2 + dir) * 256 + jch];
        cst[2][nt] = p.rwkv_ka[l * 256 + jch];
        cst[3][nt] = p.rwkv_kk[l * 256 + jch];
        cst[4][nt] = p.rwkv_rk[l * 256 + jch];
      }
#pragma unroll
      for (int i = 0; i < 4; i++) {
        const int c = lane + 64 * i;
        colv[i] = i < 3 ? i * 256 + h * 64 + lane : (lane < 32 ? 768 + dir * 32 + lane : 832 + dir * 32 + (lane - 32));
        muv[i] = p.rwkv_mu[l * 960 + colv[i]];
        (void)c;
      }
    } else if (MIX == 1) {
#pragma unroll
      for (int i = 0; i < 3; i++) {
        colv[i] = PB + i * 256 + h * 64 + lane;
#pragma unroll
        for (int tp = 0; tp < 7; tp++) cw[i][tp] = p.gdn_conv[((size_t)l * 7 + tp) * 768 + i * 256 + h * 64 + lane];
      }
    } else {
#pragma unroll
      for (int nt = 0; nt < 2; nt++) {
#pragma unroll
        for (int jj = 0; jj < 8; jj++)
          bw2[nt][jj] = fq < 2 ? (short)f2bf(p.gla_gw2[((size_t)(l * 2 + dir) * 16 + fq * 8 + jj) * 128 + h * 32 + nt * 16 + fr]) : (short)0;
        cst[0][nt] = p.gla_gb[(l * 2 + dir) * 128 + h * 32 + nt * 16 + fr];
      }
      colv[0] = PC + h * 32 + lane;
      if (lane >= 32) colv[0] = PC + 128 + h * 32 + (lane - 32);
      colv[1] = PC + 256 + h * 64 + lane;
      colv[2] = PC + 512 + dir * 16 + (lane & 15);
    }
  }
  __syncthreads();

  for (int c = 0; c <= TPB / 32 + 1; c++) {
    if (producer) {
      if (c >= 2) {
        const int cc = c - 2;
        int seg_row0, t_lo;
        if (cc < 8) { seg_row0 = b * TPB; t_lo = dir == 0 ? cc * 32 : (LC - 32 - cc * 32); }
        else { seg_row0 = b * TPB + LC; t_lo = dir == 0 ? (cc - 8) * 32 : (SEQ - 32 - (cc - 8) * 32); }
        const float* yb = sm + S2_YB + (cc & 1) * 512;
        const int t2 = tid - 256;
#pragma unroll
        for (int i = 0; i < 2; i++) {
          const int idx = t2 + i * 256, tt = idx >> 4, e = idx & 15;
          YS[(size_t)(seg_row0 + t_lo + tt) * YST + dir * 768 + MIX * 256 + h * 64 + rq * 16 + e] = f2bf(yb[idx]);
        }
      }
      if (c < TPB / 32) {
        int seg_row0, seg_len, t_lo;
        if (c < 8) { seg_row0 = b * TPB; seg_len = LC; t_lo = dir == 0 ? c * 32 : (LC - 32 - c * 32); }
        else { seg_row0 = b * TPB + LC; seg_len = SEQ; t_lo = dir == 0 ? (c - 8) * 32 : (SEQ - 32 - (c - 8) * 32); }
        const u16* Pseg = P + (size_t)seg_row0 * PST;
        float* B = sm + (c & 1) * S2_BUF;
        const int t0 = t_lo + pw * 8;
        if (MIX == 0) {
          float raw[10][4];
#pragma unroll
          for (int rr = 0; rr < 10; rr++) {
            const int t = t0 - 1 + rr;
            const float okf = (t >= 0 && t < seg_len) ? 1.f : 0.f;
            const int tc = min(max(t, 0), seg_len - 1);
#pragma unroll
            for (int i = 0; i < 4; i++) raw[rr][i] = bf2f(Pseg[(size_t)tc * PST + PA + colv[i]]) * okf;
          }
#pragma unroll
          for (int j = 0; j < 8; j++)
#pragma unroll
            for (int i = 0; i < 4; i++) {
              float xm = raw[j + 1][i] + (0.5f * (raw[j][i] + raw[j + 2][i]) - raw[j + 1][i]) * muv[i];
              if (i == 3 && lane < 32) xm = tanh_fast(xm);
              ST[j * 256 + lane + 64 * i] = xm;
            }
        } else if (MIX == 1) {
          float raw[14][3];
#pragma unroll
          for (int rr = 0; rr < 14; rr++) {
            const int t = t0 - 3 + rr;
            const float okf = (t >= 0 && t < seg_len) ? 1.f : 0.f;
            const int tc = min(max(t, 0), seg_len - 1);
#pragma unroll
            for (int i = 0; i < 3; i++) raw[rr][i] = bf2f(Pseg[(size_t)tc * PST + colv[i]]) * okf;
          }
#pragma unroll
          for (int j = 0; j < 8; j++)
#pragma unroll
            for (int i = 0; i < 3; i++) {
              float a = 0.f;
#pragma unroll
              for (int tp = 0; tp < 7; tp++) a += raw[j + tp][i] * cw[i][tp];
              ST[j * 256 + lane + 64 * i] = siluf(a);
            }
          if (lane < 8) {
            const u16* pp = Pseg + (size_t)(t0 + lane) * PST + PB;
            float bx = bf2f(pp[768 + dir * 4 + h]);
            float ax = bf2f(pp[776 + dir * 4 + h]);
            float ld = -__expf(p.gdn_a_log[(l * 2 + dir) * 4 + h]) * softplusf(ax + p.gdn_dt_bias[(l * 2 + dir) * 4 + h]);
            ST[lane * 256 + 192] = sigm(bx);
            ST[lane * 256 + 193] = __expf(ld);
          }
        } else {
          u16 raw[8][3];
#pragma unroll
          for (int j = 0; j < 8; j++) {
            const u16* pp = Pseg + (size_t)(t0 + j) * PST;
#pragma unroll
            for (int i = 0; i < 3; i++) raw[j][i] = pp[colv[i]];
          }
          const float qs = lane < 32 ? 0.17677669529663687f : 1.f;
#pragma unroll
          for (int j = 0; j < 8; j++) {
            ST[j * 256 + lane] = bf2f(raw[j][0]) * qs;
            ST[j * 256 + 64 + lane] = bf2f(raw[j][1]);
            if (lane < 16) ST[j * 256 + 128 + lane] = bf2f(raw[j][2]);
          }
        }
        wave_lds_sync();
        const bool vl = fq < 2;
        if (MIX == 0) {
          bf16x8 aw, aa;
#pragma unroll
          for (int jj = 0; jj < 8; jj++) {
            aw[jj] = fr < 8 ? (short)f2bf(ST[fr * 256 + 192 + fq * 8 + jj]) : (short)0;
            aa[jj] = fr < 8 ? (short)f2bf(ST[fr * 256 + 224 + fq * 8 + jj]) : (short)0;
          }
          f32x4 accw[4], acca[4];
#pragma unroll
          for (int nt = 0; nt < 4; nt++) {
            accw[nt] = __builtin_amdgcn_mfma_f32_16x16x32_bf16(aw, bw2[nt], f32x4{0.f, 0.f, 0.f, 0.f}, 0, 0, 0);
            acca[nt] = __builtin_amdgcn_mfma_f32_16x16x32_bf16(aa, ba2[nt], f32x4{0.f, 0.f, 0.f, 0.f}, 0, 0, 0);
          }
#pragma unroll
          for (int r = 0; r < 4; r++) {
            const int j = (fq & 1) * 4 + r, tt = pw * 8 + j;
            float kkx[4], av[4], kdv[4], rv[4], dec[4];
            float ss = 0.f;
#pragma unroll
            for (int nt = 0; nt < 4; nt++) {
              const int n = nt * 16 + fr;
              rv[nt] = ST[j * 256 + n];
              const float kx = ST[j * 256 + 64 + n];
              dec[nt] = __expf(-0.6065306597126334f * sigm(cst[0][nt] + accw[nt][r]));
              av[nt] = sigm(cst[1][nt] + acca[nt][r]);
              kdv[nt] = kx * (1.f + (av[nt] - 1.f) * cst[2][nt]);
              kkx[nt] = kx * cst[3][nt];
              ss += kkx[nt] * kkx[nt];
            }
            ss = red16(ss);
            const float rs = rsq(ss + 1e-6f);
            float c1 = 0.f, c2 = 0.f, bc = 0.f;
#pragma unroll
            for (int nt = 0; nt < 4; nt++) {
              const int n = nt * 16 + fr;
              const float kk = kkx[nt] * rs;
              if (vl) {
                B[S2_D + tt * 64 + n] = dec[nt];
                B[S2_U + tt * 64 + n] = kk;
                B[S2_P + tt * 64 + n] = -kk * av[nt];
                B[S2_K + tt * 64 + n] = kdv[nt];
                B[S2_DQ + tt * 64 + n] = dec[nt] * rv[nt];
              }
              c1 += -kk * av[nt] * rv[nt];
              c2 += kdv[nt] * rv[nt];
              bc += rv[nt] * kdv[nt] * cst[4][nt];
            }
            c1 = red16(c1); c2 = red16(c2); bc = red16(bc);
            if (vl && fr == 0) {
              B[S2_C1 + tt] = c1;
              B[S2_C2 + tt] = c2;
              if (rq == 0) BC[(size_t)(seg_row0 + t_lo + tt) * 8 + h * 2 + dir] = bc;
            }
          }
        } else if (MIX == 1) {
#pragma unroll
          for (int r = 0; r < 4; r++) {
            const int j = (fq & 1) * 4 + r, tt = pw * 8 + j;
            float qv[4], kv[4];
            float sq = 0.f, sk = 0.f;
#pragma unroll
            for (int nt = 0; nt < 4; nt++) {
              const int n = nt * 16 + fr;
              qv[nt] = ST[j * 256 + n];
              kv[nt] = ST[j * 256 + 64 + n];
              sq += qv[nt] * qv[nt];
              sk += kv[nt] * kv[nt];
            }
            sq = red16(sq); sk = red16(sk);
            const float rq_ = rsq(sq + 1e-6f) * 0.125f, rk_ = rsq(sk + 1e-6f);
            const float beta = ST[j * 256 + 192], alpha = ST[j * 256 + 193];
            float dkq = 0.f;
#pragma unroll
            for (int nt = 0; nt < 4; nt++) {
              const int n = nt * 16 + fr;
              const float qn = qv[nt] * rq_, kn = kv[nt] * rk_;
              if (vl) {
                B[S2_D + tt * 64 + n] = alpha;
                B[S2_U + tt * 64 + n] = kn;
                B[S2_P + tt * 64 + n] = -alpha * beta * kn;
                B[S2_K + tt * 64 + n] = beta * kn;
                B[S2_DQ + tt * 64 + n] = alpha * qn;
              }
              dkq += kn * qn;
            }
            dkq = red16(dkq);
            if (vl && fr == 0) {
              B[S2_C1 + tt] = -alpha * beta * dkq;
              B[S2_C2 + tt] = beta * dkq;
            }
          }
        } else {
          bf16x8 ag;
#pragma unroll
          for (int jj = 0; jj < 8; jj++) ag[jj] = (fr < 8 && fq < 2) ? (short)f2bf(ST[fr * 256 + 128 + fq * 8 + jj]) : (short)0;
          f32x4 accg[2];
#pragma unroll
          for (int nt = 0; nt < 2; nt++) accg[nt] = __builtin_amdgcn_mfma_f32_16x16x32_bf16(ag, bw2[nt], f32x4{0.f, 0.f, 0.f, 0.f}, 0, 0, 0);
#pragma unroll
          for (int r = 0; r < 4; r++) {
            const int j = (fq & 1) * 4 + r, tt = pw * 8 + j;
            float dkq = 0.f;
#pragma unroll
            for (int nt = 0; nt < 2; nt++) {
              const int n = nt * 16 + fr;
              const float lg = cst[0][nt] + accg[nt][r];
              const float ls = fminf(lg, 0.f) - __logf(1.f + __expf(-fabsf(lg)));
              const float alpha = __expf(ls * (1.f / 16.f));
              const float qv = ST[j * 256 + n], kv = ST[j * 256 + 32 + n];
              if (vl) {
                B[S2_D + tt * 64 + n] = alpha;
                B[S2_K + tt * 64 + n] = kv;
                B[S2_DQ + tt * 64 + n] = alpha * qv;
              }
              dkq += kv * qv;
            }
            dkq = red16(dkq);
            if (vl && fr == 0) B[S2_C2 + tt] = dkq;
          }
        }
#pragma unroll
        for (int i = 0; i < 2; i++) {
          const int idx = lane + 64 * i, j = idx >> 4, e = idx & 15;
          B[S2_V + (pw * 8 + j) * 16 + e] = ST[j * 256 + VOFF + rq * 16 + e];
        }
      }
    } else if (c >= 1 && c <= TPB / 32) {
      const float* B = sm + ((c - 1) & 1) * S2_BUF;
      float* yb = sm + S2_YB + ((c - 1) & 1) * 512;
      const int rl = w * 4 + fq;
      const int dtt = dir ? -1 : 1;
      int tt = dir ? 31 : 0;
      float dv[EPL], kv[EPL], qv[EPL], uv[EPL], pv[EPL], vv, c1v, c2v;
      float dn[EPL], kn[EPL], qn[EPL], un[EPL], pn[EPL], vn, c1n, c2n;
#define S2_LOAD(D_, K_, Q_, U_, P_, V_, C1_, C2_, T_)                                   \
  do {                                                                                  \
    const int o_ = (T_) * 64 + fr * EPL;                                                \
    if (EPL == 4) {                                                                     \
      float4 t4 = *(const float4*)(B + S2_D + o_);                                      \
      D_[0] = t4.x; D_[1] = t4.y; D_[2] = t4.z; D_[3] = t4.w;                           \
      t4 = *(const float4*)(B + S2_K + o_);                                             \
      K_[0] = t4.x; K_[1] = t4.y; K_[2] = t4.z; K_[3] = t4.w;                           \
      t4 = *(const float4*)(B + S2_DQ + o_);                                            \
      Q_[0] = t4.x; Q_[1] = t4.y; Q_[2] = t4.z; Q_[3] = t4.w;                           \
      t4 = *(const float4*)(B + S2_U + o_);                                             \
      U_[0] = t4.x; U_[1] = t4.y; U_[2] = t4.z; U_[3] = t4.w;                           \
      t4 = *(const float4*)(B + S2_P + o_);                                             \
      P_[0] = t4.x; P_[1] = t4.y; P_[2] = t4.z; P_[3] = t4.w;                           \
      C1_ = B[S2_C1 + (T_)];                                                            \
    } else {                                                                            \
      float2 t2 = *(const float2*)(B + S2_D + o_);                                      \
      D_[0] = t2.x; D_[1] = t2.y;                                                       \
      t2 = *(const float2*)(B + S2_K + o_);                                             \
      K_[0] = t2.x; K_[1] = t2.y;                                                       \
      t2 = *(const float2*)(B + S2_DQ + o_);                                            \
      Q_[0] = t2.x; Q_[1] = t2.y;                                                       \
      U_[0] = U_[1] = P_[0] = P_[1] = 0.f; C1_ = 0.f;                                   \
    }                                                                                   \
    V_ = B[S2_V + (T_) * 16 + rl];                                                      \
    C2_ = B[S2_C2 + (T_)];                                                              \
  } while (0)
#define S2_STEP(D_, K_, Q_, U_, P_, V_, C1_, C2_, T_)                                   \
  do {                                                                                  \
    float sq = 0.f, sa = 0.f;                                                           \
    _Pragma("unroll") for (int i = 0; i < EPL; i++) sq += s[i] * Q_[i];                 \
    if (MIX != 2) {                                                                     \
      _Pragma("unroll") for (int i = 0; i < EPL; i++) sa += s[i] * U_[i];               \
      sa = red16(sa);                                                                   \
    }                                                                                   \
    sq = red16(sq);                                                                     \
    float y = sq + V_ * C2_;                                                            \
    if (MIX != 2) y += sa * C1_;                                                        \
    _Pragma("unroll") for (int i = 0; i < EPL; i++) {                                   \
      float t = s[i] * D_[i] + V_ * K_[i];                                              \
      if (MIX != 2) t += sa * P_[i];                                                    \
      s[i] = t;                                                                         \
    }                                                                                   \
    yb[(T_) * 16 + rl] = y;                                                             \
  } while (0)
      S2_LOAD(dv, kv, qv, uv, pv, vv, c1v, c2v, tt);
#pragma unroll 1
      for (int st = 0; st < 32; st += 2) {
        const int t1 = tt + dtt;
        S2_LOAD(dn, kn, qn, un, pn, vn, c1n, c2n, t1);
        S2_STEP(dv, kv, qv, uv, pv, vv, c1v, c2v, tt);
        const int t2 = st + 2 < 32 ? t1 + dtt : t1;
        S2_LOAD(dv, kv, qv, uv, pv, vv, c1v, c2v, t2);
        S2_STEP(dn, kn, qn, un, pn, vn, c1n, c2n, t1);
        tt = t2;
      }
#undef S2_LOAD
#undef S2_STEP
    }
    __syncthreads();
  }
}

#define S3_SUB 12800
#define S3_GM 0
#define S3_KVT 9216
#define S3_QB 10240
#define S3_QV 11392
#define S3_VT 11520
#define S3_WC 12544
#define S3_TB S3_QV
#define S3_TM (S3_GM + 3328)
#define S3_QBM (S3_GM + 3072)
#define S3_QKM (S3_GM + 3200)
#define S3_KB (S3_GM + 0)
#define S3_BT (S3_GM + 2048)
#define S3_STB (8 * S3_SUB)
#define S3_END (S3_STB + 4 * 2304)

__device__ __forceinline__ float rlane(float x, int l) { return __int_as_float(__builtin_amdgcn_readlane(__float_as_int(x), l)); }
__device__ __forceinline__ float wave_sum(float x) {
  x = red16(x);
  return (rlane(x, 0) + rlane(x, 16)) + (rlane(x, 32) + rlane(x, 48));
}
__device__ __forceinline__ float clampe(float x) { return fminf(fmaxf(x, -80.f), 80.f); }
__device__ __forceinline__ uint4 pack8(const float (&v)[8]) {
  return make_uint4(pack2(v[0], v[1]), pack2(v[2], v[3]), pack2(v[4], v[5]), pack2(v[6], v[7]));
}
__device__ __forceinline__ bf16x8 ld_frag(const void* p) { return *(const bf16x8*)p; }
__device__ __forceinline__ bf16x8 zfrag() { return bf16x8{0, 0, 0, 0, 0, 0, 0, 0}; }

__device__ __forceinline__ void chunk_geom(int c, int dir, int b, int& seg_row0, int& seg_len, int& t_lo) {
  if (c < 8) { seg_row0 = b * TPB; seg_len = LC; t_lo = dir == 0 ? c * 32 : (LC - 32 - c * 32); }
  else { seg_row0 = b * TPB + LC; seg_len = SEQ; t_lo = dir == 0 ? (c - 8) * 32 : (SEQ - 32 - (c - 8) * 32); }
}
template <int MIX>
__device__ __forceinline__ void fetch_raw(const u16* P, int c, int dir, int b, int h, int pw, int lane, const int (&colv)[4], unsigned (&rawq)[14][2]) {
  int seg_row0, seg_len, t_lo;
  chunk_geom(c, dir, b, seg_row0, seg_len, t_lo);
  const u16* Pseg = P + (size_t)seg_row0 * PST;
  const int t0 = t_lo + pw * 8;
  if (MIX == 0) {
#pragma unroll
    for (int rr = 0; rr < 10; rr++) {
      const int tc = min(max(t0 - 1 + rr, 0), seg_len - 1);
#pragma unroll
      for (int i = 0; i < 2; i++)
        rawq[rr][i] = (unsigned)Pseg[(size_t)tc * PST + PA + colv[2 * i]] | ((unsigned)Pseg[(size_t)tc * PST + PA + colv[2 * i + 1]] << 16);
    }
  } else if (MIX == 1) {
#pragma unroll
    for (int rr = 0; rr < 14; rr++) {
      const int tc = min(max(t0 - 3 + rr, 0), seg_len - 1);
      rawq[rr][0] = (unsigned)Pseg[(size_t)tc * PST + colv[0]] | ((unsigned)Pseg[(size_t)tc * PST + colv[1]] << 16);
      rawq[rr][1] = (rawq[rr][1] & 0xffff0000u) | (unsigned)Pseg[(size_t)tc * PST + colv[2]];
    }
    const u16* pp = Pseg + (size_t)(t0 + (lane & 7)) * PST + PB;
    rawq[0][1] = (rawq[0][1] & 0xffffu) | ((unsigned)pp[768 + dir * 4 + h] << 16);
    rawq[1][1] = (rawq[1][1] & 0xffffu) | ((unsigned)pp[776 + dir * 4 + h] << 16);
  } else {
#pragma unroll
    for (int j = 0; j < 8; j++) {
      const u16* pp = Pseg + (size_t)(t0 + j) * PST;
      rawq[j][0] = (unsigned)pp[colv[0]] | ((unsigned)pp[colv[1]] << 16);
      rawq[j][1] = (unsigned)pp[colv[2]];
    }
  }
}

template <int MIX>
__device__ __forceinline__ void scan3_item(const Params& p, int l, int b, int h, int dir, unsigned char* smb) {
  constexpr int VOFF = (MIX == 2) ? 64 : 128;
  constexpr bool DELTA = (MIX != 2);
  const int tid = TIDX, lane = tid & 63, w = __builtin_amdgcn_readfirstlane(tid >> 6), fr = lane & 15, fq = lane >> 4;
  const bool producer = true;
  const int pw = w & 3, half = w >> 2;
  const u16* P = (const u16*)(p.ws + OFF_BIG);
  u16* YS = (u16*)(p.ws + OFF_YS);
  float* BC = (float*)(p.ws + OFF_BC);
  float* ST = (float*)(smb + w * S3_SUB + S3_GM);
  unsigned char* STBY = smb + w * S3_SUB + S3_GM;
  const f32x4 z4 = f32x4{0.f, 0.f, 0.f, 0.f};
  f32x4 st[4];
#pragma unroll
  for (int i = 0; i < 4; i++) st[i] = z4;

  bf16x8 bw2[4], ba2[4];
  float cw[3][7];
  float muv[4];
  int colv[4];
  float c_w0 = 0.f, c_a0 = 0.f, c_ka = 0.f, c_kk = 0.f, c_rk = 0.f, c_gb = 0.f;
#pragma unroll
  for (int i = 0; i < 4; i++) { bw2[i] = zfrag(); ba2[i] = zfrag(); muv[i] = 0.f; colv[i] = 0; }
  if (producer) {
    if (MIX == 0) {
      {
        float tw[4][8], ta[4][8];
#pragma unroll
        for (int nt = 0; nt < 4; nt++)
#pragma unroll
          for (int jj = 0; jj < 8; jj++) {
            tw[nt][jj] = p.rwkv_w2[((size_t)(l * 2 + dir) * 32 + fq * 8 + jj) * 256 + h * 64 + nt * 16 + fr];
            ta[nt][jj] = p.rwkv_a2[((size_t)(l * 2 + dir) * 32 + fq * 8 + jj) * 256 + h * 64 + nt * 16 + fr];
          }
#pragma unroll
        for (int nt = 0; nt < 4; nt++)
#pragma unroll
          for (int jj = 0; jj < 8; jj++) { bw2[nt][jj] = (short)f2bf(tw[nt][jj]); ba2[nt][jj] = (short)f2bf(ta[nt][jj]); }
      }
      const int jl = h * 64 + lane;
      c_w0 = p.rwkv_w0[(l * 2 + dir) * 256 + jl];
      c_a0 = p.rwkv_a0[(l * 2 + dir) * 256 + jl];
      c_ka = p.rwkv_ka[l * 256 + jl];
      c_kk = p.rwkv_kk[l * 256 + jl];
      c_rk = p.rwkv_rk[l * 256 + jl];
#pragma unroll
      for (int i = 0; i < 4; i++) {
        colv[i] = i < 3 ? i * 256 + h * 64 + lane : (lane < 32 ? 768 + dir * 32 + lane : 832 + dir * 32 + (lane - 32));
        muv[i] = p.rwkv_mu[l * 960 + colv[i]];
      }
    } else if (MIX == 1) {
#pragma unroll
      for (int i = 0; i < 3; i++) {
        colv[i] = PB + i * 256 + h * 64 + lane;
#pragma unroll
        for (int tp = 0; tp < 7; tp++) cw[i][tp] = p.gdn_conv[((size_t)l * 7 + tp) * 768 + i * 256 + h * 64 + lane];
      }
    } else {
      {
        float tg[2][8];
#pragma unroll
        for (int nt = 0; nt < 2; nt++)
#pragma unroll
          for (int jj = 0; jj < 8; jj++) tg[nt][jj] = p.gla_gw2[((size_t)(l * 2 + dir) * 16 + (fq & 1) * 8 + jj) * 128 + h * 32 + nt * 16 + fr];
#pragma unroll
        for (int nt = 0; nt < 2; nt++)
#pragma unroll
          for (int jj = 0; jj < 8; jj++) bw2[nt][jj] = fq < 2 ? (short)f2bf(tg[nt][jj]) : (short)0;
      }
      c_gb = p.gla_gb[(l * 2 + dir) * 128 + h * 32 + (lane & 31)];
      colv[0] = PC + h * 32 + lane;
      if (lane >= 32) colv[0] = PC + 128 + h * 32 + (lane - 32);
      colv[1] = PC + 256 + h * 64 + lane;
      colv[2] = PC + 512 + dir * 16 + (lane & 15);
    }
  }
  __syncthreads();
  unsigned rawq[14][2];
#pragma unroll
  for (int i = 0; i < 14; i++) { rawq[i][0] = 0u; rawq[i][1] = 0u; }
  fetch_raw<MIX>(P, half, dir, b, h, pw, lane, colv, rawq);
#define RAWP(r_, i_) ((u16)((rawq[r_][(i_) >> 1] >> (((i_) & 1) * 16)) & 0xffffu))

  for (int it = 0; it < TPB / 64; it++) {
    {
      {
        const int c = it * 2 + half;
        int seg_row0, seg_len, t_lo;
        chunk_geom(c, dir, b, seg_row0, seg_len, t_lo);
        unsigned char* SB = smb + w * S3_SUB;
        const int t0 = t_lo + pw * 8;
        if (MIX == 0) {
          float raw[10][4];
#pragma unroll
          for (int rr = 0; rr < 10; rr++) {
            const int t = t0 - 1 + rr;
            const float okf = (t >= 0 && t < seg_len) ? 1.f : 0.f;
#pragma unroll
            for (int i = 0; i < 4; i++) raw[rr][i] = bf2f(RAWP(rr, i)) * okf;
          }
#pragma unroll
          for (int j = 0; j < 8; j++)
#pragma unroll
            for (int i = 0; i < 4; i++) {
              float xm = raw[j + 1][i] + (0.5f * (raw[j][i] + raw[j + 2][i]) - raw[j + 1][i]) * muv[i];
              if (i == 3 && lane < 32) xm = tanh_fast(xm);
              ST[j * 256 + lane + 64 * i] = xm;
            }
        } else if (MIX == 1) {
          float raw[14][3];
#pragma unroll
          for (int rr = 0; rr < 14; rr++) {
            const int t = t0 - 3 + rr;
            const float okf = (t >= 0 && t < seg_len) ? 1.f : 0.f;
#pragma unroll
            for (int i = 0; i < 3; i++) raw[rr][i] = bf2f(RAWP(rr, i)) * okf;
          }
#pragma unroll
          for (int j = 0; j < 8; j++)
#pragma unroll
            for (int i = 0; i < 3; i++) {
              float a = 0.f;
#pragma unroll
              for (int tp = 0; tp < 7; tp++) a += raw[j + tp][i] * cw[i][tp];
              ST[j * 256 + lane + 64 * i] = siluf(a);
            }
          if (lane < 8) {
            float bx = bf2f(RAWP(0, 3));
            float ax = bf2f(RAWP(1, 3));
            float ld = -__expf(p.gdn_a_log[(l * 2 + dir) * 4 + h]) * softplusf(ax + p.gdn_dt_bias[(l * 2 + dir) * 4 + h]);
            ST[lane * 256 + 192] = sigm(bx);
            ST[lane * 256 + 193] = ld;
          }
        } else {
          const float qs = lane < 32 ? 0.17677669529663687f : 1.f;
#pragma unroll
          for (int j = 0; j < 8; j++) {
            ST[j * 256 + lane] = bf2f(RAWP(j, 0)) * qs;
            ST[j * 256 + 64 + lane] = bf2f(RAWP(j, 1));
            if (lane < 16) ST[j * 256 + 128 + lane] = bf2f(RAWP(j, 2));
          }
        }
        wave_lds_sync();
        {
          float vv[8];
#pragma unroll
          for (int i = 0; i < 8; i++) vv[i] = ST[(dir ? 7 - i : i) * 256 + VOFF + lane];
          *(uint4*)(SB + S3_VT + lane * 16) = pack8(vv);
        }
        if (MIX == 0) {
          bf16x8 aw, aa;
#pragma unroll
          for (int jj = 0; jj < 8; jj++) {
            aw[jj] = fr < 8 ? (short)f2bf(ST[fr * 256 + 192 + fq * 8 + jj]) : (short)0;
            aa[jj] = fr < 8 ? (short)f2bf(ST[fr * 256 + 224 + fq * 8 + jj]) : (short)0;
          }
          f32x4 accw[4], acca[4];
#pragma unroll
          for (int nt = 0; nt < 4; nt++) {
            accw[nt] = __builtin_amdgcn_mfma_f32_16x16x32_bf16(aw, bw2[nt], z4, 0, 0, 0);
            acca[nt] = __builtin_amdgcn_mfma_f32_16x16x32_bf16(aa, ba2[nt], z4, 0, 0, 0);
          }
          wave_lds_sync();
          if (fq < 2) {
#pragma unroll
            for (int nt = 0; nt < 4; nt++)
#pragma unroll
              for (int r = 0; r < 4; r++) {
                ST[(fq * 4 + r) * 256 + 128 + nt * 16 + fr] = accw[nt][r];
                ST[(fq * 4 + r) * 256 + 192 + nt * 16 + fr] = acca[nt][r];
              }
          }
          wave_lds_sync();
        } else if (MIX == 2) {
          bf16x8 ag;
#pragma unroll
          for (int jj = 0; jj < 8; jj++) ag[jj] = (fr < 8 && fq < 2) ? (short)f2bf(ST[fr * 256 + 128 + fq * 8 + jj]) : (short)0;
          f32x4 accg[2];
#pragma unroll
          for (int nt = 0; nt < 2; nt++) accg[nt] = __builtin_amdgcn_mfma_f32_16x16x32_bf16(ag, bw2[nt], z4, 0, 0, 0);
          if (fq < 2) {
#pragma unroll
            for (int nt = 0; nt < 2; nt++)
#pragma unroll
              for (int r = 0; r < 4; r++) ST[(fq * 4 + r) * 256 + 192 + nt * 16 + fr] = accg[nt][r];
          }
          wave_lds_sync();
        }
        float logd[8], kap[8], bb[8], kp[8], qq[8];
        u16* XA1 = (u16*)(SB + 9216);
        u16* XA2 = (u16*)(SB + 10368);
        const int dlane_r = fr & 3;
        if (MIX == 0) {
          float a8[8];
#pragma unroll
          for (int i = 0; i < 8; i++) {
            const float* row = ST + (dir ? 7 - i : i) * 256;
            const float r_ = row[lane], k_ = row[64 + lane];
            const float sg = sigm(c_w0 + row[128 + lane]);
            a8[i] = sigm(c_a0 + row[192 + lane]);
            kp[i] = k_ * (1.f + (a8[i] - 1.f) * c_ka);
            kap[i] = k_ * c_kk;
            qq[i] = r_;
            logd[i] = -0.6065306597126334f * sg;
            XA1[i * 72 + lane] = f2bf(kap[i]);
          }
          wave_lds_sync();
          f32x4 accS = z4;
#pragma unroll
          for (int ks = 0; ks < 2; ks++) {
            const bf16x8 fx = ld_frag(XA1 + (fr & 7) * 72 + fq * 8 + ks * 32);
            accS = __builtin_amdgcn_mfma_f32_16x16x32_bf16(fx, fx, accS, 0, 0, 0);
          }
          const float dsel = dlane_r == 0 ? accS[0] : (dlane_r == 1 ? accS[1] : (dlane_r == 2 ? accS[2] : accS[3]));
#pragma unroll
          for (int i = 0; i < 8; i++) {
            const float ss = rlane(dsel, (i >> 2) * 16 + i);
            kap[i] *= rsq(ss + 1e-6f);
            bb[i] = kap[i] * a8[i];
          }
        } else if (MIX == 1) {
#pragma unroll
          for (int i = 0; i < 8; i++) {
            const float* row = ST + (dir ? 7 - i : i) * 256;
            qq[i] = row[lane]; kap[i] = row[64 + lane];
            kp[i] = row[192];
            logd[i] = row[193];
            XA1[i * 72 + lane] = f2bf(qq[i]);
            XA2[i * 72 + lane] = f2bf(kap[i]);
          }
          wave_lds_sync();
          f32x4 accSq = z4, accSk = z4;
#pragma unroll
          for (int ks = 0; ks < 2; ks++) {
            const bf16x8 fxq = ld_frag(XA1 + (fr & 7) * 72 + fq * 8 + ks * 32), fxk = ld_frag(XA2 + (fr & 7) * 72 + fq * 8 + ks * 32);
            accSq = __builtin_amdgcn_mfma_f32_16x16x32_bf16(fxq, fxq, accSq, 0, 0, 0);
            accSk = __builtin_amdgcn_mfma_f32_16x16x32_bf16(fxk, fxk, accSk, 0, 0, 0);
          }
          const float dq = dlane_r == 0 ? accSq[0] : (dlane_r == 1 ? accSq[1] : (dlane_r == 2 ? accSq[2] : accSq[3]));
          const float dk = dlane_r == 0 ? accSk[0] : (dlane_r == 1 ? accSk[1] : (dlane_r == 2 ? accSk[2] : accSk[3]));
#pragma unroll
          for (int i = 0; i < 8; i++) {
            const float sq = rlane(dq, (i >> 2) * 16 + i), sk = rlane(dk, (i >> 2) * 16 + i);
            const float beta = kp[i], alpha = __expf(logd[i]);
            const float qn = qq[i] * rsq(sq + 1e-6f) * 0.125f, kn = kap[i] * rsq(sk + 1e-6f);
            kap[i] = kn; bb[i] = alpha * beta * kn; kp[i] = beta * kn; qq[i] = qn;
          }
        } else {
#pragma unroll
          for (int i = 0; i < 8; i++) {
            const float* row = ST + (dir ? 7 - i : i) * 256;
            const int n = lane & 31;
            const float lg = c_gb + row[192 + n];
            const float ls = fminf(lg, 0.f) - __logf(1.f + __expf(-fabsf(lg)));
            logd[i] = ls * (1.f / 16.f);
            kap[i] = 0.f; bb[i] = 0.f;
            kp[i] = lane < 32 ? row[32 + n] : 0.f;
            qq[i] = lane < 32 ? row[n] : 0.f;
          }
        }
        wave_lds_sync();
        float kt[8], qt[8], bck[8], kck[8];
        {
          float L[8];
          float run = 0.f;
#pragma unroll
          for (int i = 0; i < 8; i++) { run += logd[i]; L[i] = run; }
          const float Lr = L[3], L7 = L[7];
          float prevE = __expf(clampe(-Lr)), prevT = 1.f;
          u16* OPA = (u16*)STBY;
#pragma unroll
          for (int i = 0; i < 8; i++) {
            const float eI = __expf(clampe(L[i] - Lr)), eInv = __expf(clampe(Lr - L[i]));
            const float tI = __expf(L[i]), eEnd = __expf(L7 - L[i]);
            if (DELTA) {
              OPA[0 * 576 + i * 72 + lane] = f2bf(kap[i] * prevE);
              OPA[1 * 576 + i * 72 + lane] = f2bf(bb[i] * eInv);
            }
            OPA[2 * 576 + i * 72 + lane] = f2bf(kp[i] * eInv);
            OPA[3 * 576 + i * 72 + lane] = f2bf(qq[i] * eI);
            if (MIX == 0) OPA[4 * 576 + i * 72 + lane] = f2bf(qq[i] * eI * c_rk);
            kt[i] = kap[i] * prevT; qt[i] = qq[i] * tI;
            bck[i] = bb[i] * eEnd; kck[i] = kp[i] * eEnd;
            prevE = eI; prevT = tI;
          }
          *(float*)(SB + S3_WC + lane * 4) = __expf(L7);
        }
        wave_lds_sync();
        f32x4 accA = z4, accBm = z4, accQb = z4, accQk = z4, accBC = z4;
        {
          const u16* OPA = (const u16*)STBY;
          const int ro = (fr & 7) * 72 + fq * 8;
#pragma unroll
          for (int ks = 0; ks < 2; ks++) {
            const bf16x8 fk = ld_frag(OPA + 2 * 576 + ro + ks * 32), fqh = ld_frag(OPA + 3 * 576 + ro + ks * 32);
            accQk = __builtin_amdgcn_mfma_f32_16x16x32_bf16(fqh, fk, accQk, 0, 0, 0);
            if (MIX == 0) accBC = __builtin_amdgcn_mfma_f32_16x16x32_bf16(ld_frag(OPA + 4 * 576 + ro + ks * 32), fk, accBC, 0, 0, 0);
            if (DELTA) {
              const bf16x8 fka = ld_frag(OPA + 0 * 576 + ro + ks * 32), fb = ld_frag(OPA + 1 * 576 + ro + ks * 32);
              accA = __builtin_amdgcn_mfma_f32_16x16x32_bf16(fka, fb, accA, 0, 0, 0);
              accBm = __builtin_amdgcn_mfma_f32_16x16x32_bf16(fka, fk, accBm, 0, 0, 0);
              accQb = __builtin_amdgcn_mfma_f32_16x16x32_bf16(fqh, fb, accQb, 0, 0, 0);
            }
          }
#pragma unroll
          for (int r = 0; r < 4; r++) {
            const int i = fq * 4 + r;
            const bool ok = fq < 2 && fr < 8;
            if (!(ok && fr < i)) { accA[r] = 0.f; accBm[r] = 0.f; }
            if (!(ok && fr <= i)) { accQb[r] = 0.f; accQk[r] = 0.f; }
          }
          if (MIX == 0 && fq < 2 && fr < 8 && (fr >> 2) == fq) {
            const int r = fr & 3;
            const float bcv = r == 0 ? accBC[0] : (r == 1 ? accBC[1] : (r == 2 ? accBC[2] : accBC[3]));
            BC[(size_t)(seg_row0 + t0 + (dir ? 7 - fr : fr)) * 8 + h * 2 + dir] = bcv;
          }
        }
        *(uint4*)(SB + S3_KVT + lane * 16) = pack8(kck);
#pragma unroll
        for (int i = 0; i < 8; i++) ((u16*)(SB + S3_QB))[i * 72 + lane] = f2bf(qt[i]);
        if (fq < 2 && fr < 8) {
#pragma unroll
          for (int r = 0; r < 4; r++) {
            ((u16*)(SB + S3_QKM))[(fq * 4 + r) * 8 + fr] = f2bf(accQk[r]);
            if (DELTA) ((u16*)(SB + S3_QBM))[(fq * 4 + r) * 8 + fr] = f2bf(accQb[r]);
          }
        }
        if (DELTA) {
          float t[8];
#pragma unroll
          for (int i = 0; i < 8; i++) {
            float ti = (lane == i) ? 1.f : 0.f;
#pragma unroll
            for (int m = 0; m < i; m++) ti -= rlane(accA[i & 3], (i >> 2) * 16 + m) * t[m];
            t[i] = ti;
          }
#pragma unroll
          for (int i = 0; i < 8; i++) ((u16*)(SB + S3_KB))[i * 72 + lane] = f2bf(-kt[i]);
          *(uint4*)(SB + S3_BT + lane * 16) = pack8(bck);
          if (fq < 2 && fr < 8) {
#pragma unroll
            for (int r = 0; r < 4; r++) ((u16*)(SB + S3_TB))[(fq * 4 + r) * 8 + fr] = f2bf(-accBm[r]);
          }
          if (lane < 8) {
#pragma unroll
            for (int i = 0; i < 8; i++) ((u16*)(SB + S3_TM))[i * 8 + lane] = f2bf(t[i]);
          }
        }
      }
    }
    fetch_raw<MIX>(P, min(it + 1, TPB / 64 - 1) * 2 + half, dir, b, h, pw, lane, colv, rawq);
    __syncthreads();
    if (w < 4) {
      unsigned char* STB = smb + S3_STB + w * 2304;
#pragma unroll
      for (int kk = 0; kk < 8; kk++) {
        const int cc = it * 2 + (kk >> 2), k = kk & 3;
        int seg_row0, t_lo;
        if (cc < 8) { seg_row0 = b * TPB; t_lo = dir == 0 ? cc * 32 : (LC - 32 - cc * 32); }
        else { seg_row0 = b * TPB + LC; t_lo = dir == 0 ? (cc - 8) * 32 : (SEQ - 32 - (cc - 8) * 32); }
        const int sc = dir ? 3 - k : k;
        const unsigned char* SB = smb + ((kk >> 2) * 4 + sc) * S3_SUB;
        const bf16x8 bs0 = __builtin_bit_cast(bf16x8, u32x4v{pack2(st[0][0], st[0][1]), pack2(st[0][2], st[0][3]), pack2(st[1][0], st[1][1]), pack2(st[1][2], st[1][3])});
        const bf16x8 bs1 = __builtin_bit_cast(bf16x8, u32x4v{pack2(st[2][0], st[2][1]), pack2(st[2][2], st[2][3]), pack2(st[3][0], st[3][1]), pack2(st[3][2], st[3][3])});
#define LDP(BASE_, ROW_, KS_) ([&]() -> bf16x8 {                                                                   \
          const uint2 lo_ = *(const uint2*)((BASE_) + ((ROW_) * 72 + (KS_) * 32 + fq * 4) * 2);                      \
          const uint2 hi_ = *(const uint2*)((BASE_) + ((ROW_) * 72 + (KS_) * 32 + 16 + fq * 4) * 2);                 \
          return __builtin_bit_cast(bf16x8, u32x4v{lo_.x, lo_.y, hi_.x, hi_.y}); }())
        const bf16x8 bv = fq == 0 ? ld_frag(SB + S3_VT + (w * 16 + fr) * 16) : zfrag();
        const bf16x8 aq0 = LDP(SB + S3_QB, (fr & 7), 0), aq1 = LDP(SB + S3_QB, (fr & 7), 1);
        const bf16x8 aqk = fq == 0 ? ld_frag(SB + S3_QKM + (fr & 7) * 16) : zfrag();
        bf16x8 brv = zfrag();
        if (DELTA) {
          const bf16x8 ak0 = LDP(SB + S3_KB, (fr & 7), 0), ak1 = LDP(SB + S3_KB, (fr & 7), 1);
          const bf16x8 atb = fq == 0 ? ld_frag(SB + S3_TB + (fr & 7) * 16) : zfrag();
          f32x4 accR = __builtin_amdgcn_mfma_f32_16x16x32_bf16(ak0, bs0, z4, 0, 0, 0);
          accR = __builtin_amdgcn_mfma_f32_16x16x32_bf16(ak1, bs1, accR, 0, 0, 0);
          accR = __builtin_amdgcn_mfma_f32_16x16x32_bf16(atb, bv, accR, 0, 0, 0);
          {
            const uint2 t2 = *(const uint2*)(SB + S3_TM + (fr & 7) * 16 + (fq & 1) * 8);
            const u32x4v ta4 = {t2.x, t2.y, 0u, 0u};
            const u32x4v rb4 = {pack2(accR[0], accR[1]), pack2(accR[2], accR[3]), 0u, 0u};
            const bf16x8 at = fq < 2 ? __builtin_bit_cast(bf16x8, ta4) : zfrag();
            const bf16x8 br = fq < 2 ? __builtin_bit_cast(bf16x8, rb4) : zfrag();
            accR = __builtin_amdgcn_mfma_f32_16x16x32_bf16(at, br, z4, 0, 0, 0);
          }
          const uint2 vv2 = *(const uint2*)(SB + S3_VT + (w * 16 + fr) * 16 + (fq & 1) * 8);
          const u32x4v t4 = {pack2(accR[0], accR[1]), pack2(accR[2], accR[3]), vv2.x, vv2.y};
          brv = fq < 2 ? __builtin_bit_cast(bf16x8, t4) : zfrag();
        }
        f32x4 accY = __builtin_amdgcn_mfma_f32_16x16x32_bf16(aq0, bs0, z4, 0, 0, 0);
        accY = __builtin_amdgcn_mfma_f32_16x16x32_bf16(aq1, bs1, accY, 0, 0, 0);
        if (DELTA) {
          const uint2 qb2 = *(const uint2*)(SB + S3_QBM + (fr & 7) * 16 + (fq & 1) * 8);
          const uint2 qk2 = *(const uint2*)(SB + S3_QKM + (fr & 7) * 16 + (fq & 1) * 8);
          const u32x4v q4 = {qb2.x, qb2.y, qk2.x, qk2.y};
          const bf16x8 aqm = fq < 2 ? __builtin_bit_cast(bf16x8, q4) : zfrag();
          accY = __builtin_amdgcn_mfma_f32_16x16x32_bf16(aqm, brv, accY, 0, 0, 0);
        } else {
          accY = __builtin_amdgcn_mfma_f32_16x16x32_bf16(aqk, bv, accY, 0, 0, 0);
        }
        if (fq < 2) {
#pragma unroll
          for (int r = 0; r < 4; r++) {
            const int i = fq * 4 + r, j = dir ? 7 - i : i;
            YS[(size_t)(seg_row0 + t_lo + sc * 8 + j) * YST + dir * 768 + MIX * 256 + h * 64 + w * 16 + fr] = f2bf(accY[r]);
          }
        }
#pragma unroll
        for (int nt = 0; nt < 4; nt++) {
          f32x4 an;
          if (DELTA) {
            const uint2 b2 = *(const uint2*)(SB + S3_BT + (nt * 16 + fr) * 16 + (fq & 1) * 8);
            const uint2 k2 = *(const uint2*)(SB + S3_KVT + (nt * 16 + fr) * 16 + (fq & 1) * 8);
            const u32x4v a4 = {b2.x, b2.y, k2.x, k2.y};
            const bf16x8 am = fq < 2 ? __builtin_bit_cast(bf16x8, a4) : zfrag();
            an = __builtin_amdgcn_mfma_f32_16x16x32_bf16(am, brv, z4, 0, 0, 0);
          } else {
            const bf16x8 akv = fq == 0 ? ld_frag(SB + S3_KVT + (nt * 16 + fr) * 16) : zfrag();
            an = __builtin_amdgcn_mfma_f32_16x16x32_bf16(akv, bv, z4, 0, 0, 0);
          }
          const float4 wc = *(const float4*)(SB + S3_WC + (nt * 16 + fq * 4) * 4);
          st[nt][0] = st[nt][0] * wc.x + an[0];
          st[nt][1] = st[nt][1] * wc.y + an[1];
          st[nt][2] = st[nt][2] * wc.z + an[2];
          st[nt][3] = st[nt][3] * wc.w + an[3];
        }
#undef LDP
      }
    }
    __syncthreads();
  }
}

__device__ __forceinline__ void attn_item(const Params& p, int l, int b, int qb, int hk, bool isctx, unsigned char* smem) {
  u16* KS = (u16*)smem;
  u16* VT = KS + 64 * LDT;
  u16* PL = VT + 64 * LDT;
  float2* ROPE = (float2*)(PL + 8 * 32 * LDT);
  const int tid = TIDX, lane = tid & 63, w = tid >> 6, fr = lane & 15, fq = lane >> 4;
  const u16* P = (const u16*)(p.ws + OFF_BIG);
  u16* Y = (u16*)(p.ws + OFF_YS);
  const int qh = hk * 2 + (w >> 2);
  const int tb = qb * 128 + (w & 3) * 32;
  const int qrow0 = b * TPB + (isctx ? 0 : LC);
  __syncthreads();
  for (int i = tid; i < 1024; i += NTHR) {
    int pos = i >> 4, fi = i & 15;
    float inv = powf(10000.f, -(float)fi / 16.f);
    float sn, cs;
    sincosf((float)pos * inv, &sn, &cs);
    ROPE[i] = make_float2(cs, sn);
  }
  __syncthreads();
  bf16x8 qf[2][2];
#pragma unroll
  for (int mi = 0; mi < 2; mi++)
#pragma unroll
    for (int ks = 0; ks < 2; ks++) {
      const int tq = tb + mi * 16 + fr;
      const u16* qp = P + (size_t)(qrow0 + tq) * PST + PD + qh * 64 + ks * 32;
      uint4 own = *(const uint4*)(qp + fq * 8);
      uint4 par = *(const uint4*)(qp + (fq ^ 2) * 8);
      const unsigned ow[4] = {own.x, own.y, own.z, own.w};
      const unsigned pw[4] = {par.x, par.y, par.z, par.w};
      const int pos = ks == 0 ? (tq >> 6) : (tq & 63);
      bf16x8 f;
#pragma unroll
      for (int jj = 0; jj < 8; jj++) {
        float xo = bf2f((u16)((ow[jj >> 1] >> ((jj & 1) * 16)) & 0xffff));
        float xp = bf2f((u16)((pw[jj >> 1] >> ((jj & 1) * 16)) & 0xffff));
        float v = xo;
        if (!isctx) {
          float2 cs = ROPE[pos * 16 + (fq & 1) * 8 + jj];
          v = fq < 2 ? xo * cs.x - xp * cs.y : xp * cs.y + xo * cs.x;
        }
        f[jj] = (short)f2bf(v * 0.125f);
      }
      qf[mi][ks] = f;
    }
  f32x4 oacc[2][4];
#pragma unroll
  for (int mi = 0; mi < 2; mi++)
#pragma unroll
    for (int nd = 0; nd < 4; nd++) oacc[mi][nd] = f32x4{0.f, 0.f, 0.f, 0.f};
  float mrow[2][4], lrow[2][4];
#pragma unroll
  for (int mi = 0; mi < 2; mi++)
#pragma unroll
    for (int r = 0; r < 4; r++) { mrow[mi][r] = -1e30f; lrow[mi][r] = 0.f; }

  const int q0 = qb * 128;
  const int band_lo = isctx ? 0 : max(0, q0 - 128), band_hi = isctx ? 0 : min(SEQ, q0 + 256);
  const int ntile = 4 + (band_hi - band_lo) / 64;
  u16* pl = PL + w * 32 * LDT;
  for (int tl = 0; tl < ntile; tl++) {
    const bool band = tl >= 4;
    const int k0 = band ? band_lo + (tl - 4) * 64 : tl * 64;
    __syncthreads();
    {
      const int key = tid >> 3, kc = tid & 7;
      const int kpos = k0 + key;
      const u16* kp = P + (size_t)(b * TPB + (band ? LC : 0) + kpos) * PST + PD + 256 + hk * 64;
      uint4 own = *(const uint4*)(kp + kc * 8);
      uint4 vv = *(const uint4*)(kp + 128 + kc * 8);
      uint4 par = *(const uint4*)(kp + (kc ^ 2) * 8);
      if (band) {
        const unsigned ow[4] = {own.x, own.y, own.z, own.w};
        const unsigned pw[4] = {par.x, par.y, par.z, par.w};
        const int pos = kc < 4 ? (kpos >> 6) : (kpos & 63);
        unsigned res[4];
#pragma unroll
        for (int jj = 0; jj < 8; jj += 2) {
          float v2[2];
#pragma unroll
          for (int e = 0; e < 2; e++) {
            float xo = bf2f((u16)((ow[jj >> 1] >> (e * 16)) & 0xffff));
            float xp = bf2f((u16)((pw[jj >> 1] >> (e * 16)) & 0xffff));
            float2 cs = ROPE[pos * 16 + (kc & 1) * 8 + jj + e];
            v2[e] = (kc & 2) == 0 ? xo * cs.x - xp * cs.y : xp * cs.y + xo * cs.x;
          }
          res[jj >> 1] = pack2(v2[0], v2[1]);
        }
        own = make_uint4(res[0], res[1], res[2], res[3]);
      }
      *(uint4*)(KS + key * LDT + kc * 8) = own;
      const unsigned vw[4] = {vv.x, vv.y, vv.z, vv.w};
#pragma unroll
      for (int jj = 0; jj < 8; jj++) VT[(kc * 8 + jj) * LDT + key] = (u16)((vw[jj >> 1] >> ((jj & 1) * 16)) & 0xffff);
    }
    __syncthreads();
    f32x4 sc[2][4];
#pragma unroll
    for (int mi = 0; mi < 2; mi++)
#pragma unroll
      for (int nj = 0; nj < 4; nj++) sc[mi][nj] = f32x4{0.f, 0.f, 0.f, 0.f};
#pragma unroll
    for (int ks = 0; ks < 2; ks++) {
      bf16x8 kf[4];
#pragma unroll
      for (int nj = 0; nj < 4; nj++) kf[nj] = *(const bf16x8*)(KS + (nj * 16 + fr) * LDT + ks * 32 + fq * 8);
#pragma unroll
      for (int mi = 0; mi < 2; mi++)
#pragma unroll
        for (int nj = 0; nj < 4; nj++) sc[mi][nj] = __builtin_amdgcn_mfma_f32_16x16x32_bf16(qf[mi][ks], kf[nj], sc[mi][nj], 0, 0, 0);
    }
#pragma unroll
    for (int mi = 0; mi < 2; mi++)
#pragma unroll
      for (int r = 0; r < 4; r++) {
        const int qpos = tb + mi * 16 + fq * 4 + r;
        float mx = -1e30f;
#pragma unroll
        for (int nj = 0; nj < 4; nj++) {
          float v = sc[mi][nj][r];
          if (band) {
            int d = qpos - (k0 + nj * 16 + fr);
            if (d > 128 || d < -128) v = -1e30f;
          }
          sc[mi][nj][r] = v;
          mx = fmaxf(mx, v);
        }
        mx = fmaxf(mx, __shfl_xor(mx, 1));
        mx = fmaxf(mx, __shfl_xor(mx, 2));
        mx = fmaxf(mx, __shfl_xor(mx, 4));
        mx = fmaxf(mx, __shfl_xor(mx, 8));
        const float mnew = fmaxf(mrow[mi][r], mx);
        const float alpha = __expf(mrow[mi][r] - mnew);
        mrow[mi][r] = mnew;
        float ls = 0.f;
#pragma unroll
        for (int nj = 0; nj < 4; nj++) {
          float pe = __expf(sc[mi][nj][r] - mnew);
          ls += pe;
          pl[(mi * 16 + fq * 4 + r) * LDT + nj * 16 + fr] = f2bf(pe);
        }
        lrow[mi][r] = lrow[mi][r] * alpha + ls;
#pragma unroll
        for (int nd = 0; nd < 4; nd++) oacc[mi][nd][r] *= alpha;
      }
    asm volatile("s_waitcnt lgkmcnt(0)" ::: "memory");
    __builtin_amdgcn_wave_barrier();
#pragma unroll
    for (int ks = 0; ks < 2; ks++) {
      bf16x8 pf[2], vf[4];
#pragma unroll
      for (int mi = 0; mi < 2; mi++) pf[mi] = *(const bf16x8*)(pl + (mi * 16 + fr) * LDT + ks * 32 + fq * 8);
#pragma unroll
      for (int nd = 0; nd < 4; nd++) vf[nd] = *(const bf16x8*)(VT + (nd * 16 + fr) * LDT + ks * 32 + fq * 8);
#pragma unroll
      for (int mi = 0; mi < 2; mi++)
#pragma unroll
        for (int nd = 0; nd < 4; nd++) oacc[mi][nd] = __builtin_amdgcn_mfma_f32_16x16x32_bf16(pf[mi], vf[nd], oacc[mi][nd], 0, 0, 0);
    }
    asm volatile("s_waitcnt lgkmcnt(0)" ::: "memory");
    __builtin_amdgcn_wave_barrier();
  }
  const float sink = p.attn_sink[l * 4 + qh];
#pragma unroll
  for (int mi = 0; mi < 2; mi++)
#pragma unroll
    for (int r = 0; r < 4; r++) {
      float ls = lrow[mi][r];
      ls += __shfl_xor(ls, 1);
      ls += __shfl_xor(ls, 2);
      ls += __shfl_xor(ls, 4);
      ls += __shfl_xor(ls, 8);
      ls += __expf(sink - mrow[mi][r]);
      const float inv = 1.f / ls;
      const int tq = tb + mi * 16 + fq * 4 + r;
#pragma unroll
      for (int nd = 0; nd < 4; nd++) Y[(size_t)(qrow0 + tq) * YST + 1536 + qh * 64 + nd * 16 + fr] = f2bf(oacc[mi][nd][r] * inv);
    }
}

#ifndef SCAN3_MASK
#define SCAN3_MASK 7
#endif
__device__ __forceinline__ void phase_mix(const Params& p, int l, unsigned char* smem) {
  float* sm = (float*)smem;
  const int G = gridDim.x;
  for (int it = blockIdx.x; it < 192; it += G) {
    const int mix = it >> 6, rem = it & 63, b = rem >> 3, h = (rem >> 1) & 3, dir = rem & 1;
    if (mix == 0 && (SCAN3_MASK & 1)) scan3_item<0>(p, l, b, h, dir, smem);
    else if (mix == 1 && (SCAN3_MASK & 2)) scan3_item<1>(p, l, b, h, dir, smem);
    else if (mix == 2 && (SCAN3_MASK & 4)) scan3_item<2>(p, l, b, h, dir, smem);
  }
  if (SCAN3_MASK != 7) {
    for (int it = blockIdx.x; it < 768; it += G) {
      const int mix = it >> 8, rem = it & 255, b = rem >> 5, h = (rem >> 3) & 3, dir = (rem >> 2) & 1, rq = rem & 3;
      if (mix == 0 && !(SCAN3_MASK & 1)) scan2_item<0>(p, l, b, h, dir, rq, sm);
      else if (mix == 1 && !(SCAN3_MASK & 2)) scan2_item<1>(p, l, b, h, dir, rq, sm);
      else if (mix == 2 && !(SCAN3_MASK & 4)) scan2_item<2>(p, l, b, h, dir, rq, sm);
    }
  }
  __syncthreads();
  {
    const bool spread = G >= 192;
    const int nconv = spread ? 64 : G, fidx = spread ? (int)blockIdx.x - 128 : (int)blockIdx.x;
    if (fidx >= 0 && fidx < nconv)
      for (int it = 832 + fidx; it < 4480; it += nconv) conv_item(p, l, it, (float*)smem);
    __syncthreads();
  }
  unsigned* ctr = (unsigned*)(p.ws + OFF_CTR) + l * 16;
  volatile int* slot = (volatile int*)(smem + 131072 - 16);
  for (;;) {
    if (TIDX == 0) *slot = (int)atomicAdd(ctr, 1u);
    __syncthreads();
    const int it = *slot;
    __syncthreads();
    if (it >= (l == 0 ? 544 : 512)) break;
    if (it < 512) {
      int b = it >> 6, qb = (it >> 1) & 31, hk = it & 1;
      attn_item(p, l, b, qb, hk, false, smem);
    } else {
      int r = it - 512, b = r >> 2, qb = (r >> 1) & 1, hk = r & 1;
      attn_item(p, l, b, qb, hk, true, smem);
    }
  }
}

#define POST_DECL(PFX) uint2 PFX##ya0, PFX##ya1, PFX##ya2, PFX##yc0, PFX##yc1, PFX##yc2, PFX##vp, PFX##vc, PFX##vn, PFX##gb, PFX##gc; \
  u16 PFX##xp, PFX##xc, PFX##xn; float2 PFX##bc
#define POST_LOAD(PFX, R_)                                                                         \
  do {                                                                                             \
    const int r_ = (R_);                                                                           \
    const int b_ = r_ / TPB, t_ = r_ - b_ * TPB;                                                   \
    const bool hp_ = (t_ != 0) && (t_ != LC), hn_ = (t_ != LC - 1) && (t_ != TPB - 1);            \
    const u16* ys_ = YSc + (size_t)r_ * YST;                                                       \
    const u16* pr_ = Pc + (size_t)r_ * PST;                                                        \
    const u16* pp_ = pr_ - (hp_ ? PST : 0);                                                        \
    const u16* pn_ = pr_ + (hn_ ? PST : 0);                                                        \
    PFX##ya0 = *(const uint2*)(ys_ + j0); PFX##ya1 = *(const uint2*)(ys_ + 256 + j0); PFX##ya2 = *(const uint2*)(ys_ + 512 + j0); \
    PFX##yc0 = *(const uint2*)(ys_ + 768 + j0); PFX##yc1 = *(const uint2*)(ys_ + 1024 + j0); PFX##yc2 = *(const uint2*)(ys_ + 1280 + j0); \
    PFX##vp = *(const uint2*)(pp_ + PA + 512 + j0);                                                \
    PFX##vc = *(const uint2*)(pr_ + PA + 512 + j0);                                                \
    PFX##vn = *(const uint2*)(pn_ + PA + 512 + j0);                                                \
    PFX##gb = *(const uint2*)(pr_ + PB + 784 + j0);                                                \
    PFX##gc = *(const uint2*)(pr_ + PC + 544 + j0);                                                \
    PFX##xp = pp_[PA + 896 + lane]; PFX##xc = pr_[PA + 896 + lane]; PFX##xn = pn_[PA + 896 + lane]; \
    PFX##bc = *(const float2*)(BCc + (size_t)r_ * 8 + (lane >> 4) * 2);                            \
  } while (0)
__device__ __forceinline__ void unpack4(uint2 v, float (&o)[4]) {
  o[0] = __uint_as_float(v.x << 16); o[1] = __uint_as_float(v.x & 0xffff0000u);
  o[2] = __uint_as_float(v.y << 16); o[3] = __uint_as_float(v.y & 0xffff0000u);
}

__device__ __forceinline__ void phase_post(const Params& p, int l, float* g2s) {
  const int lane = TIDX & 63, wv = __builtin_amdgcn_readfirstlane(TIDX >> 6);
  u16* YS = (u16*)(p.ws + OFF_YS);
  const int j0 = lane * 4;
  {
    const float4* src = (const float4*)(p.rwkv_g2 + (size_t)l * 64 * 256);
    for (int i = TIDX; i < 64 * 256 / 4; i += NTHR) ((float4*)g2s)[i] = src[i];
  }
  float mu_v[4], lng[4], lnb[4], ngb[4], ngc[4];
#pragma unroll
  for (int i = 0; i < 4; i++) {
    mu_v[i] = p.rwkv_mu[l * 960 + 512 + j0 + i];
    lng[i] = p.rwkv_ln_g[l * 256 + j0 + i];
    lnb[i] = p.rwkv_ln_b[l * 256 + j0 + i];
    ngb[i] = p.gdn_norm_g[l * 64 + (lane & 15) * 4 + i];
    ngc[i] = p.gla_norm_g[l * 64 + (lane & 15) * 4 + i];
  }
  const float mu_x = p.rwkv_mu[l * 960 + 896 + lane];
  __syncthreads();
  const int stride = gridDim.x * 8;
  int r = blockIdx.x * 8 + wv;
  const u16* Pc = (const u16*)(p.ws + OFF_BIG);
  const u16* YSc = (const u16*)(p.ws + OFF_YS);
  const float* BCc = (const float*)(p.ws + OFF_BC);
  POST_DECL(cur_);
  POST_DECL(nxt_);
  POST_LOAD(cur_, r);
  for (; r < NROWS; r += stride) {
    const int rn = r + stride < NROWS ? r + stride : r;
    POST_LOAD(nxt_, rn);
    const int b = r / TPB, t = r - b * TPB;
    const float pmul = ((t != 0) && (t != LC)) ? 1.f : 0.f, nmul = ((t != LC - 1) && (t != TPB - 1)) ? 1.f : 0.f;
    if (!(l == 1 && t < LC)) {
    float y[3][4];
    {
      float a4[4], c4[4];
      unpack4(cur_ya0, a4); unpack4(cur_yc0, c4);
#pragma unroll
      for (int i = 0; i < 4; i++) y[0][i] = a4[i] + c4[i];
      unpack4(cur_ya1, a4); unpack4(cur_yc1, c4);
#pragma unroll
      for (int i = 0; i < 4; i++) y[1][i] = a4[i] + c4[i];
      unpack4(cur_ya2, a4); unpack4(cur_yc2, c4);
#pragma unroll
      for (int i = 0; i < 4; i++) y[2][i] = a4[i] + c4[i];
    }
    float o[3][4];
    {
      float sum = y[0][0] + y[0][1] + y[0][2] + y[0][3];
      sum = red16(sum);
      const float mean = sum * (1.f / 64.f);
      float vs = 0.f;
#pragma unroll
      for (int i = 0; i < 4; i++) { float d = y[0][i] - mean; vs += d * d; }
      vs = red16(vs);
      const float rstd = rsq(vs * (1.f / 64.f) + 64e-5f);
      const float pv = bf2f(cur_xc), ppv = bf2f(cur_xp) * pmul, pnv = bf2f(cur_xn) * nmul;
      const float sg = sigm(pv + (0.5f * (ppv + pnv) - pv) * mu_x);
      float gate[4] = {0.f, 0.f, 0.f, 0.f};
      const float* g2 = g2s + j0;
#pragma unroll 8
      for (int i = 0; i < 64; i++) {
        const float si = __int_as_float(__builtin_amdgcn_readlane(__float_as_int(sg), i));
        const float4 gw = *(const float4*)(g2 + i * 256);
        gate[0] += si * gw.x; gate[1] += si * gw.y; gate[2] += si * gw.z; gate[3] += si * gw.w;
      }
      const float bcs = cur_bc.x + cur_bc.y;
      float vc4[4], vp4[4], vn4[4];
      unpack4(cur_vc, vc4); unpack4(cur_vp, vp4); unpack4(cur_vn, vn4);
#pragma unroll
      for (int i = 0; i < 4; i++) {
        const float v = vc4[i] + (0.5f * (vp4[i] * pmul + vn4[i] * nmul) - vc4[i]) * mu_v[i];
        const float yn = (y[0][i] - mean) * rstd * lng[i] + lnb[i];
        o[0][i] = (yn + bcs * v) * gate[i];
      }
    }
#pragma unroll
    for (int m = 1; m < 3; m++) {
      float ss = y[m][0] * y[m][0] + y[m][1] * y[m][1] + y[m][2] * y[m][2] + y[m][3] * y[m][3];
      ss = red16(ss);
      const float inv = rsq(ss * (1.f / 64.f) + 1e-6f);
      float g4[4];
      unpack4(m == 1 ? cur_gb : cur_gc, g4);
#pragma unroll
      for (int i = 0; i < 4; i++) o[m][i] = y[m][i] * inv * (m == 1 ? ngb[i] : ngc[i]) * siluf(g4[i]);
    }
    u16* ys = YS + (size_t)r * YST;
#pragma unroll
    for (int m = 0; m < 3; m++) {
      uint2 ov;
      ov.x = pack2(o[m][0], o[m][1]);
      ov.y = pack2(o[m][2], o[m][3]);
      *(uint2*)(ys + m * 256 + j0) = ov;
    }
    }
    cur_ya0 = nxt_ya0; cur_ya1 = nxt_ya1; cur_ya2 = nxt_ya2; cur_yc0 = nxt_yc0; cur_yc1 = nxt_yc1; cur_yc2 = nxt_yc2;
    cur_vp = nxt_vp; cur_vc = nxt_vc; cur_vn = nxt_vn; cur_gb = nxt_gb; cur_gc = nxt_gc;
    cur_xp = nxt_xp; cur_xc = nxt_xc; cur_xn = nxt_xn; cur_bc = nxt_bc;
  }
}

#define XB_TMO      128
#define XB_XCNT(j)  (256  + 64 * (j))
#define XB_XSUB(j)  (1280 + 64 * (j))
#define XB_XGEN(j)  (2304 + 64 * (j))
#define XB_TOP      3328
#define XB_TOPGEN   3392
#define XCD_BAR_WORDS 3456
#define XB_SPIN_CAP (1u << 18)
#define LAS __attribute__((address_space(3)))

__device__ __forceinline__ unsigned xb_ld(unsigned* p)              { return __hip_atomic_load(p, __ATOMIC_RELAXED, __HIP_MEMORY_SCOPE_AGENT); }
__device__ __forceinline__ unsigned xb_add(unsigned* p, unsigned v) { return __hip_atomic_fetch_add(p, v, __ATOMIC_RELAXED, __HIP_MEMORY_SCOPE_AGENT); }
__device__ __forceinline__ unsigned xb_xcc_id() { return (unsigned)__builtin_amdgcn_s_getreg((3 << 11) | 20) & 0xFu; }
#define XB_SPIN(cond, bar) do { unsigned _sp = 0; while (cond) { __builtin_amdgcn_s_sleep(1); \
    if ((++_sp & 255u) == 0u) { if (xb_ld(&(bar)[XB_TMO])) break; if (_sp > XB_SPIN_CAP) { atomicAdd(&(bar)[XB_TMO], 1u); break; } } } } while (0)

struct XcdBarrier {
    unsigned* bar; unsigned x;
    volatile LAS unsigned* st;
};

__device__ __forceinline__ XcdBarrier xcd_barrier_post(unsigned* bar, volatile LAS unsigned* st) {
    XcdBarrier b; b.bar = bar; b.x = xb_xcc_id(); b.st = st;
    if (threadIdx.x == 0) (void)xb_add(&bar[XB_XCNT(b.x)], 1u);
    return b;
}
__device__ __forceinline__ void xcd_barrier_complete(unsigned* bar, unsigned x, unsigned& nloc, unsigned& nx) {
    const unsigned G = gridDim.x * gridDim.y * gridDim.z;
    unsigned sum, cnt, mine, sp = 0u;
    for (;;) {
        sum = 0u; cnt = 0u; mine = 0u;
#pragma unroll
        for (unsigned j = 0; j < 16; ++j) { const unsigned c = xb_ld(&bar[XB_XCNT(j)]); sum += c; cnt += (c > 0u) ? 1u : 0u; mine = (j == x) ? c : mine; }
        if (sum == G) break;
        __builtin_amdgcn_s_sleep(1);
        if ((++sp & 255u) == 0u) { if (xb_ld(&bar[XB_TMO])) break; if (sp > XB_SPIN_CAP) { atomicAdd(&bar[XB_TMO], 1u); break; } }
    }
    nloc = mine > 0u ? mine : 1u; nx = cnt > 0u ? cnt : 1u;
}

__device__ __forceinline__ void xcd_barrier(const XcdBarrier& b) {
    asm volatile("s_waitcnt vmcnt(0)" ::: "memory");
    __syncthreads();
    if (threadIdx.x == 0) {
        unsigned* bar = b.bar;
        __builtin_amdgcn_s_waitcnt(0);
        unsigned nloc = b.st[0], nx = b.st[1];
        if (nloc == 0u) { xcd_barrier_complete(bar, b.x, nloc, nx); b.st[0] = nloc; b.st[1] = nx; }
        const unsigned old = xb_add(&bar[XB_XSUB(b.x)], 1u);
        const unsigned gen = old / nloc;
        if (old + 1u == (gen + 1u) * nloc) {
            __builtin_amdgcn_fence(__ATOMIC_RELEASE, "agent");
            asm volatile("s_waitcnt vmcnt(0)" ::: "memory");
            const unsigned og = xb_add(&bar[XB_TOP], 1u);
            const unsigned tg = og / nx;
            if (og + 1u == (tg + 1u) * nx) xb_add(&bar[XB_TOPGEN], 1u);
            else XB_SPIN(xb_ld(&bar[XB_TOPGEN]) == tg, bar);
            __builtin_amdgcn_fence(__ATOMIC_ACQUIRE, "agent");
            xb_add(&bar[XB_XGEN(b.x)], 1u);
            asm volatile("s_waitcnt vmcnt(0)" ::: "memory");
        } else {
            XB_SPIN(xb_ld(&bar[XB_XGEN(b.x)]) == gen, bar);
            __builtin_amdgcn_fence(__ATOMIC_ACQUIRE, "agent");
            asm volatile("s_waitcnt vmcnt(0)" ::: "memory");
        }
    }
    __syncthreads();
}

#if defined(SKIPS)
#define EN(k) (SKIPS != (k))
#elif !defined(ONLYS)
#define EN(k) 1
#else
#define EN(k) (ONLYS == (k))
#endif
__device__ __forceinline__ void run_phase(const Params& p, int ph, unsigned char* smem) {
  if (ph == 0) { if (EN(10)) phase_init0(p, (float*)smem); return; }
  if (ph == 1) { if (EN(11)) phase_init1(p); return; }
  int l = 0, s = 10;
  if (ph >= 3) { l = (ph - 3) / 10; s = (ph - 3) - l * 10; }
  unsigned char* wl = p.ws + OFF_W;
  PG8_LAS unsigned char* lds = (PG8_LAS unsigned char*)smem;
  pg8::StaticOrder S;
  if (s == 10 || s == 6 || s == 9) {
    if (EN(5)) rowpass(p, l, s == 10 ? 0 : (s == 6 ? 1 : 2));
    if (s == 9 && l == 0) {
      __syncthreads();
      for (int it = blockIdx.x; it < 832; it += gridDim.x) conv_item(p, 1, it, (float*)smem);
    }
  } else if (s == 0 || s == 3 || s == 5 || s == 8) {
    pg8::Gemm g; EpiBf E;
    g.M = NROWS; E.bias = nullptr; E.act = 0;
    if (s == 0) { g.A = (const u16*)(p.ws + OFF_H); g.lda = DM; g.Bt = (const u16*)(wl + OW_IN); g.K = DM; g.N = PST; E.O = (u16*)(p.ws + OFF_BIG); E.ldc = PST; }
    else if (s == 3) {
      g.A = (const u16*)(p.ws + OFF_H); g.lda = DM; g.Bt = (const u16*)(wl + OW_G); g.K = DM; g.N = 4096;
      E.O = (u16*)(p.ws + OFF_BIG); E.ldc = 4096; E.bias = p.gate_b + (size_t)l * 4096; E.act = 1;
    }
    else if (s == 5) { g.A = (const u16*)(p.ws + OFF_H); g.lda = DM; g.Bt = (const u16*)(wl + OW_O); g.K = DM; g.N = DM; E.O = (u16*)(p.ws + OFF_BIG); E.ldc = DM; }
    else { g.A = (const u16*)(p.ws + OFF_BIG); g.lda = FH; g.Bt = (const u16*)(wl + OW_2); g.K = FH; g.N = DM; E.O = (u16*)(p.ws + OFF_YS); E.ldc = DM; }
    if (l == 1 && s != 0) S.init(NBATCH * SEQ, g.N, gridDim.x, blockIdx.x, 1);
    else S.init(g.M, g.N, gridDim.x, blockIdx.x);
    if (EN(0)) pg8::gemm_phase<EpiBf, pg8::StaticOrder, false>(lds, g, S, E, nullptr);
  } else if (s == 4) {
    if (EN(3)) phase_ypart(p, l, smem);
  } else if (s == 1) {
    if (EN(1)) phase_mix(p, l, smem);
  } else if (s == 2) {
    if (EN(2)) phase_post(p, l, (float*)smem);
  } else {
    pg8::Gemm g; EpiSwiglu E;
    g.M = NROWS; g.N = 2 * FH; g.K = DM; g.lda = DM; g.A = (const u16*)(p.ws + OFF_H); g.Bt = (const u16*)(wl + OW_1);
    E.O = (u16*)(p.ws + OFF_BIG);
    if (l == 1) S.init(NBATCH * SEQ, g.N, gridDim.x, blockIdx.x, 1);
    else S.init(g.M, g.N, gridDim.x, blockIdx.x);
    if (EN(6)) pg8::gemm_phase<EpiSwiglu, pg8::StaticOrder, false>(lds, g, S, E, nullptr);
  }
}

__global__ void __launch_bounds__(NTHR) hybrid_flow_mega(Params p, int ph0, int ph1) {
  __shared__ __attribute__((aligned(16))) unsigned char smem[131072];
  __shared__ __attribute__((aligned(16))) unsigned xbw[4];
  cg::grid_group grid = cg::this_grid();
  XcdBarrier xb;
  xb.bar = (unsigned*)(p.ws + OFF_XBAR); xb.x = 0u; xb.st = (volatile LAS unsigned*)xbw;
  for (int ph = ph0; ph < ph1; ph++) {
    run_phase(p, ph, smem);
#ifdef DUPMASK
    {
      int sidx = ph >= 3 ? (ph - 3) % 10 : 12 + ph;
      if ((DUPMASK >> sidx) & 1) { __syncthreads(); run_phase(p, ph, smem); }
    }
#endif
    if (ph + 1 < ph1) {
      if (ph == ph0) {
        grid.sync();
        if (threadIdx.x < 4) xbw[threadIdx.x] = 0u;
        __syncthreads();
        xb = xcd_barrier_post((unsigned*)(p.ws + OFF_XBAR), (volatile LAS unsigned*)xbw);
      } else {
        xcd_barrier(xb);
      }
    }
  }
  if (ph1 - ph0 > 2 && threadIdx.x == 0 && xb_ld(&xb.bar[XB_TMO]) != 0u) p.out[blockIdx.x] = __int_as_float(0x7fc00000);
}

extern "C" void kernel_launch(void* const* d_in, const int* in_sizes, int n_in, void* d_out, int out_size, void* d_ws,
                              size_t ws_size, hipStream_t stream) {
  Params p{};
  const float** pp = (const float**)&p;
  for (int i = 0; i < 32; i++) pp[i] = (const float*)d_in[i];
  p.out = (float*)d_out;
  p.ws = (unsigned char*)d_ws;
  static int grid_blocks = 0;
  if (!grid_blocks) {
    int dev = 0, cus = 0, per_cu = 0;
    hipGetDevice(&dev);
    hipDeviceGetAttribute(&cus, hipDeviceAttributeMultiprocessorCount, dev);
    hipOccupancyMaxActiveBlocksPerMultiprocessor(&per_cu, hybrid_flow_mega, NTHR, 0);
    if (per_cu < 1) per_cu = 1;
    grid_blocks = cus * per_cu;
  }
#ifdef MULTI_LAUNCH
  for (int ph = 0; ph < NPHASE; ph++) {
    hipLaunchKernelGGL(hybrid_flow_mega, dim3(grid_blocks), dim3(NTHR), 0, stream, p, ph, ph + 1);
  }
#else
  int ph0 = 0, ph1 = NPHASE;
  void* args[] = {&p, &ph0, &ph1};
  hipError_t e = hipLaunchCooperativeKernel((void*)hybrid_flow_mega, dim3(grid_blocks), dim3(NTHR), args, 0, stream);
  if (e != hipSuccess) fprintf(stderr, "cooperative launch failed: %s (grid %d)\n", hipGetErrorString(e), grid_blocks);
#endif
}
```

```cpp
#include <hip/hip_runtime.h>
#include <hip/hip_cooperative_groups.h>
#include <cstdio>
namespace cg = cooperative_groups;

typedef unsigned short u16;
using bf16x8 = __attribute__((ext_vector_type(8))) short;
using f32x4 = __attribute__((ext_vector_type(4))) float;

#define DM 1024
#define NBATCH 8
#define SEQ 4096
#define LC 256
#define TPB 4352
#define NROWS 34816
#define PST 3328
#define YST 1792
#define FH 2816
#define INW 7408
#define NTHR 512
#define PA 0
#define PB 960
#define PC 2000
#define PD 2800
#define NPHASE 23
#define SCAN3_MASK 7

struct Params {
  const float *x, *c, *ctx, *c_ctx, *ada_w, *ada_b, *norm_g, *w_in, *gate_b, *w_branch, *w_out,
      *rwkv_mu, *rwkv_w0, *rwkv_w2, *rwkv_a0, *rwkv_a2, *rwkv_g2, *rwkv_kk, *rwkv_ka, *rwkv_rk, *rwkv_ln_g,
      *rwkv_ln_b, *gdn_conv, *gdn_a_log, *gdn_dt_bias, *gdn_norm_g, *gla_gw2, *gla_gb, *gla_norm_g, *attn_sink,
      *ffn_w1, *ffn_w2;
  float* out;
  unsigned char* ws;
};

constexpr size_t SZ_WL = 36700160;
constexpr size_t OW_IN = 0;
constexpr size_t OW_G = OW_IN + (size_t)PST * 1024 * 2;
constexpr size_t OW_B = OW_G + (size_t)4096 * 1024 * 2;
constexpr size_t OW_O = OW_B + (size_t)4 * 1024 * 256 * 2;
constexpr size_t OW_1 = OW_O + (size_t)1024 * 1024 * 2;
constexpr size_t OW_2 = OW_1 + (size_t)5632 * 1024 * 2;
static_assert(OW_2 + (size_t)1024 * FH * 2 == SZ_WL, "weights size");
constexpr size_t SZ_ACT = (size_t)NROWS * DM * 2;
constexpr size_t OFF_W = 0;
constexpr size_t OFF_XC = OFF_W + SZ_WL;
constexpr size_t OFF_MODP = OFF_XC + (size_t)NBATCH * LC * DM * 4;
constexpr size_t OFF_MOD = OFF_MODP + (size_t)2 * 8 * 9 * 6144 * 4;
constexpr size_t OFF_BC = OFF_MOD + (size_t)2 * 9 * 6144 * 4;
constexpr size_t OFF_H = OFF_BC + (size_t)NROWS * 8 * 4;
constexpr size_t OFF_YS = OFF_H + SZ_ACT;
constexpr size_t OFF_BIG = OFF_YS + (size_t)NROWS * YST * 2;
constexpr size_t OFF_CTR = OFF_BIG + (size_t)NROWS * 4096 * 2;
constexpr size_t OFF_XBAR = OFF_CTR + 256;
constexpr size_t WS_END = OFF_XBAR + 3456 * 4;
static_assert(WS_END <= (size_t)536870912, "ws too large");

__device__ __forceinline__ int launder_tid() { int t = threadIdx.x; asm volatile("" : "+v"(t)); return t; }
#define TIDX (launder_tid())
typedef float f32x2_t __attribute__((ext_vector_type(2)));
typedef __bf16 bf16x2_t __attribute__((ext_vector_type(2)));
__device__ __forceinline__ unsigned pack2(float a, float b) {
  const f32x2_t v = {a, b};
  const bf16x2_t r = __builtin_convertvector(v, bf16x2_t);
  return __builtin_bit_cast(unsigned, r);
}
__device__ __forceinline__ u16 f2bf(float f) { return (u16)(pack2(f, 0.f) & 0xffffu); }
__device__ __forceinline__ float bf2f(u16 h) { return __uint_as_float(((unsigned)h) << 16); }
__device__ __forceinline__ float sigm(float x) { return __builtin_amdgcn_rcpf(1.f + __expf(-x)); }
__device__ __forceinline__ float siluf(float x) { return x * __builtin_amdgcn_rcpf(1.f + __expf(-x)); }
__device__ __forceinline__ float rsq(float x) { return __builtin_amdgcn_rsqf(x); }
__device__ __forceinline__ float softplusf(float x) { return fmaxf(x, 0.f) + __logf(1.f + __expf(-fabsf(x))); }
__device__ __forceinline__ float tanh_fast(float x) { return 1.f - 2.f * __builtin_amdgcn_rcpf(1.f + __expf(2.f * x)); }
__device__ __forceinline__ float wsum(float v) {
#pragma unroll
  for (int o = 32; o > 0; o >>= 1) v += __shfl_xor(v, o);
  return v;
}
template <int CTRL>
__device__ __forceinline__ float dppf(float x) {
  return __int_as_float(__builtin_amdgcn_update_dpp(__float_as_int(x), __float_as_int(x), CTRL, 0xf, 0xf, false));
}
__device__ __forceinline__ float red8(float x) {
  x += dppf<0xB1>(x);
  x += dppf<0x4E>(x);
  x += dppf<0x141>(x);
  return x;
}
__device__ __forceinline__ const float* xin_row(const Params& p, int r) {
  int b = r / TPB, t = r - b * TPB;
  return t < LC ? p.ctx + ((size_t)(b * LC + t)) * DM : p.x + ((size_t)(b * SEQ + t - LC)) * DM;
}
__device__ __forceinline__ float* x_row(const Params& p, int r) {
  int b = r / TPB, t = r - b * TPB;
  return t < LC ? (float*)(p.ws + OFF_XC) + ((size_t)(b * LC + t)) * DM : p.out + ((size_t)(b * SEQ + t - LC)) * DM;
}
__device__ __forceinline__ int mod_row(int r) {
  int b = r / TPB, t = r - b * TPB;
  return t < LC ? 8 : b;
}

struct MapId { int lim, off; __device__ int operator()(int n) const { return n < lim ? n + off : -1; } };
struct MapW1 { __device__ int operator()(int n) const { int q = n >> 3, s = n & 7; return s < 4 ? q * 4 + s : FH + q * 4 + (s - 4); } };

template <class Map>
__device__ __forceinline__ void conv_tile(const float* __restrict__ src, int ld, u16* __restrict__ dst, int K, int n0,
                                          int k0, Map map, float* tile) {
  const int tid = TIDX;
  const int nn = tid & 63, kr = tid >> 6;
  const int sc = map(n0 + nn);
  float tv[8];
  const int scc = sc >= 0 ? sc : 0;
  const float scm = sc >= 0 ? 1.f : 0.f;
#pragma unroll
  for (int ps = 0; ps < 8; ps++) tv[ps] = src[(size_t)(k0 + ps * 8 + kr) * ld + scc];
#pragma unroll
  for (int ps = 0; ps < 8; ps++) tile[(ps * 8 + kr) * 65 + nn] = tv[ps] * scm;
  __syncthreads();
  const int n2 = tid >> 3, kc = tid & 7;
  uint4 o;
  o.x = pack2(tile[(kc * 8 + 0) * 65 + n2], tile[(kc * 8 + 1) * 65 + n2]);
  o.y = pack2(tile[(kc * 8 + 2) * 65 + n2], tile[(kc * 8 + 3) * 65 + n2]);
  o.z = pack2(tile[(kc * 8 + 4) * 65 + n2], tile[(kc * 8 + 5) * 65 + n2]);
  o.w = pack2(tile[(kc * 8 + 6) * 65 + n2], tile[(kc * 8 + 7) * 65 + n2]);
  *(uint4*)(dst + (size_t)(n0 + n2) * K + k0 + kc * 8) = o;
  __syncthreads();
}

__device__ __forceinline__ void conv_item(const Params& p, int l, int rem, float* sm) {
      u16* wl = (u16*)(p.ws + OFF_W);
      if (rem < 832) {
        int nt = rem >> 4, kt = rem & 15;
        conv_tile(p.w_in + (size_t)l * DM * INW, INW, (u16*)((char*)wl + OW_IN), 1024, nt * 64, kt * 64, MapId{3312, 0}, sm);
      } else if (rem < 832 + 1024) {
        rem -= 832;
        int nt = rem >> 4, kt = rem & 15;
        conv_tile(p.w_in + (size_t)l * DM * INW, INW, (u16*)((char*)wl + OW_G), 1024, nt * 64, kt * 64, MapId{4096, 3312}, sm);
      } else if (rem < 1856 + 256) {
        rem -= 1856;
        int br = rem >> 6, r2 = rem & 63, nt = r2 >> 2, kt = r2 & 3;
        conv_tile(p.w_branch + ((size_t)(l * 4 + br)) * 256 * DM, DM, (u16*)((char*)wl + OW_B) + (size_t)br * 1024 * 256, 256,
                  nt * 64, kt * 64, MapId{1024, 0}, sm);
      } else if (rem < 2112 + 256) {
        rem -= 2112;
        int nt = rem >> 4, kt = rem & 15;
        conv_tile(p.w_out + (size_t)l * DM * DM, DM, (u16*)((char*)wl + OW_O), 1024, nt * 64, kt * 64, MapId{1024, 0}, sm);
      } else if (rem < 2368 + 1408) {
        rem -= 2368;
        int nt = rem >> 4, kt = rem & 15;
        conv_tile(p.ffn_w1 + (size_t)l * DM * 5632, 5632, (u16*)((char*)wl + OW_1), 1024, nt * 64, kt * 64, MapW1{}, sm);
      } else {
        rem -= 3776;
        int nt = rem / 44, kt = rem - nt * 44;
        conv_tile(p.ffn_w2 + (size_t)l * FH * DM, DM, (u16*)((char*)wl + OW_2), FH, nt * 64, kt * 64, MapId{1024, 0}, sm);
      }
}

__device__ __forceinline__ void phase_init0(const Params& p, float* sm) {
  const int tid = TIDX;
  if (blockIdx.x == 0) {
    if (tid < 64) ((unsigned*)(p.ws + OFF_CTR))[tid] = 0u;
    for (int i = tid; i < 3456; i += NTHR) ((unsigned*)(p.ws + OFF_XBAR))[i] = 0u;
  }
  constexpr int NMOD = 192, NCONV = 832;
  for (int it = blockIdx.x; it < NMOD + NCONV; it += gridDim.x) {
    if (it < NMOD) {
      int l = it / 96, rem = it - l * 96, cc = rem >> 3, ks = rem & 7;
      for (int i = tid; i < 9 * 128; i += NTHR) {
        int r = i >> 7, k = i & 127;
        float v = r < 8 ? p.c[r * DM + ks * 128 + k] : p.c_ctx[ks * 128 + k];
        sm[i] = siluf(v);
      }
      __syncthreads();
      const int n = cc * 512 + tid;
      const float* w = p.ada_w + ((size_t)l * DM + ks * 128) * 6144 + n;
      float acc[9];
#pragma unroll
      for (int r = 0; r < 9; r++) acc[r] = 0.f;
#pragma unroll 1
      for (int k0 = 0; k0 < 128; k0 += 16) {
        float wv[16];
#pragma unroll
        for (int kk = 0; kk < 16; kk++) wv[kk] = w[(size_t)(k0 + kk) * 6144];
#pragma unroll
        for (int kk = 0; kk < 16; kk++)
#pragma unroll
          for (int r = 0; r < 9; r++) acc[r] += sm[r * 128 + k0 + kk] * wv[kk];
      }
      float* mp = (float*)(p.ws + OFF_MODP) + ((size_t)(l * 8 + ks) * 9) * 6144 + n;
#pragma unroll
      for (int r = 0; r < 9; r++) mp[(size_t)r * 6144] = acc[r];
      __syncthreads();
    } else {
      conv_item(p, 0, it - NMOD, sm);
    }
  }
}

__device__ __forceinline__ void phase_init1(const Params& p) {
  const float* mp = (const float*)(p.ws + OFF_MODP);
  float* mo = (float*)(p.ws + OFF_MOD);
  for (int i = blockIdx.x * NTHR + TIDX; i < 2 * 9 * 6144; i += gridDim.x * NTHR) {
    int l = i / (9 * 6144), rem = i - l * 9 * 6144, r = rem / 6144, n = rem - r * 6144;
    float s = p.ada_b[l * 6144 + n];
#pragma unroll
    for (int ks = 0; ks < 8; ks++) s += mp[((size_t)((l * 8 + ks) * 9 + r)) * 6144 + n];
    mo[i] = s;
  }
}

__device__ __forceinline__ void rowpass(const Params& p, int l, int mode) {
  const int lane = TIDX & 63, wv = __builtin_amdgcn_readfirstlane(TIDX >> 6);
  const float* MOD = (const float*)(p.ws + OFF_MOD);
  u16* H = (u16*)(p.ws + OFF_H);
  const bool do_norm = !(mode == 2 && l == 1);
  const int ln = (mode == 2) ? (l == 1 ? l : l + 1) : l;
  const int ni = (mode == 1) ? 2 : 0, sho = (mode == 1) ? 3072 : 0, sco = (mode == 1) ? 4096 : 1024;
  for (int r = blockIdx.x * 8 + wv; r < NROWS; r += gridDim.x * 8) {
    const int mr = mod_row(r);
    if (l == 1 && mode != 0 && mr == 8) continue;
    const float* modl = MOD + ((size_t)(l * 9 + mr)) * 6144;
    const float* modn = MOD + ((size_t)(ln * 9 + mr)) * 6144;
    const float* ng2 = p.norm_g + (size_t)(ln * 4 + ni) * DM;
    const float* xs = (mode == 0 || (mode == 1 && l == 0)) ? xin_row(p, r) : (const float*)x_row(p, r);
    float4 xo[4], n2[4], sc4[4], sh4[4];
#pragma unroll
    for (int i = 0; i < 4; i++) {
      const int col = i * 256 + lane * 4;
      xo[i] = *(const float4*)(xs + col);
      n2[i] = *(const float4*)(ng2 + col);
      sc4[i] = *(const float4*)(modn + sco + col);
      sh4[i] = *(const float4*)(modn + sho + col);
    }
    float xv[16];
    if (mode == 0) {
#pragma unroll
      for (int i = 0; i < 4; i++) { xv[i * 4 + 0] = xo[i].x; xv[i * 4 + 1] = xo[i].y; xv[i * 4 + 2] = xo[i].z; xv[i * 4 + 3] = xo[i].w; }
    } else {
      const u16* src = (const u16*)(p.ws + (mode == 1 ? OFF_BIG : OFF_YS)) + (size_t)r * DM;
      const float* ng = p.norm_g + (size_t)(l * 4 + (mode == 1 ? 1 : 3)) * DM;
      const float* gt = modl + (mode == 1 ? 2048 : 5120);
      uint2 sv[4];
      float4 g4[4], n4[4];
#pragma unroll
      for (int i = 0; i < 4; i++) {
        const int col = i * 256 + lane * 4;
        {
          typedef unsigned u32x2nt __attribute__((ext_vector_type(2)));
          const u32x2nt t2 = __builtin_nontemporal_load((const u32x2nt*)(src + col));
          sv[i] = make_uint2(t2.x, t2.y);
        }
        g4[i] = *(const float4*)(gt + col);
        n4[i] = *(const float4*)(ng + col);
      }
      float ov[16];
      float ss = 0.f;
#pragma unroll
      for (int i = 0; i < 4; i++) {
        ov[i * 4 + 0] = __uint_as_float(sv[i].x << 16); ov[i * 4 + 1] = __uint_as_float(sv[i].x & 0xffff0000u);
        ov[i * 4 + 2] = __uint_as_float(sv[i].y << 16); ov[i * 4 + 3] = __uint_as_float(sv[i].y & 0xffff0000u);
      }
#pragma unroll
      for (int i = 0; i < 16; i++) ss += ov[i] * ov[i];
      ss = wsum(ss);
      const float inv = rsq(ss * (1.f / 1024.f) + 1e-6f);
      float* xd = x_row(p, r);
#pragma unroll
      for (int i = 0; i < 4; i++) {
        xv[i * 4 + 0] = xo[i].x + g4[i].x * (ov[i * 4 + 0] * inv * n4[i].x);
        xv[i * 4 + 1] = xo[i].y + g4[i].y * (ov[i * 4 + 1] * inv * n4[i].y);
        xv[i * 4 + 2] = xo[i].z + g4[i].z * (ov[i * 4 + 2] * inv * n4[i].z);
        xv[i * 4 + 3] = xo[i].w + g4[i].w * (ov[i * 4 + 3] * inv * n4[i].w);
      }
#pragma unroll
      for (int i = 0; i < 4; i++)
        *(float4*)(xd + i * 256 + lane * 4) = make_float4(xv[i * 4 + 0], xv[i * 4 + 1], xv[i * 4 + 2], xv[i * 4 + 3]);
    }
    if (!do_norm) continue;
    float ss2 = 0.f;
#pragma unroll
    for (int i = 0; i < 16; i++) ss2 += xv[i] * xv[i];
    ss2 = wsum(ss2);
    const float inv2 = rsq(ss2 * (1.f / 1024.f) + 1e-6f);
#pragma unroll
    for (int i = 0; i < 4; i++) {
      const int col = i * 256 + lane * 4;
      float h0 = xv[i * 4 + 0] * inv2 * n2[i].x * (1.f + sc4[i].x) + sh4[i].x;
      float h1 = xv[i * 4 + 1] * inv2 * n2[i].y * (1.f + sc4[i].y) + sh4[i].y;
      float h2 = xv[i * 4 + 2] * inv2 * n2[i].z * (1.f + sc4[i].z) + sh4[i].z;
      float h3 = xv[i * 4 + 3] * inv2 * n2[i].w * (1.f + sc4[i].w) + sh4[i].w;
      uint2 o;
      o.x = pack2(h0, h1);
      o.y = pack2(h2, h3);
      *(uint2*)(H + (size_t)r * DM + col) = o;
    }
  }
}

#define LDT 72
namespace pg8 {
#define PG8_LAS __attribute__((address_space(3)))
typedef unsigned short bf16_t;
typedef short bf16x8 __attribute__((ext_vector_type(8)));
typedef float f32x4 __attribute__((ext_vector_type(4)));
typedef unsigned u32x4 __attribute__((ext_vector_type(4)));
constexpr int BM = 256, BK = 64, HALF = 128, HTB = HALF * BK * 2  , STAGE_BYTES = 8 * HTB, NXCD = 8, WGM = 4;

__host__ __device__ __forceinline__ int lds_byte(int r, int c) { const int st = (r >> 4) * 2 + (c >> 5), rr = r & 15, cc = c & 31, ob = rr * 64 + cc * 2; return st * 1024 + (ob ^ (((ob >> 9) & 1) << 5)); }
__host__ __device__ __forceinline__ void stage_rc(int b, int& R, int& C) { const int st = b / 1024, sb = b % 1024, swz = sb ^ (((sb >> 9) & 1) << 5); R = (st >> 1) * 16 + swz / 64; C = (st & 1) * 32 + (swz % 64) / 2; }
__host__ __device__ __forceinline__ int perm32(int rho) { const int n = rho >> 4, i = rho & 15; return 8 * (i >> 2) + 4 * n + (i & 3); }

struct Unit { int pm, pn; };
struct Gemm { const bf16_t* A; const bf16_t* Bt; int M, N, K, lda; };
struct StaticOrder {
    int nM, nN, nwg, G, c, skip;
    __host__ __device__ void init(int M, int N, int G_, int c_, int skip_ = 0) { nM = M / BM; nN = N / BM; nwg = nM * nN; G = G_; c = c_; skip = skip_; }
    __host__ __device__ bool next(int i, Unit& u) const {
        const long L = (long)i * G + c; if (L >= nwg) return false;
        int wgid = (int)L; { const int q = nwg / NXCD, r = nwg % NXCD, xcd = wgid % NXCD, off = wgid / NXCD; wgid = (xcd < r ? xcd * (q + 1) : r * (q + 1) + (xcd - r) * q) + off; }
        const int nig = WGM * nN, gid = wgid / nig, fm = gid * WGM, gsz = (nM - fm) < WGM ? (nM - fm) : WGM;
        u.pm = fm + ((wgid % nig) % gsz); u.pn = (wgid % nig) / gsz;
        if (skip) u.pm = (u.pm >> 4) * 17 + 1 + (u.pm & 15);
        return true;
    }
    __device__ __forceinline__ void a_ready(const Unit&) const {}
    __device__ __forceinline__ void done(const Unit&) const {}
};
__device__ __forceinline__ unsigned cvt_pk_bf16(float lo, float hi) { unsigned r; asm volatile("v_cvt_pk_bf16_f32 %0, %1, %2" : "=v"(r) : "v"(lo), "v"(hi)); return r; }
template <class Epi, class Sched, bool STAMP = false>
__device__ __forceinline__ void gemm_phase(PG8_LAS unsigned char* lds, const Gemm g, const Sched& S, const Epi& E, unsigned long long* stamps) {
    const int tid = TIDX, wid = __builtin_amdgcn_readfirstlane(tid >> 6), lane = tid & 63, wr = wid >> 2, wc = wid & 3, fr = lane & 15, fq = lane >> 4;
    const int K = g.K, nt = K / BK;
    int ts_lo = 0, ts_hi = 0, nts = 0; const unsigned long long rt_entry = STAMP ? (unsigned long long)wall_clock64() : 0ull;
#define PG8_STAMP() do { if (STAMP && wid == 0 && nts < 64) { const unsigned long long _c = (unsigned long long)clock64(); \
        ts_lo = (lane == nts) ? (int)(unsigned)_c : ts_lo; ts_hi = (lane == nts) ? (int)(unsigned)(_c >> 32) : ts_hi; ++nts; } } while (0)
    PG8_STAMP();
    unsigned voffA[2], voffB[2];
#pragma unroll
    for (int i = 0; i < 2; ++i) { int R, C; stage_rc(tid * 16 + i * 8192, R, C); const int Rb = Epi::PERM ? ((R & ~31) + perm32(R & 31)) : R;
        voffA[i] = (unsigned)(R * g.lda + C) * 2u; voffB[i] = (unsigned)(Rb * K + C) * 2u; }
    const size_t kstep = (size_t)(BK * 2);
    const size_t hstepB = (size_t)HALF * K * 2, hstepA = (size_t)HALF * g.lda * 2;
    const size_t tstepB = 2 * hstepB, tstepA = 2 * hstepA;
    const unsigned ldsw = (unsigned)wid * 1024u;
    const int aoff = lds_byte(wr * 64 + fr, fq * 8), boff = lds_byte(wc * 32 + fr, fq * 8);
#define PG8_SA(b, h) (((b) * 2 + (h)) * HTB)
#define PG8_SB(b, h) ((4 + (b) * 2 + (h)) * HTB)
#define PG8_STAGE(bufoff, gbase, voff) do { _Pragma("unroll") for (int _i = 0; _i < 2; ++_i) \
        __builtin_amdgcn_global_load_lds((const unsigned*)((const char*)(gbase) + (voff)[_i]), (PG8_LAS unsigned*)(lds + (bufoff) + ldsw + _i * 8192), 16, 0, 0); } while (0)
#define PG8_LDA(dst, b, h) do { _Pragma("unroll") for (int m = 0; m < 4; ++m) _Pragma("unroll") for (int k = 0; k < 2; ++k) dst[m][k] = *(const PG8_LAS bf16x8*)(lds + PG8_SA(b, h) + aoff + m * 2048 + k * 1024); } while (0)
#define PG8_LDB(dst, b, h) do { _Pragma("unroll") for (int n = 0; n < 2; ++n) _Pragma("unroll") for (int k = 0; k < 2; ++k) dst[n][k] = *(const PG8_LAS bf16x8*)(lds + PG8_SB(b, h) + boff + n * 2048 + k * 1024); } while (0)
#define PG8_MMA(ai, bj, At, Bt) do { __builtin_amdgcn_s_setprio(1); _Pragma("unroll") for (int m = 0; m < 4; ++m) _Pragma("unroll") for (int n = 0; n < 2; ++n) _Pragma("unroll") for (int k = 0; k < 2; ++k) \
        acc[ai][bj][m][n] = __builtin_amdgcn_mfma_f32_16x16x32_bf16(Bt[n][k], At[m][k], acc[ai][bj][m][n], 0, 0, 0); __builtin_amdgcn_s_setprio(0); } while (0)
#define PG8_WAIT_V(n) asm volatile("s_waitcnt vmcnt(" #n ")" ::: "memory")
#define PG8_WAIT_L(n) asm volatile("s_waitcnt lgkmcnt(" #n ")" ::: "memory")
#define PG8_BAR __builtin_amdgcn_s_barrier()
#define PG8_SCHED __builtin_amdgcn_sched_barrier(0)
    Unit cur, nxt; int ui = 0;
    if (!S.next(0, cur)) return;
    f32x4 acc[2][2][4][2];
#pragma unroll
    for (int a = 0; a < 2; ++a)
#pragma unroll
        for (int b = 0; b < 2; ++b)
#pragma unroll
            for (int m = 0; m < 4; ++m)
#pragma unroll
                for (int n = 0; n < 2; ++n) acc[a][b][m][n] = (f32x4){0.f, 0.f, 0.f, 0.f};
    bf16x8 At[4][2], B0[2][2], B1[2][2];
    const char* cA = (const char*)g.A + (size_t)cur.pm * tstepA; const char* cB = (const char*)g.Bt + (size_t)cur.pn * tstepB;
    S.a_ready(cur);
    PG8_STAGE(PG8_SB(0, 0), cB, voffB); PG8_STAGE(PG8_SA(0, 0), cA, voffA); PG8_STAGE(PG8_SB(0, 1), cB + hstepB, voffB); PG8_STAGE(PG8_SA(0, 1), cA + hstepA, voffA);
    if (wr == 1) PG8_BAR;
    PG8_WAIT_V(4); PG8_BAR;
    PG8_STAGE(PG8_SB(1, 0), cB + kstep, voffB); PG8_STAGE(PG8_SA(1, 0), cA + kstep, voffA); PG8_STAGE(PG8_SB(1, 1), cB + hstepB + kstep, voffB);
    PG8_WAIT_V(6); PG8_BAR;
    PG8_STAMP();
    for (;;) {
        const bool has_next = S.next(ui + 1, nxt);
        const char* nA = has_next ? (const char*)g.A + (size_t)nxt.pm * tstepA : cA; const char* nB = has_next ? (const char*)g.Bt + (size_t)nxt.pn * tstepB : cB;
        for (int t = 0; t < nt; t += 2) {
            const bool last = (t == nt - 2);
            const char* a1 = cA + (size_t)(t + 1) * kstep;
            const char* a2 = last ? nA : cA + (size_t)(t + 2) * kstep; const char* b2 = last ? nB : cB + (size_t)(t + 2) * kstep;
            const char* a3 = a2 + kstep; const char* b3 = b2 + kstep;
            if (last && has_next) S.a_ready(nxt);
            PG8_LDB(B0, 0, 0); PG8_SCHED; PG8_LDA(At, 0, 0); PG8_STAGE(PG8_SA(1, 1), a1 + hstepA, voffA);
            PG8_WAIT_L(8); PG8_BAR; PG8_WAIT_L(0); PG8_MMA(0, 0, At, B0); PG8_BAR; PG8_SCHED;
            PG8_LDB(B1, 0, 1); PG8_STAGE(PG8_SB(0, 0), b2, voffB);
            PG8_BAR; PG8_WAIT_L(0); PG8_MMA(0, 1, At, B1); PG8_BAR;
            PG8_LDA(At, 0, 1); PG8_STAGE(PG8_SA(0, 0), a2, voffA);
            PG8_BAR; PG8_WAIT_L(0); PG8_MMA(1, 0, At, B0); PG8_BAR; PG8_SCHED;
            PG8_STAGE(PG8_SB(0, 1), b2 + hstepB, voffB);
            PG8_WAIT_V(6); PG8_BAR; PG8_MMA(1, 1, At, B1); PG8_BAR;
            PG8_LDB(B0, 1, 0); PG8_SCHED; PG8_LDA(At, 1, 0); PG8_STAGE(PG8_SA(0, 1), a2 + hstepA, voffA);
            PG8_WAIT_L(8); PG8_BAR; PG8_WAIT_L(0); PG8_MMA(0, 0, At, B0); PG8_BAR; PG8_SCHED;
            PG8_LDB(B1, 1, 1); PG8_STAGE(PG8_SB(1, 0), b3, voffB);
            PG8_BAR; PG8_WAIT_L(0); PG8_MMA(0, 1, At, B1); PG8_BAR;
            PG8_LDA(At, 1, 1); PG8_STAGE(PG8_SA(1, 0), a3, voffA);
            PG8_BAR; PG8_WAIT_L(0); PG8_MMA(1, 0, At, B0); PG8_BAR; PG8_SCHED;
            PG8_STAGE(PG8_SB(1, 1), b3 + hstepB, voffB);
            PG8_WAIT_V(6); PG8_BAR; PG8_MMA(1, 1, At, B1); PG8_BAR;
        }
        PG8_STAMP();
        if constexpr (!Epi::AFTER_DRAIN) { E(acc, cur, wr, wc, fr, fq); S.done(cur); }
        PG8_STAMP();
        if (!has_next) break;
#pragma unroll
        for (int a = 0; a < 2; ++a)
#pragma unroll
            for (int b = 0; b < 2; ++b)
#pragma unroll
                for (int m = 0; m < 4; ++m)
#pragma unroll
                    for (int n = 0; n < 2; ++n) acc[a][b][m][n] = (f32x4){0.f, 0.f, 0.f, 0.f};
        cur = nxt; cA = nA; cB = nB; ++ui;
    }
    PG8_WAIT_V(0);
    if (wr == 0) PG8_BAR;
    PG8_BAR;
    if constexpr (Epi::AFTER_DRAIN) { E.fused(acc, cur, wr, wc, fr, fq, lds, wid, lane); S.done(cur); }
    PG8_STAMP();
    if (STAMP && wid == 0) { stamps[lane] = lane < nts ? (((unsigned long long)(unsigned)ts_hi << 32) | (unsigned)ts_lo) : 0ull;
        if (lane == 62) stamps[62] = rt_entry; if (lane == 63) stamps[63] = (unsigned long long)wall_clock64(); }
#undef PG8_STAMP
#undef PG8_SA
#undef PG8_SB
#undef PG8_STAGE
#undef PG8_LDA
#undef PG8_LDB
#undef PG8_MMA
#undef PG8_WAIT_V
#undef PG8_WAIT_L
#undef PG8_BAR
#undef PG8_SCHED
}
}

struct EpiBf {
  static constexpr bool PERM = true, AFTER_DRAIN = false;
  u16* O; int ldc; const float* bias; int act;
  __device__ __forceinline__ void operator()(const f32x4 (&acc)[2][2][4][2], const pg8::Unit& u, int wr, int wc, int fr, int fq) const {
    const int row0 = u.pm * 256 + wr * 64 + fr, col0 = u.pn * 256 + wc * 32 + 8 * fq;
    f32x4 bv[2][2];
#pragma unroll
    for (int bj = 0; bj < 2; ++bj)
#pragma unroll
      for (int n = 0; n < 2; ++n) bv[bj][n] = bias ? *(const f32x4*)(bias + col0 + bj * 128 + 4 * n) : f32x4{0.f, 0.f, 0.f, 0.f};
#pragma unroll
    for (int ai = 0; ai < 2; ++ai)
#pragma unroll
      for (int m = 0; m < 4; ++m) {
        u16* rowp = O + (size_t)(row0 + ai * 128 + m * 16) * ldc + col0;
#pragma unroll
        for (int bj = 0; bj < 2; ++bj) {
          f32x4 v0 = acc[ai][bj][m][0] + bv[bj][0], v1 = acc[ai][bj][m][1] + bv[bj][1];
          if (act == 1) {
#pragma unroll
            for (int j = 0; j < 4; ++j) { v0[j] = sigm(v0[j]); v1[j] = sigm(v1[j]); }
          }
          uint4 wv;
          wv.x = pack2(v0[0], v0[1]); wv.y = pack2(v0[2], v0[3]); wv.z = pack2(v1[0], v1[1]); wv.w = pack2(v1[2], v1[3]);
          *(uint4*)(rowp + bj * 128) = wv;
        }
      }
  }
};
struct EpiSwiglu {
  static constexpr bool PERM = true, AFTER_DRAIN = false;
  u16* O;
  __device__ __forceinline__ void operator()(const f32x4 (&acc)[2][2][4][2], const pg8::Unit& u, int wr, int wc, int fr, int fq) const {
    const int row0 = u.pm * 256 + wr * 64 + fr, col0 = u.pn * 128 + wc * 16 + 4 * fq;
#pragma unroll
    for (int ai = 0; ai < 2; ++ai)
#pragma unroll
      for (int m = 0; m < 4; ++m) {
        u16* rowp = O + (size_t)(row0 + ai * 128 + m * 16) * FH + col0;
#pragma unroll
        for (int bj = 0; bj < 2; ++bj) {
          const f32x4 g = acc[ai][bj][m][0], up = acc[ai][bj][m][1];
          uint2 wv;
          wv.x = pack2(siluf(g[0]) * up[0], siluf(g[1]) * up[1]);
          wv.y = pack2(siluf(g[2]) * up[2], siluf(g[3]) * up[3]);
          *(uint2*)(rowp + bj * 64) = wv;
        }
      }
  }
};
struct EpiGateAcc {
  static constexpr bool PERM = true, AFTER_DRAIN = false;
  u16* ACC; const u16* G; int gcol; unsigned amask;
  __device__ __forceinline__ void operator()(const f32x4 (&acc)[2][2][4][2], const pg8::Unit& u, int wr, int wc, int fr, int fq) const {
    unsigned pk[2][2][4][4];
#pragma unroll
    for (int ai = 0; ai < 2; ++ai)
#pragma unroll
      for (int bj = 0; bj < 2; ++bj)
#pragma unroll
        for (int m = 0; m < 4; ++m) {
          pk[ai][bj][m][0] = pack2(acc[ai][bj][m][0][0], acc[ai][bj][m][0][1]);
          pk[ai][bj][m][1] = pack2(acc[ai][bj][m][0][2], acc[ai][bj][m][0][3]);
          pk[ai][bj][m][2] = pack2(acc[ai][bj][m][1][0], acc[ai][bj][m][1][1]);
          pk[ai][bj][m][3] = pack2(acc[ai][bj][m][1][2], acc[ai][bj][m][1][3]);
        }
    asm volatile("" ::: "memory");
    const int row0 = u.pm * 256 + wr * 64 + fr, col0 = u.pn * 256 + wc * 32 + 8 * fq;
#pragma unroll
    for (int ai = 0; ai < 2; ++ai)
#pragma unroll
      for (int m = 0; m < 4; ++m) {
        const size_t row = (size_t)(row0 + ai * 128 + m * 16);
#pragma unroll
        for (int bj = 0; bj < 2; ++bj) {
          const int col = col0 + bj * 128;
          const uint4 gv = *(const uint4*)(G + row * 2048 + gcol + col);
          const uint4 av = *(const uint4*)(ACC + row * DM + col);
          const unsigned gw[4] = {gv.x, gv.y, gv.z, gv.w};
          const unsigned aw[4] = {av.x & amask, av.y & amask, av.z & amask, av.w & amask};
          unsigned ow[4];
#pragma unroll
          for (int q = 0; q < 4; ++q) {
            const unsigned pv = pk[ai][bj][m][q];
            const float lo = __uint_as_float(aw[q] << 16) + __uint_as_float(gw[q] << 16) * __uint_as_float(pv << 16);
            const float hi = __uint_as_float(aw[q] & 0xffff0000u) + __uint_as_float(gw[q] & 0xffff0000u) * __uint_as_float(pv & 0xffff0000u);
            ow[q] = pack2(lo, hi);
          }
          *(uint4*)(ACC + row * DM + col) = make_uint4(ow[0], ow[1], ow[2], ow[3]);
        }
        asm volatile("" ::: "memory");
      }
  }
};

template <int MI>
__device__ __forceinline__ void gemm_loop(const u16* __restrict__ A, int lda, const u16* __restrict__ Bt, int ldb, int K,
                                          f32x4 (&acc)[MI][4], u16* sA, u16* sB) {
  constexpr int BMT = MI * 64;
  const int tid = TIDX, lane = tid & 63, w = tid >> 6, wm = w >> 1, wn = w & 1, fr = lane & 15, fq = lane >> 4;
  uint4 ra[MI], rb[2];
  const u16* ga = A + (size_t)(tid >> 3) * lda + (tid & 7) * 8;
  const u16* gb = Bt + (size_t)(tid >> 3) * ldb + (tid & 7) * 8;
  const int so = (tid >> 3) * LDT + (tid & 7) * 8;
#pragma unroll
  for (int i = 0; i < MI; i++) ra[i] = *(const uint4*)(ga + (size_t)(i * 64) * lda);
#pragma unroll
  for (int i = 0; i < 2; i++) rb[i] = *(const uint4*)(gb + (size_t)(i * 64) * ldb);
#pragma unroll
  for (int i = 0; i < MI; i++) *(uint4*)(sA + so + i * 64 * LDT) = ra[i];
#pragma unroll
  for (int i = 0; i < 2; i++) *(uint4*)(sB + so + i * 64 * LDT) = rb[i];
  __syncthreads();
  const int nk = K >> 6;
  for (int kt = 0; kt < nk; kt++) {
    const bool more = kt + 1 < nk;
    if (more) {
#pragma unroll
      for (int i = 0; i < MI; i++) ra[i] = *(const uint4*)(ga + (size_t)(i * 64) * lda + (kt + 1) * 64);
#pragma unroll
      for (int i = 0; i < 2; i++) rb[i] = *(const uint4*)(gb + (size_t)(i * 64) * ldb + (kt + 1) * 64);
    }
    const u16* a = sA + (kt & 1) * BMT * LDT + (wm * (MI * 16) + fr) * LDT + fq * 8;
    const u16* b = sB + (kt & 1) * 128 * LDT + (wn * 64 + fr) * LDT + fq * 8;
#pragma unroll
    for (int ks = 0; ks < 2; ks++) {
      bf16x8 af[MI], bfr[4];
#pragma unroll
      for (int i = 0; i < MI; i++) af[i] = *(const bf16x8*)(a + i * 16 * LDT + ks * 32);
#pragma unroll
      for (int j = 0; j < 4; j++) bfr[j] = *(const bf16x8*)(b + j * 16 * LDT + ks * 32);
#pragma unroll
      for (int i = 0; i < MI; i++)
#pragma unroll
        for (int j = 0; j < 4; j++) acc[i][j] = __builtin_amdgcn_mfma_f32_16x16x32_bf16(bfr[j], af[i], acc[i][j], 0, 0, 0);
    }
    if (more) {
      u16* da = sA + ((kt + 1) & 1) * BMT * LDT + so;
      u16* db = sB + ((kt + 1) & 1) * 128 * LDT + so;
#pragma unroll
      for (int i = 0; i < MI; i++) *(uint4*)(da + i * 64 * LDT) = ra[i];
#pragma unroll
      for (int i = 0; i < 2; i++) *(uint4*)(db + i * 64 * LDT) = rb[i];
    }
    __syncthreads();
  }
}

template <int MI>
__device__ __forceinline__ void zero_acc(f32x4 (&acc)[MI][4]) {
#pragma unroll
  for (int i = 0; i < MI; i++)
#pragma unroll
    for (int j = 0; j < 4; j++) acc[i][j] = f32x4{0.f, 0.f, 0.f, 0.f};
}


typedef unsigned u32x4v __attribute__((ext_vector_type(4)));
__device__ __forceinline__ void yp_issue(const u16* __restrict__ A, const u16* __restrict__ B, u32x4v (&ra)[8], u32x4v (&rb)[8], int tid) {
#pragma unroll
  for (int i = 0; i < 8; i++) {
    const int c = tid + i * NTHR, row = c >> 5, ch = c & 31;
    ra[i] = *(const u32x4v*)(A + (size_t)row * YST + ch * 8);
    rb[i] = *(const u32x4v*)(B + (size_t)row * 256 + ch * 8);
  }
}
__device__ __forceinline__ void yp_stage(unsigned char* sA, unsigned char* sB, const u32x4v (&ra)[8], const u32x4v (&rb)[8], int tid) {
#pragma unroll
  for (int i = 0; i < 8; i++) {
    const int c = tid + i * NTHR, row = c >> 5, ch = c & 31;
    const int off = row * 512 + ((ch ^ (row & 7)) << 4);
    *(u32x4v*)(sA + off) = ra[i];
    *(u32x4v*)(sB + off) = rb[i];
  }
}
__device__ __forceinline__ void phase_ypart(const Params& p, int l, unsigned char* smem) {
  unsigned char* sA = smem;
  unsigned char* sB = smem + 65536;
  const int tid = TIDX, lane = tid & 63, w = tid >> 6, wm = w >> 1, wn = w & 1, fr = lane & 15, fq = lane >> 4;
  const u16* Y = (const u16*)(p.ws + OFF_YS);
  const u16* Wb = (const u16*)(p.ws + OFF_W + OW_B);
  const u16* G = (const u16*)(p.ws + OFF_BIG);
  u16* ACC = (u16*)(p.ws + OFF_H);
  constexpr int NT = 8;
  const int ntiles = (NROWS / 128) * NT;
  const int G_ = gridDim.x;
  const bool xmap = (G_ == 256);
  const int xj = blockIdx.x >> 3, xx = blockIdx.x & 7;
  const bool skipc = (l == 1);
  const int nrt = skipc ? 256 : 272;
  const int ntl = nrt * NT;
  const int nmine = xmap ? (xj < nrt ? (nrt - 1 - xj) / 32 + 1 : 0)
                         : (((int)blockIdx.x < ntl) ? (ntl - 1 - (int)blockIdx.x) / G_ + 1 : 0);
  if (nmine == 0) return;
#define YP_TILE(Q_, MT_, NT_)                                                        \
  do {                                                                               \
    if (xmap) { const int s_ = (Q_) * 32 + xj; MT_ = (s_ >> 3) * 8 + xx; NT_ = s_ & 7; } \
    else { const int t_ = blockIdx.x + (Q_) * G_; MT_ = t_ / NT; NT_ = t_ - MT_ * NT; }  \
    if (skipc) MT_ = (MT_ >> 5) * 34 + 2 + (MT_ & 31);                                   \
  } while (0)
  u32x4v ra[8], rb[8];
  {
    int mt, nt;
    YP_TILE(0, mt, nt);
    yp_issue(Y + (size_t)mt * 128 * YST, Wb + ((size_t)nt * 128) * 256, ra, rb, tid);
  }
  f32x4 tot[2][4];
  zero_acc<2>(tot);
  for (int qi = 0; qi < 4 * nmine; qi++) {
    const int q = qi >> 2, k = qi & 3;
    int mt, nt;
    YP_TILE(q, mt, nt);
    const int r0 = mt * 128 + wm * 32 + fr, c0 = nt * 128 + wn * 64 + fq * 4;
    uint2 gv[2][4];
#pragma unroll
    for (int i = 0; i < 2; i++)
#pragma unroll
      for (int j = 0; j < 4; j++) gv[i][j] = *(const uint2*)(G + (size_t)(r0 + i * 16) * 4096 + k * 1024 + c0 + j * 16);
    __syncthreads();
    yp_stage(sA, sB, ra, rb, tid);
    __syncthreads();
    {
      const int qn = qi + 1 < 4 * nmine ? qi + 1 : qi;
      int mtn, ntn;
      YP_TILE(qn >> 2, mtn, ntn);
      const int brn = qn & 3, ycn = brn < 3 ? brn * 256 : 1536;
      yp_issue(Y + (size_t)mtn * 128 * YST + ycn, Wb + ((size_t)brn * 1024 + ntn * 128) * 256, ra, rb, tid);
    }
    f32x4 ay[2][4];
    zero_acc<2>(ay);
#pragma unroll 2
    for (int ks = 0; ks < 8; ks++) {
      bf16x8 af[2], bfr[4];
#pragma unroll
      for (int i = 0; i < 2; i++) {
        const int row = wm * 32 + i * 16 + fr;
        af[i] = *(const bf16x8*)(sA + row * 512 + (((ks * 4 + fq) ^ (row & 7)) << 4));
      }
#pragma unroll
      for (int j = 0; j < 4; j++) {
        const int row = wn * 64 + j * 16 + fr;
        bfr[j] = *(const bf16x8*)(sB + row * 512 + (((ks * 4 + fq) ^ (row & 7)) << 4));
      }
#pragma unroll
      for (int i = 0; i < 2; i++)
#pragma unroll
        for (int j = 0; j < 4; j++) ay[i][j] = __builtin_amdgcn_mfma_f32_16x16x32_bf16(bfr[j], af[i], ay[i][j], 0, 0, 0);
    }
#pragma unroll
    for (int i = 0; i < 2; i++)
#pragma unroll
      for (int j = 0; j < 4; j++) {
        tot[i][j][0] += __uint_as_float(gv[i][j].x << 16) * ay[i][j][0];
        tot[i][j][1] += __uint_as_float(gv[i][j].x & 0xffff0000u) * ay[i][j][1];
        tot[i][j][2] += __uint_as_float(gv[i][j].y << 16) * ay[i][j][2];
        tot[i][j][3] += __uint_as_float(gv[i][j].y & 0xffff0000u) * ay[i][j][3];
      }
    if (k == 3) {
#pragma unroll
      for (int i = 0; i < 2; i++)
#pragma unroll
        for (int j = 0; j < 4; j++) {
          uint2 ov;
          ov.x = pack2(tot[i][j][0], tot[i][j][1]); ov.y = pack2(tot[i][j][2], tot[i][j][3]);
          *(uint2*)(ACC + (size_t)(r0 + i * 16) * DM + c0 + j * 16) = ov;
        }
      zero_acc<2>(tot);
    }
  }
  __syncthreads();
#undef YP_TILE
}

#define S2_BUF 10816
#define S2_D 0
#define S2_U 2048
#define S2_P 4096
#define S2_K 6144
#define S2_DQ 8192
#define S2_V 10240
#define S2_C1 10752
#define S2_C2 10784
#define S2_ST (2 * S2_BUF)
#define S2_YB (S2_ST + 8192)

__device__ __forceinline__ float red16(float x) {
  x += dppf<0xB1>(x);
  x += dppf<0x4E>(x);
  x += dppf<0x141>(x);
  x += dppf<0x140>(x);
  return x;
}
__device__ __forceinline__ void wave_lds_sync() {
  asm volatile("s_waitcnt lgkmcnt(0)" ::: "memory");
  __builtin_amdgcn_wave_barrier();
}

template <int MIX>
__device__ __forceinline__ void scan2_item(const Params& p, int l, int b, int h, int dir, int rq, float* sm) {
  constexpr int EPL = (MIX == 2) ? 2 : 4;
  constexpr int VOFF = (MIX == 2) ? 64 : 128;
  const int tid = TIDX, lane = tid & 63, w = tid >> 6, fr = lane & 15, fq = lane >> 4;
  const bool producer = w >= 4;
  const int pw = w & 3;
  const u16* P = (const u16*)(p.ws + OFF_BIG);
  u16* YS = (u16*)(p.ws + OFF_YS);
  float* BC = (float*)(p.ws + OFF_BC);
  float* ST = sm + S2_ST + pw * 2048;
  float s[EPL];
#pragma unroll
  for (int i = 0; i < EPL; i++) s[i] = 0.f;

  bf16x8 bw2[4], ba2[4];
  float cst[5][4];
  float cw[3][7];
  float muv[4];
  int colv[4];
#pragma unroll
  for (int i = 0; i < 4; i++) { bw2[i] = bf16x8{0, 0, 0, 0, 0, 0, 0, 0}; ba2[i] = bw2[i]; muv[i] = 0.f; colv[i] = 0; }
  if (producer) {
    if (MIX == 0) {
#pragma unroll
      for (int nt = 0; nt < 4; nt++) {
        const int jch = h * 64 + nt * 16 + fr;
#pragma unroll
        for (int jj = 0; jj < 8; jj++) {
          bw2[nt][jj] = (short)f2bf(p.rwkv_w2[((size_t)(l * 2 + dir) * 32 + fq * 8 + jj) * 256 + jch]);
          ba2[nt][jj] = (short)f2bf(p.rwkv_a2[((size_t)(l * 2 + dir) * 32 + fq * 8 + jj) * 256 + jch]);
        }
        cst[0][nt] = p.rwkv_w0[(l * 2 + dir) * 256 + jch];
        cst[1][nt] = p.rwkv_a0[(l * 2 + dir) * 256 + jch];
        cst[2][nt] = p.rwkv_ka[l * 256 + jch];
        cst[3][nt] = p.rwkv_kk[l * 256 + jch];
        cst[4][nt] = p.rwkv_rk[l * 256 + jch];
      }
#pragma unroll
      for (int i = 0; i < 4; i++) {
        const int c = lane + 64 * i;
        colv[i] = i < 3 ? i * 256 + h * 64 + lane : (lane < 32 ? 768 + dir * 32 + lane : 832 + dir * 32 + (lane - 32));
        muv[i] = p.rwkv_mu[l * 960 + colv[i]];
        (void)c;
      }
    } else if (MIX == 1) {
#pragma unroll
      for (int i = 0; i < 3; i++) {
        colv[i] = PB + i * 256 + h * 64 + lane;
#pragma unroll
        for (int tp = 0; tp < 7; tp++) cw[i][tp] = p.gdn_conv[((size_t)l * 7 + tp) * 768 + i * 256 + h * 64 + lane];
      }
    } else {
#pragma unroll
      for (int nt = 0; nt < 2; nt++) {
#pragma unroll
        for (int jj = 0; jj < 8; jj++)
          bw2[nt][jj] = fq < 2 ? (short)f2bf(p.gla_gw2[((size_t)(l * 2 + dir) * 16 + fq * 8 + jj) * 128 + h * 32 + nt * 16 + fr]) : (short)0;
        cst[0][nt] = p.gla_gb[(l * 2 + dir) * 128 + h * 32 + nt * 16 + fr];
      }
      colv[0] = PC + h * 32 + lane;
      if (lane >= 32) colv[0] = PC + 128 + h * 32 + (lane - 32);
      colv[1] = PC + 256 + h * 64 + lane;
      colv[2] = PC + 512 + dir * 16 + (lane & 15);
    }
  }
  __syncthreads();

  for (int c = 0; c <= TPB / 32 + 1; c++) {
    if (producer) {
      if (c >= 2) {
        const int cc = c - 2;
        int seg_row0, t_lo;
        if (cc < 8) { seg_row0 = b * TPB; t_lo = dir == 0 ? cc * 32 : (LC - 32 - cc * 32); }
        else { seg_row0 = b * TPB + LC; t_lo = dir == 0 ? (cc - 8) * 32 : (SEQ - 32 - (cc - 8) * 32); }
        const float* yb = sm + S2_YB + (cc & 1) * 512;
        const int t2 = tid - 256;
#pragma unroll
        for (int i = 0; i < 2; i++) {
          const int idx = t2 + i * 256, tt = idx >> 4, e = idx & 15;
          YS[(size_t)(seg_row0 + t_lo + tt) * YST + dir * 768 + MIX * 256 + h * 64 + rq * 16 + e] = f2bf(yb[idx]);
        }
      }
      if (c < TPB / 32) {
        int seg_row0, seg_len, t_lo;
        if (c < 8) { seg_row0 = b * TPB; seg_len = LC; t_lo = dir == 0 ? c * 32 : (LC - 32 - c * 32); }
        else { seg_row0 = b * TPB + LC; seg_len = SEQ; t_lo = dir == 0 ? (c - 8) * 32 : (SEQ - 32 - (c - 8) * 32); }
        const u16* Pseg = P + (size_t)seg_row0 * PST;
        float* B = sm + (c & 1) * S2_BUF;
        const int t0 = t_lo + pw * 8;
        if (MIX == 0) {
          float raw[10][4];
#pragma unroll
          for (int rr = 0; rr < 10; rr++) {
            const int t = t0 - 1 + rr;
            const float okf = (t >= 0 && t < seg_len) ? 1.f : 0.f;
            const int tc = min(max(t, 0), seg_len - 1);
#pragma unroll
            for (int i = 0; i < 4; i++) raw[rr][i] = bf2f(Pseg[(size_t)tc * PST + PA + colv[i]]) * okf;
          }
#pragma unroll
          for (int j = 0; j < 8; j++)
#pragma unroll
            for (int i = 0; i < 4; i++) {
              float xm = raw[j + 1][i] + (0.5f * (raw[j][i] + raw[j + 2][i]) - raw[j + 1][i]) * muv[i];
              if (i == 3 && lane < 32) xm = tanh_fast(xm);
              ST[j * 256 + lane + 64 * i] = xm;
            }
        } else if (MIX == 1) {
          float raw[14][3];
#pragma unroll
          for (int rr = 0; rr < 14; rr++) {
            const int t = t0 - 3 + rr;
            const float okf = (t >= 0 && t < seg_len) ? 1.f : 0.f;
            const int tc = min(max(t, 0), seg_len - 1);
#pragma unroll
            for (int i = 0; i < 3; i++) raw[rr][i] = bf2f(Pseg[(size_t)tc * PST + colv[i]]) * okf;
          }
#pragma unroll
          for (int j = 0; j < 8; j++)
#pragma unroll
            for (int i = 0; i < 3; i++) {
              float a = 0.f;
#pragma unroll
              for (int tp = 0; tp < 7; tp++) a += raw[j + tp][i] * cw[i][tp];
              ST[j * 256 + lane + 64 * i] = siluf(a);
            }
          if (lane < 8) {
            const u16* pp = Pseg + (size_t)(t0 + lane) * PST + PB;
            float bx = bf2f(pp[768 + dir * 4 + h]);
            float ax = bf2f(pp[776 + dir * 4 + h]);
            float ld = -__expf(p.gdn_a_log[(l * 2 + dir) * 4 + h]) * softplusf(ax + p.gdn_dt_bias[(l * 2 + dir) * 4 + h]);
            ST[lane * 256 + 192] = sigm(bx);
            ST[lane * 256 + 193] = __expf(ld);
          }
        } else {
          u16 raw[8][3];
#pragma unroll
          for (int j = 0; j < 8; j++) {
            const u16* pp = Pseg + (size_t)(t0 + j) * PST;
#pragma unroll
            for (int i = 0; i < 3; i++) raw[j][i] = pp[colv[i]];
          }
          const float qs = lane < 32 ? 0.17677669529663687f : 1.f;
#pragma unroll
          for (int j = 0; j < 8; j++) {
            ST[j * 256 + lane] = bf2f(raw[j][0]) * qs;
            ST[j * 256 + 64 + lane] = bf2f(raw[j][1]);
            if (lane < 16) ST[j * 256 + 128 + lane] = bf2f(raw[j][2]);
          }
        }
        wave_lds_sync();
        const bool vl = fq < 2;
        if (MIX == 0) {
          bf16x8 aw, aa;
#pragma unroll
          for (int jj = 0; jj < 8; jj++) {
            aw[jj] = fr < 8 ? (short)f2bf(ST[fr * 256 + 192 + fq * 8 + jj]) : (short)0;
            aa[jj] = fr < 8 ? (short)f2bf(ST[fr * 256 + 224 + fq * 8 + jj]) : (short)0;
          }
          f32x4 accw[4], acca[4];
#pragma unroll
          for (int nt = 0; nt < 4; nt++) {
            accw[nt] = __builtin_amdgcn_mfma_f32_16x16x32_bf16(aw, bw2[nt], f32x4{0.f, 0.f, 0.f, 0.f}, 0, 0, 0);
            acca[nt] = __builtin_amdgcn_mfma_f32_16x16x32_bf16(aa, ba2[nt], f32x4{0.f, 0.f, 0.f, 0.f}, 0, 0, 0);
          }
#pragma unroll
          for (int r = 0; r < 4; r++) {
            const int j = (fq & 1) * 4 + r, tt = pw * 8 + j;
            float kkx[4], av[4], kdv[4], rv[4], dec[4];
            float ss = 0.f;
#pragma unroll
            for (int nt = 0; nt < 4; nt++) {
              const int n = nt * 16 + fr;
              rv[nt] = ST[j * 256 + n];
              const float kx = ST[j * 256 + 64 + n];
              dec[nt] = __expf(-0.6065306597126334f * sigm(cst[0][nt] + accw[nt][r]));
              av[nt] = sigm(cst[1][nt] + acca[nt][r]);
              kdv[nt] = kx * (1.f + (av[nt] - 1.f) * cst[2][nt]);
              kkx[nt] = kx * cst[3][nt];
              ss += kkx[nt] * kkx[nt];
            }
            ss = red16(ss);
            const float rs = rsq(ss + 1e-6f);
            float c1 = 0.f, c2 = 0.f, bc = 0.f;
#pragma unroll
            for (int nt = 0; nt < 4; nt++) {
              const int n = nt * 16 + fr;
              const float kk = kkx[nt] * rs;
              if (vl) {
                B[S2_D + tt * 64 + n] = dec[nt];
                B[S2_U + tt * 64 + n] = kk;
                B[S2_P + tt * 64 + n] = -kk * av[nt];
                B[S2_K + tt * 64 + n] = kdv[nt];
                B[S2_DQ + tt * 64 + n] = dec[nt] * rv[nt];
              }
              c1 += -kk * av[nt] * rv[nt];
              c2 += kdv[nt] * rv[nt];
              bc += rv[nt] * kdv[nt] * cst[4][nt];
            }
            c1 = red16(c1); c2 = red16(c2); bc = red16(bc);
            if (vl && fr == 0) {
              B[S2_C1 + tt] = c1;
              B[S2_C2 + tt] = c2;
              if (rq == 0) BC[(size_t)(seg_row0 + t_lo + tt) * 8 + h * 2 + dir] = bc;
            }
          }
        } else if (MIX == 1) {
#pragma unroll
          for (int r = 0; r < 4; r++) {
            const int j = (fq & 1) * 4 + r, tt = pw * 8 + j;
            float qv[4], kv[4];
            float sq = 0.f, sk = 0.f;
#pragma unroll
            for (int nt = 0; nt < 4; nt++) {
              const int n = nt * 16 + fr;
              qv[nt] = ST[j * 256 + n];
              kv[nt] = ST[j * 256 + 64 + n];
              sq += qv[nt] * qv[nt];
              sk += kv[nt] * kv[nt];
            }
            sq = red16(sq); sk = red16(sk);
            const float rq_ = rsq(sq + 1e-6f) * 0.125f, rk_ = rsq(sk + 1e-6f);
            const float beta = ST[j * 256 + 192], alpha = ST[j * 256 + 193];
            float dkq = 0.f;
#pragma unroll
            for (int nt = 0; nt < 4; nt++) {
              const int n = nt * 16 + fr;
              const float qn = qv[nt] * rq_, kn = kv[nt] * rk_;
              if (vl) {
                B[S2_D + tt * 64 + n] = alpha;
                B[S2_U + tt * 64 + n] = kn;
                B[S2_P + tt * 64 + n] = -alpha * beta * kn;
                B[S2_K + tt * 64 + n] = beta * kn;
                B[S2_DQ + tt * 64 + n] = alpha * qn;
              }
              dkq += kn * qn;
            }
            dkq = red16(dkq);
            if (vl && fr == 0) {
              B[S2_C1 + tt] = -alpha * beta * dkq;
              B[S2_C2 + tt] = beta * dkq;
            }
          }
        } else {
          bf16x8 ag;
#pragma unroll
          for (int jj = 0; jj < 8; jj++) ag[jj] = (fr < 8 && fq < 2) ? (short)f2bf(ST[fr * 256 + 128 + fq * 8 + jj]) : (short)0;
          f32x4 accg[2];
#pragma unroll
          for (int nt = 0; nt < 2; nt++) accg[nt] = __builtin_amdgcn_mfma_f32_16x16x32_bf16(ag, bw2[nt], f32x4{0.f, 0.f, 0.f, 0.f}, 0, 0, 0);
#pragma unroll
          for (int r = 0; r < 4; r++) {
            const int j = (fq & 1) * 4 + r, tt = pw * 8 + j;
            float dkq = 0.f;
#pragma unroll
            for (int nt = 0; nt < 2; nt++) {
              const int n = nt * 16 + fr;
              const float lg = cst[0][nt] + accg[nt][r];
              const float ls = fminf(lg, 0.f) - __logf(1.f + __expf(-fabsf(lg)));
              const float alpha = __expf(ls * (1.f / 16.f));
              const float qv = ST[j * 256 + n], kv = ST[j * 256 + 32 + n];
              if (vl) {
                B[S2_D + tt * 64 + n] = alpha;
                B[S2_K + tt * 64 + n] = kv;
                B[S2_DQ + tt * 64 + n] = alpha * qv;
              }
              dkq += kv * qv;
            }
            dkq = red16(dkq);
            if (vl && fr == 0) B[S2_C2 + tt] = dkq;
          }
        }
#pragma unroll
        for (int i = 0; i < 2; i++) {
          const int idx = lane + 64 * i, j = idx >> 4, e = idx & 15;
          B[S2_V + (pw * 8 + j) * 16 + e] = ST[j * 256 + VOFF + rq * 16 + e];
        }
      }
    } else if (c >= 1 && c <= TPB / 32) {
      const float* B = sm + ((c - 1) & 1) * S2_BUF;
      float* yb = sm + S2_YB + ((c - 1) & 1) * 512;
      const int rl = w * 4 + fq;
      const int dtt = dir ? -1 : 1;
      int tt = dir ? 31 : 0;
      float dv[EPL], kv[EPL], qv[EPL], uv[EPL], pv[EPL], vv, c1v, c2v;
      float dn[EPL], kn[EPL], qn[EPL], un[EPL], pn[EPL], vn, c1n, c2n;
#define S2_LOAD(D_, K_, Q_, U_, P_, V_, C1_, C2_, T_)                                   \
  do {                                                                                  \
    const int o_ = (T_) * 64 + fr * EPL;                                                \
    if (EPL == 4) {                                                                     \
      float4 t4 = *(const float4*)(B + S2_D + o_);                                      \
      D_[0] = t4.x; D_[1] = t4.y; D_[2] = t4.z; D_[3] = t4.w;                           \
      t4 = *(const float4*)(B + S2_K + o_);                                             \
      K_[0] = t4.x; K_[1] = t4.y; K_[2] = t4.z; K_[3] = t4.w;                           \
      t4 = *(const float4*)(B + S2_DQ + o_);                                            \
      Q_[0] = t4.x; Q_[1] = t4.y; Q_[2] = t4.z; Q_[3] = t4.w;                           \
      t4 = *(const float4*)(B + S2_U + o_);                                             \
      U_[0] = t4.x; U_[1] = t4.y; U_[2] = t4.z; U_[3] = t4.w;                           \
      t4 = *(const float4*)(B + S2_P + o_);                                             \
      P_[0] = t4.x; P_[1] = t4.y; P_[2] = t4.z; P_[3] = t4.w;                           \
      C1_ = B[S2_C1 + (T_)];                                                            \
    } else {                                                                            \
      float2 t2 = *(const float2*)(B + S2_D + o_);                                      \
      D_[0] = t2.x; D_[1] = t2.y;                                                       \
      t2 = *(const float2*)(B + S2_K + o_);                                             \
      K_[0] = t2.x; K_[1] = t2.y;                                                       \
      t2 = *(const float2*)(B + S2_DQ + o_);                                            \
      Q_[0] = t2.x; Q_[1] = t2.y;                                                       \
      U_[0] = U_[1] = P_[0] = P_[1] = 0.f; C1_ = 0.f;                                   \
    }                                                                                   \
    V_ = B[S2_V + (T_) * 16 + rl];                                                      \
    C2_ = B[S2_C2 + (T_)];                                                              \
  } while (0)
#define S2_STEP(D_, K_, Q_, U_, P_, V_, C1_, C2_, T_)                                   \
  do {                                                                                  \
    float sq = 0.f, sa = 0.f;                                                           \
    _Pragma("unroll") for (int i = 0; i < EPL; i++) sq += s[i] * Q_[i];                 \
    if (MIX != 2) {                                                                     \
      _Pragma("unroll") for (int i = 0; i < EPL; i++) sa += s[i] * U_[i];               \
      sa = red16(sa);                                                                   \
    }                                                                                   \
    sq = red16(sq);                                                                     \
    float y = sq + V_ * C2_;                                                            \
    if (MIX != 2) y += sa * C1_;                                                        \
    _Pragma("unroll") for (int i = 0; i < EPL; i++) {                                   \
      float t = s[i] * D_[i] + V_ * K_[i];                                              \
      if (MIX != 2) t += sa * P_[i];                                                    \
      s[i] = t;                                                                         \
    }                                                                                   \
    yb[(T_) * 16 + rl] = y;                                                             \
  } while (0)
      S2_LOAD(dv, kv, qv, uv, pv, vv, c1v, c2v, tt);
#pragma unroll 1
      for (int st = 0; st < 32; st += 2) {
        const int t1 = tt + dtt;
        S2_LOAD(dn, kn, qn, un, pn, vn, c1n, c2n, t1);
        S2_STEP(dv, kv, qv, uv, pv, vv, c1v, c2v, tt);
        const int t2 = st + 2 < 32 ? t1 + dtt : t1;
        S2_LOAD(dv, kv, qv, uv, pv, vv, c1v, c2v, t2);
        S2_STEP(dn, kn, qn, un, pn, vn, c1n, c2n, t1);
        tt = t2;
      }
#undef S2_LOAD
#undef S2_STEP
    }
    __syncthreads();
  }
}

#define S3_SUB 12800
#define S3_GM 0
#define S3_KVT 9216
#define S3_QB 10240
#define S3_QV 11392
#define S3_VT 11520
#define S3_WC 12544
#define S3_TB S3_QV
#define S3_TM (S3_GM + 3328)
#define S3_QBM (S3_GM + 3072)
#define S3_QKM (S3_GM + 3200)
#define S3_KB (S3_GM + 0)
#define S3_BT (S3_GM + 2048)
#define S3_STB (8 * S3_SUB)
#define S3_END (S3_STB + 4 * 2304)

__device__ __forceinline__ float rlane(float x, int l) { return __int_as_float(__builtin_amdgcn_readlane(__float_as_int(x), l)); }
__device__ __forceinline__ float wave_sum(float x) {
  x = red16(x);
  return (rlane(x, 0) + rlane(x, 16)) + (rlane(x, 32) + rlane(x, 48));
}
__device__ __forceinline__ float clampe(float x) { return fminf(fmaxf(x, -80.f), 80.f); }
__device__ __forceinline__ uint4 pack8(const float (&v)[8]) {
  return make_uint4(pack2(v[0], v[1]), pack2(v[2], v[3]), pack2(v[4], v[5]), pack2(v[6], v[7]));
}
__device__ __forceinline__ bf16x8 ld_frag(const void* p) { return *(const bf16x8*)p; }
__device__ __forceinline__ bf16x8 zfrag() { return bf16x8{0, 0, 0, 0, 0, 0, 0, 0}; }

__device__ __forceinline__ void chunk_geom(int c, int dir, int b, int& seg_row0, int& seg_len, int& t_lo) {
  if (c < 8) { seg_row0 = b * TPB; seg_len = LC; t_lo = dir == 0 ? c * 32 : (LC - 32 - c * 32); }
  else { seg_row0 = b * TPB + LC; seg_len = SEQ; t_lo = dir == 0 ? (c - 8) * 32 : (SEQ - 32 - (c - 8) * 32); }
}
template <int MIX>
__device__ __forceinline__ void fetch_raw(const u16* P, int c, int dir, int b, int h, int pw, int lane, const int (&colv)[4], unsigned (&rawq)[14][2]) {
  int seg_row0, seg_len, t_lo;
  chunk_geom(c, dir, b, seg_row0, seg_len, t_lo);
  const u16* Pseg = P + (size_t)seg_row0 * PST;
  const int t0 = t_lo + pw * 8;
  if (MIX == 0) {
#pragma unroll
    for (int rr = 0; rr < 10; rr++) {
      const int tc = min(max(t0 - 1 + rr, 0), seg_len - 1);
#pragma unroll
      for (int i = 0; i < 2; i++)
        rawq[rr][i] = (unsigned)Pseg[(size_t)tc * PST + PA + colv[2 * i]] | ((unsigned)Pseg[(size_t)tc * PST + PA + colv[2 * i + 1]] << 16);
    }
  } else if (MIX == 1) {
#pragma unroll
    for (int rr = 0; rr < 14; rr++) {
      const int tc = min(max(t0 - 3 + rr, 0), seg_len - 1);
      rawq[rr][0] = (unsigned)Pseg[(size_t)tc * PST + colv[0]] | ((unsigned)Pseg[(size_t)tc * PST + colv[1]] << 16);
      rawq[rr][1] = (rawq[rr][1] & 0xffff0000u) | (unsigned)Pseg[(size_t)tc * PST + colv[2]];
    }
    const u16* pp = Pseg + (size_t)(t0 + (lane & 7)) * PST + PB;
    rawq[0][1] = (rawq[0][1] & 0xffffu) | ((unsigned)pp[768 + dir * 4 + h] << 16);
    rawq[1][1] = (rawq[1][1] & 0xffffu) | ((unsigned)pp[776 + dir * 4 + h] << 16);
  } else {
#pragma unroll
    for (int j = 0; j < 8; j++) {
      const u16* pp = Pseg + (size_t)(t0 + j) * PST;
      rawq[j][0] = (unsigned)pp[colv[0]] | ((unsigned)pp[colv[1]] << 16);
      rawq[j][1] = (unsigned)pp[colv[2]];
    }
  }
}

template <int MIX>
__device__ __forceinline__ void scan3_item(const Params& p, int l, int b, int h, int dir, unsigned char* smb) {
  constexpr int VOFF = (MIX == 2) ? 64 : 128;
  constexpr bool DELTA = (MIX != 2);
  const int tid = TIDX, lane = tid & 63, w = __builtin_amdgcn_readfirstlane(tid >> 6), fr = lane & 15, fq = lane >> 4;
  const bool producer = true;
  const int pw = w & 3, half = w >> 2;
  const u16* P = (const u16*)(p.ws + OFF_BIG);
  u16* YS = (u16*)(p.ws + OFF_YS);
  float* BC = (float*)(p.ws + OFF_BC);
  float* ST = (float*)(smb + w * S3_SUB + S3_GM);
  unsigned char* STBY = smb + w * S3_SUB + S3_GM;
  const f32x4 z4 = f32x4{0.f, 0.f, 0.f, 0.f};
  f32x4 st[4];
#pragma unroll
  for (int i = 0; i < 4; i++) st[i] = z4;

  bf16x8 bw2[4], ba2[4];
  float cw[3][7];
  float muv[4];
  int colv[4];
  float c_w0 = 0.f, c_a0 = 0.f, c_ka = 0.f, c_kk = 0.f, c_rk = 0.f, c_gb = 0.f;
#pragma unroll
  for (int i = 0; i < 4; i++) { bw2[i] = zfrag(); ba2[i] = zfrag(); muv[i] = 0.f; colv[i] = 0; }
  if (producer) {
    if (MIX == 0) {
      {
        float tw[4][8], ta[4][8];
#pragma unroll
        for (int nt = 0; nt < 4; nt++)
#pragma unroll
          for (int jj = 0; jj < 8; jj++) {
            tw[nt][jj] = p.rwkv_w2[((size_t)(l * 2 + dir) * 32 + fq * 8 + jj) * 256 + h * 64 + nt * 16 + fr];
            ta[nt][jj] = p.rwkv_a2[((size_t)(l * 2 + dir) * 32 + fq * 8 + jj) * 256 + h * 64 + nt * 16 + fr];
          }
#pragma unroll
        for (int nt = 0; nt < 4; nt++)
#pragma unroll
          for (int jj = 0; jj < 8; jj++) { bw2[nt][jj] = (short)f2bf(tw[nt][jj]); ba2[nt][jj] = (short)f2bf(ta[nt][jj]); }
      }
      const int jl = h * 64 + lane;
      c_w0 = p.rwkv_w0[(l * 2 + dir) * 256 + jl];
      c_a0 = p.rwkv_a0[(l * 2 + dir) * 256 + jl];
      c_ka = p.rwkv_ka[l * 256 + jl];
      c_kk = p.rwkv_kk[l * 256 + jl];
      c_rk = p.rwkv_rk[l * 256 + jl];
#pragma unroll
      for (int i = 0; i < 4; i++) {
        colv[i] = i < 3 ? i * 256 + h * 64 + lane : (lane < 32 ? 768 + dir * 32 + lane : 832 + dir * 32 + (lane - 32));
        muv[i] = p.rwkv_mu[l * 960 + colv[i]];
      }
    } else if (MIX == 1) {
#pragma unroll
      for (int i = 0; i < 3; i++) {
        colv[i] = PB + i * 256 + h * 64 + lane;
#pragma unroll
        for (int tp = 0; tp < 7; tp++) cw[i][tp] = p.gdn_conv[((size_t)l * 7 + tp) * 768 + i * 256 + h * 64 + lane];
      }
    } else {
      {
        float tg[2][8];
#pragma unroll
        for (int nt = 0; nt < 2; nt++)
#pragma unroll
          for (int jj = 0; jj < 8; jj++) tg[nt][jj] = p.gla_gw2[((size_t)(l * 2 + dir) * 16 + (fq & 1) * 8 + jj) * 128 + h * 32 + nt * 16 + fr];
#pragma unroll
        for (int nt = 0; nt < 2; nt++)
#pragma unroll
          for (int jj = 0; jj < 8; jj++) bw2[nt][jj] = fq < 2 ? (short)f2bf(tg[nt][jj]) : (short)0;
      }
      c_gb = p.gla_gb[(l * 2 + dir) * 128 + h * 32 + (lane & 31)];
      colv[0] = PC + h * 32 + lane;
      if (lane >= 32) colv[0] = PC + 128 + h * 32 + (lane - 32);
      colv[1] = PC + 256 + h * 64 + lane;
      colv[2] = PC + 512 + dir * 16 + (lane & 15);
    }
  }
  __syncthreads();
  unsigned rawq[14][2];
#pragma unroll
  for (int i = 0; i < 14; i++) { rawq[i][0] = 0u; rawq[i][1] = 0u; }
  fetch_raw<MIX>(P, half, dir, b, h, pw, lane, colv, rawq);
#define RAWP(r_, i_) ((u16)((rawq[r_][(i_) >> 1] >> (((i_) & 1) * 16)) & 0xffffu))

  for (int it = 0; it < TPB / 64; it++) {
    {
      {
        const int c = it * 2 + half;
        int seg_row0, seg_len, t_lo;
        chunk_geom(c, dir, b, seg_row0, seg_len, t_lo);
        unsigned char* SB = smb + w * S3_SUB;
        const int t0 = t_lo + pw * 8;
        if (MIX == 0) {
          float raw[10][4];
#pragma unroll
          for (int rr = 0; rr < 10; rr++) {
            const int t = t0 - 1 + rr;
            const float okf = (t >= 0 && t < seg_len) ? 1.f : 0.f;
#pragma unroll
            for (int i = 0; i < 4; i++) raw[rr][i] = bf2f(RAWP(rr, i)) * okf;
          }
#pragma unroll
          for (int j = 0; j < 8; j++)
#pragma unroll
            for (int i = 0; i < 4; i++) {
              float xm = raw[j + 1][i] + (0.5f * (raw[j][i] + raw[j + 2][i]) - raw[j + 1][i]) * muv[i];
              if (i == 3 && lane < 32) xm = tanh_fast(xm);
              ST[j * 256 + lane + 64 * i] = xm;
            }
        } else if (MIX == 1) {
          float raw[14][3];
#pragma unroll
          for (int rr = 0; rr < 14; rr++) {
            const int t = t0 - 3 + rr;
            const float okf = (t >= 0 && t < seg_len) ? 1.f : 0.f;
#pragma unroll
            for (int i = 0; i < 3; i++) raw[rr][i] = bf2f(RAWP(rr, i)) * okf;
          }
#pragma unroll
          for (int j = 0; j < 8; j++)
#pragma unroll
            for (int i = 0; i < 3; i++) {
              float a = 0.f;
#pragma unroll
              for (int tp = 0; tp < 7; tp++) a += raw[j + tp][i] * cw[i][tp];
              ST[j * 256 + lane + 64 * i] = siluf(a);
            }
          if (lane < 8) {
            float bx = bf2f(RAWP(0, 3));
            float ax = bf2f(RAWP(1, 3));
            float ld = -__expf(p.gdn_a_log[(l * 2 + dir) * 4 + h]) * softplusf(ax + p.gdn_dt_bias[(l * 2 + dir) * 4 + h]);
            ST[lane * 256 + 192] = sigm(bx);
            ST[lane * 256 + 193] = ld;
          }
        } else {
          const float qs = lane < 32 ? 0.17677669529663687f : 1.f;
#pragma unroll
          for (int j = 0; j < 8; j++) {
            ST[j * 256 + lane] = bf2f(RAWP(j, 0)) * qs;
            ST[j * 256 + 64 + lane] = bf2f(RAWP(j, 1));
            if (lane < 16) ST[j * 256 + 128 + lane] = bf2f(RAWP(j, 2));
          }
        }
        wave_lds_sync();
        {
          float vv[8];
#pragma unroll
          for (int i = 0; i < 8; i++) vv[i] = ST[(dir ? 7 - i : i) * 256 + VOFF + lane];
          *(uint4*)(SB + S3_VT + lane * 16) = pack8(vv);
        }
        if (MIX == 0) {
          bf16x8 aw, aa;
#pragma unroll
          for (int jj = 0; jj < 8; jj++) {
            aw[jj] = fr < 8 ? (short)f2bf(ST[fr * 256 + 192 + fq * 8 + jj]) : (short)0;
            aa[jj] = fr < 8 ? (short)f2bf(ST[fr * 256 + 224 + fq * 8 + jj]) : (short)0;
          }
          f32x4 accw[4], acca[4];
#pragma unroll
          for (int nt = 0; nt < 4; nt++) {
            accw[nt] = __builtin_amdgcn_mfma_f32_16x16x32_bf16(aw, bw2[nt], z4, 0, 0, 0);
            acca[nt] = __builtin_amdgcn_mfma_f32_16x16x32_bf16(aa, ba2[nt], z4, 0, 0, 0);
          }
          wave_lds_sync();
          if (fq < 2) {
#pragma unroll
            for (int nt = 0; nt < 4; nt++)
#pragma unroll
              for (int r = 0; r < 4; r++) {
                ST[(fq * 4 + r) * 256 + 128 + nt * 16 + fr] = accw[nt][r];
                ST[(fq * 4 + r) * 256 + 192 + nt * 16 + fr] = acca[nt][r];
              }
          }
          wave_lds_sync();
        } else if (MIX == 2) {
          bf16x8 ag;
#pragma unroll
          for (int jj = 0; jj < 8; jj++) ag[jj] = (fr < 8 && fq < 2) ? (short)f2bf(ST[fr * 256 + 128 + fq * 8 + jj]) : (short)0;
          f32x4 accg[2];
#pragma unroll
          for (int nt = 0; nt < 2; nt++) accg[nt] = __builtin_amdgcn_mfma_f32_16x16x32_bf16(ag, bw2[nt], z4, 0, 0, 0);
          if (fq < 2) {
#pragma unroll
            for (int nt = 0; nt < 2; nt++)
#pragma unroll
              for (int r = 0; r < 4; r++) ST[(fq * 4 + r) * 256 + 192 + nt * 16 + fr] = accg[nt][r];
          }
          wave_lds_sync();
        }
        float logd[8], kap[8], bb[8], kp[8], qq[8];
        u16* XA1 = (u16*)(SB + 9216);
        u16* XA2 = (u16*)(SB + 10368);
        const int dlane_r = fr & 3;
        if (MIX == 0) {
          float a8[8];
#pragma unroll
          for (int i = 0; i < 8; i++) {
            const float* row = ST + (dir ? 7 - i : i) * 256;
            const float r_ = row[lane], k_ = row[64 + lane];
            const float sg = sigm(c_w0 + row[128 + lane]);
            a8[i] = sigm(c_a0 + row[192 + lane]);
            kp[i] = k_ * (1.f + (a8[i] - 1.f) * c_ka);
            kap[i] = k_ * c_kk;
            qq[i] = r_;
            logd[i] = -0.6065306597126334f * sg;
            XA1[i * 72 + lane] = f2bf(kap[i]);
          }
          wave_lds_sync();
          f32x4 accS = z4;
#pragma unroll
          for (int ks = 0; ks < 2; ks++) {
            const bf16x8 fx = ld_frag(XA1 + (fr & 7) * 72 + fq * 8 + ks * 32);
            accS = __builtin_amdgcn_mfma_f32_16x16x32_bf16(fx, fx, accS, 0, 0, 0);
          }
          const float dsel = dlane_r == 0 ? accS[0] : (dlane_r == 1 ? accS[1] : (dlane_r == 2 ? accS[2] : accS[3]));
#pragma unroll
          for (int i = 0; i < 8; i++) {
            const float ss = rlane(dsel, (i >> 2) * 16 + i);
            kap[i] *= rsq(ss + 1e-6f);
            bb[i] = kap[i] * a8[i];
          }
        } else if (MIX == 1) {
#pragma unroll
          for (int i = 0; i < 8; i++) {
            const float* row = ST + (dir ? 7 - i : i) * 256;
            qq[i] = row[lane]; kap[i] = row[64 + lane];
            kp[i] = row[192];
            logd[i] = row[193];
            XA1[i * 72 + lane] = f2bf(qq[i]);
            XA2[i * 72 + lane] = f2bf(kap[i]);
          }
          wave_lds_sync();
          f32x4 accSq = z4, accSk = z4;
#pragma unroll
          for (int ks = 0; ks < 2; ks++) {
            const bf16x8 fxq = ld_frag(XA1 + (fr & 7) * 72 + fq * 8 + ks * 32), fxk = ld_frag(XA2 + (fr & 7) * 72 + fq * 8 + ks * 32);
            accSq = __builtin_amdgcn_mfma_f32_16x16x32_bf16(fxq, fxq, accSq, 0, 0, 0);
            accSk = __builtin_amdgcn_mfma_f32_16x16x32_bf16(fxk, fxk, accSk, 0, 0, 0);
          }
          const float dq = dlane_r == 0 ? accSq[0] : (dlane_r == 1 ? accSq[1] : (dlane_r == 2 ? accSq[2] : accSq[3]));
          const float dk = dlane_r == 0 ? accSk[0] : (dlane_r == 1 ? accSk[1] : (dlane_r == 2 ? accSk[2] : accSk[3]));
#pragma unroll
          for (int i = 0; i < 8; i++) {
            const float sq = rlane(dq, (i >> 2) * 16 + i), sk = rlane(dk, (i >> 2) * 16 + i);
            const float beta = kp[i], alpha = __expf(logd[i]);
            const float qn = qq[i] * rsq(sq + 1e-6f) * 0.125f, kn = kap[i] * rsq(sk + 1e-6f);
            kap[i] = kn; bb[i] = alpha * beta * kn; kp[i] = beta * kn; qq[i] = qn;
          }
        } else {
#pragma unroll
          for (int i = 0; i < 8; i++) {
            const float* row = ST + (dir ? 7 - i : i) * 256;
            const int n = lane & 31;
            const float lg = c_gb + row[192 + n];
            const float ls = fminf(lg, 0.f) - __logf(1.f + __expf(-fabsf(lg)));
            logd[i] = ls * (1.f / 16.f);
            kap[i] = 0.f; bb[i] = 0.f;
            kp[i] = lane < 32 ? row[32 + n] : 0.f;
            qq[i] = lane < 32 ? row[n] : 0.f;
          }
        }
        wave_lds_sync();
        float kt[8], qt[8], bck[8], kck[8];
        {
          float L[8];
          float run = 0.f;
#pragma unroll
          for (int i = 0; i < 8; i++) { run += logd[i]; L[i] = run; }
          const float Lr = L[3], L7 = L[7];
          float prevE = __expf(clampe(-Lr)), prevT = 1.f;
          u16* OPA = (u16*)STBY;
#pragma unroll
          for (int i = 0; i < 8; i++) {
            const float eI = __expf(clampe(L[i] - Lr)), eInv = __expf(clampe(Lr - L[i]));
            const float tI = __expf(L[i]), eEnd = __expf(L7 - L[i]);
            if (DELTA) {
              OPA[0 * 576 + i * 72 + lane] = f2bf(kap[i] * prevE);
              OPA[1 * 576 + i * 72 + lane] = f2bf(bb[i] * eInv);
            }
            OPA[2 * 576 + i * 72 + lane] = f2bf(kp[i] * eInv);
            OPA[3 * 576 + i * 72 + lane] = f2bf(qq[i] * eI);
            if (MIX == 0) OPA[4 * 576 + i * 72 + lane] = f2bf(qq[i] * eI * c_rk);
            kt[i] = kap[i] * prevT; qt[i] = qq[i] * tI;
            bck[i] = bb[i] * eEnd; kck[i] = kp[i] * eEnd;
            prevE = eI; prevT = tI;
          }
          *(float*)(SB + S3_WC + lane * 4) = __expf(L7);
        }
        wave_lds_sync();
        f32x4 accA = z4, accBm = z4, accQb = z4, accQk = z4, accBC = z4;
        {
          const u16* OPA = (const u16*)STBY;
          const int ro = (fr & 7) * 72 + fq * 8;
#pragma unroll
          for (int ks = 0; ks < 2; ks++) {
            const bf16x8 fk = ld_frag(OPA + 2 * 576 + ro + ks * 32), fqh = ld_frag(OPA + 3 * 576 + ro + ks * 32);
            accQk = __builtin_amdgcn_mfma_f32_16x16x32_bf16(fqh, fk, accQk, 0, 0, 0);
            if (MIX == 0) accBC = __builtin_amdgcn_mfma_f32_16x16x32_bf16(ld_frag(OPA + 4 * 576 + ro + ks * 32), fk, accBC, 0, 0, 0);
            if (DELTA) {
              const bf16x8 fka = ld_frag(OPA + 0 * 576 + ro + ks * 32), fb = ld_frag(OPA + 1 * 576 + ro + ks * 32);
              accA = __builtin_amdgcn_mfma_f32_16x16x32_bf16(fka, fb, accA, 0, 0, 0);
              accBm = __builtin_amdgcn_mfma_f32_16x16x32_bf16(fka, fk, accBm, 0, 0, 0);
              accQb = __builtin_amdgcn_mfma_f32_16x16x32_bf16(fqh, fb, accQb, 0, 0, 0);
            }
          }
#pragma unroll
          for (int r = 0; r < 4; r++) {
            const int i = fq * 4 + r;
            const bool ok = fq < 2 && fr < 8;
            if (!(ok && fr < i)) { accA[r] = 0.f; accBm[r] = 0.f; }
            if (!(ok && fr <= i)) { accQb[r] = 0.f; accQk[r] = 0.f; }
          }
          if (MIX == 0 && fq < 2 && fr < 8 && (fr >> 2) == fq) {
            const int r = fr & 3;
            const float bcv = r == 0 ? accBC[0] : (r == 1 ? accBC[1] : (r == 2 ? accBC[2] : accBC[3]));
            BC[(size_t)(seg_row0 + t0 + (dir ? 7 - fr : fr)) * 8 + h * 2 + dir] = bcv;
          }
        }
        *(uint4*)(SB + S3_KVT + lane * 16) = pack8(kck);
#pragma unroll
        for (int i = 0; i < 8; i++) ((u16*)(SB + S3_QB))[i * 72 + lane] = f2bf(qt[i]);
        if (fq < 2 && fr < 8) {
#pragma unroll
          for (int r = 0; r < 4; r++) {
            ((u16*)(SB + S3_QKM))[(fq * 4 + r) * 8 + fr] = f2bf(accQk[r]);
            if (DELTA) ((u16*)(SB + S3_QBM))[(fq * 4 + r) * 8 + fr] = f2bf(accQb[r]);
          }
        }
        if (DELTA) {
          float t[8];
#pragma unroll
          for (int i = 0; i < 8; i++) {
            float ti = (lane == i) ? 1.f : 0.f;
#pragma unroll
            for (int m = 0; m < i; m++) ti -= rlane(accA[i & 3], (i >> 2) * 16 + m) * t[m];
            t[i] = ti;
          }
#pragma unroll
          for (int i = 0; i < 8; i++) ((u16*)(SB + S3_KB))[i * 72 + lane] = f2bf(-kt[i]);
          *(uint4*)(SB + S3_BT + lane * 16) = pack8(bck);
          if (fq < 2 && fr < 8) {
#pragma unroll
            for (int r = 0; r < 4; r++) ((u16*)(SB + S3_TB))[(fq * 4 + r) * 8 + fr] = f2bf(-accBm[r]);
          }
          if (lane < 8) {
#pragma unroll
            for (int i = 0; i < 8; i++) ((u16*)(SB + S3_TM))[i * 8 + lane] = f2bf(t[i]);
          }
        }
      }
    }
    fetch_raw<MIX>(P, min(it + 1, TPB / 64 - 1) * 2 + half, dir, b, h, pw, lane, colv, rawq);
    __syncthreads();
    if (w < 4) {
      unsigned char* STB = smb + S3_STB + w * 2304;
#pragma unroll
      for (int kk = 0; kk < 8; kk++) {
        const int cc = it * 2 + (kk >> 2), k = kk & 3;
        int seg_row0, t_lo;
        if (cc < 8) { seg_row0 = b * TPB; t_lo = dir == 0 ? cc * 32 : (LC - 32 - cc * 32); }
        else { seg_row0 = b * TPB + LC; t_lo = dir == 0 ? (cc - 8) * 32 : (SEQ - 32 - (cc - 8) * 32); }
        const int sc = dir ? 3 - k : k;
        const unsigned char* SB = smb + ((kk >> 2) * 4 + sc) * S3_SUB;
        const bf16x8 bs0 = __builtin_bit_cast(bf16x8, u32x4v{pack2(st[0][0], st[0][1]), pack2(st[0][2], st[0][3]), pack2(st[1][0], st[1][1]), pack2(st[1][2], st[1][3])});
        const bf16x8 bs1 = __builtin_bit_cast(bf16x8, u32x4v{pack2(st[2][0], st[2][1]), pack2(st[2][2], st[2][3]), pack2(st[3][0], st[3][1]), pack2(st[3][2], st[3][3])});
#define LDP(BASE_, ROW_, KS_) ([&]() -> bf16x8 {                                                                   \
          const uint2 lo_ = *(const uint2*)((BASE_) + ((ROW_) * 72 + (KS_) * 32 + fq * 4) * 2);                      \
          const uint2 hi_ = *(const uint2*)((BASE_) + ((ROW_) * 72 + (KS_) * 32 + 16 + fq * 4) * 2);                 \
          return __builtin_bit_cast(bf16x8, u32x4v{lo_.x, lo_.y, hi_.x, hi_.y}); }())
        const bf16x8 bv = fq == 0 ? ld_frag(SB + S3_VT + (w * 16 + fr) * 16) : zfrag();
        const bf16x8 aq0 = LDP(SB + S3_QB, (fr & 7), 0), aq1 = LDP(SB + S3_QB, (fr & 7), 1);
        const bf16x8 aqk = fq == 0 ? ld_frag(SB + S3_QKM + (fr & 7) * 16) : zfrag();
        bf16x8 brv = zfrag();
        if (DELTA) {
          const bf16x8 ak0 = LDP(SB + S3_KB, (fr & 7), 0), ak1 = LDP(SB + S3_KB, (fr & 7), 1);
          const bf16x8 atb = fq == 0 ? ld_frag(SB + S3_TB + (fr & 7) * 16) : zfrag();
          f32x4 accR = __builtin_amdgcn_mfma_f32_16x16x32_bf16(ak0, bs0, z4, 0, 0, 0);
          accR = __builtin_amdgcn_mfma_f32_16x16x32_bf16(ak1, bs1, accR, 0, 0, 0);
          accR = __builtin_amdgcn_mfma_f32_16x16x32_bf16(atb, bv, accR, 0, 0, 0);
          {
            const uint2 t2 = *(const uint2*)(SB + S3_TM + (fr & 7) * 16 + (fq & 1) * 8);
            const u32x4v ta4 = {t2.x, t2.y, 0u, 0u};
            const u32x4v rb4 = {pack2(accR[0], accR[1]), pack2(accR[2], accR[3]), 0u, 0u};
            const bf16x8 at = fq < 2 ? __builtin_bit_cast(bf16x8, ta4) : zfrag();
            const bf16x8 br = fq < 2 ? __builtin_bit_cast(bf16x8, rb4) : zfrag();
            accR = __builtin_amdgcn_mfma_f32_16x16x32_bf16(at, br, z4, 0, 0, 0);
          }
          const uint2 vv2 = *(const uint2*)(SB + S3_VT + (w * 16 + fr) * 16 + (fq & 1) * 8);
          const u32x4v t4 = {pack2(accR[0], accR[1]), pack2(accR[2], accR[3]), vv2.x, vv2.y};
          brv = fq < 2 ? __builtin_bit_cast(bf16x8, t4) : zfrag();
        }
        f32x4 accY = __builtin_amdgcn_mfma_f32_16x16x32_bf16(aq0, bs0, z4, 0, 0, 0);
        accY = __builtin_amdgcn_mfma_f32_16x16x32_bf16(aq1, bs1, accY, 0, 0, 0);
        if (DELTA) {
          const uint2 qb2 = *(const uint2*)(SB + S3_QBM + (fr & 7) * 16 + (fq & 1) * 8);
          const uint2 qk2 = *(const uint2*)(SB + S3_QKM + (fr & 7) * 16 + (fq & 1) * 8);
          const u32x4v q4 = {qb2.x, qb2.y, qk2.x, qk2.y};
          const bf16x8 aqm = fq < 2 ? __builtin_bit_cast(bf16x8, q4) : zfrag();
          accY = __builtin_amdgcn_mfma_f32_16x16x32_bf16(aqm, brv, accY, 0, 0, 0);
        } else {
          accY = __builtin_amdgcn_mfma_f32_16x16x32_bf16(aqk, bv, accY, 0, 0, 0);
        }
        if (fq < 2) {
#pragma unroll
          for (int r = 0; r < 4; r++) {
            const int i = fq * 4 + r, j = dir ? 7 - i : i;
            YS[(size_t)(seg_row0 + t_lo + sc * 8 + j) * YST + dir * 768 + MIX * 256 + h * 64 + w * 16 + fr] = f2bf(accY[r]);
          }
        }
#pragma unroll
        for (int nt = 0; nt < 4; nt++) {
          f32x4 an;
          if (DELTA) {
            const uint2 b2 = *(const uint2*)(SB + S3_BT + (nt * 16 + fr) * 16 + (fq & 1) * 8);
            const uint2 k2 = *(const uint2*)(SB + S3_KVT + (nt * 16 + fr) * 16 + (fq & 1) * 8);
            const u32x4v a4 = {b2.x, b2.y, k2.x, k2.y};
            const bf16x8 am = fq < 2 ? __builtin_bit_cast(bf16x8, a4) : zfrag();
            an = __builtin_amdgcn_mfma_f32_16x16x32_bf16(am, brv, z4, 0, 0, 0);
          } else {
            const bf16x8 akv = fq == 0 ? ld_frag(SB + S3_KVT + (nt * 16 + fr) * 16) : zfrag();
            an = __builtin_amdgcn_mfma_f32_16x16x32_bf16(akv, bv, z4, 0, 0, 0);
          }
          const float4 wc = *(const float4*)(SB + S3_WC + (nt * 16 + fq * 4) * 4);
          st[nt][0] = st[nt][0] * wc.x + an[0];
          st[nt][1] = st[nt][1] * wc.y + an[1];
          st[nt][2] = st[nt][2] * wc.z + an[2];
          st[nt][3] = st[nt][3] * wc.w + an[3];
        }
#undef LDP
      }
    }
    __syncthreads();
  }
}

__device__ __forceinline__ void attn_item(const Params& p, int l, int b, int qb, int hk, bool isctx, unsigned char* smem) {
  u16* KS = (u16*)smem;
  u16* VT = KS + 64 * LDT;
  u16* PL = VT + 64 * LDT;
  float2* ROPE = (float2*)(PL + 8 * 32 * LDT);
  const int tid = TIDX, lane = tid & 63, w = tid >> 6, fr = lane & 15, fq = lane >> 4;
  const u16* P = (const u16*)(p.ws + OFF_BIG);
  u16* Y = (u16*)(p.ws + OFF_YS);
  const int qh = hk * 2 + (w >> 2);
  const int tb = qb * 128 + (w & 3) * 32;
  const int qrow0 = b * TPB + (isctx ? 0 : LC);
  __syncthreads();
  for (int i = tid; i < 1024; i += NTHR) {
    int pos = i >> 4, fi = i & 15;
    float inv = powf(10000.f, -(float)fi / 16.f);
    float sn, cs;
    sincosf((float)pos * inv, &sn, &cs);
    ROPE[i] = make_float2(cs, sn);
  }
  __syncthreads();
  bf16x8 qf[2][2];
#pragma unroll
  for (int mi = 0; mi < 2; mi++)
#pragma unroll
    for (int ks = 0; ks < 2; ks++) {
      const int tq = tb + mi * 16 + fr;
      const u16* qp = P + (size_t)(qrow0 + tq) * PST + PD + qh * 64 + ks * 32;
      uint4 own = *(const uint4*)(qp + fq * 8);
      uint4 par = *(const uint4*)(qp + (fq ^ 2) * 8);
      const unsigned ow[4] = {own.x, own.y, own.z, own.w};
      const unsigned pw[4] = {par.x, par.y, par.z, par.w};
      const int pos = ks == 0 ? (tq >> 6) : (tq & 63);
      bf16x8 f;
#pragma unroll
      for (int jj = 0; jj < 8; jj++) {
        float xo = bf2f((u16)((ow[jj >> 1] >> ((jj & 1) * 16)) & 0xffff));
        float xp = bf2f((u16)((pw[jj >> 1] >> ((jj & 1) * 16)) & 0xffff));
        float v = xo;
        if (!isctx) {
          float2 cs = ROPE[pos * 16 + (fq & 1) * 8 + jj];
          v = fq < 2 ? xo * cs.x - xp * cs.y : xp * cs.y + xo * cs.x;
        }
        f[jj] = (short)f2bf(v * 0.125f);
      }
      qf[mi][ks] = f;
    }
  f32x4 oacc[2][4];
#pragma unroll
  for (int mi = 0; mi < 2; mi++)
#pragma unroll
    for (int nd = 0; nd < 4; nd++) oacc[mi][nd] = f32x4{0.f, 0.f, 0.f, 0.f};
  float mrow[2][4], lrow[2][4];
#pragma unroll
  for (int mi = 0; mi < 2; mi++)
#pragma unroll
    for (int r = 0; r < 4; r++) { mrow[mi][r] = -1e30f; lrow[mi][r] = 0.f; }

  const int q0 = qb * 128;
  const int band_lo = isctx ? 0 : max(0, q0 - 128), band_hi = isctx ? 0 : min(SEQ, q0 + 256);
  const int ntile = 4 + (band_hi - band_lo) / 64;
  u16* pl = PL + w * 32 * LDT;
  for (int tl = 0; tl < ntile; tl++) {
    const bool band = tl >= 4;
    const int k0 = band ? band_lo + (tl - 4) * 64 : tl * 64;
    __syncthreads();
    {
      const int key = tid >> 3, kc = tid & 7;
      const int kpos = k0 + key;
      const u16* kp = P + (size_t)(b * TPB + (band ? LC : 0) + kpos) * PST + PD + 256 + hk * 64;
      uint4 own = *(const uint4*)(kp + kc * 8);
      uint4 vv = *(const uint4*)(kp + 128 + kc * 8);
      uint4 par = *(const uint4*)(kp + (kc ^ 2) * 8);
      if (band) {
        const unsigned ow[4] = {own.x, own.y, own.z, own.w};
        const unsigned pw[4] = {par.x, par.y, par.z, par.w};
        const int pos = kc < 4 ? (kpos >> 6) : (kpos & 63);
        unsigned res[4];
#pragma unroll
        for (int jj = 0; jj < 8; jj += 2) {
          float v2[2];
#pragma unroll
          for (int e = 0; e < 2; e++) {
            float xo = bf2f((u16)((ow[jj >> 1] >> (e * 16)) & 0xffff));
            float xp = bf2f((u16)((pw[jj >> 1] >> (e * 16)) & 0xffff));
            float2 cs = ROPE[pos * 16 + (kc & 1) * 8 + jj + e];
            v2[e] = (kc & 2) == 0 ? xo * cs.x - xp * cs.y : xp * cs.y + xo * cs.x;
          }
          res[jj >> 1] = pack2(v2[0], v2[1]);
        }
        own = make_uint4(res[0], res[1], res[2], res[3]);
      }
      *(uint4*)(KS + key * LDT + kc * 8) = own;
      const unsigned vw[4] = {vv.x, vv.y, vv.z, vv.w};
#pragma unroll
      for (int jj = 0; jj < 8; jj++) VT[(kc * 8 + jj) * LDT + key] = (u16)((vw[jj >> 1] >> ((jj & 1) * 16)) & 0xffff);
    }
    __syncthreads();
    f32x4 sc[2][4];
#pragma unroll
    for (int mi = 0; mi < 2; mi++)
#pragma unroll
      for (int nj = 0; nj < 4; nj++) sc[mi][nj] = f32x4{0.f, 0.f, 0.f, 0.f};
#pragma unroll
    for (int ks = 0; ks < 2; ks++) {
      bf16x8 kf[4];
#pragma unroll
      for (int nj = 0; nj < 4; nj++) kf[nj] = *(const bf16x8*)(KS + (nj * 16 + fr) * LDT + ks * 32 + fq * 8);
#pragma unroll
      for (int mi = 0; mi < 2; mi++)
#pragma unroll
        for (int nj = 0; nj < 4; nj++) sc[mi][nj] = __builtin_amdgcn_mfma_f32_16x16x32_bf16(qf[mi][ks], kf[nj], sc[mi][nj], 0, 0, 0);
    }
#pragma unroll
    for (int mi = 0; mi < 2; mi++)
#pragma unroll
      for (int r = 0; r < 4; r++) {
        const int qpos = tb + mi * 16 + fq * 4 + r;
        float mx = -1e30f;
#pragma unroll
        for (int nj = 0; nj < 4; nj++) {
          float v = sc[mi][nj][r];
          if (band) {
            int d = qpos - (k0 + nj * 16 + fr);
            if (d > 128 || d < -128) v = -1e30f;
          }
          sc[mi][nj][r] = v;
          mx = fmaxf(mx, v);
        }
        mx = fmaxf(mx, __shfl_xor(mx, 1));
        mx = fmaxf(mx, __shfl_xor(mx, 2));
        mx = fmaxf(mx, __shfl_xor(mx, 4));
        mx = fmaxf(mx, __shfl_xor(mx, 8));
        const float mnew = fmaxf(mrow[mi][r], mx);
        const float alpha = __expf(mrow[mi][r] - mnew);
        mrow[mi][r] = mnew;
        float ls = 0.f;
#pragma unroll
        for (int nj = 0; nj < 4; nj++) {
          float pe = __expf(sc[mi][nj][r] - mnew);
          ls += pe;
          pl[(mi * 16 + fq * 4 + r) * LDT + nj * 16 + fr] = f2bf(pe);
        }
        lrow[mi][r] = lrow[mi][r] * alpha + ls;
#pragma unroll
        for (int nd = 0; nd < 4; nd++) oacc[mi][nd][r] *= alpha;
      }
    asm volatile("s_waitcnt lgkmcnt(0)" ::: "memory");
    __builtin_amdgcn_wave_barrier();
#pragma unroll
    for (int ks = 0; ks < 2; ks++) {
      bf16x8 pf[2], vf[4];
#pragma unroll
      for (int mi = 0; mi < 2; mi++) pf[mi] = *(const bf16x8*)(pl + (mi * 16 + fr) * LDT + ks * 32 + fq * 8);
#pragma unroll
      for (int nd = 0; nd < 4; nd++) vf[nd] = *(const bf16x8*)(VT + (nd * 16 + fr) * LDT + ks * 32 + fq * 8);
#pragma unroll
      for (int mi = 0; mi < 2; mi++)
#pragma unroll
        for (int nd = 0; nd < 4; nd++) oacc[mi][nd] = __builtin_amdgcn_mfma_f32_16x16x32_bf16(pf[mi], vf[nd], oacc[mi][nd], 0, 0, 0);
    }
    asm volatile("s_waitcnt lgkmcnt(0)" ::: "memory");
    __builtin_amdgcn_wave_barrier();
  }
  const float sink = p.attn_sink[l * 4 + qh];
#pragma unroll
  for (int mi = 0; mi < 2; mi++)
#pragma unroll
    for (int r = 0; r < 4; r++) {
      float ls = lrow[mi][r];
      ls += __shfl_xor(ls, 1);
      ls += __shfl_xor(ls, 2);
      ls += __shfl_xor(ls, 4);
      ls += __shfl_xor(ls, 8);
      ls += __expf(sink - mrow[mi][r]);
      const float inv = 1.f / ls;
      const int tq = tb + mi * 16 + fq * 4 + r;
#pragma unroll
      for (int nd = 0; nd < 4; nd++) Y[(size_t)(qrow0 + tq) * YST + 1536 + qh * 64 + nd * 16 + fr] = f2bf(oacc[mi][nd][r] * inv);
    }
}

#ifndef SCAN3_MASK
#define SCAN3_MASK 7
#endif
__device__ __forceinline__ void phase_mix(const Params& p, int l, unsigned char* smem) {
  float* sm = (float*)smem;
  const int G = gridDim.x;
  for (int it = blockIdx.x; it < 192; it += G) {
    const int mix = it >> 6, rem = it & 63, b = rem >> 3, h = (rem >> 1) & 3, dir = rem & 1;
    if (mix == 0 && (SCAN3_MASK & 1)) scan3_item<0>(p, l, b, h, dir, smem);
    else if (mix == 1 && (SCAN3_MASK & 2)) scan3_item<1>(p, l, b, h, dir, smem);
    else if (mix == 2 && (SCAN3_MASK & 4)) scan3_item<2>(p, l, b, h, dir, smem);
  }
  if (SCAN3_MASK != 7) {
    for (int it = blockIdx.x; it < 768; it += G) {
      const int mix = it >> 8, rem = it & 255, b = rem >> 5, h = (rem >> 3) & 3, dir = (rem >> 2) & 1, rq = rem & 3;
      if (mix == 0 && !(SCAN3_MASK & 1)) scan2_item<0>(p, l, b, h, dir, rq, sm);
      else if (mix == 1 && !(SCAN3_MASK & 2)) scan2_item<1>(p, l, b, h, dir, rq, sm);
      else if (mix == 2 && !(SCAN3_MASK & 4)) scan2_item<2>(p, l, b, h, dir, rq, sm);
    }
  }
  __syncthreads();
  {
    const bool spread = G >= 192;
    const int nconv = spread ? 64 : G, fidx = spread ? (int)blockIdx.x - 128 : (int)blockIdx.x;
    if (fidx >= 0 && fidx < nconv)
      for (int it = 832 + fidx; it < 4480; it += nconv) conv_item(p, l, it, (float*)smem);
    __syncthreads();
  }
  unsigned* ctr = (unsigned*)(p.ws + OFF_CTR) + l * 16;
  volatile int* slot = (volatile int*)(smem + 131072 - 16);
  for (;;) {
    if (TIDX == 0) *slot = (int)atomicAdd(ctr, 1u);
    __syncthreads();
    const int it = *slot;
    __syncthreads();
    if (it >= (l == 0 ? 544 : 512)) break;
    if (it < 512) {
      int b = it >> 6, qb = (it >> 1) & 31, hk = it & 1;
      attn_item(p, l, b, qb, hk, false, smem);
    } else {
      int r = it - 512, b = r >> 2, qb = (r >> 1) & 1, hk = r & 1;
      attn_item(p, l, b, qb, hk, true, smem);
    }
  }
}

#define POST_DECL(PFX) uint2 PFX##ya0, PFX##ya1, PFX##ya2, PFX##yc0, PFX##yc1, PFX##yc2, PFX##vp, PFX##vc, PFX##vn, PFX##gb, PFX##gc; \
  u16 PFX##xp, PFX##xc, PFX##xn; float2 PFX##bc
#define POST_LOAD(PFX, R_)                                                                         \
  do {                                                                                             \
    const int r_ = (R_);                                                                           \
    const int b_ = r_ / TPB, t_ = r_ - b_ * TPB;                                                   \
    const bool hp_ = (t_ != 0) && (t_ != LC), hn_ = (t_ != LC - 1) && (t_ != TPB - 1);            \
    const u16* ys_ = YSc + (size_t)r_ * YST;                                                       \
    const u16* pr_ = Pc + (size_t)r_ * PST;                                                        \
    const u16* pp_ = pr_ - (hp_ ? PST : 0);                                                        \
    const u16* pn_ = pr_ + (hn_ ? PST : 0);                                                        \
    PFX##ya0 = *(const uint2*)(ys_ + j0); PFX##ya1 = *(const uint2*)(ys_ + 256 + j0); PFX##ya2 = *(const uint2*)(ys_ + 512 + j0); \
    PFX##yc0 = *(const uint2*)(ys_ + 768 + j0); PFX##yc1 = *(const uint2*)(ys_ + 1024 + j0); PFX##yc2 = *(const uint2*)(ys_ + 1280 + j0); \
    PFX##vp = *(const uint2*)(pp_ + PA + 512 + j0);                                                \
    PFX##vc = *(const uint2*)(pr_ + PA + 512 + j0);                                                \
    PFX##vn = *(const uint2*)(pn_ + PA + 512 + j0);                                                \
    PFX##gb = *(const uint2*)(pr_ + PB + 784 + j0);                                                \
    PFX##gc = *(const uint2*)(pr_ + PC + 544 + j0);                                                \
    PFX##xp = pp_[PA + 896 + lane]; PFX##xc = pr_[PA + 896 + lane]; PFX##xn = pn_[PA + 896 + lane]; \
    PFX##bc = *(const float2*)(BCc + (size_t)r_ * 8 + (lane >> 4) * 2);                            \
  } while (0)
__device__ __forceinline__ void unpack4(uint2 v, float (&o)[4]) {
  o[0] = __uint_as_float(v.x << 16); o[1] = __uint_as_float(v.x & 0xffff0000u);
  o[2] = __uint_as_float(v.y << 16); o[3] = __uint_as_float(v.y & 0xffff0000u);
}

__device__ __forceinline__ void phase_post(const Params& p, int l, float* g2s) {
  const int lane = TIDX & 63, wv = __builtin_amdgcn_readfirstlane(TIDX >> 6);
  u16* YS = (u16*)(p.ws + OFF_YS);
  const int j0 = lane * 4;
  {
    const float4* src = (const float4*)(p.rwkv_g2 + (size_t)l * 64 * 256);
    for (int i = TIDX; i < 64 * 256 / 4; i += NTHR) ((float4*)g2s)[i] = src[i];
  }
  float mu_v[4], lng[4], lnb[4], ngb[4], ngc[4];
#pragma unroll
  for (int i = 0; i < 4; i++) {
    mu_v[i] = p.rwkv_mu[l * 960 + 512 + j0 + i];
    lng[i] = p.rwkv_ln_g[l * 256 + j0 + i];
    lnb[i] = p.rwkv_ln_b[l * 256 + j0 + i];
    ngb[i] = p.gdn_norm_g[l * 64 + (lane & 15) * 4 + i];
    ngc[i] = p.gla_norm_g[l * 64 + (lane & 15) * 4 + i];
  }
  const float mu_x = p.rwkv_mu[l * 960 + 896 + lane];
  __syncthreads();
  const int stride = gridDim.x * 8;
  int r = blockIdx.x * 8 + wv;
  const u16* Pc = (const u16*)(p.ws + OFF_BIG);
  const u16* YSc = (const u16*)(p.ws + OFF_YS);
  const float* BCc = (const float*)(p.ws + OFF_BC);
  POST_DECL(cur_);
  POST_DECL(nxt_);
  POST_LOAD(cur_, r);
  for (; r < NROWS; r += stride) {
    const int rn = r + stride < NROWS ? r + stride : r;
    POST_LOAD(nxt_, rn);
    const int b = r / TPB, t = r - b * TPB;
    const float pmul = ((t != 0) && (t != LC)) ? 1.f : 0.f, nmul = ((t != LC - 1) && (t != TPB - 1)) ? 1.f : 0.f;
    if (!(l == 1 && t < LC)) {
    float y[3][4];
    {
      float a4[4], c4[4];
      unpack4(cur_ya0, a4); unpack4(cur_yc0, c4);
#pragma unroll
      for (int i = 0; i < 4; i++) y[0][i] = a4[i] + c4[i];
      unpack4(cur_ya1, a4); unpack4(cur_yc1, c4);
#pragma unroll
      for (int i = 0; i < 4; i++) y[1][i] = a4[i] + c4[i];
      unpack4(cur_ya2, a4); unpack4(cur_yc2, c4);
#pragma unroll
      for (int i = 0; i < 4; i++) y[2][i] = a4[i] + c4[i];
    }
    float o[3][4];
    {
      float sum = y[0][0] + y[0][1] + y[0][2] + y[0][3];
      sum = red16(sum);
      const float mean = sum * (1.f / 64.f);
      float vs = 0.f;
#pragma unroll
      for (int i = 0; i < 4; i++) { float d = y[0][i] - mean; vs += d * d; }
      vs = red16(vs);
      const float rstd = rsq(vs * (1.f / 64.f) + 64e-5f);
      const float pv = bf2f(cur_xc), ppv = bf2f(cur_xp) * pmul, pnv = bf2f(cur_xn) * nmul;
      const float sg = sigm(pv + (0.5f * (ppv + pnv) - pv) * mu_x);
      float gate[4] = {0.f, 0.f, 0.f, 0.f};
      const float* g2 = g2s + j0;
#pragma unroll 8
      for (int i = 0; i < 64; i++) {
        const float si = __int_as_float(__builtin_amdgcn_readlane(__float_as_int(sg), i));
        const float4 gw = *(const float4*)(g2 + i * 256);
        gate[0] += si * gw.x; gate[1] += si * gw.y; gate[2] += si * gw.z; gate[3] += si * gw.w;
      }
      const float bcs = cur_bc.x + cur_bc.y;
      float vc4[4], vp4[4], vn4[4];
      unpack4(cur_vc, vc4); unpack4(cur_vp, vp4); unpack4(cur_vn, vn4);
#pragma unroll
      for (int i = 0; i < 4; i++) {
        const float v = vc4[i] + (0.5f * (vp4[i] * pmul + vn4[i] * nmul) - vc4[i]) * mu_v[i];
        const float yn = (y[0][i] - mean) * rstd * lng[i] + lnb[i];
        o[0][i] = (yn + bcs * v) * gate[i];
      }
    }
#pragma unroll
    for (int m = 1; m < 3; m++) {
      float ss = y[m][0] * y[m][0] + y[m][1] * y[m][1] + y[m][2] * y[m][2] + y[m][3] * y[m][3];
      ss = red16(ss);
      const float inv = rsq(ss * (1.f / 64.f) + 1e-6f);
      float g4[4];
      unpack4(m == 1 ? cur_gb : cur_gc, g4);
#pragma unroll
      for (int i = 0; i < 4; i++) o[m][i] = y[m][i] * inv * (m == 1 ? ngb[i] : ngc[i]) * siluf(g4[i]);
    }
    u16* ys = YS + (size_t)r * YST;
#pragma unroll
    for (int m = 0; m < 3; m++) {
      uint2 ov;
      ov.x = pack2(o[m][0], o[m][1]);
      ov.y = pack2(o[m][2], o[m][3]);
      *(uint2*)(ys + m * 256 + j0) = ov;
    }
    }
    cur_ya0 = nxt_ya0; cur_ya1 = nxt_ya1; cur_ya2 = nxt_ya2; cur_yc0 = nxt_yc0; cur_yc1 = nxt_yc1; cur_yc2 = nxt_yc2;
    cur_vp = nxt_vp; cur_vc = nxt_vc; cur_vn = nxt_vn; cur_gb = nxt_gb; cur_gc = nxt_gc;
    cur_xp = nxt_xp; cur_xc = nxt_xc; cur_xn = nxt_xn; cur_bc = nxt_bc;
  }
}

#define XB_TMO      128
#define XB_XCNT(j)  (256  + 64 * (j))
#define XB_XSUB(j)  (1280 + 64 * (j))
#define XB_XGEN(j)  (2304 + 64 * (j))
#define XB_TOP      3328
#define XB_TOPGEN   3392
#define XCD_BAR_WORDS 3456
#define XB_SPIN_CAP (1u << 18)
#define LAS __attribute__((address_space(3)))

__device__ __forceinline__ unsigned xb_ld(unsigned* p)              { return __hip_atomic_load(p, __ATOMIC_RELAXED, __HIP_MEMORY_SCOPE_AGENT); }
__device__ __forceinline__ unsigned xb_add(unsigned* p, unsigned v) { return __hip_atomic_fetch_add(p, v, __ATOMIC_RELAXED, __HIP_MEMORY_SCOPE_AGENT); }
__device__ __forceinline__ unsigned xb_xcc_id() { return (unsigned)__builtin_amdgcn_s_getreg((3 << 11) | 20) & 0xFu; }
#define XB_SPIN(cond, bar) do { unsigned _sp = 0; while (cond) { __builtin_amdgcn_s_sleep(1); \
    if ((++_sp & 255u) == 0u) { if (xb_ld(&(bar)[XB_TMO])) break; if (_sp > XB_SPIN_CAP) { atomicAdd(&(bar)[XB_TMO], 1u); break; } } } } while (0)

struct XcdBarrier {
    unsigned* bar; unsigned x;
    volatile LAS unsigned* st;
};

__device__ __forceinline__ XcdBarrier xcd_barrier_post(unsigned* bar, volatile LAS unsigned* st) {
    XcdBarrier b; b.bar = bar; b.x = xb_xcc_id(); b.st = st;
    if (threadIdx.x == 0) (void)xb_add(&bar[XB_XCNT(b.x)], 1u);
    return b;
}
__device__ __forceinline__ void xcd_barrier_complete(unsigned* bar, unsigned x, unsigned& nloc, unsigned& nx) {
    const unsigned G = gridDim.x * gridDim.y * gridDim.z;
    unsigned sum, cnt, mine, sp = 0u;
    for (;;) {
        sum = 0u; cnt = 0u; mine = 0u;
#pragma unroll
        for (unsigned j = 0; j < 16; ++j) { const unsigned c = xb_ld(&bar[XB_XCNT(j)]); sum += c; cnt += (c > 0u) ? 1u : 0u; mine = (j == x) ? c : mine; }
        if (sum == G) break;
        __builtin_amdgcn_s_sleep(1);
        if ((++sp & 255u) == 0u) { if (xb_ld(&bar[XB_TMO])) break; if (sp > XB_SPIN_CAP) { atomicAdd(&bar[XB_TMO], 1u); break; } }
    }
    nloc = mine > 0u ? mine : 1u; nx = cnt > 0u ? cnt : 1u;
}

__device__ __forceinline__ void xcd_barrier(const XcdBarrier& b) {
    asm volatile("s_waitcnt vmcnt(0)" ::: "memory");
    __syncthreads();
    if (threadIdx.x == 0) {
        unsigned* bar = b.bar;
        __builtin_amdgcn_s_waitcnt(0);
        unsigned nloc = b.st[0], nx = b.st[1];
        if (nloc == 0u) { xcd_barrier_complete(bar, b.x, nloc, nx); b.st[0] = nloc; b.st[1] = nx; }
        const unsigned old = xb_add(&bar[XB_XSUB(b.x)], 1u);
        const unsigned gen = old / nloc;
        if (old + 1u == (gen + 1u) * nloc) {
            __builtin_amdgcn_fence(__ATOMIC_RELEASE, "agent");
            asm volatile("s_waitcnt vmcnt(0)" ::: "memory");
            const unsigned og = xb_add(&bar[XB_TOP], 1u);
            const unsigned tg = og / nx;
            if (og + 1u == (tg + 1u) * nx) xb_add(&bar[XB_TOPGEN], 1u);
            else XB_SPIN(xb_ld(&bar[XB_TOPGEN]) == tg, bar);
            __builtin_amdgcn_fence(__ATOMIC_ACQUIRE, "agent");
            xb_add(&bar[XB_XGEN(b.x)], 1u);
            asm volatile("s_waitcnt vmcnt(0)" ::: "memory");
        } else {
            XB_SPIN(xb_ld(&bar[XB_XGEN(b.x)]) == gen, bar);
            __builtin_amdgcn_fence(__ATOMIC_ACQUIRE, "agent");
            asm volatile("s_waitcnt vmcnt(0)" ::: "memory");
        }
    }
    __syncthreads();
}

#if defined(SKIPS)
#define EN(k) (SKIPS != (k))
#elif !defined(ONLYS)
#define EN(k) 1
#else
#define EN(k) (ONLYS == (k))
#endif
__device__ __forceinline__ void run_phase(const Params& p, int ph, unsigned char* smem) {
  if (ph == 0) { if (EN(10)) phase_init0(p, (float*)smem); return; }
  if (ph == 1) { if (EN(11)) phase_init1(p); return; }
  int l = 0, s = 10;
  if (ph >= 3) { l = (ph - 3) / 10; s = (ph - 3) - l * 10; }
  unsigned char* wl = p.ws + OFF_W;
  PG8_LAS unsigned char* lds = (PG8_LAS unsigned char*)smem;
  pg8::StaticOrder S;
  if (s == 10 || s == 6 || s == 9) {
    if (EN(5)) rowpass(p, l, s == 10 ? 0 : (s == 6 ? 1 : 2));
    if (s == 9 && l == 0) {
      __syncthreads();
      for (int it = blockIdx.x; it < 832; it += gridDim.x) conv_item(p, 1, it, (float*)smem);
    }
  } else if (s == 0 || s == 3 || s == 5 || s == 8) {
    pg8::Gemm g; EpiBf E;
    g.M = NROWS; E.bias = nullptr; E.act = 0;
    if (s == 0) { g.A = (const u16*)(p.ws + OFF_H); g.lda = DM; g.Bt = (const u16*)(wl + OW_IN); g.K = DM; g.N = PST; E.O = (u16*)(p.ws + OFF_BIG); E.ldc = PST; }
    else if (s == 3) {
      g.A = (const u16*)(p.ws + OFF_H); g.lda = DM; g.Bt = (const u16*)(wl + OW_G); g.K = DM; g.N = 4096;
      E.O = (u16*)(p.ws + OFF_BIG); E.ldc = 4096; E.bias = p.gate_b + (size_t)l * 4096; E.act = 1;
    }
    else if (s == 5) { g.A = (const u16*)(p.ws + OFF_H); g.lda = DM; g.Bt = (const u16*)(wl + OW_O); g.K = DM; g.N = DM; E.O = (u16*)(p.ws + OFF_BIG); E.ldc = DM; }
    else { g.A = (const u16*)(p.ws + OFF_BIG); g.lda = FH; g.Bt = (const u16*)(wl + OW_2); g.K = FH; g.N = DM; E.O = (u16*)(p.ws + OFF_YS); E.ldc = DM; }
    if (l == 1 && s != 0) S.init(NBATCH * SEQ, g.N, gridDim.x, blockIdx.x, 1);
    else S.init(g.M, g.N, gridDim.x, blockIdx.x);
    if (EN(0)) pg8::gemm_phase<EpiBf, pg8::StaticOrder, false>(lds, g, S, E, nullptr);
  } else if (s == 4) {
    if (EN(3)) phase_ypart(p, l, smem);
  } else if (s == 1) {
    if (EN(1)) phase_mix(p, l, smem);
  } else if (s == 2) {
    if (EN(2)) phase_post(p, l, (float*)smem);
  } else {
    pg8::Gemm g; EpiSwiglu E;
    g.M = NROWS; g.N = 2 * FH; g.K = DM; g.lda = DM; g.A = (const u16*)(p.ws + OFF_H); g.Bt = (const u16*)(wl + OW_1);
    E.O = (u16*)(p.ws + OFF_BIG);
    if (l == 1) S.init(NBATCH * SEQ, g.N, gridDim.x, blockIdx.x, 1);
    else S.init(g.M, g.N, gridDim.x, blockIdx.x);
    if (EN(6)) pg8::gemm_phase<EpiSwiglu, pg8::StaticOrder, false>(lds, g, S, E, nullptr);
  }
}

__global__ void __launch_bounds__(NTHR) hybrid_flow_mega(Params p, int ph0, int ph1) {
  __shared__ __attribute__((aligned(16))) unsigned char smem[131072];
  __shared__ __attribute__((aligned(16))) unsigned xbw[4];
  cg::grid_group grid = cg::this_grid();
  XcdBarrier xb;
  xb.bar = (unsigned*)(p.ws + OFF_XBAR); xb.x = 0u; xb.st = (volatile LAS unsigned*)xbw;
  for (int ph = ph0; ph < ph1; ph++) {
    run_phase(p, ph, smem);
#ifdef DUPMASK
    {
      int sidx = ph >= 3 ? (ph - 3) % 10 : 12 + ph;
      if ((DUPMASK >> sidx) & 1) { __syncthreads(); run_phase(p, ph, smem); }
    }
#endif
    if (ph + 1 < ph1) {
      if (ph == ph0) {
        grid.sync();
        if (threadIdx.x < 4) xbw[threadIdx.x] = 0u;
        __syncthreads();
        xb = xcd_barrier_post((unsigned*)(p.ws + OFF_XBAR), (volatile LAS unsigned*)xbw);
      } else {
        xcd_barrier(xb);
      }
    }
  }
  if (ph1 - ph0 > 2 && threadIdx.x == 0 && xb_ld(&xb.bar[XB_TMO]) != 0u) p.out[blockIdx.x] = __int_as_float(0x7fc00000);
}

extern "C" void kernel_launch(void* const* d_in, const int* in_sizes, int n_in, void* d_out, int out_size, void* d_ws,
                              size_t ws_size, hipStream_t stream) {
  Params p{};
  const float** pp = (const float**)&p;
  for (int i = 0; i < 32; i++) pp[i] = (const float*)d_in[i];
  p.out = (float*)d_out;
  p.ws = (unsigned char*)d_ws;
  static int grid_blocks = 0;
  if (!grid_blocks) {
    int dev = 0, cus = 0, per_cu = 0;
    hipGetDevice(&dev);
    hipDeviceGetAttribute(&cus, hipDeviceAttributeMultiprocessorCount, dev);
    hipOccupancyMaxActiveBlocksPerMultiprocessor(&per_cu, hybrid_flow_mega, NTHR, 0);
    if (per_cu < 1) per_cu = 1;
    grid_blocks = cus * per_cu;
  }
#ifdef MULTI_LAUNCH
  for (int ph = 0; ph < NPHASE; ph++) {
    hipLaunchKernelGGL(hybrid_flow_mega, dim3(grid_blocks), dim3(NTHR), 0, stream, p, ph, ph + 1);
  }
#else
  int ph0 = 0, ph1 = NPHASE;
  void* args[] = {&p, &ph0, &ph1};
  hipError_t e = hipLaunchCooperativeKernel((void*)hybrid_flow_mega, dim3(grid_blocks), dim3(NTHR), args, 0, stream);
  if (e != hipSuccess) fprintf(stderr, "cooperative launch failed: %s (grid %d)\n", hipGetErrorString(e), grid_blocks);
#endif
}
```

```cpp
#include <hip/hip_runtime.h>
#include <hip/hip_cooperative_groups.h>
#include <cstdio>
namespace cg = cooperative_groups;

typedef unsigned short u16;
using bf16x8 = __attribute__((ext_vector_type(8))) short;
using f32x4 = __attribute__((ext_vector_type(4))) float;

#define DM 1024
#define NBATCH 8
#define SEQ 4096
#define LC 256
#define TPB 4352
#define NROWS 34816
#define PST 3328
#define YST 1792
#define FH 2816
#define INW 7408
#define NTHR 512
#define PA 0
#define PB 960
#define PC 2000
#define PD 2800
#define NPHASE 23
#define SCAN3_MASK 7

struct Params {
  const float *x, *c, *ctx, *c_ctx, *ada_w, *ada_b, *norm_g, *w_in, *gate_b, *w_branch, *w_out,
      *rwkv_mu, *rwkv_w0, *rwkv_w2, *rwkv_a0, *rwkv_a2, *rwkv_g2, *rwkv_kk, *rwkv_ka, *rwkv_rk, *rwkv_ln_g,
      *rwkv_ln_b, *gdn_conv, *gdn_a_log, *gdn_dt_bias, *gdn_norm_g, *gla_gw2, *gla_gb, *gla_norm_g, *attn_sink,
      *ffn_w1, *ffn_w2;
  float* out;
  unsigned char* ws;
};

constexpr size_t SZ_WL = 36700160;
constexpr size_t OW_IN = 0;
constexpr size_t OW_G = OW_IN + (size_t)PST * 1024 * 2;
constexpr size_t OW_B = OW_G + (size_t)4096 * 1024 * 2;
constexpr size_t OW_O = OW_B + (size_t)4 * 1024 * 256 * 2;
constexpr size_t OW_1 = OW_O + (size_t)1024 * 1024 * 2;
constexpr size_t OW_2 = OW_1 + (size_t)5632 * 1024 * 2;
static_assert(OW_2 + (size_t)1024 * FH * 2 == SZ_WL, "weights size");
constexpr size_t SZ_ACT = (size_t)NROWS * DM * 2;
constexpr size_t OFF_W = 0;
constexpr size_t OFF_XC = OFF_W + SZ_WL;
constexpr size_t OFF_MODP = OFF_XC + (size_t)NBATCH * LC * DM * 4;
constexpr size_t OFF_MOD = OFF_MODP + (size_t)2 * 8 * 9 * 6144 * 4;
constexpr size_t OFF_BC = OFF_MOD + (size_t)2 * 9 * 6144 * 4;
constexpr size_t OFF_H = OFF_BC + (size_t)NROWS * 8 * 4;
constexpr size_t OFF_YS = OFF_H + SZ_ACT;
constexpr size_t OFF_BIG = OFF_YS + (size_t)NROWS * YST * 2;
constexpr size_t OFF_CTR = OFF_BIG + (size_t)NROWS * 4096 * 2;
constexpr size_t OFF_XBAR = OFF_CTR + 256;
constexpr size_t WS_END = OFF_XBAR + 3456 * 4;
static_assert(WS_END <= (size_t)536870912, "ws too large");

__device__ __forceinline__ int launder_tid() { int t = threadIdx.x; asm volatile("" : "+v"(t)); return t; }
#define TIDX (launder_tid())
typedef float f32x2_t __attribute__((ext_vector_type(2)));
typedef __bf16 bf16x2_t __attribute__((ext_vector_type(2)));
__device__ __forceinline__ unsigned pack2(float a, float b) {
  const f32x2_t v = {a, b};
  const bf16x2_t r = __builtin_convertvector(v, bf16x2_t);
  return __builtin_bit_cast(unsigned, r);
}
__device__ __forceinline__ u16 f2bf(float f) { return (u16)(pack2(f, 0.f) & 0xffffu); }
__device__ __forceinline__ float bf2f(u16 h) { return __uint_as_float(((unsigned)h) << 16); }
__device__ __forceinline__ float sigm(float x) { return __builtin_amdgcn_rcpf(1.f + __expf(-x)); }
__device__ __forceinline__ float siluf(float x) { return x * __builtin_amdgcn_rcpf(1.f + __expf(-x)); }
__device__ __forceinline__ float rsq(float x) { return __builtin_amdgcn_rsqf(x); }
__device__ __forceinline__ float softplusf(float x) { return fmaxf(x, 0.f) + __logf(1.f + __expf(-fabsf(x))); }
__device__ __forceinline__ float tanh_fast(float x) { return 1.f - 2.f * __builtin_amdgcn_rcpf(1.f + __expf(2.f * x)); }
__device__ __forceinline__ float wsum(float v) {
#pragma unroll
  for (int o = 32; o > 0; o >>= 1) v += __shfl_xor(v, o);
  return v;
}
template <int CTRL>
__device__ __forceinline__ float dppf(float x) {
  return __int_as_float(__builtin_amdgcn_update_dpp(__float_as_int(x), __float_as_int(x), CTRL, 0xf, 0xf, false));
}
__device__ __forceinline__ float red8(float x) {
  x += dppf<0xB1>(x);
  x += dppf<0x4E>(x);
  x += dppf<0x141>(x);
  return x;
}
__device__ __forceinline__ const float* xin_row(const Params& p, int r) {
  int b = r / TPB, t = r - b * TPB;
  return t < LC ? p.ctx + ((size_t)(b * LC + t)) * DM : p.x + ((size_t)(b * SEQ + t - LC)) * DM;
}
__device__ __forceinline__ float* x_row(const Params& p, int r) {
  int b = r / TPB, t = r - b * TPB;
  return t < LC ? (float*)(p.ws + OFF_XC) + ((size_t)(b * LC + t)) * DM : p.out + ((size_t)(b * SEQ + t - LC)) * DM;
}
__device__ __forceinline__ int mod_row(int r) {
  int b = r / TPB, t = r - b * TPB;
  return t < LC ? 8 : b;
}

struct MapId { int lim, off; __device__ int operator()(int n) const { return n < lim ? n + off : -1; } };
struct MapW1 { __device__ int operator()(int n) const { int q = n >> 3, s = n & 7; return s < 4 ? q * 4 + s : FH + q * 4 + (s - 4); } };

template <class Map>
__device__ __forceinline__ void conv_tile(const float* __restrict__ src, int ld, u16* __restrict__ dst, int K, int n0,
                                          int k0, Map map, float* tile) {
  const int tid = TIDX;
  const int nn = tid & 63, kr = tid >> 6;
  const int sc = map(n0 + nn);
  float tv[8];
  const int scc = sc >= 0 ? sc : 0;
  const float scm = sc >= 0 ? 1.f : 0.f;
#pragma unroll
  for (int ps = 0; ps < 8; ps++) tv[ps] = src[(size_t)(k0 + ps * 8 + kr) * ld + scc];
#pragma unroll
  for (int ps = 0; ps < 8; ps++) tile[(ps * 8 + kr) * 65 + nn] = tv[ps] * scm;
  __syncthreads();
  const int n2 = tid >> 3, kc = tid & 7;
  uint4 o;
  o.x = pack2(tile[(kc * 8 + 0) * 65 + n2], tile[(kc * 8 + 1) * 65 + n2]);
  o.y = pack2(tile[(kc * 8 + 2) * 65 + n2], tile[(kc * 8 + 3) * 65 + n2]);
  o.z = pack2(tile[(kc * 8 + 4) * 65 + n2], tile[(kc * 8 + 5) * 65 + n2]);
  o.w = pack2(tile[(kc * 8 + 6) * 65 + n2], tile[(kc * 8 + 7) * 65 + n2]);
  *(uint4*)(dst + (size_t)(n0 + n2) * K + k0 + kc * 8) = o;
  __syncthreads();
}

__device__ __forceinline__ void conv_item(const Params& p, int l, int rem, float* sm) {
      u16* wl = (u16*)(p.ws + OFF_W);
      if (rem < 832) {
        int nt = rem >> 4, kt = rem & 15;
        conv_tile(p.w_in + (size_t)l * DM * INW, INW, (u16*)((char*)wl + OW_IN), 1024, nt * 64, kt * 64, MapId{3312, 0}, sm);
      } else if (rem < 832 + 1024) {
        rem -= 832;
        int nt = rem >> 4, kt = rem & 15;
        conv_tile(p.w_in + (size_t)l * DM * INW, INW, (u16*)((char*)wl + OW_G), 1024, nt * 64, kt * 64, MapId{4096, 3312}, sm);
      } else if (rem < 1856 + 256) {
        rem -= 1856;
        int br = rem >> 6, r2 = rem & 63, nt = r2 >> 2, kt = r2 & 3;
        conv_tile(p.w_branch + ((size_t)(l * 4 + br)) * 256 * DM, DM, (u16*)((char*)wl + OW_B) + (size_t)br * 1024 * 256, 256,
                  nt * 64, kt * 64, MapId{1024, 0}, sm);
      } else if (rem < 2112 + 256) {
        rem -= 2112;
        int nt = rem >> 4, kt = rem & 15;
        conv_tile(p.w_out + (size_t)l * DM * DM, DM, (u16*)((char*)wl + OW_O), 1024, nt * 64, kt * 64, MapId{1024, 0}, sm);
      } else if (rem < 2368 + 1408) {
        rem -= 2368;
        int nt = rem >> 4, kt = rem & 15;
        conv_tile(p.ffn_w1 + (size_t)l * DM * 5632, 5632, (u16*)((char*)wl + OW_1), 1024, nt * 64, kt * 64, MapW1{}, sm);
      } else {
        rem -= 3776;
        int nt = rem / 44, kt = rem - nt * 44;
        conv_tile(p.ffn_w2 + (size_t)l * FH * DM, DM, (u16*)((char*)wl + OW_2), FH, nt * 64, kt * 64, MapId{1024, 0}, sm);
      }
}

__device__ __forceinline__ void phase_init0(const Params& p, float* sm) {
  const int tid = TIDX;
  if (blockIdx.x == 0) {
    if (tid < 64) ((unsigned*)(p.ws + OFF_CTR))[tid] = 0u;
    for (int i = tid; i < 3456; i += NTHR) ((unsigned*)(p.ws + OFF_XBAR))[i] = 0u;
  }
  constexpr int NMOD = 192, NCONV = 832;
  for (int it = blockIdx.x; it < NMOD + NCONV; it += gridDim.x) {
    if (it < NMOD) {
      int l = it / 96, rem = it - l * 96, cc = rem >> 3, ks = rem & 7;
      for (int i = tid; i < 9 * 128; i += NTHR) {
        int r = i >> 7, k = i & 127;
        float v = r < 8 ? p.c[r * DM + ks * 128 + k] : p.c_ctx[ks * 128 + k];
        sm[i] = siluf(v);
      }
      __syncthreads();
      const int n = cc * 512 + tid;
      const float* w = p.ada_w + ((size_t)l * DM + ks * 128) * 6144 + n;
      float acc[9];
#pragma unroll
      for (int r = 0; r < 9; r++) acc[r] = 0.f;
#pragma unroll 1
      for (int k0 = 0; k0 < 128; k0 += 16) {
        float wv[16];
#pragma unroll
        for (int kk = 0; kk < 16; kk++) wv[kk] = w[(size_t)(k0 + kk) * 6144];
#pragma unroll
        for (int kk = 0; kk < 16; kk++)
#pragma unroll
          for (int r = 0; r < 9; r++) acc[r] += sm[r * 128 + k0 + kk] * wv[kk];
      }
      float* mp = (float*)(p.ws + OFF_MODP) + ((size_t)(l * 8 + ks) * 9) * 6144 + n;
#pragma unroll
      for (int r = 0; r < 9; r++) mp[(size_t)r * 6144] = acc[r];
      __syncthreads();
    } else {
      conv_item(p, 0, it - NMOD, sm);
    }
  }
}

__device__ __forceinline__ void phase_init1(const Params& p) {
  const float* mp = (const float*)(p.ws + OFF_MODP);
  float* mo = (float*)(p.ws + OFF_MOD);
  for (int i = blockIdx.x * NTHR + TIDX; i < 2 * 9 * 6144; i += gridDim.x * NTHR) {
    int l = i / (9 * 6144), rem = i - l * 9 * 6144, r = rem / 6144, n = rem - r * 6144;
    float s = p.ada_b[l * 6144 + n];
#pragma unroll
    for (int ks = 0; ks < 8; ks++) s += mp[((size_t)((l * 8 + ks) * 9 + r)) * 6144 + n];
    mo[i] = s;
  }
}

__device__ __forceinline__ void rowpass(const Params& p, int l, int mode) {
  const int lane = TIDX & 63, wv = __builtin_amdgcn_readfirstlane(TIDX >> 6);
  const float* MOD = (const float*)(p.ws + OFF_MOD);
  u16* H = (u16*)(p.ws + OFF_H);
  const bool do_norm = !(mode == 2 && l == 1);
  const int ln = (mode == 2) ? (l == 1 ? l : l + 1) : l;
  const int ni = (mode == 1) ? 2 : 0, sho = (mode == 1) ? 3072 : 0, sco = (mode == 1) ? 4096 : 1024;
  for (int r = blockIdx.x * 8 + wv; r < NROWS; r += gridDim.x * 8) {
    const int mr = mod_row(r);
    if (l == 1 && mode != 0 && mr == 8) continue;
    const float* modl = MOD + ((size_t)(l * 9 + mr)) * 6144;
    const float* modn = MOD + ((size_t)(ln * 9 + mr)) * 6144;
    const float* ng2 = p.norm_g + (size_t)(ln * 4 + ni) * DM;
    const float* xs = (mode == 0 || (mode == 1 && l == 0)) ? xin_row(p, r) : (const float*)x_row(p, r);
    float4 xo[4], n2[4], sc4[4], sh4[4];
#pragma unroll
    for (int i = 0; i < 4; i++) {
      const int col = i * 256 + lane * 4;
      xo[i] = *(const float4*)(xs + col);
      n2[i] = *(const float4*)(ng2 + col);
      sc4[i] = *(const float4*)(modn + sco + col);
      sh4[i] = *(const float4*)(modn + sho + col);
    }
    float xv[16];
    if (mode == 0) {
#pragma unroll
      for (int i = 0; i < 4; i++) { xv[i * 4 + 0] = xo[i].x; xv[i * 4 + 1] = xo[i].y; xv[i * 4 + 2] = xo[i].z; xv[i * 4 + 3] = xo[i].w; }
    } else {
      const u16* src = (const u16*)(p.ws + (mode == 1 ? OFF_BIG : OFF_YS)) + (size_t)r * DM;
      const float* ng = p.norm_g + (size_t)(l * 4 + (mode == 1 ? 1 : 3)) * DM;
      const float* gt = modl + (mode == 1 ? 2048 : 5120);
      uint2 sv[4];
      float4 g4[4], n4[4];
#pragma unroll
      for (int i = 0; i < 4; i++) {
        const int col = i * 256 + lane * 4;
        sv[i] = *(const uint2*)(src + col);
        g4[i] = *(const float4*)(gt + col);
        n4[i] = *(const float4*)(ng + col);
      }
      float ov[16];
      float ss = 0.f;
#pragma unroll
      for (int i = 0; i < 4; i++) {
        ov[i * 4 + 0] = __uint_as_float(sv[i].x << 16); ov[i * 4 + 1] = __uint_as_float(sv[i].x & 0xffff0000u);
        ov[i * 4 + 2] = __uint_as_float(sv[i].y << 16); ov[i * 4 + 3] = __uint_as_float(sv[i].y & 0xffff0000u);
      }
#pragma unroll
      for (int i = 0; i < 16; i++) ss += ov[i] * ov[i];
      ss = wsum(ss);
      const float inv = rsq(ss * (1.f / 1024.f) + 1e-6f);
      float* xd = x_row(p, r);
#pragma unroll
      for (int i = 0; i < 4; i++) {
        xv[i * 4 + 0] = xo[i].x + g4[i].x * (ov[i * 4 + 0] * inv * n4[i].x);
        xv[i * 4 + 1] = xo[i].y + g4[i].y * (ov[i * 4 + 1] * inv * n4[i].y);
        xv[i * 4 + 2] = xo[i].z + g4[i].z * (ov[i * 4 + 2] * inv * n4[i].z);
        xv[i * 4 + 3] = xo[i].w + g4[i].w * (ov[i * 4 + 3] * inv * n4[i].w);
      }
#pragma unroll
      for (int i = 0; i < 4; i++)
        *(float4*)(xd + i * 256 + lane * 4) = make_float4(xv[i * 4 + 0], xv[i * 4 + 1], xv[i * 4 + 2], xv[i * 4 + 3]);
    }
    if (!do_norm) continue;
    float ss2 = 0.f;
#pragma unroll
    for (int i = 0; i < 16; i++) ss2 += xv[i] * xv[i];
    ss2 = wsum(ss2);
    const float inv2 = rsq(ss2 * (1.f / 1024.f) + 1e-6f);
#pragma unroll
    for (int i = 0; i < 4; i++) {
      const int col = i * 256 + lane * 4;
      float h0 = xv[i * 4 + 0] * inv2 * n2[i].x * (1.f + sc4[i].x) + sh4[i].x;
      float h1 = xv[i * 4 + 1] * inv2 * n2[i].y * (1.f + sc4[i].y) + sh4[i].y;
      float h2 = xv[i * 4 + 2] * inv2 * n2[i].z * (1.f + sc4[i].z) + sh4[i].z;
      float h3 = xv[i * 4 + 3] * inv2 * n2[i].w * (1.f + sc4[i].w) + sh4[i].w;
      uint2 o;
      o.x = pack2(h0, h1);
      o.y = pack2(h2, h3);
      *(uint2*)(H + (size_t)r * DM + col) = o;
    }
  }
}

#define LDT 72
namespace pg8 {
#define PG8_LAS __attribute__((address_space(3)))
typedef unsigned short bf16_t;
typedef short bf16x8 __attribute__((ext_vector_type(8)));
typedef float f32x4 __attribute__((ext_vector_type(4)));
typedef unsigned u32x4 __attribute__((ext_vector_type(4)));
constexpr int BM = 256, BK = 64, HALF = 128, HTB = HALF * BK * 2  , STAGE_BYTES = 8 * HTB, NXCD = 8, WGM = 6;

__host__ __device__ __forceinline__ int lds_byte(int r, int c) { const int st = (r >> 4) * 2 + (c >> 5), rr = r & 15, cc = c & 31, ob = rr * 64 + cc * 2; return st * 1024 + (ob ^ (((ob >> 9) & 1) << 5)); }
__host__ __device__ __forceinline__ void stage_rc(int b, int& R, int& C) { const int st = b / 1024, sb = b % 1024, swz = sb ^ (((sb >> 9) & 1) << 5); R = (st >> 1) * 16 + swz / 64; C = (st & 1) * 32 + (swz % 64) / 2; }
__host__ __device__ __forceinline__ int perm32(int rho) { const int n = rho >> 4, i = rho & 15; return 8 * (i >> 2) + 4 * n + (i & 3); }

struct Unit { int pm, pn; };
struct Gemm { const bf16_t* A; const bf16_t* Bt; int M, N, K, lda; };
struct StaticOrder {
    int nM, nN, nwg, G, c, skip;
    __host__ __device__ void init(int M, int N, int G_, int c_, int skip_ = 0) { nM = M / BM; nN = N / BM; nwg = nM * nN; G = G_; c = c_; skip = skip_; }
    __host__ __device__ bool next(int i, Unit& u) const {
        const long L = (long)i * G + c; if (L >= nwg) return false;
        int wgid = (int)L; { const int q = nwg / NXCD, r = nwg % NXCD, xcd = wgid % NXCD, off = wgid / NXCD; wgid = (xcd < r ? xcd * (q + 1) : r * (q + 1) + (xcd - r) * q) + off; }
        const int nig = WGM * nN, gid = wgid / nig, fm = gid * WGM, gsz = (nM - fm) < WGM ? (nM - fm) : WGM;
        u.pm = fm + ((wgid % nig) % gsz); u.pn = (wgid % nig) / gsz;
        if (skip) u.pm = (u.pm >> 4) * 17 + 1 + (u.pm & 15);
        return true;
    }
    __device__ __forceinline__ void a_ready(const Unit&) const {}
    __device__ __forceinline__ void done(const Unit&) const {}
};
__device__ __forceinline__ unsigned cvt_pk_bf16(float lo, float hi) { unsigned r; asm volatile("v_cvt_pk_bf16_f32 %0, %1, %2" : "=v"(r) : "v"(lo), "v"(hi)); return r; }
template <class Epi, class Sched, bool STAMP = false>
__device__ __forceinline__ void gemm_phase(PG8_LAS unsigned char* lds, const Gemm g, const Sched& S, const Epi& E, unsigned long long* stamps) {
    const int tid = TIDX, wid = __builtin_amdgcn_readfirstlane(tid >> 6), lane = tid & 63, wr = wid >> 2, wc = wid & 3, fr = lane & 15, fq = lane >> 4;
    const int K = g.K, nt = K / BK;
    int ts_lo = 0, ts_hi = 0, nts = 0; const unsigned long long rt_entry = STAMP ? (unsigned long long)wall_clock64() : 0ull;
#define PG8_STAMP() do { if (STAMP && wid == 0 && nts < 64) { const unsigned long long _c = (unsigned long long)clock64(); \
        ts_lo = (lane == nts) ? (int)(unsigned)_c : ts_lo; ts_hi = (lane == nts) ? (int)(unsigned)(_c >> 32) : ts_hi; ++nts; } } while (0)
    PG8_STAMP();
    unsigned voffA[2], voffB[2];
#pragma unroll
    for (int i = 0; i < 2; ++i) { int R, C; stage_rc(tid * 16 + i * 8192, R, C); const int Rb = Epi::PERM ? ((R & ~31) + perm32(R & 31)) : R;
        voffA[i] = (unsigned)(R * g.lda + C) * 2u; voffB[i] = (unsigned)(Rb * K + C) * 2u; }
    const size_t kstep = (size_t)(BK * 2);
    const size_t hstepB = (size_t)HALF * K * 2, hstepA = (size_t)HALF * g.lda * 2;
    const size_t tstepB = 2 * hstepB, tstepA = 2 * hstepA;
    const unsigned ldsw = (unsigned)wid * 1024u;
    const int aoff = lds_byte(wr * 64 + fr, fq * 8), boff = lds_byte(wc * 32 + fr, fq * 8);
#define PG8_SA(b, h) (((b) * 2 + (h)) * HTB)
#define PG8_SB(b, h) ((4 + (b) * 2 + (h)) * HTB)
#define PG8_STAGE(bufoff, gbase, voff) do { _Pragma("unroll") for (int _i = 0; _i < 2; ++_i) \
        __builtin_amdgcn_global_load_lds((const unsigned*)((const char*)(gbase) + (voff)[_i]), (PG8_LAS unsigned*)(lds + (bufoff) + ldsw + _i * 8192), 16, 0, 0); } while (0)
#define PG8_LDA(dst, b, h) do { _Pragma("unroll") for (int m = 0; m < 4; ++m) _Pragma("unroll") for (int k = 0; k < 2; ++k) dst[m][k] = *(const PG8_LAS bf16x8*)(lds + PG8_SA(b, h) + aoff + m * 2048 + k * 1024); } while (0)
#define PG8_LDB(dst, b, h) do { _Pragma("unroll") for (int n = 0; n < 2; ++n) _Pragma("unroll") for (int k = 0; k < 2; ++k) dst[n][k] = *(const PG8_LAS bf16x8*)(lds + PG8_SB(b, h) + boff + n * 2048 + k * 1024); } while (0)
#define PG8_MMA(ai, bj, At, Bt) do { __builtin_amdgcn_s_setprio(1); _Pragma("unroll") for (int m = 0; m < 4; ++m) _Pragma("unroll") for (int n = 0; n < 2; ++n) _Pragma("unroll") for (int k = 0; k < 2; ++k) \
        acc[ai][bj][m][n] = __builtin_amdgcn_mfma_f32_16x16x32_bf16(Bt[n][k], At[m][k], acc[ai][bj][m][n], 0, 0, 0); __builtin_amdgcn_s_setprio(0); } while (0)
#define PG8_WAIT_V(n) asm volatile("s_waitcnt vmcnt(" #n ")" ::: "memory")
#define PG8_WAIT_L(n) asm volatile("s_waitcnt lgkmcnt(" #n ")" ::: "memory")
#define PG8_BAR __builtin_amdgcn_s_barrier()
#define PG8_SCHED __builtin_amdgcn_sched_barrier(0)
    Unit cur, nxt; int ui = 0;
    if (!S.next(0, cur)) return;
    f32x4 acc[2][2][4][2];
#pragma unroll
    for (int a = 0; a < 2; ++a)
#pragma unroll
        for (int b = 0; b < 2; ++b)
#pragma unroll
            for (int m = 0; m < 4; ++m)
#pragma unroll
                for (int n = 0; n < 2; ++n) acc[a][b][m][n] = (f32x4){0.f, 0.f, 0.f, 0.f};
    bf16x8 At[4][2], B0[2][2], B1[2][2];
    const char* cA = (const char*)g.A + (size_t)cur.pm * tstepA; const char* cB = (const char*)g.Bt + (size_t)cur.pn * tstepB;
    S.a_ready(cur);
    PG8_STAGE(PG8_SB(0, 0), cB, voffB); PG8_STAGE(PG8_SA(0, 0), cA, voffA); PG8_STAGE(PG8_SB(0, 1), cB + hstepB, voffB); PG8_STAGE(PG8_SA(0, 1), cA + hstepA, voffA);
    if (wr == 1) PG8_BAR;
    PG8_WAIT_V(4); PG8_BAR;
    PG8_STAGE(PG8_SB(1, 0), cB + kstep, voffB); PG8_STAGE(PG8_SA(1, 0), cA + kstep, voffA); PG8_STAGE(PG8_SB(1, 1), cB + hstepB + kstep, voffB);
    PG8_WAIT_V(6); PG8_BAR;
    PG8_STAMP();
    for (;;) {
        const bool has_next = S.next(ui + 1, nxt);
        const char* nA = has_next ? (const char*)g.A + (size_t)nxt.pm * tstepA : cA; const char* nB = has_next ? (const char*)g.Bt + (size_t)nxt.pn * tstepB : cB;
        for (int t = 0; t < nt; t += 2) {
            const bool last = (t == nt - 2);
            const char* a1 = cA + (size_t)(t + 1) * kstep;
            const char* a2 = last ? nA : cA + (size_t)(t + 2) * kstep; const char* b2 = last ? nB : cB + (size_t)(t + 2) * kstep;
            const char* a3 = a2 + kstep; const char* b3 = b2 + kstep;
            if (last && has_next) S.a_ready(nxt);
            PG8_LDB(B0, 0, 0); PG8_SCHED; PG8_LDA(At, 0, 0); PG8_STAGE(PG8_SA(1, 1), a1 + hstepA, voffA);
            PG8_WAIT_L(8); PG8_BAR; PG8_WAIT_L(0); PG8_MMA(0, 0, At, B0); PG8_BAR; PG8_SCHED;
            PG8_LDB(B1, 0, 1); PG8_STAGE(PG8_SB(0, 0), b2, voffB);
            PG8_BAR; PG8_WAIT_L(0); PG8_MMA(0, 1, At, B1); PG8_BAR;
            PG8_LDA(At, 0, 1); PG8_STAGE(PG8_SA(0, 0), a2, voffA);
            PG8_BAR; PG8_WAIT_L(0); PG8_MMA(1, 0, At, B0); PG8_BAR; PG8_SCHED;
            PG8_STAGE(PG8_SB(0, 1), b2 + hstepB, voffB);
            PG8_WAIT_V(6); PG8_BAR; PG8_MMA(1, 1, At, B1); PG8_BAR;
            PG8_LDB(B0, 1, 0); PG8_SCHED; PG8_LDA(At, 1, 0); PG8_STAGE(PG8_SA(0, 1), a2 + hstepA, voffA);
            PG8_WAIT_L(8); PG8_BAR; PG8_WAIT_L(0); PG8_MMA(0, 0, At, B0); PG8_BAR; PG8_SCHED;
            PG8_LDB(B1, 1, 1); PG8_STAGE(PG8_SB(1, 0), b3, voffB);
            PG8_BAR; PG8_WAIT_L(0); PG8_MMA(0, 1, At, B1); PG8_BAR;
            PG8_LDA(At, 1, 1); PG8_STAGE(PG8_SA(1, 0), a3, voffA);
            PG8_BAR; PG8_WAIT_L(0); PG8_MMA(1, 0, At, B0); PG8_BAR; PG8_SCHED;
            PG8_STAGE(PG8_SB(1, 1), b3 + hstepB, voffB);
            PG8_WAIT_V(6); PG8_BAR; PG8_MMA(1, 1, At, B1); PG8_BAR;
        }
        PG8_STAMP();
        if constexpr (!Epi::AFTER_DRAIN) { E(acc, cur, wr, wc, fr, fq); S.done(cur); }
        PG8_STAMP();
        if (!has_next) break;
#pragma unroll
        for (int a = 0; a < 2; ++a)
#pragma unroll
            for (int b = 0; b < 2; ++b)
#pragma unroll
                for (int m = 0; m < 4; ++m)
#pragma unroll
                    for (int n = 0; n < 2; ++n) acc[a][b][m][n] = (f32x4){0.f, 0.f, 0.f, 0.f};
        cur = nxt; cA = nA; cB = nB; ++ui;
    }
    PG8_WAIT_V(0);
    if (wr == 0) PG8_BAR;
    PG8_BAR;
    if constexpr (Epi::AFTER_DRAIN) { E.fused(acc, cur, wr, wc, fr, fq, lds, wid, lane); S.done(cur); }
    PG8_STAMP();
    if (STAMP && wid == 0) { stamps[lane] = lane < nts ? (((unsigned long long)(unsigned)ts_hi << 32) | (unsigned)ts_lo) : 0ull;
        if (lane == 62) stamps[62] = rt_entry; if (lane == 63) stamps[63] = (unsigned long long)wall_clock64(); }
#undef PG8_STAMP
#undef PG8_SA
#undef PG8_SB
#undef PG8_STAGE
#undef PG8_LDA
#undef PG8_LDB
#undef PG8_MMA
#undef PG8_WAIT_V
#undef PG8_WAIT_L
#undef PG8_BAR
#undef PG8_SCHED
}
}

struct EpiBf {
  static constexpr bool PERM = true, AFTER_DRAIN = false;
  u16* O; int ldc; const float* bias; int act;
  __device__ __forceinline__ void operator()(const f32x4 (&acc)[2][2][4][2], const pg8::Unit& u, int wr, int wc, int fr, int fq) const {
    const int row0 = u.pm * 256 + wr * 64 + fr, col0 = u.pn * 256 + wc * 32 + 8 * fq;
    f32x4 bv[2][2];
#pragma unroll
    for (int bj = 0; bj < 2; ++bj)
#pragma unroll
      for (int n = 0; n < 2; ++n) bv[bj][n] = bias ? *(const f32x4*)(bias + col0 + bj * 128 + 4 * n) : f32x4{0.f, 0.f, 0.f, 0.f};
#pragma unroll
    for (int ai = 0; ai < 2; ++ai)
#pragma unroll
      for (int m = 0; m < 4; ++m) {
        u16* rowp = O + (size_t)(row0 + ai * 128 + m * 16) * ldc + col0;
#pragma unroll
        for (int bj = 0; bj < 2; ++bj) {
          f32x4 v0 = acc[ai][bj][m][0] + bv[bj][0], v1 = acc[ai][bj][m][1] + bv[bj][1];
          if (act == 1) {
#pragma unroll
            for (int j = 0; j < 4; ++j) { v0[j] = sigm(v0[j]); v1[j] = sigm(v1[j]); }
          }
          uint4 wv;
          wv.x = pack2(v0[0], v0[1]); wv.y = pack2(v0[2], v0[3]); wv.z = pack2(v1[0], v1[1]); wv.w = pack2(v1[2], v1[3]);
          *(uint4*)(rowp + bj * 128) = wv;
        }
      }
  }
};
struct EpiSwiglu {
  static constexpr bool PERM = true, AFTER_DRAIN = false;
  u16* O;
  __device__ __forceinline__ void operator()(const f32x4 (&acc)[2][2][4][2], const pg8::Unit& u, int wr, int wc, int fr, int fq) const {
    const int row0 = u.pm * 256 + wr * 64 + fr, col0 = u.pn * 128 + wc * 16 + 4 * fq;
#pragma unroll
    for (int ai = 0; ai < 2; ++ai)
#pragma unroll
      for (int m = 0; m < 4; ++m) {
        u16* rowp = O + (size_t)(row0 + ai * 128 + m * 16) * FH + col0;
#pragma unroll
        for (int bj = 0; bj < 2; ++bj) {
          const f32x4 g = acc[ai][bj][m][0], up = acc[ai][bj][m][1];
          uint2 wv;
          wv.x = pack2(siluf(g[0]) * up[0], siluf(g[1]) * up[1]);
          wv.y = pack2(siluf(g[2]) * up[2], siluf(g[3]) * up[3]);
          *(uint2*)(rowp + bj * 64) = wv;
        }
      }
  }
};
struct EpiGateAcc {
  static constexpr bool PERM = true, AFTER_DRAIN = false;
  u16* ACC; const u16* G; int gcol; unsigned amask;
  __device__ __forceinline__ void operator()(const f32x4 (&acc)[2][2][4][2], const pg8::Unit& u, int wr, int wc, int fr, int fq) const {
    unsigned pk[2][2][4][4];
#pragma unroll
    for (int ai = 0; ai < 2; ++ai)
#pragma unroll
      for (int bj = 0; bj < 2; ++bj)
#pragma unroll
        for (int m = 0; m < 4; ++m) {
          pk[ai][bj][m][0] = pack2(acc[ai][bj][m][0][0], acc[ai][bj][m][0][1]);
          pk[ai][bj][m][1] = pack2(acc[ai][bj][m][0][2], acc[ai][bj][m][0][3]);
          pk[ai][bj][m][2] = pack2(acc[ai][bj][m][1][0], acc[ai][bj][m][1][1]);
          pk[ai][bj][m][3] = pack2(acc[ai][bj][m][1][2], acc[ai][bj][m][1][3]);
        }
    asm volatile("" ::: "memory");
    const int row0 = u.pm * 256 + wr * 64 + fr, col0 = u.pn * 256 + wc * 32 + 8 * fq;
#pragma unroll
    for (int ai = 0; ai < 2; ++ai)
#pragma unroll
      for (int m = 0; m < 4; ++m) {
        const size_t row = (size_t)(row0 + ai * 128 + m * 16);
#pragma unroll
        for (int bj = 0; bj < 2; ++bj) {
          const int col = col0 + bj * 128;
          const uint4 gv = *(const uint4*)(G + row * 2048 + gcol + col);
          const uint4 av = *(const uint4*)(ACC + row * DM + col);
          const unsigned gw[4] = {gv.x, gv.y, gv.z, gv.w};
          const unsigned aw[4] = {av.x & amask, av.y & amask, av.z & amask, av.w & amask};
          unsigned ow[4];
#pragma unroll
          for (int q = 0; q < 4; ++q) {
            const unsigned pv = pk[ai][bj][m][q];
            const float lo = __uint_as_float(aw[q] << 16) + __uint_as_float(gw[q] << 16) * __uint_as_float(pv << 16);
            const float hi = __uint_as_float(aw[q] & 0xffff0000u) + __uint_as_float(gw[q] & 0xffff0000u) * __uint_as_float(pv & 0xffff0000u);
            ow[q] = pack2(lo, hi);
          }
          *(uint4*)(ACC + row * DM + col) = make_uint4(ow[0], ow[1], ow[2], ow[3]);
        }
        asm volatile("" ::: "memory");
      }
  }
};

template <int MI>
__device__ __forceinline__ void gemm_loop(const u16* __restrict__ A, int lda, const u16* __restrict__ Bt, int ldb, int K,
                                          f32x4 (&acc)[MI][4], u16* sA, u16* sB) {
  constexpr int BMT = MI * 64;
  const int tid = TIDX, lane = tid & 63, w = tid >> 6, wm = w >> 1, wn = w & 1, fr = lane & 15, fq = lane >> 4;
  uint4 ra[MI], rb[2];
  const u16* ga = A + (size_t)(tid >> 3) * lda + (tid & 7) * 8;
  const u16* gb = Bt + (size_t)(tid >> 3) * ldb + (tid & 7) * 8;
  const int so = (tid >> 3) * LDT + (tid & 7) * 8;
#pragma unroll
  for (int i = 0; i < MI; i++) ra[i] = *(const uint4*)(ga + (size_t)(i * 64) * lda);
#pragma unroll
  for (int i = 0; i < 2; i++) rb[i] = *(const uint4*)(gb + (size_t)(i * 64) * ldb);
#pragma unroll
  for (int i = 0; i < MI; i++) *(uint4*)(sA + so + i * 64 * LDT) = ra[i];
#pragma unroll
  for (int i = 0; i < 2; i++) *(uint4*)(sB + so + i * 64 * LDT) = rb[i];
  __syncthreads();
  const int nk = K >> 6;
  for (int kt = 0; kt < nk; kt++) {
    const bool more = kt + 1 < nk;
    if (more) {
#pragma unroll
      for (int i = 0; i < MI; i++) ra[i] = *(const uint4*)(ga + (size_t)(i * 64) * lda + (kt + 1) * 64);
#pragma unroll
      for (int i = 0; i < 2; i++) rb[i] = *(const uint4*)(gb + (size_t)(i * 64) * ldb + (kt + 1) * 64);
    }
    const u16* a = sA + (kt & 1) * BMT * LDT + (wm * (MI * 16) + fr) * LDT + fq * 8;
    const u16* b = sB + (kt & 1) * 128 * LDT + (wn * 64 + fr) * LDT + fq * 8;
#pragma unroll
    for (int ks = 0; ks < 2; ks++) {
      bf16x8 af[MI], bfr[4];
#pragma unroll
      for (int i = 0; i < MI; i++) af[i] = *(const bf16x8*)(a + i * 16 * LDT + ks * 32);
#pragma unroll
      for (int j = 0; j < 4; j++) bfr[j] = *(const bf16x8*)(b + j * 16 * LDT + ks * 32);
#pragma unroll
      for (int i = 0; i < MI; i++)
#pragma unroll
        for (int j = 0; j < 4; j++) acc[i][j] = __builtin_amdgcn_mfma_f32_16x16x32_bf16(bfr[j], af[i], acc[i][j], 0, 0, 0);
    }
    if (more) {
      u16* da = sA + ((kt + 1) & 1) * BMT * LDT + so;
      u16* db = sB + ((kt + 1) & 1) * 128 * LDT + so;
#pragma unroll
      for (int i = 0; i < MI; i++) *(uint4*)(da + i * 64 * LDT) = ra[i];
#pragma unroll
      for (int i = 0; i < 2; i++) *(uint4*)(db + i * 64 * LDT) = rb[i];
    }
    __syncthreads();
  }
}

template <int MI>
__device__ __forceinline__ void zero_acc(f32x4 (&acc)[MI][4]) {
#pragma unroll
  for (int i = 0; i < MI; i++)
#pragma unroll
    for (int j = 0; j < 4; j++) acc[i][j] = f32x4{0.f, 0.f, 0.f, 0.f};
}


typedef unsigned u32x4v __attribute__((ext_vector_type(4)));
__device__ __forceinline__ void yp_issue(const u16* __restrict__ A, const u16* __restrict__ B, u32x4v (&ra)[8], u32x4v (&rb)[8], int tid) {
#pragma unroll
  for (int i = 0; i < 8; i++) {
    const int c = tid + i * NTHR, row = c >> 5, ch = c & 31;
    ra[i] = *(const u32x4v*)(A + (size_t)row * YST + ch * 8);
    rb[i] = *(const u32x4v*)(B + (size_t)row * 256 + ch * 8);
  }
}
__device__ __forceinline__ void yp_stage(unsigned char* sA, unsigned char* sB, const u32x4v (&ra)[8], const u32x4v (&rb)[8], int tid) {
#pragma unroll
  for (int i = 0; i < 8; i++) {
    const int c = tid + i * NTHR, row = c >> 5, ch = c & 31;
    const int off = row * 512 + ((ch ^ (row & 7)) << 4);
    *(u32x4v*)(sA + off) = ra[i];
    *(u32x4v*)(sB + off) = rb[i];
  }
}
__device__ __forceinline__ void phase_ypart(const Params& p, int l, unsigned char* smem) {
  unsigned char* sA = smem;
  unsigned char* sB = smem + 65536;
  const int tid = TIDX, lane = tid & 63, w = tid >> 6, wm = w >> 1, wn = w & 1, fr = lane & 15, fq = lane >> 4;
  const u16* Y = (const u16*)(p.ws + OFF_YS);
  const u16* Wb = (const u16*)(p.ws + OFF_W + OW_B);
  const u16* G = (const u16*)(p.ws + OFF_BIG);
  u16* ACC = (u16*)(p.ws + OFF_H);
  constexpr int NT = 8;
  const int ntiles = (NROWS / 128) * NT;
  const int G_ = gridDim.x;
  const bool xmap = (G_ == 256);
  const int xj = blockIdx.x >> 3, xx = blockIdx.x & 7;
  const bool skipc = (l == 1);
  const int nrt = skipc ? 256 : 272;
  const int ntl = nrt * NT;
  const int nmine = xmap ? (xj < nrt ? (nrt - 1 - xj) / 32 + 1 : 0)
                         : (((int)blockIdx.x < ntl) ? (ntl - 1 - (int)blockIdx.x) / G_ + 1 : 0);
  if (nmine == 0) return;
#define YP_TILE(Q_, MT_, NT_)                                                        \
  do {                                                                               \
    if (xmap) { const int s_ = (Q_) * 32 + xj; MT_ = (s_ >> 3) * 8 + xx; NT_ = s_ & 7; } \
    else { const int t_ = blockIdx.x + (Q_) * G_; MT_ = t_ / NT; NT_ = t_ - MT_ * NT; }  \
    if (skipc) MT_ = (MT_ >> 5) * 34 + 2 + (MT_ & 31);                                   \
  } while (0)
  u32x4v ra[8], rb[8];
  {
    int mt, nt;
    YP_TILE(0, mt, nt);
    yp_issue(Y + (size_t)mt * 128 * YST, Wb + ((size_t)nt * 128) * 256, ra, rb, tid);
  }
  f32x4 tot[2][4];
  zero_acc<2>(tot);
  for (int qi = 0; qi < 4 * nmine; qi++) {
    const int q = qi >> 2, k = qi & 3;
    int mt, nt;
    YP_TILE(q, mt, nt);
    const int r0 = mt * 128 + wm * 32 + fr, c0 = nt * 128 + wn * 64 + fq * 4;
    uint2 gv[2][4];
#pragma unroll
    for (int i = 0; i < 2; i++)
#pragma unroll
      for (int j = 0; j < 4; j++) gv[i][j] = *(const uint2*)(G + (size_t)(r0 + i * 16) * 4096 + k * 1024 + c0 + j * 16);
    __syncthreads();
    yp_stage(sA, sB, ra, rb, tid);
    __syncthreads();
    {
      const int qn = qi + 1 < 4 * nmine ? qi + 1 : qi;
      int mtn, ntn;
      YP_TILE(qn >> 2, mtn, ntn);
      const int brn = qn & 3, ycn = brn < 3 ? brn * 256 : 1536;
      yp_issue(Y + (size_t)mtn * 128 * YST + ycn, Wb + ((size_t)brn * 1024 + ntn * 128) * 256, ra, rb, tid);
    }
    f32x4 ay[2][4];
    zero_acc<2>(ay);
#pragma unroll 2
    for (int ks = 0; ks < 8; ks++) {
      bf16x8 af[2], bfr[4];
#pragma unroll
      for (int i = 0; i < 2; i++) {
        const int row = wm * 32 + i * 16 + fr;
        af[i] = *(const bf16x8*)(sA + row * 512 + (((ks * 4 + fq) ^ (row & 7)) << 4));
      }
#pragma unroll
      for (int j = 0; j < 4; j++) {
        const int row = wn * 64 + j * 16 + fr;
        bfr[j] = *(const bf16x8*)(sB + row * 512 + (((ks * 4 + fq) ^ (row & 7)) << 4));
      }
#pragma unroll
      for (int i = 0; i < 2; i++)
#pragma unroll
        for (int j = 0; j < 4; j++) ay[i][j] = __builtin_amdgcn_mfma_f32_16x16x32_bf16(bfr[j], af[i], ay[i][j], 0, 0, 0);
    }
#pragma unroll
    for (int i = 0; i < 2; i++)
#pragma unroll
      for (int j = 0; j < 4; j++) {
        tot[i][j][0] += __uint_as_float(gv[i][j].x << 16) * ay[i][j][0];
        tot[i][j][1] += __uint_as_float(gv[i][j].x & 0xffff0000u) * ay[i][j][1];
        tot[i][j][2] += __uint_as_float(gv[i][j].y << 16) * ay[i][j][2];
        tot[i][j][3] += __uint_as_float(gv[i][j].y & 0xffff0000u) * ay[i][j][3];
      }
    if (k == 3) {
#pragma unroll
      for (int i = 0; i < 2; i++)
#pragma unroll
        for (int j = 0; j < 4; j++) {
          uint2 ov;
          ov.x = pack2(tot[i][j][0], tot[i][j][1]); ov.y = pack2(tot[i][j][2], tot[i][j][3]);
          *(uint2*)(ACC + (size_t)(r0 + i * 16) * DM + c0 + j * 16) = ov;
        }
      zero_acc<2>(tot);
    }
  }
  __syncthreads();
#undef YP_TILE
}

#define S2_BUF 10816
#define S2_D 0
#define S2_U 2048
#define S2_P 4096
#define S2_K 6144
#define S2_DQ 8192
#define S2_V 10240
#define S2_C1 10752
#define S2_C2 10784
#define S2_ST (2 * S2_BUF)
#define S2_YB (S2_ST + 8192)

__device__ __forceinline__ float red16(float x) {
  x += dppf<0xB1>(x);
  x += dppf<0x4E>(x);
  x += dppf<0x141>(x);
  x += dppf<0x140>(x);
  return x;
}
__device__ __forceinline__ void wave_lds_sync() {
  asm volatile("s_waitcnt lgkmcnt(0)" ::: "memory");
  __builtin_amdgcn_wave_barrier();
}

template <int MIX>
__device__ __forceinline__ void scan2_item(const Params& p, int l, int b, int h, int dir, int rq, float* sm) {
  constexpr int EPL = (MIX == 2) ? 2 : 4;
  constexpr int VOFF = (MIX == 2) ? 64 : 128;
  const int tid = TIDX, lane = tid & 63, w = tid >> 6, fr = lane & 15, fq = lane >> 4;
  const bool producer = w >= 4;
  const int pw = w & 3;
  const u16* P = (const u16*)(p.ws + OFF_BIG);
  u16* YS = (u16*)(p.ws + OFF_YS);
  float* BC = (float*)(p.ws + OFF_BC);
  float* ST = sm + S2_ST + pw * 2048;
  float s[EPL];
#pragma unroll
  for (int i = 0; i < EPL; i++) s[i] = 0.f;

  bf16x8 bw2[4], ba2[4];
  float cst[5][4];
  float cw[3][7];
  float muv[4];
  int colv[4];
#pragma unroll
  for (int i = 0; i < 4; i++) { bw2[i] = bf16x8{0, 0, 0, 0, 0, 0, 0, 0}; ba2[i] = bw2[i]; muv[i] = 0.f; colv[i] = 0; }
  if (producer) {
    if (MIX == 0) {
#pragma unroll
      for (int nt = 0; nt < 4; nt++) {
        const int jch = h * 64 + nt * 16 + fr;
#pragma unroll
        for (int jj = 0; jj < 8; jj++) {
          bw2[nt][jj] = (short)f2bf(p.rwkv_w2[((size_t)(l * 2 + dir) * 32 + fq * 8 + jj) * 256 + jch]);
          ba2[nt][jj] = (short)f2bf(p.rwkv_a2[((size_t)(l * 2 + dir) * 32 + fq * 8 + jj) * 256 + jch]);
        }
        cst[0][nt] = p.rwkv_w0[(l * 2 + dir) * 256 + jch];
        cst[1][nt] = p.rwkv_a0[(l * 2 + dir) * 256 + jch];
        cst[2][nt] = p.rwkv_ka[l * 256 + jch];
        cst[3][nt] = p.rwkv_kk[l * 256 + jch];
        cst[4][nt] = p.rwkv_rk[l * 256 + jch];
      }
#pragma unroll
      for (int i = 0; i < 4; i++) {
        const int c = lane + 64 * i;
        colv[i] = i < 3 ? i * 256 + h * 64 + lane : (lane < 32 ? 768 + dir * 32 + lane : 832 + dir * 32 + (lane - 32));
        muv[i] = p.rwkv_mu[l * 960 + colv[i]];
        (void)c;
      }
    } else if (MIX == 1) {
#pragma unroll
      for (int i = 0; i < 3; i++) {
        colv[i] = PB + i * 256 + h * 64 + lane;
#pragma unroll
        for (int tp = 0; tp < 7; tp++) cw[i][tp] = p.gdn_conv[((size_t)l * 7 + tp) * 768 + i * 256 + h * 64 + lane];
      }
    } else {
#pragma unroll
      for (int nt = 0; nt < 2; nt++) {
#pragma unroll
        for (int jj = 0; jj < 8; jj++)
          bw2[nt][jj] = fq < 2 ? (short)f2bf(p.gla_gw2[((size_t)(l * 2 + dir) * 16 + fq * 8 + jj) * 128 + h * 32 + nt * 16 + fr]) : (short)0;
        cst[0][nt] = p.gla_gb[(l * 2 + dir) * 128 + h * 32 + nt * 16 + fr];
      }
      colv[0] = PC + h * 32 + lane;
      if (lane >= 32) colv[0] = PC + 128 + h * 32 + (lane - 32);
      colv[1] = PC + 256 + h * 64 + lane;
      colv[2] = PC + 512 + dir * 16 + (lane & 15);
    }
  }
  __syncthreads();

  for (int c = 0; c <= TPB / 32 + 1; c++) {
    if (producer) {
      if (c >= 2) {
        const int cc = c - 2;
        int seg_row0, t_lo;
        if (cc < 8) { seg_row0 = b * TPB; t_lo = dir == 0 ? cc * 32 : (LC - 32 - cc * 32); }
        else { seg_row0 = b * TPB + LC; t_lo = dir == 0 ? (cc - 8) * 32 : (SEQ - 32 - (cc - 8) * 32); }
        const float* yb = sm + S2_YB + (cc & 1) * 512;
        const int t2 = tid - 256;
#pragma unroll
        for (int i = 0; i < 2; i++) {
          const int idx = t2 + i * 256, tt = idx >> 4, e = idx & 15;
          YS[(size_t)(seg_row0 + t_lo + tt) * YST + dir * 768 + MIX * 256 + h * 64 + rq * 16 + e] = f2bf(yb[idx]);
        }
      }
      if (c < TPB / 32) {
        int seg_row0, seg_len, t_lo;
        if (c < 8) { seg_row0 = b * TPB; seg_len = LC; t_lo = dir == 0 ? c * 32 : (LC - 32 - c * 32); }
        else { seg_row0 = b * TPB + LC; seg_len = SEQ; t_lo = dir == 0 ? (c - 8) * 32 : (SEQ - 32 - (c - 8) * 32); }
        const u16* Pseg = P + (size_t)seg_row0 * PST;
        float* B = sm + (c & 1) * S2_BUF;
        const int t0 = t_lo + pw * 8;
        if (MIX == 0) {
          float raw[10][4];
#pragma unroll
          for (int rr = 0; rr < 10; rr++) {
            const int t = t0 - 1 + rr;
            const float okf = (t >= 0 && t < seg_len) ? 1.f : 0.f;
            const int tc = min(max(t, 0), seg_len - 1);
#pragma unroll
            for (int i = 0; i < 4; i++) raw[rr][i] = bf2f(Pseg[(size_t)tc * PST + PA + colv[i]]) * okf;
          }
#pragma unroll
          for (int j = 0; j < 8; j++)
#pragma unroll
            for (int i = 0; i < 4; i++) {
              float xm = raw[j + 1][i] + (0.5f * (raw[j][i] + raw[j + 2][i]) - raw[j + 1][i]) * muv[i];
              if (i == 3 && lane < 32) xm = tanh_fast(xm);
              ST[j * 256 + lane + 64 * i] = xm;
            }
        } else if (MIX == 1) {
          float raw[14][3];
#pragma unroll
          for (int rr = 0; rr < 14; rr++) {
            const int t = t0 - 3 + rr;
            const float okf = (t >= 0 && t < seg_len) ? 1.f : 0.f;
            const int tc = min(max(t, 0), seg_len - 1);
#pragma unroll
            for (int i = 0; i < 3; i++) raw[rr][i] = bf2f(Pseg[(size_t)tc * PST + colv[i]]) * okf;
          }
#pragma unroll
          for (int j = 0; j < 8; j++)
#pragma unroll
            for (int i = 0; i < 3; i++) {
              float a = 0.f;
#pragma unroll
              for (int tp = 0; tp < 7; tp++) a += raw[j + tp][i] * cw[i][tp];
              ST[j * 256 + lane + 64 * i] = siluf(a);
            }
          if (lane < 8) {
            const u16* pp = Pseg + (size_t)(t0 + lane) * PST + PB;
            float bx = bf2f(pp[768 + dir * 4 + h]);
            float ax = bf2f(pp[776 + dir * 4 + h]);
            float ld = -__expf(p.gdn_a_log[(l * 2 + dir) * 4 + h]) * softplusf(ax + p.gdn_dt_bias[(l * 2 + dir) * 4 + h]);
            ST[lane * 256 + 192] = sigm(bx);
            ST[lane * 256 + 193] = __expf(ld);
          }
        } else {
          u16 raw[8][3];
#pragma unroll
          for (int j = 0; j < 8; j++) {
            const u16* pp = Pseg + (size_t)(t0 + j) * PST;
#pragma unroll
            for (int i = 0; i < 3; i++) raw[j][i] = pp[colv[i]];
          }
          const float qs = lane < 32 ? 0.17677669529663687f : 1.f;
#pragma unroll
          for (int j = 0; j < 8; j++) {
            ST[j * 256 + lane] = bf2f(raw[j][0]) * qs;
            ST[j * 256 + 64 + lane] = bf2f(raw[j][1]);
            if (lane < 16) ST[j * 256 + 128 + lane] = bf2f(raw[j][2]);
          }
        }
        wave_lds_sync();
        const bool vl = fq < 2;
        if (MIX == 0) {
          bf16x8 aw, aa;
#pragma unroll
          for (int jj = 0; jj < 8; jj++) {
            aw[jj] = fr < 8 ? (short)f2bf(ST[fr * 256 + 192 + fq * 8 + jj]) : (short)0;
            aa[jj] = fr < 8 ? (short)f2bf(ST[fr * 256 + 224 + fq * 8 + jj]) : (short)0;
          }
          f32x4 accw[4], acca[4];
#pragma unroll
          for (int nt = 0; nt < 4; nt++) {
            accw[nt] = __builtin_amdgcn_mfma_f32_16x16x32_bf16(aw, bw2[nt], f32x4{0.f, 0.f, 0.f, 0.f}, 0, 0, 0);
            acca[nt] = __builtin_amdgcn_mfma_f32_16x16x32_bf16(aa, ba2[nt], f32x4{0.f, 0.f, 0.f, 0.f}, 0, 0, 0);
          }
#pragma unroll
          for (int r = 0; r < 4; r++) {
            const int j = (fq & 1) * 4 + r, tt = pw * 8 + j;
            float kkx[4], av[4], kdv[4], rv[4], dec[4];
            float ss = 0.f;
#pragma unroll
            for (int nt = 0; nt < 4; nt++) {
              const int n = nt * 16 + fr;
              rv[nt] = ST[j * 256 + n];
              const float kx = ST[j * 256 + 64 + n];
              dec[nt] = __expf(-0.6065306597126334f * sigm(cst[0][nt] + accw[nt][r]));
              av[nt] = sigm(cst[1][nt] + acca[nt][r]);
              kdv[nt] = kx * (1.f + (av[nt] - 1.f) * cst[2][nt]);
              kkx[nt] = kx * cst[3][nt];
              ss += kkx[nt] * kkx[nt];
            }
            ss = red16(ss);
            const float rs = rsq(ss + 1e-6f);
            float c1 = 0.f, c2 = 0.f, bc = 0.f;
#pragma unroll
            for (int nt = 0; nt < 4; nt++) {
              const int n = nt * 16 + fr;
              const float kk = kkx[nt] * rs;
              if (vl) {
                B[S2_D + tt * 64 + n] = dec[nt];
                B[S2_U + tt * 64 + n] = kk;
                B[S2_P + tt * 64 + n] = -kk * av[nt];
                B[S2_K + tt * 64 + n] = kdv[nt];
                B[S2_DQ + tt * 64 + n] = dec[nt] * rv[nt];
              }
              c1 += -kk * av[nt] * rv[nt];
              c2 += kdv[nt] * rv[nt];
              bc += rv[nt] * kdv[nt] * cst[4][nt];
            }
            c1 = red16(c1); c2 = red16(c2); bc = red16(bc);
            if (vl && fr == 0) {
              B[S2_C1 + tt] = c1;
              B[S2_C2 + tt] = c2;
              if (rq == 0) BC[(size_t)(seg_row0 + t_lo + tt) * 8 + h * 2 + dir] = bc;
            }
          }
        } else if (MIX == 1) {
#pragma unroll
          for (int r = 0; r < 4; r++) {
            const int j = (fq & 1) * 4 + r, tt = pw * 8 + j;
            float qv[4], kv[4];
            float sq = 0.f, sk = 0.f;
#pragma unroll
            for (int nt = 0; nt < 4; nt++) {
              const int n = nt * 16 + fr;
              qv[nt] = ST[j * 256 + n];
              kv[nt] = ST[j * 256 + 64 + n];
              sq += qv[nt] * qv[nt];
              sk += kv[nt] * kv[nt];
            }
            sq = red16(sq); sk = red16(sk);
            const float rq_ = rsq(sq + 1e-6f) * 0.125f, rk_ = rsq(sk + 1e-6f);
            const float beta = ST[j * 256 + 192], alpha = ST[j * 256 + 193];
            float dkq = 0.f;
#pragma unroll
            for (int nt = 0; nt < 4; nt++) {
              const int n = nt * 16 + fr;
              const float qn = qv[nt] * rq_, kn = kv[nt] * rk_;
              if (vl) {
                B[S2_D + tt * 64 + n] = alpha;
                B[S2_U + tt * 64 + n] = kn;
                B[S2_P + tt * 64 + n] = -alpha * beta * kn;
                B[S2_K + tt * 64 + n] = beta * kn;
                B[S2_DQ + tt * 64 + n] = alpha * qn;
              }
              dkq += kn * qn;
            }
            dkq = red16(dkq);
            if (vl && fr == 0) {
              B[S2_C1 + tt] = -alpha * beta * dkq;
              B[S2_C2 + tt] = beta * dkq;
            }
          }
        } else {
          bf16x8 ag;
#pragma unroll
          for (int jj = 0; jj < 8; jj++) ag[jj] = (fr < 8 && fq < 2) ? (short)f2bf(ST[fr * 256 + 128 + fq * 8 + jj]) : (short)0;
          f32x4 accg[2];
#pragma unroll
          for (int nt = 0; nt < 2; nt++) accg[nt] = __builtin_amdgcn_mfma_f32_16x16x32_bf16(ag, bw2[nt], f32x4{0.f, 0.f, 0.f, 0.f}, 0, 0, 0);
#pragma unroll
          for (int r = 0; r < 4; r++) {
            const int j = (fq & 1) * 4 + r, tt = pw * 8 + j;
            float dkq = 0.f;
#pragma unroll
            for (int nt = 0; nt < 2; nt++) {
              const int n = nt * 16 + fr;
              const float lg = cst[0][nt] + accg[nt][r];
              const float ls = fminf(lg, 0.f) - __logf(1.f + __expf(-fabsf(lg)));
              const float alpha = __expf(ls * (1.f / 16.f));
              const float qv = ST[j * 256 + n], kv = ST[j * 256 + 32 + n];
              if (vl) {
                B[S2_D + tt * 64 + n] = alpha;
                B[S2_K + tt * 64 + n] = kv;
                B[S2_DQ + tt * 64 + n] = alpha * qv;
              }
              dkq += kv * qv;
            }
            dkq = red16(dkq);
            if (vl && fr == 0) B[S2_C2 + tt] = dkq;
          }
        }
#pragma unroll
        for (int i = 0; i < 2; i++) {
          const int idx = lane + 64 * i, j = idx >> 4, e = idx & 15;
          B[S2_V + (pw * 8 + j) * 16 + e] = ST[j * 256 + VOFF + rq * 16 + e];
        }
      }
    } else if (c >= 1 && c <= TPB / 32) {
      const float* B = sm + ((c - 1) & 1) * S2_BUF;
      float* yb = sm + S2_YB + ((c - 1) & 1) * 512;
      const int rl = w * 4 + fq;
      const int dtt = dir ? -1 : 1;
      int tt = dir ? 31 : 0;
      float dv[EPL], kv[EPL], qv[EPL], uv[EPL], pv[EPL], vv, c1v, c2v;
      float dn[EPL], kn[EPL], qn[EPL], un[EPL], pn[EPL], vn, c1n, c2n;
#define S2_LOAD(D_, K_, Q_, U_, P_, V_, C1_, C2_, T_)                                   \
  do {                                                                                  \
    const int o_ = (T_) * 64 + fr * EPL;                                                \
    if (EPL == 4) {                                                                     \
      float4 t4 = *(const float4*)(B + S2_D + o_);                                      \
      D_[0] = t4.x; D_[1] = t4.y; D_[2] = t4.z; D_[3] = t4.w;                           \
      t4 = *(const float4*)(B + S2_K + o_);                                             \
      K_[0] = t4.x; K_[1] = t4.y; K_[2] = t4.z; K_[3] = t4.w;                           \
      t4 = *(const float4*)(B + S2_DQ + o_);                                            \
      Q_[0] = t4.x; Q_[1] = t4.y; Q_[2] = t4.z; Q_[3] = t4.w;                           \
      t4 = *(const float4*)(B + S2_U + o_);                                             \
      U_[0] = t4.x; U_[1] = t4.y; U_[2] = t4.z; U_[3] = t4.w;                           \
      t4 = *(const float4*)(B + S2_P + o_);                                             \
      P_[0] = t4.x; P_[1] = t4.y; P_[2] = t4.z; P_[3] = t4.w;                           \
      C1_ = B[S2_C1 + (T_)];                                                            \
    } else {                                                                            \
      float2 t2 = *(const float2*)(B + S2_D + o_);                                      \
      D_[0] = t2.x; D_[1] = t2.y;                                                       \
      t2 = *(const float2*)(B + S2_K + o_);                                             \
      K_[0] = t2.x; K_[1] = t2.y;                                                       \
      t2 = *(const float2*)(B + S2_DQ + o_);                                            \
      Q_[0] = t2.x; Q_[1] = t2.y;                                                       \
      U_[0] = U_[1] = P_[0] = P_[1] = 0.f; C1_ = 0.f;                                   \
    }                                                                                   \
    V_ = B[S2_V + (T_) * 16 + rl];                                                      \
    C2_ = B[S2_C2 + (T_)];                                                              \
  } while (0)
#define S2_STEP(D_, K_, Q_, U_, P_, V_, C1_, C2_, T_)                                   \
  do {                                                                                  \
    float sq = 0.f, sa = 0.f;                                                           \
    _Pragma("unroll") for (int i = 0; i < EPL; i++) sq += s[i] * Q_[i];                 \
    if (MIX != 2) {                                                                     \
      _Pragma("unroll") for (int i = 0; i < EPL; i++) sa += s[i] * U_[i];               \
      sa = red16(sa);                                                                   \
    }                                                                                   \
    sq = red16(sq);                                                                     \
    float y = sq + V_ * C2_;                                                            \
    if (MIX != 2) y += sa * C1_;                                                        \
    _Pragma("unroll") for (int i = 0; i < EPL; i++) {                                   \
      float t = s[i] * D_[i] + V_ * K_[i];                                              \
      if (MIX != 2) t += sa * P_[i];                                                    \
      s[i] = t;                                                                         \
    }                                                                                   \
    yb[(T_) * 16 + rl] = y;                                                             \
  } while (0)
      S2_LOAD(dv, kv, qv, uv, pv, vv, c1v, c2v, tt);
#pragma unroll 1
      for (int st = 0; st < 32; st += 2) {
        const int t1 = tt + dtt;
        S2_LOAD(dn, kn, qn, un, pn, vn, c1n, c2n, t1);
        S2_STEP(dv, kv, qv, uv, pv, vv, c1v, c2v, tt);
        const int t2 = st + 2 < 32 ? t1 + dtt : t1;
        S2_LOAD(dv, kv, qv, uv, pv, vv, c1v, c2v, t2);
        S2_STEP(dn, kn, qn, un, pn, vn, c1n, c2n, t1);
        tt = t2;
      }
#undef S2_LOAD
#undef S2_STEP
    }
    __syncthreads();
  }
}

#define S3_SUB 12800
#define S3_GM 0
#define S3_KVT 9216
#define S3_QB 10240
#define S3_QV 11392
#define S3_VT 11520
#define S3_WC 12544
#define S3_TB S3_QV
#define S3_TM (S3_GM + 3328)
#define S3_QBM (S3_GM + 3072)
#define S3_QKM (S3_GM + 3200)
#define S3_KB (S3_GM + 0)
#define S3_BT (S3_GM + 2048)
#define S3_STB (8 * S3_SUB)
#define S3_END (S3_STB + 4 * 2304)

__device__ __forceinline__ float rlane(float x, int l) { return __int_as_float(__builtin_amdgcn_readlane(__float_as_int(x), l)); }
__device__ __forceinline__ float wave_sum(float x) {
  x = red16(x);
  return (rlane(x, 0) + rlane(x, 16)) + (rlane(x, 32) + rlane(x, 48));
}
__device__ __forceinline__ float clampe(float x) { return fminf(fmaxf(x, -80.f), 80.f); }
__device__ __forceinline__ uint4 pack8(const float (&v)[8]) {
  return make_uint4(pack2(v[0], v[1]), pack2(v[2], v[3]), pack2(v[4], v[5]), pack2(v[6], v[7]));
}
__device__ __forceinline__ bf16x8 ld_frag(const void* p) { return *(const bf16x8*)p; }
__device__ __forceinline__ bf16x8 zfrag() { return bf16x8{0, 0, 0, 0, 0, 0, 0, 0}; }

__device__ __forceinline__ void chunk_geom(int c, int dir, int b, int& seg_row0, int& seg_len, int& t_lo) {
  if (c < 8) { seg_row0 = b * TPB; seg_len = LC; t_lo = dir == 0 ? c * 32 : (LC - 32 - c * 32); }
  else { seg_row0 = b * TPB + LC; seg_len = SEQ; t_lo = dir == 0 ? (c - 8) * 32 : (SEQ - 32 - (c - 8) * 32); }
}
template <int MIX>
__device__ __forceinline__ void fetch_raw(const u16* P, int c, int dir, int b, int h, int pw, int lane, const int (&colv)[4], unsigned (&rawq)[14][2]) {
  int seg_row0, seg_len, t_lo;
  chunk_geom(c, dir, b, seg_row0, seg_len, t_lo);
  const u16* Pseg = P + (size_t)seg_row0 * PST;
  const int t0 = t_lo + pw * 8;
  if (MIX == 0) {
#pragma unroll
    for (int rr = 0; rr < 10; rr++) {
      const int tc = min(max(t0 - 1 + rr, 0), seg_len - 1);
#pragma unroll
      for (int i = 0; i < 2; i++)
        rawq[rr][i] = (unsigned)Pseg[(size_t)tc * PST + PA + colv[2 * i]] | ((unsigned)Pseg[(size_t)tc * PST + PA + colv[2 * i + 1]] << 16);
    }
  } else if (MIX == 1) {
#pragma unroll
    for (int rr = 0; rr < 14; rr++) {
      const int tc = min(max(t0 - 3 + rr, 0), seg_len - 1);
      rawq[rr][0] = (unsigned)Pseg[(size_t)tc * PST + colv[0]] | ((unsigned)Pseg[(size_t)tc * PST + colv[1]] << 16);
      rawq[rr][1] = (rawq[rr][1] & 0xffff0000u) | (unsigned)Pseg[(size_t)tc * PST + colv[2]];
    }
    const u16* pp = Pseg + (size_t)(t0 + (lane & 7)) * PST + PB;
    rawq[0][1] = (rawq[0][1] & 0xffffu) | ((unsigned)pp[768 + dir * 4 + h] << 16);
    rawq[1][1] = (rawq[1][1] & 0xffffu) | ((unsigned)pp[776 + dir * 4 + h] << 16);
  } else {
#pragma unroll
    for (int j = 0; j < 8; j++) {
      const u16* pp = Pseg + (size_t)(t0 + j) * PST;
      rawq[j][0] = (unsigned)pp[colv[0]] | ((unsigned)pp[colv[1]] << 16);
      rawq[j][1] = (unsigned)pp[colv[2]];
    }
  }
}

template <int MIX>
__device__ __forceinline__ void scan3_item(const Params& p, int l, int b, int h, int dir, unsigned char* smb) {
  constexpr int VOFF = (MIX == 2) ? 64 : 128;
  constexpr bool DELTA = (MIX != 2);
  const int tid = TIDX, lane = tid & 63, w = __builtin_amdgcn_readfirstlane(tid >> 6), fr = lane & 15, fq = lane >> 4;
  const bool producer = true;
  const int pw = w & 3, half = w >> 2;
  const u16* P = (const u16*)(p.ws + OFF_BIG);
  u16* YS = (u16*)(p.ws + OFF_YS);
  float* BC = (float*)(p.ws + OFF_BC);
  float* ST = (float*)(smb + w * S3_SUB + S3_GM);
  unsigned char* STBY = smb + w * S3_SUB + S3_GM;
  const f32x4 z4 = f32x4{0.f, 0.f, 0.f, 0.f};
  f32x4 st[4];
#pragma unroll
  for (int i = 0; i < 4; i++) st[i] = z4;

  bf16x8 bw2[4], ba2[4];
  float cw[3][7];
  float muv[4];
  int colv[4];
  float c_w0 = 0.f, c_a0 = 0.f, c_ka = 0.f, c_kk = 0.f, c_rk = 0.f, c_gb = 0.f;
#pragma unroll
  for (int i = 0; i < 4; i++) { bw2[i] = zfrag(); ba2[i] = zfrag(); muv[i] = 0.f; colv[i] = 0; }
  if (producer) {
    if (MIX == 0) {
      {
        float tw[4][8], ta[4][8];
#pragma unroll
        for (int nt = 0; nt < 4; nt++)
#pragma unroll
          for (int jj = 0; jj < 8; jj++) {
            tw[nt][jj] = p.rwkv_w2[((size_t)(l * 2 + dir) * 32 + fq * 8 + jj) * 256 + h * 64 + nt * 16 + fr];
            ta[nt][jj] = p.rwkv_a2[((size_t)(l * 2 + dir) * 32 + fq * 8 + jj) * 256 + h * 64 + nt * 16 + fr];
          }
#pragma unroll
        for (int nt = 0; nt < 4; nt++)
#pragma unroll
          for (int jj = 0; jj < 8; jj++) { bw2[nt][jj] = (short)f2bf(tw[nt][jj]); ba2[nt][jj] = (short)f2bf(ta[nt][jj]); }
      }
      const int jl = h * 64 + lane;
      c_w0 = p.rwkv_w0[(l * 2 + dir) * 256 + jl];
      c_a0 = p.rwkv_a0[(l * 2 + dir) * 256 + jl];
      c_ka = p.rwkv_ka[l * 256 + jl];
      c_kk = p.rwkv_kk[l * 256 + jl];
      c_rk = p.rwkv_rk[l * 256 + jl];
#pragma unroll
      for (int i = 0; i < 4; i++) {
        colv[i] = i < 3 ? i * 256 + h * 64 + lane : (lane < 32 ? 768 + dir * 32 + lane : 832 + dir * 32 + (lane - 32));
        muv[i] = p.rwkv_mu[l * 960 + colv[i]];
      }
    } else if (MIX == 1) {
#pragma unroll
      for (int i = 0; i < 3; i++) {
        colv[i] = PB + i * 256 + h * 64 + lane;
#pragma unroll
        for (int tp = 0; tp < 7; tp++) cw[i][tp] = p.gdn_conv[((size_t)l * 7 + tp) * 768 + i * 256 + h * 64 + lane];
      }
    } else {
      {
        float tg[2][8];
#pragma unroll
        for (int nt = 0; nt < 2; nt++)
#pragma unroll
          for (int jj = 0; jj < 8; jj++) tg[nt][jj] = p.gla_gw2[((size_t)(l * 2 + dir) * 16 + (fq & 1) * 8 + jj) * 128 + h * 32 + nt * 16 + fr];
#pragma unroll
        for (int nt = 0; nt < 2; nt++)
#pragma unroll
          for (int jj = 0; jj < 8; jj++) bw2[nt][jj] = fq < 2 ? (short)f2bf(tg[nt][jj]) : (short)0;
      }
      c_gb = p.gla_gb[(l * 2 + dir) * 128 + h * 32 + (lane & 31)];
      colv[0] = PC + h * 32 + lane;
      if (lane >= 32) colv[0] = PC + 128 + h * 32 + (lane - 32);
      colv[1] = PC + 256 + h * 64 + lane;
      colv[2] = PC + 512 + dir * 16 + (lane & 15);
    }
  }
  __syncthreads();
  unsigned rawq[14][2];
#pragma unroll
  for (int i = 0; i < 14; i++) { rawq[i][0] = 0u; rawq[i][1] = 0u; }
  fetch_raw<MIX>(P, half, dir, b, h, pw, lane, colv, rawq);
#define RAWP(r_, i_) ((u16)((rawq[r_][(i_) >> 1] >> (((i_) & 1) * 16)) & 0xffffu))

  for (int it = 0; it < TPB / 64; it++) {
    {
      {
        const int c = it * 2 + half;
        int seg_row0, seg_len, t_lo;
        chunk_geom(c, dir, b, seg_row0, seg_len, t_lo);
        unsigned char* SB = smb + w * S3_SUB;
        const int t0 = t_lo + pw * 8;
        if (MIX == 0) {
          float raw[10][4];
#pragma unroll
          for (int rr = 0; rr < 10; rr++) {
            const int t = t0 - 1 + rr;
            const float okf = (t >= 0 && t < seg_len) ? 1.f : 0.f;
#pragma unroll
            for (int i = 0; i < 4; i++) raw[rr][i] = bf2f(RAWP(rr, i)) * okf;
          }
#pragma unroll
          for (int j = 0; j < 8; j++)
#pragma unroll
            for (int i = 0; i < 4; i++) {
              float xm = raw[j + 1][i] + (0.5f * (raw[j][i] + raw[j + 2][i]) - raw[j + 1][i]) * muv[i];
              if (i == 3 && lane < 32) xm = tanh_fast(xm);
              ST[j * 256 + lane + 64 * i] = xm;
            }
        } else if (MIX == 1) {
          float raw[14][3];
#pragma unroll
          for (int rr = 0; rr < 14; rr++) {
            const int t = t0 - 3 + rr;
            const float okf = (t >= 0 && t < seg_len) ? 1.f : 0.f;
#pragma unroll
            for (int i = 0; i < 3; i++) raw[rr][i] = bf2f(RAWP(rr, i)) * okf;
          }
#pragma unroll
          for (int j = 0; j < 8; j++)
#pragma unroll
            for (int i = 0; i < 3; i++) {
              float a = 0.f;
#pragma unroll
              for (int tp = 0; tp < 7; tp++) a += raw[j + tp][i] * cw[i][tp];
              ST[j * 256 + lane + 64 * i] = siluf(a);
            }
          if (lane < 8) {
            float bx = bf2f(RAWP(0, 3));
            float ax = bf2f(RAWP(1, 3));
            float ld = -__expf(p.gdn_a_log[(l * 2 + dir) * 4 + h]) * softplusf(ax + p.gdn_dt_bias[(l * 2 + dir) * 4 + h]);
            ST[lane * 256 + 192] = sigm(bx);
            ST[lane * 256 + 193] = ld;
          }
        } else {
          const float qs = lane < 32 ? 0.17677669529663687f : 1.f;
#pragma unroll
          for (int j = 0; j < 8; j++) {
            ST[j * 256 + lane] = bf2f(RAWP(j, 0)) * qs;
            ST[j * 256 + 64 + lane] = bf2f(RAWP(j, 1));
            if (lane < 16) ST[j * 256 + 128 + lane] = bf2f(RAWP(j, 2));
          }
        }
        wave_lds_sync();
        {
          float vv[8];
#pragma unroll
          for (int i = 0; i < 8; i++) vv[i] = ST[(dir ? 7 - i : i) * 256 + VOFF + lane];
          *(uint4*)(SB + S3_VT + lane * 16) = pack8(vv);
        }
        if (MIX == 0) {
          bf16x8 aw, aa;
#pragma unroll
          for (int jj = 0; jj < 8; jj++) {
            aw[jj] = fr < 8 ? (short)f2bf(ST[fr * 256 + 192 + fq * 8 + jj]) : (short)0;
            aa[jj] = fr < 8 ? (short)f2bf(ST[fr * 256 + 224 + fq * 8 + jj]) : (short)0;
          }
          f32x4 accw[4], acca[4];
#pragma unroll
          for (int nt = 0; nt < 4; nt++) {
            accw[nt] = __builtin_amdgcn_mfma_f32_16x16x32_bf16(aw, bw2[nt], z4, 0, 0, 0);
            acca[nt] = __builtin_amdgcn_mfma_f32_16x16x32_bf16(aa, ba2[nt], z4, 0, 0, 0);
          }
          wave_lds_sync();
          if (fq < 2) {
#pragma unroll
            for (int nt = 0; nt < 4; nt++)
#pragma unroll
              for (int r = 0; r < 4; r++) {
                ST[(fq * 4 + r) * 256 + 128 + nt * 16 + fr] = accw[nt][r];
                ST[(fq * 4 + r) * 256 + 192 + nt * 16 + fr] = acca[nt][r];
              }
          }
          wave_lds_sync();
        } else if (MIX == 2) {
          bf16x8 ag;
#pragma unroll
          for (int jj = 0; jj < 8; jj++) ag[jj] = (fr < 8 && fq < 2) ? (short)f2bf(ST[fr * 256 + 128 + fq * 8 + jj]) : (short)0;
          f32x4 accg[2];
#pragma unroll
          for (int nt = 0; nt < 2; nt++) accg[nt] = __builtin_amdgcn_mfma_f32_16x16x32_bf16(ag, bw2[nt], z4, 0, 0, 0);
          if (fq < 2) {
#pragma unroll
            for (int nt = 0; nt < 2; nt++)
#pragma unroll
              for (int r = 0; r < 4; r++) ST[(fq * 4 + r) * 256 + 192 + nt * 16 + fr] = accg[nt][r];
          }
          wave_lds_sync();
        }
        float logd[8], kap[8], bb[8], kp[8], qq[8];
        u16* XA1 = (u16*)(SB + 9216);
        u16* XA2 = (u16*)(SB + 10368);
        const int dlane_r = fr & 3;
        if (MIX == 0) {
          float a8[8];
#pragma unroll
          for (int i = 0; i < 8; i++) {
            const float* row = ST + (dir ? 7 - i : i) * 256;
            const float r_ = row[lane], k_ = row[64 + lane];
            const float sg = sigm(c_w0 + row[128 + lane]);
            a8[i] = sigm(c_a0 + row[192 + lane]);
            kp[i] = k_ * (1.f + (a8[i] - 1.f) * c_ka);
            kap[i] = k_ * c_kk;
            qq[i] = r_;
            logd[i] = -0.6065306597126334f * sg;
            XA1[i * 72 + lane] = f2bf(kap[i]);
          }
          wave_lds_sync();
          f32x4 accS = z4;
#pragma unroll
          for (int ks = 0; ks < 2; ks++) {
            const bf16x8 fx = ld_frag(XA1 + (fr & 7) * 72 + fq * 8 + ks * 32);
            accS = __builtin_amdgcn_mfma_f32_16x16x32_bf16(fx, fx, accS, 0, 0, 0);
          }
          const float dsel = dlane_r == 0 ? accS[0] : (dlane_r == 1 ? accS[1] : (dlane_r == 2 ? accS[2] : accS[3]));
#pragma unroll
          for (int i = 0; i < 8; i++) {
            const float ss = rlane(dsel, (i >> 2) * 16 + i);
            kap[i] *= rsq(ss + 1e-6f);
            bb[i] = kap[i] * a8[i];
          }
        } else if (MIX == 1) {
#pragma unroll
          for (int i = 0; i < 8; i++) {
            const float* row = ST + (dir ? 7 - i : i) * 256;
            qq[i] = row[lane]; kap[i] = row[64 + lane];
            kp[i] = row[192];
            logd[i] = row[193];
            XA1[i * 72 + lane] = f2bf(qq[i]);
            XA2[i * 72 + lane] = f2bf(kap[i]);
          }
          wave_lds_sync();
          f32x4 accSq = z4, accSk = z4;
#pragma unroll
          for (int ks = 0; ks < 2; ks++) {
            const bf16x8 fxq = ld_frag(XA1 + (fr & 7) * 72 + fq * 8 + ks * 32), fxk = ld_frag(XA2 + (fr & 7) * 72 + fq * 8 + ks * 32);
            accSq = __builtin_amdgcn_mfma_f32_16x16x32_bf16(fxq, fxq, accSq, 0, 0, 0);
            accSk = __builtin_amdgcn_mfma_f32_16x16x32_bf16(fxk, fxk, accSk, 0, 0, 0);
          }
          const float dq = dlane_r == 0 ? accSq[0] : (dlane_r == 1 ? accSq[1] : (dlane_r == 2 ? accSq[2] : accSq[3]));
          const float dk = dlane_r == 0 ? accSk[0] : (dlane_r == 1 ? accSk[1] : (dlane_r == 2 ? accSk[2] : accSk[3]));
#pragma unroll
          for (int i = 0; i < 8; i++) {
            const float sq = rlane(dq, (i >> 2) * 16 + i), sk = rlane(dk, (i >> 2) * 16 + i);
            const float beta = kp[i], alpha = __expf(logd[i]);
            const float qn = qq[i] * rsq(sq + 1e-6f) * 0.125f, kn = kap[i] * rsq(sk + 1e-6f);
            kap[i] = kn; bb[i] = alpha * beta * kn; kp[i] = beta * kn; qq[i] = qn;
          }
        } else {
#pragma unroll
          for (int i = 0; i < 8; i++) {
            const float* row = ST + (dir ? 7 - i : i) * 256;
            const int n = lane & 31;
            const float lg = c_gb + row[192 + n];
            const float ls = fminf(lg, 0.f) - __logf(1.f + __expf(-fabsf(lg)));
            logd[i] = ls * (1.f / 16.f);
            kap[i] = 0.f; bb[i] = 0.f;
            kp[i] = lane < 32 ? row[32 + n] : 0.f;
            qq[i] = lane < 32 ? row[n] : 0.f;
          }
        }
        wave_lds_sync();
        float kt[8], qt[8], bck[8], kck[8];
        {
          float L[8];
          float run = 0.f;
#pragma unroll
          for (int i = 0; i < 8; i++) { run += logd[i]; L[i] = run; }
          const float Lr = L[3], L7 = L[7];
          float prevE = __expf(clampe(-Lr)), prevT = 1.f;
          u16* OPA = (u16*)STBY;
#pragma unroll
          for (int i = 0; i < 8; i++) {
            const float eI = __expf(clampe(L[i] - Lr)), eInv = __expf(clampe(Lr - L[i]));
            const float tI = __expf(L[i]), eEnd = __expf(L7 - L[i]);
            if (DELTA) {
              OPA[0 * 576 + i * 72 + lane] = f2bf(kap[i] * prevE);
              OPA[1 * 576 + i * 72 + lane] = f2bf(bb[i] * eInv);
            }
            OPA[2 * 576 + i * 72 + lane] = f2bf(kp[i] * eInv);
            OPA[3 * 576 + i * 72 + lane] = f2bf(qq[i] * eI);
            if (MIX == 0) OPA[4 * 576 + i * 72 + lane] = f2bf(qq[i] * eI * c_rk);
            kt[i] = kap[i] * prevT; qt[i] = qq[i] * tI;
            bck[i] = bb[i] * eEnd; kck[i] = kp[i] * eEnd;
            prevE = eI; prevT = tI;
          }
          *(float*)(SB + S3_WC + lane * 4) = __expf(L7);
        }
        wave_lds_sync();
        f32x4 accA = z4, accBm = z4, accQb = z4, accQk = z4, accBC = z4;
        {
          const u16* OPA = (const u16*)STBY;
          const int ro = (fr & 7) * 72 + fq * 8;
#pragma unroll
          for (int ks = 0; ks < 2; ks++) {
            const bf16x8 fk = ld_frag(OPA + 2 * 576 + ro + ks * 32), fqh = ld_frag(OPA + 3 * 576 + ro + ks * 32);
            accQk = __builtin_amdgcn_mfma_f32_16x16x32_bf16(fqh, fk, accQk, 0, 0, 0);
            if (MIX == 0) accBC = __builtin_amdgcn_mfma_f32_16x16x32_bf16(ld_frag(OPA + 4 * 576 + ro + ks * 32), fk, accBC, 0, 0, 0);
            if (DELTA) {
              const bf16x8 fka = ld_frag(OPA + 0 * 576 + ro + ks * 32), fb = ld_frag(OPA + 1 * 576 + ro + ks * 32);
              accA = __builtin_amdgcn_mfma_f32_16x16x32_bf16(fka, fb, accA, 0, 0, 0);
              accBm = __builtin_amdgcn_mfma_f32_16x16x32_bf16(fka, fk, accBm, 0, 0, 0);
              accQb = __builtin_amdgcn_mfma_f32_16x16x32_bf16(fqh, fb, accQb, 0, 0, 0);
            }
          }
#pragma unroll
          for (int r = 0; r < 4; r++) {
            const int i = fq * 4 + r;
            const bool ok = fq < 2 && fr < 8;
            if (!(ok && fr < i)) { accA[r] = 0.f; accBm[r] = 0.f; }
            if (!(ok && fr <= i)) { accQb[r] = 0.f; accQk[r] = 0.f; }
          }
          if (MIX == 0 && fq < 2 && fr < 8 && (fr >> 2) == fq) {
            const int r = fr & 3;
            const float bcv = r == 0 ? accBC[0] : (r == 1 ? accBC[1] : (r == 2 ? accBC[2] : accBC[3]));
            BC[(size_t)(seg_row0 + t0 + (dir ? 7 - fr : fr)) * 8 + h * 2 + dir] = bcv;
          }
        }
        *(uint4*)(SB + S3_KVT + lane * 16) = pack8(kck);
#pragma unroll
        for (int i = 0; i < 8; i++) ((u16*)(SB + S3_QB))[i * 72 + lane] = f2bf(qt[i]);
        if (fq < 2 && fr < 8) {
#pragma unroll
          for (int r = 0; r < 4; r++) {
            ((u16*)(SB + S3_QKM))[(fq * 4 + r) * 8 + fr] = f2bf(accQk[r]);
            if (DELTA) ((u16*)(SB + S3_QBM))[(fq * 4 + r) * 8 + fr] = f2bf(accQb[r]);
          }
        }
        if (DELTA) {
          float t[8];
#pragma unroll
          for (int i = 0; i < 8; i++) {
            float ti = (lane == i) ? 1.f : 0.f;
#pragma unroll
            for (int m = 0; m < i; m++) ti -= rlane(accA[i & 3], (i >> 2) * 16 + m) * t[m];
            t[i] = ti;
          }
#pragma unroll
          for (int i = 0; i < 8; i++) ((u16*)(SB + S3_KB))[i * 72 + lane] = f2bf(-kt[i]);
          *(uint4*)(SB + S3_BT + lane * 16) = pack8(bck);
          if (fq < 2 && fr < 8) {
#pragma unroll
            for (int r = 0; r < 4; r++) ((u16*)(SB + S3_TB))[(fq * 4 + r) * 8 + fr] = f2bf(-accBm[r]);
          }
          if (lane < 8) {
#pragma unroll
            for (int i = 0; i < 8; i++) ((u16*)(SB + S3_TM))[i * 8 + lane] = f2bf(t[i]);
          }
        }
      }
    }
    fetch_raw<MIX>(P, min(it + 1, TPB / 64 - 1) * 2 + half, dir, b, h, pw, lane, colv, rawq);
    __syncthreads();
    if (w < 4) {
      unsigned char* STB = smb + S3_STB + w * 2304;
#pragma unroll
      for (int kk = 0; kk < 8; kk++) {
        const int cc = it * 2 + (kk >> 2), k = kk & 3;
        int seg_row0, t_lo;
        if (cc < 8) { seg_row0 = b * TPB; t_lo = dir == 0 ? cc * 32 : (LC - 32 - cc * 32); }
        else { seg_row0 = b * TPB + LC; t_lo = dir == 0 ? (cc - 8) * 32 : (SEQ - 32 - (cc - 8) * 32); }
        const int sc = dir ? 3 - k : k;
        const unsigned char* SB = smb + ((kk >> 2) * 4 + sc) * S3_SUB;
        const bf16x8 bs0 = __builtin_bit_cast(bf16x8, u32x4v{pack2(st[0][0], st[0][1]), pack2(st[0][2], st[0][3]), pack2(st[1][0], st[1][1]), pack2(st[1][2], st[1][3])});
        const bf16x8 bs1 = __builtin_bit_cast(bf16x8, u32x4v{pack2(st[2][0], st[2][1]), pack2(st[2][2], st[2][3]), pack2(st[3][0], st[3][1]), pack2(st[3][2], st[3][3])});
#define LDP(BASE_, ROW_, KS_) ([&]() -> bf16x8 {                                                                   \
          const uint2 lo_ = *(const uint2*)((BASE_) + ((ROW_) * 72 + (KS_) * 32 + fq * 4) * 2);                      \
          const uint2 hi_ = *(const uint2*)((BASE_) + ((ROW_) * 72 + (KS_) * 32 + 16 + fq * 4) * 2);                 \
          return __builtin_bit_cast(bf16x8, u32x4v{lo_.x, lo_.y, hi_.x, hi_.y}); }())
        const bf16x8 bv = fq == 0 ? ld_frag(SB + S3_VT + (w * 16 + fr) * 16) : zfrag();
        const bf16x8 aq0 = LDP(SB + S3_QB, (fr & 7), 0), aq1 = LDP(SB + S3_QB, (fr & 7), 1);
        const bf16x8 aqk = fq == 0 ? ld_frag(SB + S3_QKM + (fr & 7) * 16) : zfrag();
        bf16x8 brv = zfrag();
        if (DELTA) {
          const bf16x8 ak0 = LDP(SB + S3_KB, (fr & 7), 0), ak1 = LDP(SB + S3_KB, (fr & 7), 1);
          const bf16x8 atb = fq == 0 ? ld_frag(SB + S3_TB + (fr & 7) * 16) : zfrag();
          f32x4 accR = __builtin_amdgcn_mfma_f32_16x16x32_bf16(ak0, bs0, z4, 0, 0, 0);
          accR = __builtin_amdgcn_mfma_f32_16x16x32_bf16(ak1, bs1, accR, 0, 0, 0);
          accR = __builtin_amdgcn_mfma_f32_16x16x32_bf16(atb, bv, accR, 0, 0, 0);
          {
            const uint2 t2 = *(const uint2*)(SB + S3_TM + (fr & 7) * 16 + (fq & 1) * 8);
            const u32x4v ta4 = {t2.x, t2.y, 0u, 0u};
            const u32x4v rb4 = {pack2(accR[0], accR[1]), pack2(accR[2], accR[3]), 0u, 0u};
            const bf16x8 at = fq < 2 ? __builtin_bit_cast(bf16x8, ta4) : zfrag();
            const bf16x8 br = fq < 2 ? __builtin_bit_cast(bf16x8, rb4) : zfrag();
            accR = __builtin_amdgcn_mfma_f32_16x16x32_bf16(at, br, z4, 0, 0, 0);
          }
          const uint2 vv2 = *(const uint2*)(SB + S3_VT + (w * 16 + fr) * 16 + (fq & 1) * 8);
          const u32x4v t4 = {pack2(accR[0], accR[1]), pack2(accR[2], accR[3]), vv2.x, vv2.y};
          brv = fq < 2 ? __builtin_bit_cast(bf16x8, t4) : zfrag();
        }
        f32x4 accY = __builtin_amdgcn_mfma_f32_16x16x32_bf16(aq0, bs0, z4, 0, 0, 0);
        accY = __builtin_amdgcn_mfma_f32_16x16x32_bf16(aq1, bs1, accY, 0, 0, 0);
        if (DELTA) {
          const uint2 qb2 = *(const uint2*)(SB + S3_QBM + (fr & 7) * 16 + (fq & 1) * 8);
          const uint2 qk2 = *(const uint2*)(SB + S3_QKM + (fr & 7) * 16 + (fq & 1) * 8);
          const u32x4v q4 = {qb2.x, qb2.y, qk2.x, qk2.y};
          const bf16x8 aqm = fq < 2 ? __builtin_bit_cast(bf16x8, q4) : zfrag();
          accY = __builtin_amdgcn_mfma_f32_16x16x32_bf16(aqm, brv, accY, 0, 0, 0);
        } else {
          accY = __builtin_amdgcn_mfma_f32_16x16x32_bf16(aqk, bv, accY, 0, 0, 0);
        }
        if (fq < 2) {
#pragma unroll
          for (int r = 0; r < 4; r++) {
            const int i = fq * 4 + r, j = dir ? 7 - i : i;
            YS[(size_t)(seg_row0 + t_lo + sc * 8 + j) * YST + dir * 768 + MIX * 256 + h * 64 + w * 16 + fr] = f2bf(accY[r]);
          }
        }
#pragma unroll
        for (int nt = 0; nt < 4; nt++) {
          f32x4 an;
          if (DELTA) {
            const uint2 b2 = *(const uint2*)(SB + S3_BT + (nt * 16 + fr) * 16 + (fq & 1) * 8);
            const uint2 k2 = *(const uint2*)(SB + S3_KVT + (nt * 16 + fr) * 16 + (fq & 1) * 8);
            const u32x4v a4 = {b2.x, b2.y, k2.x, k2.y};
            const bf16x8 am = fq < 2 ? __builtin_bit_cast(bf16x8, a4) : zfrag();
            an = __builtin_amdgcn_mfma_f32_16x16x32_bf16(am, brv, z4, 0, 0, 0);
          } else {
            const bf16x8 akv = fq == 0 ? ld_frag(SB + S3_KVT + (nt * 16 + fr) * 16) : zfrag();
            an = __builtin_amdgcn_mfma_f32_16x16x32_bf16(akv, bv, z4, 0, 0, 0);
          }
          const float4 wc = *(const float4*)(SB + S3_WC + (nt * 16 + fq * 4) * 4);
          st[nt][0] = st[nt][0] * wc.x + an[0];
          st[nt][1] = st[nt][1] * wc.y + an[1];
          st[nt][2] = st[nt][2] * wc.z + an[2];
          st[nt][3] = st[nt][3] * wc.w + an[3];
        }
#undef LDP
      }
    }
    __syncthreads();
  }
}

__device__ __forceinline__ void attn_item(const Params& p, int l, int b, int qb, int hk, bool isctx, unsigned char* smem) {
  u16* KS = (u16*)smem;
  u16* VT = KS + 64 * LDT;
  u16* PL = VT + 64 * LDT;
  float2* ROPE = (float2*)(PL + 8 * 32 * LDT);
  const int tid = TIDX, lane = tid & 63, w = tid >> 6, fr = lane & 15, fq = lane >> 4;
  const u16* P = (const u16*)(p.ws + OFF_BIG);
  u16* Y = (u16*)(p.ws + OFF_YS);
  const int qh = hk * 2 + (w >> 2);
  const int tb = qb * 128 + (w & 3) * 32;
  const int qrow0 = b * TPB + (isctx ? 0 : LC);
  __syncthreads();
  for (int i = tid; i < 1024; i += NTHR) {
    int pos = i >> 4, fi = i & 15;
    float inv = powf(10000.f, -(float)fi / 16.f);
    float sn, cs;
    sincosf((float)pos * inv, &sn, &cs);
    ROPE[i] = make_float2(cs, sn);
  }
  __syncthreads();
  bf16x8 qf[2][2];
#pragma unroll
  for (int mi = 0; mi < 2; mi++)
#pragma unroll
    for (int ks = 0; ks < 2; ks++) {
      const int tq = tb + mi * 16 + fr;
      const u16* qp = P + (size_t)(qrow0 + tq) * PST + PD + qh * 64 + ks * 32;
      uint4 own = *(const uint4*)(qp + fq * 8);
      uint4 par = *(const uint4*)(qp + (fq ^ 2) * 8);
      const unsigned ow[4] = {own.x, own.y, own.z, own.w};
      const unsigned pw[4] = {par.x, par.y, par.z, par.w};
      const int pos = ks == 0 ? (tq >> 6) : (tq & 63);
      bf16x8 f;
#pragma unroll
      for (int jj = 0; jj < 8; jj++) {
        float xo = bf2f((u16)((ow[jj >> 1] >> ((jj & 1) * 16)) & 0xffff));
        float xp = bf2f((u16)((pw[jj >> 1] >> ((jj & 1) * 16)) & 0xffff));
        float v = xo;
        if (!isctx) {
          float2 cs = ROPE[pos * 16 + (fq & 1) * 8 + jj];
          v = fq < 2 ? xo * cs.x - xp * cs.y : xp * cs.y + xo * cs.x;
        }
        f[jj] = (short)f2bf(v * 0.125f);
      }
      qf[mi][ks] = f;
    }
  f32x4 oacc[2][4];
#pragma unroll
  for (int mi = 0; mi < 2; mi++)
#pragma unroll
    for (int nd = 0; nd < 4; nd++) oacc[mi][nd] = f32x4{0.f, 0.f, 0.f, 0.f};
  float mrow[2][4], lrow[2][4];
#pragma unroll
  for (int mi = 0; mi < 2; mi++)
#pragma unroll
    for (int r = 0; r < 4; r++) { mrow[mi][r] = -1e30f; lrow[mi][r] = 0.f; }

  const int q0 = qb * 128;
  const int band_lo = isctx ? 0 : max(0, q0 - 128), band_hi = isctx ? 0 : min(SEQ, q0 + 256);
  const int ntile = 4 + (band_hi - band_lo) / 64;
  u16* pl = PL + w * 32 * LDT;
  for (int tl = 0; tl < ntile; tl++) {
    const bool band = tl >= 4;
    const int k0 = band ? band_lo + (tl - 4) * 64 : tl * 64;
    __syncthreads();
    {
      const int key = tid >> 3, kc = tid & 7;
      const int kpos = k0 + key;
      const u16* kp = P + (size_t)(b * TPB + (band ? LC : 0) + kpos) * PST + PD + 256 + hk * 64;
      uint4 own = *(const uint4*)(kp + kc * 8);
      uint4 vv = *(const uint4*)(kp + 128 + kc * 8);
      uint4 par = *(const uint4*)(kp + (kc ^ 2) * 8);
      if (band) {
        const unsigned ow[4] = {own.x, own.y, own.z, own.w};
        const unsigned pw[4] = {par.x, par.y, par.z, par.w};
        const int pos = kc < 4 ? (kpos >> 6) : (kpos & 63);
        unsigned res[4];
#pragma unroll
        for (int jj = 0; jj < 8; jj += 2) {
          float v2[2];
#pragma unroll
          for (int e = 0; e < 2; e++) {
            float xo = bf2f((u16)((ow[jj >> 1] >> (e * 16)) & 0xffff));
            float xp = bf2f((u16)((pw[jj >> 1] >> (e * 16)) & 0xffff));
            float2 cs = ROPE[pos * 16 + (kc & 1) * 8 + jj + e];
            v2[e] = (kc & 2) == 0 ? xo * cs.x - xp * cs.y : xp * cs.y + xo * cs.x;
          }
          res[jj >> 1] = pack2(v2[0], v2[1]);
        }
        own = make_uint4(res[0], res[1], res[2], res[3]);
      }
      *(uint4*)(KS + key * LDT + kc * 8) = own;
      const unsigned vw[4] = {vv.x, vv.y, vv.z, vv.w};
#pragma unroll
      for (int jj = 0; jj < 8; jj++) VT[(kc * 8 + jj) * LDT + key] = (u16)((vw[jj >> 1] >> ((jj & 1) * 16)) & 0xffff);
    }
    __syncthreads();
    f32x4 sc[2][4];
#pragma unroll
    for (int mi = 0; mi < 2; mi++)
#pragma unroll
      for (int nj = 0; nj < 4; nj++) sc[mi][nj] = f32x4{0.f, 0.f, 0.f, 0.f};
#pragma unroll
    for (int ks = 0; ks < 2; ks++) {
      bf16x8 kf[4];
#pragma unroll
      for (int nj = 0; nj < 4; nj++) kf[nj] = *(const bf16x8*)(KS + (nj * 16 + fr) * LDT + ks * 32 + fq * 8);
#pragma unroll
      for (int mi = 0; mi < 2; mi++)
#pragma unroll
        for (int nj = 0; nj < 4; nj++) sc[mi][nj] = __builtin_amdgcn_mfma_f32_16x16x32_bf16(qf[mi][ks], kf[nj], sc[mi][nj], 0, 0, 0);
    }
#pragma unroll
    for (int mi = 0; mi < 2; mi++)
#pragma unroll
      for (int r = 0; r < 4; r++) {
        const int qpos = tb + mi * 16 + fq * 4 + r;
        float mx = -1e30f;
#pragma unroll
        for (int nj = 0; nj < 4; nj++) {
          float v = sc[mi][nj][r];
          if (band) {
            int d = qpos - (k0 + nj * 16 + fr);
            if (d > 128 || d < -128) v = -1e30f;
          }
          sc[mi][nj][r] = v;
          mx = fmaxf(mx, v);
        }
        mx = fmaxf(mx, __shfl_xor(mx, 1));
        mx = fmaxf(mx, __shfl_xor(mx, 2));
        mx = fmaxf(mx, __shfl_xor(mx, 4));
        mx = fmaxf(mx, __shfl_xor(mx, 8));
        const float mnew = fmaxf(mrow[mi][r], mx);
        const float alpha = __expf(mrow[mi][r] - mnew);
        mrow[mi][r] = mnew;
        float ls = 0.f;
#pragma unroll
        for (int nj = 0; nj < 4; nj++) {
          float pe = __expf(sc[mi][nj][r] - mnew);
          ls += pe;
          pl[(mi * 16 + fq * 4 + r) * LDT + nj * 16 + fr] = f2bf(pe);
        }
        lrow[mi][r] = lrow[mi][r] * alpha + ls;
#pragma unroll
        for (int nd = 0; nd < 4; nd++) oacc[mi][nd][r] *= alpha;
      }
    asm volatile("s_waitcnt lgkmcnt(0)" ::: "memory");
    __builtin_amdgcn_wave_barrier();
#pragma unroll
    for (int ks = 0; ks < 2; ks++) {
      bf16x8 pf[2], vf[4];
#pragma unroll
      for (int mi = 0; mi < 2; mi++) pf[mi] = *(const bf16x8*)(pl + (mi * 16 + fr) * LDT + ks * 32 + fq * 8);
#pragma unroll
      for (int nd = 0; nd < 4; nd++) vf[nd] = *(const bf16x8*)(VT + (nd * 16 + fr) * LDT + ks * 32 + fq * 8);
#pragma unroll
      for (int mi = 0; mi < 2; mi++)
#pragma unroll
        for (int nd = 0; nd < 4; nd++) oacc[mi][nd] = __builtin_amdgcn_mfma_f32_16x16x32_bf16(pf[mi], vf[nd], oacc[mi][nd], 0, 0, 0);
    }
    asm volatile("s_waitcnt lgkmcnt(0)" ::: "memory");
    __builtin_amdgcn_wave_barrier();
  }
  const float sink = p.attn_sink[l * 4 + qh];
#pragma unroll
  for (int mi = 0; mi < 2; mi++)
#pragma unroll
    for (int r = 0; r < 4; r++) {
      float ls = lrow[mi][r];
      ls += __shfl_xor(ls, 1);
      ls += __shfl_xor(ls, 2);
      ls += __shfl_xor(ls, 4);
      ls += __shfl_xor(ls, 8);
      ls += __expf(sink - mrow[mi][r]);
      const float inv = 1.f / ls;
      const int tq = tb + mi * 16 + fq * 4 + r;
#pragma unroll
      for (int nd = 0; nd < 4; nd++) Y[(size_t)(qrow0 + tq) * YST + 1536 + qh * 64 + nd * 16 + fr] = f2bf(oacc[mi][nd][r] * inv);
    }
}

#ifndef SCAN3_MASK
#define SCAN3_MASK 7
#endif
__device__ __forceinline__ void phase_mix(const Params& p, int l, unsigned char* smem) {
  float* sm = (float*)smem;
  const int G = gridDim.x;
  for (int it = blockIdx.x; it < 192; it += G) {
    const int mix = it >> 6, rem = it & 63, b = rem >> 3, h = (rem >> 1) & 3, dir = rem & 1;
    if (mix == 0 && (SCAN3_MASK & 1)) scan3_item<0>(p, l, b, h, dir, smem);
    else if (mix == 1 && (SCAN3_MASK & 2)) scan3_item<1>(p, l, b, h, dir, smem);
    else if (mix == 2 && (SCAN3_MASK & 4)) scan3_item<2>(p, l, b, h, dir, smem);
  }
  if (SCAN3_MASK != 7) {
    for (int it = blockIdx.x; it < 768; it += G) {
      const int mix = it >> 8, rem = it & 255, b = rem >> 5, h = (rem >> 3) & 3, dir = (rem >> 2) & 1, rq = rem & 3;
      if (mix == 0 && !(SCAN3_MASK & 1)) scan2_item<0>(p, l, b, h, dir, rq, sm);
      else if (mix == 1 && !(SCAN3_MASK & 2)) scan2_item<1>(p, l, b, h, dir, rq, sm);
      else if (mix == 2 && !(SCAN3_MASK & 4)) scan2_item<2>(p, l, b, h, dir, rq, sm);
    }
  }
  __syncthreads();
  {
    const bool spread = G >= 192;
    const int nconv = spread ? 64 : G, fidx = spread ? (int)blockIdx.x - 128 : (int)blockIdx.x;
    if (fidx >= 0 && fidx < nconv)
      for (int it = 832 + fidx; it < 4480; it += nconv) conv_item(p, l, it, (float*)smem);
    __syncthreads();
  }
  unsigned* ctr = (unsigned*)(p.ws + OFF_CTR) + l * 16;
  volatile int* slot = (volatile int*)(smem + 131072 - 16);
  for (;;) {
    if (TIDX == 0) *slot = (int)atomicAdd(ctr, 1u);
    __syncthreads();
    const int it = *slot;
    __syncthreads();
    if (it >= (l == 0 ? 544 : 512)) break;
    if (it < 512) {
      int b = it >> 6, qb = (it >> 1) & 31, hk = it & 1;
      attn_item(p, l, b, qb, hk, false, smem);
    } else {
      int r = it - 512, b = r >> 2, qb = (r >> 1) & 1, hk = r & 1;
      attn_item(p, l, b, qb, hk, true, smem);
    }
  }
}

#define POST_DECL(PFX) uint2 PFX##ya0, PFX##ya1, PFX##ya2, PFX##yc0, PFX##yc1, PFX##yc2, PFX##vp, PFX##vc, PFX##vn, PFX##gb, PFX##gc; \
  u16 PFX##xp, PFX##xc, PFX##xn; float2 PFX##bc
#define POST_LOAD(PFX, R_)                                                                         \
  do {                                                                                             \
    const int r_ = (R_);                                                                           \
    const int b_ = r_ / TPB, t_ = r_ - b_ * TPB;                                                   \
    const bool hp_ = (t_ != 0) && (t_ != LC), hn_ = (t_ != LC - 1) && (t_ != TPB - 1);            \
    const u16* ys_ = YSc + (size_t)r_ * YST;                                                       \
    const u16* pr_ = Pc + (size_t)r_ * PST;                                                        \
    const u16* pp_ = pr_ - (hp_ ? PST : 0);                                                        \
    const u16* pn_ = pr_ + (hn_ ? PST : 0);                                                        \
    PFX##ya0 = *(const uint2*)(ys_ + j0); PFX##ya1 = *(const uint2*)(ys_ + 256 + j0); PFX##ya2 = *(const uint2*)(ys_ + 512 + j0); \
    PFX##yc0 = *(const uint2*)(ys_ + 768 + j0); PFX##yc1 = *(const uint2*)(ys_ + 1024 + j0); PFX##yc2 = *(const uint2*)(ys_ + 1280 + j0); \
    PFX##vp = *(const uint2*)(pp_ + PA + 512 + j0);                                                \
    PFX##vc = *(const uint2*)(pr_ + PA + 512 + j0);                                                \
    PFX##vn = *(const uint2*)(pn_ + PA + 512 + j0);                                                \
    PFX##gb = *(const uint2*)(pr_ + PB + 784 + j0);                                                \
    PFX##gc = *(const uint2*)(pr_ + PC + 544 + j0);                                                \
    PFX##xp = pp_[PA + 896 + lane]; PFX##xc = pr_[PA + 896 + lane]; PFX##xn = pn_[PA + 896 + lane]; \
    PFX##bc = *(const float2*)(BCc + (size_t)r_ * 8 + (lane >> 4) * 2);                            \
  } while (0)
__device__ __forceinline__ void unpack4(uint2 v, float (&o)[4]) {
  o[0] = __uint_as_float(v.x << 16); o[1] = __uint_as_float(v.x & 0xffff0000u);
  o[2] = __uint_as_float(v.y << 16); o[3] = __uint_as_float(v.y & 0xffff0000u);
}

__device__ __forceinline__ void phase_post(const Params& p, int l, float* g2s) {
  const int lane = TIDX & 63, wv = __builtin_amdgcn_readfirstlane(TIDX >> 6);
  u16* YS = (u16*)(p.ws + OFF_YS);
  const int j0 = lane * 4;
  {
    const float4* src = (const float4*)(p.rwkv_g2 + (size_t)l * 64 * 256);
    for (int i = TIDX; i < 64 * 256 / 4; i += NTHR) ((float4*)g2s)[i] = src[i];
  }
  float mu_v[4], lng[4], lnb[4], ngb[4], ngc[4];
#pragma unroll
  for (int i = 0; i < 4; i++) {
    mu_v[i] = p.rwkv_mu[l * 960 + 512 + j0 + i];
    lng[i] = p.rwkv_ln_g[l * 256 + j0 + i];
    lnb[i] = p.rwkv_ln_b[l * 256 + j0 + i];
    ngb[i] = p.gdn_norm_g[l * 64 + (lane & 15) * 4 + i];
    ngc[i] = p.gla_norm_g[l * 64 + (lane & 15) * 4 + i];
  }
  const float mu_x = p.rwkv_mu[l * 960 + 896 + lane];
  __syncthreads();
  const int stride = gridDim.x * 8;
  int r = blockIdx.x * 8 + wv;
  const u16* Pc = (const u16*)(p.ws + OFF_BIG);
  const u16* YSc = (const u16*)(p.ws + OFF_YS);
  const float* BCc = (const float*)(p.ws + OFF_BC);
  POST_DECL(cur_);
  POST_DECL(nxt_);
  POST_LOAD(cur_, r);
  for (; r < NROWS; r += stride) {
    const int rn = r + stride < NROWS ? r + stride : r;
    POST_LOAD(nxt_, rn);
    const int b = r / TPB, t = r - b * TPB;
    const float pmul = ((t != 0) && (t != LC)) ? 1.f : 0.f, nmul = ((t != LC - 1) && (t != TPB - 1)) ? 1.f : 0.f;
    if (!(l == 1 && t < LC)) {
    float y[3][4];
    {
      float a4[4], c4[4];
      unpack4(cur_ya0, a4); unpack4(cur_yc0, c4);
#pragma unroll
      for (int i = 0; i < 4; i++) y[0][i] = a4[i] + c4[i];
      unpack4(cur_ya1, a4); unpack4(cur_yc1, c4);
#pragma unroll
      for (int i = 0; i < 4; i++) y[1][i] = a4[i] + c4[i];
      unpack4(cur_ya2, a4); unpack4(cur_yc2, c4);
#pragma unroll
      for (int i = 0; i < 4; i++) y[2][i] = a4[i] + c4[i];
    }
    float o[3][4];
    {
      float sum = y[0][0] + y[0][1] + y[0][2] + y[0][3];
      sum = red16(sum);
      const float mean = sum * (1.f / 64.f);
      float vs = 0.f;
#pragma unroll
      for (int i = 0; i < 4; i++) { float d = y[0][i] - mean; vs += d * d; }
      vs = red16(vs);
      const float rstd = rsq(vs * (1.f / 64.f) + 64e-5f);
      const float pv = bf2f(cur_xc), ppv = bf2f(cur_xp) * pmul, pnv = bf2f(cur_xn) * nmul;
      const float sg = sigm(pv + (0.5f * (ppv + pnv) - pv) * mu_x);
      float gate[4] = {0.f, 0.f, 0.f, 0.f};
      const float* g2 = g2s + j0;
#pragma unroll 8
      for (int i = 0; i < 64; i++) {
        const float si = __int_as_float(__builtin_amdgcn_readlane(__float_as_int(sg), i));
        const float4 gw = *(const float4*)(g2 + i * 256);
        gate[0] += si * gw.x; gate[1] += si * gw.y; gate[2] += si * gw.z; gate[3] += si * gw.w;
      }
      const float bcs = cur_bc.x + cur_bc.y;
      float vc4[4], vp4[4], vn4[4];
      unpack4(cur_vc, vc4); unpack4(cur_vp, vp4); unpack4(cur_vn, vn4);
#pragma unroll
      for (int i = 0; i < 4; i++) {
        const float v = vc4[i] + (0.5f * (vp4[i] * pmul + vn4[i] * nmul) - vc4[i]) * mu_v[i];
        const float yn = (y[0][i] - mean) * rstd * lng[i] + lnb[i];
        o[0][i] = (yn + bcs * v) * gate[i];
      }
    }
#pragma unroll
    for (int m = 1; m < 3; m++) {
      float ss = y[m][0] * y[m][0] + y[m][1] * y[m][1] + y[m][2] * y[m][2] + y[m][3] * y[m][3];
      ss = red16(ss);
      const float inv = rsq(ss * (1.f / 64.f) + 1e-6f);
      float g4[4];
      unpack4(m == 1 ? cur_gb : cur_gc, g4);
#pragma unroll
      for (int i = 0; i < 4; i++) o[m][i] = y[m][i] * inv * (m == 1 ? ngb[i] : ngc[i]) * siluf(g4[i]);
    }
    u16* ys = YS + (size_t)r * YST;
#pragma unroll
    for (int m = 0; m < 3; m++) {
      uint2 ov;
      ov.x = pack2(o[m][0], o[m][1]);
      ov.y = pack2(o[m][2], o[m][3]);
      *(uint2*)(ys + m * 256 + j0) = ov;
    }
    }
    cur_ya0 = nxt_ya0; cur_ya1 = nxt_ya1; cur_ya2 = nxt_ya2; cur_yc0 = nxt_yc0; cur_yc1 = nxt_yc1; cur_yc2 = nxt_yc2;
    cur_vp = nxt_vp; cur_vc = nxt_vc; cur_vn = nxt_vn; cur_gb = nxt_gb; cur_gc = nxt_gc;
    cur_xp = nxt_xp; cur_xc = nxt_xc; cur_xn = nxt_xn; cur_bc = nxt_bc;
  }
}

#define XB_TMO      128
#define XB_XCNT(j)  (256  + 64 * (j))
#define XB_XSUB(j)  (1280 + 64 * (j))
#define XB_XGEN(j)  (2304 + 64 * (j))
#define XB_TOP      3328
#define XB_TOPGEN   3392
#define XCD_BAR_WORDS 3456
#define XB_SPIN_CAP (1u << 18)
#define LAS __attribute__((address_space(3)))

__device__ __forceinline__ unsigned xb_ld(unsigned* p)              { return __hip_atomic_load(p, __ATOMIC_RELAXED, __HIP_MEMORY_SCOPE_AGENT); }
__device__ __forceinline__ unsigned xb_add(unsigned* p, unsigned v) { return __hip_atomic_fetch_add(p, v, __ATOMIC_RELAXED, __HIP_MEMORY_SCOPE_AGENT); }
__device__ __forceinline__ unsigned xb_xcc_id() { return (unsigned)__builtin_amdgcn_s_getreg((3 << 11) | 20) & 0xFu; }
#define XB_SPIN(cond, bar) do { unsigned _sp = 0; while (cond) { __builtin_amdgcn_s_sleep(1); \
    if ((++_sp & 255u) == 0u) { if (xb_ld(&(bar)[XB_TMO])) break; if (_sp > XB_SPIN_CAP) { atomicAdd(&(bar)[XB_TMO], 1u); break; } } } } while (0)

struct XcdBarrier {
    unsigned* bar; unsigned x;
    volatile LAS unsigned* st;
};

__device__ __forceinline__ XcdBarrier xcd_barrier_post(unsigned* bar, volatile LAS unsigned* st) {
    XcdBarrier b; b.bar = bar; b.x = xb_xcc_id(); b.st = st;
    if (threadIdx.x == 0) (void)xb_add(&bar[XB_XCNT(b.x)], 1u);
    return b;
}
__device__ __forceinline__ void xcd_barrier_complete(unsigned* bar, unsigned x, unsigned& nloc, unsigned& nx) {
    const unsigned G = gridDim.x * gridDim.y * gridDim.z;
    unsigned sum, cnt, mine, sp = 0u;
    for (;;) {
        sum = 0u; cnt = 0u; mine = 0u;
#pragma unroll
        for (unsigned j = 0; j < 16; ++j) { const unsigned c = xb_ld(&bar[XB_XCNT(j)]); sum += c; cnt += (c > 0u) ? 1u : 0u; mine = (j == x) ? c : mine; }
        if (sum == G) break;
        __builtin_amdgcn_s_sleep(1);
        if ((++sp & 255u) == 0u) { if (xb_ld(&bar[XB_TMO])) break; if (sp > XB_SPIN_CAP) { atomicAdd(&bar[XB_TMO], 1u); break; } }
    }
    nloc = mine > 0u ? mine : 1u; nx = cnt > 0u ? cnt : 1u;
}

__device__ __forceinline__ void xcd_barrier(const XcdBarrier& b) {
    asm volatile("s_waitcnt vmcnt(0)" ::: "memory");
    __syncthreads();
    if (threadIdx.x == 0) {
        unsigned* bar = b.bar;
        __builtin_amdgcn_s_waitcnt(0);
        unsigned nloc = b.st[0], nx = b.st[1];
        if (nloc == 0u) { xcd_barrier_complete(bar, b.x, nloc, nx); b.st[0] = nloc; b.st[1] = nx; }
        const unsigned old = xb_add(&bar[XB_XSUB(b.x)], 1u);
        const unsigned gen = old / nloc;
        if (old + 1u == (gen + 1u) * nloc) {
            __builtin_amdgcn_fence(__ATOMIC_RELEASE, "agent");
            asm volatile("s_waitcnt vmcnt(0)" ::: "memory");
            const unsigned og = xb_add(&bar[XB_TOP], 1u);
            const unsigned tg = og / nx;
            if (og + 1u == (tg + 1u) * nx) xb_add(&bar[XB_TOPGEN], 1u);
            else XB_SPIN(xb_ld(&bar[XB_TOPGEN]) == tg, bar);
            __builtin_amdgcn_fence(__ATOMIC_ACQUIRE, "agent");
            xb_add(&bar[XB_XGEN(b.x)], 1u);
            asm volatile("s_waitcnt vmcnt(0)" ::: "memory");
        } else {
            XB_SPIN(xb_ld(&bar[XB_XGEN(b.x)]) == gen, bar);
            __builtin_amdgcn_fence(__ATOMIC_ACQUIRE, "agent");
            asm volatile("s_waitcnt vmcnt(0)" ::: "memory");
        }
    }
    __syncthreads();
}

#if defined(SKIPS)
#define EN(k) (SKIPS != (k))
#elif !defined(ONLYS)
#define EN(k) 1
#else
#define EN(k) (ONLYS == (k))
#endif
__device__ __forceinline__ void run_phase(const Params& p, int ph, unsigned char* smem) {
  if (ph == 0) { if (EN(10)) phase_init0(p, (float*)smem); return; }
  if (ph == 1) { if (EN(11)) phase_init1(p); return; }
  int l = 0, s = 10;
  if (ph >= 3) { l = (ph - 3) / 10; s = (ph - 3) - l * 10; }
  unsigned char* wl = p.ws + OFF_W;
  PG8_LAS unsigned char* lds = (PG8_LAS unsigned char*)smem;
  pg8::StaticOrder S;
  if (s == 10 || s == 6 || s == 9) {
    if (EN(5)) rowpass(p, l, s == 10 ? 0 : (s == 6 ? 1 : 2));
    if (s == 9 && l == 0) {
      __syncthreads();
      for (int it = blockIdx.x; it < 832; it += gridDim.x) conv_item(p, 1, it, (float*)smem);
    }
  } else if (s == 0 || s == 3 || s == 5 || s == 8) {
    pg8::Gemm g; EpiBf E;
    g.M = NROWS; E.bias = nullptr; E.act = 0;
    if (s == 0) { g.A = (const u16*)(p.ws + OFF_H); g.lda = DM; g.Bt = (const u16*)(wl + OW_IN); g.K = DM; g.N = PST; E.O = (u16*)(p.ws + OFF_BIG); E.ldc = PST; }
    else if (s == 3) {
      g.A = (const u16*)(p.ws + OFF_H); g.lda = DM; g.Bt = (const u16*)(wl + OW_G); g.K = DM; g.N = 4096;
      E.O = (u16*)(p.ws + OFF_BIG); E.ldc = 4096; E.bias = p.gate_b + (size_t)l * 4096; E.act = 1;
    }
    else if (s == 5) { g.A = (const u16*)(p.ws + OFF_H); g.lda = DM; g.Bt = (const u16*)(wl + OW_O); g.K = DM; g.N = DM; E.O = (u16*)(p.ws + OFF_BIG); E.ldc = DM; }
    else { g.A = (const u16*)(p.ws + OFF_BIG); g.lda = FH; g.Bt = (const u16*)(wl + OW_2); g.K = FH; g.N = DM; E.O = (u16*)(p.ws + OFF_YS); E.ldc = DM; }
    if (l == 1 && s != 0) S.init(NBATCH * SEQ, g.N, gridDim.x, blockIdx.x, 1);
    else S.init(g.M, g.N, gridDim.x, blockIdx.x);
    if (EN(0)) pg8::gemm_phase<EpiBf, pg8::StaticOrder, false>(lds, g, S, E, nullptr);
  } else if (s == 4) {
    if (EN(3)) phase_ypart(p, l, smem);
  } else if (s == 1) {
    if (EN(1)) phase_mix(p, l, smem);
  } else if (s == 2) {
    if (EN(2)) phase_post(p, l, (float*)smem);
  } else {
    pg8::Gemm g; EpiSwiglu E;
    g.M = NROWS; g.N = 2 * FH; g.K = DM; g.lda = DM; g.A = (const u16*)(p.ws + OFF_H); g.Bt = (const u16*)(wl + OW_1);
    E.O = (u16*)(p.ws + OFF_BIG);
    if (l == 1) S.init(NBATCH * SEQ, g.N, gridDim.x, blockIdx.x, 1);
    else S.init(g.M, g.N, gridDim.x, blockIdx.x);
    if (EN(6)) pg8::gemm_phase<EpiSwiglu, pg8::StaticOrder, false>(lds, g, S, E, nullptr);
  }
}

__global__ void __launch_bounds__(NTHR) hybrid_flow_mega(Params p, int ph0, int ph1) {
  __shared__ __attribute__((aligned(16))) unsigned char smem[131072];
  __shared__ __attribute__((aligned(16))) unsigned xbw[4];
  cg::grid_group grid = cg::this_grid();
  XcdBarrier xb;
  xb.bar = (unsigned*)(p.ws + OFF_XBAR); xb.x = 0u; xb.st = (volatile LAS unsigned*)xbw;
  for (int ph = ph0; ph < ph1; ph++) {
    run_phase(p, ph, smem);
#ifdef DUPMASK
    {
      int sidx = ph >= 3 ? (ph - 3) % 10 : 12 + ph;
      if ((DUPMASK >> sidx) & 1) { __syncthreads(); run_phase(p, ph, smem); }
    }
#endif
    if (ph + 1 < ph1) {
      if (ph == ph0) {
        grid.sync();
        if (threadIdx.x < 4) xbw[threadIdx.x] = 0u;
        __syncthreads();
        xb = xcd_barrier_post((unsigned*)(p.ws + OFF_XBAR), (volatile LAS unsigned*)xbw);
      } else {
        xcd_barrier(xb);
      }
    }
  }
  if (ph1 - ph0 > 2 && threadIdx.x == 0 && xb_ld(&xb.bar[XB_TMO]) != 0u) p.out[blockIdx.x] = __int_as_float(0x7fc00000);
}

extern "C" void kernel_launch(void* const* d_in, const int* in_sizes, int n_in, void* d_out, int out_size, void* d_ws,
                              size_t ws_size, hipStream_t stream) {
  Params p{};
  const float** pp = (const float**)&p;
  for (int i = 0; i < 32; i++) pp[i] = (const float*)d_in[i];
  p.out = (float*)d_out;
  p.ws = (unsigned char*)d_ws;
  static int grid_blocks = 0;
  if (!grid_blocks) {
    int dev = 0, cus = 0, per_cu = 0;
    hipGetDevice(&dev);
    hipDeviceGetAttribute(&cus, hipDeviceAttributeMultiprocessorCount, dev);
    hipOccupancyMaxActiveBlocksPerMultiprocessor(&per_cu, hybrid_flow_mega, NTHR, 0);
    if (per_cu < 1) per_cu = 1;
    grid_blocks = cus * per_cu;
  }
#ifdef MULTI_LAUNCH
  for (int ph = 0; ph < NPHASE; ph++) {
    hipLaunchKernelGGL(hybrid_flow_mega, dim3(grid_blocks), dim3(NTHR), 0, stream, p, ph, ph + 1);
  }
#else
  int ph0 = 0, ph1 = NPHASE;
  void* args[] = {&p, &ph0, &ph1};
  hipError_t e = hipLaunchCooperativeKernel((void*)hybrid_flow_mega, dim3(grid_blocks), dim3(NTHR), args, 0, stream);
  if (e != hipSuccess) fprintf(stderr, "cooperative launch failed: %s (grid %d)\n", hipGetErrorString(e), grid_blocks);
#endif
}
```
